# Optimizing an MI355X kernel written in HIP

```python
import jax, jax.numpy as jnp
from jax import lax
import numpy as np

D_MODEL = 1024
BATCH = 2
SEQ = 8192
DEPTH = 2
DEC_BATCH = 128
DEC_SEQ = 4
PAST_LEN = 16384
PAGE_SIZE = 128

HEAD_DIM = 64
RWKV_HEADS = 8
RWKV_DIM = RWKV_HEADS * HEAD_DIM
D_DECAY_LORA = 64
D_AAA_LORA = 64
D_GATE_LORA = 128
RWKV_PROJ = 3 * RWKV_DIM + D_DECAY_LORA + D_AAA_LORA + D_GATE_LORA
ATT_Q_HEADS = 8
ATT_KV_HEADS = 2
ATT_GROUP = ATT_Q_HEADS // ATT_KV_HEADS
ATT_DIM = ATT_Q_HEADS * HEAD_DIM
ATT_KV_DIM = ATT_KV_HEADS * HEAD_DIM
WINDOW = 128
BLOCK = 128
IN_PROJ = RWKV_PROJ + ATT_DIM + 2 * ATT_KV_DIM + 2 * D_MODEL
D_FF = 2816
CONV_W = 3
ROPE_THETA = 10000.0
RMS_EPS = 1e-6
GN_EPS = 64e-5

kernel_name = 'rwkv7_swa_sink_gated_hybrid_step'


def rmsnorm(x, g):
    xf = x.astype(jnp.float32)
    y = xf * lax.rsqrt(jnp.mean(xf * xf, axis=-1, keepdims=True) + RMS_EPS)
    return (y * g.astype(jnp.float32)).astype(x.dtype)


def rope(x, pos):
    inv = ROPE_THETA ** (-jnp.arange(0, HEAD_DIM, 2, dtype=jnp.float32) / HEAD_DIM)
    ang = pos.astype(jnp.float32)[:, None] * inv[None, :]
    cos = jnp.cos(ang)[None, :, None, :]
    sin = jnp.sin(ang)[None, :, None, :]
    xf = x.astype(jnp.float32)
    x1, x2 = xf[..., :HEAD_DIM // 2], xf[..., HEAD_DIM // 2:]
    return jnp.concatenate([x1 * cos - x2 * sin, x2 * cos + x1 * sin], axis=-1).astype(x.dtype)


def rwkv_branch(z, shift_prev, wkv0, mu, w0, w2, a0, a2, g2, k_k, k_a, r_k, ln_g, ln_b):
    B, T, _ = z.shape
    f32 = jnp.float32
    z_prev = jnp.concatenate([shift_prev[:, None].astype(z.dtype), z[:, :-1]], axis=1)
    zs = z + mu * (z_prev - z)
    cuts = [RWKV_DIM, 2 * RWKV_DIM, 3 * RWKV_DIM, 3 * RWKV_DIM + D_DECAY_LORA,
            3 * RWKV_DIM + D_DECAY_LORA + D_AAA_LORA]
    r, k, v, zw, za, zg = jnp.split(zs, cuts, axis=-1)
    w_log = -jax.nn.softplus(-(w0 + jnp.tanh(zw) @ w2).astype(f32)) - 0.5
    decay = jnp.exp(-jnp.exp(w_log))
    a = jax.nn.sigmoid((a0 + za @ a2).astype(f32))
    g = jax.nn.sigmoid(zg) @ g2
    hs = lambda t: t.reshape(B, T, RWKV_HEADS, HEAD_DIM)
    kk = hs(k.astype(f32) * k_k)
    kk = kk / jnp.maximum(jnp.linalg.norm(kk, axis=-1, keepdims=True), 1e-12)
    kf = hs(k.astype(f32) * (1.0 + (a - 1.0) * k_a))
    rf, vf, a_h, w_h = hs(r.astype(f32)), hs(v.astype(f32)), hs(a), hs(decay)

    def step(S, inp):
        r_t, w_t, k_t, v_t, kk_t, a_t = inp
        sk = jnp.einsum('bhvk,bhk->bhv', S, kk_t)
        S = (S * w_t[:, :, None, :]
             - sk[..., None] * (kk_t * a_t)[:, :, None, :]
             + v_t[..., None] * k_t[:, :, None, :])
        return S, jnp.einsum('bhvk,bhk->bhv', S, r_t)

    tm = lambda t: jnp.swapaxes(t, 0, 1)
    S_T, y = lax.scan(step, wkv0.astype(f32), (tm(rf), tm(w_h), tm(kf), tm(vf), tm(kk), tm(a_h)))
    y = tm(y)
    y_mu = jnp.mean(y, axis=-1, keepdims=True)
    y_var = jnp.mean(jnp.square(y - y_mu), axis=-1, keepdims=True)
    yn = ((y - y_mu) * lax.rsqrt(y_var + GN_EPS)).reshape(B, T, RWKV_DIM) * ln_g + ln_b
    bonus = (jnp.sum(rf * kf * r_k, axis=-1, keepdims=True) * vf).reshape(B, T, RWKV_DIM)
    out = ((yn + bonus) * g.astype(f32)).astype(z.dtype)
    return out, z[:, -1], S_T.astype(z.dtype)


def sink_attention(q, k, v, mask, sinks):
    s = jnp.einsum('bnqkgd,bnskd->bnkgqs', q, k, preferred_element_type=jnp.float32) * (HEAD_DIM ** -0.5)
    s = jnp.where(mask[None, :, None, None], s, -jnp.inf)
    sink = sinks.astype(jnp.float32).reshape(1, 1, ATT_KV_HEADS, ATT_GROUP, 1, 1)
    m = jnp.maximum(jnp.max(s, axis=-1, keepdims=True), sink)
    e = jnp.exp(s - m)
    p = e / (jnp.sum(e, axis=-1, keepdims=True) + jnp.exp(sink - m))
    return jnp.einsum('bnkgqs,bnskd->bnqkgd', p.astype(v.dtype), v)


def swa_prompt(q, k, v, sinks):
    B, T = q.shape[:2]
    nb = T // BLOCK
    qb = q.reshape(B, nb, BLOCK, ATT_KV_HEADS, ATT_GROUP, HEAD_DIM)

    def band(t):
        tb = t.reshape(B, nb, BLOCK, ATT_KV_HEADS, HEAD_DIM)
        prev = jnp.concatenate([jnp.zeros_like(tb[:, :1]), tb[:, :-1]], axis=1)
        return jnp.concatenate([prev, tb], axis=2)

    i = jnp.arange(BLOCK)[:, None]
    j = jnp.arange(2 * BLOCK)[None, :]
    diff = BLOCK + i - j
    band_ok = (diff >= 0) & (diff < WINDOW)
    kpos = (jnp.arange(nb)[:, None, None] - 1) * BLOCK + j[None]
    mask = band_ok[None] & (kpos >= 0)
    o = sink_attention(qb, band(k), band(v), mask, sinks)
    return o.reshape(B, T, ATT_DIM)


def swa_sample(q, k, v, k_cache, v_cache, sinks):
    B, T = q.shape[:2]
    k_all = jnp.concatenate([k_cache.astype(k.dtype), k], axis=1)
    v_all = jnp.concatenate([v_cache.astype(v.dtype), v], axis=1)
    i = jnp.arange(T)[:, None]
    j = jnp.arange(WINDOW + T)[None, :]
    diff = WINDOW + i - j
    mask = ((diff >= 0) & (diff < WINDOW))[None]
    o = sink_attention(q.reshape(B, 1, T, ATT_KV_HEADS, ATT_GROUP, HEAD_DIM),
                       k_all[:, None], v_all[:, None], mask, sinks)
    return o.reshape(B, T, ATT_DIM), k_all[:, -WINDOW:], v_all[:, -WINDOW:]


def conv_ffn(h, conv_prev, w_in, conv_w, conv_b, w_down):
    T = h.shape[1]
    c, up = jnp.split(h @ w_in, 2, axis=-1)
    c_ext = jnp.concatenate([conv_prev.astype(c.dtype), c], axis=1)
    conv = conv_b
    for j in range(CONV_W):
        conv = conv + c_ext[:, j:j + T] * conv_w[j]
    a = jax.nn.gelu(conv, approximate=False) * up
    return a @ w_down, c_ext[:, -(CONV_W - 1):]


def layer(x, pos, shift_prev, wkv0, k_cache, v_cache, conv_prev, P):
    B, T, _ = x.shape
    h = rmsnorm(x, P['norm_mix_g'])
    zin = h @ P['w_in']
    cuts = [RWKV_PROJ, RWKV_PROJ + ATT_DIM, RWKV_PROJ + ATT_DIM + ATT_KV_DIM,
            RWKV_PROJ + ATT_DIM + 2 * ATT_KV_DIM, RWKV_PROJ + ATT_DIM + 2 * ATT_KV_DIM + D_MODEL]
    z_rwkv, q, k, v, g_r, g_a = jnp.split(zin, cuts, axis=-1)
    o_r, shift_new, wkv_new = rwkv_branch(
        z_rwkv, shift_prev, wkv0, P['rwkv_mu'], P['rwkv_w0'], P['rwkv_w2'], P['rwkv_a0'], P['rwkv_a2'],
        P['rwkv_g2'], P['rwkv_k_k'], P['rwkv_k_a'], P['rwkv_r_k'], P['rwkv_ln_g'], P['rwkv_ln_b'])
    q = rope(q.reshape(B, T, ATT_Q_HEADS, HEAD_DIM), pos)
    k = rope(k.reshape(B, T, ATT_KV_HEADS, HEAD_DIM), pos)
    v = v.reshape(B, T, ATT_KV_HEADS, HEAD_DIM)
    if k_cache is None:
        o_a = swa_prompt(q, k, v, P['attn_sinks'])
        k_new, v_new = k[:, -WINDOW:], v[:, -WINDOW:]
    else:
        o_a, k_new, v_new = swa_sample(q, k, v, k_cache, v_cache, P['attn_sinks'])
    merged = (jax.nn.sigmoid(g_r) * (o_r @ P['w_br_rwkv'])
              + jax.nn.sigmoid(g_a) * (o_a @ P['w_br_attn']))
    x = x + merged @ P['w_out']
    f, conv_new = conv_ffn(rmsnorm(x, P['norm_ffn_g']), conv_prev, P['ffn_w_in'],
                           P['ffn_conv_w'], P['ffn_conv_b'], P['ffn_w_down'])
    x = x + f
    return x, (shift_new, wkv_new, k_new, v_new, conv_new)


def setup_inputs(seed: int = 0) -> dict:
    key = jax.random.key(seed)
    ks = jax.random.split(key, 32)
    f32 = jnp.float32
    nrm = lambda i, shape, scale: jax.random.normal(ks[i], shape, f32) * scale
    L = DEPTH
    return {
        'x_prompt': nrm(0, (BATCH, SEQ, D_MODEL), 1.0),
        'x_sample': nrm(1, (DEC_BATCH, DEC_SEQ, D_MODEL), 1.0),
        'state_rwkv_shift': nrm(2, (L, DEC_BATCH, RWKV_PROJ), 1.0),
        'state_rwkv_wkv': nrm(3, (L, DEC_BATCH, RWKV_HEADS, HEAD_DIM, HEAD_DIM), 0.5),
        'cache_swa_k': nrm(4, (L, DEC_BATCH, WINDOW, ATT_KV_HEADS, HEAD_DIM), 1.0),
        'cache_swa_v': nrm(5, (L, DEC_BATCH, WINDOW, ATT_KV_HEADS, HEAD_DIM), 1.0),
        'state_ffn_conv': nrm(6, (L, DEC_BATCH, CONV_W - 1, D_FF), 1.0),
        'norm_mix_g': 1.0 + nrm(7, (L, D_MODEL), 0.02),
        'w_in': nrm(8, (L, D_MODEL, IN_PROJ), D_MODEL ** -0.5),
        'rwkv_mu': jax.random.uniform(ks[9], (L, RWKV_PROJ), f32),
        'rwkv_w0': jax.random.uniform(ks[10], (L, RWKV_DIM), f32, minval=-6.0, maxval=-1.0),
        'rwkv_w2': nrm(11, (L, D_DECAY_LORA, RWKV_DIM), 0.5 * D_DECAY_LORA ** -0.5),
        'rwkv_a0': nrm(12, (L, RWKV_DIM), 0.1),
        'rwkv_a2': nrm(13, (L, D_AAA_LORA, RWKV_DIM), 0.5 * D_AAA_LORA ** -0.5),
        'rwkv_g2': nrm(14, (L, D_GATE_LORA, RWKV_DIM), D_GATE_LORA ** -0.5),
        'rwkv_k_k': 0.85 + nrm(15, (L, RWKV_DIM), 0.02),
        'rwkv_k_a': 1.0 + nrm(16, (L, RWKV_DIM), 0.02),
        'rwkv_r_k': nrm(17, (L, RWKV_HEADS, HEAD_DIM), 0.1),
        'rwkv_ln_g': 1.0 + nrm(18, (L, RWKV_DIM), 0.02),
        'rwkv_ln_b': nrm(19, (L, RWKV_DIM), 0.01),
        'attn_sinks': nrm(20, (L, ATT_Q_HEADS), 0.5),
        'w_br_rwkv': nrm(21, (L, RWKV_DIM, D_MODEL), RWKV_DIM ** -0.5),
        'w_br_attn': nrm(22, (L, ATT_DIM, D_MODEL), ATT_DIM ** -0.5),
        'w_out': nrm(23, (L, D_MODEL, D_MODEL), D_MODEL ** -0.5),
        'norm_ffn_g': 1.0 + nrm(24, (L, D_MODEL), 0.02),
        'ffn_w_in': nrm(25, (L, D_MODEL, 2 * D_FF), D_MODEL ** -0.5),
        'ffn_conv_w': nrm(26, (L, CONV_W, D_FF), CONV_W ** -0.5),
        'ffn_conv_b': nrm(27, (L, D_FF), 0.01),
        'ffn_w_down': nrm(28, (L, D_FF, D_MODEL), D_FF ** -0.5),
        'norm_final_g': 1.0 + nrm(29, (D_MODEL,), 0.02),
    }


def reference(x_prompt, x_sample, state_rwkv_shift, state_rwkv_wkv, cache_swa_k, cache_swa_v,
              state_ffn_conv, norm_mix_g, w_in, rwkv_mu, rwkv_w0, rwkv_w2, rwkv_a0, rwkv_a2, rwkv_g2,
              rwkv_k_k, rwkv_k_a, rwkv_r_k, rwkv_ln_g, rwkv_ln_b, attn_sinks, w_br_rwkv, w_br_attn,
              w_out, norm_ffn_g, ffn_w_in, ffn_conv_w, ffn_conv_b, ffn_w_down, norm_final_g):
    Bp, Tp, _ = x_prompt.shape
    pos_p = jnp.arange(Tp, dtype=jnp.int32)
    pos_s = PAST_LEN + jnp.arange(x_sample.shape[1], dtype=jnp.int32)
    xp, xs = x_prompt, x_sample
    outs_p, outs_s = [], []
    for l in range(DEPTH):
        P = {
            'norm_mix_g': norm_mix_g[l], 'w_in': w_in[l], 'rwkv_mu': rwkv_mu[l],
            'rwkv_w0': rwkv_w0[l], 'rwkv_w2': rwkv_w2[l], 'rwkv_a0': rwkv_a0[l], 'rwkv_a2': rwkv_a2[l],
            'rwkv_g2': rwkv_g2[l], 'rwkv_k_k': rwkv_k_k[l], 'rwkv_k_a': rwkv_k_a[l],
            'rwkv_r_k': rwkv_r_k[l], 'rwkv_ln_g': rwkv_ln_g[l], 'rwkv_ln_b': rwkv_ln_b[l],
            'attn_sinks': attn_sinks[l], 'w_br_rwkv': w_br_rwkv[l], 'w_br_attn': w_br_attn[l],
            'w_out': w_out[l], 'norm_ffn_g': norm_ffn_g[l], 'ffn_w_in': ffn_w_in[l],
            'ffn_conv_w': ffn_conv_w[l], 'ffn_conv_b': ffn_conv_b[l], 'ffn_w_down': ffn_w_down[l],
        }
        xp, sp = layer(xp, pos_p,
                       jnp.zeros((Bp, RWKV_PROJ), xp.dtype),
                       jnp.zeros((Bp, RWKV_HEADS, HEAD_DIM, HEAD_DIM), jnp.float32),
                       None, None,
                       jnp.zeros((Bp, CONV_W - 1, D_FF), xp.dtype), P)
        xs, ss = layer(xs, pos_s, state_rwkv_shift[l], state_rwkv_wkv[l], cache_swa_k[l],
                       cache_swa_v[l], state_ffn_conv[l], P)
        outs_p.append(sp)
        outs_s.append(ss)
    y_prompt = rmsnorm(xp, norm_final_g)
    y_sample = rmsnorm(xs, norm_final_g)
    p_shift = jnp.stack([o[0] for o in outs_p])
    p_wkv = jnp.stack([o[1] for o in outs_p])
    p_k = jnp.stack([o[2] for o in outs_p])
    p_v = jnp.stack([o[3] for o in outs_p])
    p_conv = jnp.stack([o[4] for o in outs_p])
    s_shift = jnp.stack([o[0] for o in outs_s])
    s_wkv = jnp.stack([o[1] for o in outs_s])
    s_k = jnp.stack([o[2] for o in outs_s])
    s_v = jnp.stack([o[3] for o in outs_s])
    s_conv = jnp.stack([o[4] for o in outs_s])
    return (y_prompt, y_sample, p_shift, p_wkv, p_k, p_v, p_conv, s_shift, s_wkv, s_k, s_v, s_conv)
```

```cpp
#include <hip/hip_runtime.h>
#include <hip/hip_bf16.h>
#include <hip/hip_cooperative_groups.h>
#include <cstdio>
namespace cg = cooperative_groups;

typedef __attribute__((ext_vector_type(8))) short bf16x8;
typedef __attribute__((ext_vector_type(16))) float f32x16;
typedef unsigned short u16;

#ifndef PHMASK
#define PHMASK 0xFFF
#endif
#ifndef T3
#define T3 7
#endif
#ifndef COOP
#define COOP 0
#endif

#define NT 512
#define M_TOT 16896
#define M_P 16384
#define ZLD 2560
#define NPH 23

#define WS_WT   0ull
#define WS_RSTD 30932992ull
#define WS_Z    31000576ull
#define WS_R    117508096ull
#define WS_P    (WS_R)
#define WS_Q    (WS_R + 33554432ull)
#define WS_W2   (WS_R + 67108864ull)
#define WS_YL   (WS_R + 83886080ull)
#define WS_BO   (WS_R + 100663296ull)
#define WS_GA   (WS_R + 117440512ull)
#define WT_IN  0
#define WT_BRA 4718592
#define WT_BRB 5242880
#define WT_OUT 5767168
#define WT_FIN 6815744
#define WT_FDN 12582912
#define O_PSHIFT 17301504
#define O_PWKV   17308672
#define O_PK     17439744
#define O_PV     17505280
#define O_PCONV  17570816
#define O_SSHIFT 17593344
#define O_SWKV   18052096
#define O_SK     26440704
#define O_SV     30635008
#define O_SCONV  34829312

#define LDS_BYTES 151552

struct Params {
  const float* in[30];
  float* out;
  unsigned char* ws;
  int ph_lo, ph_hi;
};

__device__ __forceinline__ u16 f2bf(float f) {
  unsigned u = __float_as_uint(f);
  u += 0x7FFFu + ((u >> 16) & 1u);
  return (u16)(u >> 16);
}
__device__ __forceinline__ float bf2f(u16 h) { return __uint_as_float(((unsigned)h) << 16); }
__device__ __forceinline__ unsigned pack2(float a, float b) { return (unsigned)f2bf(a) | ((unsigned)f2bf(b) << 16); }
__device__ __forceinline__ float sigm(float x) { return __builtin_amdgcn_rcpf(1.f + __expf(-x)); }
__device__ __forceinline__ void unpack8(uint4 u, float* o) {
  o[0] = __uint_as_float(u.x << 16); o[1] = __uint_as_float(u.x & 0xFFFF0000u);
  o[2] = __uint_as_float(u.y << 16); o[3] = __uint_as_float(u.y & 0xFFFF0000u);
  o[4] = __uint_as_float(u.z << 16); o[5] = __uint_as_float(u.z & 0xFFFF0000u);
  o[6] = __uint_as_float(u.w << 16); o[7] = __uint_as_float(u.w & 0xFFFF0000u);
}
__device__ __forceinline__ uint4 pack8(const float* f) {
  uint4 u; u.x = pack2(f[0], f[1]); u.y = pack2(f[2], f[3]); u.z = pack2(f[4], f[5]); u.w = pack2(f[6], f[7]); return u;
}
__device__ __forceinline__ int opq(int x) { asm volatile("" : "+v"(x)); return x; }
__device__ __forceinline__ float wave_sum(float x) {
#pragma unroll
  for (int o = 32; o >= 1; o >>= 1) x += __shfl_xor(x, o, 64);
  return x;
}

template <bool AF32>
__device__ __forceinline__ void gemm_loop(const void* __restrict__ Ap, int lda, const u16* __restrict__ Bp, int ldb, int K,
                                          f32x16 (&acc)[2][2], u16* lds, int tid) {
  const int lane = tid & 63, wave = tid >> 6;
  const int wm = wave >> 1, wn = wave & 1, r = lane & 31, h = lane >> 5;
  constexpr int A_SZ = 256 * 40, B_SZ = 128 * 40, STAGE = A_SZ + B_SZ;
  const int arow = tid >> 1, ahalf = tid & 1;
  const int brow = tid >> 2, bq = tid & 3;
  float4 fa0, fa1, fa2, fa3;
  uint4 ra0, ra1, rb;
  const float* apf = (const float*)Ap + (size_t)arow * lda + ahalf * 16;
  const u16* aph = (const u16*)Ap + (size_t)arow * lda + ahalf * 16;
  const u16* bp = Bp + (size_t)brow * ldb + bq * 8;
  auto gload = [&](int k0) {
    if (AF32) {
      fa0 = *(const float4*)(apf + k0); fa1 = *(const float4*)(apf + k0 + 4);
      fa2 = *(const float4*)(apf + k0 + 8); fa3 = *(const float4*)(apf + k0 + 12);
    } else {
      ra0 = *(const uint4*)(aph + k0); ra1 = *(const uint4*)(aph + k0 + 8);
    }
    rb = *(const uint4*)(bp + k0);
  };
  auto lstore = [&](int s) {
    u16* A_s = lds + s * STAGE; u16* B_s = A_s + A_SZ;
    if (AF32) {
      ra0.x = pack2(fa0.x, fa0.y); ra0.y = pack2(fa0.z, fa0.w); ra0.z = pack2(fa1.x, fa1.y); ra0.w = pack2(fa1.z, fa1.w);
      ra1.x = pack2(fa2.x, fa2.y); ra1.y = pack2(fa2.z, fa2.w); ra1.z = pack2(fa3.x, fa3.y); ra1.w = pack2(fa3.z, fa3.w);
    }
    *(uint4*)(A_s + arow * 40 + ahalf * 16) = ra0;
    *(uint4*)(A_s + arow * 40 + ahalf * 16 + 8) = ra1;
    *(uint4*)(B_s + brow * 40 + bq * 8) = rb;
  };
  __syncthreads();
  gload(0); lstore(0);
  __syncthreads();
  const int nk = K >> 5;
  for (int kt = 0; kt < nk; ++kt) {
    const int cur = kt & 1;
    if (kt + 1 < nk) gload((kt + 1) << 5);
    const u16* A_s = lds + cur * STAGE; const u16* B_s = A_s + A_SZ;
#pragma unroll
    for (int s = 0; s < 2; ++s) {
      bf16x8 a0 = *(const bf16x8*)(A_s + (wm * 64 + r) * 40 + s * 16 + h * 8);
      bf16x8 a1 = *(const bf16x8*)(A_s + (wm * 64 + 32 + r) * 40 + s * 16 + h * 8);
      bf16x8 b0 = *(const bf16x8*)(B_s + (wn * 64 + r) * 40 + s * 16 + h * 8);
      bf16x8 b1 = *(const bf16x8*)(B_s + (wn * 64 + 32 + r) * 40 + s * 16 + h * 8);
      acc[0][0] = __builtin_amdgcn_mfma_f32_32x32x16_bf16(a0, b0, acc[0][0], 0, 0, 0);
      acc[0][1] = __builtin_amdgcn_mfma_f32_32x32x16_bf16(a0, b1, acc[0][1], 0, 0, 0);
      acc[1][0] = __builtin_amdgcn_mfma_f32_32x32x16_bf16(a1, b0, acc[1][0], 0, 0, 0);
      acc[1][1] = __builtin_amdgcn_mfma_f32_32x32x16_bf16(a1, b1, acc[1][1], 0, 0, 0);
    }
    if (kt + 1 < nk) lstore(cur ^ 1);
    __syncthreads();
  }
}
__device__ __forceinline__ void zero_acc(f32x16 (&acc)[2][2]) {
#pragma unroll
  for (int a = 0; a < 2; ++a)
#pragma unroll
    for (int b = 0; b < 2; ++b)
#pragma unroll
      for (int i = 0; i < 16; ++i) acc[a][b][i] = 0.f;
}
#define ROWOFF(reg, h) (((reg) & 3) + 8 * ((reg) >> 2) + 4 * (h))

__device__ void conv_tile(const float* __restrict__ src, int K, int N, u16* __restrict__ dst, const float* __restrict__ g,
                          int tile, float* lds) {
  const int tn_cnt = N >> 6;
  const int tk = tile / tn_cnt, tn = tile - tk * tn_cnt;
  const int k0 = tk << 6, n0 = tn << 6;
  const int tid = opq(threadIdx.x);
  __syncthreads();
  {
    const int k = tid >> 3, c = (tid & 7) * 8;
    const float* s = src + (size_t)(k0 + k) * N + n0 + c;
    float4 a = *(const float4*)s, b = *(const float4*)(s + 4);
    const float gs = g ? g[k0 + k] : 1.f;
    float* d = lds + k * 65 + c;
    d[0] = a.x * gs; d[1] = a.y * gs; d[2] = a.z * gs; d[3] = a.w * gs;
    d[4] = b.x * gs; d[5] = b.y * gs; d[6] = b.z * gs; d[7] = b.w * gs;
  }
  __syncthreads();
  {
    const int n = tid >> 3, kk = (tid & 7) * 8;
    float f[8];
#pragma unroll
    for (int i = 0; i < 8; ++i) f[i] = lds[(kk + i) * 65 + n];
    *(uint4*)(dst + (size_t)(n0 + n) * K + k0 + kk) = pack8(f);
  }
}

__device__ void phase_prep(const Params& p, int l, bool first_norm, float* ldsf) {
  u16* Wt = (u16*)(p.ws + WS_WT);
  float* rstd = (float*)(p.ws + WS_RSTD);
  float* X = p.out;
  const int nconv = first_norm ? 3776 : 0;
  const int ntot = nconv + 2112;
  for (int it = blockIdx.x; it < ntot; it += gridDim.x) {
    if (it < nconv) {
      int t = it;
      if (t < 1152) conv_tile(p.in[8] + (size_t)l * 1024 * 4608, 1024, 4608, Wt + WT_IN, p.in[7] + l * 1024, t, ldsf);
      else if ((t -= 1152) < 128) conv_tile(p.in[21] + (size_t)l * 512 * 1024, 512, 1024, Wt + WT_BRA, nullptr, t, ldsf);
      else if ((t -= 128) < 128) conv_tile(p.in[22] + (size_t)l * 512 * 1024, 512, 1024, Wt + WT_BRB, nullptr, t, ldsf);
      else if ((t -= 128) < 256) conv_tile(p.in[23] + (size_t)l * 1024 * 1024, 1024, 1024, Wt + WT_OUT, nullptr, t, ldsf);
      else if ((t -= 256) < 1408) conv_tile(p.in[25] + (size_t)l * 1024 * 5632, 1024, 5632, Wt + WT_FIN, p.in[24] + l * 1024, t, ldsf);
      else { t -= 1408; conv_tile(p.in[28] + (size_t)l * 2816 * 1024, 2816, 1024, Wt + WT_FDN, nullptr, t, ldsf); }
    } else {
      const int tid = opq(threadIdx.x);
      const int row = (it - nconv) * 8 + (tid >> 6);
      const int lane = tid & 63;
      const float* src;
      if (first_norm && l == 0) src = (row < M_P) ? p.in[0] + (size_t)row * 1024 : p.in[1] + (size_t)(row - M_P) * 1024;
      else src = X + (size_t)row * 1024;
      float ss = 0.f;
#pragma unroll
      for (int i = 0; i < 4; ++i) {
        float4 v = *(const float4*)(src + i * 256 + lane * 4);
        ss += v.x * v.x + v.y * v.y + v.z * v.z + v.w * v.w;
        if (first_norm && l == 0) *(float4*)(X + (size_t)row * 1024 + i * 256 + lane * 4) = v;
      }
      ss = wave_sum(ss);
      if (lane == 0) rstd[row] = rsqrtf(ss * (1.f / 1024.f) + 1e-6f);
    }
  }
}

__device__ void phase_inproj(const Params& p, int l, u16* lds) {
  const u16* Wt = (const u16*)(p.ws + WS_WT) + WT_IN;
  const float* rstd = (const float*)(p.ws + WS_RSTD);
  u16* z = (u16*)(p.ws + WS_Z);
  const float* X = p.out;
  float* out = p.out;
  for (int it = blockIdx.x; it < 66 * 20; it += gridDim.x) {
    const int tid = opq(threadIdx.x), lane = tid & 63, wave = tid >> 6;
    const int wm = wave >> 1, wn = wave & 1, r = lane & 31, h = lane >> 5;
    const float inv = __expf(-(float)r * (9.210340371976184f / 32.f));
    const int tn = it % 20, tm = it / 20;
    const int m0 = tm * 256, n0 = tn * 128;
    f32x16 acc[2][2];
    zero_acc(acc);
    gemm_loop<true>(X + (size_t)m0 * 1024, 1024, Wt + (size_t)n0 * 1024, 1024, 1024, acc, lds, tid);
    const int c0 = n0 + wn * 64;
#pragma unroll
    for (int mi = 0; mi < 2; ++mi) {
#pragma unroll
      for (int reg = 0; reg < 16; ++reg) {
        const int row = m0 + wm * 64 + mi * 32 + ROWOFF(reg, h);
        const float rs = rstd[row];
        float v0 = acc[mi][0][reg] * rs, v1 = acc[mi][1][reg] * rs;
        int b, t, pos;
        const bool prompt = row < M_P;
        if (prompt) { b = row >> 13; t = row & 8191; pos = t; }
        else { b = (row - M_P) >> 2; t = (row - M_P) & 3; pos = 16384 + t; }
        if (c0 >= 1792 && c0 < 2432) {
          const float angf = (float)pos * inv;
          double a = (double)angf;
          a -= 6.283185307179586 * rint(a * 0.15915494309189535);
          const float af = (float)a;
          const float sn = __sinf(af), cs = __cosf(af);
          const float x1 = v0 * cs - v1 * sn, x2 = v1 * cs + v0 * sn;
          v0 = x1; v1 = x2;
        }
        z[(size_t)row * ZLD + c0 + r] = f2bf(v0);
        z[(size_t)row * ZLD + c0 + 32 + r] = f2bf(v1);
        if (c0 < 1792) {
          if (prompt && t == 8191) {
            float* o = out + O_PSHIFT + (size_t)(l * 2 + b) * 1792 + c0 + r; o[0] = v0; o[32] = v1;
          } else if (!prompt && t == 3) {
            float* o = out + O_SSHIFT + (size_t)(l * 128 + b) * 1792 + c0 + r; o[0] = v0; o[32] = v1;
          }
        } else if (c0 >= 2304 && prompt && t >= 8064) {
          const int isv = c0 >= 2432;
          const int kvh = ((c0 - 2304) >> 6) & 1;
          float* o = out + (isv ? O_PV : O_PK) + ((size_t)((l * 2 + b) * 128 + (t - 8064)) * 2 + kvh) * 64 + r;
          o[0] = v0; o[32] = v1;
        }
      }
    }
  }
}

#define SL(i) (ldsf + (i) * 4160)
__device__ void rwkv_item(const Params& p, int l, int item, float* ldsf) {
  const int tid = opq(threadIdx.x), lane = tid & 63, wave = tid >> 6;
  const bool sample = item >= 2048;
  int h, cidx, rowbase;
  if (!sample) { h = item & 7; cidx = item >> 3; rowbase = cidx * 64; }
  else { int s = item - 2048; h = s & 7; cidx = s >> 3; rowbase = M_P + cidx * 64; }
  const int cc = cidx & 127;
  const u16* z = (const u16*)(p.ws + WS_Z);
  u16* zw_ = (u16*)(p.ws + WS_Z);
  const float* mu = p.in[9] + l * 1792;
  float* wbuf = SL(7);
  float* gc = ldsf + 9 * 4160;
  float* bd = ldsf + 9 * 4160 + 64;
  __syncthreads();
  {
    const int t = tid >> 3, c8 = (tid & 7) * 8;
    const int m = rowbase + t;
    const int zcs[7] = {h * 64, 512 + h * 64, 1024 + h * 64, 1536, 1600, 1664, 1728};
#pragma unroll
    for (int gi = 0; gi < 7; ++gi) {
      const int zc = zcs[gi] + c8;
      float cur[8], prv[8];
      unpack8(*(const uint4*)(z + (size_t)m * ZLD + zc), cur);
      bool zero = false, fromstate = false;
      if (!sample) zero = (t == 0 && cc == 0);
      else fromstate = ((t & 3) == 0);
      if (zero) {
#pragma unroll
        for (int i = 0; i < 8; ++i) prv[i] = 0.f;
      } else if (fromstate) {
        const int b = (m - M_P) >> 2;
        const float* sp = p.in[2] + (size_t)(l * 128 + b) * 1792 + zc;
        float4 a = *(const float4*)sp, bb = *(const float4*)(sp + 4);
        prv[0] = a.x; prv[1] = a.y; prv[2] = a.z; prv[3] = a.w; prv[4] = bb.x; prv[5] = bb.y; prv[6] = bb.z; prv[7] = bb.w;
      } else {
        unpack8(*(const uint4*)(z + (size_t)(m - 1) * ZLD + zc), prv);
      }
      float* d = SL(gi) + t * 65 + c8;
#pragma unroll
      for (int i = 0; i < 8; ++i) {
        float v = cur[i] + mu[zc + i] * (prv[i] - cur[i]);
        if (gi == 3) v = tanhf(v);
        if (gi >= 5) v = sigm(v);
        d[i] = v;
      }
    }
  }
  const int lt = tid & 63, jg = tid >> 6;
  auto load_w = [&](const float* W, int nrows) {
    for (int e = tid; e < nrows * 8; e += NT) {
      const int i = e >> 3, c = (e & 7) * 8;
      const float* s = W + (size_t)i * 512 + h * 64 + c;
      *(float4*)(wbuf + i * 64 + c) = *(const float4*)s;
      *(float4*)(wbuf + i * 64 + c + 4) = *(const float4*)(s + 4);
    }
  };
  auto lora = [&](const float* xa, const float* xb, int n, float* acc) {
#pragma unroll 2
    for (int i = 0; i < n; ++i) {
      const float x = (i < 64) ? xa[lt * 65 + i] : xb[lt * 65 + i - 64];
      const float4 w0 = *(const float4*)(wbuf + i * 64 + jg * 8);
      const float4 w1 = *(const float4*)(wbuf + i * 64 + jg * 8 + 4);
      acc[0] += x * w0.x; acc[1] += x * w0.y; acc[2] += x * w0.z; acc[3] += x * w0.w;
      acc[4] += x * w1.x; acc[5] += x * w1.y; acc[6] += x * w1.z; acc[7] += x * w1.w;
    }
  };
  float res[8];
  load_w(p.in[11] + (size_t)l * 64 * 512, 64);
  __syncthreads();
#pragma unroll
  for (int i = 0; i < 8; ++i) res[i] = p.in[10][l * 512 + h * 64 + jg * 8 + i];
  lora(SL(3), SL(3), 64, res);
  __syncthreads();
#pragma unroll
  for (int i = 0; i < 8; ++i) {
    const float x = -res[i];
    const float sp = (x > 20.f) ? x : log1pf(__expf(x));
    SL(3)[lt * 65 + jg * 8 + i] = -__expf(-sp - 0.5f);
  }
  load_w(p.in[13] + (size_t)l * 64 * 512, 64);
  __syncthreads();
#pragma unroll
  for (int i = 0; i < 8; ++i) res[i] = p.in[12][l * 512 + h * 64 + jg * 8 + i];
  lora(SL(4), SL(4), 64, res);
  __syncthreads();
#pragma unroll
  for (int i = 0; i < 8; ++i) SL(4)[lt * 65 + jg * 8 + i] = sigm(res[i]);
  load_w(p.in[14] + (size_t)l * 128 * 512, 128);
  __syncthreads();
#pragma unroll
  for (int i = 0; i < 8; ++i) res[i] = 0.f;
  lora(SL(5), SL(6), 128, res);
  __syncthreads();
  if (!sample) {
    u16* ga = (u16*)(p.ws + WS_GA) + (size_t)item * 4096;
    *(uint4*)(ga + lt * 64 + jg * 8) = pack8(res);
    if (tid < 64) {
      float c = 0.f;
      for (int t = 0; t < 64; ++t) { c += SL(3)[t * 65 + tid]; SL(5)[t * 65 + tid] = c; }
      gc[tid] = __expf(c);
    }
  } else {
#pragma unroll
    for (int i = 0; i < 8; ++i) SL(6)[lt * 65 + jg * 8 + i] = res[i];
  }
  __syncthreads();
  {
    const int t = tid >> 3, j0 = (tid & 7) * 8;
    const float* kkw = p.in[15] + l * 512 + h * 64;
    const float* kaw = p.in[16] + l * 512 + h * 64;
    const float* rkw = p.in[17] + l * 512 + h * 64;
    float kr[8], av[8], rv[8], kkv[8], kf[8];
    float nrm = 0.f, bdot = 0.f;
#pragma unroll
    for (int i = 0; i < 8; ++i) {
      const int j = j0 + i;
      kr[i] = SL(1)[t * 65 + j]; av[i] = SL(4)[t * 65 + j]; rv[i] = SL(0)[t * 65 + j];
      kkv[i] = kr[i] * kkw[j];
      nrm += kkv[i] * kkv[i];
      kf[i] = kr[i] * (1.f + (av[i] - 1.f) * kaw[j]);
      bdot += rv[i] * kf[i] * rkw[j];
    }
    nrm += __shfl_xor(nrm, 1, 64); nrm += __shfl_xor(nrm, 2, 64); nrm += __shfl_xor(nrm, 4, 64);
    bdot += __shfl_xor(bdot, 1, 64); bdot += __shfl_xor(bdot, 2, 64); bdot += __shfl_xor(bdot, 4, 64);
    const float rn = 1.f / fmaxf(sqrtf(nrm), 1e-12f);
    if (!sample) {
      float bo[8];
#pragma unroll
      for (int i = 0; i < 8; ++i) {
        const int j = j0 + i;
        const float cum = SL(5)[t * 65 + j], dl = SL(3)[t * 65 + j];
        const float eg = __expf(cum), egi = __expf(-cum), egp = __expf(cum - dl);
        const float kk = kkv[i] * rn;
        SL(0)[t * 65 + j] = rv[i] * eg;
        SL(1)[t * 65 + j] = kf[i] * egi;
        SL(3)[t * 65 + j] = kk * av[i] * egi;
        SL(4)[t * 65 + j] = kk * egp;
        bo[i] = bdot * SL(2)[t * 65 + j];
      }
      u16* bop = (u16*)(p.ws + WS_BO) + (size_t)item * 4096;
      *(uint4*)(bop + t * 64 + j0) = pack8(bo);
    } else {
#pragma unroll
      for (int i = 0; i < 8; ++i) {
        const int j = j0 + i;
        const float kk = kkv[i] * rn;
        const float dl = SL(3)[t * 65 + j];
        SL(1)[t * 65 + j] = kf[i];
        SL(3)[t * 65 + j] = __expf(dl);
        SL(4)[t * 65 + j] = kk;
        SL(5)[t * 65 + j] = kk * av[i];
      }
      if ((tid & 7) == 0) bd[t] = bdot;
    }
  }
  __syncthreads();
  if (sample) {
    const float lng = p.in[18][l * 512 + h * 64 + lane], lnb = p.in[19][l * 512 + h * 64 + lane];
    for (int round = 0; round < 2; ++round) {
      const int seq = wave + 8 * round;
      const int b = cidx * 16 + seq;
      float S[64];
      const float* sp = p.in[3] + ((size_t)((l * 128 + b) * 8 + h) * 64 + lane) * 64;
#pragma unroll
      for (int k = 0; k < 64; k += 4) { float4 v = *(const float4*)(sp + k); S[k] = v.x; S[k + 1] = v.y; S[k + 2] = v.z; S[k + 3] = v.w; }
      for (int tt = 0; tt < 4; ++tt) {
        const int t = seq * 4 + tt;
        float sk = 0.f;
#pragma unroll
        for (int kc = 0; kc < 64; kc += 8) {
#pragma unroll
          for (int k = kc; k < kc + 8; ++k) sk += S[k] * SL(4)[t * 65 + k];
          __builtin_amdgcn_sched_barrier(0);
        }
        const float vt = SL(2)[t * 65 + lane];
        float y = 0.f;
#pragma unroll
        for (int kc = 0; kc < 64; kc += 8) {
#pragma unroll
          for (int k = kc; k < kc + 8; ++k) {
            S[k] = S[k] * SL(3)[t * 65 + k] - sk * SL(5)[t * 65 + k] + vt * SL(1)[t * 65 + k];
            y += S[k] * SL(0)[t * 65 + k];
          }
          __builtin_amdgcn_sched_barrier(0);
        }
        const float mean = wave_sum(y) * (1.f / 64.f);
        const float d = y - mean;
        const float var = wave_sum(d * d) * (1.f / 64.f);
        const float yn = d * rsqrtf(var + 64e-5f) * lng + lnb;
        const float o = (yn + bd[t] * vt) * SL(6)[t * 65 + lane];
        zw_[(size_t)(M_P + b * 4 + tt) * ZLD + h * 64 + lane] = f2bf(o);
      }
      float* op = p.out + O_SWKV + ((size_t)((l * 128 + b) * 8 + h) * 64 + lane) * 64;
#pragma unroll
      for (int k = 0; k < 64; k += 4) *(float4*)(op + k) = make_float4(S[k], S[k + 1], S[k + 2], S[k + 3]);
    }
    return;
  }
  {
    const int i = lane, tg = wave;
    float ab[8], ak[8], akr[8], abr[8];
#pragma unroll
    for (int q = 0; q < 8; ++q) { ab[q] = 0.f; ak[q] = 0.f; akr[q] = 0.f; abr[q] = 0.f; }
#pragma unroll 2
    for (int k = 0; k < 64; ++k) {
      const float xb = SL(3)[i * 65 + k], xk = SL(1)[i * 65 + k];
#pragma unroll
      for (int q = 0; q < 8; ++q) {
        const int t = tg * 8 + q;
        const float yk = SL(4)[t * 65 + k], yr = SL(0)[t * 65 + k];
        ab[q] += xb * yk; ak[q] += xk * yk; akr[q] += xk * yr; abr[q] += xb * yr;
      }
    }
    __syncthreads();
#pragma unroll
    for (int q = 0; q < 8; ++q) {
      const int t = tg * 8 + q;
      SL(6)[i * 65 + t] = (i < t) ? ab[q] : 0.f;
      SL(7)[i * 65 + t] = (i < t) ? ak[q] : 0.f;
      SL(8)[i * 65 + t] = (i <= t) ? akr[q] : 0.f;
      SL(5)[i * 65 + t] = (i <= t) ? abr[q] : 0.f;
    }
  }
  __syncthreads();
  {
    const int t = tid >> 3, j0 = (tid & 7) * 8;
#pragma unroll
    for (int i = 0; i < 8; ++i) { const float g = gc[j0 + i]; SL(3)[t * 65 + j0 + i] *= g; SL(1)[t * 65 + j0 + i] *= g; }
  }
  __syncthreads();
  if (tid < 128) {
    float* X_ = (tid < 64) ? SL(5) : SL(3);
    const int col = tid & 63;
    for (int i = 62; i >= 0; --i) {
      float a = X_[i * 65 + col];
#pragma unroll 4
      for (int t = i + 1; t < 64; ++t) a -= SL(6)[i * 65 + t] * X_[t * 65 + col];
      X_[i * 65 + col] = a;
    }
  }
  __syncthreads();
  {
    const int c = tid & 127, ig = tid >> 7;
    const int which = c >> 6, cq = c & 63;
    const float* N_ = which ? SL(3) : SL(5);
    float a[16];
#pragma unroll
    for (int q = 0; q < 16; ++q) a[q] = 0.f;
#pragma unroll 2
    for (int t = 0; t < 64; ++t) {
      const float n = N_[t * 65 + cq];
#pragma unroll
      for (int q = 0; q < 16; ++q) a[q] += SL(7)[(ig * 16 + q) * 65 + t] * n;
    }
    float* T_ = which ? SL(1) : SL(8);
#pragma unroll
    for (int q = 0; q < 16; ++q) T_[(ig * 16 + q) * 65 + cq] -= a[q];
  }
  __syncthreads();
  {
    const int x = lane, yg = wave;
    float w2[8], pp[8], yl[8], qq[8];
#pragma unroll
    for (int q = 0; q < 8; ++q) { w2[q] = 0.f; pp[q] = 0.f; yl[q] = 0.f; qq[q] = 0.f; }
#pragma unroll 2
    for (int j = 0; j < 64; ++j) {
      const float l5 = SL(5)[j * 65 + x], l4 = SL(4)[j * 65 + x], l8 = SL(8)[j * 65 + x], l2 = SL(2)[j * 65 + x];
#pragma unroll
      for (int q = 0; q < 8; ++q) {
        const int y = yg * 8 + q;
        w2[q] += l5 * SL(4)[j * 65 + y];
        pp[q] += l4 * SL(3)[j * 65 + y];
        yl[q] += l8 * SL(2)[j * 65 + y];
        qq[q] += l2 * SL(1)[j * 65 + y];
      }
    }
    float o1[8], o2[8];
#pragma unroll
    for (int q = 0; q < 8; ++q) {
      const int y = yg * 8 + q;
      o1[q] = SL(0)[x * 65 + y] - w2[q];
      o2[q] = ((x == y) ? gc[x] : 0.f) - pp[q];
    }
    float* Pp = (float*)(p.ws + WS_P) + (size_t)item * 4096 + x * 64 + yg * 8;
    float* Qp = (float*)(p.ws + WS_Q) + (size_t)item * 4096 + x * 64 + yg * 8;
    *(float4*)Pp = make_float4(o2[0], o2[1], o2[2], o2[3]); *(float4*)(Pp + 4) = make_float4(o2[4], o2[5], o2[6], o2[7]);
    *(float4*)Qp = make_float4(qq[0], qq[1], qq[2], qq[3]); *(float4*)(Qp + 4) = make_float4(qq[4], qq[5], qq[6], qq[7]);
    u16* W2p = (u16*)(p.ws + WS_W2) + (size_t)item * 4096 + x * 64 + yg * 8;
    u16* YLp = (u16*)(p.ws + WS_YL) + (size_t)item * 4096 + x * 64 + yg * 8;
    *(uint4*)W2p = pack8(o1);
    *(uint4*)YLp = pack8(yl);
  }
}

__device__ void rwkv_scan(const Params& p, int l, int bh, float* ldsf) {
  const int tid = opq(threadIdx.x), v = tid & 63, kg = tid >> 6;
  const int b = bh >> 3, h = bh & 7;
  float* Sl = ldsf;
  float* Pl = ldsf + 4160;
  __syncthreads();
  for (int e = tid; e < 4160; e += NT) Sl[e] = 0.f;
  for (int cc = 0; cc < 128; ++cc) {
    const size_t id = (size_t)((b * 128 + cc) * 8 + h);
    const float* Pg = (const float*)(p.ws + WS_P) + id * 4096;
    float* Qg = (float*)(p.ws + WS_Q) + id * 4096;
    {
      const int row = tid >> 3, c = (tid & 7) * 8;
      *(float4*)(Pl + row * 68 + c) = *(const float4*)(Pg + row * 64 + c);
      *(float4*)(Pl + row * 68 + c + 4) = *(const float4*)(Pg + row * 64 + c + 4);
    }
    float4 q0 = *(const float4*)(Qg + v * 64 + kg * 8), q1 = *(const float4*)(Qg + v * 64 + kg * 8 + 4);
    float a[8] = {q0.x, q0.y, q0.z, q0.w, q1.x, q1.y, q1.z, q1.w};
    __syncthreads();
    {
      float s[8];
#pragma unroll
      for (int j = 0; j < 8; ++j) s[j] = Sl[v * 65 + kg * 8 + j];
      *(float4*)(Qg + v * 64 + kg * 8) = make_float4(s[0], s[1], s[2], s[3]);
      *(float4*)(Qg + v * 64 + kg * 8 + 4) = make_float4(s[4], s[5], s[6], s[7]);
    }
#pragma unroll 4
    for (int k = 0; k < 64; ++k) {
      const float s = Sl[v * 65 + k];
      const float4 p0 = *(const float4*)(Pl + k * 68 + kg * 8), p1 = *(const float4*)(Pl + k * 68 + kg * 8 + 4);
      a[0] += s * p0.x; a[1] += s * p0.y; a[2] += s * p0.z; a[3] += s * p0.w;
      a[4] += s * p1.x; a[5] += s * p1.y; a[6] += s * p1.z; a[7] += s * p1.w;
    }
    __syncthreads();
#pragma unroll
    for (int j = 0; j < 8; ++j) Sl[v * 65 + kg * 8 + j] = a[j];
  }
  __syncthreads();
  {
    float* o = p.out + O_PWKV + ((size_t)((l * 2 + b) * 8 + h) * 64 + v) * 64 + kg * 8;
    float s[8];
#pragma unroll
    for (int j = 0; j < 8; ++j) s[j] = Sl[v * 65 + kg * 8 + j];
    *(float4*)o = make_float4(s[0], s[1], s[2], s[3]);
    *(float4*)(o + 4) = make_float4(s[4], s[5], s[6], s[7]);
  }
}

__device__ void rwkv_out(const Params& p, int l, int item, float* ldsf) {
  const int tid = opq(threadIdx.x), lane = tid & 63, wave = tid >> 6;
  const int h = item & 7, cidx = item >> 3;
  float* Sl = ldsf; float* Wl = ldsf + 4160;
  const float* Sg = (const float*)(p.ws + WS_Q) + (size_t)item * 4096;
  const u16* W2 = (const u16*)(p.ws + WS_W2) + (size_t)item * 4096;
  const u16* YL = (const u16*)(p.ws + WS_YL) + (size_t)item * 4096;
  const u16* BO = (const u16*)(p.ws + WS_BO) + (size_t)item * 4096;
  const u16* GA = (const u16*)(p.ws + WS_GA) + (size_t)item * 4096;
  u16* z = (u16*)(p.ws + WS_Z);
  __syncthreads();
  {
    const int row = tid >> 3, c = (tid & 7) * 8;
    float4 a = *(const float4*)(Sg + row * 64 + c), bq = *(const float4*)(Sg + row * 64 + c + 4);
    float* d = Sl + row * 65 + c;
    d[0] = a.x; d[1] = a.y; d[2] = a.z; d[3] = a.w; d[4] = bq.x; d[5] = bq.y; d[6] = bq.z; d[7] = bq.w;
    float w[8];
    unpack8(*(const uint4*)(W2 + row * 64 + c), w);
    float* e = Wl + row * 65 + c;
#pragma unroll
    for (int i = 0; i < 8; ++i) e[i] = w[i];
  }
  __syncthreads();
  float y[8];
#pragma unroll
  for (int q = 0; q < 8; ++q) y[q] = bf2f(YL[(wave * 8 + q) * 64 + lane]);
#pragma unroll 2
  for (int k = 0; k < 64; ++k) {
    const float s = Sl[lane * 65 + k];
#pragma unroll
    for (int q = 0; q < 8; ++q) y[q] += s * Wl[(wave * 8 + q) * 65 + k];
  }
  const float lng = p.in[18][l * 512 + h * 64 + lane], lnb = p.in[19][l * 512 + h * 64 + lane];
#pragma unroll
  for (int q = 0; q < 8; ++q) {
    const int t = wave * 8 + q;
    const float mean = wave_sum(y[q]) * (1.f / 64.f);
    const float d = y[q] - mean;
    const float var = wave_sum(d * d) * (1.f / 64.f);
    const float yn = d * rsqrtf(var + 64e-5f) * lng + lnb;
    const float o = (yn + bf2f(BO[t * 64 + lane])) * bf2f(GA[t * 64 + lane]);
    z[(size_t)(cidx * 64 + t) * ZLD + h * 64 + lane] = f2bf(o);
  }
}

__device__ void attn_prompt(const Params& p, int l, int item, u16* lds) {
  const int tid = opq(threadIdx.x), lane = tid & 63, wave = tid >> 6;
  const int r = lane & 31, h = lane >> 5;
  const int kvh = item & 1, n = (item >> 1) & 63, b = item >> 7;
  u16* z = (u16*)(p.ws + WS_Z);
  u16* Ks = lds;
  u16* Vt = lds + 256 * 72;
  __syncthreads();
  {
    const int key = tid >> 1, half = tid & 1;
    const int t = (n - 1) * 128 + key;
    uint4 kv[4], vv[4];
    if (t >= 0) {
      const u16* kp = z + (size_t)(b * 8192 + t) * ZLD + 2304 + kvh * 64 + half * 32;
      const u16* vp = z + (size_t)(b * 8192 + t) * ZLD + 2432 + kvh * 64 + half * 32;
#pragma unroll
      for (int i = 0; i < 4; ++i) { kv[i] = *(const uint4*)(kp + i * 8); vv[i] = *(const uint4*)(vp + i * 8); }
    } else {
#pragma unroll
      for (int i = 0; i < 4; ++i) { kv[i] = make_uint4(0, 0, 0, 0); vv[i] = make_uint4(0, 0, 0, 0); }
    }
#pragma unroll
    for (int i = 0; i < 4; ++i) {
      *(uint4*)(Ks + key * 72 + half * 32 + i * 8) = kv[i];
      const unsigned w[4] = {vv[i].x, vv[i].y, vv[i].z, vv[i].w};
#pragma unroll
      for (int q = 0; q < 4; ++q) {
        const int d = half * 32 + i * 8 + q * 2;
        Vt[d * 264 + key] = (u16)(w[q] & 0xFFFFu);
        Vt[(d + 1) * 264 + key] = (u16)(w[q] >> 16);
      }
    }
  }
  __syncthreads();
#pragma unroll 1
  for (int uu = 0; uu < 2; ++uu) {
    const int u = wave * 2 + uu;
    const int hq = kvh * 4 + (u >> 2), qg = u & 3;
    const int qrow = b * 8192 + n * 128 + qg * 32 + r;
    u16* qp = z + (size_t)qrow * ZLD + 1792 + hq * 64;
    bf16x8 qf[4];
#pragma unroll
    for (int s = 0; s < 4; ++s) qf[s] = *(const bf16x8*)(qp + s * 16 + h * 8);
    f32x16 sc[5];
#pragma unroll
    for (int i5 = 0; i5 < 5; ++i5) {
#pragma unroll
      for (int i = 0; i < 16; ++i) sc[i5][i] = 0.f;
      const int kt = qg + i5;
#pragma unroll
      for (int s = 0; s < 4; ++s) {
        bf16x8 kf = *(const bf16x8*)(Ks + (kt * 32 + r) * 72 + s * 16 + h * 8);
        sc[i5] = __builtin_amdgcn_mfma_f32_32x32x16_bf16(kf, qf[s], sc[i5], 0, 0, 0);
      }
      __builtin_amdgcn_sched_barrier(0);
    }
    const int qi = qg * 32 + r;
    const float sink = p.in[20][l * 8 + hq];
    float mx = -1e30f;
#pragma unroll
    for (int i5 = 0; i5 < 5; ++i5)
#pragma unroll
      for (int reg = 0; reg < 16; ++reg) {
        const int j = (qg + i5) * 32 + ROWOFF(reg, h);
        const bool ok = (j > qi) && (j <= qi + 128) && (n > 0 || j >= 128);
        const float s = ok ? sc[i5][reg] * 0.125f : -1e30f;
        sc[i5][reg] = s;
        mx = fmaxf(mx, s);
      }
    mx = fmaxf(mx, __shfl_xor(mx, 32, 64));
    mx = fmaxf(mx, sink);
    float sum = 0.f;
#pragma unroll
    for (int i5 = 0; i5 < 5; ++i5)
#pragma unroll
      for (int reg = 0; reg < 16; ++reg) { const float e = __expf(sc[i5][reg] - mx); sc[i5][reg] = e; sum += e; }
    sum += __shfl_xor(sum, 32, 64);
    const float rden = 1.f / (sum + __expf(sink - mx));
    f32x16 oacc[2];
#pragma unroll
    for (int i = 0; i < 16; ++i) { oacc[0][i] = 0.f; oacc[1][i] = 0.f; }
#pragma unroll
    for (int i5 = 0; i5 < 5; ++i5) {
      const int kt = qg + i5;
#pragma unroll
      for (int s2 = 0; s2 < 2; ++s2) {
        bf16x8 pf;
#pragma unroll
        for (int j = 0; j < 8; ++j) pf[j] = (short)f2bf(sc[i5][s2 * 8 + j] * rden);
#pragma unroll
        for (int dt = 0; dt < 2; ++dt) {
          const u16* vp = Vt + (dt * 32 + r) * 264 + kt * 32 + s2 * 16 + h * 4;
          const uint2 lo = *(const uint2*)vp, hi = *(const uint2*)(vp + 8);
          union { uint4 u; bf16x8 v; } cv;
          cv.u = make_uint4(lo.x, lo.y, hi.x, hi.y);
          oacc[dt] = __builtin_amdgcn_mfma_f32_32x32x16_bf16(cv.v, pf, oacc[dt], 0, 0, 0);
        }
        __builtin_amdgcn_sched_barrier(0);
      }
    }
#pragma unroll
    for (int dt = 0; dt < 2; ++dt)
#pragma unroll
      for (int g4 = 0; g4 < 4; ++g4) {
        const int d = dt * 32 + 8 * g4 + 4 * h;
        uint2 o;
        o.x = pack2(oacc[dt][g4 * 4 + 0], oacc[dt][g4 * 4 + 1]);
        o.y = pack2(oacc[dt][g4 * 4 + 2], oacc[dt][g4 * 4 + 3]);
        *(uint2*)(qp + d) = o;
      }
  }
}

__device__ void attn_sample(const Params& p, int l, int item, float* ldsf) {
  const int tid = opq(threadIdx.x);
  const int kvh = item & 1, b = item >> 1;
  u16* z = (u16*)(p.ws + WS_Z);
  float* Kl = ldsf;
  float* Vl = ldsf + 132 * 65;
  float* Ql = Vl + 132 * 65;
  float* Pl = Ql + 16 * 64;
  __syncthreads();
  for (int e = tid; e < 132 * 8; e += NT) {
    const int j = e >> 3, c = (e & 7) * 8;
    float k[8], v[8];
    if (j < 128) {
      const float* kp = p.in[4] + ((size_t)((l * 128 + b) * 128 + j) * 2 + kvh) * 64 + c;
      const float* vp = p.in[5] + ((size_t)((l * 128 + b) * 128 + j) * 2 + kvh) * 64 + c;
      float4 a = *(const float4*)kp, a2 = *(const float4*)(kp + 4);
      float4 c1 = *(const float4*)vp, c2 = *(const float4*)(vp + 4);
      k[0] = a.x; k[1] = a.y; k[2] = a.z; k[3] = a.w; k[4] = a2.x; k[5] = a2.y; k[6] = a2.z; k[7] = a2.w;
      v[0] = c1.x; v[1] = c1.y; v[2] = c1.z; v[3] = c1.w; v[4] = c2.x; v[5] = c2.y; v[6] = c2.z; v[7] = c2.w;
    } else {
      const size_t row = M_P + b * 4 + (j - 128);
      unpack8(*(const uint4*)(z + row * ZLD + 2304 + kvh * 64 + c), k);
      unpack8(*(const uint4*)(z + row * ZLD + 2432 + kvh * 64 + c), v);
    }
#pragma unroll
    for (int i = 0; i < 8; ++i) { Kl[j * 65 + c + i] = k[i]; Vl[j * 65 + c + i] = v[i]; }
    if (j >= 4) {
      float* ok = p.out + O_SK + ((size_t)((l * 128 + b) * 128 + (j - 4)) * 2 + kvh) * 64 + c;
      float* ov = p.out + O_SV + ((size_t)((l * 128 + b) * 128 + (j - 4)) * 2 + kvh) * 64 + c;
      *(float4*)ok = make_float4(k[0], k[1], k[2], k[3]); *(float4*)(ok + 4) = make_float4(k[4], k[5], k[6], k[7]);
      *(float4*)ov = make_float4(v[0], v[1], v[2], v[3]); *(float4*)(ov + 4) = make_float4(v[4], v[5], v[6], v[7]);
    }
  }
  if (tid < 128) {
    const int row = tid >> 3, c = (tid & 7) * 8;
    const int hl = row >> 2, t = row & 3;
    float q[8];
    unpack8(*(const uint4*)(z + (size_t)(M_P + b * 4 + t) * ZLD + 1792 + (kvh * 4 + hl) * 64 + c), q);
#pragma unroll
    for (int i = 0; i < 8; ++i) Ql[row * 64 + c + i] = q[i];
  }
  __syncthreads();
  const int row = tid >> 5, jl = tid & 31;
  const int t = row & 3, hq = kvh * 4 + (row >> 2);
  float sc[5];
  float mx = -1e30f;
#pragma unroll
  for (int jj = 0; jj < 5; ++jj) {
    const int j = jl + 32 * jj;
    float s = -1e30f;
    if (j < 132 && j > t && j <= t + 128) {
      float a = 0.f;
#pragma unroll 8
      for (int d = 0; d < 64; ++d) a += Ql[row * 64 + d] * Kl[j * 65 + d];
      s = a * 0.125f;
    }
    sc[jj] = s; mx = fmaxf(mx, s);
    __builtin_amdgcn_sched_barrier(0);
  }
#pragma unroll
  for (int o = 16; o >= 1; o >>= 1) mx = fmaxf(mx, __shfl_xor(mx, o, 64));
  const float sink = p.in[20][l * 8 + hq];
  mx = fmaxf(mx, sink);
  float sum = 0.f;
#pragma unroll
  for (int jj = 0; jj < 5; ++jj) { sc[jj] = __expf(sc[jj] - mx); sum += sc[jj]; }
#pragma unroll
  for (int o = 16; o >= 1; o >>= 1) sum += __shfl_xor(sum, o, 64);
  const float rden = 1.f / (sum + __expf(sink - mx));
#pragma unroll
  for (int jj = 0; jj < 5; ++jj) { const int j = jl + 32 * jj; if (j < 136) Pl[row * 136 + j] = sc[jj] * rden; }
  __syncthreads();
  {
    const int d = jl * 2;
    float o0 = 0.f, o1 = 0.f;
#pragma unroll 4
    for (int j = 0; j < 132; ++j) { const float pr = Pl[row * 136 + j]; o0 += pr * Vl[j * 65 + d]; o1 += pr * Vl[j * 65 + d + 1]; }
    *(unsigned*)(z + (size_t)(M_P + b * 4 + t) * ZLD + 1792 + hq * 64 + d) = pack2(o0, o1);
  }
}

__device__ void phase_merge(const Params& p, int l, u16* lds) {
  const u16* Wt = (const u16*)(p.ws + WS_WT);
  const float* rstd = (const float*)(p.ws + WS_RSTD);
  const u16* z = (const u16*)(p.ws + WS_Z);
  u16* mg = (u16*)(p.ws + WS_R);
  const float* X = p.out;
  for (int it = blockIdx.x; it < 66 * 8; it += gridDim.x) {
    const int tid = opq(threadIdx.x), lane = tid & 63, wave = tid >> 6;
    const int wm = wave >> 1, wn = wave & 1, r = lane & 31, h = lane >> 5;
    const int tn = it & 7, tm = it >> 3;
    const int m0 = tm * 256, n0 = tn * 128;
    f32x16 acc[2][2];
    unsigned sg[2][2][8];
#pragma unroll 1
    for (int pass = 0; pass < 2; ++pass) {
      zero_acc(acc);
      gemm_loop<true>(X + (size_t)m0 * 1024, 1024, Wt + WT_IN + (size_t)(2560 + pass * 1024 + n0) * 1024, 1024, 1024, acc, lds, tid);
#pragma unroll
      for (int mi = 0; mi < 2; ++mi)
#pragma unroll
        for (int q = 0; q < 8; ++q) {
          const float r0 = rstd[m0 + wm * 64 + mi * 32 + ROWOFF(2 * q, h)], r1 = rstd[m0 + wm * 64 + mi * 32 + ROWOFF(2 * q + 1, h)];
#pragma unroll
          for (int ni = 0; ni < 2; ++ni)
            sg[mi][ni][q] = pack2(sigm(acc[mi][ni][2 * q] * r0), sigm(acc[mi][ni][2 * q + 1] * r1));
          __builtin_amdgcn_sched_barrier(0);
        }
      zero_acc(acc);
      gemm_loop<false>(z + (size_t)m0 * ZLD + pass * 1792, ZLD, Wt + (pass ? WT_BRB : WT_BRA) + (size_t)n0 * 512, 512, 512, acc, lds, tid);
#pragma unroll
      for (int mi = 0; mi < 2; ++mi)
#pragma unroll
        for (int ni = 0; ni < 2; ++ni)
#pragma unroll
          for (int reg = 0; reg < 16; ++reg) {
            const unsigned s = sg[mi][ni][reg >> 1];
            const float g = (reg & 1) ? __uint_as_float(s & 0xFFFF0000u) : __uint_as_float(s << 16);
            const int row = m0 + wm * 64 + mi * 32 + ROWOFF(reg, h);
            u16* dst = mg + (size_t)row * 1024 + n0 + wn * 64 + ni * 32 + r;
            float v = acc[mi][ni][reg] * g;
            if (pass) v += bf2f(*dst);
            *dst = f2bf(v);
            if ((reg & 3) == 3) __builtin_amdgcn_sched_barrier(0);
          }
    }
  }
}

__device__ void phase_resid(const Params& p, const u16* A, int lda, const u16* Bt, int K, u16* lds) {
  float* X = p.out;
  for (int it = blockIdx.x; it < 66 * 8; it += gridDim.x) {
    const int tid = opq(threadIdx.x), lane = tid & 63, wave = tid >> 6;
    const int wm = wave >> 1, wn = wave & 1, r = lane & 31, h = lane >> 5;
    const int tn = it & 7, tm = it >> 3;
    const int m0 = tm * 256, n0 = tn * 128;
    f32x16 acc[2][2];
    zero_acc(acc);
    gemm_loop<false>(A + (size_t)m0 * lda, lda, Bt + (size_t)n0 * K, K, K, acc, lds, tid);
#pragma unroll
    for (int mi = 0; mi < 2; ++mi)
#pragma unroll
      for (int ni = 0; ni < 2; ++ni)
#pragma unroll
        for (int reg = 0; reg < 16; ++reg) {
          const int row = m0 + wm * 64 + mi * 32 + ROWOFF(reg, h);
          float* xp = X + (size_t)row * 1024 + n0 + wn * 64 + ni * 32 + r;
          *xp = *xp + acc[mi][ni][reg];
        }
  }
}

__device__ void phase_ffnin(const Params& p, u16* lds) {
  const u16* Wt = (const u16*)(p.ws + WS_WT) + WT_FIN;
  const float* rstd = (const float*)(p.ws + WS_RSTD);
  u16* cu = (u16*)(p.ws + WS_Z);
  const float* X = p.out;
  for (int it = blockIdx.x; it < 66 * 44; it += gridDim.x) {
    const int tid = opq(threadIdx.x), lane = tid & 63, wave = tid >> 6;
    const int wm = wave >> 1, wn = wave & 1, r = lane & 31, h = lane >> 5;
    const int tn = it % 44, tm = it / 44;
    const int m0 = tm * 256, n0 = tn * 128;
    f32x16 acc[2][2];
    zero_acc(acc);
    gemm_loop<true>(X + (size_t)m0 * 1024, 1024, Wt + (size_t)n0 * 1024, 1024, 1024, acc, lds, tid);
#pragma unroll
    for (int mi = 0; mi < 2; ++mi)
#pragma unroll
      for (int reg = 0; reg < 16; ++reg) {
        const int row = m0 + wm * 64 + mi * 32 + ROWOFF(reg, h);
        const float rs = rstd[row];
#pragma unroll
        for (int ni = 0; ni < 2; ++ni)
          cu[(size_t)row * 5632 + n0 + wn * 64 + ni * 32 + r] = f2bf(acc[mi][ni][reg] * rs);
      }
  }
}

__device__ void phase_convgelu(const Params& p, int l) {
  u16* cu = (u16*)(p.ws + WS_Z);
  const float* cw = p.in[26] + (size_t)l * 3 * 2816;
  const float* cb = p.in[27] + (size_t)l * 2816;
  for (int it = blockIdx.x; it < 1056; it += gridDim.x) {
    const int tid = opq(threadIdx.x);
    if (tid >= 352) continue;
    const int j0 = tid * 8;
    float w0[8], w1[8], w2[8], bb[8];
#pragma unroll
    for (int i = 0; i < 8; ++i) { w0[i] = cw[j0 + i]; w1[i] = cw[2816 + j0 + i]; w2[i] = cw[5632 + j0 + i]; bb[i] = cb[j0 + i]; }
    float c1[8], c2[8];
    for (int rr = 0; rr < 16; ++rr) {
      const int row = it * 16 + rr;
      const bool prompt = row < M_P;
      int b, t;
      if (prompt) { b = row >> 13; t = row & 8191; } else { b = (row - M_P) >> 2; t = (row - M_P) & 3; }
      if (t == 0) {
        if (prompt) {
#pragma unroll
          for (int i = 0; i < 8; ++i) { c1[i] = 0.f; c2[i] = 0.f; }
        } else {
          const float* st = p.in[6] + (size_t)((l * 128 + b) * 2) * 2816 + j0;
#pragma unroll
          for (int i = 0; i < 8; ++i) { c2[i] = st[i]; c1[i] = st[2816 + i]; }
        }
      } else if (rr == 0) {
        unpack8(*(const uint4*)(cu + (size_t)(row - 1) * 5632 + j0), c1);
        if (t >= 2) unpack8(*(const uint4*)(cu + (size_t)(row - 2) * 5632 + j0), c2);
        else {
#pragma unroll
          for (int i = 0; i < 8; ++i) c2[i] = 0.f;
        }
      }
      float c0[8], up[8], a[8];
      unpack8(*(const uint4*)(cu + (size_t)row * 5632 + j0), c0);
      unpack8(*(const uint4*)(cu + (size_t)row * 5632 + 2816 + j0), up);
#pragma unroll
      for (int i = 0; i < 8; ++i) {
        const float cv = bb[i] + w0[i] * c2[i] + w1[i] * c1[i] + w2[i] * c0[i];
        const float ge = 0.5f * cv * (1.f + erff(cv * 0.7071067811865476f));
        a[i] = ge * up[i];
      }
      *(uint4*)(cu + (size_t)row * 5632 + 2816 + j0) = pack8(a);
      if (prompt && t >= 8190) {
        float* o = p.out + O_PCONV + (size_t)((l * 2 + b) * 2 + (t - 8190)) * 2816 + j0;
        *(float4*)o = make_float4(c0[0], c0[1], c0[2], c0[3]); *(float4*)(o + 4) = make_float4(c0[4], c0[5], c0[6], c0[7]);
      } else if (!prompt && t >= 2) {
        float* o = p.out + O_SCONV + (size_t)((l * 128 + b) * 2 + (t - 2)) * 2816 + j0;
        *(float4*)o = make_float4(c0[0], c0[1], c0[2], c0[3]); *(float4*)(o + 4) = make_float4(c0[4], c0[5], c0[6], c0[7]);
      }
#pragma unroll
      for (int i = 0; i < 8; ++i) { c2[i] = c1[i]; c1[i] = c0[i]; }
    }
  }
}

__device__ void phase_final(const Params& p) {
  float* X = p.out;
  const float* g = p.in[29];
  for (int it = blockIdx.x; it < 2112; it += gridDim.x) {
    const int tid = opq(threadIdx.x);
    const int lane = tid & 63;
    const int row = it * 8 + (tid >> 6);
    float4 v[4];
    float ss = 0.f;
#pragma unroll
    for (int i = 0; i < 4; ++i) {
      v[i] = *(const float4*)(X + (size_t)row * 1024 + i * 256 + lane * 4);
      ss += v[i].x * v[i].x + v[i].y * v[i].y + v[i].z * v[i].z + v[i].w * v[i].w;
    }
    ss = wave_sum(ss);
    const float rs = rsqrtf(ss * (1.f / 1024.f) + 1e-6f);
#pragma unroll
    for (int i = 0; i < 4; ++i) {
      const float4 gg = *(const float4*)(g + i * 256 + lane * 4);
      *(float4*)(X + (size_t)row * 1024 + i * 256 + lane * 4) =
          make_float4(v[i].x * rs * gg.x, v[i].y * rs * gg.y, v[i].z * rs * gg.z, v[i].w * rs * gg.w);
    }
  }
}

template <int KMASK>
__global__ void __launch_bounds__(NT) fwd_kernel(Params p) {
  extern __shared__ __attribute__((aligned(16))) unsigned char lds_raw[];
  float* ldsf = (float*)lds_raw;
  u16* ldsh = (u16*)lds_raw;
  for (int ph = p.ph_lo; ph < p.ph_hi; ++ph) {
    if (ph == NPH - 1) {
      if ((KMASK >> 11) & 1) phase_final(p);
    } else {
      const int l = ph / 11, k = ph % 11;
      switch (k) {
        case 0: if (!((KMASK >> 0) & 1)) break; phase_prep(p, l, true, ldsf); break;
        case 1: if (!((KMASK >> 1) & 1)) break; phase_inproj(p, l, ldsh); break;
        case 2: if (!((KMASK >> 2) & 1)) break;
          for (int it = blockIdx.x; it < 2048 + 64; it += gridDim.x) {
            const int item = (it < 64) ? 2048 + it : it - 64;
            rwkv_item(p, l, item, ldsf);
          }
          break;
        case 3: if (!((KMASK >> 3) & 1)) break;
          if (blockIdx.x < 16) { if (T3 & 1) rwkv_scan(p, l, blockIdx.x, ldsf); }
          else {
            for (int it = blockIdx.x - 16; it < 512; it += gridDim.x - 16) {
              if (it < 256) { if (T3 & 2) attn_prompt(p, l, it, ldsh); } else { if (T3 & 4) attn_sample(p, l, it - 256, ldsf); }
            }
          }
          break;
        case 4: if (!((KMASK >> 4) & 1)) break;
          for (int it = blockIdx.x; it < 2048; it += gridDim.x) rwkv_out(p, l, it, ldsf);
          break;
        case 5: if (!((KMASK >> 5) & 1)) break; phase_merge(p, l, ldsh); break;
        case 6: if (!((KMASK >> 6) & 1)) break; phase_resid(p, (const u16*)(p.ws + WS_R), 1024, (const u16*)(p.ws + WS_WT) + WT_OUT, 1024, ldsh); break;
        case 7: if (!((KMASK >> 7) & 1)) break; phase_prep(p, l, false, ldsf); break;
        case 8: if (!((KMASK >> 8) & 1)) break; phase_ffnin(p, ldsh); break;
        case 9: if (!((KMASK >> 9) & 1)) break; phase_convgelu(p, l); break;
        case 10: if (!((KMASK >> 10) & 1)) break; phase_resid(p, (const u16*)(p.ws + WS_Z) + 2816, 5632, (const u16*)(p.ws + WS_WT) + WT_FDN, 2816, ldsh); break;
      }
    }
#if COOP
    if (ph + 1 < p.ph_hi) cg::this_grid().sync();
#endif
  }
}

template <int KM>
static void launch_one(const Params& p, int grid, hipStream_t stream) {
  static bool attr = false;
  if (!attr) { (void)hipFuncSetAttribute((const void*)fwd_kernel<KM>, hipFuncAttributeMaxDynamicSharedMemorySize, LDS_BYTES); attr = true; }
  hipLaunchKernelGGL(fwd_kernel<KM>, dim3(grid), dim3(NT), LDS_BYTES, stream, p);
}

extern "C" void kernel_launch(void* const* d_in, const int* in_sizes, int n_in, void* d_out, int out_size, void* d_ws,
                              size_t ws_size, hipStream_t stream) {
  static int grid = 0;
  if (grid == 0) {
    int dev = 0, cus = 0;
    (void)hipGetDevice(&dev);
    (void)hipDeviceGetAttribute(&cus, hipDeviceAttributeMultiprocessorCount, dev);
    grid = cus > 0 ? cus : 256;
    (void)hipGetLastError();
  }
  Params p{};
  for (int i = 0; i < 30; ++i) p.in[i] = (const float*)d_in[i];
  p.out = (float*)d_out;
  p.ws = (unsigned char*)d_ws;
#if COOP
  static bool attr = false;
  if (!attr) { (void)hipFuncSetAttribute((const void*)fwd_kernel<0xFFF>, hipFuncAttributeMaxDynamicSharedMemorySize, LDS_BYTES); attr = true; }
  p.ph_lo = 0; p.ph_hi = NPH;
  void* args[] = {&p};
  hipError_t e = hipLaunchCooperativeKernel((const void*)fwd_kernel<0xFFF>, dim3(grid), dim3(NT), args, LDS_BYTES, stream);
  if (e != hipSuccess) fprintf(stderr, "cooperative launch failed: %s (grid %d)\n", hipGetErrorString(e), grid);
#else
  for (int ph = 0; ph < NPH; ++ph) {
    p.ph_lo = ph; p.ph_hi = ph + 1;
    const int k = (ph == NPH - 1) ? 11 : ph % 11;
    switch (k) {
      case 0: launch_one<1 << 0>(p, grid, stream); break;
      case 1: launch_one<1 << 1>(p, grid, stream); break;
      case 2: launch_one<1 << 2>(p, grid, stream); break;
      case 3: launch_one<1 << 3>(p, grid, stream); break;
      case 4: launch_one<1 << 4>(p, grid, stream); break;
      case 5: launch_one<1 << 5>(p, grid, stream); break;
      case 6: launch_one<1 << 6>(p, grid, stream); break;
      case 7: launch_one<1 << 7>(p, grid, stream); break;
      case 8: launch_one<1 << 8>(p, grid, stream); break;
      case 9: launch_one<1 << 9>(p, grid, stream); break;
      case 10: launch_one<1 << 10>(p, grid, stream); break;
      default: launch_one<1 << 11>(p, grid, stream); break;
    }
  }
#endif
}
```

```cpp
#include <hip/hip_runtime.h>
#include <hip/hip_bf16.h>
#include <hip/hip_cooperative_groups.h>
#include <cstdio>
namespace cg = cooperative_groups;

typedef __attribute__((ext_vector_type(8))) short bf16x8;
typedef __attribute__((ext_vector_type(16))) float f32x16;
typedef unsigned short u16;

#ifndef PHMASK
#define PHMASK 0xFFF
#endif
#ifndef T3
#define T3 7
#endif
#ifndef COOP
#define COOP 1
#endif

#define NT 512
#define M_TOT 16896
#define M_P 16384
#define ZLD 2560
#define NPH 23

#define WS_WT   0ull
#define WS_RSTD 30932992ull
#define WS_Z    31000576ull
#define WS_R    117508096ull
#define WS_P    (WS_R)
#define WS_Q    (WS_R + 33554432ull)
#define WS_W2   (WS_R + 67108864ull)
#define WS_YL   (WS_R + 83886080ull)
#define WS_BO   (WS_R + 100663296ull)
#define WS_GA   (WS_R + 117440512ull)
#define WT_IN  0
#define WT_BRA 4718592
#define WT_BRB 5242880
#define WT_OUT 5767168
#define WT_FIN 6815744
#define WT_FDN 12582912
#define O_PSHIFT 17301504
#define O_PWKV   17308672
#define O_PK     17439744
#define O_PV     17505280
#define O_PCONV  17570816
#define O_SSHIFT 17593344
#define O_SWKV   18052096
#define O_SK     26440704
#define O_SV     30635008
#define O_SCONV  34829312

#define LDS_BYTES 151552

struct Params {
  const float* in[30];
  float* out;
  unsigned char* ws;
  int ph_lo, ph_hi;
};

__device__ __forceinline__ u16 f2bf(float f) {
  unsigned u = __float_as_uint(f);
  u += 0x7FFFu + ((u >> 16) & 1u);
  return (u16)(u >> 16);
}
__device__ __forceinline__ float bf2f(u16 h) { return __uint_as_float(((unsigned)h) << 16); }
__device__ __forceinline__ unsigned pack2(float a, float b) { return (unsigned)f2bf(a) | ((unsigned)f2bf(b) << 16); }
__device__ __forceinline__ float sigm(float x) { return __builtin_amdgcn_rcpf(1.f + __expf(-x)); }
__device__ __forceinline__ void unpack8(uint4 u, float* o) {
  o[0] = __uint_as_float(u.x << 16); o[1] = __uint_as_float(u.x & 0xFFFF0000u);
  o[2] = __uint_as_float(u.y << 16); o[3] = __uint_as_float(u.y & 0xFFFF0000u);
  o[4] = __uint_as_float(u.z << 16); o[5] = __uint_as_float(u.z & 0xFFFF0000u);
  o[6] = __uint_as_float(u.w << 16); o[7] = __uint_as_float(u.w & 0xFFFF0000u);
}
__device__ __forceinline__ uint4 pack8(const float* f) {
  uint4 u; u.x = pack2(f[0], f[1]); u.y = pack2(f[2], f[3]); u.z = pack2(f[4], f[5]); u.w = pack2(f[6], f[7]); return u;
}
__device__ __forceinline__ int opq(int x) { asm volatile("" : "+v"(x)); return x; }
__device__ __forceinline__ float wave_sum(float x) {
#pragma unroll
  for (int o = 32; o >= 1; o >>= 1) x += __shfl_xor(x, o, 64);
  return x;
}

template <bool AF32>
__device__ __forceinline__ void gemm_loop(const void* __restrict__ Ap, int lda, const u16* __restrict__ Bp, int ldb, int K,
                                          f32x16 (&acc)[2][2], u16* lds, int tid) {
  const int lane = tid & 63, wave = tid >> 6;
  const int wm = wave >> 1, wn = wave & 1, r = lane & 31, h = lane >> 5;
  constexpr int A_SZ = 256 * 40, B_SZ = 128 * 40, STAGE = A_SZ + B_SZ;
  const int arow = tid >> 1, ahalf = tid & 1;
  const int brow = tid >> 2, bq = tid & 3;
  float4 fa0, fa1, fa2, fa3;
  uint4 ra0, ra1, rb;
  const float* apf = (const float*)Ap + (size_t)arow * lda + ahalf * 16;
  const u16* aph = (const u16*)Ap + (size_t)arow * lda + ahalf * 16;
  const u16* bp = Bp + (size_t)brow * ldb + bq * 8;
  auto gload = [&](int k0) {
    if (AF32) {
      fa0 = *(const float4*)(apf + k0); fa1 = *(const float4*)(apf + k0 + 4);
      fa2 = *(const float4*)(apf + k0 + 8); fa3 = *(const float4*)(apf + k0 + 12);
    } else {
      ra0 = *(const uint4*)(aph + k0); ra1 = *(const uint4*)(aph + k0 + 8);
    }
    rb = *(const uint4*)(bp + k0);
  };
  auto lstore = [&](int s) {
    u16* A_s = lds + s * STAGE; u16* B_s = A_s + A_SZ;
    if (AF32) {
      ra0.x = pack2(fa0.x, fa0.y); ra0.y = pack2(fa0.z, fa0.w); ra0.z = pack2(fa1.x, fa1.y); ra0.w = pack2(fa1.z, fa1.w);
      ra1.x = pack2(fa2.x, fa2.y); ra1.y = pack2(fa2.z, fa2.w); ra1.z = pack2(fa3.x, fa3.y); ra1.w = pack2(fa3.z, fa3.w);
    }
    *(uint4*)(A_s + arow * 40 + ahalf * 16) = ra0;
    *(uint4*)(A_s + arow * 40 + ahalf * 16 + 8) = ra1;
    *(uint4*)(B_s + brow * 40 + bq * 8) = rb;
  };
  __syncthreads();
  gload(0); lstore(0);
  __syncthreads();
  const int nk = K >> 5;
  for (int kt = 0; kt < nk; ++kt) {
    const int cur = kt & 1;
    if (kt + 1 < nk) gload((kt + 1) << 5);
    const u16* A_s = lds + cur * STAGE; const u16* B_s = A_s + A_SZ;
#pragma unroll
    for (int s = 0; s < 2; ++s) {
      bf16x8 a0 = *(const bf16x8*)(A_s + (wm * 64 + r) * 40 + s * 16 + h * 8);
      bf16x8 a1 = *(const bf16x8*)(A_s + (wm * 64 + 32 + r) * 40 + s * 16 + h * 8);
      bf16x8 b0 = *(const bf16x8*)(B_s + (wn * 64 + r) * 40 + s * 16 + h * 8);
      bf16x8 b1 = *(const bf16x8*)(B_s + (wn * 64 + 32 + r) * 40 + s * 16 + h * 8);
      acc[0][0] = __builtin_amdgcn_mfma_f32_32x32x16_bf16(a0, b0, acc[0][0], 0, 0, 0);
      acc[0][1] = __builtin_amdgcn_mfma_f32_32x32x16_bf16(a0, b1, acc[0][1], 0, 0, 0);
      acc[1][0] = __builtin_amdgcn_mfma_f32_32x32x16_bf16(a1, b0, acc[1][0], 0, 0, 0);
      acc[1][1] = __builtin_amdgcn_mfma_f32_32x32x16_bf16(a1, b1, acc[1][1], 0, 0, 0);
    }
    if (kt + 1 < nk) lstore(cur ^ 1);
    __syncthreads();
  }
}
__device__ __forceinline__ void zero_acc(f32x16 (&acc)[2][2]) {
#pragma unroll
  for (int a = 0; a < 2; ++a)
#pragma unroll
    for (int b = 0; b < 2; ++b)
#pragma unroll
      for (int i = 0; i < 16; ++i) acc[a][b][i] = 0.f;
}
#define ROWOFF(reg, h) (((reg) & 3) + 8 * ((reg) >> 2) + 4 * (h))

__device__ void conv_tile(const float* __restrict__ src, int K, int N, u16* __restrict__ dst, const float* __restrict__ g,
                          int tile, float* lds) {
  const int tn_cnt = N >> 6;
  const int tk = tile / tn_cnt, tn = tile - tk * tn_cnt;
  const int k0 = tk << 6, n0 = tn << 6;
  const int tid = opq(threadIdx.x);
  __syncthreads();
  {
    const int k = tid >> 3, c = (tid & 7) * 8;
    const float* s = src + (size_t)(k0 + k) * N + n0 + c;
    float4 a = *(const float4*)s, b = *(const float4*)(s + 4);
    const float gs = g ? g[k0 + k] : 1.f;
    float* d = lds + k * 65 + c;
    d[0] = a.x * gs; d[1] = a.y * gs; d[2] = a.z * gs; d[3] = a.w * gs;
    d[4] = b.x * gs; d[5] = b.y * gs; d[6] = b.z * gs; d[7] = b.w * gs;
  }
  __syncthreads();
  {
    const int n = tid >> 3, kk = (tid & 7) * 8;
    float f[8];
#pragma unroll
    for (int i = 0; i < 8; ++i) f[i] = lds[(kk + i) * 65 + n];
    *(uint4*)(dst + (size_t)(n0 + n) * K + k0 + kk) = pack8(f);
  }
}

__device__ void phase_prep(const Params& p, int l, bool first_norm, float* ldsf) {
  u16* Wt = (u16*)(p.ws + WS_WT);
  float* rstd = (float*)(p.ws + WS_RSTD);
  float* X = p.out;
  const int nconv = first_norm ? 3776 : 0;
  const int ntot = nconv + 2112;
  for (int it = blockIdx.x; it < ntot; it += gridDim.x) {
    if (it < nconv) {
      int t = it;
      if (t < 1152) conv_tile(p.in[8] + (size_t)l * 1024 * 4608, 1024, 4608, Wt + WT_IN, p.in[7] + l * 1024, t, ldsf);
      else if ((t -= 1152) < 128) conv_tile(p.in[21] + (size_t)l * 512 * 1024, 512, 1024, Wt + WT_BRA, nullptr, t, ldsf);
      else if ((t -= 128) < 128) conv_tile(p.in[22] + (size_t)l * 512 * 1024, 512, 1024, Wt + WT_BRB, nullptr, t, ldsf);
      else if ((t -= 128) < 256) conv_tile(p.in[23] + (size_t)l * 1024 * 1024, 1024, 1024, Wt + WT_OUT, nullptr, t, ldsf);
      else if ((t -= 256) < 1408) conv_tile(p.in[25] + (size_t)l * 1024 * 5632, 1024, 5632, Wt + WT_FIN, p.in[24] + l * 1024, t, ldsf);
      else { t -= 1408; conv_tile(p.in[28] + (size_t)l * 2816 * 1024, 2816, 1024, Wt + WT_FDN, nullptr, t, ldsf); }
    } else {
      const int tid = opq(threadIdx.x);
      const int row = (it - nconv) * 8 + (tid >> 6);
      const int lane = tid & 63;
      const float* src;
      if (first_norm && l == 0) src = (row < M_P) ? p.in[0] + (size_t)row * 1024 : p.in[1] + (size_t)(row - M_P) * 1024;
      else src = X + (size_t)row * 1024;
      float ss = 0.f;
#pragma unroll
      for (int i = 0; i < 4; ++i) {
        float4 v = *(const float4*)(src + i * 256 + lane * 4);
        ss += v.x * v.x + v.y * v.y + v.z * v.z + v.w * v.w;
        if (first_norm && l == 0) *(float4*)(X + (size_t)row * 1024 + i * 256 + lane * 4) = v;
      }
      ss = wave_sum(ss);
      if (lane == 0) rstd[row] = rsqrtf(ss * (1.f / 1024.f) + 1e-6f);
    }
  }
}

__device__ void phase_inproj(const Params& p, int l, u16* lds) {
  const u16* Wt = (const u16*)(p.ws + WS_WT) + WT_IN;
  const float* rstd = (const float*)(p.ws + WS_RSTD);
  u16* z = (u16*)(p.ws + WS_Z);
  const float* X = p.out;
  float* out = p.out;
  for (int it = blockIdx.x; it < 66 * 20; it += gridDim.x) {
    const int tid = opq(threadIdx.x), lane = tid & 63, wave = tid >> 6;
    const int wm = wave >> 1, wn = wave & 1, r = lane & 31, h = lane >> 5;
    const float inv = __expf(-(float)r * (9.210340371976184f / 32.f));
    const int tn = it % 20, tm = it / 20;
    const int m0 = tm * 256, n0 = tn * 128;
    f32x16 acc[2][2];
    zero_acc(acc);
    gemm_loop<true>(X + (size_t)m0 * 1024, 1024, Wt + (size_t)n0 * 1024, 1024, 1024, acc, lds, tid);
    const int c0 = n0 + wn * 64;
#pragma unroll
    for (int mi = 0; mi < 2; ++mi) {
#pragma unroll
      for (int reg = 0; reg < 16; ++reg) {
        const int row = m0 + wm * 64 + mi * 32 + ROWOFF(reg, h);
        const float rs = rstd[row];
        float v0 = acc[mi][0][reg] * rs, v1 = acc[mi][1][reg] * rs;
        int b, t, pos;
        const bool prompt = row < M_P;
        if (prompt) { b = row >> 13; t = row & 8191; pos = t; }
        else { b = (row - M_P) >> 2; t = (row - M_P) & 3; pos = 16384 + t; }
        if (c0 >= 1792 && c0 < 2432) {
          const float angf = (float)pos * inv;
          double a = (double)angf;
          a -= 6.283185307179586 * rint(a * 0.15915494309189535);
          const float af = (float)a;
          const float sn = __sinf(af), cs = __cosf(af);
          const float x1 = v0 * cs - v1 * sn, x2 = v1 * cs + v0 * sn;
          v0 = x1; v1 = x2;
        }
        z[(size_t)row * ZLD + c0 + r] = f2bf(v0);
        z[(size_t)row * ZLD + c0 + 32 + r] = f2bf(v1);
        if (c0 < 1792) {
          if (prompt && t == 8191) {
            float* o = out + O_PSHIFT + (size_t)(l * 2 + b) * 1792 + c0 + r; o[0] = v0; o[32] = v1;
          } else if (!prompt && t == 3) {
            float* o = out + O_SSHIFT + (size_t)(l * 128 + b) * 1792 + c0 + r; o[0] = v0; o[32] = v1;
          }
        } else if (c0 >= 2304 && prompt && t >= 8064) {
          const int isv = c0 >= 2432;
          const int kvh = ((c0 - 2304) >> 6) & 1;
          float* o = out + (isv ? O_PV : O_PK) + ((size_t)((l * 2 + b) * 128 + (t - 8064)) * 2 + kvh) * 64 + r;
          o[0] = v0; o[32] = v1;
        }
      }
    }
  }
}

#define SL(i) (ldsf + (i) * 4160)
__device__ void rwkv_item(const Params& p, int l, int item, float* ldsf) {
  const int tid = opq(threadIdx.x), lane = tid & 63, wave = tid >> 6;
  const bool sample = item >= 2048;
  int h, cidx, rowbase;
  if (!sample) { h = item & 7; cidx = item >> 3; rowbase = cidx * 64; }
  else { int s = item - 2048; h = s & 7; cidx = s >> 3; rowbase = M_P + cidx * 64; }
  const int cc = cidx & 127;
  const u16* z = (const u16*)(p.ws + WS_Z);
  u16* zw_ = (u16*)(p.ws + WS_Z);
  const float* mu = p.in[9] + l * 1792;
  float* wbuf = SL(7);
  float* gc = ldsf + 9 * 4160;
  float* bd = ldsf + 9 * 4160 + 64;
  __syncthreads();
  {
    const int t = tid >> 3, c8 = (tid & 7) * 8;
    const int m = rowbase + t;
    const int zcs[7] = {h * 64, 512 + h * 64, 1024 + h * 64, 1536, 1600, 1664, 1728};
#pragma unroll
    for (int gi = 0; gi < 7; ++gi) {
      const int zc = zcs[gi] + c8;
      float cur[8], prv[8];
      unpack8(*(const uint4*)(z + (size_t)m * ZLD + zc), cur);
      bool zero = false, fromstate = false;
      if (!sample) zero = (t == 0 && cc == 0);
      else fromstate = ((t & 3) == 0);
      if (zero) {
#pragma unroll
        for (int i = 0; i < 8; ++i) prv[i] = 0.f;
      } else if (fromstate) {
        const int b = (m - M_P) >> 2;
        const float* sp = p.in[2] + (size_t)(l * 128 + b) * 1792 + zc;
        float4 a = *(const float4*)sp, bb = *(const float4*)(sp + 4);
        prv[0] = a.x; prv[1] = a.y; prv[2] = a.z; prv[3] = a.w; prv[4] = bb.x; prv[5] = bb.y; prv[6] = bb.z; prv[7] = bb.w;
      } else {
        unpack8(*(const uint4*)(z + (size_t)(m - 1) * ZLD + zc), prv);
      }
      float* d = SL(gi) + t * 65 + c8;
#pragma unroll
      for (int i = 0; i < 8; ++i) {
        float v = cur[i] + mu[zc + i] * (prv[i] - cur[i]);
        if (gi == 3) v = tanhf(v);
        if (gi >= 5) v = sigm(v);
        d[i] = v;
      }
    }
  }
  const int lt = tid & 63, jg = tid >> 6;
  auto load_w = [&](const float* W, int nrows) {
    for (int e = tid; e < nrows * 8; e += NT) {
      const int i = e >> 3, c = (e & 7) * 8;
      const float* s = W + (size_t)i * 512 + h * 64 + c;
      *(float4*)(wbuf + i * 64 + c) = *(const float4*)s;
      *(float4*)(wbuf + i * 64 + c + 4) = *(const float4*)(s + 4);
    }
  };
  auto lora = [&](const float* xa, const float* xb, int n, float* acc) {
#pragma unroll 2
    for (int i = 0; i < n; ++i) {
      const float x = (i < 64) ? xa[lt * 65 + i] : xb[lt * 65 + i - 64];
      const float4 w0 = *(const float4*)(wbuf + i * 64 + jg * 8);
      const float4 w1 = *(const float4*)(wbuf + i * 64 + jg * 8 + 4);
      acc[0] += x * w0.x; acc[1] += x * w0.y; acc[2] += x * w0.z; acc[3] += x * w0.w;
      acc[4] += x * w1.x; acc[5] += x * w1.y; acc[6] += x * w1.z; acc[7] += x * w1.w;
    }
  };
  float res[8];
  load_w(p.in[11] + (size_t)l * 64 * 512, 64);
  __syncthreads();
#pragma unroll
  for (int i = 0; i < 8; ++i) res[i] = p.in[10][l * 512 + h * 64 + jg * 8 + i];
  lora(SL(3), SL(3), 64, res);
  __syncthreads();
#pragma unroll
  for (int i = 0; i < 8; ++i) {
    const float x = -res[i];
    const float sp = (x > 20.f) ? x : log1pf(__expf(x));
    SL(3)[lt * 65 + jg * 8 + i] = -__expf(-sp - 0.5f);
  }
  load_w(p.in[13] + (size_t)l * 64 * 512, 64);
  __syncthreads();
#pragma unroll
  for (int i = 0; i < 8; ++i) res[i] = p.in[12][l * 512 + h * 64 + jg * 8 + i];
  lora(SL(4), SL(4), 64, res);
  __syncthreads();
#pragma unroll
  for (int i = 0; i < 8; ++i) SL(4)[lt * 65 + jg * 8 + i] = sigm(res[i]);
  load_w(p.in[14] + (size_t)l * 128 * 512, 128);
  __syncthreads();
#pragma unroll
  for (int i = 0; i < 8; ++i) res[i] = 0.f;
  lora(SL(5), SL(6), 128, res);
  __syncthreads();
  if (!sample) {
    u16* ga = (u16*)(p.ws + WS_GA) + (size_t)item * 4096;
    *(uint4*)(ga + lt * 64 + jg * 8) = pack8(res);
    if (tid < 64) {
      float c = 0.f;
      for (int t = 0; t < 64; ++t) { c += SL(3)[t * 65 + tid]; SL(5)[t * 65 + tid] = c; }
      gc[tid] = __expf(c);
    }
  } else {
#pragma unroll
    for (int i = 0; i < 8; ++i) SL(6)[lt * 65 + jg * 8 + i] = res[i];
  }
  __syncthreads();
  {
    const int t = tid >> 3, j0 = (tid & 7) * 8;
    const float* kkw = p.in[15] + l * 512 + h * 64;
    const float* kaw = p.in[16] + l * 512 + h * 64;
    const float* rkw = p.in[17] + l * 512 + h * 64;
    float kr[8], av[8], rv[8], kkv[8], kf[8];
    float nrm = 0.f, bdot = 0.f;
#pragma unroll
    for (int i = 0; i < 8; ++i) {
      const int j = j0 + i;
      kr[i] = SL(1)[t * 65 + j]; av[i] = SL(4)[t * 65 + j]; rv[i] = SL(0)[t * 65 + j];
      kkv[i] = kr[i] * kkw[j];
      nrm += kkv[i] * kkv[i];
      kf[i] = kr[i] * (1.f + (av[i] - 1.f) * kaw[j]);
      bdot += rv[i] * kf[i] * rkw[j];
    }
    nrm += __shfl_xor(nrm, 1, 64); nrm += __shfl_xor(nrm, 2, 64); nrm += __shfl_xor(nrm, 4, 64);
    bdot += __shfl_xor(bdot, 1, 64); bdot += __shfl_xor(bdot, 2, 64); bdot += __shfl_xor(bdot, 4, 64);
    const float rn = 1.f / fmaxf(sqrtf(nrm), 1e-12f);
    if (!sample) {
      float bo[8];
#pragma unroll
      for (int i = 0; i < 8; ++i) {
        const int j = j0 + i;
        const float cum = SL(5)[t * 65 + j], dl = SL(3)[t * 65 + j];
        const float eg = __expf(cum), egi = __expf(-cum), egp = __expf(cum - dl);
        const float kk = kkv[i] * rn;
        SL(0)[t * 65 + j] = rv[i] * eg;
        SL(1)[t * 65 + j] = kf[i] * egi;
        SL(3)[t * 65 + j] = kk * av[i] * egi;
        SL(4)[t * 65 + j] = kk * egp;
        bo[i] = bdot * SL(2)[t * 65 + j];
      }
      u16* bop = (u16*)(p.ws + WS_BO) + (size_t)item * 4096;
      *(uint4*)(bop + t * 64 + j0) = pack8(bo);
    } else {
#pragma unroll
      for (int i = 0; i < 8; ++i) {
        const int j = j0 + i;
        const float kk = kkv[i] * rn;
        const float dl = SL(3)[t * 65 + j];
        SL(1)[t * 65 + j] = kf[i];
        SL(3)[t * 65 + j] = __expf(dl);
        SL(4)[t * 65 + j] = kk;
        SL(5)[t * 65 + j] = kk * av[i];
      }
      if ((tid & 7) == 0) bd[t] = bdot;
    }
  }
  __syncthreads();
  if (sample) {
    const float lng = p.in[18][l * 512 + h * 64 + lane], lnb = p.in[19][l * 512 + h * 64 + lane];
    for (int round = 0; round < 2; ++round) {
      const int seq = wave + 8 * round;
      const int b = cidx * 16 + seq;
      float S[64];
      const float* sp = p.in[3] + ((size_t)((l * 128 + b) * 8 + h) * 64 + lane) * 64;
#pragma unroll
      for (int k = 0; k < 64; k += 4) { float4 v = *(const float4*)(sp + k); S[k] = v.x; S[k + 1] = v.y; S[k + 2] = v.z; S[k + 3] = v.w; }
      for (int tt = 0; tt < 4; ++tt) {
        const int t = seq * 4 + tt;
        float sk = 0.f;
#pragma unroll
        for (int kc = 0; kc < 64; kc += 8) {
#pragma unroll
          for (int k = kc; k < kc + 8; ++k) sk += S[k] * SL(4)[t * 65 + k];
          __builtin_amdgcn_sched_barrier(0);
        }
        const float vt = SL(2)[t * 65 + lane];
        float y = 0.f;
#pragma unroll
        for (int kc = 0; kc < 64; kc += 8) {
#pragma unroll
          for (int k = kc; k < kc + 8; ++k) {
            S[k] = S[k] * SL(3)[t * 65 + k] - sk * SL(5)[t * 65 + k] + vt * SL(1)[t * 65 + k];
            y += S[k] * SL(0)[t * 65 + k];
          }
          __builtin_amdgcn_sched_barrier(0);
        }
        const float mean = wave_sum(y) * (1.f / 64.f);
        const float d = y - mean;
        const float var = wave_sum(d * d) * (1.f / 64.f);
        const float yn = d * rsqrtf(var + 64e-5f) * lng + lnb;
        const float o = (yn + bd[t] * vt) * SL(6)[t * 65 + lane];
        zw_[(size_t)(M_P + b * 4 + tt) * ZLD + h * 64 + lane] = f2bf(o);
      }
      float* op = p.out + O_SWKV + ((size_t)((l * 128 + b) * 8 + h) * 64 + lane) * 64;
#pragma unroll
      for (int k = 0; k < 64; k += 4) *(float4*)(op + k) = make_float4(S[k], S[k + 1], S[k + 2], S[k + 3]);
    }
    return;
  }
  {
    const int i = lane, tg = wave;
    float ab[8], ak[8], akr[8], abr[8];
#pragma unroll
    for (int q = 0; q < 8; ++q) { ab[q] = 0.f; ak[q] = 0.f; akr[q] = 0.f; abr[q] = 0.f; }
#pragma unroll 2
    for (int k = 0; k < 64; ++k) {
      const float xb = SL(3)[i * 65 + k], xk = SL(1)[i * 65 + k];
#pragma unroll
      for (int q = 0; q < 8; ++q) {
        const int t = tg * 8 + q;
        const float yk = SL(4)[t * 65 + k], yr = SL(0)[t * 65 + k];
        ab[q] += xb * yk; ak[q] += xk * yk; akr[q] += xk * yr; abr[q] += xb * yr;
      }
    }
    __syncthreads();
#pragma unroll
    for (int q = 0; q < 8; ++q) {
      const int t = tg * 8 + q;
      SL(6)[i * 65 + t] = (i < t) ? ab[q] : 0.f;
      SL(7)[i * 65 + t] = (i < t) ? ak[q] : 0.f;
      SL(8)[i * 65 + t] = (i <= t) ? akr[q] : 0.f;
      SL(5)[i * 65 + t] = (i <= t) ? abr[q] : 0.f;
    }
  }
  __syncthreads();
  {
    const int t = tid >> 3, j0 = (tid & 7) * 8;
#pragma unroll
    for (int i = 0; i < 8; ++i) { const float g = gc[j0 + i]; SL(3)[t * 65 + j0 + i] *= g; SL(1)[t * 65 + j0 + i] *= g; }
  }
  __syncthreads();
  if (tid < 128) {
    float* X_ = (tid < 64) ? SL(5) : SL(3);
    const int col = tid & 63;
    for (int i = 62; i >= 0; --i) {
      float a = X_[i * 65 + col];
#pragma unroll 4
      for (int t = i + 1; t < 64; ++t) a -= SL(6)[i * 65 + t] * X_[t * 65 + col];
      X_[i * 65 + col] = a;
    }
  }
  __syncthreads();
  {
    const int c = tid & 127, ig = tid >> 7;
    const int which = c >> 6, cq = c & 63;
    const float* N_ = which ? SL(3) : SL(5);
    float a[16];
#pragma unroll
    for (int q = 0; q < 16; ++q) a[q] = 0.f;
#pragma unroll 2
    for (int t = 0; t < 64; ++t) {
      const float n = N_[t * 65 + cq];
#pragma unroll
      for (int q = 0; q < 16; ++q) a[q] += SL(7)[(ig * 16 + q) * 65 + t] * n;
    }
    float* T_ = which ? SL(1) : SL(8);
#pragma unroll
    for (int q = 0; q < 16; ++q) T_[(ig * 16 + q) * 65 + cq] -= a[q];
  }
  __syncthreads();
  {
    const int x = lane, yg = wave;
    float w2[8], pp[8], yl[8], qq[8];
#pragma unroll
    for (int q = 0; q < 8; ++q) { w2[q] = 0.f; pp[q] = 0.f; yl[q] = 0.f; qq[q] = 0.f; }
#pragma unroll 2
    for (int j = 0; j < 64; ++j) {
      const float l5 = SL(5)[j * 65 + x], l4 = SL(4)[j * 65 + x], l8 = SL(8)[j * 65 + x], l2 = SL(2)[j * 65 + x];
#pragma unroll
      for (int q = 0; q < 8; ++q) {
        const int y = yg * 8 + q;
        w2[q] += l5 * SL(4)[j * 65 + y];
        pp[q] += l4 * SL(3)[j * 65 + y];
        yl[q] += l8 * SL(2)[j * 65 + y];
        qq[q] += l2 * SL(1)[j * 65 + y];
      }
    }
    float o1[8], o2[8];
#pragma unroll
    for (int q = 0; q < 8; ++q) {
      const int y = yg * 8 + q;
      o1[q] = SL(0)[x * 65 + y] - w2[q];
      o2[q] = ((x == y) ? gc[x] : 0.f) - pp[q];
    }
    float* Pp = (float*)(p.ws + WS_P) + (size_t)item * 4096 + x * 64 + yg * 8;
    float* Qp = (float*)(p.ws + WS_Q) + (size_t)item * 4096 + x * 64 + yg * 8;
    *(float4*)Pp = make_float4(o2[0], o2[1], o2[2], o2[3]); *(float4*)(Pp + 4) = make_float4(o2[4], o2[5], o2[6], o2[7]);
    *(float4*)Qp = make_float4(qq[0], qq[1], qq[2], qq[3]); *(float4*)(Qp + 4) = make_float4(qq[4], qq[5], qq[6], qq[7]);
    u16* W2p = (u16*)(p.ws + WS_W2) + (size_t)item * 4096 + x * 64 + yg * 8;
    u16* YLp = (u16*)(p.ws + WS_YL) + (size_t)item * 4096 + x * 64 + yg * 8;
    *(uint4*)W2p = pack8(o1);
    *(uint4*)YLp = pack8(yl);
  }
}

__device__ void rwkv_scan(const Params& p, int l, int bh, float* ldsf) {
  const int tid = opq(threadIdx.x), v = tid & 63, kg = tid >> 6;
  const int b = bh >> 3, h = bh & 7;
  float* Sl = ldsf;
  float* Pl = ldsf + 4160;
  __syncthreads();
  for (int e = tid; e < 4160; e += NT) Sl[e] = 0.f;
  for (int cc = 0; cc < 128; ++cc) {
    const size_t id = (size_t)((b * 128 + cc) * 8 + h);
    const float* Pg = (const float*)(p.ws + WS_P) + id * 4096;
    float* Qg = (float*)(p.ws + WS_Q) + id * 4096;
    {
      const int row = tid >> 3, c = (tid & 7) * 8;
      *(float4*)(Pl + row * 68 + c) = *(const float4*)(Pg + row * 64 + c);
      *(float4*)(Pl + row * 68 + c + 4) = *(const float4*)(Pg + row * 64 + c + 4);
    }
    float4 q0 = *(const float4*)(Qg + v * 64 + kg * 8), q1 = *(const float4*)(Qg + v * 64 + kg * 8 + 4);
    float a[8] = {q0.x, q0.y, q0.z, q0.w, q1.x, q1.y, q1.z, q1.w};
    __syncthreads();
    {
      float s[8];
#pragma unroll
      for (int j = 0; j < 8; ++j) s[j] = Sl[v * 65 + kg * 8 + j];
      *(float4*)(Qg + v * 64 + kg * 8) = make_float4(s[0], s[1], s[2], s[3]);
      *(float4*)(Qg + v * 64 + kg * 8 + 4) = make_float4(s[4], s[5], s[6], s[7]);
    }
#pragma unroll 4
    for (int k = 0; k < 64; ++k) {
      const float s = Sl[v * 65 + k];
      const float4 p0 = *(const float4*)(Pl + k * 68 + kg * 8), p1 = *(const float4*)(Pl + k * 68 + kg * 8 + 4);
      a[0] += s * p0.x; a[1] += s * p0.y; a[2] += s * p0.z; a[3] += s * p0.w;
      a[4] += s * p1.x; a[5] += s * p1.y; a[6] += s * p1.z; a[7] += s * p1.w;
    }
    __syncthreads();
#pragma unroll
    for (int j = 0; j < 8; ++j) Sl[v * 65 + kg * 8 + j] = a[j];
  }
  __syncthreads();
  {
    float* o = p.out + O_PWKV + ((size_t)((l * 2 + b) * 8 + h) * 64 + v) * 64 + kg * 8;
    float s[8];
#pragma unroll
    for (int j = 0; j < 8; ++j) s[j] = Sl[v * 65 + kg * 8 + j];
    *(float4*)o = make_float4(s[0], s[1], s[2], s[3]);
    *(float4*)(o + 4) = make_float4(s[4], s[5], s[6], s[7]);
  }
}

__device__ void rwkv_out(const Params& p, int l, int item, float* ldsf) {
  const int tid = opq(threadIdx.x), lane = tid & 63, wave = tid >> 6;
  const int h = item & 7, cidx = item >> 3;
  float* Sl = ldsf; float* Wl = ldsf + 4160;
  const float* Sg = (const float*)(p.ws + WS_Q) + (size_t)item * 4096;
  const u16* W2 = (const u16*)(p.ws + WS_W2) + (size_t)item * 4096;
  const u16* YL = (const u16*)(p.ws + WS_YL) + (size_t)item * 4096;
  const u16* BO = (const u16*)(p.ws + WS_BO) + (size_t)item * 4096;
  const u16* GA = (const u16*)(p.ws + WS_GA) + (size_t)item * 4096;
  u16* z = (u16*)(p.ws + WS_Z);
  __syncthreads();
  {
    const int row = tid >> 3, c = (tid & 7) * 8;
    float4 a = *(const float4*)(Sg + row * 64 + c), bq = *(const float4*)(Sg + row * 64 + c + 4);
    float* d = Sl + row * 65 + c;
    d[0] = a.x; d[1] = a.y; d[2] = a.z; d[3] = a.w; d[4] = bq.x; d[5] = bq.y; d[6] = bq.z; d[7] = bq.w;
    float w[8];
    unpack8(*(const uint4*)(W2 + row * 64 + c), w);
    float* e = Wl + row * 65 + c;
#pragma unroll
    for (int i = 0; i < 8; ++i) e[i] = w[i];
  }
  __syncthreads();
  float y[8];
#pragma unroll
  for (int q = 0; q < 8; ++q) y[q] = bf2f(YL[(wave * 8 + q) * 64 + lane]);
#pragma unroll 2
  for (int k = 0; k < 64; ++k) {
    const float s = Sl[lane * 65 + k];
#pragma unroll
    for (int q = 0; q < 8; ++q) y[q] += s * Wl[(wave * 8 + q) * 65 + k];
  }
  const float lng = p.in[18][l * 512 + h * 64 + lane], lnb = p.in[19][l * 512 + h * 64 + lane];
#pragma unroll
  for (int q = 0; q < 8; ++q) {
    const int t = wave * 8 + q;
    const float mean = wave_sum(y[q]) * (1.f / 64.f);
    const float d = y[q] - mean;
    const float var = wave_sum(d * d) * (1.f / 64.f);
    const float yn = d * rsqrtf(var + 64e-5f) * lng + lnb;
    const float o = (yn + bf2f(BO[t * 64 + lane])) * bf2f(GA[t * 64 + lane]);
    z[(size_t)(cidx * 64 + t) * ZLD + h * 64 + lane] = f2bf(o);
  }
}

__device__ void attn_prompt(const Params& p, int l, int item, u16* lds) {
  const int tid = opq(threadIdx.x), lane = tid & 63, wave = tid >> 6;
  const int r = lane & 31, h = lane >> 5;
  const int kvh = item & 1, n = (item >> 1) & 63, b = item >> 7;
  u16* z = (u16*)(p.ws + WS_Z);
  u16* Ks = lds;
  u16* Vt = lds + 256 * 72;
  __syncthreads();
  {
    const int key = tid >> 1, half = tid & 1;
    const int t = (n - 1) * 128 + key;
    uint4 kv[4], vv[4];
    if (t >= 0) {
      const u16* kp = z + (size_t)(b * 8192 + t) * ZLD + 2304 + kvh * 64 + half * 32;
      const u16* vp = z + (size_t)(b * 8192 + t) * ZLD + 2432 + kvh * 64 + half * 32;
#pragma unroll
      for (int i = 0; i < 4; ++i) { kv[i] = *(const uint4*)(kp + i * 8); vv[i] = *(const uint4*)(vp + i * 8); }
    } else {
#pragma unroll
      for (int i = 0; i < 4; ++i) { kv[i] = make_uint4(0, 0, 0, 0); vv[i] = make_uint4(0, 0, 0, 0); }
    }
#pragma unroll
    for (int i = 0; i < 4; ++i) {
      *(uint4*)(Ks + key * 72 + half * 32 + i * 8) = kv[i];
      const unsigned w[4] = {vv[i].x, vv[i].y, vv[i].z, vv[i].w};
#pragma unroll
      for (int q = 0; q < 4; ++q) {
        const int d = half * 32 + i * 8 + q * 2;
        Vt[d * 264 + key] = (u16)(w[q] & 0xFFFFu);
        Vt[(d + 1) * 264 + key] = (u16)(w[q] >> 16);
      }
    }
  }
  __syncthreads();
#pragma unroll 1
  for (int uu = 0; uu < 2; ++uu) {
    const int u = wave * 2 + uu;
    const int hq = kvh * 4 + (u >> 2), qg = u & 3;
    const int qrow = b * 8192 + n * 128 + qg * 32 + r;
    u16* qp = z + (size_t)qrow * ZLD + 1792 + hq * 64;
    bf16x8 qf[4];
#pragma unroll
    for (int s = 0; s < 4; ++s) qf[s] = *(const bf16x8*)(qp + s * 16 + h * 8);
    f32x16 sc[5];
#pragma unroll
    for (int i5 = 0; i5 < 5; ++i5) {
#pragma unroll
      for (int i = 0; i < 16; ++i) sc[i5][i] = 0.f;
      const int kt = qg + i5;
#pragma unroll
      for (int s = 0; s < 4; ++s) {
        bf16x8 kf = *(const bf16x8*)(Ks + (kt * 32 + r) * 72 + s * 16 + h * 8);
        sc[i5] = __builtin_amdgcn_mfma_f32_32x32x16_bf16(kf, qf[s], sc[i5], 0, 0, 0);
      }
      __builtin_amdgcn_sched_barrier(0);
    }
    const int qi = qg * 32 + r;
    const float sink = p.in[20][l * 8 + hq];
    float mx = -1e30f;
#pragma unroll
    for (int i5 = 0; i5 < 5; ++i5)
#pragma unroll
      for (int reg = 0; reg < 16; ++reg) {
        const int j = (qg + i5) * 32 + ROWOFF(reg, h);
        const bool ok = (j > qi) && (j <= qi + 128) && (n > 0 || j >= 128);
        const float s = ok ? sc[i5][reg] * 0.125f : -1e30f;
        sc[i5][reg] = s;
        mx = fmaxf(mx, s);
      }
    mx = fmaxf(mx, __shfl_xor(mx, 32, 64));
    mx = fmaxf(mx, sink);
    float sum = 0.f;
#pragma unroll
    for (int i5 = 0; i5 < 5; ++i5)
#pragma unroll
      for (int reg = 0; reg < 16; ++reg) { const float e = __expf(sc[i5][reg] - mx); sc[i5][reg] = e; sum += e; }
    sum += __shfl_xor(sum, 32, 64);
    const float rden = 1.f / (sum + __expf(sink - mx));
    f32x16 oacc[2];
#pragma unroll
    for (int i = 0; i < 16; ++i) { oacc[0][i] = 0.f; oacc[1][i] = 0.f; }
#pragma unroll
    for (int i5 = 0; i5 < 5; ++i5) {
      const int kt = qg + i5;
#pragma unroll
      for (int s2 = 0; s2 < 2; ++s2) {
        bf16x8 pf;
#pragma unroll
        for (int j = 0; j < 8; ++j) pf[j] = (short)f2bf(sc[i5][s2 * 8 + j] * rden);
#pragma unroll
        for (int dt = 0; dt < 2; ++dt) {
          const u16* vp = Vt + (dt * 32 + r) * 264 + kt * 32 + s2 * 16 + h * 4;
          const uint2 lo = *(const uint2*)vp, hi = *(const uint2*)(vp + 8);
          union { uint4 u; bf16x8 v; } cv;
          cv.u = make_uint4(lo.x, lo.y, hi.x, hi.y);
          oacc[dt] = __builtin_amdgcn_mfma_f32_32x32x16_bf16(cv.v, pf, oacc[dt], 0, 0, 0);
        }
        __builtin_amdgcn_sched_barrier(0);
      }
    }
#pragma unroll
    for (int dt = 0; dt < 2; ++dt)
#pragma unroll
      for (int g4 = 0; g4 < 4; ++g4) {
        const int d = dt * 32 + 8 * g4 + 4 * h;
        uint2 o;
        o.x = pack2(oacc[dt][g4 * 4 + 0], oacc[dt][g4 * 4 + 1]);
        o.y = pack2(oacc[dt][g4 * 4 + 2], oacc[dt][g4 * 4 + 3]);
        *(uint2*)(qp + d) = o;
      }
  }
}

__device__ void attn_sample(const Params& p, int l, int item, float* ldsf) {
  const int tid = opq(threadIdx.x);
  const int kvh = item & 1, b = item >> 1;
  u16* z = (u16*)(p.ws + WS_Z);
  float* Kl = ldsf;
  float* Vl = ldsf + 132 * 65;
  float* Ql = Vl + 132 * 65;
  float* Pl = Ql + 16 * 64;
  __syncthreads();
  for (int e = tid; e < 132 * 8; e += NT) {
    const int j = e >> 3, c = (e & 7) * 8;
    float k[8], v[8];
    if (j < 128) {
      const float* kp = p.in[4] + ((size_t)((l * 128 + b) * 128 + j) * 2 + kvh) * 64 + c;
      const float* vp = p.in[5] + ((size_t)((l * 128 + b) * 128 + j) * 2 + kvh) * 64 + c;
      float4 a = *(const float4*)kp, a2 = *(const float4*)(kp + 4);
      float4 c1 = *(const float4*)vp, c2 = *(const float4*)(vp + 4);
      k[0] = a.x; k[1] = a.y; k[2] = a.z; k[3] = a.w; k[4] = a2.x; k[5] = a2.y; k[6] = a2.z; k[7] = a2.w;
      v[0] = c1.x; v[1] = c1.y; v[2] = c1.z; v[3] = c1.w; v[4] = c2.x; v[5] = c2.y; v[6] = c2.z; v[7] = c2.w;
    } else {
      const size_t row = M_P + b * 4 + (j - 128);
      unpack8(*(const uint4*)(z + row * ZLD + 2304 + kvh * 64 + c), k);
      unpack8(*(const uint4*)(z + row * ZLD + 2432 + kvh * 64 + c), v);
    }
#pragma unroll
    for (int i = 0; i < 8; ++i) { Kl[j * 65 + c + i] = k[i]; Vl[j * 65 + c + i] = v[i]; }
    if (j >= 4) {
      float* ok = p.out + O_SK + ((size_t)((l * 128 + b) * 128 + (j - 4)) * 2 + kvh) * 64 + c;
      float* ov = p.out + O_SV + ((size_t)((l * 128 + b) * 128 + (j - 4)) * 2 + kvh) * 64 + c;
      *(float4*)ok = make_float4(k[0], k[1], k[2], k[3]); *(float4*)(ok + 4) = make_float4(k[4], k[5], k[6], k[7]);
      *(float4*)ov = make_float4(v[0], v[1], v[2], v[3]); *(float4*)(ov + 4) = make_float4(v[4], v[5], v[6], v[7]);
    }
  }
  if (tid < 128) {
    const int row = tid >> 3, c = (tid & 7) * 8;
    const int hl = row >> 2, t = row & 3;
    float q[8];
    unpack8(*(const uint4*)(z + (size_t)(M_P + b * 4 + t) * ZLD + 1792 + (kvh * 4 + hl) * 64 + c), q);
#pragma unroll
    for (int i = 0; i < 8; ++i) Ql[row * 64 + c + i] = q[i];
  }
  __syncthreads();
  const int row = tid >> 5, jl = tid & 31;
  const int t = row & 3, hq = kvh * 4 + (row >> 2);
  float sc[5];
  float mx = -1e30f;
#pragma unroll
  for (int jj = 0; jj < 5; ++jj) {
    const int j = jl + 32 * jj;
    float s = -1e30f;
    if (j < 132 && j > t && j <= t + 128) {
      float a = 0.f;
#pragma unroll 8
      for (int d = 0; d < 64; ++d) a += Ql[row * 64 + d] * Kl[j * 65 + d];
      s = a * 0.125f;
    }
    sc[jj] = s; mx = fmaxf(mx, s);
    __builtin_amdgcn_sched_barrier(0);
  }
#pragma unroll
  for (int o = 16; o >= 1; o >>= 1) mx = fmaxf(mx, __shfl_xor(mx, o, 64));
  const float sink = p.in[20][l * 8 + hq];
  mx = fmaxf(mx, sink);
  float sum = 0.f;
#pragma unroll
  for (int jj = 0; jj < 5; ++jj) { sc[jj] = __expf(sc[jj] - mx); sum += sc[jj]; }
#pragma unroll
  for (int o = 16; o >= 1; o >>= 1) sum += __shfl_xor(sum, o, 64);
  const float rden = 1.f / (sum + __expf(sink - mx));
#pragma unroll
  for (int jj = 0; jj < 5; ++jj) { const int j = jl + 32 * jj; if (j < 136) Pl[row * 136 + j] = sc[jj] * rden; }
  __syncthreads();
  {
    const int d = jl * 2;
    float o0 = 0.f, o1 = 0.f;
#pragma unroll 4
    for (int j = 0; j < 132; ++j) { const float pr = Pl[row * 136 + j]; o0 += pr * Vl[j * 65 + d]; o1 += pr * Vl[j * 65 + d + 1]; }
    *(unsigned*)(z + (size_t)(M_P + b * 4 + t) * ZLD + 1792 + hq * 64 + d) = pack2(o0, o1);
  }
}

__device__ void phase_merge(const Params& p, int l, u16* lds) {
  const u16* Wt = (const u16*)(p.ws + WS_WT);
  const float* rstd = (const float*)(p.ws + WS_RSTD);
  const u16* z = (const u16*)(p.ws + WS_Z);
  u16* mg = (u16*)(p.ws + WS_R);
  const float* X = p.out;
  for (int it = blockIdx.x; it < 66 * 8; it += gridDim.x) {
    const int tn = it & 7, tm = it >> 3;
    const int m0 = tm * 256, n0 = tn * 128;
    f32x16 acc[2][2];
    u16* tmp = mg + (size_t)M_TOT * 1024;
#pragma unroll 1
    for (int pass = 0; pass < 2; ++pass) {
      const int tid = opq(threadIdx.x), lane = tid & 63, wave = tid >> 6;
      const int wm = wave >> 1, wn = wave & 1, r = lane & 31, h = lane >> 5;
      zero_acc(acc);
      gemm_loop<true>(X + (size_t)m0 * 1024, 1024, Wt + WT_IN + (size_t)(2560 + pass * 1024 + n0) * 1024, 1024, 1024, acc, lds, tid);
#pragma unroll
      for (int mi = 0; mi < 2; ++mi)
#pragma unroll
        for (int reg = 0; reg < 16; ++reg) {
          const int row = m0 + wm * 64 + mi * 32 + ROWOFF(reg, h);
          const float rs = rstd[row];
#pragma unroll
          for (int ni = 0; ni < 2; ++ni)
            tmp[(size_t)row * 1024 + n0 + wn * 64 + ni * 32 + r] = f2bf(sigm(acc[mi][ni][reg] * rs));
          if ((reg & 3) == 3) __builtin_amdgcn_sched_barrier(0);
        }
      zero_acc(acc);
      gemm_loop<false>(z + (size_t)m0 * ZLD + pass * 1792, ZLD, Wt + (pass ? WT_BRB : WT_BRA) + (size_t)n0 * 512, 512, 512, acc, lds, tid);
#pragma unroll
      for (int mi = 0; mi < 2; ++mi)
#pragma unroll
        for (int ni = 0; ni < 2; ++ni)
#pragma unroll
          for (int reg = 0; reg < 16; ++reg) {
            const int row = m0 + wm * 64 + mi * 32 + ROWOFF(reg, h);
            const size_t off = (size_t)row * 1024 + n0 + wn * 64 + ni * 32 + r;
            float v = acc[mi][ni][reg] * bf2f(tmp[off]);
            if (pass) v += bf2f(mg[off]);
            mg[off] = f2bf(v);
            if ((reg & 3) == 3) __builtin_amdgcn_sched_barrier(0);
          }
    }
  }
}

__device__ void phase_resid(const Params& p, const u16* A, int lda, const u16* Bt, int K, u16* lds) {
  float* X = p.out;
  for (int it = blockIdx.x; it < 66 * 8; it += gridDim.x) {
    const int tid = opq(threadIdx.x), lane = tid & 63, wave = tid >> 6;
    const int wm = wave >> 1, wn = wave & 1, r = lane & 31, h = lane >> 5;
    const int tn = it & 7, tm = it >> 3;
    const int m0 = tm * 256, n0 = tn * 128;
    f32x16 acc[2][2];
    zero_acc(acc);
    gemm_loop<false>(A + (size_t)m0 * lda, lda, Bt + (size_t)n0 * K, K, K, acc, lds, tid);
#pragma unroll
    for (int mi = 0; mi < 2; ++mi)
#pragma unroll
      for (int ni = 0; ni < 2; ++ni)
#pragma unroll
        for (int reg = 0; reg < 16; ++reg) {
          const int row = m0 + wm * 64 + mi * 32 + ROWOFF(reg, h);
          float* xp = X + (size_t)row * 1024 + n0 + wn * 64 + ni * 32 + r;
          *xp = *xp + acc[mi][ni][reg];
        }
  }
}

__device__ void phase_ffnin(const Params& p, u16* lds) {
  const u16* Wt = (const u16*)(p.ws + WS_WT) + WT_FIN;
  const float* rstd = (const float*)(p.ws + WS_RSTD);
  u16* cu = (u16*)(p.ws + WS_Z);
  const float* X = p.out;
  for (int it = blockIdx.x; it < 66 * 44; it += gridDim.x) {
    const int tid = opq(threadIdx.x), lane = tid & 63, wave = tid >> 6;
    const int wm = wave >> 1, wn = wave & 1, r = lane & 31, h = lane >> 5;
    const int tn = it % 44, tm = it / 44;
    const int m0 = tm * 256, n0 = tn * 128;
    f32x16 acc[2][2];
    zero_acc(acc);
    gemm_loop<true>(X + (size_t)m0 * 1024, 1024, Wt + (size_t)n0 * 1024, 1024, 1024, acc, lds, tid);
#pragma unroll
    for (int mi = 0; mi < 2; ++mi)
#pragma unroll
      for (int reg = 0; reg < 16; ++reg) {
        const int row = m0 + wm * 64 + mi * 32 + ROWOFF(reg, h);
        const float rs = rstd[row];
#pragma unroll
        for (int ni = 0; ni < 2; ++ni)
          cu[(size_t)row * 5632 + n0 + wn * 64 + ni * 32 + r] = f2bf(acc[mi][ni][reg] * rs);
      }
  }
}

__device__ void phase_convgelu(const Params& p, int l) {
  u16* cu = (u16*)(p.ws + WS_Z);
  const float* cw = p.in[26] + (size_t)l * 3 * 2816;
  const float* cb = p.in[27] + (size_t)l * 2816;
  for (int it = blockIdx.x; it < 1056; it += gridDim.x) {
    const int tid = opq(threadIdx.x);
    if (tid >= 352) continue;
    const int j0 = tid * 8;
    float w0[8], w1[8], w2[8], bb[8];
#pragma unroll
    for (int i = 0; i < 8; ++i) { w0[i] = cw[j0 + i]; w1[i] = cw[2816 + j0 + i]; w2[i] = cw[5632 + j0 + i]; bb[i] = cb[j0 + i]; }
    float c1[8], c2[8];
    for (int rr = 0; rr < 16; ++rr) {
      const int row = it * 16 + rr;
      const bool prompt = row < M_P;
      int b, t;
      if (prompt) { b = row >> 13; t = row & 8191; } else { b = (row - M_P) >> 2; t = (row - M_P) & 3; }
      if (t == 0) {
        if (prompt) {
#pragma unroll
          for (int i = 0; i < 8; ++i) { c1[i] = 0.f; c2[i] = 0.f; }
        } else {
          const float* st = p.in[6] + (size_t)((l * 128 + b) * 2) * 2816 + j0;
#pragma unroll
          for (int i = 0; i < 8; ++i) { c2[i] = st[i]; c1[i] = st[2816 + i]; }
        }
      } else if (rr == 0) {
        unpack8(*(const uint4*)(cu + (size_t)(row - 1) * 5632 + j0), c1);
        if (t >= 2) unpack8(*(const uint4*)(cu + (size_t)(row - 2) * 5632 + j0), c2);
        else {
#pragma unroll
          for (int i = 0; i < 8; ++i) c2[i] = 0.f;
        }
      }
      float c0[8], up[8], a[8];
      unpack8(*(const uint4*)(cu + (size_t)row * 5632 + j0), c0);
      unpack8(*(const uint4*)(cu + (size_t)row * 5632 + 2816 + j0), up);
#pragma unroll
      for (int i = 0; i < 8; ++i) {
        const float cv = bb[i] + w0[i] * c2[i] + w1[i] * c1[i] + w2[i] * c0[i];
        const float ge = 0.5f * cv * (1.f + erff(cv * 0.7071067811865476f));
        a[i] = ge * up[i];
      }
      *(uint4*)(cu + (size_t)row * 5632 + 2816 + j0) = pack8(a);
      if (prompt && t >= 8190) {
        float* o = p.out + O_PCONV + (size_t)((l * 2 + b) * 2 + (t - 8190)) * 2816 + j0;
        *(float4*)o = make_float4(c0[0], c0[1], c0[2], c0[3]); *(float4*)(o + 4) = make_float4(c0[4], c0[5], c0[6], c0[7]);
      } else if (!prompt && t >= 2) {
        float* o = p.out + O_SCONV + (size_t)((l * 128 + b) * 2 + (t - 2)) * 2816 + j0;
        *(float4*)o = make_float4(c0[0], c0[1], c0[2], c0[3]); *(float4*)(o + 4) = make_float4(c0[4], c0[5], c0[6], c0[7]);
      }
#pragma unroll
      for (int i = 0; i < 8; ++i) { c2[i] = c1[i]; c1[i] = c0[i]; }
    }
  }
}

__device__ void phase_final(const Params& p) {
  float* X = p.out;
  const float* g = p.in[29];
  for (int it = blockIdx.x; it < 2112; it += gridDim.x) {
    const int tid = opq(threadIdx.x);
    const int lane = tid & 63;
    const int row = it * 8 + (tid >> 6);
    float4 v[4];
    float ss = 0.f;
#pragma unroll
    for (int i = 0; i < 4; ++i) {
      v[i] = *(const float4*)(X + (size_t)row * 1024 + i * 256 + lane * 4);
      ss += v[i].x * v[i].x + v[i].y * v[i].y + v[i].z * v[i].z + v[i].w * v[i].w;
    }
    ss = wave_sum(ss);
    const float rs = rsqrtf(ss * (1.f / 1024.f) + 1e-6f);
#pragma unroll
    for (int i = 0; i < 4; ++i) {
      const float4 gg = *(const float4*)(g + i * 256 + lane * 4);
      *(float4*)(X + (size_t)row * 1024 + i * 256 + lane * 4) =
          make_float4(v[i].x * rs * gg.x, v[i].y * rs * gg.y, v[i].z * rs * gg.z, v[i].w * rs * gg.w);
    }
  }
}

template <int KMASK>
__global__ void __launch_bounds__(NT) fwd_kernel(Params p) {
  extern __shared__ __attribute__((aligned(16))) unsigned char lds_raw[];
  float* ldsf = (float*)lds_raw;
  u16* ldsh = (u16*)lds_raw;
  for (int ph = p.ph_lo; ph < p.ph_hi; ++ph) {
    if (ph == NPH - 1) {
      if ((KMASK >> 11) & 1) phase_final(p);
    } else {
      const int l = ph / 11, k = ph % 11;
      switch (k) {
        case 0: if (!((KMASK >> 0) & 1)) break; phase_prep(p, l, true, ldsf); break;
        case 1: if (!((KMASK >> 1) & 1)) break; phase_inproj(p, l, ldsh); break;
        case 2: if (!((KMASK >> 2) & 1)) break;
          for (int it = blockIdx.x; it < 2048 + 64; it += gridDim.x) {
            const int item = (it < 64) ? 2048 + it : it - 64;
            rwkv_item(p, l, item, ldsf);
          }
          break;
        case 3: if (!((KMASK >> 3) & 1)) break;
          if (blockIdx.x < 16) { if (T3 & 1) rwkv_scan(p, l, blockIdx.x, ldsf); }
          else {
            for (int it = blockIdx.x - 16; it < 512; it += gridDim.x - 16) {
              if (it < 256) { if (T3 & 2) attn_prompt(p, l, it, ldsh); } else { if (T3 & 4) attn_sample(p, l, it - 256, ldsf); }
            }
          }
          break;
        case 4: if (!((KMASK >> 4) & 1)) break;
          for (int it = blockIdx.x; it < 2048; it += gridDim.x) rwkv_out(p, l, it, ldsf);
          break;
        case 5: if (!((KMASK >> 5) & 1)) break; phase_merge(p, l, ldsh); break;
        case 6: if (!((KMASK >> 6) & 1)) break; phase_resid(p, (const u16*)(p.ws + WS_R), 1024, (const u16*)(p.ws + WS_WT) + WT_OUT, 1024, ldsh); break;
        case 7: if (!((KMASK >> 7) & 1)) break; phase_prep(p, l, false, ldsf); break;
        case 8: if (!((KMASK >> 8) & 1)) break; phase_ffnin(p, ldsh); break;
        case 9: if (!((KMASK >> 9) & 1)) break; phase_convgelu(p, l); break;
        case 10: if (!((KMASK >> 10) & 1)) break; phase_resid(p, (const u16*)(p.ws + WS_Z) + 2816, 5632, (const u16*)(p.ws + WS_WT) + WT_FDN, 2816, ldsh); break;
      }
    }
#if COOP
    if (ph + 1 < p.ph_hi) cg::this_grid().sync();
#endif
  }
}

template <int KM>
static void launch_one(const Params& p, int grid, hipStream_t stream) {
  static bool attr = false;
  if (!attr) { (void)hipFuncSetAttribute((const void*)fwd_kernel<KM>, hipFuncAttributeMaxDynamicSharedMemorySize, LDS_BYTES); attr = true; }
  hipLaunchKernelGGL(fwd_kernel<KM>, dim3(grid), dim3(NT), LDS_BYTES, stream, p);
}

extern "C" void kernel_launch(void* const* d_in, const int* in_sizes, int n_in, void* d_out, int out_size, void* d_ws,
                              size_t ws_size, hipStream_t stream) {
  static int grid = 0;
  if (grid == 0) {
    int dev = 0, cus = 0;
    (void)hipGetDevice(&dev);
    (void)hipDeviceGetAttribute(&cus, hipDeviceAttributeMultiprocessorCount, dev);
    grid = cus > 0 ? cus : 256;
    (void)hipGetLastError();
  }
  Params p{};
  for (int i = 0; i < 30; ++i) p.in[i] = (const float*)d_in[i];
  p.out = (float*)d_out;
  p.ws = (unsigned char*)d_ws;
#if COOP
  static bool attr = false;
  if (!attr) { (void)hipFuncSetAttribute((const void*)fwd_kernel<PHMASK>, hipFuncAttributeMaxDynamicSharedMemorySize, LDS_BYTES); attr = true; }
  p.ph_lo = 0; p.ph_hi = NPH;
  void* args[] = {&p};
  hipError_t e = hipLaunchCooperativeKernel((const void*)fwd_kernel<PHMASK>, dim3(grid), dim3(NT), args, LDS_BYTES, stream);
  if (e != hipSuccess) fprintf(stderr, "cooperative launch failed: %s (grid %d)\n", hipGetErrorString(e), grid);
#else
  for (int ph = 0; ph < NPH; ++ph) {
    p.ph_lo = ph; p.ph_hi = ph + 1;
    const int k = (ph == NPH - 1) ? 11 : ph % 11;
    switch (k) {
      case 0: launch_one<1 << 0>(p, grid, stream); break;
      case 1: launch_one<1 << 1>(p, grid, stream); break;
      case 2: launch_one<1 << 2>(p, grid, stream); break;
      case 3: launch_one<1 << 3>(p, grid, stream); break;
      case 4: launch_one<1 << 4>(p, grid, stream); break;
      case 5: launch_one<1 << 5>(p, grid, stream); break;
      case 6: launch_one<1 << 6>(p, grid, stream); break;
      case 7: launch_one<1 << 7>(p, grid, stream); break;
      case 8: launch_one<1 << 8>(p, grid, stream); break;
      case 9: launch_one<1 << 9>(p, grid, stream); break;
      case 10: launch_one<1 << 10>(p, grid, stream); break;
      default: launch_one<1 << 11>(p, grid, stream); break;
    }
  }
#endif
}
```

```cpp
#include <hip/hip_runtime.h>
#include <hip/hip_bf16.h>
#include <hip/hip_cooperative_groups.h>
#include <cstdio>
namespace cg = cooperative_groups;

typedef __attribute__((ext_vector_type(8))) short bf16x8;
typedef __attribute__((ext_vector_type(16))) float f32x16;
typedef unsigned short u16;

#ifndef PHMASK
#define PHMASK 0x1FFF
#endif
#ifndef T3
#define T3 7
#endif
#ifndef COOP
#define COOP 1
#endif

#define NT 512
#define M_TOT 16896
#define M_P 16384
#define ZLD 2560
#define NPH 25

#define WS_WT   0ull
#define WS_H    13631488ull
#define WS_Z    48234496ull
#define WS_R    134742016ull
#define WS_PP   (WS_R)
#define WS_GC   (WS_R + 16777216ull)
#define WS_Q    (WS_R + 17301504ull)
#define WS_W2   (WS_R + 50855936ull)
#define WS_YL   (WS_R + 67633152ull)
#define WS_BO   (WS_R + 84410368ull)
#define WS_GA   (WS_R + 101187584ull)
#define WS_T1   (WS_R)
#define WS_T2   (WS_R + 34603008ull)
#define WS_MG   (WS_R + 69206016ull)
#define WS_WTF  (WS_Z)
#define WS_CU   (WS_Z + 17301504ull)
#define WT_IN  0
#define WT_G   2621440
#define WT_BRA 4718592
#define WT_BRB 5242880
#define WT_OUT 5767168
#define WT_FIN 0
#define WT_FDN 5767168
#define O_PSHIFT 17301504
#define O_PWKV   17308672
#define O_PK     17439744
#define O_PV     17505280
#define O_PCONV  17570816
#define O_SSHIFT 17593344
#define O_SWKV   18052096
#define O_SK     26440704
#define O_SV     30635008
#define O_SCONV  34829312

#define LDS_BYTES 151552

struct Params {
  const float* in[30];
  float* out;
  unsigned char* ws;
  int ph_lo, ph_hi;
};

__device__ __forceinline__ u16 f2bf(float f) {
  unsigned u = __float_as_uint(f);
  u += 0x7FFFu + ((u >> 16) & 1u);
  return (u16)(u >> 16);
}
__device__ __forceinline__ float bf2f(u16 h) { return __uint_as_float(((unsigned)h) << 16); }
__device__ __forceinline__ unsigned pack2(float a, float b) { return (unsigned)f2bf(a) | ((unsigned)f2bf(b) << 16); }
__device__ __forceinline__ float sigm(float x) { return __builtin_amdgcn_rcpf(1.f + __expf(-x)); }
__device__ __forceinline__ void unpack8(uint4 u, float* o) {
  o[0] = __uint_as_float(u.x << 16); o[1] = __uint_as_float(u.x & 0xFFFF0000u);
  o[2] = __uint_as_float(u.y << 16); o[3] = __uint_as_float(u.y & 0xFFFF0000u);
  o[4] = __uint_as_float(u.z << 16); o[5] = __uint_as_float(u.z & 0xFFFF0000u);
  o[6] = __uint_as_float(u.w << 16); o[7] = __uint_as_float(u.w & 0xFFFF0000u);
}
__device__ __forceinline__ uint4 pack8(const float* f) {
  uint4 u; u.x = pack2(f[0], f[1]); u.y = pack2(f[2], f[3]); u.z = pack2(f[4], f[5]); u.w = pack2(f[6], f[7]); return u;
}
__device__ __forceinline__ int opq(int x) { asm volatile("" : "+v"(x)); return x; }
__device__ __forceinline__ float wave_sum(float x) {
#pragma unroll
  for (int o = 32; o >= 1; o >>= 1) x += __shfl_xor(x, o, 64);
  return x;
}

namespace pg8 {
#define PG8_LAS __attribute__((address_space(3)))
typedef unsigned short bf16_t;
typedef short bf16x8 __attribute__((ext_vector_type(8)));
typedef float f32x4 __attribute__((ext_vector_type(4)));
typedef unsigned u32x4 __attribute__((ext_vector_type(4)));
constexpr int BM = 256, BK = 64, HALF = 128, HTB = HALF * BK * 2  , STAGE_BYTES = 8 * HTB, NXCD = 8, WGM = 8;
__host__ __device__ __forceinline__ int lds_byte(int r, int c) { const int st = (r >> 4) * 2 + (c >> 5), rr = r & 15, cc = c & 31, ob = rr * 64 + cc * 2; return st * 1024 + (ob ^ (((ob >> 9) & 1) << 5)); }
__host__ __device__ __forceinline__ void stage_rc(int b, int& R, int& C) { const int st = b / 1024, sb = b % 1024, swz = sb ^ (((sb >> 9) & 1) << 5); R = (st >> 1) * 16 + swz / 64; C = (st & 1) * 32 + (swz % 64) / 2; }
__host__ __device__ __forceinline__ int perm32(int rho) { const int n = rho >> 4, i = rho & 15; return 8 * (i >> 2) + 4 * n + (i & 3); }
struct Unit { int pm, pn; };
struct Gemm { const bf16_t* A; const bf16_t* Bt; int M, N, K, lda; };
struct StaticOrder {
    int nM, nN, nwg, G, c;
    __host__ __device__ void init(int M, int N, int G_, int c_) { nM = M / BM; nN = N / BM; nwg = nM * nN; G = G_; c = c_; }
    __host__ __device__ bool next(int i, Unit& u) const {
        const long L = (long)i * G + c; if (L >= nwg) return false;
        int wgid = (int)L; { const int q = nwg / NXCD, r = nwg % NXCD, xcd = wgid % NXCD, off = wgid / NXCD; wgid = (xcd < r ? xcd * (q + 1) : r * (q + 1) + (xcd - r) * q) + off; }
        const int nig = WGM * nN, gid = wgid / nig, fm = gid * WGM, gsz = (nM - fm) < WGM ? (nM - fm) : WGM;
        u.pm = fm + ((wgid % nig) % gsz); u.pn = (wgid % nig) / gsz; return true;
    }
    __device__ __forceinline__ void a_ready(const Unit&) const {}
    __device__ __forceinline__ void done(const Unit&) const {}
};
__device__ __forceinline__ unsigned cvt_pk_bf16(float lo, float hi) { unsigned r; asm volatile("v_cvt_pk_bf16_f32 %0, %1, %2" : "=v"(r) : "v"(lo), "v"(hi)); return r; }
template <class Epi, class Sched, bool STAMP = false>
__device__ __forceinline__ void gemm_phase(PG8_LAS unsigned char* lds, const Gemm g, const Sched& S, const Epi& E, unsigned long long* stamps) {
    const int tid = ::opq(threadIdx.x), wid = __builtin_amdgcn_readfirstlane(tid >> 6), lane = tid & 63, wr = wid >> 2, wc = wid & 3, fr = lane & 15, fq = lane >> 4;
    const int K = g.K, nt = K / BK;
    int ts_lo = 0, ts_hi = 0, nts = 0; const unsigned long long rt_entry = 0ull;
#define PG8_STAMP() do { if (STAMP && wid == 0 && nts < 64) { const unsigned long long _c = (unsigned long long)clock64(); \
        ts_lo = (lane == nts) ? (int)(unsigned)_c : ts_lo; ts_hi = (lane == nts) ? (int)(unsigned)(_c >> 32) : ts_hi; ++nts; } } while (0)
    PG8_STAMP();
    unsigned voffA[2], voffB[2];
#pragma unroll
    for (int i = 0; i < 2; ++i) { int R, C; stage_rc(tid * 16 + i * 8192, R, C); const int Rb = Epi::PERM ? ((R & ~31) + perm32(R & 31)) : R;
        voffA[i] = (unsigned)(R * g.lda + C) * 2u; voffB[i] = (unsigned)(Rb * K + C) * 2u; }
    const size_t kstep = (size_t)(BK * 2);
    const size_t hstep = (size_t)HALF * K * 2;
    const size_t tstep = 2 * hstep; const size_t hstepA = (size_t)HALF * g.lda * 2; const size_t tstepA = 2 * hstepA;
    const unsigned ldsw = (unsigned)wid * 1024u;
    const int aoff = lds_byte(wr * 64 + fr, fq * 8), boff = lds_byte(wc * 32 + fr, fq * 8);
#define PG8_SA(b, h) (((b) * 2 + (h)) * HTB)
#define PG8_SB(b, h) ((4 + (b) * 2 + (h)) * HTB)
#define PG8_STAGE(bufoff, gbase, voff) do { _Pragma("unroll") for (int _i = 0; _i < 2; ++_i) \
        __builtin_amdgcn_global_load_lds((const unsigned*)((const char*)(gbase) + (voff)[_i]), (PG8_LAS unsigned*)(lds + (bufoff) + ldsw + _i * 8192), 16, 0, 0); } while (0)
#define PG8_LDA(dst, b, h) do { _Pragma("unroll") for (int m = 0; m < 4; ++m) _Pragma("unroll") for (int k = 0; k < 2; ++k) dst[m][k] = *(const PG8_LAS bf16x8*)(lds + PG8_SA(b, h) + aoff + m * 2048 + k * 1024); } while (0)
#define PG8_LDB(dst, b, h) do { _Pragma("unroll") for (int n = 0; n < 2; ++n) _Pragma("unroll") for (int k = 0; k < 2; ++k) dst[n][k] = *(const PG8_LAS bf16x8*)(lds + PG8_SB(b, h) + boff + n * 2048 + k * 1024); } while (0)
#define PG8_MMA(ai, bj, At, Bt) do { __builtin_amdgcn_s_setprio(1); _Pragma("unroll") for (int m = 0; m < 4; ++m) _Pragma("unroll") for (int n = 0; n < 2; ++n) _Pragma("unroll") for (int k = 0; k < 2; ++k) \
        acc[ai][bj][m][n] = __builtin_amdgcn_mfma_f32_16x16x32_bf16(Bt[n][k], At[m][k], acc[ai][bj][m][n], 0, 0, 0); __builtin_amdgcn_s_setprio(0); } while (0)
#define PG8_WAIT_V(n) asm volatile("s_waitcnt vmcnt(" #n ")" ::: "memory")
#define PG8_WAIT_L(n) asm volatile("s_waitcnt lgkmcnt(" #n ")" ::: "memory")
#define PG8_BAR __builtin_amdgcn_s_barrier()
#define PG8_SCHED __builtin_amdgcn_sched_barrier(0)
    Unit cur, nxt; int ui = 0;
    if (!S.next(0, cur)) return;
    f32x4 acc[2][2][4][2];
#pragma unroll
    for (int a = 0; a < 2; ++a)
#pragma unroll
        for (int b = 0; b < 2; ++b)
#pragma unroll
            for (int m = 0; m < 4; ++m)
#pragma unroll
                for (int n = 0; n < 2; ++n) acc[a][b][m][n] = (f32x4){0.f, 0.f, 0.f, 0.f};
    bf16x8 At[4][2], B0[2][2], B1[2][2];
    const char* cA = (const char*)g.A + (size_t)cur.pm * tstepA; const char* cB = (const char*)g.Bt + (size_t)cur.pn * tstep;
    S.a_ready(cur);
    PG8_STAGE(PG8_SB(0, 0), cB, voffB); PG8_STAGE(PG8_SA(0, 0), cA, voffA); PG8_STAGE(PG8_SB(0, 1), cB + hstep, voffB); PG8_STAGE(PG8_SA(0, 1), cA + hstepA, voffA);
    if (wr == 1) PG8_BAR;
    PG8_WAIT_V(4); PG8_BAR;
    PG8_STAGE(PG8_SB(1, 0), cB + kstep, voffB); PG8_STAGE(PG8_SA(1, 0), cA + kstep, voffA); PG8_STAGE(PG8_SB(1, 1), cB + hstep + kstep, voffB);
    PG8_WAIT_V(6); PG8_BAR;
    PG8_STAMP();
    for (;;) {
        const bool has_next = S.next(ui + 1, nxt);
        const char* nA = has_next ? (const char*)g.A + (size_t)nxt.pm * tstepA : cA; const char* nB = has_next ? (const char*)g.Bt + (size_t)nxt.pn * tstep : cB;
        for (int t = 0; t < nt; t += 2) {
            const bool last = (t == nt - 2);
            const char* a1 = cA + (size_t)(t + 1) * kstep;
            const char* a2 = last ? nA : cA + (size_t)(t + 2) * kstep; const char* b2 = last ? nB : cB + (size_t)(t + 2) * kstep;
            const char* a3 = a2 + kstep; const char* b3 = b2 + kstep;
            if (last && has_next) S.a_ready(nxt);
            PG8_LDB(B0, 0, 0); PG8_SCHED; PG8_LDA(At, 0, 0); PG8_STAGE(PG8_SA(1, 1), a1 + hstepA, voffA);
            PG8_WAIT_L(8); PG8_BAR; PG8_WAIT_L(0); PG8_MMA(0, 0, At, B0); PG8_BAR; PG8_SCHED;
            PG8_LDB(B1, 0, 1); PG8_STAGE(PG8_SB(0, 0), b2, voffB);
            PG8_BAR; PG8_WAIT_L(0); PG8_MMA(0, 1, At, B1); PG8_BAR;
            PG8_LDA(At, 0, 1); PG8_STAGE(PG8_SA(0, 0), a2, voffA);
            PG8_BAR; PG8_WAIT_L(0); PG8_MMA(1, 0, At, B0); PG8_BAR; PG8_SCHED;
            PG8_STAGE(PG8_SB(0, 1), b2 + hstep, voffB);
            PG8_WAIT_V(6); PG8_BAR; PG8_MMA(1, 1, At, B1); PG8_BAR;
            PG8_LDB(B0, 1, 0); PG8_SCHED; PG8_LDA(At, 1, 0); PG8_STAGE(PG8_SA(0, 1), a2 + hstepA, voffA);
            PG8_WAIT_L(8); PG8_BAR; PG8_WAIT_L(0); PG8_MMA(0, 0, At, B0); PG8_BAR; PG8_SCHED;
            PG8_LDB(B1, 1, 1); PG8_STAGE(PG8_SB(1, 0), b3, voffB);
            PG8_BAR; PG8_WAIT_L(0); PG8_MMA(0, 1, At, B1); PG8_BAR;
            PG8_LDA(At, 1, 1); PG8_STAGE(PG8_SA(1, 0), a3, voffA);
            PG8_BAR; PG8_WAIT_L(0); PG8_MMA(1, 0, At, B0); PG8_BAR; PG8_SCHED;
            PG8_STAGE(PG8_SB(1, 1), b3 + hstep, voffB);
            PG8_WAIT_V(6); PG8_BAR; PG8_MMA(1, 1, At, B1); PG8_BAR;
        }
        PG8_STAMP();
        if constexpr (!Epi::AFTER_DRAIN) { E(acc, cur, wr, wc, fr, fq); S.done(cur); }
        PG8_STAMP();
        if (!has_next) break;
#pragma unroll
        for (int a = 0; a < 2; ++a)
#pragma unroll
            for (int b = 0; b < 2; ++b)
#pragma unroll
                for (int m = 0; m < 4; ++m)
#pragma unroll
                    for (int n = 0; n < 2; ++n) acc[a][b][m][n] = (f32x4){0.f, 0.f, 0.f, 0.f};
        cur = nxt; cA = nA; cB = nB; ++ui;
    }
    PG8_WAIT_V(0);
    if (wr == 0) PG8_BAR;
    PG8_BAR;
    if constexpr (Epi::AFTER_DRAIN) { E.fused(acc, cur, wr, wc, fr, fq, lds, wid, lane); S.done(cur); }
    PG8_STAMP();
    if (STAMP && wid == 0) { stamps[lane] = lane < nts ? (((unsigned long long)(unsigned)ts_hi << 32) | (unsigned)ts_lo) : 0ull;
        if (lane == 62) stamps[62] = rt_entry; if (lane == 63) stamps[63] = (unsigned long long)wall_clock64(); }
#undef PG8_STAMP
#undef PG8_SA
#undef PG8_SB
#undef PG8_STAGE
#undef PG8_LDA
#undef PG8_LDB
#undef PG8_MMA
#undef PG8_WAIT_V
#undef PG8_WAIT_L
#undef PG8_BAR
#undef PG8_SCHED
}
}
using pg8::f32x4;
#define ROWOFF(reg, h) (((reg) & 3) + 8 * ((reg) >> 2) + 4 * (h))

__device__ void conv_tile(const float* __restrict__ src, int K, int N, u16* __restrict__ dst, int k0, int n0, int sn0, float* lds) {
  const int tid = opq(threadIdx.x);
  __syncthreads();
  {
    const int k = tid >> 3, c = (tid & 7) * 8;
    const float* s = src + (size_t)(k0 + k) * N + sn0 + c;
    float4 a = *(const float4*)s, b = *(const float4*)(s + 4);
    float* d = lds + k * 65 + c;
    d[0] = a.x; d[1] = a.y; d[2] = a.z; d[3] = a.w;
    d[4] = b.x; d[5] = b.y; d[6] = b.z; d[7] = b.w;
  }
  __syncthreads();
  {
    const int n = tid >> 3, kk = (tid & 7) * 8;
    float f[8];
#pragma unroll
    for (int i = 0; i < 8; ++i) f[i] = lds[(kk + i) * 65 + n];
    *(uint4*)(dst + (size_t)(n0 + n) * K + k0 + kk) = pack8(f);
  }
}

__device__ void phase_prep(const Params& p, int l, int which, float* ldsf) {
  u16* WtA = (u16*)(p.ws + WS_WT);
  u16* WtF = (u16*)(p.ws + WS_WTF);
  u16* H = (u16*)(p.ws + WS_H);
  float* X = p.out;
  const int nconv = which == 0 ? (640 + 512 + 128 + 128 + 256) : (1408 + 704);
  const int ntot = nconv + 2112;
  const float* gw = (which == 0 ? p.in[7] : p.in[24]) + l * 1024;
  for (int it = blockIdx.x; it < ntot; it += gridDim.x) {
    if (it < nconv) {
      int t = it;
      if (which == 0) {
        if (t < 640) { const int tk = t / 40, tn = t % 40; conv_tile(p.in[8] + (size_t)l * 1024 * 4608, 1024, 4608, WtA + WT_IN, tk * 64, tn * 64, tn * 64, ldsf); }
        else if ((t -= 640) < 512) {
          const int tk = t / 32, tn = t % 32; const int n0 = tn * 64;
          const int sn0 = 2560 + ((n0 >> 7) & 1) * 1024 + (n0 >> 8) * 128 + (n0 & 127);
          conv_tile(p.in[8] + (size_t)l * 1024 * 4608, 1024, 4608, WtA + WT_G, tk * 64, n0, sn0, ldsf);
        }
        else if ((t -= 512) < 128) { const int tk = t / 16, tn = t % 16; conv_tile(p.in[21] + (size_t)l * 512 * 1024, 512, 1024, WtA + WT_BRA, tk * 64, tn * 64, tn * 64, ldsf); }
        else if ((t -= 128) < 128) { const int tk = t / 16, tn = t % 16; conv_tile(p.in[22] + (size_t)l * 512 * 1024, 512, 1024, WtA + WT_BRB, tk * 64, tn * 64, tn * 64, ldsf); }
        else { t -= 128; const int tk = t / 16, tn = t % 16; conv_tile(p.in[23] + (size_t)l * 1024 * 1024, 1024, 1024, WtA + WT_OUT, tk * 64, tn * 64, tn * 64, ldsf); }
      } else {
        if (t < 1408) {
          const int tk = t / 88, tn = t % 88; const int n0 = tn * 64;
          const int sn0 = ((n0 >> 7) & 1) * 2816 + (n0 >> 8) * 128 + (n0 & 127);
          conv_tile(p.in[25] + (size_t)l * 1024 * 5632, 1024, 5632, WtF + WT_FIN, tk * 64, n0, sn0, ldsf);
        } else { t -= 1408; const int tk = t / 16, tn = t % 16; conv_tile(p.in[28] + (size_t)l * 2816 * 1024, 2816, 1024, WtF + WT_FDN, tk * 64, tn * 64, tn * 64, ldsf); }
      }
    } else {
      const int tid = opq(threadIdx.x);
      const int row = (it - nconv) * 8 + (tid >> 6);
      const int lane = tid & 63;
      const bool first = (which == 0 && l == 0);
      const float* src;
      if (first) src = (row < M_P) ? p.in[0] + (size_t)row * 1024 : p.in[1] + (size_t)(row - M_P) * 1024;
      else src = X + (size_t)row * 1024;
      float4 v[4];
      float ss = 0.f;
#pragma unroll
      for (int i = 0; i < 4; ++i) {
        v[i] = *(const float4*)(src + i * 256 + lane * 4);
        ss += v[i].x * v[i].x + v[i].y * v[i].y + v[i].z * v[i].z + v[i].w * v[i].w;
        if (first) *(float4*)(X + (size_t)row * 1024 + i * 256 + lane * 4) = v[i];
      }
      ss = wave_sum(ss);
      const float rs = rsqrtf(ss * (1.f / 1024.f) + 1e-6f);
#pragma unroll
      for (int i = 0; i < 4; ++i) {
        const float4 g = *(const float4*)(gw + i * 256 + lane * 4);
        uint2 o; o.x = pack2(v[i].x * rs * g.x, v[i].y * rs * g.y); o.y = pack2(v[i].z * rs * g.z, v[i].w * rs * g.w);
        *(uint2*)(H + (size_t)row * 1024 + i * 256 + lane * 4) = o;
      }
    }
  }
}

struct EpiInproj {
  static constexpr bool PERM = true, AFTER_DRAIN = false;
  u16* z; float* out; int l;
  __device__ __forceinline__ void operator()(const f32x4 (&acc)[2][2][4][2], const pg8::Unit& u, int wr, int wc, int fr, int fq) const {
    const int row0 = u.pm * 256 + wr * 64 + fr, col0 = u.pn * 256 + wc * 32 + 8 * fq;
#pragma unroll
    for (int ai = 0; ai < 2; ++ai)
#pragma unroll
      for (int m = 0; m < 4; ++m) {
        const int row = row0 + ai * 128 + m * 16;
        u16* rowp = z + (size_t)row * ZLD + col0;
#pragma unroll
        for (int bj = 0; bj < 2; ++bj) {
          const f32x4 v0 = acc[ai][bj][m][0], v1 = acc[ai][bj][m][1];
          pg8::u32x4 w; w.x = pg8::cvt_pk_bf16(v0[0], v0[1]); w.y = pg8::cvt_pk_bf16(v0[2], v0[3]); w.z = pg8::cvt_pk_bf16(v1[0], v1[1]); w.w = pg8::cvt_pk_bf16(v1[2], v1[3]);
          *(pg8::u32x4*)(rowp + bj * 128) = w;
        }
        const bool prompt = row < M_P;
        int b, t;
        if (prompt) { b = row >> 13; t = row & 8191; } else { b = (row - M_P) >> 2; t = (row - M_P) & 3; }
        if (u.pn < 7) {
          if ((prompt && t == 8191) || (!prompt && t == 3)) {
            float* o = out + (prompt ? O_PSHIFT + (size_t)(l * 2 + b) * 1792 : O_SSHIFT + (size_t)(l * 128 + b) * 1792) + col0;
#pragma unroll
            for (int bj = 0; bj < 2; ++bj) { *(f32x4*)(o + bj * 128) = acc[ai][bj][m][0]; *(f32x4*)(o + bj * 128 + 4) = acc[ai][bj][m][1]; }
          }
        } else if (u.pn == 9 && prompt && t >= 8064) {
          const int c = wc * 32 + 8 * fq;
          float* o = out + O_PV + ((size_t)((l * 2 + b) * 128 + (t - 8064)) * 2 + (c >> 6)) * 64 + (c & 63);
          *(f32x4*)o = acc[ai][1][m][0]; *(f32x4*)(o + 4) = acc[ai][1][m][1];
        }
      }
  }
};
struct EpiStoreBf16 {
  static constexpr bool PERM = true, AFTER_DRAIN = false;
  u16* O; int ldc;
  __device__ __forceinline__ void operator()(const f32x4 (&acc)[2][2][4][2], const pg8::Unit& u, int wr, int wc, int fr, int fq) const {
    const int row0 = u.pm * 256 + wr * 64 + fr, col0 = u.pn * 256 + wc * 32 + 8 * fq;
#pragma unroll
    for (int ai = 0; ai < 2; ++ai)
#pragma unroll
      for (int m = 0; m < 4; ++m) {
        u16* rowp = O + (size_t)(row0 + ai * 128 + m * 16) * ldc + col0;
#pragma unroll
        for (int bj = 0; bj < 2; ++bj) {
          const f32x4 v0 = acc[ai][bj][m][0], v1 = acc[ai][bj][m][1];
          pg8::u32x4 w; w.x = pg8::cvt_pk_bf16(v0[0], v0[1]); w.y = pg8::cvt_pk_bf16(v0[2], v0[3]); w.z = pg8::cvt_pk_bf16(v1[0], v1[1]); w.w = pg8::cvt_pk_bf16(v1[2], v1[3]);
          *(pg8::u32x4*)(rowp + bj * 128) = w;
        }
      }
  }
};
struct EpiFfnIn {
  static constexpr bool PERM = true, AFTER_DRAIN = false;
  u16* cu;
  __device__ __forceinline__ void operator()(const f32x4 (&acc)[2][2][4][2], const pg8::Unit& u, int wr, int wc, int fr, int fq) const {
    const int row0 = u.pm * 256 + wr * 64 + fr, col0 = u.pn * 128 + wc * 32 + 8 * fq;
#pragma unroll
    for (int ai = 0; ai < 2; ++ai)
#pragma unroll
      for (int m = 0; m < 4; ++m) {
        u16* rowp = cu + (size_t)(row0 + ai * 128 + m * 16) * 5632 + col0;
#pragma unroll
        for (int bj = 0; bj < 2; ++bj) {
          const f32x4 v0 = acc[ai][bj][m][0], v1 = acc[ai][bj][m][1];
          pg8::u32x4 w; w.x = pg8::cvt_pk_bf16(v0[0], v0[1]); w.y = pg8::cvt_pk_bf16(v0[2], v0[3]); w.z = pg8::cvt_pk_bf16(v1[0], v1[1]); w.w = pg8::cvt_pk_bf16(v1[2], v1[3]);
          *(pg8::u32x4*)(rowp + bj * 2816) = w;
        }
      }
  }
};
struct EpiMerge {
  static constexpr bool PERM = true, AFTER_DRAIN = false;
  const u16* t1; const u16* t2; u16* mg;
  __device__ __forceinline__ void operator()(const f32x4 (&acc)[2][2][4][2], const pg8::Unit& u, int wr, int wc, int fr, int fq) const {
    const int row0 = u.pm * 256 + wr * 64 + fr, col0 = u.pn * 128 + wc * 32 + 8 * fq;
#pragma unroll
    for (int ai = 0; ai < 2; ++ai)
#pragma unroll
      for (int m = 0; m < 4; ++m) {
        const size_t off = (size_t)(row0 + ai * 128 + m * 16) * 1024 + col0;
        float a[8], b[8], o[8];
        unpack8(*(const uint4*)(t1 + off), a);
        unpack8(*(const uint4*)(t2 + off), b);
#pragma unroll
        for (int n = 0; n < 2; ++n)
#pragma unroll
          for (int j = 0; j < 4; ++j)
            o[n * 4 + j] = sigm(acc[ai][0][m][n][j]) * a[n * 4 + j] + sigm(acc[ai][1][m][n][j]) * b[n * 4 + j];
        *(uint4*)(mg + off) = pack8(o);
        asm volatile("" ::: "memory");
      }
  }
};
struct EpiResid {
  static constexpr bool PERM = false, AFTER_DRAIN = false;
  float* X;
  __device__ __forceinline__ void operator()(const f32x4 (&acc)[2][2][4][2], const pg8::Unit& u, int wr, int wc, int fr, int fq) const {
    const int row0 = u.pm * 256 + wr * 64 + fr, col0 = u.pn * 256 + wc * 32 + 4 * fq;
#pragma unroll
    for (int ai = 0; ai < 2; ++ai)
#pragma unroll
      for (int m = 0; m < 4; ++m) {
        float* rowp = X + (size_t)(row0 + ai * 128 + m * 16) * 1024 + col0;
#pragma unroll
        for (int bj = 0; bj < 2; ++bj)
#pragma unroll
          for (int n = 0; n < 2; ++n) { f32x4* q = (f32x4*)(rowp + bj * 128 + n * 16); *q = *q + acc[ai][bj][m][n]; }
        asm volatile("" ::: "memory");
      }
  }
};
template <class Epi>
__device__ __forceinline__ void run_gemm(unsigned char* lds_raw, const u16* A, int lda, const u16* Bt, int N, int K, const Epi& E) {
  pg8::Gemm g; g.A = A; g.Bt = Bt; g.M = M_TOT; g.N = N; g.K = K; g.lda = lda;
  pg8::StaticOrder S; S.init(M_TOT, N, gridDim.x, blockIdx.x);
  __syncthreads();
  pg8::gemm_phase<Epi, pg8::StaticOrder, false>((PG8_LAS unsigned char*)lds_raw, g, S, E, nullptr);
  __syncthreads();
}

__device__ void rope_item(const Params& p, int l, int item) {
  const int tid = opq(threadIdx.x);
  u16* z = (u16*)(p.ws + WS_Z);
  const int row = item * 64 + (tid >> 3);
  const int d0 = (tid & 7) * 4;
  const bool prompt = row < M_P;
  int b, t, pos;
  if (prompt) { b = row >> 13; t = row & 8191; pos = t; } else { b = (row - M_P) >> 2; t = (row - M_P) & 3; pos = 16384 + t; }
  float cs[4], sn[4];
#pragma unroll
  for (int i = 0; i < 4; ++i) {
    const float inv = __expf(-(float)(d0 + i) * (9.210340371976184f / 32.f));
    const float angf = (float)pos * inv;
    double a = (double)angf;
    a -= 6.283185307179586 * rint(a * 0.15915494309189535);
    const float af = (float)a;
    sn[i] = __sinf(af); cs[i] = __cosf(af);
  }
#pragma unroll 2
  for (int hh = 0; hh < 10; ++hh) {
    u16* q = z + (size_t)row * ZLD + 1792 + hh * 64 + d0;
    const uint2 lo = *(const uint2*)q, hi = *(const uint2*)(q + 32);
    float x1[4] = {__uint_as_float(lo.x << 16), __uint_as_float(lo.x & 0xFFFF0000u), __uint_as_float(lo.y << 16), __uint_as_float(lo.y & 0xFFFF0000u)};
    float x2[4] = {__uint_as_float(hi.x << 16), __uint_as_float(hi.x & 0xFFFF0000u), __uint_as_float(hi.y << 16), __uint_as_float(hi.y & 0xFFFF0000u)};
    float y1[4], y2[4];
#pragma unroll
    for (int i = 0; i < 4; ++i) { y1[i] = x1[i] * cs[i] - x2[i] * sn[i]; y2[i] = x2[i] * cs[i] + x1[i] * sn[i]; }
    uint2 o1, o2;
    o1.x = pack2(y1[0], y1[1]); o1.y = pack2(y1[2], y1[3]); o2.x = pack2(y2[0], y2[1]); o2.y = pack2(y2[2], y2[3]);
    *(uint2*)q = o1; *(uint2*)(q + 32) = o2;
    if (hh >= 8 && prompt && t >= 8064) {
      float* o = p.out + O_PK + ((size_t)((l * 2 + b) * 128 + (t - 8064)) * 2 + (hh - 8)) * 64 + d0;
      *(float4*)o = make_float4(y1[0], y1[1], y1[2], y1[3]);
      *(float4*)(o + 32) = make_float4(y2[0], y2[1], y2[2], y2[3]);
    }
  }
}

#define SL(i) (ldsf + (i) * 4160)
__device__ void rwkv_item(const Params& p, int l, int item, float* ldsf) {
  const int tid = opq(threadIdx.x), lane = tid & 63, wave = tid >> 6;
  const bool sample = item >= 2048;
  int h, cidx, rowbase;
  if (!sample) { h = item & 7; cidx = item >> 3; rowbase = cidx * 64; }
  else { int s = item - 2048; h = s & 7; cidx = s >> 3; rowbase = M_P + cidx * 64; }
  const int cc = cidx & 127;
  const u16* z = (const u16*)(p.ws + WS_Z);
  u16* zw_ = (u16*)(p.ws + WS_Z);
  const float* mu = p.in[9] + l * 1792;
  float* wbuf = SL(7);
  float* gc = ldsf + 9 * 4160;
  float* bd = ldsf + 9 * 4160 + 64;
  __syncthreads();
  {
    const int t = tid >> 3, c8 = (tid & 7) * 8;
    const int m = rowbase + t;
    const int zcs[7] = {h * 64, 512 + h * 64, 1024 + h * 64, 1536, 1600, 1664, 1728};
#pragma unroll
    for (int gi = 0; gi < 7; ++gi) {
      const int zc = zcs[gi] + c8;
      float cur[8], prv[8];
      unpack8(*(const uint4*)(z + (size_t)m * ZLD + zc), cur);
      bool zero = false, fromstate = false;
      if (!sample) zero = (t == 0 && cc == 0);
      else fromstate = ((t & 3) == 0);
      if (zero) {
#pragma unroll
        for (int i = 0; i < 8; ++i) prv[i] = 0.f;
      } else if (fromstate) {
        const int b = (m - M_P) >> 2;
        const float* sp = p.in[2] + (size_t)(l * 128 + b) * 1792 + zc;
        float4 a = *(const float4*)sp, bb = *(const float4*)(sp + 4);
        prv[0] = a.x; prv[1] = a.y; prv[2] = a.z; prv[3] = a.w; prv[4] = bb.x; prv[5] = bb.y; prv[6] = bb.z; prv[7] = bb.w;
      } else {
        unpack8(*(const uint4*)(z + (size_t)(m - 1) * ZLD + zc), prv);
      }
      float* d = SL(gi) + t * 65 + c8;
#pragma unroll
      for (int i = 0; i < 8; ++i) {
        float v = cur[i] + mu[zc + i] * (prv[i] - cur[i]);
        if (gi == 3) v = tanhf(v);
        if (gi >= 5) v = sigm(v);
        d[i] = v;
      }
    }
  }
  const int lt = tid & 63, jg = tid >> 6;
  auto load_w = [&](const float* W, int nrows) {
    for (int e = tid; e < nrows * 8; e += NT) {
      const int i = e >> 3, c = (e & 7) * 8;
      const float* s = W + (size_t)i * 512 + h * 64 + c;
      *(float4*)(wbuf + i * 64 + c) = *(const float4*)s;
      *(float4*)(wbuf + i * 64 + c + 4) = *(const float4*)(s + 4);
    }
  };
  auto lora = [&](const float* xa, const float* xb, int n, float* acc) {
#pragma unroll 2
    for (int i = 0; i < n; ++i) {
      const float x = (i < 64) ? xa[lt * 65 + i] : xb[lt * 65 + i - 64];
      const float4 w0 = *(const float4*)(wbuf + i * 64 + jg * 8);
      const float4 w1 = *(const float4*)(wbuf + i * 64 + jg * 8 + 4);
      acc[0] += x * w0.x; acc[1] += x * w0.y; acc[2] += x * w0.z; acc[3] += x * w0.w;
      acc[4] += x * w1.x; acc[5] += x * w1.y; acc[6] += x * w1.z; acc[7] += x * w1.w;
    }
  };
  float res[8];
  load_w(p.in[11] + (size_t)l * 64 * 512, 64);
  __syncthreads();
#pragma unroll
  for (int i = 0; i < 8; ++i) res[i] = p.in[10][l * 512 + h * 64 + jg * 8 + i];
  lora(SL(3), SL(3), 64, res);
  __syncthreads();
#pragma unroll
  for (int i = 0; i < 8; ++i) {
    const float x = -res[i];
    const float sp = (x > 20.f) ? x : log1pf(__expf(x));
    SL(3)[lt * 65 + jg * 8 + i] = -__expf(-sp - 0.5f);
  }
  load_w(p.in[13] + (size_t)l * 64 * 512, 64);
  __syncthreads();
#pragma unroll
  for (int i = 0; i < 8; ++i) res[i] = p.in[12][l * 512 + h * 64 + jg * 8 + i];
  lora(SL(4), SL(4), 64, res);
  __syncthreads();
#pragma unroll
  for (int i = 0; i < 8; ++i) SL(4)[lt * 65 + jg * 8 + i] = sigm(res[i]);
  load_w(p.in[14] + (size_t)l * 128 * 512, 128);
  __syncthreads();
#pragma unroll
  for (int i = 0; i < 8; ++i) res[i] = 0.f;
  lora(SL(5), SL(6), 128, res);
  __syncthreads();
  if (!sample) {
    u16* ga = (u16*)(p.ws + WS_GA) + (size_t)item * 4096;
    *(uint4*)(ga + lt * 64 + jg * 8) = pack8(res);
    if (tid < 64) {
      float c = 0.f;
      for (int t = 0; t < 64; ++t) { c += SL(3)[t * 65 + tid]; SL(5)[t * 65 + tid] = c; }
      gc[tid] = __expf(c);
    }
  } else {
#pragma unroll
    for (int i = 0; i < 8; ++i) SL(6)[lt * 65 + jg * 8 + i] = res[i];
  }
  __syncthreads();
  {
    const int t = tid >> 3, j0 = (tid & 7) * 8;
    const float* kkw = p.in[15] + l * 512 + h * 64;
    const float* kaw = p.in[16] + l * 512 + h * 64;
    const float* rkw = p.in[17] + l * 512 + h * 64;
    float kr[8], av[8], rv[8], kkv[8], kf[8];
    float nrm = 0.f, bdot = 0.f;
#pragma unroll
    for (int i = 0; i < 8; ++i) {
      const int j = j0 + i;
      kr[i] = SL(1)[t * 65 + j]; av[i] = SL(4)[t * 65 + j]; rv[i] = SL(0)[t * 65 + j];
      kkv[i] = kr[i] * kkw[j];
      nrm += kkv[i] * kkv[i];
      kf[i] = kr[i] * (1.f + (av[i] - 1.f) * kaw[j]);
      bdot += rv[i] * kf[i] * rkw[j];
    }
    nrm += __shfl_xor(nrm, 1, 64); nrm += __shfl_xor(nrm, 2, 64); nrm += __shfl_xor(nrm, 4, 64);
    bdot += __shfl_xor(bdot, 1, 64); bdot += __shfl_xor(bdot, 2, 64); bdot += __shfl_xor(bdot, 4, 64);
    const float rn = 1.f / fmaxf(sqrtf(nrm), 1e-12f);
    if (!sample) {
      float bo[8];
#pragma unroll
      for (int i = 0; i < 8; ++i) {
        const int j = j0 + i;
        const float cum = SL(5)[t * 65 + j], dl = SL(3)[t * 65 + j];
        const float eg = __expf(cum), egi = __expf(-cum), egp = __expf(cum - dl);
        const float kk = kkv[i] * rn;
        SL(0)[t * 65 + j] = rv[i] * eg;
        SL(1)[t * 65 + j] = kf[i] * egi;
        SL(3)[t * 65 + j] = kk * av[i] * egi;
        SL(4)[t * 65 + j] = kk * egp;
        bo[i] = bdot * SL(2)[t * 65 + j];
      }
      u16* bop = (u16*)(p.ws + WS_BO) + (size_t)item * 4096;
      *(uint4*)(bop + t * 64 + j0) = pack8(bo);
    } else {
#pragma unroll
      for (int i = 0; i < 8; ++i) {
        const int j = j0 + i;
        const float kk = kkv[i] * rn;
        const float dl = SL(3)[t * 65 + j];
        SL(1)[t * 65 + j] = kf[i];
        SL(3)[t * 65 + j] = __expf(dl);
        SL(4)[t * 65 + j] = kk;
        SL(5)[t * 65 + j] = kk * av[i];
      }
      if ((tid & 7) == 0) bd[t] = bdot;
    }
  }
  __syncthreads();
  if (sample) {
    const float lng = p.in[18][l * 512 + h * 64 + lane], lnb = p.in[19][l * 512 + h * 64 + lane];
    for (int round = 0; round < 2; ++round) {
      const int seq = wave + 8 * round;
      const int b = cidx * 16 + seq;
      float S[64];
      const float* sp = p.in[3] + ((size_t)((l * 128 + b) * 8 + h) * 64 + lane) * 64;
#pragma unroll
      for (int k = 0; k < 64; k += 4) { float4 v = *(const float4*)(sp + k); S[k] = v.x; S[k + 1] = v.y; S[k + 2] = v.z; S[k + 3] = v.w; }
      for (int tt = 0; tt < 4; ++tt) {
        const int t = seq * 4 + tt;
        float sk = 0.f;
#pragma unroll
        for (int kc = 0; kc < 64; kc += 8) {
#pragma unroll
          for (int k = kc; k < kc + 8; ++k) sk += S[k] * SL(4)[t * 65 + k];
          __builtin_amdgcn_sched_barrier(0);
        }
        const float vt = SL(2)[t * 65 + lane];
        float y = 0.f;
#pragma unroll
        for (int kc = 0; kc < 64; kc += 8) {
#pragma unroll
          for (int k = kc; k < kc + 8; ++k) {
            S[k] = S[k] * SL(3)[t * 65 + k] - sk * SL(5)[t * 65 + k] + vt * SL(1)[t * 65 + k];
            y += S[k] * SL(0)[t * 65 + k];
          }
          __builtin_amdgcn_sched_barrier(0);
        }
        const float mean = wave_sum(y) * (1.f / 64.f);
        const float d = y - mean;
        const float var = wave_sum(d * d) * (1.f / 64.f);
        const float yn = d * rsqrtf(var + 64e-5f) * lng + lnb;
        const float o = (yn + bd[t] * vt) * SL(6)[t * 65 + lane];
        zw_[(size_t)(M_P + b * 4 + tt) * ZLD + h * 64 + lane] = f2bf(o);
      }
      float* op = p.out + O_SWKV + ((size_t)((l * 128 + b) * 8 + h) * 64 + lane) * 64;
#pragma unroll
      for (int k = 0; k < 64; k += 4) *(float4*)(op + k) = make_float4(S[k], S[k + 1], S[k + 2], S[k + 3]);
    }
    return;
  }
  {
    const int i = lane, tg = wave;
    float ab[8], ak[8], akr[8], abr[8];
#pragma unroll
    for (int q = 0; q < 8; ++q) { ab[q] = 0.f; ak[q] = 0.f; akr[q] = 0.f; abr[q] = 0.f; }
#pragma unroll 2
    for (int k = 0; k < 64; ++k) {
      const float xb = SL(3)[i * 65 + k], xk = SL(1)[i * 65 + k];
#pragma unroll
      for (int q = 0; q < 8; ++q) {
        const int t = tg * 8 + q;
        const float yk = SL(4)[t * 65 + k], yr = SL(0)[t * 65 + k];
        ab[q] += xb * yk; ak[q] += xk * yk; akr[q] += xk * yr; abr[q] += xb * yr;
      }
    }
    __syncthreads();
#pragma unroll
    for (int q = 0; q < 8; ++q) {
      const int t = tg * 8 + q;
      SL(6)[i * 65 + t] = (i < t) ? ab[q] : 0.f;
      SL(7)[i * 65 + t] = (i < t) ? ak[q] : 0.f;
      SL(8)[i * 65 + t] = (i <= t) ? akr[q] : 0.f;
      SL(5)[i * 65 + t] = (i <= t) ? abr[q] : 0.f;
    }
  }
  __syncthreads();
  {
    const int t = tid >> 3, j0 = (tid & 7) * 8;
#pragma unroll
    for (int i = 0; i < 8; ++i) { const float g = gc[j0 + i]; SL(3)[t * 65 + j0 + i] *= g; SL(1)[t * 65 + j0 + i] *= g; }
  }
  __syncthreads();
  if (tid < 128) {
    float* X_ = (tid < 64) ? SL(5) : SL(3);
    const int col = tid & 63;
    for (int i = 62; i >= 0; --i) {
      float a = X_[i * 65 + col];
#pragma unroll 4
      for (int t = i + 1; t < 64; ++t) a -= SL(6)[i * 65 + t] * X_[t * 65 + col];
      X_[i * 65 + col] = a;
    }
  }
  __syncthreads();
  {
    const int c = tid & 127, ig = tid >> 7;
    const int which = c >> 6, cq = c & 63;
    const float* N_ = which ? SL(3) : SL(5);
    float a[16];
#pragma unroll
    for (int q = 0; q < 16; ++q) a[q] = 0.f;
#pragma unroll 2
    for (int t = 0; t < 64; ++t) {
      const float n = N_[t * 65 + cq];
#pragma unroll
      for (int q = 0; q < 16; ++q) a[q] += SL(7)[(ig * 16 + q) * 65 + t] * n;
    }
    float* T_ = which ? SL(1) : SL(8);
#pragma unroll
    for (int q = 0; q < 16; ++q) T_[(ig * 16 + q) * 65 + cq] -= a[q];
  }
  __syncthreads();
  {
    const int x = lane, yg = wave;
    float w2[8], pp[8], yl[8], qq[8];
#pragma unroll
    for (int q = 0; q < 8; ++q) { w2[q] = 0.f; pp[q] = 0.f; yl[q] = 0.f; qq[q] = 0.f; }
#pragma unroll 2
    for (int j = 0; j < 64; ++j) {
      const float l5 = SL(5)[j * 65 + x], l4 = SL(4)[j * 65 + x], l8 = SL(8)[j * 65 + x], l2 = SL(2)[j * 65 + x];
#pragma unroll
      for (int q = 0; q < 8; ++q) {
        const int y = yg * 8 + q;
        w2[q] += l5 * SL(4)[j * 65 + y];
        pp[q] += l4 * SL(3)[j * 65 + y];
        yl[q] += l8 * SL(2)[j * 65 + y];
        qq[q] += l2 * SL(1)[j * 65 + y];
      }
    }
    float o1[8];
#pragma unroll
    for (int q = 0; q < 8; ++q) {
      const int y = yg * 8 + q;
      o1[q] = SL(0)[x * 65 + y] - w2[q];
    }
    u16* Pp = (u16*)(p.ws + WS_PP) + (size_t)item * 4096 + x * 64 + yg * 8;
    float* Qp = (float*)(p.ws + WS_Q) + (size_t)item * 4096 + x * 64 + yg * 8;
    *(uint4*)Pp = pack8(pp);
    if (tid < 64) ((float*)(p.ws + WS_GC))[(size_t)item * 64 + tid] = gc[tid];
    *(float4*)Qp = make_float4(qq[0], qq[1], qq[2], qq[3]); *(float4*)(Qp + 4) = make_float4(qq[4], qq[5], qq[6], qq[7]);
    u16* W2p = (u16*)(p.ws + WS_W2) + (size_t)item * 4096 + x * 64 + yg * 8;
    u16* YLp = (u16*)(p.ws + WS_YL) + (size_t)item * 4096 + x * 64 + yg * 8;
    *(uint4*)W2p = pack8(o1);
    *(uint4*)YLp = pack8(yl);
  }
}

__device__ void rwkv_scan(const Params& p, int l, int bh, float* ldsf) {
  const int tid = opq(threadIdx.x), v = tid & 63, kg = tid >> 6;
  const int b = bh >> 3, h = bh & 7;
  float* Sl = ldsf;
  float* Pl = ldsf + 4160;
  __syncthreads();
  for (int e = tid; e < 4160; e += NT) Sl[e] = 0.f;
  for (int cc = 0; cc < 128; ++cc) {
    const size_t id = (size_t)((b * 128 + cc) * 8 + h);
    const u16* Pg = (const u16*)(p.ws + WS_PP) + id * 4096;
    const float* Gg = (const float*)(p.ws + WS_GC) + id * 64;
    float* Qg = (float*)(p.ws + WS_Q) + id * 4096;
    {
      const int row = tid >> 3, c = (tid & 7) * 8;
      float f[8];
      unpack8(*(const uint4*)(Pg + row * 64 + c), f);
      *(float4*)(Pl + row * 68 + c) = make_float4(-f[0], -f[1], -f[2], -f[3]);
      *(float4*)(Pl + row * 68 + c + 4) = make_float4(-f[4], -f[5], -f[6], -f[7]);
    }
    float4 q0 = *(const float4*)(Qg + v * 64 + kg * 8), q1 = *(const float4*)(Qg + v * 64 + kg * 8 + 4);
    float4 g0 = *(const float4*)(Gg + kg * 8), g1 = *(const float4*)(Gg + kg * 8 + 4);
    float a[8] = {q0.x, q0.y, q0.z, q0.w, q1.x, q1.y, q1.z, q1.w};
    __syncthreads();
    {
      float s[8];
#pragma unroll
      for (int j = 0; j < 8; ++j) s[j] = Sl[v * 65 + kg * 8 + j];
      *(float4*)(Qg + v * 64 + kg * 8) = make_float4(s[0], s[1], s[2], s[3]);
      *(float4*)(Qg + v * 64 + kg * 8 + 4) = make_float4(s[4], s[5], s[6], s[7]);
      a[0] += s[0] * g0.x; a[1] += s[1] * g0.y; a[2] += s[2] * g0.z; a[3] += s[3] * g0.w;
      a[4] += s[4] * g1.x; a[5] += s[5] * g1.y; a[6] += s[6] * g1.z; a[7] += s[7] * g1.w;
    }
#pragma unroll 4
    for (int k = 0; k < 64; ++k) {
      const float s = Sl[v * 65 + k];
      const float4 p0 = *(const float4*)(Pl + k * 68 + kg * 8), p1 = *(const float4*)(Pl + k * 68 + kg * 8 + 4);
      a[0] += s * p0.x; a[1] += s * p0.y; a[2] += s * p0.z; a[3] += s * p0.w;
      a[4] += s * p1.x; a[5] += s * p1.y; a[6] += s * p1.z; a[7] += s * p1.w;
    }
    __syncthreads();
#pragma unroll
    for (int j = 0; j < 8; ++j) Sl[v * 65 + kg * 8 + j] = a[j];
  }
  __syncthreads();
  {
    float* o = p.out + O_PWKV + ((size_t)((l * 2 + b) * 8 + h) * 64 + v) * 64 + kg * 8;
    float s[8];
#pragma unroll
    for (int j = 0; j < 8; ++j) s[j] = Sl[v * 65 + kg * 8 + j];
    *(float4*)o = make_float4(s[0], s[1], s[2], s[3]);
    *(float4*)(o + 4) = make_float4(s[4], s[5], s[6], s[7]);
  }
}

__device__ void rwkv_out(const Params& p, int l, int item, float* ldsf) {
  const int tid = opq(threadIdx.x), lane = tid & 63, wave = tid >> 6;
  const int h = item & 7, cidx = item >> 3;
  float* Sl = ldsf; float* Wl = ldsf + 4160;
  const float* Sg = (const float*)(p.ws + WS_Q) + (size_t)item * 4096;
  const u16* W2 = (const u16*)(p.ws + WS_W2) + (size_t)item * 4096;
  const u16* YL = (const u16*)(p.ws + WS_YL) + (size_t)item * 4096;
  const u16* BO = (const u16*)(p.ws + WS_BO) + (size_t)item * 4096;
  const u16* GA = (const u16*)(p.ws + WS_GA) + (size_t)item * 4096;
  u16* z = (u16*)(p.ws + WS_Z);
  __syncthreads();
  {
    const int row = tid >> 3, c = (tid & 7) * 8;
    float4 a = *(const float4*)(Sg + row * 64 + c), bq = *(const float4*)(Sg + row * 64 + c + 4);
    float* d = Sl + row * 65 + c;
    d[0] = a.x; d[1] = a.y; d[2] = a.z; d[3] = a.w; d[4] = bq.x; d[5] = bq.y; d[6] = bq.z; d[7] = bq.w;
    float w[8];
    unpack8(*(const uint4*)(W2 + row * 64 + c), w);
    float* e = Wl + row * 65 + c;
#pragma unroll
    for (int i = 0; i < 8; ++i) e[i] = w[i];
  }
  __syncthreads();
  float y[8];
#pragma unroll
  for (int q = 0; q < 8; ++q) y[q] = bf2f(YL[(wave * 8 + q) * 64 + lane]);
#pragma unroll 2
  for (int k = 0; k < 64; ++k) {
    const float s = Sl[lane * 65 + k];
#pragma unroll
    for (int q = 0; q < 8; ++q) y[q] += s * Wl[(wave * 8 + q) * 65 + k];
  }
  const float lng = p.in[18][l * 512 + h * 64 + lane], lnb = p.in[19][l * 512 + h * 64 + lane];
#pragma unroll
  for (int q = 0; q < 8; ++q) {
    const int t = wave * 8 + q;
    const float mean = wave_sum(y[q]) * (1.f / 64.f);
    const float d = y[q] - mean;
    const float var = wave_sum(d * d) * (1.f / 64.f);
    const float yn = d * rsqrtf(var + 64e-5f) * lng + lnb;
    const float o = (yn + bf2f(BO[t * 64 + lane])) * bf2f(GA[t * 64 + lane]);
    z[(size_t)(cidx * 64 + t) * ZLD + h * 64 + lane] = f2bf(o);
  }
}

__device__ void attn_prompt(const Params& p, int l, int item, u16* lds) {
  const int tid = opq(threadIdx.x), lane = tid & 63, wave = tid >> 6;
  const int r = lane & 31, h = lane >> 5;
  const int kvh = item & 1, n = (item >> 1) & 63, b = item >> 7;
  u16* z = (u16*)(p.ws + WS_Z);
  u16* Ks = lds;
  u16* Vt = lds + 256 * 72;
  __syncthreads();
  {
    const int key = tid >> 1, half = tid & 1;
    const int t = (n - 1) * 128 + key;
    uint4 kv[4], vv[4];
    if (t >= 0) {
      const u16* kp = z + (size_t)(b * 8192 + t) * ZLD + 2304 + kvh * 64 + half * 32;
      const u16* vp = z + (size_t)(b * 8192 + t) * ZLD + 2432 + kvh * 64 + half * 32;
#pragma unroll
      for (int i = 0; i < 4; ++i) { kv[i] = *(const uint4*)(kp + i * 8); vv[i] = *(const uint4*)(vp + i * 8); }
    } else {
#pragma unroll
      for (int i = 0; i < 4; ++i) { kv[i] = make_uint4(0, 0, 0, 0); vv[i] = make_uint4(0, 0, 0, 0); }
    }
#pragma unroll
    for (int i = 0; i < 4; ++i) {
      *(uint4*)(Ks + key * 72 + half * 32 + i * 8) = kv[i];
      const unsigned w[4] = {vv[i].x, vv[i].y, vv[i].z, vv[i].w};
#pragma unroll
      for (int q = 0; q < 4; ++q) {
        const int d = half * 32 + i * 8 + q * 2;
        Vt[d * 264 + key] = (u16)(w[q] & 0xFFFFu);
        Vt[(d + 1) * 264 + key] = (u16)(w[q] >> 16);
      }
    }
  }
  __syncthreads();
#pragma unroll 1
  for (int uu = 0; uu < 2; ++uu) {
    const int u = wave * 2 + uu;
    const int hq = kvh * 4 + (u >> 2), qg = u & 3;
    const int qrow = b * 8192 + n * 128 + qg * 32 + r;
    u16* qp = z + (size_t)qrow * ZLD + 1792 + hq * 64;
    bf16x8 qf[4];
#pragma unroll
    for (int s = 0; s < 4; ++s) qf[s] = *(const bf16x8*)(qp + s * 16 + h * 8);
    f32x16 sc[5];
#pragma unroll
    for (int i5 = 0; i5 < 5; ++i5) {
#pragma unroll
      for (int i = 0; i < 16; ++i) sc[i5][i] = 0.f;
      const int kt = qg + i5;
#pragma unroll
      for (int s = 0; s < 4; ++s) {
        bf16x8 kf = *(const bf16x8*)(Ks + (kt * 32 + r) * 72 + s * 16 + h * 8);
        sc[i5] = __builtin_amdgcn_mfma_f32_32x32x16_bf16(kf, qf[s], sc[i5], 0, 0, 0);
      }
      __builtin_amdgcn_sched_barrier(0);
    }
    const int qi = qg * 32 + r;
    const float sink = p.in[20][l * 8 + hq];
    float mx = -1e30f;
#pragma unroll
    for (int i5 = 0; i5 < 5; ++i5)
#pragma unroll
      for (int reg = 0; reg < 16; ++reg) {
        const int j = (qg + i5) * 32 + ROWOFF(reg, h);
        const bool ok = (j > qi) && (j <= qi + 128) && (n > 0 || j >= 128);
        const float s = ok ? sc[i5][reg] * 0.125f : -1e30f;
        sc[i5][reg] = s;
        mx = fmaxf(mx, s);
      }
    mx = fmaxf(mx, __shfl_xor(mx, 32, 64));
    mx = fmaxf(mx, sink);
    float sum = 0.f;
#pragma unroll
    for (int i5 = 0; i5 < 5; ++i5)
#pragma unroll
      for (int reg = 0; reg < 16; ++reg) { const float e = __expf(sc[i5][reg] - mx); sc[i5][reg] = e; sum += e; }
    sum += __shfl_xor(sum, 32, 64);
    const float rden = 1.f / (sum + __expf(sink - mx));
    f32x16 oacc[2];
#pragma unroll
    for (int i = 0; i < 16; ++i) { oacc[0][i] = 0.f; oacc[1][i] = 0.f; }
#pragma unroll
    for (int i5 = 0; i5 < 5; ++i5) {
      const int kt = qg + i5;
#pragma unroll
      for (int s2 = 0; s2 < 2; ++s2) {
        bf16x8 pf;
#pragma unroll
        for (int j = 0; j < 8; ++j) pf[j] = (short)f2bf(sc[i5][s2 * 8 + j] * rden);
#pragma unroll
        for (int dt = 0; dt < 2; ++dt) {
          const u16* vp = Vt + (dt * 32 + r) * 264 + kt * 32 + s2 * 16 + h * 4;
          const uint2 lo = *(const uint2*)vp, hi = *(const uint2*)(vp + 8);
          union { uint4 u; bf16x8 v; } cv;
          cv.u = make_uint4(lo.x, lo.y, hi.x, hi.y);
          oacc[dt] = __builtin_amdgcn_mfma_f32_32x32x16_bf16(cv.v, pf, oacc[dt], 0, 0, 0);
        }
        __builtin_amdgcn_sched_barrier(0);
      }
    }
#pragma unroll
    for (int dt = 0; dt < 2; ++dt)
#pragma unroll
      for (int g4 = 0; g4 < 4; ++g4) {
        const int d = dt * 32 + 8 * g4 + 4 * h;
        uint2 o;
        o.x = pack2(oacc[dt][g4 * 4 + 0], oacc[dt][g4 * 4 + 1]);
        o.y = pack2(oacc[dt][g4 * 4 + 2], oacc[dt][g4 * 4 + 3]);
        *(uint2*)(qp + d) = o;
      }
  }
}

__device__ void attn_sample(const Params& p, int l, int item, float* ldsf) {
  const int tid = opq(threadIdx.x);
  const int kvh = item & 1, b = item >> 1;
  u16* z = (u16*)(p.ws + WS_Z);
  float* Kl = ldsf;
  float* Vl = ldsf + 132 * 65;
  float* Ql = Vl + 132 * 65;
  float* Pl = Ql + 16 * 64;
  __syncthreads();
  for (int e = tid; e < 132 * 8; e += NT) {
    const int j = e >> 3, c = (e & 7) * 8;
    float k[8], v[8];
    if (j < 128) {
      const float* kp = p.in[4] + ((size_t)((l * 128 + b) * 128 + j) * 2 + kvh) * 64 + c;
      const float* vp = p.in[5] + ((size_t)((l * 128 + b) * 128 + j) * 2 + kvh) * 64 + c;
      float4 a = *(const float4*)kp, a2 = *(const float4*)(kp + 4);
      float4 c1 = *(const float4*)vp, c2 = *(const float4*)(vp + 4);
      k[0] = a.x; k[1] = a.y; k[2] = a.z; k[3] = a.w; k[4] = a2.x; k[5] = a2.y; k[6] = a2.z; k[7] = a2.w;
      v[0] = c1.x; v[1] = c1.y; v[2] = c1.z; v[3] = c1.w; v[4] = c2.x; v[5] = c2.y; v[6] = c2.z; v[7] = c2.w;
    } else {
      const size_t row = M_P + b * 4 + (j - 128);
      unpack8(*(const uint4*)(z + row * ZLD + 2304 + kvh * 64 + c), k);
      unpack8(*(const uint4*)(z + row * ZLD + 2432 + kvh * 64 + c), v);
    }
#pragma unroll
    for (int i = 0; i < 8; ++i) { Kl[j * 65 + c + i] = k[i]; Vl[j * 65 + c + i] = v[i]; }
    if (j >= 4) {
      float* ok = p.out + O_SK + ((size_t)((l * 128 + b) * 128 + (j - 4)) * 2 + kvh) * 64 + c;
      float* ov = p.out + O_SV + ((size_t)((l * 128 + b) * 128 + (j - 4)) * 2 + kvh) * 64 + c;
      *(float4*)ok = make_float4(k[0], k[1], k[2], k[3]); *(float4*)(ok + 4) = make_float4(k[4], k[5], k[6], k[7]);
      *(float4*)ov = make_float4(v[0], v[1], v[2], v[3]); *(float4*)(ov + 4) = make_float4(v[4], v[5], v[6], v[7]);
    }
  }
  if (tid < 128) {
    const int row = tid >> 3, c = (tid & 7) * 8;
    const int hl = row >> 2, t = row & 3;
    float q[8];
    unpack8(*(const uint4*)(z + (size_t)(M_P + b * 4 + t) * ZLD + 1792 + (kvh * 4 + hl) * 64 + c), q);
#pragma unroll
    for (int i = 0; i < 8; ++i) Ql[row * 64 + c + i] = q[i];
  }
  __syncthreads();
  const int row = tid >> 5, jl = tid & 31;
  const int t = row & 3, hq = kvh * 4 + (row >> 2);
  float sc[5];
  float mx = -1e30f;
#pragma unroll
  for (int jj = 0; jj < 5; ++jj) {
    const int j = jl + 32 * jj;
    float s = -1e30f;
    if (j < 132 && j > t && j <= t + 128) {
      float a = 0.f;
#pragma unroll 8
      for (int d = 0; d < 64; ++d) a += Ql[row * 64 + d] * Kl[j * 65 + d];
      s = a * 0.125f;
    }
    sc[jj] = s; mx = fmaxf(mx, s);
    __builtin_amdgcn_sched_barrier(0);
  }
#pragma unroll
  for (int o = 16; o >= 1; o >>= 1) mx = fmaxf(mx, __shfl_xor(mx, o, 64));
  const float sink = p.in[20][l * 8 + hq];
  mx = fmaxf(mx, sink);
  float sum = 0.f;
#pragma unroll
  for (int jj = 0; jj < 5; ++jj) { sc[jj] = __expf(sc[jj] - mx); sum += sc[jj]; }
#pragma unroll
  for (int o = 16; o >= 1; o >>= 1) sum += __shfl_xor(sum, o, 64);
  const float rden = 1.f / (sum + __expf(sink - mx));
#pragma unroll
  for (int jj = 0; jj < 5; ++jj) { const int j = jl + 32 * jj; if (j < 136) Pl[row * 136 + j] = sc[jj] * rden; }
  __syncthreads();
  {
    const int d = jl * 2;
    float o0 = 0.f, o1 = 0.f;
#pragma unroll 4
    for (int j = 0; j < 132; ++j) { const float pr = Pl[row * 136 + j]; o0 += pr * Vl[j * 65 + d]; o1 += pr * Vl[j * 65 + d + 1]; }
    *(unsigned*)(z + (size_t)(M_P + b * 4 + t) * ZLD + 1792 + hq * 64 + d) = pack2(o0, o1);
  }
}

__device__ void phase_convgelu(const Params& p, int l) {
  u16* cu = (u16*)(p.ws + WS_CU);
  const float* cw = p.in[26] + (size_t)l * 3 * 2816;
  const float* cb = p.in[27] + (size_t)l * 2816;
  for (int it = blockIdx.x; it < 1056; it += gridDim.x) {
    const int tid = opq(threadIdx.x);
    if (tid >= 352) continue;
    const int j0 = tid * 8;
    float w0[8], w1[8], w2[8], bb[8];
#pragma unroll
    for (int i = 0; i < 8; ++i) { w0[i] = cw[j0 + i]; w1[i] = cw[2816 + j0 + i]; w2[i] = cw[5632 + j0 + i]; bb[i] = cb[j0 + i]; }
    float c1[8], c2[8];
    for (int rr = 0; rr < 16; ++rr) {
      const int row = it * 16 + rr;
      const bool prompt = row < M_P;
      int b, t;
      if (prompt) { b = row >> 13; t = row & 8191; } else { b = (row - M_P) >> 2; t = (row - M_P) & 3; }
      if (t == 0) {
        if (prompt) {
#pragma unroll
          for (int i = 0; i < 8; ++i) { c1[i] = 0.f; c2[i] = 0.f; }
        } else {
          const float* st = p.in[6] + (size_t)((l * 128 + b) * 2) * 2816 + j0;
#pragma unroll
          for (int i = 0; i < 8; ++i) { c2[i] = st[i]; c1[i] = st[2816 + i]; }
        }
      } else if (rr == 0) {
        unpack8(*(const uint4*)(cu + (size_t)(row - 1) * 5632 + j0), c1);
        if (t >= 2) unpack8(*(const uint4*)(cu + (size_t)(row - 2) * 5632 + j0), c2);
        else {
#pragma unroll
          for (int i = 0; i < 8; ++i) c2[i] = 0.f;
        }
      }
      float c0[8], up[8], a[8];
      unpack8(*(const uint4*)(cu + (size_t)row * 5632 + j0), c0);
      unpack8(*(const uint4*)(cu + (size_t)row * 5632 + 2816 + j0), up);
#pragma unroll
      for (int i = 0; i < 8; ++i) {
        const float cv = bb[i] + w0[i] * c2[i] + w1[i] * c1[i] + w2[i] * c0[i];
        const float ge = 0.5f * cv * (1.f + erff(cv * 0.7071067811865476f));
        a[i] = ge * up[i];
      }
      *(uint4*)(cu + (size_t)row * 5632 + 2816 + j0) = pack8(a);
      if (prompt && t >= 8190) {
        float* o = p.out + O_PCONV + (size_t)((l * 2 + b) * 2 + (t - 8190)) * 2816 + j0;
        *(float4*)o = make_float4(c0[0], c0[1], c0[2], c0[3]); *(float4*)(o + 4) = make_float4(c0[4], c0[5], c0[6], c0[7]);
      } else if (!prompt && t >= 2) {
        float* o = p.out + O_SCONV + (size_t)((l * 128 + b) * 2 + (t - 2)) * 2816 + j0;
        *(float4*)o = make_float4(c0[0], c0[1], c0[2], c0[3]); *(float4*)(o + 4) = make_float4(c0[4], c0[5], c0[6], c0[7]);
      }
#pragma unroll
      for (int i = 0; i < 8; ++i) { c2[i] = c1[i]; c1[i] = c0[i]; }
    }
  }
}

__device__ void phase_final(const Params& p) {
  float* X = p.out;
  const float* g = p.in[29];
  for (int it = blockIdx.x; it < 2112; it += gridDim.x) {
    const int tid = opq(threadIdx.x);
    const int lane = tid & 63;
    const int row = it * 8 + (tid >> 6);
    float4 v[4];
    float ss = 0.f;
#pragma unroll
    for (int i = 0; i < 4; ++i) {
      v[i] = *(const float4*)(X + (size_t)row * 1024 + i * 256 + lane * 4);
      ss += v[i].x * v[i].x + v[i].y * v[i].y + v[i].z * v[i].z + v[i].w * v[i].w;
    }
    ss = wave_sum(ss);
    const float rs = rsqrtf(ss * (1.f / 1024.f) + 1e-6f);
#pragma unroll
    for (int i = 0; i < 4; ++i) {
      const float4 gg = *(const float4*)(g + i * 256 + lane * 4);
      *(float4*)(X + (size_t)row * 1024 + i * 256 + lane * 4) =
          make_float4(v[i].x * rs * gg.x, v[i].y * rs * gg.y, v[i].z * rs * gg.z, v[i].w * rs * gg.w);
    }
  }
}

#if COOP
#define PH_SYNC(idx) do { if ((idx) + 1 < ph_hi && (idx) >= ph_lo) cg::this_grid().sync(); } while (0)
#else
#define PH_SYNC(idx) do { } while (0)
#endif
#define PH_ON(idx, bit) (((KMASK >> (bit)) & 1) && ph_lo <= (idx) && (idx) < ph_hi)

__device__ __forceinline__ Params load_params() {
  auto kp0 = __builtin_amdgcn_kernarg_segment_ptr();
  asm volatile("" : "+s"(kp0));
  auto kq = (const __constant__ unsigned long long*)kp0;
  Params p;
#pragma unroll
  for (int i = 0; i < 30; ++i) p.in[i] = (const float*)kq[i];
  p.out = (float*)kq[30];
  p.ws = (unsigned char*)kq[31];
  p.ph_lo = 0; p.ph_hi = 0;
  return p;
}

template <int KMASK>
__device__ __forceinline__ void layer_phases(int l, int ph_lo, int ph_hi, unsigned char* lds_raw) {
  float* ldsf = (float*)lds_raw;
  u16* ldsh = (u16*)lds_raw;
  const int base = l * 12;
  if (PH_ON(base + 0, 0)) { const Params p = load_params(); phase_prep(p, l, 0, ldsf); }
  PH_SYNC(base + 0);
  if (PH_ON(base + 1, 1)) {
    const Params p = load_params();
    EpiInproj E; E.z = (u16*)(p.ws + WS_Z); E.out = p.out; E.l = l;
    run_gemm(lds_raw, (const u16*)(p.ws + WS_H), 1024, (const u16*)(p.ws + WS_WT) + WT_IN, 2560, 1024, E);
  }
  PH_SYNC(base + 1);
  if (PH_ON(base + 2, 2)) {
    const Params p = load_params();
    for (int it = blockIdx.x; it < 2048 + 64 + 264; it += gridDim.x) {
      if (it < 64) rwkv_item(p, l, 2048 + it, ldsf);
      else if (it < 64 + 264) rope_item(p, l, it - 64);
      else rwkv_item(p, l, it - 64 - 264, ldsf);
    }
  }
  PH_SYNC(base + 2);
  if (PH_ON(base + 3, 3)) {
    const Params p = load_params();
    if (blockIdx.x < 16) rwkv_scan(p, l, blockIdx.x, ldsf);
    else {
      for (int it = blockIdx.x - 16; it < 512; it += gridDim.x - 16) {
        if (it < 256) attn_prompt(p, l, it, ldsh); else attn_sample(p, l, it - 256, ldsf);
      }
    }
  }
  PH_SYNC(base + 3);
  if (PH_ON(base + 4, 4)) {
    const Params p = load_params();
    for (int it = blockIdx.x; it < 2048; it += gridDim.x) rwkv_out(p, l, it, ldsf);
  }
  PH_SYNC(base + 4);
  if (PH_ON(base + 5, 5)) {
    const Params p = load_params();
    EpiStoreBf16 E1; E1.O = (u16*)(p.ws + WS_T1); E1.ldc = 1024;
    run_gemm(lds_raw, (const u16*)(p.ws + WS_Z), ZLD, (const u16*)(p.ws + WS_WT) + WT_BRA, 1024, 512, E1);
    EpiStoreBf16 E2; E2.O = (u16*)(p.ws + WS_T2); E2.ldc = 1024;
    run_gemm(lds_raw, (const u16*)(p.ws + WS_Z) + 1792, ZLD, (const u16*)(p.ws + WS_WT) + WT_BRB, 1024, 512, E2);
  }
  PH_SYNC(base + 5);
  if (PH_ON(base + 6, 6)) {
    const Params p = load_params();
    EpiMerge E; E.t1 = (const u16*)(p.ws + WS_T1); E.t2 = (const u16*)(p.ws + WS_T2); E.mg = (u16*)(p.ws + WS_MG);
    run_gemm(lds_raw, (const u16*)(p.ws + WS_H), 1024, (const u16*)(p.ws + WS_WT) + WT_G, 2048, 1024, E);
  }
  PH_SYNC(base + 6);
  if (PH_ON(base + 7, 7)) {
    const Params p = load_params();
    EpiResid E; E.X = p.out;
    run_gemm(lds_raw, (const u16*)(p.ws + WS_MG), 1024, (const u16*)(p.ws + WS_WT) + WT_OUT, 1024, 1024, E);
  }
  PH_SYNC(base + 7);
  if (PH_ON(base + 8, 8)) { const Params p = load_params(); phase_prep(p, l, 1, ldsf); }
  PH_SYNC(base + 8);
  if (PH_ON(base + 9, 9)) {
    const Params p = load_params();
    EpiFfnIn E; E.cu = (u16*)(p.ws + WS_CU);
    run_gemm(lds_raw, (const u16*)(p.ws + WS_H), 1024, (const u16*)(p.ws + WS_WTF) + WT_FIN, 5632, 1024, E);
  }
  PH_SYNC(base + 9);
  if (PH_ON(base + 10, 10)) { const Params p = load_params(); phase_convgelu(p, l); }
  PH_SYNC(base + 10);
  if (PH_ON(base + 11, 11)) {
    const Params p = load_params();
    EpiResid E; E.X = p.out;
    run_gemm(lds_raw, (const u16*)(p.ws + WS_CU) + 2816, 5632, (const u16*)(p.ws + WS_WTF) + WT_FDN, 1024, 2816, E);
  }
  PH_SYNC(base + 11);
}

template <int KMASK>
__global__ void __launch_bounds__(NT) fwd_kernel(Params pin) {
  extern __shared__ __attribute__((aligned(16))) unsigned char lds_raw[];
  const int ph_lo = pin.ph_lo, ph_hi = pin.ph_hi;
  layer_phases<KMASK>(0, ph_lo, ph_hi, lds_raw);
  layer_phases<KMASK>(1, ph_lo, ph_hi, lds_raw);
  if (PH_ON(NPH - 1, 12)) { const Params p = load_params(); phase_final(p); }
}

extern "C" void kernel_launch(void* const* d_in, const int* in_sizes, int n_in, void* d_out, int out_size, void* d_ws,
                              size_t ws_size, hipStream_t stream) {
  static int grid = 0;
  if (grid == 0) {
    int dev = 0, cus = 0;
    (void)hipGetDevice(&dev);
    (void)hipDeviceGetAttribute(&cus, hipDeviceAttributeMultiprocessorCount, dev);
    grid = cus > 0 ? cus : 256;
    (void)hipFuncSetAttribute((const void*)fwd_kernel<PHMASK>, hipFuncAttributeMaxDynamicSharedMemorySize, LDS_BYTES);
    (void)hipGetLastError();
  }
  Params p{};
  for (int i = 0; i < 30; ++i) p.in[i] = (const float*)d_in[i];
  p.out = (float*)d_out;
  p.ws = (unsigned char*)d_ws;
#if COOP
  p.ph_lo = 0; p.ph_hi = NPH;
  void* args[] = {&p};
  hipError_t e = hipLaunchCooperativeKernel((const void*)fwd_kernel<PHMASK>, dim3(grid), dim3(NT), args, LDS_BYTES, stream);
  if (e != hipSuccess) fprintf(stderr, "cooperative launch failed: %s (grid %d)\n", hipGetErrorString(e), grid);
#else
  for (int ph = 0; ph < NPH; ++ph) {
    p.ph_lo = ph; p.ph_hi = ph + 1;
    hipLaunchKernelGGL(fwd_kernel<PHMASK>, dim3(grid), dim3(NT), LDS_BYTES, stream, p);
  }
#endif
}
```

```cpp
#include <hip/hip_runtime.h>
#include <hip/hip_bf16.h>
#include <hip/hip_cooperative_groups.h>
#include <cstdio>
namespace cg = cooperative_groups;

typedef __attribute__((ext_vector_type(8))) short bf16x8;
typedef __attribute__((ext_vector_type(16))) float f32x16;
typedef unsigned short u16;

#ifndef PHMASK
#define PHMASK 0x1FFF
#endif
#ifndef T3
#define T3 7
#endif
#ifndef COOP
#define COOP 1
#endif

#define NT 512
#define M_TOT 16896
#define M_P 16384
#define ZLD 2560
#define NPH 25

#define WS_WT   0ull
#define WS_H    13631488ull
#define WS_Z    48234496ull
#define WS_R    134742016ull
#define WS_PP   (WS_R)
#define WS_GC   (WS_R + 16777216ull)
#define WS_Q    (WS_R + 17301504ull)
#define WS_W2   (WS_R + 50855936ull)
#define WS_YL   (WS_R + 67633152ull)
#define WS_BO   (WS_R + 84410368ull)
#define WS_GA   (WS_R + 101187584ull)
#define WS_T1   (WS_R)
#define WS_T2   (WS_R + 34603008ull)
#define WS_MG   (WS_R + 69206016ull)
#define WS_WTF  (WS_Z)
#define WS_CU   (WS_Z + 17301504ull)
#define WT_IN  0
#define WT_G   2621440
#define WT_BRA 4718592
#define WT_BRB 5242880
#define WT_OUT 5767168
#define WT_FIN 0
#define WT_FDN 5767168
#define O_PSHIFT 17301504
#define O_PWKV   17308672
#define O_PK     17439744
#define O_PV     17505280
#define O_PCONV  17570816
#define O_SSHIFT 17593344
#define O_SWKV   18052096
#define O_SK     26440704
#define O_SV     30635008
#define O_SCONV  34829312

#define LDS_BYTES 151552

struct Params {
  const float* in[30];
  float* out;
  unsigned char* ws;
  int ph_lo, ph_hi;
};

__device__ __forceinline__ u16 f2bf(float f) {
  unsigned u = __float_as_uint(f);
  u += 0x7FFFu + ((u >> 16) & 1u);
  return (u16)(u >> 16);
}
__device__ __forceinline__ float bf2f(u16 h) { return __uint_as_float(((unsigned)h) << 16); }
__device__ __forceinline__ unsigned pack2(float a, float b) { return (unsigned)f2bf(a) | ((unsigned)f2bf(b) << 16); }
__device__ __forceinline__ float sigm(float x) { return __builtin_amdgcn_rcpf(1.f + __expf(-x)); }
__device__ __forceinline__ void unpack8(uint4 u, float* o) {
  o[0] = __uint_as_float(u.x << 16); o[1] = __uint_as_float(u.x & 0xFFFF0000u);
  o[2] = __uint_as_float(u.y << 16); o[3] = __uint_as_float(u.y & 0xFFFF0000u);
  o[4] = __uint_as_float(u.z << 16); o[5] = __uint_as_float(u.z & 0xFFFF0000u);
  o[6] = __uint_as_float(u.w << 16); o[7] = __uint_as_float(u.w & 0xFFFF0000u);
}
__device__ __forceinline__ uint4 pack8(const float* f) {
  uint4 u; u.x = pack2(f[0], f[1]); u.y = pack2(f[2], f[3]); u.z = pack2(f[4], f[5]); u.w = pack2(f[6], f[7]); return u;
}
__device__ __forceinline__ int opq(int x) { asm volatile("" : "+v"(x)); return x; }
__device__ __forceinline__ float wave_sum(float x) {
#pragma unroll
  for (int o = 32; o >= 1; o >>= 1) x += __shfl_xor(x, o, 64);
  return x;
}

namespace pg8 {
#define PG8_LAS __attribute__((address_space(3)))
typedef unsigned short bf16_t;
typedef short bf16x8 __attribute__((ext_vector_type(8)));
typedef float f32x4 __attribute__((ext_vector_type(4)));
typedef unsigned u32x4 __attribute__((ext_vector_type(4)));
constexpr int BM = 256, BK = 64, HALF = 128, HTB = HALF * BK * 2  , STAGE_BYTES = 8 * HTB, NXCD = 8, WGM = 8;
__host__ __device__ __forceinline__ int lds_byte(int r, int c) { const int st = (r >> 4) * 2 + (c >> 5), rr = r & 15, cc = c & 31, ob = rr * 64 + cc * 2; return st * 1024 + (ob ^ (((ob >> 9) & 1) << 5)); }
__host__ __device__ __forceinline__ void stage_rc(int b, int& R, int& C) { const int st = b / 1024, sb = b % 1024, swz = sb ^ (((sb >> 9) & 1) << 5); R = (st >> 1) * 16 + swz / 64; C = (st & 1) * 32 + (swz % 64) / 2; }
__host__ __device__ __forceinline__ int perm32(int rho) { const int n = rho >> 4, i = rho & 15; return 8 * (i >> 2) + 4 * n + (i & 3); }
struct Unit { int pm, pn; };
struct Gemm { const bf16_t* A; const bf16_t* Bt; int M, N, K, lda; };
struct StaticOrder {
    int nM, nN, nwg, G, c;
    __host__ __device__ void init(int M, int N, int G_, int c_) { nM = M / BM; nN = N / BM; nwg = nM * nN; G = G_; c = c_; }
    __host__ __device__ bool next(int i, Unit& u) const {
        const long L = (long)i * G + c; if (L >= nwg) return false;
        int wgid = (int)L; { const int q = nwg / NXCD, r = nwg % NXCD, xcd = wgid % NXCD, off = wgid / NXCD; wgid = (xcd < r ? xcd * (q + 1) : r * (q + 1) + (xcd - r) * q) + off; }
        const int nig = WGM * nN, gid = wgid / nig, fm = gid * WGM, gsz = (nM - fm) < WGM ? (nM - fm) : WGM;
        u.pm = fm + ((wgid % nig) % gsz); u.pn = (wgid % nig) / gsz; return true;
    }
    __device__ __forceinline__ void a_ready(const Unit&) const {}
    __device__ __forceinline__ void done(const Unit&) const {}
};
__device__ __forceinline__ unsigned cvt_pk_bf16(float lo, float hi) { unsigned r; asm volatile("v_cvt_pk_bf16_f32 %0, %1, %2" : "=v"(r) : "v"(lo), "v"(hi)); return r; }
template <class Epi, class Sched, bool STAMP = false>
__device__ __forceinline__ void gemm_phase(PG8_LAS unsigned char* lds, const Gemm g, const Sched& S, const Epi& E, unsigned long long* stamps) {
    const int tid = ::opq(threadIdx.x), wid = __builtin_amdgcn_readfirstlane(tid >> 6), lane = tid & 63, wr = wid >> 2, wc = wid & 3, fr = lane & 15, fq = lane >> 4;
    const int K = g.K, nt = K / BK;
    int ts_lo = 0, ts_hi = 0, nts = 0; const unsigned long long rt_entry = 0ull;
#define PG8_STAMP() do { if (STAMP && wid == 0 && nts < 64) { const unsigned long long _c = (unsigned long long)clock64(); \
        ts_lo = (lane == nts) ? (int)(unsigned)_c : ts_lo; ts_hi = (lane == nts) ? (int)(unsigned)(_c >> 32) : ts_hi; ++nts; } } while (0)
    PG8_STAMP();
    unsigned voffA[2], voffB[2];
#pragma unroll
    for (int i = 0; i < 2; ++i) { int R, C; stage_rc(tid * 16 + i * 8192, R, C); const int Rb = Epi::PERM ? ((R & ~31) + perm32(R & 31)) : R;
        voffA[i] = (unsigned)(R * g.lda + C) * 2u; voffB[i] = (unsigned)(Rb * K + C) * 2u; }
    const size_t kstep = (size_t)(BK * 2);
    const size_t hstep = (size_t)HALF * K * 2;
    const size_t tstep = 2 * hstep; const size_t hstepA = (size_t)HALF * g.lda * 2; const size_t tstepA = 2 * hstepA;
    const unsigned ldsw = (unsigned)wid * 1024u;
    const int aoff = lds_byte(wr * 64 + fr, fq * 8), boff = lds_byte(wc * 32 + fr, fq * 8);
#define PG8_SA(b, h) (((b) * 2 + (h)) * HTB)
#define PG8_SB(b, h) ((4 + (b) * 2 + (h)) * HTB)
#define PG8_STAGE(bufoff, gbase, voff) do { _Pragma("unroll") for (int _i = 0; _i < 2; ++_i) \
        __builtin_amdgcn_global_load_lds((const unsigned*)((const char*)(gbase) + (voff)[_i]), (PG8_LAS unsigned*)(lds + (bufoff) + ldsw + _i * 8192), 16, 0, 0); } while (0)
#define PG8_LDA(dst, b, h) do { _Pragma("unroll") for (int m = 0; m < 4; ++m) _Pragma("unroll") for (int k = 0; k < 2; ++k) dst[m][k] = *(const PG8_LAS bf16x8*)(lds + PG8_SA(b, h) + aoff + m * 2048 + k * 1024); } while (0)
#define PG8_LDB(dst, b, h) do { _Pragma("unroll") for (int n = 0; n < 2; ++n) _Pragma("unroll") for (int k = 0; k < 2; ++k) dst[n][k] = *(const PG8_LAS bf16x8*)(lds + PG8_SB(b, h) + boff + n * 2048 + k * 1024); } while (0)
#define PG8_MMA(ai, bj, At, Bt) do { __builtin_amdgcn_s_setprio(1); _Pragma("unroll") for (int m = 0; m < 4; ++m) _Pragma("unroll") for (int n = 0; n < 2; ++n) _Pragma("unroll") for (int k = 0; k < 2; ++k) \
        acc[ai][bj][m][n] = __builtin_amdgcn_mfma_f32_16x16x32_bf16(Bt[n][k], At[m][k], acc[ai][bj][m][n], 0, 0, 0); __builtin_amdgcn_s_setprio(0); } while (0)
#define PG8_WAIT_V(n) asm volatile("s_waitcnt vmcnt(" #n ")" ::: "memory")
#define PG8_WAIT_L(n) asm volatile("s_waitcnt lgkmcnt(" #n ")" ::: "memory")
#define PG8_BAR __builtin_amdgcn_s_barrier()
#define PG8_SCHED __builtin_amdgcn_sched_barrier(0)
    Unit cur, nxt; int ui = 0;
    if (!S.next(0, cur)) return;
    f32x4 acc[2][2][4][2];
#pragma unroll
    for (int a = 0; a < 2; ++a)
#pragma unroll
        for (int b = 0; b < 2; ++b)
#pragma unroll
            for (int m = 0; m < 4; ++m)
#pragma unroll
                for (int n = 0; n < 2; ++n) acc[a][b][m][n] = (f32x4){0.f, 0.f, 0.f, 0.f};
    bf16x8 At[4][2], B0[2][2], B1[2][2];
    const char* cA = (const char*)g.A + (size_t)cur.pm * tstepA; const char* cB = (const char*)g.Bt + (size_t)cur.pn * tstep;
    S.a_ready(cur);
    PG8_STAGE(PG8_SB(0, 0), cB, voffB); PG8_STAGE(PG8_SA(0, 0), cA, voffA); PG8_STAGE(PG8_SB(0, 1), cB + hstep, voffB); PG8_STAGE(PG8_SA(0, 1), cA + hstepA, voffA);
    if (wr == 1) PG8_BAR;
    PG8_WAIT_V(4); PG8_BAR;
    PG8_STAGE(PG8_SB(1, 0), cB + kstep, voffB); PG8_STAGE(PG8_SA(1, 0), cA + kstep, voffA); PG8_STAGE(PG8_SB(1, 1), cB + hstep + kstep, voffB);
    PG8_WAIT_V(6); PG8_BAR;
    PG8_STAMP();
    for (;;) {
        const bool has_next = S.next(ui + 1, nxt);
        const char* nA = has_next ? (const char*)g.A + (size_t)nxt.pm * tstepA : cA; const char* nB = has_next ? (const char*)g.Bt + (size_t)nxt.pn * tstep : cB;
        for (int t = 0; t < nt; t += 2) {
            const bool last = (t == nt - 2);
            const char* a1 = cA + (size_t)(t + 1) * kstep;
            const char* a2 = last ? nA : cA + (size_t)(t + 2) * kstep; const char* b2 = last ? nB : cB + (size_t)(t + 2) * kstep;
            const char* a3 = a2 + kstep; const char* b3 = b2 + kstep;
            if (last && has_next) S.a_ready(nxt);
            PG8_LDB(B0, 0, 0); PG8_SCHED; PG8_LDA(At, 0, 0); PG8_STAGE(PG8_SA(1, 1), a1 + hstepA, voffA);
            PG8_WAIT_L(8); PG8_BAR; PG8_WAIT_L(0); PG8_MMA(0, 0, At, B0); PG8_BAR; PG8_SCHED;
            PG8_LDB(B1, 0, 1); PG8_STAGE(PG8_SB(0, 0), b2, voffB);
            PG8_BAR; PG8_WAIT_L(0); PG8_MMA(0, 1, At, B1); PG8_BAR;
            PG8_LDA(At, 0, 1); PG8_STAGE(PG8_SA(0, 0), a2, voffA);
            PG8_BAR; PG8_WAIT_L(0); PG8_MMA(1, 0, At, B0); PG8_BAR; PG8_SCHED;
            PG8_STAGE(PG8_SB(0, 1), b2 + hstep, voffB);
            PG8_WAIT_V(6); PG8_BAR; PG8_MMA(1, 1, At, B1); PG8_BAR;
            PG8_LDB(B0, 1, 0); PG8_SCHED; PG8_LDA(At, 1, 0); PG8_STAGE(PG8_SA(0, 1), a2 + hstepA, voffA);
            PG8_WAIT_L(8); PG8_BAR; PG8_WAIT_L(0); PG8_MMA(0, 0, At, B0); PG8_BAR; PG8_SCHED;
            PG8_LDB(B1, 1, 1); PG8_STAGE(PG8_SB(1, 0), b3, voffB);
            PG8_BAR; PG8_WAIT_L(0); PG8_MMA(0, 1, At, B1); PG8_BAR;
            PG8_LDA(At, 1, 1); PG8_STAGE(PG8_SA(1, 0), a3, voffA);
            PG8_BAR; PG8_WAIT_L(0); PG8_MMA(1, 0, At, B0); PG8_BAR; PG8_SCHED;
            PG8_STAGE(PG8_SB(1, 1), b3 + hstep, voffB);
            PG8_WAIT_V(6); PG8_BAR; PG8_MMA(1, 1, At, B1); PG8_BAR;
        }
        PG8_STAMP();
        if constexpr (!Epi::AFTER_DRAIN) { E(acc, cur, wr, wc, fr, fq); S.done(cur); }
        PG8_STAMP();
        if (!has_next) break;
#pragma unroll
        for (int a = 0; a < 2; ++a)
#pragma unroll
            for (int b = 0; b < 2; ++b)
#pragma unroll
                for (int m = 0; m < 4; ++m)
#pragma unroll
                    for (int n = 0; n < 2; ++n) acc[a][b][m][n] = (f32x4){0.f, 0.f, 0.f, 0.f};
        cur = nxt; cA = nA; cB = nB; ++ui;
    }
    PG8_WAIT_V(0);
    if (wr == 0) PG8_BAR;
    PG8_BAR;
    if constexpr (Epi::AFTER_DRAIN) { E.fused(acc, cur, wr, wc, fr, fq, lds, wid, lane); S.done(cur); }
    PG8_STAMP();
    if (STAMP && wid == 0) { stamps[lane] = lane < nts ? (((unsigned long long)(unsigned)ts_hi << 32) | (unsigned)ts_lo) : 0ull;
        if (lane == 62) stamps[62] = rt_entry; if (lane == 63) stamps[63] = (unsigned long long)wall_clock64(); }
#undef PG8_STAMP
#undef PG8_SA
#undef PG8_SB
#undef PG8_STAGE
#undef PG8_LDA
#undef PG8_LDB
#undef PG8_MMA
#undef PG8_WAIT_V
#undef PG8_WAIT_L
#undef PG8_BAR
#undef PG8_SCHED
}
}
using pg8::f32x4;
#define ROWOFF(reg, h) (((reg) & 3) + 8 * ((reg) >> 2) + 4 * (h))

__device__ void conv_tile(const float* __restrict__ src, int K, int N, u16* __restrict__ dst, int k0, int n0, int sn0, float* lds) {
  const int tid = opq(threadIdx.x);
  __syncthreads();
  {
    const int k = tid >> 3, c = (tid & 7) * 8;
    const float* s = src + (size_t)(k0 + k) * N + sn0 + c;
    float4 a = *(const float4*)s, b = *(const float4*)(s + 4);
    float* d = lds + k * 65 + c;
    d[0] = a.x; d[1] = a.y; d[2] = a.z; d[3] = a.w;
    d[4] = b.x; d[5] = b.y; d[6] = b.z; d[7] = b.w;
  }
  __syncthreads();
  {
    const int n = tid >> 3, kk = (tid & 7) * 8;
    float f[8];
#pragma unroll
    for (int i = 0; i < 8; ++i) f[i] = lds[(kk + i) * 65 + n];
    *(uint4*)(dst + (size_t)(n0 + n) * K + k0 + kk) = pack8(f);
  }
}

__device__ void phase_prep(const Params& p, int l, int which, float* ldsf) {
  u16* WtA = (u16*)(p.ws + WS_WT);
  u16* WtF = (u16*)(p.ws + WS_WTF);
  u16* H = (u16*)(p.ws + WS_H);
  float* X = p.out;
  const int nconv = which == 0 ? (640 + 512 + 128 + 128 + 256) : (1408 + 704);
  const int ntot = nconv + 2112;
  const float* gw = (which == 0 ? p.in[7] : p.in[24]) + l * 1024;
  for (int it = blockIdx.x; it < ntot; it += gridDim.x) {
    if (it < nconv) {
      int t = it;
      if (which == 0) {
        if (t < 640) { const int tk = t / 40, tn = t % 40; conv_tile(p.in[8] + (size_t)l * 1024 * 4608, 1024, 4608, WtA + WT_IN, tk * 64, tn * 64, tn * 64, ldsf); }
        else if ((t -= 640) < 512) {
          const int tk = t / 32, tn = t % 32; const int n0 = tn * 64;
          const int sn0 = 2560 + ((n0 >> 7) & 1) * 1024 + (n0 >> 8) * 128 + (n0 & 127);
          conv_tile(p.in[8] + (size_t)l * 1024 * 4608, 1024, 4608, WtA + WT_G, tk * 64, n0, sn0, ldsf);
        }
        else if ((t -= 512) < 128) { const int tk = t / 16, tn = t % 16; conv_tile(p.in[21] + (size_t)l * 512 * 1024, 512, 1024, WtA + WT_BRA, tk * 64, tn * 64, tn * 64, ldsf); }
        else if ((t -= 128) < 128) { const int tk = t / 16, tn = t % 16; conv_tile(p.in[22] + (size_t)l * 512 * 1024, 512, 1024, WtA + WT_BRB, tk * 64, tn * 64, tn * 64, ldsf); }
        else { t -= 128; const int tk = t / 16, tn = t % 16; conv_tile(p.in[23] + (size_t)l * 1024 * 1024, 1024, 1024, WtA + WT_OUT, tk * 64, tn * 64, tn * 64, ldsf); }
      } else {
        if (t < 1408) {
          const int tk = t / 88, tn = t % 88; const int n0 = tn * 64;
          const int sn0 = ((n0 >> 7) & 1) * 2816 + (n0 >> 8) * 128 + (n0 & 127);
          conv_tile(p.in[25] + (size_t)l * 1024 * 5632, 1024, 5632, WtF + WT_FIN, tk * 64, n0, sn0, ldsf);
        } else { t -= 1408; const int tk = t / 16, tn = t % 16; conv_tile(p.in[28] + (size_t)l * 2816 * 1024, 2816, 1024, WtF + WT_FDN, tk * 64, tn * 64, tn * 64, ldsf); }
      }
    } else {
      const int tid = opq(threadIdx.x);
      const int row = (it - nconv) * 8 + (tid >> 6);
      const int lane = tid & 63;
      const bool first = (which == 0 && l == 0);
      const float* src;
      if (first) src = (row < M_P) ? p.in[0] + (size_t)row * 1024 : p.in[1] + (size_t)(row - M_P) * 1024;
      else src = X + (size_t)row * 1024;
      float4 v[4];
      float ss = 0.f;
#pragma unroll
      for (int i = 0; i < 4; ++i) {
        v[i] = *(const float4*)(src + i * 256 + lane * 4);
        ss += v[i].x * v[i].x + v[i].y * v[i].y + v[i].z * v[i].z + v[i].w * v[i].w;
        if (first) *(float4*)(X + (size_t)row * 1024 + i * 256 + lane * 4) = v[i];
      }
      ss = wave_sum(ss);
      const float rs = rsqrtf(ss * (1.f / 1024.f) + 1e-6f);
#pragma unroll
      for (int i = 0; i < 4; ++i) {
        const float4 g = *(const float4*)(gw + i * 256 + lane * 4);
        uint2 o; o.x = pack2(v[i].x * rs * g.x, v[i].y * rs * g.y); o.y = pack2(v[i].z * rs * g.z, v[i].w * rs * g.w);
        *(uint2*)(H + (size_t)row * 1024 + i * 256 + lane * 4) = o;
      }
    }
  }
}

struct EpiInproj {
  static constexpr bool PERM = true, AFTER_DRAIN = false;
  u16* z; float* out; int l;
  __device__ __forceinline__ void operator()(const f32x4 (&acc)[2][2][4][2], const pg8::Unit& u, int wr, int wc, int fr, int fq) const {
    const int row0 = u.pm * 256 + wr * 64 + fr, col0 = u.pn * 256 + wc * 32 + 8 * fq;
#pragma unroll
    for (int ai = 0; ai < 2; ++ai)
#pragma unroll
      for (int m = 0; m < 4; ++m) {
        const int row = row0 + ai * 128 + m * 16;
        u16* rowp = z + (size_t)row * ZLD + col0;
#pragma unroll
        for (int bj = 0; bj < 2; ++bj) {
          const f32x4 v0 = acc[ai][bj][m][0], v1 = acc[ai][bj][m][1];
          pg8::u32x4 w; w.x = pg8::cvt_pk_bf16(v0[0], v0[1]); w.y = pg8::cvt_pk_bf16(v0[2], v0[3]); w.z = pg8::cvt_pk_bf16(v1[0], v1[1]); w.w = pg8::cvt_pk_bf16(v1[2], v1[3]);
          *(pg8::u32x4*)(rowp + bj * 128) = w;
        }
        const bool prompt = row < M_P;
        int b, t;
        if (prompt) { b = row >> 13; t = row & 8191; } else { b = (row - M_P) >> 2; t = (row - M_P) & 3; }
        if (u.pn < 7) {
          if ((prompt && t == 8191) || (!prompt && t == 3)) {
            float* o = out + (prompt ? O_PSHIFT + (size_t)(l * 2 + b) * 1792 : O_SSHIFT + (size_t)(l * 128 + b) * 1792) + col0;
#pragma unroll
            for (int bj = 0; bj < 2; ++bj) { *(f32x4*)(o + bj * 128) = acc[ai][bj][m][0]; *(f32x4*)(o + bj * 128 + 4) = acc[ai][bj][m][1]; }
          }
        } else if (u.pn == 9 && prompt && t >= 8064) {
          const int c = wc * 32 + 8 * fq;
          float* o = out + O_PV + ((size_t)((l * 2 + b) * 128 + (t - 8064)) * 2 + (c >> 6)) * 64 + (c & 63);
          *(f32x4*)o = acc[ai][1][m][0]; *(f32x4*)(o + 4) = acc[ai][1][m][1];
        }
      }
  }
};
struct EpiStoreBf16 {
  static constexpr bool PERM = true, AFTER_DRAIN = false;
  u16* O; int ldc;
  __device__ __forceinline__ void operator()(const f32x4 (&acc)[2][2][4][2], const pg8::Unit& u, int wr, int wc, int fr, int fq) const {
    const int row0 = u.pm * 256 + wr * 64 + fr, col0 = u.pn * 256 + wc * 32 + 8 * fq;
#pragma unroll
    for (int ai = 0; ai < 2; ++ai)
#pragma unroll
      for (int m = 0; m < 4; ++m) {
        u16* rowp = O + (size_t)(row0 + ai * 128 + m * 16) * ldc + col0;
#pragma unroll
        for (int bj = 0; bj < 2; ++bj) {
          const f32x4 v0 = acc[ai][bj][m][0], v1 = acc[ai][bj][m][1];
          pg8::u32x4 w; w.x = pg8::cvt_pk_bf16(v0[0], v0[1]); w.y = pg8::cvt_pk_bf16(v0[2], v0[3]); w.z = pg8::cvt_pk_bf16(v1[0], v1[1]); w.w = pg8::cvt_pk_bf16(v1[2], v1[3]);
          *(pg8::u32x4*)(rowp + bj * 128) = w;
        }
      }
  }
};
struct EpiFfnIn {
  static constexpr bool PERM = true, AFTER_DRAIN = false;
  u16* cu;
  __device__ __forceinline__ void operator()(const f32x4 (&acc)[2][2][4][2], const pg8::Unit& u, int wr, int wc, int fr, int fq) const {
    const int row0 = u.pm * 256 + wr * 64 + fr, col0 = u.pn * 128 + wc * 32 + 8 * fq;
#pragma unroll
    for (int ai = 0; ai < 2; ++ai)
#pragma unroll
      for (int m = 0; m < 4; ++m) {
        u16* rowp = cu + (size_t)(row0 + ai * 128 + m * 16) * 5632 + col0;
#pragma unroll
        for (int bj = 0; bj < 2; ++bj) {
          const f32x4 v0 = acc[ai][bj][m][0], v1 = acc[ai][bj][m][1];
          pg8::u32x4 w; w.x = pg8::cvt_pk_bf16(v0[0], v0[1]); w.y = pg8::cvt_pk_bf16(v0[2], v0[3]); w.z = pg8::cvt_pk_bf16(v1[0], v1[1]); w.w = pg8::cvt_pk_bf16(v1[2], v1[3]);
          *(pg8::u32x4*)(rowp + bj * 2816) = w;
        }
      }
  }
};
struct EpiMerge {
  static constexpr bool PERM = true, AFTER_DRAIN = false;
  const u16* t1; const u16* t2; u16* mg;
  __device__ __forceinline__ void operator()(const f32x4 (&acc)[2][2][4][2], const pg8::Unit& u, int wr, int wc, int fr, int fq) const {
    const int row0 = u.pm * 256 + wr * 64 + fr, col0 = u.pn * 128 + wc * 32 + 8 * fq;
#pragma unroll
    for (int ai = 0; ai < 2; ++ai)
#pragma unroll
      for (int m = 0; m < 4; ++m) {
        const size_t off = (size_t)(row0 + ai * 128 + m * 16) * 1024 + col0;
        float a[8], b[8], o[8];
        unpack8(*(const uint4*)(t1 + off), a);
        unpack8(*(const uint4*)(t2 + off), b);
#pragma unroll
        for (int n = 0; n < 2; ++n)
#pragma unroll
          for (int j = 0; j < 4; ++j)
            o[n * 4 + j] = sigm(acc[ai][0][m][n][j]) * a[n * 4 + j] + sigm(acc[ai][1][m][n][j]) * b[n * 4 + j];
        *(uint4*)(mg + off) = pack8(o);
        asm volatile("" ::: "memory");
      }
  }
};
struct EpiResid {
  static constexpr bool PERM = false, AFTER_DRAIN = false;
  float* X;
  __device__ __forceinline__ void operator()(const f32x4 (&acc)[2][2][4][2], const pg8::Unit& u, int wr, int wc, int fr, int fq) const {
    const int row0 = u.pm * 256 + wr * 64 + fr, col0 = u.pn * 256 + wc * 32 + 4 * fq;
#pragma unroll
    for (int ai = 0; ai < 2; ++ai)
#pragma unroll
      for (int m = 0; m < 4; ++m) {
        float* rowp = X + (size_t)(row0 + ai * 128 + m * 16) * 1024 + col0;
#pragma unroll
        for (int bj = 0; bj < 2; ++bj)
#pragma unroll
          for (int n = 0; n < 2; ++n) { f32x4* q = (f32x4*)(rowp + bj * 128 + n * 16); *q = *q + acc[ai][bj][m][n]; }
        asm volatile("" ::: "memory");
      }
  }
};
template <class Epi>
__device__ __forceinline__ void run_gemm(unsigned char* lds_raw, const u16* A, int lda, const u16* Bt, int N, int K, const Epi& E) {
  pg8::Gemm g; g.A = A; g.Bt = Bt; g.M = M_TOT; g.N = N; g.K = K; g.lda = lda;
  pg8::StaticOrder S; S.init(M_TOT, N, gridDim.x, blockIdx.x);
  __syncthreads();
  pg8::gemm_phase<Epi, pg8::StaticOrder, false>((PG8_LAS unsigned char*)lds_raw, g, S, E, nullptr);
  __syncthreads();
}

__device__ void rope_item(const Params& p, int l, int item) {
  const int tid = opq(threadIdx.x);
  u16* z = (u16*)(p.ws + WS_Z);
  const int row = item * 64 + (tid >> 3);
  const int d0 = (tid & 7) * 4;
  const bool prompt = row < M_P;
  int b, t, pos;
  if (prompt) { b = row >> 13; t = row & 8191; pos = t; } else { b = (row - M_P) >> 2; t = (row - M_P) & 3; pos = 16384 + t; }
  float cs[4], sn[4];
#pragma unroll
  for (int i = 0; i < 4; ++i) {
    const float inv = __expf(-(float)(d0 + i) * (9.210340371976184f / 32.f));
    const float angf = (float)pos * inv;
    double a = (double)angf;
    a -= 6.283185307179586 * rint(a * 0.15915494309189535);
    const float af = (float)a;
    sn[i] = __sinf(af); cs[i] = __cosf(af);
  }
#pragma unroll 2
  for (int hh = 0; hh < 10; ++hh) {
    u16* q = z + (size_t)row * ZLD + 1792 + hh * 64 + d0;
    const uint2 lo = *(const uint2*)q, hi = *(const uint2*)(q + 32);
    float x1[4] = {__uint_as_float(lo.x << 16), __uint_as_float(lo.x & 0xFFFF0000u), __uint_as_float(lo.y << 16), __uint_as_float(lo.y & 0xFFFF0000u)};
    float x2[4] = {__uint_as_float(hi.x << 16), __uint_as_float(hi.x & 0xFFFF0000u), __uint_as_float(hi.y << 16), __uint_as_float(hi.y & 0xFFFF0000u)};
    float y1[4], y2[4];
#pragma unroll
    for (int i = 0; i < 4; ++i) { y1[i] = x1[i] * cs[i] - x2[i] * sn[i]; y2[i] = x2[i] * cs[i] + x1[i] * sn[i]; }
    uint2 o1, o2;
    o1.x = pack2(y1[0], y1[1]); o1.y = pack2(y1[2], y1[3]); o2.x = pack2(y2[0], y2[1]); o2.y = pack2(y2[2], y2[3]);
    *(uint2*)q = o1; *(uint2*)(q + 32) = o2;
    if (hh >= 8 && prompt && t >= 8064) {
      float* o = p.out + O_PK + ((size_t)((l * 2 + b) * 128 + (t - 8064)) * 2 + (hh - 8)) * 64 + d0;
      *(float4*)o = make_float4(y1[0], y1[1], y1[2], y1[3]);
      *(float4*)(o + 32) = make_float4(y2[0], y2[1], y2[2], y2[3]);
    }
  }
}

#define SL(i) (ldsf + (i) * 4160)
__device__ void rwkv_item(const Params& p, int l, int item, float* ldsf) {
  const int tid = opq(threadIdx.x), lane = tid & 63, wave = tid >> 6;
  const bool sample = item >= 2048;
  int h, cidx, rowbase;
  if (!sample) { h = item & 7; cidx = item >> 3; rowbase = cidx * 64; }
  else { int s = item - 2048; h = s & 7; cidx = s >> 3; rowbase = M_P + cidx * 64; }
  const int cc = cidx & 127;
  const u16* z = (const u16*)(p.ws + WS_Z);
  u16* zw_ = (u16*)(p.ws + WS_Z);
  const float* mu = p.in[9] + l * 1792;
  float* wbuf = SL(7);
  float* gc = ldsf + 9 * 4160;
  float* bd = ldsf + 9 * 4160 + 64;
  __syncthreads();
  {
    const int t = tid >> 3, c8 = (tid & 7) * 8;
    const int m = rowbase + t;
    const int zcs[7] = {h * 64, 512 + h * 64, 1024 + h * 64, 1536, 1600, 1664, 1728};
#pragma unroll
    for (int gi = 0; gi < 7; ++gi) {
      const int zc = zcs[gi] + c8;
      float cur[8], prv[8];
      unpack8(*(const uint4*)(z + (size_t)m * ZLD + zc), cur);
      bool zero = false, fromstate = false;
      if (!sample) zero = (t == 0 && cc == 0);
      else fromstate = ((t & 3) == 0);
      if (zero) {
#pragma unroll
        for (int i = 0; i < 8; ++i) prv[i] = 0.f;
      } else if (fromstate) {
        const int b = (m - M_P) >> 2;
        const float* sp = p.in[2] + (size_t)(l * 128 + b) * 1792 + zc;
        float4 a = *(const float4*)sp, bb = *(const float4*)(sp + 4);
        prv[0] = a.x; prv[1] = a.y; prv[2] = a.z; prv[3] = a.w; prv[4] = bb.x; prv[5] = bb.y; prv[6] = bb.z; prv[7] = bb.w;
      } else {
        unpack8(*(const uint4*)(z + (size_t)(m - 1) * ZLD + zc), prv);
      }
      float* d = SL(gi) + t * 65 + c8;
#pragma unroll
      for (int i = 0; i < 8; ++i) {
        float v = cur[i] + mu[zc + i] * (prv[i] - cur[i]);
        if (gi == 3) v = tanhf(v);
        if (gi >= 5) v = sigm(v);
        d[i] = v;
      }
    }
  }
  const int lt = tid & 63, jg = tid >> 6;
  auto load_w = [&](const float* W, int nrows) {
    for (int e = tid; e < nrows * 8; e += NT) {
      const int i = e >> 3, c = (e & 7) * 8;
      const float* s = W + (size_t)i * 512 + h * 64 + c;
      *(float4*)(wbuf + i * 64 + c) = *(const float4*)s;
      *(float4*)(wbuf + i * 64 + c + 4) = *(const float4*)(s + 4);
    }
  };
  auto lora = [&](const float* xa, const float* xb, int n, float* acc) {
#pragma unroll 2
    for (int i = 0; i < n; ++i) {
      const float x = (i < 64) ? xa[lt * 65 + i] : xb[lt * 65 + i - 64];
      const float4 w0 = *(const float4*)(wbuf + i * 64 + jg * 8);
      const float4 w1 = *(const float4*)(wbuf + i * 64 + jg * 8 + 4);
      acc[0] += x * w0.x; acc[1] += x * w0.y; acc[2] += x * w0.z; acc[3] += x * w0.w;
      acc[4] += x * w1.x; acc[5] += x * w1.y; acc[6] += x * w1.z; acc[7] += x * w1.w;
    }
  };
  float res[8];
  load_w(p.in[11] + (size_t)l * 64 * 512, 64);
  __syncthreads();
#pragma unroll
  for (int i = 0; i < 8; ++i) res[i] = p.in[10][l * 512 + h * 64 + jg * 8 + i];
  lora(SL(3), SL(3), 64, res);
  __syncthreads();
#pragma unroll
  for (int i = 0; i < 8; ++i) {
    const float x = -res[i];
    const float sp = (x > 20.f) ? x : log1pf(__expf(x));
    SL(3)[lt * 65 + jg * 8 + i] = -__expf(-sp - 0.5f);
  }
  load_w(p.in[13] + (size_t)l * 64 * 512, 64);
  __syncthreads();
#pragma unroll
  for (int i = 0; i < 8; ++i) res[i] = p.in[12][l * 512 + h * 64 + jg * 8 + i];
  lora(SL(4), SL(4), 64, res);
  __syncthreads();
#pragma unroll
  for (int i = 0; i < 8; ++i) SL(4)[lt * 65 + jg * 8 + i] = sigm(res[i]);
  load_w(p.in[14] + (size_t)l * 128 * 512, 128);
  __syncthreads();
#pragma unroll
  for (int i = 0; i < 8; ++i) res[i] = 0.f;
  lora(SL(5), SL(6), 128, res);
  __syncthreads();
  if (!sample) {
    u16* ga = (u16*)(p.ws + WS_GA) + (size_t)item * 4096;
    *(uint4*)(ga + lt * 64 + jg * 8) = pack8(res);
    if (tid < 64) {
      float c = 0.f;
      for (int t = 0; t < 64; ++t) { c += SL(3)[t * 65 + tid]; SL(5)[t * 65 + tid] = c; }
      gc[tid] = __expf(c);
    }
  } else {
#pragma unroll
    for (int i = 0; i < 8; ++i) SL(6)[lt * 65 + jg * 8 + i] = res[i];
  }
  __syncthreads();
  {
    const int t = tid >> 3, j0 = (tid & 7) * 8;
    const float* kkw = p.in[15] + l * 512 + h * 64;
    const float* kaw = p.in[16] + l * 512 + h * 64;
    const float* rkw = p.in[17] + l * 512 + h * 64;
    float kr[8], av[8], rv[8], kkv[8], kf[8];
    float nrm = 0.f, bdot = 0.f;
#pragma unroll
    for (int i = 0; i < 8; ++i) {
      const int j = j0 + i;
      kr[i] = SL(1)[t * 65 + j]; av[i] = SL(4)[t * 65 + j]; rv[i] = SL(0)[t * 65 + j];
      kkv[i] = kr[i] * kkw[j];
      nrm += kkv[i] * kkv[i];
      kf[i] = kr[i] * (1.f + (av[i] - 1.f) * kaw[j]);
      bdot += rv[i] * kf[i] * rkw[j];
    }
    nrm += __shfl_xor(nrm, 1, 64); nrm += __shfl_xor(nrm, 2, 64); nrm += __shfl_xor(nrm, 4, 64);
    bdot += __shfl_xor(bdot, 1, 64); bdot += __shfl_xor(bdot, 2, 64); bdot += __shfl_xor(bdot, 4, 64);
    const float rn = 1.f / fmaxf(sqrtf(nrm), 1e-12f);
    if (!sample) {
      float bo[8];
#pragma unroll
      for (int i = 0; i < 8; ++i) {
        const int j = j0 + i;
        const float cum = SL(5)[t * 65 + j], dl = SL(3)[t * 65 + j];
        const float eg = __expf(cum), egi = __expf(-cum), egp = __expf(cum - dl);
        const float kk = kkv[i] * rn;
        SL(0)[t * 65 + j] = rv[i] * eg;
        SL(1)[t * 65 + j] = kf[i] * egi;
        SL(3)[t * 65 + j] = kk * av[i] * egi;
        SL(4)[t * 65 + j] = kk * egp;
        bo[i] = bdot * SL(2)[t * 65 + j];
      }
      u16* bop = (u16*)(p.ws + WS_BO) + (size_t)item * 4096;
      *(uint4*)(bop + t * 64 + j0) = pack8(bo);
    } else {
#pragma unroll
      for (int i = 0; i < 8; ++i) {
        const int j = j0 + i;
        const float kk = kkv[i] * rn;
        const float dl = SL(3)[t * 65 + j];
        SL(1)[t * 65 + j] = kf[i];
        SL(3)[t * 65 + j] = __expf(dl);
        SL(4)[t * 65 + j] = kk;
        SL(5)[t * 65 + j] = kk * av[i];
      }
      if ((tid & 7) == 0) bd[t] = bdot;
    }
  }
  __syncthreads();
  if (sample) {
    const float lng = p.in[18][l * 512 + h * 64 + lane], lnb = p.in[19][l * 512 + h * 64 + lane];
    for (int round = 0; round < 2; ++round) {
      const int seq = wave + 8 * round;
      const int b = cidx * 16 + seq;
      float S[64];
      const float* sp = p.in[3] + ((size_t)((l * 128 + b) * 8 + h) * 64 + lane) * 64;
#pragma unroll
      for (int k = 0; k < 64; k += 4) { float4 v = *(const float4*)(sp + k); S[k] = v.x; S[k + 1] = v.y; S[k + 2] = v.z; S[k + 3] = v.w; }
      for (int tt = 0; tt < 4; ++tt) {
        const int t = seq * 4 + tt;
        float sk = 0.f;
#pragma unroll
        for (int kc = 0; kc < 64; kc += 8) {
#pragma unroll
          for (int k = kc; k < kc + 8; ++k) sk += S[k] * SL(4)[t * 65 + k];
          __builtin_amdgcn_sched_barrier(0);
        }
        const float vt = SL(2)[t * 65 + lane];
        float y = 0.f;
#pragma unroll
        for (int kc = 0; kc < 64; kc += 8) {
#pragma unroll
          for (int k = kc; k < kc + 8; ++k) {
            S[k] = S[k] * SL(3)[t * 65 + k] - sk * SL(5)[t * 65 + k] + vt * SL(1)[t * 65 + k];
            y += S[k] * SL(0)[t * 65 + k];
          }
          __builtin_amdgcn_sched_barrier(0);
        }
        const float mean = wave_sum(y) * (1.f / 64.f);
        const float d = y - mean;
        const float var = wave_sum(d * d) * (1.f / 64.f);
        const float yn = d * rsqrtf(var + 64e-5f) * lng + lnb;
        const float o = (yn + bd[t] * vt) * SL(6)[t * 65 + lane];
        zw_[(size_t)(M_P + b * 4 + tt) * ZLD + h * 64 + lane] = f2bf(o);
      }
      float* op = p.out + O_SWKV + ((size_t)((l * 128 + b) * 8 + h) * 64 + lane) * 64;
#pragma unroll
      for (int k = 0; k < 64; k += 4) *(float4*)(op + k) = make_float4(S[k], S[k + 1], S[k + 2], S[k + 3]);
    }
    return;
  }
  {
    const int i = lane, tg = wave;
    float ab[8], ak[8], akr[8], abr[8];
#pragma unroll
    for (int q = 0; q < 8; ++q) { ab[q] = 0.f; ak[q] = 0.f; akr[q] = 0.f; abr[q] = 0.f; }
#pragma unroll 2
    for (int k = 0; k < 64; ++k) {
      const float xb = SL(3)[i * 65 + k], xk = SL(1)[i * 65 + k];
#pragma unroll
      for (int q = 0; q < 8; ++q) {
        const int t = tg * 8 + q;
        const float yk = SL(4)[t * 65 + k], yr = SL(0)[t * 65 + k];
        ab[q] += xb * yk; ak[q] += xk * yk; akr[q] += xk * yr; abr[q] += xb * yr;
      }
    }
    __syncthreads();
#pragma unroll
    for (int q = 0; q < 8; ++q) {
      const int t = tg * 8 + q;
      SL(6)[i * 65 + t] = (i < t) ? ab[q] : 0.f;
      SL(7)[i * 65 + t] = (i < t) ? ak[q] : 0.f;
      SL(8)[i * 65 + t] = (i <= t) ? akr[q] : 0.f;
      SL(5)[i * 65 + t] = (i <= t) ? abr[q] : 0.f;
    }
  }
  __syncthreads();
  {
    const int t = tid >> 3, j0 = (tid & 7) * 8;
#pragma unroll
    for (int i = 0; i < 8; ++i) { const float g = gc[j0 + i]; SL(3)[t * 65 + j0 + i] *= g; SL(1)[t * 65 + j0 + i] *= g; }
  }
  __syncthreads();
  if (tid < 128) {
    float* X_ = (tid < 64) ? SL(5) : SL(3);
    const int col = tid & 63;
    for (int i = 62; i >= 0; --i) {
      float a = X_[i * 65 + col];
#pragma unroll 4
      for (int t = i + 1; t < 64; ++t) a -= SL(6)[i * 65 + t] * X_[t * 65 + col];
      X_[i * 65 + col] = a;
    }
  }
  __syncthreads();
  {
    const int c = tid & 127, ig = tid >> 7;
    const int which = c >> 6, cq = c & 63;
    const float* N_ = which ? SL(3) : SL(5);
    float a[16];
#pragma unroll
    for (int q = 0; q < 16; ++q) a[q] = 0.f;
#pragma unroll 2
    for (int t = 0; t < 64; ++t) {
      const float n = N_[t * 65 + cq];
#pragma unroll
      for (int q = 0; q < 16; ++q) a[q] += SL(7)[(ig * 16 + q) * 65 + t] * n;
    }
    float* T_ = which ? SL(1) : SL(8);
#pragma unroll
    for (int q = 0; q < 16; ++q) T_[(ig * 16 + q) * 65 + cq] -= a[q];
  }
  __syncthreads();
  {
    const int x = lane, yg = wave;
    float w2[8], pp[8], yl[8], qq[8];
#pragma unroll
    for (int q = 0; q < 8; ++q) { w2[q] = 0.f; pp[q] = 0.f; yl[q] = 0.f; qq[q] = 0.f; }
#pragma unroll 2
    for (int j = 0; j < 64; ++j) {
      const float l5 = SL(5)[j * 65 + x], l4 = SL(4)[j * 65 + x], l8 = SL(8)[j * 65 + x], l2 = SL(2)[j * 65 + x];
#pragma unroll
      for (int q = 0; q < 8; ++q) {
        const int y = yg * 8 + q;
        w2[q] += l5 * SL(4)[j * 65 + y];
        pp[q] += l4 * SL(3)[j * 65 + y];
        yl[q] += l8 * SL(2)[j * 65 + y];
        qq[q] += l2 * SL(1)[j * 65 + y];
      }
    }
    float o1[8];
#pragma unroll
    for (int q = 0; q < 8; ++q) {
      const int y = yg * 8 + q;
      o1[q] = SL(0)[x * 65 + y] - w2[q];
    }
    u16* Pf = (u16*)(p.ws + WS_PP) + (size_t)item * 4096;
    float* Qf = (float*)(p.ws + WS_Q) + (size_t)item * 4096;
    if (tid < 64) ((float*)(p.ws + WS_GC))[(size_t)item * 64 + tid] = gc[tid];
    {
      const int s_ = x >> 4, kk = x & 15, hh = (kk >> 2) & 1, jj = ((kk >> 3) << 2) | (kk & 3);
#pragma unroll
      for (int q = 0; q < 8; ++q) {
        const int y = yg * 8 + q;
        Pf[(((y >> 5) * 4 + s_) * 64 + (y & 31) + 32 * hh) * 8 + jj] = f2bf(-pp[q]);
        const int k2 = y & 31, reg = ((k2 >> 3) << 2) | (k2 & 3), h2 = (k2 >> 2) & 1;
        Qf[(((x >> 5) * 2 + (y >> 5)) * 16 + reg) * 64 + (x & 31) + 32 * h2] = qq[q];
      }
    }
    u16* W2p = (u16*)(p.ws + WS_W2) + (size_t)item * 4096 + x * 64 + yg * 8;
    u16* YLp = (u16*)(p.ws + WS_YL) + (size_t)item * 4096 + x * 64 + yg * 8;
    *(uint4*)W2p = pack8(o1);
    *(uint4*)YLp = pack8(yl);
  }
}

__device__ void rwkv_scan(const Params& p, int l, int bh, float* ldsf) {
  const int tid = opq(threadIdx.x), lane = tid & 63, wave = tid >> 6;
  __syncthreads();
  {
    const int b_ = bh >> 3, h_ = bh & 7;
    const float* G0 = (const float*)(p.ws + WS_GC);
    for (int e = tid; e < 8192; e += NT) ldsf[e] = G0[(size_t)((b_ * 128 + (e >> 6)) * 8 + h_) * 64 + (e & 63)];
  }
  __syncthreads();
  if (wave >= 2) return;
  const int vt = wave, hf = lane >> 5;
  const int b = bh >> 3, h = bh & 7;
  f32x16 S[2];
#pragma unroll
  for (int i = 0; i < 16; ++i) { S[0][i] = 0.f; S[1][i] = 0.f; }
  float nQ[2][16];
  auto issueQ = [&](int cc) {
    const size_t id = (size_t)((b * 128 + cc) * 8 + h);
    const float* Qf = (const float*)(p.ws + WS_Q) + id * 4096;
#pragma unroll
    for (int kt = 0; kt < 2; ++kt)
#pragma unroll
      for (int reg = 0; reg < 16; ++reg) nQ[kt][reg] = Qf[((vt * 2 + kt) * 16 + reg) * 64 + lane];
  };
  issueQ(0);
#pragma unroll 1
  for (int cc = 0; cc < 128; ++cc) {
    const size_t id = (size_t)((b * 128 + cc) * 8 + h);
    float* Qf = (float*)(p.ws + WS_Q) + id * 4096;
    const uint4* Pf = (const uint4*)((const u16*)(p.ws + WS_PP) + id * 4096);
    uint4 A[2][4];
#pragma unroll
    for (int kt = 0; kt < 2; ++kt)
#pragma unroll
      for (int s_ = 0; s_ < 4; ++s_) A[kt][s_] = Pf[(kt * 4 + s_) * 64 + lane];
    f32x16 acc[2];
#pragma unroll
    for (int kt = 0; kt < 2; ++kt)
#pragma unroll
      for (int reg = 0; reg < 16; ++reg) acc[kt][reg] = S[kt][reg] * ldsf[cc * 64 + kt * 32 + ROWOFF(reg, hf)] + nQ[kt][reg];
#pragma unroll
    for (int kt = 0; kt < 2; ++kt)
#pragma unroll
      for (int reg = 0; reg < 16; ++reg) Qf[((vt * 2 + kt) * 16 + reg) * 64 + lane] = S[kt][reg];
    uint4 Bh[4], Bl[4];
#pragma unroll
    for (int s_ = 0; s_ < 4; ++s_) {
      const int kt = s_ >> 1, s2 = s_ & 1;
      unsigned hw[4], lw[4];
#pragma unroll
      for (int j = 0; j < 4; ++j) {
        const float x0 = S[kt][s2 * 8 + 2 * j], x1 = S[kt][s2 * 8 + 2 * j + 1];
        const u16 h0 = f2bf(x0), h1 = f2bf(x1);
        hw[j] = (unsigned)h0 | ((unsigned)h1 << 16);
        lw[j] = pack2(x0 - bf2f(h0), x1 - bf2f(h1));
      }
      Bh[s_] = make_uint4(hw[0], hw[1], hw[2], hw[3]);
      Bl[s_] = make_uint4(lw[0], lw[1], lw[2], lw[3]);
    }
    __builtin_amdgcn_sched_barrier(0);
    if (cc + 1 < 128) issueQ(cc + 1);
    __builtin_amdgcn_sched_barrier(0);
#pragma unroll
    for (int s_ = 0; s_ < 4; ++s_) {
      union { uint4 u; bf16x8 v; } bh_, bl_;
      bh_.u = Bh[s_]; bl_.u = Bl[s_];
#pragma unroll
      for (int kt2 = 0; kt2 < 2; ++kt2) {
        union { uint4 u; bf16x8 v; } af; af.u = A[kt2][s_];
        acc[kt2] = __builtin_amdgcn_mfma_f32_32x32x16_bf16(af.v, bh_.v, acc[kt2], 0, 0, 0);
        acc[kt2] = __builtin_amdgcn_mfma_f32_32x32x16_bf16(af.v, bl_.v, acc[kt2], 0, 0, 0);
      }
    }
    __builtin_amdgcn_sched_barrier(0);
    S[0] = acc[0]; S[1] = acc[1];
  }
  {
    float* o = p.out + O_PWKV + ((size_t)((l * 2 + b) * 8 + h) * 64 + vt * 32 + (lane & 31)) * 64;
#pragma unroll
    for (int kt = 0; kt < 2; ++kt)
#pragma unroll
      for (int reg = 0; reg < 16; ++reg) o[kt * 32 + ROWOFF(reg, hf)] = S[kt][reg];
  }
}

__device__ void rwkv_out(const Params& p, int l, int item, float* ldsf) {
  const int tid = opq(threadIdx.x), lane = tid & 63, wave = tid >> 6;
  const int h = item & 7, cidx = item >> 3;
  float* Sl = ldsf; float* Wl = ldsf + 4160;
  const float* Sg = (const float*)(p.ws + WS_Q) + (size_t)item * 4096;
  const u16* W2 = (const u16*)(p.ws + WS_W2) + (size_t)item * 4096;
  const u16* YL = (const u16*)(p.ws + WS_YL) + (size_t)item * 4096;
  const u16* BO = (const u16*)(p.ws + WS_BO) + (size_t)item * 4096;
  const u16* GA = (const u16*)(p.ws + WS_GA) + (size_t)item * 4096;
  u16* z = (u16*)(p.ws + WS_Z);
  __syncthreads();
  {
    const int row = tid >> 3, c = (tid & 7) * 8;
#pragma unroll
    for (int i = 0; i < 8; ++i) {
      const int idx = i * 512 + tid;
      const int ln = idx & 63, reg = (idx >> 6) & 15, kt = (idx >> 10) & 1, vt = idx >> 11;
      Sl[(vt * 32 + (ln & 31)) * 65 + kt * 32 + ROWOFF(reg, ln >> 5)] = Sg[idx];
    }
    float w[8];
    unpack8(*(const uint4*)(W2 + row * 64 + c), w);
    float* e = Wl + row * 65 + c;
#pragma unroll
    for (int i = 0; i < 8; ++i) e[i] = w[i];
  }
  __syncthreads();
  float y[8];
#pragma unroll
  for (int q = 0; q < 8; ++q) y[q] = bf2f(YL[(wave * 8 + q) * 64 + lane]);
#pragma unroll 2
  for (int k = 0; k < 64; ++k) {
    const float s = Sl[lane * 65 + k];
#pragma unroll
    for (int q = 0; q < 8; ++q) y[q] += s * Wl[(wave * 8 + q) * 65 + k];
  }
  const float lng = p.in[18][l * 512 + h * 64 + lane], lnb = p.in[19][l * 512 + h * 64 + lane];
#pragma unroll
  for (int q = 0; q < 8; ++q) {
    const int t = wave * 8 + q;
    const float mean = wave_sum(y[q]) * (1.f / 64.f);
    const float d = y[q] - mean;
    const float var = wave_sum(d * d) * (1.f / 64.f);
    const float yn = d * rsqrtf(var + 64e-5f) * lng + lnb;
    const float o = (yn + bf2f(BO[t * 64 + lane])) * bf2f(GA[t * 64 + lane]);
    z[(size_t)(cidx * 64 + t) * ZLD + h * 64 + lane] = f2bf(o);
  }
}

__device__ void attn_prompt(const Params& p, int l, int item, u16* lds) {
  const int tid = opq(threadIdx.x), lane = tid & 63, wave = tid >> 6;
  const int r = lane & 31, h = lane >> 5;
  const int kvh = item & 1, n = (item >> 1) & 63, b = item >> 7;
  u16* z = (u16*)(p.ws + WS_Z);
  u16* Ks = lds;
  u16* Vt = lds + 256 * 72;
  __syncthreads();
  {
    const int key = tid >> 1, half = tid & 1;
    const int t = (n - 1) * 128 + key;
    uint4 kv[4], vv[4];
    if (t >= 0) {
      const u16* kp = z + (size_t)(b * 8192 + t) * ZLD + 2304 + kvh * 64 + half * 32;
      const u16* vp = z + (size_t)(b * 8192 + t) * ZLD + 2432 + kvh * 64 + half * 32;
#pragma unroll
      for (int i = 0; i < 4; ++i) { kv[i] = *(const uint4*)(kp + i * 8); vv[i] = *(const uint4*)(vp + i * 8); }
    } else {
#pragma unroll
      for (int i = 0; i < 4; ++i) { kv[i] = make_uint4(0, 0, 0, 0); vv[i] = make_uint4(0, 0, 0, 0); }
    }
#pragma unroll
    for (int i = 0; i < 4; ++i) {
      *(uint4*)(Ks + key * 72 + half * 32 + i * 8) = kv[i];
      const unsigned w[4] = {vv[i].x, vv[i].y, vv[i].z, vv[i].w};
#pragma unroll
      for (int q = 0; q < 4; ++q) {
        const int d = half * 32 + i * 8 + q * 2;
        Vt[d * 264 + key] = (u16)(w[q] & 0xFFFFu);
        Vt[(d + 1) * 264 + key] = (u16)(w[q] >> 16);
      }
    }
  }
  __syncthreads();
#pragma unroll 1
  for (int uu = 0; uu < 2; ++uu) {
    const int u = wave * 2 + uu;
    const int hq = kvh * 4 + (u >> 2), qg = u & 3;
    const int qrow = b * 8192 + n * 128 + qg * 32 + r;
    u16* qp = z + (size_t)qrow * ZLD + 1792 + hq * 64;
    bf16x8 qf[4];
#pragma unroll
    for (int s = 0; s < 4; ++s) qf[s] = *(const bf16x8*)(qp + s * 16 + h * 8);
    f32x16 sc[5];
#pragma unroll
    for (int i5 = 0; i5 < 5; ++i5) {
#pragma unroll
      for (int i = 0; i < 16; ++i) sc[i5][i] = 0.f;
      const int kt = qg + i5;
#pragma unroll
      for (int s = 0; s < 4; ++s) {
        bf16x8 kf = *(const bf16x8*)(Ks + (kt * 32 + r) * 72 + s * 16 + h * 8);
        sc[i5] = __builtin_amdgcn_mfma_f32_32x32x16_bf16(kf, qf[s], sc[i5], 0, 0, 0);
      }
      __builtin_amdgcn_sched_barrier(0);
    }
    const int qi = qg * 32 + r;
    const float sink = p.in[20][l * 8 + hq];
    float mx = -1e30f;
#pragma unroll
    for (int i5 = 0; i5 < 5; ++i5)
#pragma unroll
      for (int reg = 0; reg < 16; ++reg) {
        const int j = (qg + i5) * 32 + ROWOFF(reg, h);
        const bool ok = (j > qi) && (j <= qi + 128) && (n > 0 || j >= 128);
        const float s = ok ? sc[i5][reg] * 0.125f : -1e30f;
        sc[i5][reg] = s;
        mx = fmaxf(mx, s);
      }
    mx = fmaxf(mx, __shfl_xor(mx, 32, 64));
    mx = fmaxf(mx, sink);
    float sum = 0.f;
#pragma unroll
    for (int i5 = 0; i5 < 5; ++i5)
#pragma unroll
      for (int reg = 0; reg < 16; ++reg) { const float e = __expf(sc[i5][reg] - mx); sc[i5][reg] = e; sum += e; }
    sum += __shfl_xor(sum, 32, 64);
    const float rden = 1.f / (sum + __expf(sink - mx));
    f32x16 oacc[2];
#pragma unroll
    for (int i = 0; i < 16; ++i) { oacc[0][i] = 0.f; oacc[1][i] = 0.f; }
#pragma unroll
    for (int i5 = 0; i5 < 5; ++i5) {
      const int kt = qg + i5;
#pragma unroll
      for (int s2 = 0; s2 < 2; ++s2) {
        bf16x8 pf;
#pragma unroll
        for (int j = 0; j < 8; ++j) pf[j] = (short)f2bf(sc[i5][s2 * 8 + j] * rden);
#pragma unroll
        for (int dt = 0; dt < 2; ++dt) {
          const u16* vp = Vt + (dt * 32 + r) * 264 + kt * 32 + s2 * 16 + h * 4;
          const uint2 lo = *(const uint2*)vp, hi = *(const uint2*)(vp + 8);
          union { uint4 u; bf16x8 v; } cv;
          cv.u = make_uint4(lo.x, lo.y, hi.x, hi.y);
          oacc[dt] = __builtin_amdgcn_mfma_f32_32x32x16_bf16(cv.v, pf, oacc[dt], 0, 0, 0);
        }
        __builtin_amdgcn_sched_barrier(0);
      }
    }
#pragma unroll
    for (int dt = 0; dt < 2; ++dt)
#pragma unroll
      for (int g4 = 0; g4 < 4; ++g4) {
        const int d = dt * 32 + 8 * g4 + 4 * h;
        uint2 o;
        o.x = pack2(oacc[dt][g4 * 4 + 0], oacc[dt][g4 * 4 + 1]);
        o.y = pack2(oacc[dt][g4 * 4 + 2], oacc[dt][g4 * 4 + 3]);
        *(uint2*)(qp + d) = o;
      }
  }
}

__device__ void attn_sample(const Params& p, int l, int item, float* ldsf) {
  const int tid = opq(threadIdx.x);
  const int kvh = item & 1, b = item >> 1;
  u16* z = (u16*)(p.ws + WS_Z);
  float* Kl = ldsf;
  float* Vl = ldsf + 132 * 65;
  float* Ql = Vl + 132 * 65;
  float* Pl = Ql + 16 * 64;
  __syncthreads();
  for (int e = tid; e < 132 * 8; e += NT) {
    const int j = e >> 3, c = (e & 7) * 8;
    float k[8], v[8];
    if (j < 128) {
      const float* kp = p.in[4] + ((size_t)((l * 128 + b) * 128 + j) * 2 + kvh) * 64 + c;
      const float* vp = p.in[5] + ((size_t)((l * 128 + b) * 128 + j) * 2 + kvh) * 64 + c;
      float4 a = *(const float4*)kp, a2 = *(const float4*)(kp + 4);
      float4 c1 = *(const float4*)vp, c2 = *(const float4*)(vp + 4);
      k[0] = a.x; k[1] = a.y; k[2] = a.z; k[3] = a.w; k[4] = a2.x; k[5] = a2.y; k[6] = a2.z; k[7] = a2.w;
      v[0] = c1.x; v[1] = c1.y; v[2] = c1.z; v[3] = c1.w; v[4] = c2.x; v[5] = c2.y; v[6] = c2.z; v[7] = c2.w;
    } else {
      const size_t row = M_P + b * 4 + (j - 128);
      unpack8(*(const uint4*)(z + row * ZLD + 2304 + kvh * 64 + c), k);
      unpack8(*(const uint4*)(z + row * ZLD + 2432 + kvh * 64 + c), v);
    }
#pragma unroll
    for (int i = 0; i < 8; ++i) { Kl[j * 65 + c + i] = k[i]; Vl[j * 65 + c + i] = v[i]; }
    if (j >= 4) {
      float* ok = p.out + O_SK + ((size_t)((l * 128 + b) * 128 + (j - 4)) * 2 + kvh) * 64 + c;
      float* ov = p.out + O_SV + ((size_t)((l * 128 + b) * 128 + (j - 4)) * 2 + kvh) * 64 + c;
      *(float4*)ok = make_float4(k[0], k[1], k[2], k[3]); *(float4*)(ok + 4) = make_float4(k[4], k[5], k[6], k[7]);
      *(float4*)ov = make_float4(v[0], v[1], v[2], v[3]); *(float4*)(ov + 4) = make_float4(v[4], v[5], v[6], v[7]);
    }
  }
  if (tid < 128) {
    const int row = tid >> 3, c = (tid & 7) * 8;
    const int hl = row >> 2, t = row & 3;
    float q[8];
    unpack8(*(const uint4*)(z + (size_t)(M_P + b * 4 + t) * ZLD + 1792 + (kvh * 4 + hl) * 64 + c), q);
#pragma unroll
    for (int i = 0; i < 8; ++i) Ql[row * 64 + c + i] = q[i];
  }
  __syncthreads();
  const int row = tid >> 5, jl = tid & 31;
  const int t = row & 3, hq = kvh * 4 + (row >> 2);
  float sc[5];
  float mx = -1e30f;
#pragma unroll
  for (int jj = 0; jj < 5; ++jj) {
    const int j = jl + 32 * jj;
    float s = -1e30f;
    if (j < 132 && j > t && j <= t + 128) {
      float a = 0.f;
#pragma unroll 8
      for (int d = 0; d < 64; ++d) a += Ql[row * 64 + d] * Kl[j * 65 + d];
      s = a * 0.125f;
    }
    sc[jj] = s; mx = fmaxf(mx, s);
    __builtin_amdgcn_sched_barrier(0);
  }
#pragma unroll
  for (int o = 16; o >= 1; o >>= 1) mx = fmaxf(mx, __shfl_xor(mx, o, 64));
  const float sink = p.in[20][l * 8 + hq];
  mx = fmaxf(mx, sink);
  float sum = 0.f;
#pragma unroll
  for (int jj = 0; jj < 5; ++jj) { sc[jj] = __expf(sc[jj] - mx); sum += sc[jj]; }
#pragma unroll
  for (int o = 16; o >= 1; o >>= 1) sum += __shfl_xor(sum, o, 64);
  const float rden = 1.f / (sum + __expf(sink - mx));
#pragma unroll
  for (int jj = 0; jj < 5; ++jj) { const int j = jl + 32 * jj; if (j < 136) Pl[row * 136 + j] = sc[jj] * rden; }
  __syncthreads();
  {
    const int d = jl * 2;
    float o0 = 0.f, o1 = 0.f;
#pragma unroll 4
    for (int j = 0; j < 132; ++j) { const float pr = Pl[row * 136 + j]; o0 += pr * Vl[j * 65 + d]; o1 += pr * Vl[j * 65 + d + 1]; }
    *(unsigned*)(z + (size_t)(M_P + b * 4 + t) * ZLD + 1792 + hq * 64 + d) = pack2(o0, o1);
  }
}

__device__ void phase_convgelu(const Params& p, int l) {
  u16* cu = (u16*)(p.ws + WS_CU);
  const float* cw = p.in[26] + (size_t)l * 3 * 2816;
  const float* cb = p.in[27] + (size_t)l * 2816;
  for (int it = blockIdx.x; it < 1056; it += gridDim.x) {
    const int tid = opq(threadIdx.x);
    if (tid >= 352) continue;
    const int j0 = tid * 8;
    float w0[8], w1[8], w2[8], bb[8];
#pragma unroll
    for (int i = 0; i < 8; ++i) { w0[i] = cw[j0 + i]; w1[i] = cw[2816 + j0 + i]; w2[i] = cw[5632 + j0 + i]; bb[i] = cb[j0 + i]; }
    float c1[8], c2[8];
    for (int rr = 0; rr < 16; ++rr) {
      const int row = it * 16 + rr;
      const bool prompt = row < M_P;
      int b, t;
      if (prompt) { b = row >> 13; t = row & 8191; } else { b = (row - M_P) >> 2; t = (row - M_P) & 3; }
      if (t == 0) {
        if (prompt) {
#pragma unroll
          for (int i = 0; i < 8; ++i) { c1[i] = 0.f; c2[i] = 0.f; }
        } else {
          const float* st = p.in[6] + (size_t)((l * 128 + b) * 2) * 2816 + j0;
#pragma unroll
          for (int i = 0; i < 8; ++i) { c2[i] = st[i]; c1[i] = st[2816 + i]; }
        }
      } else if (rr == 0) {
        unpack8(*(const uint4*)(cu + (size_t)(row - 1) * 5632 + j0), c1);
        if (t >= 2) unpack8(*(const uint4*)(cu + (size_t)(row - 2) * 5632 + j0), c2);
        else {
#pragma unroll
          for (int i = 0; i < 8; ++i) c2[i] = 0.f;
        }
      }
      float c0[8], up[8], a[8];
      unpack8(*(const uint4*)(cu + (size_t)row * 5632 + j0), c0);
      unpack8(*(const uint4*)(cu + (size_t)row * 5632 + 2816 + j0), up);
#pragma unroll
      for (int i = 0; i < 8; ++i) {
        const float cv = bb[i] + w0[i] * c2[i] + w1[i] * c1[i] + w2[i] * c0[i];
        const float ge = 0.5f * cv * (1.f + erff(cv * 0.7071067811865476f));
        a[i] = ge * up[i];
      }
      *(uint4*)(cu + (size_t)row * 5632 + 2816 + j0) = pack8(a);
      if (prompt && t >= 8190) {
        float* o = p.out + O_PCONV + (size_t)((l * 2 + b) * 2 + (t - 8190)) * 2816 + j0;
        *(float4*)o = make_float4(c0[0], c0[1], c0[2], c0[3]); *(float4*)(o + 4) = make_float4(c0[4], c0[5], c0[6], c0[7]);
      } else if (!prompt && t >= 2) {
        float* o = p.out + O_SCONV + (size_t)((l * 128 + b) * 2 + (t - 2)) * 2816 + j0;
        *(float4*)o = make_float4(c0[0], c0[1], c0[2], c0[3]); *(float4*)(o + 4) = make_float4(c0[4], c0[5], c0[6], c0[7]);
      }
#pragma unroll
      for (int i = 0; i < 8; ++i) { c2[i] = c1[i]; c1[i] = c0[i]; }
    }
  }
}

__device__ void phase_final(const Params& p) {
  float* X = p.out;
  const float* g = p.in[29];
  for (int it = blockIdx.x; it < 2112; it += gridDim.x) {
    const int tid = opq(threadIdx.x);
    const int lane = tid & 63;
    const int row = it * 8 + (tid >> 6);
    float4 v[4];
    float ss = 0.f;
#pragma unroll
    for (int i = 0; i < 4; ++i) {
      v[i] = *(const float4*)(X + (size_t)row * 1024 + i * 256 + lane * 4);
      ss += v[i].x * v[i].x + v[i].y * v[i].y + v[i].z * v[i].z + v[i].w * v[i].w;
    }
    ss = wave_sum(ss);
    const float rs = rsqrtf(ss * (1.f / 1024.f) + 1e-6f);
#pragma unroll
    for (int i = 0; i < 4; ++i) {
      const float4 gg = *(const float4*)(g + i * 256 + lane * 4);
      *(float4*)(X + (size_t)row * 1024 + i * 256 + lane * 4) =
          make_float4(v[i].x * rs * gg.x, v[i].y * rs * gg.y, v[i].z * rs * gg.z, v[i].w * rs * gg.w);
    }
  }
}

#if COOP
#define PH_SYNC(idx) do { if ((idx) + 1 < ph_hi && (idx) >= ph_lo) cg::this_grid().sync(); } while (0)
#else
#define PH_SYNC(idx) do { } while (0)
#endif
#define PH_ON(idx, bit) (((KMASK >> (bit)) & 1) && ph_lo <= (idx) && (idx) < ph_hi)

__device__ __forceinline__ Params load_params() {
  auto kp0 = __builtin_amdgcn_kernarg_segment_ptr();
  asm volatile("" : "+s"(kp0));
  auto kq = (const __constant__ unsigned long long*)kp0;
  Params p;
#pragma unroll
  for (int i = 0; i < 30; ++i) p.in[i] = (const float*)kq[i];
  p.out = (float*)kq[30];
  p.ws = (unsigned char*)kq[31];
  p.ph_lo = 0; p.ph_hi = 0;
  return p;
}

template <int KMASK>
__device__ __forceinline__ void layer_phases(int l, int ph_lo, int ph_hi, unsigned char* lds_raw) {
  float* ldsf = (float*)lds_raw;
  u16* ldsh = (u16*)lds_raw;
  const int base = l * 12;
  if (PH_ON(base + 0, 0)) { const Params p = load_params(); phase_prep(p, l, 0, ldsf); }
  PH_SYNC(base + 0);
  if (PH_ON(base + 1, 1)) {
    const Params p = load_params();
    EpiInproj E; E.z = (u16*)(p.ws + WS_Z); E.out = p.out; E.l = l;
    run_gemm(lds_raw, (const u16*)(p.ws + WS_H), 1024, (const u16*)(p.ws + WS_WT) + WT_IN, 2560, 1024, E);
  }
  PH_SYNC(base + 1);
  if (PH_ON(base + 2, 2)) {
    const Params p = load_params();
    for (int it = blockIdx.x; it < 2048 + 64 + 264; it += gridDim.x) {
      if (it < 64) rwkv_item(p, l, 2048 + it, ldsf);
      else if (it < 64 + 264) rope_item(p, l, it - 64);
      else rwkv_item(p, l, it - 64 - 264, ldsf);
    }
  }
  PH_SYNC(base + 2);
  if (PH_ON(base + 3, 3)) {
    const Params p = load_params();
    if (blockIdx.x < 16) rwkv_scan(p, l, blockIdx.x, ldsf);
    else {
      for (int it = blockIdx.x - 16; it < 512; it += gridDim.x - 16) {
        if (it < 256) attn_prompt(p, l, it, ldsh); else attn_sample(p, l, it - 256, ldsf);
      }
    }
  }
  PH_SYNC(base + 3);
  if (PH_ON(base + 4, 4)) {
    const Params p = load_params();
    for (int it = blockIdx.x; it < 2048; it += gridDim.x) rwkv_out(p, l, it, ldsf);
  }
  PH_SYNC(base + 4);
  if (PH_ON(base + 5, 5)) {
    const Params p = load_params();
    EpiStoreBf16 E1; E1.O = (u16*)(p.ws + WS_T1); E1.ldc = 1024;
    run_gemm(lds_raw, (const u16*)(p.ws + WS_Z), ZLD, (const u16*)(p.ws + WS_WT) + WT_BRA, 1024, 512, E1);
    EpiStoreBf16 E2; E2.O = (u16*)(p.ws + WS_T2); E2.ldc = 1024;
    run_gemm(lds_raw, (const u16*)(p.ws + WS_Z) + 1792, ZLD, (const u16*)(p.ws + WS_WT) + WT_BRB, 1024, 512, E2);
  }
  PH_SYNC(base + 5);
  if (PH_ON(base + 6, 6)) {
    const Params p = load_params();
    EpiMerge E; E.t1 = (const u16*)(p.ws + WS_T1); E.t2 = (const u16*)(p.ws + WS_T2); E.mg = (u16*)(p.ws + WS_MG);
    run_gemm(lds_raw, (const u16*)(p.ws + WS_H), 1024, (const u16*)(p.ws + WS_WT) + WT_G, 2048, 1024, E);
  }
  PH_SYNC(base + 6);
  if (PH_ON(base + 7, 7)) {
    const Params p = load_params();
    EpiResid E; E.X = p.out;
    run_gemm(lds_raw, (const u16*)(p.ws + WS_MG), 1024, (const u16*)(p.ws + WS_WT) + WT_OUT, 1024, 1024, E);
  }
  PH_SYNC(base + 7);
  if (PH_ON(base + 8, 8)) { const Params p = load_params(); phase_prep(p, l, 1, ldsf); }
  PH_SYNC(base + 8);
  if (PH_ON(base + 9, 9)) {
    const Params p = load_params();
    EpiFfnIn E; E.cu = (u16*)(p.ws + WS_CU);
    run_gemm(lds_raw, (const u16*)(p.ws + WS_H), 1024, (const u16*)(p.ws + WS_WTF) + WT_FIN, 5632, 1024, E);
  }
  PH_SYNC(base + 9);
  if (PH_ON(base + 10, 10)) { const Params p = load_params(); phase_convgelu(p, l); }
  PH_SYNC(base + 10);
  if (PH_ON(base + 11, 11)) {
    const Params p = load_params();
    EpiResid E; E.X = p.out;
    run_gemm(lds_raw, (const u16*)(p.ws + WS_CU) + 2816, 5632, (const u16*)(p.ws + WS_WTF) + WT_FDN, 1024, 2816, E);
  }
  PH_SYNC(base + 11);
}

template <int KMASK>
__global__ void __launch_bounds__(NT) fwd_kernel(Params pin) {
  extern __shared__ __attribute__((aligned(16))) unsigned char lds_raw[];
  const int ph_lo = pin.ph_lo, ph_hi = pin.ph_hi;
  layer_phases<KMASK>(0, ph_lo, ph_hi, lds_raw);
  layer_phases<KMASK>(1, ph_lo, ph_hi, lds_raw);
  if (PH_ON(NPH - 1, 12)) { const Params p = load_params(); phase_final(p); }
}

extern "C" void kernel_launch(void* const* d_in, const int* in_sizes, int n_in, void* d_out, int out_size, void* d_ws,
                              size_t ws_size, hipStream_t stream) {
  static int grid = 0;
  if (grid == 0) {
    int dev = 0, cus = 0;
    (void)hipGetDevice(&dev);
    (void)hipDeviceGetAttribute(&cus, hipDeviceAttributeMultiprocessorCount, dev);
    grid = cus > 0 ? cus : 256;
    (void)hipFuncSetAttribute((const void*)fwd_kernel<PHMASK>, hipFuncAttributeMaxDynamicSharedMemorySize, LDS_BYTES);
    (void)hipGetLastError();
  }
  Params p{};
  for (int i = 0; i < 30; ++i) p.in[i] = (const float*)d_in[i];
  p.out = (float*)d_out;
  p.ws = (unsigned char*)d_ws;
#if COOP
  p.ph_lo = 0; p.ph_hi = NPH;
  void* args[] = {&p};
  hipError_t e = hipLaunchCooperativeKernel((const void*)fwd_kernel<PHMASK>, dim3(grid), dim3(NT), args, LDS_BYTES, stream);
  if (e != hipSuccess) fprintf(stderr, "cooperative launch failed: %s (grid %d)\n", hipGetErrorString(e), grid);
#else
  for (int ph = 0; ph < NPH; ++ph) {
    p.ph_lo = ph; p.ph_hi = ph + 1;
    hipLaunchKernelGGL(fwd_kernel<PHMASK>, dim3(grid), dim3(NT), LDS_BYTES, stream, p);
  }
#endif
}
```

```cpp
#include <hip/hip_runtime.h>
#include <hip/hip_bf16.h>
#include <hip/hip_cooperative_groups.h>
#include <cstdio>
namespace cg = cooperative_groups;

typedef __attribute__((ext_vector_type(8))) short bf16x8;
typedef __attribute__((ext_vector_type(16))) float f32x16;
typedef unsigned short u16;

#ifndef PHMASK
#define PHMASK 0x1FFF
#endif
#ifndef T3
#define T3 7
#endif
#ifndef P2SEL
#define P2SEL 7
#endif
#ifndef COOP
#define COOP 1
#endif

#define NT 512
#define M_TOT 16896
#define M_P 16384
#define ZLD 2560
#define NPH 25

#define WS_WT   0ull
#define WS_H    13631488ull
#define WS_Z    48234496ull
#define WS_R    134742016ull
#define WS_PP   (WS_R)
#define WS_GC   (WS_R + 16777216ull)
#define WS_Q    (WS_R + 17301504ull)
#define WS_W2   (WS_R + 50855936ull)
#define WS_YL   (WS_R + 67633152ull)
#define WS_BO   (WS_R + 84410368ull)
#define WS_GA   (WS_R + 101187584ull)
#define WS_T1   (WS_R)
#define WS_T2   (WS_R + 34603008ull)
#define WS_MG   (WS_R + 69206016ull)
#define WS_WTF  (WS_Z)
#define WS_CU   (WS_Z + 17301504ull)
#define WT_IN  0
#define WT_G   2621440
#define WT_BRA 4718592
#define WT_BRB 5242880
#define WT_OUT 5767168
#define WT_FIN 0
#define WT_FDN 5767168
#define O_PSHIFT 17301504
#define O_PWKV   17308672
#define O_PK     17439744
#define O_PV     17505280
#define O_PCONV  17570816
#define O_SSHIFT 17593344
#define O_SWKV   18052096
#define O_SK     26440704
#define O_SV     30635008
#define O_SCONV  34829312

#define LDS_BYTES 151552

struct Params {
  const float* in[30];
  float* out;
  unsigned char* ws;
  int ph_lo, ph_hi;
};

__device__ __forceinline__ u16 f2bf(float f) {
  unsigned u = __float_as_uint(f);
  u += 0x7FFFu + ((u >> 16) & 1u);
  return (u16)(u >> 16);
}
__device__ __forceinline__ float bf2f(u16 h) { return __uint_as_float(((unsigned)h) << 16); }
__device__ __forceinline__ unsigned pack2(float a, float b) { return (unsigned)f2bf(a) | ((unsigned)f2bf(b) << 16); }
__device__ __forceinline__ float sigm(float x) { return __builtin_amdgcn_rcpf(1.f + __expf(-x)); }
__device__ __forceinline__ void unpack8(uint4 u, float* o) {
  o[0] = __uint_as_float(u.x << 16); o[1] = __uint_as_float(u.x & 0xFFFF0000u);
  o[2] = __uint_as_float(u.y << 16); o[3] = __uint_as_float(u.y & 0xFFFF0000u);
  o[4] = __uint_as_float(u.z << 16); o[5] = __uint_as_float(u.z & 0xFFFF0000u);
  o[6] = __uint_as_float(u.w << 16); o[7] = __uint_as_float(u.w & 0xFFFF0000u);
}
__device__ __forceinline__ uint4 pack8(const float* f) {
  uint4 u; u.x = pack2(f[0], f[1]); u.y = pack2(f[2], f[3]); u.z = pack2(f[4], f[5]); u.w = pack2(f[6], f[7]); return u;
}
__device__ __forceinline__ int opq(int x) { asm volatile("" : "+v"(x)); return x; }
__device__ __forceinline__ float wave_sum(float x) {
#pragma unroll
  for (int o = 32; o >= 1; o >>= 1) x += __shfl_xor(x, o, 64);
  return x;
}

namespace pg8 {
#define PG8_LAS __attribute__((address_space(3)))
typedef unsigned short bf16_t;
typedef short bf16x8 __attribute__((ext_vector_type(8)));
typedef float f32x4 __attribute__((ext_vector_type(4)));
typedef unsigned u32x4 __attribute__((ext_vector_type(4)));
constexpr int BM = 256, BK = 64, HALF = 128, HTB = HALF * BK * 2  , STAGE_BYTES = 8 * HTB, NXCD = 8, WGM = 8;
__host__ __device__ __forceinline__ int lds_byte(int r, int c) { const int st = (r >> 4) * 2 + (c >> 5), rr = r & 15, cc = c & 31, ob = rr * 64 + cc * 2; return st * 1024 + (ob ^ (((ob >> 9) & 1) << 5)); }
__host__ __device__ __forceinline__ void stage_rc(int b, int& R, int& C) { const int st = b / 1024, sb = b % 1024, swz = sb ^ (((sb >> 9) & 1) << 5); R = (st >> 1) * 16 + swz / 64; C = (st & 1) * 32 + (swz % 64) / 2; }
__host__ __device__ __forceinline__ int perm32(int rho) { const int n = rho >> 4, i = rho & 15; return 8 * (i >> 2) + 4 * n + (i & 3); }
struct Unit { int pm, pn; };
struct Gemm { const bf16_t* A; const bf16_t* Bt; int M, N, K, lda; };
struct StaticOrder {
    int nM, nN, nwg, G, c;
    __host__ __device__ void init(int M, int N, int G_, int c_) { nM = M / BM; nN = N / BM; nwg = nM * nN; G = G_; c = c_; }
    __host__ __device__ bool next(int i, Unit& u) const {
        const long L = (long)i * G + c; if (L >= nwg) return false;
        int wgid = (int)L; { const int q = nwg / NXCD, r = nwg % NXCD, xcd = wgid % NXCD, off = wgid / NXCD; wgid = (xcd < r ? xcd * (q + 1) : r * (q + 1) + (xcd - r) * q) + off; }
        const int nig = WGM * nN, gid = wgid / nig, fm = gid * WGM, gsz = (nM - fm) < WGM ? (nM - fm) : WGM;
        u.pm = fm + ((wgid % nig) % gsz); u.pn = (wgid % nig) / gsz; return true;
    }
    __device__ __forceinline__ void a_ready(const Unit&) const {}
    __device__ __forceinline__ void done(const Unit&) const {}
};
__device__ __forceinline__ unsigned cvt_pk_bf16(float lo, float hi) { unsigned r; asm volatile("v_cvt_pk_bf16_f32 %0, %1, %2" : "=v"(r) : "v"(lo), "v"(hi)); return r; }
template <class Epi, class Sched, bool STAMP = false>
__device__ __forceinline__ void gemm_phase(PG8_LAS unsigned char* lds, const Gemm g, const Sched& S, const Epi& E, unsigned long long* stamps) {
    const int tid = ::opq(threadIdx.x), wid = __builtin_amdgcn_readfirstlane(tid >> 6), lane = tid & 63, wr = wid >> 2, wc = wid & 3, fr = lane & 15, fq = lane >> 4;
    const int K = g.K, nt = K / BK;
    int ts_lo = 0, ts_hi = 0, nts = 0; const unsigned long long rt_entry = 0ull;
#define PG8_STAMP() do { if (STAMP && wid == 0 && nts < 64) { const unsigned long long _c = (unsigned long long)clock64(); \
        ts_lo = (lane == nts) ? (int)(unsigned)_c : ts_lo; ts_hi = (lane == nts) ? (int)(unsigned)(_c >> 32) : ts_hi; ++nts; } } while (0)
    PG8_STAMP();
    unsigned voffA[2], voffB[2];
#pragma unroll
    for (int i = 0; i < 2; ++i) { int R, C; stage_rc(tid * 16 + i * 8192, R, C); const int Rb = Epi::PERM ? ((R & ~31) + perm32(R & 31)) : R;
        voffA[i] = (unsigned)(R * g.lda + C) * 2u; voffB[i] = (unsigned)(Rb * K + C) * 2u; }
    const size_t kstep = (size_t)(BK * 2);
    const size_t hstep = (size_t)HALF * K * 2;
    const size_t tstep = 2 * hstep; const size_t hstepA = (size_t)HALF * g.lda * 2; const size_t tstepA = 2 * hstepA;
    const unsigned ldsw = (unsigned)wid * 1024u;
    const int aoff = lds_byte(wr * 64 + fr, fq * 8), boff = lds_byte(wc * 32 + fr, fq * 8);
#define PG8_SA(b, h) (((b) * 2 + (h)) * HTB)
#define PG8_SB(b, h) ((4 + (b) * 2 + (h)) * HTB)
#define PG8_STAGE(bufoff, gbase, voff) do { _Pragma("unroll") for (int _i = 0; _i < 2; ++_i) \
        __builtin_amdgcn_global_load_lds((const unsigned*)((const char*)(gbase) + (voff)[_i]), (PG8_LAS unsigned*)(lds + (bufoff) + ldsw + _i * 8192), 16, 0, 0); } while (0)
#define PG8_LDA(dst, b, h) do { _Pragma("unroll") for (int m = 0; m < 4; ++m) _Pragma("unroll") for (int k = 0; k < 2; ++k) dst[m][k] = *(const PG8_LAS bf16x8*)(lds + PG8_SA(b, h) + aoff + m * 2048 + k * 1024); } while (0)
#define PG8_LDB(dst, b, h) do { _Pragma("unroll") for (int n = 0; n < 2; ++n) _Pragma("unroll") for (int k = 0; k < 2; ++k) dst[n][k] = *(const PG8_LAS bf16x8*)(lds + PG8_SB(b, h) + boff + n * 2048 + k * 1024); } while (0)
#define PG8_MMA(ai, bj, At, Bt) do { __builtin_amdgcn_s_setprio(1); _Pragma("unroll") for (int m = 0; m < 4; ++m) _Pragma("unroll") for (int n = 0; n < 2; ++n) _Pragma("unroll") for (int k = 0; k < 2; ++k) \
        acc[ai][bj][m][n] = __builtin_amdgcn_mfma_f32_16x16x32_bf16(Bt[n][k], At[m][k], acc[ai][bj][m][n], 0, 0, 0); __builtin_amdgcn_s_setprio(0); } while (0)
#define PG8_WAIT_V(n) asm volatile("s_waitcnt vmcnt(" #n ")" ::: "memory")
#define PG8_WAIT_L(n) asm volatile("s_waitcnt lgkmcnt(" #n ")" ::: "memory")
#define PG8_BAR __builtin_amdgcn_s_barrier()
#define PG8_SCHED __builtin_amdgcn_sched_barrier(0)
    Unit cur, nxt; int ui = 0;
    if (!S.next(0, cur)) return;
    f32x4 acc[2][2][4][2];
#pragma unroll
    for (int a = 0; a < 2; ++a)
#pragma unroll
        for (int b = 0; b < 2; ++b)
#pragma unroll
            for (int m = 0; m < 4; ++m)
#pragma unroll
                for (int n = 0; n < 2; ++n) acc[a][b][m][n] = (f32x4){0.f, 0.f, 0.f, 0.f};
    bf16x8 At[4][2], B0[2][2], B1[2][2];
    const char* cA = (const char*)g.A + (size_t)cur.pm * tstepA; const char* cB = (const char*)g.Bt + (size_t)cur.pn * tstep;
    S.a_ready(cur);
    PG8_STAGE(PG8_SB(0, 0), cB, voffB); PG8_STAGE(PG8_SA(0, 0), cA, voffA); PG8_STAGE(PG8_SB(0, 1), cB + hstep, voffB); PG8_STAGE(PG8_SA(0, 1), cA + hstepA, voffA);
    if (wr == 1) PG8_BAR;
    PG8_WAIT_V(4); PG8_BAR;
    PG8_STAGE(PG8_SB(1, 0), cB + kstep, voffB); PG8_STAGE(PG8_SA(1, 0), cA + kstep, voffA); PG8_STAGE(PG8_SB(1, 1), cB + hstep + kstep, voffB);
    PG8_WAIT_V(6); PG8_BAR;
    PG8_STAMP();
    for (;;) {
        const bool has_next = S.next(ui + 1, nxt);
        const char* nA = has_next ? (const char*)g.A + (size_t)nxt.pm * tstepA : cA; const char* nB = has_next ? (const char*)g.Bt + (size_t)nxt.pn * tstep : cB;
        for (int t = 0; t < nt; t += 2) {
            const bool last = (t == nt - 2);
            const char* a1 = cA + (size_t)(t + 1) * kstep;
            const char* a2 = last ? nA : cA + (size_t)(t + 2) * kstep; const char* b2 = last ? nB : cB + (size_t)(t + 2) * kstep;
            const char* a3 = a2 + kstep; const char* b3 = b2 + kstep;
            if (last && has_next) S.a_ready(nxt);
            PG8_LDB(B0, 0, 0); PG8_SCHED; PG8_LDA(At, 0, 0); PG8_STAGE(PG8_SA(1, 1), a1 + hstepA, voffA);
            PG8_WAIT_L(8); PG8_BAR; PG8_WAIT_L(0); PG8_MMA(0, 0, At, B0); PG8_BAR; PG8_SCHED;
            PG8_LDB(B1, 0, 1); PG8_STAGE(PG8_SB(0, 0), b2, voffB);
            PG8_BAR; PG8_WAIT_L(0); PG8_MMA(0, 1, At, B1); PG8_BAR;
            PG8_LDA(At, 0, 1); PG8_STAGE(PG8_SA(0, 0), a2, voffA);
            PG8_BAR; PG8_WAIT_L(0); PG8_MMA(1, 0, At, B0); PG8_BAR; PG8_SCHED;
            PG8_STAGE(PG8_SB(0, 1), b2 + hstep, voffB);
            PG8_WAIT_V(6); PG8_BAR; PG8_MMA(1, 1, At, B1); PG8_BAR;
            PG8_LDB(B0, 1, 0); PG8_SCHED; PG8_LDA(At, 1, 0); PG8_STAGE(PG8_SA(0, 1), a2 + hstepA, voffA);
            PG8_WAIT_L(8); PG8_BAR; PG8_WAIT_L(0); PG8_MMA(0, 0, At, B0); PG8_BAR; PG8_SCHED;
            PG8_LDB(B1, 1, 1); PG8_STAGE(PG8_SB(1, 0), b3, voffB);
            PG8_BAR; PG8_WAIT_L(0); PG8_MMA(0, 1, At, B1); PG8_BAR;
            PG8_LDA(At, 1, 1); PG8_STAGE(PG8_SA(1, 0), a3, voffA);
            PG8_BAR; PG8_WAIT_L(0); PG8_MMA(1, 0, At, B0); PG8_BAR; PG8_SCHED;
            PG8_STAGE(PG8_SB(1, 1), b3 + hstep, voffB);
            PG8_WAIT_V(6); PG8_BAR; PG8_MMA(1, 1, At, B1); PG8_BAR;
        }
        PG8_STAMP();
        if constexpr (!Epi::AFTER_DRAIN) { E(acc, cur, wr, wc, fr, fq); S.done(cur); }
        PG8_STAMP();
        if (!has_next) break;
#pragma unroll
        for (int a = 0; a < 2; ++a)
#pragma unroll
            for (int b = 0; b < 2; ++b)
#pragma unroll
                for (int m = 0; m < 4; ++m)
#pragma unroll
                    for (int n = 0; n < 2; ++n) acc[a][b][m][n] = (f32x4){0.f, 0.f, 0.f, 0.f};
        cur = nxt; cA = nA; cB = nB; ++ui;
    }
    PG8_WAIT_V(0);
    if (wr == 0) PG8_BAR;
    PG8_BAR;
    if constexpr (Epi::AFTER_DRAIN) { E.fused(acc, cur, wr, wc, fr, fq, lds, wid, lane); S.done(cur); }
    PG8_STAMP();
    if (STAMP && wid == 0) { stamps[lane] = lane < nts ? (((unsigned long long)(unsigned)ts_hi << 32) | (unsigned)ts_lo) : 0ull;
        if (lane == 62) stamps[62] = rt_entry; if (lane == 63) stamps[63] = (unsigned long long)wall_clock64(); }
#undef PG8_STAMP
#undef PG8_SA
#undef PG8_SB
#undef PG8_STAGE
#undef PG8_LDA
#undef PG8_LDB
#undef PG8_MMA
#undef PG8_WAIT_V
#undef PG8_WAIT_L
#undef PG8_BAR
#undef PG8_SCHED
}
}
using pg8::f32x4;
#define ROWOFF(reg, h) (((reg) & 3) + 8 * ((reg) >> 2) + 4 * (h))

__device__ __forceinline__ void conv_tile(const float* __restrict__ src, int K, int N, u16* __restrict__ dst, int k0, int n0, int sn0, float* lds) {
  const int tid = opq(threadIdx.x);
  __syncthreads();
  {
    const int k = tid >> 3, c = (tid & 7) * 8;
    const float* s = src + (size_t)(k0 + k) * N + sn0 + c;
    float4 a = *(const float4*)s, b = *(const float4*)(s + 4);
    float* d = lds + k * 65 + c;
    d[0] = a.x; d[1] = a.y; d[2] = a.z; d[3] = a.w;
    d[4] = b.x; d[5] = b.y; d[6] = b.z; d[7] = b.w;
  }
  __syncthreads();
  {
    const int n = tid >> 3, kk = (tid & 7) * 8;
    float f[8];
#pragma unroll
    for (int i = 0; i < 8; ++i) f[i] = lds[(kk + i) * 65 + n];
    *(uint4*)(dst + (size_t)(n0 + n) * K + k0 + kk) = pack8(f);
  }
}

__device__ __forceinline__ void phase_prep(const Params& p, int l, int which, float* ldsf) {
  u16* WtA = (u16*)(p.ws + WS_WT);
  u16* WtF = (u16*)(p.ws + WS_WTF);
  u16* H = (u16*)(p.ws + WS_H);
  float* X = p.out;
  const int nconv = which == 0 ? (640 + 512 + 128 + 128 + 256) : (1408 + 704);
  const int ntot = nconv + 2112;
  const float* gw = (which == 0 ? p.in[7] : p.in[24]) + l * 1024;
  for (int it = blockIdx.x; it < ntot; it += gridDim.x) {
    if (it < nconv) {
      int t = it;
      if (which == 0) {
        if (t < 640) { const int tk = t / 40, tn = t % 40; conv_tile(p.in[8] + (size_t)l * 1024 * 4608, 1024, 4608, WtA + WT_IN, tk * 64, tn * 64, tn * 64, ldsf); }
        else if ((t -= 640) < 512) {
          const int tk = t / 32, tn = t % 32; const int n0 = tn * 64;
          const int sn0 = 2560 + ((n0 >> 7) & 1) * 1024 + (n0 >> 8) * 128 + (n0 & 127);
          conv_tile(p.in[8] + (size_t)l * 1024 * 4608, 1024, 4608, WtA + WT_G, tk * 64, n0, sn0, ldsf);
        }
        else if ((t -= 512) < 128) { const int tk = t / 16, tn = t % 16; conv_tile(p.in[21] + (size_t)l * 512 * 1024, 512, 1024, WtA + WT_BRA, tk * 64, tn * 64, tn * 64, ldsf); }
        else if ((t -= 128) < 128) { const int tk = t / 16, tn = t % 16; conv_tile(p.in[22] + (size_t)l * 512 * 1024, 512, 1024, WtA + WT_BRB, tk * 64, tn * 64, tn * 64, ldsf); }
        else { t -= 128; const int tk = t / 16, tn = t % 16; conv_tile(p.in[23] + (size_t)l * 1024 * 1024, 1024, 1024, WtA + WT_OUT, tk * 64, tn * 64, tn * 64, ldsf); }
      } else {
        if (t < 1408) {
          const int tk = t / 88, tn = t % 88; const int n0 = tn * 64;
          const int sn0 = ((n0 >> 7) & 1) * 2816 + (n0 >> 8) * 128 + (n0 & 127);
          conv_tile(p.in[25] + (size_t)l * 1024 * 5632, 1024, 5632, WtF + WT_FIN, tk * 64, n0, sn0, ldsf);
        } else { t -= 1408; const int tk = t / 16, tn = t % 16; conv_tile(p.in[28] + (size_t)l * 2816 * 1024, 2816, 1024, WtF + WT_FDN, tk * 64, tn * 64, tn * 64, ldsf); }
      }
    } else {
      const int tid = opq(threadIdx.x);
      const int row = (it - nconv) * 8 + (tid >> 6);
      const int lane = tid & 63;
      const bool first = (which == 0 && l == 0);
      const float* src;
      if (first) src = (row < M_P) ? p.in[0] + (size_t)row * 1024 : p.in[1] + (size_t)(row - M_P) * 1024;
      else src = X + (size_t)row * 1024;
      float4 v[4];
      float ss = 0.f;
#pragma unroll
      for (int i = 0; i < 4; ++i) {
        v[i] = *(const float4*)(src + i * 256 + lane * 4);
        ss += v[i].x * v[i].x + v[i].y * v[i].y + v[i].z * v[i].z + v[i].w * v[i].w;
        if (first) *(float4*)(X + (size_t)row * 1024 + i * 256 + lane * 4) = v[i];
      }
      ss = wave_sum(ss);
      const float rs = rsqrtf(ss * (1.f / 1024.f) + 1e-6f);
#pragma unroll
      for (int i = 0; i < 4; ++i) {
        const float4 g = *(const float4*)(gw + i * 256 + lane * 4);
        uint2 o; o.x = pack2(v[i].x * rs * g.x, v[i].y * rs * g.y); o.y = pack2(v[i].z * rs * g.z, v[i].w * rs * g.w);
        *(uint2*)(H + (size_t)row * 1024 + i * 256 + lane * 4) = o;
      }
    }
  }
}

struct EpiInproj {
  static constexpr bool PERM = true, AFTER_DRAIN = false;
  u16* z; float* out; int l;
  __device__ __forceinline__ void operator()(const f32x4 (&acc)[2][2][4][2], const pg8::Unit& u, int wr, int wc, int fr, int fq) const {
    const int row0 = u.pm * 256 + wr * 64 + fr, col0 = u.pn * 256 + wc * 32 + 8 * fq;
#pragma unroll
    for (int ai = 0; ai < 2; ++ai)
#pragma unroll
      for (int m = 0; m < 4; ++m) {
        const int row = row0 + ai * 128 + m * 16;
        u16* rowp = z + (size_t)row * ZLD + col0;
#pragma unroll
        for (int bj = 0; bj < 2; ++bj) {
          const f32x4 v0 = acc[ai][bj][m][0], v1 = acc[ai][bj][m][1];
          pg8::u32x4 w; w.x = pg8::cvt_pk_bf16(v0[0], v0[1]); w.y = pg8::cvt_pk_bf16(v0[2], v0[3]); w.z = pg8::cvt_pk_bf16(v1[0], v1[1]); w.w = pg8::cvt_pk_bf16(v1[2], v1[3]);
          *(pg8::u32x4*)(rowp + bj * 128) = w;
        }
        const bool prompt = row < M_P;
        int b, t;
        if (prompt) { b = row >> 13; t = row & 8191; } else { b = (row - M_P) >> 2; t = (row - M_P) & 3; }
        if (u.pn < 7) {
          if ((prompt && t == 8191) || (!prompt && t == 3)) {
            float* o = out + (prompt ? O_PSHIFT + (size_t)(l * 2 + b) * 1792 : O_SSHIFT + (size_t)(l * 128 + b) * 1792) + col0;
#pragma unroll
            for (int bj = 0; bj < 2; ++bj) { *(f32x4*)(o + bj * 128) = acc[ai][bj][m][0]; *(f32x4*)(o + bj * 128 + 4) = acc[ai][bj][m][1]; }
          }
        } else if (u.pn == 9 && prompt && t >= 8064) {
          const int c = wc * 32 + 8 * fq;
          float* o = out + O_PV + ((size_t)((l * 2 + b) * 128 + (t - 8064)) * 2 + (c >> 6)) * 64 + (c & 63);
          *(f32x4*)o = acc[ai][1][m][0]; *(f32x4*)(o + 4) = acc[ai][1][m][1];
        }
      }
  }
};
struct EpiStoreBf16 {
  static constexpr bool PERM = true, AFTER_DRAIN = false;
  u16* O; int ldc;
  __device__ __forceinline__ void operator()(const f32x4 (&acc)[2][2][4][2], const pg8::Unit& u, int wr, int wc, int fr, int fq) const {
    const int row0 = u.pm * 256 + wr * 64 + fr, col0 = u.pn * 256 + wc * 32 + 8 * fq;
#pragma unroll
    for (int ai = 0; ai < 2; ++ai)
#pragma unroll
      for (int m = 0; m < 4; ++m) {
        u16* rowp = O + (size_t)(row0 + ai * 128 + m * 16) * ldc + col0;
#pragma unroll
        for (int bj = 0; bj < 2; ++bj) {
          const f32x4 v0 = acc[ai][bj][m][0], v1 = acc[ai][bj][m][1];
          pg8::u32x4 w; w.x = pg8::cvt_pk_bf16(v0[0], v0[1]); w.y = pg8::cvt_pk_bf16(v0[2], v0[3]); w.z = pg8::cvt_pk_bf16(v1[0], v1[1]); w.w = pg8::cvt_pk_bf16(v1[2], v1[3]);
          *(pg8::u32x4*)(rowp + bj * 128) = w;
        }
      }
  }
};
struct EpiFfnIn {
  static constexpr bool PERM = true, AFTER_DRAIN = false;
  u16* cu;
  __device__ __forceinline__ void operator()(const f32x4 (&acc)[2][2][4][2], const pg8::Unit& u, int wr, int wc, int fr, int fq) const {
    const int row0 = u.pm * 256 + wr * 64 + fr, col0 = u.pn * 128 + wc * 32 + 8 * fq;
#pragma unroll
    for (int ai = 0; ai < 2; ++ai)
#pragma unroll
      for (int m = 0; m < 4; ++m) {
        u16* rowp = cu + (size_t)(row0 + ai * 128 + m * 16) * 5632 + col0;
#pragma unroll
        for (int bj = 0; bj < 2; ++bj) {
          const f32x4 v0 = acc[ai][bj][m][0], v1 = acc[ai][bj][m][1];
          pg8::u32x4 w; w.x = pg8::cvt_pk_bf16(v0[0], v0[1]); w.y = pg8::cvt_pk_bf16(v0[2], v0[3]); w.z = pg8::cvt_pk_bf16(v1[0], v1[1]); w.w = pg8::cvt_pk_bf16(v1[2], v1[3]);
          *(pg8::u32x4*)(rowp + bj * 2816) = w;
        }
      }
  }
};
struct EpiMerge {
  static constexpr bool PERM = true, AFTER_DRAIN = false;
  const u16* t1; const u16* t2; u16* mg;
  __device__ __forceinline__ void operator()(const f32x4 (&acc)[2][2][4][2], const pg8::Unit& u, int wr, int wc, int fr, int fq) const {
    const int row0 = u.pm * 256 + wr * 64 + fr, col0 = u.pn * 128 + wc * 32 + 8 * fq;
#pragma unroll
    for (int ai = 0; ai < 2; ++ai)
#pragma unroll
      for (int m = 0; m < 4; ++m) {
        const size_t off = (size_t)(row0 + ai * 128 + m * 16) * 1024 + col0;
        float a[8], b[8], o[8];
        unpack8(*(const uint4*)(t1 + off), a);
        unpack8(*(const uint4*)(t2 + off), b);
#pragma unroll
        for (int n = 0; n < 2; ++n)
#pragma unroll
          for (int j = 0; j < 4; ++j)
            o[n * 4 + j] = sigm(acc[ai][0][m][n][j]) * a[n * 4 + j] + sigm(acc[ai][1][m][n][j]) * b[n * 4 + j];
        *(uint4*)(mg + off) = pack8(o);
        asm volatile("" ::: "memory");
      }
  }
};
struct EpiResid {
  static constexpr bool PERM = false, AFTER_DRAIN = false;
  float* X;
  __device__ __forceinline__ void operator()(const f32x4 (&acc)[2][2][4][2], const pg8::Unit& u, int wr, int wc, int fr, int fq) const {
    const int row0 = u.pm * 256 + wr * 64 + fr, col0 = u.pn * 256 + wc * 32 + 4 * fq;
#pragma unroll
    for (int ai = 0; ai < 2; ++ai)
#pragma unroll
      for (int m = 0; m < 4; ++m) {
        float* rowp = X + (size_t)(row0 + ai * 128 + m * 16) * 1024 + col0;
#pragma unroll
        for (int bj = 0; bj < 2; ++bj)
#pragma unroll
          for (int n = 0; n < 2; ++n) { f32x4* q = (f32x4*)(rowp + bj * 128 + n * 16); *q = *q + acc[ai][bj][m][n]; }
        asm volatile("" ::: "memory");
      }
  }
};
template <class Epi>
__device__ __forceinline__ void run_gemm(unsigned char* lds_raw, const u16* A, int lda, const u16* Bt, int N, int K, const Epi& E) {
  pg8::Gemm g; g.A = A; g.Bt = Bt; g.M = M_TOT; g.N = N; g.K = K; g.lda = lda;
  pg8::StaticOrder S; S.init(M_TOT, N, gridDim.x, blockIdx.x);
  __syncthreads();
  pg8::gemm_phase<Epi, pg8::StaticOrder, false>((PG8_LAS unsigned char*)lds_raw, g, S, E, nullptr);
  __syncthreads();
}

__device__ __forceinline__ void rope_item(const Params& p, int l, int item) {
  const int tid = opq(threadIdx.x);
  u16* z = (u16*)(p.ws + WS_Z);
  const int row = item * 64 + (tid >> 3);
  const int d0 = (tid & 7) * 4;
  const bool prompt = row < M_P;
  int b, t, pos;
  if (prompt) { b = row >> 13; t = row & 8191; pos = t; } else { b = (row - M_P) >> 2; t = (row - M_P) & 3; pos = 16384 + t; }
  float cs[4], sn[4];
#pragma unroll
  for (int i = 0; i < 4; ++i) {
    const float inv = __expf(-(float)(d0 + i) * (9.210340371976184f / 32.f));
    const float angf = (float)pos * inv;
    double a = (double)angf;
    a -= 6.283185307179586 * rint(a * 0.15915494309189535);
    const float af = (float)a;
    sn[i] = __sinf(af); cs[i] = __cosf(af);
  }
#pragma unroll 2
  for (int hh = 0; hh < 10; ++hh) {
    u16* q = z + (size_t)row * ZLD + 1792 + hh * 64 + d0;
    const uint2 lo = *(const uint2*)q, hi = *(const uint2*)(q + 32);
    float x1[4] = {__uint_as_float(lo.x << 16), __uint_as_float(lo.x & 0xFFFF0000u), __uint_as_float(lo.y << 16), __uint_as_float(lo.y & 0xFFFF0000u)};
    float x2[4] = {__uint_as_float(hi.x << 16), __uint_as_float(hi.x & 0xFFFF0000u), __uint_as_float(hi.y << 16), __uint_as_float(hi.y & 0xFFFF0000u)};
    float y1[4], y2[4];
#pragma unroll
    for (int i = 0; i < 4; ++i) { y1[i] = x1[i] * cs[i] - x2[i] * sn[i]; y2[i] = x2[i] * cs[i] + x1[i] * sn[i]; }
    uint2 o1, o2;
    o1.x = pack2(y1[0], y1[1]); o1.y = pack2(y1[2], y1[3]); o2.x = pack2(y2[0], y2[1]); o2.y = pack2(y2[2], y2[3]);
    *(uint2*)q = o1; *(uint2*)(q + 32) = o2;
    if (hh >= 8 && prompt && t >= 8064) {
      float* o = p.out + O_PK + ((size_t)((l * 2 + b) * 128 + (t - 8064)) * 2 + (hh - 8)) * 64 + d0;
      *(float4*)o = make_float4(y1[0], y1[1], y1[2], y1[3]);
      *(float4*)(o + 32) = make_float4(y2[0], y2[1], y2[2], y2[3]);
    }
  }
}

#define SL(i) (ldsf + (i) * 4160)
__device__ __forceinline__ void rwkv_item(const Params& p, int l, int item, float* ldsf) {
  const int tid = opq(threadIdx.x), lane = tid & 63, wave = tid >> 6;
  const bool sample = item >= 2048;
  int h, cidx, rowbase;
  if (!sample) { h = item & 7; cidx = item >> 3; rowbase = cidx * 64; }
  else { int s = item - 2048; h = s & 7; cidx = s >> 3; rowbase = M_P + cidx * 64; }
  const int cc = cidx & 127;
  const u16* z = (const u16*)(p.ws + WS_Z);
  u16* zw_ = (u16*)(p.ws + WS_Z);
  const float* mu = p.in[9] + l * 1792;
  float* wbuf = SL(7);
  float* gc = ldsf + 9 * 4160;
  float* bd = ldsf + 9 * 4160 + 64;
  __syncthreads();
  {
    const int t = tid >> 3, c8 = (tid & 7) * 8;
    const int m = rowbase + t;
    const int zcs[7] = {h * 64, 512 + h * 64, 1024 + h * 64, 1536, 1600, 1664, 1728};
#pragma unroll
    for (int gi = 0; gi < 7; ++gi) {
      const int zc = zcs[gi] + c8;
      float cur[8], prv[8];
      unpack8(*(const uint4*)(z + (size_t)m * ZLD + zc), cur);
      bool zero = false, fromstate = false;
      if (!sample) zero = (t == 0 && cc == 0);
      else fromstate = ((t & 3) == 0);
      if (zero) {
#pragma unroll
        for (int i = 0; i < 8; ++i) prv[i] = 0.f;
      } else if (fromstate) {
        const int b = (m - M_P) >> 2;
        const float* sp = p.in[2] + (size_t)(l * 128 + b) * 1792 + zc;
        float4 a = *(const float4*)sp, bb = *(const float4*)(sp + 4);
        prv[0] = a.x; prv[1] = a.y; prv[2] = a.z; prv[3] = a.w; prv[4] = bb.x; prv[5] = bb.y; prv[6] = bb.z; prv[7] = bb.w;
      } else {
        unpack8(*(const uint4*)(z + (size_t)(m - 1) * ZLD + zc), prv);
      }
      float* d = SL(gi) + t * 65 + c8;
#pragma unroll
      for (int i = 0; i < 8; ++i) {
        float v = cur[i] + mu[zc + i] * (prv[i] - cur[i]);
        if (gi == 3) v = tanhf(v);
        if (gi >= 5) v = sigm(v);
        d[i] = v;
      }
    }
  }
  const int lt = tid & 63, jg = tid >> 6;
  auto load_w = [&](const float* W, int nrows) {
    for (int e = tid; e < nrows * 8; e += NT) {
      const int i = e >> 3, c = (e & 7) * 8;
      const float* s = W + (size_t)i * 512 + h * 64 + c;
      *(float4*)(wbuf + i * 64 + c) = *(const float4*)s;
      *(float4*)(wbuf + i * 64 + c + 4) = *(const float4*)(s + 4);
    }
  };
  auto lora = [&](const float* xa, const float* xb, int n, float* acc) {
#pragma unroll 2
    for (int i = 0; i < n; ++i) {
      const float x = (i < 64) ? xa[lt * 65 + i] : xb[lt * 65 + i - 64];
      const float4 w0 = *(const float4*)(wbuf + i * 64 + jg * 8);
      const float4 w1 = *(const float4*)(wbuf + i * 64 + jg * 8 + 4);
      acc[0] += x * w0.x; acc[1] += x * w0.y; acc[2] += x * w0.z; acc[3] += x * w0.w;
      acc[4] += x * w1.x; acc[5] += x * w1.y; acc[6] += x * w1.z; acc[7] += x * w1.w;
    }
  };
  float res[8];
  load_w(p.in[11] + (size_t)l * 64 * 512, 64);
  __syncthreads();
#pragma unroll
  for (int i = 0; i < 8; ++i) res[i] = p.in[10][l * 512 + h * 64 + jg * 8 + i];
  lora(SL(3), SL(3), 64, res);
  __syncthreads();
#pragma unroll
  for (int i = 0; i < 8; ++i) {
    const float x = -res[i];
    const float sp = (x > 20.f) ? x : log1pf(__expf(x));
    SL(3)[lt * 65 + jg * 8 + i] = -__expf(-sp - 0.5f);
  }
  load_w(p.in[13] + (size_t)l * 64 * 512, 64);
  __syncthreads();
#pragma unroll
  for (int i = 0; i < 8; ++i) res[i] = p.in[12][l * 512 + h * 64 + jg * 8 + i];
  lora(SL(4), SL(4), 64, res);
  __syncthreads();
#pragma unroll
  for (int i = 0; i < 8; ++i) SL(4)[lt * 65 + jg * 8 + i] = sigm(res[i]);
  load_w(p.in[14] + (size_t)l * 128 * 512, 128);
  __syncthreads();
#pragma unroll
  for (int i = 0; i < 8; ++i) res[i] = 0.f;
  lora(SL(5), SL(6), 128, res);
  __syncthreads();
  if (!sample) {
    u16* ga = (u16*)(p.ws + WS_GA) + (size_t)item * 4096;
    *(uint4*)(ga + lt * 64 + jg * 8) = pack8(res);
    if (tid < 64) {
      float c = 0.f;
      for (int t = 0; t < 64; ++t) { c += SL(3)[t * 65 + tid]; SL(5)[t * 65 + tid] = c; }
      gc[tid] = __expf(c);
    }
  } else {
#pragma unroll
    for (int i = 0; i < 8; ++i) SL(6)[lt * 65 + jg * 8 + i] = res[i];
  }
  __syncthreads();
  {
    const int t = tid >> 3, j0 = (tid & 7) * 8;
    const float* kkw = p.in[15] + l * 512 + h * 64;
    const float* kaw = p.in[16] + l * 512 + h * 64;
    const float* rkw = p.in[17] + l * 512 + h * 64;
    float kr[8], av[8], rv[8], kkv[8], kf[8];
    float nrm = 0.f, bdot = 0.f;
#pragma unroll
    for (int i = 0; i < 8; ++i) {
      const int j = j0 + i;
      kr[i] = SL(1)[t * 65 + j]; av[i] = SL(4)[t * 65 + j]; rv[i] = SL(0)[t * 65 + j];
      kkv[i] = kr[i] * kkw[j];
      nrm += kkv[i] * kkv[i];
      kf[i] = kr[i] * (1.f + (av[i] - 1.f) * kaw[j]);
      bdot += rv[i] * kf[i] * rkw[j];
    }
    nrm += __shfl_xor(nrm, 1, 64); nrm += __shfl_xor(nrm, 2, 64); nrm += __shfl_xor(nrm, 4, 64);
    bdot += __shfl_xor(bdot, 1, 64); bdot += __shfl_xor(bdot, 2, 64); bdot += __shfl_xor(bdot, 4, 64);
    const float rn = 1.f / fmaxf(sqrtf(nrm), 1e-12f);
    if (!sample) {
      float bo[8];
#pragma unroll
      for (int i = 0; i < 8; ++i) {
        const int j = j0 + i;
        const float cum = SL(5)[t * 65 + j], dl = SL(3)[t * 65 + j];
        const float eg = __expf(cum), egi = __expf(-cum), egp = __expf(cum - dl);
        const float kk = kkv[i] * rn;
        SL(0)[t * 65 + j] = rv[i] * eg;
        SL(1)[t * 65 + j] = kf[i] * egi;
        SL(3)[t * 65 + j] = kk * av[i] * egi;
        SL(4)[t * 65 + j] = kk * egp;
        bo[i] = bdot * SL(2)[t * 65 + j];
      }
      u16* bop = (u16*)(p.ws + WS_BO) + (size_t)item * 4096;
      *(uint4*)(bop + t * 64 + j0) = pack8(bo);
    } else {
#pragma unroll
      for (int i = 0; i < 8; ++i) {
        const int j = j0 + i;
        const float kk = kkv[i] * rn;
        const float dl = SL(3)[t * 65 + j];
        SL(1)[t * 65 + j] = kf[i];
        SL(3)[t * 65 + j] = __expf(dl);
        SL(4)[t * 65 + j] = kk;
        SL(5)[t * 65 + j] = kk * av[i];
      }
      if ((tid & 7) == 0) bd[t] = bdot;
    }
  }
  __syncthreads();
  if (sample) {
    const float lng = p.in[18][l * 512 + h * 64 + lane], lnb = p.in[19][l * 512 + h * 64 + lane];
    for (int round = 0; round < 2; ++round) {
      const int seq = wave + 8 * round;
      const int b = cidx * 16 + seq;
      float S[64];
      const float* sp = p.in[3] + ((size_t)((l * 128 + b) * 8 + h) * 64 + lane) * 64;
#pragma unroll
      for (int k = 0; k < 64; k += 4) { float4 v = *(const float4*)(sp + k); S[k] = v.x; S[k + 1] = v.y; S[k + 2] = v.z; S[k + 3] = v.w; }
      for (int tt = 0; tt < 4; ++tt) {
        const int t = seq * 4 + tt;
        float sk = 0.f;
#pragma unroll
        for (int kc = 0; kc < 64; kc += 8) {
#pragma unroll
          for (int k = kc; k < kc + 8; ++k) sk += S[k] * SL(4)[t * 65 + k];
          __builtin_amdgcn_sched_barrier(0);
        }
        const float vt = SL(2)[t * 65 + lane];
        float y = 0.f;
#pragma unroll
        for (int kc = 0; kc < 64; kc += 8) {
#pragma unroll
          for (int k = kc; k < kc + 8; ++k) {
            S[k] = S[k] * SL(3)[t * 65 + k] - sk * SL(5)[t * 65 + k] + vt * SL(1)[t * 65 + k];
            y += S[k] * SL(0)[t * 65 + k];
          }
          __builtin_amdgcn_sched_barrier(0);
        }
        const float mean = wave_sum(y) * (1.f / 64.f);
        const float d = y - mean;
        const float var = wave_sum(d * d) * (1.f / 64.f);
        const float yn = d * rsqrtf(var + 64e-5f) * lng + lnb;
        const float o = (yn + bd[t] * vt) * SL(6)[t * 65 + lane];
        zw_[(size_t)(M_P + b * 4 + tt) * ZLD + h * 64 + lane] = f2bf(o);
      }
      float* op = p.out + O_SWKV + ((size_t)((l * 128 + b) * 8 + h) * 64 + lane) * 64;
#pragma unroll
      for (int k = 0; k < 64; k += 4) *(float4*)(op + k) = make_float4(S[k], S[k + 1], S[k + 2], S[k + 3]);
    }
    return;
  }
  {
    const int i = lane, tg = wave;
    float ab[8], ak[8], akr[8], abr[8];
#pragma unroll
    for (int q = 0; q < 8; ++q) { ab[q] = 0.f; ak[q] = 0.f; akr[q] = 0.f; abr[q] = 0.f; }
#pragma unroll 2
    for (int k = 0; k < 64; ++k) {
      const float xb = SL(3)[i * 65 + k], xk = SL(1)[i * 65 + k];
#pragma unroll
      for (int q = 0; q < 8; ++q) {
        const int t = tg * 8 + q;
        const float yk = SL(4)[t * 65 + k], yr = SL(0)[t * 65 + k];
        ab[q] += xb * yk; ak[q] += xk * yk; akr[q] += xk * yr; abr[q] += xb * yr;
      }
    }
    __syncthreads();
#pragma unroll
    for (int q = 0; q < 8; ++q) {
      const int t = tg * 8 + q;
      SL(6)[i * 65 + t] = (i < t) ? ab[q] : 0.f;
      SL(7)[i * 65 + t] = (i < t) ? ak[q] : 0.f;
      SL(8)[i * 65 + t] = (i <= t) ? akr[q] : 0.f;
      SL(5)[i * 65 + t] = (i <= t) ? abr[q] : 0.f;
    }
  }
  __syncthreads();
  {
    const int t = tid >> 3, j0 = (tid & 7) * 8;
#pragma unroll
    for (int i = 0; i < 8; ++i) { const float g = gc[j0 + i]; SL(3)[t * 65 + j0 + i] *= g; SL(1)[t * 65 + j0 + i] *= g; }
  }
  __syncthreads();
  if (tid < 128) {
    float* X_ = (tid < 64) ? SL(5) : SL(3);
    const int col = tid & 63;
    for (int i = 62; i >= 0; --i) {
      float a = X_[i * 65 + col];
#pragma unroll 4
      for (int t = i + 1; t < 64; ++t) a -= SL(6)[i * 65 + t] * X_[t * 65 + col];
      X_[i * 65 + col] = a;
    }
  }
  __syncthreads();
  {
    const int c = tid & 127, ig = tid >> 7;
    const int which = c >> 6, cq = c & 63;
    const float* N_ = which ? SL(3) : SL(5);
    float a[16];
#pragma unroll
    for (int q = 0; q < 16; ++q) a[q] = 0.f;
#pragma unroll 2
    for (int t = 0; t < 64; ++t) {
      const float n = N_[t * 65 + cq];
#pragma unroll
      for (int q = 0; q < 16; ++q) a[q] += SL(7)[(ig * 16 + q) * 65 + t] * n;
    }
    float* T_ = which ? SL(1) : SL(8);
#pragma unroll
    for (int q = 0; q < 16; ++q) T_[(ig * 16 + q) * 65 + cq] -= a[q];
  }
  __syncthreads();
  {
    const int x = lane, yg = wave;
    float w2[8], pp[8], yl[8], qq[8];
#pragma unroll
    for (int q = 0; q < 8; ++q) { w2[q] = 0.f; pp[q] = 0.f; yl[q] = 0.f; qq[q] = 0.f; }
#pragma unroll 2
    for (int j = 0; j < 64; ++j) {
      const float l5 = SL(5)[j * 65 + x], l4 = SL(4)[j * 65 + x], l8 = SL(8)[j * 65 + x], l2 = SL(2)[j * 65 + x];
#pragma unroll
      for (int q = 0; q < 8; ++q) {
        const int y = yg * 8 + q;
        w2[q] += l5 * SL(4)[j * 65 + y];
        pp[q] += l4 * SL(3)[j * 65 + y];
        yl[q] += l8 * SL(2)[j * 65 + y];
        qq[q] += l2 * SL(1)[j * 65 + y];
      }
    }
    float o1[8];
#pragma unroll
    for (int q = 0; q < 8; ++q) {
      const int y = yg * 8 + q;
      o1[q] = SL(0)[x * 65 + y] - w2[q];
    }
    u16* Pf = (u16*)(p.ws + WS_PP) + (size_t)item * 4096;
    float* Qf = (float*)(p.ws + WS_Q) + (size_t)item * 4096;
    if (tid < 64) ((float*)(p.ws + WS_GC))[(size_t)item * 64 + tid] = gc[tid];
    {
      const int s_ = x >> 4, kk = x & 15, hh = (kk >> 2) & 1, jj = ((kk >> 3) << 2) | (kk & 3);
#pragma unroll
      for (int q = 0; q < 8; ++q) {
        const int y = yg * 8 + q;
        Pf[(((y >> 5) * 4 + s_) * 64 + (y & 31) + 32 * hh) * 8 + jj] = f2bf(-pp[q]);
        const int k2 = y & 31, reg = ((k2 >> 3) << 2) | (k2 & 3), h2 = (k2 >> 2) & 1;
        Qf[(((x >> 5) * 2 + (y >> 5)) * 16 + reg) * 64 + (x & 31) + 32 * h2] = qq[q];
      }
    }
    u16* W2p = (u16*)(p.ws + WS_W2) + (size_t)item * 4096 + x * 64 + yg * 8;
    u16* YLp = (u16*)(p.ws + WS_YL) + (size_t)item * 4096 + x * 64 + yg * 8;
    *(uint4*)W2p = pack8(o1);
    *(uint4*)YLp = pack8(yl);
  }
}

__device__ __forceinline__ void mm_tile(const u16* Aop, int lda, const u16* Bop, int ldb, int mt, int nt, int r, int h, int ksteps, f32x16& acc) {
  const u16* ap = Aop + (mt * 32 + r) * lda + h * 8;
  const u16* bp = Bop + (nt * 32 + r) * ldb + h * 8;
#pragma unroll 4
  for (int s = 0; s < ksteps; ++s) {
    const bf16x8 a = *(const bf16x8*)(ap + s * 16);
    const bf16x8 b = *(const bf16x8*)(bp + s * 16);
    acc = __builtin_amdgcn_mfma_f32_32x32x16_bf16(a, b, acc, 0, 0, 0);
  }
}
__device__ __forceinline__ void store_T(u16* T, int ldt, int mt, int nt, int r, int h, const f32x16& acc) {
#pragma unroll
  for (int g = 0; g < 4; ++g) {
    uint2 o; o.x = pack2(acc[4 * g], acc[4 * g + 1]); o.y = pack2(acc[4 * g + 2], acc[4 * g + 3]);
    *(uint2*)(T + (nt * 32 + r) * ldt + mt * 32 + 8 * g + 4 * h) = o;
  }
}
__device__ __forceinline__ void tri32(const float* Ab, float* Xc) {
  const float x31 = Xc[2015];
  const float x30 = Xc[1950] - Ab[1981] * x31;
  const float x29 = Xc[1885] - Ab[1915] * x30 - Ab[1916] * x31;
  const float x28 = Xc[1820] - Ab[1849] * x29 - Ab[1850] * x30 - Ab[1851] * x31;
  const float x27 = Xc[1755] - Ab[1783] * x28 - Ab[1784] * x29 - Ab[1785] * x30 - Ab[1786] * x31;
  const float x26 = Xc[1690] - Ab[1717] * x27 - Ab[1718] * x28 - Ab[1719] * x29 - Ab[1720] * x30 - Ab[1721] * x31;
  const float x25 = Xc[1625] - Ab[1651] * x26 - Ab[1652] * x27 - Ab[1653] * x28 - Ab[1654] * x29 - Ab[1655] * x30 - Ab[1656] * x31;
  const float x24 = Xc[1560] - Ab[1585] * x25 - Ab[1586] * x26 - Ab[1587] * x27 - Ab[1588] * x28 - Ab[1589] * x29 - Ab[1590] * x30 - Ab[1591] * x31;
  const float x23 = Xc[1495] - Ab[1519] * x24 - Ab[1520] * x25 - Ab[1521] * x26 - Ab[1522] * x27 - Ab[1523] * x28 - Ab[1524] * x29 - Ab[1525] * x30 - Ab[1526] * x31;
  const float x22 = Xc[1430] - Ab[1453] * x23 - Ab[1454] * x24 - Ab[1455] * x25 - Ab[1456] * x26 - Ab[1457] * x27 - Ab[1458] * x28 - Ab[1459] * x29 - Ab[1460] * x30 - Ab[1461] * x31;
  const float x21 = Xc[1365] - Ab[1387] * x22 - Ab[1388] * x23 - Ab[1389] * x24 - Ab[1390] * x25 - Ab[1391] * x26 - Ab[1392] * x27 - Ab[1393] * x28 - Ab[1394] * x29 - Ab[1395] * x30 - Ab[1396] * x31;
  const float x20 = Xc[1300] - Ab[1321] * x21 - Ab[1322] * x22 - Ab[1323] * x23 - Ab[1324] * x24 - Ab[1325] * x25 - Ab[1326] * x26 - Ab[1327] * x27 - Ab[1328] * x28 - Ab[1329] * x29 - Ab[1330] * x30 - Ab[1331] * x31;
  const float x19 = Xc[1235] - Ab[1255] * x20 - Ab[1256] * x21 - Ab[1257] * x22 - Ab[1258] * x23 - Ab[1259] * x24 - Ab[1260] * x25 - Ab[1261] * x26 - Ab[1262] * x27 - Ab[1263] * x28 - Ab[1264] * x29 - Ab[1265] * x30 - Ab[1266] * x31;
  const float x18 = Xc[1170] - Ab[1189] * x19 - Ab[1190] * x20 - Ab[1191] * x21 - Ab[1192] * x22 - Ab[1193] * x23 - Ab[1194] * x24 - Ab[1195] * x25 - Ab[1196] * x26 - Ab[1197] * x27 - Ab[1198] * x28 - Ab[1199] * x29 - Ab[1200] * x30 - Ab[1201] * x31;
  const float x17 = Xc[1105] - Ab[1123] * x18 - Ab[1124] * x19 - Ab[1125] * x20 - Ab[1126] * x21 - Ab[1127] * x22 - Ab[1128] * x23 - Ab[1129] * x24 - Ab[1130] * x25 - Ab[1131] * x26 - Ab[1132] * x27 - Ab[1133] * x28 - Ab[1134] * x29 - Ab[1135] * x30 - Ab[1136] * x31;
  const float x16 = Xc[1040] - Ab[1057] * x17 - Ab[1058] * x18 - Ab[1059] * x19 - Ab[1060] * x20 - Ab[1061] * x21 - Ab[1062] * x22 - Ab[1063] * x23 - Ab[1064] * x24 - Ab[1065] * x25 - Ab[1066] * x26 - Ab[1067] * x27 - Ab[1068] * x28 - Ab[1069] * x29 - Ab[1070] * x30 - Ab[1071] * x31;
  const float x15 = Xc[975] - Ab[991] * x16 - Ab[992] * x17 - Ab[993] * x18 - Ab[994] * x19 - Ab[995] * x20 - Ab[996] * x21 - Ab[997] * x22 - Ab[998] * x23 - Ab[999] * x24 - Ab[1000] * x25 - Ab[1001] * x26 - Ab[1002] * x27 - Ab[1003] * x28 - Ab[1004] * x29 - Ab[1005] * x30 - Ab[1006] * x31;
  const float x14 = Xc[910] - Ab[925] * x15 - Ab[926] * x16 - Ab[927] * x17 - Ab[928] * x18 - Ab[929] * x19 - Ab[930] * x20 - Ab[931] * x21 - Ab[932] * x22 - Ab[933] * x23 - Ab[934] * x24 - Ab[935] * x25 - Ab[936] * x26 - Ab[937] * x27 - Ab[938] * x28 - Ab[939] * x29 - Ab[940] * x30 - Ab[941] * x31;
  const float x13 = Xc[845] - Ab[859] * x14 - Ab[860] * x15 - Ab[861] * x16 - Ab[862] * x17 - Ab[863] * x18 - Ab[864] * x19 - Ab[865] * x20 - Ab[866] * x21 - Ab[867] * x22 - Ab[868] * x23 - Ab[869] * x24 - Ab[870] * x25 - Ab[871] * x26 - Ab[872] * x27 - Ab[873] * x28 - Ab[874] * x29 - Ab[875] * x30 - Ab[876] * x31;
  const float x12 = Xc[780] - Ab[793] * x13 - Ab[794] * x14 - Ab[795] * x15 - Ab[796] * x16 - Ab[797] * x17 - Ab[798] * x18 - Ab[799] * x19 - Ab[800] * x20 - Ab[801] * x21 - Ab[802] * x22 - Ab[803] * x23 - Ab[804] * x24 - Ab[805] * x25 - Ab[806] * x26 - Ab[807] * x27 - Ab[808] * x28 - Ab[809] * x29 - Ab[810] * x30 - Ab[811] * x31;
  const float x11 = Xc[715] - Ab[727] * x12 - Ab[728] * x13 - Ab[729] * x14 - Ab[730] * x15 - Ab[731] * x16 - Ab[732] * x17 - Ab[733] * x18 - Ab[734] * x19 - Ab[735] * x20 - Ab[736] * x21 - Ab[737] * x22 - Ab[738] * x23 - Ab[739] * x24 - Ab[740] * x25 - Ab[741] * x26 - Ab[742] * x27 - Ab[743] * x28 - Ab[744] * x29 - Ab[745] * x30 - Ab[746] * x31;
  const float x10 = Xc[650] - Ab[661] * x11 - Ab[662] * x12 - Ab[663] * x13 - Ab[664] * x14 - Ab[665] * x15 - Ab[666] * x16 - Ab[667] * x17 - Ab[668] * x18 - Ab[669] * x19 - Ab[670] * x20 - Ab[671] * x21 - Ab[672] * x22 - Ab[673] * x23 - Ab[674] * x24 - Ab[675] * x25 - Ab[676] * x26 - Ab[677] * x27 - Ab[678] * x28 - Ab[679] * x29 - Ab[680] * x30 - Ab[681] * x31;
  const float x9 = Xc[585] - Ab[595] * x10 - Ab[596] * x11 - Ab[597] * x12 - Ab[598] * x13 - Ab[599] * x14 - Ab[600] * x15 - Ab[601] * x16 - Ab[602] * x17 - Ab[603] * x18 - Ab[604] * x19 - Ab[605] * x20 - Ab[606] * x21 - Ab[607] * x22 - Ab[608] * x23 - Ab[609] * x24 - Ab[610] * x25 - Ab[611] * x26 - Ab[612] * x27 - Ab[613] * x28 - Ab[614] * x29 - Ab[615] * x30 - Ab[616] * x31;
  const float x8 = Xc[520] - Ab[529] * x9 - Ab[530] * x10 - Ab[531] * x11 - Ab[532] * x12 - Ab[533] * x13 - Ab[534] * x14 - Ab[535] * x15 - Ab[536] * x16 - Ab[537] * x17 - Ab[538] * x18 - Ab[539] * x19 - Ab[540] * x20 - Ab[541] * x21 - Ab[542] * x22 - Ab[543] * x23 - Ab[544] * x24 - Ab[545] * x25 - Ab[546] * x26 - Ab[547] * x27 - Ab[548] * x28 - Ab[549] * x29 - Ab[550] * x30 - Ab[551] * x31;
  const float x7 = Xc[455] - Ab[463] * x8 - Ab[464] * x9 - Ab[465] * x10 - Ab[466] * x11 - Ab[467] * x12 - Ab[468] * x13 - Ab[469] * x14 - Ab[470] * x15 - Ab[471] * x16 - Ab[472] * x17 - Ab[473] * x18 - Ab[474] * x19 - Ab[475] * x20 - Ab[476] * x21 - Ab[477] * x22 - Ab[478] * x23 - Ab[479] * x24 - Ab[480] * x25 - Ab[481] * x26 - Ab[482] * x27 - Ab[483] * x28 - Ab[484] * x29 - Ab[485] * x30 - Ab[486] * x31;
  const float x6 = Xc[390] - Ab[397] * x7 - Ab[398] * x8 - Ab[399] * x9 - Ab[400] * x10 - Ab[401] * x11 - Ab[402] * x12 - Ab[403] * x13 - Ab[404] * x14 - Ab[405] * x15 - Ab[406] * x16 - Ab[407] * x17 - Ab[408] * x18 - Ab[409] * x19 - Ab[410] * x20 - Ab[411] * x21 - Ab[412] * x22 - Ab[413] * x23 - Ab[414] * x24 - Ab[415] * x25 - Ab[416] * x26 - Ab[417] * x27 - Ab[418] * x28 - Ab[419] * x29 - Ab[420] * x30 - Ab[421] * x31;
  const float x5 = Xc[325] - Ab[331] * x6 - Ab[332] * x7 - Ab[333] * x8 - Ab[334] * x9 - Ab[335] * x10 - Ab[336] * x11 - Ab[337] * x12 - Ab[338] * x13 - Ab[339] * x14 - Ab[340] * x15 - Ab[341] * x16 - Ab[342] * x17 - Ab[343] * x18 - Ab[344] * x19 - Ab[345] * x20 - Ab[346] * x21 - Ab[347] * x22 - Ab[348] * x23 - Ab[349] * x24 - Ab[350] * x25 - Ab[351] * x26 - Ab[352] * x27 - Ab[353] * x28 - Ab[354] * x29 - Ab[355] * x30 - Ab[356] * x31;
  const float x4 = Xc[260] - Ab[265] * x5 - Ab[266] * x6 - Ab[267] * x7 - Ab[268] * x8 - Ab[269] * x9 - Ab[270] * x10 - Ab[271] * x11 - Ab[272] * x12 - Ab[273] * x13 - Ab[274] * x14 - Ab[275] * x15 - Ab[276] * x16 - Ab[277] * x17 - Ab[278] * x18 - Ab[279] * x19 - Ab[280] * x20 - Ab[281] * x21 - Ab[282] * x22 - Ab[283] * x23 - Ab[284] * x24 - Ab[285] * x25 - Ab[286] * x26 - Ab[287] * x27 - Ab[288] * x28 - Ab[289] * x29 - Ab[290] * x30 - Ab[291] * x31;
  const float x3 = Xc[195] - Ab[199] * x4 - Ab[200] * x5 - Ab[201] * x6 - Ab[202] * x7 - Ab[203] * x8 - Ab[204] * x9 - Ab[205] * x10 - Ab[206] * x11 - Ab[207] * x12 - Ab[208] * x13 - Ab[209] * x14 - Ab[210] * x15 - Ab[211] * x16 - Ab[212] * x17 - Ab[213] * x18 - Ab[214] * x19 - Ab[215] * x20 - Ab[216] * x21 - Ab[217] * x22 - Ab[218] * x23 - Ab[219] * x24 - Ab[220] * x25 - Ab[221] * x26 - Ab[222] * x27 - Ab[223] * x28 - Ab[224] * x29 - Ab[225] * x30 - Ab[226] * x31;
  const float x2 = Xc[130] - Ab[133] * x3 - Ab[134] * x4 - Ab[135] * x5 - Ab[136] * x6 - Ab[137] * x7 - Ab[138] * x8 - Ab[139] * x9 - Ab[140] * x10 - Ab[141] * x11 - Ab[142] * x12 - Ab[143] * x13 - Ab[144] * x14 - Ab[145] * x15 - Ab[146] * x16 - Ab[147] * x17 - Ab[148] * x18 - Ab[149] * x19 - Ab[150] * x20 - Ab[151] * x21 - Ab[152] * x22 - Ab[153] * x23 - Ab[154] * x24 - Ab[155] * x25 - Ab[156] * x26 - Ab[157] * x27 - Ab[158] * x28 - Ab[159] * x29 - Ab[160] * x30 - Ab[161] * x31;
  const float x1 = Xc[65] - Ab[67] * x2 - Ab[68] * x3 - Ab[69] * x4 - Ab[70] * x5 - Ab[71] * x6 - Ab[72] * x7 - Ab[73] * x8 - Ab[74] * x9 - Ab[75] * x10 - Ab[76] * x11 - Ab[77] * x12 - Ab[78] * x13 - Ab[79] * x14 - Ab[80] * x15 - Ab[81] * x16 - Ab[82] * x17 - Ab[83] * x18 - Ab[84] * x19 - Ab[85] * x20 - Ab[86] * x21 - Ab[87] * x22 - Ab[88] * x23 - Ab[89] * x24 - Ab[90] * x25 - Ab[91] * x26 - Ab[92] * x27 - Ab[93] * x28 - Ab[94] * x29 - Ab[95] * x30 - Ab[96] * x31;
  const float x0 = Xc[0] - Ab[1] * x1 - Ab[2] * x2 - Ab[3] * x3 - Ab[4] * x4 - Ab[5] * x5 - Ab[6] * x6 - Ab[7] * x7 - Ab[8] * x8 - Ab[9] * x9 - Ab[10] * x10 - Ab[11] * x11 - Ab[12] * x12 - Ab[13] * x13 - Ab[14] * x14 - Ab[15] * x15 - Ab[16] * x16 - Ab[17] * x17 - Ab[18] * x18 - Ab[19] * x19 - Ab[20] * x20 - Ab[21] * x21 - Ab[22] * x22 - Ab[23] * x23 - Ab[24] * x24 - Ab[25] * x25 - Ab[26] * x26 - Ab[27] * x27 - Ab[28] * x28 - Ab[29] * x29 - Ab[30] * x30 - Ab[31] * x31;
  Xc[0] = x0;
  Xc[65] = x1;
  Xc[130] = x2;
  Xc[195] = x3;
  Xc[260] = x4;
  Xc[325] = x5;
  Xc[390] = x6;
  Xc[455] = x7;
  Xc[520] = x8;
  Xc[585] = x9;
  Xc[650] = x10;
  Xc[715] = x11;
  Xc[780] = x12;
  Xc[845] = x13;
  Xc[910] = x14;
  Xc[975] = x15;
  Xc[1040] = x16;
  Xc[1105] = x17;
  Xc[1170] = x18;
  Xc[1235] = x19;
  Xc[1300] = x20;
  Xc[1365] = x21;
  Xc[1430] = x22;
  Xc[1495] = x23;
  Xc[1560] = x24;
  Xc[1625] = x25;
  Xc[1690] = x26;
  Xc[1755] = x27;
  Xc[1820] = x28;
  Xc[1885] = x29;
  Xc[1950] = x30;
  Xc[2015] = x31;
}
#define FS(i) (ldsf + (i) * 4160)
__device__ __forceinline__ void rwkv_item2(const Params& p, int l, int item, float* ldsf) {
  const int tid = opq(threadIdx.x), lane = tid & 63, wave = tid >> 6;
  const int r = lane & 31, hf = lane >> 5;
  const int h = item & 7, cidx = item >> 3, rowbase = cidx * 64, cc = cidx & 127;
  const u16* z = (const u16*)(p.ws + WS_Z);
  const float* mu = p.in[9] + l * 1792;
  u16* BBp = (u16*)((unsigned char*)ldsf + 83200);
  u16* XW = BBp;            u16* XA = BBp + 4608;    u16* XG = BBp + 9216;   u16* WT = BBp + 17920;
  u16* Rn = BBp;            u16* Kn = BBp + 4608;    u16* Bn = BBp + 9216;   u16* Cn = BBp + 13824;
  u16* CT = BBp + 18432;    u16* KHT = BBp + 23040;  u16* VT = BBp + 27648;
  float* gc = (float*)(BBp + 32256);
  u16* AK = (u16*)FS(2);    u16* NTm = AK + 4608;
  u16* MT = (u16*)FS(0);    u16* KQT = (u16*)FS(1);
  const int mt = (wave >> 1) & 1, nt = wave & 1, grp = wave >> 2;
  __syncthreads();
  {
    const int t = tid >> 3, c8 = (tid & 7) * 8;
    const int m = rowbase + t;
    const int zcs[7] = {h * 64, 512 + h * 64, 1024 + h * 64, 1536, 1600, 1664, 1728};
#pragma unroll
    for (int gi = 0; gi < 7; ++gi) {
      const int zc = zcs[gi] + c8;
      float cur[8], prv[8], v[8];
      unpack8(*(const uint4*)(z + (size_t)m * ZLD + zc), cur);
      if (t == 0 && cc == 0) {
#pragma unroll
        for (int i = 0; i < 8; ++i) prv[i] = 0.f;
      } else {
        unpack8(*(const uint4*)(z + (size_t)(m - 1) * ZLD + zc), prv);
      }
#pragma unroll
      for (int i = 0; i < 8; ++i) {
        float x = cur[i] + mu[zc + i] * (prv[i] - cur[i]);
        if (gi == 3) x = tanhf(x);
        if (gi >= 5) x = sigm(x);
        v[i] = x;
      }
      if (gi < 2) {
        float* d = FS(gi) + t * 65 + c8;
#pragma unroll
        for (int i = 0; i < 8; ++i) d[i] = v[i];
      } else if (gi == 2) {
#pragma unroll
        for (int i = 0; i < 8; ++i) VT[(c8 + i) * 72 + t] = f2bf(v[i]);
      } else if (gi == 3) { *(uint4*)(XW + t * 72 + c8) = pack8(v); }
      else if (gi == 4) { *(uint4*)(XA + t * 72 + c8) = pack8(v); }
      else { *(uint4*)(XG + t * 136 + (gi - 5) * 64 + c8) = pack8(v); }
    }
  }
  {
    const int i = tid >> 3, j8 = (tid & 7) * 8;
    const float* s1 = p.in[11] + (size_t)l * 64 * 512 + (size_t)i * 512 + h * 64 + j8;
    const float* s2 = p.in[13] + (size_t)l * 64 * 512 + (size_t)i * 512 + h * 64 + j8;
    const float4 a0 = *(const float4*)s1, a1 = *(const float4*)(s1 + 4), b0 = *(const float4*)s2, b1 = *(const float4*)(s2 + 4);
    const float wa[8] = {a0.x, a0.y, a0.z, a0.w, a1.x, a1.y, a1.z, a1.w};
    const float wb[8] = {b0.x, b0.y, b0.z, b0.w, b1.x, b1.y, b1.z, b1.w};
#pragma unroll
    for (int q = 0; q < 8; ++q) { WT[(j8 + q) * 72 + i] = f2bf(wa[q]); WT[4608 + (j8 + q) * 72 + i] = f2bf(wb[q]); }
  }
  __syncthreads();
  {
    f32x16 acc;
#pragma unroll
    for (int i = 0; i < 16; ++i) acc[i] = 0.f;
    mm_tile(grp ? XA : XW, 72, grp ? WT + 4608 : WT, 72, mt, nt, r, hf, 4, acc);
    const int j = nt * 32 + r;
    const float bias = grp ? p.in[12][l * 512 + h * 64 + j] : p.in[10][l * 512 + h * 64 + j];
#pragma unroll
    for (int reg = 0; reg < 16; ++reg) {
      const int t = mt * 32 + ROWOFF(reg, hf);
      const float x = acc[reg] + bias;
      if (grp) FS(3)[t * 65 + j] = sigm(x);
      else {
        const float nx = -x;
        const float sp = (nx > 20.f) ? nx : log1pf(__expf(nx));
        FS(4)[t * 65 + j] = -__expf(-sp - 0.5f);
      }
    }
  }
  __syncthreads();
  {
#pragma unroll
    for (int e2 = 0; e2 < 2; ++e2) {
      const int e = tid + e2 * 512;
      const int i = e >> 3, j8 = (e & 7) * 8;
      const float* s1 = p.in[14] + (size_t)l * 128 * 512 + (size_t)i * 512 + h * 64 + j8;
      const float4 a0 = *(const float4*)s1, a1 = *(const float4*)(s1 + 4);
      const float wa[8] = {a0.x, a0.y, a0.z, a0.w, a1.x, a1.y, a1.z, a1.w};
#pragma unroll
      for (int q = 0; q < 8; ++q) WT[(j8 + q) * 136 + i] = f2bf(wa[q]);
    }
  }
  if (tid < 64) {
    float c = 0.f;
    for (int t = 0; t < 64; ++t) { c += FS(4)[t * 65 + tid]; FS(2)[t * 65 + tid] = c; }
    const float g = __expf(c);
    gc[tid] = g;
    ((float*)(p.ws + WS_GC))[(size_t)item * 64 + tid] = g;
  }
  __syncthreads();
  if (grp == 0) {
    f32x16 acc;
#pragma unroll
    for (int i = 0; i < 16; ++i) acc[i] = 0.f;
    mm_tile(XG, 136, WT, 136, mt, nt, r, hf, 8, acc);
    u16* ga = (u16*)(p.ws + WS_GA) + (size_t)item * 4096;
#pragma unroll
    for (int reg = 0; reg < 16; ++reg) ga[(mt * 32 + ROWOFF(reg, hf)) * 64 + nt * 32 + r] = f2bf(acc[reg]);
  }
  __syncthreads();
  {
    const int t = tid >> 3, j0 = (tid & 7) * 8;
    const float* kkw = p.in[15] + l * 512 + h * 64;
    const float* kaw = p.in[16] + l * 512 + h * 64;
    const float* rkw = p.in[17] + l * 512 + h * 64;
    float kr[8], av[8], rv[8], kkv[8], kf[8];
    float nrm = 0.f, bdot = 0.f;
#pragma unroll
    for (int i = 0; i < 8; ++i) {
      const int j = j0 + i;
      kr[i] = FS(1)[t * 65 + j]; av[i] = FS(3)[t * 65 + j]; rv[i] = FS(0)[t * 65 + j];
      kkv[i] = kr[i] * kkw[j];
      nrm += kkv[i] * kkv[i];
      kf[i] = kr[i] * (1.f + (av[i] - 1.f) * kaw[j]);
      bdot += rv[i] * kf[i] * rkw[j];
    }
    nrm += __shfl_xor(nrm, 1, 64); nrm += __shfl_xor(nrm, 2, 64); nrm += __shfl_xor(nrm, 4, 64);
    bdot += __shfl_xor(bdot, 1, 64); bdot += __shfl_xor(bdot, 2, 64); bdot += __shfl_xor(bdot, 4, 64);
    const float rn = 1.f / fmaxf(sqrtf(nrm), 1e-12f);
    float o_r[8], o_k[8], o_b[8], o_c[8], bo[8];
#pragma unroll
    for (int i = 0; i < 8; ++i) {
      const int j = j0 + i;
      const float cum = FS(2)[t * 65 + j], dl = FS(4)[t * 65 + j];
      const float eg = __expf(cum), egi = __expf(-cum), egp = __expf(cum - dl);
      const float kk = kkv[i] * rn;
      const float g = gc[j];
      o_r[i] = rv[i] * eg; o_k[i] = kf[i] * egi; o_b[i] = kk * av[i] * egi; o_c[i] = kk * egp;
      CT[j * 72 + t] = f2bf(o_c[i]);
      KHT[j * 72 + t] = f2bf(o_k[i] * g);
      FS(1)[t * 65 + j] = o_b[i] * g;
      bo[i] = bdot * bf2f(VT[j * 72 + t]);
    }
    *(uint4*)(Rn + t * 72 + j0) = pack8(o_r);
    *(uint4*)(Kn + t * 72 + j0) = pack8(o_k);
    *(uint4*)(Bn + t * 72 + j0) = pack8(o_b);
    *(uint4*)(Cn + t * 72 + j0) = pack8(o_c);
    u16* bop = (u16*)(p.ws + WS_BO) + (size_t)item * 4096;
    *(uint4*)(bop + t * 64 + j0) = pack8(bo);
  }
  __syncthreads();
  f32x16 akr;
#pragma unroll
  for (int i = 0; i < 16; ++i) akr[i] = 0.f;
  if (grp == 0) {
    f32x16 ab, abr;
#pragma unroll
    for (int i = 0; i < 16; ++i) { ab[i] = 0.f; abr[i] = 0.f; }
    mm_tile(Bn, 72, Cn, 72, mt, nt, r, hf, 4, ab);
    mm_tile(Bn, 72, Rn, 72, mt, nt, r, hf, 4, abr);
    const int t = nt * 32 + r;
#pragma unroll
    for (int reg = 0; reg < 16; ++reg) {
      const int i = mt * 32 + ROWOFF(reg, hf);
      FS(4)[i * 65 + t] = (i < t) ? ab[reg] : 0.f;
      FS(0)[i * 65 + t] = (i <= t) ? abr[reg] : 0.f;
    }
  } else {
    f32x16 akt;
#pragma unroll
    for (int i = 0; i < 16; ++i) akt[i] = 0.f;
    mm_tile(Cn, 72, Kn, 72, mt, nt, r, hf, 4, akt);
    {
      const int i = nt * 32 + r;
#pragma unroll
      for (int reg = 0; reg < 16; ++reg) { const int t = mt * 32 + ROWOFF(reg, hf); if (!(i < t)) akt[reg] = 0.f; }
    }
    store_T(AK, 72, mt, nt, r, hf, akt);
    mm_tile(Kn, 72, Rn, 72, mt, nt, r, hf, 4, akr);
    {
      const int t = nt * 32 + r;
#pragma unroll
      for (int reg = 0; reg < 16; ++reg) { const int i = mt * 32 + ROWOFF(reg, hf); if (!(i <= t)) akr[reg] = 0.f; }
    }
  }
  __syncthreads();
  if (tid < 128) {
    float* X_ = (tid < 64) ? FS(0) : FS(1);
    const int col = tid & 63;
    tri32(FS(4) + 32 * 65 + 32, X_ + 32 * 65 + col);
  }
  __syncthreads();
  {
    const int c = tid & 127, ig = tid >> 7;
    float* X_ = (c < 64) ? FS(0) : FS(1);
    const int col = c & 63;
    float a[8];
#pragma unroll
    for (int u = 0; u < 8; ++u) a[u] = 0.f;
#pragma unroll 4
    for (int t = 32; t < 64; ++t) {
      const float xv = X_[t * 65 + col];
#pragma unroll
      for (int u = 0; u < 8; ++u) a[u] += FS(4)[(ig * 8 + u) * 65 + t] * xv;
    }
#pragma unroll
    for (int u = 0; u < 8; ++u) X_[(ig * 8 + u) * 65 + col] -= a[u];
  }
  __syncthreads();
  if (tid < 128) {
    float* X_ = (tid < 64) ? FS(0) : FS(1);
    const int col = tid & 63;
    tri32(FS(4), X_ + col);
  }
  __syncthreads();
  {
    const int c = tid >> 2, q = tid & 3;
    const float* X_ = (c < 64) ? FS(0) : FS(1);
    const int col = c & 63;
    float o0[8], o1[8];
#pragma unroll
    for (int u = 0; u < 8; ++u) { o0[u] = -X_[(q * 16 + u) * 65 + col]; o1[u] = -X_[(q * 16 + 8 + u) * 65 + col]; }
    u16* dst = NTm + c * 72 + q * 16;
    *(uint4*)dst = pack8(o0);
    *(uint4*)(dst + 8) = pack8(o1);
  }
  __syncthreads();
  if (grp == 1) {
    mm_tile(AK, 72, NTm, 72, mt, nt, r, hf, 4, akr);
    store_T(MT, 72, mt, nt, r, hf, akr);
  } else {
    f32x16 d2;
#pragma unroll
    for (int i = 0; i < 16; ++i) d2[i] = 0.f;
    mm_tile(AK, 72, NTm + 64 * 72, 72, mt, nt, r, hf, 4, d2);
#pragma unroll
    for (int g = 0; g < 4; ++g) {
      const int idx = (nt * 32 + r) * 72 + mt * 32 + 8 * g + 4 * hf;
      const uint2 kh = *(const uint2*)(KHT + idx);
      uint2 o;
      o.x = pack2(d2[4 * g] + __uint_as_float(kh.x << 16), d2[4 * g + 1] + __uint_as_float(kh.x & 0xFFFF0000u));
      o.y = pack2(d2[4 * g + 2] + __uint_as_float(kh.y << 16), d2[4 * g + 3] + __uint_as_float(kh.y & 0xFFFF0000u));
      *(uint2*)(KQT + idx) = o;
    }
  }
  __syncthreads();
  if (grp == 0) {
    f32x16 w2, yl;
#pragma unroll
    for (int i = 0; i < 16; ++i) { w2[i] = 0.f; yl[i] = 0.f; }
    mm_tile(NTm, 72, CT, 72, mt, nt, r, hf, 4, w2);
    mm_tile(MT, 72, VT, 72, mt, nt, r, hf, 4, yl);
    u16* W2p = (u16*)(p.ws + WS_W2) + (size_t)item * 4096;
    u16* YLp = (u16*)(p.ws + WS_YL) + (size_t)item * 4096;
#pragma unroll
    for (int reg = 0; reg < 16; ++reg) {
      const int t = mt * 32 + ROWOFF(reg, hf), n = nt * 32 + r;
      W2p[t * 64 + n] = f2bf(w2[reg] + bf2f(Rn[t * 72 + n]));
      YLp[t * 64 + n] = f2bf(yl[reg]);
    }
  } else {
    f32x16 pp, qt;
#pragma unroll
    for (int i = 0; i < 16; ++i) { pp[i] = 0.f; qt[i] = 0.f; }
    mm_tile(CT, 72, NTm + 64 * 72, 72, mt, nt, r, hf, 4, pp);
    mm_tile(KQT, 72, VT, 72, mt, nt, r, hf, 4, qt);
    uint4* Pf = (uint4*)((u16*)(p.ws + WS_PP) + (size_t)item * 4096);
    float* Qf = (float*)(p.ws + WS_Q) + (size_t)item * 4096;
#pragma unroll
    for (int s2 = 0; s2 < 2; ++s2) {
      uint4 o;
      o.x = pack2(pp[s2 * 8 + 0], pp[s2 * 8 + 1]); o.y = pack2(pp[s2 * 8 + 2], pp[s2 * 8 + 3]);
      o.z = pack2(pp[s2 * 8 + 4], pp[s2 * 8 + 5]); o.w = pack2(pp[s2 * 8 + 6], pp[s2 * 8 + 7]);
      Pf[(nt * 4 + mt * 2 + s2) * 64 + lane] = o;
    }
#pragma unroll
    for (int reg = 0; reg < 16; ++reg) Qf[((nt * 2 + mt) * 16 + reg) * 64 + lane] = qt[reg];
  }
}

__device__ __forceinline__ void rwkv_scan(const Params& p, int l, int bh, float* ldsf) {
  const int tid = opq(threadIdx.x), lane = tid & 63, wave = tid >> 6;
  __syncthreads();
  {
    const int b_ = bh >> 3, h_ = bh & 7;
    const float* G0 = (const float*)(p.ws + WS_GC);
    for (int e = tid; e < 8192; e += NT) ldsf[e] = G0[(size_t)((b_ * 128 + (e >> 6)) * 8 + h_) * 64 + (e & 63)];
  }
  __syncthreads();
  if (wave >= 2) return;
  const int vt = wave, hf = lane >> 5;
  const int b = bh >> 3, h = bh & 7;
  f32x16 S[2];
#pragma unroll
  for (int i = 0; i < 16; ++i) { S[0][i] = 0.f; S[1][i] = 0.f; }
  float nQ[2][16];
  auto issueQ = [&](int cc) {
    const size_t id = (size_t)((b * 128 + cc) * 8 + h);
    const float* Qf = (const float*)(p.ws + WS_Q) + id * 4096;
#pragma unroll
    for (int kt = 0; kt < 2; ++kt)
#pragma unroll
      for (int reg = 0; reg < 16; ++reg) nQ[kt][reg] = Qf[((vt * 2 + kt) * 16 + reg) * 64 + lane];
  };
  issueQ(0);
#pragma unroll 1
  for (int cc = 0; cc < 128; ++cc) {
    const size_t id = (size_t)((b * 128 + cc) * 8 + h);
    float* Qf = (float*)(p.ws + WS_Q) + id * 4096;
    const uint4* Pf = (const uint4*)((const u16*)(p.ws + WS_PP) + id * 4096);
    uint4 A[2][4];
#pragma unroll
    for (int kt = 0; kt < 2; ++kt)
#pragma unroll
      for (int s_ = 0; s_ < 4; ++s_) A[kt][s_] = Pf[(kt * 4 + s_) * 64 + lane];
    f32x16 acc[2];
#pragma unroll
    for (int kt = 0; kt < 2; ++kt)
#pragma unroll
      for (int reg = 0; reg < 16; ++reg) acc[kt][reg] = S[kt][reg] * ldsf[cc * 64 + kt * 32 + ROWOFF(reg, hf)] + nQ[kt][reg];
#pragma unroll
    for (int kt = 0; kt < 2; ++kt)
#pragma unroll
      for (int reg = 0; reg < 16; ++reg) Qf[((vt * 2 + kt) * 16 + reg) * 64 + lane] = S[kt][reg];
    uint4 Bh[4], Bl[4];
#pragma unroll
    for (int s_ = 0; s_ < 4; ++s_) {
      const int kt = s_ >> 1, s2 = s_ & 1;
      unsigned hw[4], lw[4];
#pragma unroll
      for (int j = 0; j < 4; ++j) {
        const float x0 = S[kt][s2 * 8 + 2 * j], x1 = S[kt][s2 * 8 + 2 * j + 1];
        const u16 h0 = f2bf(x0), h1 = f2bf(x1);
        hw[j] = (unsigned)h0 | ((unsigned)h1 << 16);
        lw[j] = pack2(x0 - bf2f(h0), x1 - bf2f(h1));
      }
      Bh[s_] = make_uint4(hw[0], hw[1], hw[2], hw[3]);
      Bl[s_] = make_uint4(lw[0], lw[1], lw[2], lw[3]);
    }
    __builtin_amdgcn_sched_barrier(0);
    if (cc + 1 < 128) issueQ(cc + 1);
    __builtin_amdgcn_sched_barrier(0);
#pragma unroll
    for (int s_ = 0; s_ < 4; ++s_) {
      union { uint4 u; bf16x8 v; } bh_, bl_;
      bh_.u = Bh[s_]; bl_.u = Bl[s_];
#pragma unroll
      for (int kt2 = 0; kt2 < 2; ++kt2) {
        union { uint4 u; bf16x8 v; } af; af.u = A[kt2][s_];
        acc[kt2] = __builtin_amdgcn_mfma_f32_32x32x16_bf16(af.v, bh_.v, acc[kt2], 0, 0, 0);
        acc[kt2] = __builtin_amdgcn_mfma_f32_32x32x16_bf16(af.v, bl_.v, acc[kt2], 0, 0, 0);
      }
    }
    __builtin_amdgcn_sched_barrier(0);
    S[0] = acc[0]; S[1] = acc[1];
  }
  {
    float* o = p.out + O_PWKV + ((size_t)((l * 2 + b) * 8 + h) * 64 + vt * 32 + (lane & 31)) * 64;
#pragma unroll
    for (int kt = 0; kt < 2; ++kt)
#pragma unroll
      for (int reg = 0; reg < 16; ++reg) o[kt * 32 + ROWOFF(reg, hf)] = S[kt][reg];
  }
}

__device__ __forceinline__ void rwkv_out(const Params& p, int l, int item, float* ldsf) {
  const int tid = opq(threadIdx.x), lane = tid & 63, wave = tid >> 6;
  const int h = item & 7, cidx = item >> 3;
  float* Sl = ldsf; float* Wl = ldsf + 4160;
  const float* Sg = (const float*)(p.ws + WS_Q) + (size_t)item * 4096;
  const u16* W2 = (const u16*)(p.ws + WS_W2) + (size_t)item * 4096;
  const u16* YL = (const u16*)(p.ws + WS_YL) + (size_t)item * 4096;
  const u16* BO = (const u16*)(p.ws + WS_BO) + (size_t)item * 4096;
  const u16* GA = (const u16*)(p.ws + WS_GA) + (size_t)item * 4096;
  u16* z = (u16*)(p.ws + WS_Z);
  __syncthreads();
  {
    const int row = tid >> 3, c = (tid & 7) * 8;
#pragma unroll
    for (int i = 0; i < 8; ++i) {
      const int idx = i * 512 + tid;
      const int ln = idx & 63, reg = (idx >> 6) & 15, kt = (idx >> 10) & 1, vt = idx >> 11;
      Sl[(vt * 32 + (ln & 31)) * 65 + kt * 32 + ROWOFF(reg, ln >> 5)] = Sg[idx];
    }
    float w[8];
    unpack8(*(const uint4*)(W2 + row * 64 + c), w);
    float* e = Wl + row * 65 + c;
#pragma unroll
    for (int i = 0; i < 8; ++i) e[i] = w[i];
  }
  __syncthreads();
  float y[8];
#pragma unroll
  for (int q = 0; q < 8; ++q) y[q] = bf2f(YL[(wave * 8 + q) * 64 + lane]);
#pragma unroll 2
  for (int k = 0; k < 64; ++k) {
    const float s = Sl[lane * 65 + k];
#pragma unroll
    for (int q = 0; q < 8; ++q) y[q] += s * Wl[(wave * 8 + q) * 65 + k];
  }
  const float lng = p.in[18][l * 512 + h * 64 + lane], lnb = p.in[19][l * 512 + h * 64 + lane];
#pragma unroll
  for (int q = 0; q < 8; ++q) {
    const int t = wave * 8 + q;
    const float mean = wave_sum(y[q]) * (1.f / 64.f);
    const float d = y[q] - mean;
    const float var = wave_sum(d * d) * (1.f / 64.f);
    const float yn = d * rsqrtf(var + 64e-5f) * lng + lnb;
    const float o = (yn + bf2f(BO[t * 64 + lane])) * bf2f(GA[t * 64 + lane]);
    z[(size_t)(cidx * 64 + t) * ZLD + h * 64 + lane] = f2bf(o);
  }
}

__device__ __forceinline__ void attn_prompt(const Params& p, int l, int item, u16* lds) {
  const int tid = opq(threadIdx.x), lane = tid & 63, wave = tid >> 6;
  const int r = lane & 31, h = lane >> 5;
  const int kvh = item & 1, n = (item >> 1) & 63, b = item >> 7;
  u16* z = (u16*)(p.ws + WS_Z);
  u16* Ks = lds;
  u16* Vt = lds + 256 * 72;
  __syncthreads();
  {
    const int key = tid >> 1, half = tid & 1;
    const int t = (n - 1) * 128 + key;
    uint4 kv[4], vv[4];
    if (t >= 0) {
      const u16* kp = z + (size_t)(b * 8192 + t) * ZLD + 2304 + kvh * 64 + half * 32;
      const u16* vp = z + (size_t)(b * 8192 + t) * ZLD + 2432 + kvh * 64 + half * 32;
#pragma unroll
      for (int i = 0; i < 4; ++i) { kv[i] = *(const uint4*)(kp + i * 8); vv[i] = *(const uint4*)(vp + i * 8); }
    } else {
#pragma unroll
      for (int i = 0; i < 4; ++i) { kv[i] = make_uint4(0, 0, 0, 0); vv[i] = make_uint4(0, 0, 0, 0); }
    }
#pragma unroll
    for (int i = 0; i < 4; ++i) {
      *(uint4*)(Ks + key * 72 + half * 32 + i * 8) = kv[i];
      const unsigned w[4] = {vv[i].x, vv[i].y, vv[i].z, vv[i].w};
#pragma unroll
      for (int q = 0; q < 4; ++q) {
        const int d = half * 32 + i * 8 + q * 2;
        Vt[d * 264 + key] = (u16)(w[q] & 0xFFFFu);
        Vt[(d + 1) * 264 + key] = (u16)(w[q] >> 16);
      }
    }
  }
  __syncthreads();
#pragma unroll 1
  for (int uu = 0; uu < 2; ++uu) {
    const int u = wave * 2 + uu;
    const int hq = kvh * 4 + (u >> 2), qg = u & 3;
    const int qrow = b * 8192 + n * 128 + qg * 32 + r;
    u16* qp = z + (size_t)qrow * ZLD + 1792 + hq * 64;
    bf16x8 qf[4];
#pragma unroll
    for (int s = 0; s < 4; ++s) qf[s] = *(const bf16x8*)(qp + s * 16 + h * 8);
    f32x16 sc[5];
#pragma unroll
    for (int i5 = 0; i5 < 5; ++i5) {
#pragma unroll
      for (int i = 0; i < 16; ++i) sc[i5][i] = 0.f;
      const int kt = qg + i5;
#pragma unroll
      for (int s = 0; s < 4; ++s) {
        bf16x8 kf = *(const bf16x8*)(Ks + (kt * 32 + r) * 72 + s * 16 + h * 8);
        sc[i5] = __builtin_amdgcn_mfma_f32_32x32x16_bf16(kf, qf[s], sc[i5], 0, 0, 0);
      }
      __builtin_amdgcn_sched_barrier(0);
    }
    const int qi = qg * 32 + r;
    const float sink = p.in[20][l * 8 + hq];
    float mx = -1e30f;
#pragma unroll
    for (int i5 = 0; i5 < 5; ++i5)
#pragma unroll
      for (int reg = 0; reg < 16; ++reg) {
        const int j = (qg + i5) * 32 + ROWOFF(reg, h);
        const bool ok = (j > qi) && (j <= qi + 128) && (n > 0 || j >= 128);
        const float s = ok ? sc[i5][reg] * 0.125f : -1e30f;
        sc[i5][reg] = s;
        mx = fmaxf(mx, s);
      }
    mx = fmaxf(mx, __shfl_xor(mx, 32, 64));
    mx = fmaxf(mx, sink);
    float sum = 0.f;
#pragma unroll
    for (int i5 = 0; i5 < 5; ++i5)
#pragma unroll
      for (int reg = 0; reg < 16; ++reg) { const float e = __expf(sc[i5][reg] - mx); sc[i5][reg] = e; sum += e; }
    sum += __shfl_xor(sum, 32, 64);
    const float rden = 1.f / (sum + __expf(sink - mx));
    f32x16 oacc[2];
#pragma unroll
    for (int i = 0; i < 16; ++i) { oacc[0][i] = 0.f; oacc[1][i] = 0.f; }
#pragma unroll
    for (int i5 = 0; i5 < 5; ++i5) {
      const int kt = qg + i5;
#pragma unroll
      for (int s2 = 0; s2 < 2; ++s2) {
        bf16x8 pf;
#pragma unroll
        for (int j = 0; j < 8; ++j) pf[j] = (short)f2bf(sc[i5][s2 * 8 + j] * rden);
#pragma unroll
        for (int dt = 0; dt < 2; ++dt) {
          const u16* vp = Vt + (dt * 32 + r) * 264 + kt * 32 + s2 * 16 + h * 4;
          const uint2 lo = *(const uint2*)vp, hi = *(const uint2*)(vp + 8);
          union { uint4 u; bf16x8 v; } cv;
          cv.u = make_uint4(lo.x, lo.y, hi.x, hi.y);
          oacc[dt] = __builtin_amdgcn_mfma_f32_32x32x16_bf16(cv.v, pf, oacc[dt], 0, 0, 0);
        }
        __builtin_amdgcn_sched_barrier(0);
      }
    }
#pragma unroll
    for (int dt = 0; dt < 2; ++dt)
#pragma unroll
      for (int g4 = 0; g4 < 4; ++g4) {
        const int d = dt * 32 + 8 * g4 + 4 * h;
        uint2 o;
        o.x = pack2(oacc[dt][g4 * 4 + 0], oacc[dt][g4 * 4 + 1]);
        o.y = pack2(oacc[dt][g4 * 4 + 2], oacc[dt][g4 * 4 + 3]);
        *(uint2*)(qp + d) = o;
      }
  }
}

__device__ __forceinline__ void attn_sample(const Params& p, int l, int item, float* ldsf) {
  const int tid = opq(threadIdx.x);
  const int kvh = item & 1, b = item >> 1;
  u16* z = (u16*)(p.ws + WS_Z);
  float* Kl = ldsf;
  float* Vl = ldsf + 132 * 65;
  float* Ql = Vl + 132 * 65;
  float* Pl = Ql + 16 * 64;
  __syncthreads();
  for (int e = tid; e < 132 * 8; e += NT) {
    const int j = e >> 3, c = (e & 7) * 8;
    float k[8], v[8];
    if (j < 128) {
      const float* kp = p.in[4] + ((size_t)((l * 128 + b) * 128 + j) * 2 + kvh) * 64 + c;
      const float* vp = p.in[5] + ((size_t)((l * 128 + b) * 128 + j) * 2 + kvh) * 64 + c;
      float4 a = *(const float4*)kp, a2 = *(const float4*)(kp + 4);
      float4 c1 = *(const float4*)vp, c2 = *(const float4*)(vp + 4);
      k[0] = a.x; k[1] = a.y; k[2] = a.z; k[3] = a.w; k[4] = a2.x; k[5] = a2.y; k[6] = a2.z; k[7] = a2.w;
      v[0] = c1.x; v[1] = c1.y; v[2] = c1.z; v[3] = c1.w; v[4] = c2.x; v[5] = c2.y; v[6] = c2.z; v[7] = c2.w;
    } else {
      const size_t row = M_P + b * 4 + (j - 128);
      unpack8(*(const uint4*)(z + row * ZLD + 2304 + kvh * 64 + c), k);
      unpack8(*(const uint4*)(z + row * ZLD + 2432 + kvh * 64 + c), v);
    }
#pragma unroll
    for (int i = 0; i < 8; ++i) { Kl[j * 65 + c + i] = k[i]; Vl[j * 65 + c + i] = v[i]; }
    if (j >= 4) {
      float* ok = p.out + O_SK + ((size_t)((l * 128 + b) * 128 + (j - 4)) * 2 + kvh) * 64 + c;
      float* ov = p.out + O_SV + ((size_t)((l * 128 + b) * 128 + (j - 4)) * 2 + kvh) * 64 + c;
      *(float4*)ok = make_float4(k[0], k[1], k[2], k[3]); *(float4*)(ok + 4) = make_float4(k[4], k[5], k[6], k[7]);
      *(float4*)ov = make_float4(v[0], v[1], v[2], v[3]); *(float4*)(ov + 4) = make_float4(v[4], v[5], v[6], v[7]);
    }
  }
  if (tid < 128) {
    const int row = tid >> 3, c = (tid & 7) * 8;
    const int hl = row >> 2, t = row & 3;
    float q[8];
    unpack8(*(const uint4*)(z + (size_t)(M_P + b * 4 + t) * ZLD + 1792 + (kvh * 4 + hl) * 64 + c), q);
#pragma unroll
    for (int i = 0; i < 8; ++i) Ql[row * 64 + c + i] = q[i];
  }
  __syncthreads();
  const int row = tid >> 5, jl = tid & 31;
  const int t = row & 3, hq = kvh * 4 + (row >> 2);
  float sc[5];
  float mx = -1e30f;
#pragma unroll
  for (int jj = 0; jj < 5; ++jj) {
    const int j = jl + 32 * jj;
    float s = -1e30f;
    if (j < 132 && j > t && j <= t + 128) {
      float a = 0.f;
#pragma unroll 8
      for (int d = 0; d < 64; ++d) a += Ql[row * 64 + d] * Kl[j * 65 + d];
      s = a * 0.125f;
    }
    sc[jj] = s; mx = fmaxf(mx, s);
    __builtin_amdgcn_sched_barrier(0);
  }
#pragma unroll
  for (int o = 16; o >= 1; o >>= 1) mx = fmaxf(mx, __shfl_xor(mx, o, 64));
  const float sink = p.in[20][l * 8 + hq];
  mx = fmaxf(mx, sink);
  float sum = 0.f;
#pragma unroll
  for (int jj = 0; jj < 5; ++jj) { sc[jj] = __expf(sc[jj] - mx); sum += sc[jj]; }
#pragma unroll
  for (int o = 16; o >= 1; o >>= 1) sum += __shfl_xor(sum, o, 64);
  const float rden = 1.f / (sum + __expf(sink - mx));
#pragma unroll
  for (int jj = 0; jj < 5; ++jj) { const int j = jl + 32 * jj; if (j < 136) Pl[row * 136 + j] = sc[jj] * rden; }
  __syncthreads();
  {
    const int d = jl * 2;
    float o0 = 0.f, o1 = 0.f;
#pragma unroll 4
    for (int j = 0; j < 132; ++j) { const float pr = Pl[row * 136 + j]; o0 += pr * Vl[j * 65 + d]; o1 += pr * Vl[j * 65 + d + 1]; }
    *(unsigned*)(z + (size_t)(M_P + b * 4 + t) * ZLD + 1792 + hq * 64 + d) = pack2(o0, o1);
  }
}

__device__ __forceinline__ void phase_convgelu(const Params& p, int l) {
  u16* cu = (u16*)(p.ws + WS_CU);
  const float* cw = p.in[26] + (size_t)l * 3 * 2816;
  const float* cb = p.in[27] + (size_t)l * 2816;
  for (int it = blockIdx.x; it < 1056; it += gridDim.x) {
    const int tid = opq(threadIdx.x);
    if (tid >= 352) continue;
    const int j0 = tid * 8;
    float w0[8], w1[8], w2[8], bb[8];
#pragma unroll
    for (int i = 0; i < 8; ++i) { w0[i] = cw[j0 + i]; w1[i] = cw[2816 + j0 + i]; w2[i] = cw[5632 + j0 + i]; bb[i] = cb[j0 + i]; }
    float c1[8], c2[8];
    for (int rr = 0; rr < 16; ++rr) {
      const int row = it * 16 + rr;
      const bool prompt = row < M_P;
      int b, t;
      if (prompt) { b = row >> 13; t = row & 8191; } else { b = (row - M_P) >> 2; t = (row - M_P) & 3; }
      if (t == 0) {
        if (prompt) {
#pragma unroll
          for (int i = 0; i < 8; ++i) { c1[i] = 0.f; c2[i] = 0.f; }
        } else {
          const float* st = p.in[6] + (size_t)((l * 128 + b) * 2) * 2816 + j0;
#pragma unroll
          for (int i = 0; i < 8; ++i) { c2[i] = st[i]; c1[i] = st[2816 + i]; }
        }
      } else if (rr == 0) {
        unpack8(*(const uint4*)(cu + (size_t)(row - 1) * 5632 + j0), c1);
        if (t >= 2) unpack8(*(const uint4*)(cu + (size_t)(row - 2) * 5632 + j0), c2);
        else {
#pragma unroll
          for (int i = 0; i < 8; ++i) c2[i] = 0.f;
        }
      }
      float c0[8], up[8], a[8];
      unpack8(*(const uint4*)(cu + (size_t)row * 5632 + j0), c0);
      unpack8(*(const uint4*)(cu + (size_t)row * 5632 + 2816 + j0), up);
#pragma unroll
      for (int i = 0; i < 8; ++i) {
        const float cv = bb[i] + w0[i] * c2[i] + w1[i] * c1[i] + w2[i] * c0[i];
        const float ge = 0.5f * cv * (1.f + erff(cv * 0.7071067811865476f));
        a[i] = ge * up[i];
      }
      *(uint4*)(cu + (size_t)row * 5632 + 2816 + j0) = pack8(a);
      if (prompt && t >= 8190) {
        float* o = p.out + O_PCONV + (size_t)((l * 2 + b) * 2 + (t - 8190)) * 2816 + j0;
        *(float4*)o = make_float4(c0[0], c0[1], c0[2], c0[3]); *(float4*)(o + 4) = make_float4(c0[4], c0[5], c0[6], c0[7]);
      } else if (!prompt && t >= 2) {
        float* o = p.out + O_SCONV + (size_t)((l * 128 + b) * 2 + (t - 2)) * 2816 + j0;
        *(float4*)o = make_float4(c0[0], c0[1], c0[2], c0[3]); *(float4*)(o + 4) = make_float4(c0[4], c0[5], c0[6], c0[7]);
      }
#pragma unroll
      for (int i = 0; i < 8; ++i) { c2[i] = c1[i]; c1[i] = c0[i]; }
    }
  }
}

__device__ __forceinline__ void phase_final(const Params& p) {
  float* X = p.out;
  const float* g = p.in[29];
  for (int it = blockIdx.x; it < 2112; it += gridDim.x) {
    const int tid = opq(threadIdx.x);
    const int lane = tid & 63;
    const int row = it * 8 + (tid >> 6);
    float4 v[4];
    float ss = 0.f;
#pragma unroll
    for (int i = 0; i < 4; ++i) {
      v[i] = *(const float4*)(X + (size_t)row * 1024 + i * 256 + lane * 4);
      ss += v[i].x * v[i].x + v[i].y * v[i].y + v[i].z * v[i].z + v[i].w * v[i].w;
    }
    ss = wave_sum(ss);
    const float rs = rsqrtf(ss * (1.f / 1024.f) + 1e-6f);
#pragma unroll
    for (int i = 0; i < 4; ++i) {
      const float4 gg = *(const float4*)(g + i * 256 + lane * 4);
      *(float4*)(X + (size_t)row * 1024 + i * 256 + lane * 4) =
          make_float4(v[i].x * rs * gg.x, v[i].y * rs * gg.y, v[i].z * rs * gg.z, v[i].w * rs * gg.w);
    }
  }
}

#if COOP
#define PH_SYNC(idx) do { if ((idx) + 1 < ph_hi && (idx) >= ph_lo) cg::this_grid().sync(); } while (0)
#else
#define PH_SYNC(idx) do { } while (0)
#endif
#define PH_ON(idx, bit) (((KMASK >> (bit)) & 1) && ph_lo <= (idx) && (idx) < ph_hi)

__device__ __forceinline__ Params load_params() {
  auto kp0 = __builtin_amdgcn_kernarg_segment_ptr();
  asm volatile("" : "+s"(kp0));
  auto kq = (const __constant__ unsigned long long*)kp0;
  Params p;
#pragma unroll
  for (int i = 0; i < 30; ++i) p.in[i] = (const float*)kq[i];
  p.out = (float*)kq[30];
  p.ws = (unsigned char*)kq[31];
  p.ph_lo = 0; p.ph_hi = 0;
  return p;
}

template <int KMASK, int l>
__device__ __forceinline__ void layer_phases(int ph_lo, int ph_hi, unsigned char* lds_raw) {
  float* ldsf = (float*)lds_raw;
  u16* ldsh = (u16*)lds_raw;
  const int base = l * 12;
  if (PH_ON(base + 0, 0)) { const Params p = load_params(); phase_prep(p, l, 0, ldsf); }
  PH_SYNC(base + 0);
  if (PH_ON(base + 1, 1)) {
    const Params p = load_params();
    EpiInproj E; E.z = (u16*)(p.ws + WS_Z); E.out = p.out; E.l = l;
    run_gemm(lds_raw, (const u16*)(p.ws + WS_H), 1024, (const u16*)(p.ws + WS_WT) + WT_IN, 2560, 1024, E);
  }
  PH_SYNC(base + 1);
  if (PH_ON(base + 2, 2)) {
    const Params p = load_params();
    if (P2SEL & 1) for (int it = blockIdx.x; it < 64; it += gridDim.x) rwkv_item(p, l, 2048 + it, ldsf);
    if (P2SEL & 2) for (int it = blockIdx.x; it < 264; it += gridDim.x) rope_item(p, l, it);
    if (P2SEL & 4) {
      const Params p2 = load_params();
      for (int it = gridDim.x - 1 - blockIdx.x; it < 2048; it += gridDim.x) rwkv_item2(p2, l, it, ldsf);
    }
  }
  PH_SYNC(base + 2);
  if (PH_ON(base + 3, 3)) {
    const Params p = load_params();
    if (blockIdx.x < 16) rwkv_scan(p, l, blockIdx.x, ldsf);
    else {
      for (int it = blockIdx.x - 16; it < 512; it += gridDim.x - 16) {
        if (it < 256) attn_prompt(p, l, it, ldsh); else attn_sample(p, l, it - 256, ldsf);
      }
    }
  }
  PH_SYNC(base + 3);
  if (PH_ON(base + 4, 4)) {
    const Params p = load_params();
    for (int it = blockIdx.x; it < 2048; it += gridDim.x) rwkv_out(p, l, it, ldsf);
  }
  PH_SYNC(base + 4);
  if (PH_ON(base + 5, 5)) {
    const Params p = load_params();
    EpiStoreBf16 E1; E1.O = (u16*)(p.ws + WS_T1); E1.ldc = 1024;
    run_gemm(lds_raw, (const u16*)(p.ws + WS_Z), ZLD, (const u16*)(p.ws + WS_WT) + WT_BRA, 1024, 512, E1);
    EpiStoreBf16 E2; E2.O = (u16*)(p.ws + WS_T2); E2.ldc = 1024;
    run_gemm(lds_raw, (const u16*)(p.ws + WS_Z) + 1792, ZLD, (const u16*)(p.ws + WS_WT) + WT_BRB, 1024, 512, E2);
  }
  PH_SYNC(base + 5);
  if (PH_ON(base + 6, 6)) {
    const Params p = load_params();
    EpiMerge E; E.t1 = (const u16*)(p.ws + WS_T1); E.t2 = (const u16*)(p.ws + WS_T2); E.mg = (u16*)(p.ws + WS_MG);
    run_gemm(lds_raw, (const u16*)(p.ws + WS_H), 1024, (const u16*)(p.ws + WS_WT) + WT_G, 2048, 1024, E);
  }
  PH_SYNC(base + 6);
  if (PH_ON(base + 7, 7)) {
    const Params p = load_params();
    EpiResid E; E.X = p.out;
    run_gemm(lds_raw, (const u16*)(p.ws + WS_MG), 1024, (const u16*)(p.ws + WS_WT) + WT_OUT, 1024, 1024, E);
  }
  PH_SYNC(base + 7);
  if (PH_ON(base + 8, 8)) { const Params p = load_params(); phase_prep(p, l, 1, ldsf); }
  PH_SYNC(base + 8);
  if (PH_ON(base + 9, 9)) {
    const Params p = load_params();
    EpiFfnIn E; E.cu = (u16*)(p.ws + WS_CU);
    run_gemm(lds_raw, (const u16*)(p.ws + WS_H), 1024, (const u16*)(p.ws + WS_WTF) + WT_FIN, 5632, 1024, E);
  }
  PH_SYNC(base + 9);
  if (PH_ON(base + 10, 10)) { const Params p = load_params(); phase_convgelu(p, l); }
  PH_SYNC(base + 10);
  if (PH_ON(base + 11, 11)) {
    const Params p = load_params();
    EpiResid E; E.X = p.out;
    run_gemm(lds_raw, (const u16*)(p.ws + WS_CU) + 2816, 5632, (const u16*)(p.ws + WS_WTF) + WT_FDN, 1024, 2816, E);
  }
  PH_SYNC(base + 11);
}

template <int KMASK>
__global__ void __launch_bounds__(NT) fwd_kernel(Params pin) {
  extern __shared__ __attribute__((aligned(16))) unsigned char lds_raw[];
  const int ph_lo = pin.ph_lo, ph_hi = pin.ph_hi;
  layer_phases<KMASK, 0>(ph_lo, ph_hi, lds_raw);
  layer_phases<KMASK, 1>(ph_lo, ph_hi, lds_raw);
  if (PH_ON(NPH - 1, 12)) { const Params p = load_params(); phase_final(p); }
}

extern "C" void kernel_launch(void* const* d_in, const int* in_sizes, int n_in, void* d_out, int out_size, void* d_ws,
                              size_t ws_size, hipStream_t stream) {
  static int grid = 0;
  if (grid == 0) {
    int dev = 0, cus = 0;
    (void)hipGetDevice(&dev);
    (void)hipDeviceGetAttribute(&cus, hipDeviceAttributeMultiprocessorCount, dev);
    grid = cus > 0 ? cus : 256;
    (void)hipFuncSetAttribute((const void*)fwd_kernel<PHMASK>, hipFuncAttributeMaxDynamicSharedMemorySize, LDS_BYTES);
    (void)hipGetLastError();
  }
  Params p{};
  for (int i = 0; i < 30; ++i) p.in[i] = (const float*)d_in[i];
  p.out = (float*)d_out;
  p.ws = (unsigned char*)d_ws;
#if COOP
  p.ph_lo = 0; p.ph_hi = NPH;
  void* args[] = {&p};
  hipError_t e = hipLaunchCooperativeKernel((const void*)fwd_kernel<PHMASK>, dim3(grid), dim3(NT), args, LDS_BYTES, stream);
  if (e != hipSuccess) fprintf(stderr, "cooperative launch failed: %s (grid %d)\n", hipGetErrorString(e), grid);
#else
  for (int ph = 0; ph < NPH; ++ph) {
    p.ph_lo = ph; p.ph_hi = ph + 1;
    hipLaunchKernelGGL(fwd_kernel<PHMASK>, dim3(grid), dim3(NT), LDS_BYTES, stream, p);
  }
#endif
}
```

```cpp
#include <hip/hip_runtime.h>
#include <hip/hip_bf16.h>
#include <hip/hip_cooperative_groups.h>
#include <cstdio>
namespace cg = cooperative_groups;

typedef __attribute__((ext_vector_type(8))) short bf16x8;
typedef __attribute__((ext_vector_type(16))) float f32x16;
typedef unsigned short u16;

#ifndef PHMASK
#define PHMASK 0x1FFF
#endif
#ifndef T3
#define T3 7
#endif
#ifndef P2SEL
#define P2SEL 7
#endif
#ifndef RPT_MASK
#define RPT_MASK 0
#endif
#ifndef RPT_N
#define RPT_N 1
#endif
#define RPT(bit) for (int rp_ = 0; rp_ < (((RPT_MASK >> (bit)) & 1) ? 1 + RPT_N : 1); ++rp_)
#define RPT_CNT(bit) (((RPT_MASK >> (bit)) & 1) ? 1 + RPT_N : 1)
#define DRY(bit) (opq(rp_) + 1 < RPT_CNT(bit))
#ifndef COOP
#define COOP 1
#endif

#define NT 512
#define M_TOT 16896
#define M_P 16384
#define ZLD 2560
#define NPH 25

#define WS_WT   0ull
#define WS_H    13631488ull
#define WS_Z    48234496ull
#define WS_R    134742016ull
#define WS_PP   (WS_R)
#define WS_GC   (WS_R + 16777216ull)
#define WS_Q    (WS_R + 17301504ull)
#define WS_W2   (WS_R + 50855936ull)
#define WS_YL   (WS_R + 67633152ull)
#define WS_BO   (WS_R + 84410368ull)
#define WS_GA   (WS_R + 101187584ull)
#define WS_T1   (WS_R)
#define WS_T2   (WS_R + 34603008ull)
#define WS_MG   (WS_R + 69206016ull)
#define WS_WTF  (WS_Z)
#define WS_CU   (WS_Z + 17301504ull)
#define WT_IN  0
#define WT_G   2621440
#define WT_BRA 4718592
#define WT_BRB 5242880
#define WT_OUT 5767168
#define WT_FIN 0
#define WT_FDN 5767168
#define O_PSHIFT 17301504
#define O_PWKV   17308672
#define O_PK     17439744
#define O_PV     17505280
#define O_PCONV  17570816
#define O_SSHIFT 17593344
#define O_SWKV   18052096
#define O_SK     26440704
#define O_SV     30635008
#define O_SCONV  34829312

#define LDS_BYTES 151552

struct Params {
  const float* in[30];
  float* out;
  unsigned char* ws;
  int ph_lo, ph_hi;
};

typedef float f2v_ __attribute__((ext_vector_type(2)));
typedef __bf16 b2v_ __attribute__((ext_vector_type(2)));
__device__ __forceinline__ unsigned pack2(float a, float b) { f2v_ v = {a, b}; b2v_ r = __builtin_convertvector(v, b2v_); return __builtin_bit_cast(unsigned, r); }
__device__ __forceinline__ u16 f2bf(float f) { return (u16)(pack2(f, f) & 0xFFFFu); }
__device__ __forceinline__ float bf2f(u16 h) { return __uint_as_float(((unsigned)h) << 16); }
__device__ __forceinline__ float sigm(float x) { return __builtin_amdgcn_rcpf(1.f + __expf(-x)); }
__device__ __forceinline__ void unpack8(uint4 u, float* o) {
  o[0] = __uint_as_float(u.x << 16); o[1] = __uint_as_float(u.x & 0xFFFF0000u);
  o[2] = __uint_as_float(u.y << 16); o[3] = __uint_as_float(u.y & 0xFFFF0000u);
  o[4] = __uint_as_float(u.z << 16); o[5] = __uint_as_float(u.z & 0xFFFF0000u);
  o[6] = __uint_as_float(u.w << 16); o[7] = __uint_as_float(u.w & 0xFFFF0000u);
}
__device__ __forceinline__ uint4 pack8(const float* f) {
  uint4 u; u.x = pack2(f[0], f[1]); u.y = pack2(f[2], f[3]); u.z = pack2(f[4], f[5]); u.w = pack2(f[6], f[7]); return u;
}
__device__ __forceinline__ float gelu_fast(float v) {
  const float av = fabsf(v), d = av * 0.2316418882f + 1.0f;
  const float t = __builtin_amdgcn_rcpf(d);
  float q = t * 0.5307027145f + (-0.7265760135f); q = q * t + 0.7107068705f; q = q * t + (-0.142248368f); q = q * t + 0.127414796f; q = q * t;
  const float e = __builtin_amdgcn_exp2f((v * v) * (-0.72134752044f));
  const float m = v * (q * e);
  return v < 0.f ? m : v - m;
}
__device__ __forceinline__ int opq(int x) { asm volatile("" : "+v"(x)); return x; }
__device__ __forceinline__ float wave_sum(float x) {
#pragma unroll
  for (int o = 32; o >= 1; o >>= 1) x += __shfl_xor(x, o, 64);
  return x;
}

namespace pg8 {
#define PG8_LAS __attribute__((address_space(3)))
typedef unsigned short bf16_t;
typedef short bf16x8 __attribute__((ext_vector_type(8)));
typedef float f32x4 __attribute__((ext_vector_type(4)));
typedef unsigned u32x4 __attribute__((ext_vector_type(4)));
constexpr int BM = 256, BK = 64, HALF = 128, HTB = HALF * BK * 2  , STAGE_BYTES = 8 * HTB, NXCD = 8, WGM = 8;
__host__ __device__ __forceinline__ int lds_byte(int r, int c) { const int st = (r >> 4) * 2 + (c >> 5), rr = r & 15, cc = c & 31, ob = rr * 64 + cc * 2; return st * 1024 + (ob ^ (((ob >> 9) & 1) << 5)); }
__host__ __device__ __forceinline__ void stage_rc(int b, int& R, int& C) { const int st = b / 1024, sb = b % 1024, swz = sb ^ (((sb >> 9) & 1) << 5); R = (st >> 1) * 16 + swz / 64; C = (st & 1) * 32 + (swz % 64) / 2; }
__host__ __device__ __forceinline__ int perm32(int rho) { const int n = rho >> 4, i = rho & 15; return 8 * (i >> 2) + 4 * n + (i & 3); }
struct Unit { int pm, pn; };
struct Gemm { const bf16_t* A; const bf16_t* Bt; int M, N, K, lda; };
struct StaticOrder {
    int nM, nN, nwg, G, c;
    __host__ __device__ void init(int M, int N, int G_, int c_) { nM = M / BM; nN = N / BM; nwg = nM * nN; G = G_; c = c_; }
    __host__ __device__ bool next(int i, Unit& u) const {
        const long L = (long)i * G + c; if (L >= nwg) return false;
        int wgid = (int)L; { const int q = nwg / NXCD, r = nwg % NXCD, xcd = wgid % NXCD, off = wgid / NXCD; wgid = (xcd < r ? xcd * (q + 1) : r * (q + 1) + (xcd - r) * q) + off; }
        const int nig = WGM * nN, gid = wgid / nig, fm = gid * WGM, gsz = (nM - fm) < WGM ? (nM - fm) : WGM;
        u.pm = fm + ((wgid % nig) % gsz); u.pn = (wgid % nig) / gsz; return true;
    }
    __device__ __forceinline__ void a_ready(const Unit&) const {}
    __device__ __forceinline__ void done(const Unit&) const {}
};
__device__ __forceinline__ unsigned cvt_pk_bf16(float lo, float hi) { return ::pack2(lo, hi); }
template <class Epi, class Sched, bool STAMP = false>
__device__ __forceinline__ void gemm_phase(PG8_LAS unsigned char* lds, const Gemm g, const Sched& S, const Epi& E, unsigned long long* stamps) {
    const int tid = ::opq(threadIdx.x), wid = __builtin_amdgcn_readfirstlane(tid >> 6), lane = tid & 63, wr = wid >> 2, wc = wid & 3, fr = lane & 15, fq = lane >> 4;
    const int K = g.K, nt = K / BK;
    int ts_lo = 0, ts_hi = 0, nts = 0; const unsigned long long rt_entry = 0ull;
#define PG8_STAMP() do { if (STAMP && wid == 0 && nts < 64) { const unsigned long long _c = (unsigned long long)clock64(); \
        ts_lo = (lane == nts) ? (int)(unsigned)_c : ts_lo; ts_hi = (lane == nts) ? (int)(unsigned)(_c >> 32) : ts_hi; ++nts; } } while (0)
    PG8_STAMP();
    unsigned voffA[2], voffB[2];
#pragma unroll
    for (int i = 0; i < 2; ++i) { int R, C; stage_rc(tid * 16 + i * 8192, R, C); const int Rb = Epi::PERM ? ((R & ~31) + perm32(R & 31)) : R;
        voffA[i] = (unsigned)(R * g.lda + C) * 2u; voffB[i] = (unsigned)(Rb * K + C) * 2u; }
    const size_t kstep = (size_t)(BK * 2);
    const size_t hstep = (size_t)HALF * K * 2;
    const size_t tstep = 2 * hstep; const size_t hstepA = (size_t)HALF * g.lda * 2; const size_t tstepA = 2 * hstepA;
    const unsigned ldsw = (unsigned)wid * 1024u;
    const int aoff = lds_byte(wr * 64 + fr, fq * 8), boff = lds_byte(wc * 32 + fr, fq * 8);
#define PG8_SA(b, h) (((b) * 2 + (h)) * HTB)
#define PG8_SB(b, h) ((4 + (b) * 2 + (h)) * HTB)
#define PG8_STAGE(bufoff, gbase, voff) do { _Pragma("unroll") for (int _i = 0; _i < 2; ++_i) \
        __builtin_amdgcn_global_load_lds((const unsigned*)((const char*)(gbase) + (voff)[_i]), (PG8_LAS unsigned*)(lds + (bufoff) + ldsw + _i * 8192), 16, 0, 0); } while (0)
#define PG8_LDA(dst, b, h) do { _Pragma("unroll") for (int m = 0; m < 4; ++m) _Pragma("unroll") for (int k = 0; k < 2; ++k) dst[m][k] = *(const PG8_LAS bf16x8*)(lds + PG8_SA(b, h) + aoff + m * 2048 + k * 1024); } while (0)
#define PG8_LDB(dst, b, h) do { _Pragma("unroll") for (int n = 0; n < 2; ++n) _Pragma("unroll") for (int k = 0; k < 2; ++k) dst[n][k] = *(const PG8_LAS bf16x8*)(lds + PG8_SB(b, h) + boff + n * 2048 + k * 1024); } while (0)
#define PG8_MMA(ai, bj, At, Bt) do { __builtin_amdgcn_s_setprio(1); _Pragma("unroll") for (int m = 0; m < 4; ++m) _Pragma("unroll") for (int n = 0; n < 2; ++n) _Pragma("unroll") for (int k = 0; k < 2; ++k) \
        acc[ai][bj][m][n] = __builtin_amdgcn_mfma_f32_16x16x32_bf16(Bt[n][k], At[m][k], acc[ai][bj][m][n], 0, 0, 0); __builtin_amdgcn_s_setprio(0); } while (0)
#define PG8_WAIT_V(n) asm volatile("s_waitcnt vmcnt(" #n ")" ::: "memory")
#define PG8_WAIT_L(n) asm volatile("s_waitcnt lgkmcnt(" #n ")" ::: "memory")
#define PG8_BAR __builtin_amdgcn_s_barrier()
#define PG8_SCHED __builtin_amdgcn_sched_barrier(0)
    Unit cur, nxt; int ui = 0;
    if (!S.next(0, cur)) return;
    f32x4 acc[2][2][4][2];
#pragma unroll
    for (int a = 0; a < 2; ++a)
#pragma unroll
        for (int b = 0; b < 2; ++b)
#pragma unroll
            for (int m = 0; m < 4; ++m)
#pragma unroll
                for (int n = 0; n < 2; ++n) acc[a][b][m][n] = (f32x4){0.f, 0.f, 0.f, 0.f};
    bf16x8 At[4][2], B0[2][2], B1[2][2];
    const char* cA = (const char*)g.A + (size_t)cur.pm * tstepA; const char* cB = (const char*)g.Bt + (size_t)cur.pn * tstep;
    S.a_ready(cur);
    PG8_STAGE(PG8_SB(0, 0), cB, voffB); PG8_STAGE(PG8_SA(0, 0), cA, voffA); PG8_STAGE(PG8_SB(0, 1), cB + hstep, voffB); PG8_STAGE(PG8_SA(0, 1), cA + hstepA, voffA);
    if (wr == 1) PG8_BAR;
    PG8_WAIT_V(4); PG8_BAR;
    PG8_STAGE(PG8_SB(1, 0), cB + kstep, voffB); PG8_STAGE(PG8_SA(1, 0), cA + kstep, voffA); PG8_STAGE(PG8_SB(1, 1), cB + hstep + kstep, voffB);
    PG8_WAIT_V(6); PG8_BAR;
    PG8_STAMP();
    for (;;) {
        const bool has_next = S.next(ui + 1, nxt);
        const char* nA = has_next ? (const char*)g.A + (size_t)nxt.pm * tstepA : cA; const char* nB = has_next ? (const char*)g.Bt + (size_t)nxt.pn * tstep : cB;
        for (int t = 0; t < nt; t += 2) {
            const bool last = (t == nt - 2);
            const char* a1 = cA + (size_t)(t + 1) * kstep;
            const char* a2 = last ? nA : cA + (size_t)(t + 2) * kstep; const char* b2 = last ? nB : cB + (size_t)(t + 2) * kstep;
            const char* a3 = a2 + kstep; const char* b3 = b2 + kstep;
            if (last && has_next) S.a_ready(nxt);
            PG8_LDB(B0, 0, 0); PG8_SCHED; PG8_LDA(At, 0, 0); PG8_STAGE(PG8_SA(1, 1), a1 + hstepA, voffA);
            PG8_WAIT_L(8); PG8_BAR; PG8_WAIT_L(0); PG8_MMA(0, 0, At, B0); PG8_BAR; PG8_SCHED;
            PG8_LDB(B1, 0, 1); PG8_STAGE(PG8_SB(0, 0), b2, voffB);
            PG8_BAR; PG8_WAIT_L(0); PG8_MMA(0, 1, At, B1); PG8_BAR;
            PG8_LDA(At, 0, 1); PG8_STAGE(PG8_SA(0, 0), a2, voffA);
            PG8_BAR; PG8_WAIT_L(0); PG8_MMA(1, 0, At, B0); PG8_BAR; PG8_SCHED;
            PG8_STAGE(PG8_SB(0, 1), b2 + hstep, voffB);
            PG8_WAIT_V(6); PG8_BAR; PG8_MMA(1, 1, At, B1); PG8_BAR;
            PG8_LDB(B0, 1, 0); PG8_SCHED; PG8_LDA(At, 1, 0); PG8_STAGE(PG8_SA(0, 1), a2 + hstepA, voffA);
            PG8_WAIT_L(8); PG8_BAR; PG8_WAIT_L(0); PG8_MMA(0, 0, At, B0); PG8_BAR; PG8_SCHED;
            PG8_LDB(B1, 1, 1); PG8_STAGE(PG8_SB(1, 0), b3, voffB);
            PG8_BAR; PG8_WAIT_L(0); PG8_MMA(0, 1, At, B1); PG8_BAR;
            PG8_LDA(At, 1, 1); PG8_STAGE(PG8_SA(1, 0), a3, voffA);
            PG8_BAR; PG8_WAIT_L(0); PG8_MMA(1, 0, At, B0); PG8_BAR; PG8_SCHED;
            PG8_STAGE(PG8_SB(1, 1), b3 + hstep, voffB);
            PG8_WAIT_V(6); PG8_BAR; PG8_MMA(1, 1, At, B1); PG8_BAR;
        }
        PG8_STAMP();
        if constexpr (!Epi::AFTER_DRAIN) { E(acc, cur, wr, wc, fr, fq); S.done(cur); }
        PG8_STAMP();
        if (!has_next) break;
#pragma unroll
        for (int a = 0; a < 2; ++a)
#pragma unroll
            for (int b = 0; b < 2; ++b)
#pragma unroll
                for (int m = 0; m < 4; ++m)
#pragma unroll
                    for (int n = 0; n < 2; ++n) acc[a][b][m][n] = (f32x4){0.f, 0.f, 0.f, 0.f};
        cur = nxt; cA = nA; cB = nB; ++ui;
    }
    PG8_WAIT_V(0);
    if (wr == 0) PG8_BAR;
    PG8_BAR;
    if constexpr (Epi::AFTER_DRAIN) { E.fused(acc, cur, wr, wc, fr, fq, lds, wid, lane); S.done(cur); }
    PG8_STAMP();
    if (STAMP && wid == 0) { stamps[lane] = lane < nts ? (((unsigned long long)(unsigned)ts_hi << 32) | (unsigned)ts_lo) : 0ull;
        if (lane == 62) stamps[62] = rt_entry; if (lane == 63) stamps[63] = (unsigned long long)wall_clock64(); }
#undef PG8_STAMP
#undef PG8_SA
#undef PG8_SB
#undef PG8_STAGE
#undef PG8_LDA
#undef PG8_LDB
#undef PG8_MMA
#undef PG8_WAIT_V
#undef PG8_WAIT_L
#undef PG8_BAR
#undef PG8_SCHED
}
}
using pg8::f32x4;
#define ROWOFF(reg, h) (((reg) & 3) + 8 * ((reg) >> 2) + 4 * (h))

__device__ __forceinline__ void conv_tile(const float* __restrict__ src, int K, int N, u16* __restrict__ dst, int k0, int n0, int sn0, float* lds) {
  const int tid = opq(threadIdx.x);
  __syncthreads();
  {
    const int k = tid >> 3, c = (tid & 7) * 8;
    const float* s = src + (size_t)(k0 + k) * N + sn0 + c;
    float4 a = *(const float4*)s, b = *(const float4*)(s + 4);
    float* d = lds + k * 65 + c;
    d[0] = a.x; d[1] = a.y; d[2] = a.z; d[3] = a.w;
    d[4] = b.x; d[5] = b.y; d[6] = b.z; d[7] = b.w;
  }
  __syncthreads();
  {
    const int n = tid >> 3, kk = (tid & 7) * 8;
    float f[8];
#pragma unroll
    for (int i = 0; i < 8; ++i) f[i] = lds[(kk + i) * 65 + n];
    *(uint4*)(dst + (size_t)(n0 + n) * K + k0 + kk) = pack8(f);
  }
}

__device__ __forceinline__ void phase_prep(const Params& p, int l, int which, float* ldsf) {
  u16* WtA = (u16*)(p.ws + WS_WT);
  u16* WtF = (u16*)(p.ws + WS_WTF);
  u16* H = (u16*)(p.ws + WS_H);
  float* X = p.out;
  const int nconv = which == 0 ? (640 + 512 + 128 + 128 + 256) : (1408 + 704);
  const int ntot = nconv + 2112;
  const float* gw = (which == 0 ? p.in[7] : p.in[24]) + l * 1024;
  for (int it = blockIdx.x; it < ntot; it += gridDim.x) {
    if (it < nconv) {
      int t = it;
      if (which == 0) {
        if (t < 640) { const int tk = t / 40, tn = t % 40; conv_tile(p.in[8] + (size_t)l * 1024 * 4608, 1024, 4608, WtA + WT_IN, tk * 64, tn * 64, tn * 64, ldsf); }
        else if ((t -= 640) < 512) {
          const int tk = t / 32, tn = t % 32; const int n0 = tn * 64;
          const int sn0 = 2560 + ((n0 >> 7) & 1) * 1024 + (n0 >> 8) * 128 + (n0 & 127);
          conv_tile(p.in[8] + (size_t)l * 1024 * 4608, 1024, 4608, WtA + WT_G, tk * 64, n0, sn0, ldsf);
        }
        else if ((t -= 512) < 128) { const int tk = t / 16, tn = t % 16; conv_tile(p.in[21] + (size_t)l * 512 * 1024, 512, 1024, WtA + WT_BRA, tk * 64, tn * 64, tn * 64, ldsf); }
        else if ((t -= 128) < 128) { const int tk = t / 16, tn = t % 16; conv_tile(p.in[22] + (size_t)l * 512 * 1024, 512, 1024, WtA + WT_BRB, tk * 64, tn * 64, tn * 64, ldsf); }
        else { t -= 128; const int tk = t / 16, tn = t % 16; conv_tile(p.in[23] + (size_t)l * 1024 * 1024, 1024, 1024, WtA + WT_OUT, tk * 64, tn * 64, tn * 64, ldsf); }
      } else {
        if (t < 1408) {
          const int tk = t / 88, tn = t % 88; const int n0 = tn * 64;
          const int sn0 = ((n0 >> 7) & 1) * 2816 + (n0 >> 8) * 128 + (n0 & 127);
          conv_tile(p.in[25] + (size_t)l * 1024 * 5632, 1024, 5632, WtF + WT_FIN, tk * 64, n0, sn0, ldsf);
        } else { t -= 1408; const int tk = t / 16, tn = t % 16; conv_tile(p.in[28] + (size_t)l * 2816 * 1024, 2816, 1024, WtF + WT_FDN, tk * 64, tn * 64, tn * 64, ldsf); }
      }
    } else {
      const int tid = opq(threadIdx.x);
      const int row = (it - nconv) * 8 + (tid >> 6);
      const int lane = tid & 63;
      const bool first = (which == 0 && l == 0);
      const float* src;
      if (first) src = (row < M_P) ? p.in[0] + (size_t)row * 1024 : p.in[1] + (size_t)(row - M_P) * 1024;
      else src = X + (size_t)row * 1024;
      float4 v[4];
      float ss = 0.f;
#pragma unroll
      for (int i = 0; i < 4; ++i) {
        v[i] = *(const float4*)(src + i * 256 + lane * 4);
        ss += v[i].x * v[i].x + v[i].y * v[i].y + v[i].z * v[i].z + v[i].w * v[i].w;
        if (first) *(float4*)(X + (size_t)row * 1024 + i * 256 + lane * 4) = v[i];
      }
      ss = wave_sum(ss);
      const float rs = rsqrtf(ss * (1.f / 1024.f) + 1e-6f);
#pragma unroll
      for (int i = 0; i < 4; ++i) {
        const float4 g = *(const float4*)(gw + i * 256 + lane * 4);
        uint2 o; o.x = pack2(v[i].x * rs * g.x, v[i].y * rs * g.y); o.y = pack2(v[i].z * rs * g.z, v[i].w * rs * g.w);
        *(uint2*)(H + (size_t)row * 1024 + i * 256 + lane * 4) = o;
      }
    }
  }
}

struct EpiInproj {
  static constexpr bool PERM = true, AFTER_DRAIN = false;
  u16* z; float* out; int l;
  __device__ __forceinline__ void operator()(const f32x4 (&acc)[2][2][4][2], const pg8::Unit& u, int wr, int wc, int fr, int fq) const {
    const int row0 = u.pm * 256 + wr * 64 + fr, col0 = u.pn * 256 + wc * 32 + 8 * fq;
#pragma unroll
    for (int ai = 0; ai < 2; ++ai)
#pragma unroll
      for (int m = 0; m < 4; ++m) {
        const int row = row0 + ai * 128 + m * 16;
        u16* rowp = z + (size_t)row * ZLD + col0;
#pragma unroll
        for (int bj = 0; bj < 2; ++bj) {
          const f32x4 v0 = acc[ai][bj][m][0], v1 = acc[ai][bj][m][1];
          pg8::u32x4 w; w.x = pg8::cvt_pk_bf16(v0[0], v0[1]); w.y = pg8::cvt_pk_bf16(v0[2], v0[3]); w.z = pg8::cvt_pk_bf16(v1[0], v1[1]); w.w = pg8::cvt_pk_bf16(v1[2], v1[3]);
          *(pg8::u32x4*)(rowp + bj * 128) = w;
        }
        const bool prompt = row < M_P;
        int b, t;
        if (prompt) { b = row >> 13; t = row & 8191; } else { b = (row - M_P) >> 2; t = (row - M_P) & 3; }
        if (u.pn < 7) {
          if ((prompt && t == 8191) || (!prompt && t == 3)) {
            float* o = out + (prompt ? O_PSHIFT + (size_t)(l * 2 + b) * 1792 : O_SSHIFT + (size_t)(l * 128 + b) * 1792) + col0;
#pragma unroll
            for (int bj = 0; bj < 2; ++bj) { *(f32x4*)(o + bj * 128) = acc[ai][bj][m][0]; *(f32x4*)(o + bj * 128 + 4) = acc[ai][bj][m][1]; }
          }
        } else if (u.pn == 9 && prompt && t >= 8064) {
          const int c = wc * 32 + 8 * fq;
          float* o = out + O_PV + ((size_t)((l * 2 + b) * 128 + (t - 8064)) * 2 + (c >> 6)) * 64 + (c & 63);
          *(f32x4*)o = acc[ai][1][m][0]; *(f32x4*)(o + 4) = acc[ai][1][m][1];
        }
      }
  }
};
struct EpiStoreBf16 {
  static constexpr bool PERM = true, AFTER_DRAIN = false;
  u16* O; int ldc;
  __device__ __forceinline__ void operator()(const f32x4 (&acc)[2][2][4][2], const pg8::Unit& u, int wr, int wc, int fr, int fq) const {
    const int row0 = u.pm * 256 + wr * 64 + fr, col0 = u.pn * 256 + wc * 32 + 8 * fq;
#pragma unroll
    for (int ai = 0; ai < 2; ++ai)
#pragma unroll
      for (int m = 0; m < 4; ++m) {
        u16* rowp = O + (size_t)(row0 + ai * 128 + m * 16) * ldc + col0;
#pragma unroll
        for (int bj = 0; bj < 2; ++bj) {
          const f32x4 v0 = acc[ai][bj][m][0], v1 = acc[ai][bj][m][1];
          pg8::u32x4 w; w.x = pg8::cvt_pk_bf16(v0[0], v0[1]); w.y = pg8::cvt_pk_bf16(v0[2], v0[3]); w.z = pg8::cvt_pk_bf16(v1[0], v1[1]); w.w = pg8::cvt_pk_bf16(v1[2], v1[3]);
          *(pg8::u32x4*)(rowp + bj * 128) = w;
        }
      }
  }
};
struct EpiFfnIn {
  static constexpr bool PERM = true, AFTER_DRAIN = false;
  u16* cu;
  __device__ __forceinline__ void operator()(const f32x4 (&acc)[2][2][4][2], const pg8::Unit& u, int wr, int wc, int fr, int fq) const {
    const int row0 = u.pm * 256 + wr * 64 + fr, col0 = u.pn * 128 + wc * 32 + 8 * fq;
#pragma unroll
    for (int ai = 0; ai < 2; ++ai)
#pragma unroll
      for (int m = 0; m < 4; ++m) {
        u16* rowp = cu + (size_t)(row0 + ai * 128 + m * 16) * 5632 + col0;
#pragma unroll
        for (int bj = 0; bj < 2; ++bj) {
          const f32x4 v0 = acc[ai][bj][m][0], v1 = acc[ai][bj][m][1];
          pg8::u32x4 w; w.x = pg8::cvt_pk_bf16(v0[0], v0[1]); w.y = pg8::cvt_pk_bf16(v0[2], v0[3]); w.z = pg8::cvt_pk_bf16(v1[0], v1[1]); w.w = pg8::cvt_pk_bf16(v1[2], v1[3]);
          *(pg8::u32x4*)(rowp + bj * 2816) = w;
        }
      }
  }
};
struct EpiMerge {
  static constexpr bool PERM = true, AFTER_DRAIN = false;
  const u16* t1; const u16* t2; u16* mg;
  __device__ __forceinline__ void operator()(const f32x4 (&acc)[2][2][4][2], const pg8::Unit& u, int wr, int wc, int fr, int fq) const {
    const int row0 = u.pm * 256 + wr * 64 + fr, col0 = u.pn * 128 + wc * 32 + 8 * fq;
#pragma unroll
    for (int ai = 0; ai < 2; ++ai)
#pragma unroll
      for (int m = 0; m < 4; ++m) {
        const size_t off = (size_t)(row0 + ai * 128 + m * 16) * 1024 + col0;
        float a[8], b[8], o[8];
        unpack8(*(const uint4*)(t1 + off), a);
        unpack8(*(const uint4*)(t2 + off), b);
#pragma unroll
        for (int n = 0; n < 2; ++n)
#pragma unroll
          for (int j = 0; j < 4; ++j)
            o[n * 4 + j] = sigm(acc[ai][0][m][n][j]) * a[n * 4 + j] + sigm(acc[ai][1][m][n][j]) * b[n * 4 + j];
        *(uint4*)(mg + off) = pack8(o);
        asm volatile("" ::: "memory");
      }
  }
};
struct EpiResid {
  static constexpr bool PERM = false, AFTER_DRAIN = false;
  float* X; bool dry;
  __device__ __forceinline__ void operator()(const f32x4 (&acc)[2][2][4][2], const pg8::Unit& u, int wr, int wc, int fr, int fq) const {
    const int row0 = u.pm * 256 + wr * 64 + fr, col0 = u.pn * 256 + wc * 32 + 4 * fq;
#pragma unroll
    for (int ai = 0; ai < 2; ++ai)
#pragma unroll
      for (int m = 0; m < 4; ++m) {
        float* rowp = X + (size_t)(row0 + ai * 128 + m * 16) * 1024 + col0;
#pragma unroll
        for (int bj = 0; bj < 2; ++bj)
#pragma unroll
          for (int n = 0; n < 2; ++n) { f32x4* q = (f32x4*)(rowp + bj * 128 + n * 16); const f32x4 v_ = *q + acc[ai][bj][m][n]; if (!dry) *q = v_; }
        asm volatile("" ::: "memory");
      }
  }
};
template <class Epi>
__device__ __forceinline__ void run_gemm(unsigned char* lds_raw, const u16* A, int lda, const u16* Bt, int N, int K, const Epi& E) {
  pg8::Gemm g; g.A = A; g.Bt = Bt; g.M = M_TOT; g.N = N; g.K = K; g.lda = lda;
  pg8::StaticOrder S; S.init(M_TOT, N, gridDim.x, blockIdx.x);
  __syncthreads();
  pg8::gemm_phase<Epi, pg8::StaticOrder, false>((PG8_LAS unsigned char*)lds_raw, g, S, E, nullptr);
  __syncthreads();
}

__device__ __forceinline__ void rope_item(const Params& p, int l, int item, bool dry = false) {
  const int tid = opq(threadIdx.x);
  u16* z = (u16*)(p.ws + WS_Z);
  const int row = item * 64 + (tid >> 3);
  const int d0 = (tid & 7) * 4;
  const bool prompt = row < M_P;
  int b, t, pos;
  if (prompt) { b = row >> 13; t = row & 8191; pos = t; } else { b = (row - M_P) >> 2; t = (row - M_P) & 3; pos = 16384 + t; }
  float cs[4], sn[4];
#pragma unroll
  for (int i = 0; i < 4; ++i) {
    const float inv = __expf(-(float)(d0 + i) * (9.210340371976184f / 32.f));
    const float angf = (float)pos * inv;
    double a = (double)angf;
    a -= 6.283185307179586 * rint(a * 0.15915494309189535);
    const float af = (float)a;
    sn[i] = __sinf(af); cs[i] = __cosf(af);
  }
#pragma unroll 2
  for (int hh = 0; hh < 10; ++hh) {
    u16* q = z + (size_t)row * ZLD + 1792 + hh * 64 + d0;
    const uint2 lo = *(const uint2*)q, hi = *(const uint2*)(q + 32);
    float x1[4] = {__uint_as_float(lo.x << 16), __uint_as_float(lo.x & 0xFFFF0000u), __uint_as_float(lo.y << 16), __uint_as_float(lo.y & 0xFFFF0000u)};
    float x2[4] = {__uint_as_float(hi.x << 16), __uint_as_float(hi.x & 0xFFFF0000u), __uint_as_float(hi.y << 16), __uint_as_float(hi.y & 0xFFFF0000u)};
    float y1[4], y2[4];
#pragma unroll
    for (int i = 0; i < 4; ++i) { y1[i] = x1[i] * cs[i] - x2[i] * sn[i]; y2[i] = x2[i] * cs[i] + x1[i] * sn[i]; }
    uint2 o1, o2;
    o1.x = pack2(y1[0], y1[1]); o1.y = pack2(y1[2], y1[3]); o2.x = pack2(y2[0], y2[1]); o2.y = pack2(y2[2], y2[3]);
    if (!dry) { *(uint2*)q = o1; *(uint2*)(q + 32) = o2; }
    if (hh >= 8 && prompt && t >= 8064) {
      float* o = p.out + O_PK + ((size_t)((l * 2 + b) * 128 + (t - 8064)) * 2 + (hh - 8)) * 64 + d0;
      *(float4*)o = make_float4(y1[0], y1[1], y1[2], y1[3]);
      *(float4*)(o + 32) = make_float4(y2[0], y2[1], y2[2], y2[3]);
    }
  }
}

#define SL(i) (ldsf + (i) * 4160)
__device__ __forceinline__ void rwkv_item(const Params& p, int l, int item, float* ldsf, bool dry = false) {
  const int tid = opq(threadIdx.x), lane = tid & 63, wave = tid >> 6;
  const bool sample = item >= 2048;
  int h, cidx, rowbase;
  if (!sample) { h = item & 7; cidx = item >> 3; rowbase = cidx * 64; }
  else { int s = item - 2048; h = s & 7; cidx = s >> 3; rowbase = M_P + cidx * 64; }
  const int cc = cidx & 127;
  const u16* z = (const u16*)(p.ws + WS_Z);
  u16* zw_ = (u16*)(p.ws + WS_Z);
  const float* mu = p.in[9] + l * 1792;
  float* wbuf = SL(7);
  float* gc = ldsf + 9 * 4160;
  float* bd = ldsf + 9 * 4160 + 64;
  __syncthreads();
  {
    const int t = tid >> 3, c8 = (tid & 7) * 8;
    const int m = rowbase + t;
    const int zcs[7] = {h * 64, 512 + h * 64, 1024 + h * 64, 1536, 1600, 1664, 1728};
#pragma unroll
    for (int gi = 0; gi < 7; ++gi) {
      const int zc = zcs[gi] + c8;
      float cur[8], prv[8];
      unpack8(*(const uint4*)(z + (size_t)m * ZLD + zc), cur);
      bool zero = false, fromstate = false;
      if (!sample) zero = (t == 0 && cc == 0);
      else fromstate = ((t & 3) == 0);
      if (zero) {
#pragma unroll
        for (int i = 0; i < 8; ++i) prv[i] = 0.f;
      } else if (fromstate) {
        const int b = (m - M_P) >> 2;
        const float* sp = p.in[2] + (size_t)(l * 128 + b) * 1792 + zc;
        float4 a = *(const float4*)sp, bb = *(const float4*)(sp + 4);
        prv[0] = a.x; prv[1] = a.y; prv[2] = a.z; prv[3] = a.w; prv[4] = bb.x; prv[5] = bb.y; prv[6] = bb.z; prv[7] = bb.w;
      } else {
        unpack8(*(const uint4*)(z + (size_t)(m - 1) * ZLD + zc), prv);
      }
      float* d = SL(gi) + t * 65 + c8;
#pragma unroll
      for (int i = 0; i < 8; ++i) {
        float v = cur[i] + mu[zc + i] * (prv[i] - cur[i]);
        if (gi == 3) v = tanhf(v);
        if (gi >= 5) v = sigm(v);
        d[i] = v;
      }
    }
  }
  const int lt = tid & 63, jg = tid >> 6;
  auto load_w = [&](const float* W, int nrows) {
    for (int e = tid; e < nrows * 8; e += NT) {
      const int i = e >> 3, c = (e & 7) * 8;
      const float* s = W + (size_t)i * 512 + h * 64 + c;
      *(float4*)(wbuf + i * 64 + c) = *(const float4*)s;
      *(float4*)(wbuf + i * 64 + c + 4) = *(const float4*)(s + 4);
    }
  };
  auto lora = [&](const float* xa, const float* xb, int n, float* acc) {
#pragma unroll 2
    for (int i = 0; i < n; ++i) {
      const float x = (i < 64) ? xa[lt * 65 + i] : xb[lt * 65 + i - 64];
      const float4 w0 = *(const float4*)(wbuf + i * 64 + jg * 8);
      const float4 w1 = *(const float4*)(wbuf + i * 64 + jg * 8 + 4);
      acc[0] += x * w0.x; acc[1] += x * w0.y; acc[2] += x * w0.z; acc[3] += x * w0.w;
      acc[4] += x * w1.x; acc[5] += x * w1.y; acc[6] += x * w1.z; acc[7] += x * w1.w;
    }
  };
  float res[8];
  load_w(p.in[11] + (size_t)l * 64 * 512, 64);
  __syncthreads();
#pragma unroll
  for (int i = 0; i < 8; ++i) res[i] = p.in[10][l * 512 + h * 64 + jg * 8 + i];
  lora(SL(3), SL(3), 64, res);
  __syncthreads();
#pragma unroll
  for (int i = 0; i < 8; ++i) {
    const float x = -res[i];
    const float sp = (x > 20.f) ? x : log1pf(__expf(x));
    SL(3)[lt * 65 + jg * 8 + i] = -__expf(-sp - 0.5f);
  }
  load_w(p.in[13] + (size_t)l * 64 * 512, 64);
  __syncthreads();
#pragma unroll
  for (int i = 0; i < 8; ++i) res[i] = p.in[12][l * 512 + h * 64 + jg * 8 + i];
  lora(SL(4), SL(4), 64, res);
  __syncthreads();
#pragma unroll
  for (int i = 0; i < 8; ++i) SL(4)[lt * 65 + jg * 8 + i] = sigm(res[i]);
  load_w(p.in[14] + (size_t)l * 128 * 512, 128);
  __syncthreads();
#pragma unroll
  for (int i = 0; i < 8; ++i) res[i] = 0.f;
  lora(SL(5), SL(6), 128, res);
  __syncthreads();
  if (!sample) {
    u16* ga = (u16*)(p.ws + WS_GA) + (size_t)item * 4096;
    *(uint4*)(ga + lt * 64 + jg * 8) = pack8(res);
    if (tid < 64) {
      float c = 0.f;
      for (int t = 0; t < 64; ++t) { c += SL(3)[t * 65 + tid]; SL(5)[t * 65 + tid] = c; }
      gc[tid] = __expf(c);
    }
  } else {
#pragma unroll
    for (int i = 0; i < 8; ++i) SL(6)[lt * 65 + jg * 8 + i] = res[i];
  }
  __syncthreads();
  {
    const int t = tid >> 3, j0 = (tid & 7) * 8;
    const float* kkw = p.in[15] + l * 512 + h * 64;
    const float* kaw = p.in[16] + l * 512 + h * 64;
    const float* rkw = p.in[17] + l * 512 + h * 64;
    float kr[8], av[8], rv[8], kkv[8], kf[8];
    float nrm = 0.f, bdot = 0.f;
#pragma unroll
    for (int i = 0; i < 8; ++i) {
      const int j = j0 + i;
      kr[i] = SL(1)[t * 65 + j]; av[i] = SL(4)[t * 65 + j]; rv[i] = SL(0)[t * 65 + j];
      kkv[i] = kr[i] * kkw[j];
      nrm += kkv[i] * kkv[i];
      kf[i] = kr[i] * (1.f + (av[i] - 1.f) * kaw[j]);
      bdot += rv[i] * kf[i] * rkw[j];
    }
    nrm += __shfl_xor(nrm, 1, 64); nrm += __shfl_xor(nrm, 2, 64); nrm += __shfl_xor(nrm, 4, 64);
    bdot += __shfl_xor(bdot, 1, 64); bdot += __shfl_xor(bdot, 2, 64); bdot += __shfl_xor(bdot, 4, 64);
    const float rn = 1.f / fmaxf(sqrtf(nrm), 1e-12f);
    if (!sample) {
      float bo[8];
#pragma unroll
      for (int i = 0; i < 8; ++i) {
        const int j = j0 + i;
        const float cum = SL(5)[t * 65 + j], dl = SL(3)[t * 65 + j];
        const float eg = __expf(cum), egi = __expf(-cum), egp = __expf(cum - dl);
        const float kk = kkv[i] * rn;
        SL(0)[t * 65 + j] = rv[i] * eg;
        SL(1)[t * 65 + j] = kf[i] * egi;
        SL(3)[t * 65 + j] = kk * av[i] * egi;
        SL(4)[t * 65 + j] = kk * egp;
        bo[i] = bdot * SL(2)[t * 65 + j];
      }
      u16* bop = (u16*)(p.ws + WS_BO) + (size_t)item * 4096;
      *(uint4*)(bop + t * 64 + j0) = pack8(bo);
    } else {
#pragma unroll
      for (int i = 0; i < 8; ++i) {
        const int j = j0 + i;
        const float kk = kkv[i] * rn;
        const float dl = SL(3)[t * 65 + j];
        SL(1)[t * 65 + j] = kf[i];
        SL(3)[t * 65 + j] = __expf(dl);
        SL(4)[t * 65 + j] = kk;
        SL(5)[t * 65 + j] = kk * av[i];
      }
      if ((tid & 7) == 0) bd[t] = bdot;
    }
  }
  __syncthreads();
  if (sample) {
    const float lng = p.in[18][l * 512 + h * 64 + lane], lnb = p.in[19][l * 512 + h * 64 + lane];
    for (int round = 0; round < 2; ++round) {
      const int seq = wave + 8 * round;
      const int b = cidx * 16 + seq;
      float S[64];
      const float* sp = p.in[3] + ((size_t)((l * 128 + b) * 8 + h) * 64 + lane) * 64;
#pragma unroll
      for (int k = 0; k < 64; k += 4) { float4 v = *(const float4*)(sp + k); S[k] = v.x; S[k + 1] = v.y; S[k + 2] = v.z; S[k + 3] = v.w; }
      for (int tt = 0; tt < 4; ++tt) {
        const int t = seq * 4 + tt;
        float sk = 0.f;
#pragma unroll
        for (int kc = 0; kc < 64; kc += 8) {
#pragma unroll
          for (int k = kc; k < kc + 8; ++k) sk += S[k] * SL(4)[t * 65 + k];
          __builtin_amdgcn_sched_barrier(0);
        }
        const float vt = SL(2)[t * 65 + lane];
        float y = 0.f;
#pragma unroll
        for (int kc = 0; kc < 64; kc += 8) {
#pragma unroll
          for (int k = kc; k < kc + 8; ++k) {
            S[k] = S[k] * SL(3)[t * 65 + k] - sk * SL(5)[t * 65 + k] + vt * SL(1)[t * 65 + k];
            y += S[k] * SL(0)[t * 65 + k];
          }
          __builtin_amdgcn_sched_barrier(0);
        }
        const float mean = wave_sum(y) * (1.f / 64.f);
        const float d = y - mean;
        const float var = wave_sum(d * d) * (1.f / 64.f);
        const float yn = d * rsqrtf(var + 64e-5f) * lng + lnb;
        const float o = (yn + bd[t] * vt) * SL(6)[t * 65 + lane];
        if (!dry) zw_[(size_t)(M_P + b * 4 + tt) * ZLD + h * 64 + lane] = f2bf(o);
      }
      float* op = p.out + O_SWKV + ((size_t)((l * 128 + b) * 8 + h) * 64 + lane) * 64;
#pragma unroll
      for (int k = 0; k < 64; k += 4) *(float4*)(op + k) = make_float4(S[k], S[k + 1], S[k + 2], S[k + 3]);
    }
    return;
  }
  {
    const int i = lane, tg = wave;
    float ab[8], ak[8], akr[8], abr[8];
#pragma unroll
    for (int q = 0; q < 8; ++q) { ab[q] = 0.f; ak[q] = 0.f; akr[q] = 0.f; abr[q] = 0.f; }
#pragma unroll 2
    for (int k = 0; k < 64; ++k) {
      const float xb = SL(3)[i * 65 + k], xk = SL(1)[i * 65 + k];
#pragma unroll
      for (int q = 0; q < 8; ++q) {
        const int t = tg * 8 + q;
        const float yk = SL(4)[t * 65 + k], yr = SL(0)[t * 65 + k];
        ab[q] += xb * yk; ak[q] += xk * yk; akr[q] += xk * yr; abr[q] += xb * yr;
      }
    }
    __syncthreads();
#pragma unroll
    for (int q = 0; q < 8; ++q) {
      const int t = tg * 8 + q;
      SL(6)[i * 65 + t] = (i < t) ? ab[q] : 0.f;
      SL(7)[i * 65 + t] = (i < t) ? ak[q] : 0.f;
      SL(8)[i * 65 + t] = (i <= t) ? akr[q] : 0.f;
      SL(5)[i * 65 + t] = (i <= t) ? abr[q] : 0.f;
    }
  }
  __syncthreads();
  {
    const int t = tid >> 3, j0 = (tid & 7) * 8;
#pragma unroll
    for (int i = 0; i < 8; ++i) { const float g = gc[j0 + i]; SL(3)[t * 65 + j0 + i] *= g; SL(1)[t * 65 + j0 + i] *= g; }
  }
  __syncthreads();
  if (tid < 128) {
    float* X_ = (tid < 64) ? SL(5) : SL(3);
    const int col = tid & 63;
    for (int i = 62; i >= 0; --i) {
      float a = X_[i * 65 + col];
#pragma unroll 4
      for (int t = i + 1; t < 64; ++t) a -= SL(6)[i * 65 + t] * X_[t * 65 + col];
      X_[i * 65 + col] = a;
    }
  }
  __syncthreads();
  {
    const int c = tid & 127, ig = tid >> 7;
    const int which = c >> 6, cq = c & 63;
    const float* N_ = which ? SL(3) : SL(5);
    float a[16];
#pragma unroll
    for (int q = 0; q < 16; ++q) a[q] = 0.f;
#pragma unroll 2
    for (int t = 0; t < 64; ++t) {
      const float n = N_[t * 65 + cq];
#pragma unroll
      for (int q = 0; q < 16; ++q) a[q] += SL(7)[(ig * 16 + q) * 65 + t] * n;
    }
    float* T_ = which ? SL(1) : SL(8);
#pragma unroll
    for (int q = 0; q < 16; ++q) T_[(ig * 16 + q) * 65 + cq] -= a[q];
  }
  __syncthreads();
  {
    const int x = lane, yg = wave;
    float w2[8], pp[8], yl[8], qq[8];
#pragma unroll
    for (int q = 0; q < 8; ++q) { w2[q] = 0.f; pp[q] = 0.f; yl[q] = 0.f; qq[q] = 0.f; }
#pragma unroll 2
    for (int j = 0; j < 64; ++j) {
      const float l5 = SL(5)[j * 65 + x], l4 = SL(4)[j * 65 + x], l8 = SL(8)[j * 65 + x], l2 = SL(2)[j * 65 + x];
#pragma unroll
      for (int q = 0; q < 8; ++q) {
        const int y = yg * 8 + q;
        w2[q] += l5 * SL(4)[j * 65 + y];
        pp[q] += l4 * SL(3)[j * 65 + y];
        yl[q] += l8 * SL(2)[j * 65 + y];
        qq[q] += l2 * SL(1)[j * 65 + y];
      }
    }
    float o1[8];
#pragma unroll
    for (int q = 0; q < 8; ++q) {
      const int y = yg * 8 + q;
      o1[q] = SL(0)[x * 65 + y] - w2[q];
    }
    u16* Pf = (u16*)(p.ws + WS_PP) + (size_t)item * 4096;
    float* Qf = (float*)(p.ws + WS_Q) + (size_t)item * 4096;
    if (tid < 64) ((float*)(p.ws + WS_GC))[(size_t)item * 64 + tid] = gc[tid];
    {
      const int s_ = x >> 4, kk = x & 15, hh = (kk >> 2) & 1, jj = ((kk >> 3) << 2) | (kk & 3);
#pragma unroll
      for (int q = 0; q < 8; ++q) {
        const int y = yg * 8 + q;
        Pf[(((y >> 5) * 4 + s_) * 64 + (y & 31) + 32 * hh) * 8 + jj] = f2bf(-pp[q]);
        const int k2 = y & 31, reg = ((k2 >> 3) << 2) | (k2 & 3), h2 = (k2 >> 2) & 1;
        Qf[(((x >> 5) * 2 + (y >> 5)) * 16 + reg) * 64 + (x & 31) + 32 * h2] = qq[q];
      }
    }
    u16* W2p = (u16*)(p.ws + WS_W2) + (size_t)item * 4096 + x * 64 + yg * 8;
    u16* YLp = (u16*)(p.ws + WS_YL) + (size_t)item * 4096 + x * 64 + yg * 8;
    *(uint4*)W2p = pack8(o1);
    *(uint4*)YLp = pack8(yl);
  }
}

__device__ __forceinline__ void mm_tile(const u16* Aop, int lda, const u16* Bop, int ldb, int mt, int nt, int r, int h, int ksteps, f32x16& acc) {
  const u16* ap = Aop + (mt * 32 + r) * lda + h * 8;
  const u16* bp = Bop + (nt * 32 + r) * ldb + h * 8;
#pragma unroll 4
  for (int s = 0; s < ksteps; ++s) {
    const bf16x8 a = *(const bf16x8*)(ap + s * 16);
    const bf16x8 b = *(const bf16x8*)(bp + s * 16);
    acc = __builtin_amdgcn_mfma_f32_32x32x16_bf16(a, b, acc, 0, 0, 0);
  }
}
__device__ __forceinline__ void store_T(u16* T, int ldt, int mt, int nt, int r, int h, const f32x16& acc) {
#pragma unroll
  for (int g = 0; g < 4; ++g) {
    uint2 o; o.x = pack2(acc[4 * g], acc[4 * g + 1]); o.y = pack2(acc[4 * g + 2], acc[4 * g + 3]);
    *(uint2*)(T + (nt * 32 + r) * ldt + mt * 32 + 8 * g + 4 * h) = o;
  }
}
__device__ __forceinline__ void tri32(const float* Ab, float* Xc) {
  const float x31 = Xc[2015];
  const float x30 = Xc[1950] - Ab[1981] * x31;
  const float x29 = Xc[1885] - Ab[1915] * x30 - Ab[1916] * x31;
  const float x28 = Xc[1820] - Ab[1849] * x29 - Ab[1850] * x30 - Ab[1851] * x31;
  const float x27 = Xc[1755] - Ab[1783] * x28 - Ab[1784] * x29 - Ab[1785] * x30 - Ab[1786] * x31;
  const float x26 = Xc[1690] - Ab[1717] * x27 - Ab[1718] * x28 - Ab[1719] * x29 - Ab[1720] * x30 - Ab[1721] * x31;
  const float x25 = Xc[1625] - Ab[1651] * x26 - Ab[1652] * x27 - Ab[1653] * x28 - Ab[1654] * x29 - Ab[1655] * x30 - Ab[1656] * x31;
  const float x24 = Xc[1560] - Ab[1585] * x25 - Ab[1586] * x26 - Ab[1587] * x27 - Ab[1588] * x28 - Ab[1589] * x29 - Ab[1590] * x30 - Ab[1591] * x31;
  const float x23 = Xc[1495] - Ab[1519] * x24 - Ab[1520] * x25 - Ab[1521] * x26 - Ab[1522] * x27 - Ab[1523] * x28 - Ab[1524] * x29 - Ab[1525] * x30 - Ab[1526] * x31;
  const float x22 = Xc[1430] - Ab[1453] * x23 - Ab[1454] * x24 - Ab[1455] * x25 - Ab[1456] * x26 - Ab[1457] * x27 - Ab[1458] * x28 - Ab[1459] * x29 - Ab[1460] * x30 - Ab[1461] * x31;
  const float x21 = Xc[1365] - Ab[1387] * x22 - Ab[1388] * x23 - Ab[1389] * x24 - Ab[1390] * x25 - Ab[1391] * x26 - Ab[1392] * x27 - Ab[1393] * x28 - Ab[1394] * x29 - Ab[1395] * x30 - Ab[1396] * x31;
  const float x20 = Xc[1300] - Ab[1321] * x21 - Ab[1322] * x22 - Ab[1323] * x23 - Ab[1324] * x24 - Ab[1325] * x25 - Ab[1326] * x26 - Ab[1327] * x27 - Ab[1328] * x28 - Ab[1329] * x29 - Ab[1330] * x30 - Ab[1331] * x31;
  const float x19 = Xc[1235] - Ab[1255] * x20 - Ab[1256] * x21 - Ab[1257] * x22 - Ab[1258] * x23 - Ab[1259] * x24 - Ab[1260] * x25 - Ab[1261] * x26 - Ab[1262] * x27 - Ab[1263] * x28 - Ab[1264] * x29 - Ab[1265] * x30 - Ab[1266] * x31;
  const float x18 = Xc[1170] - Ab[1189] * x19 - Ab[1190] * x20 - Ab[1191] * x21 - Ab[1192] * x22 - Ab[1193] * x23 - Ab[1194] * x24 - Ab[1195] * x25 - Ab[1196] * x26 - Ab[1197] * x27 - Ab[1198] * x28 - Ab[1199] * x29 - Ab[1200] * x30 - Ab[1201] * x31;
  const float x17 = Xc[1105] - Ab[1123] * x18 - Ab[1124] * x19 - Ab[1125] * x20 - Ab[1126] * x21 - Ab[1127] * x22 - Ab[1128] * x23 - Ab[1129] * x24 - Ab[1130] * x25 - Ab[1131] * x26 - Ab[1132] * x27 - Ab[1133] * x28 - Ab[1134] * x29 - Ab[1135] * x30 - Ab[1136] * x31;
  const float x16 = Xc[1040] - Ab[1057] * x17 - Ab[1058] * x18 - Ab[1059] * x19 - Ab[1060] * x20 - Ab[1061] * x21 - Ab[1062] * x22 - Ab[1063] * x23 - Ab[1064] * x24 - Ab[1065] * x25 - Ab[1066] * x26 - Ab[1067] * x27 - Ab[1068] * x28 - Ab[1069] * x29 - Ab[1070] * x30 - Ab[1071] * x31;
  const float x15 = Xc[975] - Ab[991] * x16 - Ab[992] * x17 - Ab[993] * x18 - Ab[994] * x19 - Ab[995] * x20 - Ab[996] * x21 - Ab[997] * x22 - Ab[998] * x23 - Ab[999] * x24 - Ab[1000] * x25 - Ab[1001] * x26 - Ab[1002] * x27 - Ab[1003] * x28 - Ab[1004] * x29 - Ab[1005] * x30 - Ab[1006] * x31;
  const float x14 = Xc[910] - Ab[925] * x15 - Ab[926] * x16 - Ab[927] * x17 - Ab[928] * x18 - Ab[929] * x19 - Ab[930] * x20 - Ab[931] * x21 - Ab[932] * x22 - Ab[933] * x23 - Ab[934] * x24 - Ab[935] * x25 - Ab[936] * x26 - Ab[937] * x27 - Ab[938] * x28 - Ab[939] * x29 - Ab[940] * x30 - Ab[941] * x31;
  const float x13 = Xc[845] - Ab[859] * x14 - Ab[860] * x15 - Ab[861] * x16 - Ab[862] * x17 - Ab[863] * x18 - Ab[864] * x19 - Ab[865] * x20 - Ab[866] * x21 - Ab[867] * x22 - Ab[868] * x23 - Ab[869] * x24 - Ab[870] * x25 - Ab[871] * x26 - Ab[872] * x27 - Ab[873] * x28 - Ab[874] * x29 - Ab[875] * x30 - Ab[876] * x31;
  const float x12 = Xc[780] - Ab[793] * x13 - Ab[794] * x14 - Ab[795] * x15 - Ab[796] * x16 - Ab[797] * x17 - Ab[798] * x18 - Ab[799] * x19 - Ab[800] * x20 - Ab[801] * x21 - Ab[802] * x22 - Ab[803] * x23 - Ab[804] * x24 - Ab[805] * x25 - Ab[806] * x26 - Ab[807] * x27 - Ab[808] * x28 - Ab[809] * x29 - Ab[810] * x30 - Ab[811] * x31;
  const float x11 = Xc[715] - Ab[727] * x12 - Ab[728] * x13 - Ab[729] * x14 - Ab[730] * x15 - Ab[731] * x16 - Ab[732] * x17 - Ab[733] * x18 - Ab[734] * x19 - Ab[735] * x20 - Ab[736] * x21 - Ab[737] * x22 - Ab[738] * x23 - Ab[739] * x24 - Ab[740] * x25 - Ab[741] * x26 - Ab[742] * x27 - Ab[743] * x28 - Ab[744] * x29 - Ab[745] * x30 - Ab[746] * x31;
  const float x10 = Xc[650] - Ab[661] * x11 - Ab[662] * x12 - Ab[663] * x13 - Ab[664] * x14 - Ab[665] * x15 - Ab[666] * x16 - Ab[667] * x17 - Ab[668] * x18 - Ab[669] * x19 - Ab[670] * x20 - Ab[671] * x21 - Ab[672] * x22 - Ab[673] * x23 - Ab[674] * x24 - Ab[675] * x25 - Ab[676] * x26 - Ab[677] * x27 - Ab[678] * x28 - Ab[679] * x29 - Ab[680] * x30 - Ab[681] * x31;
  const float x9 = Xc[585] - Ab[595] * x10 - Ab[596] * x11 - Ab[597] * x12 - Ab[598] * x13 - Ab[599] * x14 - Ab[600] * x15 - Ab[601] * x16 - Ab[602] * x17 - Ab[603] * x18 - Ab[604] * x19 - Ab[605] * x20 - Ab[606] * x21 - Ab[607] * x22 - Ab[608] * x23 - Ab[609] * x24 - Ab[610] * x25 - Ab[611] * x26 - Ab[612] * x27 - Ab[613] * x28 - Ab[614] * x29 - Ab[615] * x30 - Ab[616] * x31;
  const float x8 = Xc[520] - Ab[529] * x9 - Ab[530] * x10 - Ab[531] * x11 - Ab[532] * x12 - Ab[533] * x13 - Ab[534] * x14 - Ab[535] * x15 - Ab[536] * x16 - Ab[537] * x17 - Ab[538] * x18 - Ab[539] * x19 - Ab[540] * x20 - Ab[541] * x21 - Ab[542] * x22 - Ab[543] * x23 - Ab[544] * x24 - Ab[545] * x25 - Ab[546] * x26 - Ab[547] * x27 - Ab[548] * x28 - Ab[549] * x29 - Ab[550] * x30 - Ab[551] * x31;
  const float x7 = Xc[455] - Ab[463] * x8 - Ab[464] * x9 - Ab[465] * x10 - Ab[466] * x11 - Ab[467] * x12 - Ab[468] * x13 - Ab[469] * x14 - Ab[470] * x15 - Ab[471] * x16 - Ab[472] * x17 - Ab[473] * x18 - Ab[474] * x19 - Ab[475] * x20 - Ab[476] * x21 - Ab[477] * x22 - Ab[478] * x23 - Ab[479] * x24 - Ab[480] * x25 - Ab[481] * x26 - Ab[482] * x27 - Ab[483] * x28 - Ab[484] * x29 - Ab[485] * x30 - Ab[486] * x31;
  const float x6 = Xc[390] - Ab[397] * x7 - Ab[398] * x8 - Ab[399] * x9 - Ab[400] * x10 - Ab[401] * x11 - Ab[402] * x12 - Ab[403] * x13 - Ab[404] * x14 - Ab[405] * x15 - Ab[406] * x16 - Ab[407] * x17 - Ab[408] * x18 - Ab[409] * x19 - Ab[410] * x20 - Ab[411] * x21 - Ab[412] * x22 - Ab[413] * x23 - Ab[414] * x24 - Ab[415] * x25 - Ab[416] * x26 - Ab[417] * x27 - Ab[418] * x28 - Ab[419] * x29 - Ab[420] * x30 - Ab[421] * x31;
  const float x5 = Xc[325] - Ab[331] * x6 - Ab[332] * x7 - Ab[333] * x8 - Ab[334] * x9 - Ab[335] * x10 - Ab[336] * x11 - Ab[337] * x12 - Ab[338] * x13 - Ab[339] * x14 - Ab[340] * x15 - Ab[341] * x16 - Ab[342] * x17 - Ab[343] * x18 - Ab[344] * x19 - Ab[345] * x20 - Ab[346] * x21 - Ab[347] * x22 - Ab[348] * x23 - Ab[349] * x24 - Ab[350] * x25 - Ab[351] * x26 - Ab[352] * x27 - Ab[353] * x28 - Ab[354] * x29 - Ab[355] * x30 - Ab[356] * x31;
  const float x4 = Xc[260] - Ab[265] * x5 - Ab[266] * x6 - Ab[267] * x7 - Ab[268] * x8 - Ab[269] * x9 - Ab[270] * x10 - Ab[271] * x11 - Ab[272] * x12 - Ab[273] * x13 - Ab[274] * x14 - Ab[275] * x15 - Ab[276] * x16 - Ab[277] * x17 - Ab[278] * x18 - Ab[279] * x19 - Ab[280] * x20 - Ab[281] * x21 - Ab[282] * x22 - Ab[283] * x23 - Ab[284] * x24 - Ab[285] * x25 - Ab[286] * x26 - Ab[287] * x27 - Ab[288] * x28 - Ab[289] * x29 - Ab[290] * x30 - Ab[291] * x31;
  const float x3 = Xc[195] - Ab[199] * x4 - Ab[200] * x5 - Ab[201] * x6 - Ab[202] * x7 - Ab[203] * x8 - Ab[204] * x9 - Ab[205] * x10 - Ab[206] * x11 - Ab[207] * x12 - Ab[208] * x13 - Ab[209] * x14 - Ab[210] * x15 - Ab[211] * x16 - Ab[212] * x17 - Ab[213] * x18 - Ab[214] * x19 - Ab[215] * x20 - Ab[216] * x21 - Ab[217] * x22 - Ab[218] * x23 - Ab[219] * x24 - Ab[220] * x25 - Ab[221] * x26 - Ab[222] * x27 - Ab[223] * x28 - Ab[224] * x29 - Ab[225] * x30 - Ab[226] * x31;
  const float x2 = Xc[130] - Ab[133] * x3 - Ab[134] * x4 - Ab[135] * x5 - Ab[136] * x6 - Ab[137] * x7 - Ab[138] * x8 - Ab[139] * x9 - Ab[140] * x10 - Ab[141] * x11 - Ab[142] * x12 - Ab[143] * x13 - Ab[144] * x14 - Ab[145] * x15 - Ab[146] * x16 - Ab[147] * x17 - Ab[148] * x18 - Ab[149] * x19 - Ab[150] * x20 - Ab[151] * x21 - Ab[152] * x22 - Ab[153] * x23 - Ab[154] * x24 - Ab[155] * x25 - Ab[156] * x26 - Ab[157] * x27 - Ab[158] * x28 - Ab[159] * x29 - Ab[160] * x30 - Ab[161] * x31;
  const float x1 = Xc[65] - Ab[67] * x2 - Ab[68] * x3 - Ab[69] * x4 - Ab[70] * x5 - Ab[71] * x6 - Ab[72] * x7 - Ab[73] * x8 - Ab[74] * x9 - Ab[75] * x10 - Ab[76] * x11 - Ab[77] * x12 - Ab[78] * x13 - Ab[79] * x14 - Ab[80] * x15 - Ab[81] * x16 - Ab[82] * x17 - Ab[83] * x18 - Ab[84] * x19 - Ab[85] * x20 - Ab[86] * x21 - Ab[87] * x22 - Ab[88] * x23 - Ab[89] * x24 - Ab[90] * x25 - Ab[91] * x26 - Ab[92] * x27 - Ab[93] * x28 - Ab[94] * x29 - Ab[95] * x30 - Ab[96] * x31;
  const float x0 = Xc[0] - Ab[1] * x1 - Ab[2] * x2 - Ab[3] * x3 - Ab[4] * x4 - Ab[5] * x5 - Ab[6] * x6 - Ab[7] * x7 - Ab[8] * x8 - Ab[9] * x9 - Ab[10] * x10 - Ab[11] * x11 - Ab[12] * x12 - Ab[13] * x13 - Ab[14] * x14 - Ab[15] * x15 - Ab[16] * x16 - Ab[17] * x17 - Ab[18] * x18 - Ab[19] * x19 - Ab[20] * x20 - Ab[21] * x21 - Ab[22] * x22 - Ab[23] * x23 - Ab[24] * x24 - Ab[25] * x25 - Ab[26] * x26 - Ab[27] * x27 - Ab[28] * x28 - Ab[29] * x29 - Ab[30] * x30 - Ab[31] * x31;
  Xc[0] = x0;
  Xc[65] = x1;
  Xc[130] = x2;
  Xc[195] = x3;
  Xc[260] = x4;
  Xc[325] = x5;
  Xc[390] = x6;
  Xc[455] = x7;
  Xc[520] = x8;
  Xc[585] = x9;
  Xc[650] = x10;
  Xc[715] = x11;
  Xc[780] = x12;
  Xc[845] = x13;
  Xc[910] = x14;
  Xc[975] = x15;
  Xc[1040] = x16;
  Xc[1105] = x17;
  Xc[1170] = x18;
  Xc[1235] = x19;
  Xc[1300] = x20;
  Xc[1365] = x21;
  Xc[1430] = x22;
  Xc[1495] = x23;
  Xc[1560] = x24;
  Xc[1625] = x25;
  Xc[1690] = x26;
  Xc[1755] = x27;
  Xc[1820] = x28;
  Xc[1885] = x29;
  Xc[1950] = x30;
  Xc[2015] = x31;
}
#define FS(i) (ldsf + (i) * 4160)
__device__ __forceinline__ void rwkv_item2(const Params& p, int l, int item, float* ldsf) {
  const int tid = opq(threadIdx.x), lane = tid & 63, wave = tid >> 6;
  const int r = lane & 31, hf = lane >> 5;
  const int h = item & 7, cidx = item >> 3, rowbase = cidx * 64, cc = cidx & 127;
  const u16* z = (const u16*)(p.ws + WS_Z);
  const float* mu = p.in[9] + l * 1792;
  u16* BBp = (u16*)((unsigned char*)ldsf + 83200);
  u16* XW = BBp;            u16* XA = BBp + 4608;    u16* XG = BBp + 9216;   u16* WT = BBp + 17920;
  u16* Rn = BBp;            u16* Kn = BBp + 4608;    u16* Bn = BBp + 9216;   u16* Cn = BBp + 13824;
  u16* CT = BBp + 18432;    u16* KHT = BBp + 23040;  u16* VT = BBp + 27648;
  float* gc = (float*)(BBp + 32256);
  u16* AK = (u16*)FS(2);    u16* NTm = AK + 4608;
  u16* MT = (u16*)FS(0);    u16* KQT = (u16*)FS(1);
  const int mt = (wave >> 1) & 1, nt = wave & 1, grp = wave >> 2;
  __syncthreads();
  {
    const int t = tid >> 3, c8 = (tid & 7) * 8;
    const int m = rowbase + t;
    const int zcs[7] = {h * 64, 512 + h * 64, 1024 + h * 64, 1536, 1600, 1664, 1728};
#pragma unroll
    for (int gi = 0; gi < 7; ++gi) {
      const int zc = zcs[gi] + c8;
      float cur[8], prv[8], v[8];
      unpack8(*(const uint4*)(z + (size_t)m * ZLD + zc), cur);
      if (t == 0 && cc == 0) {
#pragma unroll
        for (int i = 0; i < 8; ++i) prv[i] = 0.f;
      } else {
        unpack8(*(const uint4*)(z + (size_t)(m - 1) * ZLD + zc), prv);
      }
#pragma unroll
      for (int i = 0; i < 8; ++i) {
        float x = cur[i] + mu[zc + i] * (prv[i] - cur[i]);
        if (gi == 3) x = tanhf(x);
        if (gi >= 5) x = sigm(x);
        v[i] = x;
      }
      if (gi < 2) {
        float* d = FS(gi) + t * 65 + c8;
#pragma unroll
        for (int i = 0; i < 8; ++i) d[i] = v[i];
      } else if (gi == 2) {
#pragma unroll
        for (int i = 0; i < 8; ++i) VT[(c8 + i) * 72 + t] = f2bf(v[i]);
      } else if (gi == 3) { *(uint4*)(XW + t * 72 + c8) = pack8(v); }
      else if (gi == 4) { *(uint4*)(XA + t * 72 + c8) = pack8(v); }
      else { *(uint4*)(XG + t * 136 + (gi - 5) * 64 + c8) = pack8(v); }
    }
  }
  {
    const int i = tid >> 3, j8 = (tid & 7) * 8;
    const float* s1 = p.in[11] + (size_t)l * 64 * 512 + (size_t)i * 512 + h * 64 + j8;
    const float* s2 = p.in[13] + (size_t)l * 64 * 512 + (size_t)i * 512 + h * 64 + j8;
    const float4 a0 = *(const float4*)s1, a1 = *(const float4*)(s1 + 4), b0 = *(const float4*)s2, b1 = *(const float4*)(s2 + 4);
    const float wa[8] = {a0.x, a0.y, a0.z, a0.w, a1.x, a1.y, a1.z, a1.w};
    const float wb[8] = {b0.x, b0.y, b0.z, b0.w, b1.x, b1.y, b1.z, b1.w};
#pragma unroll
    for (int q = 0; q < 8; ++q) { WT[(j8 + q) * 72 + i] = f2bf(wa[q]); WT[4608 + (j8 + q) * 72 + i] = f2bf(wb[q]); }
  }
  __syncthreads();
  {
    f32x16 acc;
#pragma unroll
    for (int i = 0; i < 16; ++i) acc[i] = 0.f;
    mm_tile(grp ? XA : XW, 72, grp ? WT + 4608 : WT, 72, mt, nt, r, hf, 4, acc);
    const int j = nt * 32 + r;
    const float bias = grp ? p.in[12][l * 512 + h * 64 + j] : p.in[10][l * 512 + h * 64 + j];
#pragma unroll
    for (int reg = 0; reg < 16; ++reg) {
      const int t = mt * 32 + ROWOFF(reg, hf);
      const float x = acc[reg] + bias;
      if (grp) FS(3)[t * 65 + j] = sigm(x);
      else {
        const float nx = -x;
        const float sp = (nx > 20.f) ? nx : log1pf(__expf(nx));
        FS(4)[t * 65 + j] = -__expf(-sp - 0.5f);
      }
    }
  }
  __syncthreads();
  {
#pragma unroll
    for (int e2 = 0; e2 < 2; ++e2) {
      const int e = tid + e2 * 512;
      const int i = e >> 3, j8 = (e & 7) * 8;
      const float* s1 = p.in[14] + (size_t)l * 128 * 512 + (size_t)i * 512 + h * 64 + j8;
      const float4 a0 = *(const float4*)s1, a1 = *(const float4*)(s1 + 4);
      const float wa[8] = {a0.x, a0.y, a0.z, a0.w, a1.x, a1.y, a1.z, a1.w};
#pragma unroll
      for (int q = 0; q < 8; ++q) WT[(j8 + q) * 136 + i] = f2bf(wa[q]);
    }
  }
  if (tid < 64) {
    float c = 0.f;
    for (int t = 0; t < 64; ++t) { c += FS(4)[t * 65 + tid]; FS(2)[t * 65 + tid] = c; }
    const float g = __expf(c);
    gc[tid] = g;
    ((float*)(p.ws + WS_GC))[(size_t)item * 64 + tid] = g;
  }
  __syncthreads();
  if (grp == 0) {
    f32x16 acc;
#pragma unroll
    for (int i = 0; i < 16; ++i) acc[i] = 0.f;
    mm_tile(XG, 136, WT, 136, mt, nt, r, hf, 8, acc);
    u16* ga = (u16*)(p.ws + WS_GA) + (size_t)item * 4096;
#pragma unroll
    for (int reg = 0; reg < 16; ++reg) ga[(mt * 32 + ROWOFF(reg, hf)) * 64 + nt * 32 + r] = f2bf(acc[reg]);
  }
  __syncthreads();
  {
    const int t = tid >> 3, j0 = (tid & 7) * 8;
    const float* kkw = p.in[15] + l * 512 + h * 64;
    const float* kaw = p.in[16] + l * 512 + h * 64;
    const float* rkw = p.in[17] + l * 512 + h * 64;
    float kr[8], av[8], rv[8], kkv[8], kf[8];
    float nrm = 0.f, bdot = 0.f;
#pragma unroll
    for (int i = 0; i < 8; ++i) {
      const int j = j0 + i;
      kr[i] = FS(1)[t * 65 + j]; av[i] = FS(3)[t * 65 + j]; rv[i] = FS(0)[t * 65 + j];
      kkv[i] = kr[i] * kkw[j];
      nrm += kkv[i] * kkv[i];
      kf[i] = kr[i] * (1.f + (av[i] - 1.f) * kaw[j]);
      bdot += rv[i] * kf[i] * rkw[j];
    }
    nrm += __shfl_xor(nrm, 1, 64); nrm += __shfl_xor(nrm, 2, 64); nrm += __shfl_xor(nrm, 4, 64);
    bdot += __shfl_xor(bdot, 1, 64); bdot += __shfl_xor(bdot, 2, 64); bdot += __shfl_xor(bdot, 4, 64);
    const float rn = 1.f / fmaxf(sqrtf(nrm), 1e-12f);
    float o_r[8], o_k[8], o_b[8], o_c[8], bo[8];
#pragma unroll
    for (int i = 0; i < 8; ++i) {
      const int j = j0 + i;
      const float cum = FS(2)[t * 65 + j], dl = FS(4)[t * 65 + j];
      const float eg = __expf(cum), egi = __expf(-cum), egp = __expf(cum - dl);
      const float kk = kkv[i] * rn;
      const float g = gc[j];
      o_r[i] = rv[i] * eg; o_k[i] = kf[i] * egi; o_b[i] = kk * av[i] * egi; o_c[i] = kk * egp;
      CT[j * 72 + t] = f2bf(o_c[i]);
      KHT[j * 72 + t] = f2bf(o_k[i] * g);
      FS(1)[t * 65 + j] = o_b[i] * g;
      bo[i] = bdot * bf2f(VT[j * 72 + t]);
    }
    *(uint4*)(Rn + t * 72 + j0) = pack8(o_r);
    *(uint4*)(Kn + t * 72 + j0) = pack8(o_k);
    *(uint4*)(Bn + t * 72 + j0) = pack8(o_b);
    *(uint4*)(Cn + t * 72 + j0) = pack8(o_c);
    u16* bop = (u16*)(p.ws + WS_BO) + (size_t)item * 4096;
    *(uint4*)(bop + t * 64 + j0) = pack8(bo);
  }
  __syncthreads();
  f32x16 akr;
#pragma unroll
  for (int i = 0; i < 16; ++i) akr[i] = 0.f;
  if (grp == 0) {
    f32x16 ab, abr;
#pragma unroll
    for (int i = 0; i < 16; ++i) { ab[i] = 0.f; abr[i] = 0.f; }
    mm_tile(Bn, 72, Cn, 72, mt, nt, r, hf, 4, ab);
    mm_tile(Bn, 72, Rn, 72, mt, nt, r, hf, 4, abr);
    const int t = nt * 32 + r;
#pragma unroll
    for (int reg = 0; reg < 16; ++reg) {
      const int i = mt * 32 + ROWOFF(reg, hf);
      FS(4)[i * 65 + t] = (i < t) ? ab[reg] : 0.f;
      FS(0)[i * 65 + t] = (i <= t) ? abr[reg] : 0.f;
    }
  } else {
    f32x16 akt;
#pragma unroll
    for (int i = 0; i < 16; ++i) akt[i] = 0.f;
    mm_tile(Cn, 72, Kn, 72, mt, nt, r, hf, 4, akt);
    {
      const int i = nt * 32 + r;
#pragma unroll
      for (int reg = 0; reg < 16; ++reg) { const int t = mt * 32 + ROWOFF(reg, hf); if (!(i < t)) akt[reg] = 0.f; }
    }
    store_T(AK, 72, mt, nt, r, hf, akt);
    mm_tile(Kn, 72, Rn, 72, mt, nt, r, hf, 4, akr);
    {
      const int t = nt * 32 + r;
#pragma unroll
      for (int reg = 0; reg < 16; ++reg) { const int i = mt * 32 + ROWOFF(reg, hf); if (!(i <= t)) akr[reg] = 0.f; }
    }
  }
  __syncthreads();
  if (tid < 128) {
    float* X_ = (tid < 64) ? FS(0) : FS(1);
    const int col = tid & 63;
    tri32(FS(4) + 32 * 65 + 32, X_ + 32 * 65 + col);
  }
  __syncthreads();
  {
    const int c = tid & 127, ig = tid >> 7;
    float* X_ = (c < 64) ? FS(0) : FS(1);
    const int col = c & 63;
    float a[8];
#pragma unroll
    for (int u = 0; u < 8; ++u) a[u] = 0.f;
#pragma unroll 4
    for (int t = 32; t < 64; ++t) {
      const float xv = X_[t * 65 + col];
#pragma unroll
      for (int u = 0; u < 8; ++u) a[u] += FS(4)[(ig * 8 + u) * 65 + t] * xv;
    }
#pragma unroll
    for (int u = 0; u < 8; ++u) X_[(ig * 8 + u) * 65 + col] -= a[u];
  }
  __syncthreads();
  if (tid < 128) {
    float* X_ = (tid < 64) ? FS(0) : FS(1);
    const int col = tid & 63;
    tri32(FS(4), X_ + col);
  }
  __syncthreads();
  {
    const int c = tid >> 2, q = tid & 3;
    const float* X_ = (c < 64) ? FS(0) : FS(1);
    const int col = c & 63;
    float o0[8], o1[8];
#pragma unroll
    for (int u = 0; u < 8; ++u) { o0[u] = -X_[(q * 16 + u) * 65 + col]; o1[u] = -X_[(q * 16 + 8 + u) * 65 + col]; }
    u16* dst = NTm + c * 72 + q * 16;
    *(uint4*)dst = pack8(o0);
    *(uint4*)(dst + 8) = pack8(o1);
  }
  __syncthreads();
  if (grp == 1) {
    mm_tile(AK, 72, NTm, 72, mt, nt, r, hf, 4, akr);
    store_T(MT, 72, mt, nt, r, hf, akr);
  } else {
    f32x16 d2;
#pragma unroll
    for (int i = 0; i < 16; ++i) d2[i] = 0.f;
    mm_tile(AK, 72, NTm + 64 * 72, 72, mt, nt, r, hf, 4, d2);
#pragma unroll
    for (int g = 0; g < 4; ++g) {
      const int idx = (nt * 32 + r) * 72 + mt * 32 + 8 * g + 4 * hf;
      const uint2 kh = *(const uint2*)(KHT + idx);
      uint2 o;
      o.x = pack2(d2[4 * g] + __uint_as_float(kh.x << 16), d2[4 * g + 1] + __uint_as_float(kh.x & 0xFFFF0000u));
      o.y = pack2(d2[4 * g + 2] + __uint_as_float(kh.y << 16), d2[4 * g + 3] + __uint_as_float(kh.y & 0xFFFF0000u));
      *(uint2*)(KQT + idx) = o;
    }
  }
  __syncthreads();
  if (grp == 0) {
    f32x16 w2, yl;
#pragma unroll
    for (int i = 0; i < 16; ++i) { w2[i] = 0.f; yl[i] = 0.f; }
    mm_tile(NTm, 72, CT, 72, mt, nt, r, hf, 4, w2);
    mm_tile(MT, 72, VT, 72, mt, nt, r, hf, 4, yl);
    u16* W2p = (u16*)(p.ws + WS_W2) + (size_t)item * 4096;
    u16* YLp = (u16*)(p.ws + WS_YL) + (size_t)item * 4096;
#pragma unroll
    for (int reg = 0; reg < 16; ++reg) {
      const int t = mt * 32 + ROWOFF(reg, hf), n = nt * 32 + r;
      W2p[t * 64 + n] = f2bf(w2[reg] + bf2f(Rn[t * 72 + n]));
      YLp[t * 64 + n] = f2bf(yl[reg]);
    }
  } else {
    f32x16 pp, qt;
#pragma unroll
    for (int i = 0; i < 16; ++i) { pp[i] = 0.f; qt[i] = 0.f; }
    mm_tile(CT, 72, NTm + 64 * 72, 72, mt, nt, r, hf, 4, pp);
    mm_tile(KQT, 72, VT, 72, mt, nt, r, hf, 4, qt);
    uint4* Pf = (uint4*)((u16*)(p.ws + WS_PP) + (size_t)item * 4096);
    float* Qf = (float*)(p.ws + WS_Q) + (size_t)item * 4096;
#pragma unroll
    for (int s2 = 0; s2 < 2; ++s2) {
      uint4 o;
      o.x = pack2(pp[s2 * 8 + 0], pp[s2 * 8 + 1]); o.y = pack2(pp[s2 * 8 + 2], pp[s2 * 8 + 3]);
      o.z = pack2(pp[s2 * 8 + 4], pp[s2 * 8 + 5]); o.w = pack2(pp[s2 * 8 + 6], pp[s2 * 8 + 7]);
      Pf[(nt * 4 + mt * 2 + s2) * 64 + lane] = o;
    }
#pragma unroll
    for (int reg = 0; reg < 16; ++reg) Qf[((nt * 2 + mt) * 16 + reg) * 64 + lane] = qt[reg];
  }
}

template <int K_> struct IC { static constexpr int value = K_; };
__device__ __forceinline__ void rwkv_scan(const Params& p, int l, int bh, float* ldsf, bool dry = false) {
  const int tid = opq(threadIdx.x), lane = tid & 63, wave = tid >> 6;
  const int b = bh >> 3, h = bh & 7;
  unsigned char* ring = (unsigned char*)ldsf + 32768;
  __syncthreads();
  {
    const float* G0 = (const float*)(p.ws + WS_GC);
    for (int e = tid; e < 8192; e += NT) ldsf[e] = G0[(size_t)((b * 128 + (e >> 6)) * 8 + h) * 64 + (e & 63)];
  }
  const bool helper = wave >= 2;
  const int ht = tid - 128;
  const u16* PPb = (const u16*)(p.ws + WS_PP);
  const float* Qb = (const float*)(p.ws + WS_Q);
  const bool isP = wave < 4;
  const int hstr = isP ? 128 : 256;
  const int hidx = isP ? (tid - 128) : (tid - 256);
  const int hdst = isP ? hidx : 512 + hidx;
#define SC_GLOAD(c, D0, D1, D2, D3) do { const size_t id_ = (size_t)((b * 128 + (c)) * 8 + h); \
    const uint4* src_ = isP ? (const uint4*)(PPb + id_ * 4096) : (const uint4*)(Qb + id_ * 4096); \
    D0 = src_[hidx]; D1 = src_[hidx + hstr]; D2 = src_[hidx + 2 * hstr]; D3 = src_[hidx + 3 * hstr]; } while (0)
#define SC_LWRITE(c, D0, D1, D2, D3) do { uint4* slot_ = (uint4*)(ring + ((c) & 1) * 24576) + hdst; \
    slot_[0] = D0; slot_[hstr] = D1; slot_[2 * hstr] = D2; slot_[3 * hstr] = D3; } while (0)
  if (helper) {
    uint4 a0, a1, a2, a3, b0, b1, b2, b3, c0_, c1_, c2_, c3_, d0, d1, d2, d3;
    SC_GLOAD(0, a0, a1, a2, a3); SC_LWRITE(0, a0, a1, a2, a3);
    SC_GLOAD(1, b0, b1, b2, b3); SC_GLOAD(2, c0_, c1_, c2_, c3_); SC_GLOAD(3, d0, d1, d2, d3);
    __syncthreads();
#pragma unroll 1
    for (int cc = 0; cc < 128; cc += 4) {
      if (cc + 4 < 128) SC_GLOAD(cc + 4, a0, a1, a2, a3);
      SC_LWRITE(cc + 1, b0, b1, b2, b3);
      asm volatile("s_waitcnt lgkmcnt(0)\n\ts_barrier" ::: "memory");
      if (cc + 5 < 128) SC_GLOAD(cc + 5, b0, b1, b2, b3);
      SC_LWRITE(cc + 2, c0_, c1_, c2_, c3_);
      asm volatile("s_waitcnt lgkmcnt(0)\n\ts_barrier" ::: "memory");
      if (cc + 6 < 128) SC_GLOAD(cc + 6, c0_, c1_, c2_, c3_);
      SC_LWRITE(cc + 3, d0, d1, d2, d3);
      asm volatile("s_waitcnt lgkmcnt(0)\n\ts_barrier" ::: "memory");
      if (cc + 7 < 128) SC_GLOAD(cc + 7, d0, d1, d2, d3);
      if (cc + 4 < 128) SC_LWRITE(cc + 4, a0, a1, a2, a3);
      asm volatile("s_waitcnt lgkmcnt(0)\n\ts_barrier" ::: "memory");
    }
    return;
  }
  __syncthreads();
  const int vt = wave & 1, hf = lane >> 5;
  f32x16 S[2];
#pragma unroll
  for (int i = 0; i < 16; ++i) { S[0][i] = 0.f; S[1][i] = 0.f; }
#pragma unroll 1
  for (int cc = 0; cc < 128; ++cc) {
    const size_t id = (size_t)((b * 128 + cc) * 8 + h);
    float* Qg = (float*)Qb + id * 4096;
    const int lofs = opq(lane);
    const uint4* slotA = (const uint4*)(ring + (cc & 1) * 24576) + lofs;
    const float* slotQ = (const float*)(ring + (cc & 1) * 24576 + 8192) + vt * 2048 + lofs;
    const float* gcp = ldsf + cc * 64 + 4 * (lofs >> 5);
    Qg += vt * 2048 + lofs;
    f32x16 acc[2];
#pragma unroll
    for (int kt = 0; kt < 2; ++kt)
#pragma unroll
      for (int reg = 0; reg < 16; ++reg)
        acc[kt][reg] = S[kt][reg] * gcp[kt * 32 + ((reg) & 3) + 8 * ((reg) >> 2)] + slotQ[(kt * 16 + reg) * 64];
#pragma unroll
    for (int kt = 0; kt < 2; ++kt)
#pragma unroll
      for (int reg = 0; reg < 16; ++reg) if (!dry) Qg[(kt * 16 + reg) * 64] = S[kt][reg];
#pragma unroll
    for (int s_ = 0; s_ < 4; ++s_) {
      const int kt = s_ >> 1, s2 = s_ & 1;
      unsigned hw[4], lw[4];
#pragma unroll
      for (int j = 0; j < 4; ++j) {
        const float x0 = S[kt][s2 * 8 + 2 * j], x1 = S[kt][s2 * 8 + 2 * j + 1];
        hw[j] = pack2(x0, x1);
        lw[j] = pack2(x0 - __uint_as_float(hw[j] << 16), x1 - __uint_as_float(hw[j] & 0xFFFF0000u));
      }
      union { uint4 u; bf16x8 v; } bh_, bl_;
      bh_.u = make_uint4(hw[0], hw[1], hw[2], hw[3]);
      bl_.u = make_uint4(lw[0], lw[1], lw[2], lw[3]);
#pragma unroll
      for (int kt2 = 0; kt2 < 2; ++kt2) {
        union { uint4 u; bf16x8 v; } af; af.u = slotA[(kt2 * 4 + s_) * 64];
        acc[kt2] = __builtin_amdgcn_mfma_f32_32x32x16_bf16(af.v, bh_.v, acc[kt2], 0, 0, 0);
        acc[kt2] = __builtin_amdgcn_mfma_f32_32x32x16_bf16(af.v, bl_.v, acc[kt2], 0, 0, 0);
      }
    }
    S[0] = acc[0]; S[1] = acc[1];
    asm volatile("s_waitcnt lgkmcnt(0)\n\ts_barrier" ::: "memory");
  }
  {
    float* o = p.out + O_PWKV + ((size_t)((l * 2 + b) * 8 + h) * 64 + vt * 32 + (lane & 31)) * 64;
#pragma unroll
    for (int kt = 0; kt < 2; ++kt)
#pragma unroll
      for (int reg = 0; reg < 16; ++reg) o[kt * 32 + ROWOFF(reg, hf)] = S[kt][reg];
  }
}

__device__ __forceinline__ void rwkv_out(const Params& p, int l, int item, float* ldsf) {
  const int tid = opq(threadIdx.x), lane = tid & 63, wave = tid >> 6;
  const int h = item & 7, cidx = item >> 3;
  float* Sl = ldsf; float* Wl = ldsf + 4160;
  const float* Sg = (const float*)(p.ws + WS_Q) + (size_t)item * 4096;
  const u16* W2 = (const u16*)(p.ws + WS_W2) + (size_t)item * 4096;
  const u16* YL = (const u16*)(p.ws + WS_YL) + (size_t)item * 4096;
  const u16* BO = (const u16*)(p.ws + WS_BO) + (size_t)item * 4096;
  const u16* GA = (const u16*)(p.ws + WS_GA) + (size_t)item * 4096;
  u16* z = (u16*)(p.ws + WS_Z);
  __syncthreads();
  {
    const int row = tid >> 3, c = (tid & 7) * 8;
#pragma unroll
    for (int i = 0; i < 8; ++i) {
      const int idx = i * 512 + tid;
      const int ln = idx & 63, reg = (idx >> 6) & 15, kt = (idx >> 10) & 1, vt = idx >> 11;
      Sl[(vt * 32 + (ln & 31)) * 65 + kt * 32 + ROWOFF(reg, ln >> 5)] = Sg[idx];
    }
    float w[8];
    unpack8(*(const uint4*)(W2 + row * 64 + c), w);
    float* e = Wl + row * 65 + c;
#pragma unroll
    for (int i = 0; i < 8; ++i) e[i] = w[i];
  }
  __syncthreads();
  float y[8];
#pragma unroll
  for (int q = 0; q < 8; ++q) y[q] = bf2f(YL[(wave * 8 + q) * 64 + lane]);
#pragma unroll 2
  for (int k = 0; k < 64; ++k) {
    const float s = Sl[lane * 65 + k];
#pragma unroll
    for (int q = 0; q < 8; ++q) y[q] += s * Wl[(wave * 8 + q) * 65 + k];
  }
  const float lng = p.in[18][l * 512 + h * 64 + lane], lnb = p.in[19][l * 512 + h * 64 + lane];
#pragma unroll
  for (int q = 0; q < 8; ++q) {
    const int t = wave * 8 + q;
    const float mean = wave_sum(y[q]) * (1.f / 64.f);
    const float d = y[q] - mean;
    const float var = wave_sum(d * d) * (1.f / 64.f);
    const float yn = d * rsqrtf(var + 64e-5f) * lng + lnb;
    const float o = (yn + bf2f(BO[t * 64 + lane])) * bf2f(GA[t * 64 + lane]);
    z[(size_t)(cidx * 64 + t) * ZLD + h * 64 + lane] = f2bf(o);
  }
}

__device__ __forceinline__ void attn_prompt(const Params& p, int l, int item, u16* lds, bool dry = false) {
  const int tid = opq(threadIdx.x), lane = tid & 63, wave = tid >> 6;
  const int r = lane & 31, h = lane >> 5;
  const int kvh = item & 1, n = (item >> 1) & 63, b = item >> 7;
  u16* z = (u16*)(p.ws + WS_Z);
  u16* Ks = lds;
  u16* Vt = lds + 256 * 72;
  __syncthreads();
  {
    const int key = tid >> 1, half = tid & 1;
    const int t = (n - 1) * 128 + key;
    uint4 kv[4], vv[4];
    if (t >= 0) {
      const u16* kp = z + (size_t)(b * 8192 + t) * ZLD + 2304 + kvh * 64 + half * 32;
      const u16* vp = z + (size_t)(b * 8192 + t) * ZLD + 2432 + kvh * 64 + half * 32;
#pragma unroll
      for (int i = 0; i < 4; ++i) { kv[i] = *(const uint4*)(kp + i * 8); vv[i] = *(const uint4*)(vp + i * 8); }
    } else {
#pragma unroll
      for (int i = 0; i < 4; ++i) { kv[i] = make_uint4(0, 0, 0, 0); vv[i] = make_uint4(0, 0, 0, 0); }
    }
#pragma unroll
    for (int i = 0; i < 4; ++i) {
      *(uint4*)(Ks + key * 72 + half * 32 + i * 8) = kv[i];
      const unsigned w[4] = {vv[i].x, vv[i].y, vv[i].z, vv[i].w};
#pragma unroll
      for (int q = 0; q < 4; ++q) {
        const int d = half * 32 + i * 8 + q * 2;
        Vt[d * 264 + key] = (u16)(w[q] & 0xFFFFu);
        Vt[(d + 1) * 264 + key] = (u16)(w[q] >> 16);
      }
    }
  }
  __syncthreads();
#pragma unroll 1
  for (int uu = 0; uu < 2; ++uu) {
    const int u = wave * 2 + uu;
    const int hq = kvh * 4 + (u >> 2), qg = u & 3;
    const int qrow = b * 8192 + n * 128 + qg * 32 + r;
    u16* qp = z + (size_t)qrow * ZLD + 1792 + hq * 64;
    bf16x8 qf[4];
#pragma unroll
    for (int s = 0; s < 4; ++s) qf[s] = *(const bf16x8*)(qp + s * 16 + h * 8);
    f32x16 sc[5];
#pragma unroll
    for (int i5 = 0; i5 < 5; ++i5) {
#pragma unroll
      for (int i = 0; i < 16; ++i) sc[i5][i] = 0.f;
      const int kt = qg + i5;
#pragma unroll
      for (int s = 0; s < 4; ++s) {
        bf16x8 kf = *(const bf16x8*)(Ks + (kt * 32 + r) * 72 + s * 16 + h * 8);
        sc[i5] = __builtin_amdgcn_mfma_f32_32x32x16_bf16(kf, qf[s], sc[i5], 0, 0, 0);
      }
      __builtin_amdgcn_sched_barrier(0);
    }
    const int qi = qg * 32 + r;
    const float sink = p.in[20][l * 8 + hq];
    float mx = -1e30f;
#pragma unroll
    for (int i5 = 0; i5 < 5; ++i5)
#pragma unroll
      for (int reg = 0; reg < 16; ++reg) {
        const int j = (qg + i5) * 32 + ROWOFF(reg, h);
        const bool ok = (j > qi) && (j <= qi + 128) && (n > 0 || j >= 128);
        const float s = ok ? sc[i5][reg] * 0.125f : -1e30f;
        sc[i5][reg] = s;
        mx = fmaxf(mx, s);
      }
    mx = fmaxf(mx, __shfl_xor(mx, 32, 64));
    mx = fmaxf(mx, sink);
    float sum = 0.f;
#pragma unroll
    for (int i5 = 0; i5 < 5; ++i5)
#pragma unroll
      for (int reg = 0; reg < 16; ++reg) { const float e = __expf(sc[i5][reg] - mx); sc[i5][reg] = e; sum += e; }
    sum += __shfl_xor(sum, 32, 64);
    const float rden = 1.f / (sum + __expf(sink - mx));
    f32x16 oacc[2];
#pragma unroll
    for (int i = 0; i < 16; ++i) { oacc[0][i] = 0.f; oacc[1][i] = 0.f; }
#pragma unroll
    for (int i5 = 0; i5 < 5; ++i5) {
      const int kt = qg + i5;
#pragma unroll
      for (int s2 = 0; s2 < 2; ++s2) {
        bf16x8 pf;
#pragma unroll
        for (int j = 0; j < 8; ++j) pf[j] = (short)f2bf(sc[i5][s2 * 8 + j] * rden);
#pragma unroll
        for (int dt = 0; dt < 2; ++dt) {
          const u16* vp = Vt + (dt * 32 + r) * 264 + kt * 32 + s2 * 16 + h * 4;
          const uint2 lo = *(const uint2*)vp, hi = *(const uint2*)(vp + 8);
          union { uint4 u; bf16x8 v; } cv;
          cv.u = make_uint4(lo.x, lo.y, hi.x, hi.y);
          oacc[dt] = __builtin_amdgcn_mfma_f32_32x32x16_bf16(cv.v, pf, oacc[dt], 0, 0, 0);
        }
        __builtin_amdgcn_sched_barrier(0);
      }
    }
#pragma unroll
    for (int dt = 0; dt < 2; ++dt)
#pragma unroll
      for (int g4 = 0; g4 < 4; ++g4) {
        const int d = dt * 32 + 8 * g4 + 4 * h;
        uint2 o;
        o.x = pack2(oacc[dt][g4 * 4 + 0], oacc[dt][g4 * 4 + 1]);
        o.y = pack2(oacc[dt][g4 * 4 + 2], oacc[dt][g4 * 4 + 3]);
        if (!dry) *(uint2*)(qp + d) = o;
      }
  }
}

__device__ __forceinline__ void attn_sample(const Params& p, int l, int item, float* ldsf, bool dry = false) {
  const int tid = opq(threadIdx.x);
  const int kvh = item & 1, b = item >> 1;
  u16* z = (u16*)(p.ws + WS_Z);
  float* Kl = ldsf;
  float* Vl = ldsf + 132 * 65;
  float* Ql = Vl + 132 * 65;
  float* Pl = Ql + 16 * 64;
  __syncthreads();
  for (int e = tid; e < 132 * 8; e += NT) {
    const int j = e >> 3, c = (e & 7) * 8;
    float k[8], v[8];
    if (j < 128) {
      const float* kp = p.in[4] + ((size_t)((l * 128 + b) * 128 + j) * 2 + kvh) * 64 + c;
      const float* vp = p.in[5] + ((size_t)((l * 128 + b) * 128 + j) * 2 + kvh) * 64 + c;
      float4 a = *(const float4*)kp, a2 = *(const float4*)(kp + 4);
      float4 c1 = *(const float4*)vp, c2 = *(const float4*)(vp + 4);
      k[0] = a.x; k[1] = a.y; k[2] = a.z; k[3] = a.w; k[4] = a2.x; k[5] = a2.y; k[6] = a2.z; k[7] = a2.w;
      v[0] = c1.x; v[1] = c1.y; v[2] = c1.z; v[3] = c1.w; v[4] = c2.x; v[5] = c2.y; v[6] = c2.z; v[7] = c2.w;
    } else {
      const size_t row = M_P + b * 4 + (j - 128);
      unpack8(*(const uint4*)(z + row * ZLD + 2304 + kvh * 64 + c), k);
      unpack8(*(const uint4*)(z + row * ZLD + 2432 + kvh * 64 + c), v);
    }
#pragma unroll
    for (int i = 0; i < 8; ++i) { Kl[j * 65 + c + i] = k[i]; Vl[j * 65 + c + i] = v[i]; }
    if (j >= 4) {
      float* ok = p.out + O_SK + ((size_t)((l * 128 + b) * 128 + (j - 4)) * 2 + kvh) * 64 + c;
      float* ov = p.out + O_SV + ((size_t)((l * 128 + b) * 128 + (j - 4)) * 2 + kvh) * 64 + c;
      *(float4*)ok = make_float4(k[0], k[1], k[2], k[3]); *(float4*)(ok + 4) = make_float4(k[4], k[5], k[6], k[7]);
      *(float4*)ov = make_float4(v[0], v[1], v[2], v[3]); *(float4*)(ov + 4) = make_float4(v[4], v[5], v[6], v[7]);
    }
  }
  if (tid < 128) {
    const int row = tid >> 3, c = (tid & 7) * 8;
    const int hl = row >> 2, t = row & 3;
    float q[8];
    unpack8(*(const uint4*)(z + (size_t)(M_P + b * 4 + t) * ZLD + 1792 + (kvh * 4 + hl) * 64 + c), q);
#pragma unroll
    for (int i = 0; i < 8; ++i) Ql[row * 64 + c + i] = q[i];
  }
  __syncthreads();
  const int row = tid >> 5, jl = tid & 31;
  const int t = row & 3, hq = kvh * 4 + (row >> 2);
  float sc[5];
  float mx = -1e30f;
#pragma unroll
  for (int jj = 0; jj < 5; ++jj) {
    const int j = jl + 32 * jj;
    float s = -1e30f;
    if (j < 132 && j > t && j <= t + 128) {
      float a = 0.f;
#pragma unroll 8
      for (int d = 0; d < 64; ++d) a += Ql[row * 64 + d] * Kl[j * 65 + d];
      s = a * 0.125f;
    }
    sc[jj] = s; mx = fmaxf(mx, s);
    __builtin_amdgcn_sched_barrier(0);
  }
#pragma unroll
  for (int o = 16; o >= 1; o >>= 1) mx = fmaxf(mx, __shfl_xor(mx, o, 64));
  const float sink = p.in[20][l * 8 + hq];
  mx = fmaxf(mx, sink);
  float sum = 0.f;
#pragma unroll
  for (int jj = 0; jj < 5; ++jj) { sc[jj] = __expf(sc[jj] - mx); sum += sc[jj]; }
#pragma unroll
  for (int o = 16; o >= 1; o >>= 1) sum += __shfl_xor(sum, o, 64);
  const float rden = 1.f / (sum + __expf(sink - mx));
#pragma unroll
  for (int jj = 0; jj < 5; ++jj) { const int j = jl + 32 * jj; if (j < 136) Pl[row * 136 + j] = sc[jj] * rden; }
  __syncthreads();
  {
    const int d = jl * 2;
    float o0 = 0.f, o1 = 0.f;
#pragma unroll 4
    for (int j = 0; j < 132; ++j) { const float pr = Pl[row * 136 + j]; o0 += pr * Vl[j * 65 + d]; o1 += pr * Vl[j * 65 + d + 1]; }
    if (!dry) *(unsigned*)(z + (size_t)(M_P + b * 4 + t) * ZLD + 1792 + hq * 64 + d) = pack2(o0, o1);
  }
}

__device__ __forceinline__ void phase_convgelu(const Params& p, int l, bool dry = false) {
  u16* cu = (u16*)(p.ws + WS_CU);
  const float* cw = p.in[26] + (size_t)l * 3 * 2816;
  const float* cb = p.in[27] + (size_t)l * 2816;
  for (int it = blockIdx.x; it < 1056; it += gridDim.x) {
    const int tid = opq(threadIdx.x);
    if (tid >= 352) continue;
    const int j0 = tid * 8;
    float w0[8], w1[8], w2[8], bb[8];
#pragma unroll
    for (int i = 0; i < 8; ++i) { w0[i] = cw[j0 + i]; w1[i] = cw[2816 + j0 + i]; w2[i] = cw[5632 + j0 + i]; bb[i] = cb[j0 + i]; }
    float c1[8], c2[8];
    for (int rr = 0; rr < 16; ++rr) {
      const int row = it * 16 + rr;
      const bool prompt = row < M_P;
      int b, t;
      if (prompt) { b = row >> 13; t = row & 8191; } else { b = (row - M_P) >> 2; t = (row - M_P) & 3; }
      if (t == 0) {
        if (prompt) {
#pragma unroll
          for (int i = 0; i < 8; ++i) { c1[i] = 0.f; c2[i] = 0.f; }
        } else {
          const float* st = p.in[6] + (size_t)((l * 128 + b) * 2) * 2816 + j0;
#pragma unroll
          for (int i = 0; i < 8; ++i) { c2[i] = st[i]; c1[i] = st[2816 + i]; }
        }
      } else if (rr == 0) {
        unpack8(*(const uint4*)(cu + (size_t)(row - 1) * 5632 + j0), c1);
        if (t >= 2) unpack8(*(const uint4*)(cu + (size_t)(row - 2) * 5632 + j0), c2);
        else {
#pragma unroll
          for (int i = 0; i < 8; ++i) c2[i] = 0.f;
        }
      }
      float c0[8], up[8], a[8];
      unpack8(*(const uint4*)(cu + (size_t)row * 5632 + j0), c0);
      unpack8(*(const uint4*)(cu + (size_t)row * 5632 + 2816 + j0), up);
#pragma unroll
      for (int i = 0; i < 8; ++i) {
        const float cv = bb[i] + w0[i] * c2[i] + w1[i] * c1[i] + w2[i] * c0[i];
        a[i] = gelu_fast(cv) * up[i];
      }
      if (!dry) *(uint4*)(cu + (size_t)row * 5632 + 2816 + j0) = pack8(a);
      if (prompt && t >= 8190) {
        float* o = p.out + O_PCONV + (size_t)((l * 2 + b) * 2 + (t - 8190)) * 2816 + j0;
        *(float4*)o = make_float4(c0[0], c0[1], c0[2], c0[3]); *(float4*)(o + 4) = make_float4(c0[4], c0[5], c0[6], c0[7]);
      } else if (!prompt && t >= 2) {
        float* o = p.out + O_SCONV + (size_t)((l * 128 + b) * 2 + (t - 2)) * 2816 + j0;
        *(float4*)o = make_float4(c0[0], c0[1], c0[2], c0[3]); *(float4*)(o + 4) = make_float4(c0[4], c0[5], c0[6], c0[7]);
      }
#pragma unroll
      for (int i = 0; i < 8; ++i) { c2[i] = c1[i]; c1[i] = c0[i]; }
    }
  }
}

__device__ __forceinline__ void phase_final(const Params& p) {
  float* X = p.out;
  const float* g = p.in[29];
  for (int it = blockIdx.x; it < 2112; it += gridDim.x) {
    const int tid = opq(threadIdx.x);
    const int lane = tid & 63;
    const int row = it * 8 + (tid >> 6);
    float4 v[4];
    float ss = 0.f;
#pragma unroll
    for (int i = 0; i < 4; ++i) {
      v[i] = *(const float4*)(X + (size_t)row * 1024 + i * 256 + lane * 4);
      ss += v[i].x * v[i].x + v[i].y * v[i].y + v[i].z * v[i].z + v[i].w * v[i].w;
    }
    ss = wave_sum(ss);
    const float rs = rsqrtf(ss * (1.f / 1024.f) + 1e-6f);
#pragma unroll
    for (int i = 0; i < 4; ++i) {
      const float4 gg = *(const float4*)(g + i * 256 + lane * 4);
      *(float4*)(X + (size_t)row * 1024 + i * 256 + lane * 4) =
          make_float4(v[i].x * rs * gg.x, v[i].y * rs * gg.y, v[i].z * rs * gg.z, v[i].w * rs * gg.w);
    }
  }
}

#if COOP
#define PH_SYNC(idx) do { if ((idx) + 1 < ph_hi && (idx) >= ph_lo) cg::this_grid().sync(); } while (0)
#else
#define PH_SYNC(idx) do { } while (0)
#endif
#define PH_ON(idx, bit) (((KMASK >> (bit)) & 1) && ph_lo <= (idx) && (idx) < ph_hi)

__device__ __forceinline__ Params load_params() {
  auto kp0 = __builtin_amdgcn_kernarg_segment_ptr();
  asm volatile("" : "+s"(kp0));
  auto kq = (const __constant__ unsigned long long*)kp0;
  Params p;
#pragma unroll
  for (int i = 0; i < 30; ++i) p.in[i] = (const float*)kq[i];
  p.out = (float*)kq[30];
  p.ws = (unsigned char*)kq[31];
  p.ph_lo = 0; p.ph_hi = 0;
  return p;
}

template <int KMASK, int l>
__device__ __forceinline__ void layer_phases(int ph_lo, int ph_hi, unsigned char* lds_raw) {
  float* ldsf = (float*)lds_raw;
  u16* ldsh = (u16*)lds_raw;
  const int base = l * 12;
  if (PH_ON(base + 0, 0)) { const Params p = load_params(); RPT(0) phase_prep(p, l, 0, ldsf); }
  PH_SYNC(base + 0);
  if (PH_ON(base + 1, 1)) {
    const Params p = load_params();
    EpiInproj E; E.z = (u16*)(p.ws + WS_Z); E.out = p.out; E.l = l;
    RPT(1) run_gemm(lds_raw, (const u16*)(p.ws + WS_H), 1024, (const u16*)(p.ws + WS_WT) + WT_IN, 2560, 1024, E);
  }
  PH_SYNC(base + 1);
  if (PH_ON(base + 2, 2)) {
    const Params p = load_params();
    for (int it = blockIdx.x; it < 264; it += gridDim.x) rope_item(p, l, it, false);
    if (blockIdx.x < 64) rwkv_item(p, l, 2048 + blockIdx.x, ldsf, false);
    {
      const Params p2 = load_params();
      int i0, n;
      if (gridDim.x == 256) { if (blockIdx.x < 64) { i0 = blockIdx.x * 5; n = 5; } else { i0 = 320 + (blockIdx.x - 64) * 9; n = 9; } }
      else { i0 = 0; n = 0; }
      RPT(2) {
        if (gridDim.x == 256) { for (int i = 0; i < n; ++i) rwkv_item2(p2, l, i0 + i, ldsf); }
        else { for (int it = blockIdx.x; it < 2048; it += gridDim.x) rwkv_item2(p2, l, it, ldsf); }
      }
    }
  }
  PH_SYNC(base + 2);
  if (PH_ON(base + 3, 3)) {
    const Params p = load_params();
    if (blockIdx.x < 16) { RPT(3) rwkv_scan(p, l, blockIdx.x, ldsf, DRY(3)); }
    else {
      RPT(15) for (int it = blockIdx.x - 16; it < 512; it += gridDim.x - 16) {
        if (it < 256) attn_prompt(p, l, it, ldsh, DRY(15)); else attn_sample(p, l, it - 256, ldsf, DRY(15));
      }
    }
  }
  PH_SYNC(base + 3);
  if (PH_ON(base + 4, 4)) {
    const Params p = load_params();
    RPT(4) for (int it = blockIdx.x; it < 2048; it += gridDim.x) rwkv_out(p, l, it, ldsf);
  }
  PH_SYNC(base + 4);
  if (PH_ON(base + 5, 5)) {
    const Params p = load_params();
    EpiStoreBf16 E1; E1.O = (u16*)(p.ws + WS_T1); E1.ldc = 1024;
    RPT(5) run_gemm(lds_raw, (const u16*)(p.ws + WS_Z), ZLD, (const u16*)(p.ws + WS_WT) + WT_BRA, 1024, 512, E1);
    EpiStoreBf16 E2; E2.O = (u16*)(p.ws + WS_T2); E2.ldc = 1024;
    run_gemm(lds_raw, (const u16*)(p.ws + WS_Z) + 1792, ZLD, (const u16*)(p.ws + WS_WT) + WT_BRB, 1024, 512, E2);
  }
  PH_SYNC(base + 5);
  if (PH_ON(base + 6, 6)) {
    const Params p = load_params();
    EpiMerge E; E.t1 = (const u16*)(p.ws + WS_T1); E.t2 = (const u16*)(p.ws + WS_T2); E.mg = (u16*)(p.ws + WS_MG);
    RPT(6) run_gemm(lds_raw, (const u16*)(p.ws + WS_H), 1024, (const u16*)(p.ws + WS_WT) + WT_G, 2048, 1024, E);
  }
  PH_SYNC(base + 6);
  if (PH_ON(base + 7, 7)) {
    const Params p = load_params();
    EpiResid E; E.X = p.out;
    RPT(7) { E.dry = DRY(7); run_gemm(lds_raw, (const u16*)(p.ws + WS_MG), 1024, (const u16*)(p.ws + WS_WT) + WT_OUT, 1024, 1024, E); }
  }
  PH_SYNC(base + 7);
  if (PH_ON(base + 8, 8)) { const Params p = load_params(); RPT(8) phase_prep(p, l, 1, ldsf); }
  PH_SYNC(base + 8);
  if (PH_ON(base + 9, 9)) {
    const Params p = load_params();
    EpiFfnIn E; E.cu = (u16*)(p.ws + WS_CU);
    RPT(9) run_gemm(lds_raw, (const u16*)(p.ws + WS_H), 1024, (const u16*)(p.ws + WS_WTF) + WT_FIN, 5632, 1024, E);
  }
  PH_SYNC(base + 9);
  if (PH_ON(base + 10, 10)) { const Params p = load_params(); RPT(10) phase_convgelu(p, l, DRY(10)); }
  PH_SYNC(base + 10);
  if (PH_ON(base + 11, 11)) {
    const Params p = load_params();
    EpiResid E; E.X = p.out;
    RPT(11) { E.dry = DRY(11); run_gemm(lds_raw, (const u16*)(p.ws + WS_CU) + 2816, 5632, (const u16*)(p.ws + WS_WTF) + WT_FDN, 1024, 2816, E); }
  }
  PH_SYNC(base + 11);
}

template <int KMASK>
__global__ void __launch_bounds__(NT) fwd_kernel(Params pin) {
  extern __shared__ __attribute__((aligned(16))) unsigned char lds_raw[];
  const int ph_lo = pin.ph_lo, ph_hi = pin.ph_hi;
  layer_phases<KMASK, 0>(ph_lo, ph_hi, lds_raw);
  layer_phases<KMASK, 1>(ph_lo, ph_hi, lds_raw);
  if (PH_ON(NPH - 1, 12)) { const Params p = load_params(); phase_final(p); }
}

extern "C" void kernel_launch(void* const* d_in, const int* in_sizes, int n_in, void* d_out, int out_size, void* d_ws,
                              size_t ws_size, hipStream_t stream) {
  static int grid = 0;
  if (grid == 0) {
    int dev = 0, cus = 0;
    (void)hipGetDevice(&dev);
    (void)hipDeviceGetAttribute(&cus, hipDeviceAttributeMultiprocessorCount, dev);
    grid = cus > 0 ? cus : 256;
    (void)hipFuncSetAttribute((const void*)fwd_kernel<PHMASK>, hipFuncAttributeMaxDynamicSharedMemorySize, LDS_BYTES);
    (void)hipGetLastError();
  }
  Params p{};
  for (int i = 0; i < 30; ++i) p.in[i] = (const float*)d_in[i];
  p.out = (float*)d_out;
  p.ws = (unsigned char*)d_ws;
#if COOP
  p.ph_lo = 0; p.ph_hi = NPH;
  void* args[] = {&p};
  hipError_t e = hipLaunchCooperativeKernel((const void*)fwd_kernel<PHMASK>, dim3(grid), dim3(NT), args, LDS_BYTES, stream);
  if (e != hipSuccess) fprintf(stderr, "cooperative launch failed: %s (grid %d)\n", hipGetErrorString(e), grid);
#else
  for (int ph = 0; ph < NPH; ++ph) {
    p.ph_lo = ph; p.ph_hi = ph + 1;
    hipLaunchKernelGGL(fwd_kernel<PHMASK>, dim3(grid), dim3(NT), LDS_BYTES, stream, p);
  }
#endif
}
```

```cpp
#include <hip/hip_runtime.h>
#include <hip/hip_bf16.h>
#include <hip/hip_cooperative_groups.h>
#include <cstdio>
namespace cg = cooperative_groups;

typedef __attribute__((ext_vector_type(8))) short bf16x8;
typedef __attribute__((ext_vector_type(16))) float f32x16;
typedef unsigned short u16;

#ifndef PHMASK
#define PHMASK 0x1FFF
#endif
#ifndef T3
#define T3 7
#endif
#ifndef P2SEL
#define P2SEL 7
#endif
#ifndef RPT_MASK
#define RPT_MASK 0
#endif
#ifndef RPT_N
#define RPT_N 1
#endif
#define RPT(bit) for (int rp_ = 0; rp_ < (((RPT_MASK >> (bit)) & 1) ? 1 + RPT_N : 1); ++rp_)
#define RPT_CNT(bit) (((RPT_MASK >> (bit)) & 1) ? 1 + RPT_N : 1)
#define DRY(bit) (opq(rp_) + 1 < RPT_CNT(bit))
#ifndef COOP
#define COOP 1
#endif

#define NT 512
#define M_TOT 16896
#define M_P 16384
#define ZLD 2560
#define NPH 25

#define WS_WT   0ull
#define WS_H    13631488ull
#define WS_Z    48234496ull
#define WS_R    134742016ull
#define WS_PP   (WS_R)
#define WS_GC   (WS_R + 16777216ull)
#define WS_Q    (WS_R + 17301504ull)
#define WS_W2   (WS_R + 50855936ull)
#define WS_YL   (WS_R + 67633152ull)
#define WS_BO   (WS_R + 84410368ull)
#define WS_GA   (WS_R + 101187584ull)
#define WS_T1   (WS_R)
#define WS_T2   (WS_R + 34603008ull)
#define WS_MG   (WS_R + 69206016ull)
#define WS_WTF  (WS_Z)
#define WS_CU   (WS_Z + 17301504ull)
#define WT_IN  0
#define WT_G   2621440
#define WT_BRA 4718592
#define WT_BRB 5242880
#define WT_OUT 5767168
#define WT_FIN 0
#define WT_FDN 5767168
#define O_PSHIFT 17301504
#define O_PWKV   17308672
#define O_PK     17439744
#define O_PV     17505280
#define O_PCONV  17570816
#define O_SSHIFT 17593344
#define O_SWKV   18052096
#define O_SK     26440704
#define O_SV     30635008
#define O_SCONV  34829312

#define LDS_BYTES 151552

struct Params {
  const float* in[30];
  float* out;
  unsigned char* ws;
  int ph_lo, ph_hi;
};

typedef float f2v_ __attribute__((ext_vector_type(2)));
typedef __bf16 b2v_ __attribute__((ext_vector_type(2)));
__device__ __forceinline__ unsigned pack2(float a, float b) { f2v_ v = {a, b}; b2v_ r = __builtin_convertvector(v, b2v_); return __builtin_bit_cast(unsigned, r); }
__device__ __forceinline__ u16 f2bf(float f) { return (u16)(pack2(f, f) & 0xFFFFu); }
__device__ __forceinline__ float bf2f(u16 h) { return __uint_as_float(((unsigned)h) << 16); }
__device__ __forceinline__ float sigm(float x) { return __builtin_amdgcn_rcpf(1.f + __expf(-x)); }
__device__ __forceinline__ void unpack8(uint4 u, float* o) {
  o[0] = __uint_as_float(u.x << 16); o[1] = __uint_as_float(u.x & 0xFFFF0000u);
  o[2] = __uint_as_float(u.y << 16); o[3] = __uint_as_float(u.y & 0xFFFF0000u);
  o[4] = __uint_as_float(u.z << 16); o[5] = __uint_as_float(u.z & 0xFFFF0000u);
  o[6] = __uint_as_float(u.w << 16); o[7] = __uint_as_float(u.w & 0xFFFF0000u);
}
__device__ __forceinline__ uint4 pack8(const float* f) {
  uint4 u; u.x = pack2(f[0], f[1]); u.y = pack2(f[2], f[3]); u.z = pack2(f[4], f[5]); u.w = pack2(f[6], f[7]); return u;
}
__device__ __forceinline__ float gelu_fast(float v) {
  const float av = fabsf(v), d = av * 0.2316418882f + 1.0f;
  const float t = __builtin_amdgcn_rcpf(d);
  float q = t * 0.5307027145f + (-0.7265760135f); q = q * t + 0.7107068705f; q = q * t + (-0.142248368f); q = q * t + 0.127414796f; q = q * t;
  const float e = __builtin_amdgcn_exp2f((v * v) * (-0.72134752044f));
  const float m = v * (q * e);
  return v < 0.f ? m : v - m;
}
__device__ __forceinline__ int opq(int x) { asm volatile("" : "+v"(x)); return x; }
__device__ __forceinline__ float wave_sum(float x) {
#pragma unroll
  for (int o = 32; o >= 1; o >>= 1) x += __shfl_xor(x, o, 64);
  return x;
}

namespace pg8 {
#define PG8_LAS __attribute__((address_space(3)))
typedef unsigned short bf16_t;
typedef short bf16x8 __attribute__((ext_vector_type(8)));
typedef float f32x4 __attribute__((ext_vector_type(4)));
typedef unsigned u32x4 __attribute__((ext_vector_type(4)));
constexpr int BM = 256, BK = 64, HALF = 128, HTB = HALF * BK * 2  , STAGE_BYTES = 8 * HTB, NXCD = 8, WGM = 8;
__host__ __device__ __forceinline__ int lds_byte(int r, int c) { const int st = (r >> 4) * 2 + (c >> 5), rr = r & 15, cc = c & 31, ob = rr * 64 + cc * 2; return st * 1024 + (ob ^ (((ob >> 9) & 1) << 5)); }
__host__ __device__ __forceinline__ void stage_rc(int b, int& R, int& C) { const int st = b / 1024, sb = b % 1024, swz = sb ^ (((sb >> 9) & 1) << 5); R = (st >> 1) * 16 + swz / 64; C = (st & 1) * 32 + (swz % 64) / 2; }
__host__ __device__ __forceinline__ int perm32(int rho) { const int n = rho >> 4, i = rho & 15; return 8 * (i >> 2) + 4 * n + (i & 3); }
struct Unit { int pm, pn; };
struct Gemm { const bf16_t* A; const bf16_t* Bt; int M, N, K, lda; };
struct StaticOrder {
    int nM, nN, nwg, G, c;
    __host__ __device__ void init(int M, int N, int G_, int c_) { nM = M / BM; nN = N / BM; nwg = nM * nN; G = G_; c = c_; }
    __host__ __device__ bool next(int i, Unit& u) const {
        const long L = (long)i * G + c; if (L >= nwg) return false;
        int wgid = (int)L; { const int q = nwg / NXCD, r = nwg % NXCD, xcd = wgid % NXCD, off = wgid / NXCD; wgid = (xcd < r ? xcd * (q + 1) : r * (q + 1) + (xcd - r) * q) + off; }
        const int nig = WGM * nN, gid = wgid / nig, fm = gid * WGM, gsz = (nM - fm) < WGM ? (nM - fm) : WGM;
        u.pm = fm + ((wgid % nig) % gsz); u.pn = (wgid % nig) / gsz; return true;
    }
    __device__ __forceinline__ void a_ready(const Unit&) const {}
    __device__ __forceinline__ void done(const Unit&) const {}
};
__device__ __forceinline__ unsigned cvt_pk_bf16(float lo, float hi) { return ::pack2(lo, hi); }
template <class Epi, class Sched, bool STAMP = false>
__device__ __forceinline__ void gemm_phase(PG8_LAS unsigned char* lds, const Gemm g, const Sched& S, const Epi& E, unsigned long long* stamps) {
    const int tid = ::opq(threadIdx.x), wid = __builtin_amdgcn_readfirstlane(tid >> 6), lane = tid & 63, wr = wid >> 2, wc = wid & 3, fr = lane & 15, fq = lane >> 4;
    const int K = g.K, nt = K / BK;
    int ts_lo = 0, ts_hi = 0, nts = 0; const unsigned long long rt_entry = 0ull;
#define PG8_STAMP() do { if (STAMP && wid == 0 && nts < 64) { const unsigned long long _c = (unsigned long long)clock64(); \
        ts_lo = (lane == nts) ? (int)(unsigned)_c : ts_lo; ts_hi = (lane == nts) ? (int)(unsigned)(_c >> 32) : ts_hi; ++nts; } } while (0)
    PG8_STAMP();
    unsigned voffA[2], voffB[2];
#pragma unroll
    for (int i = 0; i < 2; ++i) { int R, C; stage_rc(tid * 16 + i * 8192, R, C); const int Rb = Epi::PERM ? ((R & ~31) + perm32(R & 31)) : R;
        voffA[i] = (unsigned)(R * g.lda + C) * 2u; voffB[i] = (unsigned)(Rb * K + C) * 2u; }
    const size_t kstep = (size_t)(BK * 2);
    const size_t hstep = (size_t)HALF * K * 2;
    const size_t tstep = 2 * hstep; const size_t hstepA = (size_t)HALF * g.lda * 2; const size_t tstepA = 2 * hstepA;
    const unsigned ldsw = (unsigned)wid * 1024u;
    const int aoff = lds_byte(wr * 64 + fr, fq * 8), boff = lds_byte(wc * 32 + fr, fq * 8);
#define PG8_SA(b, h) (((b) * 2 + (h)) * HTB)
#define PG8_SB(b, h) ((4 + (b) * 2 + (h)) * HTB)
#define PG8_STAGE(bufoff, gbase, voff) do { _Pragma("unroll") for (int _i = 0; _i < 2; ++_i) \
        __builtin_amdgcn_global_load_lds((const unsigned*)((const char*)(gbase) + (voff)[_i]), (PG8_LAS unsigned*)(lds + (bufoff) + ldsw + _i * 8192), 16, 0, 0); } while (0)
#define PG8_LDA(dst, b, h) do { _Pragma("unroll") for (int m = 0; m < 4; ++m) _Pragma("unroll") for (int k = 0; k < 2; ++k) dst[m][k] = *(const PG8_LAS bf16x8*)(lds + PG8_SA(b, h) + aoff + m * 2048 + k * 1024); } while (0)
#define PG8_LDB(dst, b, h) do { _Pragma("unroll") for (int n = 0; n < 2; ++n) _Pragma("unroll") for (int k = 0; k < 2; ++k) dst[n][k] = *(const PG8_LAS bf16x8*)(lds + PG8_SB(b, h) + boff + n * 2048 + k * 1024); } while (0)
#define PG8_MMA(ai, bj, At, Bt) do { __builtin_amdgcn_s_setprio(1); _Pragma("unroll") for (int m = 0; m < 4; ++m) _Pragma("unroll") for (int n = 0; n < 2; ++n) _Pragma("unroll") for (int k = 0; k < 2; ++k) \
        acc[ai][bj][m][n] = __builtin_amdgcn_mfma_f32_16x16x32_bf16(Bt[n][k], At[m][k], acc[ai][bj][m][n], 0, 0, 0); __builtin_amdgcn_s_setprio(0); } while (0)
#define PG8_WAIT_V(n) asm volatile("s_waitcnt vmcnt(" #n ")" ::: "memory")
#define PG8_WAIT_L(n) asm volatile("s_waitcnt lgkmcnt(" #n ")" ::: "memory")
#define PG8_BAR __builtin_amdgcn_s_barrier()
#define PG8_SCHED __builtin_amdgcn_sched_barrier(0)
    Unit cur, nxt; int ui = 0;
    if (!S.next(0, cur)) return;
    f32x4 acc[2][2][4][2];
#pragma unroll
    for (int a = 0; a < 2; ++a)
#pragma unroll
        for (int b = 0; b < 2; ++b)
#pragma unroll
            for (int m = 0; m < 4; ++m)
#pragma unroll
                for (int n = 0; n < 2; ++n) acc[a][b][m][n] = (f32x4){0.f, 0.f, 0.f, 0.f};
    bf16x8 At[4][2], B0[2][2], B1[2][2];
    const char* cA = (const char*)g.A + (size_t)cur.pm * tstepA; const char* cB = (const char*)g.Bt + (size_t)cur.pn * tstep;
    S.a_ready(cur);
    PG8_STAGE(PG8_SB(0, 0), cB, voffB); PG8_STAGE(PG8_SA(0, 0), cA, voffA); PG8_STAGE(PG8_SB(0, 1), cB + hstep, voffB); PG8_STAGE(PG8_SA(0, 1), cA + hstepA, voffA);
    if (wr == 1) PG8_BAR;
    PG8_WAIT_V(4); PG8_BAR;
    PG8_STAGE(PG8_SB(1, 0), cB + kstep, voffB); PG8_STAGE(PG8_SA(1, 0), cA + kstep, voffA); PG8_STAGE(PG8_SB(1, 1), cB + hstep + kstep, voffB);
    PG8_WAIT_V(6); PG8_BAR;
    PG8_STAMP();
    for (;;) {
        const bool has_next = S.next(ui + 1, nxt);
        const char* nA = has_next ? (const char*)g.A + (size_t)nxt.pm * tstepA : cA; const char* nB = has_next ? (const char*)g.Bt + (size_t)nxt.pn * tstep : cB;
        for (int t = 0; t < nt; t += 2) {
            const bool last = (t == nt - 2);
            const char* a1 = cA + (size_t)(t + 1) * kstep;
            const char* a2 = last ? nA : cA + (size_t)(t + 2) * kstep; const char* b2 = last ? nB : cB + (size_t)(t + 2) * kstep;
            const char* a3 = a2 + kstep; const char* b3 = b2 + kstep;
            if (last && has_next) S.a_ready(nxt);
            PG8_LDB(B0, 0, 0); PG8_SCHED; PG8_LDA(At, 0, 0); PG8_STAGE(PG8_SA(1, 1), a1 + hstepA, voffA);
            PG8_WAIT_L(8); PG8_BAR; PG8_WAIT_L(0); PG8_MMA(0, 0, At, B0); PG8_BAR; PG8_SCHED;
            PG8_LDB(B1, 0, 1); PG8_STAGE(PG8_SB(0, 0), b2, voffB);
            PG8_BAR; PG8_WAIT_L(0); PG8_MMA(0, 1, At, B1); PG8_BAR;
            PG8_LDA(At, 0, 1); PG8_STAGE(PG8_SA(0, 0), a2, voffA);
            PG8_BAR; PG8_WAIT_L(0); PG8_MMA(1, 0, At, B0); PG8_BAR; PG8_SCHED;
            PG8_STAGE(PG8_SB(0, 1), b2 + hstep, voffB);
            PG8_WAIT_V(6); PG8_BAR; PG8_MMA(1, 1, At, B1); PG8_BAR;
            PG8_LDB(B0, 1, 0); PG8_SCHED; PG8_LDA(At, 1, 0); PG8_STAGE(PG8_SA(0, 1), a2 + hstepA, voffA);
            PG8_WAIT_L(8); PG8_BAR; PG8_WAIT_L(0); PG8_MMA(0, 0, At, B0); PG8_BAR; PG8_SCHED;
            PG8_LDB(B1, 1, 1); PG8_STAGE(PG8_SB(1, 0), b3, voffB);
            PG8_BAR; PG8_WAIT_L(0); PG8_MMA(0, 1, At, B1); PG8_BAR;
            PG8_LDA(At, 1, 1); PG8_STAGE(PG8_SA(1, 0), a3, voffA);
            PG8_BAR; PG8_WAIT_L(0); PG8_MMA(1, 0, At, B0); PG8_BAR; PG8_SCHED;
            PG8_STAGE(PG8_SB(1, 1), b3 + hstep, voffB);
            PG8_WAIT_V(6); PG8_BAR; PG8_MMA(1, 1, At, B1); PG8_BAR;
        }
        PG8_STAMP();
        if constexpr (!Epi::AFTER_DRAIN) { E(acc, cur, wr, wc, fr, fq); S.done(cur); }
        PG8_STAMP();
        if (!has_next) break;
#pragma unroll
        for (int a = 0; a < 2; ++a)
#pragma unroll
            for (int b = 0; b < 2; ++b)
#pragma unroll
                for (int m = 0; m < 4; ++m)
#pragma unroll
                    for (int n = 0; n < 2; ++n) acc[a][b][m][n] = (f32x4){0.f, 0.f, 0.f, 0.f};
        cur = nxt; cA = nA; cB = nB; ++ui;
    }
    PG8_WAIT_V(0);
    if (wr == 0) PG8_BAR;
    PG8_BAR;
    if constexpr (Epi::AFTER_DRAIN) { E.fused(acc, cur, wr, wc, fr, fq, lds, wid, lane); S.done(cur); }
    PG8_STAMP();
    if (STAMP && wid == 0) { stamps[lane] = lane < nts ? (((unsigned long long)(unsigned)ts_hi << 32) | (unsigned)ts_lo) : 0ull;
        if (lane == 62) stamps[62] = rt_entry; if (lane == 63) stamps[63] = (unsigned long long)wall_clock64(); }
#undef PG8_STAMP
#undef PG8_SA
#undef PG8_SB
#undef PG8_STAGE
#undef PG8_LDA
#undef PG8_LDB
#undef PG8_MMA
#undef PG8_WAIT_V
#undef PG8_WAIT_L
#undef PG8_BAR
#undef PG8_SCHED
}
}
using pg8::f32x4;
#define ROWOFF(reg, h) (((reg) & 3) + 8 * ((reg) >> 2) + 4 * (h))

__device__ __forceinline__ void conv_tile(const float* __restrict__ src, int K, int N, u16* __restrict__ dst, int k0, int n0, int sn0, float* lds) {
  const int tid = opq(threadIdx.x);
  __syncthreads();
  {
    const int k = tid >> 3, c = (tid & 7) * 8;
    const float* s = src + (size_t)(k0 + k) * N + sn0 + c;
    float4 a = *(const float4*)s, b = *(const float4*)(s + 4);
    float* d = lds + k * 65 + c;
    d[0] = a.x; d[1] = a.y; d[2] = a.z; d[3] = a.w;
    d[4] = b.x; d[5] = b.y; d[6] = b.z; d[7] = b.w;
  }
  __syncthreads();
  {
    const int n = tid >> 3, kk = (tid & 7) * 8;
    float f[8];
#pragma unroll
    for (int i = 0; i < 8; ++i) f[i] = lds[(kk + i) * 65 + n];
    *(uint4*)(dst + (size_t)(n0 + n) * K + k0 + kk) = pack8(f);
  }
}

__device__ __forceinline__ void phase_prep(const Params& p, int l, int which, float* ldsf) {
  u16* WtA = (u16*)(p.ws + WS_WT);
  u16* WtF = (u16*)(p.ws + WS_WTF);
  u16* H = (u16*)(p.ws + WS_H);
  float* X = p.out;
  const int nconv = which == 0 ? (640 + 512 + 128 + 128 + 256) : (1408 + 704);
  const int ntot = nconv + 2112;
  const float* gw = (which == 0 ? p.in[7] : p.in[24]) + l * 1024;
  for (int it = blockIdx.x; it < ntot; it += gridDim.x) {
    if (it < nconv) {
      int t = it;
      if (which == 0) {
        if (t < 640) { const int tk = t / 40, tn = t % 40; conv_tile(p.in[8] + (size_t)l * 1024 * 4608, 1024, 4608, WtA + WT_IN, tk * 64, tn * 64, tn * 64, ldsf); }
        else if ((t -= 640) < 512) {
          const int tk = t / 32, tn = t % 32; const int n0 = tn * 64;
          const int sn0 = 2560 + ((n0 >> 7) & 1) * 1024 + (n0 >> 8) * 128 + (n0 & 127);
          conv_tile(p.in[8] + (size_t)l * 1024 * 4608, 1024, 4608, WtA + WT_G, tk * 64, n0, sn0, ldsf);
        }
        else if ((t -= 512) < 128) { const int tk = t / 16, tn = t % 16; conv_tile(p.in[21] + (size_t)l * 512 * 1024, 512, 1024, WtA + WT_BRA, tk * 64, tn * 64, tn * 64, ldsf); }
        else if ((t -= 128) < 128) { const int tk = t / 16, tn = t % 16; conv_tile(p.in[22] + (size_t)l * 512 * 1024, 512, 1024, WtA + WT_BRB, tk * 64, tn * 64, tn * 64, ldsf); }
        else { t -= 128; const int tk = t / 16, tn = t % 16; conv_tile(p.in[23] + (size_t)l * 1024 * 1024, 1024, 1024, WtA + WT_OUT, tk * 64, tn * 64, tn * 64, ldsf); }
      } else {
        if (t < 1408) {
          const int tk = t / 88, tn = t % 88; const int n0 = tn * 64;
          const int sn0 = ((n0 >> 7) & 1) * 2816 + (n0 >> 8) * 128 + (n0 & 127);
          conv_tile(p.in[25] + (size_t)l * 1024 * 5632, 1024, 5632, WtF + WT_FIN, tk * 64, n0, sn0, ldsf);
        } else { t -= 1408; const int tk = t / 16, tn = t % 16; conv_tile(p.in[28] + (size_t)l * 2816 * 1024, 2816, 1024, WtF + WT_FDN, tk * 64, tn * 64, tn * 64, ldsf); }
      }
    } else {
      const int tid = opq(threadIdx.x);
      const int row = (it - nconv) * 8 + (tid >> 6);
      const int lane = tid & 63;
      const bool first = (which == 0 && l == 0);
      const float* src;
      if (first) src = (row < M_P) ? p.in[0] + (size_t)row * 1024 : p.in[1] + (size_t)(row - M_P) * 1024;
      else src = X + (size_t)row * 1024;
      float4 v[4];
      float ss = 0.f;
#pragma unroll
      for (int i = 0; i < 4; ++i) {
        v[i] = *(const float4*)(src + i * 256 + lane * 4);
        ss += v[i].x * v[i].x + v[i].y * v[i].y + v[i].z * v[i].z + v[i].w * v[i].w;
        if (first) *(float4*)(X + (size_t)row * 1024 + i * 256 + lane * 4) = v[i];
      }
      ss = wave_sum(ss);
      const float rs = rsqrtf(ss * (1.f / 1024.f) + 1e-6f);
#pragma unroll
      for (int i = 0; i < 4; ++i) {
        const float4 g = *(const float4*)(gw + i * 256 + lane * 4);
        uint2 o; o.x = pack2(v[i].x * rs * g.x, v[i].y * rs * g.y); o.y = pack2(v[i].z * rs * g.z, v[i].w * rs * g.w);
        *(uint2*)(H + (size_t)row * 1024 + i * 256 + lane * 4) = o;
      }
    }
  }
}

struct EpiInproj {
  static constexpr bool PERM = true, AFTER_DRAIN = false;
  u16* z; float* out; int l;
  __device__ __forceinline__ void operator()(const f32x4 (&acc)[2][2][4][2], const pg8::Unit& u, int wr, int wc, int fr, int fq) const {
    const int row0 = u.pm * 256 + wr * 64 + fr, col0 = u.pn * 256 + wc * 32 + 8 * fq;
#pragma unroll
    for (int ai = 0; ai < 2; ++ai)
#pragma unroll
      for (int m = 0; m < 4; ++m) {
        const int row = row0 + ai * 128 + m * 16;
        u16* rowp = z + (size_t)row * ZLD + col0;
#pragma unroll
        for (int bj = 0; bj < 2; ++bj) {
          const f32x4 v0 = acc[ai][bj][m][0], v1 = acc[ai][bj][m][1];
          pg8::u32x4 w; w.x = pg8::cvt_pk_bf16(v0[0], v0[1]); w.y = pg8::cvt_pk_bf16(v0[2], v0[3]); w.z = pg8::cvt_pk_bf16(v1[0], v1[1]); w.w = pg8::cvt_pk_bf16(v1[2], v1[3]);
          *(pg8::u32x4*)(rowp + bj * 128) = w;
        }
        const bool prompt = row < M_P;
        int b, t;
        if (prompt) { b = row >> 13; t = row & 8191; } else { b = (row - M_P) >> 2; t = (row - M_P) & 3; }
        if (u.pn < 7) {
          if ((prompt && t == 8191) || (!prompt && t == 3)) {
            float* o = out + (prompt ? O_PSHIFT + (size_t)(l * 2 + b) * 1792 : O_SSHIFT + (size_t)(l * 128 + b) * 1792) + col0;
#pragma unroll
            for (int bj = 0; bj < 2; ++bj) { *(f32x4*)(o + bj * 128) = acc[ai][bj][m][0]; *(f32x4*)(o + bj * 128 + 4) = acc[ai][bj][m][1]; }
          }
        } else if (u.pn == 9 && prompt && t >= 8064) {
          const int c = wc * 32 + 8 * fq;
          float* o = out + O_PV + ((size_t)((l * 2 + b) * 128 + (t - 8064)) * 2 + (c >> 6)) * 64 + (c & 63);
          *(f32x4*)o = acc[ai][1][m][0]; *(f32x4*)(o + 4) = acc[ai][1][m][1];
        }
      }
  }
};
struct EpiStoreBf16 {
  static constexpr bool PERM = true, AFTER_DRAIN = false;
  u16* O; int ldc;
  __device__ __forceinline__ void operator()(const f32x4 (&acc)[2][2][4][2], const pg8::Unit& u, int wr, int wc, int fr, int fq) const {
    const int row0 = u.pm * 256 + wr * 64 + fr, col0 = u.pn * 256 + wc * 32 + 8 * fq;
#pragma unroll
    for (int ai = 0; ai < 2; ++ai)
#pragma unroll
      for (int m = 0; m < 4; ++m) {
        u16* rowp = O + (size_t)(row0 + ai * 128 + m * 16) * ldc + col0;
#pragma unroll
        for (int bj = 0; bj < 2; ++bj) {
          const f32x4 v0 = acc[ai][bj][m][0], v1 = acc[ai][bj][m][1];
          pg8::u32x4 w; w.x = pg8::cvt_pk_bf16(v0[0], v0[1]); w.y = pg8::cvt_pk_bf16(v0[2], v0[3]); w.z = pg8::cvt_pk_bf16(v1[0], v1[1]); w.w = pg8::cvt_pk_bf16(v1[2], v1[3]);
          *(pg8::u32x4*)(rowp + bj * 128) = w;
        }
      }
  }
};
struct EpiFfnIn {
  static constexpr bool PERM = true, AFTER_DRAIN = false;
  u16* cu;
  __device__ __forceinline__ void operator()(const f32x4 (&acc)[2][2][4][2], const pg8::Unit& u, int wr, int wc, int fr, int fq) const {
    const int row0 = u.pm * 256 + wr * 64 + fr, col0 = u.pn * 128 + wc * 32 + 8 * fq;
#pragma unroll
    for (int ai = 0; ai < 2; ++ai)
#pragma unroll
      for (int m = 0; m < 4; ++m) {
        u16* rowp = cu + (size_t)(row0 + ai * 128 + m * 16) * 5632 + col0;
#pragma unroll
        for (int bj = 0; bj < 2; ++bj) {
          const f32x4 v0 = acc[ai][bj][m][0], v1 = acc[ai][bj][m][1];
          pg8::u32x4 w; w.x = pg8::cvt_pk_bf16(v0[0], v0[1]); w.y = pg8::cvt_pk_bf16(v0[2], v0[3]); w.z = pg8::cvt_pk_bf16(v1[0], v1[1]); w.w = pg8::cvt_pk_bf16(v1[2], v1[3]);
          *(pg8::u32x4*)(rowp + bj * 2816) = w;
        }
      }
  }
};
struct EpiMerge {
  static constexpr bool PERM = true, AFTER_DRAIN = false;
  const u16* t1; const u16* t2; u16* mg;
  __device__ __forceinline__ void operator()(const f32x4 (&acc)[2][2][4][2], const pg8::Unit& u, int wr, int wc, int fr, int fq) const {
    const int row0 = u.pm * 256 + wr * 64 + fr, col0 = u.pn * 128 + wc * 32 + 8 * fq;
#pragma unroll
    for (int ai = 0; ai < 2; ++ai)
#pragma unroll
      for (int m = 0; m < 4; ++m) {
        const size_t off = (size_t)(row0 + ai * 128 + m * 16) * 1024 + col0;
        float a[8], b[8], o[8];
        unpack8(*(const uint4*)(t1 + off), a);
        unpack8(*(const uint4*)(t2 + off), b);
#pragma unroll
        for (int n = 0; n < 2; ++n)
#pragma unroll
          for (int j = 0; j < 4; ++j)
            o[n * 4 + j] = sigm(acc[ai][0][m][n][j]) * a[n * 4 + j] + sigm(acc[ai][1][m][n][j]) * b[n * 4 + j];
        *(uint4*)(mg + off) = pack8(o);
        asm volatile("" ::: "memory");
      }
  }
};
struct EpiResid {
  static constexpr bool PERM = false, AFTER_DRAIN = false;
  float* X; bool dry;
  __device__ __forceinline__ void operator()(const f32x4 (&acc)[2][2][4][2], const pg8::Unit& u, int wr, int wc, int fr, int fq) const {
    const int row0 = u.pm * 256 + wr * 64 + fr, col0 = u.pn * 256 + wc * 32 + 4 * fq;
#pragma unroll
    for (int ai = 0; ai < 2; ++ai)
#pragma unroll
      for (int m = 0; m < 4; ++m) {
        float* rowp = X + (size_t)(row0 + ai * 128 + m * 16) * 1024 + col0;
#pragma unroll
        for (int bj = 0; bj < 2; ++bj)
#pragma unroll
          for (int n = 0; n < 2; ++n) { f32x4* q = (f32x4*)(rowp + bj * 128 + n * 16); const f32x4 v_ = *q + acc[ai][bj][m][n]; if (!dry) *q = v_; }
        asm volatile("" ::: "memory");
      }
  }
};
template <class Epi>
__device__ __forceinline__ void run_gemm(unsigned char* lds_raw, const u16* A, int lda, const u16* Bt, int N, int K, const Epi& E) {
  pg8::Gemm g; g.A = A; g.Bt = Bt; g.M = M_TOT; g.N = N; g.K = K; g.lda = lda;
  pg8::StaticOrder S; S.init(M_TOT, N, gridDim.x, blockIdx.x);
  __syncthreads();
  pg8::gemm_phase<Epi, pg8::StaticOrder, false>((PG8_LAS unsigned char*)lds_raw, g, S, E, nullptr);
  __syncthreads();
}

__device__ __forceinline__ void rope_item(const Params& p, int l, int item, bool dry = false) {
  const int tid = opq(threadIdx.x);
  u16* z = (u16*)(p.ws + WS_Z);
  const int row = item * 64 + (tid >> 3);
  const int d0 = (tid & 7) * 4;
  const bool prompt = row < M_P;
  int b, t, pos;
  if (prompt) { b = row >> 13; t = row & 8191; pos = t; } else { b = (row - M_P) >> 2; t = (row - M_P) & 3; pos = 16384 + t; }
  float cs[4], sn[4];
#pragma unroll
  for (int i = 0; i < 4; ++i) {
    const float inv = __expf(-(float)(d0 + i) * (9.210340371976184f / 32.f));
    const float angf = (float)pos * inv;
    double a = (double)angf;
    a -= 6.283185307179586 * rint(a * 0.15915494309189535);
    const float af = (float)a;
    sn[i] = __sinf(af); cs[i] = __cosf(af);
  }
#pragma unroll 2
  for (int hh = 0; hh < 10; ++hh) {
    u16* q = z + (size_t)row * ZLD + 1792 + hh * 64 + d0;
    const uint2 lo = *(const uint2*)q, hi = *(const uint2*)(q + 32);
    float x1[4] = {__uint_as_float(lo.x << 16), __uint_as_float(lo.x & 0xFFFF0000u), __uint_as_float(lo.y << 16), __uint_as_float(lo.y & 0xFFFF0000u)};
    float x2[4] = {__uint_as_float(hi.x << 16), __uint_as_float(hi.x & 0xFFFF0000u), __uint_as_float(hi.y << 16), __uint_as_float(hi.y & 0xFFFF0000u)};
    float y1[4], y2[4];
#pragma unroll
    for (int i = 0; i < 4; ++i) { y1[i] = x1[i] * cs[i] - x2[i] * sn[i]; y2[i] = x2[i] * cs[i] + x1[i] * sn[i]; }
    uint2 o1, o2;
    o1.x = pack2(y1[0], y1[1]); o1.y = pack2(y1[2], y1[3]); o2.x = pack2(y2[0], y2[1]); o2.y = pack2(y2[2], y2[3]);
    if (!dry) { *(uint2*)q = o1; *(uint2*)(q + 32) = o2; }
    if (hh >= 8 && prompt && t >= 8064) {
      float* o = p.out + O_PK + ((size_t)((l * 2 + b) * 128 + (t - 8064)) * 2 + (hh - 8)) * 64 + d0;
      *(float4*)o = make_float4(y1[0], y1[1], y1[2], y1[3]);
      *(float4*)(o + 32) = make_float4(y2[0], y2[1], y2[2], y2[3]);
    }
  }
}

#define SL(i) (ldsf + (i) * 4160)
__device__ __forceinline__ void rwkv_item(const Params& p, int l, int item, float* ldsf, bool dry = false) {
  const int tid = opq(threadIdx.x), lane = tid & 63, wave = tid >> 6;
  const bool sample = item >= 2048;
  int h, cidx, rowbase;
  if (!sample) { h = item & 7; cidx = item >> 3; rowbase = cidx * 64; }
  else { int s = item - 2048; h = s & 7; cidx = s >> 3; rowbase = M_P + cidx * 64; }
  const int cc = cidx & 127;
  const u16* z = (const u16*)(p.ws + WS_Z);
  u16* zw_ = (u16*)(p.ws + WS_Z);
  const float* mu = p.in[9] + l * 1792;
  float* wbuf = SL(7);
  float* gc = ldsf + 9 * 4160;
  float* bd = ldsf + 9 * 4160 + 64;
  __syncthreads();
  {
    const int t = tid >> 3, c8 = (tid & 7) * 8;
    const int m = rowbase + t;
    const int zcs[7] = {h * 64, 512 + h * 64, 1024 + h * 64, 1536, 1600, 1664, 1728};
#pragma unroll
    for (int gi = 0; gi < 7; ++gi) {
      const int zc = zcs[gi] + c8;
      float cur[8], prv[8];
      unpack8(*(const uint4*)(z + (size_t)m * ZLD + zc), cur);
      bool zero = false, fromstate = false;
      if (!sample) zero = (t == 0 && cc == 0);
      else fromstate = ((t & 3) == 0);
      if (zero) {
#pragma unroll
        for (int i = 0; i < 8; ++i) prv[i] = 0.f;
      } else if (fromstate) {
        const int b = (m - M_P) >> 2;
        const float* sp = p.in[2] + (size_t)(l * 128 + b) * 1792 + zc;
        float4 a = *(const float4*)sp, bb = *(const float4*)(sp + 4);
        prv[0] = a.x; prv[1] = a.y; prv[2] = a.z; prv[3] = a.w; prv[4] = bb.x; prv[5] = bb.y; prv[6] = bb.z; prv[7] = bb.w;
      } else {
        unpack8(*(const uint4*)(z + (size_t)(m - 1) * ZLD + zc), prv);
      }
      float* d = SL(gi) + t * 65 + c8;
#pragma unroll
      for (int i = 0; i < 8; ++i) {
        float v = cur[i] + mu[zc + i] * (prv[i] - cur[i]);
        if (gi == 3) v = tanhf(v);
        if (gi >= 5) v = sigm(v);
        d[i] = v;
      }
    }
  }
  const int lt = tid & 63, jg = tid >> 6;
  auto load_w = [&](const float* W, int nrows) {
    for (int e = tid; e < nrows * 8; e += NT) {
      const int i = e >> 3, c = (e & 7) * 8;
      const float* s = W + (size_t)i * 512 + h * 64 + c;
      *(float4*)(wbuf + i * 64 + c) = *(const float4*)s;
      *(float4*)(wbuf + i * 64 + c + 4) = *(const float4*)(s + 4);
    }
  };
  auto lora = [&](const float* xa, const float* xb, int n, float* acc) {
#pragma unroll 2
    for (int i = 0; i < n; ++i) {
      const float x = (i < 64) ? xa[lt * 65 + i] : xb[lt * 65 + i - 64];
      const float4 w0 = *(const float4*)(wbuf + i * 64 + jg * 8);
      const float4 w1 = *(const float4*)(wbuf + i * 64 + jg * 8 + 4);
      acc[0] += x * w0.x; acc[1] += x * w0.y; acc[2] += x * w0.z; acc[3] += x * w0.w;
      acc[4] += x * w1.x; acc[5] += x * w1.y; acc[6] += x * w1.z; acc[7] += x * w1.w;
    }
  };
  float res[8];
  load_w(p.in[11] + (size_t)l * 64 * 512, 64);
  __syncthreads();
#pragma unroll
  for (int i = 0; i < 8; ++i) res[i] = p.in[10][l * 512 + h * 64 + jg * 8 + i];
  lora(SL(3), SL(3), 64, res);
  __syncthreads();
#pragma unroll
  for (int i = 0; i < 8; ++i) {
    const float x = -res[i];
    const float sp = (x > 20.f) ? x : log1pf(__expf(x));
    SL(3)[lt * 65 + jg * 8 + i] = -__expf(-sp - 0.5f);
  }
  load_w(p.in[13] + (size_t)l * 64 * 512, 64);
  __syncthreads();
#pragma unroll
  for (int i = 0; i < 8; ++i) res[i] = p.in[12][l * 512 + h * 64 + jg * 8 + i];
  lora(SL(4), SL(4), 64, res);
  __syncthreads();
#pragma unroll
  for (int i = 0; i < 8; ++i) SL(4)[lt * 65 + jg * 8 + i] = sigm(res[i]);
  load_w(p.in[14] + (size_t)l * 128 * 512, 128);
  __syncthreads();
#pragma unroll
  for (int i = 0; i < 8; ++i) res[i] = 0.f;
  lora(SL(5), SL(6), 128, res);
  __syncthreads();
  if (!sample) {
    u16* ga = (u16*)(p.ws + WS_GA) + (size_t)item * 4096;
    *(uint4*)(ga + lt * 64 + jg * 8) = pack8(res);
    if (tid < 64) {
      float c = 0.f;
      for (int t = 0; t < 64; ++t) { c += SL(3)[t * 65 + tid]; SL(5)[t * 65 + tid] = c; }
      gc[tid] = __expf(c);
    }
  } else {
#pragma unroll
    for (int i = 0; i < 8; ++i) SL(6)[lt * 65 + jg * 8 + i] = res[i];
  }
  __syncthreads();
  {
    const int t = tid >> 3, j0 = (tid & 7) * 8;
    const float* kkw = p.in[15] + l * 512 + h * 64;
    const float* kaw = p.in[16] + l * 512 + h * 64;
    const float* rkw = p.in[17] + l * 512 + h * 64;
    float kr[8], av[8], rv[8], kkv[8], kf[8];
    float nrm = 0.f, bdot = 0.f;
#pragma unroll
    for (int i = 0; i < 8; ++i) {
      const int j = j0 + i;
      kr[i] = SL(1)[t * 65 + j]; av[i] = SL(4)[t * 65 + j]; rv[i] = SL(0)[t * 65 + j];
      kkv[i] = kr[i] * kkw[j];
      nrm += kkv[i] * kkv[i];
      kf[i] = kr[i] * (1.f + (av[i] - 1.f) * kaw[j]);
      bdot += rv[i] * kf[i] * rkw[j];
    }
    nrm += __shfl_xor(nrm, 1, 64); nrm += __shfl_xor(nrm, 2, 64); nrm += __shfl_xor(nrm, 4, 64);
    bdot += __shfl_xor(bdot, 1, 64); bdot += __shfl_xor(bdot, 2, 64); bdot += __shfl_xor(bdot, 4, 64);
    const float rn = 1.f / fmaxf(sqrtf(nrm), 1e-12f);
    if (!sample) {
      float bo[8];
#pragma unroll
      for (int i = 0; i < 8; ++i) {
        const int j = j0 + i;
        const float cum = SL(5)[t * 65 + j], dl = SL(3)[t * 65 + j];
        const float eg = __expf(cum), egi = __expf(-cum), egp = __expf(cum - dl);
        const float kk = kkv[i] * rn;
        SL(0)[t * 65 + j] = rv[i] * eg;
        SL(1)[t * 65 + j] = kf[i] * egi;
        SL(3)[t * 65 + j] = kk * av[i] * egi;
        SL(4)[t * 65 + j] = kk * egp;
        bo[i] = bdot * SL(2)[t * 65 + j];
      }
      u16* bop = (u16*)(p.ws + WS_BO) + (size_t)item * 4096;
      *(uint4*)(bop + t * 64 + j0) = pack8(bo);
    } else {
#pragma unroll
      for (int i = 0; i < 8; ++i) {
        const int j = j0 + i;
        const float kk = kkv[i] * rn;
        const float dl = SL(3)[t * 65 + j];
        SL(1)[t * 65 + j] = kf[i];
        SL(3)[t * 65 + j] = __expf(dl);
        SL(4)[t * 65 + j] = kk;
        SL(5)[t * 65 + j] = kk * av[i];
      }
      if ((tid & 7) == 0) bd[t] = bdot;
    }
  }
  __syncthreads();
  if (sample) {
    const float lng = p.in[18][l * 512 + h * 64 + lane], lnb = p.in[19][l * 512 + h * 64 + lane];
    for (int round = 0; round < 2; ++round) {
      const int seq = wave + 8 * round;
      const int b = cidx * 16 + seq;
      float S[64];
      const float* sp = p.in[3] + ((size_t)((l * 128 + b) * 8 + h) * 64 + lane) * 64;
#pragma unroll
      for (int k = 0; k < 64; k += 4) { float4 v = *(const float4*)(sp + k); S[k] = v.x; S[k + 1] = v.y; S[k + 2] = v.z; S[k + 3] = v.w; }
      for (int tt = 0; tt < 4; ++tt) {
        const int t = seq * 4 + tt;
        float sk = 0.f;
#pragma unroll
        for (int kc = 0; kc < 64; kc += 8) {
#pragma unroll
          for (int k = kc; k < kc + 8; ++k) sk += S[k] * SL(4)[t * 65 + k];
          __builtin_amdgcn_sched_barrier(0);
        }
        const float vt = SL(2)[t * 65 + lane];
        float y = 0.f;
#pragma unroll
        for (int kc = 0; kc < 64; kc += 8) {
#pragma unroll
          for (int k = kc; k < kc + 8; ++k) {
            S[k] = S[k] * SL(3)[t * 65 + k] - sk * SL(5)[t * 65 + k] + vt * SL(1)[t * 65 + k];
            y += S[k] * SL(0)[t * 65 + k];
          }
          __builtin_amdgcn_sched_barrier(0);
        }
        const float mean = wave_sum(y) * (1.f / 64.f);
        const float d = y - mean;
        const float var = wave_sum(d * d) * (1.f / 64.f);
        const float yn = d * rsqrtf(var + 64e-5f) * lng + lnb;
        const float o = (yn + bd[t] * vt) * SL(6)[t * 65 + lane];
        if (!dry) zw_[(size_t)(M_P + b * 4 + tt) * ZLD + h * 64 + lane] = f2bf(o);
      }
      float* op = p.out + O_SWKV + ((size_t)((l * 128 + b) * 8 + h) * 64 + lane) * 64;
#pragma unroll
      for (int k = 0; k < 64; k += 4) *(float4*)(op + k) = make_float4(S[k], S[k + 1], S[k + 2], S[k + 3]);
    }
    return;
  }
  {
    const int i = lane, tg = wave;
    float ab[8], ak[8], akr[8], abr[8];
#pragma unroll
    for (int q = 0; q < 8; ++q) { ab[q] = 0.f; ak[q] = 0.f; akr[q] = 0.f; abr[q] = 0.f; }
#pragma unroll 2
    for (int k = 0; k < 64; ++k) {
      const float xb = SL(3)[i * 65 + k], xk = SL(1)[i * 65 + k];
#pragma unroll
      for (int q = 0; q < 8; ++q) {
        const int t = tg * 8 + q;
        const float yk = SL(4)[t * 65 + k], yr = SL(0)[t * 65 + k];
        ab[q] += xb * yk; ak[q] += xk * yk; akr[q] += xk * yr; abr[q] += xb * yr;
      }
    }
    __syncthreads();
#pragma unroll
    for (int q = 0; q < 8; ++q) {
      const int t = tg * 8 + q;
      SL(6)[i * 65 + t] = (i < t) ? ab[q] : 0.f;
      SL(7)[i * 65 + t] = (i < t) ? ak[q] : 0.f;
      SL(8)[i * 65 + t] = (i <= t) ? akr[q] : 0.f;
      SL(5)[i * 65 + t] = (i <= t) ? abr[q] : 0.f;
    }
  }
  __syncthreads();
  {
    const int t = tid >> 3, j0 = (tid & 7) * 8;
#pragma unroll
    for (int i = 0; i < 8; ++i) { const float g = gc[j0 + i]; SL(3)[t * 65 + j0 + i] *= g; SL(1)[t * 65 + j0 + i] *= g; }
  }
  __syncthreads();
  if (tid < 128) {
    float* X_ = (tid < 64) ? SL(5) : SL(3);
    const int col = tid & 63;
    for (int i = 62; i >= 0; --i) {
      float a = X_[i * 65 + col];
#pragma unroll 4
      for (int t = i + 1; t < 64; ++t) a -= SL(6)[i * 65 + t] * X_[t * 65 + col];
      X_[i * 65 + col] = a;
    }
  }
  __syncthreads();
  {
    const int c = tid & 127, ig = tid >> 7;
    const int which = c >> 6, cq = c & 63;
    const float* N_ = which ? SL(3) : SL(5);
    float a[16];
#pragma unroll
    for (int q = 0; q < 16; ++q) a[q] = 0.f;
#pragma unroll 2
    for (int t = 0; t < 64; ++t) {
      const float n = N_[t * 65 + cq];
#pragma unroll
      for (int q = 0; q < 16; ++q) a[q] += SL(7)[(ig * 16 + q) * 65 + t] * n;
    }
    float* T_ = which ? SL(1) : SL(8);
#pragma unroll
    for (int q = 0; q < 16; ++q) T_[(ig * 16 + q) * 65 + cq] -= a[q];
  }
  __syncthreads();
  {
    const int x = lane, yg = wave;
    float w2[8], pp[8], yl[8], qq[8];
#pragma unroll
    for (int q = 0; q < 8; ++q) { w2[q] = 0.f; pp[q] = 0.f; yl[q] = 0.f; qq[q] = 0.f; }
#pragma unroll 2
    for (int j = 0; j < 64; ++j) {
      const float l5 = SL(5)[j * 65 + x], l4 = SL(4)[j * 65 + x], l8 = SL(8)[j * 65 + x], l2 = SL(2)[j * 65 + x];
#pragma unroll
      for (int q = 0; q < 8; ++q) {
        const int y = yg * 8 + q;
        w2[q] += l5 * SL(4)[j * 65 + y];
        pp[q] += l4 * SL(3)[j * 65 + y];
        yl[q] += l8 * SL(2)[j * 65 + y];
        qq[q] += l2 * SL(1)[j * 65 + y];
      }
    }
    float o1[8];
#pragma unroll
    for (int q = 0; q < 8; ++q) {
      const int y = yg * 8 + q;
      o1[q] = SL(0)[x * 65 + y] - w2[q];
    }
    u16* Pf = (u16*)(p.ws + WS_PP) + (size_t)item * 4096;
    float* Qf = (float*)(p.ws + WS_Q) + (size_t)item * 4096;
    if (tid < 64) ((float*)(p.ws + WS_GC))[(size_t)item * 64 + tid] = gc[tid];
    {
      const int s_ = x >> 4, kk = x & 15, hh = (kk >> 2) & 1, jj = ((kk >> 3) << 2) | (kk & 3);
#pragma unroll
      for (int q = 0; q < 8; ++q) {
        const int y = yg * 8 + q;
        Pf[(((y >> 5) * 4 + s_) * 64 + (y & 31) + 32 * hh) * 8 + jj] = f2bf(-pp[q]);
        const int k2 = y & 31, reg = ((k2 >> 3) << 2) | (k2 & 3), h2 = (k2 >> 2) & 1;
        Qf[(((x >> 5) * 2 + (y >> 5)) * 16 + reg) * 64 + (x & 31) + 32 * h2] = qq[q];
      }
    }
    u16* W2p = (u16*)(p.ws + WS_W2) + (size_t)item * 4096 + x * 64 + yg * 8;
    u16* YLp = (u16*)(p.ws + WS_YL) + (size_t)item * 4096 + x * 64 + yg * 8;
    *(uint4*)W2p = pack8(o1);
    *(uint4*)YLp = pack8(yl);
  }
}

__device__ __forceinline__ void mm_tile(const u16* Aop, int lda, const u16* Bop, int ldb, int mt, int nt, int r, int h, int ksteps, f32x16& acc) {
  const u16* ap = Aop + (mt * 32 + r) * lda + h * 8;
  const u16* bp = Bop + (nt * 32 + r) * ldb + h * 8;
#pragma unroll 4
  for (int s = 0; s < ksteps; ++s) {
    const bf16x8 a = *(const bf16x8*)(ap + s * 16);
    const bf16x8 b = *(const bf16x8*)(bp + s * 16);
    acc = __builtin_amdgcn_mfma_f32_32x32x16_bf16(a, b, acc, 0, 0, 0);
  }
}
__device__ __forceinline__ void store_T(u16* T, int ldt, int mt, int nt, int r, int h, const f32x16& acc) {
#pragma unroll
  for (int g = 0; g < 4; ++g) {
    uint2 o; o.x = pack2(acc[4 * g], acc[4 * g + 1]); o.y = pack2(acc[4 * g + 2], acc[4 * g + 3]);
    *(uint2*)(T + (nt * 32 + r) * ldt + mt * 32 + 8 * g + 4 * h) = o;
  }
}
__device__ __forceinline__ void tri32(const float* Ab, float* Xc) {
  const float x31 = Xc[2015];
  const float x30 = Xc[1950] - Ab[1981] * x31;
  const float x29 = Xc[1885] - Ab[1915] * x30 - Ab[1916] * x31;
  const float x28 = Xc[1820] - Ab[1849] * x29 - Ab[1850] * x30 - Ab[1851] * x31;
  const float x27 = Xc[1755] - Ab[1783] * x28 - Ab[1784] * x29 - Ab[1785] * x30 - Ab[1786] * x31;
  const float x26 = Xc[1690] - Ab[1717] * x27 - Ab[1718] * x28 - Ab[1719] * x29 - Ab[1720] * x30 - Ab[1721] * x31;
  const float x25 = Xc[1625] - Ab[1651] * x26 - Ab[1652] * x27 - Ab[1653] * x28 - Ab[1654] * x29 - Ab[1655] * x30 - Ab[1656] * x31;
  const float x24 = Xc[1560] - Ab[1585] * x25 - Ab[1586] * x26 - Ab[1587] * x27 - Ab[1588] * x28 - Ab[1589] * x29 - Ab[1590] * x30 - Ab[1591] * x31;
  const float x23 = Xc[1495] - Ab[1519] * x24 - Ab[1520] * x25 - Ab[1521] * x26 - Ab[1522] * x27 - Ab[1523] * x28 - Ab[1524] * x29 - Ab[1525] * x30 - Ab[1526] * x31;
  const float x22 = Xc[1430] - Ab[1453] * x23 - Ab[1454] * x24 - Ab[1455] * x25 - Ab[1456] * x26 - Ab[1457] * x27 - Ab[1458] * x28 - Ab[1459] * x29 - Ab[1460] * x30 - Ab[1461] * x31;
  const float x21 = Xc[1365] - Ab[1387] * x22 - Ab[1388] * x23 - Ab[1389] * x24 - Ab[1390] * x25 - Ab[1391] * x26 - Ab[1392] * x27 - Ab[1393] * x28 - Ab[1394] * x29 - Ab[1395] * x30 - Ab[1396] * x31;
  const float x20 = Xc[1300] - Ab[1321] * x21 - Ab[1322] * x22 - Ab[1323] * x23 - Ab[1324] * x24 - Ab[1325] * x25 - Ab[1326] * x26 - Ab[1327] * x27 - Ab[1328] * x28 - Ab[1329] * x29 - Ab[1330] * x30 - Ab[1331] * x31;
  const float x19 = Xc[1235] - Ab[1255] * x20 - Ab[1256] * x21 - Ab[1257] * x22 - Ab[1258] * x23 - Ab[1259] * x24 - Ab[1260] * x25 - Ab[1261] * x26 - Ab[1262] * x27 - Ab[1263] * x28 - Ab[1264] * x29 - Ab[1265] * x30 - Ab[1266] * x31;
  const float x18 = Xc[1170] - Ab[1189] * x19 - Ab[1190] * x20 - Ab[1191] * x21 - Ab[1192] * x22 - Ab[1193] * x23 - Ab[1194] * x24 - Ab[1195] * x25 - Ab[1196] * x26 - Ab[1197] * x27 - Ab[1198] * x28 - Ab[1199] * x29 - Ab[1200] * x30 - Ab[1201] * x31;
  const float x17 = Xc[1105] - Ab[1123] * x18 - Ab[1124] * x19 - Ab[1125] * x20 - Ab[1126] * x21 - Ab[1127] * x22 - Ab[1128] * x23 - Ab[1129] * x24 - Ab[1130] * x25 - Ab[1131] * x26 - Ab[1132] * x27 - Ab[1133] * x28 - Ab[1134] * x29 - Ab[1135] * x30 - Ab[1136] * x31;
  const float x16 = Xc[1040] - Ab[1057] * x17 - Ab[1058] * x18 - Ab[1059] * x19 - Ab[1060] * x20 - Ab[1061] * x21 - Ab[1062] * x22 - Ab[1063] * x23 - Ab[1064] * x24 - Ab[1065] * x25 - Ab[1066] * x26 - Ab[1067] * x27 - Ab[1068] * x28 - Ab[1069] * x29 - Ab[1070] * x30 - Ab[1071] * x31;
  const float x15 = Xc[975] - Ab[991] * x16 - Ab[992] * x17 - Ab[993] * x18 - Ab[994] * x19 - Ab[995] * x20 - Ab[996] * x21 - Ab[997] * x22 - Ab[998] * x23 - Ab[999] * x24 - Ab[1000] * x25 - Ab[1001] * x26 - Ab[1002] * x27 - Ab[1003] * x28 - Ab[1004] * x29 - Ab[1005] * x30 - Ab[1006] * x31;
  const float x14 = Xc[910] - Ab[925] * x15 - Ab[926] * x16 - Ab[927] * x17 - Ab[928] * x18 - Ab[929] * x19 - Ab[930] * x20 - Ab[931] * x21 - Ab[932] * x22 - Ab[933] * x23 - Ab[934] * x24 - Ab[935] * x25 - Ab[936] * x26 - Ab[937] * x27 - Ab[938] * x28 - Ab[939] * x29 - Ab[940] * x30 - Ab[941] * x31;
  const float x13 = Xc[845] - Ab[859] * x14 - Ab[860] * x15 - Ab[861] * x16 - Ab[862] * x17 - Ab[863] * x18 - Ab[864] * x19 - Ab[865] * x20 - Ab[866] * x21 - Ab[867] * x22 - Ab[868] * x23 - Ab[869] * x24 - Ab[870] * x25 - Ab[871] * x26 - Ab[872] * x27 - Ab[873] * x28 - Ab[874] * x29 - Ab[875] * x30 - Ab[876] * x31;
  const float x12 = Xc[780] - Ab[793] * x13 - Ab[794] * x14 - Ab[795] * x15 - Ab[796] * x16 - Ab[797] * x17 - Ab[798] * x18 - Ab[799] * x19 - Ab[800] * x20 - Ab[801] * x21 - Ab[802] * x22 - Ab[803] * x23 - Ab[804] * x24 - Ab[805] * x25 - Ab[806] * x26 - Ab[807] * x27 - Ab[808] * x28 - Ab[809] * x29 - Ab[810] * x30 - Ab[811] * x31;
  const float x11 = Xc[715] - Ab[727] * x12 - Ab[728] * x13 - Ab[729] * x14 - Ab[730] * x15 - Ab[731] * x16 - Ab[732] * x17 - Ab[733] * x18 - Ab[734] * x19 - Ab[735] * x20 - Ab[736] * x21 - Ab[737] * x22 - Ab[738] * x23 - Ab[739] * x24 - Ab[740] * x25 - Ab[741] * x26 - Ab[742] * x27 - Ab[743] * x28 - Ab[744] * x29 - Ab[745] * x30 - Ab[746] * x31;
  const float x10 = Xc[650] - Ab[661] * x11 - Ab[662] * x12 - Ab[663] * x13 - Ab[664] * x14 - Ab[665] * x15 - Ab[666] * x16 - Ab[667] * x17 - Ab[668] * x18 - Ab[669] * x19 - Ab[670] * x20 - Ab[671] * x21 - Ab[672] * x22 - Ab[673] * x23 - Ab[674] * x24 - Ab[675] * x25 - Ab[676] * x26 - Ab[677] * x27 - Ab[678] * x28 - Ab[679] * x29 - Ab[680] * x30 - Ab[681] * x31;
  const float x9 = Xc[585] - Ab[595] * x10 - Ab[596] * x11 - Ab[597] * x12 - Ab[598] * x13 - Ab[599] * x14 - Ab[600] * x15 - Ab[601] * x16 - Ab[602] * x17 - Ab[603] * x18 - Ab[604] * x19 - Ab[605] * x20 - Ab[606] * x21 - Ab[607] * x22 - Ab[608] * x23 - Ab[609] * x24 - Ab[610] * x25 - Ab[611] * x26 - Ab[612] * x27 - Ab[613] * x28 - Ab[614] * x29 - Ab[615] * x30 - Ab[616] * x31;
  const float x8 = Xc[520] - Ab[529] * x9 - Ab[530] * x10 - Ab[531] * x11 - Ab[532] * x12 - Ab[533] * x13 - Ab[534] * x14 - Ab[535] * x15 - Ab[536] * x16 - Ab[537] * x17 - Ab[538] * x18 - Ab[539] * x19 - Ab[540] * x20 - Ab[541] * x21 - Ab[542] * x22 - Ab[543] * x23 - Ab[544] * x24 - Ab[545] * x25 - Ab[546] * x26 - Ab[547] * x27 - Ab[548] * x28 - Ab[549] * x29 - Ab[550] * x30 - Ab[551] * x31;
  const float x7 = Xc[455] - Ab[463] * x8 - Ab[464] * x9 - Ab[465] * x10 - Ab[466] * x11 - Ab[467] * x12 - Ab[468] * x13 - Ab[469] * x14 - Ab[470] * x15 - Ab[471] * x16 - Ab[472] * x17 - Ab[473] * x18 - Ab[474] * x19 - Ab[475] * x20 - Ab[476] * x21 - Ab[477] * x22 - Ab[478] * x23 - Ab[479] * x24 - Ab[480] * x25 - Ab[481] * x26 - Ab[482] * x27 - Ab[483] * x28 - Ab[484] * x29 - Ab[485] * x30 - Ab[486] * x31;
  const float x6 = Xc[390] - Ab[397] * x7 - Ab[398] * x8 - Ab[399] * x9 - Ab[400] * x10 - Ab[401] * x11 - Ab[402] * x12 - Ab[403] * x13 - Ab[404] * x14 - Ab[405] * x15 - Ab[406] * x16 - Ab[407] * x17 - Ab[408] * x18 - Ab[409] * x19 - Ab[410] * x20 - Ab[411] * x21 - Ab[412] * x22 - Ab[413] * x23 - Ab[414] * x24 - Ab[415] * x25 - Ab[416] * x26 - Ab[417] * x27 - Ab[418] * x28 - Ab[419] * x29 - Ab[420] * x30 - Ab[421] * x31;
  const float x5 = Xc[325] - Ab[331] * x6 - Ab[332] * x7 - Ab[333] * x8 - Ab[334] * x9 - Ab[335] * x10 - Ab[336] * x11 - Ab[337] * x12 - Ab[338] * x13 - Ab[339] * x14 - Ab[340] * x15 - Ab[341] * x16 - Ab[342] * x17 - Ab[343] * x18 - Ab[344] * x19 - Ab[345] * x20 - Ab[346] * x21 - Ab[347] * x22 - Ab[348] * x23 - Ab[349] * x24 - Ab[350] * x25 - Ab[351] * x26 - Ab[352] * x27 - Ab[353] * x28 - Ab[354] * x29 - Ab[355] * x30 - Ab[356] * x31;
  const float x4 = Xc[260] - Ab[265] * x5 - Ab[266] * x6 - Ab[267] * x7 - Ab[268] * x8 - Ab[269] * x9 - Ab[270] * x10 - Ab[271] * x11 - Ab[272] * x12 - Ab[273] * x13 - Ab[274] * x14 - Ab[275] * x15 - Ab[276] * x16 - Ab[277] * x17 - Ab[278] * x18 - Ab[279] * x19 - Ab[280] * x20 - Ab[281] * x21 - Ab[282] * x22 - Ab[283] * x23 - Ab[284] * x24 - Ab[285] * x25 - Ab[286] * x26 - Ab[287] * x27 - Ab[288] * x28 - Ab[289] * x29 - Ab[290] * x30 - Ab[291] * x31;
  const float x3 = Xc[195] - Ab[199] * x4 - Ab[200] * x5 - Ab[201] * x6 - Ab[202] * x7 - Ab[203] * x8 - Ab[204] * x9 - Ab[205] * x10 - Ab[206] * x11 - Ab[207] * x12 - Ab[208] * x13 - Ab[209] * x14 - Ab[210] * x15 - Ab[211] * x16 - Ab[212] * x17 - Ab[213] * x18 - Ab[214] * x19 - Ab[215] * x20 - Ab[216] * x21 - Ab[217] * x22 - Ab[218] * x23 - Ab[219] * x24 - Ab[220] * x25 - Ab[221] * x26 - Ab[222] * x27 - Ab[223] * x28 - Ab[224] * x29 - Ab[225] * x30 - Ab[226] * x31;
  const float x2 = Xc[130] - Ab[133] * x3 - Ab[134] * x4 - Ab[135] * x5 - Ab[136] * x6 - Ab[137] * x7 - Ab[138] * x8 - Ab[139] * x9 - Ab[140] * x10 - Ab[141] * x11 - Ab[142] * x12 - Ab[143] * x13 - Ab[144] * x14 - Ab[145] * x15 - Ab[146] * x16 - Ab[147] * x17 - Ab[148] * x18 - Ab[149] * x19 - Ab[150] * x20 - Ab[151] * x21 - Ab[152] * x22 - Ab[153] * x23 - Ab[154] * x24 - Ab[155] * x25 - Ab[156] * x26 - Ab[157] * x27 - Ab[158] * x28 - Ab[159] * x29 - Ab[160] * x30 - Ab[161] * x31;
  const float x1 = Xc[65] - Ab[67] * x2 - Ab[68] * x3 - Ab[69] * x4 - Ab[70] * x5 - Ab[71] * x6 - Ab[72] * x7 - Ab[73] * x8 - Ab[74] * x9 - Ab[75] * x10 - Ab[76] * x11 - Ab[77] * x12 - Ab[78] * x13 - Ab[79] * x14 - Ab[80] * x15 - Ab[81] * x16 - Ab[82] * x17 - Ab[83] * x18 - Ab[84] * x19 - Ab[85] * x20 - Ab[86] * x21 - Ab[87] * x22 - Ab[88] * x23 - Ab[89] * x24 - Ab[90] * x25 - Ab[91] * x26 - Ab[92] * x27 - Ab[93] * x28 - Ab[94] * x29 - Ab[95] * x30 - Ab[96] * x31;
  const float x0 = Xc[0] - Ab[1] * x1 - Ab[2] * x2 - Ab[3] * x3 - Ab[4] * x4 - Ab[5] * x5 - Ab[6] * x6 - Ab[7] * x7 - Ab[8] * x8 - Ab[9] * x9 - Ab[10] * x10 - Ab[11] * x11 - Ab[12] * x12 - Ab[13] * x13 - Ab[14] * x14 - Ab[15] * x15 - Ab[16] * x16 - Ab[17] * x17 - Ab[18] * x18 - Ab[19] * x19 - Ab[20] * x20 - Ab[21] * x21 - Ab[22] * x22 - Ab[23] * x23 - Ab[24] * x24 - Ab[25] * x25 - Ab[26] * x26 - Ab[27] * x27 - Ab[28] * x28 - Ab[29] * x29 - Ab[30] * x30 - Ab[31] * x31;
  Xc[0] = x0;
  Xc[65] = x1;
  Xc[130] = x2;
  Xc[195] = x3;
  Xc[260] = x4;
  Xc[325] = x5;
  Xc[390] = x6;
  Xc[455] = x7;
  Xc[520] = x8;
  Xc[585] = x9;
  Xc[650] = x10;
  Xc[715] = x11;
  Xc[780] = x12;
  Xc[845] = x13;
  Xc[910] = x14;
  Xc[975] = x15;
  Xc[1040] = x16;
  Xc[1105] = x17;
  Xc[1170] = x18;
  Xc[1235] = x19;
  Xc[1300] = x20;
  Xc[1365] = x21;
  Xc[1430] = x22;
  Xc[1495] = x23;
  Xc[1560] = x24;
  Xc[1625] = x25;
  Xc[1690] = x26;
  Xc[1755] = x27;
  Xc[1820] = x28;
  Xc[1885] = x29;
  Xc[1950] = x30;
  Xc[2015] = x31;
}
#define FS(i) (ldsf + (i) * 4160)
__device__ __forceinline__ void rwkv_item2(const Params& p, int l, int item, float* ldsf) {
  const int tid = opq(threadIdx.x), lane = tid & 63, wave = tid >> 6;
  const int r = lane & 31, hf = lane >> 5;
  const int h = item & 7, cidx = item >> 3, rowbase = cidx * 64, cc = cidx & 127;
  const u16* z = (const u16*)(p.ws + WS_Z);
  const float* mu = p.in[9] + l * 1792;
  u16* BBp = (u16*)((unsigned char*)ldsf + 83200);
  u16* XW = BBp;            u16* XA = BBp + 4608;    u16* XG = BBp + 9216;   u16* WT = BBp + 17920;
  u16* Rn = BBp;            u16* Kn = BBp + 4608;    u16* Bn = BBp + 9216;   u16* Cn = BBp + 13824;
  u16* CT = BBp + 18432;    u16* KHT = BBp + 23040;  u16* VT = BBp + 27648;
  float* gc = (float*)(BBp + 32256);
  u16* AK = (u16*)FS(2);    u16* NTm = AK + 4608;
  u16* MT = (u16*)FS(0);    u16* KQT = (u16*)FS(1);
  const int mt = (wave >> 1) & 1, nt = wave & 1, grp = wave >> 2;
  __syncthreads();
  {
    const int t = tid >> 3, c8 = (tid & 7) * 8;
    const int m = rowbase + t;
    const int zcs[7] = {h * 64, 512 + h * 64, 1024 + h * 64, 1536, 1600, 1664, 1728};
#pragma unroll
    for (int gi = 0; gi < 7; ++gi) {
      const int zc = zcs[gi] + c8;
      float cur[8], prv[8], v[8];
      unpack8(*(const uint4*)(z + (size_t)m * ZLD + zc), cur);
      if (t == 0 && cc == 0) {
#pragma unroll
        for (int i = 0; i < 8; ++i) prv[i] = 0.f;
      } else {
        unpack8(*(const uint4*)(z + (size_t)(m - 1) * ZLD + zc), prv);
      }
#pragma unroll
      for (int i = 0; i < 8; ++i) {
        float x = cur[i] + mu[zc + i] * (prv[i] - cur[i]);
        if (gi == 3) x = tanhf(x);
        if (gi >= 5) x = sigm(x);
        v[i] = x;
      }
      if (gi < 2) {
        float* d = FS(gi) + t * 65 + c8;
#pragma unroll
        for (int i = 0; i < 8; ++i) d[i] = v[i];
      } else if (gi == 2) {
#pragma unroll
        for (int i = 0; i < 8; ++i) VT[(c8 + i) * 72 + t] = f2bf(v[i]);
      } else if (gi == 3) { *(uint4*)(XW + t * 72 + c8) = pack8(v); }
      else if (gi == 4) { *(uint4*)(XA + t * 72 + c8) = pack8(v); }
      else { *(uint4*)(XG + t * 136 + (gi - 5) * 64 + c8) = pack8(v); }
    }
  }
  {
    const int i = tid >> 3, j8 = (tid & 7) * 8;
    const float* s1 = p.in[11] + (size_t)l * 64 * 512 + (size_t)i * 512 + h * 64 + j8;
    const float* s2 = p.in[13] + (size_t)l * 64 * 512 + (size_t)i * 512 + h * 64 + j8;
    const float4 a0 = *(const float4*)s1, a1 = *(const float4*)(s1 + 4), b0 = *(const float4*)s2, b1 = *(const float4*)(s2 + 4);
    const float wa[8] = {a0.x, a0.y, a0.z, a0.w, a1.x, a1.y, a1.z, a1.w};
    const float wb[8] = {b0.x, b0.y, b0.z, b0.w, b1.x, b1.y, b1.z, b1.w};
#pragma unroll
    for (int q = 0; q < 8; ++q) { WT[(j8 + q) * 72 + i] = f2bf(wa[q]); WT[4608 + (j8 + q) * 72 + i] = f2bf(wb[q]); }
  }
  __syncthreads();
  {
    f32x16 acc;
#pragma unroll
    for (int i = 0; i < 16; ++i) acc[i] = 0.f;
    mm_tile(grp ? XA : XW, 72, grp ? WT + 4608 : WT, 72, mt, nt, r, hf, 4, acc);
    const int j = nt * 32 + r;
    const float bias = grp ? p.in[12][l * 512 + h * 64 + j] : p.in[10][l * 512 + h * 64 + j];
#pragma unroll
    for (int reg = 0; reg < 16; ++reg) {
      const int t = mt * 32 + ROWOFF(reg, hf);
      const float x = acc[reg] + bias;
      if (grp) FS(3)[t * 65 + j] = sigm(x);
      else {
        const float nx = -x;
        const float sp = (nx > 20.f) ? nx : log1pf(__expf(nx));
        FS(4)[t * 65 + j] = -__expf(-sp - 0.5f);
      }
    }
  }
  __syncthreads();
  {
#pragma unroll
    for (int e2 = 0; e2 < 2; ++e2) {
      const int e = tid + e2 * 512;
      const int i = e >> 3, j8 = (e & 7) * 8;
      const float* s1 = p.in[14] + (size_t)l * 128 * 512 + (size_t)i * 512 + h * 64 + j8;
      const float4 a0 = *(const float4*)s1, a1 = *(const float4*)(s1 + 4);
      const float wa[8] = {a0.x, a0.y, a0.z, a0.w, a1.x, a1.y, a1.z, a1.w};
#pragma unroll
      for (int q = 0; q < 8; ++q) WT[(j8 + q) * 136 + i] = f2bf(wa[q]);
    }
  }
  if (tid < 64) {
    float c = 0.f;
    for (int t = 0; t < 64; ++t) { c += FS(4)[t * 65 + tid]; FS(2)[t * 65 + tid] = c; }
    const float g = __expf(c);
    gc[tid] = g;
    ((float*)(p.ws + WS_GC))[(size_t)item * 64 + tid] = g;
  }
  __syncthreads();
  if (grp == 0) {
    f32x16 acc;
#pragma unroll
    for (int i = 0; i < 16; ++i) acc[i] = 0.f;
    mm_tile(XG, 136, WT, 136, mt, nt, r, hf, 8, acc);
    u16* ga = (u16*)(p.ws + WS_GA) + (size_t)item * 4096;
#pragma unroll
    for (int reg = 0; reg < 16; ++reg) ga[(mt * 32 + ROWOFF(reg, hf)) * 64 + nt * 32 + r] = f2bf(acc[reg]);
  }
  __syncthreads();
  {
    const int t = tid >> 3, j0 = (tid & 7) * 8;
    const float* kkw = p.in[15] + l * 512 + h * 64;
    const float* kaw = p.in[16] + l * 512 + h * 64;
    const float* rkw = p.in[17] + l * 512 + h * 64;
    float kr[8], av[8], rv[8], kkv[8], kf[8];
    float nrm = 0.f, bdot = 0.f;
#pragma unroll
    for (int i = 0; i < 8; ++i) {
      const int j = j0 + i;
      kr[i] = FS(1)[t * 65 + j]; av[i] = FS(3)[t * 65 + j]; rv[i] = FS(0)[t * 65 + j];
      kkv[i] = kr[i] * kkw[j];
      nrm += kkv[i] * kkv[i];
      kf[i] = kr[i] * (1.f + (av[i] - 1.f) * kaw[j]);
      bdot += rv[i] * kf[i] * rkw[j];
    }
    nrm += __shfl_xor(nrm, 1, 64); nrm += __shfl_xor(nrm, 2, 64); nrm += __shfl_xor(nrm, 4, 64);
    bdot += __shfl_xor(bdot, 1, 64); bdot += __shfl_xor(bdot, 2, 64); bdot += __shfl_xor(bdot, 4, 64);
    const float rn = 1.f / fmaxf(sqrtf(nrm), 1e-12f);
    float o_r[8], o_k[8], o_b[8], o_c[8], bo[8];
#pragma unroll
    for (int i = 0; i < 8; ++i) {
      const int j = j0 + i;
      const float cum = FS(2)[t * 65 + j], dl = FS(4)[t * 65 + j];
      const float eg = __expf(cum), egi = __expf(-cum), egp = __expf(cum - dl);
      const float kk = kkv[i] * rn;
      const float g = gc[j];
      o_r[i] = rv[i] * eg; o_k[i] = kf[i] * egi; o_b[i] = kk * av[i] * egi; o_c[i] = kk * egp;
      CT[j * 72 + t] = f2bf(o_c[i]);
      KHT[j * 72 + t] = f2bf(o_k[i] * g);
      FS(1)[t * 65 + j] = o_b[i] * g;
      bo[i] = bdot * bf2f(VT[j * 72 + t]);
    }
    *(uint4*)(Rn + t * 72 + j0) = pack8(o_r);
    *(uint4*)(Kn + t * 72 + j0) = pack8(o_k);
    *(uint4*)(Bn + t * 72 + j0) = pack8(o_b);
    *(uint4*)(Cn + t * 72 + j0) = pack8(o_c);
    u16* bop = (u16*)(p.ws + WS_BO) + (size_t)item * 4096;
    *(uint4*)(bop + t * 64 + j0) = pack8(bo);
  }
  __syncthreads();
  f32x16 akr;
#pragma unroll
  for (int i = 0; i < 16; ++i) akr[i] = 0.f;
  if (grp == 0) {
    f32x16 ab, abr;
#pragma unroll
    for (int i = 0; i < 16; ++i) { ab[i] = 0.f; abr[i] = 0.f; }
    mm_tile(Bn, 72, Cn, 72, mt, nt, r, hf, 4, ab);
    mm_tile(Bn, 72, Rn, 72, mt, nt, r, hf, 4, abr);
    const int t = nt * 32 + r;
#pragma unroll
    for (int reg = 0; reg < 16; ++reg) {
      const int i = mt * 32 + ROWOFF(reg, hf);
      FS(4)[i * 65 + t] = (i < t) ? ab[reg] : 0.f;
      FS(0)[i * 65 + t] = (i <= t) ? abr[reg] : 0.f;
    }
  } else {
    f32x16 akt;
#pragma unroll
    for (int i = 0; i < 16; ++i) akt[i] = 0.f;
    mm_tile(Cn, 72, Kn, 72, mt, nt, r, hf, 4, akt);
    {
      const int i = nt * 32 + r;
#pragma unroll
      for (int reg = 0; reg < 16; ++reg) { const int t = mt * 32 + ROWOFF(reg, hf); if (!(i < t)) akt[reg] = 0.f; }
    }
    store_T(AK, 72, mt, nt, r, hf, akt);
    mm_tile(Kn, 72, Rn, 72, mt, nt, r, hf, 4, akr);
    {
      const int t = nt * 32 + r;
#pragma unroll
      for (int reg = 0; reg < 16; ++reg) { const int i = mt * 32 + ROWOFF(reg, hf); if (!(i <= t)) akr[reg] = 0.f; }
    }
  }
  __syncthreads();
  if (tid < 128) {
    float* X_ = (tid < 64) ? FS(0) : FS(1);
    const int col = tid & 63;
    tri32(FS(4) + 32 * 65 + 32, X_ + 32 * 65 + col);
  }
  __syncthreads();
  {
    const int c = tid & 127, ig = tid >> 7;
    float* X_ = (c < 64) ? FS(0) : FS(1);
    const int col = c & 63;
    float a[8];
#pragma unroll
    for (int u = 0; u < 8; ++u) a[u] = 0.f;
#pragma unroll 4
    for (int t = 32; t < 64; ++t) {
      const float xv = X_[t * 65 + col];
#pragma unroll
      for (int u = 0; u < 8; ++u) a[u] += FS(4)[(ig * 8 + u) * 65 + t] * xv;
    }
#pragma unroll
    for (int u = 0; u < 8; ++u) X_[(ig * 8 + u) * 65 + col] -= a[u];
  }
  __syncthreads();
  if (tid < 128) {
    float* X_ = (tid < 64) ? FS(0) : FS(1);
    const int col = tid & 63;
    tri32(FS(4), X_ + col);
  }
  __syncthreads();
  {
    const int c = tid >> 2, q = tid & 3;
    const float* X_ = (c < 64) ? FS(0) : FS(1);
    const int col = c & 63;
    float o0[8], o1[8];
#pragma unroll
    for (int u = 0; u < 8; ++u) { o0[u] = -X_[(q * 16 + u) * 65 + col]; o1[u] = -X_[(q * 16 + 8 + u) * 65 + col]; }
    u16* dst = NTm + c * 72 + q * 16;
    *(uint4*)dst = pack8(o0);
    *(uint4*)(dst + 8) = pack8(o1);
  }
  __syncthreads();
  if (grp == 1) {
    mm_tile(AK, 72, NTm, 72, mt, nt, r, hf, 4, akr);
    store_T(MT, 72, mt, nt, r, hf, akr);
  } else {
    f32x16 d2;
#pragma unroll
    for (int i = 0; i < 16; ++i) d2[i] = 0.f;
    mm_tile(AK, 72, NTm + 64 * 72, 72, mt, nt, r, hf, 4, d2);
#pragma unroll
    for (int g = 0; g < 4; ++g) {
      const int idx = (nt * 32 + r) * 72 + mt * 32 + 8 * g + 4 * hf;
      const uint2 kh = *(const uint2*)(KHT + idx);
      uint2 o;
      o.x = pack2(d2[4 * g] + __uint_as_float(kh.x << 16), d2[4 * g + 1] + __uint_as_float(kh.x & 0xFFFF0000u));
      o.y = pack2(d2[4 * g + 2] + __uint_as_float(kh.y << 16), d2[4 * g + 3] + __uint_as_float(kh.y & 0xFFFF0000u));
      *(uint2*)(KQT + idx) = o;
    }
  }
  __syncthreads();
  if (grp == 0) {
    f32x16 w2, yl;
#pragma unroll
    for (int i = 0; i < 16; ++i) { w2[i] = 0.f; yl[i] = 0.f; }
    mm_tile(NTm, 72, CT, 72, mt, nt, r, hf, 4, w2);
    mm_tile(MT, 72, VT, 72, mt, nt, r, hf, 4, yl);
    u16* W2p = (u16*)(p.ws + WS_W2) + (size_t)item * 4096;
    u16* YLp = (u16*)(p.ws + WS_YL) + (size_t)item * 4096;
#pragma unroll
    for (int reg = 0; reg < 16; ++reg) {
      const int t = mt * 32 + ROWOFF(reg, hf), n = nt * 32 + r;
      W2p[t * 64 + n] = f2bf(w2[reg] + bf2f(Rn[t * 72 + n]));
      YLp[t * 64 + n] = f2bf(yl[reg]);
    }
  } else {
    f32x16 pp, qt;
#pragma unroll
    for (int i = 0; i < 16; ++i) { pp[i] = 0.f; qt[i] = 0.f; }
    mm_tile(CT, 72, NTm + 64 * 72, 72, mt, nt, r, hf, 4, pp);
    mm_tile(KQT, 72, VT, 72, mt, nt, r, hf, 4, qt);
    uint4* Pf = (uint4*)((u16*)(p.ws + WS_PP) + (size_t)item * 4096);
    float* Qf = (float*)(p.ws + WS_Q) + (size_t)item * 4096;
#pragma unroll
    for (int s2 = 0; s2 < 2; ++s2) {
      uint4 o;
      o.x = pack2(pp[s2 * 8 + 0], pp[s2 * 8 + 1]); o.y = pack2(pp[s2 * 8 + 2], pp[s2 * 8 + 3]);
      o.z = pack2(pp[s2 * 8 + 4], pp[s2 * 8 + 5]); o.w = pack2(pp[s2 * 8 + 6], pp[s2 * 8 + 7]);
      Pf[(nt * 4 + mt * 2 + s2) * 64 + lane] = o;
    }
#pragma unroll
    for (int reg = 0; reg < 16; ++reg) Qf[((nt * 2 + mt) * 16 + reg) * 64 + lane] = qt[reg];
  }
}

template <int K_> struct IC { static constexpr int value = K_; };
__device__ __forceinline__ void rwkv_scan(const Params& p, int l, int bh, float* ldsf, bool dry = false) {
  const int tid = opq(threadIdx.x), lane = tid & 63, wave = tid >> 6;
  const int b = bh >> 3, h = bh & 7;
  unsigned char* ring = (unsigned char*)ldsf + 32768;
  __syncthreads();
  {
    const float* G0 = (const float*)(p.ws + WS_GC);
    for (int e = tid; e < 8192; e += NT) ldsf[e] = G0[(size_t)((b * 128 + (e >> 6)) * 8 + h) * 64 + (e & 63)];
  }
  const bool helper = wave >= 2;
  const int ht = tid - 128;
  const u16* PPb = (const u16*)(p.ws + WS_PP);
  const float* Qb = (const float*)(p.ws + WS_Q);
  const bool isP = wave < 4;
  const int hstr = isP ? 128 : 256;
  const int hidx = isP ? (tid - 128) : (tid - 256);
  const int hdst = isP ? hidx : 512 + hidx;
#define SC_GLOAD(c, D0, D1, D2, D3) do { const size_t id_ = (size_t)((b * 128 + (c)) * 8 + h); \
    const uint4* src_ = isP ? (const uint4*)(PPb + id_ * 4096) : (const uint4*)(Qb + id_ * 4096); \
    D0 = src_[hidx]; D1 = src_[hidx + hstr]; D2 = src_[hidx + 2 * hstr]; D3 = src_[hidx + 3 * hstr]; } while (0)
#define SC_LWRITE(c, D0, D1, D2, D3) do { uint4* slot_ = (uint4*)(ring + ((c) & 1) * 24576) + hdst; \
    slot_[0] = D0; slot_[hstr] = D1; slot_[2 * hstr] = D2; slot_[3 * hstr] = D3; } while (0)
  if (helper) {
    uint4 a0, a1, a2, a3, b0, b1, b2, b3, c0_, c1_, c2_, c3_, d0, d1, d2, d3;
    SC_GLOAD(0, a0, a1, a2, a3); SC_LWRITE(0, a0, a1, a2, a3);
    SC_GLOAD(1, b0, b1, b2, b3); SC_GLOAD(2, c0_, c1_, c2_, c3_); SC_GLOAD(3, d0, d1, d2, d3);
    __syncthreads();
#pragma unroll 1
    for (int cc = 0; cc < 128; cc += 4) {
      if (cc + 4 < 128) SC_GLOAD(cc + 4, a0, a1, a2, a3);
      SC_LWRITE(cc + 1, b0, b1, b2, b3);
      asm volatile("s_waitcnt lgkmcnt(0)\n\ts_barrier" ::: "memory");
      if (cc + 5 < 128) SC_GLOAD(cc + 5, b0, b1, b2, b3);
      SC_LWRITE(cc + 2, c0_, c1_, c2_, c3_);
      asm volatile("s_waitcnt lgkmcnt(0)\n\ts_barrier" ::: "memory");
      if (cc + 6 < 128) SC_GLOAD(cc + 6, c0_, c1_, c2_, c3_);
      SC_LWRITE(cc + 3, d0, d1, d2, d3);
      asm volatile("s_waitcnt lgkmcnt(0)\n\ts_barrier" ::: "memory");
      if (cc + 7 < 128) SC_GLOAD(cc + 7, d0, d1, d2, d3);
      if (cc + 4 < 128) SC_LWRITE(cc + 4, a0, a1, a2, a3);
      asm volatile("s_waitcnt lgkmcnt(0)\n\ts_barrier" ::: "memory");
    }
    return;
  }
  __syncthreads();
  const int vt = wave & 1, hf = lane >> 5;
  f32x16 S[2];
#pragma unroll
  for (int i = 0; i < 16; ++i) { S[0][i] = 0.f; S[1][i] = 0.f; }
#pragma unroll 1
  for (int cc = 0; cc < 128; ++cc) {
    const size_t id = (size_t)((b * 128 + cc) * 8 + h);
    float* Qg = (float*)Qb + id * 4096;
    const int lofs = opq(lane);
    const uint4* slotA = (const uint4*)(ring + (cc & 1) * 24576) + lofs;
    const float* slotQ = (const float*)(ring + (cc & 1) * 24576 + 8192) + vt * 2048 + lofs;
    const float* gcp = ldsf + cc * 64 + 4 * (lofs >> 5);
    Qg += vt * 2048 + lofs;
    f32x16 acc[2];
#pragma unroll
    for (int kt = 0; kt < 2; ++kt)
#pragma unroll
      for (int reg = 0; reg < 16; ++reg)
        acc[kt][reg] = S[kt][reg] * gcp[kt * 32 + ((reg) & 3) + 8 * ((reg) >> 2)] + slotQ[(kt * 16 + reg) * 64];
#pragma unroll
    for (int kt = 0; kt < 2; ++kt)
#pragma unroll
      for (int reg = 0; reg < 16; ++reg) if (!dry) Qg[(kt * 16 + reg) * 64] = S[kt][reg];
#pragma unroll
    for (int s_ = 0; s_ < 4; ++s_) {
      const int kt = s_ >> 1, s2 = s_ & 1;
      unsigned hw[4], lw[4];
#pragma unroll
      for (int j = 0; j < 4; ++j) {
        const float x0 = S[kt][s2 * 8 + 2 * j], x1 = S[kt][s2 * 8 + 2 * j + 1];
        hw[j] = pack2(x0, x1);
        lw[j] = pack2(x0 - __uint_as_float(hw[j] << 16), x1 - __uint_as_float(hw[j] & 0xFFFF0000u));
      }
      union { uint4 u; bf16x8 v; } bh_, bl_;
      bh_.u = make_uint4(hw[0], hw[1], hw[2], hw[3]);
      bl_.u = make_uint4(lw[0], lw[1], lw[2], lw[3]);
#pragma unroll
      for (int kt2 = 0; kt2 < 2; ++kt2) {
        union { uint4 u; bf16x8 v; } af; af.u = slotA[(kt2 * 4 + s_) * 64];
        acc[kt2] = __builtin_amdgcn_mfma_f32_32x32x16_bf16(af.v, bh_.v, acc[kt2], 0, 0, 0);
        acc[kt2] = __builtin_amdgcn_mfma_f32_32x32x16_bf16(af.v, bl_.v, acc[kt2], 0, 0, 0);
      }
    }
    S[0] = acc[0]; S[1] = acc[1];
    asm volatile("s_waitcnt lgkmcnt(0)\n\ts_barrier" ::: "memory");
  }
  {
    float* o = p.out + O_PWKV + ((size_t)((l * 2 + b) * 8 + h) * 64 + vt * 32 + (lane & 31)) * 64;
#pragma unroll
    for (int kt = 0; kt < 2; ++kt)
#pragma unroll
      for (int reg = 0; reg < 16; ++reg) o[kt * 32 + ROWOFF(reg, hf)] = S[kt][reg];
  }
}

__device__ __forceinline__ void rwkv_out(const Params& p, int l, int item, float* ldsf) {
  const int tid = opq(threadIdx.x), lane = tid & 63, wave = tid >> 6;
  const int h = item & 7, cidx = item >> 3;
  float* Sl = ldsf; float* Wl = ldsf + 4160;
  const float* Sg = (const float*)(p.ws + WS_Q) + (size_t)item * 4096;
  const u16* W2 = (const u16*)(p.ws + WS_W2) + (size_t)item * 4096;
  const u16* YL = (const u16*)(p.ws + WS_YL) + (size_t)item * 4096;
  const u16* BO = (const u16*)(p.ws + WS_BO) + (size_t)item * 4096;
  const u16* GA = (const u16*)(p.ws + WS_GA) + (size_t)item * 4096;
  u16* z = (u16*)(p.ws + WS_Z);
  __syncthreads();
  {
    const int row = tid >> 3, c = (tid & 7) * 8;
#pragma unroll
    for (int i = 0; i < 8; ++i) {
      const int idx = i * 512 + tid;
      const int ln = idx & 63, reg = (idx >> 6) & 15, kt = (idx >> 10) & 1, vt = idx >> 11;
      Sl[(vt * 32 + (ln & 31)) * 65 + kt * 32 + ROWOFF(reg, ln >> 5)] = Sg[idx];
    }
    float w[8];
    unpack8(*(const uint4*)(W2 + row * 64 + c), w);
    float* e = Wl + row * 65 + c;
#pragma unroll
    for (int i = 0; i < 8; ++i) e[i] = w[i];
  }
  __syncthreads();
  float y[8];
#pragma unroll
  for (int q = 0; q < 8; ++q) y[q] = bf2f(YL[(wave * 8 + q) * 64 + lane]);
#pragma unroll 2
  for (int k = 0; k < 64; ++k) {
    const float s = Sl[lane * 65 + k];
#pragma unroll
    for (int q = 0; q < 8; ++q) y[q] += s * Wl[(wave * 8 + q) * 65 + k];
  }
  const float lng = p.in[18][l * 512 + h * 64 + lane], lnb = p.in[19][l * 512 + h * 64 + lane];
#pragma unroll
  for (int q = 0; q < 8; ++q) {
    const int t = wave * 8 + q;
    const float mean = wave_sum(y[q]) * (1.f / 64.f);
    const float d = y[q] - mean;
    const float var = wave_sum(d * d) * (1.f / 64.f);
    const float yn = d * rsqrtf(var + 64e-5f) * lng + lnb;
    const float o = (yn + bf2f(BO[t * 64 + lane])) * bf2f(GA[t * 64 + lane]);
    z[(size_t)(cidx * 64 + t) * ZLD + h * 64 + lane] = f2bf(o);
  }
}

__device__ __forceinline__ void attn_prompt(const Params& p, int l, int item, u16* lds, bool dry = false) {
  const int tid = opq(threadIdx.x), lane = tid & 63, wave = tid >> 6;
  const int r = lane & 31, h = lane >> 5;
  const int kvh = item & 1, n = (item >> 1) & 63, b = item >> 7;
  u16* z = (u16*)(p.ws + WS_Z);
  u16* Ks = lds;
  u16* Vt = lds + 256 * 72;
  __syncthreads();
  {
    const int key = tid >> 1, half = tid & 1;
    const int t = (n - 1) * 128 + key;
    uint4 kv[4], vv[4];
    if (t >= 0) {
      const u16* kp = z + (size_t)(b * 8192 + t) * ZLD + 2304 + kvh * 64 + half * 32;
      const u16* vp = z + (size_t)(b * 8192 + t) * ZLD + 2432 + kvh * 64 + half * 32;
#pragma unroll
      for (int i = 0; i < 4; ++i) { kv[i] = *(const uint4*)(kp + i * 8); vv[i] = *(const uint4*)(vp + i * 8); }
    } else {
#pragma unroll
      for (int i = 0; i < 4; ++i) { kv[i] = make_uint4(0, 0, 0, 0); vv[i] = make_uint4(0, 0, 0, 0); }
    }
#pragma unroll
    for (int i = 0; i < 4; ++i) {
      *(uint4*)(Ks + key * 72 + half * 32 + i * 8) = kv[i];
      const unsigned w[4] = {vv[i].x, vv[i].y, vv[i].z, vv[i].w};
#pragma unroll
      for (int q = 0; q < 4; ++q) {
        const int d = half * 32 + i * 8 + q * 2;
        Vt[d * 264 + key] = (u16)(w[q] & 0xFFFFu);
        Vt[(d + 1) * 264 + key] = (u16)(w[q] >> 16);
      }
    }
  }
  __syncthreads();
#pragma unroll 1
  for (int uu = 0; uu < 2; ++uu) {
    const int u = wave * 2 + uu;
    const int hq = kvh * 4 + (u >> 2), qg = u & 3;
    const int qrow = b * 8192 + n * 128 + qg * 32 + r;
    u16* qp = z + (size_t)qrow * ZLD + 1792 + hq * 64;
    bf16x8 qf[4];
#pragma unroll
    for (int s = 0; s < 4; ++s) qf[s] = *(const bf16x8*)(qp + s * 16 + h * 8);
    f32x16 sc[5];
#pragma unroll
    for (int i5 = 0; i5 < 5; ++i5) {
#pragma unroll
      for (int i = 0; i < 16; ++i) sc[i5][i] = 0.f;
      const int kt = qg + i5;
#pragma unroll
      for (int s = 0; s < 4; ++s) {
        bf16x8 kf = *(const bf16x8*)(Ks + (kt * 32 + r) * 72 + s * 16 + h * 8);
        sc[i5] = __builtin_amdgcn_mfma_f32_32x32x16_bf16(kf, qf[s], sc[i5], 0, 0, 0);
      }
      __builtin_amdgcn_sched_barrier(0);
    }
    const int qi = qg * 32 + r;
    const float sink = p.in[20][l * 8 + hq];
    float mx = -1e30f;
#pragma unroll
    for (int i5 = 0; i5 < 5; ++i5)
#pragma unroll
      for (int reg = 0; reg < 16; ++reg) {
        const int j = (qg + i5) * 32 + ROWOFF(reg, h);
        const bool ok = (j > qi) && (j <= qi + 128) && (n > 0 || j >= 128);
        const float s = ok ? sc[i5][reg] * 0.125f : -1e30f;
        sc[i5][reg] = s;
        mx = fmaxf(mx, s);
      }
    mx = fmaxf(mx, __shfl_xor(mx, 32, 64));
    mx = fmaxf(mx, sink);
    float sum = 0.f;
#pragma unroll
    for (int i5 = 0; i5 < 5; ++i5)
#pragma unroll
      for (int reg = 0; reg < 16; ++reg) { const float e = __expf(sc[i5][reg] - mx); sc[i5][reg] = e; sum += e; }
    sum += __shfl_xor(sum, 32, 64);
    const float rden = 1.f / (sum + __expf(sink - mx));
    f32x16 oacc[2];
#pragma unroll
    for (int i = 0; i < 16; ++i) { oacc[0][i] = 0.f; oacc[1][i] = 0.f; }
#pragma unroll
    for (int i5 = 0; i5 < 5; ++i5) {
      const int kt = qg + i5;
#pragma unroll
      for (int s2 = 0; s2 < 2; ++s2) {
        bf16x8 pf;
#pragma unroll
        for (int j = 0; j < 8; ++j) pf[j] = (short)f2bf(sc[i5][s2 * 8 + j] * rden);
#pragma unroll
        for (int dt = 0; dt < 2; ++dt) {
          const u16* vp = Vt + (dt * 32 + r) * 264 + kt * 32 + s2 * 16 + h * 4;
          const uint2 lo = *(const uint2*)vp, hi = *(const uint2*)(vp + 8);
          union { uint4 u; bf16x8 v; } cv;
          cv.u = make_uint4(lo.x, lo.y, hi.x, hi.y);
          oacc[dt] = __builtin_amdgcn_mfma_f32_32x32x16_bf16(cv.v, pf, oacc[dt], 0, 0, 0);
        }
        __builtin_amdgcn_sched_barrier(0);
      }
    }
#pragma unroll
    for (int dt = 0; dt < 2; ++dt)
#pragma unroll
      for (int g4 = 0; g4 < 4; ++g4) {
        const int d = dt * 32 + 8 * g4 + 4 * h;
        uint2 o;
        o.x = pack2(oacc[dt][g4 * 4 + 0], oacc[dt][g4 * 4 + 1]);
        o.y = pack2(oacc[dt][g4 * 4 + 2], oacc[dt][g4 * 4 + 3]);
        if (!dry) *(uint2*)(qp + d) = o;
      }
  }
}

__device__ __forceinline__ void attn_sample(const Params& p, int l, int item, float* ldsf, bool dry = false) {
  const int tid = opq(threadIdx.x);
  const int kvh = item & 1, b = item >> 1;
  u16* z = (u16*)(p.ws + WS_Z);
  float* Kl = ldsf;
  float* Vl = ldsf + 132 * 65;
  float* Ql = Vl + 132 * 65;
  float* Pl = Ql + 16 * 64;
  __syncthreads();
  for (int e = tid; e < 132 * 8; e += NT) {
    const int j = e >> 3, c = (e & 7) * 8;
    float k[8], v[8];
    if (j < 128) {
      const float* kp = p.in[4] + ((size_t)((l * 128 + b) * 128 + j) * 2 + kvh) * 64 + c;
      const float* vp = p.in[5] + ((size_t)((l * 128 + b) * 128 + j) * 2 + kvh) * 64 + c;
      float4 a = *(const float4*)kp, a2 = *(const float4*)(kp + 4);
      float4 c1 = *(const float4*)vp, c2 = *(const float4*)(vp + 4);
      k[0] = a.x; k[1] = a.y; k[2] = a.z; k[3] = a.w; k[4] = a2.x; k[5] = a2.y; k[6] = a2.z; k[7] = a2.w;
      v[0] = c1.x; v[1] = c1.y; v[2] = c1.z; v[3] = c1.w; v[4] = c2.x; v[5] = c2.y; v[6] = c2.z; v[7] = c2.w;
    } else {
      const size_t row = M_P + b * 4 + (j - 128);
      unpack8(*(const uint4*)(z + row * ZLD + 2304 + kvh * 64 + c), k);
      unpack8(*(const uint4*)(z + row * ZLD + 2432 + kvh * 64 + c), v);
    }
#pragma unroll
    for (int i = 0; i < 8; ++i) { Kl[j * 65 + c + i] = k[i]; Vl[j * 65 + c + i] = v[i]; }
    if (j >= 4) {
      float* ok = p.out + O_SK + ((size_t)((l * 128 + b) * 128 + (j - 4)) * 2 + kvh) * 64 + c;
      float* ov = p.out + O_SV + ((size_t)((l * 128 + b) * 128 + (j - 4)) * 2 + kvh) * 64 + c;
      *(float4*)ok = make_float4(k[0], k[1], k[2], k[3]); *(float4*)(ok + 4) = make_float4(k[4], k[5], k[6], k[7]);
      *(float4*)ov = make_float4(v[0], v[1], v[2], v[3]); *(float4*)(ov + 4) = make_float4(v[4], v[5], v[6], v[7]);
    }
  }
  if (tid < 128) {
    const int row = tid >> 3, c = (tid & 7) * 8;
    const int hl = row >> 2, t = row & 3;
    float q[8];
    unpack8(*(const uint4*)(z + (size_t)(M_P + b * 4 + t) * ZLD + 1792 + (kvh * 4 + hl) * 64 + c), q);
#pragma unroll
    for (int i = 0; i < 8; ++i) Ql[row * 64 + c + i] = q[i];
  }
  __syncthreads();
  const int row = tid >> 5, jl = tid & 31;
  const int t = row & 3, hq = kvh * 4 + (row >> 2);
  float sc[5];
  float mx = -1e30f;
#pragma unroll
  for (int jj = 0; jj < 5; ++jj) {
    const int j = jl + 32 * jj;
    float s = -1e30f;
    if (j < 132 && j > t && j <= t + 128) {
      float a = 0.f;
#pragma unroll 8
      for (int d = 0; d < 64; ++d) a += Ql[row * 64 + d] * Kl[j * 65 + d];
      s = a * 0.125f;
    }
    sc[jj] = s; mx = fmaxf(mx, s);
    __builtin_amdgcn_sched_barrier(0);
  }
#pragma unroll
  for (int o = 16; o >= 1; o >>= 1) mx = fmaxf(mx, __shfl_xor(mx, o, 64));
  const float sink = p.in[20][l * 8 + hq];
  mx = fmaxf(mx, sink);
  float sum = 0.f;
#pragma unroll
  for (int jj = 0; jj < 5; ++jj) { sc[jj] = __expf(sc[jj] - mx); sum += sc[jj]; }
#pragma unroll
  for (int o = 16; o >= 1; o >>= 1) sum += __shfl_xor(sum, o, 64);
  const float rden = 1.f / (sum + __expf(sink - mx));
#pragma unroll
  for (int jj = 0; jj < 5; ++jj) { const int j = jl + 32 * jj; if (j < 136) Pl[row * 136 + j] = sc[jj] * rden; }
  __syncthreads();
  {
    const int d = jl * 2;
    float o0 = 0.f, o1 = 0.f;
#pragma unroll 4
    for (int j = 0; j < 132; ++j) { const float pr = Pl[row * 136 + j]; o0 += pr * Vl[j * 65 + d]; o1 += pr * Vl[j * 65 + d + 1]; }
    if (!dry) *(unsigned*)(z + (size_t)(M_P + b * 4 + t) * ZLD + 1792 + hq * 64 + d) = pack2(o0, o1);
  }
}

__device__ __forceinline__ void phase_convgelu(const Params& p, int l, bool dry = false) {
  u16* cu = (u16*)(p.ws + WS_CU);
  const float* cw = p.in[26] + (size_t)l * 3 * 2816;
  const float* cb = p.in[27] + (size_t)l * 2816;
  for (int it = blockIdx.x; it < 1056; it += gridDim.x) {
    const int tid = opq(threadIdx.x);
    if (tid >= 352) continue;
    const int j0 = tid * 8;
    float w0[8], w1[8], w2[8], bb[8];
#pragma unroll
    for (int i = 0; i < 8; ++i) { w0[i] = cw[j0 + i]; w1[i] = cw[2816 + j0 + i]; w2[i] = cw[5632 + j0 + i]; bb[i] = cb[j0 + i]; }
    float c1[8], c2[8];
    for (int rr = 0; rr < 16; ++rr) {
      const int row = it * 16 + rr;
      const bool prompt = row < M_P;
      int b, t;
      if (prompt) { b = row >> 13; t = row & 8191; } else { b = (row - M_P) >> 2; t = (row - M_P) & 3; }
      if (t == 0) {
        if (prompt) {
#pragma unroll
          for (int i = 0; i < 8; ++i) { c1[i] = 0.f; c2[i] = 0.f; }
        } else {
          const float* st = p.in[6] + (size_t)((l * 128 + b) * 2) * 2816 + j0;
#pragma unroll
          for (int i = 0; i < 8; ++i) { c2[i] = st[i]; c1[i] = st[2816 + i]; }
        }
      } else if (rr == 0) {
        unpack8(*(const uint4*)(cu + (size_t)(row - 1) * 5632 + j0), c1);
        if (t >= 2) unpack8(*(const uint4*)(cu + (size_t)(row - 2) * 5632 + j0), c2);
        else {
#pragma unroll
          for (int i = 0; i < 8; ++i) c2[i] = 0.f;
        }
      }
      float c0[8], up[8], a[8];
      unpack8(*(const uint4*)(cu + (size_t)row * 5632 + j0), c0);
      unpack8(*(const uint4*)(cu + (size_t)row * 5632 + 2816 + j0), up);
#pragma unroll
      for (int i = 0; i < 8; ++i) {
        const float cv = bb[i] + w0[i] * c2[i] + w1[i] * c1[i] + w2[i] * c0[i];
        a[i] = gelu_fast(cv) * up[i];
      }
      if (!dry) *(uint4*)(cu + (size_t)row * 5632 + 2816 + j0) = pack8(a);
      if (prompt && t >= 8190) {
        float* o = p.out + O_PCONV + (size_t)((l * 2 + b) * 2 + (t - 8190)) * 2816 + j0;
        *(float4*)o = make_float4(c0[0], c0[1], c0[2], c0[3]); *(float4*)(o + 4) = make_float4(c0[4], c0[5], c0[6], c0[7]);
      } else if (!prompt && t >= 2) {
        float* o = p.out + O_SCONV + (size_t)((l * 128 + b) * 2 + (t - 2)) * 2816 + j0;
        *(float4*)o = make_float4(c0[0], c0[1], c0[2], c0[3]); *(float4*)(o + 4) = make_float4(c0[4], c0[5], c0[6], c0[7]);
      }
#pragma unroll
      for (int i = 0; i < 8; ++i) { c2[i] = c1[i]; c1[i] = c0[i]; }
    }
  }
}

__device__ __forceinline__ void phase_final(const Params& p) {
  float* X = p.out;
  const float* g = p.in[29];
  for (int it = blockIdx.x; it < 2112; it += gridDim.x) {
    const int tid = opq(threadIdx.x);
    const int lane = tid & 63;
    const int row = it * 8 + (tid >> 6);
    float4 v[4];
    float ss = 0.f;
#pragma unroll
    for (int i = 0; i < 4; ++i) {
      v[i] = *(const float4*)(X + (size_t)row * 1024 + i * 256 + lane * 4);
      ss += v[i].x * v[i].x + v[i].y * v[i].y + v[i].z * v[i].z + v[i].w * v[i].w;
    }
    ss = wave_sum(ss);
    const float rs = rsqrtf(ss * (1.f / 1024.f) + 1e-6f);
#pragma unroll
    for (int i = 0; i < 4; ++i) {
      const float4 gg = *(const float4*)(g + i * 256 + lane * 4);
      *(float4*)(X + (size_t)row * 1024 + i * 256 + lane * 4) =
          make_float4(v[i].x * rs * gg.x, v[i].y * rs * gg.y, v[i].z * rs * gg.z, v[i].w * rs * gg.w);
    }
  }
}

#define XB_TMO      128
#define XB_XCNT(j)  (256  + 64 * (j))
#define XB_XSUB(j)  (1280 + 64 * (j))
#define XB_XGEN(j)  (2304 + 64 * (j))
#define XB_TOP      3328
#define XB_TOPGEN   3392
#define XCD_BAR_WORDS 3456
#define XB_SPIN_CAP (1u << 18)
#define LAS __attribute__((address_space(3)))

__device__ __forceinline__ unsigned xb_ld(unsigned* p)              { return __hip_atomic_load(p, __ATOMIC_RELAXED, __HIP_MEMORY_SCOPE_AGENT); }
__device__ __forceinline__ unsigned xb_add(unsigned* p, unsigned v) { return __hip_atomic_fetch_add(p, v, __ATOMIC_RELAXED, __HIP_MEMORY_SCOPE_AGENT); }
__device__ __forceinline__ unsigned xb_xcc_id() { return (unsigned)__builtin_amdgcn_s_getreg((3 << 11) | 20) & 0xFu; }
#define XB_SPIN(cond, bar) do { unsigned _sp = 0; while (cond) { __builtin_amdgcn_s_sleep(1); \
    if ((++_sp & 255u) == 0u) { if (xb_ld(&(bar)[XB_TMO])) break; if (_sp > XB_SPIN_CAP) { atomicAdd(&(bar)[XB_TMO], 1u); break; } } } } while (0)

struct XcdBarrier {
    unsigned* bar; unsigned x;
    volatile LAS unsigned* st;
};

__device__ __forceinline__ XcdBarrier xcd_barrier_post(unsigned* bar, volatile LAS unsigned* st) {
    XcdBarrier b; b.bar = bar; b.x = xb_xcc_id(); b.st = st;
    if (threadIdx.x == 0) (void)xb_add(&bar[XB_XCNT(b.x)], 1u);
    return b;
}
__device__ __forceinline__ void xcd_barrier_complete(unsigned* bar, unsigned x, unsigned& nloc, unsigned& nx) {
    const unsigned G = gridDim.x * gridDim.y * gridDim.z;
    unsigned sum, cnt, mine, sp = 0u;
    for (;;) {
        sum = 0u; cnt = 0u; mine = 0u;
#pragma unroll
        for (unsigned j = 0; j < 16; ++j) { const unsigned c = xb_ld(&bar[XB_XCNT(j)]); sum += c; cnt += (c > 0u) ? 1u : 0u; mine = (j == x) ? c : mine; }
        if (sum == G) break;
        __builtin_amdgcn_s_sleep(1);
        if ((++sp & 255u) == 0u) { if (xb_ld(&bar[XB_TMO])) break; if (sp > XB_SPIN_CAP) { atomicAdd(&bar[XB_TMO], 1u); break; } }
    }
    nloc = mine > 0u ? mine : 1u; nx = cnt > 0u ? cnt : 1u;
}

__device__ __forceinline__ void xcd_barrier(const XcdBarrier& b) {
    asm volatile("s_waitcnt vmcnt(0)" ::: "memory");
    __syncthreads();
    if (threadIdx.x == 0) {
        unsigned* bar = b.bar;
        __builtin_amdgcn_s_waitcnt(0);
        unsigned nloc = b.st[0], nx = b.st[1];
        if (nloc == 0u) { xcd_barrier_complete(bar, b.x, nloc, nx); b.st[0] = nloc; b.st[1] = nx; }
        const unsigned old = xb_add(&bar[XB_XSUB(b.x)], 1u);
        const unsigned gen = old / nloc;
        if (old + 1u == (gen + 1u) * nloc) {
            __builtin_amdgcn_fence(__ATOMIC_RELEASE, "agent");
            asm volatile("s_waitcnt vmcnt(0)" ::: "memory");
            const unsigned og = xb_add(&bar[XB_TOP], 1u);
            const unsigned tg = og / nx;
            if (og + 1u == (tg + 1u) * nx) xb_add(&bar[XB_TOPGEN], 1u);
            else XB_SPIN(xb_ld(&bar[XB_TOPGEN]) == tg, bar);
            __builtin_amdgcn_fence(__ATOMIC_ACQUIRE, "agent");
            xb_add(&bar[XB_XGEN(b.x)], 1u);
            asm volatile("s_waitcnt vmcnt(0)" ::: "memory");
        } else {
            XB_SPIN(xb_ld(&bar[XB_XGEN(b.x)]) == gen, bar);
            __builtin_amdgcn_fence(__ATOMIC_ACQUIRE, "agent");
            asm volatile("s_waitcnt vmcnt(0)" ::: "memory");
        }
    }
    __syncthreads();
}

#define WS_BAR 256000000ull
#if COOP
#ifndef SYNC_RPT
#define SYNC_RPT 1
#endif
#define PH_SYNC(idx) do { if ((idx) + 1 < ph_hi && (idx) >= ph_lo) { for (int sr_ = 0; sr_ < SYNC_RPT; ++sr_) xcd_barrier(xb); } } while (0)
#else
#define PH_SYNC(idx) do { } while (0)
#endif
#define PH_ON(idx, bit) (((KMASK >> (bit)) & 1) && ph_lo <= (idx) && (idx) < ph_hi)

__device__ __forceinline__ Params load_params() {
  auto kp0 = __builtin_amdgcn_kernarg_segment_ptr();
  asm volatile("" : "+s"(kp0));
  auto kq = (const __constant__ unsigned long long*)kp0;
  Params p;
#pragma unroll
  for (int i = 0; i < 30; ++i) p.in[i] = (const float*)kq[i];
  p.out = (float*)kq[30];
  p.ws = (unsigned char*)kq[31];
  p.ph_lo = 0; p.ph_hi = 0;
  return p;
}

template <int KMASK, int l>
__device__ __forceinline__ void layer_phases(int ph_lo, int ph_hi, unsigned char* lds_raw, const XcdBarrier& xb) {
  float* ldsf = (float*)lds_raw;
  u16* ldsh = (u16*)lds_raw;
  const int base = l * 12;
  if (PH_ON(base + 0, 0)) { const Params p = load_params(); RPT(0) phase_prep(p, l, 0, ldsf); }
  PH_SYNC(base + 0);
  if (PH_ON(base + 1, 1)) {
    const Params p = load_params();
    EpiInproj E; E.z = (u16*)(p.ws + WS_Z); E.out = p.out; E.l = l;
    RPT(1) run_gemm(lds_raw, (const u16*)(p.ws + WS_H), 1024, (const u16*)(p.ws + WS_WT) + WT_IN, 2560, 1024, E);
  }
  PH_SYNC(base + 1);
  if (PH_ON(base + 2, 2)) {
    const Params p = load_params();
    for (int it = blockIdx.x; it < 264; it += gridDim.x) rope_item(p, l, it, false);
    if (blockIdx.x < 64) rwkv_item(p, l, 2048 + blockIdx.x, ldsf, false);
    {
      const Params p2 = load_params();
      int i0, n;
      if (gridDim.x == 256) { if (blockIdx.x < 64) { i0 = blockIdx.x * 5; n = 5; } else { i0 = 320 + (blockIdx.x - 64) * 9; n = 9; } }
      else { i0 = 0; n = 0; }
      RPT(2) {
        if (gridDim.x == 256) { for (int i = 0; i < n; ++i) rwkv_item2(p2, l, i0 + i, ldsf); }
        else { for (int it = blockIdx.x; it < 2048; it += gridDim.x) rwkv_item2(p2, l, it, ldsf); }
      }
    }
  }
  PH_SYNC(base + 2);
  if (PH_ON(base + 3, 3)) {
    const Params p = load_params();
    if (blockIdx.x < 16) { RPT(3) rwkv_scan(p, l, blockIdx.x, ldsf, DRY(3)); }
    else {
      RPT(15) for (int it = blockIdx.x - 16; it < 512; it += gridDim.x - 16) {
        if (it < 256) attn_prompt(p, l, it, ldsh, DRY(15)); else attn_sample(p, l, it - 256, ldsf, DRY(15));
      }
    }
  }
  PH_SYNC(base + 3);
  if (PH_ON(base + 4, 4)) {
    const Params p = load_params();
    RPT(4) for (int it = blockIdx.x; it < 2048; it += gridDim.x) rwkv_out(p, l, it, ldsf);
  }
  PH_SYNC(base + 4);
  if (PH_ON(base + 5, 5)) {
    const Params p = load_params();
    EpiStoreBf16 E1; E1.O = (u16*)(p.ws + WS_T1); E1.ldc = 1024;
    RPT(5) run_gemm(lds_raw, (const u16*)(p.ws + WS_Z), ZLD, (const u16*)(p.ws + WS_WT) + WT_BRA, 1024, 512, E1);
    EpiStoreBf16 E2; E2.O = (u16*)(p.ws + WS_T2); E2.ldc = 1024;
    run_gemm(lds_raw, (const u16*)(p.ws + WS_Z) + 1792, ZLD, (const u16*)(p.ws + WS_WT) + WT_BRB, 1024, 512, E2);
  }
  PH_SYNC(base + 5);
  if (PH_ON(base + 6, 6)) {
    const Params p = load_params();
    EpiMerge E; E.t1 = (const u16*)(p.ws + WS_T1); E.t2 = (const u16*)(p.ws + WS_T2); E.mg = (u16*)(p.ws + WS_MG);
    RPT(6) run_gemm(lds_raw, (const u16*)(p.ws + WS_H), 1024, (const u16*)(p.ws + WS_WT) + WT_G, 2048, 1024, E);
  }
  PH_SYNC(base + 6);
  if (PH_ON(base + 7, 7)) {
    const Params p = load_params();
    EpiResid E; E.X = p.out;
    RPT(7) { E.dry = DRY(7); run_gemm(lds_raw, (const u16*)(p.ws + WS_MG), 1024, (const u16*)(p.ws + WS_WT) + WT_OUT, 1024, 1024, E); }
  }
  PH_SYNC(base + 7);
  if (PH_ON(base + 8, 8)) { const Params p = load_params(); RPT(8) phase_prep(p, l, 1, ldsf); }
  PH_SYNC(base + 8);
  if (PH_ON(base + 9, 9)) {
    const Params p = load_params();
    EpiFfnIn E; E.cu = (u16*)(p.ws + WS_CU);
    RPT(9) run_gemm(lds_raw, (const u16*)(p.ws + WS_H), 1024, (const u16*)(p.ws + WS_WTF) + WT_FIN, 5632, 1024, E);
  }
  PH_SYNC(base + 9);
  if (PH_ON(base + 10, 10)) { const Params p = load_params(); RPT(10) phase_convgelu(p, l, DRY(10)); }
  PH_SYNC(base + 10);
  if (PH_ON(base + 11, 11)) {
    const Params p = load_params();
    EpiResid E; E.X = p.out;
    RPT(11) { E.dry = DRY(11); run_gemm(lds_raw, (const u16*)(p.ws + WS_CU) + 2816, 5632, (const u16*)(p.ws + WS_WTF) + WT_FDN, 1024, 2816, E); }
  }
  PH_SYNC(base + 11);
}

template <int KMASK>
__global__ void __launch_bounds__(NT) fwd_kernel(Params pin) {
  extern __shared__ __attribute__((aligned(16))) unsigned char lds_raw[];
  const int ph_lo = pin.ph_lo, ph_hi = pin.ph_hi;
  XcdBarrier xb;
  {
    volatile LAS unsigned* st = (volatile LAS unsigned*)(lds_raw + (LDS_BYTES - 16));
    if (threadIdx.x < 2) st[threadIdx.x] = 0u;
    __syncthreads();
    xb = xcd_barrier_post((unsigned*)(pin.ws + WS_BAR), st);
  }
  if (ph_hi > 100000) cg::this_grid().sync();
  layer_phases<KMASK, 0>(ph_lo, ph_hi, lds_raw, xb);
  layer_phases<KMASK, 1>(ph_lo, ph_hi, lds_raw, xb);
  if (PH_ON(NPH - 1, 12)) { const Params p = load_params(); phase_final(p); }
}

extern "C" void kernel_launch(void* const* d_in, const int* in_sizes, int n_in, void* d_out, int out_size, void* d_ws,
                              size_t ws_size, hipStream_t stream) {
  static int grid = 0;
  if (grid == 0) {
    int dev = 0, cus = 0;
    (void)hipGetDevice(&dev);
    (void)hipDeviceGetAttribute(&cus, hipDeviceAttributeMultiprocessorCount, dev);
    grid = cus > 0 ? cus : 256;
    (void)hipFuncSetAttribute((const void*)fwd_kernel<PHMASK>, hipFuncAttributeMaxDynamicSharedMemorySize, LDS_BYTES);
    (void)hipGetLastError();
  }
  Params p{};
  for (int i = 0; i < 30; ++i) p.in[i] = (const float*)d_in[i];
  p.out = (float*)d_out;
  p.ws = (unsigned char*)d_ws;
#if COOP
  (void)hipMemsetAsync((unsigned char*)d_ws + WS_BAR, 0, XCD_BAR_WORDS * 4, stream);
  p.ph_lo = 0; p.ph_hi = NPH;
  void* args[] = {&p};
  hipError_t e = hipLaunchCooperativeKernel((const void*)fwd_kernel<PHMASK>, dim3(grid), dim3(NT), args, LDS_BYTES, stream);
  if (e != hipSuccess) fprintf(stderr, "cooperative launch failed: %s (grid %d)\n", hipGetErrorString(e), grid);
#else
  for (int ph = 0; ph < NPH; ++ph) {
    p.ph_lo = ph; p.ph_hi = ph + 1;
    hipLaunchKernelGGL(fwd_kernel<PHMASK>, dim3(grid), dim3(NT), LDS_BYTES, stream, p);
  }
#endif
}
```

```cpp
#include <hip/hip_runtime.h>
#include <hip/hip_bf16.h>
#include <hip/hip_cooperative_groups.h>
#include <cstdio>
namespace cg = cooperative_groups;

typedef __attribute__((ext_vector_type(8))) short bf16x8;
typedef __attribute__((ext_vector_type(16))) float f32x16;
typedef unsigned short u16;

#ifndef PHMASK
#define PHMASK 0x1FFF
#endif
#ifndef T3
#define T3 7
#endif
#ifndef P2SEL
#define P2SEL 7
#endif
#ifndef RPT_MASK
#define RPT_MASK 0
#endif
#ifndef RPT_N
#define RPT_N 1
#endif
#define RPT(bit) for (int rp_ = 0; rp_ < (((RPT_MASK >> (bit)) & 1) ? 1 + RPT_N : 1); ++rp_)
#define RPT_CNT(bit) (((RPT_MASK >> (bit)) & 1) ? 1 + RPT_N : 1)
#define DRY(bit) (opq(rp_) + 1 < RPT_CNT(bit))
#ifndef COOP
#define COOP 1
#endif

#define NT 512
#define M_TOT 16896
#define M_P 16384
#define ZLD 2560
#define NPH 25

#define WS_WT   0ull
#define WS_H    13631488ull
#define WS_Z    48234496ull
#define WS_R    134742016ull
#define WS_PP   (WS_R)
#define WS_GC   (WS_R + 16777216ull)
#define WS_Q    (WS_R + 17301504ull)
#define WS_W2   (WS_R + 50855936ull)
#define WS_YL   (WS_R + 67633152ull)
#define WS_BO   (WS_R + 84410368ull)
#define WS_GA   (WS_R + 101187584ull)
#define WS_T1   (WS_R)
#define WS_T2   (WS_R + 34603008ull)
#define WS_MG   (WS_R + 69206016ull)
#define WS_WTF  (WS_Z)
#define WS_CU   (WS_Z + 17301504ull)
#define WT_IN  0
#define WT_G   2621440
#define WT_BRA 4718592
#define WT_BRB 5242880
#define WT_OUT 5767168
#define WT_FIN 0
#define WT_FDN 5767168
#define O_PSHIFT 17301504
#define O_PWKV   17308672
#define O_PK     17439744
#define O_PV     17505280
#define O_PCONV  17570816
#define O_SSHIFT 17593344
#define O_SWKV   18052096
#define O_SK     26440704
#define O_SV     30635008
#define O_SCONV  34829312

#define LDS_BYTES 151552

struct Params {
  const float* in[30];
  float* out;
  unsigned char* ws;
  int ph_lo, ph_hi;
};

typedef float f2v_ __attribute__((ext_vector_type(2)));
typedef __bf16 b2v_ __attribute__((ext_vector_type(2)));
__device__ __forceinline__ unsigned pack2(float a, float b) { f2v_ v = {a, b}; b2v_ r = __builtin_convertvector(v, b2v_); return __builtin_bit_cast(unsigned, r); }
__device__ __forceinline__ u16 f2bf(float f) { return (u16)(pack2(f, f) & 0xFFFFu); }
__device__ __forceinline__ float bf2f(u16 h) { return __uint_as_float(((unsigned)h) << 16); }
__device__ __forceinline__ float sigm(float x) { return __builtin_amdgcn_rcpf(1.f + __expf(-x)); }
__device__ __forceinline__ void unpack8(uint4 u, float* o) {
  o[0] = __uint_as_float(u.x << 16); o[1] = __uint_as_float(u.x & 0xFFFF0000u);
  o[2] = __uint_as_float(u.y << 16); o[3] = __uint_as_float(u.y & 0xFFFF0000u);
  o[4] = __uint_as_float(u.z << 16); o[5] = __uint_as_float(u.z & 0xFFFF0000u);
  o[6] = __uint_as_float(u.w << 16); o[7] = __uint_as_float(u.w & 0xFFFF0000u);
}
__device__ __forceinline__ uint4 pack8(const float* f) {
  uint4 u; u.x = pack2(f[0], f[1]); u.y = pack2(f[2], f[3]); u.z = pack2(f[4], f[5]); u.w = pack2(f[6], f[7]); return u;
}
__device__ __forceinline__ float gelu_fast(float v) {
  const float av = fabsf(v), d = av * 0.2316418882f + 1.0f;
  const float t = __builtin_amdgcn_rcpf(d);
  float q = t * 0.5307027145f + (-0.7265760135f); q = q * t + 0.7107068705f; q = q * t + (-0.142248368f); q = q * t + 0.127414796f; q = q * t;
  const float e = __builtin_amdgcn_exp2f((v * v) * (-0.72134752044f));
  const float m = v * (q * e);
  return v < 0.f ? m : v - m;
}
__device__ __forceinline__ int opq(int x) { asm volatile("" : "+v"(x)); return x; }
__device__ __forceinline__ float wave_sum(float x) {
#pragma unroll
  for (int o = 32; o >= 1; o >>= 1) x += __shfl_xor(x, o, 64);
  return x;
}

namespace pg8 {
#define PG8_LAS __attribute__((address_space(3)))
typedef unsigned short bf16_t;
typedef short bf16x8 __attribute__((ext_vector_type(8)));
typedef float f32x4 __attribute__((ext_vector_type(4)));
typedef unsigned u32x4 __attribute__((ext_vector_type(4)));
constexpr int BM = 256, BK = 64, HALF = 128, HTB = HALF * BK * 2  , STAGE_BYTES = 8 * HTB, NXCD = 8, WGM = 8;
__host__ __device__ __forceinline__ int lds_byte(int r, int c) { const int st = (r >> 4) * 2 + (c >> 5), rr = r & 15, cc = c & 31, ob = rr * 64 + cc * 2; return st * 1024 + (ob ^ (((ob >> 9) & 1) << 5)); }
__host__ __device__ __forceinline__ void stage_rc(int b, int& R, int& C) { const int st = b / 1024, sb = b % 1024, swz = sb ^ (((sb >> 9) & 1) << 5); R = (st >> 1) * 16 + swz / 64; C = (st & 1) * 32 + (swz % 64) / 2; }
__host__ __device__ __forceinline__ int perm32(int rho) { const int n = rho >> 4, i = rho & 15; return 8 * (i >> 2) + 4 * n + (i & 3); }
struct Unit { int pm, pn; };
struct Gemm { const bf16_t* A; const bf16_t* Bt; int M, N, K, lda; };
struct StaticOrder {
    int nM, nN, nwg, G, c;
    __host__ __device__ void init(int M, int N, int G_, int c_) { nM = M / BM; nN = N / BM; nwg = nM * nN; G = G_; c = c_; }
    __host__ __device__ bool next(int i, Unit& u) const {
        const long L = (long)i * G + c; if (L >= nwg) return false;
        int wgid = (int)L; { const int q = nwg / NXCD, r = nwg % NXCD, xcd = wgid % NXCD, off = wgid / NXCD; wgid = (xcd < r ? xcd * (q + 1) : r * (q + 1) + (xcd - r) * q) + off; }
        const int nig = WGM * nN, gid = wgid / nig, fm = gid * WGM, gsz = (nM - fm) < WGM ? (nM - fm) : WGM;
        u.pm = fm + ((wgid % nig) % gsz); u.pn = (wgid % nig) / gsz; return true;
    }
    __device__ __forceinline__ void a_ready(const Unit&) const {}
    __device__ __forceinline__ void done(const Unit&) const {}
};
__device__ __forceinline__ unsigned cvt_pk_bf16(float lo, float hi) { return ::pack2(lo, hi); }
template <class Epi, class Sched, bool STAMP = false>
__device__ __forceinline__ void gemm_phase(PG8_LAS unsigned char* lds, const Gemm g, const Sched& S, const Epi& E, unsigned long long* stamps) {
    const int tid = ::opq(threadIdx.x), wid = __builtin_amdgcn_readfirstlane(tid >> 6), lane = tid & 63, wr = wid >> 2, wc = wid & 3, fr = lane & 15, fq = lane >> 4;
    const int K = g.K, nt = K / BK;
    int ts_lo = 0, ts_hi = 0, nts = 0; const unsigned long long rt_entry = 0ull;
#define PG8_STAMP() do { if (STAMP && wid == 0 && nts < 64) { const unsigned long long _c = (unsigned long long)clock64(); \
        ts_lo = (lane == nts) ? (int)(unsigned)_c : ts_lo; ts_hi = (lane == nts) ? (int)(unsigned)(_c >> 32) : ts_hi; ++nts; } } while (0)
    PG8_STAMP();
    unsigned voffA[2], voffB[2];
#pragma unroll
    for (int i = 0; i < 2; ++i) { int R, C; stage_rc(tid * 16 + i * 8192, R, C); const int Rb = Epi::PERM ? ((R & ~31) + perm32(R & 31)) : R;
        voffA[i] = (unsigned)(R * g.lda + C) * 2u; voffB[i] = (unsigned)(Rb * K + C) * 2u; }
    const size_t kstep = (size_t)(BK * 2);
    const size_t hstep = (size_t)HALF * K * 2;
    const size_t tstep = 2 * hstep; const size_t hstepA = (size_t)HALF * g.lda * 2; const size_t tstepA = 2 * hstepA;
    const unsigned ldsw = (unsigned)wid * 1024u;
    const int aoff = lds_byte(wr * 64 + fr, fq * 8), boff = lds_byte(wc * 32 + fr, fq * 8);
#define PG8_SA(b, h) (((b) * 2 + (h)) * HTB)
#define PG8_SB(b, h) ((4 + (b) * 2 + (h)) * HTB)
#define PG8_STAGE(bufoff, gbase, voff) do { _Pragma("unroll") for (int _i = 0; _i < 2; ++_i) \
        __builtin_amdgcn_global_load_lds((const unsigned*)((const char*)(gbase) + (voff)[_i]), (PG8_LAS unsigned*)(lds + (bufoff) + ldsw + _i * 8192), 16, 0, 0); } while (0)
#define PG8_LDA(dst, b, h) do { _Pragma("unroll") for (int m = 0; m < 4; ++m) _Pragma("unroll") for (int k = 0; k < 2; ++k) dst[m][k] = *(const PG8_LAS bf16x8*)(lds + PG8_SA(b, h) + aoff + m * 2048 + k * 1024); } while (0)
#define PG8_LDB(dst, b, h) do { _Pragma("unroll") for (int n = 0; n < 2; ++n) _Pragma("unroll") for (int k = 0; k < 2; ++k) dst[n][k] = *(const PG8_LAS bf16x8*)(lds + PG8_SB(b, h) + boff + n * 2048 + k * 1024); } while (0)
#define PG8_MMA(ai, bj, At, Bt) do { __builtin_amdgcn_s_setprio(1); _Pragma("unroll") for (int m = 0; m < 4; ++m) _Pragma("unroll") for (int n = 0; n < 2; ++n) _Pragma("unroll") for (int k = 0; k < 2; ++k) \
        acc[ai][bj][m][n] = __builtin_amdgcn_mfma_f32_16x16x32_bf16(Bt[n][k], At[m][k], acc[ai][bj][m][n], 0, 0, 0); __builtin_amdgcn_s_setprio(0); } while (0)
#define PG8_WAIT_V(n) asm volatile("s_waitcnt vmcnt(" #n ")" ::: "memory")
#define PG8_WAIT_L(n) asm volatile("s_waitcnt lgkmcnt(" #n ")" ::: "memory")
#define PG8_BAR __builtin_amdgcn_s_barrier()
#define PG8_SCHED __builtin_amdgcn_sched_barrier(0)
    Unit cur, nxt; int ui = 0;
    if (!S.next(0, cur)) return;
    f32x4 acc[2][2][4][2];
#pragma unroll
    for (int a = 0; a < 2; ++a)
#pragma unroll
        for (int b = 0; b < 2; ++b)
#pragma unroll
            for (int m = 0; m < 4; ++m)
#pragma unroll
                for (int n = 0; n < 2; ++n) acc[a][b][m][n] = (f32x4){0.f, 0.f, 0.f, 0.f};
    bf16x8 At[4][2], B0[2][2], B1[2][2];
    const char* cA = (const char*)g.A + (size_t)cur.pm * tstepA; const char* cB = (const char*)g.Bt + (size_t)cur.pn * tstep;
    S.a_ready(cur);
    PG8_STAGE(PG8_SB(0, 0), cB, voffB); PG8_STAGE(PG8_SA(0, 0), cA, voffA); PG8_STAGE(PG8_SB(0, 1), cB + hstep, voffB); PG8_STAGE(PG8_SA(0, 1), cA + hstepA, voffA);
    if (wr == 1) PG8_BAR;
    PG8_WAIT_V(4); PG8_BAR;
    PG8_STAGE(PG8_SB(1, 0), cB + kstep, voffB); PG8_STAGE(PG8_SA(1, 0), cA + kstep, voffA); PG8_STAGE(PG8_SB(1, 1), cB + hstep + kstep, voffB);
    PG8_WAIT_V(6); PG8_BAR;
    PG8_STAMP();
    for (;;) {
        const bool has_next = S.next(ui + 1, nxt);
        const char* nA = has_next ? (const char*)g.A + (size_t)nxt.pm * tstepA : cA; const char* nB = has_next ? (const char*)g.Bt + (size_t)nxt.pn * tstep : cB;
        for (int t = 0; t < nt; t += 2) {
            const bool last = (t == nt - 2);
            const char* a1 = cA + (size_t)(t + 1) * kstep;
            const char* a2 = last ? nA : cA + (size_t)(t + 2) * kstep; const char* b2 = last ? nB : cB + (size_t)(t + 2) * kstep;
            const char* a3 = a2 + kstep; const char* b3 = b2 + kstep;
            if (last && has_next) S.a_ready(nxt);
            PG8_LDB(B0, 0, 0); PG8_SCHED; PG8_LDA(At, 0, 0); PG8_STAGE(PG8_SA(1, 1), a1 + hstepA, voffA);
            PG8_WAIT_L(8); PG8_BAR; PG8_WAIT_L(0); PG8_MMA(0, 0, At, B0); PG8_BAR; PG8_SCHED;
            PG8_LDB(B1, 0, 1); PG8_STAGE(PG8_SB(0, 0), b2, voffB);
            PG8_BAR; PG8_WAIT_L(0); PG8_MMA(0, 1, At, B1); PG8_BAR;
            PG8_LDA(At, 0, 1); PG8_STAGE(PG8_SA(0, 0), a2, voffA);
            PG8_BAR; PG8_WAIT_L(0); PG8_MMA(1, 0, At, B0); PG8_BAR; PG8_SCHED;
            PG8_STAGE(PG8_SB(0, 1), b2 + hstep, voffB);
            PG8_WAIT_V(6); PG8_BAR; PG8_MMA(1, 1, At, B1); PG8_BAR;
            PG8_LDB(B0, 1, 0); PG8_SCHED; PG8_LDA(At, 1, 0); PG8_STAGE(PG8_SA(0, 1), a2 + hstepA, voffA);
            PG8_WAIT_L(8); PG8_BAR; PG8_WAIT_L(0); PG8_MMA(0, 0, At, B0); PG8_BAR; PG8_SCHED;
            PG8_LDB(B1, 1, 1); PG8_STAGE(PG8_SB(1, 0), b3, voffB);
            PG8_BAR; PG8_WAIT_L(0); PG8_MMA(0, 1, At, B1); PG8_BAR;
            PG8_LDA(At, 1, 1); PG8_STAGE(PG8_SA(1, 0), a3, voffA);
            PG8_BAR; PG8_WAIT_L(0); PG8_MMA(1, 0, At, B0); PG8_BAR; PG8_SCHED;
            PG8_STAGE(PG8_SB(1, 1), b3 + hstep, voffB);
            PG8_WAIT_V(6); PG8_BAR; PG8_MMA(1, 1, At, B1); PG8_BAR;
        }
        PG8_STAMP();
        if constexpr (!Epi::AFTER_DRAIN) { E(acc, cur, wr, wc, fr, fq); S.done(cur); }
        PG8_STAMP();
        if (!has_next) break;
#pragma unroll
        for (int a = 0; a < 2; ++a)
#pragma unroll
            for (int b = 0; b < 2; ++b)
#pragma unroll
                for (int m = 0; m < 4; ++m)
#pragma unroll
                    for (int n = 0; n < 2; ++n) acc[a][b][m][n] = (f32x4){0.f, 0.f, 0.f, 0.f};
        cur = nxt; cA = nA; cB = nB; ++ui;
    }
    PG8_WAIT_V(0);
    if (wr == 0) PG8_BAR;
    PG8_BAR;
    if constexpr (Epi::AFTER_DRAIN) { E.fused(acc, cur, wr, wc, fr, fq, lds, wid, lane); S.done(cur); }
    PG8_STAMP();
    if (STAMP && wid == 0) { stamps[lane] = lane < nts ? (((unsigned long long)(unsigned)ts_hi << 32) | (unsigned)ts_lo) : 0ull;
        if (lane == 62) stamps[62] = rt_entry; if (lane == 63) stamps[63] = (unsigned long long)wall_clock64(); }
#undef PG8_STAMP
#undef PG8_SA
#undef PG8_SB
#undef PG8_STAGE
#undef PG8_LDA
#undef PG8_LDB
#undef PG8_MMA
#undef PG8_WAIT_V
#undef PG8_WAIT_L
#undef PG8_BAR
#undef PG8_SCHED
}
}
using pg8::f32x4;
#define ROWOFF(reg, h) (((reg) & 3) + 8 * ((reg) >> 2) + 4 * (h))

__device__ __forceinline__ void conv_tile(const float* __restrict__ src, int K, int N, u16* __restrict__ dst, int k0, int n0, int sn0, float* lds) {
  const int tid = opq(threadIdx.x);
  __syncthreads();
  {
    const int k = tid >> 3, c = (tid & 7) * 8;
    const float* s = src + (size_t)(k0 + k) * N + sn0 + c;
    float4 a = *(const float4*)s, b = *(const float4*)(s + 4);
    float* d = lds + k * 65 + c;
    d[0] = a.x; d[1] = a.y; d[2] = a.z; d[3] = a.w;
    d[4] = b.x; d[5] = b.y; d[6] = b.z; d[7] = b.w;
  }
  __syncthreads();
  {
    const int n = tid >> 3, kk = (tid & 7) * 8;
    float f[8];
#pragma unroll
    for (int i = 0; i < 8; ++i) f[i] = lds[(kk + i) * 65 + n];
    *(uint4*)(dst + (size_t)(n0 + n) * K + k0 + kk) = pack8(f);
  }
}

__device__ __forceinline__ void phase_prep(const Params& p, int l, int which, float* ldsf) {
  u16* WtA = (u16*)(p.ws + WS_WT);
  u16* WtF = (u16*)(p.ws + WS_WTF);
  u16* H = (u16*)(p.ws + WS_H);
  float* X = p.out;
  const int nconv = which == 0 ? (640 + 512 + 128 + 128 + 256) : (1408 + 704);
  const int ntot = nconv + 2112;
  const float* gw = (which == 0 ? p.in[7] : p.in[24]) + l * 1024;
  for (int it = blockIdx.x; it < ntot; it += gridDim.x) {
    if (it < nconv) {
      int t = it;
      if (which == 0) {
        if (t < 640) { const int tk = t / 40, tn = t % 40; conv_tile(p.in[8] + (size_t)l * 1024 * 4608, 1024, 4608, WtA + WT_IN, tk * 64, tn * 64, tn * 64, ldsf); }
        else if ((t -= 640) < 512) {
          const int tk = t / 32, tn = t % 32; const int n0 = tn * 64;
          const int sn0 = 2560 + ((n0 >> 7) & 1) * 1024 + (n0 >> 8) * 128 + (n0 & 127);
          conv_tile(p.in[8] + (size_t)l * 1024 * 4608, 1024, 4608, WtA + WT_G, tk * 64, n0, sn0, ldsf);
        }
        else if ((t -= 512) < 128) { const int tk = t / 16, tn = t % 16; conv_tile(p.in[21] + (size_t)l * 512 * 1024, 512, 1024, WtA + WT_BRA, tk * 64, tn * 64, tn * 64, ldsf); }
        else if ((t -= 128) < 128) { const int tk = t / 16, tn = t % 16; conv_tile(p.in[22] + (size_t)l * 512 * 1024, 512, 1024, WtA + WT_BRB, tk * 64, tn * 64, tn * 64, ldsf); }
        else { t -= 128; const int tk = t / 16, tn = t % 16; conv_tile(p.in[23] + (size_t)l * 1024 * 1024, 1024, 1024, WtA + WT_OUT, tk * 64, tn * 64, tn * 64, ldsf); }
      } else {
        if (t < 1408) {
          const int tk = t / 88, tn = t % 88; const int n0 = tn * 64;
          const int sn0 = ((n0 >> 7) & 1) * 2816 + (n0 >> 8) * 128 + (n0 & 127);
          conv_tile(p.in[25] + (size_t)l * 1024 * 5632, 1024, 5632, WtF + WT_FIN, tk * 64, n0, sn0, ldsf);
        } else { t -= 1408; const int tk = t / 16, tn = t % 16; conv_tile(p.in[28] + (size_t)l * 2816 * 1024, 2816, 1024, WtF + WT_FDN, tk * 64, tn * 64, tn * 64, ldsf); }
      }
    } else {
      const int tid = opq(threadIdx.x);
      const int row = (it - nconv) * 8 + (tid >> 6);
      const int lane = tid & 63;
      const bool first = (which == 0 && l == 0);
      const float* src;
      if (first) src = (row < M_P) ? p.in[0] + (size_t)row * 1024 : p.in[1] + (size_t)(row - M_P) * 1024;
      else src = X + (size_t)row * 1024;
      float4 v[4];
      float ss = 0.f;
#pragma unroll
      for (int i = 0; i < 4; ++i) {
        v[i] = *(const float4*)(src + i * 256 + lane * 4);
        ss += v[i].x * v[i].x + v[i].y * v[i].y + v[i].z * v[i].z + v[i].w * v[i].w;
        if (first) *(float4*)(X + (size_t)row * 1024 + i * 256 + lane * 4) = v[i];
      }
      ss = wave_sum(ss);
      const float rs = rsqrtf(ss * (1.f / 1024.f) + 1e-6f);
#pragma unroll
      for (int i = 0; i < 4; ++i) {
        const float4 g = *(const float4*)(gw + i * 256 + lane * 4);
        uint2 o; o.x = pack2(v[i].x * rs * g.x, v[i].y * rs * g.y); o.y = pack2(v[i].z * rs * g.z, v[i].w * rs * g.w);
        *(uint2*)(H + (size_t)row * 1024 + i * 256 + lane * 4) = o;
      }
    }
  }
}

struct EpiInproj {
  static constexpr bool PERM = true, AFTER_DRAIN = false;
  u16* z; float* out; int l;
  __device__ __forceinline__ void operator()(const f32x4 (&acc)[2][2][4][2], const pg8::Unit& u, int wr, int wc, int fr, int fq) const {
    const int row0 = u.pm * 256 + wr * 64 + fr, col0 = u.pn * 256 + wc * 32 + 8 * fq;
#pragma unroll
    for (int ai = 0; ai < 2; ++ai)
#pragma unroll
      for (int m = 0; m < 4; ++m) {
        const int row = row0 + ai * 128 + m * 16;
        u16* rowp = z + (size_t)row * ZLD + col0;
#pragma unroll
        for (int bj = 0; bj < 2; ++bj) {
          const f32x4 v0 = acc[ai][bj][m][0], v1 = acc[ai][bj][m][1];
          pg8::u32x4 w; w.x = pg8::cvt_pk_bf16(v0[0], v0[1]); w.y = pg8::cvt_pk_bf16(v0[2], v0[3]); w.z = pg8::cvt_pk_bf16(v1[0], v1[1]); w.w = pg8::cvt_pk_bf16(v1[2], v1[3]);
          *(pg8::u32x4*)(rowp + bj * 128) = w;
        }
        const bool prompt = row < M_P;
        int b, t;
        if (prompt) { b = row >> 13; t = row & 8191; } else { b = (row - M_P) >> 2; t = (row - M_P) & 3; }
        if (u.pn < 7) {
          if ((prompt && t == 8191) || (!prompt && t == 3)) {
            float* o = out + (prompt ? O_PSHIFT + (size_t)(l * 2 + b) * 1792 : O_SSHIFT + (size_t)(l * 128 + b) * 1792) + col0;
#pragma unroll
            for (int bj = 0; bj < 2; ++bj) { *(f32x4*)(o + bj * 128) = acc[ai][bj][m][0]; *(f32x4*)(o + bj * 128 + 4) = acc[ai][bj][m][1]; }
          }
        } else if (u.pn == 9 && prompt && t >= 8064) {
          const int c = wc * 32 + 8 * fq;
          float* o = out + O_PV + ((size_t)((l * 2 + b) * 128 + (t - 8064)) * 2 + (c >> 6)) * 64 + (c & 63);
          *(f32x4*)o = acc[ai][1][m][0]; *(f32x4*)(o + 4) = acc[ai][1][m][1];
        }
      }
  }
};
struct EpiStoreBf16 {
  static constexpr bool PERM = true, AFTER_DRAIN = false;
  u16* O; int ldc;
  __device__ __forceinline__ void operator()(const f32x4 (&acc)[2][2][4][2], const pg8::Unit& u, int wr, int wc, int fr, int fq) const {
    const int row0 = u.pm * 256 + wr * 64 + fr, col0 = u.pn * 256 + wc * 32 + 8 * fq;
#pragma unroll
    for (int ai = 0; ai < 2; ++ai)
#pragma unroll
      for (int m = 0; m < 4; ++m) {
        u16* rowp = O + (size_t)(row0 + ai * 128 + m * 16) * ldc + col0;
#pragma unroll
        for (int bj = 0; bj < 2; ++bj) {
          const f32x4 v0 = acc[ai][bj][m][0], v1 = acc[ai][bj][m][1];
          pg8::u32x4 w; w.x = pg8::cvt_pk_bf16(v0[0], v0[1]); w.y = pg8::cvt_pk_bf16(v0[2], v0[3]); w.z = pg8::cvt_pk_bf16(v1[0], v1[1]); w.w = pg8::cvt_pk_bf16(v1[2], v1[3]);
          *(pg8::u32x4*)(rowp + bj * 128) = w;
        }
      }
  }
};
struct EpiFfnIn {
  static constexpr bool PERM = true, AFTER_DRAIN = false;
  u16* cu;
  __device__ __forceinline__ void operator()(const f32x4 (&acc)[2][2][4][2], const pg8::Unit& u, int wr, int wc, int fr, int fq) const {
    const int row0 = u.pm * 256 + wr * 64 + fr, col0 = u.pn * 128 + wc * 32 + 8 * fq;
#pragma unroll
    for (int ai = 0; ai < 2; ++ai)
#pragma unroll
      for (int m = 0; m < 4; ++m) {
        u16* rowp = cu + (size_t)(row0 + ai * 128 + m * 16) * 5632 + col0;
#pragma unroll
        for (int bj = 0; bj < 2; ++bj) {
          const f32x4 v0 = acc[ai][bj][m][0], v1 = acc[ai][bj][m][1];
          pg8::u32x4 w; w.x = pg8::cvt_pk_bf16(v0[0], v0[1]); w.y = pg8::cvt_pk_bf16(v0[2], v0[3]); w.z = pg8::cvt_pk_bf16(v1[0], v1[1]); w.w = pg8::cvt_pk_bf16(v1[2], v1[3]);
          *(pg8::u32x4*)(rowp + bj * 2816) = w;
        }
      }
  }
};
struct EpiMerge {
  static constexpr bool PERM = true, AFTER_DRAIN = false;
  const u16* t1; const u16* t2; u16* mg;
  __device__ __forceinline__ void operator()(const f32x4 (&acc)[2][2][4][2], const pg8::Unit& u, int wr, int wc, int fr, int fq) const {
    const int row0 = u.pm * 256 + wr * 64 + fr, col0 = u.pn * 128 + wc * 32 + 8 * fq;
#pragma unroll
    for (int ai = 0; ai < 2; ++ai)
#pragma unroll
      for (int m = 0; m < 4; ++m) {
        const size_t off = (size_t)(row0 + ai * 128 + m * 16) * 1024 + col0;
        float a[8], b[8], o[8];
        unpack8(*(const uint4*)(t1 + off), a);
        unpack8(*(const uint4*)(t2 + off), b);
#pragma unroll
        for (int n = 0; n < 2; ++n)
#pragma unroll
          for (int j = 0; j < 4; ++j)
            o[n * 4 + j] = sigm(acc[ai][0][m][n][j]) * a[n * 4 + j] + sigm(acc[ai][1][m][n][j]) * b[n * 4 + j];
        *(uint4*)(mg + off) = pack8(o);
        asm volatile("" ::: "memory");
      }
  }
};
struct EpiResid {
  static constexpr bool PERM = false, AFTER_DRAIN = false;
  float* X; bool dry;
  __device__ __forceinline__ void operator()(const f32x4 (&acc)[2][2][4][2], const pg8::Unit& u, int wr, int wc, int fr, int fq) const {
    const int row0 = u.pm * 256 + wr * 64 + fr, col0 = u.pn * 256 + wc * 32 + 4 * fq;
#pragma unroll
    for (int ai = 0; ai < 2; ++ai)
#pragma unroll
      for (int m = 0; m < 4; ++m) {
        float* rowp = X + (size_t)(row0 + ai * 128 + m * 16) * 1024 + col0;
#pragma unroll
        for (int bj = 0; bj < 2; ++bj)
#pragma unroll
          for (int n = 0; n < 2; ++n) { f32x4* q = (f32x4*)(rowp + bj * 128 + n * 16); const f32x4 v_ = *q + acc[ai][bj][m][n]; if (!dry) *q = v_; }
        asm volatile("" ::: "memory");
      }
  }
};
template <class Epi>
__device__ __forceinline__ void run_gemm(unsigned char* lds_raw, const u16* A, int lda, const u16* Bt, int N, int K, const Epi& E) {
  pg8::Gemm g; g.A = A; g.Bt = Bt; g.M = M_TOT; g.N = N; g.K = K; g.lda = lda;
  pg8::StaticOrder S; S.init(M_TOT, N, gridDim.x, blockIdx.x);
  __syncthreads();
  pg8::gemm_phase<Epi, pg8::StaticOrder, false>((PG8_LAS unsigned char*)lds_raw, g, S, E, nullptr);
  __syncthreads();
}

__device__ __forceinline__ void rope_item(const Params& p, int l, int item, bool dry = false) {
  const int tid = opq(threadIdx.x);
  u16* z = (u16*)(p.ws + WS_Z);
  const int row = item * 64 + (tid >> 3);
  const int d0 = (tid & 7) * 4;
  const bool prompt = row < M_P;
  int b, t, pos;
  if (prompt) { b = row >> 13; t = row & 8191; pos = t; } else { b = (row - M_P) >> 2; t = (row - M_P) & 3; pos = 16384 + t; }
  float cs[4], sn[4];
#pragma unroll
  for (int i = 0; i < 4; ++i) {
    const float inv = __expf(-(float)(d0 + i) * (9.210340371976184f / 32.f));
    const float angf = (float)pos * inv;
    double a = (double)angf;
    a -= 6.283185307179586 * rint(a * 0.15915494309189535);
    const float af = (float)a;
    sn[i] = __sinf(af); cs[i] = __cosf(af);
  }
#pragma unroll 2
  for (int hh = 0; hh < 10; ++hh) {
    u16* q = z + (size_t)row * ZLD + 1792 + hh * 64 + d0;
    const uint2 lo = *(const uint2*)q, hi = *(const uint2*)(q + 32);
    float x1[4] = {__uint_as_float(lo.x << 16), __uint_as_float(lo.x & 0xFFFF0000u), __uint_as_float(lo.y << 16), __uint_as_float(lo.y & 0xFFFF0000u)};
    float x2[4] = {__uint_as_float(hi.x << 16), __uint_as_float(hi.x & 0xFFFF0000u), __uint_as_float(hi.y << 16), __uint_as_float(hi.y & 0xFFFF0000u)};
    float y1[4], y2[4];
#pragma unroll
    for (int i = 0; i < 4; ++i) { y1[i] = x1[i] * cs[i] - x2[i] * sn[i]; y2[i] = x2[i] * cs[i] + x1[i] * sn[i]; }
    uint2 o1, o2;
    o1.x = pack2(y1[0], y1[1]); o1.y = pack2(y1[2], y1[3]); o2.x = pack2(y2[0], y2[1]); o2.y = pack2(y2[2], y2[3]);
    if (!dry) { *(uint2*)q = o1; *(uint2*)(q + 32) = o2; }
    if (hh >= 8 && prompt && t >= 8064) {
      float* o = p.out + O_PK + ((size_t)((l * 2 + b) * 128 + (t - 8064)) * 2 + (hh - 8)) * 64 + d0;
      *(float4*)o = make_float4(y1[0], y1[1], y1[2], y1[3]);
      *(float4*)(o + 32) = make_float4(y2[0], y2[1], y2[2], y2[3]);
    }
  }
}

#define SL(i) (ldsf + (i) * 4160)
__device__ __forceinline__ void rwkv_item(const Params& p, int l, int item, float* ldsf, bool dry = false) {
  const int tid = opq(threadIdx.x), lane = tid & 63, wave = tid >> 6;
  const bool sample = item >= 2048;
  int h, cidx, rowbase;
  if (!sample) { h = item & 7; cidx = item >> 3; rowbase = cidx * 64; }
  else { int s = item - 2048; h = s & 7; cidx = s >> 3; rowbase = M_P + cidx * 64; }
  const int cc = cidx & 127;
  const u16* z = (const u16*)(p.ws + WS_Z);
  u16* zw_ = (u16*)(p.ws + WS_Z);
  const float* mu = p.in[9] + l * 1792;
  float* wbuf = SL(7);
  float* gc = ldsf + 9 * 4160;
  float* bd = ldsf + 9 * 4160 + 64;
  __syncthreads();
  {
    const int t = tid >> 3, c8 = (tid & 7) * 8;
    const int m = rowbase + t;
    const int zcs[7] = {h * 64, 512 + h * 64, 1024 + h * 64, 1536, 1600, 1664, 1728};
#pragma unroll
    for (int gi = 0; gi < 7; ++gi) {
      const int zc = zcs[gi] + c8;
      float cur[8], prv[8];
      unpack8(*(const uint4*)(z + (size_t)m * ZLD + zc), cur);
      bool zero = false, fromstate = false;
      if (!sample) zero = (t == 0 && cc == 0);
      else fromstate = ((t & 3) == 0);
      if (zero) {
#pragma unroll
        for (int i = 0; i < 8; ++i) prv[i] = 0.f;
      } else if (fromstate) {
        const int b = (m - M_P) >> 2;
        const float* sp = p.in[2] + (size_t)(l * 128 + b) * 1792 + zc;
        float4 a = *(const float4*)sp, bb = *(const float4*)(sp + 4);
        prv[0] = a.x; prv[1] = a.y; prv[2] = a.z; prv[3] = a.w; prv[4] = bb.x; prv[5] = bb.y; prv[6] = bb.z; prv[7] = bb.w;
      } else {
        unpack8(*(const uint4*)(z + (size_t)(m - 1) * ZLD + zc), prv);
      }
      float* d = SL(gi) + t * 65 + c8;
#pragma unroll
      for (int i = 0; i < 8; ++i) {
        float v = cur[i] + mu[zc + i] * (prv[i] - cur[i]);
        if (gi == 3) v = tanhf(v);
        if (gi >= 5) v = sigm(v);
        d[i] = v;
      }
    }
  }
  const int lt = tid & 63, jg = tid >> 6;
  auto load_w = [&](const float* W, int nrows) {
    for (int e = tid; e < nrows * 8; e += NT) {
      const int i = e >> 3, c = (e & 7) * 8;
      const float* s = W + (size_t)i * 512 + h * 64 + c;
      *(float4*)(wbuf + i * 64 + c) = *(const float4*)s;
      *(float4*)(wbuf + i * 64 + c + 4) = *(const float4*)(s + 4);
    }
  };
  auto lora = [&](const float* xa, const float* xb, int n, float* acc) {
#pragma unroll 2
    for (int i = 0; i < n; ++i) {
      const float x = (i < 64) ? xa[lt * 65 + i] : xb[lt * 65 + i - 64];
      const float4 w0 = *(const float4*)(wbuf + i * 64 + jg * 8);
      const float4 w1 = *(const float4*)(wbuf + i * 64 + jg * 8 + 4);
      acc[0] += x * w0.x; acc[1] += x * w0.y; acc[2] += x * w0.z; acc[3] += x * w0.w;
      acc[4] += x * w1.x; acc[5] += x * w1.y; acc[6] += x * w1.z; acc[7] += x * w1.w;
    }
  };
  float res[8];
  load_w(p.in[11] + (size_t)l * 64 * 512, 64);
  __syncthreads();
#pragma unroll
  for (int i = 0; i < 8; ++i) res[i] = p.in[10][l * 512 + h * 64 + jg * 8 + i];
  lora(SL(3), SL(3), 64, res);
  __syncthreads();
#pragma unroll
  for (int i = 0; i < 8; ++i) {
    const float x = -res[i];
    const float sp = (x > 20.f) ? x : log1pf(__expf(x));
    SL(3)[lt * 65 + jg * 8 + i] = -__expf(-sp - 0.5f);
  }
  load_w(p.in[13] + (size_t)l * 64 * 512, 64);
  __syncthreads();
#pragma unroll
  for (int i = 0; i < 8; ++i) res[i] = p.in[12][l * 512 + h * 64 + jg * 8 + i];
  lora(SL(4), SL(4), 64, res);
  __syncthreads();
#pragma unroll
  for (int i = 0; i < 8; ++i) SL(4)[lt * 65 + jg * 8 + i] = sigm(res[i]);
  load_w(p.in[14] + (size_t)l * 128 * 512, 128);
  __syncthreads();
#pragma unroll
  for (int i = 0; i < 8; ++i) res[i] = 0.f;
  lora(SL(5), SL(6), 128, res);
  __syncthreads();
  if (!sample) {
    u16* ga = (u16*)(p.ws + WS_GA) + (size_t)item * 4096;
    *(uint4*)(ga + lt * 64 + jg * 8) = pack8(res);
    if (tid < 64) {
      float c = 0.f;
      for (int t = 0; t < 64; ++t) { c += SL(3)[t * 65 + tid]; SL(5)[t * 65 + tid] = c; }
      gc[tid] = __expf(c);
    }
  } else {
#pragma unroll
    for (int i = 0; i < 8; ++i) SL(6)[lt * 65 + jg * 8 + i] = res[i];
  }
  __syncthreads();
  {
    const int t = tid >> 3, j0 = (tid & 7) * 8;
    const float* kkw = p.in[15] + l * 512 + h * 64;
    const float* kaw = p.in[16] + l * 512 + h * 64;
    const float* rkw = p.in[17] + l * 512 + h * 64;
    float kr[8], av[8], rv[8], kkv[8], kf[8];
    float nrm = 0.f, bdot = 0.f;
#pragma unroll
    for (int i = 0; i < 8; ++i) {
      const int j = j0 + i;
      kr[i] = SL(1)[t * 65 + j]; av[i] = SL(4)[t * 65 + j]; rv[i] = SL(0)[t * 65 + j];
      kkv[i] = kr[i] * kkw[j];
      nrm += kkv[i] * kkv[i];
      kf[i] = kr[i] * (1.f + (av[i] - 1.f) * kaw[j]);
      bdot += rv[i] * kf[i] * rkw[j];
    }
    nrm += __shfl_xor(nrm, 1, 64); nrm += __shfl_xor(nrm, 2, 64); nrm += __shfl_xor(nrm, 4, 64);
    bdot += __shfl_xor(bdot, 1, 64); bdot += __shfl_xor(bdot, 2, 64); bdot += __shfl_xor(bdot, 4, 64);
    const float rn = 1.f / fmaxf(sqrtf(nrm), 1e-12f);
    if (!sample) {
      float bo[8];
#pragma unroll
      for (int i = 0; i < 8; ++i) {
        const int j = j0 + i;
        const float cum = SL(5)[t * 65 + j], dl = SL(3)[t * 65 + j];
        const float eg = __expf(cum), egi = __expf(-cum), egp = __expf(cum - dl);
        const float kk = kkv[i] * rn;
        SL(0)[t * 65 + j] = rv[i] * eg;
        SL(1)[t * 65 + j] = kf[i] * egi;
        SL(3)[t * 65 + j] = kk * av[i] * egi;
        SL(4)[t * 65 + j] = kk * egp;
        bo[i] = bdot * SL(2)[t * 65 + j];
      }
      u16* bop = (u16*)(p.ws + WS_BO) + (size_t)item * 4096;
      *(uint4*)(bop + t * 64 + j0) = pack8(bo);
    } else {
#pragma unroll
      for (int i = 0; i < 8; ++i) {
        const int j = j0 + i;
        const float kk = kkv[i] * rn;
        const float dl = SL(3)[t * 65 + j];
        SL(1)[t * 65 + j] = kf[i];
        SL(3)[t * 65 + j] = __expf(dl);
        SL(4)[t * 65 + j] = kk;
        SL(5)[t * 65 + j] = kk * av[i];
      }
      if ((tid & 7) == 0) bd[t] = bdot;
    }
  }
  __syncthreads();
  if (sample) {
    const float lng = p.in[18][l * 512 + h * 64 + lane], lnb = p.in[19][l * 512 + h * 64 + lane];
    for (int round = 0; round < 2; ++round) {
      const int seq = wave + 8 * round;
      const int b = cidx * 16 + seq;
      float S[64];
      const float* sp = p.in[3] + ((size_t)((l * 128 + b) * 8 + h) * 64 + lane) * 64;
#pragma unroll
      for (int k = 0; k < 64; k += 4) { float4 v = *(const float4*)(sp + k); S[k] = v.x; S[k + 1] = v.y; S[k + 2] = v.z; S[k + 3] = v.w; }
      for (int tt = 0; tt < 4; ++tt) {
        const int t = seq * 4 + tt;
        float sk = 0.f;
#pragma unroll
        for (int kc = 0; kc < 64; kc += 8) {
#pragma unroll
          for (int k = kc; k < kc + 8; ++k) sk += S[k] * SL(4)[t * 65 + k];
          __builtin_amdgcn_sched_barrier(0);
        }
        const float vt = SL(2)[t * 65 + lane];
        float y = 0.f;
#pragma unroll
        for (int kc = 0; kc < 64; kc += 8) {
#pragma unroll
          for (int k = kc; k < kc + 8; ++k) {
            S[k] = S[k] * SL(3)[t * 65 + k] - sk * SL(5)[t * 65 + k] + vt * SL(1)[t * 65 + k];
            y += S[k] * SL(0)[t * 65 + k];
          }
          __builtin_amdgcn_sched_barrier(0);
        }
        const float mean = wave_sum(y) * (1.f / 64.f);
        const float d = y - mean;
        const float var = wave_sum(d * d) * (1.f / 64.f);
        const float yn = d * rsqrtf(var + 64e-5f) * lng + lnb;
        const float o = (yn + bd[t] * vt) * SL(6)[t * 65 + lane];
        if (!dry) zw_[(size_t)(M_P + b * 4 + tt) * ZLD + h * 64 + lane] = f2bf(o);
      }
      float* op = p.out + O_SWKV + ((size_t)((l * 128 + b) * 8 + h) * 64 + lane) * 64;
#pragma unroll
      for (int k = 0; k < 64; k += 4) *(float4*)(op + k) = make_float4(S[k], S[k + 1], S[k + 2], S[k + 3]);
    }
    return;
  }
  {
    const int i = lane, tg = wave;
    float ab[8], ak[8], akr[8], abr[8];
#pragma unroll
    for (int q = 0; q < 8; ++q) { ab[q] = 0.f; ak[q] = 0.f; akr[q] = 0.f; abr[q] = 0.f; }
#pragma unroll 2
    for (int k = 0; k < 64; ++k) {
      const float xb = SL(3)[i * 65 + k], xk = SL(1)[i * 65 + k];
#pragma unroll
      for (int q = 0; q < 8; ++q) {
        const int t = tg * 8 + q;
        const float yk = SL(4)[t * 65 + k], yr = SL(0)[t * 65 + k];
        ab[q] += xb * yk; ak[q] += xk * yk; akr[q] += xk * yr; abr[q] += xb * yr;
      }
    }
    __syncthreads();
#pragma unroll
    for (int q = 0; q < 8; ++q) {
      const int t = tg * 8 + q;
      SL(6)[i * 65 + t] = (i < t) ? ab[q] : 0.f;
      SL(7)[i * 65 + t] = (i < t) ? ak[q] : 0.f;
      SL(8)[i * 65 + t] = (i <= t) ? akr[q] : 0.f;
      SL(5)[i * 65 + t] = (i <= t) ? abr[q] : 0.f;
    }
  }
  __syncthreads();
  {
    const int t = tid >> 3, j0 = (tid & 7) * 8;
#pragma unroll
    for (int i = 0; i < 8; ++i) { const float g = gc[j0 + i]; SL(3)[t * 65 + j0 + i] *= g; SL(1)[t * 65 + j0 + i] *= g; }
  }
  __syncthreads();
  if (tid < 128) {
    float* X_ = (tid < 64) ? SL(5) : SL(3);
    const int col = tid & 63;
    for (int i = 62; i >= 0; --i) {
      float a = X_[i * 65 + col];
#pragma unroll 4
      for (int t = i + 1; t < 64; ++t) a -= SL(6)[i * 65 + t] * X_[t * 65 + col];
      X_[i * 65 + col] = a;
    }
  }
  __syncthreads();
  {
    const int c = tid & 127, ig = tid >> 7;
    const int which = c >> 6, cq = c & 63;
    const float* N_ = which ? SL(3) : SL(5);
    float a[16];
#pragma unroll
    for (int q = 0; q < 16; ++q) a[q] = 0.f;
#pragma unroll 2
    for (int t = 0; t < 64; ++t) {
      const float n = N_[t * 65 + cq];
#pragma unroll
      for (int q = 0; q < 16; ++q) a[q] += SL(7)[(ig * 16 + q) * 65 + t] * n;
    }
    float* T_ = which ? SL(1) : SL(8);
#pragma unroll
    for (int q = 0; q < 16; ++q) T_[(ig * 16 + q) * 65 + cq] -= a[q];
  }
  __syncthreads();
  {
    const int x = lane, yg = wave;
    float w2[8], pp[8], yl[8], qq[8];
#pragma unroll
    for (int q = 0; q < 8; ++q) { w2[q] = 0.f; pp[q] = 0.f; yl[q] = 0.f; qq[q] = 0.f; }
#pragma unroll 2
    for (int j = 0; j < 64; ++j) {
      const float l5 = SL(5)[j * 65 + x], l4 = SL(4)[j * 65 + x], l8 = SL(8)[j * 65 + x], l2 = SL(2)[j * 65 + x];
#pragma unroll
      for (int q = 0; q < 8; ++q) {
        const int y = yg * 8 + q;
        w2[q] += l5 * SL(4)[j * 65 + y];
        pp[q] += l4 * SL(3)[j * 65 + y];
        yl[q] += l8 * SL(2)[j * 65 + y];
        qq[q] += l2 * SL(1)[j * 65 + y];
      }
    }
    float o1[8];
#pragma unroll
    for (int q = 0; q < 8; ++q) {
      const int y = yg * 8 + q;
      o1[q] = SL(0)[x * 65 + y] - w2[q];
    }
    u16* Pf = (u16*)(p.ws + WS_PP) + (size_t)item * 4096;
    float* Qf = (float*)(p.ws + WS_Q) + (size_t)item * 4096;
    if (tid < 64) ((float*)(p.ws + WS_GC))[(size_t)item * 64 + tid] = gc[tid];
    {
      const int s_ = x >> 4, kk = x & 15, hh = (kk >> 2) & 1, jj = ((kk >> 3) << 2) | (kk & 3);
#pragma unroll
      for (int q = 0; q < 8; ++q) {
        const int y = yg * 8 + q;
        Pf[(((y >> 5) * 4 + s_) * 64 + (y & 31) + 32 * hh) * 8 + jj] = f2bf(-pp[q]);
        const int k2 = y & 31, reg = ((k2 >> 3) << 2) | (k2 & 3), h2 = (k2 >> 2) & 1;
        Qf[(((x >> 5) * 2 + (y >> 5)) * 16 + reg) * 64 + (x & 31) + 32 * h2] = qq[q];
      }
    }
    u16* W2p = (u16*)(p.ws + WS_W2) + (size_t)item * 4096 + x * 64 + yg * 8;
    u16* YLp = (u16*)(p.ws + WS_YL) + (size_t)item * 4096 + x * 64 + yg * 8;
    *(uint4*)W2p = pack8(o1);
    *(uint4*)YLp = pack8(yl);
  }
}

__device__ __forceinline__ void mm_tile(const u16* Aop, int lda, const u16* Bop, int ldb, int mt, int nt, int r, int h, int ksteps, f32x16& acc) {
  const u16* ap = Aop + (mt * 32 + r) * lda + h * 8;
  const u16* bp = Bop + (nt * 32 + r) * ldb + h * 8;
#pragma unroll 4
  for (int s = 0; s < ksteps; ++s) {
    const bf16x8 a = *(const bf16x8*)(ap + s * 16);
    const bf16x8 b = *(const bf16x8*)(bp + s * 16);
    acc = __builtin_amdgcn_mfma_f32_32x32x16_bf16(a, b, acc, 0, 0, 0);
  }
}
__device__ __forceinline__ void store_T(u16* T, int ldt, int mt, int nt, int r, int h, const f32x16& acc) {
#pragma unroll
  for (int g = 0; g < 4; ++g) {
    uint2 o; o.x = pack2(acc[4 * g], acc[4 * g + 1]); o.y = pack2(acc[4 * g + 2], acc[4 * g + 3]);
    *(uint2*)(T + (nt * 32 + r) * ldt + mt * 32 + 8 * g + 4 * h) = o;
  }
}
__device__ __forceinline__ void tri32(const float* Ab, float* Xc) {
  float a31 = Xc[2015];
  const float x31 = a31;
  float a30 = Xc[1950];
    { const float4 c_ = *(const float4*)(Ab + 2068);
      a30 -= c_.w * x31;
    }
  const float x30 = a30;
  float a29 = Xc[1885];
    { const float4 c_ = *(const float4*)(Ab + 2000);
      a29 -= c_.z * x30;
      a29 -= c_.w * x31;
    }
  const float x29 = a29;
  float a28 = Xc[1820];
    { const float4 c_ = *(const float4*)(Ab + 1932);
      a28 -= c_.y * x29;
      a28 -= c_.z * x30;
      a28 -= c_.w * x31;
    }
  const float x28 = a28;
  float a27 = Xc[1755];
    { const float4 c_ = *(const float4*)(Ab + 1864);
      a27 -= c_.x * x28;
      a27 -= c_.y * x29;
      a27 -= c_.z * x30;
      a27 -= c_.w * x31;
    }
  const float x27 = a27;
  float a26 = Xc[1690];
    { const float4 c_ = *(const float4*)(Ab + 1792);
      a26 -= c_.w * x27;
    }
    { const float4 c_ = *(const float4*)(Ab + 1796);
      a26 -= c_.x * x28;
      a26 -= c_.y * x29;
      a26 -= c_.z * x30;
      a26 -= c_.w * x31;
    }
  const float x26 = a26;
  float a25 = Xc[1625];
    { const float4 c_ = *(const float4*)(Ab + 1724);
      a25 -= c_.z * x26;
      a25 -= c_.w * x27;
    }
    { const float4 c_ = *(const float4*)(Ab + 1728);
      a25 -= c_.x * x28;
      a25 -= c_.y * x29;
      a25 -= c_.z * x30;
      a25 -= c_.w * x31;
    }
  const float x25 = a25;
  float a24 = Xc[1560];
    { const float4 c_ = *(const float4*)(Ab + 1656);
      a24 -= c_.y * x25;
      a24 -= c_.z * x26;
      a24 -= c_.w * x27;
    }
    { const float4 c_ = *(const float4*)(Ab + 1660);
      a24 -= c_.x * x28;
      a24 -= c_.y * x29;
      a24 -= c_.z * x30;
      a24 -= c_.w * x31;
    }
  const float x24 = a24;
  float a23 = Xc[1495];
    { const float4 c_ = *(const float4*)(Ab + 1588);
      a23 -= c_.x * x24;
      a23 -= c_.y * x25;
      a23 -= c_.z * x26;
      a23 -= c_.w * x27;
    }
    { const float4 c_ = *(const float4*)(Ab + 1592);
      a23 -= c_.x * x28;
      a23 -= c_.y * x29;
      a23 -= c_.z * x30;
      a23 -= c_.w * x31;
    }
  const float x23 = a23;
  float a22 = Xc[1430];
    { const float4 c_ = *(const float4*)(Ab + 1516);
      a22 -= c_.w * x23;
    }
    { const float4 c_ = *(const float4*)(Ab + 1520);
      a22 -= c_.x * x24;
      a22 -= c_.y * x25;
      a22 -= c_.z * x26;
      a22 -= c_.w * x27;
    }
    { const float4 c_ = *(const float4*)(Ab + 1524);
      a22 -= c_.x * x28;
      a22 -= c_.y * x29;
      a22 -= c_.z * x30;
      a22 -= c_.w * x31;
    }
  const float x22 = a22;
  float a21 = Xc[1365];
    { const float4 c_ = *(const float4*)(Ab + 1448);
      a21 -= c_.z * x22;
      a21 -= c_.w * x23;
    }
    { const float4 c_ = *(const float4*)(Ab + 1452);
      a21 -= c_.x * x24;
      a21 -= c_.y * x25;
      a21 -= c_.z * x26;
      a21 -= c_.w * x27;
    }
    { const float4 c_ = *(const float4*)(Ab + 1456);
      a21 -= c_.x * x28;
      a21 -= c_.y * x29;
      a21 -= c_.z * x30;
      a21 -= c_.w * x31;
    }
  const float x21 = a21;
  float a20 = Xc[1300];
    { const float4 c_ = *(const float4*)(Ab + 1380);
      a20 -= c_.y * x21;
      a20 -= c_.z * x22;
      a20 -= c_.w * x23;
    }
    { const float4 c_ = *(const float4*)(Ab + 1384);
      a20 -= c_.x * x24;
      a20 -= c_.y * x25;
      a20 -= c_.z * x26;
      a20 -= c_.w * x27;
    }
    { const float4 c_ = *(const float4*)(Ab + 1388);
      a20 -= c_.x * x28;
      a20 -= c_.y * x29;
      a20 -= c_.z * x30;
      a20 -= c_.w * x31;
    }
  const float x20 = a20;
  float a19 = Xc[1235];
    { const float4 c_ = *(const float4*)(Ab + 1312);
      a19 -= c_.x * x20;
      a19 -= c_.y * x21;
      a19 -= c_.z * x22;
      a19 -= c_.w * x23;
    }
    { const float4 c_ = *(const float4*)(Ab + 1316);
      a19 -= c_.x * x24;
      a19 -= c_.y * x25;
      a19 -= c_.z * x26;
      a19 -= c_.w * x27;
    }
    { const float4 c_ = *(const float4*)(Ab + 1320);
      a19 -= c_.x * x28;
      a19 -= c_.y * x29;
      a19 -= c_.z * x30;
      a19 -= c_.w * x31;
    }
  const float x19 = a19;
  float a18 = Xc[1170];
    { const float4 c_ = *(const float4*)(Ab + 1240);
      a18 -= c_.w * x19;
    }
    { const float4 c_ = *(const float4*)(Ab + 1244);
      a18 -= c_.x * x20;
      a18 -= c_.y * x21;
      a18 -= c_.z * x22;
      a18 -= c_.w * x23;
    }
    { const float4 c_ = *(const float4*)(Ab + 1248);
      a18 -= c_.x * x24;
      a18 -= c_.y * x25;
      a18 -= c_.z * x26;
      a18 -= c_.w * x27;
    }
    { const float4 c_ = *(const float4*)(Ab + 1252);
      a18 -= c_.x * x28;
      a18 -= c_.y * x29;
      a18 -= c_.z * x30;
      a18 -= c_.w * x31;
    }
  const float x18 = a18;
  float a17 = Xc[1105];
    { const float4 c_ = *(const float4*)(Ab + 1172);
      a17 -= c_.z * x18;
      a17 -= c_.w * x19;
    }
    { const float4 c_ = *(const float4*)(Ab + 1176);
      a17 -= c_.x * x20;
      a17 -= c_.y * x21;
      a17 -= c_.z * x22;
      a17 -= c_.w * x23;
    }
    { const float4 c_ = *(const float4*)(Ab + 1180);
      a17 -= c_.x * x24;
      a17 -= c_.y * x25;
      a17 -= c_.z * x26;
      a17 -= c_.w * x27;
    }
    { const float4 c_ = *(const float4*)(Ab + 1184);
      a17 -= c_.x * x28;
      a17 -= c_.y * x29;
      a17 -= c_.z * x30;
      a17 -= c_.w * x31;
    }
  const float x17 = a17;
  float a16 = Xc[1040];
    { const float4 c_ = *(const float4*)(Ab + 1104);
      a16 -= c_.y * x17;
      a16 -= c_.z * x18;
      a16 -= c_.w * x19;
    }
    { const float4 c_ = *(const float4*)(Ab + 1108);
      a16 -= c_.x * x20;
      a16 -= c_.y * x21;
      a16 -= c_.z * x22;
      a16 -= c_.w * x23;
    }
    { const float4 c_ = *(const float4*)(Ab + 1112);
      a16 -= c_.x * x24;
      a16 -= c_.y * x25;
      a16 -= c_.z * x26;
      a16 -= c_.w * x27;
    }
    { const float4 c_ = *(const float4*)(Ab + 1116);
      a16 -= c_.x * x28;
      a16 -= c_.y * x29;
      a16 -= c_.z * x30;
      a16 -= c_.w * x31;
    }
  const float x16 = a16;
  float a15 = Xc[975];
    { const float4 c_ = *(const float4*)(Ab + 1036);
      a15 -= c_.x * x16;
      a15 -= c_.y * x17;
      a15 -= c_.z * x18;
      a15 -= c_.w * x19;
    }
    { const float4 c_ = *(const float4*)(Ab + 1040);
      a15 -= c_.x * x20;
      a15 -= c_.y * x21;
      a15 -= c_.z * x22;
      a15 -= c_.w * x23;
    }
    { const float4 c_ = *(const float4*)(Ab + 1044);
      a15 -= c_.x * x24;
      a15 -= c_.y * x25;
      a15 -= c_.z * x26;
      a15 -= c_.w * x27;
    }
    { const float4 c_ = *(const float4*)(Ab + 1048);
      a15 -= c_.x * x28;
      a15 -= c_.y * x29;
      a15 -= c_.z * x30;
      a15 -= c_.w * x31;
    }
  const float x15 = a15;
  float a14 = Xc[910];
    { const float4 c_ = *(const float4*)(Ab + 964);
      a14 -= c_.w * x15;
    }
    { const float4 c_ = *(const float4*)(Ab + 968);
      a14 -= c_.x * x16;
      a14 -= c_.y * x17;
      a14 -= c_.z * x18;
      a14 -= c_.w * x19;
    }
    { const float4 c_ = *(const float4*)(Ab + 972);
      a14 -= c_.x * x20;
      a14 -= c_.y * x21;
      a14 -= c_.z * x22;
      a14 -= c_.w * x23;
    }
    { const float4 c_ = *(const float4*)(Ab + 976);
      a14 -= c_.x * x24;
      a14 -= c_.y * x25;
      a14 -= c_.z * x26;
      a14 -= c_.w * x27;
    }
    { const float4 c_ = *(const float4*)(Ab + 980);
      a14 -= c_.x * x28;
      a14 -= c_.y * x29;
      a14 -= c_.z * x30;
      a14 -= c_.w * x31;
    }
  const float x14 = a14;
  float a13 = Xc[845];
    { const float4 c_ = *(const float4*)(Ab + 896);
      a13 -= c_.z * x14;
      a13 -= c_.w * x15;
    }
    { const float4 c_ = *(const float4*)(Ab + 900);
      a13 -= c_.x * x16;
      a13 -= c_.y * x17;
      a13 -= c_.z * x18;
      a13 -= c_.w * x19;
    }
    { const float4 c_ = *(const float4*)(Ab + 904);
      a13 -= c_.x * x20;
      a13 -= c_.y * x21;
      a13 -= c_.z * x22;
      a13 -= c_.w * x23;
    }
    { const float4 c_ = *(const float4*)(Ab + 908);
      a13 -= c_.x * x24;
      a13 -= c_.y * x25;
      a13 -= c_.z * x26;
      a13 -= c_.w * x27;
    }
    { const float4 c_ = *(const float4*)(Ab + 912);
      a13 -= c_.x * x28;
      a13 -= c_.y * x29;
      a13 -= c_.z * x30;
      a13 -= c_.w * x31;
    }
  const float x13 = a13;
  float a12 = Xc[780];
    { const float4 c_ = *(const float4*)(Ab + 828);
      a12 -= c_.y * x13;
      a12 -= c_.z * x14;
      a12 -= c_.w * x15;
    }
    { const float4 c_ = *(const float4*)(Ab + 832);
      a12 -= c_.x * x16;
      a12 -= c_.y * x17;
      a12 -= c_.z * x18;
      a12 -= c_.w * x19;
    }
    { const float4 c_ = *(const float4*)(Ab + 836);
      a12 -= c_.x * x20;
      a12 -= c_.y * x21;
      a12 -= c_.z * x22;
      a12 -= c_.w * x23;
    }
    { const float4 c_ = *(const float4*)(Ab + 840);
      a12 -= c_.x * x24;
      a12 -= c_.y * x25;
      a12 -= c_.z * x26;
      a12 -= c_.w * x27;
    }
    { const float4 c_ = *(const float4*)(Ab + 844);
      a12 -= c_.x * x28;
      a12 -= c_.y * x29;
      a12 -= c_.z * x30;
      a12 -= c_.w * x31;
    }
  const float x12 = a12;
  float a11 = Xc[715];
    { const float4 c_ = *(const float4*)(Ab + 760);
      a11 -= c_.x * x12;
      a11 -= c_.y * x13;
      a11 -= c_.z * x14;
      a11 -= c_.w * x15;
    }
    { const float4 c_ = *(const float4*)(Ab + 764);
      a11 -= c_.x * x16;
      a11 -= c_.y * x17;
      a11 -= c_.z * x18;
      a11 -= c_.w * x19;
    }
    { const float4 c_ = *(const float4*)(Ab + 768);
      a11 -= c_.x * x20;
      a11 -= c_.y * x21;
      a11 -= c_.z * x22;
      a11 -= c_.w * x23;
    }
    { const float4 c_ = *(const float4*)(Ab + 772);
      a11 -= c_.x * x24;
      a11 -= c_.y * x25;
      a11 -= c_.z * x26;
      a11 -= c_.w * x27;
    }
    { const float4 c_ = *(const float4*)(Ab + 776);
      a11 -= c_.x * x28;
      a11 -= c_.y * x29;
      a11 -= c_.z * x30;
      a11 -= c_.w * x31;
    }
  const float x11 = a11;
  float a10 = Xc[650];
    { const float4 c_ = *(const float4*)(Ab + 688);
      a10 -= c_.w * x11;
    }
    { const float4 c_ = *(const float4*)(Ab + 692);
      a10 -= c_.x * x12;
      a10 -= c_.y * x13;
      a10 -= c_.z * x14;
      a10 -= c_.w * x15;
    }
    { const float4 c_ = *(const float4*)(Ab + 696);
      a10 -= c_.x * x16;
      a10 -= c_.y * x17;
      a10 -= c_.z * x18;
      a10 -= c_.w * x19;
    }
    { const float4 c_ = *(const float4*)(Ab + 700);
      a10 -= c_.x * x20;
      a10 -= c_.y * x21;
      a10 -= c_.z * x22;
      a10 -= c_.w * x23;
    }
    { const float4 c_ = *(const float4*)(Ab + 704);
      a10 -= c_.x * x24;
      a10 -= c_.y * x25;
      a10 -= c_.z * x26;
      a10 -= c_.w * x27;
    }
    { const float4 c_ = *(const float4*)(Ab + 708);
      a10 -= c_.x * x28;
      a10 -= c_.y * x29;
      a10 -= c_.z * x30;
      a10 -= c_.w * x31;
    }
  const float x10 = a10;
  float a9 = Xc[585];
    { const float4 c_ = *(const float4*)(Ab + 620);
      a9 -= c_.z * x10;
      a9 -= c_.w * x11;
    }
    { const float4 c_ = *(const float4*)(Ab + 624);
      a9 -= c_.x * x12;
      a9 -= c_.y * x13;
      a9 -= c_.z * x14;
      a9 -= c_.w * x15;
    }
    { const float4 c_ = *(const float4*)(Ab + 628);
      a9 -= c_.x * x16;
      a9 -= c_.y * x17;
      a9 -= c_.z * x18;
      a9 -= c_.w * x19;
    }
    { const float4 c_ = *(const float4*)(Ab + 632);
      a9 -= c_.x * x20;
      a9 -= c_.y * x21;
      a9 -= c_.z * x22;
      a9 -= c_.w * x23;
    }
    { const float4 c_ = *(const float4*)(Ab + 636);
      a9 -= c_.x * x24;
      a9 -= c_.y * x25;
      a9 -= c_.z * x26;
      a9 -= c_.w * x27;
    }
    { const float4 c_ = *(const float4*)(Ab + 640);
      a9 -= c_.x * x28;
      a9 -= c_.y * x29;
      a9 -= c_.z * x30;
      a9 -= c_.w * x31;
    }
  const float x9 = a9;
  float a8 = Xc[520];
    { const float4 c_ = *(const float4*)(Ab + 552);
      a8 -= c_.y * x9;
      a8 -= c_.z * x10;
      a8 -= c_.w * x11;
    }
    { const float4 c_ = *(const float4*)(Ab + 556);
      a8 -= c_.x * x12;
      a8 -= c_.y * x13;
      a8 -= c_.z * x14;
      a8 -= c_.w * x15;
    }
    { const float4 c_ = *(const float4*)(Ab + 560);
      a8 -= c_.x * x16;
      a8 -= c_.y * x17;
      a8 -= c_.z * x18;
      a8 -= c_.w * x19;
    }
    { const float4 c_ = *(const float4*)(Ab + 564);
      a8 -= c_.x * x20;
      a8 -= c_.y * x21;
      a8 -= c_.z * x22;
      a8 -= c_.w * x23;
    }
    { const float4 c_ = *(const float4*)(Ab + 568);
      a8 -= c_.x * x24;
      a8 -= c_.y * x25;
      a8 -= c_.z * x26;
      a8 -= c_.w * x27;
    }
    { const float4 c_ = *(const float4*)(Ab + 572);
      a8 -= c_.x * x28;
      a8 -= c_.y * x29;
      a8 -= c_.z * x30;
      a8 -= c_.w * x31;
    }
  const float x8 = a8;
  float a7 = Xc[455];
    { const float4 c_ = *(const float4*)(Ab + 484);
      a7 -= c_.x * x8;
      a7 -= c_.y * x9;
      a7 -= c_.z * x10;
      a7 -= c_.w * x11;
    }
    { const float4 c_ = *(const float4*)(Ab + 488);
      a7 -= c_.x * x12;
      a7 -= c_.y * x13;
      a7 -= c_.z * x14;
      a7 -= c_.w * x15;
    }
    { const float4 c_ = *(const float4*)(Ab + 492);
      a7 -= c_.x * x16;
      a7 -= c_.y * x17;
      a7 -= c_.z * x18;
      a7 -= c_.w * x19;
    }
    { const float4 c_ = *(const float4*)(Ab + 496);
      a7 -= c_.x * x20;
      a7 -= c_.y * x21;
      a7 -= c_.z * x22;
      a7 -= c_.w * x23;
    }
    { const float4 c_ = *(const float4*)(Ab + 500);
      a7 -= c_.x * x24;
      a7 -= c_.y * x25;
      a7 -= c_.z * x26;
      a7 -= c_.w * x27;
    }
    { const float4 c_ = *(const float4*)(Ab + 504);
      a7 -= c_.x * x28;
      a7 -= c_.y * x29;
      a7 -= c_.z * x30;
      a7 -= c_.w * x31;
    }
  const float x7 = a7;
  float a6 = Xc[390];
    { const float4 c_ = *(const float4*)(Ab + 412);
      a6 -= c_.w * x7;
    }
    { const float4 c_ = *(const float4*)(Ab + 416);
      a6 -= c_.x * x8;
      a6 -= c_.y * x9;
      a6 -= c_.z * x10;
      a6 -= c_.w * x11;
    }
    { const float4 c_ = *(const float4*)(Ab + 420);
      a6 -= c_.x * x12;
      a6 -= c_.y * x13;
      a6 -= c_.z * x14;
      a6 -= c_.w * x15;
    }
    { const float4 c_ = *(const float4*)(Ab + 424);
      a6 -= c_.x * x16;
      a6 -= c_.y * x17;
      a6 -= c_.z * x18;
      a6 -= c_.w * x19;
    }
    { const float4 c_ = *(const float4*)(Ab + 428);
      a6 -= c_.x * x20;
      a6 -= c_.y * x21;
      a6 -= c_.z * x22;
      a6 -= c_.w * x23;
    }
    { const float4 c_ = *(const float4*)(Ab + 432);
      a6 -= c_.x * x24;
      a6 -= c_.y * x25;
      a6 -= c_.z * x26;
      a6 -= c_.w * x27;
    }
    { const float4 c_ = *(const float4*)(Ab + 436);
      a6 -= c_.x * x28;
      a6 -= c_.y * x29;
      a6 -= c_.z * x30;
      a6 -= c_.w * x31;
    }
  const float x6 = a6;
  float a5 = Xc[325];
    { const float4 c_ = *(const float4*)(Ab + 344);
      a5 -= c_.z * x6;
      a5 -= c_.w * x7;
    }
    { const float4 c_ = *(const float4*)(Ab + 348);
      a5 -= c_.x * x8;
      a5 -= c_.y * x9;
      a5 -= c_.z * x10;
      a5 -= c_.w * x11;
    }
    { const float4 c_ = *(const float4*)(Ab + 352);
      a5 -= c_.x * x12;
      a5 -= c_.y * x13;
      a5 -= c_.z * x14;
      a5 -= c_.w * x15;
    }
    { const float4 c_ = *(const float4*)(Ab + 356);
      a5 -= c_.x * x16;
      a5 -= c_.y * x17;
      a5 -= c_.z * x18;
      a5 -= c_.w * x19;
    }
    { const float4 c_ = *(const float4*)(Ab + 360);
      a5 -= c_.x * x20;
      a5 -= c_.y * x21;
      a5 -= c_.z * x22;
      a5 -= c_.w * x23;
    }
    { const float4 c_ = *(const float4*)(Ab + 364);
      a5 -= c_.x * x24;
      a5 -= c_.y * x25;
      a5 -= c_.z * x26;
      a5 -= c_.w * x27;
    }
    { const float4 c_ = *(const float4*)(Ab + 368);
      a5 -= c_.x * x28;
      a5 -= c_.y * x29;
      a5 -= c_.z * x30;
      a5 -= c_.w * x31;
    }
  const float x5 = a5;
  float a4 = Xc[260];
    { const float4 c_ = *(const float4*)(Ab + 276);
      a4 -= c_.y * x5;
      a4 -= c_.z * x6;
      a4 -= c_.w * x7;
    }
    { const float4 c_ = *(const float4*)(Ab + 280);
      a4 -= c_.x * x8;
      a4 -= c_.y * x9;
      a4 -= c_.z * x10;
      a4 -= c_.w * x11;
    }
    { const float4 c_ = *(const float4*)(Ab + 284);
      a4 -= c_.x * x12;
      a4 -= c_.y * x13;
      a4 -= c_.z * x14;
      a4 -= c_.w * x15;
    }
    { const float4 c_ = *(const float4*)(Ab + 288);
      a4 -= c_.x * x16;
      a4 -= c_.y * x17;
      a4 -= c_.z * x18;
      a4 -= c_.w * x19;
    }
    { const float4 c_ = *(const float4*)(Ab + 292);
      a4 -= c_.x * x20;
      a4 -= c_.y * x21;
      a4 -= c_.z * x22;
      a4 -= c_.w * x23;
    }
    { const float4 c_ = *(const float4*)(Ab + 296);
      a4 -= c_.x * x24;
      a4 -= c_.y * x25;
      a4 -= c_.z * x26;
      a4 -= c_.w * x27;
    }
    { const float4 c_ = *(const float4*)(Ab + 300);
      a4 -= c_.x * x28;
      a4 -= c_.y * x29;
      a4 -= c_.z * x30;
      a4 -= c_.w * x31;
    }
  const float x4 = a4;
  float a3 = Xc[195];
    { const float4 c_ = *(const float4*)(Ab + 208);
      a3 -= c_.x * x4;
      a3 -= c_.y * x5;
      a3 -= c_.z * x6;
      a3 -= c_.w * x7;
    }
    { const float4 c_ = *(const float4*)(Ab + 212);
      a3 -= c_.x * x8;
      a3 -= c_.y * x9;
      a3 -= c_.z * x10;
      a3 -= c_.w * x11;
    }
    { const float4 c_ = *(const float4*)(Ab + 216);
      a3 -= c_.x * x12;
      a3 -= c_.y * x13;
      a3 -= c_.z * x14;
      a3 -= c_.w * x15;
    }
    { const float4 c_ = *(const float4*)(Ab + 220);
      a3 -= c_.x * x16;
      a3 -= c_.y * x17;
      a3 -= c_.z * x18;
      a3 -= c_.w * x19;
    }
    { const float4 c_ = *(const float4*)(Ab + 224);
      a3 -= c_.x * x20;
      a3 -= c_.y * x21;
      a3 -= c_.z * x22;
      a3 -= c_.w * x23;
    }
    { const float4 c_ = *(const float4*)(Ab + 228);
      a3 -= c_.x * x24;
      a3 -= c_.y * x25;
      a3 -= c_.z * x26;
      a3 -= c_.w * x27;
    }
    { const float4 c_ = *(const float4*)(Ab + 232);
      a3 -= c_.x * x28;
      a3 -= c_.y * x29;
      a3 -= c_.z * x30;
      a3 -= c_.w * x31;
    }
  const float x3 = a3;
  float a2 = Xc[130];
    { const float4 c_ = *(const float4*)(Ab + 136);
      a2 -= c_.w * x3;
    }
    { const float4 c_ = *(const float4*)(Ab + 140);
      a2 -= c_.x * x4;
      a2 -= c_.y * x5;
      a2 -= c_.z * x6;
      a2 -= c_.w * x7;
    }
    { const float4 c_ = *(const float4*)(Ab + 144);
      a2 -= c_.x * x8;
      a2 -= c_.y * x9;
      a2 -= c_.z * x10;
      a2 -= c_.w * x11;
    }
    { const float4 c_ = *(const float4*)(Ab + 148);
      a2 -= c_.x * x12;
      a2 -= c_.y * x13;
      a2 -= c_.z * x14;
      a2 -= c_.w * x15;
    }
    { const float4 c_ = *(const float4*)(Ab + 152);
      a2 -= c_.x * x16;
      a2 -= c_.y * x17;
      a2 -= c_.z * x18;
      a2 -= c_.w * x19;
    }
    { const float4 c_ = *(const float4*)(Ab + 156);
      a2 -= c_.x * x20;
      a2 -= c_.y * x21;
      a2 -= c_.z * x22;
      a2 -= c_.w * x23;
    }
    { const float4 c_ = *(const float4*)(Ab + 160);
      a2 -= c_.x * x24;
      a2 -= c_.y * x25;
      a2 -= c_.z * x26;
      a2 -= c_.w * x27;
    }
    { const float4 c_ = *(const float4*)(Ab + 164);
      a2 -= c_.x * x28;
      a2 -= c_.y * x29;
      a2 -= c_.z * x30;
      a2 -= c_.w * x31;
    }
  const float x2 = a2;
  float a1 = Xc[65];
    { const float4 c_ = *(const float4*)(Ab + 68);
      a1 -= c_.z * x2;
      a1 -= c_.w * x3;
    }
    { const float4 c_ = *(const float4*)(Ab + 72);
      a1 -= c_.x * x4;
      a1 -= c_.y * x5;
      a1 -= c_.z * x6;
      a1 -= c_.w * x7;
    }
    { const float4 c_ = *(const float4*)(Ab + 76);
      a1 -= c_.x * x8;
      a1 -= c_.y * x9;
      a1 -= c_.z * x10;
      a1 -= c_.w * x11;
    }
    { const float4 c_ = *(const float4*)(Ab + 80);
      a1 -= c_.x * x12;
      a1 -= c_.y * x13;
      a1 -= c_.z * x14;
      a1 -= c_.w * x15;
    }
    { const float4 c_ = *(const float4*)(Ab + 84);
      a1 -= c_.x * x16;
      a1 -= c_.y * x17;
      a1 -= c_.z * x18;
      a1 -= c_.w * x19;
    }
    { const float4 c_ = *(const float4*)(Ab + 88);
      a1 -= c_.x * x20;
      a1 -= c_.y * x21;
      a1 -= c_.z * x22;
      a1 -= c_.w * x23;
    }
    { const float4 c_ = *(const float4*)(Ab + 92);
      a1 -= c_.x * x24;
      a1 -= c_.y * x25;
      a1 -= c_.z * x26;
      a1 -= c_.w * x27;
    }
    { const float4 c_ = *(const float4*)(Ab + 96);
      a1 -= c_.x * x28;
      a1 -= c_.y * x29;
      a1 -= c_.z * x30;
      a1 -= c_.w * x31;
    }
  const float x1 = a1;
  float a0 = Xc[0];
    { const float4 c_ = *(const float4*)(Ab + 0);
      a0 -= c_.y * x1;
      a0 -= c_.z * x2;
      a0 -= c_.w * x3;
    }
    { const float4 c_ = *(const float4*)(Ab + 4);
      a0 -= c_.x * x4;
      a0 -= c_.y * x5;
      a0 -= c_.z * x6;
      a0 -= c_.w * x7;
    }
    { const float4 c_ = *(const float4*)(Ab + 8);
      a0 -= c_.x * x8;
      a0 -= c_.y * x9;
      a0 -= c_.z * x10;
      a0 -= c_.w * x11;
    }
    { const float4 c_ = *(const float4*)(Ab + 12);
      a0 -= c_.x * x12;
      a0 -= c_.y * x13;
      a0 -= c_.z * x14;
      a0 -= c_.w * x15;
    }
    { const float4 c_ = *(const float4*)(Ab + 16);
      a0 -= c_.x * x16;
      a0 -= c_.y * x17;
      a0 -= c_.z * x18;
      a0 -= c_.w * x19;
    }
    { const float4 c_ = *(const float4*)(Ab + 20);
      a0 -= c_.x * x20;
      a0 -= c_.y * x21;
      a0 -= c_.z * x22;
      a0 -= c_.w * x23;
    }
    { const float4 c_ = *(const float4*)(Ab + 24);
      a0 -= c_.x * x24;
      a0 -= c_.y * x25;
      a0 -= c_.z * x26;
      a0 -= c_.w * x27;
    }
    { const float4 c_ = *(const float4*)(Ab + 28);
      a0 -= c_.x * x28;
      a0 -= c_.y * x29;
      a0 -= c_.z * x30;
      a0 -= c_.w * x31;
    }
  const float x0 = a0;
  Xc[0] = x0;
  Xc[65] = x1;
  Xc[130] = x2;
  Xc[195] = x3;
  Xc[260] = x4;
  Xc[325] = x5;
  Xc[390] = x6;
  Xc[455] = x7;
  Xc[520] = x8;
  Xc[585] = x9;
  Xc[650] = x10;
  Xc[715] = x11;
  Xc[780] = x12;
  Xc[845] = x13;
  Xc[910] = x14;
  Xc[975] = x15;
  Xc[1040] = x16;
  Xc[1105] = x17;
  Xc[1170] = x18;
  Xc[1235] = x19;
  Xc[1300] = x20;
  Xc[1365] = x21;
  Xc[1430] = x22;
  Xc[1495] = x23;
  Xc[1560] = x24;
  Xc[1625] = x25;
  Xc[1690] = x26;
  Xc[1755] = x27;
  Xc[1820] = x28;
  Xc[1885] = x29;
  Xc[1950] = x30;
  Xc[2015] = x31;
}
#define FS(i) (ldsf + (i) * 4160)
__device__ __forceinline__ void rwkv_item2(const Params& p, int l, int item, float* ldsf) {
  const int tid = opq(threadIdx.x), lane = tid & 63, wave = tid >> 6;
  const int r = lane & 31, hf = lane >> 5;
  const int h = item & 7, cidx = item >> 3, rowbase = cidx * 64, cc = cidx & 127;
  const u16* z = (const u16*)(p.ws + WS_Z);
  const float* mu = p.in[9] + l * 1792;
  u16* BBp = (u16*)((unsigned char*)ldsf + 83200);
  u16* XW = BBp;            u16* XA = BBp + 4608;    u16* XG = BBp + 9216;   u16* WT = BBp + 17920;
  u16* Rn = BBp;            u16* Kn = BBp + 4608;    u16* Bn = BBp + 9216;   u16* Cn = BBp + 13824;
  u16* CT = BBp + 18432;    u16* KHT = BBp + 23040;  u16* VT = BBp + 27648;
  float* gc = (float*)(BBp + 32256);
  u16* AK = (u16*)FS(2);    u16* NTm = AK + 4608;
  u16* MT = (u16*)FS(0);    u16* KQT = (u16*)FS(1);
  float* Abp = (float*)((unsigned char*)ldsf + 60928);
  const int mt = (wave >> 1) & 1, nt = wave & 1, grp = wave >> 2;
  __syncthreads();
  {
    const int t = tid >> 3, c8 = (tid & 7) * 8;
    const int m = rowbase + t;
    const int zcs[7] = {h * 64, 512 + h * 64, 1024 + h * 64, 1536, 1600, 1664, 1728};
#pragma unroll
    for (int gi = 0; gi < 7; ++gi) {
      const int zc = zcs[gi] + c8;
      float cur[8], prv[8], v[8];
      const float4 mu0 = *(const float4*)(mu + zc), mu1 = *(const float4*)(mu + zc + 4);
      const float muv[8] = {mu0.x, mu0.y, mu0.z, mu0.w, mu1.x, mu1.y, mu1.z, mu1.w};
      unpack8(*(const uint4*)(z + (size_t)m * ZLD + zc), cur);
      if (t == 0 && cc == 0) {
#pragma unroll
        for (int i = 0; i < 8; ++i) prv[i] = 0.f;
      } else {
        unpack8(*(const uint4*)(z + (size_t)(m - 1) * ZLD + zc), prv);
      }
#pragma unroll
      for (int i = 0; i < 8; ++i) {
        float x = cur[i] + muv[i] * (prv[i] - cur[i]);
        if (gi == 3) x = 1.f - 2.f * __builtin_amdgcn_rcpf(1.f + __expf(2.f * x));
        if (gi >= 5) x = sigm(x);
        v[i] = x;
      }
      if (gi < 2) {
        float* d = FS(gi) + t * 65 + c8;
#pragma unroll
        for (int i = 0; i < 8; ++i) d[i] = v[i];
      } else if (gi == 2) {
#pragma unroll
        for (int i = 0; i < 8; ++i) VT[(c8 + i) * 72 + t] = f2bf(v[i]);
      } else if (gi == 3) { *(uint4*)(XW + t * 72 + c8) = pack8(v); }
      else if (gi == 4) { *(uint4*)(XA + t * 72 + c8) = pack8(v); }
      else { *(uint4*)(XG + t * 136 + (gi - 5) * 64 + c8) = pack8(v); }
    }
  }
  {
    const int i = tid >> 3, j8 = (tid & 7) * 8;
    const float* s1 = p.in[11] + (size_t)l * 64 * 512 + (size_t)i * 512 + h * 64 + j8;
    const float* s2 = p.in[13] + (size_t)l * 64 * 512 + (size_t)i * 512 + h * 64 + j8;
    const float4 a0 = *(const float4*)s1, a1 = *(const float4*)(s1 + 4), b0 = *(const float4*)s2, b1 = *(const float4*)(s2 + 4);
    const float wa[8] = {a0.x, a0.y, a0.z, a0.w, a1.x, a1.y, a1.z, a1.w};
    const float wb[8] = {b0.x, b0.y, b0.z, b0.w, b1.x, b1.y, b1.z, b1.w};
#pragma unroll
    for (int q = 0; q < 8; ++q) { WT[(j8 + q) * 72 + i] = f2bf(wa[q]); WT[4608 + (j8 + q) * 72 + i] = f2bf(wb[q]); }
  }
  __syncthreads();
  {
    f32x16 acc;
#pragma unroll
    for (int i = 0; i < 16; ++i) acc[i] = 0.f;
    mm_tile(grp ? XA : XW, 72, grp ? WT + 4608 : WT, 72, mt, nt, r, hf, 4, acc);
    const int j = nt * 32 + r;
    const float bias = grp ? p.in[12][l * 512 + h * 64 + j] : p.in[10][l * 512 + h * 64 + j];
#pragma unroll
    for (int reg = 0; reg < 16; ++reg) {
      const int t = mt * 32 + ROWOFF(reg, hf);
      const float x = acc[reg] + bias;
      if (grp) FS(3)[t * 65 + j] = sigm(x);
      else {
        const float nx = -x;
        const float sp = (nx > 20.f) ? nx : __logf(1.f + __expf(nx));
        FS(4)[t * 65 + j] = -__expf(-sp - 0.5f);
      }
    }
  }
  __syncthreads();
  {
#pragma unroll
    for (int e2 = 0; e2 < 2; ++e2) {
      const int e = tid + e2 * 512;
      const int i = e >> 3, j8 = (e & 7) * 8;
      const float* s1 = p.in[14] + (size_t)l * 128 * 512 + (size_t)i * 512 + h * 64 + j8;
      const float4 a0 = *(const float4*)s1, a1 = *(const float4*)(s1 + 4);
      const float wa[8] = {a0.x, a0.y, a0.z, a0.w, a1.x, a1.y, a1.z, a1.w};
#pragma unroll
      for (int q = 0; q < 8; ++q) WT[(j8 + q) * 136 + i] = f2bf(wa[q]);
    }
  }
  if (tid < 64) {
    float c = 0.f;
    for (int t = 0; t < 64; ++t) { c += FS(4)[t * 65 + tid]; FS(2)[t * 65 + tid] = c; }
    const float g = __expf(c);
    gc[tid] = g;
    ((float*)(p.ws + WS_GC))[(size_t)item * 64 + tid] = g;
  }
  __syncthreads();
  if (grp == 0) {
    f32x16 acc;
#pragma unroll
    for (int i = 0; i < 16; ++i) acc[i] = 0.f;
    mm_tile(XG, 136, WT, 136, mt, nt, r, hf, 8, acc);
    u16* ga = (u16*)(p.ws + WS_GA) + (size_t)item * 4096;
#pragma unroll
    for (int reg = 0; reg < 16; ++reg) ga[(mt * 32 + ROWOFF(reg, hf)) * 64 + nt * 32 + r] = f2bf(acc[reg]);
  }
  __syncthreads();
  {
    const int t = tid >> 3, j0 = (tid & 7) * 8;
    const float* kkw = p.in[15] + l * 512 + h * 64;
    const float* kaw = p.in[16] + l * 512 + h * 64;
    const float* rkw = p.in[17] + l * 512 + h * 64;
    float kr[8], av[8], rv[8], kkv[8], kf[8];
    float nrm = 0.f, bdot = 0.f;
#pragma unroll
    for (int i = 0; i < 8; ++i) {
      const int j = j0 + i;
      kr[i] = FS(1)[t * 65 + j]; av[i] = FS(3)[t * 65 + j]; rv[i] = FS(0)[t * 65 + j];
      kkv[i] = kr[i] * kkw[j];
      nrm += kkv[i] * kkv[i];
      kf[i] = kr[i] * (1.f + (av[i] - 1.f) * kaw[j]);
      bdot += rv[i] * kf[i] * rkw[j];
    }
    nrm += __shfl_xor(nrm, 1, 64); nrm += __shfl_xor(nrm, 2, 64); nrm += __shfl_xor(nrm, 4, 64);
    bdot += __shfl_xor(bdot, 1, 64); bdot += __shfl_xor(bdot, 2, 64); bdot += __shfl_xor(bdot, 4, 64);
    const float rn = 1.f / fmaxf(sqrtf(nrm), 1e-12f);
    float o_r[8], o_k[8], o_b[8], o_c[8], bo[8];
#pragma unroll
    for (int i = 0; i < 8; ++i) {
      const int j = j0 + i;
      const float cum = FS(2)[t * 65 + j], dl = FS(4)[t * 65 + j];
      const float eg = __expf(cum), egi = __expf(-cum), egp = __expf(cum - dl);
      const float kk = kkv[i] * rn;
      const float g = gc[j];
      o_r[i] = rv[i] * eg; o_k[i] = kf[i] * egi; o_b[i] = kk * av[i] * egi; o_c[i] = kk * egp;
      CT[j * 72 + t] = f2bf(o_c[i]);
      KHT[j * 72 + t] = f2bf(o_k[i] * g);
      FS(1)[t * 65 + j] = o_b[i] * g;
      bo[i] = bdot * bf2f(VT[j * 72 + t]);
    }
    *(uint4*)(Rn + t * 72 + j0) = pack8(o_r);
    *(uint4*)(Kn + t * 72 + j0) = pack8(o_k);
    *(uint4*)(Bn + t * 72 + j0) = pack8(o_b);
    *(uint4*)(Cn + t * 72 + j0) = pack8(o_c);
    u16* bop = (u16*)(p.ws + WS_BO) + (size_t)item * 4096;
    *(uint4*)(bop + t * 64 + j0) = pack8(bo);
  }
  __syncthreads();
  f32x16 akr;
#pragma unroll
  for (int i = 0; i < 16; ++i) akr[i] = 0.f;
  if (grp == 0) {
    f32x16 ab, abr;
#pragma unroll
    for (int i = 0; i < 16; ++i) { ab[i] = 0.f; abr[i] = 0.f; }
    mm_tile(Bn, 72, Cn, 72, mt, nt, r, hf, 4, ab);
    mm_tile(Bn, 72, Rn, 72, mt, nt, r, hf, 4, abr);
    const int t = nt * 32 + r;
#pragma unroll
    for (int reg = 0; reg < 16; ++reg) {
      const int i = mt * 32 + ROWOFF(reg, hf);
      Abp[i * 68 + t] = (i < t) ? ab[reg] : 0.f;
      FS(0)[i * 65 + t] = (i <= t) ? abr[reg] : 0.f;
    }
  } else {
    f32x16 akt;
#pragma unroll
    for (int i = 0; i < 16; ++i) akt[i] = 0.f;
    mm_tile(Cn, 72, Kn, 72, mt, nt, r, hf, 4, akt);
    {
      const int i = nt * 32 + r;
#pragma unroll
      for (int reg = 0; reg < 16; ++reg) { const int t = mt * 32 + ROWOFF(reg, hf); if (!(i < t)) akt[reg] = 0.f; }
    }
    store_T(AK, 72, mt, nt, r, hf, akt);
    mm_tile(Kn, 72, Rn, 72, mt, nt, r, hf, 4, akr);
    {
      const int t = nt * 32 + r;
#pragma unroll
      for (int reg = 0; reg < 16; ++reg) { const int i = mt * 32 + ROWOFF(reg, hf); if (!(i <= t)) akr[reg] = 0.f; }
    }
  }
  __syncthreads();
  if (tid < 128) {
    float* X_ = (tid < 64) ? FS(0) : FS(1);
    const int col = tid & 63;
    tri32(Abp + 32 * 68 + 32, X_ + 32 * 65 + col);
  }
  __syncthreads();
  {
    const int c = tid & 127, ig = tid >> 7;
    float* X_ = (c < 64) ? FS(0) : FS(1);
    const int col = c & 63;
    float a[8];
#pragma unroll
    for (int u = 0; u < 8; ++u) a[u] = 0.f;
#pragma unroll 2
    for (int t = 32; t < 64; t += 4) {
      const float x0 = X_[t * 65 + col], x1 = X_[(t + 1) * 65 + col], x2 = X_[(t + 2) * 65 + col], x3 = X_[(t + 3) * 65 + col];
#pragma unroll
      for (int u = 0; u < 8; ++u) {
        const float4 c_ = *(const float4*)(Abp + (ig * 8 + u) * 68 + t);
        a[u] += c_.x * x0 + c_.y * x1 + c_.z * x2 + c_.w * x3;
      }
    }
#pragma unroll
    for (int u = 0; u < 8; ++u) X_[(ig * 8 + u) * 65 + col] -= a[u];
  }
  __syncthreads();
  if (tid < 128) {
    float* X_ = (tid < 64) ? FS(0) : FS(1);
    const int col = tid & 63;
    tri32(Abp, X_ + col);
  }
  __syncthreads();
  {
    const int c = tid >> 2, q = tid & 3;
    const float* X_ = (c < 64) ? FS(0) : FS(1);
    const int col = c & 63;
    float o0[8], o1[8];
#pragma unroll
    for (int u = 0; u < 8; ++u) { o0[u] = -X_[(q * 16 + u) * 65 + col]; o1[u] = -X_[(q * 16 + 8 + u) * 65 + col]; }
    u16* dst = NTm + c * 72 + q * 16;
    *(uint4*)dst = pack8(o0);
    *(uint4*)(dst + 8) = pack8(o1);
  }
  __syncthreads();
  if (grp == 1) {
    mm_tile(AK, 72, NTm, 72, mt, nt, r, hf, 4, akr);
    store_T(MT, 72, mt, nt, r, hf, akr);
  } else {
    f32x16 d2;
#pragma unroll
    for (int i = 0; i < 16; ++i) d2[i] = 0.f;
    mm_tile(AK, 72, NTm + 64 * 72, 72, mt, nt, r, hf, 4, d2);
#pragma unroll
    for (int g = 0; g < 4; ++g) {
      const int idx = (nt * 32 + r) * 72 + mt * 32 + 8 * g + 4 * hf;
      const uint2 kh = *(const uint2*)(KHT + idx);
      uint2 o;
      o.x = pack2(d2[4 * g] + __uint_as_float(kh.x << 16), d2[4 * g + 1] + __uint_as_float(kh.x & 0xFFFF0000u));
      o.y = pack2(d2[4 * g + 2] + __uint_as_float(kh.y << 16), d2[4 * g + 3] + __uint_as_float(kh.y & 0xFFFF0000u));
      *(uint2*)(KQT + idx) = o;
    }
  }
  __syncthreads();
  if (grp == 0) {
    f32x16 w2, yl;
#pragma unroll
    for (int i = 0; i < 16; ++i) { w2[i] = 0.f; yl[i] = 0.f; }
    mm_tile(NTm, 72, CT, 72, mt, nt, r, hf, 4, w2);
    mm_tile(MT, 72, VT, 72, mt, nt, r, hf, 4, yl);
    u16* W2p = (u16*)(p.ws + WS_W2) + (size_t)item * 4096;
    u16* YLp = (u16*)(p.ws + WS_YL) + (size_t)item * 4096;
#pragma unroll
    for (int reg = 0; reg < 16; ++reg) {
      const int t = mt * 32 + ROWOFF(reg, hf), n = nt * 32 + r;
      W2p[t * 64 + n] = f2bf(w2[reg] + bf2f(Rn[t * 72 + n]));
      YLp[t * 64 + n] = f2bf(yl[reg]);
    }
  } else {
    f32x16 pp, qt;
#pragma unroll
    for (int i = 0; i < 16; ++i) { pp[i] = 0.f; qt[i] = 0.f; }
    mm_tile(CT, 72, NTm + 64 * 72, 72, mt, nt, r, hf, 4, pp);
    mm_tile(KQT, 72, VT, 72, mt, nt, r, hf, 4, qt);
    uint4* Pf = (uint4*)((u16*)(p.ws + WS_PP) + (size_t)item * 4096);
    float* Qf = (float*)(p.ws + WS_Q) + (size_t)item * 4096;
#pragma unroll
    for (int s2 = 0; s2 < 2; ++s2) {
      uint4 o;
      o.x = pack2(pp[s2 * 8 + 0], pp[s2 * 8 + 1]); o.y = pack2(pp[s2 * 8 + 2], pp[s2 * 8 + 3]);
      o.z = pack2(pp[s2 * 8 + 4], pp[s2 * 8 + 5]); o.w = pack2(pp[s2 * 8 + 6], pp[s2 * 8 + 7]);
      Pf[(nt * 4 + mt * 2 + s2) * 64 + lane] = o;
    }
#pragma unroll
    for (int reg = 0; reg < 16; ++reg) Qf[((nt * 2 + mt) * 16 + reg) * 64 + lane] = qt[reg];
  }
}

template <int K_> struct IC { static constexpr int value = K_; };
__device__ __forceinline__ void rwkv_scan(const Params& p, int l, int bh, float* ldsf, bool dry = false) {
  const int tid = opq(threadIdx.x), lane = tid & 63, wave = tid >> 6;
  const int b = bh >> 3, h = bh & 7;
  unsigned char* ring = (unsigned char*)ldsf + 32768;
  __syncthreads();
  {
    const float* G0 = (const float*)(p.ws + WS_GC);
    for (int e = tid; e < 8192; e += NT) ldsf[e] = G0[(size_t)((b * 128 + (e >> 6)) * 8 + h) * 64 + (e & 63)];
  }
  const bool helper = wave >= 2;
  const int ht = tid - 128;
  const u16* PPb = (const u16*)(p.ws + WS_PP);
  const float* Qb = (const float*)(p.ws + WS_Q);
  const bool isP = wave < 4;
  const int hstr = isP ? 128 : 256;
  const int hidx = isP ? (tid - 128) : (tid - 256);
  const int hdst = isP ? hidx : 512 + hidx;
#define SC_GLOAD(c, D0, D1, D2, D3) do { const size_t id_ = (size_t)((b * 128 + (c)) * 8 + h); \
    const uint4* src_ = isP ? (const uint4*)(PPb + id_ * 4096) : (const uint4*)(Qb + id_ * 4096); \
    D0 = src_[hidx]; D1 = src_[hidx + hstr]; D2 = src_[hidx + 2 * hstr]; D3 = src_[hidx + 3 * hstr]; } while (0)
#define SC_LWRITE(c, D0, D1, D2, D3) do { uint4* slot_ = (uint4*)(ring + ((c) & 1) * 24576) + hdst; \
    slot_[0] = D0; slot_[hstr] = D1; slot_[2 * hstr] = D2; slot_[3 * hstr] = D3; } while (0)
  if (helper) {
    uint4 a0, a1, a2, a3, b0, b1, b2, b3, c0_, c1_, c2_, c3_, d0, d1, d2, d3;
    SC_GLOAD(0, a0, a1, a2, a3); SC_LWRITE(0, a0, a1, a2, a3);
    SC_GLOAD(1, b0, b1, b2, b3); SC_GLOAD(2, c0_, c1_, c2_, c3_); SC_GLOAD(3, d0, d1, d2, d3);
    __syncthreads();
#pragma unroll 1
    for (int cc = 0; cc < 128; cc += 4) {
      if (cc + 4 < 128) SC_GLOAD(cc + 4, a0, a1, a2, a3);
      SC_LWRITE(cc + 1, b0, b1, b2, b3);
      asm volatile("s_waitcnt lgkmcnt(0)\n\ts_barrier" ::: "memory");
      if (cc + 5 < 128) SC_GLOAD(cc + 5, b0, b1, b2, b3);
      SC_LWRITE(cc + 2, c0_, c1_, c2_, c3_);
      asm volatile("s_waitcnt lgkmcnt(0)\n\ts_barrier" ::: "memory");
      if (cc + 6 < 128) SC_GLOAD(cc + 6, c0_, c1_, c2_, c3_);
      SC_LWRITE(cc + 3, d0, d1, d2, d3);
      asm volatile("s_waitcnt lgkmcnt(0)\n\ts_barrier" ::: "memory");
      if (cc + 7 < 128) SC_GLOAD(cc + 7, d0, d1, d2, d3);
      if (cc + 4 < 128) SC_LWRITE(cc + 4, a0, a1, a2, a3);
      asm volatile("s_waitcnt lgkmcnt(0)\n\ts_barrier" ::: "memory");
    }
    return;
  }
  __syncthreads();
  const int vt = wave & 1, hf = lane >> 5;
  f32x16 S[2];
#pragma unroll
  for (int i = 0; i < 16; ++i) { S[0][i] = 0.f; S[1][i] = 0.f; }
#pragma unroll 1
  for (int cc = 0; cc < 128; ++cc) {
    const size_t id = (size_t)((b * 128 + cc) * 8 + h);
    float* Qg = (float*)Qb + id * 4096;
    const int lofs = opq(lane);
    const uint4* slotA = (const uint4*)(ring + (cc & 1) * 24576) + lofs;
    const float* slotQ = (const float*)(ring + (cc & 1) * 24576 + 8192) + vt * 2048 + lofs;
    const float* gcp = ldsf + cc * 64 + 4 * (lofs >> 5);
    Qg += vt * 2048 + lofs;
    f32x16 acc[2];
#pragma unroll
    for (int kt = 0; kt < 2; ++kt)
#pragma unroll
      for (int reg = 0; reg < 16; ++reg)
        acc[kt][reg] = S[kt][reg] * gcp[kt * 32 + ((reg) & 3) + 8 * ((reg) >> 2)] + slotQ[(kt * 16 + reg) * 64];
#pragma unroll
    for (int kt = 0; kt < 2; ++kt)
#pragma unroll
      for (int reg = 0; reg < 16; ++reg) if (!dry) Qg[(kt * 16 + reg) * 64] = S[kt][reg];
#pragma unroll
    for (int s_ = 0; s_ < 4; ++s_) {
      const int kt = s_ >> 1, s2 = s_ & 1;
      unsigned hw[4], lw[4];
#pragma unroll
      for (int j = 0; j < 4; ++j) {
        const float x0 = S[kt][s2 * 8 + 2 * j], x1 = S[kt][s2 * 8 + 2 * j + 1];
        hw[j] = pack2(x0, x1);
        lw[j] = pack2(x0 - __uint_as_float(hw[j] << 16), x1 - __uint_as_float(hw[j] & 0xFFFF0000u));
      }
      union { uint4 u; bf16x8 v; } bh_, bl_;
      bh_.u = make_uint4(hw[0], hw[1], hw[2], hw[3]);
      bl_.u = make_uint4(lw[0], lw[1], lw[2], lw[3]);
#pragma unroll
      for (int kt2 = 0; kt2 < 2; ++kt2) {
        union { uint4 u; bf16x8 v; } af; af.u = slotA[(kt2 * 4 + s_) * 64];
        acc[kt2] = __builtin_amdgcn_mfma_f32_32x32x16_bf16(af.v, bh_.v, acc[kt2], 0, 0, 0);
        acc[kt2] = __builtin_amdgcn_mfma_f32_32x32x16_bf16(af.v, bl_.v, acc[kt2], 0, 0, 0);
      }
    }
    S[0] = acc[0]; S[1] = acc[1];
    asm volatile("s_waitcnt lgkmcnt(0)\n\ts_barrier" ::: "memory");
  }
  {
    float* o = p.out + O_PWKV + ((size_t)((l * 2 + b) * 8 + h) * 64 + vt * 32 + (lane & 31)) * 64;
#pragma unroll
    for (int kt = 0; kt < 2; ++kt)
#pragma unroll
      for (int reg = 0; reg < 16; ++reg) o[kt * 32 + ROWOFF(reg, hf)] = S[kt][reg];
  }
}

__device__ __forceinline__ void rwkv_out(const Params& p, int l, int item, float* ldsf) {
  const int tid = opq(threadIdx.x), lane = tid & 63, wave = tid >> 6;
  const int h = item & 7, cidx = item >> 3;
  float* Sl = ldsf; float* Wl = ldsf + 4160;
  const float* Sg = (const float*)(p.ws + WS_Q) + (size_t)item * 4096;
  const u16* W2 = (const u16*)(p.ws + WS_W2) + (size_t)item * 4096;
  const u16* YL = (const u16*)(p.ws + WS_YL) + (size_t)item * 4096;
  const u16* BO = (const u16*)(p.ws + WS_BO) + (size_t)item * 4096;
  const u16* GA = (const u16*)(p.ws + WS_GA) + (size_t)item * 4096;
  u16* z = (u16*)(p.ws + WS_Z);
  __syncthreads();
  {
    const int row = tid >> 3, c = (tid & 7) * 8;
#pragma unroll
    for (int i = 0; i < 8; ++i) {
      const int idx = i * 512 + tid;
      const int ln = idx & 63, reg = (idx >> 6) & 15, kt = (idx >> 10) & 1, vt = idx >> 11;
      Sl[(vt * 32 + (ln & 31)) * 65 + kt * 32 + ROWOFF(reg, ln >> 5)] = Sg[idx];
    }
    float w[8];
    unpack8(*(const uint4*)(W2 + row * 64 + c), w);
    float* e = Wl + row * 65 + c;
#pragma unroll
    for (int i = 0; i < 8; ++i) e[i] = w[i];
  }
  __syncthreads();
  float y[8];
#pragma unroll
  for (int q = 0; q < 8; ++q) y[q] = bf2f(YL[(wave * 8 + q) * 64 + lane]);
#pragma unroll 2
  for (int k = 0; k < 64; ++k) {
    const float s = Sl[lane * 65 + k];
#pragma unroll
    for (int q = 0; q < 8; ++q) y[q] += s * Wl[(wave * 8 + q) * 65 + k];
  }
  const float lng = p.in[18][l * 512 + h * 64 + lane], lnb = p.in[19][l * 512 + h * 64 + lane];
#pragma unroll
  for (int q = 0; q < 8; ++q) {
    const int t = wave * 8 + q;
    const float mean = wave_sum(y[q]) * (1.f / 64.f);
    const float d = y[q] - mean;
    const float var = wave_sum(d * d) * (1.f / 64.f);
    const float yn = d * rsqrtf(var + 64e-5f) * lng + lnb;
    const float o = (yn + bf2f(BO[t * 64 + lane])) * bf2f(GA[t * 64 + lane]);
    z[(size_t)(cidx * 64 + t) * ZLD + h * 64 + lane] = f2bf(o);
  }
}

__device__ __forceinline__ void rwkv_out4(const Params& p, int l, int item0, float* ldsf) {
  const int tid = opq(threadIdx.x), lane = tid & 63, wave = tid >> 6;
  const int r = lane & 31, hf = lane >> 5;
  const int pair = wave >> 1, nt = wave & 1;
  const int item = item0 + pair;
  const int h = item & 7, cidx = item >> 3;
  u16* Sl = (u16*)ldsf + pair * 4608;
  const float* Sg = (const float*)(p.ws + WS_Q) + (size_t)item * 4096;
  const u16* W2 = (const u16*)(p.ws + WS_W2) + (size_t)item * 4096;
  const u16* YL = (const u16*)(p.ws + WS_YL) + (size_t)item * 4096;
  const u16* BO = (const u16*)(p.ws + WS_BO) + (size_t)item * 4096;
  const u16* GA = (const u16*)(p.ws + WS_GA) + (size_t)item * 4096;
  u16* z = (u16*)(p.ws + WS_Z);
  __syncthreads();
  {
    const int lt = tid & 127;
#pragma unroll
    for (int q = 0; q < 8; ++q) {
      const int e = q * 128 + lt;
      const int ln = e & 63, g = (e >> 6) & 3, kt = (e >> 8) & 1, vt = (e >> 9) & 1;
      const float* sp = Sg + ((vt * 2 + kt) * 16 + 4 * g) * 64 + ln;
      const float a0 = sp[0], a1 = sp[64], a2 = sp[128], a3 = sp[192];
      uint2 o; o.x = pack2(a0, a1); o.y = pack2(a2, a3);
      *(uint2*)(Sl + (vt * 32 + (ln & 31)) * 72 + kt * 32 + 8 * g + 4 * (ln >> 5)) = o;
    }
  }
  bf16x8 bfr[4];
#pragma unroll
  for (int s_ = 0; s_ < 4; ++s_) bfr[s_] = *(const bf16x8*)(W2 + (nt * 32 + r) * 64 + s_ * 16 + hf * 8);
  __syncthreads();
  f32x16 acc[2];
#pragma unroll
  for (int mt = 0; mt < 2; ++mt) {
#pragma unroll
    for (int i = 0; i < 16; ++i) acc[mt][i] = 0.f;
#pragma unroll
    for (int s_ = 0; s_ < 4; ++s_) {
      const bf16x8 a = *(const bf16x8*)(Sl + (mt * 32 + r) * 72 + s_ * 16 + hf * 8);
      acc[mt] = __builtin_amdgcn_mfma_f32_32x32x16_bf16(a, bfr[s_], acc[mt], 0, 0, 0);
    }
  }
  const int t = nt * 32 + r;
  float sum = 0.f;
#pragma unroll
  for (int mt = 0; mt < 2; ++mt)
#pragma unroll
    for (int g = 0; g < 4; ++g) {
      const uint2 yl = *(const uint2*)(YL + t * 64 + mt * 32 + 8 * g + 4 * hf);
      acc[mt][4 * g + 0] += __uint_as_float(yl.x << 16); acc[mt][4 * g + 1] += __uint_as_float(yl.x & 0xFFFF0000u);
      acc[mt][4 * g + 2] += __uint_as_float(yl.y << 16); acc[mt][4 * g + 3] += __uint_as_float(yl.y & 0xFFFF0000u);
      sum += acc[mt][4 * g] + acc[mt][4 * g + 1] + acc[mt][4 * g + 2] + acc[mt][4 * g + 3];
    }
  sum += __shfl_xor(sum, 32, 64);
  const float mean = sum * (1.f / 64.f);
  float vs = 0.f;
#pragma unroll
  for (int mt = 0; mt < 2; ++mt)
#pragma unroll
    for (int i = 0; i < 16; ++i) { const float d = acc[mt][i] - mean; vs += d * d; }
  vs += __shfl_xor(vs, 32, 64);
  const float rstd = rsqrtf(vs * (1.f / 64.f) + 64e-5f);
  const float* lng = p.in[18] + l * 512 + h * 64;
  const float* lnb = p.in[19] + l * 512 + h * 64;
  u16* zrow = z + (size_t)(cidx * 64 + t) * ZLD + h * 64;
#pragma unroll
  for (int mt = 0; mt < 2; ++mt)
#pragma unroll
    for (int g = 0; g < 4; ++g) {
      const int v0 = mt * 32 + 8 * g + 4 * hf;
      const uint2 bo = *(const uint2*)(BO + t * 64 + v0);
      const uint2 ga = *(const uint2*)(GA + t * 64 + v0);
      const float4 lg = *(const float4*)(lng + v0), lb = *(const float4*)(lnb + v0);
      const float bo_[4] = {__uint_as_float(bo.x << 16), __uint_as_float(bo.x & 0xFFFF0000u), __uint_as_float(bo.y << 16), __uint_as_float(bo.y & 0xFFFF0000u)};
      const float ga_[4] = {__uint_as_float(ga.x << 16), __uint_as_float(ga.x & 0xFFFF0000u), __uint_as_float(ga.y << 16), __uint_as_float(ga.y & 0xFFFF0000u)};
      const float lg_[4] = {lg.x, lg.y, lg.z, lg.w}, lb_[4] = {lb.x, lb.y, lb.z, lb.w};
      float o[4];
#pragma unroll
      for (int u = 0; u < 4; ++u) o[u] = ((acc[mt][4 * g + u] - mean) * rstd * lg_[u] + lb_[u] + bo_[u]) * ga_[u];
      uint2 ov; ov.x = pack2(o[0], o[1]); ov.y = pack2(o[2], o[3]);
      *(uint2*)(zrow + v0) = ov;
    }
}

__device__ __forceinline__ void attn_prompt(const Params& p, int l, int item, u16* lds, bool dry = false) {
  const int tid = opq(threadIdx.x), lane = tid & 63, wave = tid >> 6;
  const int r = lane & 31, h = lane >> 5;
  const int kvh = item & 1, n = (item >> 1) & 63, b = item >> 7;
  u16* z = (u16*)(p.ws + WS_Z);
  u16* Ks = lds;
  u16* Vt = lds + 256 * 72;
  __syncthreads();
  {
    const int key = tid >> 1, half = tid & 1;
    const int t = (n - 1) * 128 + key;
    uint4 kv[4], vv[4];
    if (t >= 0) {
      const u16* kp = z + (size_t)(b * 8192 + t) * ZLD + 2304 + kvh * 64 + half * 32;
      const u16* vp = z + (size_t)(b * 8192 + t) * ZLD + 2432 + kvh * 64 + half * 32;
#pragma unroll
      for (int i = 0; i < 4; ++i) { kv[i] = *(const uint4*)(kp + i * 8); vv[i] = *(const uint4*)(vp + i * 8); }
    } else {
#pragma unroll
      for (int i = 0; i < 4; ++i) { kv[i] = make_uint4(0, 0, 0, 0); vv[i] = make_uint4(0, 0, 0, 0); }
    }
#pragma unroll
    for (int i = 0; i < 4; ++i) {
      *(uint4*)(Ks + key * 72 + half * 32 + i * 8) = kv[i];
      const unsigned w[4] = {vv[i].x, vv[i].y, vv[i].z, vv[i].w};
#pragma unroll
      for (int q = 0; q < 4; ++q) {
        const int d = half * 32 + i * 8 + q * 2;
        Vt[d * 264 + key] = (u16)(w[q] & 0xFFFFu);
        Vt[(d + 1) * 264 + key] = (u16)(w[q] >> 16);
      }
    }
  }
  __syncthreads();
#pragma unroll 1
  for (int uu = 0; uu < 2; ++uu) {
    const int u = wave * 2 + uu;
    const int hq = kvh * 4 + (u >> 2), qg = u & 3;
    const int qrow = b * 8192 + n * 128 + qg * 32 + r;
    u16* qp = z + (size_t)qrow * ZLD + 1792 + hq * 64;
    bf16x8 qf[4];
#pragma unroll
    for (int s = 0; s < 4; ++s) qf[s] = *(const bf16x8*)(qp + s * 16 + h * 8);
    f32x16 sc[5];
#pragma unroll
    for (int i5 = 0; i5 < 5; ++i5) {
#pragma unroll
      for (int i = 0; i < 16; ++i) sc[i5][i] = 0.f;
      const int kt = qg + i5;
#pragma unroll
      for (int s = 0; s < 4; ++s) {
        bf16x8 kf = *(const bf16x8*)(Ks + (kt * 32 + r) * 72 + s * 16 + h * 8);
        sc[i5] = __builtin_amdgcn_mfma_f32_32x32x16_bf16(kf, qf[s], sc[i5], 0, 0, 0);
      }
      __builtin_amdgcn_sched_barrier(0);
    }
    const int qi = qg * 32 + r;
    const float sink = p.in[20][l * 8 + hq];
    float mx = -1e30f;
#pragma unroll
    for (int i5 = 0; i5 < 5; ++i5)
#pragma unroll
      for (int reg = 0; reg < 16; ++reg) {
        const int j = (qg + i5) * 32 + ROWOFF(reg, h);
        const bool ok = (j > qi) && (j <= qi + 128) && (n > 0 || j >= 128);
        const float s = ok ? sc[i5][reg] * 0.125f : -1e30f;
        sc[i5][reg] = s;
        mx = fmaxf(mx, s);
      }
    mx = fmaxf(mx, __shfl_xor(mx, 32, 64));
    mx = fmaxf(mx, sink);
    float sum = 0.f;
#pragma unroll
    for (int i5 = 0; i5 < 5; ++i5)
#pragma unroll
      for (int reg = 0; reg < 16; ++reg) { const float e = __expf(sc[i5][reg] - mx); sc[i5][reg] = e; sum += e; }
    sum += __shfl_xor(sum, 32, 64);
    const float rden = 1.f / (sum + __expf(sink - mx));
    f32x16 oacc[2];
#pragma unroll
    for (int i = 0; i < 16; ++i) { oacc[0][i] = 0.f; oacc[1][i] = 0.f; }
#pragma unroll
    for (int i5 = 0; i5 < 5; ++i5) {
      const int kt = qg + i5;
#pragma unroll
      for (int s2 = 0; s2 < 2; ++s2) {
        bf16x8 pf;
#pragma unroll
        for (int j = 0; j < 8; ++j) pf[j] = (short)f2bf(sc[i5][s2 * 8 + j] * rden);
#pragma unroll
        for (int dt = 0; dt < 2; ++dt) {
          const u16* vp = Vt + (dt * 32 + r) * 264 + kt * 32 + s2 * 16 + h * 4;
          const uint2 lo = *(const uint2*)vp, hi = *(const uint2*)(vp + 8);
          union { uint4 u; bf16x8 v; } cv;
          cv.u = make_uint4(lo.x, lo.y, hi.x, hi.y);
          oacc[dt] = __builtin_amdgcn_mfma_f32_32x32x16_bf16(cv.v, pf, oacc[dt], 0, 0, 0);
        }
        __builtin_amdgcn_sched_barrier(0);
      }
    }
#pragma unroll
    for (int dt = 0; dt < 2; ++dt)
#pragma unroll
      for (int g4 = 0; g4 < 4; ++g4) {
        const int d = dt * 32 + 8 * g4 + 4 * h;
        uint2 o;
        o.x = pack2(oacc[dt][g4 * 4 + 0], oacc[dt][g4 * 4 + 1]);
        o.y = pack2(oacc[dt][g4 * 4 + 2], oacc[dt][g4 * 4 + 3]);
        if (!dry) *(uint2*)(qp + d) = o;
      }
  }
}

__device__ __forceinline__ void attn_sample(const Params& p, int l, int item, float* ldsf, bool dry = false) {
  const int tid = opq(threadIdx.x);
  const int kvh = item & 1, b = item >> 1;
  u16* z = (u16*)(p.ws + WS_Z);
  float* Kl = ldsf;
  float* Vl = ldsf + 132 * 65;
  float* Ql = Vl + 132 * 65;
  float* Pl = Ql + 16 * 64;
  __syncthreads();
  for (int e = tid; e < 132 * 8; e += NT) {
    const int j = e >> 3, c = (e & 7) * 8;
    float k[8], v[8];
    if (j < 128) {
      const float* kp = p.in[4] + ((size_t)((l * 128 + b) * 128 + j) * 2 + kvh) * 64 + c;
      const float* vp = p.in[5] + ((size_t)((l * 128 + b) * 128 + j) * 2 + kvh) * 64 + c;
      float4 a = *(const float4*)kp, a2 = *(const float4*)(kp + 4);
      float4 c1 = *(const float4*)vp, c2 = *(const float4*)(vp + 4);
      k[0] = a.x; k[1] = a.y; k[2] = a.z; k[3] = a.w; k[4] = a2.x; k[5] = a2.y; k[6] = a2.z; k[7] = a2.w;
      v[0] = c1.x; v[1] = c1.y; v[2] = c1.z; v[3] = c1.w; v[4] = c2.x; v[5] = c2.y; v[6] = c2.z; v[7] = c2.w;
    } else {
      const size_t row = M_P + b * 4 + (j - 128);
      unpack8(*(const uint4*)(z + row * ZLD + 2304 + kvh * 64 + c), k);
      unpack8(*(const uint4*)(z + row * ZLD + 2432 + kvh * 64 + c), v);
    }
#pragma unroll
    for (int i = 0; i < 8; ++i) { Kl[j * 65 + c + i] = k[i]; Vl[j * 65 + c + i] = v[i]; }
    if (j >= 4) {
      float* ok = p.out + O_SK + ((size_t)((l * 128 + b) * 128 + (j - 4)) * 2 + kvh) * 64 + c;
      float* ov = p.out + O_SV + ((size_t)((l * 128 + b) * 128 + (j - 4)) * 2 + kvh) * 64 + c;
      *(float4*)ok = make_float4(k[0], k[1], k[2], k[3]); *(float4*)(ok + 4) = make_float4(k[4], k[5], k[6], k[7]);
      *(float4*)ov = make_float4(v[0], v[1], v[2], v[3]); *(float4*)(ov + 4) = make_float4(v[4], v[5], v[6], v[7]);
    }
  }
  if (tid < 128) {
    const int row = tid >> 3, c = (tid & 7) * 8;
    const int hl = row >> 2, t = row & 3;
    float q[8];
    unpack8(*(const uint4*)(z + (size_t)(M_P + b * 4 + t) * ZLD + 1792 + (kvh * 4 + hl) * 64 + c), q);
#pragma unroll
    for (int i = 0; i < 8; ++i) Ql[row * 64 + c + i] = q[i];
  }
  __syncthreads();
  const int row = tid >> 5, jl = tid & 31;
  const int t = row & 3, hq = kvh * 4 + (row >> 2);
  float sc[5];
  float mx = -1e30f;
#pragma unroll
  for (int jj = 0; jj < 5; ++jj) {
    const int j = jl + 32 * jj;
    float s = -1e30f;
    if (j < 132 && j > t && j <= t + 128) {
      float a = 0.f;
#pragma unroll 8
      for (int d = 0; d < 64; ++d) a += Ql[row * 64 + d] * Kl[j * 65 + d];
      s = a * 0.125f;
    }
    sc[jj] = s; mx = fmaxf(mx, s);
    __builtin_amdgcn_sched_barrier(0);
  }
#pragma unroll
  for (int o = 16; o >= 1; o >>= 1) mx = fmaxf(mx, __shfl_xor(mx, o, 64));
  const float sink = p.in[20][l * 8 + hq];
  mx = fmaxf(mx, sink);
  float sum = 0.f;
#pragma unroll
  for (int jj = 0; jj < 5; ++jj) { sc[jj] = __expf(sc[jj] - mx); sum += sc[jj]; }
#pragma unroll
  for (int o = 16; o >= 1; o >>= 1) sum += __shfl_xor(sum, o, 64);
  const float rden = 1.f / (sum + __expf(sink - mx));
#pragma unroll
  for (int jj = 0; jj < 5; ++jj) { const int j = jl + 32 * jj; if (j < 136) Pl[row * 136 + j] = sc[jj] * rden; }
  __syncthreads();
  {
    const int d = jl * 2;
    float o0 = 0.f, o1 = 0.f;
#pragma unroll 4
    for (int j = 0; j < 132; ++j) { const float pr = Pl[row * 136 + j]; o0 += pr * Vl[j * 65 + d]; o1 += pr * Vl[j * 65 + d + 1]; }
    if (!dry) *(unsigned*)(z + (size_t)(M_P + b * 4 + t) * ZLD + 1792 + hq * 64 + d) = pack2(o0, o1);
  }
}

__device__ __forceinline__ void phase_convgelu(const Params& p, int l, bool dry = false) {
  u16* cu = (u16*)(p.ws + WS_CU);
  const float* cw = p.in[26] + (size_t)l * 3 * 2816;
  const float* cb = p.in[27] + (size_t)l * 2816;
  for (int it = blockIdx.x; it < 1056; it += gridDim.x) {
    const int tid = opq(threadIdx.x);
    if (tid >= 352) continue;
    const int j0 = tid * 8;
    float w0[8], w1[8], w2[8], bb[8];
#pragma unroll
    for (int i = 0; i < 8; ++i) { w0[i] = cw[j0 + i]; w1[i] = cw[2816 + j0 + i]; w2[i] = cw[5632 + j0 + i]; bb[i] = cb[j0 + i]; }
    float c1[8], c2[8];
    for (int rr = 0; rr < 16; ++rr) {
      const int row = it * 16 + rr;
      const bool prompt = row < M_P;
      int b, t;
      if (prompt) { b = row >> 13; t = row & 8191; } else { b = (row - M_P) >> 2; t = (row - M_P) & 3; }
      if (t == 0) {
        if (prompt) {
#pragma unroll
          for (int i = 0; i < 8; ++i) { c1[i] = 0.f; c2[i] = 0.f; }
        } else {
          const float* st = p.in[6] + (size_t)((l * 128 + b) * 2) * 2816 + j0;
#pragma unroll
          for (int i = 0; i < 8; ++i) { c2[i] = st[i]; c1[i] = st[2816 + i]; }
        }
      } else if (rr == 0) {
        unpack8(*(const uint4*)(cu + (size_t)(row - 1) * 5632 + j0), c1);
        if (t >= 2) unpack8(*(const uint4*)(cu + (size_t)(row - 2) * 5632 + j0), c2);
        else {
#pragma unroll
          for (int i = 0; i < 8; ++i) c2[i] = 0.f;
        }
      }
      float c0[8], up[8], a[8];
      unpack8(*(const uint4*)(cu + (size_t)row * 5632 + j0), c0);
      unpack8(*(const uint4*)(cu + (size_t)row * 5632 + 2816 + j0), up);
#pragma unroll
      for (int i = 0; i < 8; ++i) {
        const float cv = bb[i] + w0[i] * c2[i] + w1[i] * c1[i] + w2[i] * c0[i];
        a[i] = gelu_fast(cv) * up[i];
      }
      if (!dry) *(uint4*)(cu + (size_t)row * 5632 + 2816 + j0) = pack8(a);
      if (prompt && t >= 8190) {
        float* o = p.out + O_PCONV + (size_t)((l * 2 + b) * 2 + (t - 8190)) * 2816 + j0;
        *(float4*)o = make_float4(c0[0], c0[1], c0[2], c0[3]); *(float4*)(o + 4) = make_float4(c0[4], c0[5], c0[6], c0[7]);
      } else if (!prompt && t >= 2) {
        float* o = p.out + O_SCONV + (size_t)((l * 128 + b) * 2 + (t - 2)) * 2816 + j0;
        *(float4*)o = make_float4(c0[0], c0[1], c0[2], c0[3]); *(float4*)(o + 4) = make_float4(c0[4], c0[5], c0[6], c0[7]);
      }
#pragma unroll
      for (int i = 0; i < 8; ++i) { c2[i] = c1[i]; c1[i] = c0[i]; }
    }
  }
}

__device__ __forceinline__ void phase_final(const Params& p) {
  float* X = p.out;
  const float* g = p.in[29];
  for (int it = blockIdx.x; it < 2112; it += gridDim.x) {
    const int tid = opq(threadIdx.x);
    const int lane = tid & 63;
    const int row = it * 8 + (tid >> 6);
    float4 v[4];
    float ss = 0.f;
#pragma unroll
    for (int i = 0; i < 4; ++i) {
      v[i] = *(const float4*)(X + (size_t)row * 1024 + i * 256 + lane * 4);
      ss += v[i].x * v[i].x + v[i].y * v[i].y + v[i].z * v[i].z + v[i].w * v[i].w;
    }
    ss = wave_sum(ss);
    const float rs = rsqrtf(ss * (1.f / 1024.f) + 1e-6f);
#pragma unroll
    for (int i = 0; i < 4; ++i) {
      const float4 gg = *(const float4*)(g + i * 256 + lane * 4);
      *(float4*)(X + (size_t)row * 1024 + i * 256 + lane * 4) =
          make_float4(v[i].x * rs * gg.x, v[i].y * rs * gg.y, v[i].z * rs * gg.z, v[i].w * rs * gg.w);
    }
  }
}

#define XB_TMO      128
#define XB_XCNT(j)  (256  + 64 * (j))
#define XB_XSUB(j)  (1280 + 64 * (j))
#define XB_XGEN(j)  (2304 + 64 * (j))
#define XB_TOP      3328
#define XB_TOPGEN   3392
#define XCD_BAR_WORDS 3456
#define XB_SPIN_CAP (1u << 18)
#define LAS __attribute__((address_space(3)))

__device__ __forceinline__ unsigned xb_ld(unsigned* p)              { return __hip_atomic_load(p, __ATOMIC_RELAXED, __HIP_MEMORY_SCOPE_AGENT); }
__device__ __forceinline__ unsigned xb_add(unsigned* p, unsigned v) { return __hip_atomic_fetch_add(p, v, __ATOMIC_RELAXED, __HIP_MEMORY_SCOPE_AGENT); }
__device__ __forceinline__ unsigned xb_xcc_id() { return (unsigned)__builtin_amdgcn_s_getreg((3 << 11) | 20) & 0xFu; }
#define XB_SPIN(cond, bar) do { unsigned _sp = 0; while (cond) { __builtin_amdgcn_s_sleep(1); \
    if ((++_sp & 255u) == 0u) { if (xb_ld(&(bar)[XB_TMO])) break; if (_sp > XB_SPIN_CAP) { atomicAdd(&(bar)[XB_TMO], 1u); break; } } } } while (0)

struct XcdBarrier {
    unsigned* bar; unsigned x;
    volatile LAS unsigned* st;
};

__device__ __forceinline__ XcdBarrier xcd_barrier_post(unsigned* bar, volatile LAS unsigned* st) {
    XcdBarrier b; b.bar = bar; b.x = xb_xcc_id(); b.st = st;
    if (threadIdx.x == 0) (void)xb_add(&bar[XB_XCNT(b.x)], 1u);
    return b;
}
__device__ __forceinline__ void xcd_barrier_complete(unsigned* bar, unsigned x, unsigned& nloc, unsigned& nx) {
    const unsigned G = gridDim.x * gridDim.y * gridDim.z;
    unsigned sum, cnt, mine, sp = 0u;
    for (;;) {
        sum = 0u; cnt = 0u; mine = 0u;
#pragma unroll
        for (unsigned j = 0; j < 16; ++j) { const unsigned c = xb_ld(&bar[XB_XCNT(j)]); sum += c; cnt += (c > 0u) ? 1u : 0u; mine = (j == x) ? c : mine; }
        if (sum == G) break;
        __builtin_amdgcn_s_sleep(1);
        if ((++sp & 255u) == 0u) { if (xb_ld(&bar[XB_TMO])) break; if (sp > XB_SPIN_CAP) { atomicAdd(&bar[XB_TMO], 1u); break; } }
    }
    nloc = mine > 0u ? mine : 1u; nx = cnt > 0u ? cnt : 1u;
}

__device__ __forceinline__ void xcd_barrier(const XcdBarrier& b) {
    asm volatile("s_waitcnt vmcnt(0)" ::: "memory");
    __syncthreads();
    if (threadIdx.x == 0) {
        unsigned* bar = b.bar;
        __builtin_amdgcn_s_waitcnt(0);
        unsigned nloc = b.st[0], nx = b.st[1];
        if (nloc == 0u) { xcd_barrier_complete(bar, b.x, nloc, nx); b.st[0] = nloc; b.st[1] = nx; }
        const unsigned old = xb_add(&bar[XB_XSUB(b.x)], 1u);
        const unsigned gen = old / nloc;
        if (old + 1u == (gen + 1u) * nloc) {
            __builtin_amdgcn_fence(__ATOMIC_RELEASE, "agent");
            asm volatile("s_waitcnt vmcnt(0)" ::: "memory");
            const unsigned og = xb_add(&bar[XB_TOP], 1u);
            const unsigned tg = og / nx;
            if (og + 1u == (tg + 1u) * nx) xb_add(&bar[XB_TOPGEN], 1u);
            else XB_SPIN(xb_ld(&bar[XB_TOPGEN]) == tg, bar);
            __builtin_amdgcn_fence(__ATOMIC_ACQUIRE, "agent");
            xb_add(&bar[XB_XGEN(b.x)], 1u);
            asm volatile("s_waitcnt vmcnt(0)" ::: "memory");
        } else {
            XB_SPIN(xb_ld(&bar[XB_XGEN(b.x)]) == gen, bar);
            __builtin_amdgcn_fence(__ATOMIC_ACQUIRE, "agent");
            asm volatile("s_waitcnt vmcnt(0)" ::: "memory");
        }
    }
    __syncthreads();
}

#define WS_BAR 256000000ull
#if COOP
#ifndef SYNC_RPT
#define SYNC_RPT 1
#endif
#define PH_SYNC(idx) do { if ((idx) + 1 < ph_hi && (idx) >= ph_lo) { for (int sr_ = 0; sr_ < SYNC_RPT; ++sr_) xcd_barrier(xb); } } while (0)
#else
#define PH_SYNC(idx) do { } while (0)
#endif
#define PH_ON(idx, bit) (((KMASK >> (bit)) & 1) && ph_lo <= (idx) && (idx) < ph_hi)

__device__ __forceinline__ Params load_params() {
  auto kp0 = __builtin_amdgcn_kernarg_segment_ptr();
  asm volatile("" : "+s"(kp0));
  auto kq = (const __constant__ unsigned long long*)kp0;
  Params p;
#pragma unroll
  for (int i = 0; i < 30; ++i) p.in[i] = (const float*)kq[i];
  p.out = (float*)kq[30];
  p.ws = (unsigned char*)kq[31];
  p.ph_lo = 0; p.ph_hi = 0;
  return p;
}

template <int KMASK, int l>
__device__ __forceinline__ void layer_phases(int ph_lo, int ph_hi, unsigned char* lds_raw, const XcdBarrier& xb) {
  float* ldsf = (float*)lds_raw;
  u16* ldsh = (u16*)lds_raw;
  const int base = l * 12;
  if (PH_ON(base + 0, 0)) { const Params p = load_params(); RPT(0) phase_prep(p, l, 0, ldsf); }
  PH_SYNC(base + 0);
  if (PH_ON(base + 1, 1)) {
    const Params p = load_params();
    EpiInproj E; E.z = (u16*)(p.ws + WS_Z); E.out = p.out; E.l = l;
    RPT(1) run_gemm(lds_raw, (const u16*)(p.ws + WS_H), 1024, (const u16*)(p.ws + WS_WT) + WT_IN, 2560, 1024, E);
  }
  PH_SYNC(base + 1);
  if (PH_ON(base + 2, 2)) {
    const Params p = load_params();
    for (int it = blockIdx.x; it < 264; it += gridDim.x) rope_item(p, l, it, false);
    if (blockIdx.x < 64) rwkv_item(p, l, 2048 + blockIdx.x, ldsf, false);
    {
      const Params p2 = load_params();
      int i0, n;
      if (gridDim.x == 256) { if (blockIdx.x < 64) { i0 = blockIdx.x * 5; n = 5; } else { i0 = 320 + (blockIdx.x - 64) * 9; n = 9; } }
      else { i0 = 0; n = 0; }
      RPT(2) {
        if (gridDim.x == 256) { for (int i = 0; i < n; ++i) rwkv_item2(p2, l, i0 + i, ldsf); }
        else { for (int it = blockIdx.x; it < 2048; it += gridDim.x) rwkv_item2(p2, l, it, ldsf); }
      }
    }
  }
  PH_SYNC(base + 2);
  if (PH_ON(base + 3, 3)) {
    const Params p = load_params();
    if (blockIdx.x < 16) { RPT(3) rwkv_scan(p, l, blockIdx.x, ldsf, DRY(3)); }
    else {
      RPT(15) for (int it = blockIdx.x - 16; it < 512; it += gridDim.x - 16) {
        if (it < 256) attn_prompt(p, l, it, ldsh, DRY(15)); else attn_sample(p, l, it - 256, ldsf, DRY(15));
      }
    }
  }
  PH_SYNC(base + 3);
  if (PH_ON(base + 4, 4)) {
    const Params p = load_params();
    RPT(4) for (int it = blockIdx.x * 4; it < 2048; it += gridDim.x * 4) rwkv_out4(p, l, it, ldsf);
  }
  PH_SYNC(base + 4);
  if (PH_ON(base + 5, 5)) {
    const Params p = load_params();
    EpiStoreBf16 E1; E1.O = (u16*)(p.ws + WS_T1); E1.ldc = 1024;
    RPT(5) run_gemm(lds_raw, (const u16*)(p.ws + WS_Z), ZLD, (const u16*)(p.ws + WS_WT) + WT_BRA, 1024, 512, E1);
    EpiStoreBf16 E2; E2.O = (u16*)(p.ws + WS_T2); E2.ldc = 1024;
    run_gemm(lds_raw, (const u16*)(p.ws + WS_Z) + 1792, ZLD, (const u16*)(p.ws + WS_WT) + WT_BRB, 1024, 512, E2);
  }
  PH_SYNC(base + 5);
  if (PH_ON(base + 6, 6)) {
    const Params p = load_params();
    EpiMerge E; E.t1 = (const u16*)(p.ws + WS_T1); E.t2 = (const u16*)(p.ws + WS_T2); E.mg = (u16*)(p.ws + WS_MG);
    RPT(6) run_gemm(lds_raw, (const u16*)(p.ws + WS_H), 1024, (const u16*)(p.ws + WS_WT) + WT_G, 2048, 1024, E);
  }
  PH_SYNC(base + 6);
  if (PH_ON(base + 7, 7)) {
    const Params p = load_params();
    EpiResid E; E.X = p.out;
    RPT(7) { E.dry = DRY(7); run_gemm(lds_raw, (const u16*)(p.ws + WS_MG), 1024, (const u16*)(p.ws + WS_WT) + WT_OUT, 1024, 1024, E); }
  }
  PH_SYNC(base + 7);
  if (PH_ON(base + 8, 8)) { const Params p = load_params(); RPT(8) phase_prep(p, l, 1, ldsf); }
  PH_SYNC(base + 8);
  if (PH_ON(base + 9, 9)) {
    const Params p = load_params();
    EpiFfnIn E; E.cu = (u16*)(p.ws + WS_CU);
    RPT(9) run_gemm(lds_raw, (const u16*)(p.ws + WS_H), 1024, (const u16*)(p.ws + WS_WTF) + WT_FIN, 5632, 1024, E);
  }
  PH_SYNC(base + 9);
  if (PH_ON(base + 10, 10)) { const Params p = load_params(); RPT(10) phase_convgelu(p, l, DRY(10)); }
  PH_SYNC(base + 10);
  if (PH_ON(base + 11, 11)) {
    const Params p = load_params();
    EpiResid E; E.X = p.out;
    RPT(11) { E.dry = DRY(11); run_gemm(lds_raw, (const u16*)(p.ws + WS_CU) + 2816, 5632, (const u16*)(p.ws + WS_WTF) + WT_FDN, 1024, 2816, E); }
  }
  PH_SYNC(base + 11);
}

template <int KMASK>
__global__ void __launch_bounds__(NT) fwd_kernel(Params pin) {
  extern __shared__ __attribute__((aligned(16))) unsigned char lds_raw[];
  const int ph_lo = pin.ph_lo, ph_hi = pin.ph_hi;
  XcdBarrier xb;
  {
    volatile LAS unsigned* st = (volatile LAS unsigned*)(lds_raw + (LDS_BYTES - 16));
    if (threadIdx.x < 2) st[threadIdx.x] = 0u;
    __syncthreads();
    xb = xcd_barrier_post((unsigned*)(pin.ws + WS_BAR), st);
  }
  if (ph_hi > 100000) cg::this_grid().sync();
  layer_phases<KMASK, 0>(ph_lo, ph_hi, lds_raw, xb);
  layer_phases<KMASK, 1>(ph_lo, ph_hi, lds_raw, xb);
  if (PH_ON(NPH - 1, 12)) { const Params p = load_params(); phase_final(p); }
}

extern "C" void kernel_launch(void* const* d_in, const int* in_sizes, int n_in, void* d_out, int out_size, void* d_ws,
                              size_t ws_size, hipStream_t stream) {
  static int grid = 0;
  if (grid == 0) {
    int dev = 0, cus = 0;
    (void)hipGetDevice(&dev);
    (void)hipDeviceGetAttribute(&cus, hipDeviceAttributeMultiprocessorCount, dev);
    grid = cus > 0 ? cus : 256;
    (void)hipFuncSetAttribute((const void*)fwd_kernel<PHMASK>, hipFuncAttributeMaxDynamicSharedMemorySize, LDS_BYTES);
    (void)hipGetLastError();
  }
  Params p{};
  for (int i = 0; i < 30; ++i) p.in[i] = (const float*)d_in[i];
  p.out = (float*)d_out;
  p.ws = (unsigned char*)d_ws;
#if COOP
  (void)hipMemsetAsync((unsigned char*)d_ws + WS_BAR, 0, XCD_BAR_WORDS * 4, stream);
  p.ph_lo = 0; p.ph_hi = NPH;
  void* args[] = {&p};
  hipError_t e = hipLaunchCooperativeKernel((const void*)fwd_kernel<PHMASK>, dim3(grid), dim3(NT), args, LDS_BYTES, stream);
  if (e != hipSuccess) fprintf(stderr, "cooperative launch failed: %s (grid %d)\n", hipGetErrorString(e), grid);
#else
  for (int ph = 0; ph < NPH; ++ph) {
    p.ph_lo = ph; p.ph_hi = ph + 1;
    hipLaunchKernelGGL(fwd_kernel<PHMASK>, dim3(grid), dim3(NT), LDS_BYTES, stream, p);
  }
#endif
}
```

```cpp
#include <hip/hip_runtime.h>
#include <hip/hip_bf16.h>
#include <hip/hip_cooperative_groups.h>
#include <cstdio>
namespace cg = cooperative_groups;

typedef __attribute__((ext_vector_type(8))) short bf16x8;
typedef __attribute__((ext_vector_type(16))) float f32x16;
typedef unsigned short u16;

#ifndef PHMASK
#define PHMASK 0x1FFF
#endif
#ifndef T3
#define T3 7
#endif
#ifndef P2SEL
#define P2SEL 7
#endif
#ifndef RPT_MASK
#define RPT_MASK 0
#endif
#ifndef RPT_N
#define RPT_N 1
#endif
#define RPT(bit) for (int rp_ = 0; rp_ < (((RPT_MASK >> (bit)) & 1) ? 1 + RPT_N : 1); ++rp_)
#define RPT_CNT(bit) (((RPT_MASK >> (bit)) & 1) ? 1 + RPT_N : 1)
#define DRY(bit) (opq(rp_) + 1 < RPT_CNT(bit))
#ifndef COOP
#define COOP 1
#endif

#define NT 512
#define M_TOT 16896
#define M_P 16384
#define ZLD 2560
#define NPH 25

#define WS_WT   0ull
#define WS_H    13631488ull
#define WS_Z    48234496ull
#define WS_R    134742016ull
#define WS_PP   (WS_R)
#define WS_GC   (WS_R + 16777216ull)
#define WS_Q    (WS_R + 17301504ull)
#define WS_W2   (WS_R + 50855936ull)
#define WS_YL   (WS_R + 67633152ull)
#define WS_BO   (WS_R + 84410368ull)
#define WS_GA   (WS_R + 101187584ull)
#define WS_T1   (WS_R)
#define WS_T2   (WS_R + 34603008ull)
#define WS_MG   (WS_R + 69206016ull)
#define WS_WTF  (WS_Z)
#define WS_CU   (WS_Z + 17301504ull)
#define WS_DP  256100096ull
#define WT_IN  0
#define WT_G   2621440
#define WT_BRA 4718592
#define WT_BRB 5242880
#define WT_OUT 5767168
#define WT_FIN 0
#define WT_FDN 5767168
#define O_PSHIFT 17301504
#define O_PWKV   17308672
#define O_PK     17439744
#define O_PV     17505280
#define O_PCONV  17570816
#define O_SSHIFT 17593344
#define O_SWKV   18052096
#define O_SK     26440704
#define O_SV     30635008
#define O_SCONV  34829312

#define LDS_BYTES 151552

struct Params {
  const float* in[30];
  float* out;
  unsigned char* ws;
  int ph_lo, ph_hi;
};

typedef float f2v_ __attribute__((ext_vector_type(2)));
typedef __bf16 b2v_ __attribute__((ext_vector_type(2)));
__device__ __forceinline__ unsigned pack2(float a, float b) { f2v_ v = {a, b}; b2v_ r = __builtin_convertvector(v, b2v_); return __builtin_bit_cast(unsigned, r); }
__device__ __forceinline__ u16 f2bf(float f) { return (u16)(pack2(f, f) & 0xFFFFu); }
__device__ __forceinline__ float bf2f(u16 h) { return __uint_as_float(((unsigned)h) << 16); }
__device__ __forceinline__ float sigm(float x) { return __builtin_amdgcn_rcpf(1.f + __expf(-x)); }
__device__ __forceinline__ void unpack8(uint4 u, float* o) {
  o[0] = __uint_as_float(u.x << 16); o[1] = __uint_as_float(u.x & 0xFFFF0000u);
  o[2] = __uint_as_float(u.y << 16); o[3] = __uint_as_float(u.y & 0xFFFF0000u);
  o[4] = __uint_as_float(u.z << 16); o[5] = __uint_as_float(u.z & 0xFFFF0000u);
  o[6] = __uint_as_float(u.w << 16); o[7] = __uint_as_float(u.w & 0xFFFF0000u);
}
__device__ __forceinline__ uint4 pack8(const float* f) {
  uint4 u; u.x = pack2(f[0], f[1]); u.y = pack2(f[2], f[3]); u.z = pack2(f[4], f[5]); u.w = pack2(f[6], f[7]); return u;
}
__device__ __forceinline__ float gelu_fast(float v) {
  const float av = fabsf(v), d = av * 0.2316418882f + 1.0f;
  const float t = __builtin_amdgcn_rcpf(d);
  float q = t * 0.5307027145f + (-0.7265760135f); q = q * t + 0.7107068705f; q = q * t + (-0.142248368f); q = q * t + 0.127414796f; q = q * t;
  const float e = __builtin_amdgcn_exp2f((v * v) * (-0.72134752044f));
  const float m = v * (q * e);
  return v < 0.f ? m : v - m;
}
__device__ __forceinline__ int opq(int x) { asm volatile("" : "+v"(x)); return x; }
__device__ __forceinline__ float wave_sum(float x) {
#pragma unroll
  for (int o = 32; o >= 1; o >>= 1) x += __shfl_xor(x, o, 64);
  return x;
}

namespace pg8 {
#define PG8_LAS __attribute__((address_space(3)))
typedef unsigned short bf16_t;
typedef short bf16x8 __attribute__((ext_vector_type(8)));
typedef float f32x4 __attribute__((ext_vector_type(4)));
typedef unsigned u32x4 __attribute__((ext_vector_type(4)));
constexpr int BM = 256, BK = 64, HALF = 128, HTB = HALF * BK * 2  , STAGE_BYTES = 8 * HTB, NXCD = 8, WGM = 8;
__host__ __device__ __forceinline__ int lds_byte(int r, int c) { const int st = (r >> 4) * 2 + (c >> 5), rr = r & 15, cc = c & 31, ob = rr * 64 + cc * 2; return st * 1024 + (ob ^ (((ob >> 9) & 1) << 5)); }
__host__ __device__ __forceinline__ void stage_rc(int b, int& R, int& C) { const int st = b / 1024, sb = b % 1024, swz = sb ^ (((sb >> 9) & 1) << 5); R = (st >> 1) * 16 + swz / 64; C = (st & 1) * 32 + (swz % 64) / 2; }
__host__ __device__ __forceinline__ int perm32(int rho) { const int n = rho >> 4, i = rho & 15; return 8 * (i >> 2) + 4 * n + (i & 3); }
struct Unit { int pm, pn; };
struct Gemm { const bf16_t* A; const bf16_t* Bt; int M, N, K, lda, ldb; };
struct StaticOrder {
    int nM, nN, nwg, G, c;
    __host__ __device__ void init(int M, int N, int G_, int c_) { nM = M / BM; nN = N / BM; nwg = nM * nN; G = G_; c = c_; }
    __host__ __device__ bool next(int i, Unit& u) const {
        const long L = (long)i * G + c; if (L >= nwg) return false;
        int wgid = (int)L; { const int q = nwg / NXCD, r = nwg % NXCD, xcd = wgid % NXCD, off = wgid / NXCD; wgid = (xcd < r ? xcd * (q + 1) : r * (q + 1) + (xcd - r) * q) + off; }
        const int nig = WGM * nN, gid = wgid / nig, fm = gid * WGM, gsz = (nM - fm) < WGM ? (nM - fm) : WGM;
        u.pm = fm + ((wgid % nig) % gsz); u.pn = (wgid % nig) / gsz; return true;
    }
    __device__ __forceinline__ void a_ready(const Unit&) const {}
    __device__ __forceinline__ void done(const Unit&) const {}
};
__device__ __forceinline__ unsigned cvt_pk_bf16(float lo, float hi) { return ::pack2(lo, hi); }
template <class Epi, class Sched, bool STAMP = false>
__device__ __forceinline__ void gemm_phase(PG8_LAS unsigned char* lds, const Gemm g, const Sched& S, const Epi& E, unsigned long long* stamps) {
    const int tid = ::opq(threadIdx.x), wid = __builtin_amdgcn_readfirstlane(tid >> 6), lane = tid & 63, wr = wid >> 2, wc = wid & 3, fr = lane & 15, fq = lane >> 4;
    const int K = g.K, nt = K / BK;
    int ts_lo = 0, ts_hi = 0, nts = 0; const unsigned long long rt_entry = 0ull;
#define PG8_STAMP() do { if (STAMP && wid == 0 && nts < 64) { const unsigned long long _c = (unsigned long long)clock64(); \
        ts_lo = (lane == nts) ? (int)(unsigned)_c : ts_lo; ts_hi = (lane == nts) ? (int)(unsigned)(_c >> 32) : ts_hi; ++nts; } } while (0)
    PG8_STAMP();
    unsigned voffA[2], voffB[2];
#pragma unroll
    for (int i = 0; i < 2; ++i) { int R, C; stage_rc(tid * 16 + i * 8192, R, C); const int Rb = Epi::PERM ? ((R & ~31) + perm32(R & 31)) : R;
        voffA[i] = (unsigned)(R * g.lda + C) * 2u; voffB[i] = (unsigned)(Rb * g.ldb + C) * 2u; }
    const size_t kstep = (size_t)(BK * 2);
    const size_t hstep = (size_t)HALF * g.ldb * 2;
    const size_t tstep = 2 * hstep; const size_t hstepA = (size_t)HALF * g.lda * 2; const size_t tstepA = 2 * hstepA;
    const unsigned ldsw = (unsigned)wid * 1024u;
    const int aoff = lds_byte(wr * 64 + fr, fq * 8), boff = lds_byte(wc * 32 + fr, fq * 8);
#define PG8_SA(b, h) (((b) * 2 + (h)) * HTB)
#define PG8_SB(b, h) ((4 + (b) * 2 + (h)) * HTB)
#define PG8_STAGE(bufoff, gbase, voff) do { _Pragma("unroll") for (int _i = 0; _i < 2; ++_i) \
        __builtin_amdgcn_global_load_lds((const unsigned*)((const char*)(gbase) + (voff)[_i]), (PG8_LAS unsigned*)(lds + (bufoff) + ldsw + _i * 8192), 16, 0, 0); } while (0)
#define PG8_LDA(dst, b, h) do { _Pragma("unroll") for (int m = 0; m < 4; ++m) _Pragma("unroll") for (int k = 0; k < 2; ++k) dst[m][k] = *(const PG8_LAS bf16x8*)(lds + PG8_SA(b, h) + aoff + m * 2048 + k * 1024); } while (0)
#define PG8_LDB(dst, b, h) do { _Pragma("unroll") for (int n = 0; n < 2; ++n) _Pragma("unroll") for (int k = 0; k < 2; ++k) dst[n][k] = *(const PG8_LAS bf16x8*)(lds + PG8_SB(b, h) + boff + n * 2048 + k * 1024); } while (0)
#define PG8_MMA(ai, bj, At, Bt) do { __builtin_amdgcn_s_setprio(1); _Pragma("unroll") for (int m = 0; m < 4; ++m) _Pragma("unroll") for (int n = 0; n < 2; ++n) _Pragma("unroll") for (int k = 0; k < 2; ++k) \
        acc[ai][bj][m][n] = __builtin_amdgcn_mfma_f32_16x16x32_bf16(Bt[n][k], At[m][k], acc[ai][bj][m][n], 0, 0, 0); __builtin_amdgcn_s_setprio(0); } while (0)
#define PG8_WAIT_V(n) asm volatile("s_waitcnt vmcnt(" #n ")" ::: "memory")
#define PG8_WAIT_L(n) asm volatile("s_waitcnt lgkmcnt(" #n ")" ::: "memory")
#define PG8_BAR __builtin_amdgcn_s_barrier()
#define PG8_SCHED __builtin_amdgcn_sched_barrier(0)
    Unit cur, nxt; int ui = 0;
    if (!S.next(0, cur)) return;
    f32x4 acc[2][2][4][2];
#pragma unroll
    for (int a = 0; a < 2; ++a)
#pragma unroll
        for (int b = 0; b < 2; ++b)
#pragma unroll
            for (int m = 0; m < 4; ++m)
#pragma unroll
                for (int n = 0; n < 2; ++n) acc[a][b][m][n] = (f32x4){0.f, 0.f, 0.f, 0.f};
    bf16x8 At[4][2], B0[2][2], B1[2][2];
    const char* cA = (const char*)g.A + (size_t)cur.pm * tstepA; const char* cB = (const char*)g.Bt + (size_t)cur.pn * tstep;
    S.a_ready(cur);
    PG8_STAGE(PG8_SB(0, 0), cB, voffB); PG8_STAGE(PG8_SA(0, 0), cA, voffA); PG8_STAGE(PG8_SB(0, 1), cB + hstep, voffB); PG8_STAGE(PG8_SA(0, 1), cA + hstepA, voffA);
    if (wr == 1) PG8_BAR;
    PG8_WAIT_V(4); PG8_BAR;
    PG8_STAGE(PG8_SB(1, 0), cB + kstep, voffB); PG8_STAGE(PG8_SA(1, 0), cA + kstep, voffA); PG8_STAGE(PG8_SB(1, 1), cB + hstep + kstep, voffB);
    PG8_WAIT_V(6); PG8_BAR;
    PG8_STAMP();
    for (;;) {
        const bool has_next = S.next(ui + 1, nxt);
        const char* nA = has_next ? (const char*)g.A + (size_t)nxt.pm * tstepA : cA; const char* nB = has_next ? (const char*)g.Bt + (size_t)nxt.pn * tstep : cB;
        for (int t = 0; t < nt; t += 2) {
            const bool last = (t == nt - 2);
            const char* a1 = cA + (size_t)(t + 1) * kstep;
            const char* a2 = last ? nA : cA + (size_t)(t + 2) * kstep; const char* b2 = last ? nB : cB + (size_t)(t + 2) * kstep;
            const char* a3 = a2 + kstep; const char* b3 = b2 + kstep;
            if (last && has_next) S.a_ready(nxt);
            PG8_LDB(B0, 0, 0); PG8_SCHED; PG8_LDA(At, 0, 0); PG8_STAGE(PG8_SA(1, 1), a1 + hstepA, voffA);
            PG8_WAIT_L(8); PG8_BAR; PG8_WAIT_L(0); PG8_MMA(0, 0, At, B0); PG8_BAR; PG8_SCHED;
            PG8_LDB(B1, 0, 1); PG8_STAGE(PG8_SB(0, 0), b2, voffB);
            PG8_BAR; PG8_WAIT_L(0); PG8_MMA(0, 1, At, B1); PG8_BAR;
            PG8_LDA(At, 0, 1); PG8_STAGE(PG8_SA(0, 0), a2, voffA);
            PG8_BAR; PG8_WAIT_L(0); PG8_MMA(1, 0, At, B0); PG8_BAR; PG8_SCHED;
            PG8_STAGE(PG8_SB(0, 1), b2 + hstep, voffB);
            PG8_WAIT_V(6); PG8_BAR; PG8_MMA(1, 1, At, B1); PG8_BAR;
            PG8_LDB(B0, 1, 0); PG8_SCHED; PG8_LDA(At, 1, 0); PG8_STAGE(PG8_SA(0, 1), a2 + hstepA, voffA);
            PG8_WAIT_L(8); PG8_BAR; PG8_WAIT_L(0); PG8_MMA(0, 0, At, B0); PG8_BAR; PG8_SCHED;
            PG8_LDB(B1, 1, 1); PG8_STAGE(PG8_SB(1, 0), b3, voffB);
            PG8_BAR; PG8_WAIT_L(0); PG8_MMA(0, 1, At, B1); PG8_BAR;
            PG8_LDA(At, 1, 1); PG8_STAGE(PG8_SA(1, 0), a3, voffA);
            PG8_BAR; PG8_WAIT_L(0); PG8_MMA(1, 0, At, B0); PG8_BAR; PG8_SCHED;
            PG8_STAGE(PG8_SB(1, 1), b3 + hstep, voffB);
            PG8_WAIT_V(6); PG8_BAR; PG8_MMA(1, 1, At, B1); PG8_BAR;
        }
        PG8_STAMP();
        if constexpr (!Epi::AFTER_DRAIN) { E(acc, cur, wr, wc, fr, fq); S.done(cur); }
        PG8_STAMP();
        if (!has_next) break;
#pragma unroll
        for (int a = 0; a < 2; ++a)
#pragma unroll
            for (int b = 0; b < 2; ++b)
#pragma unroll
                for (int m = 0; m < 4; ++m)
#pragma unroll
                    for (int n = 0; n < 2; ++n) acc[a][b][m][n] = (f32x4){0.f, 0.f, 0.f, 0.f};
        cur = nxt; cA = nA; cB = nB; ++ui;
    }
    PG8_WAIT_V(0);
    if (wr == 0) PG8_BAR;
    PG8_BAR;
    if constexpr (Epi::AFTER_DRAIN) { E.fused(acc, cur, wr, wc, fr, fq, lds, wid, lane); S.done(cur); }
    PG8_STAMP();
    if (STAMP && wid == 0) { stamps[lane] = lane < nts ? (((unsigned long long)(unsigned)ts_hi << 32) | (unsigned)ts_lo) : 0ull;
        if (lane == 62) stamps[62] = rt_entry; if (lane == 63) stamps[63] = (unsigned long long)wall_clock64(); }
#undef PG8_STAMP
#undef PG8_SA
#undef PG8_SB
#undef PG8_STAGE
#undef PG8_LDA
#undef PG8_LDB
#undef PG8_MMA
#undef PG8_WAIT_V
#undef PG8_WAIT_L
#undef PG8_BAR
#undef PG8_SCHED
}
}
using pg8::f32x4;
#define ROWOFF(reg, h) (((reg) & 3) + 8 * ((reg) >> 2) + 4 * (h))

__device__ __forceinline__ void conv_tile(const float* __restrict__ src, int K, int N, u16* __restrict__ dst, int k0, int n0, int sn0, float* lds) {
  const int tid = opq(threadIdx.x);
  __syncthreads();
  {
    const int k = tid >> 3, c = (tid & 7) * 8;
    const float* s = src + (size_t)(k0 + k) * N + sn0 + c;
    float4 a = *(const float4*)s, b = *(const float4*)(s + 4);
    float* d = lds + k * 65 + c;
    d[0] = a.x; d[1] = a.y; d[2] = a.z; d[3] = a.w;
    d[4] = b.x; d[5] = b.y; d[6] = b.z; d[7] = b.w;
  }
  __syncthreads();
  {
    const int n = tid >> 3, kk = (tid & 7) * 8;
    float f[8];
#pragma unroll
    for (int i = 0; i < 8; ++i) f[i] = lds[(kk + i) * 65 + n];
    *(uint4*)(dst + (size_t)(n0 + n) * K + k0 + kk) = pack8(f);
  }
}

__device__ __forceinline__ void phase_prep(const Params& p, int l, int which, float* ldsf) {
  u16* WtA = (u16*)(p.ws + WS_WT);
  u16* WtF = (u16*)(p.ws + WS_WTF);
  u16* H = (u16*)(p.ws + WS_H);
  float* X = p.out;
  const int nconv = which == 0 ? (640 + 512 + 128 + 128 + 256) : (1408 + 704);
  const int ntot = nconv + 2112;
  const float* gw = (which == 0 ? p.in[7] : p.in[24]) + l * 1024;
  for (int it = blockIdx.x; it < ntot; it += gridDim.x) {
    if (it < nconv) {
      int t = it;
      if (which == 0) {
        if (t < 640) { const int tk = t / 40, tn = t % 40; conv_tile(p.in[8] + (size_t)l * 1024 * 4608, 1024, 4608, WtA + WT_IN, tk * 64, tn * 64, tn * 64, ldsf); }
        else if ((t -= 640) < 512) {
          const int tk = t / 32, tn = t % 32; const int n0 = tn * 64;
          const int sn0 = 2560 + ((n0 >> 7) & 1) * 1024 + (n0 >> 8) * 128 + (n0 & 127);
          conv_tile(p.in[8] + (size_t)l * 1024 * 4608, 1024, 4608, WtA + WT_G, tk * 64, n0, sn0, ldsf);
        }
        else if ((t -= 512) < 128) { const int tk = t / 16, tn = t % 16; conv_tile(p.in[21] + (size_t)l * 512 * 1024, 512, 1024, WtA + WT_BRA, tk * 64, tn * 64, tn * 64, ldsf); }
        else if ((t -= 128) < 128) { const int tk = t / 16, tn = t % 16; conv_tile(p.in[22] + (size_t)l * 512 * 1024, 512, 1024, WtA + WT_BRB, tk * 64, tn * 64, tn * 64, ldsf); }
        else { t -= 128; const int tk = t / 16, tn = t % 16; conv_tile(p.in[23] + (size_t)l * 1024 * 1024, 1024, 1024, WtA + WT_OUT, tk * 64, tn * 64, tn * 64, ldsf); }
      } else {
        if (t < 1408) {
          const int tk = t / 88, tn = t % 88; const int n0 = tn * 64;
          const int sn0 = ((n0 >> 7) & 1) * 2816 + (n0 >> 8) * 128 + (n0 & 127);
          conv_tile(p.in[25] + (size_t)l * 1024 * 5632, 1024, 5632, WtF + WT_FIN, tk * 64, n0, sn0, ldsf);
        } else { t -= 1408; const int tk = t / 16, tn = t % 16; conv_tile(p.in[28] + (size_t)l * 2816 * 1024, 2816, 1024, WtF + WT_FDN, tk * 64, tn * 64, tn * 64, ldsf); }
      }
    } else {
      const int tid = opq(threadIdx.x);
      const int row = (it - nconv) * 8 + (tid >> 6);
      const int lane = tid & 63;
      const bool first = (which == 0 && l == 0);
      const float* src;
      if (first) src = (row < M_P) ? p.in[0] + (size_t)row * 1024 : p.in[1] + (size_t)(row - M_P) * 1024;
      else src = X + (size_t)row * 1024;
      float4 v[4];
      float ss = 0.f;
      const int nsl = (gridDim.x == 256 && row >= M_P && !first) ? (which == 1 ? 4 : 11) : 0;
      const float* part = (const float*)(p.ws + WS_T1) + (size_t)(row - M_P) * 1024;
      const u16* partb = (const u16*)(p.ws + WS_DP) + (size_t)(row - M_P) * 1024;
#pragma unroll
      for (int i = 0; i < 4; ++i) {
        v[i] = *(const float4*)(src + i * 256 + lane * 4);
        for (int k = 0; k < nsl; ++k) {
          if (which == 1) {
            const float4 q = *(const float4*)(part + (size_t)k * 512 * 1024 + i * 256 + lane * 4);
            v[i].x += q.x; v[i].y += q.y; v[i].z += q.z; v[i].w += q.w;
          } else {
            const uint2 q = *(const uint2*)(partb + (size_t)k * 512 * 1024 + i * 256 + lane * 4);
            v[i].x += __uint_as_float(q.x << 16); v[i].y += __uint_as_float(q.x & 0xFFFF0000u); v[i].z += __uint_as_float(q.y << 16); v[i].w += __uint_as_float(q.y & 0xFFFF0000u);
          }
        }
        ss += v[i].x * v[i].x + v[i].y * v[i].y + v[i].z * v[i].z + v[i].w * v[i].w;
        if (first || nsl) *(float4*)(X + (size_t)row * 1024 + i * 256 + lane * 4) = v[i];
      }
      ss = wave_sum(ss);
      const float rs = rsqrtf(ss * (1.f / 1024.f) + 1e-6f);
#pragma unroll
      for (int i = 0; i < 4; ++i) {
        const float4 g = *(const float4*)(gw + i * 256 + lane * 4);
        uint2 o; o.x = pack2(v[i].x * rs * g.x, v[i].y * rs * g.y); o.y = pack2(v[i].z * rs * g.z, v[i].w * rs * g.w);
        *(uint2*)(H + (size_t)row * 1024 + i * 256 + lane * 4) = o;
      }
    }
  }
}

struct EpiInproj {
  static constexpr bool PERM = true, AFTER_DRAIN = false;
  u16* z; float* out; int l;
  __device__ __forceinline__ void operator()(const f32x4 (&acc)[2][2][4][2], const pg8::Unit& u, int wr, int wc, int fr, int fq) const {
    const int row0 = u.pm * 256 + wr * 64 + fr, col0 = u.pn * 256 + wc * 32 + 8 * fq;
#pragma unroll
    for (int ai = 0; ai < 2; ++ai)
#pragma unroll
      for (int m = 0; m < 4; ++m) {
        const int row = row0 + ai * 128 + m * 16;
        u16* rowp = z + (size_t)row * ZLD + col0;
#pragma unroll
        for (int bj = 0; bj < 2; ++bj) {
          const f32x4 v0 = acc[ai][bj][m][0], v1 = acc[ai][bj][m][1];
          pg8::u32x4 w; w.x = pg8::cvt_pk_bf16(v0[0], v0[1]); w.y = pg8::cvt_pk_bf16(v0[2], v0[3]); w.z = pg8::cvt_pk_bf16(v1[0], v1[1]); w.w = pg8::cvt_pk_bf16(v1[2], v1[3]);
          *(pg8::u32x4*)(rowp + bj * 128) = w;
        }
        const bool prompt = row < M_P;
        int b, t;
        if (prompt) { b = row >> 13; t = row & 8191; } else { b = (row - M_P) >> 2; t = (row - M_P) & 3; }
        if (u.pn < 7) {
          if ((prompt && t == 8191) || (!prompt && t == 3)) {
            float* o = out + (prompt ? O_PSHIFT + (size_t)(l * 2 + b) * 1792 : O_SSHIFT + (size_t)(l * 128 + b) * 1792) + col0;
#pragma unroll
            for (int bj = 0; bj < 2; ++bj) { *(f32x4*)(o + bj * 128) = acc[ai][bj][m][0]; *(f32x4*)(o + bj * 128 + 4) = acc[ai][bj][m][1]; }
          }
        } else if (u.pn == 9 && prompt && t >= 8064) {
          const int c = wc * 32 + 8 * fq;
          float* o = out + O_PV + ((size_t)((l * 2 + b) * 128 + (t - 8064)) * 2 + (c >> 6)) * 64 + (c & 63);
          *(f32x4*)o = acc[ai][1][m][0]; *(f32x4*)(o + 4) = acc[ai][1][m][1];
        }
      }
  }
};
struct EpiStoreBf16 {
  static constexpr bool PERM = true, AFTER_DRAIN = false;
  u16* O; int ldc;
  __device__ __forceinline__ void operator()(const f32x4 (&acc)[2][2][4][2], const pg8::Unit& u, int wr, int wc, int fr, int fq) const {
    const int row0 = u.pm * 256 + wr * 64 + fr, col0 = u.pn * 256 + wc * 32 + 8 * fq;
#pragma unroll
    for (int ai = 0; ai < 2; ++ai)
#pragma unroll
      for (int m = 0; m < 4; ++m) {
        u16* rowp = O + (size_t)(row0 + ai * 128 + m * 16) * ldc + col0;
#pragma unroll
        for (int bj = 0; bj < 2; ++bj) {
          const f32x4 v0 = acc[ai][bj][m][0], v1 = acc[ai][bj][m][1];
          pg8::u32x4 w; w.x = pg8::cvt_pk_bf16(v0[0], v0[1]); w.y = pg8::cvt_pk_bf16(v0[2], v0[3]); w.z = pg8::cvt_pk_bf16(v1[0], v1[1]); w.w = pg8::cvt_pk_bf16(v1[2], v1[3]);
          *(pg8::u32x4*)(rowp + bj * 128) = w;
        }
      }
  }
};
struct EpiFfnIn {
  static constexpr bool PERM = true, AFTER_DRAIN = false;
  u16* cu;
  __device__ __forceinline__ void operator()(const f32x4 (&acc)[2][2][4][2], const pg8::Unit& u, int wr, int wc, int fr, int fq) const {
    const int row0 = u.pm * 256 + wr * 64 + fr, col0 = u.pn * 128 + wc * 32 + 8 * fq;
#pragma unroll
    for (int ai = 0; ai < 2; ++ai)
#pragma unroll
      for (int m = 0; m < 4; ++m) {
        u16* rowp = cu + (size_t)(row0 + ai * 128 + m * 16) * 5632 + col0;
#pragma unroll
        for (int bj = 0; bj < 2; ++bj) {
          const f32x4 v0 = acc[ai][bj][m][0], v1 = acc[ai][bj][m][1];
          pg8::u32x4 w; w.x = pg8::cvt_pk_bf16(v0[0], v0[1]); w.y = pg8::cvt_pk_bf16(v0[2], v0[3]); w.z = pg8::cvt_pk_bf16(v1[0], v1[1]); w.w = pg8::cvt_pk_bf16(v1[2], v1[3]);
          *(pg8::u32x4*)(rowp + bj * 2816) = w;
        }
      }
  }
};
struct EpiMerge {
  static constexpr bool PERM = true, AFTER_DRAIN = false;
  const u16* t1; const u16* t2; u16* mg;
  __device__ __forceinline__ void operator()(const f32x4 (&acc)[2][2][4][2], const pg8::Unit& u, int wr, int wc, int fr, int fq) const {
    const int row0 = u.pm * 256 + wr * 64 + fr, col0 = u.pn * 128 + wc * 32 + 8 * fq;
#pragma unroll
    for (int ai = 0; ai < 2; ++ai)
#pragma unroll
      for (int m = 0; m < 4; ++m) {
        const size_t off = (size_t)(row0 + ai * 128 + m * 16) * 1024 + col0;
        float a[8], b[8], o[8];
        unpack8(*(const uint4*)(t1 + off), a);
        unpack8(*(const uint4*)(t2 + off), b);
#pragma unroll
        for (int n = 0; n < 2; ++n)
#pragma unroll
          for (int j = 0; j < 4; ++j)
            o[n * 4 + j] = sigm(acc[ai][0][m][n][j]) * a[n * 4 + j] + sigm(acc[ai][1][m][n][j]) * b[n * 4 + j];
        *(uint4*)(mg + off) = pack8(o);
        asm volatile("" ::: "memory");
      }
  }
};
struct EpiResid {
  static constexpr bool PERM = false, AFTER_DRAIN = false;
  float* X; bool dry; bool atomic; int rowoff; u16* pbf;
  __device__ __forceinline__ void operator()(const f32x4 (&acc)[2][2][4][2], const pg8::Unit& u, int wr, int wc, int fr, int fq) const {
    const int row0 = rowoff + u.pm * 256 + wr * 64 + fr, col0 = u.pn * 256 + wc * 32 + 4 * fq;
#pragma unroll
    for (int ai = 0; ai < 2; ++ai)
#pragma unroll
      for (int m = 0; m < 4; ++m) {
        float* rowp = X + (size_t)(row0 + ai * 128 + m * 16) * 1024 + col0;
#pragma unroll
        for (int bj = 0; bj < 2; ++bj)
#pragma unroll
          for (int n = 0; n < 2; ++n) {
            f32x4* q = (f32x4*)(rowp + bj * 128 + n * 16);
            if (atomic) {
              if (pbf) {
                uint2 o; o.x = pack2(acc[ai][bj][m][n][0], acc[ai][bj][m][n][1]); o.y = pack2(acc[ai][bj][m][n][2], acc[ai][bj][m][n][3]);
                *(uint2*)(pbf + ((float*)q - X)) = o;
              } else *q = acc[ai][bj][m][n];
            } else { const f32x4 v_ = *q + acc[ai][bj][m][n]; if (!dry) *q = v_; }
          }
        asm volatile("" ::: "memory");
      }
  }
};
template <class Epi>
__device__ __forceinline__ void run_gemm_ex(unsigned char* lds_raw, const u16* A, int lda, const u16* Bt, int ldb, int M, int N, int K, int G, int c, const Epi& E) {
  if (c < 0) return;
  pg8::Gemm g; g.A = A; g.Bt = Bt; g.M = M; g.N = N; g.K = K; g.lda = lda; g.ldb = ldb;
  pg8::StaticOrder S; S.init(M, N, G, c);
  __syncthreads();
  pg8::gemm_phase<Epi, pg8::StaticOrder, false>((PG8_LAS unsigned char*)lds_raw, g, S, E, nullptr);
  __syncthreads();
}
template <class Epi>
__device__ __forceinline__ void run_gemm(unsigned char* lds_raw, const u16* A, int lda, const u16* Bt, int N, int K, const Epi& E) {
  pg8::Gemm g; g.A = A; g.Bt = Bt; g.M = M_TOT; g.N = N; g.K = K; g.lda = lda; g.ldb = K;
  pg8::StaticOrder S; S.init(M_TOT, N, gridDim.x, blockIdx.x);
  __syncthreads();
  pg8::gemm_phase<Epi, pg8::StaticOrder, false>((PG8_LAS unsigned char*)lds_raw, g, S, E, nullptr);
  __syncthreads();
}

__device__ __forceinline__ void rope_item(const Params& p, int l, int item, bool dry = false) {
  const int tid = opq(threadIdx.x);
  u16* z = (u16*)(p.ws + WS_Z);
  const int row = item * 64 + (tid >> 3);
  const int d0 = (tid & 7) * 4;
  const bool prompt = row < M_P;
  int b, t, pos;
  if (prompt) { b = row >> 13; t = row & 8191; pos = t; } else { b = (row - M_P) >> 2; t = (row - M_P) & 3; pos = 16384 + t; }
  float cs[4], sn[4];
#pragma unroll
  for (int i = 0; i < 4; ++i) {
    const float inv = __expf(-(float)(d0 + i) * (9.210340371976184f / 32.f));
    const float angf = (float)pos * inv;
    double a = (double)angf;
    a -= 6.283185307179586 * rint(a * 0.15915494309189535);
    const float af = (float)a;
    sn[i] = __sinf(af); cs[i] = __cosf(af);
  }
#pragma unroll 2
  for (int hh = 0; hh < 10; ++hh) {
    u16* q = z + (size_t)row * ZLD + 1792 + hh * 64 + d0;
    const uint2 lo = *(const uint2*)q, hi = *(const uint2*)(q + 32);
    float x1[4] = {__uint_as_float(lo.x << 16), __uint_as_float(lo.x & 0xFFFF0000u), __uint_as_float(lo.y << 16), __uint_as_float(lo.y & 0xFFFF0000u)};
    float x2[4] = {__uint_as_float(hi.x << 16), __uint_as_float(hi.x & 0xFFFF0000u), __uint_as_float(hi.y << 16), __uint_as_float(hi.y & 0xFFFF0000u)};
    float y1[4], y2[4];
#pragma unroll
    for (int i = 0; i < 4; ++i) { y1[i] = x1[i] * cs[i] - x2[i] * sn[i]; y2[i] = x2[i] * cs[i] + x1[i] * sn[i]; }
    uint2 o1, o2;
    o1.x = pack2(y1[0], y1[1]); o1.y = pack2(y1[2], y1[3]); o2.x = pack2(y2[0], y2[1]); o2.y = pack2(y2[2], y2[3]);
    if (!dry) { *(uint2*)q = o1; *(uint2*)(q + 32) = o2; }
    if (hh >= 8 && prompt && t >= 8064) {
      float* o = p.out + O_PK + ((size_t)((l * 2 + b) * 128 + (t - 8064)) * 2 + (hh - 8)) * 64 + d0;
      *(float4*)o = make_float4(y1[0], y1[1], y1[2], y1[3]);
      *(float4*)(o + 32) = make_float4(y2[0], y2[1], y2[2], y2[3]);
    }
  }
}

#define SL(i) (ldsf + (i) * 4160)
__device__ __forceinline__ void rwkv_item(const Params& p, int l, int item, float* ldsf, bool dry = false) {
  const int tid = opq(threadIdx.x), lane = tid & 63, wave = tid >> 6;
  const bool sample = item >= 2048;
  int h, cidx, rowbase;
  if (!sample) { h = item & 7; cidx = item >> 3; rowbase = cidx * 64; }
  else { int s = item - 2048; h = s & 7; cidx = s >> 3; rowbase = M_P + cidx * 64; }
  const int cc = cidx & 127;
  const u16* z = (const u16*)(p.ws + WS_Z);
  u16* zw_ = (u16*)(p.ws + WS_Z);
  const float* mu = p.in[9] + l * 1792;
  float* wbuf = SL(7);
  float* gc = ldsf + 9 * 4160;
  float* bd = ldsf + 9 * 4160 + 64;
  __syncthreads();
  {
    const int t = tid >> 3, c8 = (tid & 7) * 8;
    const int m = rowbase + t;
    const int zcs[7] = {h * 64, 512 + h * 64, 1024 + h * 64, 1536, 1600, 1664, 1728};
#pragma unroll
    for (int gi = 0; gi < 7; ++gi) {
      const int zc = zcs[gi] + c8;
      float cur[8], prv[8];
      unpack8(*(const uint4*)(z + (size_t)m * ZLD + zc), cur);
      bool zero = false, fromstate = false;
      if (!sample) zero = (t == 0 && cc == 0);
      else fromstate = ((t & 3) == 0);
      if (zero) {
#pragma unroll
        for (int i = 0; i < 8; ++i) prv[i] = 0.f;
      } else if (fromstate) {
        const int b = (m - M_P) >> 2;
        const float* sp = p.in[2] + (size_t)(l * 128 + b) * 1792 + zc;
        float4 a = *(const float4*)sp, bb = *(const float4*)(sp + 4);
        prv[0] = a.x; prv[1] = a.y; prv[2] = a.z; prv[3] = a.w; prv[4] = bb.x; prv[5] = bb.y; prv[6] = bb.z; prv[7] = bb.w;
      } else {
        unpack8(*(const uint4*)(z + (size_t)(m - 1) * ZLD + zc), prv);
      }
      float* d = SL(gi) + t * 65 + c8;
#pragma unroll
      for (int i = 0; i < 8; ++i) {
        float v = cur[i] + mu[zc + i] * (prv[i] - cur[i]);
        if (gi == 3) v = tanhf(v);
        if (gi >= 5) v = sigm(v);
        d[i] = v;
      }
    }
  }
  const int lt = tid & 63, jg = tid >> 6;
  auto load_w = [&](const float* W, int nrows) {
    for (int e = tid; e < nrows * 8; e += NT) {
      const int i = e >> 3, c = (e & 7) * 8;
      const float* s = W + (size_t)i * 512 + h * 64 + c;
      *(float4*)(wbuf + i * 64 + c) = *(const float4*)s;
      *(float4*)(wbuf + i * 64 + c + 4) = *(const float4*)(s + 4);
    }
  };
  auto lora = [&](const float* xa, const float* xb, int n, float* acc) {
#pragma unroll 2
    for (int i = 0; i < n; ++i) {
      const float x = (i < 64) ? xa[lt * 65 + i] : xb[lt * 65 + i - 64];
      const float4 w0 = *(const float4*)(wbuf + i * 64 + jg * 8);
      const float4 w1 = *(const float4*)(wbuf + i * 64 + jg * 8 + 4);
      acc[0] += x * w0.x; acc[1] += x * w0.y; acc[2] += x * w0.z; acc[3] += x * w0.w;
      acc[4] += x * w1.x; acc[5] += x * w1.y; acc[6] += x * w1.z; acc[7] += x * w1.w;
    }
  };
  float res[8];
  load_w(p.in[11] + (size_t)l * 64 * 512, 64);
  __syncthreads();
#pragma unroll
  for (int i = 0; i < 8; ++i) res[i] = p.in[10][l * 512 + h * 64 + jg * 8 + i];
  lora(SL(3), SL(3), 64, res);
  __syncthreads();
#pragma unroll
  for (int i = 0; i < 8; ++i) {
    const float x = -res[i];
    const float sp = (x > 20.f) ? x : log1pf(__expf(x));
    SL(3)[lt * 65 + jg * 8 + i] = -__expf(-sp - 0.5f);
  }
  load_w(p.in[13] + (size_t)l * 64 * 512, 64);
  __syncthreads();
#pragma unroll
  for (int i = 0; i < 8; ++i) res[i] = p.in[12][l * 512 + h * 64 + jg * 8 + i];
  lora(SL(4), SL(4), 64, res);
  __syncthreads();
#pragma unroll
  for (int i = 0; i < 8; ++i) SL(4)[lt * 65 + jg * 8 + i] = sigm(res[i]);
  load_w(p.in[14] + (size_t)l * 128 * 512, 128);
  __syncthreads();
#pragma unroll
  for (int i = 0; i < 8; ++i) res[i] = 0.f;
  lora(SL(5), SL(6), 128, res);
  __syncthreads();
  if (!sample) {
    u16* ga = (u16*)(p.ws + WS_GA) + (size_t)item * 4096;
    *(uint4*)(ga + lt * 64 + jg * 8) = pack8(res);
    if (tid < 64) {
      float c = 0.f;
      for (int t = 0; t < 64; ++t) { c += SL(3)[t * 65 + tid]; SL(5)[t * 65 + tid] = c; }
      gc[tid] = __expf(c);
    }
  } else {
#pragma unroll
    for (int i = 0; i < 8; ++i) SL(6)[lt * 65 + jg * 8 + i] = res[i];
  }
  __syncthreads();
  {
    const int t = tid >> 3, j0 = (tid & 7) * 8;
    const float* kkw = p.in[15] + l * 512 + h * 64;
    const float* kaw = p.in[16] + l * 512 + h * 64;
    const float* rkw = p.in[17] + l * 512 + h * 64;
    float kr[8], av[8], rv[8], kkv[8], kf[8];
    float nrm = 0.f, bdot = 0.f;
#pragma unroll
    for (int i = 0; i < 8; ++i) {
      const int j = j0 + i;
      kr[i] = SL(1)[t * 65 + j]; av[i] = SL(4)[t * 65 + j]; rv[i] = SL(0)[t * 65 + j];
      kkv[i] = kr[i] * kkw[j];
      nrm += kkv[i] * kkv[i];
      kf[i] = kr[i] * (1.f + (av[i] - 1.f) * kaw[j]);
      bdot += rv[i] * kf[i] * rkw[j];
    }
    nrm += __shfl_xor(nrm, 1, 64); nrm += __shfl_xor(nrm, 2, 64); nrm += __shfl_xor(nrm, 4, 64);
    bdot += __shfl_xor(bdot, 1, 64); bdot += __shfl_xor(bdot, 2, 64); bdot += __shfl_xor(bdot, 4, 64);
    const float rn = 1.f / fmaxf(sqrtf(nrm), 1e-12f);
    if (!sample) {
      float bo[8];
#pragma unroll
      for (int i = 0; i < 8; ++i) {
        const int j = j0 + i;
        const float cum = SL(5)[t * 65 + j], dl = SL(3)[t * 65 + j];
        const float eg = __expf(cum), egi = __expf(-cum), egp = __expf(cum - dl);
        const float kk = kkv[i] * rn;
        SL(0)[t * 65 + j] = rv[i] * eg;
        SL(1)[t * 65 + j] = kf[i] * egi;
        SL(3)[t * 65 + j] = kk * av[i] * egi;
        SL(4)[t * 65 + j] = kk * egp;
        bo[i] = bdot * SL(2)[t * 65 + j];
      }
      u16* bop = (u16*)(p.ws + WS_BO) + (size_t)item * 4096;
      *(uint4*)(bop + t * 64 + j0) = pack8(bo);
    } else {
#pragma unroll
      for (int i = 0; i < 8; ++i) {
        const int j = j0 + i;
        const float kk = kkv[i] * rn;
        const float dl = SL(3)[t * 65 + j];
        SL(1)[t * 65 + j] = kf[i];
        SL(3)[t * 65 + j] = __expf(dl);
        SL(4)[t * 65 + j] = kk;
        SL(5)[t * 65 + j] = kk * av[i];
      }
      if ((tid & 7) == 0) bd[t] = bdot;
    }
  }
  __syncthreads();
  if (sample) {
    const float lng = p.in[18][l * 512 + h * 64 + lane], lnb = p.in[19][l * 512 + h * 64 + lane];
    for (int round = 0; round < 2; ++round) {
      const int seq = wave + 8 * round;
      const int b = cidx * 16 + seq;
      float S[64];
      const float* sp = p.in[3] + ((size_t)((l * 128 + b) * 8 + h) * 64 + lane) * 64;
#pragma unroll
      for (int k = 0; k < 64; k += 4) { float4 v = *(const float4*)(sp + k); S[k] = v.x; S[k + 1] = v.y; S[k + 2] = v.z; S[k + 3] = v.w; }
      for (int tt = 0; tt < 4; ++tt) {
        const int t = seq * 4 + tt;
        float sk = 0.f;
#pragma unroll
        for (int kc = 0; kc < 64; kc += 8) {
#pragma unroll
          for (int k = kc; k < kc + 8; ++k) sk += S[k] * SL(4)[t * 65 + k];
          __builtin_amdgcn_sched_barrier(0);
        }
        const float vt = SL(2)[t * 65 + lane];
        float y = 0.f;
#pragma unroll
        for (int kc = 0; kc < 64; kc += 8) {
#pragma unroll
          for (int k = kc; k < kc + 8; ++k) {
            S[k] = S[k] * SL(3)[t * 65 + k] - sk * SL(5)[t * 65 + k] + vt * SL(1)[t * 65 + k];
            y += S[k] * SL(0)[t * 65 + k];
          }
          __builtin_amdgcn_sched_barrier(0);
        }
        const float mean = wave_sum(y) * (1.f / 64.f);
        const float d = y - mean;
        const float var = wave_sum(d * d) * (1.f / 64.f);
        const float yn = d * rsqrtf(var + 64e-5f) * lng + lnb;
        const float o = (yn + bd[t] * vt) * SL(6)[t * 65 + lane];
        if (!dry) zw_[(size_t)(M_P + b * 4 + tt) * ZLD + h * 64 + lane] = f2bf(o);
      }
      float* op = p.out + O_SWKV + ((size_t)((l * 128 + b) * 8 + h) * 64 + lane) * 64;
#pragma unroll
      for (int k = 0; k < 64; k += 4) *(float4*)(op + k) = make_float4(S[k], S[k + 1], S[k + 2], S[k + 3]);
    }
    return;
  }
  {
    const int i = lane, tg = wave;
    float ab[8], ak[8], akr[8], abr[8];
#pragma unroll
    for (int q = 0; q < 8; ++q) { ab[q] = 0.f; ak[q] = 0.f; akr[q] = 0.f; abr[q] = 0.f; }
#pragma unroll 2
    for (int k = 0; k < 64; ++k) {
      const float xb = SL(3)[i * 65 + k], xk = SL(1)[i * 65 + k];
#pragma unroll
      for (int q = 0; q < 8; ++q) {
        const int t = tg * 8 + q;
        const float yk = SL(4)[t * 65 + k], yr = SL(0)[t * 65 + k];
        ab[q] += xb * yk; ak[q] += xk * yk; akr[q] += xk * yr; abr[q] += xb * yr;
      }
    }
    __syncthreads();
#pragma unroll
    for (int q = 0; q < 8; ++q) {
      const int t = tg * 8 + q;
      SL(6)[i * 65 + t] = (i < t) ? ab[q] : 0.f;
      SL(7)[i * 65 + t] = (i < t) ? ak[q] : 0.f;
      SL(8)[i * 65 + t] = (i <= t) ? akr[q] : 0.f;
      SL(5)[i * 65 + t] = (i <= t) ? abr[q] : 0.f;
    }
  }
  __syncthreads();
  {
    const int t = tid >> 3, j0 = (tid & 7) * 8;
#pragma unroll
    for (int i = 0; i < 8; ++i) { const float g = gc[j0 + i]; SL(3)[t * 65 + j0 + i] *= g; SL(1)[t * 65 + j0 + i] *= g; }
  }
  __syncthreads();
  if (tid < 128) {
    float* X_ = (tid < 64) ? SL(5) : SL(3);
    const int col = tid & 63;
    for (int i = 62; i >= 0; --i) {
      float a = X_[i * 65 + col];
#pragma unroll 4
      for (int t = i + 1; t < 64; ++t) a -= SL(6)[i * 65 + t] * X_[t * 65 + col];
      X_[i * 65 + col] = a;
    }
  }
  __syncthreads();
  {
    const int c = tid & 127, ig = tid >> 7;
    const int which = c >> 6, cq = c & 63;
    const float* N_ = which ? SL(3) : SL(5);
    float a[16];
#pragma unroll
    for (int q = 0; q < 16; ++q) a[q] = 0.f;
#pragma unroll 2
    for (int t = 0; t < 64; ++t) {
      const float n = N_[t * 65 + cq];
#pragma unroll
      for (int q = 0; q < 16; ++q) a[q] += SL(7)[(ig * 16 + q) * 65 + t] * n;
    }
    float* T_ = which ? SL(1) : SL(8);
#pragma unroll
    for (int q = 0; q < 16; ++q) T_[(ig * 16 + q) * 65 + cq] -= a[q];
  }
  __syncthreads();
  {
    const int x = lane, yg = wave;
    float w2[8], pp[8], yl[8], qq[8];
#pragma unroll
    for (int q = 0; q < 8; ++q) { w2[q] = 0.f; pp[q] = 0.f; yl[q] = 0.f; qq[q] = 0.f; }
#pragma unroll 2
    for (int j = 0; j < 64; ++j) {
      const float l5 = SL(5)[j * 65 + x], l4 = SL(4)[j * 65 + x], l8 = SL(8)[j * 65 + x], l2 = SL(2)[j * 65 + x];
#pragma unroll
      for (int q = 0; q < 8; ++q) {
        const int y = yg * 8 + q;
        w2[q] += l5 * SL(4)[j * 65 + y];
        pp[q] += l4 * SL(3)[j * 65 + y];
        yl[q] += l8 * SL(2)[j * 65 + y];
        qq[q] += l2 * SL(1)[j * 65 + y];
      }
    }
    float o1[8];
#pragma unroll
    for (int q = 0; q < 8; ++q) {
      const int y = yg * 8 + q;
      o1[q] = SL(0)[x * 65 + y] - w2[q];
    }
    u16* Pf = (u16*)(p.ws + WS_PP) + (size_t)item * 4096;
    float* Qf = (float*)(p.ws + WS_Q) + (size_t)item * 4096;
    if (tid < 64) ((float*)(p.ws + WS_GC))[(size_t)item * 64 + tid] = gc[tid];
    {
      const int s_ = x >> 4, kk = x & 15, hh = (kk >> 2) & 1, jj = ((kk >> 3) << 2) | (kk & 3);
#pragma unroll
      for (int q = 0; q < 8; ++q) {
        const int y = yg * 8 + q;
        Pf[(((y >> 5) * 4 + s_) * 64 + (y & 31) + 32 * hh) * 8 + jj] = f2bf(-pp[q]);
        const int k2 = y & 31, reg = ((k2 >> 3) << 2) | (k2 & 3), h2 = (k2 >> 2) & 1;
        Qf[(((x >> 5) * 2 + (y >> 5)) * 16 + reg) * 64 + (x & 31) + 32 * h2] = qq[q];
      }
    }
    u16* W2p = (u16*)(p.ws + WS_W2) + (size_t)item * 4096 + x * 64 + yg * 8;
    u16* YLp = (u16*)(p.ws + WS_YL) + (size_t)item * 4096 + x * 64 + yg * 8;
    *(uint4*)W2p = pack8(o1);
    *(uint4*)YLp = pack8(yl);
  }
}

__device__ __forceinline__ void mm_tile(const u16* Aop, int lda, const u16* Bop, int ldb, int mt, int nt, int r, int h, int ksteps, f32x16& acc) {
  const u16* ap = Aop + (mt * 32 + r) * lda + h * 8;
  const u16* bp = Bop + (nt * 32 + r) * ldb + h * 8;
#pragma unroll 4
  for (int s = 0; s < ksteps; ++s) {
    const bf16x8 a = *(const bf16x8*)(ap + s * 16);
    const bf16x8 b = *(const bf16x8*)(bp + s * 16);
    acc = __builtin_amdgcn_mfma_f32_32x32x16_bf16(a, b, acc, 0, 0, 0);
  }
}
__device__ __forceinline__ void store_T(u16* T, int ldt, int mt, int nt, int r, int h, const f32x16& acc) {
#pragma unroll
  for (int g = 0; g < 4; ++g) {
    uint2 o; o.x = pack2(acc[4 * g], acc[4 * g + 1]); o.y = pack2(acc[4 * g + 2], acc[4 * g + 3]);
    *(uint2*)(T + (nt * 32 + r) * ldt + mt * 32 + 8 * g + 4 * h) = o;
  }
}
__device__ __forceinline__ void tri32(const float* Ab, float* Xc) {
  float a31 = Xc[2015];
  const float x31 = a31;
  float a30 = Xc[1950];
    { const float4 c_ = *(const float4*)(Ab + 2068);
      a30 -= c_.w * x31;
    }
  const float x30 = a30;
  float a29 = Xc[1885];
    { const float4 c_ = *(const float4*)(Ab + 2000);
      a29 -= c_.z * x30;
      a29 -= c_.w * x31;
    }
  const float x29 = a29;
  float a28 = Xc[1820];
    { const float4 c_ = *(const float4*)(Ab + 1932);
      a28 -= c_.y * x29;
      a28 -= c_.z * x30;
      a28 -= c_.w * x31;
    }
  const float x28 = a28;
  float a27 = Xc[1755];
    { const float4 c_ = *(const float4*)(Ab + 1864);
      a27 -= c_.x * x28;
      a27 -= c_.y * x29;
      a27 -= c_.z * x30;
      a27 -= c_.w * x31;
    }
  const float x27 = a27;
  float a26 = Xc[1690];
    { const float4 c_ = *(const float4*)(Ab + 1792);
      a26 -= c_.w * x27;
    }
    { const float4 c_ = *(const float4*)(Ab + 1796);
      a26 -= c_.x * x28;
      a26 -= c_.y * x29;
      a26 -= c_.z * x30;
      a26 -= c_.w * x31;
    }
  const float x26 = a26;
  float a25 = Xc[1625];
    { const float4 c_ = *(const float4*)(Ab + 1724);
      a25 -= c_.z * x26;
      a25 -= c_.w * x27;
    }
    { const float4 c_ = *(const float4*)(Ab + 1728);
      a25 -= c_.x * x28;
      a25 -= c_.y * x29;
      a25 -= c_.z * x30;
      a25 -= c_.w * x31;
    }
  const float x25 = a25;
  float a24 = Xc[1560];
    { const float4 c_ = *(const float4*)(Ab + 1656);
      a24 -= c_.y * x25;
      a24 -= c_.z * x26;
      a24 -= c_.w * x27;
    }
    { const float4 c_ = *(const float4*)(Ab + 1660);
      a24 -= c_.x * x28;
      a24 -= c_.y * x29;
      a24 -= c_.z * x30;
      a24 -= c_.w * x31;
    }
  const float x24 = a24;
  float a23 = Xc[1495];
    { const float4 c_ = *(const float4*)(Ab + 1588);
      a23 -= c_.x * x24;
      a23 -= c_.y * x25;
      a23 -= c_.z * x26;
      a23 -= c_.w * x27;
    }
    { const float4 c_ = *(const float4*)(Ab + 1592);
      a23 -= c_.x * x28;
      a23 -= c_.y * x29;
      a23 -= c_.z * x30;
      a23 -= c_.w * x31;
    }
  const float x23 = a23;
  float a22 = Xc[1430];
    { const float4 c_ = *(const float4*)(Ab + 1516);
      a22 -= c_.w * x23;
    }
    { const float4 c_ = *(const float4*)(Ab + 1520);
      a22 -= c_.x * x24;
      a22 -= c_.y * x25;
      a22 -= c_.z * x26;
      a22 -= c_.w * x27;
    }
    { const float4 c_ = *(const float4*)(Ab + 1524);
      a22 -= c_.x * x28;
      a22 -= c_.y * x29;
      a22 -= c_.z * x30;
      a22 -= c_.w * x31;
    }
  const float x22 = a22;
  float a21 = Xc[1365];
    { const float4 c_ = *(const float4*)(Ab + 1448);
      a21 -= c_.z * x22;
      a21 -= c_.w * x23;
    }
    { const float4 c_ = *(const float4*)(Ab + 1452);
      a21 -= c_.x * x24;
      a21 -= c_.y * x25;
      a21 -= c_.z * x26;
      a21 -= c_.w * x27;
    }
    { const float4 c_ = *(const float4*)(Ab + 1456);
      a21 -= c_.x * x28;
      a21 -= c_.y * x29;
      a21 -= c_.z * x30;
      a21 -= c_.w * x31;
    }
  const float x21 = a21;
  float a20 = Xc[1300];
    { const float4 c_ = *(const float4*)(Ab + 1380);
      a20 -= c_.y * x21;
      a20 -= c_.z * x22;
      a20 -= c_.w * x23;
    }
    { const float4 c_ = *(const float4*)(Ab + 1384);
      a20 -= c_.x * x24;
      a20 -= c_.y * x25;
      a20 -= c_.z * x26;
      a20 -= c_.w * x27;
    }
    { const float4 c_ = *(const float4*)(Ab + 1388);
      a20 -= c_.x * x28;
      a20 -= c_.y * x29;
      a20 -= c_.z * x30;
      a20 -= c_.w * x31;
    }
  const float x20 = a20;
  float a19 = Xc[1235];
    { const float4 c_ = *(const float4*)(Ab + 1312);
      a19 -= c_.x * x20;
      a19 -= c_.y * x21;
      a19 -= c_.z * x22;
      a19 -= c_.w * x23;
    }
    { const float4 c_ = *(const float4*)(Ab + 1316);
      a19 -= c_.x * x24;
      a19 -= c_.y * x25;
      a19 -= c_.z * x26;
      a19 -= c_.w * x27;
    }
    { const float4 c_ = *(const float4*)(Ab + 1320);
      a19 -= c_.x * x28;
      a19 -= c_.y * x29;
      a19 -= c_.z * x30;
      a19 -= c_.w * x31;
    }
  const float x19 = a19;
  float a18 = Xc[1170];
    { const float4 c_ = *(const float4*)(Ab + 1240);
      a18 -= c_.w * x19;
    }
    { const float4 c_ = *(const float4*)(Ab + 1244);
      a18 -= c_.x * x20;
      a18 -= c_.y * x21;
      a18 -= c_.z * x22;
      a18 -= c_.w * x23;
    }
    { const float4 c_ = *(const float4*)(Ab + 1248);
      a18 -= c_.x * x24;
      a18 -= c_.y * x25;
      a18 -= c_.z * x26;
      a18 -= c_.w * x27;
    }
    { const float4 c_ = *(const float4*)(Ab + 1252);
      a18 -= c_.x * x28;
      a18 -= c_.y * x29;
      a18 -= c_.z * x30;
      a18 -= c_.w * x31;
    }
  const float x18 = a18;
  float a17 = Xc[1105];
    { const float4 c_ = *(const float4*)(Ab + 1172);
      a17 -= c_.z * x18;
      a17 -= c_.w * x19;
    }
    { const float4 c_ = *(const float4*)(Ab + 1176);
      a17 -= c_.x * x20;
      a17 -= c_.y * x21;
      a17 -= c_.z * x22;
      a17 -= c_.w * x23;
    }
    { const float4 c_ = *(const float4*)(Ab + 1180);
      a17 -= c_.x * x24;
      a17 -= c_.y * x25;
      a17 -= c_.z * x26;
      a17 -= c_.w * x27;
    }
    { const float4 c_ = *(const float4*)(Ab + 1184);
      a17 -= c_.x * x28;
      a17 -= c_.y * x29;
      a17 -= c_.z * x30;
      a17 -= c_.w * x31;
    }
  const float x17 = a17;
  float a16 = Xc[1040];
    { const float4 c_ = *(const float4*)(Ab + 1104);
      a16 -= c_.y * x17;
      a16 -= c_.z * x18;
      a16 -= c_.w * x19;
    }
    { const float4 c_ = *(const float4*)(Ab + 1108);
      a16 -= c_.x * x20;
      a16 -= c_.y * x21;
      a16 -= c_.z * x22;
      a16 -= c_.w * x23;
    }
    { const float4 c_ = *(const float4*)(Ab + 1112);
      a16 -= c_.x * x24;
      a16 -= c_.y * x25;
      a16 -= c_.z * x26;
      a16 -= c_.w * x27;
    }
    { const float4 c_ = *(const float4*)(Ab + 1116);
      a16 -= c_.x * x28;
      a16 -= c_.y * x29;
      a16 -= c_.z * x30;
      a16 -= c_.w * x31;
    }
  const float x16 = a16;
  float a15 = Xc[975];
    { const float4 c_ = *(const float4*)(Ab + 1036);
      a15 -= c_.x * x16;
      a15 -= c_.y * x17;
      a15 -= c_.z * x18;
      a15 -= c_.w * x19;
    }
    { const float4 c_ = *(const float4*)(Ab + 1040);
      a15 -= c_.x * x20;
      a15 -= c_.y * x21;
      a15 -= c_.z * x22;
      a15 -= c_.w * x23;
    }
    { const float4 c_ = *(const float4*)(Ab + 1044);
      a15 -= c_.x * x24;
      a15 -= c_.y * x25;
      a15 -= c_.z * x26;
      a15 -= c_.w * x27;
    }
    { const float4 c_ = *(const float4*)(Ab + 1048);
      a15 -= c_.x * x28;
      a15 -= c_.y * x29;
      a15 -= c_.z * x30;
      a15 -= c_.w * x31;
    }
  const float x15 = a15;
  float a14 = Xc[910];
    { const float4 c_ = *(const float4*)(Ab + 964);
      a14 -= c_.w * x15;
    }
    { const float4 c_ = *(const float4*)(Ab + 968);
      a14 -= c_.x * x16;
      a14 -= c_.y * x17;
      a14 -= c_.z * x18;
      a14 -= c_.w * x19;
    }
    { const float4 c_ = *(const float4*)(Ab + 972);
      a14 -= c_.x * x20;
      a14 -= c_.y * x21;
      a14 -= c_.z * x22;
      a14 -= c_.w * x23;
    }
    { const float4 c_ = *(const float4*)(Ab + 976);
      a14 -= c_.x * x24;
      a14 -= c_.y * x25;
      a14 -= c_.z * x26;
      a14 -= c_.w * x27;
    }
    { const float4 c_ = *(const float4*)(Ab + 980);
      a14 -= c_.x * x28;
      a14 -= c_.y * x29;
      a14 -= c_.z * x30;
      a14 -= c_.w * x31;
    }
  const float x14 = a14;
  float a13 = Xc[845];
    { const float4 c_ = *(const float4*)(Ab + 896);
      a13 -= c_.z * x14;
      a13 -= c_.w * x15;
    }
    { const float4 c_ = *(const float4*)(Ab + 900);
      a13 -= c_.x * x16;
      a13 -= c_.y * x17;
      a13 -= c_.z * x18;
      a13 -= c_.w * x19;
    }
    { const float4 c_ = *(const float4*)(Ab + 904);
      a13 -= c_.x * x20;
      a13 -= c_.y * x21;
      a13 -= c_.z * x22;
      a13 -= c_.w * x23;
    }
    { const float4 c_ = *(const float4*)(Ab + 908);
      a13 -= c_.x * x24;
      a13 -= c_.y * x25;
      a13 -= c_.z * x26;
      a13 -= c_.w * x27;
    }
    { const float4 c_ = *(const float4*)(Ab + 912);
      a13 -= c_.x * x28;
      a13 -= c_.y * x29;
      a13 -= c_.z * x30;
      a13 -= c_.w * x31;
    }
  const float x13 = a13;
  float a12 = Xc[780];
    { const float4 c_ = *(const float4*)(Ab + 828);
      a12 -= c_.y * x13;
      a12 -= c_.z * x14;
      a12 -= c_.w * x15;
    }
    { const float4 c_ = *(const float4*)(Ab + 832);
      a12 -= c_.x * x16;
      a12 -= c_.y * x17;
      a12 -= c_.z * x18;
      a12 -= c_.w * x19;
    }
    { const float4 c_ = *(const float4*)(Ab + 836);
      a12 -= c_.x * x20;
      a12 -= c_.y * x21;
      a12 -= c_.z * x22;
      a12 -= c_.w * x23;
    }
    { const float4 c_ = *(const float4*)(Ab + 840);
      a12 -= c_.x * x24;
      a12 -= c_.y * x25;
      a12 -= c_.z * x26;
      a12 -= c_.w * x27;
    }
    { const float4 c_ = *(const float4*)(Ab + 844);
      a12 -= c_.x * x28;
      a12 -= c_.y * x29;
      a12 -= c_.z * x30;
      a12 -= c_.w * x31;
    }
  const float x12 = a12;
  float a11 = Xc[715];
    { const float4 c_ = *(const float4*)(Ab + 760);
      a11 -= c_.x * x12;
      a11 -= c_.y * x13;
      a11 -= c_.z * x14;
      a11 -= c_.w * x15;
    }
    { const float4 c_ = *(const float4*)(Ab + 764);
      a11 -= c_.x * x16;
      a11 -= c_.y * x17;
      a11 -= c_.z * x18;
      a11 -= c_.w * x19;
    }
    { const float4 c_ = *(const float4*)(Ab + 768);
      a11 -= c_.x * x20;
      a11 -= c_.y * x21;
      a11 -= c_.z * x22;
      a11 -= c_.w * x23;
    }
    { const float4 c_ = *(const float4*)(Ab + 772);
      a11 -= c_.x * x24;
      a11 -= c_.y * x25;
      a11 -= c_.z * x26;
      a11 -= c_.w * x27;
    }
    { const float4 c_ = *(const float4*)(Ab + 776);
      a11 -= c_.x * x28;
      a11 -= c_.y * x29;
      a11 -= c_.z * x30;
      a11 -= c_.w * x31;
    }
  const float x11 = a11;
  float a10 = Xc[650];
    { const float4 c_ = *(const float4*)(Ab + 688);
      a10 -= c_.w * x11;
    }
    { const float4 c_ = *(const float4*)(Ab + 692);
      a10 -= c_.x * x12;
      a10 -= c_.y * x13;
      a10 -= c_.z * x14;
      a10 -= c_.w * x15;
    }
    { const float4 c_ = *(const float4*)(Ab + 696);
      a10 -= c_.x * x16;
      a10 -= c_.y * x17;
      a10 -= c_.z * x18;
      a10 -= c_.w * x19;
    }
    { const float4 c_ = *(const float4*)(Ab + 700);
      a10 -= c_.x * x20;
      a10 -= c_.y * x21;
      a10 -= c_.z * x22;
      a10 -= c_.w * x23;
    }
    { const float4 c_ = *(const float4*)(Ab + 704);
      a10 -= c_.x * x24;
      a10 -= c_.y * x25;
      a10 -= c_.z * x26;
      a10 -= c_.w * x27;
    }
    { const float4 c_ = *(const float4*)(Ab + 708);
      a10 -= c_.x * x28;
      a10 -= c_.y * x29;
      a10 -= c_.z * x30;
      a10 -= c_.w * x31;
    }
  const float x10 = a10;
  float a9 = Xc[585];
    { const float4 c_ = *(const float4*)(Ab + 620);
      a9 -= c_.z * x10;
      a9 -= c_.w * x11;
    }
    { const float4 c_ = *(const float4*)(Ab + 624);
      a9 -= c_.x * x12;
      a9 -= c_.y * x13;
      a9 -= c_.z * x14;
      a9 -= c_.w * x15;
    }
    { const float4 c_ = *(const float4*)(Ab + 628);
      a9 -= c_.x * x16;
      a9 -= c_.y * x17;
      a9 -= c_.z * x18;
      a9 -= c_.w * x19;
    }
    { const float4 c_ = *(const float4*)(Ab + 632);
      a9 -= c_.x * x20;
      a9 -= c_.y * x21;
      a9 -= c_.z * x22;
      a9 -= c_.w * x23;
    }
    { const float4 c_ = *(const float4*)(Ab + 636);
      a9 -= c_.x * x24;
      a9 -= c_.y * x25;
      a9 -= c_.z * x26;
      a9 -= c_.w * x27;
    }
    { const float4 c_ = *(const float4*)(Ab + 640);
      a9 -= c_.x * x28;
      a9 -= c_.y * x29;
      a9 -= c_.z * x30;
      a9 -= c_.w * x31;
    }
  const float x9 = a9;
  float a8 = Xc[520];
    { const float4 c_ = *(const float4*)(Ab + 552);
      a8 -= c_.y * x9;
      a8 -= c_.z * x10;
      a8 -= c_.w * x11;
    }
    { const float4 c_ = *(const float4*)(Ab + 556);
      a8 -= c_.x * x12;
      a8 -= c_.y * x13;
      a8 -= c_.z * x14;
      a8 -= c_.w * x15;
    }
    { const float4 c_ = *(const float4*)(Ab + 560);
      a8 -= c_.x * x16;
      a8 -= c_.y * x17;
      a8 -= c_.z * x18;
      a8 -= c_.w * x19;
    }
    { const float4 c_ = *(const float4*)(Ab + 564);
      a8 -= c_.x * x20;
      a8 -= c_.y * x21;
      a8 -= c_.z * x22;
      a8 -= c_.w * x23;
    }
    { const float4 c_ = *(const float4*)(Ab + 568);
      a8 -= c_.x * x24;
      a8 -= c_.y * x25;
      a8 -= c_.z * x26;
      a8 -= c_.w * x27;
    }
    { const float4 c_ = *(const float4*)(Ab + 572);
      a8 -= c_.x * x28;
      a8 -= c_.y * x29;
      a8 -= c_.z * x30;
      a8 -= c_.w * x31;
    }
  const float x8 = a8;
  float a7 = Xc[455];
    { const float4 c_ = *(const float4*)(Ab + 484);
      a7 -= c_.x * x8;
      a7 -= c_.y * x9;
      a7 -= c_.z * x10;
      a7 -= c_.w * x11;
    }
    { const float4 c_ = *(const float4*)(Ab + 488);
      a7 -= c_.x * x12;
      a7 -= c_.y * x13;
      a7 -= c_.z * x14;
      a7 -= c_.w * x15;
    }
    { const float4 c_ = *(const float4*)(Ab + 492);
      a7 -= c_.x * x16;
      a7 -= c_.y * x17;
      a7 -= c_.z * x18;
      a7 -= c_.w * x19;
    }
    { const float4 c_ = *(const float4*)(Ab + 496);
      a7 -= c_.x * x20;
      a7 -= c_.y * x21;
      a7 -= c_.z * x22;
      a7 -= c_.w * x23;
    }
    { const float4 c_ = *(const float4*)(Ab + 500);
      a7 -= c_.x * x24;
      a7 -= c_.y * x25;
      a7 -= c_.z * x26;
      a7 -= c_.w * x27;
    }
    { const float4 c_ = *(const float4*)(Ab + 504);
      a7 -= c_.x * x28;
      a7 -= c_.y * x29;
      a7 -= c_.z * x30;
      a7 -= c_.w * x31;
    }
  const float x7 = a7;
  float a6 = Xc[390];
    { const float4 c_ = *(const float4*)(Ab + 412);
      a6 -= c_.w * x7;
    }
    { const float4 c_ = *(const float4*)(Ab + 416);
      a6 -= c_.x * x8;
      a6 -= c_.y * x9;
      a6 -= c_.z * x10;
      a6 -= c_.w * x11;
    }
    { const float4 c_ = *(const float4*)(Ab + 420);
      a6 -= c_.x * x12;
      a6 -= c_.y * x13;
      a6 -= c_.z * x14;
      a6 -= c_.w * x15;
    }
    { const float4 c_ = *(const float4*)(Ab + 424);
      a6 -= c_.x * x16;
      a6 -= c_.y * x17;
      a6 -= c_.z * x18;
      a6 -= c_.w * x19;
    }
    { const float4 c_ = *(const float4*)(Ab + 428);
      a6 -= c_.x * x20;
      a6 -= c_.y * x21;
      a6 -= c_.z * x22;
      a6 -= c_.w * x23;
    }
    { const float4 c_ = *(const float4*)(Ab + 432);
      a6 -= c_.x * x24;
      a6 -= c_.y * x25;
      a6 -= c_.z * x26;
      a6 -= c_.w * x27;
    }
    { const float4 c_ = *(const float4*)(Ab + 436);
      a6 -= c_.x * x28;
      a6 -= c_.y * x29;
      a6 -= c_.z * x30;
      a6 -= c_.w * x31;
    }
  const float x6 = a6;
  float a5 = Xc[325];
    { const float4 c_ = *(const float4*)(Ab + 344);
      a5 -= c_.z * x6;
      a5 -= c_.w * x7;
    }
    { const float4 c_ = *(const float4*)(Ab + 348);
      a5 -= c_.x * x8;
      a5 -= c_.y * x9;
      a5 -= c_.z * x10;
      a5 -= c_.w * x11;
    }
    { const float4 c_ = *(const float4*)(Ab + 352);
      a5 -= c_.x * x12;
      a5 -= c_.y * x13;
      a5 -= c_.z * x14;
      a5 -= c_.w * x15;
    }
    { const float4 c_ = *(const float4*)(Ab + 356);
      a5 -= c_.x * x16;
      a5 -= c_.y * x17;
      a5 -= c_.z * x18;
      a5 -= c_.w * x19;
    }
    { const float4 c_ = *(const float4*)(Ab + 360);
      a5 -= c_.x * x20;
      a5 -= c_.y * x21;
      a5 -= c_.z * x22;
      a5 -= c_.w * x23;
    }
    { const float4 c_ = *(const float4*)(Ab + 364);
      a5 -= c_.x * x24;
      a5 -= c_.y * x25;
      a5 -= c_.z * x26;
      a5 -= c_.w * x27;
    }
    { const float4 c_ = *(const float4*)(Ab + 368);
      a5 -= c_.x * x28;
      a5 -= c_.y * x29;
      a5 -= c_.z * x30;
      a5 -= c_.w * x31;
    }
  const float x5 = a5;
  float a4 = Xc[260];
    { const float4 c_ = *(const float4*)(Ab + 276);
      a4 -= c_.y * x5;
      a4 -= c_.z * x6;
      a4 -= c_.w * x7;
    }
    { const float4 c_ = *(const float4*)(Ab + 280);
      a4 -= c_.x * x8;
      a4 -= c_.y * x9;
      a4 -= c_.z * x10;
      a4 -= c_.w * x11;
    }
    { const float4 c_ = *(const float4*)(Ab + 284);
      a4 -= c_.x * x12;
      a4 -= c_.y * x13;
      a4 -= c_.z * x14;
      a4 -= c_.w * x15;
    }
    { const float4 c_ = *(const float4*)(Ab + 288);
      a4 -= c_.x * x16;
      a4 -= c_.y * x17;
      a4 -= c_.z * x18;
      a4 -= c_.w * x19;
    }
    { const float4 c_ = *(const float4*)(Ab + 292);
      a4 -= c_.x * x20;
      a4 -= c_.y * x21;
      a4 -= c_.z * x22;
      a4 -= c_.w * x23;
    }
    { const float4 c_ = *(const float4*)(Ab + 296);
      a4 -= c_.x * x24;
      a4 -= c_.y * x25;
      a4 -= c_.z * x26;
      a4 -= c_.w * x27;
    }
    { const float4 c_ = *(const float4*)(Ab + 300);
      a4 -= c_.x * x28;
      a4 -= c_.y * x29;
      a4 -= c_.z * x30;
      a4 -= c_.w * x31;
    }
  const float x4 = a4;
  float a3 = Xc[195];
    { const float4 c_ = *(const float4*)(Ab + 208);
      a3 -= c_.x * x4;
      a3 -= c_.y * x5;
      a3 -= c_.z * x6;
      a3 -= c_.w * x7;
    }
    { const float4 c_ = *(const float4*)(Ab + 212);
      a3 -= c_.x * x8;
      a3 -= c_.y * x9;
      a3 -= c_.z * x10;
      a3 -= c_.w * x11;
    }
    { const float4 c_ = *(const float4*)(Ab + 216);
      a3 -= c_.x * x12;
      a3 -= c_.y * x13;
      a3 -= c_.z * x14;
      a3 -= c_.w * x15;
    }
    { const float4 c_ = *(const float4*)(Ab + 220);
      a3 -= c_.x * x16;
      a3 -= c_.y * x17;
      a3 -= c_.z * x18;
      a3 -= c_.w * x19;
    }
    { const float4 c_ = *(const float4*)(Ab + 224);
      a3 -= c_.x * x20;
      a3 -= c_.y * x21;
      a3 -= c_.z * x22;
      a3 -= c_.w * x23;
    }
    { const float4 c_ = *(const float4*)(Ab + 228);
      a3 -= c_.x * x24;
      a3 -= c_.y * x25;
      a3 -= c_.z * x26;
      a3 -= c_.w * x27;
    }
    { const float4 c_ = *(const float4*)(Ab + 232);
      a3 -= c_.x * x28;
      a3 -= c_.y * x29;
      a3 -= c_.z * x30;
      a3 -= c_.w * x31;
    }
  const float x3 = a3;
  float a2 = Xc[130];
    { const float4 c_ = *(const float4*)(Ab + 136);
      a2 -= c_.w * x3;
    }
    { const float4 c_ = *(const float4*)(Ab + 140);
      a2 -= c_.x * x4;
      a2 -= c_.y * x5;
      a2 -= c_.z * x6;
      a2 -= c_.w * x7;
    }
    { const float4 c_ = *(const float4*)(Ab + 144);
      a2 -= c_.x * x8;
      a2 -= c_.y * x9;
      a2 -= c_.z * x10;
      a2 -= c_.w * x11;
    }
    { const float4 c_ = *(const float4*)(Ab + 148);
      a2 -= c_.x * x12;
      a2 -= c_.y * x13;
      a2 -= c_.z * x14;
      a2 -= c_.w * x15;
    }
    { const float4 c_ = *(const float4*)(Ab + 152);
      a2 -= c_.x * x16;
      a2 -= c_.y * x17;
      a2 -= c_.z * x18;
      a2 -= c_.w * x19;
    }
    { const float4 c_ = *(const float4*)(Ab + 156);
      a2 -= c_.x * x20;
      a2 -= c_.y * x21;
      a2 -= c_.z * x22;
      a2 -= c_.w * x23;
    }
    { const float4 c_ = *(const float4*)(Ab + 160);
      a2 -= c_.x * x24;
      a2 -= c_.y * x25;
      a2 -= c_.z * x26;
      a2 -= c_.w * x27;
    }
    { const float4 c_ = *(const float4*)(Ab + 164);
      a2 -= c_.x * x28;
      a2 -= c_.y * x29;
      a2 -= c_.z * x30;
      a2 -= c_.w * x31;
    }
  const float x2 = a2;
  float a1 = Xc[65];
    { const float4 c_ = *(const float4*)(Ab + 68);
      a1 -= c_.z * x2;
      a1 -= c_.w * x3;
    }
    { const float4 c_ = *(const float4*)(Ab + 72);
      a1 -= c_.x * x4;
      a1 -= c_.y * x5;
      a1 -= c_.z * x6;
      a1 -= c_.w * x7;
    }
    { const float4 c_ = *(const float4*)(Ab + 76);
      a1 -= c_.x * x8;
      a1 -= c_.y * x9;
      a1 -= c_.z * x10;
      a1 -= c_.w * x11;
    }
    { const float4 c_ = *(const float4*)(Ab + 80);
      a1 -= c_.x * x12;
      a1 -= c_.y * x13;
      a1 -= c_.z * x14;
      a1 -= c_.w * x15;
    }
    { const float4 c_ = *(const float4*)(Ab + 84);
      a1 -= c_.x * x16;
      a1 -= c_.y * x17;
      a1 -= c_.z * x18;
      a1 -= c_.w * x19;
    }
    { const float4 c_ = *(const float4*)(Ab + 88);
      a1 -= c_.x * x20;
      a1 -= c_.y * x21;
      a1 -= c_.z * x22;
      a1 -= c_.w * x23;
    }
    { const float4 c_ = *(const float4*)(Ab + 92);
      a1 -= c_.x * x24;
      a1 -= c_.y * x25;
      a1 -= c_.z * x26;
      a1 -= c_.w * x27;
    }
    { const float4 c_ = *(const float4*)(Ab + 96);
      a1 -= c_.x * x28;
      a1 -= c_.y * x29;
      a1 -= c_.z * x30;
      a1 -= c_.w * x31;
    }
  const float x1 = a1;
  float a0 = Xc[0];
    { const float4 c_ = *(const float4*)(Ab + 0);
      a0 -= c_.y * x1;
      a0 -= c_.z * x2;
      a0 -= c_.w * x3;
    }
    { const float4 c_ = *(const float4*)(Ab + 4);
      a0 -= c_.x * x4;
      a0 -= c_.y * x5;
      a0 -= c_.z * x6;
      a0 -= c_.w * x7;
    }
    { const float4 c_ = *(const float4*)(Ab + 8);
      a0 -= c_.x * x8;
      a0 -= c_.y * x9;
      a0 -= c_.z * x10;
      a0 -= c_.w * x11;
    }
    { const float4 c_ = *(const float4*)(Ab + 12);
      a0 -= c_.x * x12;
      a0 -= c_.y * x13;
      a0 -= c_.z * x14;
      a0 -= c_.w * x15;
    }
    { const float4 c_ = *(const float4*)(Ab + 16);
      a0 -= c_.x * x16;
      a0 -= c_.y * x17;
      a0 -= c_.z * x18;
      a0 -= c_.w * x19;
    }
    { const float4 c_ = *(const float4*)(Ab + 20);
      a0 -= c_.x * x20;
      a0 -= c_.y * x21;
      a0 -= c_.z * x22;
      a0 -= c_.w * x23;
    }
    { const float4 c_ = *(const float4*)(Ab + 24);
      a0 -= c_.x * x24;
      a0 -= c_.y * x25;
      a0 -= c_.z * x26;
      a0 -= c_.w * x27;
    }
    { const float4 c_ = *(const float4*)(Ab + 28);
      a0 -= c_.x * x28;
      a0 -= c_.y * x29;
      a0 -= c_.z * x30;
      a0 -= c_.w * x31;
    }
  const float x0 = a0;
  Xc[0] = x0;
  Xc[65] = x1;
  Xc[130] = x2;
  Xc[195] = x3;
  Xc[260] = x4;
  Xc[325] = x5;
  Xc[390] = x6;
  Xc[455] = x7;
  Xc[520] = x8;
  Xc[585] = x9;
  Xc[650] = x10;
  Xc[715] = x11;
  Xc[780] = x12;
  Xc[845] = x13;
  Xc[910] = x14;
  Xc[975] = x15;
  Xc[1040] = x16;
  Xc[1105] = x17;
  Xc[1170] = x18;
  Xc[1235] = x19;
  Xc[1300] = x20;
  Xc[1365] = x21;
  Xc[1430] = x22;
  Xc[1495] = x23;
  Xc[1560] = x24;
  Xc[1625] = x25;
  Xc[1690] = x26;
  Xc[1755] = x27;
  Xc[1820] = x28;
  Xc[1885] = x29;
  Xc[1950] = x30;
  Xc[2015] = x31;
}
#define FS(i) (ldsf + (i) * 4160)
__device__ __forceinline__ void rwkv_item2(const Params& p, int l, int item, float* ldsf) {
  const int tid = opq(threadIdx.x), lane = tid & 63, wave = tid >> 6;
  const int r = lane & 31, hf = lane >> 5;
  const int h = item & 7, cidx = item >> 3, rowbase = cidx * 64, cc = cidx & 127;
  const u16* z = (const u16*)(p.ws + WS_Z);
  const float* mu = p.in[9] + l * 1792;
  u16* BBp = (u16*)((unsigned char*)ldsf + 83200);
  u16* XW = BBp;            u16* XA = BBp + 4608;    u16* XG = BBp + 9216;   u16* WT = BBp + 17920;
  u16* Rn = BBp;            u16* Kn = BBp + 4608;    u16* Bn = BBp + 9216;   u16* Cn = BBp + 13824;
  u16* CT = BBp + 18432;    u16* KHT = BBp + 23040;  u16* VT = BBp + 27648;
  float* gc = (float*)(BBp + 32256);
  u16* AK = (u16*)FS(2);    u16* NTm = AK + 4608;
  u16* MT = (u16*)FS(0);    u16* KQT = (u16*)FS(1);
  float* Abp = (float*)((unsigned char*)ldsf + 60928);
  const int mt = (wave >> 1) & 1, nt = wave & 1, grp = wave >> 2;
  __syncthreads();
  {
    const int t = tid >> 3, c8 = (tid & 7) * 8;
    const int m = rowbase + t;
    const int zcs[7] = {h * 64, 512 + h * 64, 1024 + h * 64, 1536, 1600, 1664, 1728};
#pragma unroll
    for (int gi = 0; gi < 7; ++gi) {
      const int zc = zcs[gi] + c8;
      float cur[8], prv[8], v[8];
      const float4 mu0 = *(const float4*)(mu + zc), mu1 = *(const float4*)(mu + zc + 4);
      const float muv[8] = {mu0.x, mu0.y, mu0.z, mu0.w, mu1.x, mu1.y, mu1.z, mu1.w};
      unpack8(*(const uint4*)(z + (size_t)m * ZLD + zc), cur);
      if (t == 0 && cc == 0) {
#pragma unroll
        for (int i = 0; i < 8; ++i) prv[i] = 0.f;
      } else {
        unpack8(*(const uint4*)(z + (size_t)(m - 1) * ZLD + zc), prv);
      }
#pragma unroll
      for (int i = 0; i < 8; ++i) {
        float x = cur[i] + muv[i] * (prv[i] - cur[i]);
        if (gi == 3) x = 1.f - 2.f * __builtin_amdgcn_rcpf(1.f + __expf(2.f * x));
        if (gi >= 5) x = sigm(x);
        v[i] = x;
      }
      if (gi < 2) {
        float* d = FS(gi) + t * 65 + c8;
#pragma unroll
        for (int i = 0; i < 8; ++i) d[i] = v[i];
      } else if (gi == 2) {
#pragma unroll
        for (int i = 0; i < 8; ++i) VT[(c8 + i) * 72 + t] = f2bf(v[i]);
      } else if (gi == 3) { *(uint4*)(XW + t * 72 + c8) = pack8(v); }
      else if (gi == 4) { *(uint4*)(XA + t * 72 + c8) = pack8(v); }
      else { *(uint4*)(XG + t * 136 + (gi - 5) * 64 + c8) = pack8(v); }
    }
  }
  {
    const int i = tid >> 3, j8 = (tid & 7) * 8;
    const float* s1 = p.in[11] + (size_t)l * 64 * 512 + (size_t)i * 512 + h * 64 + j8;
    const float* s2 = p.in[13] + (size_t)l * 64 * 512 + (size_t)i * 512 + h * 64 + j8;
    const float4 a0 = *(const float4*)s1, a1 = *(const float4*)(s1 + 4), b0 = *(const float4*)s2, b1 = *(const float4*)(s2 + 4);
    const float wa[8] = {a0.x, a0.y, a0.z, a0.w, a1.x, a1.y, a1.z, a1.w};
    const float wb[8] = {b0.x, b0.y, b0.z, b0.w, b1.x, b1.y, b1.z, b1.w};
#pragma unroll
    for (int q = 0; q < 8; ++q) { WT[(j8 + q) * 72 + i] = f2bf(wa[q]); WT[4608 + (j8 + q) * 72 + i] = f2bf(wb[q]); }
  }
  __syncthreads();
  {
    f32x16 acc;
#pragma unroll
    for (int i = 0; i < 16; ++i) acc[i] = 0.f;
    mm_tile(grp ? XA : XW, 72, grp ? WT + 4608 : WT, 72, mt, nt, r, hf, 4, acc);
    const int j = nt * 32 + r;
    const float bias = grp ? p.in[12][l * 512 + h * 64 + j] : p.in[10][l * 512 + h * 64 + j];
#pragma unroll
    for (int reg = 0; reg < 16; ++reg) {
      const int t = mt * 32 + ROWOFF(reg, hf);
      const float x = acc[reg] + bias;
      if (grp) FS(3)[t * 65 + j] = sigm(x);
      else {
        const float nx = -x;
        const float sp = (nx > 20.f) ? nx : __logf(1.f + __expf(nx));
        FS(4)[t * 65 + j] = -__expf(-sp - 0.5f);
      }
    }
  }
  __syncthreads();
  {
#pragma unroll
    for (int e2 = 0; e2 < 2; ++e2) {
      const int e = tid + e2 * 512;
      const int i = e >> 3, j8 = (e & 7) * 8;
      const float* s1 = p.in[14] + (size_t)l * 128 * 512 + (size_t)i * 512 + h * 64 + j8;
      const float4 a0 = *(const float4*)s1, a1 = *(const float4*)(s1 + 4);
      const float wa[8] = {a0.x, a0.y, a0.z, a0.w, a1.x, a1.y, a1.z, a1.w};
#pragma unroll
      for (int q = 0; q < 8; ++q) WT[(j8 + q) * 136 + i] = f2bf(wa[q]);
    }
  }
  if (tid < 64) {
    float c = 0.f;
    for (int t = 0; t < 64; ++t) { c += FS(4)[t * 65 + tid]; FS(2)[t * 65 + tid] = c; }
    const float g = __expf(c);
    gc[tid] = g;
    ((float*)(p.ws + WS_GC))[(size_t)item * 64 + tid] = g;
  }
  __syncthreads();
  if (grp == 0) {
    f32x16 acc;
#pragma unroll
    for (int i = 0; i < 16; ++i) acc[i] = 0.f;
    mm_tile(XG, 136, WT, 136, mt, nt, r, hf, 8, acc);
    u16* ga = (u16*)(p.ws + WS_GA) + (size_t)item * 4096;
#pragma unroll
    for (int reg = 0; reg < 16; ++reg) ga[(mt * 32 + ROWOFF(reg, hf)) * 64 + nt * 32 + r] = f2bf(acc[reg]);
  }
  __syncthreads();
  {
    const int t = tid >> 3, j0 = (tid & 7) * 8;
    const float* kkw = p.in[15] + l * 512 + h * 64;
    const float* kaw = p.in[16] + l * 512 + h * 64;
    const float* rkw = p.in[17] + l * 512 + h * 64;
    float kr[8], av[8], rv[8], kkv[8], kf[8];
    float nrm = 0.f, bdot = 0.f;
#pragma unroll
    for (int i = 0; i < 8; ++i) {
      const int j = j0 + i;
      kr[i] = FS(1)[t * 65 + j]; av[i] = FS(3)[t * 65 + j]; rv[i] = FS(0)[t * 65 + j];
      kkv[i] = kr[i] * kkw[j];
      nrm += kkv[i] * kkv[i];
      kf[i] = kr[i] * (1.f + (av[i] - 1.f) * kaw[j]);
      bdot += rv[i] * kf[i] * rkw[j];
    }
    nrm += __shfl_xor(nrm, 1, 64); nrm += __shfl_xor(nrm, 2, 64); nrm += __shfl_xor(nrm, 4, 64);
    bdot += __shfl_xor(bdot, 1, 64); bdot += __shfl_xor(bdot, 2, 64); bdot += __shfl_xor(bdot, 4, 64);
    const float rn = 1.f / fmaxf(sqrtf(nrm), 1e-12f);
    float o_r[8], o_k[8], o_b[8], o_c[8], bo[8];
#pragma unroll
    for (int i = 0; i < 8; ++i) {
      const int j = j0 + i;
      const float cum = FS(2)[t * 65 + j], dl = FS(4)[t * 65 + j];
      const float eg = __expf(cum), egi = __expf(-cum), egp = __expf(cum - dl);
      const float kk = kkv[i] * rn;
      const float g = gc[j];
      o_r[i] = rv[i] * eg; o_k[i] = kf[i] * egi; o_b[i] = kk * av[i] * egi; o_c[i] = kk * egp;
      CT[j * 72 + t] = f2bf(o_c[i]);
      KHT[j * 72 + t] = f2bf(o_k[i] * g);
      FS(1)[t * 65 + j] = o_b[i] * g;
      bo[i] = bdot * bf2f(VT[j * 72 + t]);
    }
    *(uint4*)(Rn + t * 72 + j0) = pack8(o_r);
    *(uint4*)(Kn + t * 72 + j0) = pack8(o_k);
    *(uint4*)(Bn + t * 72 + j0) = pack8(o_b);
    *(uint4*)(Cn + t * 72 + j0) = pack8(o_c);
    u16* bop = (u16*)(p.ws + WS_BO) + (size_t)item * 4096;
    *(uint4*)(bop + t * 64 + j0) = pack8(bo);
  }
  __syncthreads();
  f32x16 akr;
#pragma unroll
  for (int i = 0; i < 16; ++i) akr[i] = 0.f;
  if (grp == 0) {
    f32x16 ab, abr;
#pragma unroll
    for (int i = 0; i < 16; ++i) { ab[i] = 0.f; abr[i] = 0.f; }
    mm_tile(Bn, 72, Cn, 72, mt, nt, r, hf, 4, ab);
    mm_tile(Bn, 72, Rn, 72, mt, nt, r, hf, 4, abr);
    const int t = nt * 32 + r;
#pragma unroll
    for (int reg = 0; reg < 16; ++reg) {
      const int i = mt * 32 + ROWOFF(reg, hf);
      Abp[i * 68 + t] = (i < t) ? ab[reg] : 0.f;
      FS(0)[i * 65 + t] = (i <= t) ? abr[reg] : 0.f;
    }
  } else {
    f32x16 akt;
#pragma unroll
    for (int i = 0; i < 16; ++i) akt[i] = 0.f;
    mm_tile(Cn, 72, Kn, 72, mt, nt, r, hf, 4, akt);
    {
      const int i = nt * 32 + r;
#pragma unroll
      for (int reg = 0; reg < 16; ++reg) { const int t = mt * 32 + ROWOFF(reg, hf); if (!(i < t)) akt[reg] = 0.f; }
    }
    store_T(AK, 72, mt, nt, r, hf, akt);
    mm_tile(Kn, 72, Rn, 72, mt, nt, r, hf, 4, akr);
    {
      const int t = nt * 32 + r;
#pragma unroll
      for (int reg = 0; reg < 16; ++reg) { const int i = mt * 32 + ROWOFF(reg, hf); if (!(i <= t)) akr[reg] = 0.f; }
    }
  }
  __syncthreads();
  if (tid < 128) {
    float* X_ = (tid < 64) ? FS(0) : FS(1);
    const int col = tid & 63;
    tri32(Abp + 32 * 68 + 32, X_ + 32 * 65 + col);
  }
  __syncthreads();
  {
    const int c = tid & 127, ig = tid >> 7;
    float* X_ = (c < 64) ? FS(0) : FS(1);
    const int col = c & 63;
    float a[8];
#pragma unroll
    for (int u = 0; u < 8; ++u) a[u] = 0.f;
#pragma unroll 2
    for (int t = 32; t < 64; t += 4) {
      const float x0 = X_[t * 65 + col], x1 = X_[(t + 1) * 65 + col], x2 = X_[(t + 2) * 65 + col], x3 = X_[(t + 3) * 65 + col];
#pragma unroll
      for (int u = 0; u < 8; ++u) {
        const float4 c_ = *(const float4*)(Abp + (ig * 8 + u) * 68 + t);
        a[u] += c_.x * x0 + c_.y * x1 + c_.z * x2 + c_.w * x3;
      }
    }
#pragma unroll
    for (int u = 0; u < 8; ++u) X_[(ig * 8 + u) * 65 + col] -= a[u];
  }
  __syncthreads();
  if (tid < 128) {
    float* X_ = (tid < 64) ? FS(0) : FS(1);
    const int col = tid & 63;
    tri32(Abp, X_ + col);
  }
  __syncthreads();
  {
    const int c = tid >> 2, q = tid & 3;
    const float* X_ = (c < 64) ? FS(0) : FS(1);
    const int col = c & 63;
    float o0[8], o1[8];
#pragma unroll
    for (int u = 0; u < 8; ++u) { o0[u] = -X_[(q * 16 + u) * 65 + col]; o1[u] = -X_[(q * 16 + 8 + u) * 65 + col]; }
    u16* dst = NTm + c * 72 + q * 16;
    *(uint4*)dst = pack8(o0);
    *(uint4*)(dst + 8) = pack8(o1);
  }
  __syncthreads();
  if (grp == 1) {
    mm_tile(AK, 72, NTm, 72, mt, nt, r, hf, 4, akr);
    store_T(MT, 72, mt, nt, r, hf, akr);
  } else {
    f32x16 d2;
#pragma unroll
    for (int i = 0; i < 16; ++i) d2[i] = 0.f;
    mm_tile(AK, 72, NTm + 64 * 72, 72, mt, nt, r, hf, 4, d2);
#pragma unroll
    for (int g = 0; g < 4; ++g) {
      const int idx = (nt * 32 + r) * 72 + mt * 32 + 8 * g + 4 * hf;
      const uint2 kh = *(const uint2*)(KHT + idx);
      uint2 o;
      o.x = pack2(d2[4 * g] + __uint_as_float(kh.x << 16), d2[4 * g + 1] + __uint_as_float(kh.x & 0xFFFF0000u));
      o.y = pack2(d2[4 * g + 2] + __uint_as_float(kh.y << 16), d2[4 * g + 3] + __uint_as_float(kh.y & 0xFFFF0000u));
      *(uint2*)(KQT + idx) = o;
    }
  }
  __syncthreads();
  if (grp == 0) {
    f32x16 w2, yl;
#pragma unroll
    for (int i = 0; i < 16; ++i) { w2[i] = 0.f; yl[i] = 0.f; }
    mm_tile(NTm, 72, CT, 72, mt, nt, r, hf, 4, w2);
    mm_tile(MT, 72, VT, 72, mt, nt, r, hf, 4, yl);
    u16* W2p = (u16*)(p.ws + WS_W2) + (size_t)item * 4096;
    u16* YLp = (u16*)(p.ws + WS_YL) + (size_t)item * 4096;
#pragma unroll
    for (int reg = 0; reg < 16; ++reg) {
      const int t = mt * 32 + ROWOFF(reg, hf), n = nt * 32 + r;
      W2p[t * 64 + n] = f2bf(w2[reg] + bf2f(Rn[t * 72 + n]));
      YLp[t * 64 + n] = f2bf(yl[reg]);
    }
  } else {
    f32x16 pp, qt;
#pragma unroll
    for (int i = 0; i < 16; ++i) { pp[i] = 0.f; qt[i] = 0.f; }
    mm_tile(CT, 72, NTm + 64 * 72, 72, mt, nt, r, hf, 4, pp);
    mm_tile(KQT, 72, VT, 72, mt, nt, r, hf, 4, qt);
    uint4* Pf = (uint4*)((u16*)(p.ws + WS_PP) + (size_t)item * 4096);
    float* Qf = (float*)(p.ws + WS_Q) + (size_t)item * 4096;
#pragma unroll
    for (int s2 = 0; s2 < 2; ++s2) {
      uint4 o;
      o.x = pack2(pp[s2 * 8 + 0], pp[s2 * 8 + 1]); o.y = pack2(pp[s2 * 8 + 2], pp[s2 * 8 + 3]);
      o.z = pack2(pp[s2 * 8 + 4], pp[s2 * 8 + 5]); o.w = pack2(pp[s2 * 8 + 6], pp[s2 * 8 + 7]);
      Pf[(nt * 4 + mt * 2 + s2) * 64 + lane] = o;
    }
#pragma unroll
    for (int reg = 0; reg < 16; ++reg) Qf[((nt * 2 + mt) * 16 + reg) * 64 + lane] = qt[reg];
  }
}

template <int K_> struct IC { static constexpr int value = K_; };
__device__ __forceinline__ void rwkv_scan(const Params& p, int l, int bh, float* ldsf, bool dry = false) {
  const int tid = opq(threadIdx.x), lane = tid & 63, wave = tid >> 6;
  const int b = bh >> 3, h = bh & 7;
  unsigned char* ring = (unsigned char*)ldsf + 32768;
  __syncthreads();
  {
    const float* G0 = (const float*)(p.ws + WS_GC);
    for (int e = tid; e < 8192; e += NT) ldsf[e] = G0[(size_t)((b * 128 + (e >> 6)) * 8 + h) * 64 + (e & 63)];
  }
  const bool helper = wave >= 2;
  const int ht = tid - 128;
  const u16* PPb = (const u16*)(p.ws + WS_PP);
  const float* Qb = (const float*)(p.ws + WS_Q);
  const bool isP = wave < 4;
  const int hstr = isP ? 128 : 256;
  const int hidx = isP ? (tid - 128) : (tid - 256);
  const int hdst = isP ? hidx : 512 + hidx;
#define SC_GLOAD(c, D0, D1, D2, D3) do { const size_t id_ = (size_t)((b * 128 + (c)) * 8 + h); \
    const uint4* src_ = isP ? (const uint4*)(PPb + id_ * 4096) : (const uint4*)(Qb + id_ * 4096); \
    D0 = src_[hidx]; D1 = src_[hidx + hstr]; D2 = src_[hidx + 2 * hstr]; D3 = src_[hidx + 3 * hstr]; } while (0)
#define SC_LWRITE(c, D0, D1, D2, D3) do { uint4* slot_ = (uint4*)(ring + ((c) & 1) * 24576) + hdst; \
    slot_[0] = D0; slot_[hstr] = D1; slot_[2 * hstr] = D2; slot_[3 * hstr] = D3; } while (0)
  if (helper) {
    uint4 a0, a1, a2, a3, b0, b1, b2, b3, c0_, c1_, c2_, c3_, d0, d1, d2, d3;
    SC_GLOAD(0, a0, a1, a2, a3); SC_LWRITE(0, a0, a1, a2, a3);
    SC_GLOAD(1, b0, b1, b2, b3); SC_GLOAD(2, c0_, c1_, c2_, c3_); SC_GLOAD(3, d0, d1, d2, d3);
    __syncthreads();
#pragma unroll 1
    for (int cc = 0; cc < 128; cc += 4) {
      if (cc + 4 < 128) SC_GLOAD(cc + 4, a0, a1, a2, a3);
      SC_LWRITE(cc + 1, b0, b1, b2, b3);
      asm volatile("s_waitcnt lgkmcnt(0)\n\ts_barrier" ::: "memory");
      if (cc + 5 < 128) SC_GLOAD(cc + 5, b0, b1, b2, b3);
      SC_LWRITE(cc + 2, c0_, c1_, c2_, c3_);
      asm volatile("s_waitcnt lgkmcnt(0)\n\ts_barrier" ::: "memory");
      if (cc + 6 < 128) SC_GLOAD(cc + 6, c0_, c1_, c2_, c3_);
      SC_LWRITE(cc + 3, d0, d1, d2, d3);
      asm volatile("s_waitcnt lgkmcnt(0)\n\ts_barrier" ::: "memory");
      if (cc + 7 < 128) SC_GLOAD(cc + 7, d0, d1, d2, d3);
      if (cc + 4 < 128) SC_LWRITE(cc + 4, a0, a1, a2, a3);
      asm volatile("s_waitcnt lgkmcnt(0)\n\ts_barrier" ::: "memory");
    }
    return;
  }
  __syncthreads();
  const int vt = wave & 1, hf = lane >> 5;
  f32x16 S[2];
#pragma unroll
  for (int i = 0; i < 16; ++i) { S[0][i] = 0.f; S[1][i] = 0.f; }
#pragma unroll 1
  for (int cc = 0; cc < 128; ++cc) {
    const size_t id = (size_t)((b * 128 + cc) * 8 + h);
    float* Qg = (float*)Qb + id * 4096;
    const int lofs = opq(lane);
    const uint4* slotA = (const uint4*)(ring + (cc & 1) * 24576) + lofs;
    const float* slotQ = (const float*)(ring + (cc & 1) * 24576 + 8192) + vt * 2048 + lofs;
    const float* gcp = ldsf + cc * 64 + 4 * (lofs >> 5);
    Qg += vt * 2048 + lofs;
    f32x16 acc[2];
#pragma unroll
    for (int kt = 0; kt < 2; ++kt)
#pragma unroll
      for (int reg = 0; reg < 16; ++reg)
        acc[kt][reg] = S[kt][reg] * gcp[kt * 32 + ((reg) & 3) + 8 * ((reg) >> 2)] + slotQ[(kt * 16 + reg) * 64];
#pragma unroll
    for (int kt = 0; kt < 2; ++kt)
#pragma unroll
      for (int reg = 0; reg < 16; ++reg) if (!dry) Qg[(kt * 16 + reg) * 64] = S[kt][reg];
#pragma unroll
    for (int s_ = 0; s_ < 4; ++s_) {
      const int kt = s_ >> 1, s2 = s_ & 1;
      unsigned hw[4], lw[4];
#pragma unroll
      for (int j = 0; j < 4; ++j) {
        const float x0 = S[kt][s2 * 8 + 2 * j], x1 = S[kt][s2 * 8 + 2 * j + 1];
        hw[j] = pack2(x0, x1);
        lw[j] = pack2(x0 - __uint_as_float(hw[j] << 16), x1 - __uint_as_float(hw[j] & 0xFFFF0000u));
      }
      union { uint4 u; bf16x8 v; } bh_, bl_;
      bh_.u = make_uint4(hw[0], hw[1], hw[2], hw[3]);
      bl_.u = make_uint4(lw[0], lw[1], lw[2], lw[3]);
#pragma unroll
      for (int kt2 = 0; kt2 < 2; ++kt2) {
        union { uint4 u; bf16x8 v; } af; af.u = slotA[(kt2 * 4 + s_) * 64];
        acc[kt2] = __builtin_amdgcn_mfma_f32_32x32x16_bf16(af.v, bh_.v, acc[kt2], 0, 0, 0);
        acc[kt2] = __builtin_amdgcn_mfma_f32_32x32x16_bf16(af.v, bl_.v, acc[kt2], 0, 0, 0);
      }
    }
    S[0] = acc[0]; S[1] = acc[1];
    asm volatile("s_waitcnt lgkmcnt(0)\n\ts_barrier" ::: "memory");
  }
  {
    float* o = p.out + O_PWKV + ((size_t)((l * 2 + b) * 8 + h) * 64 + vt * 32 + (lane & 31)) * 64;
#pragma unroll
    for (int kt = 0; kt < 2; ++kt)
#pragma unroll
      for (int reg = 0; reg < 16; ++reg) o[kt * 32 + ROWOFF(reg, hf)] = S[kt][reg];
  }
}

__device__ __forceinline__ void rwkv_out(const Params& p, int l, int item, float* ldsf) {
  const int tid = opq(threadIdx.x), lane = tid & 63, wave = tid >> 6;
  const int h = item & 7, cidx = item >> 3;
  float* Sl = ldsf; float* Wl = ldsf + 4160;
  const float* Sg = (const float*)(p.ws + WS_Q) + (size_t)item * 4096;
  const u16* W2 = (const u16*)(p.ws + WS_W2) + (size_t)item * 4096;
  const u16* YL = (const u16*)(p.ws + WS_YL) + (size_t)item * 4096;
  const u16* BO = (const u16*)(p.ws + WS_BO) + (size_t)item * 4096;
  const u16* GA = (const u16*)(p.ws + WS_GA) + (size_t)item * 4096;
  u16* z = (u16*)(p.ws + WS_Z);
  __syncthreads();
  {
    const int row = tid >> 3, c = (tid & 7) * 8;
#pragma unroll
    for (int i = 0; i < 8; ++i) {
      const int idx = i * 512 + tid;
      const int ln = idx & 63, reg = (idx >> 6) & 15, kt = (idx >> 10) & 1, vt = idx >> 11;
      Sl[(vt * 32 + (ln & 31)) * 65 + kt * 32 + ROWOFF(reg, ln >> 5)] = Sg[idx];
    }
    float w[8];
    unpack8(*(const uint4*)(W2 + row * 64 + c), w);
    float* e = Wl + row * 65 + c;
#pragma unroll
    for (int i = 0; i < 8; ++i) e[i] = w[i];
  }
  __syncthreads();
  float y[8];
#pragma unroll
  for (int q = 0; q < 8; ++q) y[q] = bf2f(YL[(wave * 8 + q) * 64 + lane]);
#pragma unroll 2
  for (int k = 0; k < 64; ++k) {
    const float s = Sl[lane * 65 + k];
#pragma unroll
    for (int q = 0; q < 8; ++q) y[q] += s * Wl[(wave * 8 + q) * 65 + k];
  }
  const float lng = p.in[18][l * 512 + h * 64 + lane], lnb = p.in[19][l * 512 + h * 64 + lane];
#pragma unroll
  for (int q = 0; q < 8; ++q) {
    const int t = wave * 8 + q;
    const float mean = wave_sum(y[q]) * (1.f / 64.f);
    const float d = y[q] - mean;
    const float var = wave_sum(d * d) * (1.f / 64.f);
    const float yn = d * rsqrtf(var + 64e-5f) * lng + lnb;
    const float o = (yn + bf2f(BO[t * 64 + lane])) * bf2f(GA[t * 64 + lane]);
    z[(size_t)(cidx * 64 + t) * ZLD + h * 64 + lane] = f2bf(o);
  }
}

__device__ __forceinline__ void rwkv_out4(const Params& p, int l, int item0, float* ldsf) {
  const int tid = opq(threadIdx.x), lane = tid & 63, wave = tid >> 6;
  const int r = lane & 31, hf = lane >> 5;
  const int pair = wave >> 1, nt = wave & 1;
  const int item = item0 + pair;
  const int h = item & 7, cidx = item >> 3;
  u16* Sl = (u16*)ldsf + pair * 4608;
  const float* Sg = (const float*)(p.ws + WS_Q) + (size_t)item * 4096;
  const u16* W2 = (const u16*)(p.ws + WS_W2) + (size_t)item * 4096;
  const u16* YL = (const u16*)(p.ws + WS_YL) + (size_t)item * 4096;
  const u16* BO = (const u16*)(p.ws + WS_BO) + (size_t)item * 4096;
  const u16* GA = (const u16*)(p.ws + WS_GA) + (size_t)item * 4096;
  u16* z = (u16*)(p.ws + WS_Z);
  __syncthreads();
  {
    const int lt = tid & 127;
#pragma unroll
    for (int q = 0; q < 8; ++q) {
      const int e = q * 128 + lt;
      const int ln = e & 63, g = (e >> 6) & 3, kt = (e >> 8) & 1, vt = (e >> 9) & 1;
      const float* sp = Sg + ((vt * 2 + kt) * 16 + 4 * g) * 64 + ln;
      const float a0 = sp[0], a1 = sp[64], a2 = sp[128], a3 = sp[192];
      uint2 o; o.x = pack2(a0, a1); o.y = pack2(a2, a3);
      *(uint2*)(Sl + (vt * 32 + (ln & 31)) * 72 + kt * 32 + 8 * g + 4 * (ln >> 5)) = o;
    }
  }
  bf16x8 bfr[4];
#pragma unroll
  for (int s_ = 0; s_ < 4; ++s_) bfr[s_] = *(const bf16x8*)(W2 + (nt * 32 + r) * 64 + s_ * 16 + hf * 8);
  __syncthreads();
  f32x16 acc[2];
#pragma unroll
  for (int mt = 0; mt < 2; ++mt) {
#pragma unroll
    for (int i = 0; i < 16; ++i) acc[mt][i] = 0.f;
#pragma unroll
    for (int s_ = 0; s_ < 4; ++s_) {
      const bf16x8 a = *(const bf16x8*)(Sl + (mt * 32 + r) * 72 + s_ * 16 + hf * 8);
      acc[mt] = __builtin_amdgcn_mfma_f32_32x32x16_bf16(a, bfr[s_], acc[mt], 0, 0, 0);
    }
  }
  const int t = nt * 32 + r;
  float sum = 0.f;
#pragma unroll
  for (int mt = 0; mt < 2; ++mt)
#pragma unroll
    for (int g = 0; g < 4; ++g) {
      const uint2 yl = *(const uint2*)(YL + t * 64 + mt * 32 + 8 * g + 4 * hf);
      acc[mt][4 * g + 0] += __uint_as_float(yl.x << 16); acc[mt][4 * g + 1] += __uint_as_float(yl.x & 0xFFFF0000u);
      acc[mt][4 * g + 2] += __uint_as_float(yl.y << 16); acc[mt][4 * g + 3] += __uint_as_float(yl.y & 0xFFFF0000u);
      sum += acc[mt][4 * g] + acc[mt][4 * g + 1] + acc[mt][4 * g + 2] + acc[mt][4 * g + 3];
    }
  sum += __shfl_xor(sum, 32, 64);
  const float mean = sum * (1.f / 64.f);
  float vs = 0.f;
#pragma unroll
  for (int mt = 0; mt < 2; ++mt)
#pragma unroll
    for (int i = 0; i < 16; ++i) { const float d = acc[mt][i] - mean; vs += d * d; }
  vs += __shfl_xor(vs, 32, 64);
  const float rstd = rsqrtf(vs * (1.f / 64.f) + 64e-5f);
  const float* lng = p.in[18] + l * 512 + h * 64;
  const float* lnb = p.in[19] + l * 512 + h * 64;
  u16* zrow = z + (size_t)(cidx * 64 + t) * ZLD + h * 64;
#pragma unroll
  for (int mt = 0; mt < 2; ++mt)
#pragma unroll
    for (int g = 0; g < 4; ++g) {
      const int v0 = mt * 32 + 8 * g + 4 * hf;
      const uint2 bo = *(const uint2*)(BO + t * 64 + v0);
      const uint2 ga = *(const uint2*)(GA + t * 64 + v0);
      const float4 lg = *(const float4*)(lng + v0), lb = *(const float4*)(lnb + v0);
      const float bo_[4] = {__uint_as_float(bo.x << 16), __uint_as_float(bo.x & 0xFFFF0000u), __uint_as_float(bo.y << 16), __uint_as_float(bo.y & 0xFFFF0000u)};
      const float ga_[4] = {__uint_as_float(ga.x << 16), __uint_as_float(ga.x & 0xFFFF0000u), __uint_as_float(ga.y << 16), __uint_as_float(ga.y & 0xFFFF0000u)};
      const float lg_[4] = {lg.x, lg.y, lg.z, lg.w}, lb_[4] = {lb.x, lb.y, lb.z, lb.w};
      float o[4];
#pragma unroll
      for (int u = 0; u < 4; ++u) o[u] = ((acc[mt][4 * g + u] - mean) * rstd * lg_[u] + lb_[u] + bo_[u]) * ga_[u];
      uint2 ov; ov.x = pack2(o[0], o[1]); ov.y = pack2(o[2], o[3]);
      *(uint2*)(zrow + v0) = ov;
    }
}

__device__ __forceinline__ void attn_prompt(const Params& p, int l, int item, u16* lds, bool dry = false) {
  const int tid = opq(threadIdx.x), lane = tid & 63, wave = tid >> 6;
  const int r = lane & 31, h = lane >> 5;
  const int kvh = item & 1, n = (item >> 1) & 63, b = item >> 7;
  u16* z = (u16*)(p.ws + WS_Z);
  u16* Ks = lds;
  u16* Vt = lds + 256 * 72;
  __syncthreads();
  {
    const int key = tid >> 1, half = tid & 1;
    const int t = (n - 1) * 128 + key;
    uint4 kv[4], vv[4];
    if (t >= 0) {
      const u16* kp = z + (size_t)(b * 8192 + t) * ZLD + 2304 + kvh * 64 + half * 32;
      const u16* vp = z + (size_t)(b * 8192 + t) * ZLD + 2432 + kvh * 64 + half * 32;
#pragma unroll
      for (int i = 0; i < 4; ++i) { kv[i] = *(const uint4*)(kp + i * 8); vv[i] = *(const uint4*)(vp + i * 8); }
    } else {
#pragma unroll
      for (int i = 0; i < 4; ++i) { kv[i] = make_uint4(0, 0, 0, 0); vv[i] = make_uint4(0, 0, 0, 0); }
    }
#pragma unroll
    for (int i = 0; i < 4; ++i) {
      *(uint4*)(Ks + key * 72 + half * 32 + i * 8) = kv[i];
      const unsigned w[4] = {vv[i].x, vv[i].y, vv[i].z, vv[i].w};
#pragma unroll
      for (int q = 0; q < 4; ++q) {
        const int d = half * 32 + i * 8 + q * 2;
        Vt[d * 264 + key] = (u16)(w[q] & 0xFFFFu);
        Vt[(d + 1) * 264 + key] = (u16)(w[q] >> 16);
      }
    }
  }
  __syncthreads();
#pragma unroll 1
  for (int uu = 0; uu < 2; ++uu) {
    const int u = wave * 2 + uu;
    const int hq = kvh * 4 + (u >> 2), qg = u & 3;
    const int qrow = b * 8192 + n * 128 + qg * 32 + r;
    u16* qp = z + (size_t)qrow * ZLD + 1792 + hq * 64;
    bf16x8 qf[4];
#pragma unroll
    for (int s = 0; s < 4; ++s) qf[s] = *(const bf16x8*)(qp + s * 16 + h * 8);
    f32x16 sc[5];
#pragma unroll
    for (int i5 = 0; i5 < 5; ++i5) {
#pragma unroll
      for (int i = 0; i < 16; ++i) sc[i5][i] = 0.f;
      const int kt = qg + i5;
#pragma unroll
      for (int s = 0; s < 4; ++s) {
        bf16x8 kf = *(const bf16x8*)(Ks + (kt * 32 + r) * 72 + s * 16 + h * 8);
        sc[i5] = __builtin_amdgcn_mfma_f32_32x32x16_bf16(kf, qf[s], sc[i5], 0, 0, 0);
      }
      __builtin_amdgcn_sched_barrier(0);
    }
    const int qi = qg * 32 + r;
    const float sink = p.in[20][l * 8 + hq];
    float mx = -1e30f;
#pragma unroll
    for (int i5 = 0; i5 < 5; ++i5)
#pragma unroll
      for (int reg = 0; reg < 16; ++reg) {
        const int j = (qg + i5) * 32 + ROWOFF(reg, h);
        const bool ok = (j > qi) && (j <= qi + 128) && (n > 0 || j >= 128);
        const float s = ok ? sc[i5][reg] * 0.125f : -1e30f;
        sc[i5][reg] = s;
        mx = fmaxf(mx, s);
      }
    mx = fmaxf(mx, __shfl_xor(mx, 32, 64));
    mx = fmaxf(mx, sink);
    float sum = 0.f;
#pragma unroll
    for (int i5 = 0; i5 < 5; ++i5)
#pragma unroll
      for (int reg = 0; reg < 16; ++reg) { const float e = __expf(sc[i5][reg] - mx); sc[i5][reg] = e; sum += e; }
    sum += __shfl_xor(sum, 32, 64);
    const float rden = 1.f / (sum + __expf(sink - mx));
    f32x16 oacc[2];
#pragma unroll
    for (int i = 0; i < 16; ++i) { oacc[0][i] = 0.f; oacc[1][i] = 0.f; }
#pragma unroll
    for (int i5 = 0; i5 < 5; ++i5) {
      const int kt = qg + i5;
#pragma unroll
      for (int s2 = 0; s2 < 2; ++s2) {
        bf16x8 pf;
#pragma unroll
        for (int j = 0; j < 8; ++j) pf[j] = (short)f2bf(sc[i5][s2 * 8 + j] * rden);
#pragma unroll
        for (int dt = 0; dt < 2; ++dt) {
          const u16* vp = Vt + (dt * 32 + r) * 264 + kt * 32 + s2 * 16 + h * 4;
          const uint2 lo = *(const uint2*)vp, hi = *(const uint2*)(vp + 8);
          union { uint4 u; bf16x8 v; } cv;
          cv.u = make_uint4(lo.x, lo.y, hi.x, hi.y);
          oacc[dt] = __builtin_amdgcn_mfma_f32_32x32x16_bf16(cv.v, pf, oacc[dt], 0, 0, 0);
        }
        __builtin_amdgcn_sched_barrier(0);
      }
    }
#pragma unroll
    for (int dt = 0; dt < 2; ++dt)
#pragma unroll
      for (int g4 = 0; g4 < 4; ++g4) {
        const int d = dt * 32 + 8 * g4 + 4 * h;
        uint2 o;
        o.x = pack2(oacc[dt][g4 * 4 + 0], oacc[dt][g4 * 4 + 1]);
        o.y = pack2(oacc[dt][g4 * 4 + 2], oacc[dt][g4 * 4 + 3]);
        if (!dry) *(uint2*)(qp + d) = o;
      }
  }
}

__device__ __forceinline__ void attn_sample(const Params& p, int l, int item, float* ldsf, bool dry = false) {
  const int tid = opq(threadIdx.x);
  const int kvh = item & 1, b = item >> 1;
  u16* z = (u16*)(p.ws + WS_Z);
  float* Kl = ldsf;
  float* Vl = ldsf + 132 * 65;
  float* Ql = Vl + 132 * 65;
  float* Pl = Ql + 16 * 64;
  __syncthreads();
  for (int e = tid; e < 132 * 8; e += NT) {
    const int j = e >> 3, c = (e & 7) * 8;
    float k[8], v[8];
    if (j < 128) {
      const float* kp = p.in[4] + ((size_t)((l * 128 + b) * 128 + j) * 2 + kvh) * 64 + c;
      const float* vp = p.in[5] + ((size_t)((l * 128 + b) * 128 + j) * 2 + kvh) * 64 + c;
      float4 a = *(const float4*)kp, a2 = *(const float4*)(kp + 4);
      float4 c1 = *(const float4*)vp, c2 = *(const float4*)(vp + 4);
      k[0] = a.x; k[1] = a.y; k[2] = a.z; k[3] = a.w; k[4] = a2.x; k[5] = a2.y; k[6] = a2.z; k[7] = a2.w;
      v[0] = c1.x; v[1] = c1.y; v[2] = c1.z; v[3] = c1.w; v[4] = c2.x; v[5] = c2.y; v[6] = c2.z; v[7] = c2.w;
    } else {
      const size_t row = M_P + b * 4 + (j - 128);
      unpack8(*(const uint4*)(z + row * ZLD + 2304 + kvh * 64 + c), k);
      unpack8(*(const uint4*)(z + row * ZLD + 2432 + kvh * 64 + c), v);
    }
#pragma unroll
    for (int i = 0; i < 8; ++i) { Kl[j * 65 + c + i] = k[i]; Vl[j * 65 + c + i] = v[i]; }
    if (j >= 4) {
      float* ok = p.out + O_SK + ((size_t)((l * 128 + b) * 128 + (j - 4)) * 2 + kvh) * 64 + c;
      float* ov = p.out + O_SV + ((size_t)((l * 128 + b) * 128 + (j - 4)) * 2 + kvh) * 64 + c;
      *(float4*)ok = make_float4(k[0], k[1], k[2], k[3]); *(float4*)(ok + 4) = make_float4(k[4], k[5], k[6], k[7]);
      *(float4*)ov = make_float4(v[0], v[1], v[2], v[3]); *(float4*)(ov + 4) = make_float4(v[4], v[5], v[6], v[7]);
    }
  }
  if (tid < 128) {
    const int row = tid >> 3, c = (tid & 7) * 8;
    const int hl = row >> 2, t = row & 3;
    float q[8];
    unpack8(*(const uint4*)(z + (size_t)(M_P + b * 4 + t) * ZLD + 1792 + (kvh * 4 + hl) * 64 + c), q);
#pragma unroll
    for (int i = 0; i < 8; ++i) Ql[row * 64 + c + i] = q[i];
  }
  __syncthreads();
  const int row = tid >> 5, jl = tid & 31;
  const int t = row & 3, hq = kvh * 4 + (row >> 2);
  float sc[5];
  float mx = -1e30f;
#pragma unroll
  for (int jj = 0; jj < 5; ++jj) {
    const int j = jl + 32 * jj;
    float s = -1e30f;
    if (j < 132 && j > t && j <= t + 128) {
      float a = 0.f;
#pragma unroll 8
      for (int d = 0; d < 64; ++d) a += Ql[row * 64 + d] * Kl[j * 65 + d];
      s = a * 0.125f;
    }
    sc[jj] = s; mx = fmaxf(mx, s);
    __builtin_amdgcn_sched_barrier(0);
  }
#pragma unroll
  for (int o = 16; o >= 1; o >>= 1) mx = fmaxf(mx, __shfl_xor(mx, o, 64));
  const float sink = p.in[20][l * 8 + hq];
  mx = fmaxf(mx, sink);
  float sum = 0.f;
#pragma unroll
  for (int jj = 0; jj < 5; ++jj) { sc[jj] = __expf(sc[jj] - mx); sum += sc[jj]; }
#pragma unroll
  for (int o = 16; o >= 1; o >>= 1) sum += __shfl_xor(sum, o, 64);
  const float rden = 1.f / (sum + __expf(sink - mx));
#pragma unroll
  for (int jj = 0; jj < 5; ++jj) { const int j = jl + 32 * jj; if (j < 136) Pl[row * 136 + j] = sc[jj] * rden; }
  __syncthreads();
  {
    const int d = jl * 2;
    float o0 = 0.f, o1 = 0.f;
#pragma unroll 4
    for (int j = 0; j < 132; ++j) { const float pr = Pl[row * 136 + j]; o0 += pr * Vl[j * 65 + d]; o1 += pr * Vl[j * 65 + d + 1]; }
    if (!dry) *(unsigned*)(z + (size_t)(M_P + b * 4 + t) * ZLD + 1792 + hq * 64 + d) = pack2(o0, o1);
  }
}

__device__ __forceinline__ void phase_convgelu(const Params& p, int l, bool dry = false) {
  u16* cu = (u16*)(p.ws + WS_CU);
  const float* cw = p.in[26] + (size_t)l * 3 * 2816;
  const float* cb = p.in[27] + (size_t)l * 2816;
  for (int it = blockIdx.x; it < 1056; it += gridDim.x) {
    const int tid = opq(threadIdx.x);
    if (tid >= 352) continue;
    const int j0 = tid * 8;
    float w0[8], w1[8], w2[8], bb[8];
#pragma unroll
    for (int i = 0; i < 8; ++i) { w0[i] = cw[j0 + i]; w1[i] = cw[2816 + j0 + i]; w2[i] = cw[5632 + j0 + i]; bb[i] = cb[j0 + i]; }
    float c1[8], c2[8];
    for (int rr = 0; rr < 16; ++rr) {
      const int row = it * 16 + rr;
      const bool prompt = row < M_P;
      int b, t;
      if (prompt) { b = row >> 13; t = row & 8191; } else { b = (row - M_P) >> 2; t = (row - M_P) & 3; }
      if (t == 0) {
        if (prompt) {
#pragma unroll
          for (int i = 0; i < 8; ++i) { c1[i] = 0.f; c2[i] = 0.f; }
        } else {
          const float* st = p.in[6] + (size_t)((l * 128 + b) * 2) * 2816 + j0;
#pragma unroll
          for (int i = 0; i < 8; ++i) { c2[i] = st[i]; c1[i] = st[2816 + i]; }
        }
      } else if (rr == 0) {
        unpack8(*(const uint4*)(cu + (size_t)(row - 1) * 5632 + j0), c1);
        if (t >= 2) unpack8(*(const uint4*)(cu + (size_t)(row - 2) * 5632 + j0), c2);
        else {
#pragma unroll
          for (int i = 0; i < 8; ++i) c2[i] = 0.f;
        }
      }
      float c0[8], up[8], a[8];
      unpack8(*(const uint4*)(cu + (size_t)row * 5632 + j0), c0);
      unpack8(*(const uint4*)(cu + (size_t)row * 5632 + 2816 + j0), up);
#pragma unroll
      for (int i = 0; i < 8; ++i) {
        const float cv = bb[i] + w0[i] * c2[i] + w1[i] * c1[i] + w2[i] * c0[i];
        a[i] = gelu_fast(cv) * up[i];
      }
      if (!dry) *(uint4*)(cu + (size_t)row * 5632 + 2816 + j0) = pack8(a);
      if (prompt && t >= 8190) {
        float* o = p.out + O_PCONV + (size_t)((l * 2 + b) * 2 + (t - 8190)) * 2816 + j0;
        *(float4*)o = make_float4(c0[0], c0[1], c0[2], c0[3]); *(float4*)(o + 4) = make_float4(c0[4], c0[5], c0[6], c0[7]);
      } else if (!prompt && t >= 2) {
        float* o = p.out + O_SCONV + (size_t)((l * 128 + b) * 2 + (t - 2)) * 2816 + j0;
        *(float4*)o = make_float4(c0[0], c0[1], c0[2], c0[3]); *(float4*)(o + 4) = make_float4(c0[4], c0[5], c0[6], c0[7]);
      }
#pragma unroll
      for (int i = 0; i < 8; ++i) { c2[i] = c1[i]; c1[i] = c0[i]; }
    }
  }
}

__device__ __forceinline__ void phase_final(const Params& p) {
  float* X = p.out;
  const float* g = p.in[29];
  for (int it = blockIdx.x; it < 2112; it += gridDim.x) {
    const int tid = opq(threadIdx.x);
    const int lane = tid & 63;
    const int row = it * 8 + (tid >> 6);
    float4 v[4];
    float ss = 0.f;
#pragma unroll
    for (int i = 0; i < 4; ++i) {
      v[i] = *(const float4*)(X + (size_t)row * 1024 + i * 256 + lane * 4);
      if (gridDim.x == 256 && row >= M_P) {
        const u16* partb = (const u16*)(p.ws + WS_DP) + (size_t)(row - M_P) * 1024 + i * 256 + lane * 4;
        for (int k = 0; k < 11; ++k) { const uint2 q = *(const uint2*)(partb + (size_t)k * 512 * 1024);
          v[i].x += __uint_as_float(q.x << 16); v[i].y += __uint_as_float(q.x & 0xFFFF0000u); v[i].z += __uint_as_float(q.y << 16); v[i].w += __uint_as_float(q.y & 0xFFFF0000u); }
      }
      ss += v[i].x * v[i].x + v[i].y * v[i].y + v[i].z * v[i].z + v[i].w * v[i].w;
    }
    ss = wave_sum(ss);
    const float rs = rsqrtf(ss * (1.f / 1024.f) + 1e-6f);
#pragma unroll
    for (int i = 0; i < 4; ++i) {
      const float4 gg = *(const float4*)(g + i * 256 + lane * 4);
      *(float4*)(X + (size_t)row * 1024 + i * 256 + lane * 4) =
          make_float4(v[i].x * rs * gg.x, v[i].y * rs * gg.y, v[i].z * rs * gg.z, v[i].w * rs * gg.w);
    }
  }
}

#define XB_TMO      128
#define XB_XCNT(j)  (256  + 64 * (j))
#define XB_XSUB(j)  (1280 + 64 * (j))
#define XB_XGEN(j)  (2304 + 64 * (j))
#define XB_TOP      3328
#define XB_TOPGEN   3392
#define XCD_BAR_WORDS 3456
#define XB_SPIN_CAP (1u << 18)
#define LAS __attribute__((address_space(3)))

__device__ __forceinline__ unsigned xb_ld(unsigned* p)              { return __hip_atomic_load(p, __ATOMIC_RELAXED, __HIP_MEMORY_SCOPE_AGENT); }
__device__ __forceinline__ unsigned xb_add(unsigned* p, unsigned v) { return __hip_atomic_fetch_add(p, v, __ATOMIC_RELAXED, __HIP_MEMORY_SCOPE_AGENT); }
__device__ __forceinline__ unsigned xb_xcc_id() { return (unsigned)__builtin_amdgcn_s_getreg((3 << 11) | 20) & 0xFu; }
#define XB_SPIN(cond, bar) do { unsigned _sp = 0; while (cond) { __builtin_amdgcn_s_sleep(1); \
    if ((++_sp & 255u) == 0u) { if (xb_ld(&(bar)[XB_TMO])) break; if (_sp > XB_SPIN_CAP) { atomicAdd(&(bar)[XB_TMO], 1u); break; } } } } while (0)

struct XcdBarrier {
    unsigned* bar; unsigned x;
    volatile LAS unsigned* st;
};

__device__ __forceinline__ XcdBarrier xcd_barrier_post(unsigned* bar, volatile LAS unsigned* st) {
    XcdBarrier b; b.bar = bar; b.x = xb_xcc_id(); b.st = st;
    if (threadIdx.x == 0) (void)xb_add(&bar[XB_XCNT(b.x)], 1u);
    return b;
}
__device__ __forceinline__ void xcd_barrier_complete(unsigned* bar, unsigned x, unsigned& nloc, unsigned& nx) {
    const unsigned G = gridDim.x * gridDim.y * gridDim.z;
    unsigned sum, cnt, mine, sp = 0u;
    for (;;) {
        sum = 0u; cnt = 0u; mine = 0u;
#pragma unroll
        for (unsigned j = 0; j < 16; ++j) { const unsigned c = xb_ld(&bar[XB_XCNT(j)]); sum += c; cnt += (c > 0u) ? 1u : 0u; mine = (j == x) ? c : mine; }
        if (sum == G) break;
        __builtin_amdgcn_s_sleep(1);
        if ((++sp & 255u) == 0u) { if (xb_ld(&bar[XB_TMO])) break; if (sp > XB_SPIN_CAP) { atomicAdd(&bar[XB_TMO], 1u); break; } }
    }
    nloc = mine > 0u ? mine : 1u; nx = cnt > 0u ? cnt : 1u;
}

__device__ __forceinline__ void xcd_barrier(const XcdBarrier& b) {
    asm volatile("s_waitcnt vmcnt(0)" ::: "memory");
    __syncthreads();
    if (threadIdx.x == 0) {
        unsigned* bar = b.bar;
        __builtin_amdgcn_s_waitcnt(0);
        unsigned nloc = b.st[0], nx = b.st[1];
        if (nloc == 0u) { xcd_barrier_complete(bar, b.x, nloc, nx); b.st[0] = nloc; b.st[1] = nx; }
        const unsigned old = xb_add(&bar[XB_XSUB(b.x)], 1u);
        const unsigned gen = old / nloc;
        if (old + 1u == (gen + 1u) * nloc) {
            __builtin_amdgcn_fence(__ATOMIC_RELEASE, "agent");
            asm volatile("s_waitcnt vmcnt(0)" ::: "memory");
            const unsigned og = xb_add(&bar[XB_TOP], 1u);
            const unsigned tg = og / nx;
            if (og + 1u == (tg + 1u) * nx) xb_add(&bar[XB_TOPGEN], 1u);
            else XB_SPIN(xb_ld(&bar[XB_TOPGEN]) == tg, bar);
            __builtin_amdgcn_fence(__ATOMIC_ACQUIRE, "agent");
            xb_add(&bar[XB_XGEN(b.x)], 1u);
            asm volatile("s_waitcnt vmcnt(0)" ::: "memory");
        } else {
            XB_SPIN(xb_ld(&bar[XB_XGEN(b.x)]) == gen, bar);
            __builtin_amdgcn_fence(__ATOMIC_ACQUIRE, "agent");
            asm volatile("s_waitcnt vmcnt(0)" ::: "memory");
        }
    }
    __syncthreads();
}

#define WS_BAR 256000000ull
#if COOP
#ifndef SYNC_RPT
#define SYNC_RPT 1
#endif
#define PH_SYNC(idx) do { if ((idx) + 1 < ph_hi && (idx) >= ph_lo) { for (int sr_ = 0; sr_ < SYNC_RPT; ++sr_) xcd_barrier(xb); } } while (0)
#else
#define PH_SYNC(idx) do { } while (0)
#endif
#define PH_ON(idx, bit) (((KMASK >> (bit)) & 1) && ph_lo <= (idx) && (idx) < ph_hi)

__device__ __forceinline__ Params load_params() {
  auto kp0 = __builtin_amdgcn_kernarg_segment_ptr();
  asm volatile("" : "+s"(kp0));
  auto kq = (const __constant__ unsigned long long*)kp0;
  Params p;
#pragma unroll
  for (int i = 0; i < 30; ++i) p.in[i] = (const float*)kq[i];
  p.out = (float*)kq[30];
  p.ws = (unsigned char*)kq[31];
  p.ph_lo = 0; p.ph_hi = 0;
  return p;
}

template <int KMASK, int l>
__device__ __forceinline__ void layer_phases(int ph_lo, int ph_hi, unsigned char* lds_raw, const XcdBarrier& xb) {
  float* ldsf = (float*)lds_raw;
  u16* ldsh = (u16*)lds_raw;
  const int base = l * 12;
  if (PH_ON(base + 0, 0)) { const Params p = load_params(); RPT(0) phase_prep(p, l, 0, ldsf); }
  PH_SYNC(base + 0);
  if (PH_ON(base + 1, 1)) {
    const Params p = load_params();
    EpiInproj E; E.z = (u16*)(p.ws + WS_Z); E.out = p.out; E.l = l;
    RPT(1) run_gemm(lds_raw, (const u16*)(p.ws + WS_H), 1024, (const u16*)(p.ws + WS_WT) + WT_IN, 2560, 1024, E);
  }
  PH_SYNC(base + 1);
  if (PH_ON(base + 2, 2)) {
    const Params p = load_params();
    for (int it = blockIdx.x; it < 264; it += gridDim.x) rope_item(p, l, it, false);
    if (blockIdx.x < 64) rwkv_item(p, l, 2048 + blockIdx.x, ldsf, false);
    {
      const Params p2 = load_params();
      int i0, n;
      if (gridDim.x == 256) { if (blockIdx.x < 64) { i0 = blockIdx.x * 5; n = 5; } else { i0 = 320 + (blockIdx.x - 64) * 9; n = 9; } }
      else { i0 = 0; n = 0; }
      RPT(2) {
        if (gridDim.x == 256) { for (int i = 0; i < n; ++i) rwkv_item2(p2, l, i0 + i, ldsf); }
        else { for (int it = blockIdx.x; it < 2048; it += gridDim.x) rwkv_item2(p2, l, it, ldsf); }
      }
    }
  }
  PH_SYNC(base + 2);
  if (PH_ON(base + 3, 3)) {
    const Params p = load_params();
    if (blockIdx.x < 16) { RPT(3) rwkv_scan(p, l, blockIdx.x, ldsf, DRY(3)); }
    else {
      RPT(15) for (int it = blockIdx.x - 16; it < 512; it += gridDim.x - 16) {
        if (it < 256) attn_prompt(p, l, it, ldsh, DRY(15)); else attn_sample(p, l, it - 256, ldsf, DRY(15));
      }
    }
  }
  PH_SYNC(base + 3);
  if (PH_ON(base + 4, 4)) {
    const Params p = load_params();
    RPT(4) for (int it = blockIdx.x * 4; it < 2048; it += gridDim.x * 4) rwkv_out4(p, l, it, ldsf);
  }
  PH_SYNC(base + 4);
  if (PH_ON(base + 5, 5)) {
    const Params p = load_params();
    EpiStoreBf16 E1; E1.O = (u16*)(p.ws + WS_T1); E1.ldc = 1024;
    RPT(5) run_gemm(lds_raw, (const u16*)(p.ws + WS_Z), ZLD, (const u16*)(p.ws + WS_WT) + WT_BRA, 1024, 512, E1);
    EpiStoreBf16 E2; E2.O = (u16*)(p.ws + WS_T2); E2.ldc = 1024;
    run_gemm(lds_raw, (const u16*)(p.ws + WS_Z) + 1792, ZLD, (const u16*)(p.ws + WS_WT) + WT_BRB, 1024, 512, E2);
  }
  PH_SYNC(base + 5);
  if (PH_ON(base + 6, 6)) {
    const Params p = load_params();
    EpiMerge E; E.t1 = (const u16*)(p.ws + WS_T1); E.t2 = (const u16*)(p.ws + WS_T2); E.mg = (u16*)(p.ws + WS_MG);
    RPT(6) run_gemm(lds_raw, (const u16*)(p.ws + WS_H), 1024, (const u16*)(p.ws + WS_WT) + WT_G, 2048, 1024, E);
  }
  PH_SYNC(base + 6);
  if (PH_ON(base + 7, 7)) {
    const Params p = load_params();
    EpiResid E; E.X = p.out;
    RPT(7) {
      E.dry = DRY(7); E.X = p.out; E.pbf = nullptr;
      if (gridDim.x == 256) {
        E.atomic = false; E.rowoff = 0;
        run_gemm_ex(lds_raw, (const u16*)(p.ws + WS_MG), 1024, (const u16*)(p.ws + WS_WT) + WT_OUT, 1024, M_P, 1024, 1024, 256, (int)blockIdx.x, E);
        const int ks = blockIdx.x >> 3;
        E.atomic = true; E.rowoff = 0; E.X = (float*)(p.ws + WS_T1) + (size_t)ks * 512 * 1024;
        run_gemm_ex(lds_raw, (const u16*)(p.ws + WS_MG) + (size_t)M_P * 1024 + ks * 256, 1024, (const u16*)(p.ws + WS_WT) + WT_OUT + ks * 256, 1024,
                    512, 1024, 256, 8, (blockIdx.x < 32) ? (int)(blockIdx.x & 7) : -1, E);
      } else {
        E.atomic = false; E.rowoff = 0;
        run_gemm(lds_raw, (const u16*)(p.ws + WS_MG), 1024, (const u16*)(p.ws + WS_WT) + WT_OUT, 1024, 1024, E);
      }
    }
  }
  PH_SYNC(base + 7);
  if (PH_ON(base + 8, 8)) { const Params p = load_params(); RPT(8) phase_prep(p, l, 1, ldsf); }
  PH_SYNC(base + 8);
  if (PH_ON(base + 9, 9)) {
    const Params p = load_params();
    EpiFfnIn E; E.cu = (u16*)(p.ws + WS_CU);
    RPT(9) run_gemm(lds_raw, (const u16*)(p.ws + WS_H), 1024, (const u16*)(p.ws + WS_WTF) + WT_FIN, 5632, 1024, E);
  }
  PH_SYNC(base + 9);
  if (PH_ON(base + 10, 10)) { const Params p = load_params(); RPT(10) phase_convgelu(p, l, DRY(10)); }
  PH_SYNC(base + 10);
  if (PH_ON(base + 11, 11)) {
    const Params p = load_params();
    EpiResid E; E.X = p.out;
    RPT(11) {
      E.dry = DRY(11); E.X = p.out; E.pbf = nullptr;
      const u16* Aa = (const u16*)(p.ws + WS_CU) + 2816;
      const u16* Bd = (const u16*)(p.ws + WS_WTF) + WT_FDN;
      if (gridDim.x == 256) {
        E.atomic = false; E.rowoff = 0;
        run_gemm_ex(lds_raw, Aa, 5632, Bd, 2816, M_P, 1024, 2816, 256, (int)blockIdx.x, E);
        const int ks = blockIdx.x >> 3;
        E.atomic = true; E.rowoff = 0; E.X = nullptr; E.pbf = (u16*)(p.ws + WS_DP) + (size_t)ks * 512 * 1024;
        run_gemm_ex(lds_raw, Aa + (size_t)M_P * 5632 + ks * 256, 5632, Bd + ks * 256, 2816, 512, 1024, 256, 8, (blockIdx.x < 88) ? (int)(blockIdx.x & 7) : -1, E);
      } else {
        E.atomic = false; E.rowoff = 0;
        run_gemm(lds_raw, Aa, 5632, Bd, 1024, 2816, E);
      }
    }
  }
  PH_SYNC(base + 11);
}

template <int KMASK>
__global__ void __launch_bounds__(NT) fwd_kernel(Params pin) {
  extern __shared__ __attribute__((aligned(16))) unsigned char lds_raw[];
  const int ph_lo = pin.ph_lo, ph_hi = pin.ph_hi;
  XcdBarrier xb;
  {
    volatile LAS unsigned* st = (volatile LAS unsigned*)(lds_raw + (LDS_BYTES - 16));
    if (threadIdx.x < 2) st[threadIdx.x] = 0u;
    __syncthreads();
    xb = xcd_barrier_post((unsigned*)(pin.ws + WS_BAR), st);
  }
  if (ph_hi > 100000) cg::this_grid().sync();
  layer_phases<KMASK, 0>(ph_lo, ph_hi, lds_raw, xb);
  layer_phases<KMASK, 1>(ph_lo, ph_hi, lds_raw, xb);
  if (PH_ON(NPH - 1, 12)) { const Params p = load_params(); phase_final(p); }
}

extern "C" void kernel_launch(void* const* d_in, const int* in_sizes, int n_in, void* d_out, int out_size, void* d_ws,
                              size_t ws_size, hipStream_t stream) {
  static int grid = 0;
  if (grid == 0) {
    int dev = 0, cus = 0;
    (void)hipGetDevice(&dev);
    (void)hipDeviceGetAttribute(&cus, hipDeviceAttributeMultiprocessorCount, dev);
    grid = cus > 0 ? cus : 256;
    (void)hipFuncSetAttribute((const void*)fwd_kernel<PHMASK>, hipFuncAttributeMaxDynamicSharedMemorySize, LDS_BYTES);
    (void)hipGetLastError();
  }
  Params p{};
  for (int i = 0; i < 30; ++i) p.in[i] = (const float*)d_in[i];
  p.out = (float*)d_out;
  p.ws = (unsigned char*)d_ws;
#if COOP
  (void)hipMemsetAsync((unsigned char*)d_ws + WS_BAR, 0, XCD_BAR_WORDS * 4, stream);
  p.ph_lo = 0; p.ph_hi = NPH;
  void* args[] = {&p};
  hipError_t e = hipLaunchCooperativeKernel((const void*)fwd_kernel<PHMASK>, dim3(grid), dim3(NT), args, LDS_BYTES, stream);
  if (e != hipSuccess) fprintf(stderr, "cooperative launch failed: %s (grid %d)\n", hipGetErrorString(e), grid);
#else
  for (int ph = 0; ph < NPH; ++ph) {
    p.ph_lo = ph; p.ph_hi = ph + 1;
    hipLaunchKernelGGL(fwd_kernel<PHMASK>, dim3(grid), dim3(NT), LDS_BYTES, stream, p);
  }
#endif
}
```

```cpp
#include <hip/hip_runtime.h>
#include <hip/hip_bf16.h>
#include <hip/hip_cooperative_groups.h>
#include <cstdio>
namespace cg = cooperative_groups;

typedef __attribute__((ext_vector_type(8))) short bf16x8;
typedef __attribute__((ext_vector_type(16))) float f32x16;
typedef unsigned short u16;

#ifndef PHMASK
#define PHMASK 0x1FFF
#endif
#ifndef T3
#define T3 7
#endif
#ifndef P2SEL
#define P2SEL 7
#endif
#ifndef RPT_MASK
#define RPT_MASK 0
#endif
#ifndef RPT_N
#define RPT_N 1
#endif
#define RPT(bit) for (int rp_ = 0; rp_ < (((RPT_MASK >> (bit)) & 1) ? 1 + RPT_N : 1); ++rp_)
#define RPT_CNT(bit) (((RPT_MASK >> (bit)) & 1) ? 1 + RPT_N : 1)
#define DRY(bit) (opq(rp_) + 1 < RPT_CNT(bit))
#ifndef R1P
#define R1P 1
#endif
#ifndef COOP
#define COOP 1
#endif

#define NT 512
#define M_TOT 16896
#define M_P 16384
#define ZLD 2560
#define NPH 25

#define WS_WT   0ull
#define WS_H    13631488ull
#define WS_Z    48234496ull
#define WS_R    134742016ull
#define WS_PP   (WS_R)
#define WS_GC   (WS_R + 16777216ull)
#define WS_Q    (WS_R + 17301504ull)
#define WS_W2   (WS_R + 50855936ull)
#define WS_YL   (WS_R + 67633152ull)
#define WS_BO   (WS_R + 84410368ull)
#define WS_GA   (WS_R + 101187584ull)
#define WS_T1   (WS_R)
#define WS_T2   (WS_R + 34603008ull)
#define WS_MG   (WS_R + 69206016ull)
#define WS_WTF  (WS_Z)
#define WS_CU   (WS_Z + 17301504ull)
#define WS_LW  267634432ull
#define WS_DP  256100096ull
#define WT_IN  0
#define WT_G   2621440
#define WT_BRA 4718592
#define WT_BRB 5242880
#define WT_OUT 5767168
#define WT_FIN 0
#define WT_FDN 5767168
#define O_PSHIFT 17301504
#define O_PWKV   17308672
#define O_PK     17439744
#define O_PV     17505280
#define O_PCONV  17570816
#define O_SSHIFT 17593344
#define O_SWKV   18052096
#define O_SK     26440704
#define O_SV     30635008
#define O_SCONV  34829312

#define LDS_BYTES 151552

struct Params {
  const float* in[30];
  float* out;
  unsigned char* ws;
  int ph_lo, ph_hi;
};

typedef float f2v_ __attribute__((ext_vector_type(2)));
typedef __bf16 b2v_ __attribute__((ext_vector_type(2)));
__device__ __forceinline__ unsigned pack2(float a, float b) { f2v_ v = {a, b}; b2v_ r = __builtin_convertvector(v, b2v_); return __builtin_bit_cast(unsigned, r); }
__device__ __forceinline__ u16 f2bf(float f) { return (u16)(pack2(f, f) & 0xFFFFu); }
__device__ __forceinline__ float bf2f(u16 h) { return __uint_as_float(((unsigned)h) << 16); }
__device__ __forceinline__ float sigm(float x) { return __builtin_amdgcn_rcpf(1.f + __expf(-x)); }
__device__ __forceinline__ void unpack8(uint4 u, float* o) {
  o[0] = __uint_as_float(u.x << 16); o[1] = __uint_as_float(u.x & 0xFFFF0000u);
  o[2] = __uint_as_float(u.y << 16); o[3] = __uint_as_float(u.y & 0xFFFF0000u);
  o[4] = __uint_as_float(u.z << 16); o[5] = __uint_as_float(u.z & 0xFFFF0000u);
  o[6] = __uint_as_float(u.w << 16); o[7] = __uint_as_float(u.w & 0xFFFF0000u);
}
__device__ __forceinline__ uint4 pack8(const float* f) {
  uint4 u; u.x = pack2(f[0], f[1]); u.y = pack2(f[2], f[3]); u.z = pack2(f[4], f[5]); u.w = pack2(f[6], f[7]); return u;
}
__device__ __forceinline__ float gelu_fast(float v) {
  const float av = fabsf(v), d = av * 0.2316418882f + 1.0f;
  const float t = __builtin_amdgcn_rcpf(d);
  float q = t * 0.5307027145f + (-0.7265760135f); q = q * t + 0.7107068705f; q = q * t + (-0.142248368f); q = q * t + 0.127414796f; q = q * t;
  const float e = __builtin_amdgcn_exp2f((v * v) * (-0.72134752044f));
  const float m = v * (q * e);
  return v < 0.f ? m : v - m;
}
__device__ __forceinline__ int opq(int x) { asm volatile("" : "+v"(x)); return x; }
__device__ __forceinline__ float wave_sum(float x) {
#pragma unroll
  for (int o = 32; o >= 1; o >>= 1) x += __shfl_xor(x, o, 64);
  return x;
}

namespace pg8 {
#define PG8_LAS __attribute__((address_space(3)))
typedef unsigned short bf16_t;
typedef short bf16x8 __attribute__((ext_vector_type(8)));
typedef float f32x4 __attribute__((ext_vector_type(4)));
typedef unsigned u32x4 __attribute__((ext_vector_type(4)));
constexpr int BM = 256, BK = 64, HALF = 128, HTB = HALF * BK * 2  , STAGE_BYTES = 8 * HTB, NXCD = 8, WGM = 8;
__host__ __device__ __forceinline__ int lds_byte(int r, int c) { const int st = (r >> 4) * 2 + (c >> 5), rr = r & 15, cc = c & 31, ob = rr * 64 + cc * 2; return st * 1024 + (ob ^ (((ob >> 9) & 1) << 5)); }
__host__ __device__ __forceinline__ void stage_rc(int b, int& R, int& C) { const int st = b / 1024, sb = b % 1024, swz = sb ^ (((sb >> 9) & 1) << 5); R = (st >> 1) * 16 + swz / 64; C = (st & 1) * 32 + (swz % 64) / 2; }
__host__ __device__ __forceinline__ int perm32(int rho) { const int n = rho >> 4, i = rho & 15; return 8 * (i >> 2) + 4 * n + (i & 3); }
struct Unit { int pm, pn; };
struct Gemm { const bf16_t* A; const bf16_t* Bt; int M, N, K, lda, ldb; };
struct StaticOrder {
    int nM, nN, nwg, G, c;
    __host__ __device__ void init(int M, int N, int G_, int c_) { nM = M / BM; nN = N / BM; nwg = nM * nN; G = G_; c = c_; }
    __host__ __device__ bool next(int i, Unit& u) const {
        const long L = (long)i * G + c; if (L >= nwg) return false;
        int wgid = (int)L; { const int q = nwg / NXCD, r = nwg % NXCD, xcd = wgid % NXCD, off = wgid / NXCD; wgid = (xcd < r ? xcd * (q + 1) : r * (q + 1) + (xcd - r) * q) + off; }
        const int nig = WGM * nN, gid = wgid / nig, fm = gid * WGM, gsz = (nM - fm) < WGM ? (nM - fm) : WGM;
        u.pm = fm + ((wgid % nig) % gsz); u.pn = (wgid % nig) / gsz; return true;
    }
    __device__ __forceinline__ void a_ready(const Unit&) const {}
    __device__ __forceinline__ void done(const Unit&) const {}
};
__device__ __forceinline__ unsigned cvt_pk_bf16(float lo, float hi) { return ::pack2(lo, hi); }
template <class Epi, class Sched, bool STAMP = false>
__device__ __forceinline__ void gemm_phase(PG8_LAS unsigned char* lds, const Gemm g, const Sched& S, const Epi& E, unsigned long long* stamps) {
    const int tid = ::opq(threadIdx.x), wid = __builtin_amdgcn_readfirstlane(tid >> 6), lane = tid & 63, wr = wid >> 2, wc = wid & 3, fr = lane & 15, fq = lane >> 4;
    const int K = g.K, nt = K / BK;
    int ts_lo = 0, ts_hi = 0, nts = 0; const unsigned long long rt_entry = 0ull;
#define PG8_STAMP() do { if (STAMP && wid == 0 && nts < 64) { const unsigned long long _c = (unsigned long long)clock64(); \
        ts_lo = (lane == nts) ? (int)(unsigned)_c : ts_lo; ts_hi = (lane == nts) ? (int)(unsigned)(_c >> 32) : ts_hi; ++nts; } } while (0)
    PG8_STAMP();
    unsigned voffA[2], voffB[2];
#pragma unroll
    for (int i = 0; i < 2; ++i) { int R, C; stage_rc(tid * 16 + i * 8192, R, C); const int Rb = Epi::PERM ? ((R & ~31) + perm32(R & 31)) : R;
        voffA[i] = (unsigned)(R * g.lda + C) * 2u; voffB[i] = (unsigned)(Rb * g.ldb + C) * 2u; }
    const size_t kstep = (size_t)(BK * 2);
    const size_t hstep = (size_t)HALF * g.ldb * 2;
    const size_t tstep = 2 * hstep; const size_t hstepA = (size_t)HALF * g.lda * 2; const size_t tstepA = 2 * hstepA;
    const unsigned ldsw = (unsigned)wid * 1024u;
    const int aoff = lds_byte(wr * 64 + fr, fq * 8), boff = lds_byte(wc * 32 + fr, fq * 8);
#define PG8_SA(b, h) (((b) * 2 + (h)) * HTB)
#define PG8_SB(b, h) ((4 + (b) * 2 + (h)) * HTB)
#define PG8_STAGE(bufoff, gbase, voff) do { _Pragma("unroll") for (int _i = 0; _i < 2; ++_i) \
        __builtin_amdgcn_global_load_lds((const unsigned*)((const char*)(gbase) + (voff)[_i]), (PG8_LAS unsigned*)(lds + (bufoff) + ldsw + _i * 8192), 16, 0, 0); } while (0)
#define PG8_LDA(dst, b, h) do { _Pragma("unroll") for (int m = 0; m < 4; ++m) _Pragma("unroll") for (int k = 0; k < 2; ++k) dst[m][k] = *(const PG8_LAS bf16x8*)(lds + PG8_SA(b, h) + aoff + m * 2048 + k * 1024); } while (0)
#define PG8_LDB(dst, b, h) do { _Pragma("unroll") for (int n = 0; n < 2; ++n) _Pragma("unroll") for (int k = 0; k < 2; ++k) dst[n][k] = *(const PG8_LAS bf16x8*)(lds + PG8_SB(b, h) + boff + n * 2048 + k * 1024); } while (0)
#define PG8_MMA(ai, bj, At, Bt) do { __builtin_amdgcn_s_setprio(1); _Pragma("unroll") for (int m = 0; m < 4; ++m) _Pragma("unroll") for (int n = 0; n < 2; ++n) _Pragma("unroll") for (int k = 0; k < 2; ++k) \
        acc[ai][bj][m][n] = __builtin_amdgcn_mfma_f32_16x16x32_bf16(Bt[n][k], At[m][k], acc[ai][bj][m][n], 0, 0, 0); __builtin_amdgcn_s_setprio(0); } while (0)
#define PG8_WAIT_V(n) asm volatile("s_waitcnt vmcnt(" #n ")" ::: "memory")
#define PG8_WAIT_L(n) asm volatile("s_waitcnt lgkmcnt(" #n ")" ::: "memory")
#define PG8_BAR __builtin_amdgcn_s_barrier()
#define PG8_SCHED __builtin_amdgcn_sched_barrier(0)
    Unit cur, nxt; int ui = 0;
    if (!S.next(0, cur)) return;
    f32x4 acc[2][2][4][2];
#pragma unroll
    for (int a = 0; a < 2; ++a)
#pragma unroll
        for (int b = 0; b < 2; ++b)
#pragma unroll
            for (int m = 0; m < 4; ++m)
#pragma unroll
                for (int n = 0; n < 2; ++n) acc[a][b][m][n] = (f32x4){0.f, 0.f, 0.f, 0.f};
    bf16x8 At[4][2], B0[2][2], B1[2][2];
    const char* cA = (const char*)g.A + (size_t)cur.pm * tstepA; const char* cB = (const char*)g.Bt + (size_t)cur.pn * tstep;
    S.a_ready(cur);
    PG8_STAGE(PG8_SB(0, 0), cB, voffB); PG8_STAGE(PG8_SA(0, 0), cA, voffA); PG8_STAGE(PG8_SB(0, 1), cB + hstep, voffB); PG8_STAGE(PG8_SA(0, 1), cA + hstepA, voffA);
    if (wr == 1) PG8_BAR;
    PG8_WAIT_V(4); PG8_BAR;
    PG8_STAGE(PG8_SB(1, 0), cB + kstep, voffB); PG8_STAGE(PG8_SA(1, 0), cA + kstep, voffA); PG8_STAGE(PG8_SB(1, 1), cB + hstep + kstep, voffB);
    PG8_WAIT_V(6); PG8_BAR;
    PG8_STAMP();
    for (;;) {
        const bool has_next = S.next(ui + 1, nxt);
        const char* nA = has_next ? (const char*)g.A + (size_t)nxt.pm * tstepA : cA; const char* nB = has_next ? (const char*)g.Bt + (size_t)nxt.pn * tstep : cB;
        for (int t = 0; t < nt; t += 2) {
            const bool last = (t == nt - 2);
            const char* a1 = cA + (size_t)(t + 1) * kstep;
            const char* a2 = last ? nA : cA + (size_t)(t + 2) * kstep; const char* b2 = last ? nB : cB + (size_t)(t + 2) * kstep;
            const char* a3 = a2 + kstep; const char* b3 = b2 + kstep;
            if (last && has_next) S.a_ready(nxt);
            PG8_LDB(B0, 0, 0); PG8_SCHED; PG8_LDA(At, 0, 0); PG8_STAGE(PG8_SA(1, 1), a1 + hstepA, voffA);
            PG8_WAIT_L(8); PG8_BAR; PG8_WAIT_L(0); PG8_MMA(0, 0, At, B0); PG8_BAR; PG8_SCHED;
            PG8_LDB(B1, 0, 1); PG8_STAGE(PG8_SB(0, 0), b2, voffB);
            PG8_BAR; PG8_WAIT_L(0); PG8_MMA(0, 1, At, B1); PG8_BAR;
            PG8_LDA(At, 0, 1); PG8_STAGE(PG8_SA(0, 0), a2, voffA);
            PG8_BAR; PG8_WAIT_L(0); PG8_MMA(1, 0, At, B0); PG8_BAR; PG8_SCHED;
            PG8_STAGE(PG8_SB(0, 1), b2 + hstep, voffB);
            PG8_WAIT_V(6); PG8_BAR; PG8_MMA(1, 1, At, B1); PG8_BAR;
            PG8_LDB(B0, 1, 0); PG8_SCHED; PG8_LDA(At, 1, 0); PG8_STAGE(PG8_SA(0, 1), a2 + hstepA, voffA);
            PG8_WAIT_L(8); PG8_BAR; PG8_WAIT_L(0); PG8_MMA(0, 0, At, B0); PG8_BAR; PG8_SCHED;
            PG8_LDB(B1, 1, 1); PG8_STAGE(PG8_SB(1, 0), b3, voffB);
            PG8_BAR; PG8_WAIT_L(0); PG8_MMA(0, 1, At, B1); PG8_BAR;
            PG8_LDA(At, 1, 1); PG8_STAGE(PG8_SA(1, 0), a3, voffA);
            PG8_BAR; PG8_WAIT_L(0); PG8_MMA(1, 0, At, B0); PG8_BAR; PG8_SCHED;
            PG8_STAGE(PG8_SB(1, 1), b3 + hstep, voffB);
            PG8_WAIT_V(6); PG8_BAR; PG8_MMA(1, 1, At, B1); PG8_BAR;
        }
        PG8_STAMP();
        if constexpr (!Epi::AFTER_DRAIN) { E(acc, cur, wr, wc, fr, fq); S.done(cur); }
        PG8_STAMP();
        if (!has_next) break;
#pragma unroll
        for (int a = 0; a < 2; ++a)
#pragma unroll
            for (int b = 0; b < 2; ++b)
#pragma unroll
                for (int m = 0; m < 4; ++m)
#pragma unroll
                    for (int n = 0; n < 2; ++n) acc[a][b][m][n] = (f32x4){0.f, 0.f, 0.f, 0.f};
        cur = nxt; cA = nA; cB = nB; ++ui;
    }
    PG8_WAIT_V(0);
    if (wr == 0) PG8_BAR;
    PG8_BAR;
    if constexpr (Epi::AFTER_DRAIN) { E.fused(acc, cur, wr, wc, fr, fq, lds, wid, lane); S.done(cur); }
    PG8_STAMP();
    if (STAMP && wid == 0) { stamps[lane] = lane < nts ? (((unsigned long long)(unsigned)ts_hi << 32) | (unsigned)ts_lo) : 0ull;
        if (lane == 62) stamps[62] = rt_entry; if (lane == 63) stamps[63] = (unsigned long long)wall_clock64(); }
#undef PG8_STAMP
#undef PG8_SA
#undef PG8_SB
#undef PG8_STAGE
#undef PG8_LDA
#undef PG8_LDB
#undef PG8_MMA
#undef PG8_WAIT_V
#undef PG8_WAIT_L
#undef PG8_BAR
#undef PG8_SCHED
}
}
using pg8::f32x4;
#define ROWOFF(reg, h) (((reg) & 3) + 8 * ((reg) >> 2) + 4 * (h))

__device__ __forceinline__ void conv_tile(const float* __restrict__ src, int K, int N, u16* __restrict__ dst, int k0, int n0, int sn0, float* lds) {
  const int tid = opq(threadIdx.x);
  __syncthreads();
  {
    const int k = tid >> 3, c = (tid & 7) * 8;
    const float* s = src + (size_t)(k0 + k) * N + sn0 + c;
    float4 a = *(const float4*)s, b = *(const float4*)(s + 4);
    float* d = lds + k * 65 + c;
    d[0] = a.x; d[1] = a.y; d[2] = a.z; d[3] = a.w;
    d[4] = b.x; d[5] = b.y; d[6] = b.z; d[7] = b.w;
  }
  __syncthreads();
  {
    const int n = tid >> 3, kk = (tid & 7) * 8;
    float f[8];
#pragma unroll
    for (int i = 0; i < 8; ++i) f[i] = lds[(kk + i) * 65 + n];
    *(uint4*)(dst + (size_t)(n0 + n) * K + k0 + kk) = pack8(f);
  }
}

__device__ __forceinline__ void phase_prep(const Params& p, int l, int which, float* ldsf) {
  u16* WtA = (u16*)(p.ws + WS_WT);
  u16* WtF = (u16*)(p.ws + WS_WTF);
  u16* H = (u16*)(p.ws + WS_H);
  float* X = p.out;
  const int nconv = which == 0 ? (640 + 512 + 128 + 128 + 256) : (1408 + 704);
  const int nlw = which == 0 ? 8 : 0;
  const int ntot = nconv + 2112 + nlw;
  const float* gw = (which == 0 ? p.in[7] : p.in[24]) + l * 1024;
  for (int it = blockIdx.x; it < ntot; it += gridDim.x) {
    if (it < nconv) {
      int t = it;
      if (which == 0) {
        if (t < 640) { const int tk = t / 40, tn = t % 40; conv_tile(p.in[8] + (size_t)l * 1024 * 4608, 1024, 4608, WtA + WT_IN, tk * 64, tn * 64, tn * 64, ldsf); }
        else if ((t -= 640) < 512) {
          const int tk = t / 32, tn = t % 32; const int n0 = tn * 64;
          const int sn0 = 2560 + ((n0 >> 7) & 1) * 1024 + (n0 >> 8) * 128 + (n0 & 127);
          conv_tile(p.in[8] + (size_t)l * 1024 * 4608, 1024, 4608, WtA + WT_G, tk * 64, n0, sn0, ldsf);
        }
        else if ((t -= 512) < 128) { const int tk = t / 16, tn = t % 16; conv_tile(p.in[21] + (size_t)l * 512 * 1024, 512, 1024, WtA + WT_BRA, tk * 64, tn * 64, tn * 64, ldsf); }
        else if ((t -= 128) < 128) { const int tk = t / 16, tn = t % 16; conv_tile(p.in[22] + (size_t)l * 512 * 1024, 512, 1024, WtA + WT_BRB, tk * 64, tn * 64, tn * 64, ldsf); }
        else { t -= 128; const int tk = t / 16, tn = t % 16; conv_tile(p.in[23] + (size_t)l * 1024 * 1024, 1024, 1024, WtA + WT_OUT, tk * 64, tn * 64, tn * 64, ldsf); }
      } else {
        if (t < 1408) {
          const int tk = t / 88, tn = t % 88; const int n0 = tn * 64;
          const int sn0 = ((n0 >> 7) & 1) * 2816 + (n0 >> 8) * 128 + (n0 & 127);
          conv_tile(p.in[25] + (size_t)l * 1024 * 5632, 1024, 5632, WtF + WT_FIN, tk * 64, n0, sn0, ldsf);
        } else { t -= 1408; const int tk = t / 16, tn = t % 16; conv_tile(p.in[28] + (size_t)l * 2816 * 1024, 2816, 1024, WtF + WT_FDN, tk * 64, tn * 64, tn * 64, ldsf); }
      }
    } else if (it >= nconv + 2112) {
      const int tid = opq(threadIdx.x);
      const int hh = it - nconv - 2112;
      u16* dst = (u16*)(p.ws + WS_LW) + (size_t)hh * 17920;
      const float* w2 = p.in[11] + (size_t)l * 64 * 512 + hh * 64;
      const float* a2 = p.in[13] + (size_t)l * 64 * 512 + hh * 64;
      const float* g2 = p.in[14] + (size_t)l * 128 * 512 + hh * 64;
      for (int e = tid; e < 4096; e += NT) {
        const int i = e >> 6, j = e & 63;
        dst[j * 72 + i] = f2bf(w2[(size_t)i * 512 + j]);
        dst[4608 + j * 72 + i] = f2bf(a2[(size_t)i * 512 + j]);
      }
      for (int e = tid; e < 8192; e += NT) {
        const int i = e >> 6, j = e & 63;
        dst[9216 + j * 136 + i] = f2bf(g2[(size_t)i * 512 + j]);
      }
    } else {
      const int tid = opq(threadIdx.x);
      const int row = (it - nconv) * 8 + (tid >> 6);
      const int lane = tid & 63;
      const bool first = (which == 0 && l == 0);
      const float* src;
      if (first) src = (row < M_P) ? p.in[0] + (size_t)row * 1024 : p.in[1] + (size_t)(row - M_P) * 1024;
      else src = X + (size_t)row * 1024;
      float4 v[4];
      float ss = 0.f;
      const int nsl = (gridDim.x == 256 && row >= M_P && !first) ? (which == 1 ? 4 : 11) : 0;
      const float* part = (const float*)(p.ws + WS_T1) + (size_t)(row - M_P) * 1024;
      const u16* partb = (const u16*)(p.ws + WS_DP) + (size_t)(row - M_P) * 1024;
#pragma unroll
      for (int i = 0; i < 4; ++i) {
        v[i] = *(const float4*)(src + i * 256 + lane * 4);
        for (int k = 0; k < nsl; ++k) {
          if (which == 1) {
            const float4 q = *(const float4*)(part + (size_t)k * 512 * 1024 + i * 256 + lane * 4);
            v[i].x += q.x; v[i].y += q.y; v[i].z += q.z; v[i].w += q.w;
          } else {
            const uint2 q = *(const uint2*)(partb + (size_t)k * 512 * 1024 + i * 256 + lane * 4);
            v[i].x += __uint_as_float(q.x << 16); v[i].y += __uint_as_float(q.x & 0xFFFF0000u); v[i].z += __uint_as_float(q.y << 16); v[i].w += __uint_as_float(q.y & 0xFFFF0000u);
          }
        }
        ss += v[i].x * v[i].x + v[i].y * v[i].y + v[i].z * v[i].z + v[i].w * v[i].w;
        if (first || nsl) *(float4*)(X + (size_t)row * 1024 + i * 256 + lane * 4) = v[i];
      }
      ss = wave_sum(ss);
      const float rs = rsqrtf(ss * (1.f / 1024.f) + 1e-6f);
#pragma unroll
      for (int i = 0; i < 4; ++i) {
        const float4 g = *(const float4*)(gw + i * 256 + lane * 4);
        uint2 o; o.x = pack2(v[i].x * rs * g.x, v[i].y * rs * g.y); o.y = pack2(v[i].z * rs * g.z, v[i].w * rs * g.w);
        *(uint2*)(H + (size_t)row * 1024 + i * 256 + lane * 4) = o;
      }
    }
  }
}

struct EpiInproj {
  static constexpr bool PERM = true, AFTER_DRAIN = false;
  u16* z; float* out; int l;
  __device__ __forceinline__ void operator()(const f32x4 (&acc)[2][2][4][2], const pg8::Unit& u, int wr, int wc, int fr, int fq) const {
    const int row0 = u.pm * 256 + wr * 64 + fr, col0 = u.pn * 256 + wc * 32 + 8 * fq;
#pragma unroll
    for (int ai = 0; ai < 2; ++ai)
#pragma unroll
      for (int m = 0; m < 4; ++m) {
        const int row = row0 + ai * 128 + m * 16;
        u16* rowp = z + (size_t)row * ZLD + col0;
#pragma unroll
        for (int bj = 0; bj < 2; ++bj) {
          const f32x4 v0 = acc[ai][bj][m][0], v1 = acc[ai][bj][m][1];
          pg8::u32x4 w; w.x = pg8::cvt_pk_bf16(v0[0], v0[1]); w.y = pg8::cvt_pk_bf16(v0[2], v0[3]); w.z = pg8::cvt_pk_bf16(v1[0], v1[1]); w.w = pg8::cvt_pk_bf16(v1[2], v1[3]);
          *(pg8::u32x4*)(rowp + bj * 128) = w;
        }
        const bool prompt = row < M_P;
        int b, t;
        if (prompt) { b = row >> 13; t = row & 8191; } else { b = (row - M_P) >> 2; t = (row - M_P) & 3; }
        if (u.pn < 7) {
          if ((prompt && t == 8191) || (!prompt && t == 3)) {
            float* o = out + (prompt ? O_PSHIFT + (size_t)(l * 2 + b) * 1792 : O_SSHIFT + (size_t)(l * 128 + b) * 1792) + col0;
#pragma unroll
            for (int bj = 0; bj < 2; ++bj) { *(f32x4*)(o + bj * 128) = acc[ai][bj][m][0]; *(f32x4*)(o + bj * 128 + 4) = acc[ai][bj][m][1]; }
          }
        } else if (u.pn == 9 && prompt && t >= 8064) {
          const int c = wc * 32 + 8 * fq;
          float* o = out + O_PV + ((size_t)((l * 2 + b) * 128 + (t - 8064)) * 2 + (c >> 6)) * 64 + (c & 63);
          *(f32x4*)o = acc[ai][1][m][0]; *(f32x4*)(o + 4) = acc[ai][1][m][1];
        }
      }
  }
};
struct EpiStoreBf16 {
  static constexpr bool PERM = true, AFTER_DRAIN = false;
  u16* O; int ldc;
  __device__ __forceinline__ void operator()(const f32x4 (&acc)[2][2][4][2], const pg8::Unit& u, int wr, int wc, int fr, int fq) const {
    const int row0 = u.pm * 256 + wr * 64 + fr, col0 = u.pn * 256 + wc * 32 + 8 * fq;
#pragma unroll
    for (int ai = 0; ai < 2; ++ai)
#pragma unroll
      for (int m = 0; m < 4; ++m) {
        u16* rowp = O + (size_t)(row0 + ai * 128 + m * 16) * ldc + col0;
#pragma unroll
        for (int bj = 0; bj < 2; ++bj) {
          const f32x4 v0 = acc[ai][bj][m][0], v1 = acc[ai][bj][m][1];
          pg8::u32x4 w; w.x = pg8::cvt_pk_bf16(v0[0], v0[1]); w.y = pg8::cvt_pk_bf16(v0[2], v0[3]); w.z = pg8::cvt_pk_bf16(v1[0], v1[1]); w.w = pg8::cvt_pk_bf16(v1[2], v1[3]);
          *(pg8::u32x4*)(rowp + bj * 128) = w;
        }
      }
  }
};
struct EpiFfnIn {
  static constexpr bool PERM = true, AFTER_DRAIN = false;
  u16* cu;
  __device__ __forceinline__ void operator()(const f32x4 (&acc)[2][2][4][2], const pg8::Unit& u, int wr, int wc, int fr, int fq) const {
    const int row0 = u.pm * 256 + wr * 64 + fr, col0 = u.pn * 128 + wc * 32 + 8 * fq;
#pragma unroll
    for (int ai = 0; ai < 2; ++ai)
#pragma unroll
      for (int m = 0; m < 4; ++m) {
        u16* rowp = cu + (size_t)(row0 + ai * 128 + m * 16) * 5632 + col0;
#pragma unroll
        for (int bj = 0; bj < 2; ++bj) {
          const f32x4 v0 = acc[ai][bj][m][0], v1 = acc[ai][bj][m][1];
          pg8::u32x4 w; w.x = pg8::cvt_pk_bf16(v0[0], v0[1]); w.y = pg8::cvt_pk_bf16(v0[2], v0[3]); w.z = pg8::cvt_pk_bf16(v1[0], v1[1]); w.w = pg8::cvt_pk_bf16(v1[2], v1[3]);
          *(pg8::u32x4*)(rowp + bj * 2816) = w;
        }
      }
  }
};
struct EpiMerge {
  static constexpr bool PERM = true, AFTER_DRAIN = false;
  const u16* t1; const u16* t2; u16* mg;
  __device__ __forceinline__ void operator()(const f32x4 (&acc)[2][2][4][2], const pg8::Unit& u, int wr, int wc, int fr, int fq) const {
    const int row0 = u.pm * 256 + wr * 64 + fr, col0 = u.pn * 128 + wc * 32 + 8 * fq;
#pragma unroll
    for (int ai = 0; ai < 2; ++ai)
#pragma unroll
      for (int m = 0; m < 4; ++m) {
        const size_t off = (size_t)(row0 + ai * 128 + m * 16) * 1024 + col0;
        float a[8], b[8], o[8];
        unpack8(*(const uint4*)(t1 + off), a);
        unpack8(*(const uint4*)(t2 + off), b);
#pragma unroll
        for (int n = 0; n < 2; ++n)
#pragma unroll
          for (int j = 0; j < 4; ++j)
            o[n * 4 + j] = sigm(acc[ai][0][m][n][j]) * a[n * 4 + j] + sigm(acc[ai][1][m][n][j]) * b[n * 4 + j];
        *(uint4*)(mg + off) = pack8(o);
        asm volatile("" ::: "memory");
      }
  }
};
struct EpiResid {
  static constexpr bool PERM = false, AFTER_DRAIN = false;
  float* X; bool dry; bool atomic; int rowoff; u16* pbf;
  __device__ __forceinline__ void operator()(const f32x4 (&acc)[2][2][4][2], const pg8::Unit& u, int wr, int wc, int fr, int fq) const {
    const int row0 = rowoff + u.pm * 256 + wr * 64 + fr, col0 = u.pn * 256 + wc * 32 + 4 * fq;
#pragma unroll
    for (int ai = 0; ai < 2; ++ai)
#pragma unroll
      for (int m = 0; m < 4; ++m) {
        float* rowp = X + (size_t)(row0 + ai * 128 + m * 16) * 1024 + col0;
#pragma unroll
        for (int bj = 0; bj < 2; ++bj)
#pragma unroll
          for (int n = 0; n < 2; ++n) {
            f32x4* q = (f32x4*)(rowp + bj * 128 + n * 16);
            if (atomic) {
              if (pbf) {
                uint2 o; o.x = pack2(acc[ai][bj][m][n][0], acc[ai][bj][m][n][1]); o.y = pack2(acc[ai][bj][m][n][2], acc[ai][bj][m][n][3]);
                *(uint2*)(pbf + ((float*)q - X)) = o;
              } else *q = acc[ai][bj][m][n];
            } else { const f32x4 v_ = *q + acc[ai][bj][m][n]; if (!dry) *q = v_; }
          }
        asm volatile("" ::: "memory");
      }
  }
};
template <class Epi>
__device__ __forceinline__ void run_gemm_ex(unsigned char* lds_raw, const u16* A, int lda, const u16* Bt, int ldb, int M, int N, int K, int G, int c, const Epi& E) {
  if (c < 0) return;
  pg8::Gemm g; g.A = A; g.Bt = Bt; g.M = M; g.N = N; g.K = K; g.lda = lda; g.ldb = ldb;
  pg8::StaticOrder S; S.init(M, N, G, c);
  __syncthreads();
  pg8::gemm_phase<Epi, pg8::StaticOrder, false>((PG8_LAS unsigned char*)lds_raw, g, S, E, nullptr);
  __syncthreads();
}
template <class Epi>
__device__ __forceinline__ void run_gemm(unsigned char* lds_raw, const u16* A, int lda, const u16* Bt, int N, int K, const Epi& E) {
  pg8::Gemm g; g.A = A; g.Bt = Bt; g.M = M_TOT; g.N = N; g.K = K; g.lda = lda; g.ldb = K;
  pg8::StaticOrder S; S.init(M_TOT, N, gridDim.x, blockIdx.x);
  __syncthreads();
  pg8::gemm_phase<Epi, pg8::StaticOrder, false>((PG8_LAS unsigned char*)lds_raw, g, S, E, nullptr);
  __syncthreads();
}

__device__ __forceinline__ void rope_item(const Params& p, int l, int item, bool dry = false) {
  const int tid = opq(threadIdx.x);
  u16* z = (u16*)(p.ws + WS_Z);
  const int row = item * 64 + (tid >> 3);
  const int d0 = (tid & 7) * 4;
  const bool prompt = row < M_P;
  int b, t, pos;
  if (prompt) { b = row >> 13; t = row & 8191; pos = t; } else { b = (row - M_P) >> 2; t = (row - M_P) & 3; pos = 16384 + t; }
  float cs[4], sn[4];
#pragma unroll
  for (int i = 0; i < 4; ++i) {
    const float inv = __expf(-(float)(d0 + i) * (9.210340371976184f / 32.f));
    const float angf = (float)pos * inv;
    double a = (double)angf;
    a -= 6.283185307179586 * rint(a * 0.15915494309189535);
    const float af = (float)a;
    sn[i] = __sinf(af); cs[i] = __cosf(af);
  }
#pragma unroll 2
  for (int hh = 0; hh < 10; ++hh) {
    u16* q = z + (size_t)row * ZLD + 1792 + hh * 64 + d0;
    const uint2 lo = *(const uint2*)q, hi = *(const uint2*)(q + 32);
    float x1[4] = {__uint_as_float(lo.x << 16), __uint_as_float(lo.x & 0xFFFF0000u), __uint_as_float(lo.y << 16), __uint_as_float(lo.y & 0xFFFF0000u)};
    float x2[4] = {__uint_as_float(hi.x << 16), __uint_as_float(hi.x & 0xFFFF0000u), __uint_as_float(hi.y << 16), __uint_as_float(hi.y & 0xFFFF0000u)};
    float y1[4], y2[4];
#pragma unroll
    for (int i = 0; i < 4; ++i) { y1[i] = x1[i] * cs[i] - x2[i] * sn[i]; y2[i] = x2[i] * cs[i] + x1[i] * sn[i]; }
    uint2 o1, o2;
    o1.x = pack2(y1[0], y1[1]); o1.y = pack2(y1[2], y1[3]); o2.x = pack2(y2[0], y2[1]); o2.y = pack2(y2[2], y2[3]);
    if (!dry) { *(uint2*)q = o1; *(uint2*)(q + 32) = o2; }
    if (hh >= 8 && prompt && t >= 8064) {
      float* o = p.out + O_PK + ((size_t)((l * 2 + b) * 128 + (t - 8064)) * 2 + (hh - 8)) * 64 + d0;
      *(float4*)o = make_float4(y1[0], y1[1], y1[2], y1[3]);
      *(float4*)(o + 32) = make_float4(y2[0], y2[1], y2[2], y2[3]);
    }
  }
}

#define SL(i) (ldsf + (i) * 4160)
__device__ __forceinline__ void rwkv_item(const Params& p, int l, int item, float* ldsf, bool dry = false) {
  const int tid = opq(threadIdx.x), lane = tid & 63, wave = tid >> 6;
  const bool sample = item >= 2048;
  int h, cidx, rowbase;
  if (!sample) { h = item & 7; cidx = item >> 3; rowbase = cidx * 64; }
  else { int s = item - 2048; h = s & 7; cidx = s >> 3; rowbase = M_P + cidx * 64; }
  const int cc = cidx & 127;
  const u16* z = (const u16*)(p.ws + WS_Z);
  u16* zw_ = (u16*)(p.ws + WS_Z);
  const float* mu = p.in[9] + l * 1792;
  float* wbuf = SL(7);
  float* gc = ldsf + 9 * 4160;
  float* bd = ldsf + 9 * 4160 + 64;
  __syncthreads();
  {
    const int t = tid >> 3, c8 = (tid & 7) * 8;
    const int m = rowbase + t;
    const int zcs[7] = {h * 64, 512 + h * 64, 1024 + h * 64, 1536, 1600, 1664, 1728};
#pragma unroll
    for (int gi = 0; gi < 7; ++gi) {
      const int zc = zcs[gi] + c8;
      float cur[8], prv[8];
      unpack8(*(const uint4*)(z + (size_t)m * ZLD + zc), cur);
      bool zero = false, fromstate = false;
      if (!sample) zero = (t == 0 && cc == 0);
      else fromstate = ((t & 3) == 0);
      if (zero) {
#pragma unroll
        for (int i = 0; i < 8; ++i) prv[i] = 0.f;
      } else if (fromstate) {
        const int b = (m - M_P) >> 2;
        const float* sp = p.in[2] + (size_t)(l * 128 + b) * 1792 + zc;
        float4 a = *(const float4*)sp, bb = *(const float4*)(sp + 4);
        prv[0] = a.x; prv[1] = a.y; prv[2] = a.z; prv[3] = a.w; prv[4] = bb.x; prv[5] = bb.y; prv[6] = bb.z; prv[7] = bb.w;
      } else {
        unpack8(*(const uint4*)(z + (size_t)(m - 1) * ZLD + zc), prv);
      }
      float* d = SL(gi) + t * 65 + c8;
#pragma unroll
      for (int i = 0; i < 8; ++i) {
        float v = cur[i] + mu[zc + i] * (prv[i] - cur[i]);
        if (gi == 3) v = tanhf(v);
        if (gi >= 5) v = sigm(v);
        d[i] = v;
      }
    }
  }
  const int lt = tid & 63, jg = tid >> 6;
  auto load_w = [&](const float* W, int nrows) {
    for (int e = tid; e < nrows * 8; e += NT) {
      const int i = e >> 3, c = (e & 7) * 8;
      const float* s = W + (size_t)i * 512 + h * 64 + c;
      *(float4*)(wbuf + i * 64 + c) = *(const float4*)s;
      *(float4*)(wbuf + i * 64 + c + 4) = *(const float4*)(s + 4);
    }
  };
  auto lora = [&](const float* xa, const float* xb, int n, float* acc) {
#pragma unroll 2
    for (int i = 0; i < n; ++i) {
      const float x = (i < 64) ? xa[lt * 65 + i] : xb[lt * 65 + i - 64];
      const float4 w0 = *(const float4*)(wbuf + i * 64 + jg * 8);
      const float4 w1 = *(const float4*)(wbuf + i * 64 + jg * 8 + 4);
      acc[0] += x * w0.x; acc[1] += x * w0.y; acc[2] += x * w0.z; acc[3] += x * w0.w;
      acc[4] += x * w1.x; acc[5] += x * w1.y; acc[6] += x * w1.z; acc[7] += x * w1.w;
    }
  };
  float res[8];
  load_w(p.in[11] + (size_t)l * 64 * 512, 64);
  __syncthreads();
#pragma unroll
  for (int i = 0; i < 8; ++i) res[i] = p.in[10][l * 512 + h * 64 + jg * 8 + i];
  lora(SL(3), SL(3), 64, res);
  __syncthreads();
#pragma unroll
  for (int i = 0; i < 8; ++i) {
    const float x = -res[i];
    const float sp = (x > 20.f) ? x : log1pf(__expf(x));
    SL(3)[lt * 65 + jg * 8 + i] = -__expf(-sp - 0.5f);
  }
  load_w(p.in[13] + (size_t)l * 64 * 512, 64);
  __syncthreads();
#pragma unroll
  for (int i = 0; i < 8; ++i) res[i] = p.in[12][l * 512 + h * 64 + jg * 8 + i];
  lora(SL(4), SL(4), 64, res);
  __syncthreads();
#pragma unroll
  for (int i = 0; i < 8; ++i) SL(4)[lt * 65 + jg * 8 + i] = sigm(res[i]);
  load_w(p.in[14] + (size_t)l * 128 * 512, 128);
  __syncthreads();
#pragma unroll
  for (int i = 0; i < 8; ++i) res[i] = 0.f;
  lora(SL(5), SL(6), 128, res);
  __syncthreads();
  if (!sample) {
    u16* ga = (u16*)(p.ws + WS_GA) + (size_t)item * 4096;
    *(uint4*)(ga + lt * 64 + jg * 8) = pack8(res);
    if (tid < 64) {
      float c = 0.f;
      for (int t = 0; t < 64; ++t) { c += SL(3)[t * 65 + tid]; SL(5)[t * 65 + tid] = c; }
      gc[tid] = __expf(c);
    }
  } else {
#pragma unroll
    for (int i = 0; i < 8; ++i) SL(6)[lt * 65 + jg * 8 + i] = res[i];
  }
  __syncthreads();
  {
    const int t = tid >> 3, j0 = (tid & 7) * 8;
    const float* kkw = p.in[15] + l * 512 + h * 64;
    const float* kaw = p.in[16] + l * 512 + h * 64;
    const float* rkw = p.in[17] + l * 512 + h * 64;
    float kr[8], av[8], rv[8], kkv[8], kf[8];
    float nrm = 0.f, bdot = 0.f;
#pragma unroll
    for (int i = 0; i < 8; ++i) {
      const int j = j0 + i;
      kr[i] = SL(1)[t * 65 + j]; av[i] = SL(4)[t * 65 + j]; rv[i] = SL(0)[t * 65 + j];
      kkv[i] = kr[i] * kkw[j];
      nrm += kkv[i] * kkv[i];
      kf[i] = kr[i] * (1.f + (av[i] - 1.f) * kaw[j]);
      bdot += rv[i] * kf[i] * rkw[j];
    }
    nrm += __shfl_xor(nrm, 1, 64); nrm += __shfl_xor(nrm, 2, 64); nrm += __shfl_xor(nrm, 4, 64);
    bdot += __shfl_xor(bdot, 1, 64); bdot += __shfl_xor(bdot, 2, 64); bdot += __shfl_xor(bdot, 4, 64);
    const float rn = 1.f / fmaxf(sqrtf(nrm), 1e-12f);
    if (!sample) {
      float bo[8];
#pragma unroll
      for (int i = 0; i < 8; ++i) {
        const int j = j0 + i;
        const float cum = SL(5)[t * 65 + j], dl = SL(3)[t * 65 + j];
        const float eg = __expf(cum), egi = __expf(-cum), egp = __expf(cum - dl);
        const float kk = kkv[i] * rn;
        SL(0)[t * 65 + j] = rv[i] * eg;
        SL(1)[t * 65 + j] = kf[i] * egi;
        SL(3)[t * 65 + j] = kk * av[i] * egi;
        SL(4)[t * 65 + j] = kk * egp;
        bo[i] = bdot * SL(2)[t * 65 + j];
      }
      u16* bop = (u16*)(p.ws + WS_BO) + (size_t)item * 4096;
      *(uint4*)(bop + t * 64 + j0) = pack8(bo);
    } else {
#pragma unroll
      for (int i = 0; i < 8; ++i) {
        const int j = j0 + i;
        const float kk = kkv[i] * rn;
        const float dl = SL(3)[t * 65 + j];
        SL(1)[t * 65 + j] = kf[i];
        SL(3)[t * 65 + j] = __expf(dl);
        SL(4)[t * 65 + j] = kk;
        SL(5)[t * 65 + j] = kk * av[i];
      }
      if ((tid & 7) == 0) bd[t] = bdot;
    }
  }
  __syncthreads();
  if (sample) {
    const float lng = p.in[18][l * 512 + h * 64 + lane], lnb = p.in[19][l * 512 + h * 64 + lane];
    for (int round = 0; round < 2; ++round) {
      const int seq = wave + 8 * round;
      const int b = cidx * 16 + seq;
      float S[64];
      const float* sp = p.in[3] + ((size_t)((l * 128 + b) * 8 + h) * 64 + lane) * 64;
#pragma unroll
      for (int k = 0; k < 64; k += 4) { float4 v = *(const float4*)(sp + k); S[k] = v.x; S[k + 1] = v.y; S[k + 2] = v.z; S[k + 3] = v.w; }
      for (int tt = 0; tt < 4; ++tt) {
        const int t = seq * 4 + tt;
        float sk = 0.f;
#pragma unroll
        for (int kc = 0; kc < 64; kc += 8) {
#pragma unroll
          for (int k = kc; k < kc + 8; ++k) sk += S[k] * SL(4)[t * 65 + k];
          __builtin_amdgcn_sched_barrier(0);
        }
        const float vt = SL(2)[t * 65 + lane];
        float y = 0.f;
#pragma unroll
        for (int kc = 0; kc < 64; kc += 8) {
#pragma unroll
          for (int k = kc; k < kc + 8; ++k) {
            S[k] = S[k] * SL(3)[t * 65 + k] - sk * SL(5)[t * 65 + k] + vt * SL(1)[t * 65 + k];
            y += S[k] * SL(0)[t * 65 + k];
          }
          __builtin_amdgcn_sched_barrier(0);
        }
        const float mean = wave_sum(y) * (1.f / 64.f);
        const float d = y - mean;
        const float var = wave_sum(d * d) * (1.f / 64.f);
        const float yn = d * rsqrtf(var + 64e-5f) * lng + lnb;
        const float o = (yn + bd[t] * vt) * SL(6)[t * 65 + lane];
        if (!dry) zw_[(size_t)(M_P + b * 4 + tt) * ZLD + h * 64 + lane] = f2bf(o);
      }
      float* op = p.out + O_SWKV + ((size_t)((l * 128 + b) * 8 + h) * 64 + lane) * 64;
#pragma unroll
      for (int k = 0; k < 64; k += 4) *(float4*)(op + k) = make_float4(S[k], S[k + 1], S[k + 2], S[k + 3]);
    }
    return;
  }
  {
    const int i = lane, tg = wave;
    float ab[8], ak[8], akr[8], abr[8];
#pragma unroll
    for (int q = 0; q < 8; ++q) { ab[q] = 0.f; ak[q] = 0.f; akr[q] = 0.f; abr[q] = 0.f; }
#pragma unroll 2
    for (int k = 0; k < 64; ++k) {
      const float xb = SL(3)[i * 65 + k], xk = SL(1)[i * 65 + k];
#pragma unroll
      for (int q = 0; q < 8; ++q) {
        const int t = tg * 8 + q;
        const float yk = SL(4)[t * 65 + k], yr = SL(0)[t * 65 + k];
        ab[q] += xb * yk; ak[q] += xk * yk; akr[q] += xk * yr; abr[q] += xb * yr;
      }
    }
    __syncthreads();
#pragma unroll
    for (int q = 0; q < 8; ++q) {
      const int t = tg * 8 + q;
      SL(6)[i * 65 + t] = (i < t) ? ab[q] : 0.f;
      SL(7)[i * 65 + t] = (i < t) ? ak[q] : 0.f;
      SL(8)[i * 65 + t] = (i <= t) ? akr[q] : 0.f;
      SL(5)[i * 65 + t] = (i <= t) ? abr[q] : 0.f;
    }
  }
  __syncthreads();
  {
    const int t = tid >> 3, j0 = (tid & 7) * 8;
#pragma unroll
    for (int i = 0; i < 8; ++i) { const float g = gc[j0 + i]; SL(3)[t * 65 + j0 + i] *= g; SL(1)[t * 65 + j0 + i] *= g; }
  }
  __syncthreads();
  if (tid < 128) {
    float* X_ = (tid < 64) ? SL(5) : SL(3);
    const int col = tid & 63;
    for (int i = 62; i >= 0; --i) {
      float a = X_[i * 65 + col];
#pragma unroll 4
      for (int t = i + 1; t < 64; ++t) a -= SL(6)[i * 65 + t] * X_[t * 65 + col];
      X_[i * 65 + col] = a;
    }
  }
  __syncthreads();
  {
    const int c = tid & 127, ig = tid >> 7;
    const int which = c >> 6, cq = c & 63;
    const float* N_ = which ? SL(3) : SL(5);
    float a[16];
#pragma unroll
    for (int q = 0; q < 16; ++q) a[q] = 0.f;
#pragma unroll 2
    for (int t = 0; t < 64; ++t) {
      const float n = N_[t * 65 + cq];
#pragma unroll
      for (int q = 0; q < 16; ++q) a[q] += SL(7)[(ig * 16 + q) * 65 + t] * n;
    }
    float* T_ = which ? SL(1) : SL(8);
#pragma unroll
    for (int q = 0; q < 16; ++q) T_[(ig * 16 + q) * 65 + cq] -= a[q];
  }
  __syncthreads();
  {
    const int x = lane, yg = wave;
    float w2[8], pp[8], yl[8], qq[8];
#pragma unroll
    for (int q = 0; q < 8; ++q) { w2[q] = 0.f; pp[q] = 0.f; yl[q] = 0.f; qq[q] = 0.f; }
#pragma unroll 2
    for (int j = 0; j < 64; ++j) {
      const float l5 = SL(5)[j * 65 + x], l4 = SL(4)[j * 65 + x], l8 = SL(8)[j * 65 + x], l2 = SL(2)[j * 65 + x];
#pragma unroll
      for (int q = 0; q < 8; ++q) {
        const int y = yg * 8 + q;
        w2[q] += l5 * SL(4)[j * 65 + y];
        pp[q] += l4 * SL(3)[j * 65 + y];
        yl[q] += l8 * SL(2)[j * 65 + y];
        qq[q] += l2 * SL(1)[j * 65 + y];
      }
    }
    float o1[8];
#pragma unroll
    for (int q = 0; q < 8; ++q) {
      const int y = yg * 8 + q;
      o1[q] = SL(0)[x * 65 + y] - w2[q];
    }
    u16* Pf = (u16*)(p.ws + WS_PP) + (size_t)item * 4096;
    float* Qf = (float*)(p.ws + WS_Q) + (size_t)item * 4096;
    if (tid < 64) ((float*)(p.ws + WS_GC))[(size_t)item * 64 + tid] = gc[tid];
    {
      const int s_ = x >> 4, kk = x & 15, hh = (kk >> 2) & 1, jj = ((kk >> 3) << 2) | (kk & 3);
#pragma unroll
      for (int q = 0; q < 8; ++q) {
        const int y = yg * 8 + q;
        Pf[(((y >> 5) * 4 + s_) * 64 + (y & 31) + 32 * hh) * 8 + jj] = f2bf(-pp[q]);
        const int k2 = y & 31, reg = ((k2 >> 3) << 2) | (k2 & 3), h2 = (k2 >> 2) & 1;
        Qf[(((x >> 5) * 2 + (y >> 5)) * 16 + reg) * 64 + (x & 31) + 32 * h2] = qq[q];
      }
    }
    u16* W2p = (u16*)(p.ws + WS_W2) + (size_t)item * 4096 + x * 64 + yg * 8;
    u16* YLp = (u16*)(p.ws + WS_YL) + (size_t)item * 4096 + x * 64 + yg * 8;
    *(uint4*)W2p = pack8(o1);
    *(uint4*)YLp = pack8(yl);
  }
}

__device__ __forceinline__ void mm_tile(const u16* Aop, int lda, const u16* Bop, int ldb, int mt, int nt, int r, int h, int ksteps, f32x16& acc) {
  const u16* ap = Aop + (mt * 32 + r) * lda + h * 8;
  const u16* bp = Bop + (nt * 32 + r) * ldb + h * 8;
#pragma unroll 4
  for (int s = 0; s < ksteps; ++s) {
    const bf16x8 a = *(const bf16x8*)(ap + s * 16);
    const bf16x8 b = *(const bf16x8*)(bp + s * 16);
    acc = __builtin_amdgcn_mfma_f32_32x32x16_bf16(a, b, acc, 0, 0, 0);
  }
}
__device__ __forceinline__ void store_T(u16* T, int ldt, int mt, int nt, int r, int h, const f32x16& acc) {
#pragma unroll
  for (int g = 0; g < 4; ++g) {
    uint2 o; o.x = pack2(acc[4 * g], acc[4 * g + 1]); o.y = pack2(acc[4 * g + 2], acc[4 * g + 3]);
    *(uint2*)(T + (nt * 32 + r) * ldt + mt * 32 + 8 * g + 4 * h) = o;
  }
}
__device__ __forceinline__ void tri32(const float* Ab, float* Xc) {
  float a0 = Xc[0];
  float a1 = Xc[65];
  float a2 = Xc[130];
  float a3 = Xc[195];
  float a4 = Xc[260];
  float a5 = Xc[325];
  float a6 = Xc[390];
  float a7 = Xc[455];
  float a8 = Xc[520];
  float a9 = Xc[585];
  float a10 = Xc[650];
  float a11 = Xc[715];
  float a12 = Xc[780];
  float a13 = Xc[845];
  float a14 = Xc[910];
  float a15 = Xc[975];
  float a16 = Xc[1040];
  float a17 = Xc[1105];
  float a18 = Xc[1170];
  float a19 = Xc[1235];
  float a20 = Xc[1300];
  float a21 = Xc[1365];
  float a22 = Xc[1430];
  float a23 = Xc[1495];
  float a24 = Xc[1560];
  float a25 = Xc[1625];
  float a26 = Xc[1690];
  float a27 = Xc[1755];
  float a28 = Xc[1820];
  float a29 = Xc[1885];
  float a30 = Xc[1950];
  float a31 = Xc[2015];
  const float4 c30_28 = *(const float4*)(Ab + 2068);
  const float4 c29_28 = *(const float4*)(Ab + 2000);
  const float4 c28_28 = *(const float4*)(Ab + 1932);
  a30 -= c30_28.w * a31;
  const float4 c27_28 = *(const float4*)(Ab + 1864);
  a29 -= c29_28.z * a30;
  a29 -= c29_28.w * a31;
  const float4 c26_24 = *(const float4*)(Ab + 1792);
  const float4 c26_28 = *(const float4*)(Ab + 1796);
  a28 -= c28_28.y * a29;
  a28 -= c28_28.z * a30;
  a28 -= c28_28.w * a31;
  __builtin_amdgcn_sched_barrier(0);
  const float4 c25_24 = *(const float4*)(Ab + 1724);
  const float4 c25_28 = *(const float4*)(Ab + 1728);
  a27 -= c27_28.x * a28;
  a27 -= c27_28.y * a29;
  a27 -= c27_28.z * a30;
  a27 -= c27_28.w * a31;
  const float4 c24_24 = *(const float4*)(Ab + 1656);
  const float4 c24_28 = *(const float4*)(Ab + 1660);
  a26 -= c26_24.w * a27;
  a26 -= c26_28.x * a28;
  a26 -= c26_28.y * a29;
  a26 -= c26_28.z * a30;
  a26 -= c26_28.w * a31;
  const float4 c23_24 = *(const float4*)(Ab + 1588);
  const float4 c23_28 = *(const float4*)(Ab + 1592);
  a25 -= c25_24.z * a26;
  a25 -= c25_24.w * a27;
  a25 -= c25_28.x * a28;
  a25 -= c25_28.y * a29;
  a25 -= c25_28.z * a30;
  a25 -= c25_28.w * a31;
  const float4 c22_20 = *(const float4*)(Ab + 1516);
  const float4 c22_24 = *(const float4*)(Ab + 1520);
  const float4 c22_28 = *(const float4*)(Ab + 1524);
  a24 -= c24_24.y * a25;
  a24 -= c24_24.z * a26;
  a24 -= c24_24.w * a27;
  a24 -= c24_28.x * a28;
  a24 -= c24_28.y * a29;
  a24 -= c24_28.z * a30;
  a24 -= c24_28.w * a31;
  __builtin_amdgcn_sched_barrier(0);
  const float4 c21_20 = *(const float4*)(Ab + 1448);
  const float4 c21_24 = *(const float4*)(Ab + 1452);
  const float4 c21_28 = *(const float4*)(Ab + 1456);
  a23 -= c23_24.x * a24;
  a23 -= c23_24.y * a25;
  a23 -= c23_24.z * a26;
  a23 -= c23_24.w * a27;
  a23 -= c23_28.x * a28;
  a23 -= c23_28.y * a29;
  a23 -= c23_28.z * a30;
  a23 -= c23_28.w * a31;
  const float4 c20_20 = *(const float4*)(Ab + 1380);
  const float4 c20_24 = *(const float4*)(Ab + 1384);
  const float4 c20_28 = *(const float4*)(Ab + 1388);
  a22 -= c22_20.w * a23;
  a22 -= c22_24.x * a24;
  a22 -= c22_24.y * a25;
  a22 -= c22_24.z * a26;
  a22 -= c22_24.w * a27;
  a22 -= c22_28.x * a28;
  a22 -= c22_28.y * a29;
  a22 -= c22_28.z * a30;
  a22 -= c22_28.w * a31;
  const float4 c19_20 = *(const float4*)(Ab + 1312);
  const float4 c19_24 = *(const float4*)(Ab + 1316);
  const float4 c19_28 = *(const float4*)(Ab + 1320);
  a21 -= c21_20.z * a22;
  a21 -= c21_20.w * a23;
  a21 -= c21_24.x * a24;
  a21 -= c21_24.y * a25;
  a21 -= c21_24.z * a26;
  a21 -= c21_24.w * a27;
  a21 -= c21_28.x * a28;
  a21 -= c21_28.y * a29;
  a21 -= c21_28.z * a30;
  a21 -= c21_28.w * a31;
  const float4 c18_16 = *(const float4*)(Ab + 1240);
  const float4 c18_20 = *(const float4*)(Ab + 1244);
  const float4 c18_24 = *(const float4*)(Ab + 1248);
  const float4 c18_28 = *(const float4*)(Ab + 1252);
  a20 -= c20_20.y * a21;
  a20 -= c20_20.z * a22;
  a20 -= c20_20.w * a23;
  a20 -= c20_24.x * a24;
  a20 -= c20_24.y * a25;
  a20 -= c20_24.z * a26;
  a20 -= c20_24.w * a27;
  a20 -= c20_28.x * a28;
  a20 -= c20_28.y * a29;
  a20 -= c20_28.z * a30;
  a20 -= c20_28.w * a31;
  __builtin_amdgcn_sched_barrier(0);
  const float4 c17_16 = *(const float4*)(Ab + 1172);
  const float4 c17_20 = *(const float4*)(Ab + 1176);
  const float4 c17_24 = *(const float4*)(Ab + 1180);
  const float4 c17_28 = *(const float4*)(Ab + 1184);
  a19 -= c19_20.x * a20;
  a19 -= c19_20.y * a21;
  a19 -= c19_20.z * a22;
  a19 -= c19_20.w * a23;
  a19 -= c19_24.x * a24;
  a19 -= c19_24.y * a25;
  a19 -= c19_24.z * a26;
  a19 -= c19_24.w * a27;
  a19 -= c19_28.x * a28;
  a19 -= c19_28.y * a29;
  a19 -= c19_28.z * a30;
  a19 -= c19_28.w * a31;
  const float4 c16_16 = *(const float4*)(Ab + 1104);
  const float4 c16_20 = *(const float4*)(Ab + 1108);
  const float4 c16_24 = *(const float4*)(Ab + 1112);
  const float4 c16_28 = *(const float4*)(Ab + 1116);
  a18 -= c18_16.w * a19;
  a18 -= c18_20.x * a20;
  a18 -= c18_20.y * a21;
  a18 -= c18_20.z * a22;
  a18 -= c18_20.w * a23;
  a18 -= c18_24.x * a24;
  a18 -= c18_24.y * a25;
  a18 -= c18_24.z * a26;
  a18 -= c18_24.w * a27;
  a18 -= c18_28.x * a28;
  a18 -= c18_28.y * a29;
  a18 -= c18_28.z * a30;
  a18 -= c18_28.w * a31;
  const float4 c15_16 = *(const float4*)(Ab + 1036);
  const float4 c15_20 = *(const float4*)(Ab + 1040);
  const float4 c15_24 = *(const float4*)(Ab + 1044);
  const float4 c15_28 = *(const float4*)(Ab + 1048);
  a17 -= c17_16.z * a18;
  a17 -= c17_16.w * a19;
  a17 -= c17_20.x * a20;
  a17 -= c17_20.y * a21;
  a17 -= c17_20.z * a22;
  a17 -= c17_20.w * a23;
  a17 -= c17_24.x * a24;
  a17 -= c17_24.y * a25;
  a17 -= c17_24.z * a26;
  a17 -= c17_24.w * a27;
  a17 -= c17_28.x * a28;
  a17 -= c17_28.y * a29;
  a17 -= c17_28.z * a30;
  a17 -= c17_28.w * a31;
  const float4 c14_12 = *(const float4*)(Ab + 964);
  const float4 c14_16 = *(const float4*)(Ab + 968);
  const float4 c14_20 = *(const float4*)(Ab + 972);
  const float4 c14_24 = *(const float4*)(Ab + 976);
  const float4 c14_28 = *(const float4*)(Ab + 980);
  a16 -= c16_16.y * a17;
  a16 -= c16_16.z * a18;
  a16 -= c16_16.w * a19;
  a16 -= c16_20.x * a20;
  a16 -= c16_20.y * a21;
  a16 -= c16_20.z * a22;
  a16 -= c16_20.w * a23;
  a16 -= c16_24.x * a24;
  a16 -= c16_24.y * a25;
  a16 -= c16_24.z * a26;
  a16 -= c16_24.w * a27;
  a16 -= c16_28.x * a28;
  a16 -= c16_28.y * a29;
  a16 -= c16_28.z * a30;
  a16 -= c16_28.w * a31;
  __builtin_amdgcn_sched_barrier(0);
  const float4 c13_12 = *(const float4*)(Ab + 896);
  const float4 c13_16 = *(const float4*)(Ab + 900);
  const float4 c13_20 = *(const float4*)(Ab + 904);
  const float4 c13_24 = *(const float4*)(Ab + 908);
  const float4 c13_28 = *(const float4*)(Ab + 912);
  a15 -= c15_16.x * a16;
  a15 -= c15_16.y * a17;
  a15 -= c15_16.z * a18;
  a15 -= c15_16.w * a19;
  a15 -= c15_20.x * a20;
  a15 -= c15_20.y * a21;
  a15 -= c15_20.z * a22;
  a15 -= c15_20.w * a23;
  a15 -= c15_24.x * a24;
  a15 -= c15_24.y * a25;
  a15 -= c15_24.z * a26;
  a15 -= c15_24.w * a27;
  a15 -= c15_28.x * a28;
  a15 -= c15_28.y * a29;
  a15 -= c15_28.z * a30;
  a15 -= c15_28.w * a31;
  const float4 c12_12 = *(const float4*)(Ab + 828);
  const float4 c12_16 = *(const float4*)(Ab + 832);
  const float4 c12_20 = *(const float4*)(Ab + 836);
  const float4 c12_24 = *(const float4*)(Ab + 840);
  const float4 c12_28 = *(const float4*)(Ab + 844);
  a14 -= c14_12.w * a15;
  a14 -= c14_16.x * a16;
  a14 -= c14_16.y * a17;
  a14 -= c14_16.z * a18;
  a14 -= c14_16.w * a19;
  a14 -= c14_20.x * a20;
  a14 -= c14_20.y * a21;
  a14 -= c14_20.z * a22;
  a14 -= c14_20.w * a23;
  a14 -= c14_24.x * a24;
  a14 -= c14_24.y * a25;
  a14 -= c14_24.z * a26;
  a14 -= c14_24.w * a27;
  a14 -= c14_28.x * a28;
  a14 -= c14_28.y * a29;
  a14 -= c14_28.z * a30;
  a14 -= c14_28.w * a31;
  const float4 c11_12 = *(const float4*)(Ab + 760);
  const float4 c11_16 = *(const float4*)(Ab + 764);
  const float4 c11_20 = *(const float4*)(Ab + 768);
  const float4 c11_24 = *(const float4*)(Ab + 772);
  const float4 c11_28 = *(const float4*)(Ab + 776);
  a13 -= c13_12.z * a14;
  a13 -= c13_12.w * a15;
  a13 -= c13_16.x * a16;
  a13 -= c13_16.y * a17;
  a13 -= c13_16.z * a18;
  a13 -= c13_16.w * a19;
  a13 -= c13_20.x * a20;
  a13 -= c13_20.y * a21;
  a13 -= c13_20.z * a22;
  a13 -= c13_20.w * a23;
  a13 -= c13_24.x * a24;
  a13 -= c13_24.y * a25;
  a13 -= c13_24.z * a26;
  a13 -= c13_24.w * a27;
  a13 -= c13_28.x * a28;
  a13 -= c13_28.y * a29;
  a13 -= c13_28.z * a30;
  a13 -= c13_28.w * a31;
  const float4 c10_8 = *(const float4*)(Ab + 688);
  const float4 c10_12 = *(const float4*)(Ab + 692);
  const float4 c10_16 = *(const float4*)(Ab + 696);
  const float4 c10_20 = *(const float4*)(Ab + 700);
  const float4 c10_24 = *(const float4*)(Ab + 704);
  const float4 c10_28 = *(const float4*)(Ab + 708);
  a12 -= c12_12.y * a13;
  a12 -= c12_12.z * a14;
  a12 -= c12_12.w * a15;
  a12 -= c12_16.x * a16;
  a12 -= c12_16.y * a17;
  a12 -= c12_16.z * a18;
  a12 -= c12_16.w * a19;
  a12 -= c12_20.x * a20;
  a12 -= c12_20.y * a21;
  a12 -= c12_20.z * a22;
  a12 -= c12_20.w * a23;
  a12 -= c12_24.x * a24;
  a12 -= c12_24.y * a25;
  a12 -= c12_24.z * a26;
  a12 -= c12_24.w * a27;
  a12 -= c12_28.x * a28;
  a12 -= c12_28.y * a29;
  a12 -= c12_28.z * a30;
  a12 -= c12_28.w * a31;
  __builtin_amdgcn_sched_barrier(0);
  const float4 c9_8 = *(const float4*)(Ab + 620);
  const float4 c9_12 = *(const float4*)(Ab + 624);
  const float4 c9_16 = *(const float4*)(Ab + 628);
  const float4 c9_20 = *(const float4*)(Ab + 632);
  const float4 c9_24 = *(const float4*)(Ab + 636);
  const float4 c9_28 = *(const float4*)(Ab + 640);
  a11 -= c11_12.x * a12;
  a11 -= c11_12.y * a13;
  a11 -= c11_12.z * a14;
  a11 -= c11_12.w * a15;
  a11 -= c11_16.x * a16;
  a11 -= c11_16.y * a17;
  a11 -= c11_16.z * a18;
  a11 -= c11_16.w * a19;
  a11 -= c11_20.x * a20;
  a11 -= c11_20.y * a21;
  a11 -= c11_20.z * a22;
  a11 -= c11_20.w * a23;
  a11 -= c11_24.x * a24;
  a11 -= c11_24.y * a25;
  a11 -= c11_24.z * a26;
  a11 -= c11_24.w * a27;
  a11 -= c11_28.x * a28;
  a11 -= c11_28.y * a29;
  a11 -= c11_28.z * a30;
  a11 -= c11_28.w * a31;
  const float4 c8_8 = *(const float4*)(Ab + 552);
  const float4 c8_12 = *(const float4*)(Ab + 556);
  const float4 c8_16 = *(const float4*)(Ab + 560);
  const float4 c8_20 = *(const float4*)(Ab + 564);
  const float4 c8_24 = *(const float4*)(Ab + 568);
  const float4 c8_28 = *(const float4*)(Ab + 572);
  a10 -= c10_8.w * a11;
  a10 -= c10_12.x * a12;
  a10 -= c10_12.y * a13;
  a10 -= c10_12.z * a14;
  a10 -= c10_12.w * a15;
  a10 -= c10_16.x * a16;
  a10 -= c10_16.y * a17;
  a10 -= c10_16.z * a18;
  a10 -= c10_16.w * a19;
  a10 -= c10_20.x * a20;
  a10 -= c10_20.y * a21;
  a10 -= c10_20.z * a22;
  a10 -= c10_20.w * a23;
  a10 -= c10_24.x * a24;
  a10 -= c10_24.y * a25;
  a10 -= c10_24.z * a26;
  a10 -= c10_24.w * a27;
  a10 -= c10_28.x * a28;
  a10 -= c10_28.y * a29;
  a10 -= c10_28.z * a30;
  a10 -= c10_28.w * a31;
  const float4 c7_8 = *(const float4*)(Ab + 484);
  const float4 c7_12 = *(const float4*)(Ab + 488);
  const float4 c7_16 = *(const float4*)(Ab + 492);
  const float4 c7_20 = *(const float4*)(Ab + 496);
  const float4 c7_24 = *(const float4*)(Ab + 500);
  const float4 c7_28 = *(const float4*)(Ab + 504);
  a9 -= c9_8.z * a10;
  a9 -= c9_8.w * a11;
  a9 -= c9_12.x * a12;
  a9 -= c9_12.y * a13;
  a9 -= c9_12.z * a14;
  a9 -= c9_12.w * a15;
  a9 -= c9_16.x * a16;
  a9 -= c9_16.y * a17;
  a9 -= c9_16.z * a18;
  a9 -= c9_16.w * a19;
  a9 -= c9_20.x * a20;
  a9 -= c9_20.y * a21;
  a9 -= c9_20.z * a22;
  a9 -= c9_20.w * a23;
  a9 -= c9_24.x * a24;
  a9 -= c9_24.y * a25;
  a9 -= c9_24.z * a26;
  a9 -= c9_24.w * a27;
  a9 -= c9_28.x * a28;
  a9 -= c9_28.y * a29;
  a9 -= c9_28.z * a30;
  a9 -= c9_28.w * a31;
  const float4 c6_4 = *(const float4*)(Ab + 412);
  const float4 c6_8 = *(const float4*)(Ab + 416);
  const float4 c6_12 = *(const float4*)(Ab + 420);
  const float4 c6_16 = *(const float4*)(Ab + 424);
  const float4 c6_20 = *(const float4*)(Ab + 428);
  const float4 c6_24 = *(const float4*)(Ab + 432);
  const float4 c6_28 = *(const float4*)(Ab + 436);
  a8 -= c8_8.y * a9;
  a8 -= c8_8.z * a10;
  a8 -= c8_8.w * a11;
  a8 -= c8_12.x * a12;
  a8 -= c8_12.y * a13;
  a8 -= c8_12.z * a14;
  a8 -= c8_12.w * a15;
  a8 -= c8_16.x * a16;
  a8 -= c8_16.y * a17;
  a8 -= c8_16.z * a18;
  a8 -= c8_16.w * a19;
  a8 -= c8_20.x * a20;
  a8 -= c8_20.y * a21;
  a8 -= c8_20.z * a22;
  a8 -= c8_20.w * a23;
  a8 -= c8_24.x * a24;
  a8 -= c8_24.y * a25;
  a8 -= c8_24.z * a26;
  a8 -= c8_24.w * a27;
  a8 -= c8_28.x * a28;
  a8 -= c8_28.y * a29;
  a8 -= c8_28.z * a30;
  a8 -= c8_28.w * a31;
  __builtin_amdgcn_sched_barrier(0);
  const float4 c5_4 = *(const float4*)(Ab + 344);
  const float4 c5_8 = *(const float4*)(Ab + 348);
  const float4 c5_12 = *(const float4*)(Ab + 352);
  const float4 c5_16 = *(const float4*)(Ab + 356);
  const float4 c5_20 = *(const float4*)(Ab + 360);
  const float4 c5_24 = *(const float4*)(Ab + 364);
  const float4 c5_28 = *(const float4*)(Ab + 368);
  a7 -= c7_8.x * a8;
  a7 -= c7_8.y * a9;
  a7 -= c7_8.z * a10;
  a7 -= c7_8.w * a11;
  a7 -= c7_12.x * a12;
  a7 -= c7_12.y * a13;
  a7 -= c7_12.z * a14;
  a7 -= c7_12.w * a15;
  a7 -= c7_16.x * a16;
  a7 -= c7_16.y * a17;
  a7 -= c7_16.z * a18;
  a7 -= c7_16.w * a19;
  a7 -= c7_20.x * a20;
  a7 -= c7_20.y * a21;
  a7 -= c7_20.z * a22;
  a7 -= c7_20.w * a23;
  a7 -= c7_24.x * a24;
  a7 -= c7_24.y * a25;
  a7 -= c7_24.z * a26;
  a7 -= c7_24.w * a27;
  a7 -= c7_28.x * a28;
  a7 -= c7_28.y * a29;
  a7 -= c7_28.z * a30;
  a7 -= c7_28.w * a31;
  const float4 c4_4 = *(const float4*)(Ab + 276);
  const float4 c4_8 = *(const float4*)(Ab + 280);
  const float4 c4_12 = *(const float4*)(Ab + 284);
  const float4 c4_16 = *(const float4*)(Ab + 288);
  const float4 c4_20 = *(const float4*)(Ab + 292);
  const float4 c4_24 = *(const float4*)(Ab + 296);
  const float4 c4_28 = *(const float4*)(Ab + 300);
  a6 -= c6_4.w * a7;
  a6 -= c6_8.x * a8;
  a6 -= c6_8.y * a9;
  a6 -= c6_8.z * a10;
  a6 -= c6_8.w * a11;
  a6 -= c6_12.x * a12;
  a6 -= c6_12.y * a13;
  a6 -= c6_12.z * a14;
  a6 -= c6_12.w * a15;
  a6 -= c6_16.x * a16;
  a6 -= c6_16.y * a17;
  a6 -= c6_16.z * a18;
  a6 -= c6_16.w * a19;
  a6 -= c6_20.x * a20;
  a6 -= c6_20.y * a21;
  a6 -= c6_20.z * a22;
  a6 -= c6_20.w * a23;
  a6 -= c6_24.x * a24;
  a6 -= c6_24.y * a25;
  a6 -= c6_24.z * a26;
  a6 -= c6_24.w * a27;
  a6 -= c6_28.x * a28;
  a6 -= c6_28.y * a29;
  a6 -= c6_28.z * a30;
  a6 -= c6_28.w * a31;
  const float4 c3_4 = *(const float4*)(Ab + 208);
  const float4 c3_8 = *(const float4*)(Ab + 212);
  const float4 c3_12 = *(const float4*)(Ab + 216);
  const float4 c3_16 = *(const float4*)(Ab + 220);
  const float4 c3_20 = *(const float4*)(Ab + 224);
  const float4 c3_24 = *(const float4*)(Ab + 228);
  const float4 c3_28 = *(const float4*)(Ab + 232);
  a5 -= c5_4.z * a6;
  a5 -= c5_4.w * a7;
  a5 -= c5_8.x * a8;
  a5 -= c5_8.y * a9;
  a5 -= c5_8.z * a10;
  a5 -= c5_8.w * a11;
  a5 -= c5_12.x * a12;
  a5 -= c5_12.y * a13;
  a5 -= c5_12.z * a14;
  a5 -= c5_12.w * a15;
  a5 -= c5_16.x * a16;
  a5 -= c5_16.y * a17;
  a5 -= c5_16.z * a18;
  a5 -= c5_16.w * a19;
  a5 -= c5_20.x * a20;
  a5 -= c5_20.y * a21;
  a5 -= c5_20.z * a22;
  a5 -= c5_20.w * a23;
  a5 -= c5_24.x * a24;
  a5 -= c5_24.y * a25;
  a5 -= c5_24.z * a26;
  a5 -= c5_24.w * a27;
  a5 -= c5_28.x * a28;
  a5 -= c5_28.y * a29;
  a5 -= c5_28.z * a30;
  a5 -= c5_28.w * a31;
  const float4 c2_0 = *(const float4*)(Ab + 136);
  const float4 c2_4 = *(const float4*)(Ab + 140);
  const float4 c2_8 = *(const float4*)(Ab + 144);
  const float4 c2_12 = *(const float4*)(Ab + 148);
  const float4 c2_16 = *(const float4*)(Ab + 152);
  const float4 c2_20 = *(const float4*)(Ab + 156);
  const float4 c2_24 = *(const float4*)(Ab + 160);
  const float4 c2_28 = *(const float4*)(Ab + 164);
  a4 -= c4_4.y * a5;
  a4 -= c4_4.z * a6;
  a4 -= c4_4.w * a7;
  a4 -= c4_8.x * a8;
  a4 -= c4_8.y * a9;
  a4 -= c4_8.z * a10;
  a4 -= c4_8.w * a11;
  a4 -= c4_12.x * a12;
  a4 -= c4_12.y * a13;
  a4 -= c4_12.z * a14;
  a4 -= c4_12.w * a15;
  a4 -= c4_16.x * a16;
  a4 -= c4_16.y * a17;
  a4 -= c4_16.z * a18;
  a4 -= c4_16.w * a19;
  a4 -= c4_20.x * a20;
  a4 -= c4_20.y * a21;
  a4 -= c4_20.z * a22;
  a4 -= c4_20.w * a23;
  a4 -= c4_24.x * a24;
  a4 -= c4_24.y * a25;
  a4 -= c4_24.z * a26;
  a4 -= c4_24.w * a27;
  a4 -= c4_28.x * a28;
  a4 -= c4_28.y * a29;
  a4 -= c4_28.z * a30;
  a4 -= c4_28.w * a31;
  __builtin_amdgcn_sched_barrier(0);
  const float4 c1_0 = *(const float4*)(Ab + 68);
  const float4 c1_4 = *(const float4*)(Ab + 72);
  const float4 c1_8 = *(const float4*)(Ab + 76);
  const float4 c1_12 = *(const float4*)(Ab + 80);
  const float4 c1_16 = *(const float4*)(Ab + 84);
  const float4 c1_20 = *(const float4*)(Ab + 88);
  const float4 c1_24 = *(const float4*)(Ab + 92);
  const float4 c1_28 = *(const float4*)(Ab + 96);
  a3 -= c3_4.x * a4;
  a3 -= c3_4.y * a5;
  a3 -= c3_4.z * a6;
  a3 -= c3_4.w * a7;
  a3 -= c3_8.x * a8;
  a3 -= c3_8.y * a9;
  a3 -= c3_8.z * a10;
  a3 -= c3_8.w * a11;
  a3 -= c3_12.x * a12;
  a3 -= c3_12.y * a13;
  a3 -= c3_12.z * a14;
  a3 -= c3_12.w * a15;
  a3 -= c3_16.x * a16;
  a3 -= c3_16.y * a17;
  a3 -= c3_16.z * a18;
  a3 -= c3_16.w * a19;
  a3 -= c3_20.x * a20;
  a3 -= c3_20.y * a21;
  a3 -= c3_20.z * a22;
  a3 -= c3_20.w * a23;
  a3 -= c3_24.x * a24;
  a3 -= c3_24.y * a25;
  a3 -= c3_24.z * a26;
  a3 -= c3_24.w * a27;
  a3 -= c3_28.x * a28;
  a3 -= c3_28.y * a29;
  a3 -= c3_28.z * a30;
  a3 -= c3_28.w * a31;
  const float4 c0_0 = *(const float4*)(Ab + 0);
  const float4 c0_4 = *(const float4*)(Ab + 4);
  const float4 c0_8 = *(const float4*)(Ab + 8);
  const float4 c0_12 = *(const float4*)(Ab + 12);
  const float4 c0_16 = *(const float4*)(Ab + 16);
  const float4 c0_20 = *(const float4*)(Ab + 20);
  const float4 c0_24 = *(const float4*)(Ab + 24);
  const float4 c0_28 = *(const float4*)(Ab + 28);
  a2 -= c2_0.w * a3;
  a2 -= c2_4.x * a4;
  a2 -= c2_4.y * a5;
  a2 -= c2_4.z * a6;
  a2 -= c2_4.w * a7;
  a2 -= c2_8.x * a8;
  a2 -= c2_8.y * a9;
  a2 -= c2_8.z * a10;
  a2 -= c2_8.w * a11;
  a2 -= c2_12.x * a12;
  a2 -= c2_12.y * a13;
  a2 -= c2_12.z * a14;
  a2 -= c2_12.w * a15;
  a2 -= c2_16.x * a16;
  a2 -= c2_16.y * a17;
  a2 -= c2_16.z * a18;
  a2 -= c2_16.w * a19;
  a2 -= c2_20.x * a20;
  a2 -= c2_20.y * a21;
  a2 -= c2_20.z * a22;
  a2 -= c2_20.w * a23;
  a2 -= c2_24.x * a24;
  a2 -= c2_24.y * a25;
  a2 -= c2_24.z * a26;
  a2 -= c2_24.w * a27;
  a2 -= c2_28.x * a28;
  a2 -= c2_28.y * a29;
  a2 -= c2_28.z * a30;
  a2 -= c2_28.w * a31;
  a1 -= c1_0.z * a2;
  a1 -= c1_0.w * a3;
  a1 -= c1_4.x * a4;
  a1 -= c1_4.y * a5;
  a1 -= c1_4.z * a6;
  a1 -= c1_4.w * a7;
  a1 -= c1_8.x * a8;
  a1 -= c1_8.y * a9;
  a1 -= c1_8.z * a10;
  a1 -= c1_8.w * a11;
  a1 -= c1_12.x * a12;
  a1 -= c1_12.y * a13;
  a1 -= c1_12.z * a14;
  a1 -= c1_12.w * a15;
  a1 -= c1_16.x * a16;
  a1 -= c1_16.y * a17;
  a1 -= c1_16.z * a18;
  a1 -= c1_16.w * a19;
  a1 -= c1_20.x * a20;
  a1 -= c1_20.y * a21;
  a1 -= c1_20.z * a22;
  a1 -= c1_20.w * a23;
  a1 -= c1_24.x * a24;
  a1 -= c1_24.y * a25;
  a1 -= c1_24.z * a26;
  a1 -= c1_24.w * a27;
  a1 -= c1_28.x * a28;
  a1 -= c1_28.y * a29;
  a1 -= c1_28.z * a30;
  a1 -= c1_28.w * a31;
  a0 -= c0_0.y * a1;
  a0 -= c0_0.z * a2;
  a0 -= c0_0.w * a3;
  a0 -= c0_4.x * a4;
  a0 -= c0_4.y * a5;
  a0 -= c0_4.z * a6;
  a0 -= c0_4.w * a7;
  a0 -= c0_8.x * a8;
  a0 -= c0_8.y * a9;
  a0 -= c0_8.z * a10;
  a0 -= c0_8.w * a11;
  a0 -= c0_12.x * a12;
  a0 -= c0_12.y * a13;
  a0 -= c0_12.z * a14;
  a0 -= c0_12.w * a15;
  a0 -= c0_16.x * a16;
  a0 -= c0_16.y * a17;
  a0 -= c0_16.z * a18;
  a0 -= c0_16.w * a19;
  a0 -= c0_20.x * a20;
  a0 -= c0_20.y * a21;
  a0 -= c0_20.z * a22;
  a0 -= c0_20.w * a23;
  a0 -= c0_24.x * a24;
  a0 -= c0_24.y * a25;
  a0 -= c0_24.z * a26;
  a0 -= c0_24.w * a27;
  a0 -= c0_28.x * a28;
  a0 -= c0_28.y * a29;
  a0 -= c0_28.z * a30;
  a0 -= c0_28.w * a31;
  __builtin_amdgcn_sched_barrier(0);
  Xc[0] = a0;
  Xc[65] = a1;
  Xc[130] = a2;
  Xc[195] = a3;
  Xc[260] = a4;
  Xc[325] = a5;
  Xc[390] = a6;
  Xc[455] = a7;
  Xc[520] = a8;
  Xc[585] = a9;
  Xc[650] = a10;
  Xc[715] = a11;
  Xc[780] = a12;
  Xc[845] = a13;
  Xc[910] = a14;
  Xc[975] = a15;
  Xc[1040] = a16;
  Xc[1105] = a17;
  Xc[1170] = a18;
  Xc[1235] = a19;
  Xc[1300] = a20;
  Xc[1365] = a21;
  Xc[1430] = a22;
  Xc[1495] = a23;
  Xc[1560] = a24;
  Xc[1625] = a25;
  Xc[1690] = a26;
  Xc[1755] = a27;
  Xc[1820] = a28;
  Xc[1885] = a29;
  Xc[1950] = a30;
  Xc[2015] = a31;
}
#define FS(i) (ldsf + (i) * 4160)
__device__ __forceinline__ void rwkv_item2(const Params& p, int l, int item, float* ldsf) {
  const int tid = opq(threadIdx.x), lane = tid & 63, wave = tid >> 6;
  const int r = lane & 31, hf = lane >> 5;
  const int h = item & 7, cidx = item >> 3, rowbase = cidx * 64, cc = cidx & 127;
  const u16* z = (const u16*)(p.ws + WS_Z);
  const float* mu = p.in[9] + l * 1792;
  u16* BBp = (u16*)((unsigned char*)ldsf + 83200);
  u16* XW = BBp;            u16* XA = BBp + 4608;    u16* XG = BBp + 9216;   u16* WT = BBp + 17920;
  u16* Rn = BBp;            u16* Kn = BBp + 4608;    u16* Bn = BBp + 9216;   u16* Cn = BBp + 13824;
  u16* CT = BBp + 18432;    u16* KHT = BBp + 23040;  u16* VT = BBp + 27648;
  float* gc = (float*)(BBp + 32256);
  u16* AK = (u16*)FS(2);    u16* NTm = AK + 4608;
  u16* MT = (u16*)FS(0);    u16* KQT = (u16*)FS(1);
  float* Abp = (float*)((unsigned char*)ldsf + 60928);
  const int mt = (wave >> 1) & 1, nt = wave & 1, grp = wave >> 2;
  const uint4* lwsrc = (const uint4*)((const u16*)(p.ws + WS_LW) + (size_t)h * 17920);
  const float bias_w = p.in[10][l * 512 + h * 64 + nt * 32 + r], bias_a = p.in[12][l * 512 + h * 64 + nt * 32 + r];
  float kkw_[8], kaw_[8], rkw_[8];
  {
    const int j0 = (tid & 7) * 8;
    const float* q1 = p.in[15] + l * 512 + h * 64 + j0; const float* q2 = p.in[16] + l * 512 + h * 64 + j0; const float* q3 = p.in[17] + l * 512 + h * 64 + j0;
    const float4 x0 = *(const float4*)q1, x1 = *(const float4*)(q1 + 4), y0 = *(const float4*)q2, y1 = *(const float4*)(q2 + 4), z0 = *(const float4*)q3, z1 = *(const float4*)(q3 + 4);
    kkw_[0] = x0.x; kkw_[1] = x0.y; kkw_[2] = x0.z; kkw_[3] = x0.w; kkw_[4] = x1.x; kkw_[5] = x1.y; kkw_[6] = x1.z; kkw_[7] = x1.w;
    kaw_[0] = y0.x; kaw_[1] = y0.y; kaw_[2] = y0.z; kaw_[3] = y0.w; kaw_[4] = y1.x; kaw_[5] = y1.y; kaw_[6] = y1.z; kaw_[7] = y1.w;
    rkw_[0] = z0.x; rkw_[1] = z0.y; rkw_[2] = z0.z; rkw_[3] = z0.w; rkw_[4] = z1.x; rkw_[5] = z1.y; rkw_[6] = z1.z; rkw_[7] = z1.w;
  }
  const uint4 g2a = lwsrc[1152 + tid], g2b = lwsrc[1152 + 512 + tid], g2c = (tid < 64) ? lwsrc[1152 + 1024 + tid] : make_uint4(0, 0, 0, 0);
  __syncthreads();
  {
    const int t = tid >> 3, c8 = (tid & 7) * 8;
    const int m = rowbase + t;
    const int zcs[7] = {h * 64, 512 + h * 64, 1024 + h * 64, 1536, 1600, 1664, 1728};
#pragma unroll
    for (int gi = 0; gi < 7; ++gi) {
      const int zc = zcs[gi] + c8;
      float cur[8], prv[8], v[8];
      const float4 mu0 = *(const float4*)(mu + zc), mu1 = *(const float4*)(mu + zc + 4);
      const float muv[8] = {mu0.x, mu0.y, mu0.z, mu0.w, mu1.x, mu1.y, mu1.z, mu1.w};
      unpack8(*(const uint4*)(z + (size_t)m * ZLD + zc), cur);
      if (t == 0 && cc == 0) {
#pragma unroll
        for (int i = 0; i < 8; ++i) prv[i] = 0.f;
      } else {
        unpack8(*(const uint4*)(z + (size_t)(m - 1) * ZLD + zc), prv);
      }
#pragma unroll
      for (int i = 0; i < 8; ++i) {
        float x = cur[i] + muv[i] * (prv[i] - cur[i]);
        if (gi == 3) x = 1.f - 2.f * __builtin_amdgcn_rcpf(1.f + __expf(2.f * x));
        if (gi >= 5) x = sigm(x);
        v[i] = x;
      }
      if (gi < 2) {
        float* d = FS(gi) + t * 65 + c8;
#pragma unroll
        for (int i = 0; i < 8; ++i) d[i] = v[i];
      } else if (gi == 2) {
#pragma unroll
        for (int i = 0; i < 8; ++i) VT[(c8 + i) * 72 + t] = f2bf(v[i]);
      } else if (gi == 3) { *(uint4*)(XW + t * 72 + c8) = pack8(v); }
      else if (gi == 4) { *(uint4*)(XA + t * 72 + c8) = pack8(v); }
      else { *(uint4*)(XG + t * 136 + (gi - 5) * 64 + c8) = pack8(v); }
    }
  }
  {
    uint4* d = (uint4*)WT;
    for (int e = tid; e < 1152; e += 512) d[e] = lwsrc[e];
  }
  __syncthreads();
  {
    f32x16 acc;
#pragma unroll
    for (int i = 0; i < 16; ++i) acc[i] = 0.f;
    mm_tile(grp ? XA : XW, 72, grp ? WT + 4608 : WT, 72, mt, nt, r, hf, 4, acc);
    const int j = nt * 32 + r;
    const float bias = grp ? bias_a : bias_w;
#pragma unroll
    for (int reg = 0; reg < 16; ++reg) {
      const int t = mt * 32 + ROWOFF(reg, hf);
      const float x = acc[reg] + bias;
      if (grp) FS(3)[t * 65 + j] = sigm(x);
      else {
        const float nx = -x;
        const float sp = (nx > 20.f) ? nx : __logf(1.f + __expf(nx));
        FS(4)[t * 65 + j] = -__expf(-sp - 0.5f);
      }
    }
  }
  __syncthreads();
  {
    uint4* d = (uint4*)WT;
    d[tid] = g2a; d[512 + tid] = g2b; if (tid < 64) d[1024 + tid] = g2c;
  }
  float* psum = (float*)((unsigned char*)ldsf + 147968);
  float pl[8];
  {
    const int j = tid & 63, sg = tid >> 6;
    float c = 0.f;
#pragma unroll
    for (int u = 0; u < 8; ++u) { c += FS(4)[(sg * 8 + u) * 65 + j]; pl[u] = c; }
    psum[sg * 64 + j] = c;
  }
  __syncthreads();
  {
    const int j = tid & 63, sg = tid >> 6;
    float off = 0.f, tot = 0.f;
#pragma unroll
    for (int q = 0; q < 8; ++q) { const float v = psum[q * 64 + j]; tot += v; if (q < sg) off += v; }
#pragma unroll
    for (int u = 0; u < 8; ++u) FS(2)[(sg * 8 + u) * 65 + j] = off + pl[u];
    if (sg == 0) { const float g = __expf(tot); gc[j] = g; ((float*)(p.ws + WS_GC))[(size_t)item * 64 + j] = g; }
  }
  __syncthreads();
  if (grp == 0) {
    f32x16 acc;
#pragma unroll
    for (int i = 0; i < 16; ++i) acc[i] = 0.f;
    mm_tile(XG, 136, WT, 136, mt, nt, r, hf, 8, acc);
    u16* ga = (u16*)(p.ws + WS_GA) + (size_t)item * 4096;
#pragma unroll
    for (int reg = 0; reg < 16; ++reg) ga[(mt * 32 + ROWOFF(reg, hf)) * 64 + nt * 32 + r] = f2bf(acc[reg]);
  }
  __syncthreads();
  {
    const int t = tid >> 3, j0 = (tid & 7) * 8;
    float kr[8], av[8], rv[8], kkv[8], kf[8];
    float nrm = 0.f, bdot = 0.f;
#pragma unroll
    for (int i = 0; i < 8; ++i) {
      const int j = j0 + i;
      kr[i] = FS(1)[t * 65 + j]; av[i] = FS(3)[t * 65 + j]; rv[i] = FS(0)[t * 65 + j];
      kkv[i] = kr[i] * kkw_[i];
      nrm += kkv[i] * kkv[i];
      kf[i] = kr[i] * (1.f + (av[i] - 1.f) * kaw_[i]);
      bdot += rv[i] * kf[i] * rkw_[i];
    }
    nrm += __shfl_xor(nrm, 1, 64); nrm += __shfl_xor(nrm, 2, 64); nrm += __shfl_xor(nrm, 4, 64);
    bdot += __shfl_xor(bdot, 1, 64); bdot += __shfl_xor(bdot, 2, 64); bdot += __shfl_xor(bdot, 4, 64);
    const float rn = 1.f / fmaxf(sqrtf(nrm), 1e-12f);
    float o_r[8], o_k[8], o_b[8], o_c[8], bo[8];
#pragma unroll
    for (int i = 0; i < 8; ++i) {
      const int j = j0 + i;
      const float cum = FS(2)[t * 65 + j], dl = FS(4)[t * 65 + j];
      const float eg = __expf(cum), egi = __expf(-cum), egp = __expf(cum - dl);
      const float kk = kkv[i] * rn;
      const float g = gc[j];
      o_r[i] = rv[i] * eg; o_k[i] = kf[i] * egi; o_b[i] = kk * av[i] * egi; o_c[i] = kk * egp;
      CT[j * 72 + t] = f2bf(o_c[i]);
      KHT[j * 72 + t] = f2bf(o_k[i] * g);
      FS(1)[t * 65 + j] = o_b[i] * g;
      bo[i] = bdot * bf2f(VT[j * 72 + t]);
    }
    *(uint4*)(Rn + t * 72 + j0) = pack8(o_r);
    *(uint4*)(Kn + t * 72 + j0) = pack8(o_k);
    *(uint4*)(Bn + t * 72 + j0) = pack8(o_b);
    *(uint4*)(Cn + t * 72 + j0) = pack8(o_c);
    u16* bop = (u16*)(p.ws + WS_BO) + (size_t)item * 4096;
    *(uint4*)(bop + t * 64 + j0) = pack8(bo);
  }
  __syncthreads();
  f32x16 akr;
#pragma unroll
  for (int i = 0; i < 16; ++i) akr[i] = 0.f;
  if (grp == 0) {
    f32x16 ab, abr;
#pragma unroll
    for (int i = 0; i < 16; ++i) { ab[i] = 0.f; abr[i] = 0.f; }
    mm_tile(Bn, 72, Cn, 72, mt, nt, r, hf, 4, ab);
    mm_tile(Bn, 72, Rn, 72, mt, nt, r, hf, 4, abr);
    const int t = nt * 32 + r;
#pragma unroll
    for (int reg = 0; reg < 16; ++reg) {
      const int i = mt * 32 + ROWOFF(reg, hf);
      Abp[i * 68 + t] = (i < t) ? ab[reg] : 0.f;
      FS(0)[i * 65 + t] = (i <= t) ? abr[reg] : 0.f;
    }
  } else {
    f32x16 akt;
#pragma unroll
    for (int i = 0; i < 16; ++i) akt[i] = 0.f;
    mm_tile(Cn, 72, Kn, 72, mt, nt, r, hf, 4, akt);
    {
      const int i = nt * 32 + r;
#pragma unroll
      for (int reg = 0; reg < 16; ++reg) { const int t = mt * 32 + ROWOFF(reg, hf); if (!(i < t)) akt[reg] = 0.f; }
    }
    store_T(AK, 72, mt, nt, r, hf, akt);
    mm_tile(Kn, 72, Rn, 72, mt, nt, r, hf, 4, akr);
    {
      const int t = nt * 32 + r;
#pragma unroll
      for (int reg = 0; reg < 16; ++reg) { const int i = mt * 32 + ROWOFF(reg, hf); if (!(i <= t)) akr[reg] = 0.f; }
    }
  }
  __syncthreads();
  if (tid < 128) {
    float* X_ = (tid < 64) ? FS(0) : FS(1);
    const int col = tid & 63;
    tri32(Abp + 32 * 68 + 32, X_ + 32 * 65 + col);
  }
  __syncthreads();
  {
    const int c = tid & 127, ig = tid >> 7;
    float* X_ = (c < 64) ? FS(0) : FS(1);
    const int col = c & 63;
    float a[8];
#pragma unroll
    for (int u = 0; u < 8; ++u) a[u] = 0.f;
#pragma unroll 2
    for (int t = 32; t < 64; t += 4) {
      const float x0 = X_[t * 65 + col], x1 = X_[(t + 1) * 65 + col], x2 = X_[(t + 2) * 65 + col], x3 = X_[(t + 3) * 65 + col];
#pragma unroll
      for (int u = 0; u < 8; ++u) {
        const float4 c_ = *(const float4*)(Abp + (ig * 8 + u) * 68 + t);
        a[u] += c_.x * x0 + c_.y * x1 + c_.z * x2 + c_.w * x3;
      }
    }
#pragma unroll
    for (int u = 0; u < 8; ++u) X_[(ig * 8 + u) * 65 + col] -= a[u];
  }
  __syncthreads();
  if (tid < 128) {
    float* X_ = (tid < 64) ? FS(0) : FS(1);
    const int col = tid & 63;
    tri32(Abp, X_ + col);
  }
  __syncthreads();
  {
    const int c = tid >> 2, q = tid & 3;
    const float* X_ = (c < 64) ? FS(0) : FS(1);
    const int col = c & 63;
    float o0[8], o1[8];
#pragma unroll
    for (int u = 0; u < 8; ++u) { o0[u] = -X_[(q * 16 + u) * 65 + col]; o1[u] = -X_[(q * 16 + 8 + u) * 65 + col]; }
    u16* dst = NTm + c * 72 + q * 16;
    *(uint4*)dst = pack8(o0);
    *(uint4*)(dst + 8) = pack8(o1);
  }
  __syncthreads();
  if (grp == 1) {
    mm_tile(AK, 72, NTm, 72, mt, nt, r, hf, 4, akr);
    store_T(MT, 72, mt, nt, r, hf, akr);
  } else {
    f32x16 d2;
#pragma unroll
    for (int i = 0; i < 16; ++i) d2[i] = 0.f;
    mm_tile(AK, 72, NTm + 64 * 72, 72, mt, nt, r, hf, 4, d2);
#pragma unroll
    for (int g = 0; g < 4; ++g) {
      const int idx = (nt * 32 + r) * 72 + mt * 32 + 8 * g + 4 * hf;
      const uint2 kh = *(const uint2*)(KHT + idx);
      uint2 o;
      o.x = pack2(d2[4 * g] + __uint_as_float(kh.x << 16), d2[4 * g + 1] + __uint_as_float(kh.x & 0xFFFF0000u));
      o.y = pack2(d2[4 * g + 2] + __uint_as_float(kh.y << 16), d2[4 * g + 3] + __uint_as_float(kh.y & 0xFFFF0000u));
      *(uint2*)(KQT + idx) = o;
    }
  }
  __syncthreads();
  if (grp == 0) {
    f32x16 w2, yl;
#pragma unroll
    for (int i = 0; i < 16; ++i) { w2[i] = 0.f; yl[i] = 0.f; }
    mm_tile(NTm, 72, CT, 72, mt, nt, r, hf, 4, w2);
    mm_tile(MT, 72, VT, 72, mt, nt, r, hf, 4, yl);
    u16* W2p = (u16*)(p.ws + WS_W2) + (size_t)item * 4096;
    u16* YLp = (u16*)(p.ws + WS_YL) + (size_t)item * 4096;
#pragma unroll
    for (int reg = 0; reg < 16; ++reg) {
      const int t = mt * 32 + ROWOFF(reg, hf), n = nt * 32 + r;
      W2p[t * 64 + n] = f2bf(w2[reg] + bf2f(Rn[t * 72 + n]));
      YLp[t * 64 + n] = f2bf(yl[reg]);
    }
  } else {
    f32x16 pp, qt;
#pragma unroll
    for (int i = 0; i < 16; ++i) { pp[i] = 0.f; qt[i] = 0.f; }
    mm_tile(CT, 72, NTm + 64 * 72, 72, mt, nt, r, hf, 4, pp);
    mm_tile(KQT, 72, VT, 72, mt, nt, r, hf, 4, qt);
    uint4* Pf = (uint4*)((u16*)(p.ws + WS_PP) + (size_t)item * 4096);
    float* Qf = (float*)(p.ws + WS_Q) + (size_t)item * 4096;
#pragma unroll
    for (int s2 = 0; s2 < 2; ++s2) {
      uint4 o;
      o.x = pack2(pp[s2 * 8 + 0], pp[s2 * 8 + 1]); o.y = pack2(pp[s2 * 8 + 2], pp[s2 * 8 + 3]);
      o.z = pack2(pp[s2 * 8 + 4], pp[s2 * 8 + 5]); o.w = pack2(pp[s2 * 8 + 6], pp[s2 * 8 + 7]);
      Pf[(nt * 4 + mt * 2 + s2) * 64 + lane] = o;
    }
#pragma unroll
    for (int reg = 0; reg < 16; ++reg) Qf[((nt * 2 + mt) * 16 + reg) * 64 + lane] = qt[reg];
  }
}

template <int K_> struct IC { static constexpr int value = K_; };
__device__ __forceinline__ void rwkv_scan(const Params& p, int l, int bh, float* ldsf, bool dry = false) {
  const int tid = opq(threadIdx.x), lane = tid & 63, wave = tid >> 6;
  const int b = bh >> 3, h = bh & 7;
  unsigned char* ring = (unsigned char*)ldsf + 32768;
  __syncthreads();
  {
    const float* G0 = (const float*)(p.ws + WS_GC);
    for (int e = tid; e < 8192; e += NT) ldsf[e] = G0[(size_t)((b * 128 + (e >> 6)) * 8 + h) * 64 + (e & 63)];
  }
  const bool helper = wave >= 2;
  const int ht = tid - 128;
  const u16* PPb = (const u16*)(p.ws + WS_PP);
  const float* Qb = (const float*)(p.ws + WS_Q);
  const bool isP = wave < 4;
  const int hstr = isP ? 128 : 256;
  const int hidx = isP ? (tid - 128) : (tid - 256);
  const int hdst = isP ? hidx : 512 + hidx;
#define SC_GLOAD(c, D0, D1, D2, D3) do { const size_t id_ = (size_t)((b * 128 + (c)) * 8 + h); \
    const uint4* src_ = isP ? (const uint4*)(PPb + id_ * 4096) : (const uint4*)(Qb + id_ * 4096); \
    D0 = src_[hidx]; D1 = src_[hidx + hstr]; D2 = src_[hidx + 2 * hstr]; D3 = src_[hidx + 3 * hstr]; } while (0)
#define SC_LWRITE(c, D0, D1, D2, D3) do { uint4* slot_ = (uint4*)(ring + ((c) & 1) * 24576) + hdst; \
    slot_[0] = D0; slot_[hstr] = D1; slot_[2 * hstr] = D2; slot_[3 * hstr] = D3; } while (0)
  if (helper) {
    uint4 a0, a1, a2, a3, b0, b1, b2, b3, c0_, c1_, c2_, c3_, d0, d1, d2, d3;
    SC_GLOAD(0, a0, a1, a2, a3); SC_LWRITE(0, a0, a1, a2, a3);
    SC_GLOAD(1, b0, b1, b2, b3); SC_GLOAD(2, c0_, c1_, c2_, c3_); SC_GLOAD(3, d0, d1, d2, d3);
    __syncthreads();
#pragma unroll 1
    for (int cc = 0; cc < 128; cc += 4) {
      if (cc + 4 < 128) SC_GLOAD(cc + 4, a0, a1, a2, a3);
      SC_LWRITE(cc + 1, b0, b1, b2, b3);
      asm volatile("s_waitcnt lgkmcnt(0)\n\ts_barrier" ::: "memory");
      if (cc + 5 < 128) SC_GLOAD(cc + 5, b0, b1, b2, b3);
      SC_LWRITE(cc + 2, c0_, c1_, c2_, c3_);
      asm volatile("s_waitcnt lgkmcnt(0)\n\ts_barrier" ::: "memory");
      if (cc + 6 < 128) SC_GLOAD(cc + 6, c0_, c1_, c2_, c3_);
      SC_LWRITE(cc + 3, d0, d1, d2, d3);
      asm volatile("s_waitcnt lgkmcnt(0)\n\ts_barrier" ::: "memory");
      if (cc + 7 < 128) SC_GLOAD(cc + 7, d0, d1, d2, d3);
      if (cc + 4 < 128) SC_LWRITE(cc + 4, a0, a1, a2, a3);
      asm volatile("s_waitcnt lgkmcnt(0)\n\ts_barrier" ::: "memory");
    }
    return;
  }
  __syncthreads();
  const int vt = wave & 1, hf = lane >> 5;
  f32x16 S[2];
#pragma unroll
  for (int i = 0; i < 16; ++i) { S[0][i] = 0.f; S[1][i] = 0.f; }
#pragma unroll 1
  for (int cc = 0; cc < 128; ++cc) {
    const size_t id = (size_t)((b * 128 + cc) * 8 + h);
    float* Qg = (float*)Qb + id * 4096;
    const int lofs = opq(lane);
    const uint4* slotA = (const uint4*)(ring + (cc & 1) * 24576) + lofs;
    const float* slotQ = (const float*)(ring + (cc & 1) * 24576 + 8192) + vt * 2048 + lofs;
    const float* gcp = ldsf + cc * 64 + 4 * (lofs >> 5);
    Qg += vt * 2048 + lofs;
    f32x16 acc[2];
#pragma unroll
    for (int kt = 0; kt < 2; ++kt)
#pragma unroll
      for (int reg = 0; reg < 16; ++reg)
        acc[kt][reg] = S[kt][reg] * gcp[kt * 32 + ((reg) & 3) + 8 * ((reg) >> 2)] + slotQ[(kt * 16 + reg) * 64];
#pragma unroll
    for (int kt = 0; kt < 2; ++kt)
#pragma unroll
      for (int reg = 0; reg < 16; ++reg) if (!dry) Qg[(kt * 16 + reg) * 64] = S[kt][reg];
#pragma unroll
    for (int s_ = 0; s_ < 4; ++s_) {
      const int kt = s_ >> 1, s2 = s_ & 1;
      unsigned hw[4];
#pragma unroll
      for (int j = 0; j < 4; ++j) hw[j] = pack2(S[kt][s2 * 8 + 2 * j], S[kt][s2 * 8 + 2 * j + 1]);
      union { uint4 u; bf16x8 v; } bh_;
      bh_.u = make_uint4(hw[0], hw[1], hw[2], hw[3]);
#pragma unroll
      for (int kt2 = 0; kt2 < 2; ++kt2) {
        union { uint4 u; bf16x8 v; } af; af.u = slotA[(kt2 * 4 + s_) * 64];
        acc[kt2] = __builtin_amdgcn_mfma_f32_32x32x16_bf16(af.v, bh_.v, acc[kt2], 0, 0, 0);
      }
    }
    S[0] = acc[0]; S[1] = acc[1];
    asm volatile("s_waitcnt lgkmcnt(0)\n\ts_barrier" ::: "memory");
  }
  {
    float* o = p.out + O_PWKV + ((size_t)((l * 2 + b) * 8 + h) * 64 + vt * 32 + (lane & 31)) * 64;
#pragma unroll
    for (int kt = 0; kt < 2; ++kt)
#pragma unroll
      for (int reg = 0; reg < 16; ++reg) o[kt * 32 + ROWOFF(reg, hf)] = S[kt][reg];
  }
}

__device__ __forceinline__ void rwkv_out(const Params& p, int l, int item, float* ldsf) {
  const int tid = opq(threadIdx.x), lane = tid & 63, wave = tid >> 6;
  const int h = item & 7, cidx = item >> 3;
  float* Sl = ldsf; float* Wl = ldsf + 4160;
  const float* Sg = (const float*)(p.ws + WS_Q) + (size_t)item * 4096;
  const u16* W2 = (const u16*)(p.ws + WS_W2) + (size_t)item * 4096;
  const u16* YL = (const u16*)(p.ws + WS_YL) + (size_t)item * 4096;
  const u16* BO = (const u16*)(p.ws + WS_BO) + (size_t)item * 4096;
  const u16* GA = (const u16*)(p.ws + WS_GA) + (size_t)item * 4096;
  u16* z = (u16*)(p.ws + WS_Z);
  __syncthreads();
  {
    const int row = tid >> 3, c = (tid & 7) * 8;
#pragma unroll
    for (int i = 0; i < 8; ++i) {
      const int idx = i * 512 + tid;
      const int ln = idx & 63, reg = (idx >> 6) & 15, kt = (idx >> 10) & 1, vt = idx >> 11;
      Sl[(vt * 32 + (ln & 31)) * 65 + kt * 32 + ROWOFF(reg, ln >> 5)] = Sg[idx];
    }
    float w[8];
    unpack8(*(const uint4*)(W2 + row * 64 + c), w);
    float* e = Wl + row * 65 + c;
#pragma unroll
    for (int i = 0; i < 8; ++i) e[i] = w[i];
  }
  __syncthreads();
  float y[8];
#pragma unroll
  for (int q = 0; q < 8; ++q) y[q] = bf2f(YL[(wave * 8 + q) * 64 + lane]);
#pragma unroll 2
  for (int k = 0; k < 64; ++k) {
    const float s = Sl[lane * 65 + k];
#pragma unroll
    for (int q = 0; q < 8; ++q) y[q] += s * Wl[(wave * 8 + q) * 65 + k];
  }
  const float lng = p.in[18][l * 512 + h * 64 + lane], lnb = p.in[19][l * 512 + h * 64 + lane];
#pragma unroll
  for (int q = 0; q < 8; ++q) {
    const int t = wave * 8 + q;
    const float mean = wave_sum(y[q]) * (1.f / 64.f);
    const float d = y[q] - mean;
    const float var = wave_sum(d * d) * (1.f / 64.f);
    const float yn = d * rsqrtf(var + 64e-5f) * lng + lnb;
    const float o = (yn + bf2f(BO[t * 64 + lane])) * bf2f(GA[t * 64 + lane]);
    z[(size_t)(cidx * 64 + t) * ZLD + h * 64 + lane] = f2bf(o);
  }
}

__device__ __forceinline__ void rwkv_out4(const Params& p, int l, int item0, float* ldsf) {
  const int tid = opq(threadIdx.x), lane = tid & 63, wave = tid >> 6;
  const int r = lane & 31, hf = lane >> 5;
  const int pair = wave >> 1, nt = wave & 1;
  const int item = item0 + pair;
  const int h = item & 7, cidx = item >> 3;
  u16* Sl = (u16*)ldsf + pair * 4608;
  const float* Sg = (const float*)(p.ws + WS_Q) + (size_t)item * 4096;
  const u16* W2 = (const u16*)(p.ws + WS_W2) + (size_t)item * 4096;
  const u16* YL = (const u16*)(p.ws + WS_YL) + (size_t)item * 4096;
  const u16* BO = (const u16*)(p.ws + WS_BO) + (size_t)item * 4096;
  const u16* GA = (const u16*)(p.ws + WS_GA) + (size_t)item * 4096;
  u16* z = (u16*)(p.ws + WS_Z);
  __syncthreads();
  {
    const int lt = tid & 127;
#pragma unroll
    for (int q = 0; q < 8; ++q) {
      const int e = q * 128 + lt;
      const int ln = e & 63, g = (e >> 6) & 3, kt = (e >> 8) & 1, vt = (e >> 9) & 1;
      const float* sp = Sg + ((vt * 2 + kt) * 16 + 4 * g) * 64 + ln;
      const float a0 = sp[0], a1 = sp[64], a2 = sp[128], a3 = sp[192];
      uint2 o; o.x = pack2(a0, a1); o.y = pack2(a2, a3);
      *(uint2*)(Sl + (vt * 32 + (ln & 31)) * 72 + kt * 32 + 8 * g + 4 * (ln >> 5)) = o;
    }
  }
  bf16x8 bfr[4];
#pragma unroll
  for (int s_ = 0; s_ < 4; ++s_) bfr[s_] = *(const bf16x8*)(W2 + (nt * 32 + r) * 64 + s_ * 16 + hf * 8);
  __syncthreads();
  f32x16 acc[2];
#pragma unroll
  for (int mt = 0; mt < 2; ++mt) {
#pragma unroll
    for (int i = 0; i < 16; ++i) acc[mt][i] = 0.f;
#pragma unroll
    for (int s_ = 0; s_ < 4; ++s_) {
      const bf16x8 a = *(const bf16x8*)(Sl + (mt * 32 + r) * 72 + s_ * 16 + hf * 8);
      acc[mt] = __builtin_amdgcn_mfma_f32_32x32x16_bf16(a, bfr[s_], acc[mt], 0, 0, 0);
    }
  }
  const int t = nt * 32 + r;
  float sum = 0.f;
#pragma unroll
  for (int mt = 0; mt < 2; ++mt)
#pragma unroll
    for (int g = 0; g < 4; ++g) {
      const uint2 yl = *(const uint2*)(YL + t * 64 + mt * 32 + 8 * g + 4 * hf);
      acc[mt][4 * g + 0] += __uint_as_float(yl.x << 16); acc[mt][4 * g + 1] += __uint_as_float(yl.x & 0xFFFF0000u);
      acc[mt][4 * g + 2] += __uint_as_float(yl.y << 16); acc[mt][4 * g + 3] += __uint_as_float(yl.y & 0xFFFF0000u);
      sum += acc[mt][4 * g] + acc[mt][4 * g + 1] + acc[mt][4 * g + 2] + acc[mt][4 * g + 3];
    }
  sum += __shfl_xor(sum, 32, 64);
  const float mean = sum * (1.f / 64.f);
  float vs = 0.f;
#pragma unroll
  for (int mt = 0; mt < 2; ++mt)
#pragma unroll
    for (int i = 0; i < 16; ++i) { const float d = acc[mt][i] - mean; vs += d * d; }
  vs += __shfl_xor(vs, 32, 64);
  const float rstd = rsqrtf(vs * (1.f / 64.f) + 64e-5f);
  const float* lng = p.in[18] + l * 512 + h * 64;
  const float* lnb = p.in[19] + l * 512 + h * 64;
  u16* zrow = z + (size_t)(cidx * 64 + t) * ZLD + h * 64;
#pragma unroll
  for (int mt = 0; mt < 2; ++mt)
#pragma unroll
    for (int g = 0; g < 4; ++g) {
      const int v0 = mt * 32 + 8 * g + 4 * hf;
      const uint2 bo = *(const uint2*)(BO + t * 64 + v0);
      const uint2 ga = *(const uint2*)(GA + t * 64 + v0);
      const float4 lg = *(const float4*)(lng + v0), lb = *(const float4*)(lnb + v0);
      const float bo_[4] = {__uint_as_float(bo.x << 16), __uint_as_float(bo.x & 0xFFFF0000u), __uint_as_float(bo.y << 16), __uint_as_float(bo.y & 0xFFFF0000u)};
      const float ga_[4] = {__uint_as_float(ga.x << 16), __uint_as_float(ga.x & 0xFFFF0000u), __uint_as_float(ga.y << 16), __uint_as_float(ga.y & 0xFFFF0000u)};
      const float lg_[4] = {lg.x, lg.y, lg.z, lg.w}, lb_[4] = {lb.x, lb.y, lb.z, lb.w};
      float o[4];
#pragma unroll
      for (int u = 0; u < 4; ++u) o[u] = ((acc[mt][4 * g + u] - mean) * rstd * lg_[u] + lb_[u] + bo_[u]) * ga_[u];
      uint2 ov; ov.x = pack2(o[0], o[1]); ov.y = pack2(o[2], o[3]);
      *(uint2*)(zrow + v0) = ov;
    }
}

__device__ __forceinline__ void attn_prompt(const Params& p, int l, int item, u16* lds, bool dry = false) {
  const int tid = opq(threadIdx.x), lane = tid & 63, wave = tid >> 6;
  const int r = lane & 31, h = lane >> 5;
  const int kvh = item & 1, n = (item >> 1) & 63, b = item >> 7;
  u16* z = (u16*)(p.ws + WS_Z);
  u16* Ks = lds;
  u16* Vt = lds + 256 * 72;
  __syncthreads();
  {
    const int key = tid >> 1, half = tid & 1;
    const int t = (n - 1) * 128 + key;
    uint4 kv[4], vv[4];
    if (t >= 0) {
      const u16* kp = z + (size_t)(b * 8192 + t) * ZLD + 2304 + kvh * 64 + half * 32;
      const u16* vp = z + (size_t)(b * 8192 + t) * ZLD + 2432 + kvh * 64 + half * 32;
#pragma unroll
      for (int i = 0; i < 4; ++i) { kv[i] = *(const uint4*)(kp + i * 8); vv[i] = *(const uint4*)(vp + i * 8); }
    } else {
#pragma unroll
      for (int i = 0; i < 4; ++i) { kv[i] = make_uint4(0, 0, 0, 0); vv[i] = make_uint4(0, 0, 0, 0); }
    }
#pragma unroll
    for (int i = 0; i < 4; ++i) {
      *(uint4*)(Ks + key * 72 + half * 32 + i * 8) = kv[i];
      const unsigned w[4] = {vv[i].x, vv[i].y, vv[i].z, vv[i].w};
#pragma unroll
      for (int q = 0; q < 4; ++q) {
        const int d = half * 32 + i * 8 + q * 2;
        Vt[d * 264 + key] = (u16)(w[q] & 0xFFFFu);
        Vt[(d + 1) * 264 + key] = (u16)(w[q] >> 16);
      }
    }
  }
  __syncthreads();
#pragma unroll 1
  for (int uu = 0; uu < 2; ++uu) {
    const int u = wave * 2 + uu;
    const int hq = kvh * 4 + (u >> 2), qg = u & 3;
    const int qrow = b * 8192 + n * 128 + qg * 32 + r;
    u16* qp = z + (size_t)qrow * ZLD + 1792 + hq * 64;
    bf16x8 qf[4];
#pragma unroll
    for (int s = 0; s < 4; ++s) qf[s] = *(const bf16x8*)(qp + s * 16 + h * 8);
    f32x16 sc[5];
#pragma unroll
    for (int i5 = 0; i5 < 5; ++i5) {
#pragma unroll
      for (int i = 0; i < 16; ++i) sc[i5][i] = 0.f;
      const int kt = qg + i5;
#pragma unroll
      for (int s = 0; s < 4; ++s) {
        bf16x8 kf = *(const bf16x8*)(Ks + (kt * 32 + r) * 72 + s * 16 + h * 8);
        sc[i5] = __builtin_amdgcn_mfma_f32_32x32x16_bf16(kf, qf[s], sc[i5], 0, 0, 0);
      }
      __builtin_amdgcn_sched_barrier(0);
    }
    const int qi = qg * 32 + r;
    const float sink = p.in[20][l * 8 + hq];
    float mx = -1e30f;
#pragma unroll
    for (int i5 = 0; i5 < 5; ++i5)
#pragma unroll
      for (int reg = 0; reg < 16; ++reg) {
        const int j = (qg + i5) * 32 + ROWOFF(reg, h);
        const bool ok = (j > qi) && (j <= qi + 128) && (n > 0 || j >= 128);
        const float s = ok ? sc[i5][reg] * 0.125f : -1e30f;
        sc[i5][reg] = s;
        mx = fmaxf(mx, s);
      }
    mx = fmaxf(mx, __shfl_xor(mx, 32, 64));
    mx = fmaxf(mx, sink);
    float sum = 0.f;
#pragma unroll
    for (int i5 = 0; i5 < 5; ++i5)
#pragma unroll
      for (int reg = 0; reg < 16; ++reg) { const float e = __expf(sc[i5][reg] - mx); sc[i5][reg] = e; sum += e; }
    sum += __shfl_xor(sum, 32, 64);
    const float rden = 1.f / (sum + __expf(sink - mx));
    f32x16 oacc[2];
#pragma unroll
    for (int i = 0; i < 16; ++i) { oacc[0][i] = 0.f; oacc[1][i] = 0.f; }
#pragma unroll
    for (int i5 = 0; i5 < 5; ++i5) {
      const int kt = qg + i5;
#pragma unroll
      for (int s2 = 0; s2 < 2; ++s2) {
        bf16x8 pf;
#pragma unroll
        for (int j = 0; j < 8; ++j) pf[j] = (short)f2bf(sc[i5][s2 * 8 + j] * rden);
#pragma unroll
        for (int dt = 0; dt < 2; ++dt) {
          const u16* vp = Vt + (dt * 32 + r) * 264 + kt * 32 + s2 * 16 + h * 4;
          const uint2 lo = *(const uint2*)vp, hi = *(const uint2*)(vp + 8);
          union { uint4 u; bf16x8 v; } cv;
          cv.u = make_uint4(lo.x, lo.y, hi.x, hi.y);
          oacc[dt] = __builtin_amdgcn_mfma_f32_32x32x16_bf16(cv.v, pf, oacc[dt], 0, 0, 0);
        }
        __builtin_amdgcn_sched_barrier(0);
      }
    }
#pragma unroll
    for (int dt = 0; dt < 2; ++dt)
#pragma unroll
      for (int g4 = 0; g4 < 4; ++g4) {
        const int d = dt * 32 + 8 * g4 + 4 * h;
        uint2 o;
        o.x = pack2(oacc[dt][g4 * 4 + 0], oacc[dt][g4 * 4 + 1]);
        o.y = pack2(oacc[dt][g4 * 4 + 2], oacc[dt][g4 * 4 + 3]);
        if (!dry) *(uint2*)(qp + d) = o;
      }
  }
}

__device__ __forceinline__ void attn_sample(const Params& p, int l, int item, float* ldsf, bool dry = false) {
  const int tid = opq(threadIdx.x);
  const int kvh = item & 1, b = item >> 1;
  u16* z = (u16*)(p.ws + WS_Z);
  float* Kl = ldsf;
  float* Vl = ldsf + 132 * 65;
  float* Ql = Vl + 132 * 65;
  float* Pl = Ql + 16 * 64;
  __syncthreads();
  for (int e = tid; e < 132 * 8; e += NT) {
    const int j = e >> 3, c = (e & 7) * 8;
    float k[8], v[8];
    if (j < 128) {
      const float* kp = p.in[4] + ((size_t)((l * 128 + b) * 128 + j) * 2 + kvh) * 64 + c;
      const float* vp = p.in[5] + ((size_t)((l * 128 + b) * 128 + j) * 2 + kvh) * 64 + c;
      float4 a = *(const float4*)kp, a2 = *(const float4*)(kp + 4);
      float4 c1 = *(const float4*)vp, c2 = *(const float4*)(vp + 4);
      k[0] = a.x; k[1] = a.y; k[2] = a.z; k[3] = a.w; k[4] = a2.x; k[5] = a2.y; k[6] = a2.z; k[7] = a2.w;
      v[0] = c1.x; v[1] = c1.y; v[2] = c1.z; v[3] = c1.w; v[4] = c2.x; v[5] = c2.y; v[6] = c2.z; v[7] = c2.w;
    } else {
      const size_t row = M_P + b * 4 + (j - 128);
      unpack8(*(const uint4*)(z + row * ZLD + 2304 + kvh * 64 + c), k);
      unpack8(*(const uint4*)(z + row * ZLD + 2432 + kvh * 64 + c), v);
    }
#pragma unroll
    for (int i = 0; i < 8; ++i) { Kl[j * 65 + c + i] = k[i]; Vl[j * 65 + c + i] = v[i]; }
    if (j >= 4) {
      float* ok = p.out + O_SK + ((size_t)((l * 128 + b) * 128 + (j - 4)) * 2 + kvh) * 64 + c;
      float* ov = p.out + O_SV + ((size_t)((l * 128 + b) * 128 + (j - 4)) * 2 + kvh) * 64 + c;
      *(float4*)ok = make_float4(k[0], k[1], k[2], k[3]); *(float4*)(ok + 4) = make_float4(k[4], k[5], k[6], k[7]);
      *(float4*)ov = make_float4(v[0], v[1], v[2], v[3]); *(float4*)(ov + 4) = make_float4(v[4], v[5], v[6], v[7]);
    }
  }
  if (tid < 128) {
    const int row = tid >> 3, c = (tid & 7) * 8;
    const int hl = row >> 2, t = row & 3;
    float q[8];
    unpack8(*(const uint4*)(z + (size_t)(M_P + b * 4 + t) * ZLD + 1792 + (kvh * 4 + hl) * 64 + c), q);
#pragma unroll
    for (int i = 0; i < 8; ++i) Ql[row * 64 + c + i] = q[i];
  }
  __syncthreads();
  const int row = tid >> 5, jl = tid & 31;
  const int t = row & 3, hq = kvh * 4 + (row >> 2);
  float sc[5];
  float mx = -1e30f;
#pragma unroll
  for (int jj = 0; jj < 5; ++jj) {
    const int j = jl + 32 * jj;
    float s = -1e30f;
    if (j < 132 && j > t && j <= t + 128) {
      float a = 0.f;
#pragma unroll 8
      for (int d = 0; d < 64; ++d) a += Ql[row * 64 + d] * Kl[j * 65 + d];
      s = a * 0.125f;
    }
    sc[jj] = s; mx = fmaxf(mx, s);
    __builtin_amdgcn_sched_barrier(0);
  }
#pragma unroll
  for (int o = 16; o >= 1; o >>= 1) mx = fmaxf(mx, __shfl_xor(mx, o, 64));
  const float sink = p.in[20][l * 8 + hq];
  mx = fmaxf(mx, sink);
  float sum = 0.f;
#pragma unroll
  for (int jj = 0; jj < 5; ++jj) { sc[jj] = __expf(sc[jj] - mx); sum += sc[jj]; }
#pragma unroll
  for (int o = 16; o >= 1; o >>= 1) sum += __shfl_xor(sum, o, 64);
  const float rden = 1.f / (sum + __expf(sink - mx));
#pragma unroll
  for (int jj = 0; jj < 5; ++jj) { const int j = jl + 32 * jj; if (j < 136) Pl[row * 136 + j] = sc[jj] * rden; }
  __syncthreads();
  {
    const int d = jl * 2;
    float o0 = 0.f, o1 = 0.f;
#pragma unroll 4
    for (int j = 0; j < 132; ++j) { const float pr = Pl[row * 136 + j]; o0 += pr * Vl[j * 65 + d]; o1 += pr * Vl[j * 65 + d + 1]; }
    if (!dry) *(unsigned*)(z + (size_t)(M_P + b * 4 + t) * ZLD + 1792 + hq * 64 + d) = pack2(o0, o1);
  }
}

__device__ __forceinline__ void phase_convgelu(const Params& p, int l, bool dry = false) {
  u16* cu = (u16*)(p.ws + WS_CU);
  const float* cw = p.in[26] + (size_t)l * 3 * 2816;
  const float* cb = p.in[27] + (size_t)l * 2816;
  for (int it = blockIdx.x; it < 1056; it += gridDim.x) {
    const int tid = opq(threadIdx.x);
    if (tid >= 352) continue;
    const int j0 = tid * 8;
    float w0[8], w1[8], w2[8], bb[8];
#pragma unroll
    for (int i = 0; i < 8; ++i) { w0[i] = cw[j0 + i]; w1[i] = cw[2816 + j0 + i]; w2[i] = cw[5632 + j0 + i]; bb[i] = cb[j0 + i]; }
    float c1[8], c2[8];
    for (int rr = 0; rr < 16; ++rr) {
      const int row = it * 16 + rr;
      const bool prompt = row < M_P;
      int b, t;
      if (prompt) { b = row >> 13; t = row & 8191; } else { b = (row - M_P) >> 2; t = (row - M_P) & 3; }
      if (t == 0) {
        if (prompt) {
#pragma unroll
          for (int i = 0; i < 8; ++i) { c1[i] = 0.f; c2[i] = 0.f; }
        } else {
          const float* st = p.in[6] + (size_t)((l * 128 + b) * 2) * 2816 + j0;
#pragma unroll
          for (int i = 0; i < 8; ++i) { c2[i] = st[i]; c1[i] = st[2816 + i]; }
        }
      } else if (rr == 0) {
        unpack8(*(const uint4*)(cu + (size_t)(row - 1) * 5632 + j0), c1);
        if (t >= 2) unpack8(*(const uint4*)(cu + (size_t)(row - 2) * 5632 + j0), c2);
        else {
#pragma unroll
          for (int i = 0; i < 8; ++i) c2[i] = 0.f;
        }
      }
      float c0[8], up[8], a[8];
      unpack8(*(const uint4*)(cu + (size_t)row * 5632 + j0), c0);
      unpack8(*(const uint4*)(cu + (size_t)row * 5632 + 2816 + j0), up);
#pragma unroll
      for (int i = 0; i < 8; ++i) {
        const float cv = bb[i] + w0[i] * c2[i] + w1[i] * c1[i] + w2[i] * c0[i];
        a[i] = gelu_fast(cv) * up[i];
      }
      if (!dry) *(uint4*)(cu + (size_t)row * 5632 + 2816 + j0) = pack8(a);
      if (prompt && t >= 8190) {
        float* o = p.out + O_PCONV + (size_t)((l * 2 + b) * 2 + (t - 8190)) * 2816 + j0;
        *(float4*)o = make_float4(c0[0], c0[1], c0[2], c0[3]); *(float4*)(o + 4) = make_float4(c0[4], c0[5], c0[6], c0[7]);
      } else if (!prompt && t >= 2) {
        float* o = p.out + O_SCONV + (size_t)((l * 128 + b) * 2 + (t - 2)) * 2816 + j0;
        *(float4*)o = make_float4(c0[0], c0[1], c0[2], c0[3]); *(float4*)(o + 4) = make_float4(c0[4], c0[5], c0[6], c0[7]);
      }
#pragma unroll
      for (int i = 0; i < 8; ++i) { c2[i] = c1[i]; c1[i] = c0[i]; }
    }
  }
}

__device__ __forceinline__ void phase_final(const Params& p) {
  float* X = p.out;
  const float* g = p.in[29];
  for (int it = blockIdx.x; it < 2112; it += gridDim.x) {
    const int tid = opq(threadIdx.x);
    const int lane = tid & 63;
    const int row = it * 8 + (tid >> 6);
    float4 v[4];
    float ss = 0.f;
#pragma unroll
    for (int i = 0; i < 4; ++i) {
      v[i] = *(const float4*)(X + (size_t)row * 1024 + i * 256 + lane * 4);
      if (gridDim.x == 256 && row >= M_P) {
        const u16* partb = (const u16*)(p.ws + WS_DP) + (size_t)(row - M_P) * 1024 + i * 256 + lane * 4;
        for (int k = 0; k < 11; ++k) { const uint2 q = *(const uint2*)(partb + (size_t)k * 512 * 1024);
          v[i].x += __uint_as_float(q.x << 16); v[i].y += __uint_as_float(q.x & 0xFFFF0000u); v[i].z += __uint_as_float(q.y << 16); v[i].w += __uint_as_float(q.y & 0xFFFF0000u); }
      }
      ss += v[i].x * v[i].x + v[i].y * v[i].y + v[i].z * v[i].z + v[i].w * v[i].w;
    }
    ss = wave_sum(ss);
    const float rs = rsqrtf(ss * (1.f / 1024.f) + 1e-6f);
#pragma unroll
    for (int i = 0; i < 4; ++i) {
      const float4 gg = *(const float4*)(g + i * 256 + lane * 4);
      *(float4*)(X + (size_t)row * 1024 + i * 256 + lane * 4) =
          make_float4(v[i].x * rs * gg.x, v[i].y * rs * gg.y, v[i].z * rs * gg.z, v[i].w * rs * gg.w);
    }
  }
}

#define XB_TMO      128
#define XB_XCNT(j)  (256  + 64 * (j))
#define XB_XSUB(j)  (1280 + 64 * (j))
#define XB_XGEN(j)  (2304 + 64 * (j))
#define XB_TOP      3328
#define XB_TOPGEN   3392
#define XCD_BAR_WORDS 3456
#define XB_SPIN_CAP (1u << 18)
#define LAS __attribute__((address_space(3)))

__device__ __forceinline__ unsigned xb_ld(unsigned* p)              { return __hip_atomic_load(p, __ATOMIC_RELAXED, __HIP_MEMORY_SCOPE_AGENT); }
__device__ __forceinline__ unsigned xb_add(unsigned* p, unsigned v) { return __hip_atomic_fetch_add(p, v, __ATOMIC_RELAXED, __HIP_MEMORY_SCOPE_AGENT); }
__device__ __forceinline__ unsigned xb_xcc_id() { return (unsigned)__builtin_amdgcn_s_getreg((3 << 11) | 20) & 0xFu; }
#define XB_SPIN(cond, bar) do { unsigned _sp = 0; while (cond) { __builtin_amdgcn_s_sleep(1); \
    if ((++_sp & 255u) == 0u) { if (xb_ld(&(bar)[XB_TMO])) break; if (_sp > XB_SPIN_CAP) { atomicAdd(&(bar)[XB_TMO], 1u); break; } } } } while (0)

struct XcdBarrier {
    unsigned* bar; unsigned x;
    volatile LAS unsigned* st;
};

__device__ __forceinline__ XcdBarrier xcd_barrier_post(unsigned* bar, volatile LAS unsigned* st) {
    XcdBarrier b; b.bar = bar; b.x = xb_xcc_id(); b.st = st;
    if (threadIdx.x == 0) (void)xb_add(&bar[XB_XCNT(b.x)], 1u);
    return b;
}
__device__ __forceinline__ void xcd_barrier_complete(unsigned* bar, unsigned x, unsigned& nloc, unsigned& nx) {
    const unsigned G = gridDim.x * gridDim.y * gridDim.z;
    unsigned sum, cnt, mine, sp = 0u;
    for (;;) {
        sum = 0u; cnt = 0u; mine = 0u;
#pragma unroll
        for (unsigned j = 0; j < 16; ++j) { const unsigned c = xb_ld(&bar[XB_XCNT(j)]); sum += c; cnt += (c > 0u) ? 1u : 0u; mine = (j == x) ? c : mine; }
        if (sum == G) break;
        __builtin_amdgcn_s_sleep(1);
        if ((++sp & 255u) == 0u) { if (xb_ld(&bar[XB_TMO])) break; if (sp > XB_SPIN_CAP) { atomicAdd(&bar[XB_TMO], 1u); break; } }
    }
    nloc = mine > 0u ? mine : 1u; nx = cnt > 0u ? cnt : 1u;
}

__device__ __forceinline__ void xcd_barrier(const XcdBarrier& b) {
    asm volatile("s_waitcnt vmcnt(0)" ::: "memory");
    __syncthreads();
    if (threadIdx.x == 0) {
        unsigned* bar = b.bar;
        __builtin_amdgcn_s_waitcnt(0);
        unsigned nloc = b.st[0], nx = b.st[1];
        if (nloc == 0u) { xcd_barrier_complete(bar, b.x, nloc, nx); b.st[0] = nloc; b.st[1] = nx; }
        const unsigned old = xb_add(&bar[XB_XSUB(b.x)], 1u);
        const unsigned gen = old / nloc;
        if (old + 1u == (gen + 1u) * nloc) {
            __builtin_amdgcn_fence(__ATOMIC_RELEASE, "agent");
            asm volatile("s_waitcnt vmcnt(0)" ::: "memory");
            const unsigned og = xb_add(&bar[XB_TOP], 1u);
            const unsigned tg = og / nx;
            if (og + 1u == (tg + 1u) * nx) xb_add(&bar[XB_TOPGEN], 1u);
            else XB_SPIN(xb_ld(&bar[XB_TOPGEN]) == tg, bar);
            __builtin_amdgcn_fence(__ATOMIC_ACQUIRE, "agent");
            xb_add(&bar[XB_XGEN(b.x)], 1u);
            asm volatile("s_waitcnt vmcnt(0)" ::: "memory");
        } else {
            XB_SPIN(xb_ld(&bar[XB_XGEN(b.x)]) == gen, bar);
            __builtin_amdgcn_fence(__ATOMIC_ACQUIRE, "agent");
            asm volatile("s_waitcnt vmcnt(0)" ::: "memory");
        }
    }
    __syncthreads();
}

#define WS_BAR 256000000ull
#if COOP
#ifndef SYNC_RPT
#define SYNC_RPT 1
#endif
#define PH_SYNC(idx) do { if ((idx) + 1 < ph_hi && (idx) >= ph_lo) { for (int sr_ = 0; sr_ < SYNC_RPT; ++sr_) xcd_barrier(xb); } } while (0)
#else
#define PH_SYNC(idx) do { } while (0)
#endif
#define PH_ON(idx, bit) (((KMASK >> (bit)) & 1) && ph_lo <= (idx) && (idx) < ph_hi)

__device__ __forceinline__ Params load_params() {
  auto kp0 = __builtin_amdgcn_kernarg_segment_ptr();
  asm volatile("" : "+s"(kp0));
  auto kq = (const __constant__ unsigned long long*)kp0;
  Params p;
#pragma unroll
  for (int i = 0; i < 30; ++i) p.in[i] = (const float*)kq[i];
  p.out = (float*)kq[30];
  p.ws = (unsigned char*)kq[31];
  p.ph_lo = 0; p.ph_hi = 0;
  return p;
}

template <int KMASK, int l>
__device__ __forceinline__ void layer_phases(int ph_lo, int ph_hi, unsigned char* lds_raw, const XcdBarrier& xb) {
  float* ldsf = (float*)lds_raw;
  u16* ldsh = (u16*)lds_raw;
  const int base = l * 12;
  if (PH_ON(base + 0, 0)) { const Params p = load_params(); RPT(0) phase_prep(p, l, 0, ldsf); }
  PH_SYNC(base + 0);
  if (PH_ON(base + 1, 1)) {
    const Params p = load_params();
    EpiInproj E; E.z = (u16*)(p.ws + WS_Z); E.out = p.out; E.l = l;
    RPT(1) run_gemm(lds_raw, (const u16*)(p.ws + WS_H), 1024, (const u16*)(p.ws + WS_WT) + WT_IN, 2560, 1024, E);
  }
  PH_SYNC(base + 1);
  if (PH_ON(base + 2, 2)) {
    const Params p = load_params();
    for (int it = blockIdx.x; it < 264; it += gridDim.x) rope_item(p, l, it, false);
    if (blockIdx.x < 64) rwkv_item(p, l, 2048 + blockIdx.x, ldsf, false);
    {
      const Params p2 = load_params();
      int i0, n;
      if (gridDim.x == 256) { if (blockIdx.x < 64) { i0 = blockIdx.x * 5; n = 5; } else { i0 = 320 + (blockIdx.x - 64) * 9; n = 9; } }
      else { i0 = 0; n = 0; }
      RPT(2) {
        if (gridDim.x == 256) { for (int i = 0; i < n; ++i) rwkv_item2(p2, l, i0 + i, ldsf); }
        else { for (int it = blockIdx.x; it < 2048; it += gridDim.x) rwkv_item2(p2, l, it, ldsf); }
      }
    }
  }
  PH_SYNC(base + 2);
  if (PH_ON(base + 3, 3)) {
    const Params p = load_params();
    if (blockIdx.x < 16) { RPT(3) rwkv_scan(p, l, blockIdx.x, ldsf, DRY(3)); }
    else {
      RPT(15) for (int it = blockIdx.x - 16; it < 512; it += gridDim.x - 16) {
        if (it < 256) attn_prompt(p, l, it, ldsh, DRY(15)); else attn_sample(p, l, it - 256, ldsf, DRY(15));
      }
    }
  }
  PH_SYNC(base + 3);
  if (PH_ON(base + 4, 4)) {
    const Params p = load_params();
    RPT(4) for (int it = blockIdx.x * 4; it < 2048; it += gridDim.x * 4) rwkv_out4(p, l, it, ldsf);
  }
  PH_SYNC(base + 4);
  if (PH_ON(base + 5, 5)) {
    const Params p = load_params();
    EpiStoreBf16 E1; E1.O = (u16*)(p.ws + WS_T1); E1.ldc = 1024;
    RPT(5) run_gemm(lds_raw, (const u16*)(p.ws + WS_Z), ZLD, (const u16*)(p.ws + WS_WT) + WT_BRA, 1024, 512, E1);
    EpiStoreBf16 E2; E2.O = (u16*)(p.ws + WS_T2); E2.ldc = 1024;
    run_gemm(lds_raw, (const u16*)(p.ws + WS_Z) + 1792, ZLD, (const u16*)(p.ws + WS_WT) + WT_BRB, 1024, 512, E2);
  }
  PH_SYNC(base + 5);
  if (PH_ON(base + 6, 6)) {
    const Params p = load_params();
    EpiMerge E; E.t1 = (const u16*)(p.ws + WS_T1); E.t2 = (const u16*)(p.ws + WS_T2); E.mg = (u16*)(p.ws + WS_MG);
    RPT(6) run_gemm(lds_raw, (const u16*)(p.ws + WS_H), 1024, (const u16*)(p.ws + WS_WT) + WT_G, 2048, 1024, E);
  }
  PH_SYNC(base + 6);
  if (PH_ON(base + 7, 7)) {
    const Params p = load_params();
    EpiResid E; E.X = p.out;
    RPT(7) {
      E.dry = DRY(7); E.X = p.out; E.pbf = nullptr;
      if (gridDim.x == 256) {
        E.atomic = false; E.rowoff = 0;
        run_gemm_ex(lds_raw, (const u16*)(p.ws + WS_MG), 1024, (const u16*)(p.ws + WS_WT) + WT_OUT, 1024, M_P, 1024, 1024, 256, (int)blockIdx.x, E);
        const int ks = blockIdx.x >> 3;
        E.atomic = true; E.rowoff = 0; E.X = (float*)(p.ws + WS_T1) + (size_t)ks * 512 * 1024;
        run_gemm_ex(lds_raw, (const u16*)(p.ws + WS_MG) + (size_t)M_P * 1024 + ks * 256, 1024, (const u16*)(p.ws + WS_WT) + WT_OUT + ks * 256, 1024,
                    512, 1024, 256, 8, (blockIdx.x < 32) ? (int)(blockIdx.x & 7) : -1, E);
      } else {
        E.atomic = false; E.rowoff = 0;
        run_gemm(lds_raw, (const u16*)(p.ws + WS_MG), 1024, (const u16*)(p.ws + WS_WT) + WT_OUT, 1024, 1024, E);
      }
    }
  }
  PH_SYNC(base + 7);
  if (PH_ON(base + 8, 8)) { const Params p = load_params(); RPT(8) phase_prep(p, l, 1, ldsf); }
  PH_SYNC(base + 8);
  if (PH_ON(base + 9, 9)) {
    const Params p = load_params();
    EpiFfnIn E; E.cu = (u16*)(p.ws + WS_CU);
    RPT(9) run_gemm(lds_raw, (const u16*)(p.ws + WS_H), 1024, (const u16*)(p.ws + WS_WTF) + WT_FIN, 5632, 1024, E);
  }
  PH_SYNC(base + 9);
  if (PH_ON(base + 10, 10)) { const Params p = load_params(); RPT(10) phase_convgelu(p, l, DRY(10)); }
  PH_SYNC(base + 10);
  if (PH_ON(base + 11, 11)) {
    const Params p = load_params();
    EpiResid E; E.X = p.out;
    RPT(11) {
      E.dry = DRY(11); E.X = p.out; E.pbf = nullptr;
      const u16* Aa = (const u16*)(p.ws + WS_CU) + 2816;
      const u16* Bd = (const u16*)(p.ws + WS_WTF) + WT_FDN;
      if (gridDim.x == 256) {
        E.atomic = false; E.rowoff = 0;
        run_gemm_ex(lds_raw, Aa, 5632, Bd, 2816, M_P, 1024, 2816, 256, (int)blockIdx.x, E);
        const int ks = blockIdx.x >> 3;
        E.atomic = true; E.rowoff = 0; E.X = nullptr; E.pbf = (u16*)(p.ws + WS_DP) + (size_t)ks * 512 * 1024;
        run_gemm_ex(lds_raw, Aa + (size_t)M_P * 5632 + ks * 256, 5632, Bd + ks * 256, 2816, 512, 1024, 256, 8, (blockIdx.x < 88) ? (int)(blockIdx.x & 7) : -1, E);
      } else {
        E.atomic = false; E.rowoff = 0;
        run_gemm(lds_raw, Aa, 5632, Bd, 1024, 2816, E);
      }
    }
  }
  PH_SYNC(base + 11);
}

template <int KMASK>
__global__ void __launch_bounds__(NT) fwd_kernel(Params pin) {
  extern __shared__ __attribute__((aligned(16))) unsigned char lds_raw[];
  const int ph_lo = pin.ph_lo, ph_hi = pin.ph_hi;
  XcdBarrier xb;
  {
    volatile LAS unsigned* st = (volatile LAS unsigned*)(lds_raw + (LDS_BYTES - 16));
    if (threadIdx.x < 2) st[threadIdx.x] = 0u;
    __syncthreads();
    xb = xcd_barrier_post((unsigned*)(pin.ws + WS_BAR), st);
  }
  if (ph_hi > 100000) cg::this_grid().sync();
  layer_phases<KMASK, 0>(ph_lo, ph_hi, lds_raw, xb);
  layer_phases<KMASK, 1>(ph_lo, ph_hi, lds_raw, xb);
  if (PH_ON(NPH - 1, 12)) { const Params p = load_params(); phase_final(p); }
}

extern "C" void kernel_launch(void* const* d_in, const int* in_sizes, int n_in, void* d_out, int out_size, void* d_ws,
                              size_t ws_size, hipStream_t stream) {
  static int grid = 0;
  if (grid == 0) {
    int dev = 0, cus = 0;
    (void)hipGetDevice(&dev);
    (void)hipDeviceGetAttribute(&cus, hipDeviceAttributeMultiprocessorCount, dev);
    grid = cus > 0 ? cus : 256;
    (void)hipFuncSetAttribute((const void*)fwd_kernel<PHMASK>, hipFuncAttributeMaxDynamicSharedMemorySize, LDS_BYTES);
    (void)hipGetLastError();
  }
  Params p{};
  for (int i = 0; i < 30; ++i) p.in[i] = (const float*)d_in[i];
  p.out = (float*)d_out;
  p.ws = (unsigned char*)d_ws;
#if COOP
  (void)hipMemsetAsync((unsigned char*)d_ws + WS_BAR, 0, XCD_BAR_WORDS * 4, stream);
  p.ph_lo = 0; p.ph_hi = NPH;
  void* args[] = {&p};
  hipError_t e = hipLaunchCooperativeKernel((const void*)fwd_kernel<PHMASK>, dim3(grid), dim3(NT), args, LDS_BYTES, stream);
  if (e != hipSuccess) fprintf(stderr, "cooperative launch failed: %s (grid %d)\n", hipGetErrorString(e), grid);
#else
  for (int ph = 0; ph < NPH; ++ph) {
    p.ph_lo = ph; p.ph_hi = ph + 1;
    hipLaunchKernelGGL(fwd_kernel<PHMASK>, dim3(grid), dim3(NT), LDS_BYTES, stream, p);
  }
#endif
}
```

```cpp
#include <hip/hip_runtime.h>
#include <hip/hip_bf16.h>
#include <hip/hip_cooperative_groups.h>
#include <cstdio>
namespace cg = cooperative_groups;

typedef __attribute__((ext_vector_type(8))) short bf16x8;
typedef __attribute__((ext_vector_type(16))) float f32x16;
typedef unsigned short u16;

#ifndef PHMASK
#define PHMASK 0x1FFF
#endif
#ifndef T3
#define T3 7
#endif
#ifndef P2SEL
#define P2SEL 7
#endif
#ifndef RPT_MASK
#define RPT_MASK 0
#endif
#ifndef RPT_N
#define RPT_N 1
#endif
#define RPT(bit) for (int rp_ = 0; rp_ < (((RPT_MASK >> (bit)) & 1) ? 1 + RPT_N : 1); ++rp_)
#define RPT_CNT(bit) (((RPT_MASK >> (bit)) & 1) ? 1 + RPT_N : 1)
#define DRY(bit) (opq(rp_) + 1 < RPT_CNT(bit))
#ifndef R1P
#define R1P 1
#endif
#ifndef COOP
#define COOP 1
#endif

#define NT 512
#define M_TOT 16896
#define M_P 16384
#define ZLD 2560
#define NPH 25

#define WS_WT   0ull
#define WS_H    13631488ull
#define WS_Z    48234496ull
#define WS_R    134742016ull
#define WS_PP   (WS_R)
#define WS_GC   (WS_R + 16777216ull)
#define WS_Q    (WS_R + 17301504ull)
#define WS_W2   (WS_R + 50855936ull)
#define WS_YL   (WS_R + 67633152ull)
#define WS_BO   (WS_R + 84410368ull)
#define WS_GA   (WS_R + 101187584ull)
#define WS_T1   (WS_R)
#define WS_T2   (WS_R + 34603008ull)
#define WS_MG   (WS_R + 69206016ull)
#define WS_WTF  (WS_Z)
#define WS_CU   (WS_Z + 17301504ull)
#define WS_LW  267634432ull
#define WS_DP  256100096ull
#define WT_IN  0
#define WT_G   2621440
#define WT_BRA 4718592
#define WT_BRB 5242880
#define WT_OUT 5767168
#define WT_FIN 0
#define WT_FDN 5767168
#define O_PSHIFT 17301504
#define O_PWKV   17308672
#define O_PK     17439744
#define O_PV     17505280
#define O_PCONV  17570816
#define O_SSHIFT 17593344
#define O_SWKV   18052096
#define O_SK     26440704
#define O_SV     30635008
#define O_SCONV  34829312

#define LDS_BYTES 151552

struct Params {
  const float* in[30];
  float* out;
  unsigned char* ws;
  int ph_lo, ph_hi;
};

typedef float f2v_ __attribute__((ext_vector_type(2)));
typedef __bf16 b2v_ __attribute__((ext_vector_type(2)));
__device__ __forceinline__ unsigned pack2(float a, float b) { f2v_ v = {a, b}; b2v_ r = __builtin_convertvector(v, b2v_); return __builtin_bit_cast(unsigned, r); }
__device__ __forceinline__ u16 f2bf(float f) { return (u16)(pack2(f, f) & 0xFFFFu); }
__device__ __forceinline__ float bf2f(u16 h) { return __uint_as_float(((unsigned)h) << 16); }
__device__ __forceinline__ float sigm(float x) { return __builtin_amdgcn_rcpf(1.f + __expf(-x)); }
__device__ __forceinline__ void unpack8(uint4 u, float* o) {
  o[0] = __uint_as_float(u.x << 16); o[1] = __uint_as_float(u.x & 0xFFFF0000u);
  o[2] = __uint_as_float(u.y << 16); o[3] = __uint_as_float(u.y & 0xFFFF0000u);
  o[4] = __uint_as_float(u.z << 16); o[5] = __uint_as_float(u.z & 0xFFFF0000u);
  o[6] = __uint_as_float(u.w << 16); o[7] = __uint_as_float(u.w & 0xFFFF0000u);
}
__device__ __forceinline__ uint4 pack8(const float* f) {
  uint4 u; u.x = pack2(f[0], f[1]); u.y = pack2(f[2], f[3]); u.z = pack2(f[4], f[5]); u.w = pack2(f[6], f[7]); return u;
}
__device__ __forceinline__ float gelu_fast(float v) {
  const float av = fabsf(v), d = av * 0.2316418882f + 1.0f;
  const float t = __builtin_amdgcn_rcpf(d);
  float q = t * 0.5307027145f + (-0.7265760135f); q = q * t + 0.7107068705f; q = q * t + (-0.142248368f); q = q * t + 0.127414796f; q = q * t;
  const float e = __builtin_amdgcn_exp2f((v * v) * (-0.72134752044f));
  const float m = v * (q * e);
  return v < 0.f ? m : v - m;
}
__device__ __forceinline__ int opq(int x) { asm volatile("" : "+v"(x)); return x; }
__device__ __forceinline__ float wave_sum(float x) {
#pragma unroll
  for (int o = 32; o >= 1; o >>= 1) x += __shfl_xor(x, o, 64);
  return x;
}

namespace pg8 {
#define PG8_LAS __attribute__((address_space(3)))
typedef unsigned short bf16_t;
typedef short bf16x8 __attribute__((ext_vector_type(8)));
typedef float f32x4 __attribute__((ext_vector_type(4)));
typedef unsigned u32x4 __attribute__((ext_vector_type(4)));
constexpr int BM = 256, BK = 64, HALF = 128, HTB = HALF * BK * 2  , STAGE_BYTES = 8 * HTB, NXCD = 8, WGM = 8;
__host__ __device__ __forceinline__ int lds_byte(int r, int c) { const int st = (r >> 4) * 2 + (c >> 5), rr = r & 15, cc = c & 31, ob = rr * 64 + cc * 2; return st * 1024 + (ob ^ (((ob >> 9) & 1) << 5)); }
__host__ __device__ __forceinline__ void stage_rc(int b, int& R, int& C) { const int st = b / 1024, sb = b % 1024, swz = sb ^ (((sb >> 9) & 1) << 5); R = (st >> 1) * 16 + swz / 64; C = (st & 1) * 32 + (swz % 64) / 2; }
__host__ __device__ __forceinline__ int perm32(int rho) { const int n = rho >> 4, i = rho & 15; return 8 * (i >> 2) + 4 * n + (i & 3); }
struct Unit { int pm, pn; };
struct Gemm { const bf16_t* A; const bf16_t* Bt; int M, N, K, lda, ldb; };
struct StaticOrder {
    int nM, nN, nwg, G, c;
    __host__ __device__ void init(int M, int N, int G_, int c_) { nM = M / BM; nN = N / BM; nwg = nM * nN; G = G_; c = c_; }
    __host__ __device__ bool next(int i, Unit& u) const {
        const long L = (long)i * G + c; if (L >= nwg) return false;
        int wgid = (int)L; { const int q = nwg / NXCD, r = nwg % NXCD, xcd = wgid % NXCD, off = wgid / NXCD; wgid = (xcd < r ? xcd * (q + 1) : r * (q + 1) + (xcd - r) * q) + off; }
        const int nig = WGM * nN, gid = wgid / nig, fm = gid * WGM, gsz = (nM - fm) < WGM ? (nM - fm) : WGM;
        u.pm = fm + ((wgid % nig) % gsz); u.pn = (wgid % nig) / gsz; return true;
    }
    __device__ __forceinline__ void a_ready(const Unit&) const {}
    __device__ __forceinline__ void done(const Unit&) const {}
};
__device__ __forceinline__ unsigned cvt_pk_bf16(float lo, float hi) { return ::pack2(lo, hi); }
template <class Epi, class Sched, bool STAMP = false>
__device__ __forceinline__ void gemm_phase(PG8_LAS unsigned char* lds, const Gemm g, const Sched& S, const Epi& E, unsigned long long* stamps) {
    const int tid = ::opq(threadIdx.x), wid = __builtin_amdgcn_readfirstlane(tid >> 6), lane = tid & 63, wr = wid >> 2, wc = wid & 3, fr = lane & 15, fq = lane >> 4;
    const int K = g.K, nt = K / BK;
    int ts_lo = 0, ts_hi = 0, nts = 0; const unsigned long long rt_entry = 0ull;
#define PG8_STAMP() do { if (STAMP && wid == 0 && nts < 64) { const unsigned long long _c = (unsigned long long)clock64(); \
        ts_lo = (lane == nts) ? (int)(unsigned)_c : ts_lo; ts_hi = (lane == nts) ? (int)(unsigned)(_c >> 32) : ts_hi; ++nts; } } while (0)
    PG8_STAMP();
    unsigned voffA[2], voffB[2];
#pragma unroll
    for (int i = 0; i < 2; ++i) { int R, C; stage_rc(tid * 16 + i * 8192, R, C); const int Rb = Epi::PERM ? ((R & ~31) + perm32(R & 31)) : R;
        voffA[i] = (unsigned)(R * g.lda + C) * 2u; voffB[i] = (unsigned)(Rb * g.ldb + C) * 2u; }
    const size_t kstep = (size_t)(BK * 2);
    const size_t hstep = (size_t)HALF * g.ldb * 2;
    const size_t tstep = 2 * hstep; const size_t hstepA = (size_t)HALF * g.lda * 2; const size_t tstepA = 2 * hstepA;
    const unsigned ldsw = (unsigned)wid * 1024u;
    const int aoff = lds_byte(wr * 64 + fr, fq * 8), boff = lds_byte(wc * 32 + fr, fq * 8);
#define PG8_SA(b, h) (((b) * 2 + (h)) * HTB)
#define PG8_SB(b, h) ((4 + (b) * 2 + (h)) * HTB)
#define PG8_STAGE(bufoff, gbase, voff) do { _Pragma("unroll") for (int _i = 0; _i < 2; ++_i) \
        __builtin_amdgcn_global_load_lds((const unsigned*)((const char*)(gbase) + (voff)[_i]), (PG8_LAS unsigned*)(lds + (bufoff) + ldsw + _i * 8192), 16, 0, 0); } while (0)
#define PG8_LDA(dst, b, h) do { _Pragma("unroll") for (int m = 0; m < 4; ++m) _Pragma("unroll") for (int k = 0; k < 2; ++k) dst[m][k] = *(const PG8_LAS bf16x8*)(lds + PG8_SA(b, h) + aoff + m * 2048 + k * 1024); } while (0)
#define PG8_LDB(dst, b, h) do { _Pragma("unroll") for (int n = 0; n < 2; ++n) _Pragma("unroll") for (int k = 0; k < 2; ++k) dst[n][k] = *(const PG8_LAS bf16x8*)(lds + PG8_SB(b, h) + boff + n * 2048 + k * 1024); } while (0)
#define PG8_MMA(ai, bj, At, Bt) do { __builtin_amdgcn_s_setprio(1); _Pragma("unroll") for (int m = 0; m < 4; ++m) _Pragma("unroll") for (int n = 0; n < 2; ++n) _Pragma("unroll") for (int k = 0; k < 2; ++k) \
        acc[ai][bj][m][n] = __builtin_amdgcn_mfma_f32_16x16x32_bf16(Bt[n][k], At[m][k], acc[ai][bj][m][n], 0, 0, 0); __builtin_amdgcn_s_setprio(0); } while (0)
#define PG8_WAIT_V(n) asm volatile("s_waitcnt vmcnt(" #n ")" ::: "memory")
#define PG8_WAIT_L(n) asm volatile("s_waitcnt lgkmcnt(" #n ")" ::: "memory")
#define PG8_BAR __builtin_amdgcn_s_barrier()
#define PG8_SCHED __builtin_amdgcn_sched_barrier(0)
    Unit cur, nxt; int ui = 0;
    if (!S.next(0, cur)) return;
    f32x4 acc[2][2][4][2];
#pragma unroll
    for (int a = 0; a < 2; ++a)
#pragma unroll
        for (int b = 0; b < 2; ++b)
#pragma unroll
            for (int m = 0; m < 4; ++m)
#pragma unroll
                for (int n = 0; n < 2; ++n) acc[a][b][m][n] = (f32x4){0.f, 0.f, 0.f, 0.f};
    bf16x8 At[4][2], B0[2][2], B1[2][2];
    const char* cA = (const char*)g.A + (size_t)cur.pm * tstepA; const char* cB = (const char*)g.Bt + (size_t)cur.pn * tstep;
    S.a_ready(cur);
    PG8_STAGE(PG8_SB(0, 0), cB, voffB); PG8_STAGE(PG8_SA(0, 0), cA, voffA); PG8_STAGE(PG8_SB(0, 1), cB + hstep, voffB); PG8_STAGE(PG8_SA(0, 1), cA + hstepA, voffA);
    if (wr == 1) PG8_BAR;
    PG8_WAIT_V(4); PG8_BAR;
    PG8_STAGE(PG8_SB(1, 0), cB + kstep, voffB); PG8_STAGE(PG8_SA(1, 0), cA + kstep, voffA); PG8_STAGE(PG8_SB(1, 1), cB + hstep + kstep, voffB);
    PG8_WAIT_V(6); PG8_BAR;
    PG8_STAMP();
    for (;;) {
        const bool has_next = S.next(ui + 1, nxt);
        const char* nA = has_next ? (const char*)g.A + (size_t)nxt.pm * tstepA : cA; const char* nB = has_next ? (const char*)g.Bt + (size_t)nxt.pn * tstep : cB;
        for (int t = 0; t < nt; t += 2) {
            const bool last = (t == nt - 2);
            const char* a1 = cA + (size_t)(t + 1) * kstep;
            const char* a2 = last ? nA : cA + (size_t)(t + 2) * kstep; const char* b2 = last ? nB : cB + (size_t)(t + 2) * kstep;
            const char* a3 = a2 + kstep; const char* b3 = b2 + kstep;
            if (last && has_next) S.a_ready(nxt);
            PG8_LDB(B0, 0, 0); PG8_SCHED; PG8_LDA(At, 0, 0); PG8_STAGE(PG8_SA(1, 1), a1 + hstepA, voffA);
            PG8_WAIT_L(8); PG8_BAR; PG8_WAIT_L(0); PG8_MMA(0, 0, At, B0); PG8_BAR; PG8_SCHED;
            PG8_LDB(B1, 0, 1); PG8_STAGE(PG8_SB(0, 0), b2, voffB);
            PG8_BAR; PG8_WAIT_L(0); PG8_MMA(0, 1, At, B1); PG8_BAR;
            PG8_LDA(At, 0, 1); PG8_STAGE(PG8_SA(0, 0), a2, voffA);
            PG8_BAR; PG8_WAIT_L(0); PG8_MMA(1, 0, At, B0); PG8_BAR; PG8_SCHED;
            PG8_STAGE(PG8_SB(0, 1), b2 + hstep, voffB);
            PG8_WAIT_V(6); PG8_BAR; PG8_MMA(1, 1, At, B1); PG8_BAR;
            PG8_LDB(B0, 1, 0); PG8_SCHED; PG8_LDA(At, 1, 0); PG8_STAGE(PG8_SA(0, 1), a2 + hstepA, voffA);
            PG8_WAIT_L(8); PG8_BAR; PG8_WAIT_L(0); PG8_MMA(0, 0, At, B0); PG8_BAR; PG8_SCHED;
            PG8_LDB(B1, 1, 1); PG8_STAGE(PG8_SB(1, 0), b3, voffB);
            PG8_BAR; PG8_WAIT_L(0); PG8_MMA(0, 1, At, B1); PG8_BAR;
            PG8_LDA(At, 1, 1); PG8_STAGE(PG8_SA(1, 0), a3, voffA);
            PG8_BAR; PG8_WAIT_L(0); PG8_MMA(1, 0, At, B0); PG8_BAR; PG8_SCHED;
            PG8_STAGE(PG8_SB(1, 1), b3 + hstep, voffB);
            PG8_WAIT_V(6); PG8_BAR; PG8_MMA(1, 1, At, B1); PG8_BAR;
        }
        PG8_STAMP();
        if constexpr (!Epi::AFTER_DRAIN) { E(acc, cur, wr, wc, fr, fq); S.done(cur); }
        PG8_STAMP();
        if (!has_next) break;
#pragma unroll
        for (int a = 0; a < 2; ++a)
#pragma unroll
            for (int b = 0; b < 2; ++b)
#pragma unroll
                for (int m = 0; m < 4; ++m)
#pragma unroll
                    for (int n = 0; n < 2; ++n) acc[a][b][m][n] = (f32x4){0.f, 0.f, 0.f, 0.f};
        cur = nxt; cA = nA; cB = nB; ++ui;
    }
    PG8_WAIT_V(0);
    if (wr == 0) PG8_BAR;
    PG8_BAR;
    if constexpr (Epi::AFTER_DRAIN) { E.fused(acc, cur, wr, wc, fr, fq, lds, wid, lane); S.done(cur); }
    PG8_STAMP();
    if (STAMP && wid == 0) { stamps[lane] = lane < nts ? (((unsigned long long)(unsigned)ts_hi << 32) | (unsigned)ts_lo) : 0ull;
        if (lane == 62) stamps[62] = rt_entry; if (lane == 63) stamps[63] = (unsigned long long)wall_clock64(); }
#undef PG8_STAMP
#undef PG8_SA
#undef PG8_SB
#undef PG8_STAGE
#undef PG8_LDA
#undef PG8_LDB
#undef PG8_MMA
#undef PG8_WAIT_V
#undef PG8_WAIT_L
#undef PG8_BAR
#undef PG8_SCHED
}
}
using pg8::f32x4;
#define ROWOFF(reg, h) (((reg) & 3) + 8 * ((reg) >> 2) + 4 * (h))

__device__ __forceinline__ void conv_tile(const float* __restrict__ src, int K, int N, u16* __restrict__ dst, int k0, int n0, int sn0, float* lds) {
  const int tid = opq(threadIdx.x);
  __syncthreads();
  {
    const int k = tid >> 3, c = (tid & 7) * 8;
    const float* s = src + (size_t)(k0 + k) * N + sn0 + c;
    float4 a = *(const float4*)s, b = *(const float4*)(s + 4);
    float* d = lds + k * 65 + c;
    d[0] = a.x; d[1] = a.y; d[2] = a.z; d[3] = a.w;
    d[4] = b.x; d[5] = b.y; d[6] = b.z; d[7] = b.w;
  }
  __syncthreads();
  {
    const int n = tid >> 3, kk = (tid & 7) * 8;
    float f[8];
#pragma unroll
    for (int i = 0; i < 8; ++i) f[i] = lds[(kk + i) * 65 + n];
    *(uint4*)(dst + (size_t)(n0 + n) * K + k0 + kk) = pack8(f);
  }
}

__device__ __forceinline__ void phase_prep(const Params& p, int l, int which, float* ldsf) {
  u16* WtA = (u16*)(p.ws + WS_WT);
  u16* WtF = (u16*)(p.ws + WS_WTF);
  u16* H = (u16*)(p.ws + WS_H);
  float* X = p.out;
  const int nconv = which == 0 ? (640 + 512 + 128 + 128 + 256) : (1408 + 704);
  const int nlw = which == 0 ? 8 : 0;
  const int ntot = nconv + 2112 + nlw;
  const float* gw = (which == 0 ? p.in[7] : p.in[24]) + l * 1024;
  for (int it = blockIdx.x; it < ntot; it += gridDim.x) {
    if (it < nconv) {
      int t = it;
      if (which == 0) {
        if (t < 640) { const int tk = t / 40, tn = t % 40; conv_tile(p.in[8] + (size_t)l * 1024 * 4608, 1024, 4608, WtA + WT_IN, tk * 64, tn * 64, tn * 64, ldsf); }
        else if ((t -= 640) < 512) {
          const int tk = t / 32, tn = t % 32; const int n0 = tn * 64;
          const int sn0 = 2560 + ((n0 >> 7) & 1) * 1024 + (n0 >> 8) * 128 + (n0 & 127);
          conv_tile(p.in[8] + (size_t)l * 1024 * 4608, 1024, 4608, WtA + WT_G, tk * 64, n0, sn0, ldsf);
        }
        else if ((t -= 512) < 128) { const int tk = t / 16, tn = t % 16; conv_tile(p.in[21] + (size_t)l * 512 * 1024, 512, 1024, WtA + WT_BRA, tk * 64, tn * 64, tn * 64, ldsf); }
        else if ((t -= 128) < 128) { const int tk = t / 16, tn = t % 16; conv_tile(p.in[22] + (size_t)l * 512 * 1024, 512, 1024, WtA + WT_BRB, tk * 64, tn * 64, tn * 64, ldsf); }
        else { t -= 128; const int tk = t / 16, tn = t % 16; conv_tile(p.in[23] + (size_t)l * 1024 * 1024, 1024, 1024, WtA + WT_OUT, tk * 64, tn * 64, tn * 64, ldsf); }
      } else {
        if (t < 1408) {
          const int tk = t / 88, tn = t % 88; const int n0 = tn * 64;
          const int sn0 = ((n0 >> 7) & 1) * 2816 + (n0 >> 8) * 128 + (n0 & 127);
          conv_tile(p.in[25] + (size_t)l * 1024 * 5632, 1024, 5632, WtF + WT_FIN, tk * 64, n0, sn0, ldsf);
        } else { t -= 1408; const int tk = t / 16, tn = t % 16; conv_tile(p.in[28] + (size_t)l * 2816 * 1024, 2816, 1024, WtF + WT_FDN, tk * 64, tn * 64, tn * 64, ldsf); }
      }
    } else if (it >= nconv + 2112) {
      const int tid = opq(threadIdx.x);
      const int hh = it - nconv - 2112;
      u16* dst = (u16*)(p.ws + WS_LW) + (size_t)hh * 17920;
      const float* w2 = p.in[11] + (size_t)l * 64 * 512 + hh * 64;
      const float* a2 = p.in[13] + (size_t)l * 64 * 512 + hh * 64;
      const float* g2 = p.in[14] + (size_t)l * 128 * 512 + hh * 64;
      for (int e = tid; e < 4096; e += NT) {
        const int i = e >> 6, j = e & 63;
        dst[j * 72 + i] = f2bf(w2[(size_t)i * 512 + j]);
        dst[4608 + j * 72 + i] = f2bf(a2[(size_t)i * 512 + j]);
      }
      for (int e = tid; e < 8192; e += NT) {
        const int i = e >> 6, j = e & 63;
        dst[9216 + j * 136 + i] = f2bf(g2[(size_t)i * 512 + j]);
      }
    } else {
      const int tid = opq(threadIdx.x);
      const int row = (it - nconv) * 8 + (tid >> 6);
      const int lane = tid & 63;
      const bool first = (which == 0 && l == 0);
      const float* src;
      if (first) src = (row < M_P) ? p.in[0] + (size_t)row * 1024 : p.in[1] + (size_t)(row - M_P) * 1024;
      else src = X + (size_t)row * 1024;
      float4 v[4];
      float ss = 0.f;
      const int nsl = (gridDim.x == 256 && row >= M_P && !first) ? (which == 1 ? 4 : 11) : 0;
      const float* part = (const float*)(p.ws + WS_T1) + (size_t)(row - M_P) * 1024;
      const u16* partb = (const u16*)(p.ws + WS_DP) + (size_t)(row - M_P) * 1024;
#pragma unroll
      for (int i = 0; i < 4; ++i) {
        v[i] = *(const float4*)(src + i * 256 + lane * 4);
        for (int k = 0; k < nsl; ++k) {
          if (which == 1) {
            const float4 q = *(const float4*)(part + (size_t)k * 512 * 1024 + i * 256 + lane * 4);
            v[i].x += q.x; v[i].y += q.y; v[i].z += q.z; v[i].w += q.w;
          } else {
            const uint2 q = *(const uint2*)(partb + (size_t)k * 512 * 1024 + i * 256 + lane * 4);
            v[i].x += __uint_as_float(q.x << 16); v[i].y += __uint_as_float(q.x & 0xFFFF0000u); v[i].z += __uint_as_float(q.y << 16); v[i].w += __uint_as_float(q.y & 0xFFFF0000u);
          }
        }
        ss += v[i].x * v[i].x + v[i].y * v[i].y + v[i].z * v[i].z + v[i].w * v[i].w;
        if (first || nsl) *(float4*)(X + (size_t)row * 1024 + i * 256 + lane * 4) = v[i];
      }
      ss = wave_sum(ss);
      const float rs = rsqrtf(ss * (1.f / 1024.f) + 1e-6f);
#pragma unroll
      for (int i = 0; i < 4; ++i) {
        const float4 g = *(const float4*)(gw + i * 256 + lane * 4);
        uint2 o; o.x = pack2(v[i].x * rs * g.x, v[i].y * rs * g.y); o.y = pack2(v[i].z * rs * g.z, v[i].w * rs * g.w);
        *(uint2*)(H + (size_t)row * 1024 + i * 256 + lane * 4) = o;
      }
    }
  }
}

struct EpiInproj {
  static constexpr bool PERM = true, AFTER_DRAIN = false;
  u16* z; float* out; int l;
  __device__ __forceinline__ void operator()(const f32x4 (&acc)[2][2][4][2], const pg8::Unit& u, int wr, int wc, int fr, int fq) const {
    const int row0 = u.pm * 256 + wr * 64 + fr, col0 = u.pn * 256 + wc * 32 + 8 * fq;
#pragma unroll
    for (int ai = 0; ai < 2; ++ai)
#pragma unroll
      for (int m = 0; m < 4; ++m) {
        const int row = row0 + ai * 128 + m * 16;
        u16* rowp = z + (size_t)row * ZLD + col0;
#pragma unroll
        for (int bj = 0; bj < 2; ++bj) {
          const f32x4 v0 = acc[ai][bj][m][0], v1 = acc[ai][bj][m][1];
          pg8::u32x4 w; w.x = pg8::cvt_pk_bf16(v0[0], v0[1]); w.y = pg8::cvt_pk_bf16(v0[2], v0[3]); w.z = pg8::cvt_pk_bf16(v1[0], v1[1]); w.w = pg8::cvt_pk_bf16(v1[2], v1[3]);
          *(pg8::u32x4*)(rowp + bj * 128) = w;
        }
        const bool prompt = row < M_P;
        int b, t;
        if (prompt) { b = row >> 13; t = row & 8191; } else { b = (row - M_P) >> 2; t = (row - M_P) & 3; }
        if (u.pn < 7) {
          if ((prompt && t == 8191) || (!prompt && t == 3)) {
            float* o = out + (prompt ? O_PSHIFT + (size_t)(l * 2 + b) * 1792 : O_SSHIFT + (size_t)(l * 128 + b) * 1792) + col0;
#pragma unroll
            for (int bj = 0; bj < 2; ++bj) { *(f32x4*)(o + bj * 128) = acc[ai][bj][m][0]; *(f32x4*)(o + bj * 128 + 4) = acc[ai][bj][m][1]; }
          }
        } else if (u.pn == 9 && prompt && t >= 8064) {
          const int c = wc * 32 + 8 * fq;
          float* o = out + O_PV + ((size_t)((l * 2 + b) * 128 + (t - 8064)) * 2 + (c >> 6)) * 64 + (c & 63);
          *(f32x4*)o = acc[ai][1][m][0]; *(f32x4*)(o + 4) = acc[ai][1][m][1];
        }
      }
  }
};
struct EpiStoreBf16 {
  static constexpr bool PERM = true, AFTER_DRAIN = false;
  u16* O; int ldc; int rowoff;
  __device__ __forceinline__ void operator()(const f32x4 (&acc)[2][2][4][2], const pg8::Unit& u, int wr, int wc, int fr, int fq) const {
    const int row0 = rowoff + u.pm * 256 + wr * 64 + fr, col0 = u.pn * 256 + wc * 32 + 8 * fq;
#pragma unroll
    for (int ai = 0; ai < 2; ++ai)
#pragma unroll
      for (int m = 0; m < 4; ++m) {
        u16* rowp = O + (size_t)(row0 + ai * 128 + m * 16) * ldc + col0;
#pragma unroll
        for (int bj = 0; bj < 2; ++bj) {
          const f32x4 v0 = acc[ai][bj][m][0], v1 = acc[ai][bj][m][1];
          pg8::u32x4 w; w.x = pg8::cvt_pk_bf16(v0[0], v0[1]); w.y = pg8::cvt_pk_bf16(v0[2], v0[3]); w.z = pg8::cvt_pk_bf16(v1[0], v1[1]); w.w = pg8::cvt_pk_bf16(v1[2], v1[3]);
          *(pg8::u32x4*)(rowp + bj * 128) = w;
        }
      }
  }
};
struct EpiFfnIn {
  static constexpr bool PERM = true, AFTER_DRAIN = false;
  u16* cu;
  __device__ __forceinline__ void operator()(const f32x4 (&acc)[2][2][4][2], const pg8::Unit& u, int wr, int wc, int fr, int fq) const {
    const int row0 = u.pm * 256 + wr * 64 + fr, col0 = u.pn * 128 + wc * 32 + 8 * fq;
#pragma unroll
    for (int ai = 0; ai < 2; ++ai)
#pragma unroll
      for (int m = 0; m < 4; ++m) {
        u16* rowp = cu + (size_t)(row0 + ai * 128 + m * 16) * 5632 + col0;
#pragma unroll
        for (int bj = 0; bj < 2; ++bj) {
          const f32x4 v0 = acc[ai][bj][m][0], v1 = acc[ai][bj][m][1];
          pg8::u32x4 w; w.x = pg8::cvt_pk_bf16(v0[0], v0[1]); w.y = pg8::cvt_pk_bf16(v0[2], v0[3]); w.z = pg8::cvt_pk_bf16(v1[0], v1[1]); w.w = pg8::cvt_pk_bf16(v1[2], v1[3]);
          *(pg8::u32x4*)(rowp + bj * 2816) = w;
        }
      }
  }
};
struct EpiMerge {
  static constexpr bool PERM = true, AFTER_DRAIN = false;
  const u16* t1; const u16* t2; u16* mg;
  __device__ __forceinline__ void operator()(const f32x4 (&acc)[2][2][4][2], const pg8::Unit& u, int wr, int wc, int fr, int fq) const {
    const int row0 = u.pm * 256 + wr * 64 + fr, col0 = u.pn * 128 + wc * 32 + 8 * fq;
#pragma unroll
    for (int ai = 0; ai < 2; ++ai)
#pragma unroll
      for (int m = 0; m < 4; ++m) {
        const size_t off = (size_t)(row0 + ai * 128 + m * 16) * 1024 + col0;
        float a[8], b[8], o[8];
        unpack8(*(const uint4*)(t1 + off), a);
        unpack8(*(const uint4*)(t2 + off), b);
#pragma unroll
        for (int n = 0; n < 2; ++n)
#pragma unroll
          for (int j = 0; j < 4; ++j)
            o[n * 4 + j] = sigm(acc[ai][0][m][n][j]) * a[n * 4 + j] + sigm(acc[ai][1][m][n][j]) * b[n * 4 + j];
        *(uint4*)(mg + off) = pack8(o);
        asm volatile("" ::: "memory");
      }
  }
};
struct EpiResid {
  static constexpr bool PERM = false, AFTER_DRAIN = false;
  float* X; bool dry; bool atomic; int rowoff; u16* pbf;
  __device__ __forceinline__ void operator()(const f32x4 (&acc)[2][2][4][2], const pg8::Unit& u, int wr, int wc, int fr, int fq) const {
    const int row0 = rowoff + u.pm * 256 + wr * 64 + fr, col0 = u.pn * 256 + wc * 32 + 4 * fq;
#pragma unroll
    for (int ai = 0; ai < 2; ++ai)
#pragma unroll
      for (int m = 0; m < 4; ++m) {
        float* rowp = X + (size_t)(row0 + ai * 128 + m * 16) * 1024 + col0;
#pragma unroll
        for (int bj = 0; bj < 2; ++bj)
#pragma unroll
          for (int n = 0; n < 2; ++n) {
            f32x4* q = (f32x4*)(rowp + bj * 128 + n * 16);
            if (atomic) {
              if (pbf) {
                uint2 o; o.x = pack2(acc[ai][bj][m][n][0], acc[ai][bj][m][n][1]); o.y = pack2(acc[ai][bj][m][n][2], acc[ai][bj][m][n][3]);
                *(uint2*)(pbf + ((float*)q - X)) = o;
              } else *q = acc[ai][bj][m][n];
            } else { const f32x4 v_ = *q + acc[ai][bj][m][n]; if (!dry) *q = v_; }
          }
        asm volatile("" ::: "memory");
      }
  }
};
template <class Epi>
__device__ __forceinline__ void run_gemm_ex(unsigned char* lds_raw, const u16* A, int lda, const u16* Bt, int ldb, int M, int N, int K, int G, int c, const Epi& E) {
  if (c < 0) return;
  pg8::Gemm g; g.A = A; g.Bt = Bt; g.M = M; g.N = N; g.K = K; g.lda = lda; g.ldb = ldb;
  pg8::StaticOrder S; S.init(M, N, G, c);
  __syncthreads();
  pg8::gemm_phase<Epi, pg8::StaticOrder, false>((PG8_LAS unsigned char*)lds_raw, g, S, E, nullptr);
  __syncthreads();
}
template <class Epi>
__device__ __forceinline__ void run_gemm(unsigned char* lds_raw, const u16* A, int lda, const u16* Bt, int N, int K, const Epi& E) {
  pg8::Gemm g; g.A = A; g.Bt = Bt; g.M = M_TOT; g.N = N; g.K = K; g.lda = lda; g.ldb = K;
  pg8::StaticOrder S; S.init(M_TOT, N, gridDim.x, blockIdx.x);
  __syncthreads();
  pg8::gemm_phase<Epi, pg8::StaticOrder, false>((PG8_LAS unsigned char*)lds_raw, g, S, E, nullptr);
  __syncthreads();
}

__device__ __forceinline__ void rope_item(const Params& p, int l, int item, bool dry = false) {
  const int tid = opq(threadIdx.x);
  u16* z = (u16*)(p.ws + WS_Z);
  const int row = item * 64 + (tid >> 3);
  const int d0 = (tid & 7) * 4;
  const bool prompt = row < M_P;
  int b, t, pos;
  if (prompt) { b = row >> 13; t = row & 8191; pos = t; } else { b = (row - M_P) >> 2; t = (row - M_P) & 3; pos = 16384 + t; }
  float cs[4], sn[4];
#pragma unroll
  for (int i = 0; i < 4; ++i) {
    const float inv = __expf(-(float)(d0 + i) * (9.210340371976184f / 32.f));
    const float angf = (float)pos * inv;
    double a = (double)angf;
    a -= 6.283185307179586 * rint(a * 0.15915494309189535);
    const float af = (float)a;
    sn[i] = __sinf(af); cs[i] = __cosf(af);
  }
#pragma unroll 2
  for (int hh = 0; hh < 10; ++hh) {
    u16* q = z + (size_t)row * ZLD + 1792 + hh * 64 + d0;
    const uint2 lo = *(const uint2*)q, hi = *(const uint2*)(q + 32);
    float x1[4] = {__uint_as_float(lo.x << 16), __uint_as_float(lo.x & 0xFFFF0000u), __uint_as_float(lo.y << 16), __uint_as_float(lo.y & 0xFFFF0000u)};
    float x2[4] = {__uint_as_float(hi.x << 16), __uint_as_float(hi.x & 0xFFFF0000u), __uint_as_float(hi.y << 16), __uint_as_float(hi.y & 0xFFFF0000u)};
    float y1[4], y2[4];
#pragma unroll
    for (int i = 0; i < 4; ++i) { y1[i] = x1[i] * cs[i] - x2[i] * sn[i]; y2[i] = x2[i] * cs[i] + x1[i] * sn[i]; }
    uint2 o1, o2;
    o1.x = pack2(y1[0], y1[1]); o1.y = pack2(y1[2], y1[3]); o2.x = pack2(y2[0], y2[1]); o2.y = pack2(y2[2], y2[3]);
    if (!dry) { *(uint2*)q = o1; *(uint2*)(q + 32) = o2; }
    if (hh >= 8 && prompt && t >= 8064) {
      float* o = p.out + O_PK + ((size_t)((l * 2 + b) * 128 + (t - 8064)) * 2 + (hh - 8)) * 64 + d0;
      *(float4*)o = make_float4(y1[0], y1[1], y1[2], y1[3]);
      *(float4*)(o + 32) = make_float4(y2[0], y2[1], y2[2], y2[3]);
    }
  }
}

#define SL(i) (ldsf + (i) * 4160)
__device__ __forceinline__ void rwkv_item(const Params& p, int l, int item, float* ldsf, bool dry = false) {
  const int tid = opq(threadIdx.x), lane = tid & 63, wave = tid >> 6;
  const bool sample = item >= 2048;
  int h, cidx, rowbase;
  if (!sample) { h = item & 7; cidx = item >> 3; rowbase = cidx * 64; }
  else { int s = item - 2048; h = s & 7; cidx = s >> 3; rowbase = M_P + cidx * 64; }
  const int cc = cidx & 127;
  const u16* z = (const u16*)(p.ws + WS_Z);
  u16* zw_ = (u16*)(p.ws + WS_Z);
  const float* mu = p.in[9] + l * 1792;
  float* wbuf = SL(7);
  float* gc = ldsf + 9 * 4160;
  float* bd = ldsf + 9 * 4160 + 64;
  __syncthreads();
  {
    const int t = tid >> 3, c8 = (tid & 7) * 8;
    const int m = rowbase + t;
    const int zcs[7] = {h * 64, 512 + h * 64, 1024 + h * 64, 1536, 1600, 1664, 1728};
#pragma unroll
    for (int gi = 0; gi < 7; ++gi) {
      const int zc = zcs[gi] + c8;
      float cur[8], prv[8];
      unpack8(*(const uint4*)(z + (size_t)m * ZLD + zc), cur);
      bool zero = false, fromstate = false;
      if (!sample) zero = (t == 0 && cc == 0);
      else fromstate = ((t & 3) == 0);
      if (zero) {
#pragma unroll
        for (int i = 0; i < 8; ++i) prv[i] = 0.f;
      } else if (fromstate) {
        const int b = (m - M_P) >> 2;
        const float* sp = p.in[2] + (size_t)(l * 128 + b) * 1792 + zc;
        float4 a = *(const float4*)sp, bb = *(const float4*)(sp + 4);
        prv[0] = a.x; prv[1] = a.y; prv[2] = a.z; prv[3] = a.w; prv[4] = bb.x; prv[5] = bb.y; prv[6] = bb.z; prv[7] = bb.w;
      } else {
        unpack8(*(const uint4*)(z + (size_t)(m - 1) * ZLD + zc), prv);
      }
      float* d = SL(gi) + t * 65 + c8;
#pragma unroll
      for (int i = 0; i < 8; ++i) {
        float v = cur[i] + mu[zc + i] * (prv[i] - cur[i]);
        if (gi == 3) v = tanhf(v);
        if (gi >= 5) v = sigm(v);
        d[i] = v;
      }
    }
  }
  const int lt = tid & 63, jg = tid >> 6;
  auto load_w = [&](const float* W, int nrows) {
    for (int e = tid; e < nrows * 8; e += NT) {
      const int i = e >> 3, c = (e & 7) * 8;
      const float* s = W + (size_t)i * 512 + h * 64 + c;
      *(float4*)(wbuf + i * 64 + c) = *(const float4*)s;
      *(float4*)(wbuf + i * 64 + c + 4) = *(const float4*)(s + 4);
    }
  };
  auto lora = [&](const float* xa, const float* xb, int n, float* acc) {
#pragma unroll 2
    for (int i = 0; i < n; ++i) {
      const float x = (i < 64) ? xa[lt * 65 + i] : xb[lt * 65 + i - 64];
      const float4 w0 = *(const float4*)(wbuf + i * 64 + jg * 8);
      const float4 w1 = *(const float4*)(wbuf + i * 64 + jg * 8 + 4);
      acc[0] += x * w0.x; acc[1] += x * w0.y; acc[2] += x * w0.z; acc[3] += x * w0.w;
      acc[4] += x * w1.x; acc[5] += x * w1.y; acc[6] += x * w1.z; acc[7] += x * w1.w;
    }
  };
  float res[8];
  load_w(p.in[11] + (size_t)l * 64 * 512, 64);
  __syncthreads();
#pragma unroll
  for (int i = 0; i < 8; ++i) res[i] = p.in[10][l * 512 + h * 64 + jg * 8 + i];
  lora(SL(3), SL(3), 64, res);
  __syncthreads();
#pragma unroll
  for (int i = 0; i < 8; ++i) {
    const float x = -res[i];
    const float sp = (x > 20.f) ? x : log1pf(__expf(x));
    SL(3)[lt * 65 + jg * 8 + i] = -__expf(-sp - 0.5f);
  }
  load_w(p.in[13] + (size_t)l * 64 * 512, 64);
  __syncthreads();
#pragma unroll
  for (int i = 0; i < 8; ++i) res[i] = p.in[12][l * 512 + h * 64 + jg * 8 + i];
  lora(SL(4), SL(4), 64, res);
  __syncthreads();
#pragma unroll
  for (int i = 0; i < 8; ++i) SL(4)[lt * 65 + jg * 8 + i] = sigm(res[i]);
  load_w(p.in[14] + (size_t)l * 128 * 512, 128);
  __syncthreads();
#pragma unroll
  for (int i = 0; i < 8; ++i) res[i] = 0.f;
  lora(SL(5), SL(6), 128, res);
  __syncthreads();
  if (!sample) {
    u16* ga = (u16*)(p.ws + WS_GA) + (size_t)item * 4096;
    *(uint4*)(ga + lt * 64 + jg * 8) = pack8(res);
    if (tid < 64) {
      float c = 0.f;
      for (int t = 0; t < 64; ++t) { c += SL(3)[t * 65 + tid]; SL(5)[t * 65 + tid] = c; }
      gc[tid] = __expf(c);
    }
  } else {
#pragma unroll
    for (int i = 0; i < 8; ++i) SL(6)[lt * 65 + jg * 8 + i] = res[i];
  }
  __syncthreads();
  {
    const int t = tid >> 3, j0 = (tid & 7) * 8;
    const float* kkw = p.in[15] + l * 512 + h * 64;
    const float* kaw = p.in[16] + l * 512 + h * 64;
    const float* rkw = p.in[17] + l * 512 + h * 64;
    float kr[8], av[8], rv[8], kkv[8], kf[8];
    float nrm = 0.f, bdot = 0.f;
#pragma unroll
    for (int i = 0; i < 8; ++i) {
      const int j = j0 + i;
      kr[i] = SL(1)[t * 65 + j]; av[i] = SL(4)[t * 65 + j]; rv[i] = SL(0)[t * 65 + j];
      kkv[i] = kr[i] * kkw[j];
      nrm += kkv[i] * kkv[i];
      kf[i] = kr[i] * (1.f + (av[i] - 1.f) * kaw[j]);
      bdot += rv[i] * kf[i] * rkw[j];
    }
    nrm += __shfl_xor(nrm, 1, 64); nrm += __shfl_xor(nrm, 2, 64); nrm += __shfl_xor(nrm, 4, 64);
    bdot += __shfl_xor(bdot, 1, 64); bdot += __shfl_xor(bdot, 2, 64); bdot += __shfl_xor(bdot, 4, 64);
    const float rn = 1.f / fmaxf(sqrtf(nrm), 1e-12f);
    if (!sample) {
      float bo[8];
#pragma unroll
      for (int i = 0; i < 8; ++i) {
        const int j = j0 + i;
        const float cum = SL(5)[t * 65 + j], dl = SL(3)[t * 65 + j];
        const float eg = __expf(cum), egi = __expf(-cum), egp = __expf(cum - dl);
        const float kk = kkv[i] * rn;
        SL(0)[t * 65 + j] = rv[i] * eg;
        SL(1)[t * 65 + j] = kf[i] * egi;
        SL(3)[t * 65 + j] = kk * av[i] * egi;
        SL(4)[t * 65 + j] = kk * egp;
        bo[i] = bdot * SL(2)[t * 65 + j];
      }
      u16* bop = (u16*)(p.ws + WS_BO) + (size_t)item * 4096;
      *(uint4*)(bop + t * 64 + j0) = pack8(bo);
    } else {
#pragma unroll
      for (int i = 0; i < 8; ++i) {
        const int j = j0 + i;
        const float kk = kkv[i] * rn;
        const float dl = SL(3)[t * 65 + j];
        SL(1)[t * 65 + j] = kf[i];
        SL(3)[t * 65 + j] = __expf(dl);
        SL(4)[t * 65 + j] = kk;
        SL(5)[t * 65 + j] = kk * av[i];
      }
      if ((tid & 7) == 0) bd[t] = bdot;
    }
  }
  __syncthreads();
  if (sample) {
    const float lng = p.in[18][l * 512 + h * 64 + lane], lnb = p.in[19][l * 512 + h * 64 + lane];
    for (int round = 0; round < 2; ++round) {
      const int seq = wave + 8 * round;
      const int b = cidx * 16 + seq;
      float S[64];
      const float* sp = p.in[3] + ((size_t)((l * 128 + b) * 8 + h) * 64 + lane) * 64;
#pragma unroll
      for (int k = 0; k < 64; k += 4) { float4 v = *(const float4*)(sp + k); S[k] = v.x; S[k + 1] = v.y; S[k + 2] = v.z; S[k + 3] = v.w; }
      for (int tt = 0; tt < 4; ++tt) {
        const int t = seq * 4 + tt;
        float sk = 0.f;
#pragma unroll
        for (int kc = 0; kc < 64; kc += 8) {
#pragma unroll
          for (int k = kc; k < kc + 8; ++k) sk += S[k] * SL(4)[t * 65 + k];
          __builtin_amdgcn_sched_barrier(0);
        }
        const float vt = SL(2)[t * 65 + lane];
        float y = 0.f;
#pragma unroll
        for (int kc = 0; kc < 64; kc += 8) {
#pragma unroll
          for (int k = kc; k < kc + 8; ++k) {
            S[k] = S[k] * SL(3)[t * 65 + k] - sk * SL(5)[t * 65 + k] + vt * SL(1)[t * 65 + k];
            y += S[k] * SL(0)[t * 65 + k];
          }
          __builtin_amdgcn_sched_barrier(0);
        }
        const float mean = wave_sum(y) * (1.f / 64.f);
        const float d = y - mean;
        const float var = wave_sum(d * d) * (1.f / 64.f);
        const float yn = d * rsqrtf(var + 64e-5f) * lng + lnb;
        const float o = (yn + bd[t] * vt) * SL(6)[t * 65 + lane];
        if (!dry) zw_[(size_t)(M_P + b * 4 + tt) * ZLD + h * 64 + lane] = f2bf(o);
      }
      float* op = p.out + O_SWKV + ((size_t)((l * 128 + b) * 8 + h) * 64 + lane) * 64;
#pragma unroll
      for (int k = 0; k < 64; k += 4) *(float4*)(op + k) = make_float4(S[k], S[k + 1], S[k + 2], S[k + 3]);
    }
    return;
  }
  {
    const int i = lane, tg = wave;
    float ab[8], ak[8], akr[8], abr[8];
#pragma unroll
    for (int q = 0; q < 8; ++q) { ab[q] = 0.f; ak[q] = 0.f; akr[q] = 0.f; abr[q] = 0.f; }
#pragma unroll 2
    for (int k = 0; k < 64; ++k) {
      const float xb = SL(3)[i * 65 + k], xk = SL(1)[i * 65 + k];
#pragma unroll
      for (int q = 0; q < 8; ++q) {
        const int t = tg * 8 + q;
        const float yk = SL(4)[t * 65 + k], yr = SL(0)[t * 65 + k];
        ab[q] += xb * yk; ak[q] += xk * yk; akr[q] += xk * yr; abr[q] += xb * yr;
      }
    }
    __syncthreads();
#pragma unroll
    for (int q = 0; q < 8; ++q) {
      const int t = tg * 8 + q;
      SL(6)[i * 65 + t] = (i < t) ? ab[q] : 0.f;
      SL(7)[i * 65 + t] = (i < t) ? ak[q] : 0.f;
      SL(8)[i * 65 + t] = (i <= t) ? akr[q] : 0.f;
      SL(5)[i * 65 + t] = (i <= t) ? abr[q] : 0.f;
    }
  }
  __syncthreads();
  {
    const int t = tid >> 3, j0 = (tid & 7) * 8;
#pragma unroll
    for (int i = 0; i < 8; ++i) { const float g = gc[j0 + i]; SL(3)[t * 65 + j0 + i] *= g; SL(1)[t * 65 + j0 + i] *= g; }
  }
  __syncthreads();
  if (tid < 128) {
    float* X_ = (tid < 64) ? SL(5) : SL(3);
    const int col = tid & 63;
    for (int i = 62; i >= 0; --i) {
      float a = X_[i * 65 + col];
#pragma unroll 4
      for (int t = i + 1; t < 64; ++t) a -= SL(6)[i * 65 + t] * X_[t * 65 + col];
      X_[i * 65 + col] = a;
    }
  }
  __syncthreads();
  {
    const int c = tid & 127, ig = tid >> 7;
    const int which = c >> 6, cq = c & 63;
    const float* N_ = which ? SL(3) : SL(5);
    float a[16];
#pragma unroll
    for (int q = 0; q < 16; ++q) a[q] = 0.f;
#pragma unroll 2
    for (int t = 0; t < 64; ++t) {
      const float n = N_[t * 65 + cq];
#pragma unroll
      for (int q = 0; q < 16; ++q) a[q] += SL(7)[(ig * 16 + q) * 65 + t] * n;
    }
    float* T_ = which ? SL(1) : SL(8);
#pragma unroll
    for (int q = 0; q < 16; ++q) T_[(ig * 16 + q) * 65 + cq] -= a[q];
  }
  __syncthreads();
  {
    const int x = lane, yg = wave;
    float w2[8], pp[8], yl[8], qq[8];
#pragma unroll
    for (int q = 0; q < 8; ++q) { w2[q] = 0.f; pp[q] = 0.f; yl[q] = 0.f; qq[q] = 0.f; }
#pragma unroll 2
    for (int j = 0; j < 64; ++j) {
      const float l5 = SL(5)[j * 65 + x], l4 = SL(4)[j * 65 + x], l8 = SL(8)[j * 65 + x], l2 = SL(2)[j * 65 + x];
#pragma unroll
      for (int q = 0; q < 8; ++q) {
        const int y = yg * 8 + q;
        w2[q] += l5 * SL(4)[j * 65 + y];
        pp[q] += l4 * SL(3)[j * 65 + y];
        yl[q] += l8 * SL(2)[j * 65 + y];
        qq[q] += l2 * SL(1)[j * 65 + y];
      }
    }
    float o1[8];
#pragma unroll
    for (int q = 0; q < 8; ++q) {
      const int y = yg * 8 + q;
      o1[q] = SL(0)[x * 65 + y] - w2[q];
    }
    u16* Pf = (u16*)(p.ws + WS_PP) + (size_t)item * 4096;
    float* Qf = (float*)(p.ws + WS_Q) + (size_t)item * 4096;
    if (tid < 64) ((float*)(p.ws + WS_GC))[(size_t)item * 64 + tid] = gc[tid];
    {
      const int s_ = x >> 4, kk = x & 15, hh = (kk >> 2) & 1, jj = ((kk >> 3) << 2) | (kk & 3);
#pragma unroll
      for (int q = 0; q < 8; ++q) {
        const int y = yg * 8 + q;
        Pf[(((y >> 5) * 4 + s_) * 64 + (y & 31) + 32 * hh) * 8 + jj] = f2bf(-pp[q]);
        const int k2 = y & 31, reg = ((k2 >> 3) << 2) | (k2 & 3), h2 = (k2 >> 2) & 1;
        Qf[(((x >> 5) * 2 + (y >> 5)) * 16 + reg) * 64 + (x & 31) + 32 * h2] = qq[q];
      }
    }
    u16* W2p = (u16*)(p.ws + WS_W2) + (size_t)item * 4096 + x * 64 + yg * 8;
    u16* YLp = (u16*)(p.ws + WS_YL) + (size_t)item * 4096 + x * 64 + yg * 8;
    *(uint4*)W2p = pack8(o1);
    *(uint4*)YLp = pack8(yl);
  }
}

__device__ __forceinline__ void mm_tile(const u16* Aop, int lda, const u16* Bop, int ldb, int mt, int nt, int r, int h, int ksteps, f32x16& acc) {
  const u16* ap = Aop + (mt * 32 + r) * lda + h * 8;
  const u16* bp = Bop + (nt * 32 + r) * ldb + h * 8;
#pragma unroll 4
  for (int s = 0; s < ksteps; ++s) {
    const bf16x8 a = *(const bf16x8*)(ap + s * 16);
    const bf16x8 b = *(const bf16x8*)(bp + s * 16);
    acc = __builtin_amdgcn_mfma_f32_32x32x16_bf16(a, b, acc, 0, 0, 0);
  }
}
__device__ __forceinline__ void store_T(u16* T, int ldt, int mt, int nt, int r, int h, const f32x16& acc) {
#pragma unroll
  for (int g = 0; g < 4; ++g) {
    uint2 o; o.x = pack2(acc[4 * g], acc[4 * g + 1]); o.y = pack2(acc[4 * g + 2], acc[4 * g + 3]);
    *(uint2*)(T + (nt * 32 + r) * ldt + mt * 32 + 8 * g + 4 * h) = o;
  }
}
__device__ __forceinline__ void tri32(const float* Ab, float* Xc) {
  float a0 = Xc[0];
  float a1 = Xc[65];
  float a2 = Xc[130];
  float a3 = Xc[195];
  float a4 = Xc[260];
  float a5 = Xc[325];
  float a6 = Xc[390];
  float a7 = Xc[455];
  float a8 = Xc[520];
  float a9 = Xc[585];
  float a10 = Xc[650];
  float a11 = Xc[715];
  float a12 = Xc[780];
  float a13 = Xc[845];
  float a14 = Xc[910];
  float a15 = Xc[975];
  float a16 = Xc[1040];
  float a17 = Xc[1105];
  float a18 = Xc[1170];
  float a19 = Xc[1235];
  float a20 = Xc[1300];
  float a21 = Xc[1365];
  float a22 = Xc[1430];
  float a23 = Xc[1495];
  float a24 = Xc[1560];
  float a25 = Xc[1625];
  float a26 = Xc[1690];
  float a27 = Xc[1755];
  float a28 = Xc[1820];
  float a29 = Xc[1885];
  float a30 = Xc[1950];
  float a31 = Xc[2015];
  const float4 c30_28 = *(const float4*)(Ab + 2068);
  const float4 c29_28 = *(const float4*)(Ab + 2000);
  const float4 c28_28 = *(const float4*)(Ab + 1932);
  a30 -= c30_28.w * a31;
  const float4 c27_28 = *(const float4*)(Ab + 1864);
  a29 -= c29_28.z * a30;
  a29 -= c29_28.w * a31;
  const float4 c26_24 = *(const float4*)(Ab + 1792);
  const float4 c26_28 = *(const float4*)(Ab + 1796);
  a28 -= c28_28.y * a29;
  a28 -= c28_28.z * a30;
  a28 -= c28_28.w * a31;
  __builtin_amdgcn_sched_barrier(0);
  const float4 c25_24 = *(const float4*)(Ab + 1724);
  const float4 c25_28 = *(const float4*)(Ab + 1728);
  a27 -= c27_28.x * a28;
  a27 -= c27_28.y * a29;
  a27 -= c27_28.z * a30;
  a27 -= c27_28.w * a31;
  const float4 c24_24 = *(const float4*)(Ab + 1656);
  const float4 c24_28 = *(const float4*)(Ab + 1660);
  a26 -= c26_24.w * a27;
  a26 -= c26_28.x * a28;
  a26 -= c26_28.y * a29;
  a26 -= c26_28.z * a30;
  a26 -= c26_28.w * a31;
  const float4 c23_24 = *(const float4*)(Ab + 1588);
  const float4 c23_28 = *(const float4*)(Ab + 1592);
  a25 -= c25_24.z * a26;
  a25 -= c25_24.w * a27;
  a25 -= c25_28.x * a28;
  a25 -= c25_28.y * a29;
  a25 -= c25_28.z * a30;
  a25 -= c25_28.w * a31;
  const float4 c22_20 = *(const float4*)(Ab + 1516);
  const float4 c22_24 = *(const float4*)(Ab + 1520);
  const float4 c22_28 = *(const float4*)(Ab + 1524);
  a24 -= c24_24.y * a25;
  a24 -= c24_24.z * a26;
  a24 -= c24_24.w * a27;
  a24 -= c24_28.x * a28;
  a24 -= c24_28.y * a29;
  a24 -= c24_28.z * a30;
  a24 -= c24_28.w * a31;
  __builtin_amdgcn_sched_barrier(0);
  const float4 c21_20 = *(const float4*)(Ab + 1448);
  const float4 c21_24 = *(const float4*)(Ab + 1452);
  const float4 c21_28 = *(const float4*)(Ab + 1456);
  a23 -= c23_24.x * a24;
  a23 -= c23_24.y * a25;
  a23 -= c23_24.z * a26;
  a23 -= c23_24.w * a27;
  a23 -= c23_28.x * a28;
  a23 -= c23_28.y * a29;
  a23 -= c23_28.z * a30;
  a23 -= c23_28.w * a31;
  const float4 c20_20 = *(const float4*)(Ab + 1380);
  const float4 c20_24 = *(const float4*)(Ab + 1384);
  const float4 c20_28 = *(const float4*)(Ab + 1388);
  a22 -= c22_20.w * a23;
  a22 -= c22_24.x * a24;
  a22 -= c22_24.y * a25;
  a22 -= c22_24.z * a26;
  a22 -= c22_24.w * a27;
  a22 -= c22_28.x * a28;
  a22 -= c22_28.y * a29;
  a22 -= c22_28.z * a30;
  a22 -= c22_28.w * a31;
  const float4 c19_20 = *(const float4*)(Ab + 1312);
  const float4 c19_24 = *(const float4*)(Ab + 1316);
  const float4 c19_28 = *(const float4*)(Ab + 1320);
  a21 -= c21_20.z * a22;
  a21 -= c21_20.w * a23;
  a21 -= c21_24.x * a24;
  a21 -= c21_24.y * a25;
  a21 -= c21_24.z * a26;
  a21 -= c21_24.w * a27;
  a21 -= c21_28.x * a28;
  a21 -= c21_28.y * a29;
  a21 -= c21_28.z * a30;
  a21 -= c21_28.w * a31;
  const float4 c18_16 = *(const float4*)(Ab + 1240);
  const float4 c18_20 = *(const float4*)(Ab + 1244);
  const float4 c18_24 = *(const float4*)(Ab + 1248);
  const float4 c18_28 = *(const float4*)(Ab + 1252);
  a20 -= c20_20.y * a21;
  a20 -= c20_20.z * a22;
  a20 -= c20_20.w * a23;
  a20 -= c20_24.x * a24;
  a20 -= c20_24.y * a25;
  a20 -= c20_24.z * a26;
  a20 -= c20_24.w * a27;
  a20 -= c20_28.x * a28;
  a20 -= c20_28.y * a29;
  a20 -= c20_28.z * a30;
  a20 -= c20_28.w * a31;
  __builtin_amdgcn_sched_barrier(0);
  const float4 c17_16 = *(const float4*)(Ab + 1172);
  const float4 c17_20 = *(const float4*)(Ab + 1176);
  const float4 c17_24 = *(const float4*)(Ab + 1180);
  const float4 c17_28 = *(const float4*)(Ab + 1184);
  a19 -= c19_20.x * a20;
  a19 -= c19_20.y * a21;
  a19 -= c19_20.z * a22;
  a19 -= c19_20.w * a23;
  a19 -= c19_24.x * a24;
  a19 -= c19_24.y * a25;
  a19 -= c19_24.z * a26;
  a19 -= c19_24.w * a27;
  a19 -= c19_28.x * a28;
  a19 -= c19_28.y * a29;
  a19 -= c19_28.z * a30;
  a19 -= c19_28.w * a31;
  const float4 c16_16 = *(const float4*)(Ab + 1104);
  const float4 c16_20 = *(const float4*)(Ab + 1108);
  const float4 c16_24 = *(const float4*)(Ab + 1112);
  const float4 c16_28 = *(const float4*)(Ab + 1116);
  a18 -= c18_16.w * a19;
  a18 -= c18_20.x * a20;
  a18 -= c18_20.y * a21;
  a18 -= c18_20.z * a22;
  a18 -= c18_20.w * a23;
  a18 -= c18_24.x * a24;
  a18 -= c18_24.y * a25;
  a18 -= c18_24.z * a26;
  a18 -= c18_24.w * a27;
  a18 -= c18_28.x * a28;
  a18 -= c18_28.y * a29;
  a18 -= c18_28.z * a30;
  a18 -= c18_28.w * a31;
  const float4 c15_16 = *(const float4*)(Ab + 1036);
  const float4 c15_20 = *(const float4*)(Ab + 1040);
  const float4 c15_24 = *(const float4*)(Ab + 1044);
  const float4 c15_28 = *(const float4*)(Ab + 1048);
  a17 -= c17_16.z * a18;
  a17 -= c17_16.w * a19;
  a17 -= c17_20.x * a20;
  a17 -= c17_20.y * a21;
  a17 -= c17_20.z * a22;
  a17 -= c17_20.w * a23;
  a17 -= c17_24.x * a24;
  a17 -= c17_24.y * a25;
  a17 -= c17_24.z * a26;
  a17 -= c17_24.w * a27;
  a17 -= c17_28.x * a28;
  a17 -= c17_28.y * a29;
  a17 -= c17_28.z * a30;
  a17 -= c17_28.w * a31;
  const float4 c14_12 = *(const float4*)(Ab + 964);
  const float4 c14_16 = *(const float4*)(Ab + 968);
  const float4 c14_20 = *(const float4*)(Ab + 972);
  const float4 c14_24 = *(const float4*)(Ab + 976);
  const float4 c14_28 = *(const float4*)(Ab + 980);
  a16 -= c16_16.y * a17;
  a16 -= c16_16.z * a18;
  a16 -= c16_16.w * a19;
  a16 -= c16_20.x * a20;
  a16 -= c16_20.y * a21;
  a16 -= c16_20.z * a22;
  a16 -= c16_20.w * a23;
  a16 -= c16_24.x * a24;
  a16 -= c16_24.y * a25;
  a16 -= c16_24.z * a26;
  a16 -= c16_24.w * a27;
  a16 -= c16_28.x * a28;
  a16 -= c16_28.y * a29;
  a16 -= c16_28.z * a30;
  a16 -= c16_28.w * a31;
  __builtin_amdgcn_sched_barrier(0);
  const float4 c13_12 = *(const float4*)(Ab + 896);
  const float4 c13_16 = *(const float4*)(Ab + 900);
  const float4 c13_20 = *(const float4*)(Ab + 904);
  const float4 c13_24 = *(const float4*)(Ab + 908);
  const float4 c13_28 = *(const float4*)(Ab + 912);
  a15 -= c15_16.x * a16;
  a15 -= c15_16.y * a17;
  a15 -= c15_16.z * a18;
  a15 -= c15_16.w * a19;
  a15 -= c15_20.x * a20;
  a15 -= c15_20.y * a21;
  a15 -= c15_20.z * a22;
  a15 -= c15_20.w * a23;
  a15 -= c15_24.x * a24;
  a15 -= c15_24.y * a25;
  a15 -= c15_24.z * a26;
  a15 -= c15_24.w * a27;
  a15 -= c15_28.x * a28;
  a15 -= c15_28.y * a29;
  a15 -= c15_28.z * a30;
  a15 -= c15_28.w * a31;
  const float4 c12_12 = *(const float4*)(Ab + 828);
  const float4 c12_16 = *(const float4*)(Ab + 832);
  const float4 c12_20 = *(const float4*)(Ab + 836);
  const float4 c12_24 = *(const float4*)(Ab + 840);
  const float4 c12_28 = *(const float4*)(Ab + 844);
  a14 -= c14_12.w * a15;
  a14 -= c14_16.x * a16;
  a14 -= c14_16.y * a17;
  a14 -= c14_16.z * a18;
  a14 -= c14_16.w * a19;
  a14 -= c14_20.x * a20;
  a14 -= c14_20.y * a21;
  a14 -= c14_20.z * a22;
  a14 -= c14_20.w * a23;
  a14 -= c14_24.x * a24;
  a14 -= c14_24.y * a25;
  a14 -= c14_24.z * a26;
  a14 -= c14_24.w * a27;
  a14 -= c14_28.x * a28;
  a14 -= c14_28.y * a29;
  a14 -= c14_28.z * a30;
  a14 -= c14_28.w * a31;
  const float4 c11_12 = *(const float4*)(Ab + 760);
  const float4 c11_16 = *(const float4*)(Ab + 764);
  const float4 c11_20 = *(const float4*)(Ab + 768);
  const float4 c11_24 = *(const float4*)(Ab + 772);
  const float4 c11_28 = *(const float4*)(Ab + 776);
  a13 -= c13_12.z * a14;
  a13 -= c13_12.w * a15;
  a13 -= c13_16.x * a16;
  a13 -= c13_16.y * a17;
  a13 -= c13_16.z * a18;
  a13 -= c13_16.w * a19;
  a13 -= c13_20.x * a20;
  a13 -= c13_20.y * a21;
  a13 -= c13_20.z * a22;
  a13 -= c13_20.w * a23;
  a13 -= c13_24.x * a24;
  a13 -= c13_24.y * a25;
  a13 -= c13_24.z * a26;
  a13 -= c13_24.w * a27;
  a13 -= c13_28.x * a28;
  a13 -= c13_28.y * a29;
  a13 -= c13_28.z * a30;
  a13 -= c13_28.w * a31;
  const float4 c10_8 = *(const float4*)(Ab + 688);
  const float4 c10_12 = *(const float4*)(Ab + 692);
  const float4 c10_16 = *(const float4*)(Ab + 696);
  const float4 c10_20 = *(const float4*)(Ab + 700);
  const float4 c10_24 = *(const float4*)(Ab + 704);
  const float4 c10_28 = *(const float4*)(Ab + 708);
  a12 -= c12_12.y * a13;
  a12 -= c12_12.z * a14;
  a12 -= c12_12.w * a15;
  a12 -= c12_16.x * a16;
  a12 -= c12_16.y * a17;
  a12 -= c12_16.z * a18;
  a12 -= c12_16.w * a19;
  a12 -= c12_20.x * a20;
  a12 -= c12_20.y * a21;
  a12 -= c12_20.z * a22;
  a12 -= c12_20.w * a23;
  a12 -= c12_24.x * a24;
  a12 -= c12_24.y * a25;
  a12 -= c12_24.z * a26;
  a12 -= c12_24.w * a27;
  a12 -= c12_28.x * a28;
  a12 -= c12_28.y * a29;
  a12 -= c12_28.z * a30;
  a12 -= c12_28.w * a31;
  __builtin_amdgcn_sched_barrier(0);
  const float4 c9_8 = *(const float4*)(Ab + 620);
  const float4 c9_12 = *(const float4*)(Ab + 624);
  const float4 c9_16 = *(const float4*)(Ab + 628);
  const float4 c9_20 = *(const float4*)(Ab + 632);
  const float4 c9_24 = *(const float4*)(Ab + 636);
  const float4 c9_28 = *(const float4*)(Ab + 640);
  a11 -= c11_12.x * a12;
  a11 -= c11_12.y * a13;
  a11 -= c11_12.z * a14;
  a11 -= c11_12.w * a15;
  a11 -= c11_16.x * a16;
  a11 -= c11_16.y * a17;
  a11 -= c11_16.z * a18;
  a11 -= c11_16.w * a19;
  a11 -= c11_20.x * a20;
  a11 -= c11_20.y * a21;
  a11 -= c11_20.z * a22;
  a11 -= c11_20.w * a23;
  a11 -= c11_24.x * a24;
  a11 -= c11_24.y * a25;
  a11 -= c11_24.z * a26;
  a11 -= c11_24.w * a27;
  a11 -= c11_28.x * a28;
  a11 -= c11_28.y * a29;
  a11 -= c11_28.z * a30;
  a11 -= c11_28.w * a31;
  const float4 c8_8 = *(const float4*)(Ab + 552);
  const float4 c8_12 = *(const float4*)(Ab + 556);
  const float4 c8_16 = *(const float4*)(Ab + 560);
  const float4 c8_20 = *(const float4*)(Ab + 564);
  const float4 c8_24 = *(const float4*)(Ab + 568);
  const float4 c8_28 = *(const float4*)(Ab + 572);
  a10 -= c10_8.w * a11;
  a10 -= c10_12.x * a12;
  a10 -= c10_12.y * a13;
  a10 -= c10_12.z * a14;
  a10 -= c10_12.w * a15;
  a10 -= c10_16.x * a16;
  a10 -= c10_16.y * a17;
  a10 -= c10_16.z * a18;
  a10 -= c10_16.w * a19;
  a10 -= c10_20.x * a20;
  a10 -= c10_20.y * a21;
  a10 -= c10_20.z * a22;
  a10 -= c10_20.w * a23;
  a10 -= c10_24.x * a24;
  a10 -= c10_24.y * a25;
  a10 -= c10_24.z * a26;
  a10 -= c10_24.w * a27;
  a10 -= c10_28.x * a28;
  a10 -= c10_28.y * a29;
  a10 -= c10_28.z * a30;
  a10 -= c10_28.w * a31;
  const float4 c7_8 = *(const float4*)(Ab + 484);
  const float4 c7_12 = *(const float4*)(Ab + 488);
  const float4 c7_16 = *(const float4*)(Ab + 492);
  const float4 c7_20 = *(const float4*)(Ab + 496);
  const float4 c7_24 = *(const float4*)(Ab + 500);
  const float4 c7_28 = *(const float4*)(Ab + 504);
  a9 -= c9_8.z * a10;
  a9 -= c9_8.w * a11;
  a9 -= c9_12.x * a12;
  a9 -= c9_12.y * a13;
  a9 -= c9_12.z * a14;
  a9 -= c9_12.w * a15;
  a9 -= c9_16.x * a16;
  a9 -= c9_16.y * a17;
  a9 -= c9_16.z * a18;
  a9 -= c9_16.w * a19;
  a9 -= c9_20.x * a20;
  a9 -= c9_20.y * a21;
  a9 -= c9_20.z * a22;
  a9 -= c9_20.w * a23;
  a9 -= c9_24.x * a24;
  a9 -= c9_24.y * a25;
  a9 -= c9_24.z * a26;
  a9 -= c9_24.w * a27;
  a9 -= c9_28.x * a28;
  a9 -= c9_28.y * a29;
  a9 -= c9_28.z * a30;
  a9 -= c9_28.w * a31;
  const float4 c6_4 = *(const float4*)(Ab + 412);
  const float4 c6_8 = *(const float4*)(Ab + 416);
  const float4 c6_12 = *(const float4*)(Ab + 420);
  const float4 c6_16 = *(const float4*)(Ab + 424);
  const float4 c6_20 = *(const float4*)(Ab + 428);
  const float4 c6_24 = *(const float4*)(Ab + 432);
  const float4 c6_28 = *(const float4*)(Ab + 436);
  a8 -= c8_8.y * a9;
  a8 -= c8_8.z * a10;
  a8 -= c8_8.w * a11;
  a8 -= c8_12.x * a12;
  a8 -= c8_12.y * a13;
  a8 -= c8_12.z * a14;
  a8 -= c8_12.w * a15;
  a8 -= c8_16.x * a16;
  a8 -= c8_16.y * a17;
  a8 -= c8_16.z * a18;
  a8 -= c8_16.w * a19;
  a8 -= c8_20.x * a20;
  a8 -= c8_20.y * a21;
  a8 -= c8_20.z * a22;
  a8 -= c8_20.w * a23;
  a8 -= c8_24.x * a24;
  a8 -= c8_24.y * a25;
  a8 -= c8_24.z * a26;
  a8 -= c8_24.w * a27;
  a8 -= c8_28.x * a28;
  a8 -= c8_28.y * a29;
  a8 -= c8_28.z * a30;
  a8 -= c8_28.w * a31;
  __builtin_amdgcn_sched_barrier(0);
  const float4 c5_4 = *(const float4*)(Ab + 344);
  const float4 c5_8 = *(const float4*)(Ab + 348);
  const float4 c5_12 = *(const float4*)(Ab + 352);
  const float4 c5_16 = *(const float4*)(Ab + 356);
  const float4 c5_20 = *(const float4*)(Ab + 360);
  const float4 c5_24 = *(const float4*)(Ab + 364);
  const float4 c5_28 = *(const float4*)(Ab + 368);
  a7 -= c7_8.x * a8;
  a7 -= c7_8.y * a9;
  a7 -= c7_8.z * a10;
  a7 -= c7_8.w * a11;
  a7 -= c7_12.x * a12;
  a7 -= c7_12.y * a13;
  a7 -= c7_12.z * a14;
  a7 -= c7_12.w * a15;
  a7 -= c7_16.x * a16;
  a7 -= c7_16.y * a17;
  a7 -= c7_16.z * a18;
  a7 -= c7_16.w * a19;
  a7 -= c7_20.x * a20;
  a7 -= c7_20.y * a21;
  a7 -= c7_20.z * a22;
  a7 -= c7_20.w * a23;
  a7 -= c7_24.x * a24;
  a7 -= c7_24.y * a25;
  a7 -= c7_24.z * a26;
  a7 -= c7_24.w * a27;
  a7 -= c7_28.x * a28;
  a7 -= c7_28.y * a29;
  a7 -= c7_28.z * a30;
  a7 -= c7_28.w * a31;
  const float4 c4_4 = *(const float4*)(Ab + 276);
  const float4 c4_8 = *(const float4*)(Ab + 280);
  const float4 c4_12 = *(const float4*)(Ab + 284);
  const float4 c4_16 = *(const float4*)(Ab + 288);
  const float4 c4_20 = *(const float4*)(Ab + 292);
  const float4 c4_24 = *(const float4*)(Ab + 296);
  const float4 c4_28 = *(const float4*)(Ab + 300);
  a6 -= c6_4.w * a7;
  a6 -= c6_8.x * a8;
  a6 -= c6_8.y * a9;
  a6 -= c6_8.z * a10;
  a6 -= c6_8.w * a11;
  a6 -= c6_12.x * a12;
  a6 -= c6_12.y * a13;
  a6 -= c6_12.z * a14;
  a6 -= c6_12.w * a15;
  a6 -= c6_16.x * a16;
  a6 -= c6_16.y * a17;
  a6 -= c6_16.z * a18;
  a6 -= c6_16.w * a19;
  a6 -= c6_20.x * a20;
  a6 -= c6_20.y * a21;
  a6 -= c6_20.z * a22;
  a6 -= c6_20.w * a23;
  a6 -= c6_24.x * a24;
  a6 -= c6_24.y * a25;
  a6 -= c6_24.z * a26;
  a6 -= c6_24.w * a27;
  a6 -= c6_28.x * a28;
  a6 -= c6_28.y * a29;
  a6 -= c6_28.z * a30;
  a6 -= c6_28.w * a31;
  const float4 c3_4 = *(const float4*)(Ab + 208);
  const float4 c3_8 = *(const float4*)(Ab + 212);
  const float4 c3_12 = *(const float4*)(Ab + 216);
  const float4 c3_16 = *(const float4*)(Ab + 220);
  const float4 c3_20 = *(const float4*)(Ab + 224);
  const float4 c3_24 = *(const float4*)(Ab + 228);
  const float4 c3_28 = *(const float4*)(Ab + 232);
  a5 -= c5_4.z * a6;
  a5 -= c5_4.w * a7;
  a5 -= c5_8.x * a8;
  a5 -= c5_8.y * a9;
  a5 -= c5_8.z * a10;
  a5 -= c5_8.w * a11;
  a5 -= c5_12.x * a12;
  a5 -= c5_12.y * a13;
  a5 -= c5_12.z * a14;
  a5 -= c5_12.w * a15;
  a5 -= c5_16.x * a16;
  a5 -= c5_16.y * a17;
  a5 -= c5_16.z * a18;
  a5 -= c5_16.w * a19;
  a5 -= c5_20.x * a20;
  a5 -= c5_20.y * a21;
  a5 -= c5_20.z * a22;
  a5 -= c5_20.w * a23;
  a5 -= c5_24.x * a24;
  a5 -= c5_24.y * a25;
  a5 -= c5_24.z * a26;
  a5 -= c5_24.w * a27;
  a5 -= c5_28.x * a28;
  a5 -= c5_28.y * a29;
  a5 -= c5_28.z * a30;
  a5 -= c5_28.w * a31;
  const float4 c2_0 = *(const float4*)(Ab + 136);
  const float4 c2_4 = *(const float4*)(Ab + 140);
  const float4 c2_8 = *(const float4*)(Ab + 144);
  const float4 c2_12 = *(const float4*)(Ab + 148);
  const float4 c2_16 = *(const float4*)(Ab + 152);
  const float4 c2_20 = *(const float4*)(Ab + 156);
  const float4 c2_24 = *(const float4*)(Ab + 160);
  const float4 c2_28 = *(const float4*)(Ab + 164);
  a4 -= c4_4.y * a5;
  a4 -= c4_4.z * a6;
  a4 -= c4_4.w * a7;
  a4 -= c4_8.x * a8;
  a4 -= c4_8.y * a9;
  a4 -= c4_8.z * a10;
  a4 -= c4_8.w * a11;
  a4 -= c4_12.x * a12;
  a4 -= c4_12.y * a13;
  a4 -= c4_12.z * a14;
  a4 -= c4_12.w * a15;
  a4 -= c4_16.x * a16;
  a4 -= c4_16.y * a17;
  a4 -= c4_16.z * a18;
  a4 -= c4_16.w * a19;
  a4 -= c4_20.x * a20;
  a4 -= c4_20.y * a21;
  a4 -= c4_20.z * a22;
  a4 -= c4_20.w * a23;
  a4 -= c4_24.x * a24;
  a4 -= c4_24.y * a25;
  a4 -= c4_24.z * a26;
  a4 -= c4_24.w * a27;
  a4 -= c4_28.x * a28;
  a4 -= c4_28.y * a29;
  a4 -= c4_28.z * a30;
  a4 -= c4_28.w * a31;
  __builtin_amdgcn_sched_barrier(0);
  const float4 c1_0 = *(const float4*)(Ab + 68);
  const float4 c1_4 = *(const float4*)(Ab + 72);
  const float4 c1_8 = *(const float4*)(Ab + 76);
  const float4 c1_12 = *(const float4*)(Ab + 80);
  const float4 c1_16 = *(const float4*)(Ab + 84);
  const float4 c1_20 = *(const float4*)(Ab + 88);
  const float4 c1_24 = *(const float4*)(Ab + 92);
  const float4 c1_28 = *(const float4*)(Ab + 96);
  a3 -= c3_4.x * a4;
  a3 -= c3_4.y * a5;
  a3 -= c3_4.z * a6;
  a3 -= c3_4.w * a7;
  a3 -= c3_8.x * a8;
  a3 -= c3_8.y * a9;
  a3 -= c3_8.z * a10;
  a3 -= c3_8.w * a11;
  a3 -= c3_12.x * a12;
  a3 -= c3_12.y * a13;
  a3 -= c3_12.z * a14;
  a3 -= c3_12.w * a15;
  a3 -= c3_16.x * a16;
  a3 -= c3_16.y * a17;
  a3 -= c3_16.z * a18;
  a3 -= c3_16.w * a19;
  a3 -= c3_20.x * a20;
  a3 -= c3_20.y * a21;
  a3 -= c3_20.z * a22;
  a3 -= c3_20.w * a23;
  a3 -= c3_24.x * a24;
  a3 -= c3_24.y * a25;
  a3 -= c3_24.z * a26;
  a3 -= c3_24.w * a27;
  a3 -= c3_28.x * a28;
  a3 -= c3_28.y * a29;
  a3 -= c3_28.z * a30;
  a3 -= c3_28.w * a31;
  const float4 c0_0 = *(const float4*)(Ab + 0);
  const float4 c0_4 = *(const float4*)(Ab + 4);
  const float4 c0_8 = *(const float4*)(Ab + 8);
  const float4 c0_12 = *(const float4*)(Ab + 12);
  const float4 c0_16 = *(const float4*)(Ab + 16);
  const float4 c0_20 = *(const float4*)(Ab + 20);
  const float4 c0_24 = *(const float4*)(Ab + 24);
  const float4 c0_28 = *(const float4*)(Ab + 28);
  a2 -= c2_0.w * a3;
  a2 -= c2_4.x * a4;
  a2 -= c2_4.y * a5;
  a2 -= c2_4.z * a6;
  a2 -= c2_4.w * a7;
  a2 -= c2_8.x * a8;
  a2 -= c2_8.y * a9;
  a2 -= c2_8.z * a10;
  a2 -= c2_8.w * a11;
  a2 -= c2_12.x * a12;
  a2 -= c2_12.y * a13;
  a2 -= c2_12.z * a14;
  a2 -= c2_12.w * a15;
  a2 -= c2_16.x * a16;
  a2 -= c2_16.y * a17;
  a2 -= c2_16.z * a18;
  a2 -= c2_16.w * a19;
  a2 -= c2_20.x * a20;
  a2 -= c2_20.y * a21;
  a2 -= c2_20.z * a22;
  a2 -= c2_20.w * a23;
  a2 -= c2_24.x * a24;
  a2 -= c2_24.y * a25;
  a2 -= c2_24.z * a26;
  a2 -= c2_24.w * a27;
  a2 -= c2_28.x * a28;
  a2 -= c2_28.y * a29;
  a2 -= c2_28.z * a30;
  a2 -= c2_28.w * a31;
  a1 -= c1_0.z * a2;
  a1 -= c1_0.w * a3;
  a1 -= c1_4.x * a4;
  a1 -= c1_4.y * a5;
  a1 -= c1_4.z * a6;
  a1 -= c1_4.w * a7;
  a1 -= c1_8.x * a8;
  a1 -= c1_8.y * a9;
  a1 -= c1_8.z * a10;
  a1 -= c1_8.w * a11;
  a1 -= c1_12.x * a12;
  a1 -= c1_12.y * a13;
  a1 -= c1_12.z * a14;
  a1 -= c1_12.w * a15;
  a1 -= c1_16.x * a16;
  a1 -= c1_16.y * a17;
  a1 -= c1_16.z * a18;
  a1 -= c1_16.w * a19;
  a1 -= c1_20.x * a20;
  a1 -= c1_20.y * a21;
  a1 -= c1_20.z * a22;
  a1 -= c1_20.w * a23;
  a1 -= c1_24.x * a24;
  a1 -= c1_24.y * a25;
  a1 -= c1_24.z * a26;
  a1 -= c1_24.w * a27;
  a1 -= c1_28.x * a28;
  a1 -= c1_28.y * a29;
  a1 -= c1_28.z * a30;
  a1 -= c1_28.w * a31;
  a0 -= c0_0.y * a1;
  a0 -= c0_0.z * a2;
  a0 -= c0_0.w * a3;
  a0 -= c0_4.x * a4;
  a0 -= c0_4.y * a5;
  a0 -= c0_4.z * a6;
  a0 -= c0_4.w * a7;
  a0 -= c0_8.x * a8;
  a0 -= c0_8.y * a9;
  a0 -= c0_8.z * a10;
  a0 -= c0_8.w * a11;
  a0 -= c0_12.x * a12;
  a0 -= c0_12.y * a13;
  a0 -= c0_12.z * a14;
  a0 -= c0_12.w * a15;
  a0 -= c0_16.x * a16;
  a0 -= c0_16.y * a17;
  a0 -= c0_16.z * a18;
  a0 -= c0_16.w * a19;
  a0 -= c0_20.x * a20;
  a0 -= c0_20.y * a21;
  a0 -= c0_20.z * a22;
  a0 -= c0_20.w * a23;
  a0 -= c0_24.x * a24;
  a0 -= c0_24.y * a25;
  a0 -= c0_24.z * a26;
  a0 -= c0_24.w * a27;
  a0 -= c0_28.x * a28;
  a0 -= c0_28.y * a29;
  a0 -= c0_28.z * a30;
  a0 -= c0_28.w * a31;
  __builtin_amdgcn_sched_barrier(0);
  Xc[0] = a0;
  Xc[65] = a1;
  Xc[130] = a2;
  Xc[195] = a3;
  Xc[260] = a4;
  Xc[325] = a5;
  Xc[390] = a6;
  Xc[455] = a7;
  Xc[520] = a8;
  Xc[585] = a9;
  Xc[650] = a10;
  Xc[715] = a11;
  Xc[780] = a12;
  Xc[845] = a13;
  Xc[910] = a14;
  Xc[975] = a15;
  Xc[1040] = a16;
  Xc[1105] = a17;
  Xc[1170] = a18;
  Xc[1235] = a19;
  Xc[1300] = a20;
  Xc[1365] = a21;
  Xc[1430] = a22;
  Xc[1495] = a23;
  Xc[1560] = a24;
  Xc[1625] = a25;
  Xc[1690] = a26;
  Xc[1755] = a27;
  Xc[1820] = a28;
  Xc[1885] = a29;
  Xc[1950] = a30;
  Xc[2015] = a31;
}
#define FS(i) (ldsf + (i) * 4160)
__device__ __forceinline__ void rwkv_item2(const Params& p, int l, int item, float* ldsf) {
  const int tid = opq(threadIdx.x), lane = tid & 63, wave = tid >> 6;
  const int r = lane & 31, hf = lane >> 5;
  const int h = item & 7, cidx = item >> 3, rowbase = cidx * 64, cc = cidx & 127;
  const u16* z = (const u16*)(p.ws + WS_Z);
  const float* mu = p.in[9] + l * 1792;
  u16* BBp = (u16*)((unsigned char*)ldsf + 83200);
  u16* XW = BBp;            u16* XA = BBp + 4608;    u16* XG = BBp + 9216;   u16* WT = BBp + 17920;
  u16* Rn = BBp;            u16* Kn = BBp + 4608;    u16* Bn = BBp + 9216;   u16* Cn = BBp + 13824;
  u16* CT = BBp + 18432;    u16* KHT = BBp + 23040;  u16* VT = BBp + 27648;
  float* gc = (float*)(BBp + 32256);
  u16* AK = (u16*)FS(2);    u16* NTm = AK + 4608;
  u16* MT = (u16*)FS(0);    u16* KQT = (u16*)FS(1);
  float* Abp = (float*)((unsigned char*)ldsf + 60928);
  const int mt = (wave >> 1) & 1, nt = wave & 1, grp = wave >> 2;
  const uint4* lwsrc = (const uint4*)((const u16*)(p.ws + WS_LW) + (size_t)h * 17920);
  const float bias_w = p.in[10][l * 512 + h * 64 + nt * 32 + r], bias_a = p.in[12][l * 512 + h * 64 + nt * 32 + r];
  float kkw_[8], kaw_[8], rkw_[8];
  {
    const int j0 = (tid & 7) * 8;
    const float* q1 = p.in[15] + l * 512 + h * 64 + j0; const float* q2 = p.in[16] + l * 512 + h * 64 + j0; const float* q3 = p.in[17] + l * 512 + h * 64 + j0;
    const float4 x0 = *(const float4*)q1, x1 = *(const float4*)(q1 + 4), y0 = *(const float4*)q2, y1 = *(const float4*)(q2 + 4), z0 = *(const float4*)q3, z1 = *(const float4*)(q3 + 4);
    kkw_[0] = x0.x; kkw_[1] = x0.y; kkw_[2] = x0.z; kkw_[3] = x0.w; kkw_[4] = x1.x; kkw_[5] = x1.y; kkw_[6] = x1.z; kkw_[7] = x1.w;
    kaw_[0] = y0.x; kaw_[1] = y0.y; kaw_[2] = y0.z; kaw_[3] = y0.w; kaw_[4] = y1.x; kaw_[5] = y1.y; kaw_[6] = y1.z; kaw_[7] = y1.w;
    rkw_[0] = z0.x; rkw_[1] = z0.y; rkw_[2] = z0.z; rkw_[3] = z0.w; rkw_[4] = z1.x; rkw_[5] = z1.y; rkw_[6] = z1.z; rkw_[7] = z1.w;
  }
  const uint4 g2a = lwsrc[1152 + tid], g2b = lwsrc[1152 + 512 + tid], g2c = (tid < 64) ? lwsrc[1152 + 1024 + tid] : make_uint4(0, 0, 0, 0);
  __syncthreads();
  {
    const int t = tid >> 3, c8 = (tid & 7) * 8;
    const int m = rowbase + t;
    const int zcs[7] = {h * 64, 512 + h * 64, 1024 + h * 64, 1536, 1600, 1664, 1728};
#pragma unroll
    for (int gi = 0; gi < 7; ++gi) {
      const int zc = zcs[gi] + c8;
      float cur[8], prv[8], v[8];
      const float4 mu0 = *(const float4*)(mu + zc), mu1 = *(const float4*)(mu + zc + 4);
      const float muv[8] = {mu0.x, mu0.y, mu0.z, mu0.w, mu1.x, mu1.y, mu1.z, mu1.w};
      unpack8(*(const uint4*)(z + (size_t)m * ZLD + zc), cur);
      if (t == 0 && cc == 0) {
#pragma unroll
        for (int i = 0; i < 8; ++i) prv[i] = 0.f;
      } else {
        unpack8(*(const uint4*)(z + (size_t)(m - 1) * ZLD + zc), prv);
      }
#pragma unroll
      for (int i = 0; i < 8; ++i) {
        float x = cur[i] + muv[i] * (prv[i] - cur[i]);
        if (gi == 3) x = 1.f - 2.f * __builtin_amdgcn_rcpf(1.f + __expf(2.f * x));
        if (gi >= 5) x = sigm(x);
        v[i] = x;
      }
      if (gi < 2) {
        float* d = FS(gi) + t * 65 + c8;
#pragma unroll
        for (int i = 0; i < 8; ++i) d[i] = v[i];
      } else if (gi == 2) {
#pragma unroll
        for (int i = 0; i < 8; ++i) VT[(c8 + i) * 72 + t] = f2bf(v[i]);
      } else if (gi == 3) { *(uint4*)(XW + t * 72 + c8) = pack8(v); }
      else if (gi == 4) { *(uint4*)(XA + t * 72 + c8) = pack8(v); }
      else { *(uint4*)(XG + t * 136 + (gi - 5) * 64 + c8) = pack8(v); }
    }
  }
  {
    uint4* d = (uint4*)WT;
    for (int e = tid; e < 1152; e += 512) d[e] = lwsrc[e];
  }
  __syncthreads();
  {
    f32x16 acc;
#pragma unroll
    for (int i = 0; i < 16; ++i) acc[i] = 0.f;
    mm_tile(grp ? XA : XW, 72, grp ? WT + 4608 : WT, 72, mt, nt, r, hf, 4, acc);
    const int j = nt * 32 + r;
    const float bias = grp ? bias_a : bias_w;
#pragma unroll
    for (int reg = 0; reg < 16; ++reg) {
      const int t = mt * 32 + ROWOFF(reg, hf);
      const float x = acc[reg] + bias;
      if (grp) FS(3)[t * 65 + j] = sigm(x);
      else {
        const float nx = -x;
        const float sp = (nx > 20.f) ? nx : __logf(1.f + __expf(nx));
        FS(4)[t * 65 + j] = -__expf(-sp - 0.5f);
      }
    }
  }
  __syncthreads();
  {
    uint4* d = (uint4*)WT;
    d[tid] = g2a; d[512 + tid] = g2b; if (tid < 64) d[1024 + tid] = g2c;
  }
  float* psum = (float*)((unsigned char*)ldsf + 147968);
  float pl[8];
  {
    const int j = tid & 63, sg = tid >> 6;
    float c = 0.f;
#pragma unroll
    for (int u = 0; u < 8; ++u) { c += FS(4)[(sg * 8 + u) * 65 + j]; pl[u] = c; }
    psum[sg * 64 + j] = c;
  }
  __syncthreads();
  {
    const int j = tid & 63, sg = tid >> 6;
    float off = 0.f, tot = 0.f;
#pragma unroll
    for (int q = 0; q < 8; ++q) { const float v = psum[q * 64 + j]; tot += v; if (q < sg) off += v; }
#pragma unroll
    for (int u = 0; u < 8; ++u) FS(2)[(sg * 8 + u) * 65 + j] = off + pl[u];
    if (sg == 0) { const float g = __expf(tot); gc[j] = g; ((float*)(p.ws + WS_GC))[(size_t)item * 64 + j] = g; }
  }
  __syncthreads();
  if (grp == 0) {
    f32x16 acc;
#pragma unroll
    for (int i = 0; i < 16; ++i) acc[i] = 0.f;
    mm_tile(XG, 136, WT, 136, mt, nt, r, hf, 8, acc);
    u16* ga = (u16*)(p.ws + WS_GA) + (size_t)item * 4096;
#pragma unroll
    for (int reg = 0; reg < 16; ++reg) ga[(mt * 32 + ROWOFF(reg, hf)) * 64 + nt * 32 + r] = f2bf(acc[reg]);
  }
  __syncthreads();
  {
    const int t = tid >> 3, j0 = (tid & 7) * 8;
    float kr[8], av[8], rv[8], kkv[8], kf[8];
    float nrm = 0.f, bdot = 0.f;
#pragma unroll
    for (int i = 0; i < 8; ++i) {
      const int j = j0 + i;
      kr[i] = FS(1)[t * 65 + j]; av[i] = FS(3)[t * 65 + j]; rv[i] = FS(0)[t * 65 + j];
      kkv[i] = kr[i] * kkw_[i];
      nrm += kkv[i] * kkv[i];
      kf[i] = kr[i] * (1.f + (av[i] - 1.f) * kaw_[i]);
      bdot += rv[i] * kf[i] * rkw_[i];
    }
    nrm += __shfl_xor(nrm, 1, 64); nrm += __shfl_xor(nrm, 2, 64); nrm += __shfl_xor(nrm, 4, 64);
    bdot += __shfl_xor(bdot, 1, 64); bdot += __shfl_xor(bdot, 2, 64); bdot += __shfl_xor(bdot, 4, 64);
    const float rn = 1.f / fmaxf(sqrtf(nrm), 1e-12f);
    float o_r[8], o_k[8], o_b[8], o_c[8], bo[8];
#pragma unroll
    for (int i = 0; i < 8; ++i) {
      const int j = j0 + i;
      const float cum = FS(2)[t * 65 + j], dl = FS(4)[t * 65 + j];
      const float eg = __expf(cum), egi = __expf(-cum), egp = __expf(cum - dl);
      const float kk = kkv[i] * rn;
      const float g = gc[j];
      o_r[i] = rv[i] * eg; o_k[i] = kf[i] * egi; o_b[i] = kk * av[i] * egi; o_c[i] = kk * egp;
      CT[j * 72 + t] = f2bf(o_c[i]);
      KHT[j * 72 + t] = f2bf(o_k[i] * g);
      FS(1)[t * 65 + j] = o_b[i] * g;
      bo[i] = bdot * bf2f(VT[j * 72 + t]);
    }
    *(uint4*)(Rn + t * 72 + j0) = pack8(o_r);
    *(uint4*)(Kn + t * 72 + j0) = pack8(o_k);
    *(uint4*)(Bn + t * 72 + j0) = pack8(o_b);
    *(uint4*)(Cn + t * 72 + j0) = pack8(o_c);
    u16* bop = (u16*)(p.ws + WS_BO) + (size_t)item * 4096;
    *(uint4*)(bop + t * 64 + j0) = pack8(bo);
  }
  __syncthreads();
  f32x16 akr;
#pragma unroll
  for (int i = 0; i < 16; ++i) akr[i] = 0.f;
  if (grp == 0) {
    f32x16 ab, abr;
#pragma unroll
    for (int i = 0; i < 16; ++i) { ab[i] = 0.f; abr[i] = 0.f; }
    mm_tile(Bn, 72, Cn, 72, mt, nt, r, hf, 4, ab);
    mm_tile(Bn, 72, Rn, 72, mt, nt, r, hf, 4, abr);
    const int t = nt * 32 + r;
#pragma unroll
    for (int reg = 0; reg < 16; ++reg) {
      const int i = mt * 32 + ROWOFF(reg, hf);
      Abp[i * 68 + t] = (i < t) ? ab[reg] : 0.f;
      FS(0)[i * 65 + t] = (i <= t) ? abr[reg] : 0.f;
    }
  } else {
    f32x16 akt;
#pragma unroll
    for (int i = 0; i < 16; ++i) akt[i] = 0.f;
    mm_tile(Cn, 72, Kn, 72, mt, nt, r, hf, 4, akt);
    {
      const int i = nt * 32 + r;
#pragma unroll
      for (int reg = 0; reg < 16; ++reg) { const int t = mt * 32 + ROWOFF(reg, hf); if (!(i < t)) akt[reg] = 0.f; }
    }
    store_T(AK, 72, mt, nt, r, hf, akt);
    mm_tile(Kn, 72, Rn, 72, mt, nt, r, hf, 4, akr);
    {
      const int t = nt * 32 + r;
#pragma unroll
      for (int reg = 0; reg < 16; ++reg) { const int i = mt * 32 + ROWOFF(reg, hf); if (!(i <= t)) akr[reg] = 0.f; }
    }
  }
  __syncthreads();
  if (tid < 128) {
    float* X_ = (tid < 64) ? FS(0) : FS(1);
    const int col = tid & 63;
    tri32(Abp + 32 * 68 + 32, X_ + 32 * 65 + col);
  }
  __syncthreads();
  {
    const int c = tid & 127, ig = tid >> 7;
    float* X_ = (c < 64) ? FS(0) : FS(1);
    const int col = c & 63;
    float a[8];
#pragma unroll
    for (int u = 0; u < 8; ++u) a[u] = 0.f;
#pragma unroll 2
    for (int t = 32; t < 64; t += 4) {
      const float x0 = X_[t * 65 + col], x1 = X_[(t + 1) * 65 + col], x2 = X_[(t + 2) * 65 + col], x3 = X_[(t + 3) * 65 + col];
#pragma unroll
      for (int u = 0; u < 8; ++u) {
        const float4 c_ = *(const float4*)(Abp + (ig * 8 + u) * 68 + t);
        a[u] += c_.x * x0 + c_.y * x1 + c_.z * x2 + c_.w * x3;
      }
    }
#pragma unroll
    for (int u = 0; u < 8; ++u) X_[(ig * 8 + u) * 65 + col] -= a[u];
  }
  __syncthreads();
  if (tid < 128) {
    float* X_ = (tid < 64) ? FS(0) : FS(1);
    const int col = tid & 63;
    tri32(Abp, X_ + col);
  }
  __syncthreads();
  {
    const int c = tid >> 2, q = tid & 3;
    const float* X_ = (c < 64) ? FS(0) : FS(1);
    const int col = c & 63;
    float o0[8], o1[8];
#pragma unroll
    for (int u = 0; u < 8; ++u) { o0[u] = -X_[(q * 16 + u) * 65 + col]; o1[u] = -X_[(q * 16 + 8 + u) * 65 + col]; }
    u16* dst = NTm + c * 72 + q * 16;
    *(uint4*)dst = pack8(o0);
    *(uint4*)(dst + 8) = pack8(o1);
  }
  __syncthreads();
  if (grp == 1) {
    mm_tile(AK, 72, NTm, 72, mt, nt, r, hf, 4, akr);
    store_T(MT, 72, mt, nt, r, hf, akr);
  } else {
    f32x16 d2;
#pragma unroll
    for (int i = 0; i < 16; ++i) d2[i] = 0.f;
    mm_tile(AK, 72, NTm + 64 * 72, 72, mt, nt, r, hf, 4, d2);
#pragma unroll
    for (int g = 0; g < 4; ++g) {
      const int idx = (nt * 32 + r) * 72 + mt * 32 + 8 * g + 4 * hf;
      const uint2 kh = *(const uint2*)(KHT + idx);
      uint2 o;
      o.x = pack2(d2[4 * g] + __uint_as_float(kh.x << 16), d2[4 * g + 1] + __uint_as_float(kh.x & 0xFFFF0000u));
      o.y = pack2(d2[4 * g + 2] + __uint_as_float(kh.y << 16), d2[4 * g + 3] + __uint_as_float(kh.y & 0xFFFF0000u));
      *(uint2*)(KQT + idx) = o;
    }
  }
  __syncthreads();
  if (grp == 0) {
    f32x16 w2, yl;
#pragma unroll
    for (int i = 0; i < 16; ++i) { w2[i] = 0.f; yl[i] = 0.f; }
    mm_tile(NTm, 72, CT, 72, mt, nt, r, hf, 4, w2);
    mm_tile(MT, 72, VT, 72, mt, nt, r, hf, 4, yl);
    u16* W2p = (u16*)(p.ws + WS_W2) + (size_t)item * 4096;
    u16* YLp = (u16*)(p.ws + WS_YL) + (size_t)item * 4096;
#pragma unroll
    for (int reg = 0; reg < 16; ++reg) {
      const int t = mt * 32 + ROWOFF(reg, hf), n = nt * 32 + r;
      W2p[t * 64 + n] = f2bf(w2[reg] + bf2f(Rn[t * 72 + n]));
      YLp[t * 64 + n] = f2bf(yl[reg]);
    }
  } else {
    f32x16 pp, qt;
#pragma unroll
    for (int i = 0; i < 16; ++i) { pp[i] = 0.f; qt[i] = 0.f; }
    mm_tile(CT, 72, NTm + 64 * 72, 72, mt, nt, r, hf, 4, pp);
    mm_tile(KQT, 72, VT, 72, mt, nt, r, hf, 4, qt);
    uint4* Pf = (uint4*)((u16*)(p.ws + WS_PP) + (size_t)item * 4096);
    float* Qf = (float*)(p.ws + WS_Q) + (size_t)item * 4096;
#pragma unroll
    for (int s2 = 0; s2 < 2; ++s2) {
      uint4 o;
      o.x = pack2(pp[s2 * 8 + 0], pp[s2 * 8 + 1]); o.y = pack2(pp[s2 * 8 + 2], pp[s2 * 8 + 3]);
      o.z = pack2(pp[s2 * 8 + 4], pp[s2 * 8 + 5]); o.w = pack2(pp[s2 * 8 + 6], pp[s2 * 8 + 7]);
      Pf[(nt * 4 + mt * 2 + s2) * 64 + lane] = o;
    }
#pragma unroll
    for (int reg = 0; reg < 16; ++reg) Qf[((nt * 2 + mt) * 16 + reg) * 64 + lane] = qt[reg];
  }
}

template <int K_> struct IC { static constexpr int value = K_; };
__device__ __forceinline__ void rwkv_scan(const Params& p, int l, int bh, float* ldsf, bool dry = false) {
  const int tid = opq(threadIdx.x), lane = tid & 63, wave = tid >> 6;
  const int b = bh >> 3, h = bh & 7;
  unsigned char* ring = (unsigned char*)ldsf + 32768;
  __syncthreads();
  {
    const float* G0 = (const float*)(p.ws + WS_GC);
    for (int e = tid; e < 8192; e += NT) ldsf[e] = G0[(size_t)((b * 128 + (e >> 6)) * 8 + h) * 64 + (e & 63)];
  }
  const bool helper = wave >= 2;
  const int ht = tid - 128;
  const u16* PPb = (const u16*)(p.ws + WS_PP);
  const float* Qb = (const float*)(p.ws + WS_Q);
  const bool isP = wave < 4;
  const int hstr = isP ? 128 : 256;
  const int hidx = isP ? (tid - 128) : (tid - 256);
  const int hdst = isP ? hidx : 512 + hidx;
#define SC_GLOAD(c, D0, D1, D2, D3) do { const size_t id_ = (size_t)((b * 128 + (c)) * 8 + h); \
    const uint4* src_ = isP ? (const uint4*)(PPb + id_ * 4096) : (const uint4*)(Qb + id_ * 4096); \
    D0 = src_[hidx]; D1 = src_[hidx + hstr]; D2 = src_[hidx + 2 * hstr]; D3 = src_[hidx + 3 * hstr]; } while (0)
#define SC_LWRITE(c, D0, D1, D2, D3) do { uint4* slot_ = (uint4*)(ring + ((c) & 1) * 24576) + hdst; \
    slot_[0] = D0; slot_[hstr] = D1; slot_[2 * hstr] = D2; slot_[3 * hstr] = D3; } while (0)
  if (helper) {
    uint4 a0, a1, a2, a3, b0, b1, b2, b3, c0_, c1_, c2_, c3_, d0, d1, d2, d3;
    SC_GLOAD(0, a0, a1, a2, a3); SC_LWRITE(0, a0, a1, a2, a3);
    SC_GLOAD(1, b0, b1, b2, b3); SC_GLOAD(2, c0_, c1_, c2_, c3_); SC_GLOAD(3, d0, d1, d2, d3);
    __syncthreads();
#pragma unroll 1
    for (int cc = 0; cc < 128; cc += 4) {
      if (cc + 4 < 128) SC_GLOAD(cc + 4, a0, a1, a2, a3);
      SC_LWRITE(cc + 1, b0, b1, b2, b3);
      asm volatile("s_waitcnt lgkmcnt(0)\n\ts_barrier" ::: "memory");
      if (cc + 5 < 128) SC_GLOAD(cc + 5, b0, b1, b2, b3);
      SC_LWRITE(cc + 2, c0_, c1_, c2_, c3_);
      asm volatile("s_waitcnt lgkmcnt(0)\n\ts_barrier" ::: "memory");
      if (cc + 6 < 128) SC_GLOAD(cc + 6, c0_, c1_, c2_, c3_);
      SC_LWRITE(cc + 3, d0, d1, d2, d3);
      asm volatile("s_waitcnt lgkmcnt(0)\n\ts_barrier" ::: "memory");
      if (cc + 7 < 128) SC_GLOAD(cc + 7, d0, d1, d2, d3);
      if (cc + 4 < 128) SC_LWRITE(cc + 4, a0, a1, a2, a3);
      asm volatile("s_waitcnt lgkmcnt(0)\n\ts_barrier" ::: "memory");
    }
    return;
  }
  __syncthreads();
  const int vt = wave & 1, hf = lane >> 5;
  f32x16 S[2];
#pragma unroll
  for (int i = 0; i < 16; ++i) { S[0][i] = 0.f; S[1][i] = 0.f; }
#pragma unroll 1
  for (int cc = 0; cc < 128; ++cc) {
    const size_t id = (size_t)((b * 128 + cc) * 8 + h);
    float* Qg = (float*)Qb + id * 4096;
    const int lofs = opq(lane);
    const uint4* slotA = (const uint4*)(ring + (cc & 1) * 24576) + lofs;
    const float* slotQ = (const float*)(ring + (cc & 1) * 24576 + 8192) + vt * 2048 + lofs;
    const float* gcp = ldsf + cc * 64 + 4 * (lofs >> 5);
    Qg += vt * 2048 + lofs;
    f32x16 acc[2];
#pragma unroll
    for (int kt = 0; kt < 2; ++kt)
#pragma unroll
      for (int reg = 0; reg < 16; ++reg)
        acc[kt][reg] = S[kt][reg] * gcp[kt * 32 + ((reg) & 3) + 8 * ((reg) >> 2)] + slotQ[(kt * 16 + reg) * 64];
#pragma unroll
    for (int kt = 0; kt < 2; ++kt)
#pragma unroll
      for (int reg = 0; reg < 16; ++reg) if (!dry) Qg[(kt * 16 + reg) * 64] = S[kt][reg];
#pragma unroll
    for (int s_ = 0; s_ < 4; ++s_) {
      const int kt = s_ >> 1, s2 = s_ & 1;
      unsigned hw[4];
#pragma unroll
      for (int j = 0; j < 4; ++j) hw[j] = pack2(S[kt][s2 * 8 + 2 * j], S[kt][s2 * 8 + 2 * j + 1]);
      union { uint4 u; bf16x8 v; } bh_;
      bh_.u = make_uint4(hw[0], hw[1], hw[2], hw[3]);
#pragma unroll
      for (int kt2 = 0; kt2 < 2; ++kt2) {
        union { uint4 u; bf16x8 v; } af; af.u = slotA[(kt2 * 4 + s_) * 64];
        acc[kt2] = __builtin_amdgcn_mfma_f32_32x32x16_bf16(af.v, bh_.v, acc[kt2], 0, 0, 0);
      }
    }
    S[0] = acc[0]; S[1] = acc[1];
    asm volatile("s_waitcnt lgkmcnt(0)\n\ts_barrier" ::: "memory");
  }
  {
    float* o = p.out + O_PWKV + ((size_t)((l * 2 + b) * 8 + h) * 64 + vt * 32 + (lane & 31)) * 64;
#pragma unroll
    for (int kt = 0; kt < 2; ++kt)
#pragma unroll
      for (int reg = 0; reg < 16; ++reg) o[kt * 32 + ROWOFF(reg, hf)] = S[kt][reg];
  }
}

__device__ __forceinline__ void rwkv_out(const Params& p, int l, int item, float* ldsf) {
  const int tid = opq(threadIdx.x), lane = tid & 63, wave = tid >> 6;
  const int h = item & 7, cidx = item >> 3;
  float* Sl = ldsf; float* Wl = ldsf + 4160;
  const float* Sg = (const float*)(p.ws + WS_Q) + (size_t)item * 4096;
  const u16* W2 = (const u16*)(p.ws + WS_W2) + (size_t)item * 4096;
  const u16* YL = (const u16*)(p.ws + WS_YL) + (size_t)item * 4096;
  const u16* BO = (const u16*)(p.ws + WS_BO) + (size_t)item * 4096;
  const u16* GA = (const u16*)(p.ws + WS_GA) + (size_t)item * 4096;
  u16* z = (u16*)(p.ws + WS_Z);
  __syncthreads();
  {
    const int row = tid >> 3, c = (tid & 7) * 8;
#pragma unroll
    for (int i = 0; i < 8; ++i) {
      const int idx = i * 512 + tid;
      const int ln = idx & 63, reg = (idx >> 6) & 15, kt = (idx >> 10) & 1, vt = idx >> 11;
      Sl[(vt * 32 + (ln & 31)) * 65 + kt * 32 + ROWOFF(reg, ln >> 5)] = Sg[idx];
    }
    float w[8];
    unpack8(*(const uint4*)(W2 + row * 64 + c), w);
    float* e = Wl + row * 65 + c;
#pragma unroll
    for (int i = 0; i < 8; ++i) e[i] = w[i];
  }
  __syncthreads();
  float y[8];
#pragma unroll
  for (int q = 0; q < 8; ++q) y[q] = bf2f(YL[(wave * 8 + q) * 64 + lane]);
#pragma unroll 2
  for (int k = 0; k < 64; ++k) {
    const float s = Sl[lane * 65 + k];
#pragma unroll
    for (int q = 0; q < 8; ++q) y[q] += s * Wl[(wave * 8 + q) * 65 + k];
  }
  const float lng = p.in[18][l * 512 + h * 64 + lane], lnb = p.in[19][l * 512 + h * 64 + lane];
#pragma unroll
  for (int q = 0; q < 8; ++q) {
    const int t = wave * 8 + q;
    const float mean = wave_sum(y[q]) * (1.f / 64.f);
    const float d = y[q] - mean;
    const float var = wave_sum(d * d) * (1.f / 64.f);
    const float yn = d * rsqrtf(var + 64e-5f) * lng + lnb;
    const float o = (yn + bf2f(BO[t * 64 + lane])) * bf2f(GA[t * 64 + lane]);
    z[(size_t)(cidx * 64 + t) * ZLD + h * 64 + lane] = f2bf(o);
  }
}

__device__ __forceinline__ void rwkv_out4(const Params& p, int l, int item0, float* ldsf) {
  const int tid = opq(threadIdx.x), lane = tid & 63, wave = tid >> 6;
  const int r = lane & 31, hf = lane >> 5;
  const int pair = wave >> 1, nt = wave & 1;
  const int item = item0 + pair;
  const int h = item & 7, cidx = item >> 3;
  u16* Sl = (u16*)ldsf + pair * 4608;
  const float* Sg = (const float*)(p.ws + WS_Q) + (size_t)item * 4096;
  const u16* W2 = (const u16*)(p.ws + WS_W2) + (size_t)item * 4096;
  const u16* YL = (const u16*)(p.ws + WS_YL) + (size_t)item * 4096;
  const u16* BO = (const u16*)(p.ws + WS_BO) + (size_t)item * 4096;
  const u16* GA = (const u16*)(p.ws + WS_GA) + (size_t)item * 4096;
  u16* z = (u16*)(p.ws + WS_Z);
  __syncthreads();
  {
    const int lt = tid & 127;
#pragma unroll
    for (int q = 0; q < 8; ++q) {
      const int e = q * 128 + lt;
      const int ln = e & 63, g = (e >> 6) & 3, kt = (e >> 8) & 1, vt = (e >> 9) & 1;
      const float* sp = Sg + ((vt * 2 + kt) * 16 + 4 * g) * 64 + ln;
      const float a0 = sp[0], a1 = sp[64], a2 = sp[128], a3 = sp[192];
      uint2 o; o.x = pack2(a0, a1); o.y = pack2(a2, a3);
      *(uint2*)(Sl + (vt * 32 + (ln & 31)) * 72 + kt * 32 + 8 * g + 4 * (ln >> 5)) = o;
    }
  }
  bf16x8 bfr[4];
#pragma unroll
  for (int s_ = 0; s_ < 4; ++s_) bfr[s_] = *(const bf16x8*)(W2 + (nt * 32 + r) * 64 + s_ * 16 + hf * 8);
  __syncthreads();
  f32x16 acc[2];
#pragma unroll
  for (int mt = 0; mt < 2; ++mt) {
#pragma unroll
    for (int i = 0; i < 16; ++i) acc[mt][i] = 0.f;
#pragma unroll
    for (int s_ = 0; s_ < 4; ++s_) {
      const bf16x8 a = *(const bf16x8*)(Sl + (mt * 32 + r) * 72 + s_ * 16 + hf * 8);
      acc[mt] = __builtin_amdgcn_mfma_f32_32x32x16_bf16(a, bfr[s_], acc[mt], 0, 0, 0);
    }
  }
  const int t = nt * 32 + r;
  float sum = 0.f;
#pragma unroll
  for (int mt = 0; mt < 2; ++mt)
#pragma unroll
    for (int g = 0; g < 4; ++g) {
      const uint2 yl = *(const uint2*)(YL + t * 64 + mt * 32 + 8 * g + 4 * hf);
      acc[mt][4 * g + 0] += __uint_as_float(yl.x << 16); acc[mt][4 * g + 1] += __uint_as_float(yl.x & 0xFFFF0000u);
      acc[mt][4 * g + 2] += __uint_as_float(yl.y << 16); acc[mt][4 * g + 3] += __uint_as_float(yl.y & 0xFFFF0000u);
      sum += acc[mt][4 * g] + acc[mt][4 * g + 1] + acc[mt][4 * g + 2] + acc[mt][4 * g + 3];
    }
  sum += __shfl_xor(sum, 32, 64);
  const float mean = sum * (1.f / 64.f);
  float vs = 0.f;
#pragma unroll
  for (int mt = 0; mt < 2; ++mt)
#pragma unroll
    for (int i = 0; i < 16; ++i) { const float d = acc[mt][i] - mean; vs += d * d; }
  vs += __shfl_xor(vs, 32, 64);
  const float rstd = rsqrtf(vs * (1.f / 64.f) + 64e-5f);
  const float* lng = p.in[18] + l * 512 + h * 64;
  const float* lnb = p.in[19] + l * 512 + h * 64;
  u16* zrow = z + (size_t)(cidx * 64 + t) * ZLD + h * 64;
#pragma unroll
  for (int mt = 0; mt < 2; ++mt)
#pragma unroll
    for (int g = 0; g < 4; ++g) {
      const int v0 = mt * 32 + 8 * g + 4 * hf;
      const uint2 bo = *(const uint2*)(BO + t * 64 + v0);
      const uint2 ga = *(const uint2*)(GA + t * 64 + v0);
      const float4 lg = *(const float4*)(lng + v0), lb = *(const float4*)(lnb + v0);
      const float bo_[4] = {__uint_as_float(bo.x << 16), __uint_as_float(bo.x & 0xFFFF0000u), __uint_as_float(bo.y << 16), __uint_as_float(bo.y & 0xFFFF0000u)};
      const float ga_[4] = {__uint_as_float(ga.x << 16), __uint_as_float(ga.x & 0xFFFF0000u), __uint_as_float(ga.y << 16), __uint_as_float(ga.y & 0xFFFF0000u)};
      const float lg_[4] = {lg.x, lg.y, lg.z, lg.w}, lb_[4] = {lb.x, lb.y, lb.z, lb.w};
      float o[4];
#pragma unroll
      for (int u = 0; u < 4; ++u) o[u] = ((acc[mt][4 * g + u] - mean) * rstd * lg_[u] + lb_[u] + bo_[u]) * ga_[u];
      uint2 ov; ov.x = pack2(o[0], o[1]); ov.y = pack2(o[2], o[3]);
      *(uint2*)(zrow + v0) = ov;
    }
}

__device__ __forceinline__ void attn_prompt(const Params& p, int l, int item, u16* lds, bool dry = false) {
  const int tid = opq(threadIdx.x), lane = tid & 63, wave = tid >> 6;
  const int r = lane & 31, h = lane >> 5;
  const int kvh = item & 1, n = (item >> 1) & 63, b = item >> 7;
  u16* z = (u16*)(p.ws + WS_Z);
  u16* Ks = lds;
  u16* Vt = lds + 256 * 72;
  __syncthreads();
  {
    const int key = tid >> 1, half = tid & 1;
    const int t = (n - 1) * 128 + key;
    uint4 kv[4], vv[4];
    if (t >= 0) {
      const u16* kp = z + (size_t)(b * 8192 + t) * ZLD + 2304 + kvh * 64 + half * 32;
      const u16* vp = z + (size_t)(b * 8192 + t) * ZLD + 2432 + kvh * 64 + half * 32;
#pragma unroll
      for (int i = 0; i < 4; ++i) { kv[i] = *(const uint4*)(kp + i * 8); vv[i] = *(const uint4*)(vp + i * 8); }
    } else {
#pragma unroll
      for (int i = 0; i < 4; ++i) { kv[i] = make_uint4(0, 0, 0, 0); vv[i] = make_uint4(0, 0, 0, 0); }
    }
#pragma unroll
    for (int i = 0; i < 4; ++i) {
      *(uint4*)(Ks + key * 72 + half * 32 + i * 8) = kv[i];
      const unsigned w[4] = {vv[i].x, vv[i].y, vv[i].z, vv[i].w};
#pragma unroll
      for (int q = 0; q < 4; ++q) {
        const int d = half * 32 + i * 8 + q * 2;
        Vt[d * 264 + key] = (u16)(w[q] & 0xFFFFu);
        Vt[(d + 1) * 264 + key] = (u16)(w[q] >> 16);
      }
    }
  }
  __syncthreads();
#pragma unroll 1
  for (int uu = 0; uu < 2; ++uu) {
    const int u = wave * 2 + uu;
    const int hq = kvh * 4 + (u >> 2), qg = u & 3;
    const int qrow = b * 8192 + n * 128 + qg * 32 + r;
    u16* qp = z + (size_t)qrow * ZLD + 1792 + hq * 64;
    bf16x8 qf[4];
#pragma unroll
    for (int s = 0; s < 4; ++s) qf[s] = *(const bf16x8*)(qp + s * 16 + h * 8);
    f32x16 sc[5];
#pragma unroll
    for (int i5 = 0; i5 < 5; ++i5) {
#pragma unroll
      for (int i = 0; i < 16; ++i) sc[i5][i] = 0.f;
      const int kt = qg + i5;
#pragma unroll
      for (int s = 0; s < 4; ++s) {
        bf16x8 kf = *(const bf16x8*)(Ks + (kt * 32 + r) * 72 + s * 16 + h * 8);
        sc[i5] = __builtin_amdgcn_mfma_f32_32x32x16_bf16(kf, qf[s], sc[i5], 0, 0, 0);
      }
      __builtin_amdgcn_sched_barrier(0);
    }
    const int qi = qg * 32 + r;
    const float sink = p.in[20][l * 8 + hq];
    float mx = -1e30f;
#pragma unroll
    for (int i5 = 0; i5 < 5; ++i5)
#pragma unroll
      for (int reg = 0; reg < 16; ++reg) {
        const int j = (qg + i5) * 32 + ROWOFF(reg, h);
        const bool ok = (j > qi) && (j <= qi + 128) && (n > 0 || j >= 128);
        const float s = ok ? sc[i5][reg] * 0.125f : -1e30f;
        sc[i5][reg] = s;
        mx = fmaxf(mx, s);
      }
    mx = fmaxf(mx, __shfl_xor(mx, 32, 64));
    mx = fmaxf(mx, sink);
    float sum = 0.f;
#pragma unroll
    for (int i5 = 0; i5 < 5; ++i5)
#pragma unroll
      for (int reg = 0; reg < 16; ++reg) { const float e = __expf(sc[i5][reg] - mx); sc[i5][reg] = e; sum += e; }
    sum += __shfl_xor(sum, 32, 64);
    const float rden = 1.f / (sum + __expf(sink - mx));
    f32x16 oacc[2];
#pragma unroll
    for (int i = 0; i < 16; ++i) { oacc[0][i] = 0.f; oacc[1][i] = 0.f; }
#pragma unroll
    for (int i5 = 0; i5 < 5; ++i5) {
      const int kt = qg + i5;
#pragma unroll
      for (int s2 = 0; s2 < 2; ++s2) {
        bf16x8 pf;
#pragma unroll
        for (int j = 0; j < 8; ++j) pf[j] = (short)f2bf(sc[i5][s2 * 8 + j] * rden);
#pragma unroll
        for (int dt = 0; dt < 2; ++dt) {
          const u16* vp = Vt + (dt * 32 + r) * 264 + kt * 32 + s2 * 16 + h * 4;
          const uint2 lo = *(const uint2*)vp, hi = *(const uint2*)(vp + 8);
          union { uint4 u; bf16x8 v; } cv;
          cv.u = make_uint4(lo.x, lo.y, hi.x, hi.y);
          oacc[dt] = __builtin_amdgcn_mfma_f32_32x32x16_bf16(cv.v, pf, oacc[dt], 0, 0, 0);
        }
        __builtin_amdgcn_sched_barrier(0);
      }
    }
#pragma unroll
    for (int dt = 0; dt < 2; ++dt)
#pragma unroll
      for (int g4 = 0; g4 < 4; ++g4) {
        const int d = dt * 32 + 8 * g4 + 4 * h;
        uint2 o;
        o.x = pack2(oacc[dt][g4 * 4 + 0], oacc[dt][g4 * 4 + 1]);
        o.y = pack2(oacc[dt][g4 * 4 + 2], oacc[dt][g4 * 4 + 3]);
        if (!dry) *(uint2*)(qp + d) = o;
      }
  }
}

__device__ __forceinline__ void attn_sample(const Params& p, int l, int item, float* ldsf, bool dry = false) {
  const int tid = opq(threadIdx.x);
  const int kvh = item & 1, b = item >> 1;
  u16* z = (u16*)(p.ws + WS_Z);
  float* Kl = ldsf;
  float* Vl = ldsf + 132 * 65;
  float* Ql = Vl + 132 * 65;
  float* Pl = Ql + 16 * 64;
  __syncthreads();
  for (int e = tid; e < 132 * 8; e += NT) {
    const int j = e >> 3, c = (e & 7) * 8;
    float k[8], v[8];
    if (j < 128) {
      const float* kp = p.in[4] + ((size_t)((l * 128 + b) * 128 + j) * 2 + kvh) * 64 + c;
      const float* vp = p.in[5] + ((size_t)((l * 128 + b) * 128 + j) * 2 + kvh) * 64 + c;
      float4 a = *(const float4*)kp, a2 = *(const float4*)(kp + 4);
      float4 c1 = *(const float4*)vp, c2 = *(const float4*)(vp + 4);
      k[0] = a.x; k[1] = a.y; k[2] = a.z; k[3] = a.w; k[4] = a2.x; k[5] = a2.y; k[6] = a2.z; k[7] = a2.w;
      v[0] = c1.x; v[1] = c1.y; v[2] = c1.z; v[3] = c1.w; v[4] = c2.x; v[5] = c2.y; v[6] = c2.z; v[7] = c2.w;
    } else {
      const size_t row = M_P + b * 4 + (j - 128);
      unpack8(*(const uint4*)(z + row * ZLD + 2304 + kvh * 64 + c), k);
      unpack8(*(const uint4*)(z + row * ZLD + 2432 + kvh * 64 + c), v);
    }
#pragma unroll
    for (int i = 0; i < 8; ++i) { Kl[j * 65 + c + i] = k[i]; Vl[j * 65 + c + i] = v[i]; }
    if (j >= 4) {
      float* ok = p.out + O_SK + ((size_t)((l * 128 + b) * 128 + (j - 4)) * 2 + kvh) * 64 + c;
      float* ov = p.out + O_SV + ((size_t)((l * 128 + b) * 128 + (j - 4)) * 2 + kvh) * 64 + c;
      *(float4*)ok = make_float4(k[0], k[1], k[2], k[3]); *(float4*)(ok + 4) = make_float4(k[4], k[5], k[6], k[7]);
      *(float4*)ov = make_float4(v[0], v[1], v[2], v[3]); *(float4*)(ov + 4) = make_float4(v[4], v[5], v[6], v[7]);
    }
  }
  if (tid < 128) {
    const int row = tid >> 3, c = (tid & 7) * 8;
    const int hl = row >> 2, t = row & 3;
    float q[8];
    unpack8(*(const uint4*)(z + (size_t)(M_P + b * 4 + t) * ZLD + 1792 + (kvh * 4 + hl) * 64 + c), q);
#pragma unroll
    for (int i = 0; i < 8; ++i) Ql[row * 64 + c + i] = q[i];
  }
  __syncthreads();
  const int row = tid >> 5, jl = tid & 31;
  const int t = row & 3, hq = kvh * 4 + (row >> 2);
  float sc[5];
  float mx = -1e30f;
#pragma unroll
  for (int jj = 0; jj < 5; ++jj) {
    const int j = jl + 32 * jj;
    float s = -1e30f;
    if (j < 132 && j > t && j <= t + 128) {
      float a = 0.f;
#pragma unroll 8
      for (int d = 0; d < 64; ++d) a += Ql[row * 64 + d] * Kl[j * 65 + d];
      s = a * 0.125f;
    }
    sc[jj] = s; mx = fmaxf(mx, s);
    __builtin_amdgcn_sched_barrier(0);
  }
#pragma unroll
  for (int o = 16; o >= 1; o >>= 1) mx = fmaxf(mx, __shfl_xor(mx, o, 64));
  const float sink = p.in[20][l * 8 + hq];
  mx = fmaxf(mx, sink);
  float sum = 0.f;
#pragma unroll
  for (int jj = 0; jj < 5; ++jj) { sc[jj] = __expf(sc[jj] - mx); sum += sc[jj]; }
#pragma unroll
  for (int o = 16; o >= 1; o >>= 1) sum += __shfl_xor(sum, o, 64);
  const float rden = 1.f / (sum + __expf(sink - mx));
#pragma unroll
  for (int jj = 0; jj < 5; ++jj) { const int j = jl + 32 * jj; if (j < 136) Pl[row * 136 + j] = sc[jj] * rden; }
  __syncthreads();
  {
    const int d = jl * 2;
    float o0 = 0.f, o1 = 0.f;
#pragma unroll 4
    for (int j = 0; j < 132; ++j) { const float pr = Pl[row * 136 + j]; o0 += pr * Vl[j * 65 + d]; o1 += pr * Vl[j * 65 + d + 1]; }
    if (!dry) *(unsigned*)(z + (size_t)(M_P + b * 4 + t) * ZLD + 1792 + hq * 64 + d) = pack2(o0, o1);
  }
}

__device__ __forceinline__ void phase_convgelu(const Params& p, int l, bool dry = false) {
  u16* cu = (u16*)(p.ws + WS_CU);
  const float* cw = p.in[26] + (size_t)l * 3 * 2816;
  const float* cb = p.in[27] + (size_t)l * 2816;
  for (int it = blockIdx.x; it < 1056; it += gridDim.x) {
    const int tid = opq(threadIdx.x);
    if (tid >= 352) continue;
    const int j0 = tid * 8;
    float w0[8], w1[8], w2[8], bb[8];
#pragma unroll
    for (int i = 0; i < 8; ++i) { w0[i] = cw[j0 + i]; w1[i] = cw[2816 + j0 + i]; w2[i] = cw[5632 + j0 + i]; bb[i] = cb[j0 + i]; }
    float c1[8], c2[8];
    for (int rr = 0; rr < 16; ++rr) {
      const int row = it * 16 + rr;
      const bool prompt = row < M_P;
      int b, t;
      if (prompt) { b = row >> 13; t = row & 8191; } else { b = (row - M_P) >> 2; t = (row - M_P) & 3; }
      if (t == 0) {
        if (prompt) {
#pragma unroll
          for (int i = 0; i < 8; ++i) { c1[i] = 0.f; c2[i] = 0.f; }
        } else {
          const float* st = p.in[6] + (size_t)((l * 128 + b) * 2) * 2816 + j0;
#pragma unroll
          for (int i = 0; i < 8; ++i) { c2[i] = st[i]; c1[i] = st[2816 + i]; }
        }
      } else if (rr == 0) {
        unpack8(*(const uint4*)(cu + (size_t)(row - 1) * 5632 + j0), c1);
        if (t >= 2) unpack8(*(const uint4*)(cu + (size_t)(row - 2) * 5632 + j0), c2);
        else {
#pragma unroll
          for (int i = 0; i < 8; ++i) c2[i] = 0.f;
        }
      }
      float c0[8], up[8], a[8];
      unpack8(*(const uint4*)(cu + (size_t)row * 5632 + j0), c0);
      unpack8(*(const uint4*)(cu + (size_t)row * 5632 + 2816 + j0), up);
#pragma unroll
      for (int i = 0; i < 8; ++i) {
        const float cv = bb[i] + w0[i] * c2[i] + w1[i] * c1[i] + w2[i] * c0[i];
        a[i] = gelu_fast(cv) * up[i];
      }
      if (!dry) *(uint4*)(cu + (size_t)row * 5632 + 2816 + j0) = pack8(a);
      if (prompt && t >= 8190) {
        float* o = p.out + O_PCONV + (size_t)((l * 2 + b) * 2 + (t - 8190)) * 2816 + j0;
        *(float4*)o = make_float4(c0[0], c0[1], c0[2], c0[3]); *(float4*)(o + 4) = make_float4(c0[4], c0[5], c0[6], c0[7]);
      } else if (!prompt && t >= 2) {
        float* o = p.out + O_SCONV + (size_t)((l * 128 + b) * 2 + (t - 2)) * 2816 + j0;
        *(float4*)o = make_float4(c0[0], c0[1], c0[2], c0[3]); *(float4*)(o + 4) = make_float4(c0[4], c0[5], c0[6], c0[7]);
      }
#pragma unroll
      for (int i = 0; i < 8; ++i) { c2[i] = c1[i]; c1[i] = c0[i]; }
    }
  }
}

__device__ __forceinline__ void phase_final(const Params& p) {
  float* X = p.out;
  const float* g = p.in[29];
  for (int it = blockIdx.x; it < 2112; it += gridDim.x) {
    const int tid = opq(threadIdx.x);
    const int lane = tid & 63;
    const int row = it * 8 + (tid >> 6);
    float4 v[4];
    float ss = 0.f;
#pragma unroll
    for (int i = 0; i < 4; ++i) {
      v[i] = *(const float4*)(X + (size_t)row * 1024 + i * 256 + lane * 4);
      if (gridDim.x == 256 && row >= M_P) {
        const u16* partb = (const u16*)(p.ws + WS_DP) + (size_t)(row - M_P) * 1024 + i * 256 + lane * 4;
        for (int k = 0; k < 11; ++k) { const uint2 q = *(const uint2*)(partb + (size_t)k * 512 * 1024);
          v[i].x += __uint_as_float(q.x << 16); v[i].y += __uint_as_float(q.x & 0xFFFF0000u); v[i].z += __uint_as_float(q.y << 16); v[i].w += __uint_as_float(q.y & 0xFFFF0000u); }
      }
      ss += v[i].x * v[i].x + v[i].y * v[i].y + v[i].z * v[i].z + v[i].w * v[i].w;
    }
    ss = wave_sum(ss);
    const float rs = rsqrtf(ss * (1.f / 1024.f) + 1e-6f);
#pragma unroll
    for (int i = 0; i < 4; ++i) {
      const float4 gg = *(const float4*)(g + i * 256 + lane * 4);
      *(float4*)(X + (size_t)row * 1024 + i * 256 + lane * 4) =
          make_float4(v[i].x * rs * gg.x, v[i].y * rs * gg.y, v[i].z * rs * gg.z, v[i].w * rs * gg.w);
    }
  }
}

#define XB_TMO      128
#define XB_XCNT(j)  (256  + 64 * (j))
#define XB_XSUB(j)  (1280 + 64 * (j))
#define XB_XGEN(j)  (2304 + 64 * (j))
#define XB_TOP      3328
#define XB_TOPGEN   3392
#define XCD_BAR_WORDS 3456
#define XB_SPIN_CAP (1u << 18)
#define LAS __attribute__((address_space(3)))

__device__ __forceinline__ unsigned xb_ld(unsigned* p)              { return __hip_atomic_load(p, __ATOMIC_RELAXED, __HIP_MEMORY_SCOPE_AGENT); }
__device__ __forceinline__ unsigned xb_add(unsigned* p, unsigned v) { return __hip_atomic_fetch_add(p, v, __ATOMIC_RELAXED, __HIP_MEMORY_SCOPE_AGENT); }
__device__ __forceinline__ unsigned xb_xcc_id() { return (unsigned)__builtin_amdgcn_s_getreg((3 << 11) | 20) & 0xFu; }
#define XB_SPIN(cond, bar) do { unsigned _sp = 0; while (cond) { __builtin_amdgcn_s_sleep(1); \
    if ((++_sp & 255u) == 0u) { if (xb_ld(&(bar)[XB_TMO])) break; if (_sp > XB_SPIN_CAP) { atomicAdd(&(bar)[XB_TMO], 1u); break; } } } } while (0)

struct XcdBarrier {
    unsigned* bar; unsigned x;
    volatile LAS unsigned* st;
};

__device__ __forceinline__ XcdBarrier xcd_barrier_post(unsigned* bar, volatile LAS unsigned* st) {
    XcdBarrier b; b.bar = bar; b.x = xb_xcc_id(); b.st = st;
    if (threadIdx.x == 0) (void)xb_add(&bar[XB_XCNT(b.x)], 1u);
    return b;
}
__device__ __forceinline__ void xcd_barrier_complete(unsigned* bar, unsigned x, unsigned& nloc, unsigned& nx) {
    const unsigned G = gridDim.x * gridDim.y * gridDim.z;
    unsigned sum, cnt, mine, sp = 0u;
    for (;;) {
        sum = 0u; cnt = 0u; mine = 0u;
#pragma unroll
        for (unsigned j = 0; j < 16; ++j) { const unsigned c = xb_ld(&bar[XB_XCNT(j)]); sum += c; cnt += (c > 0u) ? 1u : 0u; mine = (j == x) ? c : mine; }
        if (sum == G) break;
        __builtin_amdgcn_s_sleep(1);
        if ((++sp & 255u) == 0u) { if (xb_ld(&bar[XB_TMO])) break; if (sp > XB_SPIN_CAP) { atomicAdd(&bar[XB_TMO], 1u); break; } }
    }
    nloc = mine > 0u ? mine : 1u; nx = cnt > 0u ? cnt : 1u;
}

__device__ __forceinline__ void xcd_barrier(const XcdBarrier& b) {
    asm volatile("s_waitcnt vmcnt(0)" ::: "memory");
    __syncthreads();
    if (threadIdx.x == 0) {
        unsigned* bar = b.bar;
        __builtin_amdgcn_s_waitcnt(0);
        unsigned nloc = b.st[0], nx = b.st[1];
        if (nloc == 0u) { xcd_barrier_complete(bar, b.x, nloc, nx); b.st[0] = nloc; b.st[1] = nx; }
        const unsigned old = xb_add(&bar[XB_XSUB(b.x)], 1u);
        const unsigned gen = old / nloc;
        if (old + 1u == (gen + 1u) * nloc) {
            __builtin_amdgcn_fence(__ATOMIC_RELEASE, "agent");
            asm volatile("s_waitcnt vmcnt(0)" ::: "memory");
            const unsigned og = xb_add(&bar[XB_TOP], 1u);
            const unsigned tg = og / nx;
            if (og + 1u == (tg + 1u) * nx) xb_add(&bar[XB_TOPGEN], 1u);
            else XB_SPIN(xb_ld(&bar[XB_TOPGEN]) == tg, bar);
            __builtin_amdgcn_fence(__ATOMIC_ACQUIRE, "agent");
            xb_add(&bar[XB_XGEN(b.x)], 1u);
            asm volatile("s_waitcnt vmcnt(0)" ::: "memory");
        } else {
            XB_SPIN(xb_ld(&bar[XB_XGEN(b.x)]) == gen, bar);
            __builtin_amdgcn_fence(__ATOMIC_ACQUIRE, "agent");
            asm volatile("s_waitcnt vmcnt(0)" ::: "memory");
        }
    }
    __syncthreads();
}

#define WS_BAR 256000000ull
#if COOP
#ifndef SYNC_RPT
#define SYNC_RPT 1
#endif
#define PH_SYNC(idx) do { if ((idx) + 1 < ph_hi && (idx) >= ph_lo) { for (int sr_ = 0; sr_ < SYNC_RPT; ++sr_) xcd_barrier(xb); } } while (0)
#else
#define PH_SYNC(idx) do { } while (0)
#endif
#define PH_ON(idx, bit) (((KMASK >> (bit)) & 1) && ph_lo <= (idx) && (idx) < ph_hi)

__device__ __forceinline__ Params load_params() {
  auto kp0 = __builtin_amdgcn_kernarg_segment_ptr();
  asm volatile("" : "+s"(kp0));
  auto kq = (const __constant__ unsigned long long*)kp0;
  Params p;
#pragma unroll
  for (int i = 0; i < 30; ++i) p.in[i] = (const float*)kq[i];
  p.out = (float*)kq[30];
  p.ws = (unsigned char*)kq[31];
  p.ph_lo = 0; p.ph_hi = 0;
  return p;
}

template <int KMASK, int l>
__device__ __forceinline__ void layer_phases(int ph_lo, int ph_hi, unsigned char* lds_raw, const XcdBarrier& xb) {
  float* ldsf = (float*)lds_raw;
  u16* ldsh = (u16*)lds_raw;
  const int base = l * 12;
  if (PH_ON(base + 0, 0)) { const Params p = load_params(); RPT(0) phase_prep(p, l, 0, ldsf); }
  PH_SYNC(base + 0);
  if (PH_ON(base + 1, 1)) {
    const Params p = load_params();
    EpiInproj E; E.z = (u16*)(p.ws + WS_Z); E.out = p.out; E.l = l;
    RPT(1) run_gemm(lds_raw, (const u16*)(p.ws + WS_H), 1024, (const u16*)(p.ws + WS_WT) + WT_IN, 2560, 1024, E);
  }
  PH_SYNC(base + 1);
  if (PH_ON(base + 2, 2)) {
    const Params p = load_params();
    for (int it = blockIdx.x; it < 264; it += gridDim.x) rope_item(p, l, it, false);
    if (blockIdx.x < 64) rwkv_item(p, l, 2048 + blockIdx.x, ldsf, false);
    {
      const Params p2 = load_params();
      int i0, n;
      if (gridDim.x == 256) { if (blockIdx.x < 64) { i0 = blockIdx.x * 5; n = 5; } else { i0 = 320 + (blockIdx.x - 64) * 9; n = 9; } }
      else { i0 = 0; n = 0; }
      RPT(2) {
        if (gridDim.x == 256) { for (int i = 0; i < n; ++i) rwkv_item2(p2, l, i0 + i, ldsf); }
        else { for (int it = blockIdx.x; it < 2048; it += gridDim.x) rwkv_item2(p2, l, it, ldsf); }
      }
    }
  }
  PH_SYNC(base + 2);
  if (PH_ON(base + 3, 3)) {
    const Params p = load_params();
    if (blockIdx.x < 16) { RPT(3) rwkv_scan(p, l, blockIdx.x, ldsf, DRY(3)); }
    else {
      RPT(15) for (int it = blockIdx.x - 16; it < 512; it += gridDim.x - 16) {
        if (it < 256) attn_prompt(p, l, it, ldsh, DRY(15)); else attn_sample(p, l, it - 256, ldsf, DRY(15));
      }
    }
  }
  PH_SYNC(base + 3);
  if (PH_ON(base + 4, 4)) {
    const Params p = load_params();
    RPT(4) for (int it = blockIdx.x * 4; it < 2048; it += gridDim.x * 4) rwkv_out4(p, l, it, ldsf);
  }
  PH_SYNC(base + 4);
  if (PH_ON(base + 5, 5)) {
    const Params p = load_params();
    EpiStoreBf16 E1; E1.O = (u16*)(p.ws + WS_T1); E1.ldc = 1024; E1.rowoff = 0;
    EpiStoreBf16 E2; E2.O = (u16*)(p.ws + WS_T2); E2.ldc = 1024; E2.rowoff = 0;
    const u16* zA = (const u16*)(p.ws + WS_Z);
    const u16* Wr = (const u16*)(p.ws + WS_WT) + WT_BRA;
    const u16* Wa = (const u16*)(p.ws + WS_WT) + WT_BRB;
    RPT(5) {
      if (gridDim.x == 256) {
        run_gemm_ex(lds_raw, zA, ZLD, Wr, 512, M_P, 1024, 512, 256, (int)blockIdx.x, E1);
        run_gemm_ex(lds_raw, zA + 1792, ZLD, Wa, 512, M_P, 1024, 512, 256, (int)blockIdx.x, E2);
        EpiStoreBf16 E3 = (blockIdx.x < 8) ? E1 : E2; E3.rowoff = M_P;
        run_gemm_ex(lds_raw, zA + (size_t)M_P * ZLD + ((blockIdx.x < 8) ? 0 : 1792), ZLD, (blockIdx.x < 8) ? Wr : Wa, 512, 512, 1024, 512, 8,
                    (blockIdx.x < 16) ? (int)(blockIdx.x & 7) : -1, E3);
      } else {
        run_gemm(lds_raw, zA, ZLD, Wr, 1024, 512, E1);
        run_gemm(lds_raw, zA + 1792, ZLD, Wa, 1024, 512, E2);
      }
    }
  }
  PH_SYNC(base + 5);
  if (PH_ON(base + 6, 6)) {
    const Params p = load_params();
    EpiMerge E; E.t1 = (const u16*)(p.ws + WS_T1); E.t2 = (const u16*)(p.ws + WS_T2); E.mg = (u16*)(p.ws + WS_MG);
    RPT(6) run_gemm(lds_raw, (const u16*)(p.ws + WS_H), 1024, (const u16*)(p.ws + WS_WT) + WT_G, 2048, 1024, E);
  }
  PH_SYNC(base + 6);
  if (PH_ON(base + 7, 7)) {
    const Params p = load_params();
    EpiResid E; E.X = p.out;
    RPT(7) {
      E.dry = DRY(7); E.X = p.out; E.pbf = nullptr;
      if (gridDim.x == 256) {
        E.atomic = false; E.rowoff = 0;
        run_gemm_ex(lds_raw, (const u16*)(p.ws + WS_MG), 1024, (const u16*)(p.ws + WS_WT) + WT_OUT, 1024, M_P, 1024, 1024, 256, (int)blockIdx.x, E);
        const int ks = blockIdx.x >> 3;
        E.atomic = true; E.rowoff = 0; E.X = (float*)(p.ws + WS_T1) + (size_t)ks * 512 * 1024;
        run_gemm_ex(lds_raw, (const u16*)(p.ws + WS_MG) + (size_t)M_P * 1024 + ks * 256, 1024, (const u16*)(p.ws + WS_WT) + WT_OUT + ks * 256, 1024,
                    512, 1024, 256, 8, (blockIdx.x < 32) ? (int)(blockIdx.x & 7) : -1, E);
      } else {
        E.atomic = false; E.rowoff = 0;
        run_gemm(lds_raw, (const u16*)(p.ws + WS_MG), 1024, (const u16*)(p.ws + WS_WT) + WT_OUT, 1024, 1024, E);
      }
    }
  }
  PH_SYNC(base + 7);
  if (PH_ON(base + 8, 8)) { const Params p = load_params(); RPT(8) phase_prep(p, l, 1, ldsf); }
  PH_SYNC(base + 8);
  if (PH_ON(base + 9, 9)) {
    const Params p = load_params();
    EpiFfnIn E; E.cu = (u16*)(p.ws + WS_CU);
    RPT(9) run_gemm(lds_raw, (const u16*)(p.ws + WS_H), 1024, (const u16*)(p.ws + WS_WTF) + WT_FIN, 5632, 1024, E);
  }
  PH_SYNC(base + 9);
  if (PH_ON(base + 10, 10)) { const Params p = load_params(); RPT(10) phase_convgelu(p, l, DRY(10)); }
  PH_SYNC(base + 10);
  if (PH_ON(base + 11, 11)) {
    const Params p = load_params();
    EpiResid E; E.X = p.out;
    RPT(11) {
      E.dry = DRY(11); E.X = p.out; E.pbf = nullptr;
      const u16* Aa = (const u16*)(p.ws + WS_CU) + 2816;
      const u16* Bd = (const u16*)(p.ws + WS_WTF) + WT_FDN;
      if (gridDim.x == 256) {
        E.atomic = false; E.rowoff = 0;
        run_gemm_ex(lds_raw, Aa, 5632, Bd, 2816, M_P, 1024, 2816, 256, (int)blockIdx.x, E);
        const int ks = blockIdx.x >> 3;
        E.atomic = true; E.rowoff = 0; E.X = nullptr; E.pbf = (u16*)(p.ws + WS_DP) + (size_t)ks * 512 * 1024;
        run_gemm_ex(lds_raw, Aa + (size_t)M_P * 5632 + ks * 256, 5632, Bd + ks * 256, 2816, 512, 1024, 256, 8, (blockIdx.x < 88) ? (int)(blockIdx.x & 7) : -1, E);
      } else {
        E.atomic = false; E.rowoff = 0;
        run_gemm(lds_raw, Aa, 5632, Bd, 1024, 2816, E);
      }
    }
  }
  PH_SYNC(base + 11);
}

template <int KMASK>
__global__ void __launch_bounds__(NT) fwd_kernel(Params pin) {
  extern __shared__ __attribute__((aligned(16))) unsigned char lds_raw[];
  const int ph_lo = pin.ph_lo, ph_hi = pin.ph_hi;
  XcdBarrier xb;
  {
    volatile LAS unsigned* st = (volatile LAS unsigned*)(lds_raw + (LDS_BYTES - 16));
    if (threadIdx.x < 2) st[threadIdx.x] = 0u;
    __syncthreads();
    xb = xcd_barrier_post((unsigned*)(pin.ws + WS_BAR), st);
  }
  if (ph_hi > 100000) cg::this_grid().sync();
  layer_phases<KMASK, 0>(ph_lo, ph_hi, lds_raw, xb);
  layer_phases<KMASK, 1>(ph_lo, ph_hi, lds_raw, xb);
  if (PH_ON(NPH - 1, 12)) { const Params p = load_params(); phase_final(p); }
}

extern "C" void kernel_launch(void* const* d_in, const int* in_sizes, int n_in, void* d_out, int out_size, void* d_ws,
                              size_t ws_size, hipStream_t stream) {
  static int grid = 0;
  if (grid == 0) {
    int dev = 0, cus = 0;
    (void)hipGetDevice(&dev);
    (void)hipDeviceGetAttribute(&cus, hipDeviceAttributeMultiprocessorCount, dev);
    grid = cus > 0 ? cus : 256;
    (void)hipFuncSetAttribute((const void*)fwd_kernel<PHMASK>, hipFuncAttributeMaxDynamicSharedMemorySize, LDS_BYTES);
    (void)hipGetLastError();
  }
  Params p{};
  for (int i = 0; i < 30; ++i) p.in[i] = (const float*)d_in[i];
  p.out = (float*)d_out;
  p.ws = (unsigned char*)d_ws;
#if COOP
  (void)hipMemsetAsync((unsigned char*)d_ws + WS_BAR, 0, XCD_BAR_WORDS * 4, stream);
  p.ph_lo = 0; p.ph_hi = NPH;
  void* args[] = {&p};
  hipError_t e = hipLaunchCooperativeKernel((const void*)fwd_kernel<PHMASK>, dim3(grid), dim3(NT), args, LDS_BYTES, stream);
  if (e != hipSuccess) fprintf(stderr, "cooperative launch failed: %s (grid %d)\n", hipGetErrorString(e), grid);
#else
  for (int ph = 0; ph < NPH; ++ph) {
    p.ph_lo = ph; p.ph_hi = ph + 1;
    hipLaunchKernelGGL(fwd_kernel<PHMASK>, dim3(grid), dim3(NT), LDS_BYTES, stream, p);
  }
#endif
}
```

```cpp
#include <hip/hip_runtime.h>
#include <hip/hip_bf16.h>
#include <hip/hip_cooperative_groups.h>
#include <cstdio>
namespace cg = cooperative_groups;

typedef __attribute__((ext_vector_type(8))) short bf16x8;
typedef __attribute__((ext_vector_type(16))) float f32x16;
typedef unsigned short u16;

#ifndef PHMASK
#define PHMASK 0x1FFF
#endif
#ifndef T3
#define T3 7
#endif
#ifndef P2SEL
#define P2SEL 7
#endif
#ifndef RPT_MASK
#define RPT_MASK 0
#endif
#ifndef RPT_N
#define RPT_N 1
#endif
#define RPT(bit) for (int rp_ = 0; rp_ < (((RPT_MASK >> (bit)) & 1) ? 1 + RPT_N : 1); ++rp_)
#define RPT_CNT(bit) (((RPT_MASK >> (bit)) & 1) ? 1 + RPT_N : 1)
#define DRY(bit) (opq(rp_) + 1 < RPT_CNT(bit))
#ifndef R1P
#define R1P 1
#endif
#ifndef COOP
#define COOP 1
#endif

#define NT 512
#define M_TOT 16896
#define M_P 16384
#define ZLD 2560
#define NPH 25

#define WS_WT   0ull
#define WS_H    13631488ull
#define WS_Z    48234496ull
#define WS_R    134742016ull
#define WS_PP   (WS_R)
#define WS_GC   (WS_R + 16777216ull)
#define WS_Q    (WS_R + 17301504ull)
#define WS_W2   (WS_R + 50855936ull)
#define WS_YL   (WS_R + 67633152ull)
#define WS_BO   (WS_R + 84410368ull)
#define WS_GA   (WS_R + 101187584ull)
#define WS_T1   (WS_R)
#define WS_T2   (WS_R + 34603008ull)
#define WS_MG   (WS_R + 69206016ull)
#define WS_WTF  (WS_Z)
#define WS_CU   (WS_Z + 17301504ull)
#define WS_LW  267634432ull
#define WS_DP  256100096ull
#define WT_IN  0
#define WT_G   2621440
#define WT_BRA 4718592
#define WT_BRB 5242880
#define WT_OUT 5767168
#define WT_FIN 0
#define WT_FDN 5767168
#define O_PSHIFT 17301504
#define O_PWKV   17308672
#define O_PK     17439744
#define O_PV     17505280
#define O_PCONV  17570816
#define O_SSHIFT 17593344
#define O_SWKV   18052096
#define O_SK     26440704
#define O_SV     30635008
#define O_SCONV  34829312

#define LDS_BYTES 151552

struct Params {
  const float* in[30];
  float* out;
  unsigned char* ws;
  int ph_lo, ph_hi;
};

typedef float f2v_ __attribute__((ext_vector_type(2)));
typedef __bf16 b2v_ __attribute__((ext_vector_type(2)));
__device__ __forceinline__ unsigned pack2(float a, float b) { f2v_ v = {a, b}; b2v_ r = __builtin_convertvector(v, b2v_); return __builtin_bit_cast(unsigned, r); }
__device__ __forceinline__ u16 f2bf(float f) { return (u16)(pack2(f, f) & 0xFFFFu); }
__device__ __forceinline__ float bf2f(u16 h) { return __uint_as_float(((unsigned)h) << 16); }
__device__ __forceinline__ float sigm(float x) { return __builtin_amdgcn_rcpf(1.f + __expf(-x)); }
__device__ __forceinline__ void unpack8(uint4 u, float* o) {
  o[0] = __uint_as_float(u.x << 16); o[1] = __uint_as_float(u.x & 0xFFFF0000u);
  o[2] = __uint_as_float(u.y << 16); o[3] = __uint_as_float(u.y & 0xFFFF0000u);
  o[4] = __uint_as_float(u.z << 16); o[5] = __uint_as_float(u.z & 0xFFFF0000u);
  o[6] = __uint_as_float(u.w << 16); o[7] = __uint_as_float(u.w & 0xFFFF0000u);
}
__device__ __forceinline__ uint4 pack8(const float* f) {
  uint4 u; u.x = pack2(f[0], f[1]); u.y = pack2(f[2], f[3]); u.z = pack2(f[4], f[5]); u.w = pack2(f[6], f[7]); return u;
}
__device__ __forceinline__ float gelu_fast(float v) {
  const float av = fabsf(v), d = av * 0.2316418882f + 1.0f;
  const float t = __builtin_amdgcn_rcpf(d);
  float q = t * 0.5307027145f + (-0.7265760135f); q = q * t + 0.7107068705f; q = q * t + (-0.142248368f); q = q * t + 0.127414796f; q = q * t;
  const float e = __builtin_amdgcn_exp2f((v * v) * (-0.72134752044f));
  const float m = v * (q * e);
  return v < 0.f ? m : v - m;
}
__device__ __forceinline__ int opq(int x) { asm volatile("" : "+v"(x)); return x; }
__device__ __forceinline__ float wave_sum(float x) {
#pragma unroll
  for (int o = 32; o >= 1; o >>= 1) x += __shfl_xor(x, o, 64);
  return x;
}

namespace pg8 {
#define PG8_LAS __attribute__((address_space(3)))
typedef unsigned short bf16_t;
typedef short bf16x8 __attribute__((ext_vector_type(8)));
typedef float f32x4 __attribute__((ext_vector_type(4)));
typedef unsigned u32x4 __attribute__((ext_vector_type(4)));
constexpr int BM = 256, BK = 64, HALF = 128, HTB = HALF * BK * 2  , STAGE_BYTES = 8 * HTB, NXCD = 8, WGM = 8;
__host__ __device__ __forceinline__ int lds_byte(int r, int c) { const int st = (r >> 4) * 2 + (c >> 5), rr = r & 15, cc = c & 31, ob = rr * 64 + cc * 2; return st * 1024 + (ob ^ (((ob >> 9) & 1) << 5)); }
__host__ __device__ __forceinline__ void stage_rc(int b, int& R, int& C) { const int st = b / 1024, sb = b % 1024, swz = sb ^ (((sb >> 9) & 1) << 5); R = (st >> 1) * 16 + swz / 64; C = (st & 1) * 32 + (swz % 64) / 2; }
__host__ __device__ __forceinline__ int perm32(int rho) { const int n = rho >> 4, i = rho & 15; return 8 * (i >> 2) + 4 * n + (i & 3); }
struct Unit { int pm, pn; };
struct Gemm { const bf16_t* A; const bf16_t* Bt; int M, N, K, lda, ldb; };
struct StaticOrder {
    int nM, nN, nwg, G, c;
    __host__ __device__ void init(int M, int N, int G_, int c_) { nM = M / BM; nN = N / BM; nwg = nM * nN; G = G_; c = c_; }
    __host__ __device__ bool next(int i, Unit& u) const {
        const long L = (long)i * G + c; if (L >= nwg) return false;
        int wgid = (int)L; { const int q = nwg / NXCD, r = nwg % NXCD, xcd = wgid % NXCD, off = wgid / NXCD; wgid = (xcd < r ? xcd * (q + 1) : r * (q + 1) + (xcd - r) * q) + off; }
        const int nig = WGM * nN, gid = wgid / nig, fm = gid * WGM, gsz = (nM - fm) < WGM ? (nM - fm) : WGM;
        u.pm = fm + ((wgid % nig) % gsz); u.pn = (wgid % nig) / gsz; return true;
    }
    __device__ __forceinline__ void a_ready(const Unit&) const {}
    __device__ __forceinline__ void done(const Unit&) const {}
};
__device__ __forceinline__ unsigned cvt_pk_bf16(float lo, float hi) { return ::pack2(lo, hi); }
template <class Epi, class Sched, bool STAMP = false>
__device__ __forceinline__ void gemm_phase(PG8_LAS unsigned char* lds, const Gemm g, const Sched& S, const Epi& E, unsigned long long* stamps) {
    const int tid = ::opq(threadIdx.x), wid = __builtin_amdgcn_readfirstlane(tid >> 6), lane = tid & 63, wr = wid >> 2, wc = wid & 3, fr = lane & 15, fq = lane >> 4;
    const int K = g.K, nt = K / BK;
    int ts_lo = 0, ts_hi = 0, nts = 0; const unsigned long long rt_entry = 0ull;
#define PG8_STAMP() do { if (STAMP && wid == 0 && nts < 64) { const unsigned long long _c = (unsigned long long)clock64(); \
        ts_lo = (lane == nts) ? (int)(unsigned)_c : ts_lo; ts_hi = (lane == nts) ? (int)(unsigned)(_c >> 32) : ts_hi; ++nts; } } while (0)
    PG8_STAMP();
    unsigned voffA[2], voffB[2];
#pragma unroll
    for (int i = 0; i < 2; ++i) { int R, C; stage_rc(tid * 16 + i * 8192, R, C); const int Rb = Epi::PERM ? ((R & ~31) + perm32(R & 31)) : R;
        voffA[i] = (unsigned)(R * g.lda + C) * 2u; voffB[i] = (unsigned)(Rb * g.ldb + C) * 2u; }
    const size_t kstep = (size_t)(BK * 2);
    const size_t hstep = (size_t)HALF * g.ldb * 2;
    const size_t tstep = 2 * hstep; const size_t hstepA = (size_t)HALF * g.lda * 2; const size_t tstepA = 2 * hstepA;
    const unsigned ldsw = (unsigned)wid * 1024u;
    const int aoff = lds_byte(wr * 64 + fr, fq * 8), boff = lds_byte(wc * 32 + fr, fq * 8);
#define PG8_SA(b, h) (((b) * 2 + (h)) * HTB)
#define PG8_SB(b, h) ((4 + (b) * 2 + (h)) * HTB)
#define PG8_STAGE(bufoff, gbase, voff) do { _Pragma("unroll") for (int _i = 0; _i < 2; ++_i) \
        __builtin_amdgcn_global_load_lds((const unsigned*)((const char*)(gbase) + (voff)[_i]), (PG8_LAS unsigned*)(lds + (bufoff) + ldsw + _i * 8192), 16, 0, 0); } while (0)
#define PG8_LDA(dst, b, h) do { _Pragma("unroll") for (int m = 0; m < 4; ++m) _Pragma("unroll") for (int k = 0; k < 2; ++k) dst[m][k] = *(const PG8_LAS bf16x8*)(lds + PG8_SA(b, h) + aoff + m * 2048 + k * 1024); } while (0)
#define PG8_LDB(dst, b, h) do { _Pragma("unroll") for (int n = 0; n < 2; ++n) _Pragma("unroll") for (int k = 0; k < 2; ++k) dst[n][k] = *(const PG8_LAS bf16x8*)(lds + PG8_SB(b, h) + boff + n * 2048 + k * 1024); } while (0)
#define PG8_MMA(ai, bj, At, Bt) do { __builtin_amdgcn_s_setprio(1); _Pragma("unroll") for (int m = 0; m < 4; ++m) _Pragma("unroll") for (int n = 0; n < 2; ++n) _Pragma("unroll") for (int k = 0; k < 2; ++k) \
        acc[ai][bj][m][n] = __builtin_amdgcn_mfma_f32_16x16x32_bf16(Bt[n][k], At[m][k], acc[ai][bj][m][n], 0, 0, 0); __builtin_amdgcn_s_setprio(0); } while (0)
#define PG8_WAIT_V(n) asm volatile("s_waitcnt vmcnt(" #n ")" ::: "memory")
#define PG8_WAIT_L(n) asm volatile("s_waitcnt lgkmcnt(" #n ")" ::: "memory")
#define PG8_BAR __builtin_amdgcn_s_barrier()
#define PG8_SCHED __builtin_amdgcn_sched_barrier(0)
    Unit cur, nxt; int ui = 0;
    if (!S.next(0, cur)) return;
    f32x4 acc[2][2][4][2];
#pragma unroll
    for (int a = 0; a < 2; ++a)
#pragma unroll
        for (int b = 0; b < 2; ++b)
#pragma unroll
            for (int m = 0; m < 4; ++m)
#pragma unroll
                for (int n = 0; n < 2; ++n) acc[a][b][m][n] = (f32x4){0.f, 0.f, 0.f, 0.f};
    bf16x8 At[4][2], B0[2][2], B1[2][2];
    const char* cA = (const char*)g.A + (size_t)cur.pm * tstepA; const char* cB = (const char*)g.Bt + (size_t)cur.pn * tstep;
    S.a_ready(cur);
    PG8_STAGE(PG8_SB(0, 0), cB, voffB); PG8_STAGE(PG8_SA(0, 0), cA, voffA); PG8_STAGE(PG8_SB(0, 1), cB + hstep, voffB); PG8_STAGE(PG8_SA(0, 1), cA + hstepA, voffA);
    if (wr == 1) PG8_BAR;
    PG8_WAIT_V(4); PG8_BAR;
    PG8_STAGE(PG8_SB(1, 0), cB + kstep, voffB); PG8_STAGE(PG8_SA(1, 0), cA + kstep, voffA); PG8_STAGE(PG8_SB(1, 1), cB + hstep + kstep, voffB);
    PG8_WAIT_V(6); PG8_BAR;
    PG8_STAMP();
    for (;;) {
        const bool has_next = S.next(ui + 1, nxt);
        const char* nA = has_next ? (const char*)g.A + (size_t)nxt.pm * tstepA : cA; const char* nB = has_next ? (const char*)g.Bt + (size_t)nxt.pn * tstep : cB;
        for (int t = 0; t < nt; t += 2) {
            const bool last = (t == nt - 2);
            const char* a1 = cA + (size_t)(t + 1) * kstep;
            const char* a2 = last ? nA : cA + (size_t)(t + 2) * kstep; const char* b2 = last ? nB : cB + (size_t)(t + 2) * kstep;
            const char* a3 = a2 + kstep; const char* b3 = b2 + kstep;
            if (last && has_next) S.a_ready(nxt);
            PG8_LDB(B0, 0, 0); PG8_SCHED; PG8_LDA(At, 0, 0); PG8_STAGE(PG8_SA(1, 1), a1 + hstepA, voffA);
            PG8_WAIT_L(8); PG8_BAR; PG8_WAIT_L(0); PG8_MMA(0, 0, At, B0); PG8_BAR; PG8_SCHED;
            PG8_LDB(B1, 0, 1); PG8_STAGE(PG8_SB(0, 0), b2, voffB);
            PG8_BAR; PG8_WAIT_L(0); PG8_MMA(0, 1, At, B1); PG8_BAR;
            PG8_LDA(At, 0, 1); PG8_STAGE(PG8_SA(0, 0), a2, voffA);
            PG8_BAR; PG8_WAIT_L(0); PG8_MMA(1, 0, At, B0); PG8_BAR; PG8_SCHED;
            PG8_STAGE(PG8_SB(0, 1), b2 + hstep, voffB);
            PG8_WAIT_V(6); PG8_BAR; PG8_MMA(1, 1, At, B1); PG8_BAR;
            PG8_LDB(B0, 1, 0); PG8_SCHED; PG8_LDA(At, 1, 0); PG8_STAGE(PG8_SA(0, 1), a2 + hstepA, voffA);
            PG8_WAIT_L(8); PG8_BAR; PG8_WAIT_L(0); PG8_MMA(0, 0, At, B0); PG8_BAR; PG8_SCHED;
            PG8_LDB(B1, 1, 1); PG8_STAGE(PG8_SB(1, 0), b3, voffB);
            PG8_BAR; PG8_WAIT_L(0); PG8_MMA(0, 1, At, B1); PG8_BAR;
            PG8_LDA(At, 1, 1); PG8_STAGE(PG8_SA(1, 0), a3, voffA);
            PG8_BAR; PG8_WAIT_L(0); PG8_MMA(1, 0, At, B0); PG8_BAR; PG8_SCHED;
            PG8_STAGE(PG8_SB(1, 1), b3 + hstep, voffB);
            PG8_WAIT_V(6); PG8_BAR; PG8_MMA(1, 1, At, B1); PG8_BAR;
        }
        PG8_STAMP();
        if constexpr (!Epi::AFTER_DRAIN) { E(acc, cur, wr, wc, fr, fq); S.done(cur); }
        PG8_STAMP();
        if (!has_next) break;
#pragma unroll
        for (int a = 0; a < 2; ++a)
#pragma unroll
            for (int b = 0; b < 2; ++b)
#pragma unroll
                for (int m = 0; m < 4; ++m)
#pragma unroll
                    for (int n = 0; n < 2; ++n) acc[a][b][m][n] = (f32x4){0.f, 0.f, 0.f, 0.f};
        cur = nxt; cA = nA; cB = nB; ++ui;
    }
    PG8_WAIT_V(0);
    if (wr == 0) PG8_BAR;
    PG8_BAR;
    if constexpr (Epi::AFTER_DRAIN) { E.fused(acc, cur, wr, wc, fr, fq, lds, wid, lane); S.done(cur); }
    PG8_STAMP();
    if (STAMP && wid == 0) { stamps[lane] = lane < nts ? (((unsigned long long)(unsigned)ts_hi << 32) | (unsigned)ts_lo) : 0ull;
        if (lane == 62) stamps[62] = rt_entry; if (lane == 63) stamps[63] = (unsigned long long)wall_clock64(); }
#undef PG8_STAMP
#undef PG8_SA
#undef PG8_SB
#undef PG8_STAGE
#undef PG8_LDA
#undef PG8_LDB
#undef PG8_MMA
#undef PG8_WAIT_V
#undef PG8_WAIT_L
#undef PG8_BAR
#undef PG8_SCHED
}
}
using pg8::f32x4;
#define ROWOFF(reg, h) (((reg) & 3) + 8 * ((reg) >> 2) + 4 * (h))

__device__ __forceinline__ void conv_tile(const float* __restrict__ src, int K, int N, u16* __restrict__ dst, int k0, int n0, int sn0, float* lds) {
  const int tid = opq(threadIdx.x);
  __syncthreads();
  {
    const int k = tid >> 3, c = (tid & 7) * 8;
    const float* s = src + (size_t)(k0 + k) * N + sn0 + c;
    float4 a = *(const float4*)s, b = *(const float4*)(s + 4);
    float* d = lds + k * 65 + c;
    d[0] = a.x; d[1] = a.y; d[2] = a.z; d[3] = a.w;
    d[4] = b.x; d[5] = b.y; d[6] = b.z; d[7] = b.w;
  }
  __syncthreads();
  {
    const int n = tid >> 3, kk = (tid & 7) * 8;
    float f[8];
#pragma unroll
    for (int i = 0; i < 8; ++i) f[i] = lds[(kk + i) * 65 + n];
    *(uint4*)(dst + (size_t)(n0 + n) * K + k0 + kk) = pack8(f);
  }
}

__device__ __forceinline__ void phase_prep(const Params& p, int l, int which, float* ldsf) {
  u16* WtA = (u16*)(p.ws + WS_WT);
  u16* WtF = (u16*)(p.ws + WS_WTF);
  u16* H = (u16*)(p.ws + WS_H);
  float* X = p.out;
  const int nconv = which == 0 ? (640 + 512 + 128 + 128 + 256) : (1408 + 704);
  const int nlw = which == 0 ? 8 : 0;
  const int ntot = nconv + 2112 + nlw;
  const float* gw = (which == 0 ? p.in[7] : p.in[24]) + l * 1024;
  for (int it = blockIdx.x; it < ntot; it += gridDim.x) {
    if (it < nconv) {
      int t = it;
      if (which == 0) {
        if (t < 640) { const int tk = t / 40, tn = t % 40; conv_tile(p.in[8] + (size_t)l * 1024 * 4608, 1024, 4608, WtA + WT_IN, tk * 64, tn * 64, tn * 64, ldsf); }
        else if ((t -= 640) < 512) {
          const int tk = t / 32, tn = t % 32; const int n0 = tn * 64;
          const int sn0 = 2560 + ((n0 >> 7) & 1) * 1024 + (n0 >> 8) * 128 + (n0 & 127);
          conv_tile(p.in[8] + (size_t)l * 1024 * 4608, 1024, 4608, WtA + WT_G, tk * 64, n0, sn0, ldsf);
        }
        else if ((t -= 512) < 128) { const int tk = t / 16, tn = t % 16; conv_tile(p.in[21] + (size_t)l * 512 * 1024, 512, 1024, WtA + WT_BRA, tk * 64, tn * 64, tn * 64, ldsf); }
        else if ((t -= 128) < 128) { const int tk = t / 16, tn = t % 16; conv_tile(p.in[22] + (size_t)l * 512 * 1024, 512, 1024, WtA + WT_BRB, tk * 64, tn * 64, tn * 64, ldsf); }
        else { t -= 128; const int tk = t / 16, tn = t % 16; conv_tile(p.in[23] + (size_t)l * 1024 * 1024, 1024, 1024, WtA + WT_OUT, tk * 64, tn * 64, tn * 64, ldsf); }
      } else {
        if (t < 1408) {
          const int tk = t / 88, tn = t % 88; const int n0 = tn * 64;
          const int sn0 = ((n0 >> 7) & 1) * 2816 + (n0 >> 8) * 128 + (n0 & 127);
          conv_tile(p.in[25] + (size_t)l * 1024 * 5632, 1024, 5632, WtF + WT_FIN, tk * 64, n0, sn0, ldsf);
        } else { t -= 1408; const int tk = t / 16, tn = t % 16; conv_tile(p.in[28] + (size_t)l * 2816 * 1024, 2816, 1024, WtF + WT_FDN, tk * 64, tn * 64, tn * 64, ldsf); }
      }
    } else if (it >= nconv + 2112) {
      const int tid = opq(threadIdx.x);
      const int hh = it - nconv - 2112;
      u16* dst = (u16*)(p.ws + WS_LW) + (size_t)hh * 17920;
      const float* w2 = p.in[11] + (size_t)l * 64 * 512 + hh * 64;
      const float* a2 = p.in[13] + (size_t)l * 64 * 512 + hh * 64;
      const float* g2 = p.in[14] + (size_t)l * 128 * 512 + hh * 64;
      for (int e = tid; e < 4096; e += NT) {
        const int i = e >> 6, j = e & 63;
        dst[j * 72 + i] = f2bf(w2[(size_t)i * 512 + j]);
        dst[4608 + j * 72 + i] = f2bf(a2[(size_t)i * 512 + j]);
      }
      for (int e = tid; e < 8192; e += NT) {
        const int i = e >> 6, j = e & 63;
        dst[9216 + j * 136 + i] = f2bf(g2[(size_t)i * 512 + j]);
      }
    } else {
      const int tid = opq(threadIdx.x);
      const int row = (it - nconv) * 8 + (tid >> 6);
      const int lane = tid & 63;
      const bool first = (which == 0 && l == 0);
      const float* src;
      if (first) src = (row < M_P) ? p.in[0] + (size_t)row * 1024 : p.in[1] + (size_t)(row - M_P) * 1024;
      else src = X + (size_t)row * 1024;
      float4 v[4];
      float ss = 0.f;
      const int nsl = (gridDim.x == 256 && row >= M_P && !first) ? (which == 1 ? 4 : 11) : 0;
      const float* part = (const float*)(p.ws + WS_T1) + (size_t)(row - M_P) * 1024;
      const u16* partb = (const u16*)(p.ws + WS_DP) + (size_t)(row - M_P) * 1024;
#pragma unroll
      for (int i = 0; i < 4; ++i) {
        v[i] = *(const float4*)(src + i * 256 + lane * 4);
        for (int k = 0; k < nsl; ++k) {
          if (which == 1) {
            const float4 q = *(const float4*)(part + (size_t)k * 512 * 1024 + i * 256 + lane * 4);
            v[i].x += q.x; v[i].y += q.y; v[i].z += q.z; v[i].w += q.w;
          } else {
            const uint2 q = *(const uint2*)(partb + (size_t)k * 512 * 1024 + i * 256 + lane * 4);
            v[i].x += __uint_as_float(q.x << 16); v[i].y += __uint_as_float(q.x & 0xFFFF0000u); v[i].z += __uint_as_float(q.y << 16); v[i].w += __uint_as_float(q.y & 0xFFFF0000u);
          }
        }
        ss += v[i].x * v[i].x + v[i].y * v[i].y + v[i].z * v[i].z + v[i].w * v[i].w;
        if (first || nsl) *(float4*)(X + (size_t)row * 1024 + i * 256 + lane * 4) = v[i];
      }
      ss = wave_sum(ss);
      const float rs = rsqrtf(ss * (1.f / 1024.f) + 1e-6f);
#pragma unroll
      for (int i = 0; i < 4; ++i) {
        const float4 g = *(const float4*)(gw + i * 256 + lane * 4);
        uint2 o; o.x = pack2(v[i].x * rs * g.x, v[i].y * rs * g.y); o.y = pack2(v[i].z * rs * g.z, v[i].w * rs * g.w);
        *(uint2*)(H + (size_t)row * 1024 + i * 256 + lane * 4) = o;
      }
    }
  }
}

struct EpiInproj {
  static constexpr bool PERM = true, AFTER_DRAIN = false;
  u16* z; float* out; int l;
  __device__ __forceinline__ void operator()(const f32x4 (&acc)[2][2][4][2], const pg8::Unit& u, int wr, int wc, int fr, int fq) const {
    const int row0 = u.pm * 256 + wr * 64 + fr, col0 = u.pn * 256 + wc * 32 + 8 * fq;
#pragma unroll
    for (int ai = 0; ai < 2; ++ai)
#pragma unroll
      for (int m = 0; m < 4; ++m) {
        const int row = row0 + ai * 128 + m * 16;
        u16* rowp = z + (size_t)row * ZLD + col0;
#pragma unroll
        for (int bj = 0; bj < 2; ++bj) {
          const f32x4 v0 = acc[ai][bj][m][0], v1 = acc[ai][bj][m][1];
          pg8::u32x4 w; w.x = pg8::cvt_pk_bf16(v0[0], v0[1]); w.y = pg8::cvt_pk_bf16(v0[2], v0[3]); w.z = pg8::cvt_pk_bf16(v1[0], v1[1]); w.w = pg8::cvt_pk_bf16(v1[2], v1[3]);
          *(pg8::u32x4*)(rowp + bj * 128) = w;
        }
        const bool prompt = row < M_P;
        int b, t;
        if (prompt) { b = row >> 13; t = row & 8191; } else { b = (row - M_P) >> 2; t = (row - M_P) & 3; }
        if (u.pn < 7) {
          if ((prompt && t == 8191) || (!prompt && t == 3)) {
            float* o = out + (prompt ? O_PSHIFT + (size_t)(l * 2 + b) * 1792 : O_SSHIFT + (size_t)(l * 128 + b) * 1792) + col0;
#pragma unroll
            for (int bj = 0; bj < 2; ++bj) { *(f32x4*)(o + bj * 128) = acc[ai][bj][m][0]; *(f32x4*)(o + bj * 128 + 4) = acc[ai][bj][m][1]; }
          }
        } else if (u.pn == 9 && prompt && t >= 8064) {
          const int c = wc * 32 + 8 * fq;
          float* o = out + O_PV + ((size_t)((l * 2 + b) * 128 + (t - 8064)) * 2 + (c >> 6)) * 64 + (c & 63);
          *(f32x4*)o = acc[ai][1][m][0]; *(f32x4*)(o + 4) = acc[ai][1][m][1];
        }
      }
  }
};
struct EpiStoreBf16 {
  static constexpr bool PERM = true, AFTER_DRAIN = false;
  u16* O; int ldc; int rowoff;
  __device__ __forceinline__ void operator()(const f32x4 (&acc)[2][2][4][2], const pg8::Unit& u, int wr, int wc, int fr, int fq) const {
    const int row0 = rowoff + u.pm * 256 + wr * 64 + fr, col0 = u.pn * 256 + wc * 32 + 8 * fq;
#pragma unroll
    for (int ai = 0; ai < 2; ++ai)
#pragma unroll
      for (int m = 0; m < 4; ++m) {
        u16* rowp = O + (size_t)(row0 + ai * 128 + m * 16) * ldc + col0;
#pragma unroll
        for (int bj = 0; bj < 2; ++bj) {
          const f32x4 v0 = acc[ai][bj][m][0], v1 = acc[ai][bj][m][1];
          pg8::u32x4 w; w.x = pg8::cvt_pk_bf16(v0[0], v0[1]); w.y = pg8::cvt_pk_bf16(v0[2], v0[3]); w.z = pg8::cvt_pk_bf16(v1[0], v1[1]); w.w = pg8::cvt_pk_bf16(v1[2], v1[3]);
          *(pg8::u32x4*)(rowp + bj * 128) = w;
        }
      }
  }
};
struct EpiFfnIn {
  static constexpr bool PERM = true, AFTER_DRAIN = false;
  u16* cu;
  __device__ __forceinline__ void operator()(const f32x4 (&acc)[2][2][4][2], const pg8::Unit& u, int wr, int wc, int fr, int fq) const {
    const int row0 = u.pm * 256 + wr * 64 + fr, col0 = u.pn * 128 + wc * 32 + 8 * fq;
#pragma unroll
    for (int ai = 0; ai < 2; ++ai)
#pragma unroll
      for (int m = 0; m < 4; ++m) {
        u16* rowp = cu + (size_t)(row0 + ai * 128 + m * 16) * 5632 + col0;
#pragma unroll
        for (int bj = 0; bj < 2; ++bj) {
          const f32x4 v0 = acc[ai][bj][m][0], v1 = acc[ai][bj][m][1];
          pg8::u32x4 w; w.x = pg8::cvt_pk_bf16(v0[0], v0[1]); w.y = pg8::cvt_pk_bf16(v0[2], v0[3]); w.z = pg8::cvt_pk_bf16(v1[0], v1[1]); w.w = pg8::cvt_pk_bf16(v1[2], v1[3]);
          *(pg8::u32x4*)(rowp + bj * 2816) = w;
        }
      }
  }
};
struct EpiMerge {
  static constexpr bool PERM = true, AFTER_DRAIN = false;
  const u16* t1; const u16* t2; u16* mg;
  __device__ __forceinline__ void operator()(const f32x4 (&acc)[2][2][4][2], const pg8::Unit& u, int wr, int wc, int fr, int fq) const {
    const int row0 = u.pm * 256 + wr * 64 + fr, col0 = u.pn * 128 + wc * 32 + 8 * fq;
#pragma unroll
    for (int ai = 0; ai < 2; ++ai)
#pragma unroll
      for (int m = 0; m < 4; ++m) {
        const size_t off = (size_t)(row0 + ai * 128 + m * 16) * 1024 + col0;
        float a[8], b[8], o[8];
        unpack8(*(const uint4*)(t1 + off), a);
        unpack8(*(const uint4*)(t2 + off), b);
#pragma unroll
        for (int n = 0; n < 2; ++n)
#pragma unroll
          for (int j = 0; j < 4; ++j)
            o[n * 4 + j] = sigm(acc[ai][0][m][n][j]) * a[n * 4 + j] + sigm(acc[ai][1][m][n][j]) * b[n * 4 + j];
        *(uint4*)(mg + off) = pack8(o);
        asm volatile("" ::: "memory");
      }
  }
};
struct EpiResid {
  static constexpr bool PERM = false, AFTER_DRAIN = false;
  float* X; bool dry; bool atomic; int rowoff; u16* pbf;
  __device__ __forceinline__ void operator()(const f32x4 (&acc)[2][2][4][2], const pg8::Unit& u, int wr, int wc, int fr, int fq) const {
    const int row0 = rowoff + u.pm * 256 + wr * 64 + fr, col0 = u.pn * 256 + wc * 32 + 4 * fq;
#pragma unroll
    for (int ai = 0; ai < 2; ++ai)
#pragma unroll
      for (int m = 0; m < 4; ++m) {
        float* rowp = X + (size_t)(row0 + ai * 128 + m * 16) * 1024 + col0;
#pragma unroll
        for (int bj = 0; bj < 2; ++bj)
#pragma unroll
          for (int n = 0; n < 2; ++n) {
            f32x4* q = (f32x4*)(rowp + bj * 128 + n * 16);
            if (atomic) {
              if (pbf) {
                uint2 o; o.x = pack2(acc[ai][bj][m][n][0], acc[ai][bj][m][n][1]); o.y = pack2(acc[ai][bj][m][n][2], acc[ai][bj][m][n][3]);
                *(uint2*)(pbf + ((float*)q - X)) = o;
              } else *q = acc[ai][bj][m][n];
            } else { const f32x4 v_ = *q + acc[ai][bj][m][n]; if (!dry) *q = v_; }
          }
        asm volatile("" ::: "memory");
      }
  }
};
template <class Epi>
__device__ __forceinline__ void run_gemm_ex(unsigned char* lds_raw, const u16* A, int lda, const u16* Bt, int ldb, int M, int N, int K, int G, int c, const Epi& E) {
  if (c < 0) return;
  pg8::Gemm g; g.A = A; g.Bt = Bt; g.M = M; g.N = N; g.K = K; g.lda = lda; g.ldb = ldb;
  pg8::StaticOrder S; S.init(M, N, G, c);
  __syncthreads();
  pg8::gemm_phase<Epi, pg8::StaticOrder, false>((PG8_LAS unsigned char*)lds_raw, g, S, E, nullptr);
  __syncthreads();
}
template <class Epi>
__device__ __forceinline__ void run_gemm(unsigned char* lds_raw, const u16* A, int lda, const u16* Bt, int N, int K, const Epi& E) {
  pg8::Gemm g; g.A = A; g.Bt = Bt; g.M = M_TOT; g.N = N; g.K = K; g.lda = lda; g.ldb = K;
  pg8::StaticOrder S; S.init(M_TOT, N, gridDim.x, blockIdx.x);
  __syncthreads();
  pg8::gemm_phase<Epi, pg8::StaticOrder, false>((PG8_LAS unsigned char*)lds_raw, g, S, E, nullptr);
  __syncthreads();
}

__device__ __forceinline__ void rope_item(const Params& p, int l, int item, bool dry = false) {
  const int tid = opq(threadIdx.x);
  u16* z = (u16*)(p.ws + WS_Z);
  const int row = item * 64 + (tid >> 3);
  const int d0 = (tid & 7) * 4;
  const bool prompt = row < M_P;
  int b, t, pos;
  if (prompt) { b = row >> 13; t = row & 8191; pos = t; } else { b = (row - M_P) >> 2; t = (row - M_P) & 3; pos = 16384 + t; }
  float cs[4], sn[4];
#pragma unroll
  for (int i = 0; i < 4; ++i) {
    const float inv = __expf(-(float)(d0 + i) * (9.210340371976184f / 32.f));
    const float angf = (float)pos * inv;
    double a = (double)angf;
    a -= 6.283185307179586 * rint(a * 0.15915494309189535);
    const float af = (float)a;
    sn[i] = __sinf(af); cs[i] = __cosf(af);
  }
#pragma unroll 2
  for (int hh = 0; hh < 10; ++hh) {
    u16* q = z + (size_t)row * ZLD + 1792 + hh * 64 + d0;
    const uint2 lo = *(const uint2*)q, hi = *(const uint2*)(q + 32);
    float x1[4] = {__uint_as_float(lo.x << 16), __uint_as_float(lo.x & 0xFFFF0000u), __uint_as_float(lo.y << 16), __uint_as_float(lo.y & 0xFFFF0000u)};
    float x2[4] = {__uint_as_float(hi.x << 16), __uint_as_float(hi.x & 0xFFFF0000u), __uint_as_float(hi.y << 16), __uint_as_float(hi.y & 0xFFFF0000u)};
    float y1[4], y2[4];
#pragma unroll
    for (int i = 0; i < 4; ++i) { y1[i] = x1[i] * cs[i] - x2[i] * sn[i]; y2[i] = x2[i] * cs[i] + x1[i] * sn[i]; }
    uint2 o1, o2;
    o1.x = pack2(y1[0], y1[1]); o1.y = pack2(y1[2], y1[3]); o2.x = pack2(y2[0], y2[1]); o2.y = pack2(y2[2], y2[3]);
    if (!dry) { *(uint2*)q = o1; *(uint2*)(q + 32) = o2; }
    if (hh >= 8 && prompt && t >= 8064) {
      float* o = p.out + O_PK + ((size_t)((l * 2 + b) * 128 + (t - 8064)) * 2 + (hh - 8)) * 64 + d0;
      *(float4*)o = make_float4(y1[0], y1[1], y1[2], y1[3]);
      *(float4*)(o + 32) = make_float4(y2[0], y2[1], y2[2], y2[3]);
    }
  }
}

#define SL(i) (ldsf + (i) * 4160)
__device__ __forceinline__ void rwkv_item(const Params& p, int l, int item, float* ldsf, bool dry = false) {
  const int tid = opq(threadIdx.x), lane = tid & 63, wave = tid >> 6;
  const bool sample = item >= 2048;
  int h, cidx, rowbase;
  if (!sample) { h = item & 7; cidx = item >> 3; rowbase = cidx * 64; }
  else { int s = item - 2048; h = s & 7; cidx = s >> 3; rowbase = M_P + cidx * 64; }
  const int cc = cidx & 127;
  const u16* z = (const u16*)(p.ws + WS_Z);
  u16* zw_ = (u16*)(p.ws + WS_Z);
  const float* mu = p.in[9] + l * 1792;
  float* wbuf = SL(7);
  float* gc = ldsf + 9 * 4160;
  float* bd = ldsf + 9 * 4160 + 64;
  __syncthreads();
  {
    const int t = tid >> 3, c8 = (tid & 7) * 8;
    const int m = rowbase + t;
    const int zcs[7] = {h * 64, 512 + h * 64, 1024 + h * 64, 1536, 1600, 1664, 1728};
#pragma unroll
    for (int gi = 0; gi < 7; ++gi) {
      const int zc = zcs[gi] + c8;
      float cur[8], prv[8];
      unpack8(*(const uint4*)(z + (size_t)m * ZLD + zc), cur);
      bool zero = false, fromstate = false;
      if (!sample) zero = (t == 0 && cc == 0);
      else fromstate = ((t & 3) == 0);
      if (zero) {
#pragma unroll
        for (int i = 0; i < 8; ++i) prv[i] = 0.f;
      } else if (fromstate) {
        const int b = (m - M_P) >> 2;
        const float* sp = p.in[2] + (size_t)(l * 128 + b) * 1792 + zc;
        float4 a = *(const float4*)sp, bb = *(const float4*)(sp + 4);
        prv[0] = a.x; prv[1] = a.y; prv[2] = a.z; prv[3] = a.w; prv[4] = bb.x; prv[5] = bb.y; prv[6] = bb.z; prv[7] = bb.w;
      } else {
        unpack8(*(const uint4*)(z + (size_t)(m - 1) * ZLD + zc), prv);
      }
      float* d = SL(gi) + t * 65 + c8;
#pragma unroll
      for (int i = 0; i < 8; ++i) {
        float v = cur[i] + mu[zc + i] * (prv[i] - cur[i]);
        if (gi == 3) v = tanhf(v);
        if (gi >= 5) v = sigm(v);
        d[i] = v;
      }
    }
  }
  const int lt = tid & 63, jg = tid >> 6;
  auto load_w = [&](const float* W, int nrows) {
    for (int e = tid; e < nrows * 8; e += NT) {
      const int i = e >> 3, c = (e & 7) * 8;
      const float* s = W + (size_t)i * 512 + h * 64 + c;
      *(float4*)(wbuf + i * 64 + c) = *(const float4*)s;
      *(float4*)(wbuf + i * 64 + c + 4) = *(const float4*)(s + 4);
    }
  };
  auto lora = [&](const float* xa, const float* xb, int n, float* acc) {
#pragma unroll 2
    for (int i = 0; i < n; ++i) {
      const float x = (i < 64) ? xa[lt * 65 + i] : xb[lt * 65 + i - 64];
      const float4 w0 = *(const float4*)(wbuf + i * 64 + jg * 8);
      const float4 w1 = *(const float4*)(wbuf + i * 64 + jg * 8 + 4);
      acc[0] += x * w0.x; acc[1] += x * w0.y; acc[2] += x * w0.z; acc[3] += x * w0.w;
      acc[4] += x * w1.x; acc[5] += x * w1.y; acc[6] += x * w1.z; acc[7] += x * w1.w;
    }
  };
  float res[8];
  load_w(p.in[11] + (size_t)l * 64 * 512, 64);
  __syncthreads();
#pragma unroll
  for (int i = 0; i < 8; ++i) res[i] = p.in[10][l * 512 + h * 64 + jg * 8 + i];
  lora(SL(3), SL(3), 64, res);
  __syncthreads();
#pragma unroll
  for (int i = 0; i < 8; ++i) {
    const float x = -res[i];
    const float sp = (x > 20.f) ? x : log1pf(__expf(x));
    SL(3)[lt * 65 + jg * 8 + i] = -__expf(-sp - 0.5f);
  }
  load_w(p.in[13] + (size_t)l * 64 * 512, 64);
  __syncthreads();
#pragma unroll
  for (int i = 0; i < 8; ++i) res[i] = p.in[12][l * 512 + h * 64 + jg * 8 + i];
  lora(SL(4), SL(4), 64, res);
  __syncthreads();
#pragma unroll
  for (int i = 0; i < 8; ++i) SL(4)[lt * 65 + jg * 8 + i] = sigm(res[i]);
  load_w(p.in[14] + (size_t)l * 128 * 512, 128);
  __syncthreads();
#pragma unroll
  for (int i = 0; i < 8; ++i) res[i] = 0.f;
  lora(SL(5), SL(6), 128, res);
  __syncthreads();
  if (!sample) {
    u16* ga = (u16*)(p.ws + WS_GA) + (size_t)item * 4096;
    *(uint4*)(ga + lt * 64 + jg * 8) = pack8(res);
    if (tid < 64) {
      float c = 0.f;
      for (int t = 0; t < 64; ++t) { c += SL(3)[t * 65 + tid]; SL(5)[t * 65 + tid] = c; }
      gc[tid] = __expf(c);
    }
  } else {
#pragma unroll
    for (int i = 0; i < 8; ++i) SL(6)[lt * 65 + jg * 8 + i] = res[i];
  }
  __syncthreads();
  {
    const int t = tid >> 3, j0 = (tid & 7) * 8;
    const float* kkw = p.in[15] + l * 512 + h * 64;
    const float* kaw = p.in[16] + l * 512 + h * 64;
    const float* rkw = p.in[17] + l * 512 + h * 64;
    float kr[8], av[8], rv[8], kkv[8], kf[8];
    float nrm = 0.f, bdot = 0.f;
#pragma unroll
    for (int i = 0; i < 8; ++i) {
      const int j = j0 + i;
      kr[i] = SL(1)[t * 65 + j]; av[i] = SL(4)[t * 65 + j]; rv[i] = SL(0)[t * 65 + j];
      kkv[i] = kr[i] * kkw[j];
      nrm += kkv[i] * kkv[i];
      kf[i] = kr[i] * (1.f + (av[i] - 1.f) * kaw[j]);
      bdot += rv[i] * kf[i] * rkw[j];
    }
    nrm += __shfl_xor(nrm, 1, 64); nrm += __shfl_xor(nrm, 2, 64); nrm += __shfl_xor(nrm, 4, 64);
    bdot += __shfl_xor(bdot, 1, 64); bdot += __shfl_xor(bdot, 2, 64); bdot += __shfl_xor(bdot, 4, 64);
    const float rn = 1.f / fmaxf(sqrtf(nrm), 1e-12f);
    if (!sample) {
      float bo[8];
#pragma unroll
      for (int i = 0; i < 8; ++i) {
        const int j = j0 + i;
        const float cum = SL(5)[t * 65 + j], dl = SL(3)[t * 65 + j];
        const float eg = __expf(cum), egi = __expf(-cum), egp = __expf(cum - dl);
        const float kk = kkv[i] * rn;
        SL(0)[t * 65 + j] = rv[i] * eg;
        SL(1)[t * 65 + j] = kf[i] * egi;
        SL(3)[t * 65 + j] = kk * av[i] * egi;
        SL(4)[t * 65 + j] = kk * egp;
        bo[i] = bdot * SL(2)[t * 65 + j];
      }
      u16* bop = (u16*)(p.ws + WS_BO) + (size_t)item * 4096;
      *(uint4*)(bop + t * 64 + j0) = pack8(bo);
    } else {
#pragma unroll
      for (int i = 0; i < 8; ++i) {
        const int j = j0 + i;
        const float kk = kkv[i] * rn;
        const float dl = SL(3)[t * 65 + j];
        SL(1)[t * 65 + j] = kf[i];
        SL(3)[t * 65 + j] = __expf(dl);
        SL(4)[t * 65 + j] = kk;
        SL(5)[t * 65 + j] = kk * av[i];
      }
      if ((tid & 7) == 0) bd[t] = bdot;
    }
  }
  __syncthreads();
  if (sample) {
    const float lng = p.in[18][l * 512 + h * 64 + lane], lnb = p.in[19][l * 512 + h * 64 + lane];
    for (int round = 0; round < 2; ++round) {
      const int seq = wave + 8 * round;
      const int b = cidx * 16 + seq;
      float S[64];
      const float* sp = p.in[3] + ((size_t)((l * 128 + b) * 8 + h) * 64 + lane) * 64;
#pragma unroll
      for (int k = 0; k < 64; k += 4) { float4 v = *(const float4*)(sp + k); S[k] = v.x; S[k + 1] = v.y; S[k + 2] = v.z; S[k + 3] = v.w; }
      for (int tt = 0; tt < 4; ++tt) {
        const int t = seq * 4 + tt;
        float sk = 0.f;
#pragma unroll
        for (int kc = 0; kc < 64; kc += 8) {
#pragma unroll
          for (int k = kc; k < kc + 8; ++k) sk += S[k] * SL(4)[t * 65 + k];
          __builtin_amdgcn_sched_barrier(0);
        }
        const float vt = SL(2)[t * 65 + lane];
        float y = 0.f;
#pragma unroll
        for (int kc = 0; kc < 64; kc += 8) {
#pragma unroll
          for (int k = kc; k < kc + 8; ++k) {
            S[k] = S[k] * SL(3)[t * 65 + k] - sk * SL(5)[t * 65 + k] + vt * SL(1)[t * 65 + k];
            y += S[k] * SL(0)[t * 65 + k];
          }
          __builtin_amdgcn_sched_barrier(0);
        }
        const float mean = wave_sum(y) * (1.f / 64.f);
        const float d = y - mean;
        const float var = wave_sum(d * d) * (1.f / 64.f);
        const float yn = d * rsqrtf(var + 64e-5f) * lng + lnb;
        const float o = (yn + bd[t] * vt) * SL(6)[t * 65 + lane];
        if (!dry) zw_[(size_t)(M_P + b * 4 + tt) * ZLD + h * 64 + lane] = f2bf(o);
      }
      float* op = p.out + O_SWKV + ((size_t)((l * 128 + b) * 8 + h) * 64 + lane) * 64;
#pragma unroll
      for (int k = 0; k < 64; k += 4) *(float4*)(op + k) = make_float4(S[k], S[k + 1], S[k + 2], S[k + 3]);
    }
    return;
  }
  {
    const int i = lane, tg = wave;
    float ab[8], ak[8], akr[8], abr[8];
#pragma unroll
    for (int q = 0; q < 8; ++q) { ab[q] = 0.f; ak[q] = 0.f; akr[q] = 0.f; abr[q] = 0.f; }
#pragma unroll 2
    for (int k = 0; k < 64; ++k) {
      const float xb = SL(3)[i * 65 + k], xk = SL(1)[i * 65 + k];
#pragma unroll
      for (int q = 0; q < 8; ++q) {
        const int t = tg * 8 + q;
        const float yk = SL(4)[t * 65 + k], yr = SL(0)[t * 65 + k];
        ab[q] += xb * yk; ak[q] += xk * yk; akr[q] += xk * yr; abr[q] += xb * yr;
      }
    }
    __syncthreads();
#pragma unroll
    for (int q = 0; q < 8; ++q) {
      const int t = tg * 8 + q;
      SL(6)[i * 65 + t] = (i < t) ? ab[q] : 0.f;
      SL(7)[i * 65 + t] = (i < t) ? ak[q] : 0.f;
      SL(8)[i * 65 + t] = (i <= t) ? akr[q] : 0.f;
      SL(5)[i * 65 + t] = (i <= t) ? abr[q] : 0.f;
    }
  }
  __syncthreads();
  {
    const int t = tid >> 3, j0 = (tid & 7) * 8;
#pragma unroll
    for (int i = 0; i < 8; ++i) { const float g = gc[j0 + i]; SL(3)[t * 65 + j0 + i] *= g; SL(1)[t * 65 + j0 + i] *= g; }
  }
  __syncthreads();
  if (tid < 128) {
    float* X_ = (tid < 64) ? SL(5) : SL(3);
    const int col = tid & 63;
    for (int i = 62; i >= 0; --i) {
      float a = X_[i * 65 + col];
#pragma unroll 4
      for (int t = i + 1; t < 64; ++t) a -= SL(6)[i * 65 + t] * X_[t * 65 + col];
      X_[i * 65 + col] = a;
    }
  }
  __syncthreads();
  {
    const int c = tid & 127, ig = tid >> 7;
    const int which = c >> 6, cq = c & 63;
    const float* N_ = which ? SL(3) : SL(5);
    float a[16];
#pragma unroll
    for (int q = 0; q < 16; ++q) a[q] = 0.f;
#pragma unroll 2
    for (int t = 0; t < 64; ++t) {
      const float n = N_[t * 65 + cq];
#pragma unroll
      for (int q = 0; q < 16; ++q) a[q] += SL(7)[(ig * 16 + q) * 65 + t] * n;
    }
    float* T_ = which ? SL(1) : SL(8);
#pragma unroll
    for (int q = 0; q < 16; ++q) T_[(ig * 16 + q) * 65 + cq] -= a[q];
  }
  __syncthreads();
  {
    const int x = lane, yg = wave;
    float w2[8], pp[8], yl[8], qq[8];
#pragma unroll
    for (int q = 0; q < 8; ++q) { w2[q] = 0.f; pp[q] = 0.f; yl[q] = 0.f; qq[q] = 0.f; }
#pragma unroll 2
    for (int j = 0; j < 64; ++j) {
      const float l5 = SL(5)[j * 65 + x], l4 = SL(4)[j * 65 + x], l8 = SL(8)[j * 65 + x], l2 = SL(2)[j * 65 + x];
#pragma unroll
      for (int q = 0; q < 8; ++q) {
        const int y = yg * 8 + q;
        w2[q] += l5 * SL(4)[j * 65 + y];
        pp[q] += l4 * SL(3)[j * 65 + y];
        yl[q] += l8 * SL(2)[j * 65 + y];
        qq[q] += l2 * SL(1)[j * 65 + y];
      }
    }
    float o1[8];
#pragma unroll
    for (int q = 0; q < 8; ++q) {
      const int y = yg * 8 + q;
      o1[q] = SL(0)[x * 65 + y] - w2[q];
    }
    u16* Pf = (u16*)(p.ws + WS_PP) + (size_t)item * 4096;
    float* Qf = (float*)(p.ws + WS_Q) + (size_t)item * 4096;
    if (tid < 64) ((float*)(p.ws + WS_GC))[(size_t)item * 64 + tid] = gc[tid];
    {
      const int s_ = x >> 4, kk = x & 15, hh = (kk >> 2) & 1, jj = ((kk >> 3) << 2) | (kk & 3);
#pragma unroll
      for (int q = 0; q < 8; ++q) {
        const int y = yg * 8 + q;
        Pf[(((y >> 5) * 4 + s_) * 64 + (y & 31) + 32 * hh) * 8 + jj] = f2bf(-pp[q]);
        const int k2 = y & 31, reg = ((k2 >> 3) << 2) | (k2 & 3), h2 = (k2 >> 2) & 1;
        Qf[(((x >> 5) * 2 + (y >> 5)) * 16 + reg) * 64 + (x & 31) + 32 * h2] = qq[q];
      }
    }
    u16* W2p = (u16*)(p.ws + WS_W2) + (size_t)item * 4096 + x * 64 + yg * 8;
    u16* YLp = (u16*)(p.ws + WS_YL) + (size_t)item * 4096 + x * 64 + yg * 8;
    *(uint4*)W2p = pack8(o1);
    *(uint4*)YLp = pack8(yl);
  }
}

__device__ __forceinline__ void mm_tile(const u16* Aop, int lda, const u16* Bop, int ldb, int mt, int nt, int r, int h, int ksteps, f32x16& acc) {
  const u16* ap = Aop + (mt * 32 + r) * lda + h * 8;
  const u16* bp = Bop + (nt * 32 + r) * ldb + h * 8;
#pragma unroll 4
  for (int s = 0; s < ksteps; ++s) {
    const bf16x8 a = *(const bf16x8*)(ap + s * 16);
    const bf16x8 b = *(const bf16x8*)(bp + s * 16);
    acc = __builtin_amdgcn_mfma_f32_32x32x16_bf16(a, b, acc, 0, 0, 0);
  }
}
__device__ __forceinline__ void store_T(u16* T, int ldt, int mt, int nt, int r, int h, const f32x16& acc) {
#pragma unroll
  for (int g = 0; g < 4; ++g) {
    uint2 o; o.x = pack2(acc[4 * g], acc[4 * g + 1]); o.y = pack2(acc[4 * g + 2], acc[4 * g + 3]);
    *(uint2*)(T + (nt * 32 + r) * ldt + mt * 32 + 8 * g + 4 * h) = o;
  }
}
__device__ __forceinline__ void tri16(const float* Ab, float* Xc) {
  float a0 = Xc[0];
  float a1 = Xc[65];
  float a2 = Xc[130];
  float a3 = Xc[195];
  float a4 = Xc[260];
  float a5 = Xc[325];
  float a6 = Xc[390];
  float a7 = Xc[455];
  float a8 = Xc[520];
  float a9 = Xc[585];
  float a10 = Xc[650];
  float a11 = Xc[715];
  float a12 = Xc[780];
  float a13 = Xc[845];
  float a14 = Xc[910];
  float a15 = Xc[975];
  const float4 c14_12 = *(const float4*)(Ab + 964);
  const float4 c13_12 = *(const float4*)(Ab + 896);
  const float4 c12_12 = *(const float4*)(Ab + 828);
  const float4 c11_12 = *(const float4*)(Ab + 760);
  a14 -= c14_12.w * a15;
  const float4 c10_8 = *(const float4*)(Ab + 688);
  const float4 c10_12 = *(const float4*)(Ab + 692);
  a13 -= c13_12.z * a14;
  a13 -= c13_12.w * a15;
  const float4 c9_8 = *(const float4*)(Ab + 620);
  const float4 c9_12 = *(const float4*)(Ab + 624);
  a12 -= c12_12.y * a13;
  a12 -= c12_12.z * a14;
  a12 -= c12_12.w * a15;
  const float4 c8_8 = *(const float4*)(Ab + 552);
  const float4 c8_12 = *(const float4*)(Ab + 556);
  a11 -= c11_12.x * a12;
  a11 -= c11_12.y * a13;
  a11 -= c11_12.z * a14;
  a11 -= c11_12.w * a15;
  const float4 c7_8 = *(const float4*)(Ab + 484);
  const float4 c7_12 = *(const float4*)(Ab + 488);
  a10 -= c10_8.w * a11;
  a10 -= c10_12.x * a12;
  a10 -= c10_12.y * a13;
  a10 -= c10_12.z * a14;
  a10 -= c10_12.w * a15;
  const float4 c6_4 = *(const float4*)(Ab + 412);
  const float4 c6_8 = *(const float4*)(Ab + 416);
  const float4 c6_12 = *(const float4*)(Ab + 420);
  a9 -= c9_8.z * a10;
  a9 -= c9_8.w * a11;
  a9 -= c9_12.x * a12;
  a9 -= c9_12.y * a13;
  a9 -= c9_12.z * a14;
  a9 -= c9_12.w * a15;
  const float4 c5_4 = *(const float4*)(Ab + 344);
  const float4 c5_8 = *(const float4*)(Ab + 348);
  const float4 c5_12 = *(const float4*)(Ab + 352);
  a8 -= c8_8.y * a9;
  a8 -= c8_8.z * a10;
  a8 -= c8_8.w * a11;
  a8 -= c8_12.x * a12;
  a8 -= c8_12.y * a13;
  a8 -= c8_12.z * a14;
  a8 -= c8_12.w * a15;
  const float4 c4_4 = *(const float4*)(Ab + 276);
  const float4 c4_8 = *(const float4*)(Ab + 280);
  const float4 c4_12 = *(const float4*)(Ab + 284);
  a7 -= c7_8.x * a8;
  a7 -= c7_8.y * a9;
  a7 -= c7_8.z * a10;
  a7 -= c7_8.w * a11;
  a7 -= c7_12.x * a12;
  a7 -= c7_12.y * a13;
  a7 -= c7_12.z * a14;
  a7 -= c7_12.w * a15;
  const float4 c3_4 = *(const float4*)(Ab + 208);
  const float4 c3_8 = *(const float4*)(Ab + 212);
  const float4 c3_12 = *(const float4*)(Ab + 216);
  a6 -= c6_4.w * a7;
  a6 -= c6_8.x * a8;
  a6 -= c6_8.y * a9;
  a6 -= c6_8.z * a10;
  a6 -= c6_8.w * a11;
  a6 -= c6_12.x * a12;
  a6 -= c6_12.y * a13;
  a6 -= c6_12.z * a14;
  a6 -= c6_12.w * a15;
  const float4 c2_0 = *(const float4*)(Ab + 136);
  const float4 c2_4 = *(const float4*)(Ab + 140);
  const float4 c2_8 = *(const float4*)(Ab + 144);
  const float4 c2_12 = *(const float4*)(Ab + 148);
  a5 -= c5_4.z * a6;
  a5 -= c5_4.w * a7;
  a5 -= c5_8.x * a8;
  a5 -= c5_8.y * a9;
  a5 -= c5_8.z * a10;
  a5 -= c5_8.w * a11;
  a5 -= c5_12.x * a12;
  a5 -= c5_12.y * a13;
  a5 -= c5_12.z * a14;
  a5 -= c5_12.w * a15;
  const float4 c1_0 = *(const float4*)(Ab + 68);
  const float4 c1_4 = *(const float4*)(Ab + 72);
  const float4 c1_8 = *(const float4*)(Ab + 76);
  const float4 c1_12 = *(const float4*)(Ab + 80);
  a4 -= c4_4.y * a5;
  a4 -= c4_4.z * a6;
  a4 -= c4_4.w * a7;
  a4 -= c4_8.x * a8;
  a4 -= c4_8.y * a9;
  a4 -= c4_8.z * a10;
  a4 -= c4_8.w * a11;
  a4 -= c4_12.x * a12;
  a4 -= c4_12.y * a13;
  a4 -= c4_12.z * a14;
  a4 -= c4_12.w * a15;
  const float4 c0_0 = *(const float4*)(Ab + 0);
  const float4 c0_4 = *(const float4*)(Ab + 4);
  const float4 c0_8 = *(const float4*)(Ab + 8);
  const float4 c0_12 = *(const float4*)(Ab + 12);
  a3 -= c3_4.x * a4;
  a3 -= c3_4.y * a5;
  a3 -= c3_4.z * a6;
  a3 -= c3_4.w * a7;
  a3 -= c3_8.x * a8;
  a3 -= c3_8.y * a9;
  a3 -= c3_8.z * a10;
  a3 -= c3_8.w * a11;
  a3 -= c3_12.x * a12;
  a3 -= c3_12.y * a13;
  a3 -= c3_12.z * a14;
  a3 -= c3_12.w * a15;
  a2 -= c2_0.w * a3;
  a2 -= c2_4.x * a4;
  a2 -= c2_4.y * a5;
  a2 -= c2_4.z * a6;
  a2 -= c2_4.w * a7;
  a2 -= c2_8.x * a8;
  a2 -= c2_8.y * a9;
  a2 -= c2_8.z * a10;
  a2 -= c2_8.w * a11;
  a2 -= c2_12.x * a12;
  a2 -= c2_12.y * a13;
  a2 -= c2_12.z * a14;
  a2 -= c2_12.w * a15;
  a1 -= c1_0.z * a2;
  a1 -= c1_0.w * a3;
  a1 -= c1_4.x * a4;
  a1 -= c1_4.y * a5;
  a1 -= c1_4.z * a6;
  a1 -= c1_4.w * a7;
  a1 -= c1_8.x * a8;
  a1 -= c1_8.y * a9;
  a1 -= c1_8.z * a10;
  a1 -= c1_8.w * a11;
  a1 -= c1_12.x * a12;
  a1 -= c1_12.y * a13;
  a1 -= c1_12.z * a14;
  a1 -= c1_12.w * a15;
  a0 -= c0_0.y * a1;
  a0 -= c0_0.z * a2;
  a0 -= c0_0.w * a3;
  a0 -= c0_4.x * a4;
  a0 -= c0_4.y * a5;
  a0 -= c0_4.z * a6;
  a0 -= c0_4.w * a7;
  a0 -= c0_8.x * a8;
  a0 -= c0_8.y * a9;
  a0 -= c0_8.z * a10;
  a0 -= c0_8.w * a11;
  a0 -= c0_12.x * a12;
  a0 -= c0_12.y * a13;
  a0 -= c0_12.z * a14;
  a0 -= c0_12.w * a15;
  Xc[0] = a0;
  Xc[65] = a1;
  Xc[130] = a2;
  Xc[195] = a3;
  Xc[260] = a4;
  Xc[325] = a5;
  Xc[390] = a6;
  Xc[455] = a7;
  Xc[520] = a8;
  Xc[585] = a9;
  Xc[650] = a10;
  Xc[715] = a11;
  Xc[780] = a12;
  Xc[845] = a13;
  Xc[910] = a14;
  Xc[975] = a15;
}
#define FS(i) (ldsf + (i) * 4160)
__device__ __forceinline__ void rwkv_item2(const Params& p, int l, int item, float* ldsf) {
  const int tid = opq(threadIdx.x), lane = tid & 63, wave = tid >> 6;
  const int r = lane & 31, hf = lane >> 5;
  const int h = item & 7, cidx = item >> 3, rowbase = cidx * 64, cc = cidx & 127;
  const u16* z = (const u16*)(p.ws + WS_Z);
  const float* mu = p.in[9] + l * 1792;
  u16* BBp = (u16*)((unsigned char*)ldsf + 83200);
  u16* XW = BBp;            u16* XA = BBp + 4608;    u16* XG = BBp + 9216;   u16* WT = BBp + 17920;
  u16* Rn = BBp;            u16* Kn = BBp + 4608;    u16* Bn = BBp + 9216;   u16* Cn = BBp + 13824;
  u16* CT = BBp + 18432;    u16* KHT = BBp + 23040;  u16* VT = BBp + 27648;
  float* gc = (float*)(BBp + 32256);
  u16* AK = (u16*)FS(2);    u16* NTm = AK + 4608;
  u16* MT = (u16*)FS(0);    u16* KQT = (u16*)FS(1);
  float* Abp = (float*)((unsigned char*)ldsf + 60928);
  const int mt = (wave >> 1) & 1, nt = wave & 1, grp = wave >> 2;
  const uint4* lwsrc = (const uint4*)((const u16*)(p.ws + WS_LW) + (size_t)h * 17920);
  const float bias_w = p.in[10][l * 512 + h * 64 + nt * 32 + r], bias_a = p.in[12][l * 512 + h * 64 + nt * 32 + r];
  float kkw_[8], kaw_[8], rkw_[8];
  {
    const int j0 = (tid & 7) * 8;
    const float* q1 = p.in[15] + l * 512 + h * 64 + j0; const float* q2 = p.in[16] + l * 512 + h * 64 + j0; const float* q3 = p.in[17] + l * 512 + h * 64 + j0;
    const float4 x0 = *(const float4*)q1, x1 = *(const float4*)(q1 + 4), y0 = *(const float4*)q2, y1 = *(const float4*)(q2 + 4), z0 = *(const float4*)q3, z1 = *(const float4*)(q3 + 4);
    kkw_[0] = x0.x; kkw_[1] = x0.y; kkw_[2] = x0.z; kkw_[3] = x0.w; kkw_[4] = x1.x; kkw_[5] = x1.y; kkw_[6] = x1.z; kkw_[7] = x1.w;
    kaw_[0] = y0.x; kaw_[1] = y0.y; kaw_[2] = y0.z; kaw_[3] = y0.w; kaw_[4] = y1.x; kaw_[5] = y1.y; kaw_[6] = y1.z; kaw_[7] = y1.w;
    rkw_[0] = z0.x; rkw_[1] = z0.y; rkw_[2] = z0.z; rkw_[3] = z0.w; rkw_[4] = z1.x; rkw_[5] = z1.y; rkw_[6] = z1.z; rkw_[7] = z1.w;
  }
  const uint4 g2a = lwsrc[1152 + tid], g2b = lwsrc[1152 + 512 + tid], g2c = (tid < 64) ? lwsrc[1152 + 1024 + tid] : make_uint4(0, 0, 0, 0);
  __syncthreads();
  {
    const int t = tid >> 3, c8 = (tid & 7) * 8;
    const int m = rowbase + t;
    const int zcs[7] = {h * 64, 512 + h * 64, 1024 + h * 64, 1536, 1600, 1664, 1728};
#pragma unroll
    for (int gi = 0; gi < 7; ++gi) {
      const int zc = zcs[gi] + c8;
      float cur[8], prv[8], v[8];
      const float4 mu0 = *(const float4*)(mu + zc), mu1 = *(const float4*)(mu + zc + 4);
      const float muv[8] = {mu0.x, mu0.y, mu0.z, mu0.w, mu1.x, mu1.y, mu1.z, mu1.w};
      unpack8(*(const uint4*)(z + (size_t)m * ZLD + zc), cur);
      if (t == 0 && cc == 0) {
#pragma unroll
        for (int i = 0; i < 8; ++i) prv[i] = 0.f;
      } else {
        unpack8(*(const uint4*)(z + (size_t)(m - 1) * ZLD + zc), prv);
      }
#pragma unroll
      for (int i = 0; i < 8; ++i) {
        float x = cur[i] + muv[i] * (prv[i] - cur[i]);
        if (gi == 3) x = 1.f - 2.f * __builtin_amdgcn_rcpf(1.f + __expf(2.f * x));
        if (gi >= 5) x = sigm(x);
        v[i] = x;
      }
      if (gi < 2) {
        float* d = FS(gi) + t * 65 + c8;
#pragma unroll
        for (int i = 0; i < 8; ++i) d[i] = v[i];
      } else if (gi == 2) {
#pragma unroll
        for (int i = 0; i < 8; ++i) VT[(c8 + i) * 72 + t] = f2bf(v[i]);
      } else if (gi == 3) { *(uint4*)(XW + t * 72 + c8) = pack8(v); }
      else if (gi == 4) { *(uint4*)(XA + t * 72 + c8) = pack8(v); }
      else { *(uint4*)(XG + t * 136 + (gi - 5) * 64 + c8) = pack8(v); }
    }
  }
  {
    uint4* d = (uint4*)WT;
    for (int e = tid; e < 1152; e += 512) d[e] = lwsrc[e];
  }
  __syncthreads();
  {
    f32x16 acc;
#pragma unroll
    for (int i = 0; i < 16; ++i) acc[i] = 0.f;
    mm_tile(grp ? XA : XW, 72, grp ? WT + 4608 : WT, 72, mt, nt, r, hf, 4, acc);
    const int j = nt * 32 + r;
    const float bias = grp ? bias_a : bias_w;
#pragma unroll
    for (int reg = 0; reg < 16; ++reg) {
      const int t = mt * 32 + ROWOFF(reg, hf);
      const float x = acc[reg] + bias;
      if (grp) FS(3)[t * 65 + j] = sigm(x);
      else {
        const float nx = -x;
        const float sp = (nx > 20.f) ? nx : __logf(1.f + __expf(nx));
        FS(4)[t * 65 + j] = -__expf(-sp - 0.5f);
      }
    }
  }
  __syncthreads();
  {
    uint4* d = (uint4*)WT;
    d[tid] = g2a; d[512 + tid] = g2b; if (tid < 64) d[1024 + tid] = g2c;
  }
  float* psum = (float*)((unsigned char*)ldsf + 147968);
  float pl[8];
  {
    const int j = tid & 63, sg = tid >> 6;
    float c = 0.f;
#pragma unroll
    for (int u = 0; u < 8; ++u) { c += FS(4)[(sg * 8 + u) * 65 + j]; pl[u] = c; }
    psum[sg * 64 + j] = c;
  }
  __syncthreads();
  {
    const int j = tid & 63, sg = tid >> 6;
    float off = 0.f, tot = 0.f;
#pragma unroll
    for (int q = 0; q < 8; ++q) { const float v = psum[q * 64 + j]; tot += v; if (q < sg) off += v; }
#pragma unroll
    for (int u = 0; u < 8; ++u) FS(2)[(sg * 8 + u) * 65 + j] = off + pl[u];
    if (sg == 0) { const float g = __expf(tot); gc[j] = g; ((float*)(p.ws + WS_GC))[(size_t)item * 64 + j] = g; }
  }
  __syncthreads();
  if (grp == 0) {
    f32x16 acc;
#pragma unroll
    for (int i = 0; i < 16; ++i) acc[i] = 0.f;
    mm_tile(XG, 136, WT, 136, mt, nt, r, hf, 8, acc);
    u16* ga = (u16*)(p.ws + WS_GA) + (size_t)item * 4096;
#pragma unroll
    for (int reg = 0; reg < 16; ++reg) ga[(mt * 32 + ROWOFF(reg, hf)) * 64 + nt * 32 + r] = f2bf(acc[reg]);
  }
  __syncthreads();
  {
    const int t = tid >> 3, j0 = (tid & 7) * 8;
    float kr[8], av[8], rv[8], kkv[8], kf[8];
    float nrm = 0.f, bdot = 0.f;
#pragma unroll
    for (int i = 0; i < 8; ++i) {
      const int j = j0 + i;
      kr[i] = FS(1)[t * 65 + j]; av[i] = FS(3)[t * 65 + j]; rv[i] = FS(0)[t * 65 + j];
      kkv[i] = kr[i] * kkw_[i];
      nrm += kkv[i] * kkv[i];
      kf[i] = kr[i] * (1.f + (av[i] - 1.f) * kaw_[i]);
      bdot += rv[i] * kf[i] * rkw_[i];
    }
    nrm += __shfl_xor(nrm, 1, 64); nrm += __shfl_xor(nrm, 2, 64); nrm += __shfl_xor(nrm, 4, 64);
    bdot += __shfl_xor(bdot, 1, 64); bdot += __shfl_xor(bdot, 2, 64); bdot += __shfl_xor(bdot, 4, 64);
    const float rn = 1.f / fmaxf(sqrtf(nrm), 1e-12f);
    float o_r[8], o_k[8], o_b[8], o_c[8], bo[8];
#pragma unroll
    for (int i = 0; i < 8; ++i) {
      const int j = j0 + i;
      const float cum = FS(2)[t * 65 + j], dl = FS(4)[t * 65 + j];
      const float eg = __expf(cum), egi = __expf(-cum), egp = __expf(cum - dl);
      const float kk = kkv[i] * rn;
      const float g = gc[j];
      o_r[i] = rv[i] * eg; o_k[i] = kf[i] * egi; o_b[i] = kk * av[i] * egi; o_c[i] = kk * egp;
      CT[j * 72 + t] = f2bf(o_c[i]);
      KHT[j * 72 + t] = f2bf(o_k[i] * g);
      FS(1)[t * 65 + j] = o_b[i] * g;
      bo[i] = bdot * bf2f(VT[j * 72 + t]);
    }
    *(uint4*)(Rn + t * 72 + j0) = pack8(o_r);
    *(uint4*)(Kn + t * 72 + j0) = pack8(o_k);
    *(uint4*)(Bn + t * 72 + j0) = pack8(o_b);
    *(uint4*)(Cn + t * 72 + j0) = pack8(o_c);
    u16* bop = (u16*)(p.ws + WS_BO) + (size_t)item * 4096;
    *(uint4*)(bop + t * 64 + j0) = pack8(bo);
  }
  __syncthreads();
  f32x16 akr;
#pragma unroll
  for (int i = 0; i < 16; ++i) akr[i] = 0.f;
  if (grp == 0) {
    f32x16 ab, abr;
#pragma unroll
    for (int i = 0; i < 16; ++i) { ab[i] = 0.f; abr[i] = 0.f; }
    mm_tile(Bn, 72, Cn, 72, mt, nt, r, hf, 4, ab);
    mm_tile(Bn, 72, Rn, 72, mt, nt, r, hf, 4, abr);
    const int t = nt * 32 + r;
#pragma unroll
    for (int reg = 0; reg < 16; ++reg) {
      const int i = mt * 32 + ROWOFF(reg, hf);
      Abp[i * 68 + t] = (i < t) ? ab[reg] : 0.f;
      FS(0)[i * 65 + t] = (i <= t) ? abr[reg] : 0.f;
    }
  } else {
    f32x16 akt;
#pragma unroll
    for (int i = 0; i < 16; ++i) akt[i] = 0.f;
    mm_tile(Cn, 72, Kn, 72, mt, nt, r, hf, 4, akt);
    {
      const int i = nt * 32 + r;
#pragma unroll
      for (int reg = 0; reg < 16; ++reg) { const int t = mt * 32 + ROWOFF(reg, hf); if (!(i < t)) akt[reg] = 0.f; }
    }
    store_T(AK, 72, mt, nt, r, hf, akt);
    mm_tile(Kn, 72, Rn, 72, mt, nt, r, hf, 4, akr);
    {
      const int t = nt * 32 + r;
#pragma unroll
      for (int reg = 0; reg < 16; ++reg) { const int i = mt * 32 + ROWOFF(reg, hf); if (!(i <= t)) akr[reg] = 0.f; }
    }
  }
  __syncthreads();
#pragma unroll 1
  for (int I = 3; I >= 0; --I) {
    if (tid < 128) {
      float* X_ = (tid < 64) ? FS(0) : FS(1);
      tri16(Abp + I * 16 * 69, X_ + I * 16 * 65 + (tid & 63));
    }
    __syncthreads();
    if (I > 0) {
      const int c = tid & 127, rg = tid >> 7;
      float* X_ = (c < 64) ? FS(0) : FS(1);
      const int col = c & 63;
      float xv[16];
#pragma unroll
      for (int t = 0; t < 16; ++t) xv[t] = X_[(I * 16 + t) * 65 + col];
      for (int i = rg; i < I * 16; i += 4) {
        const float* ar = Abp + i * 68 + I * 16;
        const float4 c0 = *(const float4*)ar, c1 = *(const float4*)(ar + 4), c2 = *(const float4*)(ar + 8), c3 = *(const float4*)(ar + 12);
        float a = c0.x * xv[0] + c0.y * xv[1] + c0.z * xv[2] + c0.w * xv[3];
        a += c1.x * xv[4] + c1.y * xv[5] + c1.z * xv[6] + c1.w * xv[7];
        a += c2.x * xv[8] + c2.y * xv[9] + c2.z * xv[10] + c2.w * xv[11];
        a += c3.x * xv[12] + c3.y * xv[13] + c3.z * xv[14] + c3.w * xv[15];
        X_[i * 65 + col] -= a;
      }
      __syncthreads();
    }
  }
  {
    const int c = tid >> 2, q = tid & 3;
    const float* X_ = (c < 64) ? FS(0) : FS(1);
    const int col = c & 63;
    float o0[8], o1[8];
#pragma unroll
    for (int u = 0; u < 8; ++u) { o0[u] = -X_[(q * 16 + u) * 65 + col]; o1[u] = -X_[(q * 16 + 8 + u) * 65 + col]; }
    u16* dst = NTm + c * 72 + q * 16;
    *(uint4*)dst = pack8(o0);
    *(uint4*)(dst + 8) = pack8(o1);
  }
  __syncthreads();
  if (grp == 1) {
    mm_tile(AK, 72, NTm, 72, mt, nt, r, hf, 4, akr);
    store_T(MT, 72, mt, nt, r, hf, akr);
  } else {
    f32x16 d2;
#pragma unroll
    for (int i = 0; i < 16; ++i) d2[i] = 0.f;
    mm_tile(AK, 72, NTm + 64 * 72, 72, mt, nt, r, hf, 4, d2);
#pragma unroll
    for (int g = 0; g < 4; ++g) {
      const int idx = (nt * 32 + r) * 72 + mt * 32 + 8 * g + 4 * hf;
      const uint2 kh = *(const uint2*)(KHT + idx);
      uint2 o;
      o.x = pack2(d2[4 * g] + __uint_as_float(kh.x << 16), d2[4 * g + 1] + __uint_as_float(kh.x & 0xFFFF0000u));
      o.y = pack2(d2[4 * g + 2] + __uint_as_float(kh.y << 16), d2[4 * g + 3] + __uint_as_float(kh.y & 0xFFFF0000u));
      *(uint2*)(KQT + idx) = o;
    }
  }
  __syncthreads();
  if (grp == 0) {
    f32x16 w2, yl;
#pragma unroll
    for (int i = 0; i < 16; ++i) { w2[i] = 0.f; yl[i] = 0.f; }
    mm_tile(NTm, 72, CT, 72, mt, nt, r, hf, 4, w2);
    mm_tile(MT, 72, VT, 72, mt, nt, r, hf, 4, yl);
    u16* W2p = (u16*)(p.ws + WS_W2) + (size_t)item * 4096;
    u16* YLp = (u16*)(p.ws + WS_YL) + (size_t)item * 4096;
#pragma unroll
    for (int reg = 0; reg < 16; ++reg) {
      const int t = mt * 32 + ROWOFF(reg, hf), n = nt * 32 + r;
      W2p[t * 64 + n] = f2bf(w2[reg] + bf2f(Rn[t * 72 + n]));
      YLp[t * 64 + n] = f2bf(yl[reg]);
    }
  } else {
    f32x16 pp, qt;
#pragma unroll
    for (int i = 0; i < 16; ++i) { pp[i] = 0.f; qt[i] = 0.f; }
    mm_tile(CT, 72, NTm + 64 * 72, 72, mt, nt, r, hf, 4, pp);
    mm_tile(KQT, 72, VT, 72, mt, nt, r, hf, 4, qt);
    uint4* Pf = (uint4*)((u16*)(p.ws + WS_PP) + (size_t)item * 4096);
    float* Qf = (float*)(p.ws + WS_Q) + (size_t)item * 4096;
#pragma unroll
    for (int s2 = 0; s2 < 2; ++s2) {
      uint4 o;
      o.x = pack2(pp[s2 * 8 + 0], pp[s2 * 8 + 1]); o.y = pack2(pp[s2 * 8 + 2], pp[s2 * 8 + 3]);
      o.z = pack2(pp[s2 * 8 + 4], pp[s2 * 8 + 5]); o.w = pack2(pp[s2 * 8 + 6], pp[s2 * 8 + 7]);
      Pf[(nt * 4 + mt * 2 + s2) * 64 + lane] = o;
    }
#pragma unroll
    for (int reg = 0; reg < 16; ++reg) Qf[((nt * 2 + mt) * 16 + reg) * 64 + lane] = qt[reg];
  }
}

template <int K_> struct IC { static constexpr int value = K_; };
__device__ __forceinline__ void rwkv_scan(const Params& p, int l, int bh, float* ldsf, bool dry = false) {
  const int tid = opq(threadIdx.x), lane = tid & 63, wave = tid >> 6;
  const int b = bh >> 3, h = bh & 7;
  unsigned char* ring = (unsigned char*)ldsf + 32768;
  uint4* xch = (uint4*)((unsigned char*)ldsf + 32768 + 49152);
  __syncthreads();
  {
    const float* G0 = (const float*)(p.ws + WS_GC);
    for (int e = tid; e < 8192; e += NT) ldsf[e] = G0[(size_t)((b * 128 + (e >> 6)) * 8 + h) * 64 + (e & 63)];
    if (tid < 256) { for (int e = tid; e < 1024; e += 256) xch[e] = make_uint4(0, 0, 0, 0); }
  }
  const bool helper = wave >= 4;
  const u16* PPb = (const u16*)(p.ws + WS_PP);
  const float* Qb = (const float*)(p.ws + WS_Q);
  if (helper) {
    const bool isP = wave < 6;
    const int hidx = isP ? (tid - 256) : (tid - 384);
    const int hdst = isP ? hidx : 512 + hidx;
#define SC_GLOAD(c, R) do { const size_t id_ = (size_t)((b * 128 + (c)) * 8 + h); \
      if (isP) { const uint4* src_ = (const uint4*)(PPb + id_ * 4096) + hidx; R##0 = src_[0]; R##1 = src_[128]; R##2 = src_[256]; R##3 = src_[384]; } \
      else { const uint4* src_ = (const uint4*)(Qb + id_ * 4096) + hidx; R##0 = src_[0]; R##1 = src_[128]; R##2 = src_[256]; R##3 = src_[384]; \
             R##4 = src_[512]; R##5 = src_[640]; R##6 = src_[768]; R##7 = src_[896]; } } while (0)
#define SC_LWRITE(c, R) do { uint4* slot_ = (uint4*)(ring + ((c) & 1) * 24576) + hdst; \
      slot_[0] = R##0; slot_[128] = R##1; slot_[256] = R##2; slot_[384] = R##3; \
      if (!isP) { slot_[512] = R##4; slot_[640] = R##5; slot_[768] = R##6; slot_[896] = R##7; } } while (0)
    uint4 a0, a1, a2, a3, a4, a5, a6, a7, b0, b1, b2, b3, b4, b5, b6, b7, c0, c1, c2, c3, c4, c5, c6, c7, d0, d1, d2, d3, d4, d5, d6, d7;
    a4 = a5 = a6 = a7 = b4 = b5 = b6 = b7 = c4 = c5 = c6 = c7 = d4 = d5 = d6 = d7 = make_uint4(0, 0, 0, 0);
    SC_GLOAD(0, a); SC_LWRITE(0, a);
    SC_GLOAD(1, b); SC_GLOAD(2, c); SC_GLOAD(3, d);
    __syncthreads();
#pragma unroll 1
    for (int cc = 0; cc < 128; cc += 4) {
      if (cc + 4 < 128) SC_GLOAD(cc + 4, a);
      SC_LWRITE(cc + 1, b);
      asm volatile("s_waitcnt lgkmcnt(0)\n\ts_barrier" ::: "memory");
      if (cc + 5 < 128) SC_GLOAD(cc + 5, b);
      SC_LWRITE(cc + 2, c);
      asm volatile("s_waitcnt lgkmcnt(0)\n\ts_barrier" ::: "memory");
      if (cc + 6 < 128) SC_GLOAD(cc + 6, c);
      SC_LWRITE(cc + 3, d);
      asm volatile("s_waitcnt lgkmcnt(0)\n\ts_barrier" ::: "memory");
      if (cc + 7 < 128) SC_GLOAD(cc + 7, d);
      if (cc + 4 < 128) SC_LWRITE(cc + 4, a);
      asm volatile("s_waitcnt lgkmcnt(0)\n\ts_barrier" ::: "memory");
    }
    return;
  }
  __syncthreads();
  const int vt = wave & 1, kt2 = wave >> 1, hf = lane >> 5;
  f32x16 S;
#pragma unroll
  for (int i = 0; i < 16; ++i) S[i] = 0.f;
  uint4 own0 = make_uint4(0, 0, 0, 0), own1 = make_uint4(0, 0, 0, 0);
#pragma unroll 1
  for (int cc = 0; cc < 128; ++cc) {
    const size_t id = (size_t)((b * 128 + cc) * 8 + h);
    const int lofs = opq(lane);
    float* Qg = (float*)Qb + id * 4096 + (vt * 2 + kt2) * 1024 + lofs;
    const uint4* slotA = (const uint4*)(ring + (cc & 1) * 24576) + kt2 * 256 + lofs;
    const float* slotQ = (const float*)(ring + (cc & 1) * 24576 + 8192) + (vt * 2 + kt2) * 1024 + lofs;
    const float* gcp = ldsf + cc * 64 + kt2 * 32 + 4 * (lofs >> 5);
    const uint4* xin = xch + (((cc & 1) * 2 + vt) * 2 + (kt2 ^ 1)) * 128 + lofs;
    uint4* xout = xch + ((((cc + 1) & 1) * 2 + vt) * 2 + kt2) * 128 + lofs;
    f32x16 acc;
#pragma unroll
    for (int reg = 0; reg < 16; ++reg) acc[reg] = S[reg] * gcp[((reg) & 3) + 8 * ((reg) >> 2)] + slotQ[reg * 64];
#pragma unroll
    for (int reg = 0; reg < 16; ++reg) if (!dry) Qg[reg * 64] = S[reg];
    const uint4 p0 = xin[0], p1 = xin[64];
#pragma unroll
    for (int s_ = 0; s_ < 4; ++s_) {
      union { uint4 u; bf16x8 v; } bfr, af;
      const bool mine = (s_ >> 1) == kt2;
      bfr.u = mine ? ((s_ & 1) ? own1 : own0) : ((s_ & 1) ? p1 : p0);
      af.u = slotA[s_ * 64];
      acc = __builtin_amdgcn_mfma_f32_32x32x16_bf16(af.v, bfr.v, acc, 0, 0, 0);
    }
    S = acc;
    own0 = make_uint4(pack2(S[0], S[1]), pack2(S[2], S[3]), pack2(S[4], S[5]), pack2(S[6], S[7]));
    own1 = make_uint4(pack2(S[8], S[9]), pack2(S[10], S[11]), pack2(S[12], S[13]), pack2(S[14], S[15]));
    xout[0] = own0; xout[64] = own1;
    asm volatile("s_waitcnt lgkmcnt(0)\n\ts_barrier" ::: "memory");
  }
  {
    float* o = p.out + O_PWKV + ((size_t)((l * 2 + b) * 8 + h) * 64 + vt * 32 + (lane & 31)) * 64 + kt2 * 32;
#pragma unroll
    for (int reg = 0; reg < 16; ++reg) o[ROWOFF(reg, hf)] = S[reg];
  }
}

__device__ __forceinline__ void rwkv_out(const Params& p, int l, int item, float* ldsf) {
  const int tid = opq(threadIdx.x), lane = tid & 63, wave = tid >> 6;
  const int h = item & 7, cidx = item >> 3;
  float* Sl = ldsf; float* Wl = ldsf + 4160;
  const float* Sg = (const float*)(p.ws + WS_Q) + (size_t)item * 4096;
  const u16* W2 = (const u16*)(p.ws + WS_W2) + (size_t)item * 4096;
  const u16* YL = (const u16*)(p.ws + WS_YL) + (size_t)item * 4096;
  const u16* BO = (const u16*)(p.ws + WS_BO) + (size_t)item * 4096;
  const u16* GA = (const u16*)(p.ws + WS_GA) + (size_t)item * 4096;
  u16* z = (u16*)(p.ws + WS_Z);
  __syncthreads();
  {
    const int row = tid >> 3, c = (tid & 7) * 8;
#pragma unroll
    for (int i = 0; i < 8; ++i) {
      const int idx = i * 512 + tid;
      const int ln = idx & 63, reg = (idx >> 6) & 15, kt = (idx >> 10) & 1, vt = idx >> 11;
      Sl[(vt * 32 + (ln & 31)) * 65 + kt * 32 + ROWOFF(reg, ln >> 5)] = Sg[idx];
    }
    float w[8];
    unpack8(*(const uint4*)(W2 + row * 64 + c), w);
    float* e = Wl + row * 65 + c;
#pragma unroll
    for (int i = 0; i < 8; ++i) e[i] = w[i];
  }
  __syncthreads();
  float y[8];
#pragma unroll
  for (int q = 0; q < 8; ++q) y[q] = bf2f(YL[(wave * 8 + q) * 64 + lane]);
#pragma unroll 2
  for (int k = 0; k < 64; ++k) {
    const float s = Sl[lane * 65 + k];
#pragma unroll
    for (int q = 0; q < 8; ++q) y[q] += s * Wl[(wave * 8 + q) * 65 + k];
  }
  const float lng = p.in[18][l * 512 + h * 64 + lane], lnb = p.in[19][l * 512 + h * 64 + lane];
#pragma unroll
  for (int q = 0; q < 8; ++q) {
    const int t = wave * 8 + q;
    const float mean = wave_sum(y[q]) * (1.f / 64.f);
    const float d = y[q] - mean;
    const float var = wave_sum(d * d) * (1.f / 64.f);
    const float yn = d * rsqrtf(var + 64e-5f) * lng + lnb;
    const float o = (yn + bf2f(BO[t * 64 + lane])) * bf2f(GA[t * 64 + lane]);
    z[(size_t)(cidx * 64 + t) * ZLD + h * 64 + lane] = f2bf(o);
  }
}

__device__ __forceinline__ void rwkv_out4(const Params& p, int l, int item0, float* ldsf) {
  const int tid = opq(threadIdx.x), lane = tid & 63, wave = tid >> 6;
  const int r = lane & 31, hf = lane >> 5;
  const int pair = wave >> 1, nt = wave & 1;
  const int item = item0 + pair;
  const int h = item & 7, cidx = item >> 3;
  u16* Sl = (u16*)ldsf + pair * 4608;
  const float* Sg = (const float*)(p.ws + WS_Q) + (size_t)item * 4096;
  const u16* W2 = (const u16*)(p.ws + WS_W2) + (size_t)item * 4096;
  const u16* YL = (const u16*)(p.ws + WS_YL) + (size_t)item * 4096;
  const u16* BO = (const u16*)(p.ws + WS_BO) + (size_t)item * 4096;
  const u16* GA = (const u16*)(p.ws + WS_GA) + (size_t)item * 4096;
  u16* z = (u16*)(p.ws + WS_Z);
  __syncthreads();
  {
    const int lt = tid & 127;
#pragma unroll
    for (int q = 0; q < 8; ++q) {
      const int e = q * 128 + lt;
      const int ln = e & 63, g = (e >> 6) & 3, kt = (e >> 8) & 1, vt = (e >> 9) & 1;
      const float* sp = Sg + ((vt * 2 + kt) * 16 + 4 * g) * 64 + ln;
      const float a0 = sp[0], a1 = sp[64], a2 = sp[128], a3 = sp[192];
      uint2 o; o.x = pack2(a0, a1); o.y = pack2(a2, a3);
      *(uint2*)(Sl + (vt * 32 + (ln & 31)) * 72 + kt * 32 + 8 * g + 4 * (ln >> 5)) = o;
    }
  }
  bf16x8 bfr[4];
#pragma unroll
  for (int s_ = 0; s_ < 4; ++s_) bfr[s_] = *(const bf16x8*)(W2 + (nt * 32 + r) * 64 + s_ * 16 + hf * 8);
  __syncthreads();
  f32x16 acc[2];
#pragma unroll
  for (int mt = 0; mt < 2; ++mt) {
#pragma unroll
    for (int i = 0; i < 16; ++i) acc[mt][i] = 0.f;
#pragma unroll
    for (int s_ = 0; s_ < 4; ++s_) {
      const bf16x8 a = *(const bf16x8*)(Sl + (mt * 32 + r) * 72 + s_ * 16 + hf * 8);
      acc[mt] = __builtin_amdgcn_mfma_f32_32x32x16_bf16(a, bfr[s_], acc[mt], 0, 0, 0);
    }
  }
  const int t = nt * 32 + r;
  float sum = 0.f;
#pragma unroll
  for (int mt = 0; mt < 2; ++mt)
#pragma unroll
    for (int g = 0; g < 4; ++g) {
      const uint2 yl = *(const uint2*)(YL + t * 64 + mt * 32 + 8 * g + 4 * hf);
      acc[mt][4 * g + 0] += __uint_as_float(yl.x << 16); acc[mt][4 * g + 1] += __uint_as_float(yl.x & 0xFFFF0000u);
      acc[mt][4 * g + 2] += __uint_as_float(yl.y << 16); acc[mt][4 * g + 3] += __uint_as_float(yl.y & 0xFFFF0000u);
      sum += acc[mt][4 * g] + acc[mt][4 * g + 1] + acc[mt][4 * g + 2] + acc[mt][4 * g + 3];
    }
  sum += __shfl_xor(sum, 32, 64);
  const float mean = sum * (1.f / 64.f);
  float vs = 0.f;
#pragma unroll
  for (int mt = 0; mt < 2; ++mt)
#pragma unroll
    for (int i = 0; i < 16; ++i) { const float d = acc[mt][i] - mean; vs += d * d; }
  vs += __shfl_xor(vs, 32, 64);
  const float rstd = rsqrtf(vs * (1.f / 64.f) + 64e-5f);
  const float* lng = p.in[18] + l * 512 + h * 64;
  const float* lnb = p.in[19] + l * 512 + h * 64;
  u16* zrow = z + (size_t)(cidx * 64 + t) * ZLD + h * 64;
#pragma unroll
  for (int mt = 0; mt < 2; ++mt)
#pragma unroll
    for (int g = 0; g < 4; ++g) {
      const int v0 = mt * 32 + 8 * g + 4 * hf;
      const uint2 bo = *(const uint2*)(BO + t * 64 + v0);
      const uint2 ga = *(const uint2*)(GA + t * 64 + v0);
      const float4 lg = *(const float4*)(lng + v0), lb = *(const float4*)(lnb + v0);
      const float bo_[4] = {__uint_as_float(bo.x << 16), __uint_as_float(bo.x & 0xFFFF0000u), __uint_as_float(bo.y << 16), __uint_as_float(bo.y & 0xFFFF0000u)};
      const float ga_[4] = {__uint_as_float(ga.x << 16), __uint_as_float(ga.x & 0xFFFF0000u), __uint_as_float(ga.y << 16), __uint_as_float(ga.y & 0xFFFF0000u)};
      const float lg_[4] = {lg.x, lg.y, lg.z, lg.w}, lb_[4] = {lb.x, lb.y, lb.z, lb.w};
      float o[4];
#pragma unroll
      for (int u = 0; u < 4; ++u) o[u] = ((acc[mt][4 * g + u] - mean) * rstd * lg_[u] + lb_[u] + bo_[u]) * ga_[u];
      uint2 ov; ov.x = pack2(o[0], o[1]); ov.y = pack2(o[2], o[3]);
      *(uint2*)(zrow + v0) = ov;
    }
}

__device__ __forceinline__ void attn_prompt(const Params& p, int l, int item, u16* lds, bool dry = false) {
  const int tid = opq(threadIdx.x), lane = tid & 63, wave = tid >> 6;
  const int r = lane & 31, h = lane >> 5;
  const int kvh = item & 1, n = (item >> 1) & 63, b = item >> 7;
  u16* z = (u16*)(p.ws + WS_Z);
  u16* Ks = lds;
  u16* Vt = lds + 256 * 72;
  __syncthreads();
  {
    const int key = tid >> 1, half = tid & 1;
    const int t = (n - 1) * 128 + key;
    uint4 kv[4], vv[4];
    if (t >= 0) {
      const u16* kp = z + (size_t)(b * 8192 + t) * ZLD + 2304 + kvh * 64 + half * 32;
      const u16* vp = z + (size_t)(b * 8192 + t) * ZLD + 2432 + kvh * 64 + half * 32;
#pragma unroll
      for (int i = 0; i < 4; ++i) { kv[i] = *(const uint4*)(kp + i * 8); vv[i] = *(const uint4*)(vp + i * 8); }
    } else {
#pragma unroll
      for (int i = 0; i < 4; ++i) { kv[i] = make_uint4(0, 0, 0, 0); vv[i] = make_uint4(0, 0, 0, 0); }
    }
#pragma unroll
    for (int i = 0; i < 4; ++i) {
      *(uint4*)(Ks + key * 72 + half * 32 + i * 8) = kv[i];
      const unsigned w[4] = {vv[i].x, vv[i].y, vv[i].z, vv[i].w};
#pragma unroll
      for (int q = 0; q < 4; ++q) {
        const int d = half * 32 + i * 8 + q * 2;
        Vt[d * 264 + key] = (u16)(w[q] & 0xFFFFu);
        Vt[(d + 1) * 264 + key] = (u16)(w[q] >> 16);
      }
    }
  }
  __syncthreads();
#pragma unroll 1
  for (int uu = 0; uu < 2; ++uu) {
    const int u = wave * 2 + uu;
    const int hq = kvh * 4 + (u >> 2), qg = u & 3;
    const int qrow = b * 8192 + n * 128 + qg * 32 + r;
    u16* qp = z + (size_t)qrow * ZLD + 1792 + hq * 64;
    bf16x8 qf[4];
#pragma unroll
    for (int s = 0; s < 4; ++s) qf[s] = *(const bf16x8*)(qp + s * 16 + h * 8);
    f32x16 sc[5];
#pragma unroll
    for (int i5 = 0; i5 < 5; ++i5) {
#pragma unroll
      for (int i = 0; i < 16; ++i) sc[i5][i] = 0.f;
      const int kt = qg + i5;
#pragma unroll
      for (int s = 0; s < 4; ++s) {
        bf16x8 kf = *(const bf16x8*)(Ks + (kt * 32 + r) * 72 + s * 16 + h * 8);
        sc[i5] = __builtin_amdgcn_mfma_f32_32x32x16_bf16(kf, qf[s], sc[i5], 0, 0, 0);
      }
      __builtin_amdgcn_sched_barrier(0);
    }
    const int qi = qg * 32 + r;
    const float sink = p.in[20][l * 8 + hq];
    float mx = -1e30f;
#pragma unroll
    for (int i5 = 0; i5 < 5; ++i5)
#pragma unroll
      for (int reg = 0; reg < 16; ++reg) {
        const int j = (qg + i5) * 32 + ROWOFF(reg, h);
        const bool ok = (j > qi) && (j <= qi + 128) && (n > 0 || j >= 128);
        const float s = ok ? sc[i5][reg] * 0.125f : -1e30f;
        sc[i5][reg] = s;
        mx = fmaxf(mx, s);
      }
    mx = fmaxf(mx, __shfl_xor(mx, 32, 64));
    mx = fmaxf(mx, sink);
    float sum = 0.f;
#pragma unroll
    for (int i5 = 0; i5 < 5; ++i5)
#pragma unroll
      for (int reg = 0; reg < 16; ++reg) { const float e = __expf(sc[i5][reg] - mx); sc[i5][reg] = e; sum += e; }
    sum += __shfl_xor(sum, 32, 64);
    const float rden = 1.f / (sum + __expf(sink - mx));
    f32x16 oacc[2];
#pragma unroll
    for (int i = 0; i < 16; ++i) { oacc[0][i] = 0.f; oacc[1][i] = 0.f; }
#pragma unroll
    for (int i5 = 0; i5 < 5; ++i5) {
      const int kt = qg + i5;
#pragma unroll
      for (int s2 = 0; s2 < 2; ++s2) {
        bf16x8 pf;
#pragma unroll
        for (int j = 0; j < 8; ++j) pf[j] = (short)f2bf(sc[i5][s2 * 8 + j] * rden);
#pragma unroll
        for (int dt = 0; dt < 2; ++dt) {
          const u16* vp = Vt + (dt * 32 + r) * 264 + kt * 32 + s2 * 16 + h * 4;
          const uint2 lo = *(const uint2*)vp, hi = *(const uint2*)(vp + 8);
          union { uint4 u; bf16x8 v; } cv;
          cv.u = make_uint4(lo.x, lo.y, hi.x, hi.y);
          oacc[dt] = __builtin_amdgcn_mfma_f32_32x32x16_bf16(cv.v, pf, oacc[dt], 0, 0, 0);
        }
        __builtin_amdgcn_sched_barrier(0);
      }
    }
#pragma unroll
    for (int dt = 0; dt < 2; ++dt)
#pragma unroll
      for (int g4 = 0; g4 < 4; ++g4) {
        const int d = dt * 32 + 8 * g4 + 4 * h;
        uint2 o;
        o.x = pack2(oacc[dt][g4 * 4 + 0], oacc[dt][g4 * 4 + 1]);
        o.y = pack2(oacc[dt][g4 * 4 + 2], oacc[dt][g4 * 4 + 3]);
        if (!dry) *(uint2*)(qp + d) = o;
      }
  }
}

__device__ __forceinline__ void attn_sample(const Params& p, int l, int item, float* ldsf, bool dry = false) {
  const int tid = opq(threadIdx.x);
  const int kvh = item & 1, b = item >> 1;
  u16* z = (u16*)(p.ws + WS_Z);
  float* Kl = ldsf;
  float* Vl = ldsf + 132 * 65;
  float* Ql = Vl + 132 * 65;
  float* Pl = Ql + 16 * 64;
  __syncthreads();
  for (int e = tid; e < 132 * 8; e += NT) {
    const int j = e >> 3, c = (e & 7) * 8;
    float k[8], v[8];
    if (j < 128) {
      const float* kp = p.in[4] + ((size_t)((l * 128 + b) * 128 + j) * 2 + kvh) * 64 + c;
      const float* vp = p.in[5] + ((size_t)((l * 128 + b) * 128 + j) * 2 + kvh) * 64 + c;
      float4 a = *(const float4*)kp, a2 = *(const float4*)(kp + 4);
      float4 c1 = *(const float4*)vp, c2 = *(const float4*)(vp + 4);
      k[0] = a.x; k[1] = a.y; k[2] = a.z; k[3] = a.w; k[4] = a2.x; k[5] = a2.y; k[6] = a2.z; k[7] = a2.w;
      v[0] = c1.x; v[1] = c1.y; v[2] = c1.z; v[3] = c1.w; v[4] = c2.x; v[5] = c2.y; v[6] = c2.z; v[7] = c2.w;
    } else {
      const size_t row = M_P + b * 4 + (j - 128);
      unpack8(*(const uint4*)(z + row * ZLD + 2304 + kvh * 64 + c), k);
      unpack8(*(const uint4*)(z + row * ZLD + 2432 + kvh * 64 + c), v);
    }
#pragma unroll
    for (int i = 0; i < 8; ++i) { Kl[j * 65 + c + i] = k[i]; Vl[j * 65 + c + i] = v[i]; }
    if (j >= 4) {
      float* ok = p.out + O_SK + ((size_t)((l * 128 + b) * 128 + (j - 4)) * 2 + kvh) * 64 + c;
      float* ov = p.out + O_SV + ((size_t)((l * 128 + b) * 128 + (j - 4)) * 2 + kvh) * 64 + c;
      *(float4*)ok = make_float4(k[0], k[1], k[2], k[3]); *(float4*)(ok + 4) = make_float4(k[4], k[5], k[6], k[7]);
      *(float4*)ov = make_float4(v[0], v[1], v[2], v[3]); *(float4*)(ov + 4) = make_float4(v[4], v[5], v[6], v[7]);
    }
  }
  if (tid < 128) {
    const int row = tid >> 3, c = (tid & 7) * 8;
    const int hl = row >> 2, t = row & 3;
    float q[8];
    unpack8(*(const uint4*)(z + (size_t)(M_P + b * 4 + t) * ZLD + 1792 + (kvh * 4 + hl) * 64 + c), q);
#pragma unroll
    for (int i = 0; i < 8; ++i) Ql[row * 64 + c + i] = q[i];
  }
  __syncthreads();
  const int row = tid >> 5, jl = tid & 31;
  const int t = row & 3, hq = kvh * 4 + (row >> 2);
  float sc[5];
  float mx = -1e30f;
#pragma unroll
  for (int jj = 0; jj < 5; ++jj) {
    const int j = jl + 32 * jj;
    float s = -1e30f;
    if (j < 132 && j > t && j <= t + 128) {
      float a = 0.f;
#pragma unroll 8
      for (int d = 0; d < 64; ++d) a += Ql[row * 64 + d] * Kl[j * 65 + d];
      s = a * 0.125f;
    }
    sc[jj] = s; mx = fmaxf(mx, s);
    __builtin_amdgcn_sched_barrier(0);
  }
#pragma unroll
  for (int o = 16; o >= 1; o >>= 1) mx = fmaxf(mx, __shfl_xor(mx, o, 64));
  const float sink = p.in[20][l * 8 + hq];
  mx = fmaxf(mx, sink);
  float sum = 0.f;
#pragma unroll
  for (int jj = 0; jj < 5; ++jj) { sc[jj] = __expf(sc[jj] - mx); sum += sc[jj]; }
#pragma unroll
  for (int o = 16; o >= 1; o >>= 1) sum += __shfl_xor(sum, o, 64);
  const float rden = 1.f / (sum + __expf(sink - mx));
#pragma unroll
  for (int jj = 0; jj < 5; ++jj) { const int j = jl + 32 * jj; if (j < 136) Pl[row * 136 + j] = sc[jj] * rden; }
  __syncthreads();
  {
    const int d = jl * 2;
    float o0 = 0.f, o1 = 0.f;
#pragma unroll 4
    for (int j = 0; j < 132; ++j) { const float pr = Pl[row * 136 + j]; o0 += pr * Vl[j * 65 + d]; o1 += pr * Vl[j * 65 + d + 1]; }
    if (!dry) *(unsigned*)(z + (size_t)(M_P + b * 4 + t) * ZLD + 1792 + hq * 64 + d) = pack2(o0, o1);
  }
}

__device__ __forceinline__ void phase_convgelu(const Params& p, int l, bool dry = false) {
  u16* cu = (u16*)(p.ws + WS_CU);
  const float* cw = p.in[26] + (size_t)l * 3 * 2816;
  const float* cb = p.in[27] + (size_t)l * 2816;
  for (int it = blockIdx.x; it < 1056; it += gridDim.x) {
    const int tid = opq(threadIdx.x);
    if (tid >= 352) continue;
    const int j0 = tid * 8;
    float w0[8], w1[8], w2[8], bb[8];
#pragma unroll
    for (int i = 0; i < 8; ++i) { w0[i] = cw[j0 + i]; w1[i] = cw[2816 + j0 + i]; w2[i] = cw[5632 + j0 + i]; bb[i] = cb[j0 + i]; }
    float c1[8], c2[8];
    for (int rr = 0; rr < 16; ++rr) {
      const int row = it * 16 + rr;
      const bool prompt = row < M_P;
      int b, t;
      if (prompt) { b = row >> 13; t = row & 8191; } else { b = (row - M_P) >> 2; t = (row - M_P) & 3; }
      if (t == 0) {
        if (prompt) {
#pragma unroll
          for (int i = 0; i < 8; ++i) { c1[i] = 0.f; c2[i] = 0.f; }
        } else {
          const float* st = p.in[6] + (size_t)((l * 128 + b) * 2) * 2816 + j0;
#pragma unroll
          for (int i = 0; i < 8; ++i) { c2[i] = st[i]; c1[i] = st[2816 + i]; }
        }
      } else if (rr == 0) {
        unpack8(*(const uint4*)(cu + (size_t)(row - 1) * 5632 + j0), c1);
        if (t >= 2) unpack8(*(const uint4*)(cu + (size_t)(row - 2) * 5632 + j0), c2);
        else {
#pragma unroll
          for (int i = 0; i < 8; ++i) c2[i] = 0.f;
        }
      }
      float c0[8], up[8], a[8];
      unpack8(*(const uint4*)(cu + (size_t)row * 5632 + j0), c0);
      unpack8(*(const uint4*)(cu + (size_t)row * 5632 + 2816 + j0), up);
#pragma unroll
      for (int i = 0; i < 8; ++i) {
        const float cv = bb[i] + w0[i] * c2[i] + w1[i] * c1[i] + w2[i] * c0[i];
        a[i] = gelu_fast(cv) * up[i];
      }
      if (!dry) *(uint4*)(cu + (size_t)row * 5632 + 2816 + j0) = pack8(a);
      if (prompt && t >= 8190) {
        float* o = p.out + O_PCONV + (size_t)((l * 2 + b) * 2 + (t - 8190)) * 2816 + j0;
        *(float4*)o = make_float4(c0[0], c0[1], c0[2], c0[3]); *(float4*)(o + 4) = make_float4(c0[4], c0[5], c0[6], c0[7]);
      } else if (!prompt && t >= 2) {
        float* o = p.out + O_SCONV + (size_t)((l * 128 + b) * 2 + (t - 2)) * 2816 + j0;
        *(float4*)o = make_float4(c0[0], c0[1], c0[2], c0[3]); *(float4*)(o + 4) = make_float4(c0[4], c0[5], c0[6], c0[7]);
      }
#pragma unroll
      for (int i = 0; i < 8; ++i) { c2[i] = c1[i]; c1[i] = c0[i]; }
    }
  }
}

__device__ __forceinline__ void phase_final(const Params& p) {
  float* X = p.out;
  const float* g = p.in[29];
  for (int it = blockIdx.x; it < 2112; it += gridDim.x) {
    const int tid = opq(threadIdx.x);
    const int lane = tid & 63;
    const int row = it * 8 + (tid >> 6);
    float4 v[4];
    float ss = 0.f;
#pragma unroll
    for (int i = 0; i < 4; ++i) {
      v[i] = *(const float4*)(X + (size_t)row * 1024 + i * 256 + lane * 4);
      if (gridDim.x == 256 && row >= M_P) {
        const u16* partb = (const u16*)(p.ws + WS_DP) + (size_t)(row - M_P) * 1024 + i * 256 + lane * 4;
        for (int k = 0; k < 11; ++k) { const uint2 q = *(const uint2*)(partb + (size_t)k * 512 * 1024);
          v[i].x += __uint_as_float(q.x << 16); v[i].y += __uint_as_float(q.x & 0xFFFF0000u); v[i].z += __uint_as_float(q.y << 16); v[i].w += __uint_as_float(q.y & 0xFFFF0000u); }
      }
      ss += v[i].x * v[i].x + v[i].y * v[i].y + v[i].z * v[i].z + v[i].w * v[i].w;
    }
    ss = wave_sum(ss);
    const float rs = rsqrtf(ss * (1.f / 1024.f) + 1e-6f);
#pragma unroll
    for (int i = 0; i < 4; ++i) {
      const float4 gg = *(const float4*)(g + i * 256 + lane * 4);
      *(float4*)(X + (size_t)row * 1024 + i * 256 + lane * 4) =
          make_float4(v[i].x * rs * gg.x, v[i].y * rs * gg.y, v[i].z * rs * gg.z, v[i].w * rs * gg.w);
    }
  }
}

#define XB_TMO      128
#define XB_XCNT(j)  (256  + 64 * (j))
#define XB_XSUB(j)  (1280 + 64 * (j))
#define XB_XGEN(j)  (2304 + 64 * (j))
#define XB_TOP      3328
#define XB_TOPGEN   3392
#define XCD_BAR_WORDS 3456
#define XB_SPIN_CAP (1u << 18)
#define LAS __attribute__((address_space(3)))

__device__ __forceinline__ unsigned xb_ld(unsigned* p)              { return __hip_atomic_load(p, __ATOMIC_RELAXED, __HIP_MEMORY_SCOPE_AGENT); }
__device__ __forceinline__ unsigned xb_add(unsigned* p, unsigned v) { return __hip_atomic_fetch_add(p, v, __ATOMIC_RELAXED, __HIP_MEMORY_SCOPE_AGENT); }
__device__ __forceinline__ unsigned xb_xcc_id() { return (unsigned)__builtin_amdgcn_s_getreg((3 << 11) | 20) & 0xFu; }
#define XB_SPIN(cond, bar) do { unsigned _sp = 0; while (cond) { __builtin_amdgcn_s_sleep(1); \
    if ((++_sp & 255u) == 0u) { if (xb_ld(&(bar)[XB_TMO])) break; if (_sp > XB_SPIN_CAP) { atomicAdd(&(bar)[XB_TMO], 1u); break; } } } } while (0)

struct XcdBarrier {
    unsigned* bar; unsigned x;
    volatile LAS unsigned* st;
};

__device__ __forceinline__ XcdBarrier xcd_barrier_post(unsigned* bar, volatile LAS unsigned* st) {
    XcdBarrier b; b.bar = bar; b.x = xb_xcc_id(); b.st = st;
    if (threadIdx.x == 0) (void)xb_add(&bar[XB_XCNT(b.x)], 1u);
    return b;
}
__device__ __forceinline__ void xcd_barrier_complete(unsigned* bar, unsigned x, unsigned& nloc, unsigned& nx) {
    const unsigned G = gridDim.x * gridDim.y * gridDim.z;
    unsigned sum, cnt, mine, sp = 0u;
    for (;;) {
        sum = 0u; cnt = 0u; mine = 0u;
#pragma unroll
        for (unsigned j = 0; j < 16; ++j) { const unsigned c = xb_ld(&bar[XB_XCNT(j)]); sum += c; cnt += (c > 0u) ? 1u : 0u; mine = (j == x) ? c : mine; }
        if (sum == G) break;
        __builtin_amdgcn_s_sleep(1);
        if ((++sp & 255u) == 0u) { if (xb_ld(&bar[XB_TMO])) break; if (sp > XB_SPIN_CAP) { atomicAdd(&bar[XB_TMO], 1u); break; } }
    }
    nloc = mine > 0u ? mine : 1u; nx = cnt > 0u ? cnt : 1u;
}

__device__ __forceinline__ void xcd_barrier(const XcdBarrier& b) {
    asm volatile("s_waitcnt vmcnt(0)" ::: "memory");
    __syncthreads();
    if (threadIdx.x == 0) {
        unsigned* bar = b.bar;
        __builtin_amdgcn_s_waitcnt(0);
        unsigned nloc = b.st[0], nx = b.st[1];
        if (nloc == 0u) { xcd_barrier_complete(bar, b.x, nloc, nx); b.st[0] = nloc; b.st[1] = nx; }
        const unsigned old = xb_add(&bar[XB_XSUB(b.x)], 1u);
        const unsigned gen = old / nloc;
        if (old + 1u == (gen + 1u) * nloc) {
            __builtin_amdgcn_fence(__ATOMIC_RELEASE, "agent");
            asm volatile("s_waitcnt vmcnt(0)" ::: "memory");
            const unsigned og = xb_add(&bar[XB_TOP], 1u);
            const unsigned tg = og / nx;
            if (og + 1u == (tg + 1u) * nx) xb_add(&bar[XB_TOPGEN], 1u);
            else XB_SPIN(xb_ld(&bar[XB_TOPGEN]) == tg, bar);
            __builtin_amdgcn_fence(__ATOMIC_ACQUIRE, "agent");
            xb_add(&bar[XB_XGEN(b.x)], 1u);
            asm volatile("s_waitcnt vmcnt(0)" ::: "memory");
        } else {
            XB_SPIN(xb_ld(&bar[XB_XGEN(b.x)]) == gen, bar);
            __builtin_amdgcn_fence(__ATOMIC_ACQUIRE, "agent");
            asm volatile("s_waitcnt vmcnt(0)" ::: "memory");
        }
    }
    __syncthreads();
}

#define WS_BAR 256000000ull
#if COOP
#ifndef SYNC_RPT
#define SYNC_RPT 1
#endif
#define PH_SYNC(idx) do { if ((idx) + 1 < ph_hi && (idx) >= ph_lo) { for (int sr_ = 0; sr_ < SYNC_RPT; ++sr_) xcd_barrier(xb); } } while (0)
#else
#define PH_SYNC(idx) do { } while (0)
#endif
#define PH_ON(idx, bit) (((KMASK >> (bit)) & 1) && ph_lo <= (idx) && (idx) < ph_hi)

__device__ __forceinline__ Params load_params() {
  auto kp0 = __builtin_amdgcn_kernarg_segment_ptr();
  asm volatile("" : "+s"(kp0));
  auto kq = (const __constant__ unsigned long long*)kp0;
  Params p;
#pragma unroll
  for (int i = 0; i < 30; ++i) p.in[i] = (const float*)kq[i];
  p.out = (float*)kq[30];
  p.ws = (unsigned char*)kq[31];
  p.ph_lo = 0; p.ph_hi = 0;
  return p;
}

template <int KMASK, int l>
__device__ __forceinline__ void layer_phases(int ph_lo, int ph_hi, unsigned char* lds_raw, const XcdBarrier& xb) {
  float* ldsf = (float*)lds_raw;
  u16* ldsh = (u16*)lds_raw;
  const int base = l * 12;
  if (PH_ON(base + 0, 0)) { const Params p = load_params(); RPT(0) phase_prep(p, l, 0, ldsf); }
  PH_SYNC(base + 0);
  if (PH_ON(base + 1, 1)) {
    const Params p = load_params();
    EpiInproj E; E.z = (u16*)(p.ws + WS_Z); E.out = p.out; E.l = l;
    RPT(1) run_gemm(lds_raw, (const u16*)(p.ws + WS_H), 1024, (const u16*)(p.ws + WS_WT) + WT_IN, 2560, 1024, E);
  }
  PH_SYNC(base + 1);
  if (PH_ON(base + 2, 2)) {
    const Params p = load_params();
    for (int it = blockIdx.x; it < 264; it += gridDim.x) rope_item(p, l, it, false);
    if (blockIdx.x < 64) rwkv_item(p, l, 2048 + blockIdx.x, ldsf, false);
    {
      const Params p2 = load_params();
      int i0, n;
      if (gridDim.x == 256) { if (blockIdx.x < 64) { i0 = blockIdx.x * 5; n = 5; } else { i0 = 320 + (blockIdx.x - 64) * 9; n = 9; } }
      else { i0 = 0; n = 0; }
      RPT(2) {
        if (gridDim.x == 256) { for (int i = 0; i < n; ++i) rwkv_item2(p2, l, i0 + i, ldsf); }
        else { for (int it = blockIdx.x; it < 2048; it += gridDim.x) rwkv_item2(p2, l, it, ldsf); }
      }
    }
  }
  PH_SYNC(base + 2);
  if (PH_ON(base + 3, 3)) {
    const Params p = load_params();
    if (blockIdx.x < 16) { RPT(3) rwkv_scan(p, l, blockIdx.x, ldsf, DRY(3)); }
    else {
      RPT(15) for (int it = blockIdx.x - 16; it < 512; it += gridDim.x - 16) {
        if (it < 256) attn_prompt(p, l, it, ldsh, DRY(15)); else attn_sample(p, l, it - 256, ldsf, DRY(15));
      }
    }
  }
  PH_SYNC(base + 3);
  if (PH_ON(base + 4, 4)) {
    const Params p = load_params();
    RPT(4) for (int it = blockIdx.x * 4; it < 2048; it += gridDim.x * 4) rwkv_out4(p, l, it, ldsf);
  }
  PH_SYNC(base + 4);
  if (PH_ON(base + 5, 5)) {
    const Params p = load_params();
    EpiStoreBf16 E1; E1.O = (u16*)(p.ws + WS_T1); E1.ldc = 1024; E1.rowoff = 0;
    EpiStoreBf16 E2; E2.O = (u16*)(p.ws + WS_T2); E2.ldc = 1024; E2.rowoff = 0;
    const u16* zA = (const u16*)(p.ws + WS_Z);
    const u16* Wr = (const u16*)(p.ws + WS_WT) + WT_BRA;
    const u16* Wa = (const u16*)(p.ws + WS_WT) + WT_BRB;
    RPT(5) {
      if (gridDim.x == 256) {
        run_gemm_ex(lds_raw, zA, ZLD, Wr, 512, M_P, 1024, 512, 256, (int)blockIdx.x, E1);
        run_gemm_ex(lds_raw, zA + 1792, ZLD, Wa, 512, M_P, 1024, 512, 256, (int)blockIdx.x, E2);
        EpiStoreBf16 E3 = (blockIdx.x < 8) ? E1 : E2; E3.rowoff = M_P;
        run_gemm_ex(lds_raw, zA + (size_t)M_P * ZLD + ((blockIdx.x < 8) ? 0 : 1792), ZLD, (blockIdx.x < 8) ? Wr : Wa, 512, 512, 1024, 512, 8,
                    (blockIdx.x < 16) ? (int)(blockIdx.x & 7) : -1, E3);
      } else {
        run_gemm(lds_raw, zA, ZLD, Wr, 1024, 512, E1);
        run_gemm(lds_raw, zA + 1792, ZLD, Wa, 1024, 512, E2);
      }
    }
  }
  PH_SYNC(base + 5);
  if (PH_ON(base + 6, 6)) {
    const Params p = load_params();
    EpiMerge E; E.t1 = (const u16*)(p.ws + WS_T1); E.t2 = (const u16*)(p.ws + WS_T2); E.mg = (u16*)(p.ws + WS_MG);
    RPT(6) run_gemm(lds_raw, (const u16*)(p.ws + WS_H), 1024, (const u16*)(p.ws + WS_WT) + WT_G, 2048, 1024, E);
  }
  PH_SYNC(base + 6);
  if (PH_ON(base + 7, 7)) {
    const Params p = load_params();
    EpiResid E; E.X = p.out;
    RPT(7) {
      E.dry = DRY(7); E.X = p.out; E.pbf = nullptr;
      if (gridDim.x == 256) {
        E.atomic = false; E.rowoff = 0;
        run_gemm_ex(lds_raw, (const u16*)(p.ws + WS_MG), 1024, (const u16*)(p.ws + WS_WT) + WT_OUT, 1024, M_P, 1024, 1024, 256, (int)blockIdx.x, E);
        const int ks = blockIdx.x >> 3;
        E.atomic = true; E.rowoff = 0; E.X = (float*)(p.ws + WS_T1) + (size_t)ks * 512 * 1024;
        run_gemm_ex(lds_raw, (const u16*)(p.ws + WS_MG) + (size_t)M_P * 1024 + ks * 256, 1024, (const u16*)(p.ws + WS_WT) + WT_OUT + ks * 256, 1024,
                    512, 1024, 256, 8, (blockIdx.x < 32) ? (int)(blockIdx.x & 7) : -1, E);
      } else {
        E.atomic = false; E.rowoff = 0;
        run_gemm(lds_raw, (const u16*)(p.ws + WS_MG), 1024, (const u16*)(p.ws + WS_WT) + WT_OUT, 1024, 1024, E);
      }
    }
  }
  PH_SYNC(base + 7);
  if (PH_ON(base + 8, 8)) { const Params p = load_params(); RPT(8) phase_prep(p, l, 1, ldsf); }
  PH_SYNC(base + 8);
  if (PH_ON(base + 9, 9)) {
    const Params p = load_params();
    EpiFfnIn E; E.cu = (u16*)(p.ws + WS_CU);
    RPT(9) run_gemm(lds_raw, (const u16*)(p.ws + WS_H), 1024, (const u16*)(p.ws + WS_WTF) + WT_FIN, 5632, 1024, E);
  }
  PH_SYNC(base + 9);
  if (PH_ON(base + 10, 10)) { const Params p = load_params(); RPT(10) phase_convgelu(p, l, DRY(10)); }
  PH_SYNC(base + 10);
  if (PH_ON(base + 11, 11)) {
    const Params p = load_params();
    EpiResid E; E.X = p.out;
    RPT(11) {
      E.dry = DRY(11); E.X = p.out; E.pbf = nullptr;
      const u16* Aa = (const u16*)(p.ws + WS_CU) + 2816;
      const u16* Bd = (const u16*)(p.ws + WS_WTF) + WT_FDN;
      if (gridDim.x == 256) {
        E.atomic = false; E.rowoff = 0;
        run_gemm_ex(lds_raw, Aa, 5632, Bd, 2816, M_P, 1024, 2816, 256, (int)blockIdx.x, E);
        const int ks = blockIdx.x >> 3;
        E.atomic = true; E.rowoff = 0; E.X = nullptr; E.pbf = (u16*)(p.ws + WS_DP) + (size_t)ks * 512 * 1024;
        run_gemm_ex(lds_raw, Aa + (size_t)M_P * 5632 + ks * 256, 5632, Bd + ks * 256, 2816, 512, 1024, 256, 8, (blockIdx.x < 88) ? (int)(blockIdx.x & 7) : -1, E);
      } else {
        E.atomic = false; E.rowoff = 0;
        run_gemm(lds_raw, Aa, 5632, Bd, 1024, 2816, E);
      }
    }
  }
  PH_SYNC(base + 11);
}

template <int KMASK>
__global__ void __launch_bounds__(NT) fwd_kernel(Params pin) {
  extern __shared__ __attribute__((aligned(16))) unsigned char lds_raw[];
  const int ph_lo = pin.ph_lo, ph_hi = pin.ph_hi;
  XcdBarrier xb;
  {
    volatile LAS unsigned* st = (volatile LAS unsigned*)(lds_raw + (LDS_BYTES - 16));
    if (threadIdx.x < 2) st[threadIdx.x] = 0u;
    __syncthreads();
    xb = xcd_barrier_post((unsigned*)(pin.ws + WS_BAR), st);
  }
  if (ph_hi > 100000) cg::this_grid().sync();
  layer_phases<KMASK, 0>(ph_lo, ph_hi, lds_raw, xb);
  layer_phases<KMASK, 1>(ph_lo, ph_hi, lds_raw, xb);
  if (PH_ON(NPH - 1, 12)) { const Params p = load_params(); phase_final(p); }
}

extern "C" void kernel_launch(void* const* d_in, const int* in_sizes, int n_in, void* d_out, int out_size, void* d_ws,
                              size_t ws_size, hipStream_t stream) {
  static int grid = 0;
  if (grid == 0) {
    int dev = 0, cus = 0;
    (void)hipGetDevice(&dev);
    (void)hipDeviceGetAttribute(&cus, hipDeviceAttributeMultiprocessorCount, dev);
    grid = cus > 0 ? cus : 256;
    (void)hipFuncSetAttribute((const void*)fwd_kernel<PHMASK>, hipFuncAttributeMaxDynamicSharedMemorySize, LDS_BYTES);
    (void)hipGetLastError();
  }
  Params p{};
  for (int i = 0; i < 30; ++i) p.in[i] = (const float*)d_in[i];
  p.out = (float*)d_out;
  p.ws = (unsigned char*)d_ws;
#if COOP
  (void)hipMemsetAsync((unsigned char*)d_ws + WS_BAR, 0, XCD_BAR_WORDS * 4, stream);
  p.ph_lo = 0; p.ph_hi = NPH;
  void* args[] = {&p};
  hipError_t e = hipLaunchCooperativeKernel((const void*)fwd_kernel<PHMASK>, dim3(grid), dim3(NT), args, LDS_BYTES, stream);
  if (e != hipSuccess) fprintf(stderr, "cooperative launch failed: %s (grid %d)\n", hipGetErrorString(e), grid);
#else
  for (int ph = 0; ph < NPH; ++ph) {
    p.ph_lo = ph; p.ph_hi = ph + 1;
    hipLaunchKernelGGL(fwd_kernel<PHMASK>, dim3(grid), dim3(NT), LDS_BYTES, stream, p);
  }
#endif
}
```

```cpp
#include <hip/hip_runtime.h>
#include <hip/hip_bf16.h>
#include <hip/hip_cooperative_groups.h>
#include <cstdio>
namespace cg = cooperative_groups;

typedef __attribute__((ext_vector_type(8))) short bf16x8;
typedef __attribute__((ext_vector_type(16))) float f32x16;
typedef unsigned short u16;

#ifndef PHMASK
#define PHMASK 0x1FFF
#endif
#ifndef T3
#define T3 7
#endif
#ifndef P2SEL
#define P2SEL 7
#endif
#ifndef RPT_MASK
#define RPT_MASK 0
#endif
#ifndef RPT_N
#define RPT_N 1
#endif
#define RPT(bit) for (int rp_ = 0; rp_ < (((RPT_MASK >> (bit)) & 1) ? 1 + RPT_N : 1); ++rp_)
#define RPT_CNT(bit) (((RPT_MASK >> (bit)) & 1) ? 1 + RPT_N : 1)
#define DRY(bit) (opq(rp_) + 1 < RPT_CNT(bit))
#ifndef R1P
#define R1P 1
#endif
#ifndef COOP
#define COOP 1
#endif

#define NT 512
#define M_TOT 16896
#define M_P 16384
#define ZLD 2560
#define NPH 25

#define WS_WT   0ull
#define WS_H    13631488ull
#define WS_Z    48234496ull
#define WS_R    134742016ull
#define WS_PP   (WS_R)
#define WS_GC   (WS_R + 16777216ull)
#define WS_Q    (WS_R + 17301504ull)
#define WS_W2   (WS_R + 50855936ull)
#define WS_YL   (WS_R + 67633152ull)
#define WS_BO   (WS_R + 84410368ull)
#define WS_GA   (WS_R + 101187584ull)
#define WS_T1   (WS_R)
#define WS_T2   (WS_R + 34603008ull)
#define WS_MG   (WS_R + 69206016ull)
#define WS_SG   256100096ull
#define WS_WTF  (WS_Z)
#define WS_CU   (WS_Z + 17301504ull)
#define WS_LW  267634432ull
#define WS_DP  256100096ull
#define WT_IN  0
#define WT_G   2621440
#define WT_BRA 4718592
#define WT_BRB 5242880
#define WT_OUT 5767168
#define WT_FIN 0
#define WT_FDN 5767168
#define O_PSHIFT 17301504
#define O_PWKV   17308672
#define O_PK     17439744
#define O_PV     17505280
#define O_PCONV  17570816
#define O_SSHIFT 17593344
#define O_SWKV   18052096
#define O_SK     26440704
#define O_SV     30635008
#define O_SCONV  34829312

#define LDS_BYTES 151552

struct Params {
  const float* in[30];
  float* out;
  unsigned char* ws;
  int ph_lo, ph_hi;
};

typedef float f2v_ __attribute__((ext_vector_type(2)));
typedef __bf16 b2v_ __attribute__((ext_vector_type(2)));
__device__ __forceinline__ unsigned pack2(float a, float b) { f2v_ v = {a, b}; b2v_ r = __builtin_convertvector(v, b2v_); return __builtin_bit_cast(unsigned, r); }
__device__ __forceinline__ u16 f2bf(float f) { return (u16)(pack2(f, f) & 0xFFFFu); }
__device__ __forceinline__ float bf2f(u16 h) { return __uint_as_float(((unsigned)h) << 16); }
__device__ __forceinline__ float sigm(float x) { return __builtin_amdgcn_rcpf(1.f + __expf(-x)); }
__device__ __forceinline__ void unpack8(uint4 u, float* o) {
  o[0] = __uint_as_float(u.x << 16); o[1] = __uint_as_float(u.x & 0xFFFF0000u);
  o[2] = __uint_as_float(u.y << 16); o[3] = __uint_as_float(u.y & 0xFFFF0000u);
  o[4] = __uint_as_float(u.z << 16); o[5] = __uint_as_float(u.z & 0xFFFF0000u);
  o[6] = __uint_as_float(u.w << 16); o[7] = __uint_as_float(u.w & 0xFFFF0000u);
}
__device__ __forceinline__ uint4 pack8(const float* f) {
  uint4 u; u.x = pack2(f[0], f[1]); u.y = pack2(f[2], f[3]); u.z = pack2(f[4], f[5]); u.w = pack2(f[6], f[7]); return u;
}
__device__ __forceinline__ float gelu_fast(float v) {
  const float av = fabsf(v), d = av * 0.2316418882f + 1.0f;
  const float t = __builtin_amdgcn_rcpf(d);
  float q = t * 0.5307027145f + (-0.7265760135f); q = q * t + 0.7107068705f; q = q * t + (-0.142248368f); q = q * t + 0.127414796f; q = q * t;
  const float e = __builtin_amdgcn_exp2f((v * v) * (-0.72134752044f));
  const float m = v * (q * e);
  return v < 0.f ? m : v - m;
}
__device__ __forceinline__ int opq(int x) { asm volatile("" : "+v"(x)); return x; }
__device__ __forceinline__ float wave_sum(float x) {
#pragma unroll
  for (int o = 32; o >= 1; o >>= 1) x += __shfl_xor(x, o, 64);
  return x;
}

namespace pg8 {
#define PG8_LAS __attribute__((address_space(3)))
typedef unsigned short bf16_t;
typedef short bf16x8 __attribute__((ext_vector_type(8)));
typedef float f32x4 __attribute__((ext_vector_type(4)));
typedef unsigned u32x4 __attribute__((ext_vector_type(4)));
constexpr int BM = 256, BK = 64, HALF = 128, HTB = HALF * BK * 2  , STAGE_BYTES = 8 * HTB, NXCD = 8, WGM = 8;
__host__ __device__ __forceinline__ int lds_byte(int r, int c) { const int st = (r >> 4) * 2 + (c >> 5), rr = r & 15, cc = c & 31, ob = rr * 64 + cc * 2; return st * 1024 + (ob ^ (((ob >> 9) & 1) << 5)); }
__host__ __device__ __forceinline__ void stage_rc(int b, int& R, int& C) { const int st = b / 1024, sb = b % 1024, swz = sb ^ (((sb >> 9) & 1) << 5); R = (st >> 1) * 16 + swz / 64; C = (st & 1) * 32 + (swz % 64) / 2; }
__host__ __device__ __forceinline__ int perm32(int rho) { const int n = rho >> 4, i = rho & 15; return 8 * (i >> 2) + 4 * n + (i & 3); }
struct Unit { int pm, pn; };
struct Gemm { const bf16_t* A; const bf16_t* Bt; int M, N, K, lda, ldb; };
struct StaticOrder {
    int nM, nN, nwg, G, c;
    __host__ __device__ void init(int M, int N, int G_, int c_) { nM = M / BM; nN = N / BM; nwg = nM * nN; G = G_; c = c_; }
    __host__ __device__ bool next(int i, Unit& u) const {
        const long L = (long)i * G + c; if (L >= nwg) return false;
        int wgid = (int)L; { const int q = nwg / NXCD, r = nwg % NXCD, xcd = wgid % NXCD, off = wgid / NXCD; wgid = (xcd < r ? xcd * (q + 1) : r * (q + 1) + (xcd - r) * q) + off; }
        const int nig = WGM * nN, gid = wgid / nig, fm = gid * WGM, gsz = (nM - fm) < WGM ? (nM - fm) : WGM;
        u.pm = fm + ((wgid % nig) % gsz); u.pn = (wgid % nig) / gsz; return true;
    }
    __device__ __forceinline__ void a_ready(const Unit&) const {}
    __device__ __forceinline__ void done(const Unit&) const {}
};
__device__ __forceinline__ unsigned cvt_pk_bf16(float lo, float hi) { return ::pack2(lo, hi); }
template <class Epi, class Sched, bool STAMP = false>
__device__ __forceinline__ void gemm_phase(PG8_LAS unsigned char* lds, const Gemm g, const Sched& S, const Epi& E, unsigned long long* stamps) {
    const int tid = ::opq(threadIdx.x), wid = __builtin_amdgcn_readfirstlane(tid >> 6), lane = tid & 63, wr = wid >> 2, wc = wid & 3, fr = lane & 15, fq = lane >> 4;
    const int K = g.K, nt = K / BK;
    int ts_lo = 0, ts_hi = 0, nts = 0; const unsigned long long rt_entry = 0ull;
#define PG8_STAMP() do { if (STAMP && wid == 0 && nts < 64) { const unsigned long long _c = (unsigned long long)clock64(); \
        ts_lo = (lane == nts) ? (int)(unsigned)_c : ts_lo; ts_hi = (lane == nts) ? (int)(unsigned)(_c >> 32) : ts_hi; ++nts; } } while (0)
    PG8_STAMP();
    unsigned voffA[2], voffB[2];
#pragma unroll
    for (int i = 0; i < 2; ++i) { int R, C; stage_rc(tid * 16 + i * 8192, R, C); const int Rb = Epi::PERM ? ((R & ~31) + perm32(R & 31)) : R;
        voffA[i] = (unsigned)(R * g.lda + C) * 2u; voffB[i] = (unsigned)(Rb * g.ldb + C) * 2u; }
    const size_t kstep = (size_t)(BK * 2);
    const size_t hstep = (size_t)HALF * g.ldb * 2;
    const size_t tstep = 2 * hstep; const size_t hstepA = (size_t)HALF * g.lda * 2; const size_t tstepA = 2 * hstepA;
    const unsigned ldsw = (unsigned)wid * 1024u;
    const int aoff = lds_byte(wr * 64 + fr, fq * 8), boff = lds_byte(wc * 32 + fr, fq * 8);
#define PG8_SA(b, h) (((b) * 2 + (h)) * HTB)
#define PG8_SB(b, h) ((4 + (b) * 2 + (h)) * HTB)
#define PG8_STAGE(bufoff, gbase, voff) do { _Pragma("unroll") for (int _i = 0; _i < 2; ++_i) \
        __builtin_amdgcn_global_load_lds((const unsigned*)((const char*)(gbase) + (voff)[_i]), (PG8_LAS unsigned*)(lds + (bufoff) + ldsw + _i * 8192), 16, 0, 0); } while (0)
#define PG8_LDA(dst, b, h) do { _Pragma("unroll") for (int m = 0; m < 4; ++m) _Pragma("unroll") for (int k = 0; k < 2; ++k) dst[m][k] = *(const PG8_LAS bf16x8*)(lds + PG8_SA(b, h) + aoff + m * 2048 + k * 1024); } while (0)
#define PG8_LDB(dst, b, h) do { _Pragma("unroll") for (int n = 0; n < 2; ++n) _Pragma("unroll") for (int k = 0; k < 2; ++k) dst[n][k] = *(const PG8_LAS bf16x8*)(lds + PG8_SB(b, h) + boff + n * 2048 + k * 1024); } while (0)
#define PG8_MMA(ai, bj, At, Bt) do { __builtin_amdgcn_s_setprio(1); _Pragma("unroll") for (int m = 0; m < 4; ++m) _Pragma("unroll") for (int n = 0; n < 2; ++n) _Pragma("unroll") for (int k = 0; k < 2; ++k) \
        acc[ai][bj][m][n] = __builtin_amdgcn_mfma_f32_16x16x32_bf16(Bt[n][k], At[m][k], acc[ai][bj][m][n], 0, 0, 0); __builtin_amdgcn_s_setprio(0); } while (0)
#define PG8_WAIT_V(n) asm volatile("s_waitcnt vmcnt(" #n ")" ::: "memory")
#define PG8_WAIT_L(n) asm volatile("s_waitcnt lgkmcnt(" #n ")" ::: "memory")
#define PG8_BAR __builtin_amdgcn_s_barrier()
#define PG8_SCHED __builtin_amdgcn_sched_barrier(0)
    Unit cur, nxt; int ui = 0;
    if (!S.next(0, cur)) return;
    f32x4 acc[2][2][4][2];
#pragma unroll
    for (int a = 0; a < 2; ++a)
#pragma unroll
        for (int b = 0; b < 2; ++b)
#pragma unroll
            for (int m = 0; m < 4; ++m)
#pragma unroll
                for (int n = 0; n < 2; ++n) acc[a][b][m][n] = (f32x4){0.f, 0.f, 0.f, 0.f};
    bf16x8 At[4][2], B0[2][2], B1[2][2];
    const char* cA = (const char*)g.A + (size_t)cur.pm * tstepA; const char* cB = (const char*)g.Bt + (size_t)cur.pn * tstep;
    S.a_ready(cur);
    PG8_STAGE(PG8_SB(0, 0), cB, voffB); PG8_STAGE(PG8_SA(0, 0), cA, voffA); PG8_STAGE(PG8_SB(0, 1), cB + hstep, voffB); PG8_STAGE(PG8_SA(0, 1), cA + hstepA, voffA);
    if (wr == 1) PG8_BAR;
    PG8_WAIT_V(4); PG8_BAR;
    PG8_STAGE(PG8_SB(1, 0), cB + kstep, voffB); PG8_STAGE(PG8_SA(1, 0), cA + kstep, voffA); PG8_STAGE(PG8_SB(1, 1), cB + hstep + kstep, voffB);
    PG8_WAIT_V(6); PG8_BAR;
    PG8_STAMP();
    for (;;) {
        const bool has_next = S.next(ui + 1, nxt);
        const char* nA = has_next ? (const char*)g.A + (size_t)nxt.pm * tstepA : cA; const char* nB = has_next ? (const char*)g.Bt + (size_t)nxt.pn * tstep : cB;
        for (int t = 0; t < nt; t += 2) {
            const bool last = (t == nt - 2);
            const char* a1 = cA + (size_t)(t + 1) * kstep;
            const char* a2 = last ? nA : cA + (size_t)(t + 2) * kstep; const char* b2 = last ? nB : cB + (size_t)(t + 2) * kstep;
            const char* a3 = a2 + kstep; const char* b3 = b2 + kstep;
            if (last && has_next) S.a_ready(nxt);
            PG8_LDB(B0, 0, 0); PG8_SCHED; PG8_LDA(At, 0, 0); PG8_STAGE(PG8_SA(1, 1), a1 + hstepA, voffA);
            PG8_WAIT_L(8); PG8_BAR; PG8_WAIT_L(0); PG8_MMA(0, 0, At, B0); PG8_BAR; PG8_SCHED;
            PG8_LDB(B1, 0, 1); PG8_STAGE(PG8_SB(0, 0), b2, voffB);
            PG8_BAR; PG8_WAIT_L(0); PG8_MMA(0, 1, At, B1); PG8_BAR;
            PG8_LDA(At, 0, 1); PG8_STAGE(PG8_SA(0, 0), a2, voffA);
            PG8_BAR; PG8_WAIT_L(0); PG8_MMA(1, 0, At, B0); PG8_BAR; PG8_SCHED;
            PG8_STAGE(PG8_SB(0, 1), b2 + hstep, voffB);
            PG8_WAIT_V(6); PG8_BAR; PG8_MMA(1, 1, At, B1); PG8_BAR;
            PG8_LDB(B0, 1, 0); PG8_SCHED; PG8_LDA(At, 1, 0); PG8_STAGE(PG8_SA(0, 1), a2 + hstepA, voffA);
            PG8_WAIT_L(8); PG8_BAR; PG8_WAIT_L(0); PG8_MMA(0, 0, At, B0); PG8_BAR; PG8_SCHED;
            PG8_LDB(B1, 1, 1); PG8_STAGE(PG8_SB(1, 0), b3, voffB);
            PG8_BAR; PG8_WAIT_L(0); PG8_MMA(0, 1, At, B1); PG8_BAR;
            PG8_LDA(At, 1, 1); PG8_STAGE(PG8_SA(1, 0), a3, voffA);
            PG8_BAR; PG8_WAIT_L(0); PG8_MMA(1, 0, At, B0); PG8_BAR; PG8_SCHED;
            PG8_STAGE(PG8_SB(1, 1), b3 + hstep, voffB);
            PG8_WAIT_V(6); PG8_BAR; PG8_MMA(1, 1, At, B1); PG8_BAR;
        }
        PG8_STAMP();
        if constexpr (!Epi::AFTER_DRAIN) { E(acc, cur, wr, wc, fr, fq); S.done(cur); }
        PG8_STAMP();
        if (!has_next) break;
#pragma unroll
        for (int a = 0; a < 2; ++a)
#pragma unroll
            for (int b = 0; b < 2; ++b)
#pragma unroll
                for (int m = 0; m < 4; ++m)
#pragma unroll
                    for (int n = 0; n < 2; ++n) acc[a][b][m][n] = (f32x4){0.f, 0.f, 0.f, 0.f};
        cur = nxt; cA = nA; cB = nB; ++ui;
    }
    PG8_WAIT_V(0);
    if (wr == 0) PG8_BAR;
    PG8_BAR;
    if constexpr (Epi::AFTER_DRAIN) { E.fused(acc, cur, wr, wc, fr, fq, lds, wid, lane); S.done(cur); }
    PG8_STAMP();
    if (STAMP && wid == 0) { stamps[lane] = lane < nts ? (((unsigned long long)(unsigned)ts_hi << 32) | (unsigned)ts_lo) : 0ull;
        if (lane == 62) stamps[62] = rt_entry; if (lane == 63) stamps[63] = (unsigned long long)wall_clock64(); }
#undef PG8_STAMP
#undef PG8_SA
#undef PG8_SB
#undef PG8_STAGE
#undef PG8_LDA
#undef PG8_LDB
#undef PG8_MMA
#undef PG8_WAIT_V
#undef PG8_WAIT_L
#undef PG8_BAR
#undef PG8_SCHED
}
}
using pg8::f32x4;
#define ROWOFF(reg, h) (((reg) & 3) + 8 * ((reg) >> 2) + 4 * (h))

struct CDesc { const float* src; u16* dst; int K, N, k0, n0, sn0; };
__device__ __forceinline__ CDesc conv_desc(const Params& p, int l, int which, int t) {
  CDesc d;
  u16* WtA = (u16*)(p.ws + WS_WT);
  u16* WtF = (u16*)(p.ws + WS_WTF);
  if (which == 0) {
    if (t < 640) { const int tk = t / 40, tn = t % 40; d.src = p.in[8] + (size_t)l * 1024 * 4608; d.K = 1024; d.N = 4608; d.dst = WtA + WT_IN; d.k0 = tk * 64; d.n0 = tn * 64; d.sn0 = tn * 64; }
    else if ((t -= 640) < 512) {
      const int tk = t / 32, tn = t % 32; const int n0 = tn * 64;
      d.src = p.in[8] + (size_t)l * 1024 * 4608; d.K = 1024; d.N = 4608; d.dst = WtA + WT_G; d.k0 = tk * 64; d.n0 = n0;
      d.sn0 = 2560 + ((n0 >> 7) & 1) * 1024 + (n0 >> 8) * 128 + (n0 & 127);
    }
    else if ((t -= 512) < 128) { const int tk = t / 16, tn = t % 16; d.src = p.in[21] + (size_t)l * 512 * 1024; d.K = 512; d.N = 1024; d.dst = WtA + WT_BRA; d.k0 = tk * 64; d.n0 = tn * 64; d.sn0 = tn * 64; }
    else if ((t -= 128) < 128) { const int tk = t / 16, tn = t % 16; d.src = p.in[22] + (size_t)l * 512 * 1024; d.K = 512; d.N = 1024; d.dst = WtA + WT_BRB; d.k0 = tk * 64; d.n0 = tn * 64; d.sn0 = tn * 64; }
    else { t -= 128; const int tk = t / 16, tn = t % 16; d.src = p.in[23] + (size_t)l * 1024 * 1024; d.K = 1024; d.N = 1024; d.dst = WtA + WT_OUT; d.k0 = tk * 64; d.n0 = tn * 64; d.sn0 = tn * 64; }
  } else {
    if (t < 1408) {
      const int tk = t / 88, tn = t % 88; const int n0 = tn * 64;
      d.src = p.in[25] + (size_t)l * 1024 * 5632; d.K = 1024; d.N = 5632; d.dst = WtF + WT_FIN; d.k0 = tk * 64; d.n0 = n0;
      d.sn0 = ((n0 >> 7) & 1) * 2816 + (n0 >> 8) * 128 + (n0 & 127);
    } else { t -= 1408; const int tk = t / 16, tn = t % 16; d.src = p.in[28] + (size_t)l * 2816 * 1024; d.K = 2816; d.N = 1024; d.dst = WtF + WT_FDN; d.k0 = tk * 64; d.n0 = tn * 64; d.sn0 = tn * 64; }
  }
  return d;
}
__device__ __forceinline__ void conv_pair(const CDesc& A, const CDesc& B, float* lds) {
  const int tid = opq(threadIdx.x);
  const int k = tid >> 3, c = (tid & 7) * 8;
  const float* sa = A.src + (size_t)(A.k0 + k) * A.N + A.sn0 + c;
  const float* sb = B.src + (size_t)(B.k0 + k) * B.N + B.sn0 + c;
  const float4 a0 = *(const float4*)sa, a1 = *(const float4*)(sa + 4);
  const float4 b0 = *(const float4*)sb, b1 = *(const float4*)(sb + 4);
  __syncthreads();
  {
    float* d = lds + k * 65 + c;
    d[0] = a0.x; d[1] = a0.y; d[2] = a0.z; d[3] = a0.w; d[4] = a1.x; d[5] = a1.y; d[6] = a1.z; d[7] = a1.w;
    float* e = lds + 4160 + k * 65 + c;
    e[0] = b0.x; e[1] = b0.y; e[2] = b0.z; e[3] = b0.w; e[4] = b1.x; e[5] = b1.y; e[6] = b1.z; e[7] = b1.w;
  }
  __syncthreads();
  {
    const int n = tid >> 3, kk = (tid & 7) * 8;
    float f[8], g[8];
#pragma unroll
    for (int i = 0; i < 8; ++i) { f[i] = lds[(kk + i) * 65 + n]; g[i] = lds[4160 + (kk + i) * 65 + n]; }
    *(uint4*)(A.dst + (size_t)(A.n0 + n) * A.K + A.k0 + kk) = pack8(f);
    *(uint4*)(B.dst + (size_t)(B.n0 + n) * B.K + B.k0 + kk) = pack8(g);
  }
}

__device__ __forceinline__ void phase_prep(const Params& p, int l, int which, float* ldsf) {
  u16* H = (u16*)(p.ws + WS_H);
  float* X = p.out;
  const int nconv = which == 0 ? (640 + 512 + 128 + 128 + 256) : (1408 + 704);
  const float* gw = (which == 0 ? p.in[7] : p.in[24]) + l * 1024;
  for (int it = blockIdx.x * 2; it < nconv; it += gridDim.x * 2) {
    const CDesc A = conv_desc(p, l, which, it), B = conv_desc(p, l, which, it + 1);
    conv_pair(A, B, ldsf);
  }
  if (which == 0) {
    const int hh = (int)gridDim.x - 1 - (int)blockIdx.x;
    if (hh < 8) {
      const int tid = opq(threadIdx.x);
      u16* dst = (u16*)(p.ws + WS_LW) + (size_t)hh * 17920;
      const float* w2 = p.in[11] + (size_t)l * 64 * 512 + hh * 64;
      const float* a2 = p.in[13] + (size_t)l * 64 * 512 + hh * 64;
      const float* g2 = p.in[14] + (size_t)l * 128 * 512 + hh * 64;
      for (int e = tid; e < 4096; e += NT) {
        const int i = e >> 6, j = e & 63;
        dst[j * 72 + i] = f2bf(w2[(size_t)i * 512 + j]);
        dst[4608 + j * 72 + i] = f2bf(a2[(size_t)i * 512 + j]);
      }
      for (int e = tid; e < 8192; e += NT) {
        const int i = e >> 6, j = e & 63;
        dst[9216 + j * 136 + i] = f2bf(g2[(size_t)i * 512 + j]);
      }
    }
  }
  const bool first = (which == 0 && l == 0);
  for (int it = blockIdx.x; it < 2112; it += gridDim.x) {
    const int tid = opq(threadIdx.x);
    const int lane = tid & 63;
    const int rowa = it * 8 + (tid >> 6);
    float4 v[2][4];
#pragma unroll
    for (int rr = 0; rr < 1; ++rr) {
      const int row = rowa + rr * 8;
      const float* src;
      if (first) src = (row < M_P) ? p.in[0] + (size_t)row * 1024 : p.in[1] + (size_t)(row - M_P) * 1024;
      else src = X + (size_t)row * 1024;
#pragma unroll
      for (int i = 0; i < 4; ++i) v[rr][i] = *(const float4*)(src + i * 256 + lane * 4);
    }
#pragma unroll
    for (int rr = 0; rr < 1; ++rr) {
      const int row = rowa + rr * 8;
      const int nsl = (gridDim.x == 256 && row >= M_P && !first) ? (which == 1 ? 4 : 11) : 0;
      const float* part = (const float*)(p.ws + WS_T1) + (size_t)(row - M_P) * 1024;
      const u16* partb = (const u16*)(p.ws + WS_DP) + (size_t)(row - M_P) * 1024;
      float ss = 0.f;
#pragma unroll
      for (int i = 0; i < 4; ++i) {
        for (int k = 0; k < nsl; ++k) {
          if (which == 1) {
            const float4 q = *(const float4*)(part + (size_t)k * 512 * 1024 + i * 256 + lane * 4);
            v[rr][i].x += q.x; v[rr][i].y += q.y; v[rr][i].z += q.z; v[rr][i].w += q.w;
          } else {
            const uint2 q = *(const uint2*)(partb + (size_t)k * 512 * 1024 + i * 256 + lane * 4);
            v[rr][i].x += __uint_as_float(q.x << 16); v[rr][i].y += __uint_as_float(q.x & 0xFFFF0000u); v[rr][i].z += __uint_as_float(q.y << 16); v[rr][i].w += __uint_as_float(q.y & 0xFFFF0000u);
          }
        }
        ss += v[rr][i].x * v[rr][i].x + v[rr][i].y * v[rr][i].y + v[rr][i].z * v[rr][i].z + v[rr][i].w * v[rr][i].w;
        if (first || nsl) *(float4*)(X + (size_t)row * 1024 + i * 256 + lane * 4) = v[rr][i];
      }
      ss = wave_sum(ss);
      const float rs = rsqrtf(ss * (1.f / 1024.f) + 1e-6f);
#pragma unroll
      for (int i = 0; i < 4; ++i) {
        const float4 g = *(const float4*)(gw + i * 256 + lane * 4);
        uint2 o; o.x = pack2(v[rr][i].x * rs * g.x, v[rr][i].y * rs * g.y); o.y = pack2(v[rr][i].z * rs * g.z, v[rr][i].w * rs * g.w);
        *(uint2*)(H + (size_t)row * 1024 + i * 256 + lane * 4) = o;
      }
    }
  }
}

struct EpiInproj {
  static constexpr bool PERM = true, AFTER_DRAIN = false;
  u16* z; float* out; int l;
  __device__ __forceinline__ void operator()(const f32x4 (&acc)[2][2][4][2], const pg8::Unit& u, int wr, int wc, int fr, int fq) const {
    const int row0 = u.pm * 256 + wr * 64 + fr, col0 = u.pn * 256 + wc * 32 + 8 * fq;
#pragma unroll
    for (int ai = 0; ai < 2; ++ai)
#pragma unroll
      for (int m = 0; m < 4; ++m) {
        const int row = row0 + ai * 128 + m * 16;
        u16* rowp = z + (size_t)row * ZLD + col0;
#pragma unroll
        for (int bj = 0; bj < 2; ++bj) {
          const f32x4 v0 = acc[ai][bj][m][0], v1 = acc[ai][bj][m][1];
          pg8::u32x4 w; w.x = pg8::cvt_pk_bf16(v0[0], v0[1]); w.y = pg8::cvt_pk_bf16(v0[2], v0[3]); w.z = pg8::cvt_pk_bf16(v1[0], v1[1]); w.w = pg8::cvt_pk_bf16(v1[2], v1[3]);
          *(pg8::u32x4*)(rowp + bj * 128) = w;
        }
        const bool prompt = row < M_P;
        int b, t;
        if (prompt) { b = row >> 13; t = row & 8191; } else { b = (row - M_P) >> 2; t = (row - M_P) & 3; }
        if (u.pn < 7) {
          if ((prompt && t == 8191) || (!prompt && t == 3)) {
            float* o = out + (prompt ? O_PSHIFT + (size_t)(l * 2 + b) * 1792 : O_SSHIFT + (size_t)(l * 128 + b) * 1792) + col0;
#pragma unroll
            for (int bj = 0; bj < 2; ++bj) { *(f32x4*)(o + bj * 128) = acc[ai][bj][m][0]; *(f32x4*)(o + bj * 128 + 4) = acc[ai][bj][m][1]; }
          }
        } else if (u.pn == 9 && prompt && t >= 8064) {
          const int c = wc * 32 + 8 * fq;
          float* o = out + O_PV + ((size_t)((l * 2 + b) * 128 + (t - 8064)) * 2 + (c >> 6)) * 64 + (c & 63);
          *(f32x4*)o = acc[ai][1][m][0]; *(f32x4*)(o + 4) = acc[ai][1][m][1];
        }
      }
  }
};
struct EpiStoreBf16 {
  static constexpr bool PERM = true, AFTER_DRAIN = false;
  u16* O; int ldc; int rowoff;
  __device__ __forceinline__ void operator()(const f32x4 (&acc)[2][2][4][2], const pg8::Unit& u, int wr, int wc, int fr, int fq) const {
    const int row0 = rowoff + u.pm * 256 + wr * 64 + fr, col0 = u.pn * 256 + wc * 32 + 8 * fq;
#pragma unroll
    for (int ai = 0; ai < 2; ++ai)
#pragma unroll
      for (int m = 0; m < 4; ++m) {
        u16* rowp = O + (size_t)(row0 + ai * 128 + m * 16) * ldc + col0;
#pragma unroll
        for (int bj = 0; bj < 2; ++bj) {
          const f32x4 v0 = acc[ai][bj][m][0], v1 = acc[ai][bj][m][1];
          pg8::u32x4 w; w.x = pg8::cvt_pk_bf16(v0[0], v0[1]); w.y = pg8::cvt_pk_bf16(v0[2], v0[3]); w.z = pg8::cvt_pk_bf16(v1[0], v1[1]); w.w = pg8::cvt_pk_bf16(v1[2], v1[3]);
          *(pg8::u32x4*)(rowp + bj * 128) = w;
        }
      }
  }
};
struct EpiFfnIn {
  static constexpr bool PERM = true, AFTER_DRAIN = false;
  u16* cu;
  __device__ __forceinline__ void operator()(const f32x4 (&acc)[2][2][4][2], const pg8::Unit& u, int wr, int wc, int fr, int fq) const {
    const int row0 = u.pm * 256 + wr * 64 + fr, col0 = u.pn * 128 + wc * 32 + 8 * fq;
#pragma unroll
    for (int ai = 0; ai < 2; ++ai)
#pragma unroll
      for (int m = 0; m < 4; ++m) {
        u16* rowp = cu + (size_t)(row0 + ai * 128 + m * 16) * 5632 + col0;
#pragma unroll
        for (int bj = 0; bj < 2; ++bj) {
          const f32x4 v0 = acc[ai][bj][m][0], v1 = acc[ai][bj][m][1];
          pg8::u32x4 w; w.x = pg8::cvt_pk_bf16(v0[0], v0[1]); w.y = pg8::cvt_pk_bf16(v0[2], v0[3]); w.z = pg8::cvt_pk_bf16(v1[0], v1[1]); w.w = pg8::cvt_pk_bf16(v1[2], v1[3]);
          *(pg8::u32x4*)(rowp + bj * 2816) = w;
        }
      }
  }
};
struct EpiSig {
  static constexpr bool PERM = true, AFTER_DRAIN = false;
  u16* sr; u16* sa;
  __device__ __forceinline__ void operator()(const f32x4 (&acc)[2][2][4][2], const pg8::Unit& u, int wr, int wc, int fr, int fq) const {
    const int row0 = u.pm * 256 + wr * 64 + fr, col0 = u.pn * 128 + wc * 32 + 8 * fq;
#pragma unroll
    for (int ai = 0; ai < 2; ++ai)
#pragma unroll
      for (int m = 0; m < 4; ++m) {
        const size_t off = (size_t)(row0 + ai * 128 + m * 16) * 1024 + col0;
#pragma unroll
        for (int bj = 0; bj < 2; ++bj) {
          float o[8];
#pragma unroll
          for (int n = 0; n < 2; ++n)
#pragma unroll
            for (int j = 0; j < 4; ++j) o[n * 4 + j] = sigm(acc[ai][bj][m][n][j]);
          *(uint4*)((bj ? sa : sr) + off) = pack8(o);
        }
      }
  }
};
struct EpiMerge {
  static constexpr bool PERM = true, AFTER_DRAIN = false;
  const u16* t1; const u16* t2; u16* mg;
  __device__ __forceinline__ void operator()(const f32x4 (&acc)[2][2][4][2], const pg8::Unit& u, int wr, int wc, int fr, int fq) const {
    const int row0 = u.pm * 256 + wr * 64 + fr, col0 = u.pn * 128 + wc * 32 + 8 * fq;
#pragma unroll
    for (int ai = 0; ai < 2; ++ai)
#pragma unroll
      for (int m = 0; m < 4; ++m) {
        const size_t off = (size_t)(row0 + ai * 128 + m * 16) * 1024 + col0;
        float a[8], b[8], o[8];
        unpack8(*(const uint4*)(t1 + off), a);
        unpack8(*(const uint4*)(t2 + off), b);
#pragma unroll
        for (int n = 0; n < 2; ++n)
#pragma unroll
          for (int j = 0; j < 4; ++j)
            o[n * 4 + j] = sigm(acc[ai][0][m][n][j]) * a[n * 4 + j] + sigm(acc[ai][1][m][n][j]) * b[n * 4 + j];
        *(uint4*)(mg + off) = pack8(o);
        asm volatile("" ::: "memory");
      }
  }
};
struct EpiResid {
  static constexpr bool PERM = false, AFTER_DRAIN = false;
  float* X; bool dry; bool atomic; int rowoff; u16* pbf;
  __device__ __forceinline__ void operator()(const f32x4 (&acc)[2][2][4][2], const pg8::Unit& u, int wr, int wc, int fr, int fq) const {
    const int row0 = rowoff + u.pm * 256 + wr * 64 + fr, col0 = u.pn * 256 + wc * 32 + 4 * fq;
#pragma unroll
    for (int ai = 0; ai < 2; ++ai)
#pragma unroll
      for (int m = 0; m < 4; ++m) {
        float* rowp = X + (size_t)(row0 + ai * 128 + m * 16) * 1024 + col0;
#pragma unroll
        for (int bj = 0; bj < 2; ++bj)
#pragma unroll
          for (int n = 0; n < 2; ++n) {
            f32x4* q = (f32x4*)(rowp + bj * 128 + n * 16);
            if (atomic) {
              if (pbf) {
                uint2 o; o.x = pack2(acc[ai][bj][m][n][0], acc[ai][bj][m][n][1]); o.y = pack2(acc[ai][bj][m][n][2], acc[ai][bj][m][n][3]);
                *(uint2*)(pbf + ((float*)q - X)) = o;
              } else *q = acc[ai][bj][m][n];
            } else { const f32x4 v_ = *q + acc[ai][bj][m][n]; if (!dry) *q = v_; }
          }
        asm volatile("" ::: "memory");
      }
  }
};
template <class Epi>
__device__ __forceinline__ void run_gemm_ex(unsigned char* lds_raw, const u16* A, int lda, const u16* Bt, int ldb, int M, int N, int K, int G, int c, const Epi& E) {
  if (c < 0) return;
  pg8::Gemm g; g.A = A; g.Bt = Bt; g.M = M; g.N = N; g.K = K; g.lda = lda; g.ldb = ldb;
  pg8::StaticOrder S; S.init(M, N, G, c);
  __syncthreads();
  pg8::gemm_phase<Epi, pg8::StaticOrder, false>((PG8_LAS unsigned char*)lds_raw, g, S, E, nullptr);
  __syncthreads();
}
template <class Epi>
__device__ __forceinline__ void run_gemm(unsigned char* lds_raw, const u16* A, int lda, const u16* Bt, int N, int K, const Epi& E) {
  pg8::Gemm g; g.A = A; g.Bt = Bt; g.M = M_TOT; g.N = N; g.K = K; g.lda = lda; g.ldb = K;
  pg8::StaticOrder S; S.init(M_TOT, N, gridDim.x, blockIdx.x);
  __syncthreads();
  pg8::gemm_phase<Epi, pg8::StaticOrder, false>((PG8_LAS unsigned char*)lds_raw, g, S, E, nullptr);
  __syncthreads();
}

__device__ __forceinline__ void rope_item(const Params& p, int l, int item, bool dry = false) {
  const int tid = opq(threadIdx.x);
  u16* z = (u16*)(p.ws + WS_Z);
  const int row = item * 64 + (tid >> 3);
  const int d0 = (tid & 7) * 4;
  const bool prompt = row < M_P;
  int b, t, pos;
  if (prompt) { b = row >> 13; t = row & 8191; pos = t; } else { b = (row - M_P) >> 2; t = (row - M_P) & 3; pos = 16384 + t; }
  float cs[4], sn[4];
#pragma unroll
  for (int i = 0; i < 4; ++i) {
    const float inv = __expf(-(float)(d0 + i) * (9.210340371976184f / 32.f));
    const float angf = (float)pos * inv;
    double a = (double)angf;
    a -= 6.283185307179586 * rint(a * 0.15915494309189535);
    const float af = (float)a;
    sn[i] = __sinf(af); cs[i] = __cosf(af);
  }
#pragma unroll 2
  for (int hh = 0; hh < 10; ++hh) {
    u16* q = z + (size_t)row * ZLD + 1792 + hh * 64 + d0;
    const uint2 lo = *(const uint2*)q, hi = *(const uint2*)(q + 32);
    float x1[4] = {__uint_as_float(lo.x << 16), __uint_as_float(lo.x & 0xFFFF0000u), __uint_as_float(lo.y << 16), __uint_as_float(lo.y & 0xFFFF0000u)};
    float x2[4] = {__uint_as_float(hi.x << 16), __uint_as_float(hi.x & 0xFFFF0000u), __uint_as_float(hi.y << 16), __uint_as_float(hi.y & 0xFFFF0000u)};
    float y1[4], y2[4];
#pragma unroll
    for (int i = 0; i < 4; ++i) { y1[i] = x1[i] * cs[i] - x2[i] * sn[i]; y2[i] = x2[i] * cs[i] + x1[i] * sn[i]; }
    uint2 o1, o2;
    o1.x = pack2(y1[0], y1[1]); o1.y = pack2(y1[2], y1[3]); o2.x = pack2(y2[0], y2[1]); o2.y = pack2(y2[2], y2[3]);
    if (!dry) { *(uint2*)q = o1; *(uint2*)(q + 32) = o2; }
    if (hh >= 8 && prompt && t >= 8064) {
      float* o = p.out + O_PK + ((size_t)((l * 2 + b) * 128 + (t - 8064)) * 2 + (hh - 8)) * 64 + d0;
      *(float4*)o = make_float4(y1[0], y1[1], y1[2], y1[3]);
      *(float4*)(o + 32) = make_float4(y2[0], y2[1], y2[2], y2[3]);
    }
  }
}

#define SL(i) (ldsf + (i) * 4160)
__device__ __forceinline__ void rwkv_item(const Params& p, int l, int item, float* ldsf, bool dry = false) {
  const int tid = opq(threadIdx.x), lane = tid & 63, wave = tid >> 6;
  const bool sample = item >= 2048;
  int h, cidx, rowbase;
  if (!sample) { h = item & 7; cidx = item >> 3; rowbase = cidx * 64; }
  else { int s = item - 2048; h = s & 7; cidx = s >> 3; rowbase = M_P + cidx * 64; }
  const int cc = cidx & 127;
  const u16* z = (const u16*)(p.ws + WS_Z);
  u16* zw_ = (u16*)(p.ws + WS_Z);
  const float* mu = p.in[9] + l * 1792;
  float* wbuf = SL(7);
  float* gc = ldsf + 9 * 4160;
  float* bd = ldsf + 9 * 4160 + 64;
  __syncthreads();
  {
    const int t = tid >> 3, c8 = (tid & 7) * 8;
    const int m = rowbase + t;
    const int zcs[7] = {h * 64, 512 + h * 64, 1024 + h * 64, 1536, 1600, 1664, 1728};
#pragma unroll
    for (int gi = 0; gi < 7; ++gi) {
      const int zc = zcs[gi] + c8;
      float cur[8], prv[8];
      unpack8(*(const uint4*)(z + (size_t)m * ZLD + zc), cur);
      bool zero = false, fromstate = false;
      if (!sample) zero = (t == 0 && cc == 0);
      else fromstate = ((t & 3) == 0);
      if (zero) {
#pragma unroll
        for (int i = 0; i < 8; ++i) prv[i] = 0.f;
      } else if (fromstate) {
        const int b = (m - M_P) >> 2;
        const float* sp = p.in[2] + (size_t)(l * 128 + b) * 1792 + zc;
        float4 a = *(const float4*)sp, bb = *(const float4*)(sp + 4);
        prv[0] = a.x; prv[1] = a.y; prv[2] = a.z; prv[3] = a.w; prv[4] = bb.x; prv[5] = bb.y; prv[6] = bb.z; prv[7] = bb.w;
      } else {
        unpack8(*(const uint4*)(z + (size_t)(m - 1) * ZLD + zc), prv);
      }
      float* d = SL(gi) + t * 65 + c8;
#pragma unroll
      for (int i = 0; i < 8; ++i) {
        float v = cur[i] + mu[zc + i] * (prv[i] - cur[i]);
        if (gi == 3) v = tanhf(v);
        if (gi >= 5) v = sigm(v);
        d[i] = v;
      }
    }
  }
  const int lt = tid & 63, jg = tid >> 6;
  auto load_w = [&](const float* W, int nrows) {
    for (int e = tid; e < nrows * 8; e += NT) {
      const int i = e >> 3, c = (e & 7) * 8;
      const float* s = W + (size_t)i * 512 + h * 64 + c;
      *(float4*)(wbuf + i * 64 + c) = *(const float4*)s;
      *(float4*)(wbuf + i * 64 + c + 4) = *(const float4*)(s + 4);
    }
  };
  auto lora = [&](const float* xa, const float* xb, int n, float* acc) {
#pragma unroll 2
    for (int i = 0; i < n; ++i) {
      const float x = (i < 64) ? xa[lt * 65 + i] : xb[lt * 65 + i - 64];
      const float4 w0 = *(const float4*)(wbuf + i * 64 + jg * 8);
      const float4 w1 = *(const float4*)(wbuf + i * 64 + jg * 8 + 4);
      acc[0] += x * w0.x; acc[1] += x * w0.y; acc[2] += x * w0.z; acc[3] += x * w0.w;
      acc[4] += x * w1.x; acc[5] += x * w1.y; acc[6] += x * w1.z; acc[7] += x * w1.w;
    }
  };
  float res[8];
  load_w(p.in[11] + (size_t)l * 64 * 512, 64);
  __syncthreads();
#pragma unroll
  for (int i = 0; i < 8; ++i) res[i] = p.in[10][l * 512 + h * 64 + jg * 8 + i];
  lora(SL(3), SL(3), 64, res);
  __syncthreads();
#pragma unroll
  for (int i = 0; i < 8; ++i) {
    const float x = -res[i];
    const float sp = (x > 20.f) ? x : log1pf(__expf(x));
    SL(3)[lt * 65 + jg * 8 + i] = -__expf(-sp - 0.5f);
  }
  load_w(p.in[13] + (size_t)l * 64 * 512, 64);
  __syncthreads();
#pragma unroll
  for (int i = 0; i < 8; ++i) res[i] = p.in[12][l * 512 + h * 64 + jg * 8 + i];
  lora(SL(4), SL(4), 64, res);
  __syncthreads();
#pragma unroll
  for (int i = 0; i < 8; ++i) SL(4)[lt * 65 + jg * 8 + i] = sigm(res[i]);
  load_w(p.in[14] + (size_t)l * 128 * 512, 128);
  __syncthreads();
#pragma unroll
  for (int i = 0; i < 8; ++i) res[i] = 0.f;
  lora(SL(5), SL(6), 128, res);
  __syncthreads();
  if (!sample) {
    u16* ga = (u16*)(p.ws + WS_GA) + (size_t)item * 4096;
    *(uint4*)(ga + lt * 64 + jg * 8) = pack8(res);
    if (tid < 64) {
      float c = 0.f;
      for (int t = 0; t < 64; ++t) { c += SL(3)[t * 65 + tid]; SL(5)[t * 65 + tid] = c; }
      gc[tid] = __expf(c);
    }
  } else {
#pragma unroll
    for (int i = 0; i < 8; ++i) SL(6)[lt * 65 + jg * 8 + i] = res[i];
  }
  __syncthreads();
  {
    const int t = tid >> 3, j0 = (tid & 7) * 8;
    const float* kkw = p.in[15] + l * 512 + h * 64;
    const float* kaw = p.in[16] + l * 512 + h * 64;
    const float* rkw = p.in[17] + l * 512 + h * 64;
    float kr[8], av[8], rv[8], kkv[8], kf[8];
    float nrm = 0.f, bdot = 0.f;
#pragma unroll
    for (int i = 0; i < 8; ++i) {
      const int j = j0 + i;
      kr[i] = SL(1)[t * 65 + j]; av[i] = SL(4)[t * 65 + j]; rv[i] = SL(0)[t * 65 + j];
      kkv[i] = kr[i] * kkw[j];
      nrm += kkv[i] * kkv[i];
      kf[i] = kr[i] * (1.f + (av[i] - 1.f) * kaw[j]);
      bdot += rv[i] * kf[i] * rkw[j];
    }
    nrm += __shfl_xor(nrm, 1, 64); nrm += __shfl_xor(nrm, 2, 64); nrm += __shfl_xor(nrm, 4, 64);
    bdot += __shfl_xor(bdot, 1, 64); bdot += __shfl_xor(bdot, 2, 64); bdot += __shfl_xor(bdot, 4, 64);
    const float rn = 1.f / fmaxf(sqrtf(nrm), 1e-12f);
    if (!sample) {
      float bo[8];
#pragma unroll
      for (int i = 0; i < 8; ++i) {
        const int j = j0 + i;
        const float cum = SL(5)[t * 65 + j], dl = SL(3)[t * 65 + j];
        const float eg = __expf(cum), egi = __expf(-cum), egp = __expf(cum - dl);
        const float kk = kkv[i] * rn;
        SL(0)[t * 65 + j] = rv[i] * eg;
        SL(1)[t * 65 + j] = kf[i] * egi;
        SL(3)[t * 65 + j] = kk * av[i] * egi;
        SL(4)[t * 65 + j] = kk * egp;
        bo[i] = bdot * SL(2)[t * 65 + j];
      }
      u16* bop = (u16*)(p.ws + WS_BO) + (size_t)item * 4096;
      *(uint4*)(bop + t * 64 + j0) = pack8(bo);
    } else {
#pragma unroll
      for (int i = 0; i < 8; ++i) {
        const int j = j0 + i;
        const float kk = kkv[i] * rn;
        const float dl = SL(3)[t * 65 + j];
        SL(1)[t * 65 + j] = kf[i];
        SL(3)[t * 65 + j] = __expf(dl);
        SL(4)[t * 65 + j] = kk;
        SL(5)[t * 65 + j] = kk * av[i];
      }
      if ((tid & 7) == 0) bd[t] = bdot;
    }
  }
  __syncthreads();
  if (sample) {
    const float lng = p.in[18][l * 512 + h * 64 + lane], lnb = p.in[19][l * 512 + h * 64 + lane];
    for (int round = 0; round < 2; ++round) {
      const int seq = wave + 8 * round;
      const int b = cidx * 16 + seq;
      float S[64];
      const float* sp = p.in[3] + ((size_t)((l * 128 + b) * 8 + h) * 64 + lane) * 64;
#pragma unroll
      for (int k = 0; k < 64; k += 4) { float4 v = *(const float4*)(sp + k); S[k] = v.x; S[k + 1] = v.y; S[k + 2] = v.z; S[k + 3] = v.w; }
      for (int tt = 0; tt < 4; ++tt) {
        const int t = seq * 4 + tt;
        float sk = 0.f;
#pragma unroll
        for (int kc = 0; kc < 64; kc += 8) {
#pragma unroll
          for (int k = kc; k < kc + 8; ++k) sk += S[k] * SL(4)[t * 65 + k];
          __builtin_amdgcn_sched_barrier(0);
        }
        const float vt = SL(2)[t * 65 + lane];
        float y = 0.f;
#pragma unroll
        for (int kc = 0; kc < 64; kc += 8) {
#pragma unroll
          for (int k = kc; k < kc + 8; ++k) {
            S[k] = S[k] * SL(3)[t * 65 + k] - sk * SL(5)[t * 65 + k] + vt * SL(1)[t * 65 + k];
            y += S[k] * SL(0)[t * 65 + k];
          }
          __builtin_amdgcn_sched_barrier(0);
        }
        const float mean = wave_sum(y) * (1.f / 64.f);
        const float d = y - mean;
        const float var = wave_sum(d * d) * (1.f / 64.f);
        const float yn = d * rsqrtf(var + 64e-5f) * lng + lnb;
        const float o = (yn + bd[t] * vt) * SL(6)[t * 65 + lane];
        if (!dry) zw_[(size_t)(M_P + b * 4 + tt) * ZLD + h * 64 + lane] = f2bf(o);
      }
      float* op = p.out + O_SWKV + ((size_t)((l * 128 + b) * 8 + h) * 64 + lane) * 64;
#pragma unroll
      for (int k = 0; k < 64; k += 4) *(float4*)(op + k) = make_float4(S[k], S[k + 1], S[k + 2], S[k + 3]);
    }
    return;
  }
  {
    const int i = lane, tg = wave;
    float ab[8], ak[8], akr[8], abr[8];
#pragma unroll
    for (int q = 0; q < 8; ++q) { ab[q] = 0.f; ak[q] = 0.f; akr[q] = 0.f; abr[q] = 0.f; }
#pragma unroll 2
    for (int k = 0; k < 64; ++k) {
      const float xb = SL(3)[i * 65 + k], xk = SL(1)[i * 65 + k];
#pragma unroll
      for (int q = 0; q < 8; ++q) {
        const int t = tg * 8 + q;
        const float yk = SL(4)[t * 65 + k], yr = SL(0)[t * 65 + k];
        ab[q] += xb * yk; ak[q] += xk * yk; akr[q] += xk * yr; abr[q] += xb * yr;
      }
    }
    __syncthreads();
#pragma unroll
    for (int q = 0; q < 8; ++q) {
      const int t = tg * 8 + q;
      SL(6)[i * 65 + t] = (i < t) ? ab[q] : 0.f;
      SL(7)[i * 65 + t] = (i < t) ? ak[q] : 0.f;
      SL(8)[i * 65 + t] = (i <= t) ? akr[q] : 0.f;
      SL(5)[i * 65 + t] = (i <= t) ? abr[q] : 0.f;
    }
  }
  __syncthreads();
  {
    const int t = tid >> 3, j0 = (tid & 7) * 8;
#pragma unroll
    for (int i = 0; i < 8; ++i) { const float g = gc[j0 + i]; SL(3)[t * 65 + j0 + i] *= g; SL(1)[t * 65 + j0 + i] *= g; }
  }
  __syncthreads();
  if (tid < 128) {
    float* X_ = (tid < 64) ? SL(5) : SL(3);
    const int col = tid & 63;
    for (int i = 62; i >= 0; --i) {
      float a = X_[i * 65 + col];
#pragma unroll 4
      for (int t = i + 1; t < 64; ++t) a -= SL(6)[i * 65 + t] * X_[t * 65 + col];
      X_[i * 65 + col] = a;
    }
  }
  __syncthreads();
  {
    const int c = tid & 127, ig = tid >> 7;
    const int which = c >> 6, cq = c & 63;
    const float* N_ = which ? SL(3) : SL(5);
    float a[16];
#pragma unroll
    for (int q = 0; q < 16; ++q) a[q] = 0.f;
#pragma unroll 2
    for (int t = 0; t < 64; ++t) {
      const float n = N_[t * 65 + cq];
#pragma unroll
      for (int q = 0; q < 16; ++q) a[q] += SL(7)[(ig * 16 + q) * 65 + t] * n;
    }
    float* T_ = which ? SL(1) : SL(8);
#pragma unroll
    for (int q = 0; q < 16; ++q) T_[(ig * 16 + q) * 65 + cq] -= a[q];
  }
  __syncthreads();
  {
    const int x = lane, yg = wave;
    float w2[8], pp[8], yl[8], qq[8];
#pragma unroll
    for (int q = 0; q < 8; ++q) { w2[q] = 0.f; pp[q] = 0.f; yl[q] = 0.f; qq[q] = 0.f; }
#pragma unroll 2
    for (int j = 0; j < 64; ++j) {
      const float l5 = SL(5)[j * 65 + x], l4 = SL(4)[j * 65 + x], l8 = SL(8)[j * 65 + x], l2 = SL(2)[j * 65 + x];
#pragma unroll
      for (int q = 0; q < 8; ++q) {
        const int y = yg * 8 + q;
        w2[q] += l5 * SL(4)[j * 65 + y];
        pp[q] += l4 * SL(3)[j * 65 + y];
        yl[q] += l8 * SL(2)[j * 65 + y];
        qq[q] += l2 * SL(1)[j * 65 + y];
      }
    }
    float o1[8];
#pragma unroll
    for (int q = 0; q < 8; ++q) {
      const int y = yg * 8 + q;
      o1[q] = SL(0)[x * 65 + y] - w2[q];
    }
    u16* Pf = (u16*)(p.ws + WS_PP) + (size_t)item * 4096;
    float* Qf = (float*)(p.ws + WS_Q) + (size_t)item * 4096;
    if (tid < 64) ((float*)(p.ws + WS_GC))[(size_t)item * 64 + tid] = gc[tid];
    {
      const int s_ = x >> 4, kk = x & 15, hh = (kk >> 2) & 1, jj = ((kk >> 3) << 2) | (kk & 3);
#pragma unroll
      for (int q = 0; q < 8; ++q) {
        const int y = yg * 8 + q;
        Pf[(((y >> 5) * 4 + s_) * 64 + (y & 31) + 32 * hh) * 8 + jj] = f2bf(-pp[q]);
        const int k2 = y & 31, reg = ((k2 >> 3) << 2) | (k2 & 3), h2 = (k2 >> 2) & 1;
        Qf[(((x >> 5) * 2 + (y >> 5)) * 16 + reg) * 64 + (x & 31) + 32 * h2] = qq[q];
      }
    }
    u16* W2p = (u16*)(p.ws + WS_W2) + (size_t)item * 4096 + x * 64 + yg * 8;
    u16* YLp = (u16*)(p.ws + WS_YL) + (size_t)item * 4096 + x * 64 + yg * 8;
    *(uint4*)W2p = pack8(o1);
    *(uint4*)YLp = pack8(yl);
  }
}

template <bool SWA = false, bool SWB = false>
__device__ __forceinline__ void mm_tile(const u16* Aop, int lda, const u16* Bop, int ldb, int mt, int nt, int r, int h, int ksteps, f32x16& acc) {
  const int ra = mt * 32 + r, rb = nt * 32 + r;
  const u16* ap = Aop + ra * lda;
  const u16* bp = Bop + rb * ldb;
  const int swa = SWA ? ((ra >> 3) & 7) : 0, swb = SWB ? ((rb >> 3) & 7) : 0;
#pragma unroll 4
  for (int s = 0; s < ksteps; ++s) {
    const bf16x8 a = *(const bf16x8*)(ap + (((2 * s + h) ^ swa) << 3));
    const bf16x8 b = *(const bf16x8*)(bp + (((2 * s + h) ^ swb) << 3));
    acc = __builtin_amdgcn_mfma_f32_32x32x16_bf16(a, b, acc, 0, 0, 0);
  }
}
#define SWZ(row, col) ((row) * 72 + (((((col) >> 3) ^ (((row) >> 3) & 7)) << 3) | ((col) & 7)))
__device__ __forceinline__ void store_T(u16* T, int ldt, int mt, int nt, int r, int h, const f32x16& acc) {
#pragma unroll
  for (int g = 0; g < 4; ++g) {
    uint2 o; o.x = pack2(acc[4 * g], acc[4 * g + 1]); o.y = pack2(acc[4 * g + 2], acc[4 * g + 3]);
    *(uint2*)(T + (nt * 32 + r) * ldt + mt * 32 + 8 * g + 4 * h) = o;
  }
}
__device__ __forceinline__ void tri16(const float* Ab, float* Xc) {
  float a0 = Xc[0];
  float a1 = Xc[65];
  float a2 = Xc[130];
  float a3 = Xc[195];
  float a4 = Xc[260];
  float a5 = Xc[325];
  float a6 = Xc[390];
  float a7 = Xc[455];
  float a8 = Xc[520];
  float a9 = Xc[585];
  float a10 = Xc[650];
  float a11 = Xc[715];
  float a12 = Xc[780];
  float a13 = Xc[845];
  float a14 = Xc[910];
  float a15 = Xc[975];
  const float4 c14_12 = *(const float4*)(Ab + 964);
  const float4 c13_12 = *(const float4*)(Ab + 896);
  const float4 c12_12 = *(const float4*)(Ab + 828);
  const float4 c11_12 = *(const float4*)(Ab + 760);
  a14 -= c14_12.w * a15;
  const float4 c10_8 = *(const float4*)(Ab + 688);
  const float4 c10_12 = *(const float4*)(Ab + 692);
  a13 -= c13_12.z * a14;
  a13 -= c13_12.w * a15;
  const float4 c9_8 = *(const float4*)(Ab + 620);
  const float4 c9_12 = *(const float4*)(Ab + 624);
  a12 -= c12_12.y * a13;
  a12 -= c12_12.z * a14;
  a12 -= c12_12.w * a15;
  const float4 c8_8 = *(const float4*)(Ab + 552);
  const float4 c8_12 = *(const float4*)(Ab + 556);
  a11 -= c11_12.x * a12;
  a11 -= c11_12.y * a13;
  a11 -= c11_12.z * a14;
  a11 -= c11_12.w * a15;
  const float4 c7_8 = *(const float4*)(Ab + 484);
  const float4 c7_12 = *(const float4*)(Ab + 488);
  a10 -= c10_8.w * a11;
  a10 -= c10_12.x * a12;
  a10 -= c10_12.y * a13;
  a10 -= c10_12.z * a14;
  a10 -= c10_12.w * a15;
  const float4 c6_4 = *(const float4*)(Ab + 412);
  const float4 c6_8 = *(const float4*)(Ab + 416);
  const float4 c6_12 = *(const float4*)(Ab + 420);
  a9 -= c9_8.z * a10;
  a9 -= c9_8.w * a11;
  a9 -= c9_12.x * a12;
  a9 -= c9_12.y * a13;
  a9 -= c9_12.z * a14;
  a9 -= c9_12.w * a15;
  const float4 c5_4 = *(const float4*)(Ab + 344);
  const float4 c5_8 = *(const float4*)(Ab + 348);
  const float4 c5_12 = *(const float4*)(Ab + 352);
  a8 -= c8_8.y * a9;
  a8 -= c8_8.z * a10;
  a8 -= c8_8.w * a11;
  a8 -= c8_12.x * a12;
  a8 -= c8_12.y * a13;
  a8 -= c8_12.z * a14;
  a8 -= c8_12.w * a15;
  const float4 c4_4 = *(const float4*)(Ab + 276);
  const float4 c4_8 = *(const float4*)(Ab + 280);
  const float4 c4_12 = *(const float4*)(Ab + 284);
  a7 -= c7_8.x * a8;
  a7 -= c7_8.y * a9;
  a7 -= c7_8.z * a10;
  a7 -= c7_8.w * a11;
  a7 -= c7_12.x * a12;
  a7 -= c7_12.y * a13;
  a7 -= c7_12.z * a14;
  a7 -= c7_12.w * a15;
  const float4 c3_4 = *(const float4*)(Ab + 208);
  const float4 c3_8 = *(const float4*)(Ab + 212);
  const float4 c3_12 = *(const float4*)(Ab + 216);
  a6 -= c6_4.w * a7;
  a6 -= c6_8.x * a8;
  a6 -= c6_8.y * a9;
  a6 -= c6_8.z * a10;
  a6 -= c6_8.w * a11;
  a6 -= c6_12.x * a12;
  a6 -= c6_12.y * a13;
  a6 -= c6_12.z * a14;
  a6 -= c6_12.w * a15;
  const float4 c2_0 = *(const float4*)(Ab + 136);
  const float4 c2_4 = *(const float4*)(Ab + 140);
  const float4 c2_8 = *(const float4*)(Ab + 144);
  const float4 c2_12 = *(const float4*)(Ab + 148);
  a5 -= c5_4.z * a6;
  a5 -= c5_4.w * a7;
  a5 -= c5_8.x * a8;
  a5 -= c5_8.y * a9;
  a5 -= c5_8.z * a10;
  a5 -= c5_8.w * a11;
  a5 -= c5_12.x * a12;
  a5 -= c5_12.y * a13;
  a5 -= c5_12.z * a14;
  a5 -= c5_12.w * a15;
  const float4 c1_0 = *(const float4*)(Ab + 68);
  const float4 c1_4 = *(const float4*)(Ab + 72);
  const float4 c1_8 = *(const float4*)(Ab + 76);
  const float4 c1_12 = *(const float4*)(Ab + 80);
  a4 -= c4_4.y * a5;
  a4 -= c4_4.z * a6;
  a4 -= c4_4.w * a7;
  a4 -= c4_8.x * a8;
  a4 -= c4_8.y * a9;
  a4 -= c4_8.z * a10;
  a4 -= c4_8.w * a11;
  a4 -= c4_12.x * a12;
  a4 -= c4_12.y * a13;
  a4 -= c4_12.z * a14;
  a4 -= c4_12.w * a15;
  const float4 c0_0 = *(const float4*)(Ab + 0);
  const float4 c0_4 = *(const float4*)(Ab + 4);
  const float4 c0_8 = *(const float4*)(Ab + 8);
  const float4 c0_12 = *(const float4*)(Ab + 12);
  a3 -= c3_4.x * a4;
  a3 -= c3_4.y * a5;
  a3 -= c3_4.z * a6;
  a3 -= c3_4.w * a7;
  a3 -= c3_8.x * a8;
  a3 -= c3_8.y * a9;
  a3 -= c3_8.z * a10;
  a3 -= c3_8.w * a11;
  a3 -= c3_12.x * a12;
  a3 -= c3_12.y * a13;
  a3 -= c3_12.z * a14;
  a3 -= c3_12.w * a15;
  a2 -= c2_0.w * a3;
  a2 -= c2_4.x * a4;
  a2 -= c2_4.y * a5;
  a2 -= c2_4.z * a6;
  a2 -= c2_4.w * a7;
  a2 -= c2_8.x * a8;
  a2 -= c2_8.y * a9;
  a2 -= c2_8.z * a10;
  a2 -= c2_8.w * a11;
  a2 -= c2_12.x * a12;
  a2 -= c2_12.y * a13;
  a2 -= c2_12.z * a14;
  a2 -= c2_12.w * a15;
  a1 -= c1_0.z * a2;
  a1 -= c1_0.w * a3;
  a1 -= c1_4.x * a4;
  a1 -= c1_4.y * a5;
  a1 -= c1_4.z * a6;
  a1 -= c1_4.w * a7;
  a1 -= c1_8.x * a8;
  a1 -= c1_8.y * a9;
  a1 -= c1_8.z * a10;
  a1 -= c1_8.w * a11;
  a1 -= c1_12.x * a12;
  a1 -= c1_12.y * a13;
  a1 -= c1_12.z * a14;
  a1 -= c1_12.w * a15;
  a0 -= c0_0.y * a1;
  a0 -= c0_0.z * a2;
  a0 -= c0_0.w * a3;
  a0 -= c0_4.x * a4;
  a0 -= c0_4.y * a5;
  a0 -= c0_4.z * a6;
  a0 -= c0_4.w * a7;
  a0 -= c0_8.x * a8;
  a0 -= c0_8.y * a9;
  a0 -= c0_8.z * a10;
  a0 -= c0_8.w * a11;
  a0 -= c0_12.x * a12;
  a0 -= c0_12.y * a13;
  a0 -= c0_12.z * a14;
  a0 -= c0_12.w * a15;
  Xc[0] = a0;
  Xc[65] = a1;
  Xc[130] = a2;
  Xc[195] = a3;
  Xc[260] = a4;
  Xc[325] = a5;
  Xc[390] = a6;
  Xc[455] = a7;
  Xc[520] = a8;
  Xc[585] = a9;
  Xc[650] = a10;
  Xc[715] = a11;
  Xc[780] = a12;
  Xc[845] = a13;
  Xc[910] = a14;
  Xc[975] = a15;
}
#define FS(i) (ldsf + (i) * 4160)
__device__ __forceinline__ void rwkv_item2(const Params& p, int l, int item, float* ldsf) {
  const int tid = opq(threadIdx.x), lane = tid & 63, wave = tid >> 6;
  const int r = lane & 31, hf = lane >> 5;
  const int h = item & 7, cidx = item >> 3, rowbase = cidx * 64, cc = cidx & 127;
  const u16* z = (const u16*)(p.ws + WS_Z);
  const float* mu = p.in[9] + l * 1792;
  u16* BBp = (u16*)((unsigned char*)ldsf + 83200);
  u16* XW = BBp;            u16* XA = BBp + 4608;    u16* XG = BBp + 9216;   u16* WT = BBp + 17920;
  u16* Rn = BBp;            u16* Kn = BBp + 4608;    u16* Bn = BBp + 9216;   u16* Cn = BBp + 13824;
  u16* CT = BBp + 18432;    u16* KHT = BBp + 23040;  u16* VT = BBp + 27648;
  float* gc = (float*)(BBp + 32256);
  u16* AK = (u16*)FS(2);    u16* NTm = AK + 4608;
  u16* MT = (u16*)FS(0);    u16* KQT = (u16*)FS(1);
  float* Abp = (float*)((unsigned char*)ldsf + 60928);
  const int mt = (wave >> 1) & 1, nt = wave & 1, grp = wave >> 2;
  const uint4* lwsrc = (const uint4*)((const u16*)(p.ws + WS_LW) + (size_t)h * 17920);
  const float bias_w = p.in[10][l * 512 + h * 64 + nt * 32 + r], bias_a = p.in[12][l * 512 + h * 64 + nt * 32 + r];
  float kkw_[8], kaw_[8], rkw_[8];
  {
    const int j0 = (tid & 7) * 8;
    const float* q1 = p.in[15] + l * 512 + h * 64 + j0; const float* q2 = p.in[16] + l * 512 + h * 64 + j0; const float* q3 = p.in[17] + l * 512 + h * 64 + j0;
    const float4 x0 = *(const float4*)q1, x1 = *(const float4*)(q1 + 4), y0 = *(const float4*)q2, y1 = *(const float4*)(q2 + 4), z0 = *(const float4*)q3, z1 = *(const float4*)(q3 + 4);
    kkw_[0] = x0.x; kkw_[1] = x0.y; kkw_[2] = x0.z; kkw_[3] = x0.w; kkw_[4] = x1.x; kkw_[5] = x1.y; kkw_[6] = x1.z; kkw_[7] = x1.w;
    kaw_[0] = y0.x; kaw_[1] = y0.y; kaw_[2] = y0.z; kaw_[3] = y0.w; kaw_[4] = y1.x; kaw_[5] = y1.y; kaw_[6] = y1.z; kaw_[7] = y1.w;
    rkw_[0] = z0.x; rkw_[1] = z0.y; rkw_[2] = z0.z; rkw_[3] = z0.w; rkw_[4] = z1.x; rkw_[5] = z1.y; rkw_[6] = z1.z; rkw_[7] = z1.w;
  }
  const uint4 g2a = lwsrc[1152 + tid], g2b = lwsrc[1152 + 512 + tid], g2c = (tid < 64) ? lwsrc[1152 + 1024 + tid] : make_uint4(0, 0, 0, 0);
  __syncthreads();
  {
    const int t = tid >> 3, c8 = (tid & 7) * 8;
    const int m = rowbase + t;
    const int zcs[7] = {h * 64, 512 + h * 64, 1024 + h * 64, 1536, 1600, 1664, 1728};
#pragma unroll
    for (int gi = 0; gi < 7; ++gi) {
      const int zc = zcs[gi] + c8;
      float cur[8], prv[8], v[8];
      const float4 mu0 = *(const float4*)(mu + zc), mu1 = *(const float4*)(mu + zc + 4);
      const float muv[8] = {mu0.x, mu0.y, mu0.z, mu0.w, mu1.x, mu1.y, mu1.z, mu1.w};
      unpack8(*(const uint4*)(z + (size_t)m * ZLD + zc), cur);
      if (t == 0 && cc == 0) {
#pragma unroll
        for (int i = 0; i < 8; ++i) prv[i] = 0.f;
      } else {
        unpack8(*(const uint4*)(z + (size_t)(m - 1) * ZLD + zc), prv);
      }
#pragma unroll
      for (int i = 0; i < 8; ++i) {
        float x = cur[i] + muv[i] * (prv[i] - cur[i]);
        if (gi == 3) x = 1.f - 2.f * __builtin_amdgcn_rcpf(1.f + __expf(2.f * x));
        if (gi >= 5) x = sigm(x);
        v[i] = x;
      }
      if (gi < 2) {
        float* d = FS(gi) + t * 65 + c8;
#pragma unroll
        for (int i = 0; i < 8; ++i) d[i] = v[i];
      } else if (gi == 2) {
#pragma unroll
        for (int i = 0; i < 8; ++i) VT[SWZ(c8 + i, t)] = f2bf(v[i]);
      } else if (gi == 3) { *(uint4*)(XW + t * 72 + c8) = pack8(v); }
      else if (gi == 4) { *(uint4*)(XA + t * 72 + c8) = pack8(v); }
      else { *(uint4*)(XG + t * 136 + (gi - 5) * 64 + c8) = pack8(v); }
    }
  }
  {
    uint4* d = (uint4*)WT;
    for (int e = tid; e < 1152; e += 512) d[e] = lwsrc[e];
  }
  __syncthreads();
  {
    f32x16 acc;
#pragma unroll
    for (int i = 0; i < 16; ++i) acc[i] = 0.f;
    mm_tile(grp ? XA : XW, 72, grp ? WT + 4608 : WT, 72, mt, nt, r, hf, 4, acc);
    const int j = nt * 32 + r;
    const float bias = grp ? bias_a : bias_w;
#pragma unroll
    for (int reg = 0; reg < 16; ++reg) {
      const int t = mt * 32 + ROWOFF(reg, hf);
      const float x = acc[reg] + bias;
      if (grp) FS(3)[t * 65 + j] = sigm(x);
      else {
        const float nx = -x;
        const float sp = (nx > 20.f) ? nx : __logf(1.f + __expf(nx));
        FS(4)[t * 65 + j] = -__expf(-sp - 0.5f);
      }
    }
  }
  __syncthreads();
  {
    uint4* d = (uint4*)WT;
    d[tid] = g2a; d[512 + tid] = g2b; if (tid < 64) d[1024 + tid] = g2c;
  }
  float* psum = (float*)((unsigned char*)ldsf + 147968);
  float pl[8];
  {
    const int j = tid & 63, sg = tid >> 6;
    float c = 0.f;
#pragma unroll
    for (int u = 0; u < 8; ++u) { c += FS(4)[(sg * 8 + u) * 65 + j]; pl[u] = c; }
    psum[sg * 64 + j] = c;
  }
  __syncthreads();
  {
    const int j = tid & 63, sg = tid >> 6;
    float off = 0.f, tot = 0.f;
#pragma unroll
    for (int q = 0; q < 8; ++q) { const float v = psum[q * 64 + j]; tot += v; if (q < sg) off += v; }
#pragma unroll
    for (int u = 0; u < 8; ++u) FS(2)[(sg * 8 + u) * 65 + j] = off + pl[u];
    if (sg == 0) { const float g = __expf(tot); gc[j] = g; ((float*)(p.ws + WS_GC))[(size_t)item * 64 + j] = g; }
  }
  __syncthreads();
  if (grp == 0) {
    f32x16 acc;
#pragma unroll
    for (int i = 0; i < 16; ++i) acc[i] = 0.f;
    mm_tile(XG, 136, WT, 136, mt, nt, r, hf, 8, acc);
    u16* ga = (u16*)(p.ws + WS_GA) + (size_t)item * 4096;
#pragma unroll
    for (int reg = 0; reg < 16; ++reg) ga[(mt * 32 + ROWOFF(reg, hf)) * 64 + nt * 32 + r] = f2bf(acc[reg]);
  }
  __syncthreads();
  {
    const int t = tid >> 3, j0 = (tid & 7) * 8;
    float kr[8], av[8], rv[8], kkv[8], kf[8];
    float nrm = 0.f, bdot = 0.f;
#pragma unroll
    for (int i = 0; i < 8; ++i) {
      const int j = j0 + i;
      kr[i] = FS(1)[t * 65 + j]; av[i] = FS(3)[t * 65 + j]; rv[i] = FS(0)[t * 65 + j];
      kkv[i] = kr[i] * kkw_[i];
      nrm += kkv[i] * kkv[i];
      kf[i] = kr[i] * (1.f + (av[i] - 1.f) * kaw_[i]);
      bdot += rv[i] * kf[i] * rkw_[i];
    }
    nrm += __shfl_xor(nrm, 1, 64); nrm += __shfl_xor(nrm, 2, 64); nrm += __shfl_xor(nrm, 4, 64);
    bdot += __shfl_xor(bdot, 1, 64); bdot += __shfl_xor(bdot, 2, 64); bdot += __shfl_xor(bdot, 4, 64);
    const float rn = 1.f / fmaxf(sqrtf(nrm), 1e-12f);
    float o_r[8], o_k[8], o_b[8], o_c[8], bo[8];
#pragma unroll
    for (int i = 0; i < 8; ++i) {
      const int j = j0 + i;
      const float cum = FS(2)[t * 65 + j], dl = FS(4)[t * 65 + j];
      const float eg = __expf(cum), egi = __expf(-cum), egp = __expf(cum - dl);
      const float kk = kkv[i] * rn;
      const float g = gc[j];
      o_r[i] = rv[i] * eg; o_k[i] = kf[i] * egi; o_b[i] = kk * av[i] * egi; o_c[i] = kk * egp;
      CT[SWZ(j, t)] = f2bf(o_c[i]);
      KHT[SWZ(j, t)] = f2bf(o_k[i] * g);
      FS(1)[t * 65 + j] = o_b[i] * g;
      bo[i] = bdot * bf2f(VT[SWZ(j, t)]);
    }
    *(uint4*)(Rn + t * 72 + j0) = pack8(o_r);
    *(uint4*)(Kn + t * 72 + j0) = pack8(o_k);
    *(uint4*)(Bn + t * 72 + j0) = pack8(o_b);
    *(uint4*)(Cn + t * 72 + j0) = pack8(o_c);
    u16* bop = (u16*)(p.ws + WS_BO) + (size_t)item * 4096;
    *(uint4*)(bop + t * 64 + j0) = pack8(bo);
  }
  __syncthreads();
  f32x16 akr;
#pragma unroll
  for (int i = 0; i < 16; ++i) akr[i] = 0.f;
  if (grp == 0) {
    f32x16 ab, abr;
#pragma unroll
    for (int i = 0; i < 16; ++i) { ab[i] = 0.f; abr[i] = 0.f; }
    mm_tile(Bn, 72, Cn, 72, mt, nt, r, hf, 4, ab);
    mm_tile(Bn, 72, Rn, 72, mt, nt, r, hf, 4, abr);
    const int t = nt * 32 + r;
#pragma unroll
    for (int reg = 0; reg < 16; ++reg) {
      const int i = mt * 32 + ROWOFF(reg, hf);
      Abp[i * 68 + t] = (i < t) ? ab[reg] : 0.f;
      FS(0)[i * 65 + t] = (i <= t) ? abr[reg] : 0.f;
    }
  } else {
    f32x16 akt;
#pragma unroll
    for (int i = 0; i < 16; ++i) akt[i] = 0.f;
    mm_tile(Cn, 72, Kn, 72, mt, nt, r, hf, 4, akt);
    {
      const int i = nt * 32 + r;
#pragma unroll
      for (int reg = 0; reg < 16; ++reg) { const int t = mt * 32 + ROWOFF(reg, hf); if (!(i < t)) akt[reg] = 0.f; }
    }
    store_T(AK, 72, mt, nt, r, hf, akt);
    mm_tile(Kn, 72, Rn, 72, mt, nt, r, hf, 4, akr);
    {
      const int t = nt * 32 + r;
#pragma unroll
      for (int reg = 0; reg < 16; ++reg) { const int i = mt * 32 + ROWOFF(reg, hf); if (!(i <= t)) akr[reg] = 0.f; }
    }
  }
  __syncthreads();
#pragma unroll 1
  for (int I = 3; I >= 0; --I) {
    if (tid < 128) {
      float* X_ = (tid < 64) ? FS(0) : FS(1);
      tri16(Abp + I * 16 * 69, X_ + I * 16 * 65 + (tid & 63));
    }
    __syncthreads();
    if (I > 0) {
      const int c = tid & 127, rg = tid >> 7;
      float* X_ = (c < 64) ? FS(0) : FS(1);
      const int col = c & 63;
      float xv[16];
#pragma unroll
      for (int t = 0; t < 16; ++t) xv[t] = X_[(I * 16 + t) * 65 + col];
      for (int i = rg; i < I * 16; i += 4) {
        const float* ar = Abp + i * 68 + I * 16;
        const float4 c0 = *(const float4*)ar, c1 = *(const float4*)(ar + 4), c2 = *(const float4*)(ar + 8), c3 = *(const float4*)(ar + 12);
        float a = c0.x * xv[0] + c0.y * xv[1] + c0.z * xv[2] + c0.w * xv[3];
        a += c1.x * xv[4] + c1.y * xv[5] + c1.z * xv[6] + c1.w * xv[7];
        a += c2.x * xv[8] + c2.y * xv[9] + c2.z * xv[10] + c2.w * xv[11];
        a += c3.x * xv[12] + c3.y * xv[13] + c3.z * xv[14] + c3.w * xv[15];
        X_[i * 65 + col] -= a;
      }
      __syncthreads();
    }
  }
  {
    const int c = tid >> 2, q = tid & 3;
    const float* X_ = (c < 64) ? FS(0) : FS(1);
    const int col = c & 63;
    float o0[8], o1[8];
#pragma unroll
    for (int u = 0; u < 8; ++u) { o0[u] = -X_[(q * 16 + u) * 65 + col]; o1[u] = -X_[(q * 16 + 8 + u) * 65 + col]; }
    u16* dst = NTm + c * 72 + q * 16;
    *(uint4*)dst = pack8(o0);
    *(uint4*)(dst + 8) = pack8(o1);
  }
  __syncthreads();
  if (grp == 1) {
    mm_tile(AK, 72, NTm, 72, mt, nt, r, hf, 4, akr);
    store_T(MT, 72, mt, nt, r, hf, akr);
  } else {
    f32x16 d2;
#pragma unroll
    for (int i = 0; i < 16; ++i) d2[i] = 0.f;
    mm_tile(AK, 72, NTm + 64 * 72, 72, mt, nt, r, hf, 4, d2);
#pragma unroll
    for (int g = 0; g < 4; ++g) {
      const int idx = (nt * 32 + r) * 72 + mt * 32 + 8 * g + 4 * hf;
      const uint2 kh = *(const uint2*)(KHT + SWZ(nt * 32 + r, mt * 32 + 8 * g + 4 * hf));
      uint2 o;
      o.x = pack2(d2[4 * g] + __uint_as_float(kh.x << 16), d2[4 * g + 1] + __uint_as_float(kh.x & 0xFFFF0000u));
      o.y = pack2(d2[4 * g + 2] + __uint_as_float(kh.y << 16), d2[4 * g + 3] + __uint_as_float(kh.y & 0xFFFF0000u));
      *(uint2*)(KQT + idx) = o;
    }
  }
  __syncthreads();
  if (grp == 0) {
    f32x16 w2, yl;
#pragma unroll
    for (int i = 0; i < 16; ++i) { w2[i] = 0.f; yl[i] = 0.f; }
    mm_tile<false, true>(NTm, 72, CT, 72, mt, nt, r, hf, 4, w2);
    mm_tile<false, true>(MT, 72, VT, 72, mt, nt, r, hf, 4, yl);
    u16* W2p = (u16*)(p.ws + WS_W2) + (size_t)item * 4096;
    u16* YLp = (u16*)(p.ws + WS_YL) + (size_t)item * 4096;
#pragma unroll
    for (int reg = 0; reg < 16; ++reg) {
      const int t = mt * 32 + ROWOFF(reg, hf), n = nt * 32 + r;
      W2p[t * 64 + n] = f2bf(w2[reg] + bf2f(Rn[t * 72 + n]));
      YLp[t * 64 + n] = f2bf(yl[reg]);
    }
  } else {
    f32x16 pp, qt;
#pragma unroll
    for (int i = 0; i < 16; ++i) { pp[i] = 0.f; qt[i] = 0.f; }
    mm_tile<true, false>(CT, 72, NTm + 64 * 72, 72, mt, nt, r, hf, 4, pp);
    mm_tile<false, true>(KQT, 72, VT, 72, mt, nt, r, hf, 4, qt);
    uint4* Pf = (uint4*)((u16*)(p.ws + WS_PP) + (size_t)item * 4096);
    float* Qf = (float*)(p.ws + WS_Q) + (size_t)item * 4096;
#pragma unroll
    for (int s2 = 0; s2 < 2; ++s2) {
      uint4 o;
      o.x = pack2(pp[s2 * 8 + 0], pp[s2 * 8 + 1]); o.y = pack2(pp[s2 * 8 + 2], pp[s2 * 8 + 3]);
      o.z = pack2(pp[s2 * 8 + 4], pp[s2 * 8 + 5]); o.w = pack2(pp[s2 * 8 + 6], pp[s2 * 8 + 7]);
      Pf[(nt * 4 + mt * 2 + s2) * 64 + lane] = o;
    }
#pragma unroll
    for (int reg = 0; reg < 16; ++reg) Qf[((nt * 2 + mt) * 16 + reg) * 64 + lane] = qt[reg];
  }
}

template <int K_> struct IC { static constexpr int value = K_; };
__device__ __forceinline__ void rwkv_scan(const Params& p, int l, int bh, float* ldsf, bool dry = false) {
  const int tid = opq(threadIdx.x), lane = tid & 63, wave = tid >> 6;
  const int b = bh >> 3, h = bh & 7;
  unsigned char* ring = (unsigned char*)ldsf + 32768;
  uint4* xch = (uint4*)((unsigned char*)ldsf + 32768 + 49152);
  __syncthreads();
  {
    const float* G0 = (const float*)(p.ws + WS_GC);
    for (int e = tid; e < 8192; e += NT) ldsf[e] = G0[(size_t)((b * 128 + (e >> 6)) * 8 + h) * 64 + (e & 63)];
    if (tid < 256) { for (int e = tid; e < 1024; e += 256) xch[e] = make_uint4(0, 0, 0, 0); }
  }
  const bool helper = wave >= 4;
  const u16* PPb = (const u16*)(p.ws + WS_PP);
  const float* Qb = (const float*)(p.ws + WS_Q);
  if (helper) {
    const bool isP = wave < 6;
    const int hidx = isP ? (tid - 256) : (tid - 384);
    const int hdst = isP ? hidx : 512 + hidx;
#define SC_GLOAD(c, R) do { const size_t id_ = (size_t)((b * 128 + (c)) * 8 + h); \
      if (isP) { const uint4* src_ = (const uint4*)(PPb + id_ * 4096) + hidx; R##0 = src_[0]; R##1 = src_[128]; R##2 = src_[256]; R##3 = src_[384]; } \
      else { const uint4* src_ = (const uint4*)(Qb + id_ * 4096) + hidx; R##0 = src_[0]; R##1 = src_[128]; R##2 = src_[256]; R##3 = src_[384]; \
             R##4 = src_[512]; R##5 = src_[640]; R##6 = src_[768]; R##7 = src_[896]; } } while (0)
#define SC_LWRITE(c, R) do { uint4* slot_ = (uint4*)(ring + ((c) & 1) * 24576) + hdst; \
      slot_[0] = R##0; slot_[128] = R##1; slot_[256] = R##2; slot_[384] = R##3; \
      if (!isP) { slot_[512] = R##4; slot_[640] = R##5; slot_[768] = R##6; slot_[896] = R##7; } } while (0)
    uint4 a0, a1, a2, a3, a4, a5, a6, a7, b0, b1, b2, b3, b4, b5, b6, b7, c0, c1, c2, c3, c4, c5, c6, c7, d0, d1, d2, d3, d4, d5, d6, d7;
    a4 = a5 = a6 = a7 = b4 = b5 = b6 = b7 = c4 = c5 = c6 = c7 = d4 = d5 = d6 = d7 = make_uint4(0, 0, 0, 0);
    SC_GLOAD(0, a); SC_LWRITE(0, a);
    SC_GLOAD(1, b); SC_GLOAD(2, c); SC_GLOAD(3, d);
    __syncthreads();
#pragma unroll 1
    for (int cc = 0; cc < 128; cc += 4) {
      if (cc + 4 < 128) SC_GLOAD(cc + 4, a);
      SC_LWRITE(cc + 1, b);
      asm volatile("s_waitcnt lgkmcnt(0)\n\ts_barrier" ::: "memory");
      if (cc + 5 < 128) SC_GLOAD(cc + 5, b);
      SC_LWRITE(cc + 2, c);
      asm volatile("s_waitcnt lgkmcnt(0)\n\ts_barrier" ::: "memory");
      if (cc + 6 < 128) SC_GLOAD(cc + 6, c);
      SC_LWRITE(cc + 3, d);
      asm volatile("s_waitcnt lgkmcnt(0)\n\ts_barrier" ::: "memory");
      if (cc + 7 < 128) SC_GLOAD(cc + 7, d);
      if (cc + 4 < 128) SC_LWRITE(cc + 4, a);
      asm volatile("s_waitcnt lgkmcnt(0)\n\ts_barrier" ::: "memory");
    }
    return;
  }
  __syncthreads();
  const int vt = wave & 1, kt2 = wave >> 1, hf = lane >> 5;
  f32x16 S;
#pragma unroll
  for (int i = 0; i < 16; ++i) S[i] = 0.f;
  uint4 own0 = make_uint4(0, 0, 0, 0), own1 = make_uint4(0, 0, 0, 0);
#pragma unroll 1
  for (int cc = 0; cc < 128; ++cc) {
    const size_t id = (size_t)((b * 128 + cc) * 8 + h);
    const int lofs = opq(lane);
    float* Qg = (float*)Qb + id * 4096 + (vt * 2 + kt2) * 1024 + lofs;
    const uint4* slotA = (const uint4*)(ring + (cc & 1) * 24576) + kt2 * 256 + lofs;
    const float* slotQ = (const float*)(ring + (cc & 1) * 24576 + 8192) + (vt * 2 + kt2) * 1024 + lofs;
    const float* gcp = ldsf + cc * 64 + kt2 * 32 + 4 * (lofs >> 5);
    const uint4* xin = xch + (((cc & 1) * 2 + vt) * 2 + (kt2 ^ 1)) * 128 + lofs;
    uint4* xout = xch + ((((cc + 1) & 1) * 2 + vt) * 2 + kt2) * 128 + lofs;
    f32x16 acc;
#pragma unroll
    for (int reg = 0; reg < 16; ++reg) acc[reg] = S[reg] * gcp[((reg) & 3) + 8 * ((reg) >> 2)] + slotQ[reg * 64];
#pragma unroll
    for (int reg = 0; reg < 16; ++reg) if (!dry) Qg[reg * 64] = S[reg];
    const uint4 p0 = xin[0], p1 = xin[64];
#pragma unroll
    for (int s_ = 0; s_ < 4; ++s_) {
      union { uint4 u; bf16x8 v; } bfr, af;
      const bool mine = (s_ >> 1) == kt2;
      bfr.u = mine ? ((s_ & 1) ? own1 : own0) : ((s_ & 1) ? p1 : p0);
      af.u = slotA[s_ * 64];
      acc = __builtin_amdgcn_mfma_f32_32x32x16_bf16(af.v, bfr.v, acc, 0, 0, 0);
    }
    S = acc;
    own0 = make_uint4(pack2(S[0], S[1]), pack2(S[2], S[3]), pack2(S[4], S[5]), pack2(S[6], S[7]));
    own1 = make_uint4(pack2(S[8], S[9]), pack2(S[10], S[11]), pack2(S[12], S[13]), pack2(S[14], S[15]));
    xout[0] = own0; xout[64] = own1;
    asm volatile("s_waitcnt lgkmcnt(0)\n\ts_barrier" ::: "memory");
  }
  {
    float* o = p.out + O_PWKV + ((size_t)((l * 2 + b) * 8 + h) * 64 + vt * 32 + (lane & 31)) * 64 + kt2 * 32;
#pragma unroll
    for (int reg = 0; reg < 16; ++reg) o[ROWOFF(reg, hf)] = S[reg];
  }
}

__device__ __forceinline__ void rwkv_out(const Params& p, int l, int item, float* ldsf) {
  const int tid = opq(threadIdx.x), lane = tid & 63, wave = tid >> 6;
  const int h = item & 7, cidx = item >> 3;
  float* Sl = ldsf; float* Wl = ldsf + 4160;
  const float* Sg = (const float*)(p.ws + WS_Q) + (size_t)item * 4096;
  const u16* W2 = (const u16*)(p.ws + WS_W2) + (size_t)item * 4096;
  const u16* YL = (const u16*)(p.ws + WS_YL) + (size_t)item * 4096;
  const u16* BO = (const u16*)(p.ws + WS_BO) + (size_t)item * 4096;
  const u16* GA = (const u16*)(p.ws + WS_GA) + (size_t)item * 4096;
  u16* z = (u16*)(p.ws + WS_Z);
  __syncthreads();
  {
    const int row = tid >> 3, c = (tid & 7) * 8;
#pragma unroll
    for (int i = 0; i < 8; ++i) {
      const int idx = i * 512 + tid;
      const int ln = idx & 63, reg = (idx >> 6) & 15, kt = (idx >> 10) & 1, vt = idx >> 11;
      Sl[(vt * 32 + (ln & 31)) * 65 + kt * 32 + ROWOFF(reg, ln >> 5)] = Sg[idx];
    }
    float w[8];
    unpack8(*(const uint4*)(W2 + row * 64 + c), w);
    float* e = Wl + row * 65 + c;
#pragma unroll
    for (int i = 0; i < 8; ++i) e[i] = w[i];
  }
  __syncthreads();
  float y[8];
#pragma unroll
  for (int q = 0; q < 8; ++q) y[q] = bf2f(YL[(wave * 8 + q) * 64 + lane]);
#pragma unroll 2
  for (int k = 0; k < 64; ++k) {
    const float s = Sl[lane * 65 + k];
#pragma unroll
    for (int q = 0; q < 8; ++q) y[q] += s * Wl[(wave * 8 + q) * 65 + k];
  }
  const float lng = p.in[18][l * 512 + h * 64 + lane], lnb = p.in[19][l * 512 + h * 64 + lane];
#pragma unroll
  for (int q = 0; q < 8; ++q) {
    const int t = wave * 8 + q;
    const float mean = wave_sum(y[q]) * (1.f / 64.f);
    const float d = y[q] - mean;
    const float var = wave_sum(d * d) * (1.f / 64.f);
    const float yn = d * rsqrtf(var + 64e-5f) * lng + lnb;
    const float o = (yn + bf2f(BO[t * 64 + lane])) * bf2f(GA[t * 64 + lane]);
    z[(size_t)(cidx * 64 + t) * ZLD + h * 64 + lane] = f2bf(o);
  }
}

__device__ __forceinline__ void rwkv_out4(const Params& p, int l, int item0, float* ldsf) {
  const int tid = opq(threadIdx.x), lane = tid & 63, wave = tid >> 6;
  const int r = lane & 31, hf = lane >> 5;
  const int pair = wave >> 1, nt = wave & 1;
  const int item = item0 + pair;
  const int h = item & 7, cidx = item >> 3;
  u16* Sl = (u16*)ldsf + pair * 4608;
  const float* Sg = (const float*)(p.ws + WS_Q) + (size_t)item * 4096;
  const u16* W2 = (const u16*)(p.ws + WS_W2) + (size_t)item * 4096;
  const u16* YL = (const u16*)(p.ws + WS_YL) + (size_t)item * 4096;
  const u16* BO = (const u16*)(p.ws + WS_BO) + (size_t)item * 4096;
  const u16* GA = (const u16*)(p.ws + WS_GA) + (size_t)item * 4096;
  u16* z = (u16*)(p.ws + WS_Z);
  __syncthreads();
  {
    const int lt = tid & 127;
#pragma unroll
    for (int q = 0; q < 8; ++q) {
      const int e = q * 128 + lt;
      const int ln = e & 63, g = (e >> 6) & 3, kt = (e >> 8) & 1, vt = (e >> 9) & 1;
      const float* sp = Sg + ((vt * 2 + kt) * 16 + 4 * g) * 64 + ln;
      const float a0 = sp[0], a1 = sp[64], a2 = sp[128], a3 = sp[192];
      uint2 o; o.x = pack2(a0, a1); o.y = pack2(a2, a3);
      *(uint2*)(Sl + (vt * 32 + (ln & 31)) * 72 + kt * 32 + 8 * g + 4 * (ln >> 5)) = o;
    }
  }
  bf16x8 bfr[4];
#pragma unroll
  for (int s_ = 0; s_ < 4; ++s_) bfr[s_] = *(const bf16x8*)(W2 + (nt * 32 + r) * 64 + s_ * 16 + hf * 8);
  __syncthreads();
  f32x16 acc[2];
#pragma unroll
  for (int mt = 0; mt < 2; ++mt) {
#pragma unroll
    for (int i = 0; i < 16; ++i) acc[mt][i] = 0.f;
#pragma unroll
    for (int s_ = 0; s_ < 4; ++s_) {
      const bf16x8 a = *(const bf16x8*)(Sl + (mt * 32 + r) * 72 + s_ * 16 + hf * 8);
      acc[mt] = __builtin_amdgcn_mfma_f32_32x32x16_bf16(a, bfr[s_], acc[mt], 0, 0, 0);
    }
  }
  const int t = nt * 32 + r;
  float sum = 0.f;
#pragma unroll
  for (int mt = 0; mt < 2; ++mt)
#pragma unroll
    for (int g = 0; g < 4; ++g) {
      const uint2 yl = *(const uint2*)(YL + t * 64 + mt * 32 + 8 * g + 4 * hf);
      acc[mt][4 * g + 0] += __uint_as_float(yl.x << 16); acc[mt][4 * g + 1] += __uint_as_float(yl.x & 0xFFFF0000u);
      acc[mt][4 * g + 2] += __uint_as_float(yl.y << 16); acc[mt][4 * g + 3] += __uint_as_float(yl.y & 0xFFFF0000u);
      sum += acc[mt][4 * g] + acc[mt][4 * g + 1] + acc[mt][4 * g + 2] + acc[mt][4 * g + 3];
    }
  sum += __shfl_xor(sum, 32, 64);
  const float mean = sum * (1.f / 64.f);
  float vs = 0.f;
#pragma unroll
  for (int mt = 0; mt < 2; ++mt)
#pragma unroll
    for (int i = 0; i < 16; ++i) { const float d = acc[mt][i] - mean; vs += d * d; }
  vs += __shfl_xor(vs, 32, 64);
  const float rstd = rsqrtf(vs * (1.f / 64.f) + 64e-5f);
  const float* lng = p.in[18] + l * 512 + h * 64;
  const float* lnb = p.in[19] + l * 512 + h * 64;
  u16* zrow = z + (size_t)(cidx * 64 + t) * ZLD + h * 64;
#pragma unroll
  for (int mt = 0; mt < 2; ++mt)
#pragma unroll
    for (int g = 0; g < 4; ++g) {
      const int v0 = mt * 32 + 8 * g + 4 * hf;
      const uint2 bo = *(const uint2*)(BO + t * 64 + v0);
      const uint2 ga = *(const uint2*)(GA + t * 64 + v0);
      const float4 lg = *(const float4*)(lng + v0), lb = *(const float4*)(lnb + v0);
      const float bo_[4] = {__uint_as_float(bo.x << 16), __uint_as_float(bo.x & 0xFFFF0000u), __uint_as_float(bo.y << 16), __uint_as_float(bo.y & 0xFFFF0000u)};
      const float ga_[4] = {__uint_as_float(ga.x << 16), __uint_as_float(ga.x & 0xFFFF0000u), __uint_as_float(ga.y << 16), __uint_as_float(ga.y & 0xFFFF0000u)};
      const float lg_[4] = {lg.x, lg.y, lg.z, lg.w}, lb_[4] = {lb.x, lb.y, lb.z, lb.w};
      float o[4];
#pragma unroll
      for (int u = 0; u < 4; ++u) o[u] = ((acc[mt][4 * g + u] - mean) * rstd * lg_[u] + lb_[u] + bo_[u]) * ga_[u];
      uint2 ov; ov.x = pack2(o[0], o[1]); ov.y = pack2(o[2], o[3]);
      *(uint2*)(zrow + v0) = ov;
    }
}

__device__ __forceinline__ void attn_prompt(const Params& p, int l, int item, u16* lds, bool dry = false) {
  const int tid = opq(threadIdx.x), lane = tid & 63, wave = tid >> 6;
  const int r = lane & 31, h = lane >> 5;
  const int kvh = item & 1, n = (item >> 1) & 63, b = item >> 7;
  u16* z = (u16*)(p.ws + WS_Z);
  u16* Ks = lds;
  u16* Vt = lds + 256 * 72;
  __syncthreads();
  {
    const int key = tid >> 1, half = tid & 1;
    const int t = (n - 1) * 128 + key;
    uint4 kv[4], vv[4];
    if (t >= 0) {
      const u16* kp = z + (size_t)(b * 8192 + t) * ZLD + 2304 + kvh * 64 + half * 32;
      const u16* vp = z + (size_t)(b * 8192 + t) * ZLD + 2432 + kvh * 64 + half * 32;
#pragma unroll
      for (int i = 0; i < 4; ++i) { kv[i] = *(const uint4*)(kp + i * 8); vv[i] = *(const uint4*)(vp + i * 8); }
    } else {
#pragma unroll
      for (int i = 0; i < 4; ++i) { kv[i] = make_uint4(0, 0, 0, 0); vv[i] = make_uint4(0, 0, 0, 0); }
    }
#pragma unroll
    for (int i = 0; i < 4; ++i) {
      *(uint4*)(Ks + key * 72 + half * 32 + i * 8) = kv[i];
      const unsigned w[4] = {vv[i].x, vv[i].y, vv[i].z, vv[i].w};
#pragma unroll
      for (int q = 0; q < 4; ++q) {
        const int d = half * 32 + i * 8 + q * 2;
        Vt[d * 264 + key] = (u16)(w[q] & 0xFFFFu);
        Vt[(d + 1) * 264 + key] = (u16)(w[q] >> 16);
      }
    }
  }
  __syncthreads();
#pragma unroll 1
  for (int uu = 0; uu < 2; ++uu) {
    const int u = wave * 2 + uu;
    const int hq = kvh * 4 + (u >> 2), qg = u & 3;
    const int qrow = b * 8192 + n * 128 + qg * 32 + r;
    u16* qp = z + (size_t)qrow * ZLD + 1792 + hq * 64;
    bf16x8 qf[4];
#pragma unroll
    for (int s = 0; s < 4; ++s) qf[s] = *(const bf16x8*)(qp + s * 16 + h * 8);
    f32x16 sc[5];
#pragma unroll
    for (int i5 = 0; i5 < 5; ++i5) {
#pragma unroll
      for (int i = 0; i < 16; ++i) sc[i5][i] = 0.f;
      const int kt = qg + i5;
#pragma unroll
      for (int s = 0; s < 4; ++s) {
        bf16x8 kf = *(const bf16x8*)(Ks + (kt * 32 + r) * 72 + s * 16 + h * 8);
        sc[i5] = __builtin_amdgcn_mfma_f32_32x32x16_bf16(kf, qf[s], sc[i5], 0, 0, 0);
      }
      __builtin_amdgcn_sched_barrier(0);
    }
    const int qi = qg * 32 + r;
    const float sink = p.in[20][l * 8 + hq];
    float mx = -1e30f;
#pragma unroll
    for (int i5 = 0; i5 < 5; ++i5)
#pragma unroll
      for (int reg = 0; reg < 16; ++reg) {
        const int j = (qg + i5) * 32 + ROWOFF(reg, h);
        const bool ok = (j > qi) && (j <= qi + 128) && (n > 0 || j >= 128);
        const float s = ok ? sc[i5][reg] * 0.125f : -1e30f;
        sc[i5][reg] = s;
        mx = fmaxf(mx, s);
      }
    mx = fmaxf(mx, __shfl_xor(mx, 32, 64));
    mx = fmaxf(mx, sink);
    float sum = 0.f;
#pragma unroll
    for (int i5 = 0; i5 < 5; ++i5)
#pragma unroll
      for (int reg = 0; reg < 16; ++reg) { const float e = __expf(sc[i5][reg] - mx); sc[i5][reg] = e; sum += e; }
    sum += __shfl_xor(sum, 32, 64);
    const float rden = 1.f / (sum + __expf(sink - mx));
    f32x16 oacc[2];
#pragma unroll
    for (int i = 0; i < 16; ++i) { oacc[0][i] = 0.f; oacc[1][i] = 0.f; }
#pragma unroll
    for (int i5 = 0; i5 < 5; ++i5) {
      const int kt = qg + i5;
#pragma unroll
      for (int s2 = 0; s2 < 2; ++s2) {
        bf16x8 pf;
#pragma unroll
        for (int j = 0; j < 8; ++j) pf[j] = (short)f2bf(sc[i5][s2 * 8 + j] * rden);
#pragma unroll
        for (int dt = 0; dt < 2; ++dt) {
          const u16* vp = Vt + (dt * 32 + r) * 264 + kt * 32 + s2 * 16 + h * 4;
          const uint2 lo = *(const uint2*)vp, hi = *(const uint2*)(vp + 8);
          union { uint4 u; bf16x8 v; } cv;
          cv.u = make_uint4(lo.x, lo.y, hi.x, hi.y);
          oacc[dt] = __builtin_amdgcn_mfma_f32_32x32x16_bf16(cv.v, pf, oacc[dt], 0, 0, 0);
        }
        __builtin_amdgcn_sched_barrier(0);
      }
    }
#pragma unroll
    for (int dt = 0; dt < 2; ++dt)
#pragma unroll
      for (int g4 = 0; g4 < 4; ++g4) {
        const int d = dt * 32 + 8 * g4 + 4 * h;
        uint2 o;
        o.x = pack2(oacc[dt][g4 * 4 + 0], oacc[dt][g4 * 4 + 1]);
        o.y = pack2(oacc[dt][g4 * 4 + 2], oacc[dt][g4 * 4 + 3]);
        if (!dry) *(uint2*)(qp + d) = o;
      }
  }
}

__device__ __forceinline__ void attn_sample(const Params& p, int l, int item, float* ldsf, bool dry = false) {
  const int tid = opq(threadIdx.x);
  const int kvh = item & 1, b = item >> 1;
  u16* z = (u16*)(p.ws + WS_Z);
  float* Kl = ldsf;
  float* Vl = ldsf + 132 * 65;
  float* Ql = Vl + 132 * 65;
  float* Pl = Ql + 16 * 64;
  __syncthreads();
  for (int e = tid; e < 132 * 8; e += NT) {
    const int j = e >> 3, c = (e & 7) * 8;
    float k[8], v[8];
    if (j < 128) {
      const float* kp = p.in[4] + ((size_t)((l * 128 + b) * 128 + j) * 2 + kvh) * 64 + c;
      const float* vp = p.in[5] + ((size_t)((l * 128 + b) * 128 + j) * 2 + kvh) * 64 + c;
      float4 a = *(const float4*)kp, a2 = *(const float4*)(kp + 4);
      float4 c1 = *(const float4*)vp, c2 = *(const float4*)(vp + 4);
      k[0] = a.x; k[1] = a.y; k[2] = a.z; k[3] = a.w; k[4] = a2.x; k[5] = a2.y; k[6] = a2.z; k[7] = a2.w;
      v[0] = c1.x; v[1] = c1.y; v[2] = c1.z; v[3] = c1.w; v[4] = c2.x; v[5] = c2.y; v[6] = c2.z; v[7] = c2.w;
    } else {
      const size_t row = M_P + b * 4 + (j - 128);
      unpack8(*(const uint4*)(z + row * ZLD + 2304 + kvh * 64 + c), k);
      unpack8(*(const uint4*)(z + row * ZLD + 2432 + kvh * 64 + c), v);
    }
#pragma unroll
    for (int i = 0; i < 8; ++i) { Kl[j * 65 + c + i] = k[i]; Vl[j * 65 + c + i] = v[i]; }
    if (j >= 4) {
      float* ok = p.out + O_SK + ((size_t)((l * 128 + b) * 128 + (j - 4)) * 2 + kvh) * 64 + c;
      float* ov = p.out + O_SV + ((size_t)((l * 128 + b) * 128 + (j - 4)) * 2 + kvh) * 64 + c;
      *(float4*)ok = make_float4(k[0], k[1], k[2], k[3]); *(float4*)(ok + 4) = make_float4(k[4], k[5], k[6], k[7]);
      *(float4*)ov = make_float4(v[0], v[1], v[2], v[3]); *(float4*)(ov + 4) = make_float4(v[4], v[5], v[6], v[7]);
    }
  }
  if (tid < 128) {
    const int row = tid >> 3, c = (tid & 7) * 8;
    const int hl = row >> 2, t = row & 3;
    float q[8];
    unpack8(*(const uint4*)(z + (size_t)(M_P + b * 4 + t) * ZLD + 1792 + (kvh * 4 + hl) * 64 + c), q);
#pragma unroll
    for (int i = 0; i < 8; ++i) Ql[row * 64 + c + i] = q[i];
  }
  __syncthreads();
  const int row = tid >> 5, jl = tid & 31;
  const int t = row & 3, hq = kvh * 4 + (row >> 2);
  float sc[5];
  float mx = -1e30f;
#pragma unroll
  for (int jj = 0; jj < 5; ++jj) {
    const int j = jl + 32 * jj;
    float s = -1e30f;
    if (j < 132 && j > t && j <= t + 128) {
      float a = 0.f;
#pragma unroll 8
      for (int d = 0; d < 64; ++d) a += Ql[row * 64 + d] * Kl[j * 65 + d];
      s = a * 0.125f;
    }
    sc[jj] = s; mx = fmaxf(mx, s);
    __builtin_amdgcn_sched_barrier(0);
  }
#pragma unroll
  for (int o = 16; o >= 1; o >>= 1) mx = fmaxf(mx, __shfl_xor(mx, o, 64));
  const float sink = p.in[20][l * 8 + hq];
  mx = fmaxf(mx, sink);
  float sum = 0.f;
#pragma unroll
  for (int jj = 0; jj < 5; ++jj) { sc[jj] = __expf(sc[jj] - mx); sum += sc[jj]; }
#pragma unroll
  for (int o = 16; o >= 1; o >>= 1) sum += __shfl_xor(sum, o, 64);
  const float rden = 1.f / (sum + __expf(sink - mx));
#pragma unroll
  for (int jj = 0; jj < 5; ++jj) { const int j = jl + 32 * jj; if (j < 136) Pl[row * 136 + j] = sc[jj] * rden; }
  __syncthreads();
  {
    const int d = jl * 2;
    float o0 = 0.f, o1 = 0.f;
#pragma unroll 4
    for (int j = 0; j < 132; ++j) { const float pr = Pl[row * 136 + j]; o0 += pr * Vl[j * 65 + d]; o1 += pr * Vl[j * 65 + d + 1]; }
    if (!dry) *(unsigned*)(z + (size_t)(M_P + b * 4 + t) * ZLD + 1792 + hq * 64 + d) = pack2(o0, o1);
  }
}

__device__ __forceinline__ void phase_convgelu(const Params& p, int l, bool dry = false) {
  u16* cu = (u16*)(p.ws + WS_CU);
  const float* cw = p.in[26] + (size_t)l * 3 * 2816;
  const float* cb = p.in[27] + (size_t)l * 2816;
  for (int it = blockIdx.x; it < 2112; it += gridDim.x) {
    const int tid = opq(threadIdx.x);
    if (tid >= 352) continue;
    const int j0 = tid * 8;
    float w0[8], w1[8], w2[8], bb[8];
#pragma unroll
    for (int i = 0; i < 8; ++i) { w0[i] = cw[j0 + i]; w1[i] = cw[2816 + j0 + i]; w2[i] = cw[5632 + j0 + i]; bb[i] = cb[j0 + i]; }
    float c1[8], c2[8];
    for (int rr = 0; rr < 8; ++rr) {
      const int row = it * 8 + rr;
      const bool prompt = row < M_P;
      int b, t;
      if (prompt) { b = row >> 13; t = row & 8191; } else { b = (row - M_P) >> 2; t = (row - M_P) & 3; }
      if (t == 0) {
        if (prompt) {
#pragma unroll
          for (int i = 0; i < 8; ++i) { c1[i] = 0.f; c2[i] = 0.f; }
        } else {
          const float* st = p.in[6] + (size_t)((l * 128 + b) * 2) * 2816 + j0;
#pragma unroll
          for (int i = 0; i < 8; ++i) { c2[i] = st[i]; c1[i] = st[2816 + i]; }
        }
      } else if (rr == 0) {
        unpack8(*(const uint4*)(cu + (size_t)(row - 1) * 5632 + j0), c1);
        if (t >= 2) unpack8(*(const uint4*)(cu + (size_t)(row - 2) * 5632 + j0), c2);
        else {
#pragma unroll
          for (int i = 0; i < 8; ++i) c2[i] = 0.f;
        }
      }
      float c0[8], up[8], a[8];
      unpack8(*(const uint4*)(cu + (size_t)row * 5632 + j0), c0);
      unpack8(*(const uint4*)(cu + (size_t)row * 5632 + 2816 + j0), up);
#pragma unroll
      for (int i = 0; i < 8; ++i) {
        const float cv = bb[i] + w0[i] * c2[i] + w1[i] * c1[i] + w2[i] * c0[i];
        a[i] = gelu_fast(cv) * up[i];
      }
      if (!dry) *(uint4*)(cu + (size_t)row * 5632 + 2816 + j0) = pack8(a);
      if (prompt && t >= 8190) {
        float* o = p.out + O_PCONV + (size_t)((l * 2 + b) * 2 + (t - 8190)) * 2816 + j0;
        *(float4*)o = make_float4(c0[0], c0[1], c0[2], c0[3]); *(float4*)(o + 4) = make_float4(c0[4], c0[5], c0[6], c0[7]);
      } else if (!prompt && t >= 2) {
        float* o = p.out + O_SCONV + (size_t)((l * 128 + b) * 2 + (t - 2)) * 2816 + j0;
        *(float4*)o = make_float4(c0[0], c0[1], c0[2], c0[3]); *(float4*)(o + 4) = make_float4(c0[4], c0[5], c0[6], c0[7]);
      }
#pragma unroll
      for (int i = 0; i < 8; ++i) { c2[i] = c1[i]; c1[i] = c0[i]; }
    }
  }
}

__device__ __forceinline__ void phase_final(const Params& p) {
  float* X = p.out;
  const float* g = p.in[29];
  for (int it = blockIdx.x; it < 2112; it += gridDim.x) {
    const int tid = opq(threadIdx.x);
    const int lane = tid & 63;
    const int row = it * 8 + (tid >> 6);
    float4 v[4];
    float ss = 0.f;
#pragma unroll
    for (int i = 0; i < 4; ++i) {
      v[i] = *(const float4*)(X + (size_t)row * 1024 + i * 256 + lane * 4);
      if (gridDim.x == 256 && row >= M_P) {
        const u16* partb = (const u16*)(p.ws + WS_DP) + (size_t)(row - M_P) * 1024 + i * 256 + lane * 4;
        for (int k = 0; k < 11; ++k) { const uint2 q = *(const uint2*)(partb + (size_t)k * 512 * 1024);
          v[i].x += __uint_as_float(q.x << 16); v[i].y += __uint_as_float(q.x & 0xFFFF0000u); v[i].z += __uint_as_float(q.y << 16); v[i].w += __uint_as_float(q.y & 0xFFFF0000u); }
      }
      ss += v[i].x * v[i].x + v[i].y * v[i].y + v[i].z * v[i].z + v[i].w * v[i].w;
    }
    ss = wave_sum(ss);
    const float rs = rsqrtf(ss * (1.f / 1024.f) + 1e-6f);
#pragma unroll
    for (int i = 0; i < 4; ++i) {
      const float4 gg = *(const float4*)(g + i * 256 + lane * 4);
      *(float4*)(X + (size_t)row * 1024 + i * 256 + lane * 4) =
          make_float4(v[i].x * rs * gg.x, v[i].y * rs * gg.y, v[i].z * rs * gg.z, v[i].w * rs * gg.w);
    }
  }
}

#define XB_TMO      128
#define XB_XCNT(j)  (256  + 64 * (j))
#define XB_XSUB(j)  (1280 + 64 * (j))
#define XB_XGEN(j)  (2304 + 64 * (j))
#define XB_TOP      3328
#define XB_TOPGEN   3392
#define XCD_BAR_WORDS 3456
#define XB_SPIN_CAP (1u << 18)
#define LAS __attribute__((address_space(3)))

__device__ __forceinline__ unsigned xb_ld(unsigned* p)              { return __hip_atomic_load(p, __ATOMIC_RELAXED, __HIP_MEMORY_SCOPE_AGENT); }
__device__ __forceinline__ unsigned xb_add(unsigned* p, unsigned v) { return __hip_atomic_fetch_add(p, v, __ATOMIC_RELAXED, __HIP_MEMORY_SCOPE_AGENT); }
__device__ __forceinline__ unsigned xb_xcc_id() { return (unsigned)__builtin_amdgcn_s_getreg((3 << 11) | 20) & 0xFu; }
#define XB_SPIN(cond, bar) do { unsigned _sp = 0; while (cond) { __builtin_amdgcn_s_sleep(1); \
    if ((++_sp & 255u) == 0u) { if (xb_ld(&(bar)[XB_TMO])) break; if (_sp > XB_SPIN_CAP) { atomicAdd(&(bar)[XB_TMO], 1u); break; } } } } while (0)

struct XcdBarrier {
    unsigned* bar; unsigned x;
    volatile LAS unsigned* st;
};

__device__ __forceinline__ XcdBarrier xcd_barrier_post(unsigned* bar, volatile LAS unsigned* st) {
    XcdBarrier b; b.bar = bar; b.x = xb_xcc_id(); b.st = st;
    if (threadIdx.x == 0) (void)xb_add(&bar[XB_XCNT(b.x)], 1u);
    return b;
}
__device__ __forceinline__ void xcd_barrier_complete(unsigned* bar, unsigned x, unsigned& nloc, unsigned& nx) {
    const unsigned G = gridDim.x * gridDim.y * gridDim.z;
    unsigned sum, cnt, mine, sp = 0u;
    for (;;) {
        sum = 0u; cnt = 0u; mine = 0u;
#pragma unroll
        for (unsigned j = 0; j < 16; ++j) { const unsigned c = xb_ld(&bar[XB_XCNT(j)]); sum += c; cnt += (c > 0u) ? 1u : 0u; mine = (j == x) ? c : mine; }
        if (sum == G) break;
        __builtin_amdgcn_s_sleep(1);
        if ((++sp & 255u) == 0u) { if (xb_ld(&bar[XB_TMO])) break; if (sp > XB_SPIN_CAP) { atomicAdd(&bar[XB_TMO], 1u); break; } }
    }
    nloc = mine > 0u ? mine : 1u; nx = cnt > 0u ? cnt : 1u;
}

__device__ __forceinline__ void xcd_barrier(const XcdBarrier& b) {
    asm volatile("s_waitcnt vmcnt(0)" ::: "memory");
    __syncthreads();
    if (threadIdx.x == 0) {
        unsigned* bar = b.bar;
        __builtin_amdgcn_s_waitcnt(0);
        unsigned nloc = b.st[0], nx = b.st[1];
        if (nloc == 0u) { xcd_barrier_complete(bar, b.x, nloc, nx); b.st[0] = nloc; b.st[1] = nx; }
        const unsigned old = xb_add(&bar[XB_XSUB(b.x)], 1u);
        const unsigned gen = old / nloc;
        if (old + 1u == (gen + 1u) * nloc) {
            __builtin_amdgcn_fence(__ATOMIC_RELEASE, "agent");
            asm volatile("s_waitcnt vmcnt(0)" ::: "memory");
            const unsigned og = xb_add(&bar[XB_TOP], 1u);
            const unsigned tg = og / nx;
            if (og + 1u == (tg + 1u) * nx) xb_add(&bar[XB_TOPGEN], 1u);
            else XB_SPIN(xb_ld(&bar[XB_TOPGEN]) == tg, bar);
            __builtin_amdgcn_fence(__ATOMIC_ACQUIRE, "agent");
            xb_add(&bar[XB_XGEN(b.x)], 1u);
            asm volatile("s_waitcnt vmcnt(0)" ::: "memory");
        } else {
            XB_SPIN(xb_ld(&bar[XB_XGEN(b.x)]) == gen, bar);
            __builtin_amdgcn_fence(__ATOMIC_ACQUIRE, "agent");
            asm volatile("s_waitcnt vmcnt(0)" ::: "memory");
        }
    }
    __syncthreads();
}

#define WS_BAR 256000000ull
#if COOP
#ifndef SYNC_RPT
#define SYNC_RPT 1
#endif
#define PH_SYNC(idx) do { if ((idx) + 1 < ph_hi && (idx) >= ph_lo) { for (int sr_ = 0; sr_ < SYNC_RPT; ++sr_) xcd_barrier(xb); } } while (0)
#else
#define PH_SYNC(idx) do { } while (0)
#endif
#define PH_ON(idx, bit) (((KMASK >> (bit)) & 1) && ph_lo <= (idx) && (idx) < ph_hi)

__device__ __forceinline__ Params load_params() {
  auto kp0 = __builtin_amdgcn_kernarg_segment_ptr();
  asm volatile("" : "+s"(kp0));
  auto kq = (const __constant__ unsigned long long*)kp0;
  Params p;
#pragma unroll
  for (int i = 0; i < 30; ++i) p.in[i] = (const float*)kq[i];
  p.out = (float*)kq[30];
  p.ws = (unsigned char*)kq[31];
  p.ph_lo = 0; p.ph_hi = 0;
  return p;
}

template <int KMASK, int l>
__device__ __forceinline__ void layer_phases(int ph_lo, int ph_hi, unsigned char* lds_raw, const XcdBarrier& xb) {
  float* ldsf = (float*)lds_raw;
  u16* ldsh = (u16*)lds_raw;
  const int base = l * 12;
  if (PH_ON(base + 0, 0)) { const Params p = load_params(); RPT(0) phase_prep(p, l, 0, ldsf); }
  PH_SYNC(base + 0);
  if (PH_ON(base + 1, 1)) {
    const Params p = load_params();
    EpiInproj E; E.z = (u16*)(p.ws + WS_Z); E.out = p.out; E.l = l;
    RPT(1) run_gemm(lds_raw, (const u16*)(p.ws + WS_H), 1024, (const u16*)(p.ws + WS_WT) + WT_IN, 2560, 1024, E);
  }
  PH_SYNC(base + 1);
  if (PH_ON(base + 2, 2)) {
    const Params p = load_params();
    for (int it = blockIdx.x; it < 264; it += gridDim.x) rope_item(p, l, it, false);
    if (blockIdx.x < 64) rwkv_item(p, l, 2048 + blockIdx.x, ldsf, false);
    {
      const Params p2 = load_params();
      int i0, n;
      if (gridDim.x == 256) { if (blockIdx.x < 64) { i0 = blockIdx.x * 5; n = 5; } else { i0 = 320 + (blockIdx.x - 64) * 9; n = 9; } }
      else { i0 = 0; n = 0; }
      RPT(2) {
        if (gridDim.x == 256) { for (int i = 0; i < n; ++i) rwkv_item2(p2, l, i0 + i, ldsf); }
        else { for (int it = blockIdx.x; it < 2048; it += gridDim.x) rwkv_item2(p2, l, it, ldsf); }
      }
    }
  }
  PH_SYNC(base + 2);
  if (PH_ON(base + 3, 3)) {
    const Params p = load_params();
    if (blockIdx.x < 16) { RPT(3) rwkv_scan(p, l, blockIdx.x, ldsf, DRY(3)); }
    else {
      RPT(15) for (int it = blockIdx.x - 16; it < 512; it += gridDim.x - 16) {
        if (it < 256) attn_prompt(p, l, it, ldsh, DRY(15)); else attn_sample(p, l, it - 256, ldsf, DRY(15));
      }
      if (gridDim.x == 256 && blockIdx.x < 32) {
        EpiSig Es; Es.sr = (u16*)(p.ws + WS_SG); Es.sa = (u16*)(p.ws + WS_SG) + (size_t)512 * 1024;
        run_gemm_ex(lds_raw, (const u16*)(p.ws + WS_H) + (size_t)M_P * 1024, 1024, (const u16*)(p.ws + WS_WT) + WT_G, 1024, 512, 2048, 1024, 16,
                    (int)blockIdx.x - 16, Es);
      }
    }
  }
  PH_SYNC(base + 3);
  if (PH_ON(base + 4, 4)) {
    const Params p = load_params();
    RPT(4) for (int it = blockIdx.x * 4; it < 2048; it += gridDim.x * 4) rwkv_out4(p, l, it, ldsf);
  }
  PH_SYNC(base + 4);
  if (PH_ON(base + 5, 5)) {
    const Params p = load_params();
    EpiStoreBf16 E1; E1.O = (u16*)(p.ws + WS_T1); E1.ldc = 1024; E1.rowoff = 0;
    EpiStoreBf16 E2; E2.O = (u16*)(p.ws + WS_T2); E2.ldc = 1024; E2.rowoff = 0;
    const u16* zA = (const u16*)(p.ws + WS_Z);
    const u16* Wr = (const u16*)(p.ws + WS_WT) + WT_BRA;
    const u16* Wa = (const u16*)(p.ws + WS_WT) + WT_BRB;
    RPT(5) {
      if (gridDim.x == 256) {
        run_gemm_ex(lds_raw, zA, ZLD, Wr, 512, M_P, 1024, 512, 256, (int)blockIdx.x, E1);
        run_gemm_ex(lds_raw, zA + 1792, ZLD, Wa, 512, M_P, 1024, 512, 256, (int)blockIdx.x, E2);
        const int wh = (blockIdx.x >> 3) & 1, ks = (blockIdx.x >> 4) & 1;
        EpiStoreBf16 E3; E3.ldc = 1024; E3.rowoff = 0; E3.O = (u16*)(p.ws + WS_SG) + (size_t)(2 + wh * 2 + ks) * 512 * 1024;
        run_gemm_ex(lds_raw, zA + (size_t)M_P * ZLD + (wh ? 1792 : 0) + ks * 256, ZLD, (wh ? Wa : Wr) + ks * 256, 512, 512, 1024, 256, 8,
                    (blockIdx.x < 32) ? (int)(blockIdx.x & 7) : -1, E3);

      } else {
        run_gemm(lds_raw, zA, ZLD, Wr, 1024, 512, E1);
        run_gemm(lds_raw, zA + 1792, ZLD, Wa, 1024, 512, E2);
      }
    }
  }
  PH_SYNC(base + 5);
  if (PH_ON(base + 6, 6)) {
    const Params p = load_params();
    EpiMerge E; E.t1 = (const u16*)(p.ws + WS_T1); E.t2 = (const u16*)(p.ws + WS_T2); E.mg = (u16*)(p.ws + WS_MG);
    RPT(6) {
      if (gridDim.x == 256) {
        run_gemm_ex(lds_raw, (const u16*)(p.ws + WS_H), 1024, (const u16*)(p.ws + WS_WT) + WT_G, 1024, M_P, 2048, 1024, 256, (int)blockIdx.x, E);
        const int gid = blockIdx.x * NT + opq(threadIdx.x);
        if (gid < 65536) {
          const int r_ = gid >> 7, c_ = (gid & 127) * 8;
          const size_t offs = (size_t)r_ * 1024 + c_, offm = (size_t)(M_P + r_) * 1024 + c_;
          float a[8], b[8], gr[8], ga[8], o[8];
          {
            const u16* pb = (const u16*)(p.ws + WS_SG) + (size_t)2 * 512 * 1024 + offs;
            float a1[8], b1[8];
            unpack8(*(const uint4*)pb, a); unpack8(*(const uint4*)(pb + (size_t)512 * 1024), a1);
            unpack8(*(const uint4*)(pb + (size_t)2 * 512 * 1024), b); unpack8(*(const uint4*)(pb + (size_t)3 * 512 * 1024), b1);
#pragma unroll
            for (int i = 0; i < 8; ++i) { a[i] += a1[i]; b[i] += b1[i]; }
          }
          unpack8(*(const uint4*)((const u16*)(p.ws + WS_SG) + offs), gr);
          unpack8(*(const uint4*)((const u16*)(p.ws + WS_SG) + (size_t)512 * 1024 + offs), ga);
#pragma unroll
          for (int i = 0; i < 8; ++i) o[i] = gr[i] * a[i] + ga[i] * b[i];
          *(uint4*)(E.mg + offm) = pack8(o);
        }
      } else {
        run_gemm(lds_raw, (const u16*)(p.ws + WS_H), 1024, (const u16*)(p.ws + WS_WT) + WT_G, 2048, 1024, E);
      }
    }
  }
  PH_SYNC(base + 6);
  if (PH_ON(base + 7, 7)) {
    const Params p = load_params();
    EpiResid E; E.X = p.out;
    RPT(7) {
      E.dry = DRY(7); E.X = p.out; E.pbf = nullptr;
      if (gridDim.x == 256) {
        E.atomic = false; E.rowoff = 0;
        run_gemm_ex(lds_raw, (const u16*)(p.ws + WS_MG), 1024, (const u16*)(p.ws + WS_WT) + WT_OUT, 1024, M_P, 1024, 1024, 256, (int)blockIdx.x, E);
        const int ks = blockIdx.x >> 3;
        E.atomic = true; E.rowoff = 0; E.X = (float*)(p.ws + WS_T1) + (size_t)ks * 512 * 1024;
        run_gemm_ex(lds_raw, (const u16*)(p.ws + WS_MG) + (size_t)M_P * 1024 + ks * 256, 1024, (const u16*)(p.ws + WS_WT) + WT_OUT + ks * 256, 1024,
                    512, 1024, 256, 8, (blockIdx.x < 32) ? (int)(blockIdx.x & 7) : -1, E);
      } else {
        E.atomic = false; E.rowoff = 0;
        run_gemm(lds_raw, (const u16*)(p.ws + WS_MG), 1024, (const u16*)(p.ws + WS_WT) + WT_OUT, 1024, 1024, E);
      }
    }
  }
  PH_SYNC(base + 7);
  if (PH_ON(base + 8, 8)) { const Params p = load_params(); RPT(8) phase_prep(p, l, 1, ldsf); }
  PH_SYNC(base + 8);
  if (PH_ON(base + 9, 9)) {
    const Params p = load_params();
    EpiFfnIn E; E.cu = (u16*)(p.ws + WS_CU);
    RPT(9) run_gemm(lds_raw, (const u16*)(p.ws + WS_H), 1024, (const u16*)(p.ws + WS_WTF) + WT_FIN, 5632, 1024, E);
  }
  PH_SYNC(base + 9);
  if (PH_ON(base + 10, 10)) { const Params p = load_params(); RPT(10) phase_convgelu(p, l, DRY(10)); }
  PH_SYNC(base + 10);
  if (PH_ON(base + 11, 11)) {
    const Params p = load_params();
    EpiResid E; E.X = p.out;
    RPT(11) {
      E.dry = DRY(11); E.X = p.out; E.pbf = nullptr;
      const u16* Aa = (const u16*)(p.ws + WS_CU) + 2816;
      const u16* Bd = (const u16*)(p.ws + WS_WTF) + WT_FDN;
      if (gridDim.x == 256) {
        E.atomic = false; E.rowoff = 0;
        run_gemm_ex(lds_raw, Aa, 5632, Bd, 2816, M_P, 1024, 2816, 256, (int)blockIdx.x, E);
        const int ks = blockIdx.x >> 3;
        E.atomic = true; E.rowoff = 0; E.X = nullptr; E.pbf = (u16*)(p.ws + WS_DP) + (size_t)ks * 512 * 1024;
        run_gemm_ex(lds_raw, Aa + (size_t)M_P * 5632 + ks * 256, 5632, Bd + ks * 256, 2816, 512, 1024, 256, 8, (blockIdx.x < 88) ? (int)(blockIdx.x & 7) : -1, E);
      } else {
        E.atomic = false; E.rowoff = 0;
        run_gemm(lds_raw, Aa, 5632, Bd, 1024, 2816, E);
      }
    }
  }
  PH_SYNC(base + 11);
}

template <int KMASK>
__global__ void __launch_bounds__(NT) fwd_kernel(Params pin) {
  extern __shared__ __attribute__((aligned(16))) unsigned char lds_raw[];
  const int ph_lo = pin.ph_lo, ph_hi = pin.ph_hi;
  XcdBarrier xb;
  {
    volatile LAS unsigned* st = (volatile LAS unsigned*)(lds_raw + (LDS_BYTES - 16));
    if (threadIdx.x < 2) st[threadIdx.x] = 0u;
    __syncthreads();
    xb = xcd_barrier_post((unsigned*)(pin.ws + WS_BAR), st);
  }
  if (ph_hi > 100000) cg::this_grid().sync();
  layer_phases<KMASK, 0>(ph_lo, ph_hi, lds_raw, xb);
  layer_phases<KMASK, 1>(ph_lo, ph_hi, lds_raw, xb);
  if (PH_ON(NPH - 1, 12)) { const Params p = load_params(); phase_final(p); }
}

extern "C" void kernel_launch(void* const* d_in, const int* in_sizes, int n_in, void* d_out, int out_size, void* d_ws,
                              size_t ws_size, hipStream_t stream) {
  static int grid = 0;
  if (grid == 0) {
    int dev = 0, cus = 0;
    (void)hipGetDevice(&dev);
    (void)hipDeviceGetAttribute(&cus, hipDeviceAttributeMultiprocessorCount, dev);
    grid = cus > 0 ? cus : 256;
    (void)hipFuncSetAttribute((const void*)fwd_kernel<PHMASK>, hipFuncAttributeMaxDynamicSharedMemorySize, LDS_BYTES);
    (void)hipGetLastError();
  }
  Params p{};
  for (int i = 0; i < 30; ++i) p.in[i] = (const float*)d_in[i];
  p.out = (float*)d_out;
  p.ws = (unsigned char*)d_ws;
#if COOP
  (void)hipMemsetAsync((unsigned char*)d_ws + WS_BAR, 0, XCD_BAR_WORDS * 4, stream);
  p.ph_lo = 0; p.ph_hi = NPH;
  void* args[] = {&p};
  hipError_t e = hipLaunchCooperativeKernel((const void*)fwd_kernel<PHMASK>, dim3(grid), dim3(NT), args, LDS_BYTES, stream);
  if (e != hipSuccess) fprintf(stderr, "cooperative launch failed: %s (grid %d)\n", hipGetErrorString(e), grid);
#else
  for (int ph = 0; ph < NPH; ++ph) {
    p.ph_lo = ph; p.ph_hi = ph + 1;
    hipLaunchKernelGGL(fwd_kernel<PHMASK>, dim3(grid), dim3(NT), LDS_BYTES, stream, p);
  }
#endif
}
```

```cpp
#include <hip/hip_runtime.h>
#include <hip/hip_bf16.h>
#include <hip/hip_cooperative_groups.h>
#include <cstdio>
namespace cg = cooperative_groups;

typedef __attribute__((ext_vector_type(8))) short bf16x8;
typedef __attribute__((ext_vector_type(16))) float f32x16;
typedef unsigned short u16;

#ifndef PHMASK
#define PHMASK 0x1FFF
#endif
#ifndef T3
#define T3 7
#endif
#ifndef P2SEL
#define P2SEL 7
#endif
#ifndef RPT_MASK
#define RPT_MASK 0
#endif
#ifndef RPT_N
#define RPT_N 1
#endif
#define RPT(bit) for (int rp_ = 0; rp_ < (((RPT_MASK >> (bit)) & 1) ? 1 + RPT_N : 1); ++rp_)
#define RPT_CNT(bit) (((RPT_MASK >> (bit)) & 1) ? 1 + RPT_N : 1)
#define DRY(bit) (opq(rp_) + 1 < RPT_CNT(bit))
#ifndef R1P
#define R1P 1
#endif
#ifndef COOP
#define COOP 1
#endif

#define NT 512
#define M_TOT 16896
#define M_P 16384
#define ZLD 2560
#define NPH 25

#define WS_WT   0ull
#define WS_H    13631488ull
#define WS_Z    48234496ull
#define WS_R    134742016ull
#define WS_PP   (WS_R)
#define WS_GC   (WS_R + 16777216ull)
#define WS_Q    (WS_R + 17301504ull)
#define WS_W2   (WS_R + 50855936ull)
#define WS_YL   (WS_R + 67633152ull)
#define WS_BO   (WS_R + 84410368ull)
#define WS_GA   (WS_R + 101187584ull)
#define WS_T1   (WS_R)
#define WS_T2   (WS_R + 34603008ull)
#define WS_MG   (WS_R + 69206016ull)
#define WS_SG   256100096ull
#define WS_WTF  (WS_Z)
#define WS_CU   (WS_Z + 17301504ull)
#define WS_LW  267634432ull
#define WS_DP  256100096ull
#define WT_IN  0
#define WT_G   2621440
#define WT_BRA 4718592
#define WT_BRB 5242880
#define WT_OUT 5767168
#define WT_FIN 0
#define WT_FDN 5767168
#define O_PSHIFT 17301504
#define O_PWKV   17308672
#define O_PK     17439744
#define O_PV     17505280
#define O_PCONV  17570816
#define O_SSHIFT 17593344
#define O_SWKV   18052096
#define O_SK     26440704
#define O_SV     30635008
#define O_SCONV  34829312

#define LDS_BYTES 151552

struct Params {
  const float* in[30];
  float* out;
  unsigned char* ws;
  int ph_lo, ph_hi;
};

typedef float f2v_ __attribute__((ext_vector_type(2)));
typedef __bf16 b2v_ __attribute__((ext_vector_type(2)));
__device__ __forceinline__ unsigned pack2(float a, float b) { f2v_ v = {a, b}; b2v_ r = __builtin_convertvector(v, b2v_); return __builtin_bit_cast(unsigned, r); }
__device__ __forceinline__ u16 f2bf(float f) { return (u16)(pack2(f, f) & 0xFFFFu); }
__device__ __forceinline__ float bf2f(u16 h) { return __uint_as_float(((unsigned)h) << 16); }
__device__ __forceinline__ float sigm(float x) { return __builtin_amdgcn_rcpf(1.f + __expf(-x)); }
__device__ __forceinline__ void unpack8(uint4 u, float* o) {
  o[0] = __uint_as_float(u.x << 16); o[1] = __uint_as_float(u.x & 0xFFFF0000u);
  o[2] = __uint_as_float(u.y << 16); o[3] = __uint_as_float(u.y & 0xFFFF0000u);
  o[4] = __uint_as_float(u.z << 16); o[5] = __uint_as_float(u.z & 0xFFFF0000u);
  o[6] = __uint_as_float(u.w << 16); o[7] = __uint_as_float(u.w & 0xFFFF0000u);
}
__device__ __forceinline__ uint4 pack8(const float* f) {
  uint4 u; u.x = pack2(f[0], f[1]); u.y = pack2(f[2], f[3]); u.z = pack2(f[4], f[5]); u.w = pack2(f[6], f[7]); return u;
}
__device__ __forceinline__ float gelu_fast(float v) {
  const float av = fabsf(v), d = av * 0.2316418882f + 1.0f;
  const float t = __builtin_amdgcn_rcpf(d);
  float q = t * 0.5307027145f + (-0.7265760135f); q = q * t + 0.7107068705f; q = q * t + (-0.142248368f); q = q * t + 0.127414796f; q = q * t;
  const float e = __builtin_amdgcn_exp2f((v * v) * (-0.72134752044f));
  const float m = v * (q * e);
  return v < 0.f ? m : v - m;
}
__device__ __forceinline__ int opq(int x) { asm volatile("" : "+v"(x)); return x; }
__device__ __forceinline__ float wave_sum(float x) {
#pragma unroll
  for (int o = 32; o >= 1; o >>= 1) x += __shfl_xor(x, o, 64);
  return x;
}

namespace pg8 {
#define PG8_LAS __attribute__((address_space(3)))
typedef unsigned short bf16_t;
typedef short bf16x8 __attribute__((ext_vector_type(8)));
typedef float f32x4 __attribute__((ext_vector_type(4)));
typedef unsigned u32x4 __attribute__((ext_vector_type(4)));
constexpr int BM = 256, BK = 64, HALF = 128, HTB = HALF * BK * 2  , STAGE_BYTES = 8 * HTB, NXCD = 8, WGM = 8;
__host__ __device__ __forceinline__ int lds_byte(int r, int c) { const int st = (r >> 4) * 2 + (c >> 5), rr = r & 15, cc = c & 31, ob = rr * 64 + cc * 2; return st * 1024 + (ob ^ (((ob >> 9) & 1) << 5)); }
__host__ __device__ __forceinline__ void stage_rc(int b, int& R, int& C) { const int st = b / 1024, sb = b % 1024, swz = sb ^ (((sb >> 9) & 1) << 5); R = (st >> 1) * 16 + swz / 64; C = (st & 1) * 32 + (swz % 64) / 2; }
__host__ __device__ __forceinline__ int perm32(int rho) { const int n = rho >> 4, i = rho & 15; return 8 * (i >> 2) + 4 * n + (i & 3); }
struct Unit { int pm, pn; };
struct Gemm { const bf16_t* A; const bf16_t* Bt; int M, N, K, lda, ldb; };
struct StaticOrder {
    int nM, nN, nwg, G, c;
    __host__ __device__ void init(int M, int N, int G_, int c_) { nM = M / BM; nN = N / BM; nwg = nM * nN; G = G_; c = c_; }
    __host__ __device__ bool next(int i, Unit& u) const {
        const long L = (long)i * G + c; if (L >= nwg) return false;
        int wgid = (int)L; { const int q = nwg / NXCD, r = nwg % NXCD, xcd = wgid % NXCD, off = wgid / NXCD; wgid = (xcd < r ? xcd * (q + 1) : r * (q + 1) + (xcd - r) * q) + off; }
        const int nig = WGM * nN, gid = wgid / nig, fm = gid * WGM, gsz = (nM - fm) < WGM ? (nM - fm) : WGM;
        u.pm = fm + ((wgid % nig) % gsz); u.pn = (wgid % nig) / gsz; return true;
    }
    __device__ __forceinline__ void a_ready(const Unit&) const {}
    __device__ __forceinline__ void done(const Unit&) const {}
};
__device__ __forceinline__ unsigned cvt_pk_bf16(float lo, float hi) { return ::pack2(lo, hi); }
template <class Epi, class Sched, bool STAMP = false>
__device__ __forceinline__ void gemm_phase(PG8_LAS unsigned char* lds, const Gemm g, const Sched& S, const Epi& E, unsigned long long* stamps) {
    const int tid = ::opq(threadIdx.x), wid = __builtin_amdgcn_readfirstlane(tid >> 6), lane = tid & 63, wr = wid >> 2, wc = wid & 3, fr = lane & 15, fq = lane >> 4;
    const int K = g.K, nt = K / BK;
    int ts_lo = 0, ts_hi = 0, nts = 0; const unsigned long long rt_entry = 0ull;
#define PG8_STAMP() do { if (STAMP && wid == 0 && nts < 64) { const unsigned long long _c = (unsigned long long)clock64(); \
        ts_lo = (lane == nts) ? (int)(unsigned)_c : ts_lo; ts_hi = (lane == nts) ? (int)(unsigned)(_c >> 32) : ts_hi; ++nts; } } while (0)
    PG8_STAMP();
    unsigned voffA[2], voffB[2];
#pragma unroll
    for (int i = 0; i < 2; ++i) { int R, C; stage_rc(tid * 16 + i * 8192, R, C); const int Rb = Epi::PERM ? ((R & ~31) + perm32(R & 31)) : R;
        voffA[i] = (unsigned)(R * g.lda + C) * 2u; voffB[i] = (unsigned)(Rb * g.ldb + C) * 2u; }
    const size_t kstep = (size_t)(BK * 2);
    const size_t hstep = (size_t)HALF * g.ldb * 2;
    const size_t tstep = 2 * hstep; const size_t hstepA = (size_t)HALF * g.lda * 2; const size_t tstepA = 2 * hstepA;
    const unsigned ldsw = (unsigned)wid * 1024u;
    const int aoff = lds_byte(wr * 64 + fr, fq * 8), boff = lds_byte(wc * 32 + fr, fq * 8);
#define PG8_SA(b, h) (((b) * 2 + (h)) * HTB)
#define PG8_SB(b, h) ((4 + (b) * 2 + (h)) * HTB)
#define PG8_STAGE(bufoff, gbase, voff) do { _Pragma("unroll") for (int _i = 0; _i < 2; ++_i) \
        __builtin_amdgcn_global_load_lds((const unsigned*)((const char*)(gbase) + (voff)[_i]), (PG8_LAS unsigned*)(lds + (bufoff) + ldsw + _i * 8192), 16, 0, 0); } while (0)
#define PG8_LDA(dst, b, h) do { _Pragma("unroll") for (int m = 0; m < 4; ++m) _Pragma("unroll") for (int k = 0; k < 2; ++k) dst[m][k] = *(const PG8_LAS bf16x8*)(lds + PG8_SA(b, h) + aoff + m * 2048 + k * 1024); } while (0)
#define PG8_LDB(dst, b, h) do { _Pragma("unroll") for (int n = 0; n < 2; ++n) _Pragma("unroll") for (int k = 0; k < 2; ++k) dst[n][k] = *(const PG8_LAS bf16x8*)(lds + PG8_SB(b, h) + boff + n * 2048 + k * 1024); } while (0)
#define PG8_MMA(ai, bj, At, Bt) do { __builtin_amdgcn_s_setprio(1); _Pragma("unroll") for (int m = 0; m < 4; ++m) _Pragma("unroll") for (int n = 0; n < 2; ++n) _Pragma("unroll") for (int k = 0; k < 2; ++k) \
        acc[ai][bj][m][n] = __builtin_amdgcn_mfma_f32_16x16x32_bf16(Bt[n][k], At[m][k], acc[ai][bj][m][n], 0, 0, 0); __builtin_amdgcn_s_setprio(0); } while (0)
#define PG8_WAIT_V(n) asm volatile("s_waitcnt vmcnt(" #n ")" ::: "memory")
#define PG8_WAIT_L(n) asm volatile("s_waitcnt lgkmcnt(" #n ")" ::: "memory")
#define PG8_BAR __builtin_amdgcn_s_barrier()
#define PG8_SCHED __builtin_amdgcn_sched_barrier(0)
    Unit cur, nxt; int ui = 0;
    if (!S.next(0, cur)) return;
    f32x4 acc[2][2][4][2];
#pragma unroll
    for (int a = 0; a < 2; ++a)
#pragma unroll
        for (int b = 0; b < 2; ++b)
#pragma unroll
            for (int m = 0; m < 4; ++m)
#pragma unroll
                for (int n = 0; n < 2; ++n) acc[a][b][m][n] = (f32x4){0.f, 0.f, 0.f, 0.f};
    bf16x8 At[4][2], B0[2][2], B1[2][2];
    const char* cA = (const char*)g.A + (size_t)cur.pm * tstepA; const char* cB = (const char*)g.Bt + (size_t)cur.pn * tstep;
    S.a_ready(cur);
    PG8_STAGE(PG8_SB(0, 0), cB, voffB); PG8_STAGE(PG8_SA(0, 0), cA, voffA); PG8_STAGE(PG8_SB(0, 1), cB + hstep, voffB); PG8_STAGE(PG8_SA(0, 1), cA + hstepA, voffA);
    if (wr == 1) PG8_BAR;
    PG8_WAIT_V(4); PG8_BAR;
    PG8_STAGE(PG8_SB(1, 0), cB + kstep, voffB); PG8_STAGE(PG8_SA(1, 0), cA + kstep, voffA); PG8_STAGE(PG8_SB(1, 1), cB + hstep + kstep, voffB);
    PG8_WAIT_V(6); PG8_BAR;
    PG8_STAMP();
    for (;;) {
        const bool has_next = S.next(ui + 1, nxt);
        const char* nA = has_next ? (const char*)g.A + (size_t)nxt.pm * tstepA : cA; const char* nB = has_next ? (const char*)g.Bt + (size_t)nxt.pn * tstep : cB;
        for (int t = 0; t < nt; t += 2) {
            const bool last = (t == nt - 2);
            const char* a1 = cA + (size_t)(t + 1) * kstep;
            const char* a2 = last ? nA : cA + (size_t)(t + 2) * kstep; const char* b2 = last ? nB : cB + (size_t)(t + 2) * kstep;
            const char* a3 = a2 + kstep; const char* b3 = b2 + kstep;
            if (last && has_next) S.a_ready(nxt);
            PG8_LDB(B0, 0, 0); PG8_SCHED; PG8_LDA(At, 0, 0); PG8_STAGE(PG8_SA(1, 1), a1 + hstepA, voffA);
            PG8_WAIT_L(8); PG8_BAR; PG8_WAIT_L(0); PG8_MMA(0, 0, At, B0); PG8_BAR; PG8_SCHED;
            PG8_LDB(B1, 0, 1); PG8_STAGE(PG8_SB(0, 0), b2, voffB);
            PG8_BAR; PG8_WAIT_L(0); PG8_MMA(0, 1, At, B1); PG8_BAR;
            PG8_LDA(At, 0, 1); PG8_STAGE(PG8_SA(0, 0), a2, voffA);
            PG8_BAR; PG8_WAIT_L(0); PG8_MMA(1, 0, At, B0); PG8_BAR; PG8_SCHED;
            PG8_STAGE(PG8_SB(0, 1), b2 + hstep, voffB);
            PG8_WAIT_V(6); PG8_BAR; PG8_MMA(1, 1, At, B1); PG8_BAR;
            PG8_LDB(B0, 1, 0); PG8_SCHED; PG8_LDA(At, 1, 0); PG8_STAGE(PG8_SA(0, 1), a2 + hstepA, voffA);
            PG8_WAIT_L(8); PG8_BAR; PG8_WAIT_L(0); PG8_MMA(0, 0, At, B0); PG8_BAR; PG8_SCHED;
            PG8_LDB(B1, 1, 1); PG8_STAGE(PG8_SB(1, 0), b3, voffB);
            PG8_BAR; PG8_WAIT_L(0); PG8_MMA(0, 1, At, B1); PG8_BAR;
            PG8_LDA(At, 1, 1); PG8_STAGE(PG8_SA(1, 0), a3, voffA);
            PG8_BAR; PG8_WAIT_L(0); PG8_MMA(1, 0, At, B0); PG8_BAR; PG8_SCHED;
            PG8_STAGE(PG8_SB(1, 1), b3 + hstep, voffB);
            PG8_WAIT_V(6); PG8_BAR; PG8_MMA(1, 1, At, B1); PG8_BAR;
        }
        PG8_STAMP();
        if constexpr (!Epi::AFTER_DRAIN) { E(acc, cur, wr, wc, fr, fq); S.done(cur); }
        PG8_STAMP();
        if (!has_next) break;
#pragma unroll
        for (int a = 0; a < 2; ++a)
#pragma unroll
            for (int b = 0; b < 2; ++b)
#pragma unroll
                for (int m = 0; m < 4; ++m)
#pragma unroll
                    for (int n = 0; n < 2; ++n) acc[a][b][m][n] = (f32x4){0.f, 0.f, 0.f, 0.f};
        cur = nxt; cA = nA; cB = nB; ++ui;
    }
    PG8_WAIT_V(0);
    if (wr == 0) PG8_BAR;
    PG8_BAR;
    if constexpr (Epi::AFTER_DRAIN) { E.fused(acc, cur, wr, wc, fr, fq, lds, wid, lane); S.done(cur); }
    PG8_STAMP();
    if (STAMP && wid == 0) { stamps[lane] = lane < nts ? (((unsigned long long)(unsigned)ts_hi << 32) | (unsigned)ts_lo) : 0ull;
        if (lane == 62) stamps[62] = rt_entry; if (lane == 63) stamps[63] = (unsigned long long)wall_clock64(); }
#undef PG8_STAMP
#undef PG8_SA
#undef PG8_SB
#undef PG8_STAGE
#undef PG8_LDA
#undef PG8_LDB
#undef PG8_MMA
#undef PG8_WAIT_V
#undef PG8_WAIT_L
#undef PG8_BAR
#undef PG8_SCHED
}
}
using pg8::f32x4;
#define ROWOFF(reg, h) (((reg) & 3) + 8 * ((reg) >> 2) + 4 * (h))

struct CDesc { const float* src; u16* dst; int K, N, k0, n0, sn0; };
__device__ __forceinline__ CDesc conv_desc(const Params& p, int l, int which, int t) {
  CDesc d;
  u16* WtA = (u16*)(p.ws + WS_WT);
  u16* WtF = (u16*)(p.ws + WS_WTF);
  if (which == 0) {
    if (t < 640) { const int tk = t / 40, tn = t % 40; d.src = p.in[8] + (size_t)l * 1024 * 4608; d.K = 1024; d.N = 4608; d.dst = WtA + WT_IN; d.k0 = tk * 64; d.n0 = tn * 64; d.sn0 = tn * 64; }
    else if ((t -= 640) < 512) {
      const int tk = t / 32, tn = t % 32; const int n0 = tn * 64;
      d.src = p.in[8] + (size_t)l * 1024 * 4608; d.K = 1024; d.N = 4608; d.dst = WtA + WT_G; d.k0 = tk * 64; d.n0 = n0;
      d.sn0 = 2560 + ((n0 >> 7) & 1) * 1024 + (n0 >> 8) * 128 + (n0 & 127);
    }
    else if ((t -= 512) < 128) { const int tk = t / 16, tn = t % 16; d.src = p.in[21] + (size_t)l * 512 * 1024; d.K = 512; d.N = 1024; d.dst = WtA + WT_BRA; d.k0 = tk * 64; d.n0 = tn * 64; d.sn0 = tn * 64; }
    else if ((t -= 128) < 128) { const int tk = t / 16, tn = t % 16; d.src = p.in[22] + (size_t)l * 512 * 1024; d.K = 512; d.N = 1024; d.dst = WtA + WT_BRB; d.k0 = tk * 64; d.n0 = tn * 64; d.sn0 = tn * 64; }
    else { t -= 128; const int tk = t / 16, tn = t % 16; d.src = p.in[23] + (size_t)l * 1024 * 1024; d.K = 1024; d.N = 1024; d.dst = WtA + WT_OUT; d.k0 = tk * 64; d.n0 = tn * 64; d.sn0 = tn * 64; }
  } else {
    if (t < 1408) {
      const int tk = t / 88, tn = t % 88; const int n0 = tn * 64;
      d.src = p.in[25] + (size_t)l * 1024 * 5632; d.K = 1024; d.N = 5632; d.dst = WtF + WT_FIN; d.k0 = tk * 64; d.n0 = n0;
      d.sn0 = ((n0 >> 7) & 1) * 2816 + (n0 >> 8) * 128 + (n0 & 127);
    } else { t -= 1408; const int tk = t / 16, tn = t % 16; d.src = p.in[28] + (size_t)l * 2816 * 1024; d.K = 2816; d.N = 1024; d.dst = WtF + WT_FDN; d.k0 = tk * 64; d.n0 = tn * 64; d.sn0 = tn * 64; }
  }
  return d;
}
__device__ __forceinline__ void conv_pair(const CDesc& A, const CDesc& B, float* lds) {
  const int tid = opq(threadIdx.x);
  const int k = tid >> 3, c = (tid & 7) * 8;
  const float* sa = A.src + (size_t)(A.k0 + k) * A.N + A.sn0 + c;
  const float* sb = B.src + (size_t)(B.k0 + k) * B.N + B.sn0 + c;
  const float4 a0 = *(const float4*)sa, a1 = *(const float4*)(sa + 4);
  const float4 b0 = *(const float4*)sb, b1 = *(const float4*)(sb + 4);
  __syncthreads();
  {
    float* d = lds + k * 65 + c;
    d[0] = a0.x; d[1] = a0.y; d[2] = a0.z; d[3] = a0.w; d[4] = a1.x; d[5] = a1.y; d[6] = a1.z; d[7] = a1.w;
    float* e = lds + 4160 + k * 65 + c;
    e[0] = b0.x; e[1] = b0.y; e[2] = b0.z; e[3] = b0.w; e[4] = b1.x; e[5] = b1.y; e[6] = b1.z; e[7] = b1.w;
  }
  __syncthreads();
  {
    const int n = tid >> 3, kk = (tid & 7) * 8;
    float f[8], g[8];
#pragma unroll
    for (int i = 0; i < 8; ++i) { f[i] = lds[(kk + i) * 65 + n]; g[i] = lds[4160 + (kk + i) * 65 + n]; }
    *(uint4*)(A.dst + (size_t)(A.n0 + n) * A.K + A.k0 + kk) = pack8(f);
    *(uint4*)(B.dst + (size_t)(B.n0 + n) * B.K + B.k0 + kk) = pack8(g);
  }
}

__device__ __forceinline__ void phase_prep(const Params& p, int l, int which, float* ldsf) {
  u16* H = (u16*)(p.ws + WS_H);
  float* X = p.out;
  const int nconv = which == 0 ? (640 + 512 + 128 + 128 + 256) : (1408 + 704);
  const float* gw = (which == 0 ? p.in[7] : p.in[24]) + l * 1024;
  for (int it = blockIdx.x * 2; it < nconv; it += gridDim.x * 2) {
    const CDesc A = conv_desc(p, l, which, it), B = conv_desc(p, l, which, it + 1);
    conv_pair(A, B, ldsf);
  }
  if (which == 0) {
    const int hh = (int)gridDim.x - 1 - (int)blockIdx.x;
    if (hh < 8) {
      const int tid = opq(threadIdx.x);
      u16* dst = (u16*)(p.ws + WS_LW) + (size_t)hh * 17920;
      const float* w2 = p.in[11] + (size_t)l * 64 * 512 + hh * 64;
      const float* a2 = p.in[13] + (size_t)l * 64 * 512 + hh * 64;
      const float* g2 = p.in[14] + (size_t)l * 128 * 512 + hh * 64;
      for (int e = tid; e < 4096; e += NT) {
        const int i = e >> 6, j = e & 63;
        dst[j * 72 + i] = f2bf(w2[(size_t)i * 512 + j]);
        dst[4608 + j * 72 + i] = f2bf(a2[(size_t)i * 512 + j]);
      }
      for (int e = tid; e < 8192; e += NT) {
        const int i = e >> 6, j = e & 63;
        dst[9216 + j * 136 + i] = f2bf(g2[(size_t)i * 512 + j]);
      }
    }
  }
  const bool first = (which == 0 && l == 0);
  for (int it = blockIdx.x; it < 1056; it += gridDim.x) {
    const int tid = opq(threadIdx.x);
    const int lane = tid & 63;
    const int rowa = it * 16 + (tid >> 6);
    float4 v[2][4];
#pragma unroll
    for (int rr = 0; rr < 2; ++rr) {
      const int row = rowa + rr * 8;
      const float* src;
      if (first) src = (row < M_P) ? p.in[0] + (size_t)row * 1024 : p.in[1] + (size_t)(row - M_P) * 1024;
      else src = X + (size_t)row * 1024;
#pragma unroll
      for (int i = 0; i < 4; ++i) v[rr][i] = *(const float4*)(src + i * 256 + lane * 4);
    }
#pragma unroll
    for (int rr = 0; rr < 2; ++rr) {
      const int row = rowa + rr * 8;
      const int nsl = (gridDim.x == 256 && row >= M_P && !first) ? (which == 1 ? 4 : 11) : 0;
      const float* part = (const float*)(p.ws + WS_T1) + (size_t)(row - M_P) * 1024;
      const u16* partb = (const u16*)(p.ws + WS_DP) + (size_t)(row - M_P) * 1024;
      float ss = 0.f;
#pragma unroll
      for (int i = 0; i < 4; ++i) {
        for (int k = 0; k < nsl; ++k) {
          if (which == 1) {
            const float4 q = *(const float4*)(part + (size_t)k * 512 * 1024 + i * 256 + lane * 4);
            v[rr][i].x += q.x; v[rr][i].y += q.y; v[rr][i].z += q.z; v[rr][i].w += q.w;
          } else {
            const uint2 q = *(const uint2*)(partb + (size_t)k * 512 * 1024 + i * 256 + lane * 4);
            v[rr][i].x += __uint_as_float(q.x << 16); v[rr][i].y += __uint_as_float(q.x & 0xFFFF0000u); v[rr][i].z += __uint_as_float(q.y << 16); v[rr][i].w += __uint_as_float(q.y & 0xFFFF0000u);
          }
        }
        ss += v[rr][i].x * v[rr][i].x + v[rr][i].y * v[rr][i].y + v[rr][i].z * v[rr][i].z + v[rr][i].w * v[rr][i].w;
        if (first || nsl) *(float4*)(X + (size_t)row * 1024 + i * 256 + lane * 4) = v[rr][i];
      }
      ss = wave_sum(ss);
      const float rs = rsqrtf(ss * (1.f / 1024.f) + 1e-6f);
#pragma unroll
      for (int i = 0; i < 4; ++i) {
        const float4 g = *(const float4*)(gw + i * 256 + lane * 4);
        uint2 o; o.x = pack2(v[rr][i].x * rs * g.x, v[rr][i].y * rs * g.y); o.y = pack2(v[rr][i].z * rs * g.z, v[rr][i].w * rs * g.w);
        *(uint2*)(H + (size_t)row * 1024 + i * 256 + lane * 4) = o;
      }
    }
  }
}

struct EpiInproj {
  static constexpr bool PERM = true, AFTER_DRAIN = false;
  u16* z; float* out; int l;
  __device__ __forceinline__ void operator()(const f32x4 (&acc)[2][2][4][2], const pg8::Unit& u, int wr, int wc, int fr, int fq) const {
    const int row0 = u.pm * 256 + wr * 64 + fr, col0 = u.pn * 256 + wc * 32 + 8 * fq;
#pragma unroll
    for (int ai = 0; ai < 2; ++ai)
#pragma unroll
      for (int m = 0; m < 4; ++m) {
        const int row = row0 + ai * 128 + m * 16;
        u16* rowp = z + (size_t)row * ZLD + col0;
#pragma unroll
        for (int bj = 0; bj < 2; ++bj) {
          const f32x4 v0 = acc[ai][bj][m][0], v1 = acc[ai][bj][m][1];
          pg8::u32x4 w; w.x = pg8::cvt_pk_bf16(v0[0], v0[1]); w.y = pg8::cvt_pk_bf16(v0[2], v0[3]); w.z = pg8::cvt_pk_bf16(v1[0], v1[1]); w.w = pg8::cvt_pk_bf16(v1[2], v1[3]);
          *(pg8::u32x4*)(rowp + bj * 128) = w;
        }
        const bool prompt = row < M_P;
        int b, t;
        if (prompt) { b = row >> 13; t = row & 8191; } else { b = (row - M_P) >> 2; t = (row - M_P) & 3; }
        if (u.pn < 7) {
          if ((prompt && t == 8191) || (!prompt && t == 3)) {
            float* o = out + (prompt ? O_PSHIFT + (size_t)(l * 2 + b) * 1792 : O_SSHIFT + (size_t)(l * 128 + b) * 1792) + col0;
#pragma unroll
            for (int bj = 0; bj < 2; ++bj) { *(f32x4*)(o + bj * 128) = acc[ai][bj][m][0]; *(f32x4*)(o + bj * 128 + 4) = acc[ai][bj][m][1]; }
          }
        } else if (u.pn == 9 && prompt && t >= 8064) {
          const int c = wc * 32 + 8 * fq;
          float* o = out + O_PV + ((size_t)((l * 2 + b) * 128 + (t - 8064)) * 2 + (c >> 6)) * 64 + (c & 63);
          *(f32x4*)o = acc[ai][1][m][0]; *(f32x4*)(o + 4) = acc[ai][1][m][1];
        }
      }
  }
};
struct EpiStoreBf16 {
  static constexpr bool PERM = true, AFTER_DRAIN = false;
  u16* O; int ldc; int rowoff;
  __device__ __forceinline__ void operator()(const f32x4 (&acc)[2][2][4][2], const pg8::Unit& u, int wr, int wc, int fr, int fq) const {
    const int row0 = rowoff + u.pm * 256 + wr * 64 + fr, col0 = u.pn * 256 + wc * 32 + 8 * fq;
#pragma unroll
    for (int ai = 0; ai < 2; ++ai)
#pragma unroll
      for (int m = 0; m < 4; ++m) {
        u16* rowp = O + (size_t)(row0 + ai * 128 + m * 16) * ldc + col0;
#pragma unroll
        for (int bj = 0; bj < 2; ++bj) {
          const f32x4 v0 = acc[ai][bj][m][0], v1 = acc[ai][bj][m][1];
          pg8::u32x4 w; w.x = pg8::cvt_pk_bf16(v0[0], v0[1]); w.y = pg8::cvt_pk_bf16(v0[2], v0[3]); w.z = pg8::cvt_pk_bf16(v1[0], v1[1]); w.w = pg8::cvt_pk_bf16(v1[2], v1[3]);
          *(pg8::u32x4*)(rowp + bj * 128) = w;
        }
      }
  }
};
struct EpiFfnIn {
  static constexpr bool PERM = true, AFTER_DRAIN = false;
  u16* cu;
  __device__ __forceinline__ void operator()(const f32x4 (&acc)[2][2][4][2], const pg8::Unit& u, int wr, int wc, int fr, int fq) const {
    const int row0 = u.pm * 256 + wr * 64 + fr, col0 = u.pn * 128 + wc * 32 + 8 * fq;
#pragma unroll
    for (int ai = 0; ai < 2; ++ai)
#pragma unroll
      for (int m = 0; m < 4; ++m) {
        u16* rowp = cu + (size_t)(row0 + ai * 128 + m * 16) * 5632 + col0;
#pragma unroll
        for (int bj = 0; bj < 2; ++bj) {
          const f32x4 v0 = acc[ai][bj][m][0], v1 = acc[ai][bj][m][1];
          pg8::u32x4 w; w.x = pg8::cvt_pk_bf16(v0[0], v0[1]); w.y = pg8::cvt_pk_bf16(v0[2], v0[3]); w.z = pg8::cvt_pk_bf16(v1[0], v1[1]); w.w = pg8::cvt_pk_bf16(v1[2], v1[3]);
          *(pg8::u32x4*)(rowp + bj * 2816) = w;
        }
      }
  }
};
struct EpiSig {
  static constexpr bool PERM = true, AFTER_DRAIN = false;
  u16* sr; u16* sa;
  __device__ __forceinline__ void operator()(const f32x4 (&acc)[2][2][4][2], const pg8::Unit& u, int wr, int wc, int fr, int fq) const {
    const int row0 = u.pm * 256 + wr * 64 + fr, col0 = u.pn * 128 + wc * 32 + 8 * fq;
#pragma unroll
    for (int ai = 0; ai < 2; ++ai)
#pragma unroll
      for (int m = 0; m < 4; ++m) {
        const size_t off = (size_t)(row0 + ai * 128 + m * 16) * 1024 + col0;
#pragma unroll
        for (int bj = 0; bj < 2; ++bj) {
          float o[8];
#pragma unroll
          for (int n = 0; n < 2; ++n)
#pragma unroll
            for (int j = 0; j < 4; ++j) o[n * 4 + j] = sigm(acc[ai][bj][m][n][j]);
          *(uint4*)((bj ? sa : sr) + off) = pack8(o);
        }
      }
  }
};
struct EpiMerge {
  static constexpr bool PERM = true, AFTER_DRAIN = false;
  const u16* t1; const u16* t2; u16* mg;
  __device__ __forceinline__ void operator()(const f32x4 (&acc)[2][2][4][2], const pg8::Unit& u, int wr, int wc, int fr, int fq) const {
    const int row0 = u.pm * 256 + wr * 64 + fr, col0 = u.pn * 128 + wc * 32 + 8 * fq;
#pragma unroll
    for (int ai = 0; ai < 2; ++ai)
#pragma unroll
      for (int m = 0; m < 4; ++m) {
        const size_t off = (size_t)(row0 + ai * 128 + m * 16) * 1024 + col0;
        float a[8], b[8], o[8];
        unpack8(*(const uint4*)(t1 + off), a);
        unpack8(*(const uint4*)(t2 + off), b);
#pragma unroll
        for (int n = 0; n < 2; ++n)
#pragma unroll
          for (int j = 0; j < 4; ++j)
            o[n * 4 + j] = sigm(acc[ai][0][m][n][j]) * a[n * 4 + j] + sigm(acc[ai][1][m][n][j]) * b[n * 4 + j];
        *(uint4*)(mg + off) = pack8(o);
        asm volatile("" ::: "memory");
      }
  }
};
struct EpiResid {
  static constexpr bool PERM = false, AFTER_DRAIN = false;
  float* X; bool dry; bool atomic; int rowoff; u16* pbf;
  __device__ __forceinline__ void operator()(const f32x4 (&acc)[2][2][4][2], const pg8::Unit& u, int wr, int wc, int fr, int fq) const {
    const int row0 = rowoff + u.pm * 256 + wr * 64 + fr, col0 = u.pn * 256 + wc * 32 + 4 * fq;
#pragma unroll
    for (int ai = 0; ai < 2; ++ai)
#pragma unroll
      for (int m = 0; m < 4; ++m) {
        float* rowp = X + (size_t)(row0 + ai * 128 + m * 16) * 1024 + col0;
#pragma unroll
        for (int bj = 0; bj < 2; ++bj)
#pragma unroll
          for (int n = 0; n < 2; ++n) {
            f32x4* q = (f32x4*)(rowp + bj * 128 + n * 16);
            if (atomic) {
              if (pbf) {
                uint2 o; o.x = pack2(acc[ai][bj][m][n][0], acc[ai][bj][m][n][1]); o.y = pack2(acc[ai][bj][m][n][2], acc[ai][bj][m][n][3]);
                *(uint2*)(pbf + ((float*)q - X)) = o;
              } else *q = acc[ai][bj][m][n];
            } else { const f32x4 v_ = *q + acc[ai][bj][m][n]; if (!dry) *q = v_; }
          }
        asm volatile("" ::: "memory");
      }
  }
};
template <class Epi>
__device__ __forceinline__ void run_gemm_ex(unsigned char* lds_raw, const u16* A, int lda, const u16* Bt, int ldb, int M, int N, int K, int G, int c, const Epi& E) {
  if (c < 0) return;
  pg8::Gemm g; g.A = A; g.Bt = Bt; g.M = M; g.N = N; g.K = K; g.lda = lda; g.ldb = ldb;
  pg8::StaticOrder S; S.init(M, N, G, c);
  __syncthreads();
  pg8::gemm_phase<Epi, pg8::StaticOrder, false>((PG8_LAS unsigned char*)lds_raw, g, S, E, nullptr);
  __syncthreads();
}
template <class Epi>
__device__ __forceinline__ void run_gemm(unsigned char* lds_raw, const u16* A, int lda, const u16* Bt, int N, int K, const Epi& E) {
  pg8::Gemm g; g.A = A; g.Bt = Bt; g.M = M_TOT; g.N = N; g.K = K; g.lda = lda; g.ldb = K;
  pg8::StaticOrder S; S.init(M_TOT, N, gridDim.x, blockIdx.x);
  __syncthreads();
  pg8::gemm_phase<Epi, pg8::StaticOrder, false>((PG8_LAS unsigned char*)lds_raw, g, S, E, nullptr);
  __syncthreads();
}

__device__ __forceinline__ void rope_item(const Params& p, int l, int item, bool dry = false) {
  const int tid = opq(threadIdx.x);
  u16* z = (u16*)(p.ws + WS_Z);
  const int row = item * 64 + (tid >> 3);
  const int d0 = (tid & 7) * 4;
  const bool prompt = row < M_P;
  int b, t, pos;
  if (prompt) { b = row >> 13; t = row & 8191; pos = t; } else { b = (row - M_P) >> 2; t = (row - M_P) & 3; pos = 16384 + t; }
  float cs[4], sn[4];
#pragma unroll
  for (int i = 0; i < 4; ++i) {
    const float inv = __expf(-(float)(d0 + i) * (9.210340371976184f / 32.f));
    const float angf = (float)pos * inv;
    double a = (double)angf;
    a -= 6.283185307179586 * rint(a * 0.15915494309189535);
    const float af = (float)a;
    sn[i] = __sinf(af); cs[i] = __cosf(af);
  }
#pragma unroll 2
  for (int hh = 0; hh < 10; ++hh) {
    u16* q = z + (size_t)row * ZLD + 1792 + hh * 64 + d0;
    const uint2 lo = *(const uint2*)q, hi = *(const uint2*)(q + 32);
    float x1[4] = {__uint_as_float(lo.x << 16), __uint_as_float(lo.x & 0xFFFF0000u), __uint_as_float(lo.y << 16), __uint_as_float(lo.y & 0xFFFF0000u)};
    float x2[4] = {__uint_as_float(hi.x << 16), __uint_as_float(hi.x & 0xFFFF0000u), __uint_as_float(hi.y << 16), __uint_as_float(hi.y & 0xFFFF0000u)};
    float y1[4], y2[4];
#pragma unroll
    for (int i = 0; i < 4; ++i) { y1[i] = x1[i] * cs[i] - x2[i] * sn[i]; y2[i] = x2[i] * cs[i] + x1[i] * sn[i]; }
    uint2 o1, o2;
    o1.x = pack2(y1[0], y1[1]); o1.y = pack2(y1[2], y1[3]); o2.x = pack2(y2[0], y2[1]); o2.y = pack2(y2[2], y2[3]);
    if (!dry) { *(uint2*)q = o1; *(uint2*)(q + 32) = o2; }
    if (hh >= 8 && prompt && t >= 8064) {
      float* o = p.out + O_PK + ((size_t)((l * 2 + b) * 128 + (t - 8064)) * 2 + (hh - 8)) * 64 + d0;
      *(float4*)o = make_float4(y1[0], y1[1], y1[2], y1[3]);
      *(float4*)(o + 32) = make_float4(y2[0], y2[1], y2[2], y2[3]);
    }
  }
}

#define SL(i) (ldsf + (i) * 4160)
__device__ __forceinline__ void rwkv_item(const Params& p, int l, int item, float* ldsf, bool dry = false) {
  const int tid = opq(threadIdx.x), lane = tid & 63, wave = tid >> 6;
  const bool sample = item >= 2048;
  int h, cidx, rowbase;
  if (!sample) { h = item & 7; cidx = item >> 3; rowbase = cidx * 64; }
  else { int s = item - 2048; h = s & 7; cidx = s >> 3; rowbase = M_P + cidx * 64; }
  const int cc = cidx & 127;
  const u16* z = (const u16*)(p.ws + WS_Z);
  u16* zw_ = (u16*)(p.ws + WS_Z);
  const float* mu = p.in[9] + l * 1792;
  float* wbuf = SL(7);
  float* gc = ldsf + 9 * 4160;
  float* bd = ldsf + 9 * 4160 + 64;
  __syncthreads();
  {
    const int t = tid >> 3, c8 = (tid & 7) * 8;
    const int m = rowbase + t;
    const int zcs[7] = {h * 64, 512 + h * 64, 1024 + h * 64, 1536, 1600, 1664, 1728};
#pragma unroll
    for (int gi = 0; gi < 7; ++gi) {
      const int zc = zcs[gi] + c8;
      float cur[8], prv[8];
      unpack8(*(const uint4*)(z + (size_t)m * ZLD + zc), cur);
      bool zero = false, fromstate = false;
      if (!sample) zero = (t == 0 && cc == 0);
      else fromstate = ((t & 3) == 0);
      if (zero) {
#pragma unroll
        for (int i = 0; i < 8; ++i) prv[i] = 0.f;
      } else if (fromstate) {
        const int b = (m - M_P) >> 2;
        const float* sp = p.in[2] + (size_t)(l * 128 + b) * 1792 + zc;
        float4 a = *(const float4*)sp, bb = *(const float4*)(sp + 4);
        prv[0] = a.x; prv[1] = a.y; prv[2] = a.z; prv[3] = a.w; prv[4] = bb.x; prv[5] = bb.y; prv[6] = bb.z; prv[7] = bb.w;
      } else {
        unpack8(*(const uint4*)(z + (size_t)(m - 1) * ZLD + zc), prv);
      }
      float* d = SL(gi) + t * 65 + c8;
#pragma unroll
      for (int i = 0; i < 8; ++i) {
        float v = cur[i] + mu[zc + i] * (prv[i] - cur[i]);
        if (gi == 3) v = tanhf(v);
        if (gi >= 5) v = sigm(v);
        d[i] = v;
      }
    }
  }
  const int lt = tid & 63, jg = tid >> 6;
  auto load_w = [&](const float* W, int nrows) {
    for (int e = tid; e < nrows * 8; e += NT) {
      const int i = e >> 3, c = (e & 7) * 8;
      const float* s = W + (size_t)i * 512 + h * 64 + c;
      *(float4*)(wbuf + i * 64 + c) = *(const float4*)s;
      *(float4*)(wbuf + i * 64 + c + 4) = *(const float4*)(s + 4);
    }
  };
  auto lora = [&](const float* xa, const float* xb, int n, float* acc) {
#pragma unroll 2
    for (int i = 0; i < n; ++i) {
      const float x = (i < 64) ? xa[lt * 65 + i] : xb[lt * 65 + i - 64];
      const float4 w0 = *(const float4*)(wbuf + i * 64 + jg * 8);
      const float4 w1 = *(const float4*)(wbuf + i * 64 + jg * 8 + 4);
      acc[0] += x * w0.x; acc[1] += x * w0.y; acc[2] += x * w0.z; acc[3] += x * w0.w;
      acc[4] += x * w1.x; acc[5] += x * w1.y; acc[6] += x * w1.z; acc[7] += x * w1.w;
    }
  };
  float res[8];
  load_w(p.in[11] + (size_t)l * 64 * 512, 64);
  __syncthreads();
#pragma unroll
  for (int i = 0; i < 8; ++i) res[i] = p.in[10][l * 512 + h * 64 + jg * 8 + i];
  lora(SL(3), SL(3), 64, res);
  __syncthreads();
#pragma unroll
  for (int i = 0; i < 8; ++i) {
    const float x = -res[i];
    const float sp = (x > 20.f) ? x : log1pf(__expf(x));
    SL(3)[lt * 65 + jg * 8 + i] = -__expf(-sp - 0.5f);
  }
  load_w(p.in[13] + (size_t)l * 64 * 512, 64);
  __syncthreads();
#pragma unroll
  for (int i = 0; i < 8; ++i) res[i] = p.in[12][l * 512 + h * 64 + jg * 8 + i];
  lora(SL(4), SL(4), 64, res);
  __syncthreads();
#pragma unroll
  for (int i = 0; i < 8; ++i) SL(4)[lt * 65 + jg * 8 + i] = sigm(res[i]);
  load_w(p.in[14] + (size_t)l * 128 * 512, 128);
  __syncthreads();
#pragma unroll
  for (int i = 0; i < 8; ++i) res[i] = 0.f;
  lora(SL(5), SL(6), 128, res);
  __syncthreads();
  if (!sample) {
    u16* ga = (u16*)(p.ws + WS_GA) + (size_t)item * 4096;
    *(uint4*)(ga + lt * 64 + jg * 8) = pack8(res);
    if (tid < 64) {
      float c = 0.f;
      for (int t = 0; t < 64; ++t) { c += SL(3)[t * 65 + tid]; SL(5)[t * 65 + tid] = c; }
      gc[tid] = __expf(c);
    }
  } else {
#pragma unroll
    for (int i = 0; i < 8; ++i) SL(6)[lt * 65 + jg * 8 + i] = res[i];
  }
  __syncthreads();
  {
    const int t = tid >> 3, j0 = (tid & 7) * 8;
    const float* kkw = p.in[15] + l * 512 + h * 64;
    const float* kaw = p.in[16] + l * 512 + h * 64;
    const float* rkw = p.in[17] + l * 512 + h * 64;
    float kr[8], av[8], rv[8], kkv[8], kf[8];
    float nrm = 0.f, bdot = 0.f;
#pragma unroll
    for (int i = 0; i < 8; ++i) {
      const int j = j0 + i;
      kr[i] = SL(1)[t * 65 + j]; av[i] = SL(4)[t * 65 + j]; rv[i] = SL(0)[t * 65 + j];
      kkv[i] = kr[i] * kkw[j];
      nrm += kkv[i] * kkv[i];
      kf[i] = kr[i] * (1.f + (av[i] - 1.f) * kaw[j]);
      bdot += rv[i] * kf[i] * rkw[j];
    }
    nrm += __shfl_xor(nrm, 1, 64); nrm += __shfl_xor(nrm, 2, 64); nrm += __shfl_xor(nrm, 4, 64);
    bdot += __shfl_xor(bdot, 1, 64); bdot += __shfl_xor(bdot, 2, 64); bdot += __shfl_xor(bdot, 4, 64);
    const float rn = 1.f / fmaxf(sqrtf(nrm), 1e-12f);
    if (!sample) {
      float bo[8];
#pragma unroll
      for (int i = 0; i < 8; ++i) {
        const int j = j0 + i;
        const float cum = SL(5)[t * 65 + j], dl = SL(3)[t * 65 + j];
        const float eg = __expf(cum), egi = __expf(-cum), egp = __expf(cum - dl);
        const float kk = kkv[i] * rn;
        SL(0)[t * 65 + j] = rv[i] * eg;
        SL(1)[t * 65 + j] = kf[i] * egi;
        SL(3)[t * 65 + j] = kk * av[i] * egi;
        SL(4)[t * 65 + j] = kk * egp;
        bo[i] = bdot * SL(2)[t * 65 + j];
      }
      u16* bop = (u16*)(p.ws + WS_BO) + (size_t)item * 4096;
      *(uint4*)(bop + t * 64 + j0) = pack8(bo);
    } else {
#pragma unroll
      for (int i = 0; i < 8; ++i) {
        const int j = j0 + i;
        const float kk = kkv[i] * rn;
        const float dl = SL(3)[t * 65 + j];
        SL(1)[t * 65 + j] = kf[i];
        SL(3)[t * 65 + j] = __expf(dl);
        SL(4)[t * 65 + j] = kk;
        SL(5)[t * 65 + j] = kk * av[i];
      }
      if ((tid & 7) == 0) bd[t] = bdot;
    }
  }
  __syncthreads();
  if (sample) {
    const float lng = p.in[18][l * 512 + h * 64 + lane], lnb = p.in[19][l * 512 + h * 64 + lane];
    for (int round = 0; round < 2; ++round) {
      const int seq = wave + 8 * round;
      const int b = cidx * 16 + seq;
      float S[64];
      const float* sp = p.in[3] + ((size_t)((l * 128 + b) * 8 + h) * 64 + lane) * 64;
#pragma unroll
      for (int k = 0; k < 64; k += 4) { float4 v = *(const float4*)(sp + k); S[k] = v.x; S[k + 1] = v.y; S[k + 2] = v.z; S[k + 3] = v.w; }
      for (int tt = 0; tt < 4; ++tt) {
        const int t = seq * 4 + tt;
        float sk = 0.f;
#pragma unroll
        for (int kc = 0; kc < 64; kc += 8) {
#pragma unroll
          for (int k = kc; k < kc + 8; ++k) sk += S[k] * SL(4)[t * 65 + k];
          __builtin_amdgcn_sched_barrier(0);
        }
        const float vt = SL(2)[t * 65 + lane];
        float y = 0.f;
#pragma unroll
        for (int kc = 0; kc < 64; kc += 8) {
#pragma unroll
          for (int k = kc; k < kc + 8; ++k) {
            S[k] = S[k] * SL(3)[t * 65 + k] - sk * SL(5)[t * 65 + k] + vt * SL(1)[t * 65 + k];
            y += S[k] * SL(0)[t * 65 + k];
          }
          __builtin_amdgcn_sched_barrier(0);
        }
        const float mean = wave_sum(y) * (1.f / 64.f);
        const float d = y - mean;
        const float var = wave_sum(d * d) * (1.f / 64.f);
        const float yn = d * rsqrtf(var + 64e-5f) * lng + lnb;
        const float o = (yn + bd[t] * vt) * SL(6)[t * 65 + lane];
        if (!dry) zw_[(size_t)(M_P + b * 4 + tt) * ZLD + h * 64 + lane] = f2bf(o);
      }
      float* op = p.out + O_SWKV + ((size_t)((l * 128 + b) * 8 + h) * 64 + lane) * 64;
#pragma unroll
      for (int k = 0; k < 64; k += 4) *(float4*)(op + k) = make_float4(S[k], S[k + 1], S[k + 2], S[k + 3]);
    }
    return;
  }
  {
    const int i = lane, tg = wave;
    float ab[8], ak[8], akr[8], abr[8];
#pragma unroll
    for (int q = 0; q < 8; ++q) { ab[q] = 0.f; ak[q] = 0.f; akr[q] = 0.f; abr[q] = 0.f; }
#pragma unroll 2
    for (int k = 0; k < 64; ++k) {
      const float xb = SL(3)[i * 65 + k], xk = SL(1)[i * 65 + k];
#pragma unroll
      for (int q = 0; q < 8; ++q) {
        const int t = tg * 8 + q;
        const float yk = SL(4)[t * 65 + k], yr = SL(0)[t * 65 + k];
        ab[q] += xb * yk; ak[q] += xk * yk; akr[q] += xk * yr; abr[q] += xb * yr;
      }
    }
    __syncthreads();
#pragma unroll
    for (int q = 0; q < 8; ++q) {
      const int t = tg * 8 + q;
      SL(6)[i * 65 + t] = (i < t) ? ab[q] : 0.f;
      SL(7)[i * 65 + t] = (i < t) ? ak[q] : 0.f;
      SL(8)[i * 65 + t] = (i <= t) ? akr[q] : 0.f;
      SL(5)[i * 65 + t] = (i <= t) ? abr[q] : 0.f;
    }
  }
  __syncthreads();
  {
    const int t = tid >> 3, j0 = (tid & 7) * 8;
#pragma unroll
    for (int i = 0; i < 8; ++i) { const float g = gc[j0 + i]; SL(3)[t * 65 + j0 + i] *= g; SL(1)[t * 65 + j0 + i] *= g; }
  }
  __syncthreads();
  if (tid < 128) {
    float* X_ = (tid < 64) ? SL(5) : SL(3);
    const int col = tid & 63;
    for (int i = 62; i >= 0; --i) {
      float a = X_[i * 65 + col];
#pragma unroll 4
      for (int t = i + 1; t < 64; ++t) a -= SL(6)[i * 65 + t] * X_[t * 65 + col];
      X_[i * 65 + col] = a;
    }
  }
  __syncthreads();
  {
    const int c = tid & 127, ig = tid >> 7;
    const int which = c >> 6, cq = c & 63;
    const float* N_ = which ? SL(3) : SL(5);
    float a[16];
#pragma unroll
    for (int q = 0; q < 16; ++q) a[q] = 0.f;
#pragma unroll 2
    for (int t = 0; t < 64; ++t) {
      const float n = N_[t * 65 + cq];
#pragma unroll
      for (int q = 0; q < 16; ++q) a[q] += SL(7)[(ig * 16 + q) * 65 + t] * n;
    }
    float* T_ = which ? SL(1) : SL(8);
#pragma unroll
    for (int q = 0; q < 16; ++q) T_[(ig * 16 + q) * 65 + cq] -= a[q];
  }
  __syncthreads();
  {
    const int x = lane, yg = wave;
    float w2[8], pp[8], yl[8], qq[8];
#pragma unroll
    for (int q = 0; q < 8; ++q) { w2[q] = 0.f; pp[q] = 0.f; yl[q] = 0.f; qq[q] = 0.f; }
#pragma unroll 2
    for (int j = 0; j < 64; ++j) {
      const float l5 = SL(5)[j * 65 + x], l4 = SL(4)[j * 65 + x], l8 = SL(8)[j * 65 + x], l2 = SL(2)[j * 65 + x];
#pragma unroll
      for (int q = 0; q < 8; ++q) {
        const int y = yg * 8 + q;
        w2[q] += l5 * SL(4)[j * 65 + y];
        pp[q] += l4 * SL(3)[j * 65 + y];
        yl[q] += l8 * SL(2)[j * 65 + y];
        qq[q] += l2 * SL(1)[j * 65 + y];
      }
    }
    float o1[8];
#pragma unroll
    for (int q = 0; q < 8; ++q) {
      const int y = yg * 8 + q;
      o1[q] = SL(0)[x * 65 + y] - w2[q];
    }
    u16* Pf = (u16*)(p.ws + WS_PP) + (size_t)item * 4096;
    float* Qf = (float*)(p.ws + WS_Q) + (size_t)item * 4096;
    if (tid < 64) ((float*)(p.ws + WS_GC))[(size_t)item * 64 + tid] = gc[tid];
    {
      const int s_ = x >> 4, kk = x & 15, hh = (kk >> 2) & 1, jj = ((kk >> 3) << 2) | (kk & 3);
#pragma unroll
      for (int q = 0; q < 8; ++q) {
        const int y = yg * 8 + q;
        Pf[(((y >> 5) * 4 + s_) * 64 + (y & 31) + 32 * hh) * 8 + jj] = f2bf(-pp[q]);
        const int k2 = y & 31, reg = ((k2 >> 3) << 2) | (k2 & 3), h2 = (k2 >> 2) & 1;
        Qf[(((x >> 5) * 2 + (y >> 5)) * 16 + reg) * 64 + (x & 31) + 32 * h2] = qq[q];
      }
    }
    u16* W2p = (u16*)(p.ws + WS_W2) + (size_t)item * 4096 + x * 64 + yg * 8;
    u16* YLp = (u16*)(p.ws + WS_YL) + (size_t)item * 4096 + x * 64 + yg * 8;
    *(uint4*)W2p = pack8(o1);
    *(uint4*)YLp = pack8(yl);
  }
}

template <bool SWA = false, bool SWB = false>
__device__ __forceinline__ void mm_tile(const u16* Aop, int lda, const u16* Bop, int ldb, int mt, int nt, int r, int h, int ksteps, f32x16& acc) {
  const int ra = mt * 32 + r, rb = nt * 32 + r;
  const u16* ap = Aop + ra * lda;
  const u16* bp = Bop + rb * ldb;
  const int swa = SWA ? ((ra >> 3) & 7) : 0, swb = SWB ? ((rb >> 3) & 7) : 0;
#pragma unroll 4
  for (int s = 0; s < ksteps; ++s) {
    const bf16x8 a = *(const bf16x8*)(ap + (((2 * s + h) ^ swa) << 3));
    const bf16x8 b = *(const bf16x8*)(bp + (((2 * s + h) ^ swb) << 3));
    acc = __builtin_amdgcn_mfma_f32_32x32x16_bf16(a, b, acc, 0, 0, 0);
  }
}
#define SWZ(row, col) ((row) * 72 + (((((col) >> 3) ^ (((row) >> 3) & 7)) << 3) | ((col) & 7)))
__device__ __forceinline__ void store_T(u16* T, int ldt, int mt, int nt, int r, int h, const f32x16& acc) {
#pragma unroll
  for (int g = 0; g < 4; ++g) {
    uint2 o; o.x = pack2(acc[4 * g], acc[4 * g + 1]); o.y = pack2(acc[4 * g + 2], acc[4 * g + 3]);
    *(uint2*)(T + (nt * 32 + r) * ldt + mt * 32 + 8 * g + 4 * h) = o;
  }
}
__device__ __forceinline__ void tri16(const float* Ab, float* Xc) {
  float a0 = Xc[0];
  float a1 = Xc[65];
  float a2 = Xc[130];
  float a3 = Xc[195];
  float a4 = Xc[260];
  float a5 = Xc[325];
  float a6 = Xc[390];
  float a7 = Xc[455];
  float a8 = Xc[520];
  float a9 = Xc[585];
  float a10 = Xc[650];
  float a11 = Xc[715];
  float a12 = Xc[780];
  float a13 = Xc[845];
  float a14 = Xc[910];
  float a15 = Xc[975];
  const float4 c14_12 = *(const float4*)(Ab + 964);
  const float4 c13_12 = *(const float4*)(Ab + 896);
  const float4 c12_12 = *(const float4*)(Ab + 828);
  const float4 c11_12 = *(const float4*)(Ab + 760);
  a14 -= c14_12.w * a15;
  const float4 c10_8 = *(const float4*)(Ab + 688);
  const float4 c10_12 = *(const float4*)(Ab + 692);
  a13 -= c13_12.z * a14;
  a13 -= c13_12.w * a15;
  const float4 c9_8 = *(const float4*)(Ab + 620);
  const float4 c9_12 = *(const float4*)(Ab + 624);
  a12 -= c12_12.y * a13;
  a12 -= c12_12.z * a14;
  a12 -= c12_12.w * a15;
  const float4 c8_8 = *(const float4*)(Ab + 552);
  const float4 c8_12 = *(const float4*)(Ab + 556);
  a11 -= c11_12.x * a12;
  a11 -= c11_12.y * a13;
  a11 -= c11_12.z * a14;
  a11 -= c11_12.w * a15;
  const float4 c7_8 = *(const float4*)(Ab + 484);
  const float4 c7_12 = *(const float4*)(Ab + 488);
  a10 -= c10_8.w * a11;
  a10 -= c10_12.x * a12;
  a10 -= c10_12.y * a13;
  a10 -= c10_12.z * a14;
  a10 -= c10_12.w * a15;
  const float4 c6_4 = *(const float4*)(Ab + 412);
  const float4 c6_8 = *(const float4*)(Ab + 416);
  const float4 c6_12 = *(const float4*)(Ab + 420);
  a9 -= c9_8.z * a10;
  a9 -= c9_8.w * a11;
  a9 -= c9_12.x * a12;
  a9 -= c9_12.y * a13;
  a9 -= c9_12.z * a14;
  a9 -= c9_12.w * a15;
  const float4 c5_4 = *(const float4*)(Ab + 344);
  const float4 c5_8 = *(const float4*)(Ab + 348);
  const float4 c5_12 = *(const float4*)(Ab + 352);
  a8 -= c8_8.y * a9;
  a8 -= c8_8.z * a10;
  a8 -= c8_8.w * a11;
  a8 -= c8_12.x * a12;
  a8 -= c8_12.y * a13;
  a8 -= c8_12.z * a14;
  a8 -= c8_12.w * a15;
  const float4 c4_4 = *(const float4*)(Ab + 276);
  const float4 c4_8 = *(const float4*)(Ab + 280);
  const float4 c4_12 = *(const float4*)(Ab + 284);
  a7 -= c7_8.x * a8;
  a7 -= c7_8.y * a9;
  a7 -= c7_8.z * a10;
  a7 -= c7_8.w * a11;
  a7 -= c7_12.x * a12;
  a7 -= c7_12.y * a13;
  a7 -= c7_12.z * a14;
  a7 -= c7_12.w * a15;
  const float4 c3_4 = *(const float4*)(Ab + 208);
  const float4 c3_8 = *(const float4*)(Ab + 212);
  const float4 c3_12 = *(const float4*)(Ab + 216);
  a6 -= c6_4.w * a7;
  a6 -= c6_8.x * a8;
  a6 -= c6_8.y * a9;
  a6 -= c6_8.z * a10;
  a6 -= c6_8.w * a11;
  a6 -= c6_12.x * a12;
  a6 -= c6_12.y * a13;
  a6 -= c6_12.z * a14;
  a6 -= c6_12.w * a15;
  const float4 c2_0 = *(const float4*)(Ab + 136);
  const float4 c2_4 = *(const float4*)(Ab + 140);
  const float4 c2_8 = *(const float4*)(Ab + 144);
  const float4 c2_12 = *(const float4*)(Ab + 148);
  a5 -= c5_4.z * a6;
  a5 -= c5_4.w * a7;
  a5 -= c5_8.x * a8;
  a5 -= c5_8.y * a9;
  a5 -= c5_8.z * a10;
  a5 -= c5_8.w * a11;
  a5 -= c5_12.x * a12;
  a5 -= c5_12.y * a13;
  a5 -= c5_12.z * a14;
  a5 -= c5_12.w * a15;
  const float4 c1_0 = *(const float4*)(Ab + 68);
  const float4 c1_4 = *(const float4*)(Ab + 72);
  const float4 c1_8 = *(const float4*)(Ab + 76);
  const float4 c1_12 = *(const float4*)(Ab + 80);
  a4 -= c4_4.y * a5;
  a4 -= c4_4.z * a6;
  a4 -= c4_4.w * a7;
  a4 -= c4_8.x * a8;
  a4 -= c4_8.y * a9;
  a4 -= c4_8.z * a10;
  a4 -= c4_8.w * a11;
  a4 -= c4_12.x * a12;
  a4 -= c4_12.y * a13;
  a4 -= c4_12.z * a14;
  a4 -= c4_12.w * a15;
  const float4 c0_0 = *(const float4*)(Ab + 0);
  const float4 c0_4 = *(const float4*)(Ab + 4);
  const float4 c0_8 = *(const float4*)(Ab + 8);
  const float4 c0_12 = *(const float4*)(Ab + 12);
  a3 -= c3_4.x * a4;
  a3 -= c3_4.y * a5;
  a3 -= c3_4.z * a6;
  a3 -= c3_4.w * a7;
  a3 -= c3_8.x * a8;
  a3 -= c3_8.y * a9;
  a3 -= c3_8.z * a10;
  a3 -= c3_8.w * a11;
  a3 -= c3_12.x * a12;
  a3 -= c3_12.y * a13;
  a3 -= c3_12.z * a14;
  a3 -= c3_12.w * a15;
  a2 -= c2_0.w * a3;
  a2 -= c2_4.x * a4;
  a2 -= c2_4.y * a5;
  a2 -= c2_4.z * a6;
  a2 -= c2_4.w * a7;
  a2 -= c2_8.x * a8;
  a2 -= c2_8.y * a9;
  a2 -= c2_8.z * a10;
  a2 -= c2_8.w * a11;
  a2 -= c2_12.x * a12;
  a2 -= c2_12.y * a13;
  a2 -= c2_12.z * a14;
  a2 -= c2_12.w * a15;
  a1 -= c1_0.z * a2;
  a1 -= c1_0.w * a3;
  a1 -= c1_4.x * a4;
  a1 -= c1_4.y * a5;
  a1 -= c1_4.z * a6;
  a1 -= c1_4.w * a7;
  a1 -= c1_8.x * a8;
  a1 -= c1_8.y * a9;
  a1 -= c1_8.z * a10;
  a1 -= c1_8.w * a11;
  a1 -= c1_12.x * a12;
  a1 -= c1_12.y * a13;
  a1 -= c1_12.z * a14;
  a1 -= c1_12.w * a15;
  a0 -= c0_0.y * a1;
  a0 -= c0_0.z * a2;
  a0 -= c0_0.w * a3;
  a0 -= c0_4.x * a4;
  a0 -= c0_4.y * a5;
  a0 -= c0_4.z * a6;
  a0 -= c0_4.w * a7;
  a0 -= c0_8.x * a8;
  a0 -= c0_8.y * a9;
  a0 -= c0_8.z * a10;
  a0 -= c0_8.w * a11;
  a0 -= c0_12.x * a12;
  a0 -= c0_12.y * a13;
  a0 -= c0_12.z * a14;
  a0 -= c0_12.w * a15;
  Xc[0] = a0;
  Xc[65] = a1;
  Xc[130] = a2;
  Xc[195] = a3;
  Xc[260] = a4;
  Xc[325] = a5;
  Xc[390] = a6;
  Xc[455] = a7;
  Xc[520] = a8;
  Xc[585] = a9;
  Xc[650] = a10;
  Xc[715] = a11;
  Xc[780] = a12;
  Xc[845] = a13;
  Xc[910] = a14;
  Xc[975] = a15;
}
#define FS(i) (ldsf + (i) * 4160)
__device__ __forceinline__ void rwkv_item2(const Params& p, int l, int item, float* ldsf) {
  const int tid = opq(threadIdx.x), lane = tid & 63, wave = tid >> 6;
  const int r = lane & 31, hf = lane >> 5;
  const int h = item & 7, cidx = item >> 3, rowbase = cidx * 64, cc = cidx & 127;
  const u16* z = (const u16*)(p.ws + WS_Z);
  const float* mu = p.in[9] + l * 1792;
  u16* BBp = (u16*)((unsigned char*)ldsf + 83200);
  u16* XW = BBp;            u16* XA = BBp + 4608;    u16* XG = BBp + 9216;   u16* WT = BBp + 17920;
  u16* Rn = BBp;            u16* Kn = BBp + 4608;    u16* Bn = BBp + 9216;   u16* Cn = BBp + 13824;
  u16* CT = BBp + 18432;    u16* KHT = BBp + 23040;  u16* VT = BBp + 27648;
  float* gc = (float*)(BBp + 32256);
  u16* AK = (u16*)FS(2);    u16* NTm = AK + 4608;
  u16* MT = (u16*)FS(0);    u16* KQT = (u16*)FS(1);
  float* Abp = (float*)((unsigned char*)ldsf + 60928);
  const int mt = (wave >> 1) & 1, nt = wave & 1, grp = wave >> 2;
  const uint4* lwsrc = (const uint4*)((const u16*)(p.ws + WS_LW) + (size_t)h * 17920);
  const float bias_w = p.in[10][l * 512 + h * 64 + nt * 32 + r], bias_a = p.in[12][l * 512 + h * 64 + nt * 32 + r];
  float kkw_[8], kaw_[8], rkw_[8];
  {
    const int j0 = (tid & 7) * 8;
    const float* q1 = p.in[15] + l * 512 + h * 64 + j0; const float* q2 = p.in[16] + l * 512 + h * 64 + j0; const float* q3 = p.in[17] + l * 512 + h * 64 + j0;
    const float4 x0 = *(const float4*)q1, x1 = *(const float4*)(q1 + 4), y0 = *(const float4*)q2, y1 = *(const float4*)(q2 + 4), z0 = *(const float4*)q3, z1 = *(const float4*)(q3 + 4);
    kkw_[0] = x0.x; kkw_[1] = x0.y; kkw_[2] = x0.z; kkw_[3] = x0.w; kkw_[4] = x1.x; kkw_[5] = x1.y; kkw_[6] = x1.z; kkw_[7] = x1.w;
    kaw_[0] = y0.x; kaw_[1] = y0.y; kaw_[2] = y0.z; kaw_[3] = y0.w; kaw_[4] = y1.x; kaw_[5] = y1.y; kaw_[6] = y1.z; kaw_[7] = y1.w;
    rkw_[0] = z0.x; rkw_[1] = z0.y; rkw_[2] = z0.z; rkw_[3] = z0.w; rkw_[4] = z1.x; rkw_[5] = z1.y; rkw_[6] = z1.z; rkw_[7] = z1.w;
  }
  const uint4 g2a = lwsrc[1152 + tid], g2b = lwsrc[1152 + 512 + tid], g2c = (tid < 64) ? lwsrc[1152 + 1024 + tid] : make_uint4(0, 0, 0, 0);
  __syncthreads();
  {
    const int t = tid >> 3, c8 = (tid & 7) * 8;
    const int m = rowbase + t;
    const int zcs[7] = {h * 64, 512 + h * 64, 1024 + h * 64, 1536, 1600, 1664, 1728};
#pragma unroll
    for (int gi = 0; gi < 7; ++gi) {
      const int zc = zcs[gi] + c8;
      float cur[8], prv[8], v[8];
      const float4 mu0 = *(const float4*)(mu + zc), mu1 = *(const float4*)(mu + zc + 4);
      const float muv[8] = {mu0.x, mu0.y, mu0.z, mu0.w, mu1.x, mu1.y, mu1.z, mu1.w};
      unpack8(*(const uint4*)(z + (size_t)m * ZLD + zc), cur);
      if (t == 0 && cc == 0) {
#pragma unroll
        for (int i = 0; i < 8; ++i) prv[i] = 0.f;
      } else {
        unpack8(*(const uint4*)(z + (size_t)(m - 1) * ZLD + zc), prv);
      }
#pragma unroll
      for (int i = 0; i < 8; ++i) {
        float x = cur[i] + muv[i] * (prv[i] - cur[i]);
        if (gi == 3) x = 1.f - 2.f * __builtin_amdgcn_rcpf(1.f + __expf(2.f * x));
        if (gi >= 5) x = sigm(x);
        v[i] = x;
      }
      if (gi < 2) {
        float* d = FS(gi) + t * 65 + c8;
#pragma unroll
        for (int i = 0; i < 8; ++i) d[i] = v[i];
      } else if (gi == 2) {
#pragma unroll
        for (int i = 0; i < 8; ++i) VT[SWZ(c8 + i, t)] = f2bf(v[i]);
      } else if (gi == 3) { *(uint4*)(XW + t * 72 + c8) = pack8(v); }
      else if (gi == 4) { *(uint4*)(XA + t * 72 + c8) = pack8(v); }
      else { *(uint4*)(XG + t * 136 + (gi - 5) * 64 + c8) = pack8(v); }
    }
  }
  {
    uint4* d = (uint4*)WT;
    for (int e = tid; e < 1152; e += 512) d[e] = lwsrc[e];
  }
  __syncthreads();
  {
    f32x16 acc;
#pragma unroll
    for (int i = 0; i < 16; ++i) acc[i] = 0.f;
    mm_tile(grp ? XA : XW, 72, grp ? WT + 4608 : WT, 72, mt, nt, r, hf, 4, acc);
    const int j = nt * 32 + r;
    const float bias = grp ? bias_a : bias_w;
#pragma unroll
    for (int reg = 0; reg < 16; ++reg) {
      const int t = mt * 32 + ROWOFF(reg, hf);
      const float x = acc[reg] + bias;
      if (grp) FS(3)[t * 65 + j] = sigm(x);
      else {
        const float nx = -x;
        const float sp = (nx > 20.f) ? nx : __logf(1.f + __expf(nx));
        FS(4)[t * 65 + j] = -__expf(-sp - 0.5f);
      }
    }
  }
  __syncthreads();
  {
    uint4* d = (uint4*)WT;
    d[tid] = g2a; d[512 + tid] = g2b; if (tid < 64) d[1024 + tid] = g2c;
  }
  float* psum = (float*)((unsigned char*)ldsf + 147968);
  float pl[8];
  {
    const int j = tid & 63, sg = tid >> 6;
    float c = 0.f;
#pragma unroll
    for (int u = 0; u < 8; ++u) { c += FS(4)[(sg * 8 + u) * 65 + j]; pl[u] = c; }
    psum[sg * 64 + j] = c;
  }
  __syncthreads();
  {
    const int j = tid & 63, sg = tid >> 6;
    float off = 0.f, tot = 0.f;
#pragma unroll
    for (int q = 0; q < 8; ++q) { const float v = psum[q * 64 + j]; tot += v; if (q < sg) off += v; }
#pragma unroll
    for (int u = 0; u < 8; ++u) FS(2)[(sg * 8 + u) * 65 + j] = off + pl[u];
    if (sg == 0) { const float g = __expf(tot); gc[j] = g; ((float*)(p.ws + WS_GC))[(size_t)item * 64 + j] = g; }
  }
  __syncthreads();
  if (grp == 0) {
    f32x16 acc;
#pragma unroll
    for (int i = 0; i < 16; ++i) acc[i] = 0.f;
    mm_tile(XG, 136, WT, 136, mt, nt, r, hf, 8, acc);
    u16* ga = (u16*)(p.ws + WS_GA) + (size_t)item * 4096;
#pragma unroll
    for (int reg = 0; reg < 16; ++reg) ga[(mt * 32 + ROWOFF(reg, hf)) * 64 + nt * 32 + r] = f2bf(acc[reg]);
  }
  __syncthreads();
  {
    const int t = tid >> 3, j0 = (tid & 7) * 8;
    float kr[8], av[8], rv[8], kkv[8], kf[8];
    float nrm = 0.f, bdot = 0.f;
#pragma unroll
    for (int i = 0; i < 8; ++i) {
      const int j = j0 + i;
      kr[i] = FS(1)[t * 65 + j]; av[i] = FS(3)[t * 65 + j]; rv[i] = FS(0)[t * 65 + j];
      kkv[i] = kr[i] * kkw_[i];
      nrm += kkv[i] * kkv[i];
      kf[i] = kr[i] * (1.f + (av[i] - 1.f) * kaw_[i]);
      bdot += rv[i] * kf[i] * rkw_[i];
    }
    nrm += __shfl_xor(nrm, 1, 64); nrm += __shfl_xor(nrm, 2, 64); nrm += __shfl_xor(nrm, 4, 64);
    bdot += __shfl_xor(bdot, 1, 64); bdot += __shfl_xor(bdot, 2, 64); bdot += __shfl_xor(bdot, 4, 64);
    const float rn = 1.f / fmaxf(sqrtf(nrm), 1e-12f);
    float o_r[8], o_k[8], o_b[8], o_c[8], bo[8];
#pragma unroll
    for (int i = 0; i < 8; ++i) {
      const int j = j0 + i;
      const float cum = FS(2)[t * 65 + j], dl = FS(4)[t * 65 + j];
      const float eg = __expf(cum), egi = __expf(-cum), egp = __expf(cum - dl);
      const float kk = kkv[i] * rn;
      const float g = gc[j];
      o_r[i] = rv[i] * eg; o_k[i] = kf[i] * egi; o_b[i] = kk * av[i] * egi; o_c[i] = kk * egp;
      CT[SWZ(j, t)] = f2bf(o_c[i]);
      KHT[SWZ(j, t)] = f2bf(o_k[i] * g);
      FS(1)[t * 65 + j] = o_b[i] * g;
      bo[i] = bdot * bf2f(VT[SWZ(j, t)]);
    }
    *(uint4*)(Rn + t * 72 + j0) = pack8(o_r);
    *(uint4*)(Kn + t * 72 + j0) = pack8(o_k);
    *(uint4*)(Bn + t * 72 + j0) = pack8(o_b);
    *(uint4*)(Cn + t * 72 + j0) = pack8(o_c);
    u16* bop = (u16*)(p.ws + WS_BO) + (size_t)item * 4096;
    *(uint4*)(bop + t * 64 + j0) = pack8(bo);
  }
  __syncthreads();
  f32x16 akr;
#pragma unroll
  for (int i = 0; i < 16; ++i) akr[i] = 0.f;
  if (grp == 0) {
    f32x16 ab, abr;
#pragma unroll
    for (int i = 0; i < 16; ++i) { ab[i] = 0.f; abr[i] = 0.f; }
    mm_tile(Bn, 72, Cn, 72, mt, nt, r, hf, 4, ab);
    mm_tile(Bn, 72, Rn, 72, mt, nt, r, hf, 4, abr);
    const int t = nt * 32 + r;
#pragma unroll
    for (int reg = 0; reg < 16; ++reg) {
      const int i = mt * 32 + ROWOFF(reg, hf);
      Abp[i * 68 + t] = (i < t) ? ab[reg] : 0.f;
      FS(0)[i * 65 + t] = (i <= t) ? abr[reg] : 0.f;
    }
  } else {
    f32x16 akt;
#pragma unroll
    for (int i = 0; i < 16; ++i) akt[i] = 0.f;
    mm_tile(Cn, 72, Kn, 72, mt, nt, r, hf, 4, akt);
    {
      const int i = nt * 32 + r;
#pragma unroll
      for (int reg = 0; reg < 16; ++reg) { const int t = mt * 32 + ROWOFF(reg, hf); if (!(i < t)) akt[reg] = 0.f; }
    }
    store_T(AK, 72, mt, nt, r, hf, akt);
    mm_tile(Kn, 72, Rn, 72, mt, nt, r, hf, 4, akr);
    {
      const int t = nt * 32 + r;
#pragma unroll
      for (int reg = 0; reg < 16; ++reg) { const int i = mt * 32 + ROWOFF(reg, hf); if (!(i <= t)) akr[reg] = 0.f; }
    }
  }
  __syncthreads();
#pragma unroll 1
  for (int I = 3; I >= 0; --I) {
    if (tid < 128) {
      float* X_ = (tid < 64) ? FS(0) : FS(1);
      tri16(Abp + I * 16 * 69, X_ + I * 16 * 65 + (tid & 63));
    }
    __syncthreads();
    if (I > 0) {
      const int c = tid & 127, rg = tid >> 7;
      float* X_ = (c < 64) ? FS(0) : FS(1);
      const int col = c & 63;
      float xv[16];
#pragma unroll
      for (int t = 0; t < 16; ++t) xv[t] = X_[(I * 16 + t) * 65 + col];
      for (int i = rg; i < I * 16; i += 4) {
        const float* ar = Abp + i * 68 + I * 16;
        const float4 c0 = *(const float4*)ar, c1 = *(const float4*)(ar + 4), c2 = *(const float4*)(ar + 8), c3 = *(const float4*)(ar + 12);
        float a = c0.x * xv[0] + c0.y * xv[1] + c0.z * xv[2] + c0.w * xv[3];
        a += c1.x * xv[4] + c1.y * xv[5] + c1.z * xv[6] + c1.w * xv[7];
        a += c2.x * xv[8] + c2.y * xv[9] + c2.z * xv[10] + c2.w * xv[11];
        a += c3.x * xv[12] + c3.y * xv[13] + c3.z * xv[14] + c3.w * xv[15];
        X_[i * 65 + col] -= a;
      }
      __syncthreads();
    }
  }
  {
    const int c = tid >> 2, q = tid & 3;
    const float* X_ = (c < 64) ? FS(0) : FS(1);
    const int col = c & 63;
    float o0[8], o1[8];
#pragma unroll
    for (int u = 0; u < 8; ++u) { o0[u] = -X_[(q * 16 + u) * 65 + col]; o1[u] = -X_[(q * 16 + 8 + u) * 65 + col]; }
    u16* dst = NTm + c * 72 + q * 16;
    *(uint4*)dst = pack8(o0);
    *(uint4*)(dst + 8) = pack8(o1);
  }
  __syncthreads();
  if (grp == 1) {
    mm_tile(AK, 72, NTm, 72, mt, nt, r, hf, 4, akr);
    store_T(MT, 72, mt, nt, r, hf, akr);
  } else {
    f32x16 d2;
#pragma unroll
    for (int i = 0; i < 16; ++i) d2[i] = 0.f;
    mm_tile(AK, 72, NTm + 64 * 72, 72, mt, nt, r, hf, 4, d2);
#pragma unroll
    for (int g = 0; g < 4; ++g) {
      const int idx = (nt * 32 + r) * 72 + mt * 32 + 8 * g + 4 * hf;
      const uint2 kh = *(const uint2*)(KHT + SWZ(nt * 32 + r, mt * 32 + 8 * g + 4 * hf));
      uint2 o;
      o.x = pack2(d2[4 * g] + __uint_as_float(kh.x << 16), d2[4 * g + 1] + __uint_as_float(kh.x & 0xFFFF0000u));
      o.y = pack2(d2[4 * g + 2] + __uint_as_float(kh.y << 16), d2[4 * g + 3] + __uint_as_float(kh.y & 0xFFFF0000u));
      *(uint2*)(KQT + idx) = o;
    }
  }
  __syncthreads();
  if (grp == 0) {
    f32x16 w2, yl;
#pragma unroll
    for (int i = 0; i < 16; ++i) { w2[i] = 0.f; yl[i] = 0.f; }
    mm_tile<false, true>(NTm, 72, CT, 72, mt, nt, r, hf, 4, w2);
    mm_tile<false, true>(MT, 72, VT, 72, mt, nt, r, hf, 4, yl);
    u16* W2p = (u16*)(p.ws + WS_W2) + (size_t)item * 4096;
    u16* YLp = (u16*)(p.ws + WS_YL) + (size_t)item * 4096;
#pragma unroll
    for (int reg = 0; reg < 16; ++reg) {
      const int t = mt * 32 + ROWOFF(reg, hf), n = nt * 32 + r;
      W2p[t * 64 + n] = f2bf(w2[reg] + bf2f(Rn[t * 72 + n]));
      YLp[t * 64 + n] = f2bf(yl[reg]);
    }
  } else {
    f32x16 pp, qt;
#pragma unroll
    for (int i = 0; i < 16; ++i) { pp[i] = 0.f; qt[i] = 0.f; }
    mm_tile<true, false>(CT, 72, NTm + 64 * 72, 72, mt, nt, r, hf, 4, pp);
    mm_tile<false, true>(KQT, 72, VT, 72, mt, nt, r, hf, 4, qt);
    uint4* Pf = (uint4*)((u16*)(p.ws + WS_PP) + (size_t)item * 4096);
    float* Qf = (float*)(p.ws + WS_Q) + (size_t)item * 4096;
#pragma unroll
    for (int s2 = 0; s2 < 2; ++s2) {
      uint4 o;
      o.x = pack2(pp[s2 * 8 + 0], pp[s2 * 8 + 1]); o.y = pack2(pp[s2 * 8 + 2], pp[s2 * 8 + 3]);
      o.z = pack2(pp[s2 * 8 + 4], pp[s2 * 8 + 5]); o.w = pack2(pp[s2 * 8 + 6], pp[s2 * 8 + 7]);
      Pf[(nt * 4 + mt * 2 + s2) * 64 + lane] = o;
    }
#pragma unroll
    for (int reg = 0; reg < 16; ++reg) Qf[((nt * 2 + mt) * 16 + reg) * 64 + lane] = qt[reg];
  }
}

template <int K_> struct IC { static constexpr int value = K_; };
__device__ __forceinline__ void rwkv_scan(const Params& p, int l, int bh, float* ldsf, bool dry = false) {
  const int tid = opq(threadIdx.x), lane = tid & 63, wave = tid >> 6;
  const int b = bh >> 3, h = bh & 7;
  unsigned char* ring = (unsigned char*)ldsf + 32768;
  uint4* xch = (uint4*)((unsigned char*)ldsf + 32768 + 49152);
  __syncthreads();
  {
    const float* G0 = (const float*)(p.ws + WS_GC);
    for (int e = tid; e < 8192; e += NT) ldsf[e] = G0[(size_t)((b * 128 + (e >> 6)) * 8 + h) * 64 + (e & 63)];
    if (tid < 256) { for (int e = tid; e < 1024; e += 256) xch[e] = make_uint4(0, 0, 0, 0); }
  }
  const bool helper = wave >= 4;
  const u16* PPb = (const u16*)(p.ws + WS_PP);
  const float* Qb = (const float*)(p.ws + WS_Q);
  if (helper) {
    const bool isP = wave < 6;
    const int hidx = isP ? (tid - 256) : (tid - 384);
    const int hdst = isP ? hidx : 512 + hidx;
#define SC_GLOAD(c, R) do { const size_t id_ = (size_t)((b * 128 + (c)) * 8 + h); \
      if (isP) { const uint4* src_ = (const uint4*)(PPb + id_ * 4096) + hidx; R##0 = src_[0]; R##1 = src_[128]; R##2 = src_[256]; R##3 = src_[384]; } \
      else { const uint4* src_ = (const uint4*)(Qb + id_ * 4096) + hidx; R##0 = src_[0]; R##1 = src_[128]; R##2 = src_[256]; R##3 = src_[384]; \
             R##4 = src_[512]; R##5 = src_[640]; R##6 = src_[768]; R##7 = src_[896]; } } while (0)
#define SC_LWRITE(c, R) do { uint4* slot_ = (uint4*)(ring + ((c) & 1) * 24576) + hdst; \
      slot_[0] = R##0; slot_[128] = R##1; slot_[256] = R##2; slot_[384] = R##3; \
      if (!isP) { slot_[512] = R##4; slot_[640] = R##5; slot_[768] = R##6; slot_[896] = R##7; } } while (0)
    uint4 a0, a1, a2, a3, a4, a5, a6, a7, b0, b1, b2, b3, b4, b5, b6, b7, c0, c1, c2, c3, c4, c5, c6, c7, d0, d1, d2, d3, d4, d5, d6, d7;
    a4 = a5 = a6 = a7 = b4 = b5 = b6 = b7 = c4 = c5 = c6 = c7 = d4 = d5 = d6 = d7 = make_uint4(0, 0, 0, 0);
    SC_GLOAD(0, a); SC_LWRITE(0, a);
    SC_GLOAD(1, b); SC_GLOAD(2, c); SC_GLOAD(3, d);
    __syncthreads();
#pragma unroll 1
    for (int cc = 0; cc < 128; cc += 4) {
      if (cc + 4 < 128) SC_GLOAD(cc + 4, a);
      SC_LWRITE(cc + 1, b);
      asm volatile("s_waitcnt lgkmcnt(0)\n\ts_barrier" ::: "memory");
      if (cc + 5 < 128) SC_GLOAD(cc + 5, b);
      SC_LWRITE(cc + 2, c);
      asm volatile("s_waitcnt lgkmcnt(0)\n\ts_barrier" ::: "memory");
      if (cc + 6 < 128) SC_GLOAD(cc + 6, c);
      SC_LWRITE(cc + 3, d);
      asm volatile("s_waitcnt lgkmcnt(0)\n\ts_barrier" ::: "memory");
      if (cc + 7 < 128) SC_GLOAD(cc + 7, d);
      if (cc + 4 < 128) SC_LWRITE(cc + 4, a);
      asm volatile("s_waitcnt lgkmcnt(0)\n\ts_barrier" ::: "memory");
    }
    return;
  }
  __syncthreads();
  const int vt = wave & 1, kt2 = wave >> 1, hf = lane >> 5;
  f32x16 S;
#pragma unroll
  for (int i = 0; i < 16; ++i) S[i] = 0.f;
  uint4 own0 = make_uint4(0, 0, 0, 0), own1 = make_uint4(0, 0, 0, 0);
#pragma unroll 1
  for (int cc = 0; cc < 128; ++cc) {
    const size_t id = (size_t)((b * 128 + cc) * 8 + h);
    const int lofs = opq(lane);
    float* Qg = (float*)Qb + id * 4096 + (vt * 2 + kt2) * 1024 + lofs;
    const uint4* slotA = (const uint4*)(ring + (cc & 1) * 24576) + kt2 * 256 + lofs;
    const float* slotQ = (const float*)(ring + (cc & 1) * 24576 + 8192) + (vt * 2 + kt2) * 1024 + lofs;
    const float* gcp = ldsf + cc * 64 + kt2 * 32 + 4 * (lofs >> 5);
    const uint4* xin = xch + (((cc & 1) * 2 + vt) * 2 + (kt2 ^ 1)) * 128 + lofs;
    uint4* xout = xch + ((((cc + 1) & 1) * 2 + vt) * 2 + kt2) * 128 + lofs;
    f32x16 acc;
#pragma unroll
    for (int reg = 0; reg < 16; ++reg) acc[reg] = S[reg] * gcp[((reg) & 3) + 8 * ((reg) >> 2)] + slotQ[reg * 64];
#pragma unroll
    for (int reg = 0; reg < 16; ++reg) if (!dry) Qg[reg * 64] = S[reg];
    const uint4 p0 = xin[0], p1 = xin[64];
#pragma unroll
    for (int s_ = 0; s_ < 4; ++s_) {
      union { uint4 u; bf16x8 v; } bfr, af;
      const bool mine = (s_ >> 1) == kt2;
      bfr.u = mine ? ((s_ & 1) ? own1 : own0) : ((s_ & 1) ? p1 : p0);
      af.u = slotA[s_ * 64];
      acc = __builtin_amdgcn_mfma_f32_32x32x16_bf16(af.v, bfr.v, acc, 0, 0, 0);
    }
    S = acc;
    own0 = make_uint4(pack2(S[0], S[1]), pack2(S[2], S[3]), pack2(S[4], S[5]), pack2(S[6], S[7]));
    own1 = make_uint4(pack2(S[8], S[9]), pack2(S[10], S[11]), pack2(S[12], S[13]), pack2(S[14], S[15]));
    xout[0] = own0; xout[64] = own1;
    asm volatile("s_waitcnt lgkmcnt(0)\n\ts_barrier" ::: "memory");
  }
  {
    float* o = p.out + O_PWKV + ((size_t)((l * 2 + b) * 8 + h) * 64 + vt * 32 + (lane & 31)) * 64 + kt2 * 32;
#pragma unroll
    for (int reg = 0; reg < 16; ++reg) o[ROWOFF(reg, hf)] = S[reg];
  }
}

__device__ __forceinline__ void rwkv_out(const Params& p, int l, int item, float* ldsf) {
  const int tid = opq(threadIdx.x), lane = tid & 63, wave = tid >> 6;
  const int h = item & 7, cidx = item >> 3;
  float* Sl = ldsf; float* Wl = ldsf + 4160;
  const float* Sg = (const float*)(p.ws + WS_Q) + (size_t)item * 4096;
  const u16* W2 = (const u16*)(p.ws + WS_W2) + (size_t)item * 4096;
  const u16* YL = (const u16*)(p.ws + WS_YL) + (size_t)item * 4096;
  const u16* BO = (const u16*)(p.ws + WS_BO) + (size_t)item * 4096;
  const u16* GA = (const u16*)(p.ws + WS_GA) + (size_t)item * 4096;
  u16* z = (u16*)(p.ws + WS_Z);
  __syncthreads();
  {
    const int row = tid >> 3, c = (tid & 7) * 8;
#pragma unroll
    for (int i = 0; i < 8; ++i) {
      const int idx = i * 512 + tid;
      const int ln = idx & 63, reg = (idx >> 6) & 15, kt = (idx >> 10) & 1, vt = idx >> 11;
      Sl[(vt * 32 + (ln & 31)) * 65 + kt * 32 + ROWOFF(reg, ln >> 5)] = Sg[idx];
    }
    float w[8];
    unpack8(*(const uint4*)(W2 + row * 64 + c), w);
    float* e = Wl + row * 65 + c;
#pragma unroll
    for (int i = 0; i < 8; ++i) e[i] = w[i];
  }
  __syncthreads();
  float y[8];
#pragma unroll
  for (int q = 0; q < 8; ++q) y[q] = bf2f(YL[(wave * 8 + q) * 64 + lane]);
#pragma unroll 2
  for (int k = 0; k < 64; ++k) {
    const float s = Sl[lane * 65 + k];
#pragma unroll
    for (int q = 0; q < 8; ++q) y[q] += s * Wl[(wave * 8 + q) * 65 + k];
  }
  const float lng = p.in[18][l * 512 + h * 64 + lane], lnb = p.in[19][l * 512 + h * 64 + lane];
#pragma unroll
  for (int q = 0; q < 8; ++q) {
    const int t = wave * 8 + q;
    const float mean = wave_sum(y[q]) * (1.f / 64.f);
    const float d = y[q] - mean;
    const float var = wave_sum(d * d) * (1.f / 64.f);
    const float yn = d * rsqrtf(var + 64e-5f) * lng + lnb;
    const float o = (yn + bf2f(BO[t * 64 + lane])) * bf2f(GA[t * 64 + lane]);
    z[(size_t)(cidx * 64 + t) * ZLD + h * 64 + lane] = f2bf(o);
  }
}

__device__ __forceinline__ void rwkv_out4(const Params& p, int l, int item0, float* ldsf) {
  const int tid = opq(threadIdx.x), lane = tid & 63, wave = tid >> 6;
  const int r = lane & 31, hf = lane >> 5;
  const int pair = wave >> 1, nt = wave & 1;
  const int item = item0 + pair;
  const int h = item & 7, cidx = item >> 3;
  u16* Sl = (u16*)ldsf + pair * 4608;
  const float* Sg = (const float*)(p.ws + WS_Q) + (size_t)item * 4096;
  const u16* W2 = (const u16*)(p.ws + WS_W2) + (size_t)item * 4096;
  const u16* YL = (const u16*)(p.ws + WS_YL) + (size_t)item * 4096;
  const u16* BO = (const u16*)(p.ws + WS_BO) + (size_t)item * 4096;
  const u16* GA = (const u16*)(p.ws + WS_GA) + (size_t)item * 4096;
  u16* z = (u16*)(p.ws + WS_Z);
  __syncthreads();
  {
    const int lt = tid & 127;
#pragma unroll
    for (int q = 0; q < 8; ++q) {
      const int e = q * 128 + lt;
      const int ln = e & 63, g = (e >> 6) & 3, kt = (e >> 8) & 1, vt = (e >> 9) & 1;
      const float* sp = Sg + ((vt * 2 + kt) * 16 + 4 * g) * 64 + ln;
      const float a0 = sp[0], a1 = sp[64], a2 = sp[128], a3 = sp[192];
      uint2 o; o.x = pack2(a0, a1); o.y = pack2(a2, a3);
      *(uint2*)(Sl + (vt * 32 + (ln & 31)) * 72 + kt * 32 + 8 * g + 4 * (ln >> 5)) = o;
    }
  }
  bf16x8 bfr[4];
#pragma unroll
  for (int s_ = 0; s_ < 4; ++s_) bfr[s_] = *(const bf16x8*)(W2 + (nt * 32 + r) * 64 + s_ * 16 + hf * 8);
  __syncthreads();
  f32x16 acc[2];
#pragma unroll
  for (int mt = 0; mt < 2; ++mt) {
#pragma unroll
    for (int i = 0; i < 16; ++i) acc[mt][i] = 0.f;
#pragma unroll
    for (int s_ = 0; s_ < 4; ++s_) {
      const bf16x8 a = *(const bf16x8*)(Sl + (mt * 32 + r) * 72 + s_ * 16 + hf * 8);
      acc[mt] = __builtin_amdgcn_mfma_f32_32x32x16_bf16(a, bfr[s_], acc[mt], 0, 0, 0);
    }
  }
  const int t = nt * 32 + r;
  float sum = 0.f;
#pragma unroll
  for (int mt = 0; mt < 2; ++mt)
#pragma unroll
    for (int g = 0; g < 4; ++g) {
      const uint2 yl = *(const uint2*)(YL + t * 64 + mt * 32 + 8 * g + 4 * hf);
      acc[mt][4 * g + 0] += __uint_as_float(yl.x << 16); acc[mt][4 * g + 1] += __uint_as_float(yl.x & 0xFFFF0000u);
      acc[mt][4 * g + 2] += __uint_as_float(yl.y << 16); acc[mt][4 * g + 3] += __uint_as_float(yl.y & 0xFFFF0000u);
      sum += acc[mt][4 * g] + acc[mt][4 * g + 1] + acc[mt][4 * g + 2] + acc[mt][4 * g + 3];
    }
  sum += __shfl_xor(sum, 32, 64);
  const float mean = sum * (1.f / 64.f);
  float vs = 0.f;
#pragma unroll
  for (int mt = 0; mt < 2; ++mt)
#pragma unroll
    for (int i = 0; i < 16; ++i) { const float d = acc[mt][i] - mean; vs += d * d; }
  vs += __shfl_xor(vs, 32, 64);
  const float rstd = rsqrtf(vs * (1.f / 64.f) + 64e-5f);
  const float* lng = p.in[18] + l * 512 + h * 64;
  const float* lnb = p.in[19] + l * 512 + h * 64;
  u16* zrow = z + (size_t)(cidx * 64 + t) * ZLD + h * 64;
#pragma unroll
  for (int mt = 0; mt < 2; ++mt)
#pragma unroll
    for (int g = 0; g < 4; ++g) {
      const int v0 = mt * 32 + 8 * g + 4 * hf;
      const uint2 bo = *(const uint2*)(BO + t * 64 + v0);
      const uint2 ga = *(const uint2*)(GA + t * 64 + v0);
      const float4 lg = *(const float4*)(lng + v0), lb = *(const float4*)(lnb + v0);
      const float bo_[4] = {__uint_as_float(bo.x << 16), __uint_as_float(bo.x & 0xFFFF0000u), __uint_as_float(bo.y << 16), __uint_as_float(bo.y & 0xFFFF0000u)};
      const float ga_[4] = {__uint_as_float(ga.x << 16), __uint_as_float(ga.x & 0xFFFF0000u), __uint_as_float(ga.y << 16), __uint_as_float(ga.y & 0xFFFF0000u)};
      const float lg_[4] = {lg.x, lg.y, lg.z, lg.w}, lb_[4] = {lb.x, lb.y, lb.z, lb.w};
      float o[4];
#pragma unroll
      for (int u = 0; u < 4; ++u) o[u] = ((acc[mt][4 * g + u] - mean) * rstd * lg_[u] + lb_[u] + bo_[u]) * ga_[u];
      uint2 ov; ov.x = pack2(o[0], o[1]); ov.y = pack2(o[2], o[3]);
      *(uint2*)(zrow + v0) = ov;
    }
}

__device__ __forceinline__ void attn_prompt(const Params& p, int l, int item, u16* lds, bool dry = false) {
  const int tid = opq(threadIdx.x), lane = tid & 63, wave = tid >> 6;
  const int r = lane & 31, h = lane >> 5;
  const int kvh = item & 1, n = (item >> 1) & 63, b = item >> 7;
  u16* z = (u16*)(p.ws + WS_Z);
  u16* Ks = lds;
  u16* Vt = lds + 256 * 72;
  __syncthreads();
  {
    const int key = tid >> 1, half = tid & 1;
    const int t = (n - 1) * 128 + key;
    uint4 kv[4], vv[4];
    if (t >= 0) {
      const u16* kp = z + (size_t)(b * 8192 + t) * ZLD + 2304 + kvh * 64 + half * 32;
      const u16* vp = z + (size_t)(b * 8192 + t) * ZLD + 2432 + kvh * 64 + half * 32;
#pragma unroll
      for (int i = 0; i < 4; ++i) { kv[i] = *(const uint4*)(kp + i * 8); vv[i] = *(const uint4*)(vp + i * 8); }
    } else {
#pragma unroll
      for (int i = 0; i < 4; ++i) { kv[i] = make_uint4(0, 0, 0, 0); vv[i] = make_uint4(0, 0, 0, 0); }
    }
#pragma unroll
    for (int i = 0; i < 4; ++i) {
      *(uint4*)(Ks + key * 72 + half * 32 + i * 8) = kv[i];
      const unsigned w[4] = {vv[i].x, vv[i].y, vv[i].z, vv[i].w};
#pragma unroll
      for (int q = 0; q < 4; ++q) {
        const int d = half * 32 + i * 8 + q * 2;
        Vt[d * 264 + key] = (u16)(w[q] & 0xFFFFu);
        Vt[(d + 1) * 264 + key] = (u16)(w[q] >> 16);
      }
    }
  }
  __syncthreads();
#pragma unroll 1
  for (int uu = 0; uu < 2; ++uu) {
    const int u = wave * 2 + uu;
    const int hq = kvh * 4 + (u >> 2), qg = u & 3;
    const int qrow = b * 8192 + n * 128 + qg * 32 + r;
    u16* qp = z + (size_t)qrow * ZLD + 1792 + hq * 64;
    bf16x8 qf[4];
#pragma unroll
    for (int s = 0; s < 4; ++s) qf[s] = *(const bf16x8*)(qp + s * 16 + h * 8);
    f32x16 sc[5];
#pragma unroll
    for (int i5 = 0; i5 < 5; ++i5) {
#pragma unroll
      for (int i = 0; i < 16; ++i) sc[i5][i] = 0.f;
      const int kt = qg + i5;
#pragma unroll
      for (int s = 0; s < 4; ++s) {
        bf16x8 kf = *(const bf16x8*)(Ks + (kt * 32 + r) * 72 + s * 16 + h * 8);
        sc[i5] = __builtin_amdgcn_mfma_f32_32x32x16_bf16(kf, qf[s], sc[i5], 0, 0, 0);
      }
      __builtin_amdgcn_sched_barrier(0);
    }
    const int qi = qg * 32 + r;
    const float sink = p.in[20][l * 8 + hq];
    float mx = -1e30f;
#pragma unroll
    for (int i5 = 0; i5 < 5; ++i5)
#pragma unroll
      for (int reg = 0; reg < 16; ++reg) {
        const int j = (qg + i5) * 32 + ROWOFF(reg, h);
        const bool ok = (j > qi) && (j <= qi + 128) && (n > 0 || j >= 128);
        const float s = ok ? sc[i5][reg] * 0.125f : -1e30f;
        sc[i5][reg] = s;
        mx = fmaxf(mx, s);
      }
    mx = fmaxf(mx, __shfl_xor(mx, 32, 64));
    mx = fmaxf(mx, sink);
    float sum = 0.f;
#pragma unroll
    for (int i5 = 0; i5 < 5; ++i5)
#pragma unroll
      for (int reg = 0; reg < 16; ++reg) { const float e = __expf(sc[i5][reg] - mx); sc[i5][reg] = e; sum += e; }
    sum += __shfl_xor(sum, 32, 64);
    const float rden = 1.f / (sum + __expf(sink - mx));
    f32x16 oacc[2];
#pragma unroll
    for (int i = 0; i < 16; ++i) { oacc[0][i] = 0.f; oacc[1][i] = 0.f; }
#pragma unroll
    for (int i5 = 0; i5 < 5; ++i5) {
      const int kt = qg + i5;
#pragma unroll
      for (int s2 = 0; s2 < 2; ++s2) {
        bf16x8 pf;
#pragma unroll
        for (int j = 0; j < 8; ++j) pf[j] = (short)f2bf(sc[i5][s2 * 8 + j] * rden);
#pragma unroll
        for (int dt = 0; dt < 2; ++dt) {
          const u16* vp = Vt + (dt * 32 + r) * 264 + kt * 32 + s2 * 16 + h * 4;
          const uint2 lo = *(const uint2*)vp, hi = *(const uint2*)(vp + 8);
          union { uint4 u; bf16x8 v; } cv;
          cv.u = make_uint4(lo.x, lo.y, hi.x, hi.y);
          oacc[dt] = __builtin_amdgcn_mfma_f32_32x32x16_bf16(cv.v, pf, oacc[dt], 0, 0, 0);
        }
        __builtin_amdgcn_sched_barrier(0);
      }
    }
#pragma unroll
    for (int dt = 0; dt < 2; ++dt)
#pragma unroll
      for (int g4 = 0; g4 < 4; ++g4) {
        const int d = dt * 32 + 8 * g4 + 4 * h;
        uint2 o;
        o.x = pack2(oacc[dt][g4 * 4 + 0], oacc[dt][g4 * 4 + 1]);
        o.y = pack2(oacc[dt][g4 * 4 + 2], oacc[dt][g4 * 4 + 3]);
        if (!dry) *(uint2*)(qp + d) = o;
      }
  }
}

__device__ __forceinline__ void attn_sample(const Params& p, int l, int item, float* ldsf, bool dry = false) {
  const int tid = opq(threadIdx.x);
  const int kvh = item & 1, b = item >> 1;
  u16* z = (u16*)(p.ws + WS_Z);
  float* Kl = ldsf;
  float* Vl = ldsf + 132 * 65;
  float* Ql = Vl + 132 * 65;
  float* Pl = Ql + 16 * 64;
  __syncthreads();
  for (int e = tid; e < 132 * 8; e += NT) {
    const int j = e >> 3, c = (e & 7) * 8;
    float k[8], v[8];
    if (j < 128) {
      const float* kp = p.in[4] + ((size_t)((l * 128 + b) * 128 + j) * 2 + kvh) * 64 + c;
      const float* vp = p.in[5] + ((size_t)((l * 128 + b) * 128 + j) * 2 + kvh) * 64 + c;
      float4 a = *(const float4*)kp, a2 = *(const float4*)(kp + 4);
      float4 c1 = *(const float4*)vp, c2 = *(const float4*)(vp + 4);
      k[0] = a.x; k[1] = a.y; k[2] = a.z; k[3] = a.w; k[4] = a2.x; k[5] = a2.y; k[6] = a2.z; k[7] = a2.w;
      v[0] = c1.x; v[1] = c1.y; v[2] = c1.z; v[3] = c1.w; v[4] = c2.x; v[5] = c2.y; v[6] = c2.z; v[7] = c2.w;
    } else {
      const size_t row = M_P + b * 4 + (j - 128);
      unpack8(*(const uint4*)(z + row * ZLD + 2304 + kvh * 64 + c), k);
      unpack8(*(const uint4*)(z + row * ZLD + 2432 + kvh * 64 + c), v);
    }
#pragma unroll
    for (int i = 0; i < 8; ++i) { Kl[j * 65 + c + i] = k[i]; Vl[j * 65 + c + i] = v[i]; }
    if (j >= 4) {
      float* ok = p.out + O_SK + ((size_t)((l * 128 + b) * 128 + (j - 4)) * 2 + kvh) * 64 + c;
      float* ov = p.out + O_SV + ((size_t)((l * 128 + b) * 128 + (j - 4)) * 2 + kvh) * 64 + c;
      *(float4*)ok = make_float4(k[0], k[1], k[2], k[3]); *(float4*)(ok + 4) = make_float4(k[4], k[5], k[6], k[7]);
      *(float4*)ov = make_float4(v[0], v[1], v[2], v[3]); *(float4*)(ov + 4) = make_float4(v[4], v[5], v[6], v[7]);
    }
  }
  if (tid < 128) {
    const int row = tid >> 3, c = (tid & 7) * 8;
    const int hl = row >> 2, t = row & 3;
    float q[8];
    unpack8(*(const uint4*)(z + (size_t)(M_P + b * 4 + t) * ZLD + 1792 + (kvh * 4 + hl) * 64 + c), q);
#pragma unroll
    for (int i = 0; i < 8; ++i) Ql[row * 64 + c + i] = q[i];
  }
  __syncthreads();
  const int row = tid >> 5, jl = tid & 31;
  const int t = row & 3, hq = kvh * 4 + (row >> 2);
  float sc[5];
  float mx = -1e30f;
#pragma unroll
  for (int jj = 0; jj < 5; ++jj) {
    const int j = jl + 32 * jj;
    float s = -1e30f;
    if (j < 132 && j > t && j <= t + 128) {
      float a = 0.f;
#pragma unroll 8
      for (int d = 0; d < 64; ++d) a += Ql[row * 64 + d] * Kl[j * 65 + d];
      s = a * 0.125f;
    }
    sc[jj] = s; mx = fmaxf(mx, s);
    __builtin_amdgcn_sched_barrier(0);
  }
#pragma unroll
  for (int o = 16; o >= 1; o >>= 1) mx = fmaxf(mx, __shfl_xor(mx, o, 64));
  const float sink = p.in[20][l * 8 + hq];
  mx = fmaxf(mx, sink);
  float sum = 0.f;
#pragma unroll
  for (int jj = 0; jj < 5; ++jj) { sc[jj] = __expf(sc[jj] - mx); sum += sc[jj]; }
#pragma unroll
  for (int o = 16; o >= 1; o >>= 1) sum += __shfl_xor(sum, o, 64);
  const float rden = 1.f / (sum + __expf(sink - mx));
#pragma unroll
  for (int jj = 0; jj < 5; ++jj) { const int j = jl + 32 * jj; if (j < 136) Pl[row * 136 + j] = sc[jj] * rden; }
  __syncthreads();
  {
    const int d = jl * 2;
    float o0 = 0.f, o1 = 0.f;
#pragma unroll 4
    for (int j = 0; j < 132; ++j) { const float pr = Pl[row * 136 + j]; o0 += pr * Vl[j * 65 + d]; o1 += pr * Vl[j * 65 + d + 1]; }
    if (!dry) *(unsigned*)(z + (size_t)(M_P + b * 4 + t) * ZLD + 1792 + hq * 64 + d) = pack2(o0, o1);
  }
}

__device__ __forceinline__ void phase_convgelu(const Params& p, int l, bool dry = false) {
  u16* cu = (u16*)(p.ws + WS_CU);
  const float* cw = p.in[26] + (size_t)l * 3 * 2816;
  const float* cb = p.in[27] + (size_t)l * 2816;
  for (int it = blockIdx.x; it < 2112; it += gridDim.x) {
    const int tid = opq(threadIdx.x);
    if (tid >= 352) continue;
    const int j0 = tid * 8;
    float w0[8], w1[8], w2[8], bb[8];
#pragma unroll
    for (int i = 0; i < 8; ++i) { w0[i] = cw[j0 + i]; w1[i] = cw[2816 + j0 + i]; w2[i] = cw[5632 + j0 + i]; bb[i] = cb[j0 + i]; }
    float c1[8], c2[8];
    for (int rr = 0; rr < 8; ++rr) {
      const int row = it * 8 + rr;
      const bool prompt = row < M_P;
      int b, t;
      if (prompt) { b = row >> 13; t = row & 8191; } else { b = (row - M_P) >> 2; t = (row - M_P) & 3; }
      if (t == 0) {
        if (prompt) {
#pragma unroll
          for (int i = 0; i < 8; ++i) { c1[i] = 0.f; c2[i] = 0.f; }
        } else {
          const float* st = p.in[6] + (size_t)((l * 128 + b) * 2) * 2816 + j0;
#pragma unroll
          for (int i = 0; i < 8; ++i) { c2[i] = st[i]; c1[i] = st[2816 + i]; }
        }
      } else if (rr == 0) {
        unpack8(*(const uint4*)(cu + (size_t)(row - 1) * 5632 + j0), c1);
        if (t >= 2) unpack8(*(const uint4*)(cu + (size_t)(row - 2) * 5632 + j0), c2);
        else {
#pragma unroll
          for (int i = 0; i < 8; ++i) c2[i] = 0.f;
        }
      }
      float c0[8], up[8], a[8];
      unpack8(*(const uint4*)(cu + (size_t)row * 5632 + j0), c0);
      unpack8(*(const uint4*)(cu + (size_t)row * 5632 + 2816 + j0), up);
#pragma unroll
      for (int i = 0; i < 8; ++i) {
        const float cv = bb[i] + w0[i] * c2[i] + w1[i] * c1[i] + w2[i] * c0[i];
        a[i] = gelu_fast(cv) * up[i];
      }
      if (!dry) *(uint4*)(cu + (size_t)row * 5632 + 2816 + j0) = pack8(a);
      if (prompt && t >= 8190) {
        float* o = p.out + O_PCONV + (size_t)((l * 2 + b) * 2 + (t - 8190)) * 2816 + j0;
        *(float4*)o = make_float4(c0[0], c0[1], c0[2], c0[3]); *(float4*)(o + 4) = make_float4(c0[4], c0[5], c0[6], c0[7]);
      } else if (!prompt && t >= 2) {
        float* o = p.out + O_SCONV + (size_t)((l * 128 + b) * 2 + (t - 2)) * 2816 + j0;
        *(float4*)o = make_float4(c0[0], c0[1], c0[2], c0[3]); *(float4*)(o + 4) = make_float4(c0[4], c0[5], c0[6], c0[7]);
      }
#pragma unroll
      for (int i = 0; i < 8; ++i) { c2[i] = c1[i]; c1[i] = c0[i]; }
    }
  }
}

__device__ __forceinline__ void phase_final(const Params& p) {
  float* X = p.out;
  const float* g = p.in[29];
  for (int it = blockIdx.x; it < 2112; it += gridDim.x) {
    const int tid = opq(threadIdx.x);
    const int lane = tid & 63;
    const int row = it * 8 + (tid >> 6);
    float4 v[4];
    float ss = 0.f;
#pragma unroll
    for (int i = 0; i < 4; ++i) {
      v[i] = *(const float4*)(X + (size_t)row * 1024 + i * 256 + lane * 4);
      if (gridDim.x == 256 && row >= M_P) {
        const u16* partb = (const u16*)(p.ws + WS_DP) + (size_t)(row - M_P) * 1024 + i * 256 + lane * 4;
        for (int k = 0; k < 11; ++k) { const uint2 q = *(const uint2*)(partb + (size_t)k * 512 * 1024);
          v[i].x += __uint_as_float(q.x << 16); v[i].y += __uint_as_float(q.x & 0xFFFF0000u); v[i].z += __uint_as_float(q.y << 16); v[i].w += __uint_as_float(q.y & 0xFFFF0000u); }
      }
      ss += v[i].x * v[i].x + v[i].y * v[i].y + v[i].z * v[i].z + v[i].w * v[i].w;
    }
    ss = wave_sum(ss);
    const float rs = rsqrtf(ss * (1.f / 1024.f) + 1e-6f);
#pragma unroll
    for (int i = 0; i < 4; ++i) {
      const float4 gg = *(const float4*)(g + i * 256 + lane * 4);
      *(float4*)(X + (size_t)row * 1024 + i * 256 + lane * 4) =
          make_float4(v[i].x * rs * gg.x, v[i].y * rs * gg.y, v[i].z * rs * gg.z, v[i].w * rs * gg.w);
    }
  }
}

#define XB_TMO      128
#define XB_XCNT(j)  (256  + 64 * (j))
#define XB_XSUB(j)  (1280 + 64 * (j))
#define XB_XGEN(j)  (2304 + 64 * (j))
#define XB_TOP      3328
#define XB_TOPGEN   3392
#define XCD_BAR_WORDS 3456
#define XB_SPIN_CAP (1u << 18)
#define LAS __attribute__((address_space(3)))

__device__ __forceinline__ unsigned xb_ld(unsigned* p)              { return __hip_atomic_load(p, __ATOMIC_RELAXED, __HIP_MEMORY_SCOPE_AGENT); }
__device__ __forceinline__ unsigned xb_add(unsigned* p, unsigned v) { return __hip_atomic_fetch_add(p, v, __ATOMIC_RELAXED, __HIP_MEMORY_SCOPE_AGENT); }
__device__ __forceinline__ unsigned xb_xcc_id() { return (unsigned)__builtin_amdgcn_s_getreg((3 << 11) | 20) & 0xFu; }
#define XB_SPIN(cond, bar) do { unsigned _sp = 0; while (cond) { __builtin_amdgcn_s_sleep(1); \
    if ((++_sp & 255u) == 0u) { if (xb_ld(&(bar)[XB_TMO])) break; if (_sp > XB_SPIN_CAP) { atomicAdd(&(bar)[XB_TMO], 1u); break; } } } } while (0)

struct XcdBarrier {
    unsigned* bar; unsigned x;
    volatile LAS unsigned* st;
};

__device__ __forceinline__ XcdBarrier xcd_barrier_post(unsigned* bar, volatile LAS unsigned* st) {
    XcdBarrier b; b.bar = bar; b.x = xb_xcc_id(); b.st = st;
    if (threadIdx.x == 0) (void)xb_add(&bar[XB_XCNT(b.x)], 1u);
    return b;
}
__device__ __forceinline__ void xcd_barrier_complete(unsigned* bar, unsigned x, unsigned& nloc, unsigned& nx) {
    const unsigned G = gridDim.x * gridDim.y * gridDim.z;
    unsigned sum, cnt, mine, sp = 0u;
    for (;;) {
        sum = 0u; cnt = 0u; mine = 0u;
#pragma unroll
        for (unsigned j = 0; j < 16; ++j) { const unsigned c = xb_ld(&bar[XB_XCNT(j)]); sum += c; cnt += (c > 0u) ? 1u : 0u; mine = (j == x) ? c : mine; }
        if (sum == G) break;
        __builtin_amdgcn_s_sleep(1);
        if ((++sp & 255u) == 0u) { if (xb_ld(&bar[XB_TMO])) break; if (sp > XB_SPIN_CAP) { atomicAdd(&bar[XB_TMO], 1u); break; } }
    }
    nloc = mine > 0u ? mine : 1u; nx = cnt > 0u ? cnt : 1u;
}

__device__ __forceinline__ void xcd_barrier(const XcdBarrier& b) {
    asm volatile("s_waitcnt vmcnt(0)" ::: "memory");
    __syncthreads();
    if (threadIdx.x == 0) {
        unsigned* bar = b.bar;
        __builtin_amdgcn_s_waitcnt(0);
        unsigned nloc = b.st[0], nx = b.st[1];
        if (nloc == 0u) { xcd_barrier_complete(bar, b.x, nloc, nx); b.st[0] = nloc; b.st[1] = nx; }
        const unsigned old = xb_add(&bar[XB_XSUB(b.x)], 1u);
        const unsigned gen = old / nloc;
        if (old + 1u == (gen + 1u) * nloc) {
            __builtin_amdgcn_fence(__ATOMIC_RELEASE, "agent");
            asm volatile("s_waitcnt vmcnt(0)" ::: "memory");
            const unsigned og = xb_add(&bar[XB_TOP], 1u);
            const unsigned tg = og / nx;
            if (og + 1u == (tg + 1u) * nx) xb_add(&bar[XB_TOPGEN], 1u);
            else XB_SPIN(xb_ld(&bar[XB_TOPGEN]) == tg, bar);
            __builtin_amdgcn_fence(__ATOMIC_ACQUIRE, "agent");
            xb_add(&bar[XB_XGEN(b.x)], 1u);
            asm volatile("s_waitcnt vmcnt(0)" ::: "memory");
        } else {
            XB_SPIN(xb_ld(&bar[XB_XGEN(b.x)]) == gen, bar);
            __builtin_amdgcn_fence(__ATOMIC_ACQUIRE, "agent");
            asm volatile("s_waitcnt vmcnt(0)" ::: "memory");
        }
    }
    __syncthreads();
}

#define WS_BAR 256000000ull
#if COOP
#ifndef SYNC_RPT
#define SYNC_RPT 1
#endif
#define PH_SYNC(idx) do { if ((idx) + 1 < ph_hi && (idx) >= ph_lo) { for (int sr_ = 0; sr_ < SYNC_RPT; ++sr_) xcd_barrier(xb); } } while (0)
#else
#define PH_SYNC(idx) do { } while (0)
#endif
#define PH_ON(idx, bit) (((KMASK >> (bit)) & 1) && ph_lo <= (idx) && (idx) < ph_hi)

__device__ __forceinline__ Params load_params() {
  auto kp0 = __builtin_amdgcn_kernarg_segment_ptr();
  asm volatile("" : "+s"(kp0));
  auto kq = (const __constant__ unsigned long long*)kp0;
  Params p;
#pragma unroll
  for (int i = 0; i < 30; ++i) p.in[i] = (const float*)kq[i];
  p.out = (float*)kq[30];
  p.ws = (unsigned char*)kq[31];
  p.ph_lo = 0; p.ph_hi = 0;
  return p;
}

template <int KMASK, int l>
__device__ __forceinline__ void layer_phases(int ph_lo, int ph_hi, unsigned char* lds_raw, const XcdBarrier& xb) {
  float* ldsf = (float*)lds_raw;
  u16* ldsh = (u16*)lds_raw;
  const int base = l * 12;
  if (PH_ON(base + 0, 0)) { const Params p = load_params(); RPT(0) phase_prep(p, l, 0, ldsf); }
  PH_SYNC(base + 0);
  if (PH_ON(base + 1, 1)) {
    const Params p = load_params();
    EpiInproj E; E.z = (u16*)(p.ws + WS_Z); E.out = p.out; E.l = l;
    RPT(1) run_gemm(lds_raw, (const u16*)(p.ws + WS_H), 1024, (const u16*)(p.ws + WS_WT) + WT_IN, 2560, 1024, E);
  }
  PH_SYNC(base + 1);
  if (PH_ON(base + 2, 2)) {
    const Params p = load_params();
    if (gridDim.x == 256) {
      if (blockIdx.x >= 64) for (int it = (int)blockIdx.x - 64; it < 264; it += 192) rope_item(p, l, it, false);
    } else {
      for (int it = blockIdx.x; it < 264; it += gridDim.x) rope_item(p, l, it, false);
    }
    if (blockIdx.x < 64) rwkv_item(p, l, 2048 + blockIdx.x, ldsf, false);
    {
      const Params p2 = load_params();
      int i0, n;
      if (gridDim.x == 256) { if (blockIdx.x < 64) { i0 = blockIdx.x * 5; n = 5; } else { i0 = 320 + (blockIdx.x - 64) * 9; n = 9; } }
      else { i0 = 0; n = 0; }
      RPT(2) {
        if (gridDim.x == 256) { for (int i = 0; i < n; ++i) rwkv_item2(p2, l, i0 + i, ldsf); }
        else { for (int it = blockIdx.x; it < 2048; it += gridDim.x) rwkv_item2(p2, l, it, ldsf); }
      }
    }
  }
  PH_SYNC(base + 2);
  if (PH_ON(base + 3, 3)) {
    const Params p = load_params();
    if (blockIdx.x < 16) { RPT(3) rwkv_scan(p, l, blockIdx.x, ldsf, DRY(3)); }
    else {
      RPT(15) for (int it = blockIdx.x - 16; it < 512; it += gridDim.x - 16) {
        if (it < 256) attn_prompt(p, l, it, ldsh, DRY(15)); else attn_sample(p, l, it - 256, ldsf, DRY(15));
      }
      if (gridDim.x == 256 && blockIdx.x < 32) {
        EpiSig Es; Es.sr = (u16*)(p.ws + WS_SG); Es.sa = (u16*)(p.ws + WS_SG) + (size_t)512 * 1024;
        run_gemm_ex(lds_raw, (const u16*)(p.ws + WS_H) + (size_t)M_P * 1024, 1024, (const u16*)(p.ws + WS_WT) + WT_G, 1024, 512, 2048, 1024, 16,
                    (int)blockIdx.x - 16, Es);
      }
    }
  }
  PH_SYNC(base + 3);
  if (PH_ON(base + 4, 4)) {
    const Params p = load_params();
    RPT(4) for (int it = blockIdx.x * 4; it < 2048; it += gridDim.x * 4) rwkv_out4(p, l, it, ldsf);
  }
  PH_SYNC(base + 4);
  if (PH_ON(base + 5, 5)) {
    const Params p = load_params();
    EpiStoreBf16 E1; E1.O = (u16*)(p.ws + WS_T1); E1.ldc = 1024; E1.rowoff = 0;
    EpiStoreBf16 E2; E2.O = (u16*)(p.ws + WS_T2); E2.ldc = 1024; E2.rowoff = 0;
    const u16* zA = (const u16*)(p.ws + WS_Z);
    const u16* Wr = (const u16*)(p.ws + WS_WT) + WT_BRA;
    const u16* Wa = (const u16*)(p.ws + WS_WT) + WT_BRB;
    RPT(5) {
      if (gridDim.x == 256) {
        run_gemm_ex(lds_raw, zA, ZLD, Wr, 512, M_P, 1024, 512, 256, (int)blockIdx.x, E1);
        run_gemm_ex(lds_raw, zA + 1792, ZLD, Wa, 512, M_P, 1024, 512, 256, (int)blockIdx.x, E2);
        const int wh = (blockIdx.x >> 3) & 1, ks = (blockIdx.x >> 4) & 1;
        EpiStoreBf16 E3; E3.ldc = 1024; E3.rowoff = 0; E3.O = (u16*)(p.ws + WS_SG) + (size_t)(2 + wh * 2 + ks) * 512 * 1024;
        run_gemm_ex(lds_raw, zA + (size_t)M_P * ZLD + (wh ? 1792 : 0) + ks * 256, ZLD, (wh ? Wa : Wr) + ks * 256, 512, 512, 1024, 256, 8,
                    (blockIdx.x < 32) ? (int)(blockIdx.x & 7) : -1, E3);

      } else {
        run_gemm(lds_raw, zA, ZLD, Wr, 1024, 512, E1);
        run_gemm(lds_raw, zA + 1792, ZLD, Wa, 1024, 512, E2);
      }
    }
  }
  PH_SYNC(base + 5);
  if (PH_ON(base + 6, 6)) {
    const Params p = load_params();
    EpiMerge E; E.t1 = (const u16*)(p.ws + WS_T1); E.t2 = (const u16*)(p.ws + WS_T2); E.mg = (u16*)(p.ws + WS_MG);
    RPT(6) {
      if (gridDim.x == 256) {
        run_gemm_ex(lds_raw, (const u16*)(p.ws + WS_H), 1024, (const u16*)(p.ws + WS_WT) + WT_G, 1024, M_P, 2048, 1024, 256, (int)blockIdx.x, E);
        const int gid = blockIdx.x * NT + opq(threadIdx.x);
        if (gid < 65536) {
          const int r_ = gid >> 7, c_ = (gid & 127) * 8;
          const size_t offs = (size_t)r_ * 1024 + c_, offm = (size_t)(M_P + r_) * 1024 + c_;
          float a[8], b[8], gr[8], ga[8], o[8];
          {
            const u16* pb = (const u16*)(p.ws + WS_SG) + (size_t)2 * 512 * 1024 + offs;
            float a1[8], b1[8];
            unpack8(*(const uint4*)pb, a); unpack8(*(const uint4*)(pb + (size_t)512 * 1024), a1);
            unpack8(*(const uint4*)(pb + (size_t)2 * 512 * 1024), b); unpack8(*(const uint4*)(pb + (size_t)3 * 512 * 1024), b1);
#pragma unroll
            for (int i = 0; i < 8; ++i) { a[i] += a1[i]; b[i] += b1[i]; }
          }
          unpack8(*(const uint4*)((const u16*)(p.ws + WS_SG) + offs), gr);
          unpack8(*(const uint4*)((const u16*)(p.ws + WS_SG) + (size_t)512 * 1024 + offs), ga);
#pragma unroll
          for (int i = 0; i < 8; ++i) o[i] = gr[i] * a[i] + ga[i] * b[i];
          *(uint4*)(E.mg + offm) = pack8(o);
        }
      } else {
        run_gemm(lds_raw, (const u16*)(p.ws + WS_H), 1024, (const u16*)(p.ws + WS_WT) + WT_G, 2048, 1024, E);
      }
    }
  }
  PH_SYNC(base + 6);
  if (PH_ON(base + 7, 7)) {
    const Params p = load_params();
    EpiResid E; E.X = p.out;
    RPT(7) {
      E.dry = DRY(7); E.X = p.out; E.pbf = nullptr;
      if (gridDim.x == 256) {
        E.atomic = false; E.rowoff = 0;
        run_gemm_ex(lds_raw, (const u16*)(p.ws + WS_MG), 1024, (const u16*)(p.ws + WS_WT) + WT_OUT, 1024, M_P, 1024, 1024, 256, (int)blockIdx.x, E);
        const int ks = blockIdx.x >> 3;
        E.atomic = true; E.rowoff = 0; E.X = (float*)(p.ws + WS_T1) + (size_t)ks * 512 * 1024;
        run_gemm_ex(lds_raw, (const u16*)(p.ws + WS_MG) + (size_t)M_P * 1024 + ks * 256, 1024, (const u16*)(p.ws + WS_WT) + WT_OUT + ks * 256, 1024,
                    512, 1024, 256, 8, (blockIdx.x < 32) ? (int)(blockIdx.x & 7) : -1, E);
      } else {
        E.atomic = false; E.rowoff = 0;
        run_gemm(lds_raw, (const u16*)(p.ws + WS_MG), 1024, (const u16*)(p.ws + WS_WT) + WT_OUT, 1024, 1024, E);
      }
    }
  }
  PH_SYNC(base + 7);
  if (PH_ON(base + 8, 8)) { const Params p = load_params(); RPT(8) phase_prep(p, l, 1, ldsf); }
  PH_SYNC(base + 8);
  if (PH_ON(base + 9, 9)) {
    const Params p = load_params();
    EpiFfnIn E; E.cu = (u16*)(p.ws + WS_CU);
    RPT(9) run_gemm(lds_raw, (const u16*)(p.ws + WS_H), 1024, (const u16*)(p.ws + WS_WTF) + WT_FIN, 5632, 1024, E);
  }
  PH_SYNC(base + 9);
  if (PH_ON(base + 10, 10)) { const Params p = load_params(); RPT(10) phase_convgelu(p, l, DRY(10)); }
  PH_SYNC(base + 10);
  if (PH_ON(base + 11, 11)) {
    const Params p = load_params();
    EpiResid E; E.X = p.out;
    RPT(11) {
      E.dry = DRY(11); E.X = p.out; E.pbf = nullptr;
      const u16* Aa = (const u16*)(p.ws + WS_CU) + 2816;
      const u16* Bd = (const u16*)(p.ws + WS_WTF) + WT_FDN;
      if (gridDim.x == 256) {
        E.atomic = false; E.rowoff = 0;
        run_gemm_ex(lds_raw, Aa, 5632, Bd, 2816, M_P, 1024, 2816, 256, (int)blockIdx.x, E);
        const int ks = blockIdx.x >> 3;
        E.atomic = true; E.rowoff = 0; E.X = nullptr; E.pbf = (u16*)(p.ws + WS_DP) + (size_t)ks * 512 * 1024;
        run_gemm_ex(lds_raw, Aa + (size_t)M_P * 5632 + ks * 256, 5632, Bd + ks * 256, 2816, 512, 1024, 256, 8, (blockIdx.x < 88) ? (int)(blockIdx.x & 7) : -1, E);
      } else {
        E.atomic = false; E.rowoff = 0;
        run_gemm(lds_raw, Aa, 5632, Bd, 1024, 2816, E);
      }
    }
  }
  PH_SYNC(base + 11);
}

template <int KMASK>
__global__ void __launch_bounds__(NT) fwd_kernel(Params pin) {
  extern __shared__ __attribute__((aligned(16))) unsigned char lds_raw[];
  const int ph_lo = pin.ph_lo, ph_hi = pin.ph_hi;
  XcdBarrier xb;
  {
    volatile LAS unsigned* st = (volatile LAS unsigned*)(lds_raw + (LDS_BYTES - 16));
    if (threadIdx.x < 2) st[threadIdx.x] = 0u;
    __syncthreads();
    xb = xcd_barrier_post((unsigned*)(pin.ws + WS_BAR), st);
  }
  if (ph_hi > 100000) cg::this_grid().sync();
  layer_phases<KMASK, 0>(ph_lo, ph_hi, lds_raw, xb);
  layer_phases<KMASK, 1>(ph_lo, ph_hi, lds_raw, xb);
  if (PH_ON(NPH - 1, 12)) { const Params p = load_params(); phase_final(p); }
}

extern "C" void kernel_launch(void* const* d_in, const int* in_sizes, int n_in, void* d_out, int out_size, void* d_ws,
                              size_t ws_size, hipStream_t stream) {
  static int grid = 0;
  if (grid == 0) {
    int dev = 0, cus = 0;
    (void)hipGetDevice(&dev);
    (void)hipDeviceGetAttribute(&cus, hipDeviceAttributeMultiprocessorCount, dev);
    grid = cus > 0 ? cus : 256;
    (void)hipFuncSetAttribute((const void*)fwd_kernel<PHMASK>, hipFuncAttributeMaxDynamicSharedMemorySize, LDS_BYTES);
    (void)hipGetLastError();
  }
  Params p{};
  for (int i = 0; i < 30; ++i) p.in[i] = (const float*)d_in[i];
  p.out = (float*)d_out;
  p.ws = (unsigned char*)d_ws;
#if COOP
  (void)hipMemsetAsync((unsigned char*)d_ws + WS_BAR, 0, XCD_BAR_WORDS * 4, stream);
  p.ph_lo = 0; p.ph_hi = NPH;
  void* args[] = {&p};
  hipError_t e = hipLaunchCooperativeKernel((const void*)fwd_kernel<PHMASK>, dim3(grid), dim3(NT), args, LDS_BYTES, stream);
  if (e != hipSuccess) fprintf(stderr, "cooperative launch failed: %s (grid %d)\n", hipGetErrorString(e), grid);
#else
  for (int ph = 0; ph < NPH; ++ph) {
    p.ph_lo = ph; p.ph_hi = ph + 1;
    hipLaunchKernelGGL(fwd_kernel<PHMASK>, dim3(grid), dim3(NT), LDS_BYTES, stream, p);
  }
#endif
}
```

```cpp
#include <hip/hip_runtime.h>
#include <hip/hip_bf16.h>
#include <hip/hip_cooperative_groups.h>
#include <cstdio>
namespace cg = cooperative_groups;

typedef __attribute__((ext_vector_type(8))) short bf16x8;
typedef __attribute__((ext_vector_type(16))) float f32x16;
typedef unsigned short u16;

#ifndef PHMASK
#define PHMASK 0x1FFF
#endif
#ifndef T3
#define T3 7
#endif
#ifndef P2SEL
#define P2SEL 7
#endif
#ifndef RPT_MASK
#define RPT_MASK 0
#endif
#ifndef RPT_N
#define RPT_N 1
#endif
#define RPT(bit) for (int rp_ = 0; rp_ < (((RPT_MASK >> (bit)) & 1) ? 1 + RPT_N : 1); ++rp_)
#define RPT_CNT(bit) (((RPT_MASK >> (bit)) & 1) ? 1 + RPT_N : 1)
#define DRY(bit) (opq(rp_) + 1 < RPT_CNT(bit))
#ifndef R1P
#define R1P 1
#endif
#ifndef COOP
#define COOP 1
#endif

#define NT 512
#define M_TOT 16896
#define M_P 16384
#define ZLD 2560
#define NPH 25

#define WS_WT   0ull
#define WS_H    13631488ull
#define WS_Z    48234496ull
#define WS_R    134742016ull
#define WS_PP   (WS_R)
#define WS_GC   (WS_R + 16777216ull)
#define WS_Q    (WS_R + 17301504ull)
#define WS_W2   (WS_R + 50855936ull)
#define WS_YL   (WS_R + 67633152ull)
#define WS_BO   (WS_R + 84410368ull)
#define WS_GA   (WS_R + 101187584ull)
#define WS_T1   (WS_R)
#define WS_T2   (WS_R + 34603008ull)
#define WS_MG   (WS_R + 69206016ull)
#define WS_SG   256100096ull
#define WS_WTF  (WS_Z)
#define WS_CU   (WS_Z + 17301504ull)
#define WS_LW  267634432ull
#define WS_DP  256100096ull
#define WT_IN  0
#define WT_G   2621440
#define WT_BRA 4718592
#define WT_BRB 5242880
#define WT_OUT 5767168
#define WT_FIN 0
#define WT_FDN 5767168
#define O_PSHIFT 17301504
#define O_PWKV   17308672
#define O_PK     17439744
#define O_PV     17505280
#define O_PCONV  17570816
#define O_SSHIFT 17593344
#define O_SWKV   18052096
#define O_SK     26440704
#define O_SV     30635008
#define O_SCONV  34829312

#define LDS_BYTES 151552

struct Params {
  const float* in[30];
  float* out;
  unsigned char* ws;
  int ph_lo, ph_hi;
};

typedef float f2v_ __attribute__((ext_vector_type(2)));
typedef __bf16 b2v_ __attribute__((ext_vector_type(2)));
__device__ __forceinline__ unsigned pack2(float a, float b) { f2v_ v = {a, b}; b2v_ r = __builtin_convertvector(v, b2v_); return __builtin_bit_cast(unsigned, r); }
__device__ __forceinline__ u16 f2bf(float f) { return (u16)(pack2(f, f) & 0xFFFFu); }
__device__ __forceinline__ float bf2f(u16 h) { return __uint_as_float(((unsigned)h) << 16); }
__device__ __forceinline__ float sigm(float x) { return __builtin_amdgcn_rcpf(1.f + __expf(-x)); }
__device__ __forceinline__ void unpack8(uint4 u, float* o) {
  o[0] = __uint_as_float(u.x << 16); o[1] = __uint_as_float(u.x & 0xFFFF0000u);
  o[2] = __uint_as_float(u.y << 16); o[3] = __uint_as_float(u.y & 0xFFFF0000u);
  o[4] = __uint_as_float(u.z << 16); o[5] = __uint_as_float(u.z & 0xFFFF0000u);
  o[6] = __uint_as_float(u.w << 16); o[7] = __uint_as_float(u.w & 0xFFFF0000u);
}
__device__ __forceinline__ uint4 pack8(const float* f) {
  uint4 u; u.x = pack2(f[0], f[1]); u.y = pack2(f[2], f[3]); u.z = pack2(f[4], f[5]); u.w = pack2(f[6], f[7]); return u;
}
__device__ __forceinline__ float gelu_fast(float v) {
  const float av = fabsf(v), d = av * 0.2316418882f + 1.0f;
  const float t = __builtin_amdgcn_rcpf(d);
  float q = t * 0.5307027145f + (-0.7265760135f); q = q * t + 0.7107068705f; q = q * t + (-0.142248368f); q = q * t + 0.127414796f; q = q * t;
  const float e = __builtin_amdgcn_exp2f((v * v) * (-0.72134752044f));
  const float m = v * (q * e);
  return v < 0.f ? m : v - m;
}
__device__ __forceinline__ int opq(int x) { asm volatile("" : "+v"(x)); return x; }
__device__ __forceinline__ float wave_sum(float x) {
#pragma unroll
  for (int o = 32; o >= 1; o >>= 1) x += __shfl_xor(x, o, 64);
  return x;
}

namespace pg8 {
#define PG8_LAS __attribute__((address_space(3)))
typedef unsigned short bf16_t;
typedef short bf16x8 __attribute__((ext_vector_type(8)));
typedef float f32x4 __attribute__((ext_vector_type(4)));
typedef unsigned u32x4 __attribute__((ext_vector_type(4)));
constexpr int BM = 256, BK = 64, HALF = 128, HTB = HALF * BK * 2  , STAGE_BYTES = 8 * HTB, NXCD = 8, WGM = 8;
__host__ __device__ __forceinline__ int lds_byte(int r, int c) { const int st = (r >> 4) * 2 + (c >> 5), rr = r & 15, cc = c & 31, ob = rr * 64 + cc * 2; return st * 1024 + (ob ^ (((ob >> 9) & 1) << 5)); }
__host__ __device__ __forceinline__ void stage_rc(int b, int& R, int& C) { const int st = b / 1024, sb = b % 1024, swz = sb ^ (((sb >> 9) & 1) << 5); R = (st >> 1) * 16 + swz / 64; C = (st & 1) * 32 + (swz % 64) / 2; }
__host__ __device__ __forceinline__ int perm32(int rho) { const int n = rho >> 4, i = rho & 15; return 8 * (i >> 2) + 4 * n + (i & 3); }
struct Unit { int pm, pn; };
struct Gemm { const bf16_t* A; const bf16_t* Bt; int M, N, K, lda, ldb; };
struct StaticOrder {
    int nM, nN, nwg, G, c;
    __host__ __device__ void init(int M, int N, int G_, int c_) { nM = M / BM; nN = N / BM; nwg = nM * nN; G = G_; c = c_; }
    __host__ __device__ bool next(int i, Unit& u) const {
        const long L = (long)i * G + c; if (L >= nwg) return false;
        int wgid = (int)L; { const int q = nwg / NXCD, r = nwg % NXCD, xcd = wgid % NXCD, off = wgid / NXCD; wgid = (xcd < r ? xcd * (q + 1) : r * (q + 1) + (xcd - r) * q) + off; }
        const int nig = WGM * nN, gid = wgid / nig, fm = gid * WGM, gsz = (nM - fm) < WGM ? (nM - fm) : WGM;
        u.pm = fm + ((wgid % nig) % gsz); u.pn = (wgid % nig) / gsz; return true;
    }
    __device__ __forceinline__ void a_ready(const Unit&) const {}
    __device__ __forceinline__ void done(const Unit&) const {}
};
__device__ __forceinline__ unsigned cvt_pk_bf16(float lo, float hi) { return ::pack2(lo, hi); }
template <class Epi, class Sched, bool STAMP = false>
__device__ __forceinline__ void gemm_phase(PG8_LAS unsigned char* lds, const Gemm g, const Sched& S, const Epi& E, unsigned long long* stamps) {
    const int tid = ::opq(threadIdx.x), wid = __builtin_amdgcn_readfirstlane(tid >> 6), lane = tid & 63, wr = wid >> 2, wc = wid & 3, fr = lane & 15, fq = lane >> 4;
    const int K = g.K, nt = K / BK;
    int ts_lo = 0, ts_hi = 0, nts = 0; const unsigned long long rt_entry = 0ull;
#define PG8_STAMP() do { if (STAMP && wid == 0 && nts < 64) { const unsigned long long _c = (unsigned long long)clock64(); \
        ts_lo = (lane == nts) ? (int)(unsigned)_c : ts_lo; ts_hi = (lane == nts) ? (int)(unsigned)(_c >> 32) : ts_hi; ++nts; } } while (0)
    PG8_STAMP();
    unsigned voffA[2], voffB[2];
#pragma unroll
    for (int i = 0; i < 2; ++i) { int R, C; stage_rc(tid * 16 + i * 8192, R, C); const int Rb = Epi::PERM ? ((R & ~31) + perm32(R & 31)) : R;
        voffA[i] = (unsigned)(R * g.lda + C) * 2u; voffB[i] = (unsigned)(Rb * g.ldb + C) * 2u; }
    const size_t kstep = (size_t)(BK * 2);
    const size_t hstep = (size_t)HALF * g.ldb * 2;
    const size_t tstep = 2 * hstep; const size_t hstepA = (size_t)HALF * g.lda * 2; const size_t tstepA = 2 * hstepA;
    const unsigned ldsw = (unsigned)wid * 1024u;
    const int aoff = lds_byte(wr * 64 + fr, fq * 8), boff = lds_byte(wc * 32 + fr, fq * 8);
#define PG8_SA(b, h) (((b) * 2 + (h)) * HTB)
#define PG8_SB(b, h) ((4 + (b) * 2 + (h)) * HTB)
#define PG8_STAGE(bufoff, gbase, voff) do { _Pragma("unroll") for (int _i = 0; _i < 2; ++_i) \
        __builtin_amdgcn_global_load_lds((const unsigned*)((const char*)(gbase) + (voff)[_i]), (PG8_LAS unsigned*)(lds + (bufoff) + ldsw + _i * 8192), 16, 0, 0); } while (0)
#define PG8_LDA(dst, b, h) do { _Pragma("unroll") for (int m = 0; m < 4; ++m) _Pragma("unroll") for (int k = 0; k < 2; ++k) dst[m][k] = *(const PG8_LAS bf16x8*)(lds + PG8_SA(b, h) + aoff + m * 2048 + k * 1024); } while (0)
#define PG8_LDB(dst, b, h) do { _Pragma("unroll") for (int n = 0; n < 2; ++n) _Pragma("unroll") for (int k = 0; k < 2; ++k) dst[n][k] = *(const PG8_LAS bf16x8*)(lds + PG8_SB(b, h) + boff + n * 2048 + k * 1024); } while (0)
#define PG8_MMA(ai, bj, At, Bt) do { __builtin_amdgcn_s_setprio(1); _Pragma("unroll") for (int m = 0; m < 4; ++m) _Pragma("unroll") for (int n = 0; n < 2; ++n) _Pragma("unroll") for (int k = 0; k < 2; ++k) \
        acc[ai][bj][m][n] = __builtin_amdgcn_mfma_f32_16x16x32_bf16(Bt[n][k], At[m][k], acc[ai][bj][m][n], 0, 0, 0); __builtin_amdgcn_s_setprio(0); } while (0)
#define PG8_WAIT_V(n) asm volatile("s_waitcnt vmcnt(" #n ")" ::: "memory")
#define PG8_WAIT_L(n) asm volatile("s_waitcnt lgkmcnt(" #n ")" ::: "memory")
#define PG8_BAR __builtin_amdgcn_s_barrier()
#define PG8_SCHED __builtin_amdgcn_sched_barrier(0)
    Unit cur, nxt; int ui = 0;
    if (!S.next(0, cur)) return;
    f32x4 acc[2][2][4][2];
#pragma unroll
    for (int a = 0; a < 2; ++a)
#pragma unroll
        for (int b = 0; b < 2; ++b)
#pragma unroll
            for (int m = 0; m < 4; ++m)
#pragma unroll
                for (int n = 0; n < 2; ++n) acc[a][b][m][n] = (f32x4){0.f, 0.f, 0.f, 0.f};
    bf16x8 At[4][2], B0[2][2], B1[2][2];
    const char* cA = (const char*)g.A + (size_t)cur.pm * tstepA; const char* cB = (const char*)g.Bt + (size_t)cur.pn * tstep;
    S.a_ready(cur);
    PG8_STAGE(PG8_SB(0, 0), cB, voffB); PG8_STAGE(PG8_SA(0, 0), cA, voffA); PG8_STAGE(PG8_SB(0, 1), cB + hstep, voffB); PG8_STAGE(PG8_SA(0, 1), cA + hstepA, voffA);
    if (wr == 1) PG8_BAR;
    PG8_WAIT_V(4); PG8_BAR;
    PG8_STAGE(PG8_SB(1, 0), cB + kstep, voffB); PG8_STAGE(PG8_SA(1, 0), cA + kstep, voffA); PG8_STAGE(PG8_SB(1, 1), cB + hstep + kstep, voffB);
    PG8_WAIT_V(6); PG8_BAR;
    PG8_STAMP();
    for (;;) {
        const bool has_next = S.next(ui + 1, nxt);
        const char* nA = has_next ? (const char*)g.A + (size_t)nxt.pm * tstepA : cA; const char* nB = has_next ? (const char*)g.Bt + (size_t)nxt.pn * tstep : cB;
        for (int t = 0; t < nt; t += 2) {
            const bool last = (t == nt - 2);
            const char* a1 = cA + (size_t)(t + 1) * kstep;
            const char* a2 = last ? nA : cA + (size_t)(t + 2) * kstep; const char* b2 = last ? nB : cB + (size_t)(t + 2) * kstep;
            const char* a3 = a2 + kstep; const char* b3 = b2 + kstep;
            if (last && has_next) S.a_ready(nxt);
            PG8_LDB(B0, 0, 0); PG8_SCHED; PG8_LDA(At, 0, 0); PG8_STAGE(PG8_SA(1, 1), a1 + hstepA, voffA);
            PG8_WAIT_L(8); PG8_BAR; PG8_WAIT_L(0); PG8_MMA(0, 0, At, B0); PG8_BAR; PG8_SCHED;
            PG8_LDB(B1, 0, 1); PG8_STAGE(PG8_SB(0, 0), b2, voffB);
            PG8_BAR; PG8_WAIT_L(0); PG8_MMA(0, 1, At, B1); PG8_BAR;
            PG8_LDA(At, 0, 1); PG8_STAGE(PG8_SA(0, 0), a2, voffA);
            PG8_BAR; PG8_WAIT_L(0); PG8_MMA(1, 0, At, B0); PG8_BAR; PG8_SCHED;
            PG8_STAGE(PG8_SB(0, 1), b2 + hstep, voffB);
            PG8_WAIT_V(6); PG8_BAR; PG8_MMA(1, 1, At, B1); PG8_BAR;
            PG8_LDB(B0, 1, 0); PG8_SCHED; PG8_LDA(At, 1, 0); PG8_STAGE(PG8_SA(0, 1), a2 + hstepA, voffA);
            PG8_WAIT_L(8); PG8_BAR; PG8_WAIT_L(0); PG8_MMA(0, 0, At, B0); PG8_BAR; PG8_SCHED;
            PG8_LDB(B1, 1, 1); PG8_STAGE(PG8_SB(1, 0), b3, voffB);
            PG8_BAR; PG8_WAIT_L(0); PG8_MMA(0, 1, At, B1); PG8_BAR;
            PG8_LDA(At, 1, 1); PG8_STAGE(PG8_SA(1, 0), a3, voffA);
            PG8_BAR; PG8_WAIT_L(0); PG8_MMA(1, 0, At, B0); PG8_BAR; PG8_SCHED;
            PG8_STAGE(PG8_SB(1, 1), b3 + hstep, voffB);
            PG8_WAIT_V(6); PG8_BAR; PG8_MMA(1, 1, At, B1); PG8_BAR;
        }
        PG8_STAMP();
        if constexpr (!Epi::AFTER_DRAIN) { E(acc, cur, wr, wc, fr, fq); S.done(cur); }
        PG8_STAMP();
        if (!has_next) break;
#pragma unroll
        for (int a = 0; a < 2; ++a)
#pragma unroll
            for (int b = 0; b < 2; ++b)
#pragma unroll
                for (int m = 0; m < 4; ++m)
#pragma unroll
                    for (int n = 0; n < 2; ++n) acc[a][b][m][n] = (f32x4){0.f, 0.f, 0.f, 0.f};
        cur = nxt; cA = nA; cB = nB; ++ui;
    }
    PG8_WAIT_V(0);
    if (wr == 0) PG8_BAR;
    PG8_BAR;
    if constexpr (Epi::AFTER_DRAIN) { E.fused(acc, cur, wr, wc, fr, fq, lds, wid, lane); S.done(cur); }
    PG8_STAMP();
    if (STAMP && wid == 0) { stamps[lane] = lane < nts ? (((unsigned long long)(unsigned)ts_hi << 32) | (unsigned)ts_lo) : 0ull;
        if (lane == 62) stamps[62] = rt_entry; if (lane == 63) stamps[63] = (unsigned long long)wall_clock64(); }
#undef PG8_STAMP
#undef PG8_SA
#undef PG8_SB
#undef PG8_STAGE
#undef PG8_LDA
#undef PG8_LDB
#undef PG8_MMA
#undef PG8_WAIT_V
#undef PG8_WAIT_L
#undef PG8_BAR
#undef PG8_SCHED
}
}
using pg8::f32x4;
#define ROWOFF(reg, h) (((reg) & 3) + 8 * ((reg) >> 2) + 4 * (h))

struct CDesc { const float* src; u16* dst; int K, N, k0, n0, sn0; };
__device__ __forceinline__ CDesc conv_desc(const Params& p, int l, int which, int t) {
  CDesc d;
  u16* WtA = (u16*)(p.ws + WS_WT);
  u16* WtF = (u16*)(p.ws + WS_WTF);
  if (which == 0) {
    if (t < 640) { const int tk = t / 40, tn = t % 40; d.src = p.in[8] + (size_t)l * 1024 * 4608; d.K = 1024; d.N = 4608; d.dst = WtA + WT_IN; d.k0 = tk * 64; d.n0 = tn * 64; d.sn0 = tn * 64; }
    else if ((t -= 640) < 512) {
      const int tk = t / 32, tn = t % 32; const int n0 = tn * 64;
      d.src = p.in[8] + (size_t)l * 1024 * 4608; d.K = 1024; d.N = 4608; d.dst = WtA + WT_G; d.k0 = tk * 64; d.n0 = n0;
      d.sn0 = 2560 + ((n0 >> 7) & 1) * 1024 + (n0 >> 8) * 128 + (n0 & 127);
    }
    else if ((t -= 512) < 128) { const int tk = t / 16, tn = t % 16; d.src = p.in[21] + (size_t)l * 512 * 1024; d.K = 512; d.N = 1024; d.dst = WtA + WT_BRA; d.k0 = tk * 64; d.n0 = tn * 64; d.sn0 = tn * 64; }
    else if ((t -= 128) < 128) { const int tk = t / 16, tn = t % 16; d.src = p.in[22] + (size_t)l * 512 * 1024; d.K = 512; d.N = 1024; d.dst = WtA + WT_BRB; d.k0 = tk * 64; d.n0 = tn * 64; d.sn0 = tn * 64; }
    else { t -= 128; const int tk = t / 16, tn = t % 16; d.src = p.in[23] + (size_t)l * 1024 * 1024; d.K = 1024; d.N = 1024; d.dst = WtA + WT_OUT; d.k0 = tk * 64; d.n0 = tn * 64; d.sn0 = tn * 64; }
  } else {
    if (t < 1408) {
      const int tk = t / 88, tn = t % 88; const int n0 = tn * 64;
      d.src = p.in[25] + (size_t)l * 1024 * 5632; d.K = 1024; d.N = 5632; d.dst = WtF + WT_FIN; d.k0 = tk * 64; d.n0 = n0;
      d.sn0 = ((n0 >> 7) & 1) * 2816 + (n0 >> 8) * 128 + (n0 & 127);
    } else { t -= 1408; const int tk = t / 16, tn = t % 16; d.src = p.in[28] + (size_t)l * 2816 * 1024; d.K = 2816; d.N = 1024; d.dst = WtF + WT_FDN; d.k0 = tk * 64; d.n0 = tn * 64; d.sn0 = tn * 64; }
  }
  return d;
}
__device__ __forceinline__ void conv_pair(const CDesc& A, const CDesc& B, float* lds) {
  const int tid = opq(threadIdx.x);
  const int k = tid >> 3, c = (tid & 7) * 8;
  const float* sa = A.src + (size_t)(A.k0 + k) * A.N + A.sn0 + c;
  const float* sb = B.src + (size_t)(B.k0 + k) * B.N + B.sn0 + c;
  const float4 a0 = *(const float4*)sa, a1 = *(const float4*)(sa + 4);
  const float4 b0 = *(const float4*)sb, b1 = *(const float4*)(sb + 4);
  __syncthreads();
  {
    float* d = lds + k * 65 + c;
    d[0] = a0.x; d[1] = a0.y; d[2] = a0.z; d[3] = a0.w; d[4] = a1.x; d[5] = a1.y; d[6] = a1.z; d[7] = a1.w;
    float* e = lds + 4160 + k * 65 + c;
    e[0] = b0.x; e[1] = b0.y; e[2] = b0.z; e[3] = b0.w; e[4] = b1.x; e[5] = b1.y; e[6] = b1.z; e[7] = b1.w;
  }
  __syncthreads();
  {
    const int n = tid >> 3, kk = (tid & 7) * 8;
    float f[8], g[8];
#pragma unroll
    for (int i = 0; i < 8; ++i) { f[i] = lds[(kk + i) * 65 + n]; g[i] = lds[4160 + (kk + i) * 65 + n]; }
    *(uint4*)(A.dst + (size_t)(A.n0 + n) * A.K + A.k0 + kk) = pack8(f);
    *(uint4*)(B.dst + (size_t)(B.n0 + n) * B.K + B.k0 + kk) = pack8(g);
  }
}

__device__ __forceinline__ void phase_prep(const Params& p, int l, int which, float* ldsf) {
  u16* H = (u16*)(p.ws + WS_H);
  float* X = p.out;
  const int nconv = which == 0 ? (640 + 512 + 128 + 128 + 256) : (1408 + 704);
  const float* gw = (which == 0 ? p.in[7] : p.in[24]) + l * 1024;
  for (int it = blockIdx.x * 2; it < nconv; it += gridDim.x * 2) {
    const CDesc A = conv_desc(p, l, which, it), B = conv_desc(p, l, which, it + 1);
    conv_pair(A, B, ldsf);
  }
  if (which == 0) {
    const int hh = (int)gridDim.x - 1 - (int)blockIdx.x;
    if (hh < 8) {
      const int tid = opq(threadIdx.x);
      u16* dst = (u16*)(p.ws + WS_LW) + (size_t)hh * 17920;
      const float* w2 = p.in[11] + (size_t)l * 64 * 512 + hh * 64;
      const float* a2 = p.in[13] + (size_t)l * 64 * 512 + hh * 64;
      const float* g2 = p.in[14] + (size_t)l * 128 * 512 + hh * 64;
      for (int e = tid; e < 4096; e += NT) {
        const int i = e >> 6, j = e & 63;
        dst[j * 72 + i] = f2bf(w2[(size_t)i * 512 + j]);
        dst[4608 + j * 72 + i] = f2bf(a2[(size_t)i * 512 + j]);
      }
      for (int e = tid; e < 8192; e += NT) {
        const int i = e >> 6, j = e & 63;
        dst[9216 + j * 136 + i] = f2bf(g2[(size_t)i * 512 + j]);
      }
    }
  }
  const bool first = (which == 0 && l == 0);
  for (int it = blockIdx.x; it < 1056; it += gridDim.x) {
    const int tid = opq(threadIdx.x);
    const int lane = tid & 63;
    const int rowa = it * 16 + (tid >> 6);
    float4 v[2][4];
#pragma unroll
    for (int rr = 0; rr < 2; ++rr) {
      const int row = rowa + rr * 8;
      const float* src;
      if (first) src = (row < M_P) ? p.in[0] + (size_t)row * 1024 : p.in[1] + (size_t)(row - M_P) * 1024;
      else src = X + (size_t)row * 1024;
#pragma unroll
      for (int i = 0; i < 4; ++i) v[rr][i] = *(const float4*)(src + i * 256 + lane * 4);
    }
#pragma unroll
    for (int rr = 0; rr < 2; ++rr) {
      const int row = rowa + rr * 8;
      const int nsl = (gridDim.x == 256 && row >= M_P && !first) ? (which == 1 ? 4 : 11) : 0;
      const float* part = (const float*)(p.ws + WS_T1) + (size_t)(row - M_P) * 1024;
      const u16* partb = (const u16*)(p.ws + WS_DP) + (size_t)(row - M_P) * 1024;
      float ss = 0.f;
#pragma unroll
      for (int i = 0; i < 4; ++i) {
        for (int k = 0; k < nsl; ++k) {
          if (which == 1) {
            const float4 q = *(const float4*)(part + (size_t)k * 512 * 1024 + i * 256 + lane * 4);
            v[rr][i].x += q.x; v[rr][i].y += q.y; v[rr][i].z += q.z; v[rr][i].w += q.w;
          } else {
            const uint2 q = *(const uint2*)(partb + (size_t)k * 512 * 1024 + i * 256 + lane * 4);
            v[rr][i].x += __uint_as_float(q.x << 16); v[rr][i].y += __uint_as_float(q.x & 0xFFFF0000u); v[rr][i].z += __uint_as_float(q.y << 16); v[rr][i].w += __uint_as_float(q.y & 0xFFFF0000u);
          }
        }
        ss += v[rr][i].x * v[rr][i].x + v[rr][i].y * v[rr][i].y + v[rr][i].z * v[rr][i].z + v[rr][i].w * v[rr][i].w;
        if (first || nsl) *(float4*)(X + (size_t)row * 1024 + i * 256 + lane * 4) = v[rr][i];
      }
      ss = wave_sum(ss);
      const float rs = rsqrtf(ss * (1.f / 1024.f) + 1e-6f);
#pragma unroll
      for (int i = 0; i < 4; ++i) {
        const float4 g = *(const float4*)(gw + i * 256 + lane * 4);
        uint2 o; o.x = pack2(v[rr][i].x * rs * g.x, v[rr][i].y * rs * g.y); o.y = pack2(v[rr][i].z * rs * g.z, v[rr][i].w * rs * g.w);
        *(uint2*)(H + (size_t)row * 1024 + i * 256 + lane * 4) = o;
      }
    }
  }
}

struct EpiInproj {
  static constexpr bool PERM = true, AFTER_DRAIN = false;
  u16* z; float* out; int l;
  __device__ __forceinline__ void operator()(const f32x4 (&acc)[2][2][4][2], const pg8::Unit& u, int wr, int wc, int fr, int fq) const {
    const int row0 = u.pm * 256 + wr * 64 + fr, col0 = u.pn * 256 + wc * 32 + 8 * fq;
#pragma unroll
    for (int ai = 0; ai < 2; ++ai)
#pragma unroll
      for (int m = 0; m < 4; ++m) {
        const int row = row0 + ai * 128 + m * 16;
        u16* rowp = z + (size_t)row * ZLD + col0;
#pragma unroll
        for (int bj = 0; bj < 2; ++bj) {
          const f32x4 v0 = acc[ai][bj][m][0], v1 = acc[ai][bj][m][1];
          pg8::u32x4 w; w.x = pg8::cvt_pk_bf16(v0[0], v0[1]); w.y = pg8::cvt_pk_bf16(v0[2], v0[3]); w.z = pg8::cvt_pk_bf16(v1[0], v1[1]); w.w = pg8::cvt_pk_bf16(v1[2], v1[3]);
          *(pg8::u32x4*)(rowp + bj * 128) = w;
        }
        const bool prompt = row < M_P;
        int b, t;
        if (prompt) { b = row >> 13; t = row & 8191; } else { b = (row - M_P) >> 2; t = (row - M_P) & 3; }
        if (u.pn < 7) {
          if ((prompt && t == 8191) || (!prompt && t == 3)) {
            float* o = out + (prompt ? O_PSHIFT + (size_t)(l * 2 + b) * 1792 : O_SSHIFT + (size_t)(l * 128 + b) * 1792) + col0;
#pragma unroll
            for (int bj = 0; bj < 2; ++bj) { *(f32x4*)(o + bj * 128) = acc[ai][bj][m][0]; *(f32x4*)(o + bj * 128 + 4) = acc[ai][bj][m][1]; }
          }
        } else if (u.pn == 9 && prompt && t >= 8064) {
          const int c = wc * 32 + 8 * fq;
          float* o = out + O_PV + ((size_t)((l * 2 + b) * 128 + (t - 8064)) * 2 + (c >> 6)) * 64 + (c & 63);
          *(f32x4*)o = acc[ai][1][m][0]; *(f32x4*)(o + 4) = acc[ai][1][m][1];
        }
      }
  }
};
struct EpiStoreBf16 {
  static constexpr bool PERM = true, AFTER_DRAIN = false;
  u16* O; int ldc; int rowoff;
  __device__ __forceinline__ void operator()(const f32x4 (&acc)[2][2][4][2], const pg8::Unit& u, int wr, int wc, int fr, int fq) const {
    const int row0 = rowoff + u.pm * 256 + wr * 64 + fr, col0 = u.pn * 256 + wc * 32 + 8 * fq;
#pragma unroll
    for (int ai = 0; ai < 2; ++ai)
#pragma unroll
      for (int m = 0; m < 4; ++m) {
        u16* rowp = O + (size_t)(row0 + ai * 128 + m * 16) * ldc + col0;
#pragma unroll
        for (int bj = 0; bj < 2; ++bj) {
          const f32x4 v0 = acc[ai][bj][m][0], v1 = acc[ai][bj][m][1];
          pg8::u32x4 w; w.x = pg8::cvt_pk_bf16(v0[0], v0[1]); w.y = pg8::cvt_pk_bf16(v0[2], v0[3]); w.z = pg8::cvt_pk_bf16(v1[0], v1[1]); w.w = pg8::cvt_pk_bf16(v1[2], v1[3]);
          *(pg8::u32x4*)(rowp + bj * 128) = w;
        }
      }
  }
};
struct EpiFfnIn {
  static constexpr bool PERM = true, AFTER_DRAIN = false;
  u16* cu;
  __device__ __forceinline__ void operator()(const f32x4 (&acc)[2][2][4][2], const pg8::Unit& u, int wr, int wc, int fr, int fq) const {
    const int row0 = u.pm * 256 + wr * 64 + fr, col0 = u.pn * 128 + wc * 32 + 8 * fq;
#pragma unroll
    for (int ai = 0; ai < 2; ++ai)
#pragma unroll
      for (int m = 0; m < 4; ++m) {
        u16* rowp = cu + (size_t)(row0 + ai * 128 + m * 16) * 5632 + col0;
#pragma unroll
        for (int bj = 0; bj < 2; ++bj) {
          const f32x4 v0 = acc[ai][bj][m][0], v1 = acc[ai][bj][m][1];
          pg8::u32x4 w; w.x = pg8::cvt_pk_bf16(v0[0], v0[1]); w.y = pg8::cvt_pk_bf16(v0[2], v0[3]); w.z = pg8::cvt_pk_bf16(v1[0], v1[1]); w.w = pg8::cvt_pk_bf16(v1[2], v1[3]);
          *(pg8::u32x4*)(rowp + bj * 2816) = w;
        }
      }
  }
};
struct EpiSig {
  static constexpr bool PERM = true, AFTER_DRAIN = false;
  u16* sr; u16* sa;
  __device__ __forceinline__ void operator()(const f32x4 (&acc)[2][2][4][2], const pg8::Unit& u, int wr, int wc, int fr, int fq) const {
    const int row0 = u.pm * 256 + wr * 64 + fr, col0 = u.pn * 128 + wc * 32 + 8 * fq;
#pragma unroll
    for (int ai = 0; ai < 2; ++ai)
#pragma unroll
      for (int m = 0; m < 4; ++m) {
        const size_t off = (size_t)(row0 + ai * 128 + m * 16) * 1024 + col0;
#pragma unroll
        for (int bj = 0; bj < 2; ++bj) {
          float o[8];
#pragma unroll
          for (int n = 0; n < 2; ++n)
#pragma unroll
            for (int j = 0; j < 4; ++j) o[n * 4 + j] = sigm(acc[ai][bj][m][n][j]);
          *(uint4*)((bj ? sa : sr) + off) = pack8(o);
        }
      }
  }
};
struct EpiMerge {
  static constexpr bool PERM = true, AFTER_DRAIN = false;
  const u16* t1; const u16* t2; u16* mg;
  __device__ __forceinline__ void operator()(const f32x4 (&acc)[2][2][4][2], const pg8::Unit& u, int wr, int wc, int fr, int fq) const {
    const int row0 = u.pm * 256 + wr * 64 + fr, col0 = u.pn * 128 + wc * 32 + 8 * fq;
#pragma unroll
    for (int ai = 0; ai < 2; ++ai)
#pragma unroll
      for (int m = 0; m < 4; ++m) {
        const size_t off = (size_t)(row0 + ai * 128 + m * 16) * 1024 + col0;
        float a[8], b[8], o[8];
        unpack8(*(const uint4*)(t1 + off), a);
        unpack8(*(const uint4*)(t2 + off), b);
#pragma unroll
        for (int n = 0; n < 2; ++n)
#pragma unroll
          for (int j = 0; j < 4; ++j)
            o[n * 4 + j] = sigm(acc[ai][0][m][n][j]) * a[n * 4 + j] + sigm(acc[ai][1][m][n][j]) * b[n * 4 + j];
        *(uint4*)(mg + off) = pack8(o);
        asm volatile("" ::: "memory");
      }
  }
};
struct EpiResid {
  static constexpr bool PERM = false, AFTER_DRAIN = false;
  float* X; bool dry; bool atomic; int rowoff; u16* pbf;
  __device__ __forceinline__ void operator()(const f32x4 (&acc)[2][2][4][2], const pg8::Unit& u, int wr, int wc, int fr, int fq) const {
    const int row0 = rowoff + u.pm * 256 + wr * 64 + fr, col0 = u.pn * 256 + wc * 32 + 4 * fq;
#pragma unroll
    for (int ai = 0; ai < 2; ++ai)
#pragma unroll
      for (int m = 0; m < 4; ++m) {
        float* rowp = X + (size_t)(row0 + ai * 128 + m * 16) * 1024 + col0;
#pragma unroll
        for (int bj = 0; bj < 2; ++bj)
#pragma unroll
          for (int n = 0; n < 2; ++n) {
            f32x4* q = (f32x4*)(rowp + bj * 128 + n * 16);
            if (atomic) {
              if (pbf) {
                uint2 o; o.x = pack2(acc[ai][bj][m][n][0], acc[ai][bj][m][n][1]); o.y = pack2(acc[ai][bj][m][n][2], acc[ai][bj][m][n][3]);
                *(uint2*)(pbf + ((float*)q - X)) = o;
              } else *q = acc[ai][bj][m][n];
            } else { const f32x4 v_ = *q + acc[ai][bj][m][n]; if (!dry) *q = v_; }
          }
        asm volatile("" ::: "memory");
      }
  }
};
template <class Epi>
__device__ __forceinline__ void run_gemm_ex(unsigned char* lds_raw, const u16* A, int lda, const u16* Bt, int ldb, int M, int N, int K, int G, int c, const Epi& E) {
  if (c < 0) return;
  pg8::Gemm g; g.A = A; g.Bt = Bt; g.M = M; g.N = N; g.K = K; g.lda = lda; g.ldb = ldb;
  pg8::StaticOrder S; S.init(M, N, G, c);
  __syncthreads();
  pg8::gemm_phase<Epi, pg8::StaticOrder, false>((PG8_LAS unsigned char*)lds_raw, g, S, E, nullptr);
  __syncthreads();
}
template <class Epi>
__device__ __forceinline__ void run_gemm(unsigned char* lds_raw, const u16* A, int lda, const u16* Bt, int N, int K, const Epi& E) {
  pg8::Gemm g; g.A = A; g.Bt = Bt; g.M = M_TOT; g.N = N; g.K = K; g.lda = lda; g.ldb = K;
  pg8::StaticOrder S; S.init(M_TOT, N, gridDim.x, blockIdx.x);
  __syncthreads();
  pg8::gemm_phase<Epi, pg8::StaticOrder, false>((PG8_LAS unsigned char*)lds_raw, g, S, E, nullptr);
  __syncthreads();
}

__device__ __forceinline__ void rope_item(const Params& p, int l, int item, bool dry = false) {
  const int tid = opq(threadIdx.x);
  u16* z = (u16*)(p.ws + WS_Z);
  const int row = item * 64 + (tid >> 3);
  const int d0 = (tid & 7) * 4;
  const bool prompt = row < M_P;
  int b, t, pos;
  if (prompt) { b = row >> 13; t = row & 8191; pos = t; } else { b = (row - M_P) >> 2; t = (row - M_P) & 3; pos = 16384 + t; }
  float cs[4], sn[4];
#pragma unroll
  for (int i = 0; i < 4; ++i) {
    const float inv = __expf(-(float)(d0 + i) * (9.210340371976184f / 32.f));
    const float angf = (float)pos * inv;
    double a = (double)angf;
    a -= 6.283185307179586 * rint(a * 0.15915494309189535);
    const float af = (float)a;
    sn[i] = __sinf(af); cs[i] = __cosf(af);
  }
#pragma unroll 2
  for (int hh = 0; hh < 10; ++hh) {
    u16* q = z + (size_t)row * ZLD + 1792 + hh * 64 + d0;
    const uint2 lo = *(const uint2*)q, hi = *(const uint2*)(q + 32);
    float x1[4] = {__uint_as_float(lo.x << 16), __uint_as_float(lo.x & 0xFFFF0000u), __uint_as_float(lo.y << 16), __uint_as_float(lo.y & 0xFFFF0000u)};
    float x2[4] = {__uint_as_float(hi.x << 16), __uint_as_float(hi.x & 0xFFFF0000u), __uint_as_float(hi.y << 16), __uint_as_float(hi.y & 0xFFFF0000u)};
    float y1[4], y2[4];
#pragma unroll
    for (int i = 0; i < 4; ++i) { y1[i] = x1[i] * cs[i] - x2[i] * sn[i]; y2[i] = x2[i] * cs[i] + x1[i] * sn[i]; }
    uint2 o1, o2;
    o1.x = pack2(y1[0], y1[1]); o1.y = pack2(y1[2], y1[3]); o2.x = pack2(y2[0], y2[1]); o2.y = pack2(y2[2], y2[3]);
    if (!dry) { *(uint2*)q = o1; *(uint2*)(q + 32) = o2; }
    if (hh >= 8 && prompt && t >= 8064) {
      float* o = p.out + O_PK + ((size_t)((l * 2 + b) * 128 + (t - 8064)) * 2 + (hh - 8)) * 64 + d0;
      *(float4*)o = make_float4(y1[0], y1[1], y1[2], y1[3]);
      *(float4*)(o + 32) = make_float4(y2[0], y2[1], y2[2], y2[3]);
    }
  }
}

#define SL(i) (ldsf + (i) * 4160)
__device__ __forceinline__ void rwkv_item(const Params& p, int l, int item, float* ldsf, bool dry = false) {
  const int tid = opq(threadIdx.x), lane = tid & 63, wave = tid >> 6;
  const bool sample = item >= 2048;
  int h, cidx, rowbase;
  if (!sample) { h = item & 7; cidx = item >> 3; rowbase = cidx * 64; }
  else { int s = item - 2048; h = s & 7; cidx = s >> 3; rowbase = M_P + cidx * 64; }
  const int cc = cidx & 127;
  const u16* z = (const u16*)(p.ws + WS_Z);
  u16* zw_ = (u16*)(p.ws + WS_Z);
  const float* mu = p.in[9] + l * 1792;
  float* wbuf = SL(7);
  float* gc = ldsf + 9 * 4160;
  float* bd = ldsf + 9 * 4160 + 64;
  __syncthreads();
  {
    const int t = tid >> 3, c8 = (tid & 7) * 8;
    const int m = rowbase + t;
    const int zcs[7] = {h * 64, 512 + h * 64, 1024 + h * 64, 1536, 1600, 1664, 1728};
#pragma unroll
    for (int gi = 0; gi < 7; ++gi) {
      const int zc = zcs[gi] + c8;
      float cur[8], prv[8];
      unpack8(*(const uint4*)(z + (size_t)m * ZLD + zc), cur);
      bool zero = false, fromstate = false;
      if (!sample) zero = (t == 0 && cc == 0);
      else fromstate = ((t & 3) == 0);
      if (zero) {
#pragma unroll
        for (int i = 0; i < 8; ++i) prv[i] = 0.f;
      } else if (fromstate) {
        const int b = (m - M_P) >> 2;
        const float* sp = p.in[2] + (size_t)(l * 128 + b) * 1792 + zc;
        float4 a = *(const float4*)sp, bb = *(const float4*)(sp + 4);
        prv[0] = a.x; prv[1] = a.y; prv[2] = a.z; prv[3] = a.w; prv[4] = bb.x; prv[5] = bb.y; prv[6] = bb.z; prv[7] = bb.w;
      } else {
        unpack8(*(const uint4*)(z + (size_t)(m - 1) * ZLD + zc), prv);
      }
      float* d = SL(gi) + t * 65 + c8;
#pragma unroll
      for (int i = 0; i < 8; ++i) {
        float v = cur[i] + mu[zc + i] * (prv[i] - cur[i]);
        if (gi == 3) v = tanhf(v);
        if (gi >= 5) v = sigm(v);
        d[i] = v;
      }
    }
  }
  const int lt = tid & 63, jg = tid >> 6;
  auto load_w = [&](const float* W, int nrows) {
    for (int e = tid; e < nrows * 8; e += NT) {
      const int i = e >> 3, c = (e & 7) * 8;
      const float* s = W + (size_t)i * 512 + h * 64 + c;
      *(float4*)(wbuf + i * 64 + c) = *(const float4*)s;
      *(float4*)(wbuf + i * 64 + c + 4) = *(const float4*)(s + 4);
    }
  };
  auto lora = [&](const float* xa, const float* xb, int n, float* acc) {
#pragma unroll 2
    for (int i = 0; i < n; ++i) {
      const float x = (i < 64) ? xa[lt * 65 + i] : xb[lt * 65 + i - 64];
      const float4 w0 = *(const float4*)(wbuf + i * 64 + jg * 8);
      const float4 w1 = *(const float4*)(wbuf + i * 64 + jg * 8 + 4);
      acc[0] += x * w0.x; acc[1] += x * w0.y; acc[2] += x * w0.z; acc[3] += x * w0.w;
      acc[4] += x * w1.x; acc[5] += x * w1.y; acc[6] += x * w1.z; acc[7] += x * w1.w;
    }
  };
  float res[8];
  load_w(p.in[11] + (size_t)l * 64 * 512, 64);
  __syncthreads();
#pragma unroll
  for (int i = 0; i < 8; ++i) res[i] = p.in[10][l * 512 + h * 64 + jg * 8 + i];
  lora(SL(3), SL(3), 64, res);
  __syncthreads();
#pragma unroll
  for (int i = 0; i < 8; ++i) {
    const float x = -res[i];
    const float sp = (x > 20.f) ? x : log1pf(__expf(x));
    SL(3)[lt * 65 + jg * 8 + i] = -__expf(-sp - 0.5f);
  }
  load_w(p.in[13] + (size_t)l * 64 * 512, 64);
  __syncthreads();
#pragma unroll
  for (int i = 0; i < 8; ++i) res[i] = p.in[12][l * 512 + h * 64 + jg * 8 + i];
  lora(SL(4), SL(4), 64, res);
  __syncthreads();
#pragma unroll
  for (int i = 0; i < 8; ++i) SL(4)[lt * 65 + jg * 8 + i] = sigm(res[i]);
  load_w(p.in[14] + (size_t)l * 128 * 512, 128);
  __syncthreads();
#pragma unroll
  for (int i = 0; i < 8; ++i) res[i] = 0.f;
  lora(SL(5), SL(6), 128, res);
  __syncthreads();
  if (!sample) {
    u16* ga = (u16*)(p.ws + WS_GA) + (size_t)item * 4096;
    *(uint4*)(ga + lt * 64 + jg * 8) = pack8(res);
    if (tid < 64) {
      float c = 0.f;
      for (int t = 0; t < 64; ++t) { c += SL(3)[t * 65 + tid]; SL(5)[t * 65 + tid] = c; }
      gc[tid] = __expf(c);
    }
  } else {
#pragma unroll
    for (int i = 0; i < 8; ++i) SL(6)[lt * 65 + jg * 8 + i] = res[i];
  }
  __syncthreads();
  {
    const int t = tid >> 3, j0 = (tid & 7) * 8;
    const float* kkw = p.in[15] + l * 512 + h * 64;
    const float* kaw = p.in[16] + l * 512 + h * 64;
    const float* rkw = p.in[17] + l * 512 + h * 64;
    float kr[8], av[8], rv[8], kkv[8], kf[8];
    float nrm = 0.f, bdot = 0.f;
#pragma unroll
    for (int i = 0; i < 8; ++i) {
      const int j = j0 + i;
      kr[i] = SL(1)[t * 65 + j]; av[i] = SL(4)[t * 65 + j]; rv[i] = SL(0)[t * 65 + j];
      kkv[i] = kr[i] * kkw[j];
      nrm += kkv[i] * kkv[i];
      kf[i] = kr[i] * (1.f + (av[i] - 1.f) * kaw[j]);
      bdot += rv[i] * kf[i] * rkw[j];
    }
    nrm += __shfl_xor(nrm, 1, 64); nrm += __shfl_xor(nrm, 2, 64); nrm += __shfl_xor(nrm, 4, 64);
    bdot += __shfl_xor(bdot, 1, 64); bdot += __shfl_xor(bdot, 2, 64); bdot += __shfl_xor(bdot, 4, 64);
    const float rn = 1.f / fmaxf(sqrtf(nrm), 1e-12f);
    if (!sample) {
      float bo[8];
#pragma unroll
      for (int i = 0; i < 8; ++i) {
        const int j = j0 + i;
        const float cum = SL(5)[t * 65 + j], dl = SL(3)[t * 65 + j];
        const float eg = __expf(cum), egi = __expf(-cum), egp = __expf(cum - dl);
        const float kk = kkv[i] * rn;
        SL(0)[t * 65 + j] = rv[i] * eg;
        SL(1)[t * 65 + j] = kf[i] * egi;
        SL(3)[t * 65 + j] = kk * av[i] * egi;
        SL(4)[t * 65 + j] = kk * egp;
        bo[i] = bdot * SL(2)[t * 65 + j];
      }
      u16* bop = (u16*)(p.ws + WS_BO) + (size_t)item * 4096;
      *(uint4*)(bop + t * 64 + j0) = pack8(bo);
    } else {
#pragma unroll
      for (int i = 0; i < 8; ++i) {
        const int j = j0 + i;
        const float kk = kkv[i] * rn;
        const float dl = SL(3)[t * 65 + j];
        SL(1)[t * 65 + j] = kf[i];
        SL(3)[t * 65 + j] = __expf(dl);
        SL(4)[t * 65 + j] = kk;
        SL(5)[t * 65 + j] = kk * av[i];
      }
      if ((tid & 7) == 0) bd[t] = bdot;
    }
  }
  __syncthreads();
  if (sample) {
    const float lng = p.in[18][l * 512 + h * 64 + lane], lnb = p.in[19][l * 512 + h * 64 + lane];
    for (int round = 0; round < 2; ++round) {
      const int seq = wave + 8 * round;
      const int b = cidx * 16 + seq;
      float S[64];
      const float* sp = p.in[3] + ((size_t)((l * 128 + b) * 8 + h) * 64 + lane) * 64;
#pragma unroll
      for (int k = 0; k < 64; k += 4) { float4 v = *(const float4*)(sp + k); S[k] = v.x; S[k + 1] = v.y; S[k + 2] = v.z; S[k + 3] = v.w; }
      for (int tt = 0; tt < 4; ++tt) {
        const int t = seq * 4 + tt;
        float sk = 0.f;
#pragma unroll
        for (int kc = 0; kc < 64; kc += 8) {
#pragma unroll
          for (int k = kc; k < kc + 8; ++k) sk += S[k] * SL(4)[t * 65 + k];
          __builtin_amdgcn_sched_barrier(0);
        }
        const float vt = SL(2)[t * 65 + lane];
        float y = 0.f;
#pragma unroll
        for (int kc = 0; kc < 64; kc += 8) {
#pragma unroll
          for (int k = kc; k < kc + 8; ++k) {
            S[k] = S[k] * SL(3)[t * 65 + k] - sk * SL(5)[t * 65 + k] + vt * SL(1)[t * 65 + k];
            y += S[k] * SL(0)[t * 65 + k];
          }
          __builtin_amdgcn_sched_barrier(0);
        }
        const float mean = wave_sum(y) * (1.f / 64.f);
        const float d = y - mean;
        const float var = wave_sum(d * d) * (1.f / 64.f);
        const float yn = d * rsqrtf(var + 64e-5f) * lng + lnb;
        const float o = (yn + bd[t] * vt) * SL(6)[t * 65 + lane];
        if (!dry) zw_[(size_t)(M_P + b * 4 + tt) * ZLD + h * 64 + lane] = f2bf(o);
      }
      float* op = p.out + O_SWKV + ((size_t)((l * 128 + b) * 8 + h) * 64 + lane) * 64;
#pragma unroll
      for (int k = 0; k < 64; k += 4) *(float4*)(op + k) = make_float4(S[k], S[k + 1], S[k + 2], S[k + 3]);
    }
    return;
  }
  {
    const int i = lane, tg = wave;
    float ab[8], ak[8], akr[8], abr[8];
#pragma unroll
    for (int q = 0; q < 8; ++q) { ab[q] = 0.f; ak[q] = 0.f; akr[q] = 0.f; abr[q] = 0.f; }
#pragma unroll 2
    for (int k = 0; k < 64; ++k) {
      const float xb = SL(3)[i * 65 + k], xk = SL(1)[i * 65 + k];
#pragma unroll
      for (int q = 0; q < 8; ++q) {
        const int t = tg * 8 + q;
        const float yk = SL(4)[t * 65 + k], yr = SL(0)[t * 65 + k];
        ab[q] += xb * yk; ak[q] += xk * yk; akr[q] += xk * yr; abr[q] += xb * yr;
      }
    }
    __syncthreads();
#pragma unroll
    for (int q = 0; q < 8; ++q) {
      const int t = tg * 8 + q;
      SL(6)[i * 65 + t] = (i < t) ? ab[q] : 0.f;
      SL(7)[i * 65 + t] = (i < t) ? ak[q] : 0.f;
      SL(8)[i * 65 + t] = (i <= t) ? akr[q] : 0.f;
      SL(5)[i * 65 + t] = (i <= t) ? abr[q] : 0.f;
    }
  }
  __syncthreads();
  {
    const int t = tid >> 3, j0 = (tid & 7) * 8;
#pragma unroll
    for (int i = 0; i < 8; ++i) { const float g = gc[j0 + i]; SL(3)[t * 65 + j0 + i] *= g; SL(1)[t * 65 + j0 + i] *= g; }
  }
  __syncthreads();
  if (tid < 128) {
    float* X_ = (tid < 64) ? SL(5) : SL(3);
    const int col = tid & 63;
    for (int i = 62; i >= 0; --i) {
      float a = X_[i * 65 + col];
#pragma unroll 4
      for (int t = i + 1; t < 64; ++t) a -= SL(6)[i * 65 + t] * X_[t * 65 + col];
      X_[i * 65 + col] = a;
    }
  }
  __syncthreads();
  {
    const int c = tid & 127, ig = tid >> 7;
    const int which = c >> 6, cq = c & 63;
    const float* N_ = which ? SL(3) : SL(5);
    float a[16];
#pragma unroll
    for (int q = 0; q < 16; ++q) a[q] = 0.f;
#pragma unroll 2
    for (int t = 0; t < 64; ++t) {
      const float n = N_[t * 65 + cq];
#pragma unroll
      for (int q = 0; q < 16; ++q) a[q] += SL(7)[(ig * 16 + q) * 65 + t] * n;
    }
    float* T_ = which ? SL(1) : SL(8);
#pragma unroll
    for (int q = 0; q < 16; ++q) T_[(ig * 16 + q) * 65 + cq] -= a[q];
  }
  __syncthreads();
  {
    const int x = lane, yg = wave;
    float w2[8], pp[8], yl[8], qq[8];
#pragma unroll
    for (int q = 0; q < 8; ++q) { w2[q] = 0.f; pp[q] = 0.f; yl[q] = 0.f; qq[q] = 0.f; }
#pragma unroll 2
    for (int j = 0; j < 64; ++j) {
      const float l5 = SL(5)[j * 65 + x], l4 = SL(4)[j * 65 + x], l8 = SL(8)[j * 65 + x], l2 = SL(2)[j * 65 + x];
#pragma unroll
      for (int q = 0; q < 8; ++q) {
        const int y = yg * 8 + q;
        w2[q] += l5 * SL(4)[j * 65 + y];
        pp[q] += l4 * SL(3)[j * 65 + y];
        yl[q] += l8 * SL(2)[j * 65 + y];
        qq[q] += l2 * SL(1)[j * 65 + y];
      }
    }
    float o1[8];
#pragma unroll
    for (int q = 0; q < 8; ++q) {
      const int y = yg * 8 + q;
      o1[q] = SL(0)[x * 65 + y] - w2[q];
    }
    u16* Pf = (u16*)(p.ws + WS_PP) + (size_t)item * 4096;
    float* Qf = (float*)(p.ws + WS_Q) + (size_t)item * 4096;
    if (tid < 64) ((float*)(p.ws + WS_GC))[(size_t)item * 64 + tid] = gc[tid];
    {
      const int s_ = x >> 4, kk = x & 15, hh = (kk >> 2) & 1, jj = ((kk >> 3) << 2) | (kk & 3);
#pragma unroll
      for (int q = 0; q < 8; ++q) {
        const int y = yg * 8 + q;
        Pf[(((y >> 5) * 4 + s_) * 64 + (y & 31) + 32 * hh) * 8 + jj] = f2bf(-pp[q]);
        const int k2 = y & 31, reg = ((k2 >> 3) << 2) | (k2 & 3), h2 = (k2 >> 2) & 1;
        Qf[(((x >> 5) * 2 + (y >> 5)) * 16 + reg) * 64 + (x & 31) + 32 * h2] = qq[q];
      }
    }
    u16* W2p = (u16*)(p.ws + WS_W2) + (size_t)item * 4096 + x * 64 + yg * 8;
    u16* YLp = (u16*)(p.ws + WS_YL) + (size_t)item * 4096 + x * 64 + yg * 8;
    *(uint4*)W2p = pack8(o1);
    *(uint4*)YLp = pack8(yl);
  }
}

template <bool SWA = false, bool SWB = false>
__device__ __forceinline__ void mm_tile(const u16* Aop, int lda, const u16* Bop, int ldb, int mt, int nt, int r, int h, int ksteps, f32x16& acc) {
  const int ra = mt * 32 + r, rb = nt * 32 + r;
  const u16* ap = Aop + ra * lda;
  const u16* bp = Bop + rb * ldb;
  const int swa = SWA ? ((ra >> 3) & 7) : 0, swb = SWB ? ((rb >> 3) & 7) : 0;
#pragma unroll 4
  for (int s = 0; s < ksteps; ++s) {
    const bf16x8 a = *(const bf16x8*)(ap + (((2 * s + h) ^ swa) << 3));
    const bf16x8 b = *(const bf16x8*)(bp + (((2 * s + h) ^ swb) << 3));
    acc = __builtin_amdgcn_mfma_f32_32x32x16_bf16(a, b, acc, 0, 0, 0);
  }
}
#define SWZ(row, col) ((row) * 72 + (((((col) >> 3) ^ (((row) >> 3) & 7)) << 3) | ((col) & 7)))
__device__ __forceinline__ void store_T(u16* T, int ldt, int mt, int nt, int r, int h, const f32x16& acc) {
#pragma unroll
  for (int g = 0; g < 4; ++g) {
    uint2 o; o.x = pack2(acc[4 * g], acc[4 * g + 1]); o.y = pack2(acc[4 * g + 2], acc[4 * g + 3]);
    *(uint2*)(T + (nt * 32 + r) * ldt + mt * 32 + 8 * g + 4 * h) = o;
  }
}
__device__ __forceinline__ void tri16(const float* Ab, float* Xc) {
  float a0 = Xc[0];
  float a1 = Xc[65];
  float a2 = Xc[130];
  float a3 = Xc[195];
  float a4 = Xc[260];
  float a5 = Xc[325];
  float a6 = Xc[390];
  float a7 = Xc[455];
  float a8 = Xc[520];
  float a9 = Xc[585];
  float a10 = Xc[650];
  float a11 = Xc[715];
  float a12 = Xc[780];
  float a13 = Xc[845];
  float a14 = Xc[910];
  float a15 = Xc[975];
  const float4 c14_12 = *(const float4*)(Ab + 964);
  const float4 c13_12 = *(const float4*)(Ab + 896);
  const float4 c12_12 = *(const float4*)(Ab + 828);
  const float4 c11_12 = *(const float4*)(Ab + 760);
  a14 -= c14_12.w * a15;
  const float4 c10_8 = *(const float4*)(Ab + 688);
  const float4 c10_12 = *(const float4*)(Ab + 692);
  a13 -= c13_12.z * a14;
  a13 -= c13_12.w * a15;
  const float4 c9_8 = *(const float4*)(Ab + 620);
  const float4 c9_12 = *(const float4*)(Ab + 624);
  a12 -= c12_12.y * a13;
  a12 -= c12_12.z * a14;
  a12 -= c12_12.w * a15;
  const float4 c8_8 = *(const float4*)(Ab + 552);
  const float4 c8_12 = *(const float4*)(Ab + 556);
  a11 -= c11_12.x * a12;
  a11 -= c11_12.y * a13;
  a11 -= c11_12.z * a14;
  a11 -= c11_12.w * a15;
  const float4 c7_8 = *(const float4*)(Ab + 484);
  const float4 c7_12 = *(const float4*)(Ab + 488);
  a10 -= c10_8.w * a11;
  a10 -= c10_12.x * a12;
  a10 -= c10_12.y * a13;
  a10 -= c10_12.z * a14;
  a10 -= c10_12.w * a15;
  const float4 c6_4 = *(const float4*)(Ab + 412);
  const float4 c6_8 = *(const float4*)(Ab + 416);
  const float4 c6_12 = *(const float4*)(Ab + 420);
  a9 -= c9_8.z * a10;
  a9 -= c9_8.w * a11;
  a9 -= c9_12.x * a12;
  a9 -= c9_12.y * a13;
  a9 -= c9_12.z * a14;
  a9 -= c9_12.w * a15;
  const float4 c5_4 = *(const float4*)(Ab + 344);
  const float4 c5_8 = *(const float4*)(Ab + 348);
  const float4 c5_12 = *(const float4*)(Ab + 352);
  a8 -= c8_8.y * a9;
  a8 -= c8_8.z * a10;
  a8 -= c8_8.w * a11;
  a8 -= c8_12.x * a12;
  a8 -= c8_12.y * a13;
  a8 -= c8_12.z * a14;
  a8 -= c8_12.w * a15;
  const float4 c4_4 = *(const float4*)(Ab + 276);
  const float4 c4_8 = *(const float4*)(Ab + 280);
  const float4 c4_12 = *(const float4*)(Ab + 284);
  a7 -= c7_8.x * a8;
  a7 -= c7_8.y * a9;
  a7 -= c7_8.z * a10;
  a7 -= c7_8.w * a11;
  a7 -= c7_12.x * a12;
  a7 -= c7_12.y * a13;
  a7 -= c7_12.z * a14;
  a7 -= c7_12.w * a15;
  const float4 c3_4 = *(const float4*)(Ab + 208);
  const float4 c3_8 = *(const float4*)(Ab + 212);
  const float4 c3_12 = *(const float4*)(Ab + 216);
  a6 -= c6_4.w * a7;
  a6 -= c6_8.x * a8;
  a6 -= c6_8.y * a9;
  a6 -= c6_8.z * a10;
  a6 -= c6_8.w * a11;
  a6 -= c6_12.x * a12;
  a6 -= c6_12.y * a13;
  a6 -= c6_12.z * a14;
  a6 -= c6_12.w * a15;
  const float4 c2_0 = *(const float4*)(Ab + 136);
  const float4 c2_4 = *(const float4*)(Ab + 140);
  const float4 c2_8 = *(const float4*)(Ab + 144);
  const float4 c2_12 = *(const float4*)(Ab + 148);
  a5 -= c5_4.z * a6;
  a5 -= c5_4.w * a7;
  a5 -= c5_8.x * a8;
  a5 -= c5_8.y * a9;
  a5 -= c5_8.z * a10;
  a5 -= c5_8.w * a11;
  a5 -= c5_12.x * a12;
  a5 -= c5_12.y * a13;
  a5 -= c5_12.z * a14;
  a5 -= c5_12.w * a15;
  const float4 c1_0 = *(const float4*)(Ab + 68);
  const float4 c1_4 = *(const float4*)(Ab + 72);
  const float4 c1_8 = *(const float4*)(Ab + 76);
  const float4 c1_12 = *(const float4*)(Ab + 80);
  a4 -= c4_4.y * a5;
  a4 -= c4_4.z * a6;
  a4 -= c4_4.w * a7;
  a4 -= c4_8.x * a8;
  a4 -= c4_8.y * a9;
  a4 -= c4_8.z * a10;
  a4 -= c4_8.w * a11;
  a4 -= c4_12.x * a12;
  a4 -= c4_12.y * a13;
  a4 -= c4_12.z * a14;
  a4 -= c4_12.w * a15;
  const float4 c0_0 = *(const float4*)(Ab + 0);
  const float4 c0_4 = *(const float4*)(Ab + 4);
  const float4 c0_8 = *(const float4*)(Ab + 8);
  const float4 c0_12 = *(const float4*)(Ab + 12);
  a3 -= c3_4.x * a4;
  a3 -= c3_4.y * a5;
  a3 -= c3_4.z * a6;
  a3 -= c3_4.w * a7;
  a3 -= c3_8.x * a8;
  a3 -= c3_8.y * a9;
  a3 -= c3_8.z * a10;
  a3 -= c3_8.w * a11;
  a3 -= c3_12.x * a12;
  a3 -= c3_12.y * a13;
  a3 -= c3_12.z * a14;
  a3 -= c3_12.w * a15;
  a2 -= c2_0.w * a3;
  a2 -= c2_4.x * a4;
  a2 -= c2_4.y * a5;
  a2 -= c2_4.z * a6;
  a2 -= c2_4.w * a7;
  a2 -= c2_8.x * a8;
  a2 -= c2_8.y * a9;
  a2 -= c2_8.z * a10;
  a2 -= c2_8.w * a11;
  a2 -= c2_12.x * a12;
  a2 -= c2_12.y * a13;
  a2 -= c2_12.z * a14;
  a2 -= c2_12.w * a15;
  a1 -= c1_0.z * a2;
  a1 -= c1_0.w * a3;
  a1 -= c1_4.x * a4;
  a1 -= c1_4.y * a5;
  a1 -= c1_4.z * a6;
  a1 -= c1_4.w * a7;
  a1 -= c1_8.x * a8;
  a1 -= c1_8.y * a9;
  a1 -= c1_8.z * a10;
  a1 -= c1_8.w * a11;
  a1 -= c1_12.x * a12;
  a1 -= c1_12.y * a13;
  a1 -= c1_12.z * a14;
  a1 -= c1_12.w * a15;
  a0 -= c0_0.y * a1;
  a0 -= c0_0.z * a2;
  a0 -= c0_0.w * a3;
  a0 -= c0_4.x * a4;
  a0 -= c0_4.y * a5;
  a0 -= c0_4.z * a6;
  a0 -= c0_4.w * a7;
  a0 -= c0_8.x * a8;
  a0 -= c0_8.y * a9;
  a0 -= c0_8.z * a10;
  a0 -= c0_8.w * a11;
  a0 -= c0_12.x * a12;
  a0 -= c0_12.y * a13;
  a0 -= c0_12.z * a14;
  a0 -= c0_12.w * a15;
  Xc[0] = a0;
  Xc[65] = a1;
  Xc[130] = a2;
  Xc[195] = a3;
  Xc[260] = a4;
  Xc[325] = a5;
  Xc[390] = a6;
  Xc[455] = a7;
  Xc[520] = a8;
  Xc[585] = a9;
  Xc[650] = a10;
  Xc[715] = a11;
  Xc[780] = a12;
  Xc[845] = a13;
  Xc[910] = a14;
  Xc[975] = a15;
}
#define FS(i) (ldsf + (i) * 4160)
__device__ __forceinline__ void rwkv_item2(const Params& p, int l, int item, float* ldsf) {
  const int tid = opq(threadIdx.x), lane = tid & 63, wave = tid >> 6;
  const int r = lane & 31, hf = lane >> 5;
  const int h = item & 7, cidx = item >> 3, rowbase = cidx * 64, cc = cidx & 127;
  const u16* z = (const u16*)(p.ws + WS_Z);
  const float* mu = p.in[9] + l * 1792;
  u16* BBp = (u16*)((unsigned char*)ldsf + 83200);
  u16* XW = BBp;            u16* XA = BBp + 4608;    u16* XG = BBp + 9216;   u16* WT = BBp + 17920;
  u16* Rn = BBp;            u16* Kn = BBp + 4608;    u16* Bn = BBp + 9216;   u16* Cn = BBp + 13824;
  u16* CT = BBp + 18432;    u16* KHT = BBp + 23040;  u16* VT = BBp + 27648;
  float* gc = (float*)(BBp + 32256);
  u16* AK = (u16*)FS(2);    u16* NTm = AK + 4608;
  u16* MT = (u16*)FS(0);    u16* KQT = (u16*)FS(1);
  float* Abp = (float*)((unsigned char*)ldsf + 60928);
  const int mt = (wave >> 1) & 1, nt = wave & 1, grp = wave >> 2;
  const uint4* lwsrc = (const uint4*)((const u16*)(p.ws + WS_LW) + (size_t)h * 17920);
  const float bias_w = p.in[10][l * 512 + h * 64 + nt * 32 + r], bias_a = p.in[12][l * 512 + h * 64 + nt * 32 + r];
  float kkw_[8], kaw_[8], rkw_[8];
  {
    const int j0 = (tid & 7) * 8;
    const float* q1 = p.in[15] + l * 512 + h * 64 + j0; const float* q2 = p.in[16] + l * 512 + h * 64 + j0; const float* q3 = p.in[17] + l * 512 + h * 64 + j0;
    const float4 x0 = *(const float4*)q1, x1 = *(const float4*)(q1 + 4), y0 = *(const float4*)q2, y1 = *(const float4*)(q2 + 4), z0 = *(const float4*)q3, z1 = *(const float4*)(q3 + 4);
    kkw_[0] = x0.x; kkw_[1] = x0.y; kkw_[2] = x0.z; kkw_[3] = x0.w; kkw_[4] = x1.x; kkw_[5] = x1.y; kkw_[6] = x1.z; kkw_[7] = x1.w;
    kaw_[0] = y0.x; kaw_[1] = y0.y; kaw_[2] = y0.z; kaw_[3] = y0.w; kaw_[4] = y1.x; kaw_[5] = y1.y; kaw_[6] = y1.z; kaw_[7] = y1.w;
    rkw_[0] = z0.x; rkw_[1] = z0.y; rkw_[2] = z0.z; rkw_[3] = z0.w; rkw_[4] = z1.x; rkw_[5] = z1.y; rkw_[6] = z1.z; rkw_[7] = z1.w;
  }
  const uint4 g2a = lwsrc[1152 + tid], g2b = lwsrc[1152 + 512 + tid], g2c = (tid < 64) ? lwsrc[1152 + 1024 + tid] : make_uint4(0, 0, 0, 0);
  __syncthreads();
  {
    const int t = tid >> 3, c8 = (tid & 7) * 8;
    const int m = rowbase + t;
    const int zcs[7] = {h * 64, 512 + h * 64, 1024 + h * 64, 1536, 1600, 1664, 1728};
#pragma unroll
    for (int gi = 0; gi < 7; ++gi) {
      const int zc = zcs[gi] + c8;
      float cur[8], prv[8], v[8];
      const float4 mu0 = *(const float4*)(mu + zc), mu1 = *(const float4*)(mu + zc + 4);
      const float muv[8] = {mu0.x, mu0.y, mu0.z, mu0.w, mu1.x, mu1.y, mu1.z, mu1.w};
      unpack8(*(const uint4*)(z + (size_t)m * ZLD + zc), cur);
      if (t == 0 && cc == 0) {
#pragma unroll
        for (int i = 0; i < 8; ++i) prv[i] = 0.f;
      } else {
        unpack8(*(const uint4*)(z + (size_t)(m - 1) * ZLD + zc), prv);
      }
#pragma unroll
      for (int i = 0; i < 8; ++i) {
        float x = cur[i] + muv[i] * (prv[i] - cur[i]);
        if (gi == 3) x = 1.f - 2.f * __builtin_amdgcn_rcpf(1.f + __expf(2.f * x));
        if (gi >= 5) x = sigm(x);
        v[i] = x;
      }
      if (gi < 2) {
        float* d = FS(gi) + t * 65 + c8;
#pragma unroll
        for (int i = 0; i < 8; ++i) d[i] = v[i];
      } else if (gi == 2) {
#pragma unroll
        for (int i = 0; i < 8; ++i) VT[SWZ(c8 + i, t)] = f2bf(v[i]);
      } else if (gi == 3) { *(uint4*)(XW + t * 72 + c8) = pack8(v); }
      else if (gi == 4) { *(uint4*)(XA + t * 72 + c8) = pack8(v); }
      else { *(uint4*)(XG + t * 136 + (gi - 5) * 64 + c8) = pack8(v); }
    }
  }
  {
    uint4* d = (uint4*)WT;
    for (int e = tid; e < 1152; e += 512) d[e] = lwsrc[e];
  }
  __syncthreads();
  {
    f32x16 acc;
#pragma unroll
    for (int i = 0; i < 16; ++i) acc[i] = 0.f;
    mm_tile(grp ? XA : XW, 72, grp ? WT + 4608 : WT, 72, mt, nt, r, hf, 4, acc);
    const int j = nt * 32 + r;
    const float bias = grp ? bias_a : bias_w;
#pragma unroll
    for (int reg = 0; reg < 16; ++reg) {
      const int t = mt * 32 + ROWOFF(reg, hf);
      const float x = acc[reg] + bias;
      if (grp) FS(3)[t * 65 + j] = sigm(x);
      else {
        const float nx = -x;
        const float sp = (nx > 20.f) ? nx : __logf(1.f + __expf(nx));
        FS(4)[t * 65 + j] = -__expf(-sp - 0.5f);
      }
    }
  }
  __syncthreads();
  {
    uint4* d = (uint4*)WT;
    d[tid] = g2a; d[512 + tid] = g2b; if (tid < 64) d[1024 + tid] = g2c;
  }
  float* psum = (float*)((unsigned char*)ldsf + 147968);
  float pl[8];
  {
    const int j = tid & 63, sg = tid >> 6;
    float c = 0.f;
#pragma unroll
    for (int u = 0; u < 8; ++u) { c += FS(4)[(sg * 8 + u) * 65 + j]; pl[u] = c; }
    psum[sg * 64 + j] = c;
  }
  __syncthreads();
  {
    const int j = tid & 63, sg = tid >> 6;
    float off = 0.f, tot = 0.f;
#pragma unroll
    for (int q = 0; q < 8; ++q) { const float v = psum[q * 64 + j]; tot += v; if (q < sg) off += v; }
#pragma unroll
    for (int u = 0; u < 8; ++u) FS(2)[(sg * 8 + u) * 65 + j] = off + pl[u];
    if (sg == 0) { const float g = __expf(tot); gc[j] = g; ((float*)(p.ws + WS_GC))[(size_t)item * 64 + j] = g; }
  }
  if (grp == 0) {
    f32x16 acc;
#pragma unroll
    for (int i = 0; i < 16; ++i) acc[i] = 0.f;
    mm_tile(XG, 136, WT, 136, mt, nt, r, hf, 8, acc);
    u16* ga = (u16*)(p.ws + WS_GA) + (size_t)item * 4096;
#pragma unroll
    for (int reg = 0; reg < 16; ++reg) ga[(mt * 32 + ROWOFF(reg, hf)) * 64 + nt * 32 + r] = f2bf(acc[reg]);
  }
  __syncthreads();
  {
    const int t = tid >> 3, j0 = (tid & 7) * 8;
    float kr[8], av[8], rv[8], kkv[8], kf[8];
    float nrm = 0.f, bdot = 0.f;
#pragma unroll
    for (int i = 0; i < 8; ++i) {
      const int j = j0 + i;
      kr[i] = FS(1)[t * 65 + j]; av[i] = FS(3)[t * 65 + j]; rv[i] = FS(0)[t * 65 + j];
      kkv[i] = kr[i] * kkw_[i];
      nrm += kkv[i] * kkv[i];
      kf[i] = kr[i] * (1.f + (av[i] - 1.f) * kaw_[i]);
      bdot += rv[i] * kf[i] * rkw_[i];
    }
    nrm += __shfl_xor(nrm, 1, 64); nrm += __shfl_xor(nrm, 2, 64); nrm += __shfl_xor(nrm, 4, 64);
    bdot += __shfl_xor(bdot, 1, 64); bdot += __shfl_xor(bdot, 2, 64); bdot += __shfl_xor(bdot, 4, 64);
    const float rn = 1.f / fmaxf(sqrtf(nrm), 1e-12f);
    float o_r[8], o_k[8], o_b[8], o_c[8], bo[8];
#pragma unroll
    for (int i = 0; i < 8; ++i) {
      const int j = j0 + i;
      const float cum = FS(2)[t * 65 + j], dl = FS(4)[t * 65 + j];
      const float eg = __expf(cum), egi = __expf(-cum), egp = __expf(cum - dl);
      const float kk = kkv[i] * rn;
      const float g = gc[j];
      o_r[i] = rv[i] * eg; o_k[i] = kf[i] * egi; o_b[i] = kk * av[i] * egi; o_c[i] = kk * egp;
      CT[SWZ(j, t)] = f2bf(o_c[i]);
      KHT[SWZ(j, t)] = f2bf(o_k[i] * g);
      FS(1)[t * 65 + j] = o_b[i] * g;
      bo[i] = bdot * bf2f(VT[SWZ(j, t)]);
    }
    *(uint4*)(Rn + t * 72 + j0) = pack8(o_r);
    *(uint4*)(Kn + t * 72 + j0) = pack8(o_k);
    *(uint4*)(Bn + t * 72 + j0) = pack8(o_b);
    *(uint4*)(Cn + t * 72 + j0) = pack8(o_c);
    u16* bop = (u16*)(p.ws + WS_BO) + (size_t)item * 4096;
    *(uint4*)(bop + t * 64 + j0) = pack8(bo);
  }
  __syncthreads();
  f32x16 akr;
#pragma unroll
  for (int i = 0; i < 16; ++i) akr[i] = 0.f;
  if (grp == 0) {
    f32x16 ab, abr;
#pragma unroll
    for (int i = 0; i < 16; ++i) { ab[i] = 0.f; abr[i] = 0.f; }
    mm_tile(Bn, 72, Cn, 72, mt, nt, r, hf, 4, ab);
    mm_tile(Bn, 72, Rn, 72, mt, nt, r, hf, 4, abr);
    const int t = nt * 32 + r;
#pragma unroll
    for (int reg = 0; reg < 16; ++reg) {
      const int i = mt * 32 + ROWOFF(reg, hf);
      Abp[i * 68 + t] = (i < t) ? ab[reg] : 0.f;
      FS(0)[i * 65 + t] = (i <= t) ? abr[reg] : 0.f;
    }
  } else {
    f32x16 akt;
#pragma unroll
    for (int i = 0; i < 16; ++i) akt[i] = 0.f;
    mm_tile(Cn, 72, Kn, 72, mt, nt, r, hf, 4, akt);
    {
      const int i = nt * 32 + r;
#pragma unroll
      for (int reg = 0; reg < 16; ++reg) { const int t = mt * 32 + ROWOFF(reg, hf); if (!(i < t)) akt[reg] = 0.f; }
    }
    store_T(AK, 72, mt, nt, r, hf, akt);
    mm_tile(Kn, 72, Rn, 72, mt, nt, r, hf, 4, akr);
    {
      const int t = nt * 32 + r;
#pragma unroll
      for (int reg = 0; reg < 16; ++reg) { const int i = mt * 32 + ROWOFF(reg, hf); if (!(i <= t)) akr[reg] = 0.f; }
    }
  }
  __syncthreads();
#pragma unroll 1
  for (int I = 3; I >= 0; --I) {
    if (tid < 128) {
      float* X_ = (tid < 64) ? FS(0) : FS(1);
      tri16(Abp + I * 16 * 69, X_ + I * 16 * 65 + (tid & 63));
    }
    __syncthreads();
    if (I > 0) {
      const int c = tid & 127, rg = tid >> 7;
      float* X_ = (c < 64) ? FS(0) : FS(1);
      const int col = c & 63;
      float xv[16];
#pragma unroll
      for (int t = 0; t < 16; ++t) xv[t] = X_[(I * 16 + t) * 65 + col];
      for (int i = rg; i < I * 16; i += 4) {
        const float* ar = Abp + i * 68 + I * 16;
        const float4 c0 = *(const float4*)ar, c1 = *(const float4*)(ar + 4), c2 = *(const float4*)(ar + 8), c3 = *(const float4*)(ar + 12);
        float a = c0.x * xv[0] + c0.y * xv[1] + c0.z * xv[2] + c0.w * xv[3];
        a += c1.x * xv[4] + c1.y * xv[5] + c1.z * xv[6] + c1.w * xv[7];
        a += c2.x * xv[8] + c2.y * xv[9] + c2.z * xv[10] + c2.w * xv[11];
        a += c3.x * xv[12] + c3.y * xv[13] + c3.z * xv[14] + c3.w * xv[15];
        X_[i * 65 + col] -= a;
      }
      __syncthreads();
    }
  }
  {
    const int c = tid >> 2, q = tid & 3;
    const float* X_ = (c < 64) ? FS(0) : FS(1);
    const int col = c & 63;
    float o0[8], o1[8];
#pragma unroll
    for (int u = 0; u < 8; ++u) { o0[u] = -X_[(q * 16 + u) * 65 + col]; o1[u] = -X_[(q * 16 + 8 + u) * 65 + col]; }
    u16* dst = NTm + c * 72 + q * 16;
    *(uint4*)dst = pack8(o0);
    *(uint4*)(dst + 8) = pack8(o1);
  }
  __syncthreads();
  if (grp == 1) {
    mm_tile(AK, 72, NTm, 72, mt, nt, r, hf, 4, akr);
    store_T(MT, 72, mt, nt, r, hf, akr);
  } else {
    f32x16 d2;
#pragma unroll
    for (int i = 0; i < 16; ++i) d2[i] = 0.f;
    mm_tile(AK, 72, NTm + 64 * 72, 72, mt, nt, r, hf, 4, d2);
#pragma unroll
    for (int g = 0; g < 4; ++g) {
      const int idx = (nt * 32 + r) * 72 + mt * 32 + 8 * g + 4 * hf;
      const uint2 kh = *(const uint2*)(KHT + SWZ(nt * 32 + r, mt * 32 + 8 * g + 4 * hf));
      uint2 o;
      o.x = pack2(d2[4 * g] + __uint_as_float(kh.x << 16), d2[4 * g + 1] + __uint_as_float(kh.x & 0xFFFF0000u));
      o.y = pack2(d2[4 * g + 2] + __uint_as_float(kh.y << 16), d2[4 * g + 3] + __uint_as_float(kh.y & 0xFFFF0000u));
      *(uint2*)(KQT + idx) = o;
    }
  }
  __syncthreads();
  if (grp == 0) {
    f32x16 w2, yl;
#pragma unroll
    for (int i = 0; i < 16; ++i) { w2[i] = 0.f; yl[i] = 0.f; }
    mm_tile<false, true>(NTm, 72, CT, 72, mt, nt, r, hf, 4, w2);
    mm_tile<false, true>(MT, 72, VT, 72, mt, nt, r, hf, 4, yl);
    u16* W2p = (u16*)(p.ws + WS_W2) + (size_t)item * 4096;
    u16* YLp = (u16*)(p.ws + WS_YL) + (size_t)item * 4096;
#pragma unroll
    for (int reg = 0; reg < 16; ++reg) {
      const int t = mt * 32 + ROWOFF(reg, hf), n = nt * 32 + r;
      W2p[t * 64 + n] = f2bf(w2[reg] + bf2f(Rn[t * 72 + n]));
      YLp[t * 64 + n] = f2bf(yl[reg]);
    }
  } else {
    f32x16 pp, qt;
#pragma unroll
    for (int i = 0; i < 16; ++i) { pp[i] = 0.f; qt[i] = 0.f; }
    mm_tile<true, false>(CT, 72, NTm + 64 * 72, 72, mt, nt, r, hf, 4, pp);
    mm_tile<false, true>(KQT, 72, VT, 72, mt, nt, r, hf, 4, qt);
    uint4* Pf = (uint4*)((u16*)(p.ws + WS_PP) + (size_t)item * 4096);
    float* Qf = (float*)(p.ws + WS_Q) + (size_t)item * 4096;
#pragma unroll
    for (int s2 = 0; s2 < 2; ++s2) {
      uint4 o;
      o.x = pack2(pp[s2 * 8 + 0], pp[s2 * 8 + 1]); o.y = pack2(pp[s2 * 8 + 2], pp[s2 * 8 + 3]);
      o.z = pack2(pp[s2 * 8 + 4], pp[s2 * 8 + 5]); o.w = pack2(pp[s2 * 8 + 6], pp[s2 * 8 + 7]);
      Pf[(nt * 4 + mt * 2 + s2) * 64 + lane] = o;
    }
#pragma unroll
    for (int reg = 0; reg < 16; ++reg) Qf[((nt * 2 + mt) * 16 + reg) * 64 + lane] = qt[reg];
  }
}

template <int K_> struct IC { static constexpr int value = K_; };
__device__ __forceinline__ void rwkv_scan(const Params& p, int l, int bh, float* ldsf, bool dry = false) {
  const int tid = opq(threadIdx.x), lane = tid & 63, wave = tid >> 6;
  const int b = bh >> 3, h = bh & 7;
  unsigned char* ring = (unsigned char*)ldsf + 32768;
  uint4* xch = (uint4*)((unsigned char*)ldsf + 32768 + 49152);
  __syncthreads();
  {
    const float* G0 = (const float*)(p.ws + WS_GC);
    for (int e = tid; e < 8192; e += NT) ldsf[e] = G0[(size_t)((b * 128 + (e >> 6)) * 8 + h) * 64 + (e & 63)];
    if (tid < 256) { for (int e = tid; e < 1024; e += 256) xch[e] = make_uint4(0, 0, 0, 0); }
  }
  const bool helper = wave >= 4;
  const u16* PPb = (const u16*)(p.ws + WS_PP);
  const float* Qb = (const float*)(p.ws + WS_Q);
  if (helper) {
    const bool isP = wave < 6;
    const int hidx = isP ? (tid - 256) : (tid - 384);
    const int hdst = isP ? hidx : 512 + hidx;
#define SC_GLOAD(c, R) do { const size_t id_ = (size_t)((b * 128 + (c)) * 8 + h); \
      if (isP) { const uint4* src_ = (const uint4*)(PPb + id_ * 4096) + hidx; R##0 = src_[0]; R##1 = src_[128]; R##2 = src_[256]; R##3 = src_[384]; } \
      else { const uint4* src_ = (const uint4*)(Qb + id_ * 4096) + hidx; R##0 = src_[0]; R##1 = src_[128]; R##2 = src_[256]; R##3 = src_[384]; \
             R##4 = src_[512]; R##5 = src_[640]; R##6 = src_[768]; R##7 = src_[896]; } } while (0)
#define SC_LWRITE(c, R) do { uint4* slot_ = (uint4*)(ring + ((c) & 1) * 24576) + hdst; \
      slot_[0] = R##0; slot_[128] = R##1; slot_[256] = R##2; slot_[384] = R##3; \
      if (!isP) { slot_[512] = R##4; slot_[640] = R##5; slot_[768] = R##6; slot_[896] = R##7; } } while (0)
    uint4 a0, a1, a2, a3, a4, a5, a6, a7, b0, b1, b2, b3, b4, b5, b6, b7, c0, c1, c2, c3, c4, c5, c6, c7, d0, d1, d2, d3, d4, d5, d6, d7;
    a4 = a5 = a6 = a7 = b4 = b5 = b6 = b7 = c4 = c5 = c6 = c7 = d4 = d5 = d6 = d7 = make_uint4(0, 0, 0, 0);
    SC_GLOAD(0, a); SC_LWRITE(0, a);
    SC_GLOAD(1, b); SC_GLOAD(2, c); SC_GLOAD(3, d);
    __syncthreads();
#pragma unroll 1
    for (int cc = 0; cc < 128; cc += 4) {
      if (cc + 4 < 128) SC_GLOAD(cc + 4, a);
      SC_LWRITE(cc + 1, b);
      asm volatile("s_waitcnt lgkmcnt(0)\n\ts_barrier" ::: "memory");
      if (cc + 5 < 128) SC_GLOAD(cc + 5, b);
      SC_LWRITE(cc + 2, c);
      asm volatile("s_waitcnt lgkmcnt(0)\n\ts_barrier" ::: "memory");
      if (cc + 6 < 128) SC_GLOAD(cc + 6, c);
      SC_LWRITE(cc + 3, d);
      asm volatile("s_waitcnt lgkmcnt(0)\n\ts_barrier" ::: "memory");
      if (cc + 7 < 128) SC_GLOAD(cc + 7, d);
      if (cc + 4 < 128) SC_LWRITE(cc + 4, a);
      asm volatile("s_waitcnt lgkmcnt(0)\n\ts_barrier" ::: "memory");
    }
    return;
  }
  __syncthreads();
  const int vt = wave & 1, kt2 = wave >> 1, hf = lane >> 5;
  f32x16 S;
#pragma unroll
  for (int i = 0; i < 16; ++i) S[i] = 0.f;
  uint4 own0 = make_uint4(0, 0, 0, 0), own1 = make_uint4(0, 0, 0, 0);
#pragma unroll 1
  for (int cc = 0; cc < 128; ++cc) {
    const size_t id = (size_t)((b * 128 + cc) * 8 + h);
    const int lofs = opq(lane);
    float* Qg = (float*)Qb + id * 4096 + (vt * 2 + kt2) * 1024 + lofs;
    const uint4* slotA = (const uint4*)(ring + (cc & 1) * 24576) + kt2 * 256 + lofs;
    const float* slotQ = (const float*)(ring + (cc & 1) * 24576 + 8192) + (vt * 2 + kt2) * 1024 + lofs;
    const float* gcp = ldsf + cc * 64 + kt2 * 32 + 4 * (lofs >> 5);
    const uint4* xin = xch + (((cc & 1) * 2 + vt) * 2 + (kt2 ^ 1)) * 128 + lofs;
    uint4* xout = xch + ((((cc + 1) & 1) * 2 + vt) * 2 + kt2) * 128 + lofs;
    f32x16 acc;
#pragma unroll
    for (int reg = 0; reg < 16; ++reg) acc[reg] = S[reg] * gcp[((reg) & 3) + 8 * ((reg) >> 2)] + slotQ[reg * 64];
#pragma unroll
    for (int reg = 0; reg < 16; ++reg) if (!dry) Qg[reg * 64] = S[reg];
    const uint4 p0 = xin[0], p1 = xin[64];
#pragma unroll
    for (int s_ = 0; s_ < 4; ++s_) {
      union { uint4 u; bf16x8 v; } bfr, af;
      const bool mine = (s_ >> 1) == kt2;
      bfr.u = mine ? ((s_ & 1) ? own1 : own0) : ((s_ & 1) ? p1 : p0);
      af.u = slotA[s_ * 64];
      acc = __builtin_amdgcn_mfma_f32_32x32x16_bf16(af.v, bfr.v, acc, 0, 0, 0);
    }
    S = acc;
    own0 = make_uint4(pack2(S[0], S[1]), pack2(S[2], S[3]), pack2(S[4], S[5]), pack2(S[6], S[7]));
    own1 = make_uint4(pack2(S[8], S[9]), pack2(S[10], S[11]), pack2(S[12], S[13]), pack2(S[14], S[15]));
    xout[0] = own0; xout[64] = own1;
    asm volatile("s_waitcnt lgkmcnt(0)\n\ts_barrier" ::: "memory");
  }
  {
    float* o = p.out + O_PWKV + ((size_t)((l * 2 + b) * 8 + h) * 64 + vt * 32 + (lane & 31)) * 64 + kt2 * 32;
#pragma unroll
    for (int reg = 0; reg < 16; ++reg) o[ROWOFF(reg, hf)] = S[reg];
  }
}

__device__ __forceinline__ void rwkv_out(const Params& p, int l, int item, float* ldsf) {
  const int tid = opq(threadIdx.x), lane = tid & 63, wave = tid >> 6;
  const int h = item & 7, cidx = item >> 3;
  float* Sl = ldsf; float* Wl = ldsf + 4160;
  const float* Sg = (const float*)(p.ws + WS_Q) + (size_t)item * 4096;
  const u16* W2 = (const u16*)(p.ws + WS_W2) + (size_t)item * 4096;
  const u16* YL = (const u16*)(p.ws + WS_YL) + (size_t)item * 4096;
  const u16* BO = (const u16*)(p.ws + WS_BO) + (size_t)item * 4096;
  const u16* GA = (const u16*)(p.ws + WS_GA) + (size_t)item * 4096;
  u16* z = (u16*)(p.ws + WS_Z);
  __syncthreads();
  {
    const int row = tid >> 3, c = (tid & 7) * 8;
#pragma unroll
    for (int i = 0; i < 8; ++i) {
      const int idx = i * 512 + tid;
      const int ln = idx & 63, reg = (idx >> 6) & 15, kt = (idx >> 10) & 1, vt = idx >> 11;
      Sl[(vt * 32 + (ln & 31)) * 65 + kt * 32 + ROWOFF(reg, ln >> 5)] = Sg[idx];
    }
    float w[8];
    unpack8(*(const uint4*)(W2 + row * 64 + c), w);
    float* e = Wl + row * 65 + c;
#pragma unroll
    for (int i = 0; i < 8; ++i) e[i] = w[i];
  }
  __syncthreads();
  float y[8];
#pragma unroll
  for (int q = 0; q < 8; ++q) y[q] = bf2f(YL[(wave * 8 + q) * 64 + lane]);
#pragma unroll 2
  for (int k = 0; k < 64; ++k) {
    const float s = Sl[lane * 65 + k];
#pragma unroll
    for (int q = 0; q < 8; ++q) y[q] += s * Wl[(wave * 8 + q) * 65 + k];
  }
  const float lng = p.in[18][l * 512 + h * 64 + lane], lnb = p.in[19][l * 512 + h * 64 + lane];
#pragma unroll
  for (int q = 0; q < 8; ++q) {
    const int t = wave * 8 + q;
    const float mean = wave_sum(y[q]) * (1.f / 64.f);
    const float d = y[q] - mean;
    const float var = wave_sum(d * d) * (1.f / 64.f);
    const float yn = d * rsqrtf(var + 64e-5f) * lng + lnb;
    const float o = (yn + bf2f(BO[t * 64 + lane])) * bf2f(GA[t * 64 + lane]);
    z[(size_t)(cidx * 64 + t) * ZLD + h * 64 + lane] = f2bf(o);
  }
}

__device__ __forceinline__ void rwkv_out4(const Params& p, int l, int item0, float* ldsf) {
  const int tid = opq(threadIdx.x), lane = tid & 63, wave = tid >> 6;
  const int r = lane & 31, hf = lane >> 5;
  const int pair = wave >> 1, nt = wave & 1;
  const int item = item0 + pair;
  const int h = item & 7, cidx = item >> 3;
  u16* Sl = (u16*)ldsf + pair * 4608;
  const float* Sg = (const float*)(p.ws + WS_Q) + (size_t)item * 4096;
  const u16* W2 = (const u16*)(p.ws + WS_W2) + (size_t)item * 4096;
  const u16* YL = (const u16*)(p.ws + WS_YL) + (size_t)item * 4096;
  const u16* BO = (const u16*)(p.ws + WS_BO) + (size_t)item * 4096;
  const u16* GA = (const u16*)(p.ws + WS_GA) + (size_t)item * 4096;
  u16* z = (u16*)(p.ws + WS_Z);
  __syncthreads();
  {
    const int lt = tid & 127;
#pragma unroll
    for (int q = 0; q < 8; ++q) {
      const int e = q * 128 + lt;
      const int ln = e & 63, g = (e >> 6) & 3, kt = (e >> 8) & 1, vt = (e >> 9) & 1;
      const float* sp = Sg + ((vt * 2 + kt) * 16 + 4 * g) * 64 + ln;
      const float a0 = sp[0], a1 = sp[64], a2 = sp[128], a3 = sp[192];
      uint2 o; o.x = pack2(a0, a1); o.y = pack2(a2, a3);
      *(uint2*)(Sl + (vt * 32 + (ln & 31)) * 72 + kt * 32 + 8 * g + 4 * (ln >> 5)) = o;
    }
  }
  bf16x8 bfr[4];
#pragma unroll
  for (int s_ = 0; s_ < 4; ++s_) bfr[s_] = *(const bf16x8*)(W2 + (nt * 32 + r) * 64 + s_ * 16 + hf * 8);
  __syncthreads();
  f32x16 acc[2];
#pragma unroll
  for (int mt = 0; mt < 2; ++mt) {
#pragma unroll
    for (int i = 0; i < 16; ++i) acc[mt][i] = 0.f;
#pragma unroll
    for (int s_ = 0; s_ < 4; ++s_) {
      const bf16x8 a = *(const bf16x8*)(Sl + (mt * 32 + r) * 72 + s_ * 16 + hf * 8);
      acc[mt] = __builtin_amdgcn_mfma_f32_32x32x16_bf16(a, bfr[s_], acc[mt], 0, 0, 0);
    }
  }
  const int t = nt * 32 + r;
  float sum = 0.f;
#pragma unroll
  for (int mt = 0; mt < 2; ++mt)
#pragma unroll
    for (int g = 0; g < 4; ++g) {
      const uint2 yl = *(const uint2*)(YL + t * 64 + mt * 32 + 8 * g + 4 * hf);
      acc[mt][4 * g + 0] += __uint_as_float(yl.x << 16); acc[mt][4 * g + 1] += __uint_as_float(yl.x & 0xFFFF0000u);
      acc[mt][4 * g + 2] += __uint_as_float(yl.y << 16); acc[mt][4 * g + 3] += __uint_as_float(yl.y & 0xFFFF0000u);
      sum += acc[mt][4 * g] + acc[mt][4 * g + 1] + acc[mt][4 * g + 2] + acc[mt][4 * g + 3];
    }
  sum += __shfl_xor(sum, 32, 64);
  const float mean = sum * (1.f / 64.f);
  float vs = 0.f;
#pragma unroll
  for (int mt = 0; mt < 2; ++mt)
#pragma unroll
    for (int i = 0; i < 16; ++i) { const float d = acc[mt][i] - mean; vs += d * d; }
  vs += __shfl_xor(vs, 32, 64);
  const float rstd = rsqrtf(vs * (1.f / 64.f) + 64e-5f);
  const float* lng = p.in[18] + l * 512 + h * 64;
  const float* lnb = p.in[19] + l * 512 + h * 64;
  u16* zrow = z + (size_t)(cidx * 64 + t) * ZLD + h * 64;
#pragma unroll
  for (int mt = 0; mt < 2; ++mt)
#pragma unroll
    for (int g = 0; g < 4; ++g) {
      const int v0 = mt * 32 + 8 * g + 4 * hf;
      const uint2 bo = *(const uint2*)(BO + t * 64 + v0);
      const uint2 ga = *(const uint2*)(GA + t * 64 + v0);
      const float4 lg = *(const float4*)(lng + v0), lb = *(const float4*)(lnb + v0);
      const float bo_[4] = {__uint_as_float(bo.x << 16), __uint_as_float(bo.x & 0xFFFF0000u), __uint_as_float(bo.y << 16), __uint_as_float(bo.y & 0xFFFF0000u)};
      const float ga_[4] = {__uint_as_float(ga.x << 16), __uint_as_float(ga.x & 0xFFFF0000u), __uint_as_float(ga.y << 16), __uint_as_float(ga.y & 0xFFFF0000u)};
      const float lg_[4] = {lg.x, lg.y, lg.z, lg.w}, lb_[4] = {lb.x, lb.y, lb.z, lb.w};
      float o[4];
#pragma unroll
      for (int u = 0; u < 4; ++u) o[u] = ((acc[mt][4 * g + u] - mean) * rstd * lg_[u] + lb_[u] + bo_[u]) * ga_[u];
      uint2 ov; ov.x = pack2(o[0], o[1]); ov.y = pack2(o[2], o[3]);
      *(uint2*)(zrow + v0) = ov;
    }
}

__device__ __forceinline__ void attn_prompt(const Params& p, int l, int item, u16* lds, bool dry = false) {
  const int tid = opq(threadIdx.x), lane = tid & 63, wave = tid >> 6;
  const int r = lane & 31, h = lane >> 5;
  const int kvh = item & 1, n = (item >> 1) & 63, b = item >> 7;
  u16* z = (u16*)(p.ws + WS_Z);
  u16* Ks = lds;
  u16* Vt = lds + 256 * 72;
  __syncthreads();
  {
    const int key = tid >> 1, half = tid & 1;
    const int t = (n - 1) * 128 + key;
    uint4 kv[4], vv[4];
    if (t >= 0) {
      const u16* kp = z + (size_t)(b * 8192 + t) * ZLD + 2304 + kvh * 64 + half * 32;
      const u16* vp = z + (size_t)(b * 8192 + t) * ZLD + 2432 + kvh * 64 + half * 32;
#pragma unroll
      for (int i = 0; i < 4; ++i) { kv[i] = *(const uint4*)(kp + i * 8); vv[i] = *(const uint4*)(vp + i * 8); }
    } else {
#pragma unroll
      for (int i = 0; i < 4; ++i) { kv[i] = make_uint4(0, 0, 0, 0); vv[i] = make_uint4(0, 0, 0, 0); }
    }
#pragma unroll
    for (int i = 0; i < 4; ++i) {
      *(uint4*)(Ks + key * 72 + half * 32 + i * 8) = kv[i];
      const unsigned w[4] = {vv[i].x, vv[i].y, vv[i].z, vv[i].w};
#pragma unroll
      for (int q = 0; q < 4; ++q) {
        const int d = half * 32 + i * 8 + q * 2;
        Vt[d * 264 + key] = (u16)(w[q] & 0xFFFFu);
        Vt[(d + 1) * 264 + key] = (u16)(w[q] >> 16);
      }
    }
  }
  __syncthreads();
#pragma unroll 1
  for (int uu = 0; uu < 2; ++uu) {
    const int u = wave * 2 + uu;
    const int hq = kvh * 4 + (u >> 2), qg = u & 3;
    const int qrow = b * 8192 + n * 128 + qg * 32 + r;
    u16* qp = z + (size_t)qrow * ZLD + 1792 + hq * 64;
    bf16x8 qf[4];
#pragma unroll
    for (int s = 0; s < 4; ++s) qf[s] = *(const bf16x8*)(qp + s * 16 + h * 8);
    f32x16 sc[5];
#pragma unroll
    for (int i5 = 0; i5 < 5; ++i5) {
#pragma unroll
      for (int i = 0; i < 16; ++i) sc[i5][i] = 0.f;
      const int kt = qg + i5;
#pragma unroll
      for (int s = 0; s < 4; ++s) {
        bf16x8 kf = *(const bf16x8*)(Ks + (kt * 32 + r) * 72 + s * 16 + h * 8);
        sc[i5] = __builtin_amdgcn_mfma_f32_32x32x16_bf16(kf, qf[s], sc[i5], 0, 0, 0);
      }
      __builtin_amdgcn_sched_barrier(0);
    }
    const int qi = qg * 32 + r;
    const float sink = p.in[20][l * 8 + hq];
    float mx = -1e30f;
#pragma unroll
    for (int i5 = 0; i5 < 5; ++i5)
#pragma unroll
      for (int reg = 0; reg < 16; ++reg) {
        const int j = (qg + i5) * 32 + ROWOFF(reg, h);
        const bool ok = (j > qi) && (j <= qi + 128) && (n > 0 || j >= 128);
        const float s = ok ? sc[i5][reg] * 0.125f : -1e30f;
        sc[i5][reg] = s;
        mx = fmaxf(mx, s);
      }
    mx = fmaxf(mx, __shfl_xor(mx, 32, 64));
    mx = fmaxf(mx, sink);
    float sum = 0.f;
#pragma unroll
    for (int i5 = 0; i5 < 5; ++i5)
#pragma unroll
      for (int reg = 0; reg < 16; ++reg) { const float e = __expf(sc[i5][reg] - mx); sc[i5][reg] = e; sum += e; }
    sum += __shfl_xor(sum, 32, 64);
    const float rden = 1.f / (sum + __expf(sink - mx));
    f32x16 oacc[2];
#pragma unroll
    for (int i = 0; i < 16; ++i) { oacc[0][i] = 0.f; oacc[1][i] = 0.f; }
#pragma unroll
    for (int i5 = 0; i5 < 5; ++i5) {
      const int kt = qg + i5;
#pragma unroll
      for (int s2 = 0; s2 < 2; ++s2) {
        bf16x8 pf;
#pragma unroll
        for (int j = 0; j < 8; ++j) pf[j] = (short)f2bf(sc[i5][s2 * 8 + j] * rden);
#pragma unroll
        for (int dt = 0; dt < 2; ++dt) {
          const u16* vp = Vt + (dt * 32 + r) * 264 + kt * 32 + s2 * 16 + h * 4;
          const uint2 lo = *(const uint2*)vp, hi = *(const uint2*)(vp + 8);
          union { uint4 u; bf16x8 v; } cv;
          cv.u = make_uint4(lo.x, lo.y, hi.x, hi.y);
          oacc[dt] = __builtin_amdgcn_mfma_f32_32x32x16_bf16(cv.v, pf, oacc[dt], 0, 0, 0);
        }
        __builtin_amdgcn_sched_barrier(0);
      }
    }
#pragma unroll
    for (int dt = 0; dt < 2; ++dt)
#pragma unroll
      for (int g4 = 0; g4 < 4; ++g4) {
        const int d = dt * 32 + 8 * g4 + 4 * h;
        uint2 o;
        o.x = pack2(oacc[dt][g4 * 4 + 0], oacc[dt][g4 * 4 + 1]);
        o.y = pack2(oacc[dt][g4 * 4 + 2], oacc[dt][g4 * 4 + 3]);
        if (!dry) *(uint2*)(qp + d) = o;
      }
  }
}

__device__ __forceinline__ void attn_sample(const Params& p, int l, int item, float* ldsf, bool dry = false) {
  const int tid = opq(threadIdx.x);
  const int kvh = item & 1, b = item >> 1;
  u16* z = (u16*)(p.ws + WS_Z);
  float* Kl = ldsf;
  float* Vl = ldsf + 132 * 65;
  float* Ql = Vl + 132 * 65;
  float* Pl = Ql + 16 * 64;
  __syncthreads();
  for (int e = tid; e < 132 * 8; e += NT) {
    const int j = e >> 3, c = (e & 7) * 8;
    float k[8], v[8];
    if (j < 128) {
      const float* kp = p.in[4] + ((size_t)((l * 128 + b) * 128 + j) * 2 + kvh) * 64 + c;
      const float* vp = p.in[5] + ((size_t)((l * 128 + b) * 128 + j) * 2 + kvh) * 64 + c;
      float4 a = *(const float4*)kp, a2 = *(const float4*)(kp + 4);
      float4 c1 = *(const float4*)vp, c2 = *(const float4*)(vp + 4);
      k[0] = a.x; k[1] = a.y; k[2] = a.z; k[3] = a.w; k[4] = a2.x; k[5] = a2.y; k[6] = a2.z; k[7] = a2.w;
      v[0] = c1.x; v[1] = c1.y; v[2] = c1.z; v[3] = c1.w; v[4] = c2.x; v[5] = c2.y; v[6] = c2.z; v[7] = c2.w;
    } else {
      const size_t row = M_P + b * 4 + (j - 128);
      unpack8(*(const uint4*)(z + row * ZLD + 2304 + kvh * 64 + c), k);
      unpack8(*(const uint4*)(z + row * ZLD + 2432 + kvh * 64 + c), v);
    }
#pragma unroll
    for (int i = 0; i < 8; ++i) { Kl[j * 65 + c + i] = k[i]; Vl[j * 65 + c + i] = v[i]; }
    if (j >= 4) {
      float* ok = p.out + O_SK + ((size_t)((l * 128 + b) * 128 + (j - 4)) * 2 + kvh) * 64 + c;
      float* ov = p.out + O_SV + ((size_t)((l * 128 + b) * 128 + (j - 4)) * 2 + kvh) * 64 + c;
      *(float4*)ok = make_float4(k[0], k[1], k[2], k[3]); *(float4*)(ok + 4) = make_float4(k[4], k[5], k[6], k[7]);
      *(float4*)ov = make_float4(v[0], v[1], v[2], v[3]); *(float4*)(ov + 4) = make_float4(v[4], v[5], v[6], v[7]);
    }
  }
  if (tid < 128) {
    const int row = tid >> 3, c = (tid & 7) * 8;
    const int hl = row >> 2, t = row & 3;
    float q[8];
    unpack8(*(const uint4*)(z + (size_t)(M_P + b * 4 + t) * ZLD + 1792 + (kvh * 4 + hl) * 64 + c), q);
#pragma unroll
    for (int i = 0; i < 8; ++i) Ql[row * 64 + c + i] = q[i];
  }
  __syncthreads();
  const int row = tid >> 5, jl = tid & 31;
  const int t = row & 3, hq = kvh * 4 + (row >> 2);
  float sc[5];
  float mx = -1e30f;
#pragma unroll
  for (int jj = 0; jj < 5; ++jj) {
    const int j = jl + 32 * jj;
    float s = -1e30f;
    if (j < 132 && j > t && j <= t + 128) {
      float a = 0.f;
#pragma unroll 8
      for (int d = 0; d < 64; ++d) a += Ql[row * 64 + d] * Kl[j * 65 + d];
      s = a * 0.125f;
    }
    sc[jj] = s; mx = fmaxf(mx, s);
    __builtin_amdgcn_sched_barrier(0);
  }
#pragma unroll
  for (int o = 16; o >= 1; o >>= 1) mx = fmaxf(mx, __shfl_xor(mx, o, 64));
  const float sink = p.in[20][l * 8 + hq];
  mx = fmaxf(mx, sink);
  float sum = 0.f;
#pragma unroll
  for (int jj = 0; jj < 5; ++jj) { sc[jj] = __expf(sc[jj] - mx); sum += sc[jj]; }
#pragma unroll
  for (int o = 16; o >= 1; o >>= 1) sum += __shfl_xor(sum, o, 64);
  const float rden = 1.f / (sum + __expf(sink - mx));
#pragma unroll
  for (int jj = 0; jj < 5; ++jj) { const int j = jl + 32 * jj; if (j < 136) Pl[row * 136 + j] = sc[jj] * rden; }
  __syncthreads();
  {
    const int d = jl * 2;
    float o0 = 0.f, o1 = 0.f;
#pragma unroll 4
    for (int j = 0; j < 132; ++j) { const float pr = Pl[row * 136 + j]; o0 += pr * Vl[j * 65 + d]; o1 += pr * Vl[j * 65 + d + 1]; }
    if (!dry) *(unsigned*)(z + (size_t)(M_P + b * 4 + t) * ZLD + 1792 + hq * 64 + d) = pack2(o0, o1);
  }
}

__device__ __forceinline__ void phase_convgelu(const Params& p, int l, bool dry = false) {
  u16* cu = (u16*)(p.ws + WS_CU);
  const float* cw = p.in[26] + (size_t)l * 3 * 2816;
  const float* cb = p.in[27] + (size_t)l * 2816;
  for (int it = blockIdx.x; it < 2112; it += gridDim.x) {
    const int tid = opq(threadIdx.x);
    if (tid >= 352) continue;
    const int j0 = tid * 8;
    float w0[8], w1[8], w2[8], bb[8];
#pragma unroll
    for (int i = 0; i < 8; ++i) { w0[i] = cw[j0 + i]; w1[i] = cw[2816 + j0 + i]; w2[i] = cw[5632 + j0 + i]; bb[i] = cb[j0 + i]; }
    float c1[8], c2[8];
    for (int rr = 0; rr < 8; ++rr) {
      const int row = it * 8 + rr;
      const bool prompt = row < M_P;
      int b, t;
      if (prompt) { b = row >> 13; t = row & 8191; } else { b = (row - M_P) >> 2; t = (row - M_P) & 3; }
      if (t == 0) {
        if (prompt) {
#pragma unroll
          for (int i = 0; i < 8; ++i) { c1[i] = 0.f; c2[i] = 0.f; }
        } else {
          const float* st = p.in[6] + (size_t)((l * 128 + b) * 2) * 2816 + j0;
#pragma unroll
          for (int i = 0; i < 8; ++i) { c2[i] = st[i]; c1[i] = st[2816 + i]; }
        }
      } else if (rr == 0) {
        unpack8(*(const uint4*)(cu + (size_t)(row - 1) * 5632 + j0), c1);
        if (t >= 2) unpack8(*(const uint4*)(cu + (size_t)(row - 2) * 5632 + j0), c2);
        else {
#pragma unroll
          for (int i = 0; i < 8; ++i) c2[i] = 0.f;
        }
      }
      float c0[8], up[8], a[8];
      unpack8(*(const uint4*)(cu + (size_t)row * 5632 + j0), c0);
      unpack8(*(const uint4*)(cu + (size_t)row * 5632 + 2816 + j0), up);
#pragma unroll
      for (int i = 0; i < 8; ++i) {
        const float cv = bb[i] + w0[i] * c2[i] + w1[i] * c1[i] + w2[i] * c0[i];
        a[i] = gelu_fast(cv) * up[i];
      }
      if (!dry) *(uint4*)(cu + (size_t)row * 5632 + 2816 + j0) = pack8(a);
      if (prompt && t >= 8190) {
        float* o = p.out + O_PCONV + (size_t)((l * 2 + b) * 2 + (t - 8190)) * 2816 + j0;
        *(float4*)o = make_float4(c0[0], c0[1], c0[2], c0[3]); *(float4*)(o + 4) = make_float4(c0[4], c0[5], c0[6], c0[7]);
      } else if (!prompt && t >= 2) {
        float* o = p.out + O_SCONV + (size_t)((l * 128 + b) * 2 + (t - 2)) * 2816 + j0;
        *(float4*)o = make_float4(c0[0], c0[1], c0[2], c0[3]); *(float4*)(o + 4) = make_float4(c0[4], c0[5], c0[6], c0[7]);
      }
#pragma unroll
      for (int i = 0; i < 8; ++i) { c2[i] = c1[i]; c1[i] = c0[i]; }
    }
  }
}

__device__ __forceinline__ void phase_final(const Params& p) {
  float* X = p.out;
  const float* g = p.in[29];
  for (int it = blockIdx.x; it < 2112; it += gridDim.x) {
    const int tid = opq(threadIdx.x);
    const int lane = tid & 63;
    const int row = it * 8 + (tid >> 6);
    float4 v[4];
    float ss = 0.f;
#pragma unroll
    for (int i = 0; i < 4; ++i) {
      v[i] = *(const float4*)(X + (size_t)row * 1024 + i * 256 + lane * 4);
      if (gridDim.x == 256 && row >= M_P) {
        const u16* partb = (const u16*)(p.ws + WS_DP) + (size_t)(row - M_P) * 1024 + i * 256 + lane * 4;
        for (int k = 0; k < 11; ++k) { const uint2 q = *(const uint2*)(partb + (size_t)k * 512 * 1024);
          v[i].x += __uint_as_float(q.x << 16); v[i].y += __uint_as_float(q.x & 0xFFFF0000u); v[i].z += __uint_as_float(q.y << 16); v[i].w += __uint_as_float(q.y & 0xFFFF0000u); }
      }
      ss += v[i].x * v[i].x + v[i].y * v[i].y + v[i].z * v[i].z + v[i].w * v[i].w;
    }
    ss = wave_sum(ss);
    const float rs = rsqrtf(ss * (1.f / 1024.f) + 1e-6f);
#pragma unroll
    for (int i = 0; i < 4; ++i) {
      const float4 gg = *(const float4*)(g + i * 256 + lane * 4);
      *(float4*)(X + (size_t)row * 1024 + i * 256 + lane * 4) =
          make_float4(v[i].x * rs * gg.x, v[i].y * rs * gg.y, v[i].z * rs * gg.z, v[i].w * rs * gg.w);
    }
  }
}

#define XB_TMO      128
#define XB_XCNT(j)  (256  + 64 * (j))
#define XB_XSUB(j)  (1280 + 64 * (j))
#define XB_XGEN(j)  (2304 + 64 * (j))
#define XB_TOP      3328
#define XB_TOPGEN   3392
#define XCD_BAR_WORDS 3456
#define XB_SPIN_CAP (1u << 18)
#define LAS __attribute__((address_space(3)))

__device__ __forceinline__ unsigned xb_ld(unsigned* p)              { return __hip_atomic_load(p, __ATOMIC_RELAXED, __HIP_MEMORY_SCOPE_AGENT); }
__device__ __forceinline__ unsigned xb_add(unsigned* p, unsigned v) { return __hip_atomic_fetch_add(p, v, __ATOMIC_RELAXED, __HIP_MEMORY_SCOPE_AGENT); }
__device__ __forceinline__ unsigned xb_xcc_id() { return (unsigned)__builtin_amdgcn_s_getreg((3 << 11) | 20) & 0xFu; }
#define XB_SPIN(cond, bar) do { unsigned _sp = 0; while (cond) { __builtin_amdgcn_s_sleep(1); \
    if ((++_sp & 255u) == 0u) { if (xb_ld(&(bar)[XB_TMO])) break; if (_sp > XB_SPIN_CAP) { atomicAdd(&(bar)[XB_TMO], 1u); break; } } } } while (0)

struct XcdBarrier {
    unsigned* bar; unsigned x;
    volatile LAS unsigned* st;
};

__device__ __forceinline__ XcdBarrier xcd_barrier_post(unsigned* bar, volatile LAS unsigned* st) {
    XcdBarrier b; b.bar = bar; b.x = xb_xcc_id(); b.st = st;
    if (threadIdx.x == 0) (void)xb_add(&bar[XB_XCNT(b.x)], 1u);
    return b;
}
__device__ __forceinline__ void xcd_barrier_complete(unsigned* bar, unsigned x, unsigned& nloc, unsigned& nx) {
    const unsigned G = gridDim.x * gridDim.y * gridDim.z;
    unsigned sum, cnt, mine, sp = 0u;
    for (;;) {
        sum = 0u; cnt = 0u; mine = 0u;
#pragma unroll
        for (unsigned j = 0; j < 16; ++j) { const unsigned c = xb_ld(&bar[XB_XCNT(j)]); sum += c; cnt += (c > 0u) ? 1u : 0u; mine = (j == x) ? c : mine; }
        if (sum == G) break;
        __builtin_amdgcn_s_sleep(1);
        if ((++sp & 255u) == 0u) { if (xb_ld(&bar[XB_TMO])) break; if (sp > XB_SPIN_CAP) { atomicAdd(&bar[XB_TMO], 1u); break; } }
    }
    nloc = mine > 0u ? mine : 1u; nx = cnt > 0u ? cnt : 1u;
}

__device__ __forceinline__ void xcd_barrier(const XcdBarrier& b) {
    asm volatile("s_waitcnt vmcnt(0)" ::: "memory");
    __syncthreads();
    if (threadIdx.x == 0) {
        unsigned* bar = b.bar;
        __builtin_amdgcn_s_waitcnt(0);
        unsigned nloc = b.st[0], nx = b.st[1];
        if (nloc == 0u) { xcd_barrier_complete(bar, b.x, nloc, nx); b.st[0] = nloc; b.st[1] = nx; }
        const unsigned old = xb_add(&bar[XB_XSUB(b.x)], 1u);
        const unsigned gen = old / nloc;
        if (old + 1u == (gen + 1u) * nloc) {
            __builtin_amdgcn_fence(__ATOMIC_RELEASE, "agent");
            asm volatile("s_waitcnt vmcnt(0)" ::: "memory");
            const unsigned og = xb_add(&bar[XB_TOP], 1u);
            const unsigned tg = og / nx;
            if (og + 1u == (tg + 1u) * nx) xb_add(&bar[XB_TOPGEN], 1u);
            else XB_SPIN(xb_ld(&bar[XB_TOPGEN]) == tg, bar);
            __builtin_amdgcn_fence(__ATOMIC_ACQUIRE, "agent");
            xb_add(&bar[XB_XGEN(b.x)], 1u);
            asm volatile("s_waitcnt vmcnt(0)" ::: "memory");
        } else {
            XB_SPIN(xb_ld(&bar[XB_XGEN(b.x)]) == gen, bar);
            __builtin_amdgcn_fence(__ATOMIC_ACQUIRE, "agent");
            asm volatile("s_waitcnt vmcnt(0)" ::: "memory");
        }
    }
    __syncthreads();
}

#define WS_BAR 256000000ull
#if COOP
#ifndef SYNC_RPT
#define SYNC_RPT 1
#endif
#define PH_SYNC(idx) do { if ((idx) + 1 < ph_hi && (idx) >= ph_lo) { for (int sr_ = 0; sr_ < SYNC_RPT; ++sr_) xcd_barrier(xb); } } while (0)
#else
#define PH_SYNC(idx) do { } while (0)
#endif
#define PH_ON(idx, bit) (((KMASK >> (bit)) & 1) && ph_lo <= (idx) && (idx) < ph_hi)

__device__ __forceinline__ Params load_params() {
  auto kp0 = __builtin_amdgcn_kernarg_segment_ptr();
  asm volatile("" : "+s"(kp0));
  auto kq = (const __constant__ unsigned long long*)kp0;
  Params p;
#pragma unroll
  for (int i = 0; i < 30; ++i) p.in[i] = (const float*)kq[i];
  p.out = (float*)kq[30];
  p.ws = (unsigned char*)kq[31];
  p.ph_lo = 0; p.ph_hi = 0;
  return p;
}

template <int KMASK, int l>
__device__ __forceinline__ void layer_phases(int ph_lo, int ph_hi, unsigned char* lds_raw, const XcdBarrier& xb) {
  float* ldsf = (float*)lds_raw;
  u16* ldsh = (u16*)lds_raw;
  const int base = l * 12;
  if (PH_ON(base + 0, 0)) { const Params p = load_params(); RPT(0) phase_prep(p, l, 0, ldsf); }
  PH_SYNC(base + 0);
  if (PH_ON(base + 1, 1)) {
    const Params p = load_params();
    EpiInproj E; E.z = (u16*)(p.ws + WS_Z); E.out = p.out; E.l = l;
    RPT(1) run_gemm(lds_raw, (const u16*)(p.ws + WS_H), 1024, (const u16*)(p.ws + WS_WT) + WT_IN, 2560, 1024, E);
  }
  PH_SYNC(base + 1);
  if (PH_ON(base + 2, 2)) {
    const Params p = load_params();
    for (int it = blockIdx.x; it < 264; it += gridDim.x) rope_item(p, l, it, false);
    if (blockIdx.x < 64) rwkv_item(p, l, 2048 + blockIdx.x, ldsf, false);
    {
      const Params p2 = load_params();
      int i0, n;
      if (gridDim.x == 256) { if (blockIdx.x < 64) { i0 = blockIdx.x * 5; n = 5; } else { i0 = 320 + (blockIdx.x - 64) * 9; n = 9; } }
      else { i0 = 0; n = 0; }
      RPT(2) {
        if (gridDim.x == 256) { for (int i = 0; i < n; ++i) rwkv_item2(p2, l, i0 + i, ldsf); }
        else { for (int it = blockIdx.x; it < 2048; it += gridDim.x) rwkv_item2(p2, l, it, ldsf); }
      }
    }
  }
  PH_SYNC(base + 2);
  if (PH_ON(base + 3, 3)) {
    const Params p = load_params();
    if (blockIdx.x < 16) { RPT(3) rwkv_scan(p, l, blockIdx.x, ldsf, DRY(3)); }
    else {
      RPT(15) for (int it = blockIdx.x - 16; it < 512; it += gridDim.x - 16) {
        if (it < 256) attn_prompt(p, l, it, ldsh, DRY(15)); else attn_sample(p, l, it - 256, ldsf, DRY(15));
      }
      if (gridDim.x == 256 && blockIdx.x < 32) {
        EpiSig Es; Es.sr = (u16*)(p.ws + WS_SG); Es.sa = (u16*)(p.ws + WS_SG) + (size_t)512 * 1024;
        run_gemm_ex(lds_raw, (const u16*)(p.ws + WS_H) + (size_t)M_P * 1024, 1024, (const u16*)(p.ws + WS_WT) + WT_G, 1024, 512, 2048, 1024, 16,
                    (int)blockIdx.x - 16, Es);
      }
    }
  }
  PH_SYNC(base + 3);
  if (PH_ON(base + 4, 4)) {
    const Params p = load_params();
    RPT(4) for (int it = blockIdx.x * 4; it < 2048; it += gridDim.x * 4) rwkv_out4(p, l, it, ldsf);
  }
  PH_SYNC(base + 4);
  if (PH_ON(base + 5, 5)) {
    const Params p = load_params();
    EpiStoreBf16 E1; E1.O = (u16*)(p.ws + WS_T1); E1.ldc = 1024; E1.rowoff = 0;
    EpiStoreBf16 E2; E2.O = (u16*)(p.ws + WS_T2); E2.ldc = 1024; E2.rowoff = 0;
    const u16* zA = (const u16*)(p.ws + WS_Z);
    const u16* Wr = (const u16*)(p.ws + WS_WT) + WT_BRA;
    const u16* Wa = (const u16*)(p.ws + WS_WT) + WT_BRB;
    RPT(5) {
      if (gridDim.x == 256) {
        run_gemm_ex(lds_raw, zA, ZLD, Wr, 512, M_P, 1024, 512, 256, (int)blockIdx.x, E1);
        run_gemm_ex(lds_raw, zA + 1792, ZLD, Wa, 512, M_P, 1024, 512, 256, (int)blockIdx.x, E2);
        const int wh = (blockIdx.x >> 3) & 1, ks = (blockIdx.x >> 4) & 1;
        EpiStoreBf16 E3; E3.ldc = 1024; E3.rowoff = 0; E3.O = (u16*)(p.ws + WS_SG) + (size_t)(2 + wh * 2 + ks) * 512 * 1024;
        run_gemm_ex(lds_raw, zA + (size_t)M_P * ZLD + (wh ? 1792 : 0) + ks * 256, ZLD, (wh ? Wa : Wr) + ks * 256, 512, 512, 1024, 256, 8,
                    (blockIdx.x < 32) ? (int)(blockIdx.x & 7) : -1, E3);

      } else {
        run_gemm(lds_raw, zA, ZLD, Wr, 1024, 512, E1);
        run_gemm(lds_raw, zA + 1792, ZLD, Wa, 1024, 512, E2);
      }
    }
  }
  PH_SYNC(base + 5);
  if (PH_ON(base + 6, 6)) {
    const Params p = load_params();
    EpiMerge E; E.t1 = (const u16*)(p.ws + WS_T1); E.t2 = (const u16*)(p.ws + WS_T2); E.mg = (u16*)(p.ws + WS_MG);
    RPT(6) {
      if (gridDim.x == 256) {
        run_gemm_ex(lds_raw, (const u16*)(p.ws + WS_H), 1024, (const u16*)(p.ws + WS_WT) + WT_G, 1024, M_P, 2048, 1024, 256, (int)blockIdx.x, E);
        const int gid = blockIdx.x * NT + opq(threadIdx.x);
        if (gid < 65536) {
          const int r_ = gid >> 7, c_ = (gid & 127) * 8;
          const size_t offs = (size_t)r_ * 1024 + c_, offm = (size_t)(M_P + r_) * 1024 + c_;
          float a[8], b[8], gr[8], ga[8], o[8];
          {
            const u16* pb = (const u16*)(p.ws + WS_SG) + (size_t)2 * 512 * 1024 + offs;
            float a1[8], b1[8];
            unpack8(*(const uint4*)pb, a); unpack8(*(const uint4*)(pb + (size_t)512 * 1024), a1);
            unpack8(*(const uint4*)(pb + (size_t)2 * 512 * 1024), b); unpack8(*(const uint4*)(pb + (size_t)3 * 512 * 1024), b1);
#pragma unroll
            for (int i = 0; i < 8; ++i) { a[i] += a1[i]; b[i] += b1[i]; }
          }
          unpack8(*(const uint4*)((const u16*)(p.ws + WS_SG) + offs), gr);
          unpack8(*(const uint4*)((const u16*)(p.ws + WS_SG) + (size_t)512 * 1024 + offs), ga);
#pragma unroll
          for (int i = 0; i < 8; ++i) o[i] = gr[i] * a[i] + ga[i] * b[i];
          *(uint4*)(E.mg + offm) = pack8(o);
        }
      } else {
        run_gemm(lds_raw, (const u16*)(p.ws + WS_H), 1024, (const u16*)(p.ws + WS_WT) + WT_G, 2048, 1024, E);
      }
    }
  }
  PH_SYNC(base + 6);
  if (PH_ON(base + 7, 7)) {
    const Params p = load_params();
    EpiResid E; E.X = p.out;
    RPT(7) {
      E.dry = DRY(7); E.X = p.out; E.pbf = nullptr;
      if (gridDim.x == 256) {
        E.atomic = false; E.rowoff = 0;
        run_gemm_ex(lds_raw, (const u16*)(p.ws + WS_MG), 1024, (const u16*)(p.ws + WS_WT) + WT_OUT, 1024, M_P, 1024, 1024, 256, (int)blockIdx.x, E);
        const int ks = blockIdx.x >> 3;
        E.atomic = true; E.rowoff = 0; E.X = (float*)(p.ws + WS_T1) + (size_t)ks * 512 * 1024;
        run_gemm_ex(lds_raw, (const u16*)(p.ws + WS_MG) + (size_t)M_P * 1024 + ks * 256, 1024, (const u16*)(p.ws + WS_WT) + WT_OUT + ks * 256, 1024,
                    512, 1024, 256, 8, (blockIdx.x < 32) ? (int)(blockIdx.x & 7) : -1, E);
      } else {
        E.atomic = false; E.rowoff = 0;
        run_gemm(lds_raw, (const u16*)(p.ws + WS_MG), 1024, (const u16*)(p.ws + WS_WT) + WT_OUT, 1024, 1024, E);
      }
    }
  }
  PH_SYNC(base + 7);
  if (PH_ON(base + 8, 8)) { const Params p = load_params(); RPT(8) phase_prep(p, l, 1, ldsf); }
  PH_SYNC(base + 8);
  if (PH_ON(base + 9, 9)) {
    const Params p = load_params();
    EpiFfnIn E; E.cu = (u16*)(p.ws + WS_CU);
    RPT(9) run_gemm(lds_raw, (const u16*)(p.ws + WS_H), 1024, (const u16*)(p.ws + WS_WTF) + WT_FIN, 5632, 1024, E);
  }
  PH_SYNC(base + 9);
  if (PH_ON(base + 10, 10)) { const Params p = load_params(); RPT(10) phase_convgelu(p, l, DRY(10)); }
  PH_SYNC(base + 10);
  if (PH_ON(base + 11, 11)) {
    const Params p = load_params();
    EpiResid E; E.X = p.out;
    RPT(11) {
      E.dry = DRY(11); E.X = p.out; E.pbf = nullptr;
      const u16* Aa = (const u16*)(p.ws + WS_CU) + 2816;
      const u16* Bd = (const u16*)(p.ws + WS_WTF) + WT_FDN;
      if (gridDim.x == 256) {
        E.atomic = false; E.rowoff = 0;
        run_gemm_ex(lds_raw, Aa, 5632, Bd, 2816, M_P, 1024, 2816, 256, (int)blockIdx.x, E);
        const int ks = blockIdx.x >> 3;
        E.atomic = true; E.rowoff = 0; E.X = nullptr; E.pbf = (u16*)(p.ws + WS_DP) + (size_t)ks * 512 * 1024;
        run_gemm_ex(lds_raw, Aa + (size_t)M_P * 5632 + ks * 256, 5632, Bd + ks * 256, 2816, 512, 1024, 256, 8, (blockIdx.x < 88) ? (int)(blockIdx.x & 7) : -1, E);
      } else {
        E.atomic = false; E.rowoff = 0;
        run_gemm(lds_raw, Aa, 5632, Bd, 1024, 2816, E);
      }
    }
  }
  PH_SYNC(base + 11);
}

template <int KMASK>
__global__ void __launch_bounds__(NT) fwd_kernel(Params pin) {
  extern __shared__ __attribute__((aligned(16))) unsigned char lds_raw[];
  const int ph_lo = pin.ph_lo, ph_hi = pin.ph_hi;
  XcdBarrier xb;
  {
    volatile LAS unsigned* st = (volatile LAS unsigned*)(lds_raw + (LDS_BYTES - 16));
    if (threadIdx.x < 2) st[threadIdx.x] = 0u;
    __syncthreads();
    xb = xcd_barrier_post((unsigned*)(pin.ws + WS_BAR), st);
  }
  if (ph_hi > 100000) cg::this_grid().sync();
  layer_phases<KMASK, 0>(ph_lo, ph_hi, lds_raw, xb);
  layer_phases<KMASK, 1>(ph_lo, ph_hi, lds_raw, xb);
  if (PH_ON(NPH - 1, 12)) { const Params p = load_params(); phase_final(p); }
}

extern "C" void kernel_launch(void* const* d_in, const int* in_sizes, int n_in, void* d_out, int out_size, void* d_ws,
                              size_t ws_size, hipStream_t stream) {
  static int grid = 0;
  if (grid == 0) {
    int dev = 0, cus = 0;
    (void)hipGetDevice(&dev);
    (void)hipDeviceGetAttribute(&cus, hipDeviceAttributeMultiprocessorCount, dev);
    grid = cus > 0 ? cus : 256;
    (void)hipFuncSetAttribute((const void*)fwd_kernel<PHMASK>, hipFuncAttributeMaxDynamicSharedMemorySize, LDS_BYTES);
    (void)hipGetLastError();
  }
  Params p{};
  for (int i = 0; i < 30; ++i) p.in[i] = (const float*)d_in[i];
  p.out = (float*)d_out;
  p.ws = (unsigned char*)d_ws;
#if COOP
  (void)hipMemsetAsync((unsigned char*)d_ws + WS_BAR, 0, XCD_BAR_WORDS * 4, stream);
  p.ph_lo = 0; p.ph_hi = NPH;
  void* args[] = {&p};
  hipError_t e = hipLaunchCooperativeKernel((const void*)fwd_kernel<PHMASK>, dim3(grid), dim3(NT), args, LDS_BYTES, stream);
  if (e != hipSuccess) fprintf(stderr, "cooperative launch failed: %s (grid %d)\n", hipGetErrorString(e), grid);
#else
  for (int ph = 0; ph < NPH; ++ph) {
    p.ph_lo = ph; p.ph_hi = ph + 1;
    hipLaunchKernelGGL(fwd_kernel<PHMASK>, dim3(grid), dim3(NT), LDS_BYTES, stream, p);
  }
#endif
}
```

```cpp
#include <hip/hip_runtime.h>
#include <hip/hip_bf16.h>
#include <hip/hip_cooperative_groups.h>
#include <cstdio>
namespace cg = cooperative_groups;

typedef __attribute__((ext_vector_type(8))) short bf16x8;
typedef __attribute__((ext_vector_type(16))) float f32x16;
typedef unsigned short u16;

#ifndef PHMASK
#define PHMASK 0x1FFF
#endif
#ifndef T3
#define T3 7
#endif
#ifndef P2SEL
#define P2SEL 7
#endif
#ifndef RPT_MASK
#define RPT_MASK 0
#endif
#ifndef RPT_N
#define RPT_N 1
#endif
#define RPT(bit) for (int rp_ = 0; rp_ < (((RPT_MASK >> (bit)) & 1) ? 1 + RPT_N : 1); ++rp_)
#define RPT_CNT(bit) (((RPT_MASK >> (bit)) & 1) ? 1 + RPT_N : 1)
#define DRY(bit) (opq(rp_) + 1 < RPT_CNT(bit))
#ifndef R1P
#define R1P 1
#endif
#ifndef COOP
#define COOP 1
#endif

#define NT 512
#define M_TOT 16896
#define M_P 16384
#define ZLD 2560
#define NPH 25

#define WS_WT   0ull
#define WS_H    13631488ull
#define WS_Z    48234496ull
#define WS_R    134742016ull
#define WS_PP   (WS_R)
#define WS_GC   (WS_R + 16777216ull)
#define WS_Q    (WS_R + 17301504ull)
#define WS_W2   (WS_R + 50855936ull)
#define WS_YL   (WS_R + 67633152ull)
#define WS_BO   (WS_R + 84410368ull)
#define WS_GA   (WS_R + 101187584ull)
#define WS_T1   (WS_R)
#define WS_T2   (WS_R + 34603008ull)
#define WS_MG   (WS_R + 69206016ull)
#define WS_SG   256100096ull
#define WS_WTF  (WS_Z)
#define WS_CU   (WS_Z + 17301504ull)
#define WS_LW  267634432ull
#define WS_DP  256100096ull
#define WT_IN  0
#define WT_G   2621440
#define WT_BRA 4718592
#define WT_BRB 5242880
#define WT_OUT 5767168
#define WT_FIN 0
#define WT_FDN 5767168
#define O_PSHIFT 17301504
#define O_PWKV   17308672
#define O_PK     17439744
#define O_PV     17505280
#define O_PCONV  17570816
#define O_SSHIFT 17593344
#define O_SWKV   18052096
#define O_SK     26440704
#define O_SV     30635008
#define O_SCONV  34829312

#define LDS_BYTES 151552

struct Params {
  const float* in[30];
  float* out;
  unsigned char* ws;
  int ph_lo, ph_hi;
};

typedef float f2v_ __attribute__((ext_vector_type(2)));
typedef __bf16 b2v_ __attribute__((ext_vector_type(2)));
__device__ __forceinline__ unsigned pack2(float a, float b) { f2v_ v = {a, b}; b2v_ r = __builtin_convertvector(v, b2v_); return __builtin_bit_cast(unsigned, r); }
__device__ __forceinline__ u16 f2bf(float f) { return (u16)(pack2(f, f) & 0xFFFFu); }
__device__ __forceinline__ float bf2f(u16 h) { return __uint_as_float(((unsigned)h) << 16); }
__device__ __forceinline__ float sigm(float x) { return __builtin_amdgcn_rcpf(1.f + __expf(-x)); }
__device__ __forceinline__ void unpack8(uint4 u, float* o) {
  o[0] = __uint_as_float(u.x << 16); o[1] = __uint_as_float(u.x & 0xFFFF0000u);
  o[2] = __uint_as_float(u.y << 16); o[3] = __uint_as_float(u.y & 0xFFFF0000u);
  o[4] = __uint_as_float(u.z << 16); o[5] = __uint_as_float(u.z & 0xFFFF0000u);
  o[6] = __uint_as_float(u.w << 16); o[7] = __uint_as_float(u.w & 0xFFFF0000u);
}
__device__ __forceinline__ uint4 pack8(const float* f) {
  uint4 u; u.x = pack2(f[0], f[1]); u.y = pack2(f[2], f[3]); u.z = pack2(f[4], f[5]); u.w = pack2(f[6], f[7]); return u;
}
__device__ __forceinline__ float gelu_fast(float v) {
  const float av = fabsf(v), d = av * 0.2316418882f + 1.0f;
  const float t = __builtin_amdgcn_rcpf(d);
  float q = t * 0.5307027145f + (-0.7265760135f); q = q * t + 0.7107068705f; q = q * t + (-0.142248368f); q = q * t + 0.127414796f; q = q * t;
  const float e = __builtin_amdgcn_exp2f((v * v) * (-0.72134752044f));
  const float m = v * (q * e);
  return v < 0.f ? m : v - m;
}
__device__ __forceinline__ int opq(int x) { asm volatile("" : "+v"(x)); return x; }
__device__ __forceinline__ float wave_sum(float x) {
#pragma unroll
  for (int o = 32; o >= 1; o >>= 1) x += __shfl_xor(x, o, 64);
  return x;
}

namespace pg8 {
#define PG8_LAS __attribute__((address_space(3)))
typedef unsigned short bf16_t;
typedef short bf16x8 __attribute__((ext_vector_type(8)));
typedef float f32x4 __attribute__((ext_vector_type(4)));
typedef unsigned u32x4 __attribute__((ext_vector_type(4)));
constexpr int BM = 256, BK = 64, HALF = 128, HTB = HALF * BK * 2  , STAGE_BYTES = 8 * HTB, NXCD = 8, WGM = 8;
__host__ __device__ __forceinline__ int lds_byte(int r, int c) { const int st = (r >> 4) * 2 + (c >> 5), rr = r & 15, cc = c & 31, ob = rr * 64 + cc * 2; return st * 1024 + (ob ^ (((ob >> 9) & 1) << 5)); }
__host__ __device__ __forceinline__ void stage_rc(int b, int& R, int& C) { const int st = b / 1024, sb = b % 1024, swz = sb ^ (((sb >> 9) & 1) << 5); R = (st >> 1) * 16 + swz / 64; C = (st & 1) * 32 + (swz % 64) / 2; }
__host__ __device__ __forceinline__ int perm32(int rho) { const int n = rho >> 4, i = rho & 15; return 8 * (i >> 2) + 4 * n + (i & 3); }
struct Unit { int pm, pn; };
struct Gemm { const bf16_t* A; const bf16_t* Bt; int M, N, K, lda, ldb; };
struct StaticOrder {
    int nM, nN, nwg, G, c;
    __host__ __device__ void init(int M, int N, int G_, int c_) { nM = M / BM; nN = N / BM; nwg = nM * nN; G = G_; c = c_; }
    __host__ __device__ bool next(int i, Unit& u) const {
        const long L = (long)i * G + c; if (L >= nwg) return false;
        int wgid = (int)L; { const int q = nwg / NXCD, r = nwg % NXCD, xcd = wgid % NXCD, off = wgid / NXCD; wgid = (xcd < r ? xcd * (q + 1) : r * (q + 1) + (xcd - r) * q) + off; }
        const int nig = WGM * nN, gid = wgid / nig, fm = gid * WGM, gsz = (nM - fm) < WGM ? (nM - fm) : WGM;
        u.pm = fm + ((wgid % nig) % gsz); u.pn = (wgid % nig) / gsz; return true;
    }
    __device__ __forceinline__ void a_ready(const Unit&) const {}
    __device__ __forceinline__ void done(const Unit&) const {}
};
__device__ __forceinline__ unsigned cvt_pk_bf16(float lo, float hi) { return ::pack2(lo, hi); }
template <class Epi, class Sched, bool STAMP = false>
__device__ __forceinline__ void gemm_phase(PG8_LAS unsigned char* lds, const Gemm g, const Sched& S, const Epi& E, unsigned long long* stamps) {
    const int tid = ::opq(threadIdx.x), wid = __builtin_amdgcn_readfirstlane(tid >> 6), lane = tid & 63, wr = wid >> 2, wc = wid & 3, fr = lane & 15, fq = lane >> 4;
    const int K = g.K, nt = K / BK;
    int ts_lo = 0, ts_hi = 0, nts = 0; const unsigned long long rt_entry = 0ull;
#define PG8_STAMP() do { if (STAMP && wid == 0 && nts < 64) { const unsigned long long _c = (unsigned long long)clock64(); \
        ts_lo = (lane == nts) ? (int)(unsigned)_c : ts_lo; ts_hi = (lane == nts) ? (int)(unsigned)(_c >> 32) : ts_hi; ++nts; } } while (0)
    PG8_STAMP();
    unsigned voffA[2], voffB[2];
#pragma unroll
    for (int i = 0; i < 2; ++i) { int R, C; stage_rc(tid * 16 + i * 8192, R, C); const int Rb = Epi::PERM ? ((R & ~31) + perm32(R & 31)) : R;
        voffA[i] = (unsigned)(R * g.lda + C) * 2u; voffB[i] = (unsigned)(Rb * g.ldb + C) * 2u; }
    const size_t kstep = (size_t)(BK * 2);
    const size_t hstep = (size_t)HALF * g.ldb * 2;
    const size_t tstep = 2 * hstep; const size_t hstepA = (size_t)HALF * g.lda * 2; const size_t tstepA = 2 * hstepA;
    const unsigned ldsw = (unsigned)wid * 1024u;
    const int aoff = lds_byte(wr * 64 + fr, fq * 8), boff = lds_byte(wc * 32 + fr, fq * 8);
#define PG8_SA(b, h) (((b) * 2 + (h)) * HTB)
#define PG8_SB(b, h) ((4 + (b) * 2 + (h)) * HTB)
#define PG8_STAGE(bufoff, gbase, voff) do { _Pragma("unroll") for (int _i = 0; _i < 2; ++_i) \
        __builtin_amdgcn_global_load_lds((const unsigned*)((const char*)(gbase) + (voff)[_i]), (PG8_LAS unsigned*)(lds + (bufoff) + ldsw + _i * 8192), 16, 0, 0); } while (0)
#define PG8_LDA(dst, b, h) do { _Pragma("unroll") for (int m = 0; m < 4; ++m) _Pragma("unroll") for (int k = 0; k < 2; ++k) dst[m][k] = *(const PG8_LAS bf16x8*)(lds + PG8_SA(b, h) + aoff + m * 2048 + k * 1024); } while (0)
#define PG8_LDB(dst, b, h) do { _Pragma("unroll") for (int n = 0; n < 2; ++n) _Pragma("unroll") for (int k = 0; k < 2; ++k) dst[n][k] = *(const PG8_LAS bf16x8*)(lds + PG8_SB(b, h) + boff + n * 2048 + k * 1024); } while (0)
#define PG8_MMA(ai, bj, At, Bt) do { __builtin_amdgcn_s_setprio(1); _Pragma("unroll") for (int m = 0; m < 4; ++m) _Pragma("unroll") for (int n = 0; n < 2; ++n) _Pragma("unroll") for (int k = 0; k < 2; ++k) \
        acc[ai][bj][m][n] = __builtin_amdgcn_mfma_f32_16x16x32_bf16(Bt[n][k], At[m][k], acc[ai][bj][m][n], 0, 0, 0); __builtin_amdgcn_s_setprio(0); } while (0)
#define PG8_WAIT_V(n) asm volatile("s_waitcnt vmcnt(" #n ")" ::: "memory")
#define PG8_WAIT_L(n) asm volatile("s_waitcnt lgkmcnt(" #n ")" ::: "memory")
#define PG8_BAR __builtin_amdgcn_s_barrier()
#define PG8_SCHED __builtin_amdgcn_sched_barrier(0)
    Unit cur, nxt; int ui = 0;
    if (!S.next(0, cur)) return;
    f32x4 acc[2][2][4][2];
#pragma unroll
    for (int a = 0; a < 2; ++a)
#pragma unroll
        for (int b = 0; b < 2; ++b)
#pragma unroll
            for (int m = 0; m < 4; ++m)
#pragma unroll
                for (int n = 0; n < 2; ++n) acc[a][b][m][n] = (f32x4){0.f, 0.f, 0.f, 0.f};
    bf16x8 At[4][2], B0[2][2], B1[2][2];
    const char* cA = (const char*)g.A + (size_t)cur.pm * tstepA; const char* cB = (const char*)g.Bt + (size_t)cur.pn * tstep;
    S.a_ready(cur);
    PG8_STAGE(PG8_SB(0, 0), cB, voffB); PG8_STAGE(PG8_SA(0, 0), cA, voffA); PG8_STAGE(PG8_SB(0, 1), cB + hstep, voffB); PG8_STAGE(PG8_SA(0, 1), cA + hstepA, voffA);
    if (wr == 1) PG8_BAR;
    PG8_WAIT_V(4); PG8_BAR;
    PG8_STAGE(PG8_SB(1, 0), cB + kstep, voffB); PG8_STAGE(PG8_SA(1, 0), cA + kstep, voffA); PG8_STAGE(PG8_SB(1, 1), cB + hstep + kstep, voffB);
    PG8_WAIT_V(6); PG8_BAR;
    PG8_STAMP();
    for (;;) {
        const bool has_next = S.next(ui + 1, nxt);
        const char* nA = has_next ? (const char*)g.A + (size_t)nxt.pm * tstepA : cA; const char* nB = has_next ? (const char*)g.Bt + (size_t)nxt.pn * tstep : cB;
        for (int t = 0; t < nt; t += 2) {
            const bool last = (t == nt - 2);
            const char* a1 = cA + (size_t)(t + 1) * kstep;
            const char* a2 = last ? nA : cA + (size_t)(t + 2) * kstep; const char* b2 = last ? nB : cB + (size_t)(t + 2) * kstep;
            const char* a3 = a2 + kstep; const char* b3 = b2 + kstep;
            if (last && has_next) S.a_ready(nxt);
            PG8_LDB(B0, 0, 0); PG8_SCHED; PG8_LDA(At, 0, 0); PG8_STAGE(PG8_SA(1, 1), a1 + hstepA, voffA);
            PG8_WAIT_L(8); PG8_BAR; PG8_WAIT_L(0); PG8_MMA(0, 0, At, B0); PG8_BAR; PG8_SCHED;
            PG8_LDB(B1, 0, 1); PG8_STAGE(PG8_SB(0, 0), b2, voffB);
            PG8_BAR; PG8_WAIT_L(0); PG8_MMA(0, 1, At, B1); PG8_BAR;
            PG8_LDA(At, 0, 1); PG8_STAGE(PG8_SA(0, 0), a2, voffA);
            PG8_BAR; PG8_WAIT_L(0); PG8_MMA(1, 0, At, B0); PG8_BAR; PG8_SCHED;
            PG8_STAGE(PG8_SB(0, 1), b2 + hstep, voffB);
            PG8_WAIT_V(6); PG8_BAR; PG8_MMA(1, 1, At, B1); PG8_BAR;
            PG8_LDB(B0, 1, 0); PG8_SCHED; PG8_LDA(At, 1, 0); PG8_STAGE(PG8_SA(0, 1), a2 + hstepA, voffA);
            PG8_WAIT_L(8); PG8_BAR; PG8_WAIT_L(0); PG8_MMA(0, 0, At, B0); PG8_BAR; PG8_SCHED;
            PG8_LDB(B1, 1, 1); PG8_STAGE(PG8_SB(1, 0), b3, voffB);
            PG8_BAR; PG8_WAIT_L(0); PG8_MMA(0, 1, At, B1); PG8_BAR;
            PG8_LDA(At, 1, 1); PG8_STAGE(PG8_SA(1, 0), a3, voffA);
            PG8_BAR; PG8_WAIT_L(0); PG8_MMA(1, 0, At, B0); PG8_BAR; PG8_SCHED;
            PG8_STAGE(PG8_SB(1, 1), b3 + hstep, voffB);
            PG8_WAIT_V(6); PG8_BAR; PG8_MMA(1, 1, At, B1); PG8_BAR;
        }
        PG8_STAMP();
        if constexpr (!Epi::AFTER_DRAIN) { E(acc, cur, wr, wc, fr, fq); S.done(cur); }
        PG8_STAMP();
        if (!has_next) break;
#pragma unroll
        for (int a = 0; a < 2; ++a)
#pragma unroll
            for (int b = 0; b < 2; ++b)
#pragma unroll
                for (int m = 0; m < 4; ++m)
#pragma unroll
                    for (int n = 0; n < 2; ++n) acc[a][b][m][n] = (f32x4){0.f, 0.f, 0.f, 0.f};
        cur = nxt; cA = nA; cB = nB; ++ui;
    }
    PG8_WAIT_V(0);
    if (wr == 0) PG8_BAR;
    PG8_BAR;
    if constexpr (Epi::AFTER_DRAIN) { E.fused(acc, cur, wr, wc, fr, fq, lds, wid, lane); S.done(cur); }
    PG8_STAMP();
    if (STAMP && wid == 0) { stamps[lane] = lane < nts ? (((unsigned long long)(unsigned)ts_hi << 32) | (unsigned)ts_lo) : 0ull;
        if (lane == 62) stamps[62] = rt_entry; if (lane == 63) stamps[63] = (unsigned long long)wall_clock64(); }
#undef PG8_STAMP
#undef PG8_SA
#undef PG8_SB
#undef PG8_STAGE
#undef PG8_LDA
#undef PG8_LDB
#undef PG8_MMA
#undef PG8_WAIT_V
#undef PG8_WAIT_L
#undef PG8_BAR
#undef PG8_SCHED
}
}
using pg8::f32x4;
#define ROWOFF(reg, h) (((reg) & 3) + 8 * ((reg) >> 2) + 4 * (h))

struct CDesc { const float* src; u16* dst; int K, N, k0, n0, sn0; };
__device__ __forceinline__ CDesc conv_desc(const Params& p, int l, int which, int t) {
  CDesc d;
  u16* WtA = (u16*)(p.ws + WS_WT);
  u16* WtF = (u16*)(p.ws + WS_WTF);
  if (which == 0) {
    if (t < 640) { const int tk = t / 40, tn = t % 40; d.src = p.in[8] + (size_t)l * 1024 * 4608; d.K = 1024; d.N = 4608; d.dst = WtA + WT_IN; d.k0 = tk * 64; d.n0 = tn * 64; d.sn0 = tn * 64; }
    else if ((t -= 640) < 512) {
      const int tk = t / 32, tn = t % 32; const int n0 = tn * 64;
      d.src = p.in[8] + (size_t)l * 1024 * 4608; d.K = 1024; d.N = 4608; d.dst = WtA + WT_G; d.k0 = tk * 64; d.n0 = n0;
      d.sn0 = 2560 + ((n0 >> 7) & 1) * 1024 + (n0 >> 8) * 128 + (n0 & 127);
    }
    else if ((t -= 512) < 128) { const int tk = t / 16, tn = t % 16; d.src = p.in[21] + (size_t)l * 512 * 1024; d.K = 512; d.N = 1024; d.dst = WtA + WT_BRA; d.k0 = tk * 64; d.n0 = tn * 64; d.sn0 = tn * 64; }
    else if ((t -= 128) < 128) { const int tk = t / 16, tn = t % 16; d.src = p.in[22] + (size_t)l * 512 * 1024; d.K = 512; d.N = 1024; d.dst = WtA + WT_BRB; d.k0 = tk * 64; d.n0 = tn * 64; d.sn0 = tn * 64; }
    else { t -= 128; const int tk = t / 16, tn = t % 16; d.src = p.in[23] + (size_t)l * 1024 * 1024; d.K = 1024; d.N = 1024; d.dst = WtA + WT_OUT; d.k0 = tk * 64; d.n0 = tn * 64; d.sn0 = tn * 64; }
  } else {
    if (t < 1408) {
      const int tk = t / 88, tn = t % 88; const int n0 = tn * 64;
      d.src = p.in[25] + (size_t)l * 1024 * 5632; d.K = 1024; d.N = 5632; d.dst = WtF + WT_FIN; d.k0 = tk * 64; d.n0 = n0;
      d.sn0 = ((n0 >> 7) & 1) * 2816 + (n0 >> 8) * 128 + (n0 & 127);
    } else { t -= 1408; const int tk = t / 16, tn = t % 16; d.src = p.in[28] + (size_t)l * 2816 * 1024; d.K = 2816; d.N = 1024; d.dst = WtF + WT_FDN; d.k0 = tk * 64; d.n0 = tn * 64; d.sn0 = tn * 64; }
  }
  return d;
}
__device__ __forceinline__ void conv_pair(const CDesc& A, const CDesc& B, float* lds) {
  const int tid = opq(threadIdx.x);
  const int k = tid >> 3, c = (tid & 7) * 8;
  const float* sa = A.src + (size_t)(A.k0 + k) * A.N + A.sn0 + c;
  const float* sb = B.src + (size_t)(B.k0 + k) * B.N + B.sn0 + c;
  const float4 a0 = *(const float4*)sa, a1 = *(const float4*)(sa + 4);
  const float4 b0 = *(const float4*)sb, b1 = *(const float4*)(sb + 4);
  __syncthreads();
  {
    float* d = lds + k * 65 + c;
    d[0] = a0.x; d[1] = a0.y; d[2] = a0.z; d[3] = a0.w; d[4] = a1.x; d[5] = a1.y; d[6] = a1.z; d[7] = a1.w;
    float* e = lds + 4160 + k * 65 + c;
    e[0] = b0.x; e[1] = b0.y; e[2] = b0.z; e[3] = b0.w; e[4] = b1.x; e[5] = b1.y; e[6] = b1.z; e[7] = b1.w;
  }
  __syncthreads();
  {
    const int n = tid >> 3, kk = (tid & 7) * 8;
    float f[8], g[8];
#pragma unroll
    for (int i = 0; i < 8; ++i) { f[i] = lds[(kk + i) * 65 + n]; g[i] = lds[4160 + (kk + i) * 65 + n]; }
    *(uint4*)(A.dst + (size_t)(A.n0 + n) * A.K + A.k0 + kk) = pack8(f);
    *(uint4*)(B.dst + (size_t)(B.n0 + n) * B.K + B.k0 + kk) = pack8(g);
  }
}

__device__ __forceinline__ void phase_prep(const Params& p, int l, int which, float* ldsf) {
  u16* H = (u16*)(p.ws + WS_H);
  float* X = p.out;
  const int nconv = which == 0 ? (640 + 512 + 128 + 128 + 256) : (1408 + 704);
  const float* gw = (which == 0 ? p.in[7] : p.in[24]) + l * 1024;
  for (int it = blockIdx.x * 2; it < nconv; it += gridDim.x * 2) {
    const CDesc A = conv_desc(p, l, which, it), B = conv_desc(p, l, which, it + 1);
    conv_pair(A, B, ldsf);
  }
  if (which == 0) {
    const int hh = (int)gridDim.x - 1 - (int)blockIdx.x;
    if (hh < 8) {
      const int tid = opq(threadIdx.x);
      u16* dst = (u16*)(p.ws + WS_LW) + (size_t)hh * 17920;
      const float* w2 = p.in[11] + (size_t)l * 64 * 512 + hh * 64;
      const float* a2 = p.in[13] + (size_t)l * 64 * 512 + hh * 64;
      const float* g2 = p.in[14] + (size_t)l * 128 * 512 + hh * 64;
      for (int e = tid; e < 4096; e += NT) {
        const int i = e >> 6, j = e & 63;
        dst[j * 72 + i] = f2bf(w2[(size_t)i * 512 + j]);
        dst[4608 + j * 72 + i] = f2bf(a2[(size_t)i * 512 + j]);
      }
      for (int e = tid; e < 8192; e += NT) {
        const int i = e >> 6, j = e & 63;
        dst[9216 + j * 136 + i] = f2bf(g2[(size_t)i * 512 + j]);
      }
    }
  }
  const bool first = (which == 0 && l == 0);
  for (int it = blockIdx.x; it < 1056; it += gridDim.x) {
    const int tid = opq(threadIdx.x);
    const int lane = tid & 63;
    const int rowa = it * 16 + (tid >> 6);
    float4 v[2][4];
#pragma unroll
    for (int rr = 0; rr < 2; ++rr) {
      const int row = rowa + rr * 8;
      const float* src;
      if (first) src = (row < M_P) ? p.in[0] + (size_t)row * 1024 : p.in[1] + (size_t)(row - M_P) * 1024;
      else src = X + (size_t)row * 1024;
#pragma unroll
      for (int i = 0; i < 4; ++i) v[rr][i] = *(const float4*)(src + i * 256 + lane * 4);
    }
#pragma unroll
    for (int rr = 0; rr < 2; ++rr) {
      const int row = rowa + rr * 8;
      const int nsl = (gridDim.x == 256 && row >= M_P && !first) ? (which == 1 ? 4 : 11) : 0;
      const float* part = (const float*)(p.ws + WS_T1) + (size_t)(row - M_P) * 1024;
      const u16* partb = (const u16*)(p.ws + WS_DP) + (size_t)(row - M_P) * 1024;
      float ss = 0.f;
#pragma unroll
      for (int i = 0; i < 4; ++i) {
        for (int k = 0; k < nsl; ++k) {
          if (which == 1) {
            const float4 q = *(const float4*)(part + (size_t)k * 512 * 1024 + i * 256 + lane * 4);
            v[rr][i].x += q.x; v[rr][i].y += q.y; v[rr][i].z += q.z; v[rr][i].w += q.w;
          } else {
            const uint2 q = *(const uint2*)(partb + (size_t)k * 512 * 1024 + i * 256 + lane * 4);
            v[rr][i].x += __uint_as_float(q.x << 16); v[rr][i].y += __uint_as_float(q.x & 0xFFFF0000u); v[rr][i].z += __uint_as_float(q.y << 16); v[rr][i].w += __uint_as_float(q.y & 0xFFFF0000u);
          }
        }
        ss += v[rr][i].x * v[rr][i].x + v[rr][i].y * v[rr][i].y + v[rr][i].z * v[rr][i].z + v[rr][i].w * v[rr][i].w;
        if (first || nsl) *(float4*)(X + (size_t)row * 1024 + i * 256 + lane * 4) = v[rr][i];
      }
      ss = wave_sum(ss);
      const float rs = rsqrtf(ss * (1.f / 1024.f) + 1e-6f);
#pragma unroll
      for (int i = 0; i < 4; ++i) {
        const float4 g = *(const float4*)(gw + i * 256 + lane * 4);
        uint2 o; o.x = pack2(v[rr][i].x * rs * g.x, v[rr][i].y * rs * g.y); o.y = pack2(v[rr][i].z * rs * g.z, v[rr][i].w * rs * g.w);
        *(uint2*)(H + (size_t)row * 1024 + i * 256 + lane * 4) = o;
      }
    }
  }
}

struct EpiInproj {
  static constexpr bool PERM = true, AFTER_DRAIN = false;
  u16* z; float* out; int l;
  __device__ __forceinline__ void operator()(const f32x4 (&acc)[2][2][4][2], const pg8::Unit& u, int wr, int wc, int fr, int fq) const {
    const int row0 = u.pm * 256 + wr * 64 + fr, col0 = u.pn * 256 + wc * 32 + 8 * fq;
#pragma unroll
    for (int ai = 0; ai < 2; ++ai)
#pragma unroll
      for (int m = 0; m < 4; ++m) {
        const int row = row0 + ai * 128 + m * 16;
        u16* rowp = z + (size_t)row * ZLD + col0;
#pragma unroll
        for (int bj = 0; bj < 2; ++bj) {
          const f32x4 v0 = acc[ai][bj][m][0], v1 = acc[ai][bj][m][1];
          pg8::u32x4 w; w.x = pg8::cvt_pk_bf16(v0[0], v0[1]); w.y = pg8::cvt_pk_bf16(v0[2], v0[3]); w.z = pg8::cvt_pk_bf16(v1[0], v1[1]); w.w = pg8::cvt_pk_bf16(v1[2], v1[3]);
          *(pg8::u32x4*)(rowp + bj * 128) = w;
        }
        const bool prompt = row < M_P;
        int b, t;
        if (prompt) { b = row >> 13; t = row & 8191; } else { b = (row - M_P) >> 2; t = (row - M_P) & 3; }
        if (u.pn < 7) {
          if ((prompt && t == 8191) || (!prompt && t == 3)) {
            float* o = out + (prompt ? O_PSHIFT + (size_t)(l * 2 + b) * 1792 : O_SSHIFT + (size_t)(l * 128 + b) * 1792) + col0;
#pragma unroll
            for (int bj = 0; bj < 2; ++bj) { *(f32x4*)(o + bj * 128) = acc[ai][bj][m][0]; *(f32x4*)(o + bj * 128 + 4) = acc[ai][bj][m][1]; }
          }
        } else if (u.pn == 9 && prompt && t >= 8064) {
          const int c = wc * 32 + 8 * fq;
          float* o = out + O_PV + ((size_t)((l * 2 + b) * 128 + (t - 8064)) * 2 + (c >> 6)) * 64 + (c & 63);
          *(f32x4*)o = acc[ai][1][m][0]; *(f32x4*)(o + 4) = acc[ai][1][m][1];
        }
      }
  }
};
struct EpiStoreBf16 {
  static constexpr bool PERM = true, AFTER_DRAIN = false;
  u16* O; int ldc; int rowoff;
  __device__ __forceinline__ void operator()(const f32x4 (&acc)[2][2][4][2], const pg8::Unit& u, int wr, int wc, int fr, int fq) const {
    const int row0 = rowoff + u.pm * 256 + wr * 64 + fr, col0 = u.pn * 256 + wc * 32 + 8 * fq;
#pragma unroll
    for (int ai = 0; ai < 2; ++ai)
#pragma unroll
      for (int m = 0; m < 4; ++m) {
        u16* rowp = O + (size_t)(row0 + ai * 128 + m * 16) * ldc + col0;
#pragma unroll
        for (int bj = 0; bj < 2; ++bj) {
          const f32x4 v0 = acc[ai][bj][m][0], v1 = acc[ai][bj][m][1];
          pg8::u32x4 w; w.x = pg8::cvt_pk_bf16(v0[0], v0[1]); w.y = pg8::cvt_pk_bf16(v0[2], v0[3]); w.z = pg8::cvt_pk_bf16(v1[0], v1[1]); w.w = pg8::cvt_pk_bf16(v1[2], v1[3]);
          *(pg8::u32x4*)(rowp + bj * 128) = w;
        }
      }
  }
};
struct EpiFfnIn {
  static constexpr bool PERM = true, AFTER_DRAIN = false;
  u16* cu;
  __device__ __forceinline__ void operator()(const f32x4 (&acc)[2][2][4][2], const pg8::Unit& u, int wr, int wc, int fr, int fq) const {
    const int row0 = u.pm * 256 + wr * 64 + fr, col0 = u.pn * 128 + wc * 32 + 8 * fq;
#pragma unroll
    for (int ai = 0; ai < 2; ++ai)
#pragma unroll
      for (int m = 0; m < 4; ++m) {
        u16* rowp = cu + (size_t)(row0 + ai * 128 + m * 16) * 5632 + col0;
#pragma unroll
        for (int bj = 0; bj < 2; ++bj) {
          const f32x4 v0 = acc[ai][bj][m][0], v1 = acc[ai][bj][m][1];
          pg8::u32x4 w; w.x = pg8::cvt_pk_bf16(v0[0], v0[1]); w.y = pg8::cvt_pk_bf16(v0[2], v0[3]); w.z = pg8::cvt_pk_bf16(v1[0], v1[1]); w.w = pg8::cvt_pk_bf16(v1[2], v1[3]);
          *(pg8::u32x4*)(rowp + bj * 2816) = w;
        }
      }
  }
};
struct EpiSig {
  static constexpr bool PERM = true, AFTER_DRAIN = false;
  u16* sr; u16* sa;
  __device__ __forceinline__ void operator()(const f32x4 (&acc)[2][2][4][2], const pg8::Unit& u, int wr, int wc, int fr, int fq) const {
    const int row0 = u.pm * 256 + wr * 64 + fr, col0 = u.pn * 128 + wc * 32 + 8 * fq;
#pragma unroll
    for (int ai = 0; ai < 2; ++ai)
#pragma unroll
      for (int m = 0; m < 4; ++m) {
        const size_t off = (size_t)(row0 + ai * 128 + m * 16) * 1024 + col0;
#pragma unroll
        for (int bj = 0; bj < 2; ++bj) {
          float o[8];
#pragma unroll
          for (int n = 0; n < 2; ++n)
#pragma unroll
            for (int j = 0; j < 4; ++j) o[n * 4 + j] = sigm(acc[ai][bj][m][n][j]);
          *(uint4*)((bj ? sa : sr) + off) = pack8(o);
        }
      }
  }
};
struct EpiMerge {
  static constexpr bool PERM = true, AFTER_DRAIN = false;
  const u16* t1; const u16* t2; u16* mg;
  __device__ __forceinline__ void operator()(const f32x4 (&acc)[2][2][4][2], const pg8::Unit& u, int wr, int wc, int fr, int fq) const {
    const int row0 = u.pm * 256 + wr * 64 + fr, col0 = u.pn * 128 + wc * 32 + 8 * fq;
#pragma unroll
    for (int ai = 0; ai < 2; ++ai)
#pragma unroll
      for (int m = 0; m < 4; ++m) {
        const size_t off = (size_t)(row0 + ai * 128 + m * 16) * 1024 + col0;
        float a[8], b[8], o[8];
        unpack8(*(const uint4*)(t1 + off), a);
        unpack8(*(const uint4*)(t2 + off), b);
#pragma unroll
        for (int n = 0; n < 2; ++n)
#pragma unroll
          for (int j = 0; j < 4; ++j)
            o[n * 4 + j] = sigm(acc[ai][0][m][n][j]) * a[n * 4 + j] + sigm(acc[ai][1][m][n][j]) * b[n * 4 + j];
        *(uint4*)(mg + off) = pack8(o);
        asm volatile("" ::: "memory");
      }
  }
};
struct EpiResid {
  static constexpr bool PERM = false, AFTER_DRAIN = false;
  float* X; bool dry; bool atomic; int rowoff; u16* pbf;
  __device__ __forceinline__ void operator()(const f32x4 (&acc)[2][2][4][2], const pg8::Unit& u, int wr, int wc, int fr, int fq) const {
    const int row0 = rowoff + u.pm * 256 + wr * 64 + fr, col0 = u.pn * 256 + wc * 32 + 4 * fq;
#pragma unroll
    for (int ai = 0; ai < 2; ++ai)
#pragma unroll
      for (int m = 0; m < 4; ++m) {
        float* rowp = X + (size_t)(row0 + ai * 128 + m * 16) * 1024 + col0;
#pragma unroll
        for (int bj = 0; bj < 2; ++bj)
#pragma unroll
          for (int n = 0; n < 2; ++n) {
            f32x4* q = (f32x4*)(rowp + bj * 128 + n * 16);
            if (atomic) {
              if (pbf) {
                uint2 o; o.x = pack2(acc[ai][bj][m][n][0], acc[ai][bj][m][n][1]); o.y = pack2(acc[ai][bj][m][n][2], acc[ai][bj][m][n][3]);
                *(uint2*)(pbf + ((float*)q - X)) = o;
              } else *q = acc[ai][bj][m][n];
            } else { const f32x4 v_ = *q + acc[ai][bj][m][n]; if (!dry) *q = v_; }
          }
        asm volatile("" ::: "memory");
      }
  }
};
template <class Epi>
__device__ __forceinline__ void run_gemm_ex(unsigned char* lds_raw, const u16* A, int lda, const u16* Bt, int ldb, int M, int N, int K, int G, int c, const Epi& E) {
  if (c < 0) return;
  pg8::Gemm g; g.A = A; g.Bt = Bt; g.M = M; g.N = N; g.K = K; g.lda = lda; g.ldb = ldb;
  pg8::StaticOrder S; S.init(M, N, G, c);
  __syncthreads();
  pg8::gemm_phase<Epi, pg8::StaticOrder, false>((PG8_LAS unsigned char*)lds_raw, g, S, E, nullptr);
  __syncthreads();
}
template <class Epi>
__device__ __forceinline__ void run_gemm(unsigned char* lds_raw, const u16* A, int lda, const u16* Bt, int N, int K, const Epi& E) {
  pg8::Gemm g; g.A = A; g.Bt = Bt; g.M = M_TOT; g.N = N; g.K = K; g.lda = lda; g.ldb = K;
  pg8::StaticOrder S; S.init(M_TOT, N, gridDim.x, blockIdx.x);
  __syncthreads();
  pg8::gemm_phase<Epi, pg8::StaticOrder, false>((PG8_LAS unsigned char*)lds_raw, g, S, E, nullptr);
  __syncthreads();
}

__device__ __forceinline__ void rope_item(const Params& p, int l, int item, bool dry = false) {
  const int tid = opq(threadIdx.x);
  u16* z = (u16*)(p.ws + WS_Z);
  const int row = item * 64 + (tid >> 3);
  const int d0 = (tid & 7) * 4;
  const bool prompt = row < M_P;
  int b, t, pos;
  if (prompt) { b = row >> 13; t = row & 8191; pos = t; } else { b = (row - M_P) >> 2; t = (row - M_P) & 3; pos = 16384 + t; }
  float cs[4], sn[4];
#pragma unroll
  for (int i = 0; i < 4; ++i) {
    const float inv = __expf(-(float)(d0 + i) * (9.210340371976184f / 32.f));
    const float angf = (float)pos * inv;
    double a = (double)angf;
    a -= 6.283185307179586 * rint(a * 0.15915494309189535);
    const float af = (float)a;
    sn[i] = __sinf(af); cs[i] = __cosf(af);
  }
#pragma unroll 2
  for (int hh = 0; hh < 10; ++hh) {
    u16* q = z + (size_t)row * ZLD + 1792 + hh * 64 + d0;
    const uint2 lo = *(const uint2*)q, hi = *(const uint2*)(q + 32);
    float x1[4] = {__uint_as_float(lo.x << 16), __uint_as_float(lo.x & 0xFFFF0000u), __uint_as_float(lo.y << 16), __uint_as_float(lo.y & 0xFFFF0000u)};
    float x2[4] = {__uint_as_float(hi.x << 16), __uint_as_float(hi.x & 0xFFFF0000u), __uint_as_float(hi.y << 16), __uint_as_float(hi.y & 0xFFFF0000u)};
    float y1[4], y2[4];
#pragma unroll
    for (int i = 0; i < 4; ++i) { y1[i] = x1[i] * cs[i] - x2[i] * sn[i]; y2[i] = x2[i] * cs[i] + x1[i] * sn[i]; }
    uint2 o1, o2;
    o1.x = pack2(y1[0], y1[1]); o1.y = pack2(y1[2], y1[3]); o2.x = pack2(y2[0], y2[1]); o2.y = pack2(y2[2], y2[3]);
    if (!dry) { *(uint2*)q = o1; *(uint2*)(q + 32) = o2; }
    if (hh >= 8 && prompt && t >= 8064) {
      float* o = p.out + O_PK + ((size_t)((l * 2 + b) * 128 + (t - 8064)) * 2 + (hh - 8)) * 64 + d0;
      *(float4*)o = make_float4(y1[0], y1[1], y1[2], y1[3]);
      *(float4*)(o + 32) = make_float4(y2[0], y2[1], y2[2], y2[3]);
    }
  }
}

#define SL(i) (ldsf + (i) * 4160)
__device__ __forceinline__ void rwkv_item(const Params& p, int l, int item, float* ldsf, bool dry = false) {
  const int tid = opq(threadIdx.x), lane = tid & 63, wave = tid >> 6;
  const bool sample = item >= 2048;
  int h, cidx, rowbase;
  if (!sample) { h = item & 7; cidx = item >> 3; rowbase = cidx * 64; }
  else { int s = item - 2048; h = s & 7; cidx = s >> 3; rowbase = M_P + cidx * 64; }
  const int cc = cidx & 127;
  const u16* z = (const u16*)(p.ws + WS_Z);
  u16* zw_ = (u16*)(p.ws + WS_Z);
  const float* mu = p.in[9] + l * 1792;
  float* wbuf = SL(7);
  float* gc = ldsf + 9 * 4160;
  float* bd = ldsf + 9 * 4160 + 64;
  __syncthreads();
  {
    const int t = tid >> 3, c8 = (tid & 7) * 8;
    const int m = rowbase + t;
    const int zcs[7] = {h * 64, 512 + h * 64, 1024 + h * 64, 1536, 1600, 1664, 1728};
#pragma unroll
    for (int gi = 0; gi < 7; ++gi) {
      const int zc = zcs[gi] + c8;
      float cur[8], prv[8];
      unpack8(*(const uint4*)(z + (size_t)m * ZLD + zc), cur);
      bool zero = false, fromstate = false;
      if (!sample) zero = (t == 0 && cc == 0);
      else fromstate = ((t & 3) == 0);
      if (zero) {
#pragma unroll
        for (int i = 0; i < 8; ++i) prv[i] = 0.f;
      } else if (fromstate) {
        const int b = (m - M_P) >> 2;
        const float* sp = p.in[2] + (size_t)(l * 128 + b) * 1792 + zc;
        float4 a = *(const float4*)sp, bb = *(const float4*)(sp + 4);
        prv[0] = a.x; prv[1] = a.y; prv[2] = a.z; prv[3] = a.w; prv[4] = bb.x; prv[5] = bb.y; prv[6] = bb.z; prv[7] = bb.w;
      } else {
        unpack8(*(const uint4*)(z + (size_t)(m - 1) * ZLD + zc), prv);
      }
      float* d = SL(gi) + t * 65 + c8;
#pragma unroll
      for (int i = 0; i < 8; ++i) {
        float v = cur[i] + mu[zc + i] * (prv[i] - cur[i]);
        if (gi == 3) v = tanhf(v);
        if (gi >= 5) v = sigm(v);
        d[i] = v;
      }
    }
  }
  const int lt = tid & 63, jg = tid >> 6;
  auto load_w = [&](const float* W, int nrows) {
    for (int e = tid; e < nrows * 8; e += NT) {
      const int i = e >> 3, c = (e & 7) * 8;
      const float* s = W + (size_t)i * 512 + h * 64 + c;
      *(float4*)(wbuf + i * 64 + c) = *(const float4*)s;
      *(float4*)(wbuf + i * 64 + c + 4) = *(const float4*)(s + 4);
    }
  };
  auto lora = [&](const float* xa, const float* xb, int n, float* acc) {
#pragma unroll 2
    for (int i = 0; i < n; ++i) {
      const float x = (i < 64) ? xa[lt * 65 + i] : xb[lt * 65 + i - 64];
      const float4 w0 = *(const float4*)(wbuf + i * 64 + jg * 8);
      const float4 w1 = *(const float4*)(wbuf + i * 64 + jg * 8 + 4);
      acc[0] += x * w0.x; acc[1] += x * w0.y; acc[2] += x * w0.z; acc[3] += x * w0.w;
      acc[4] += x * w1.x; acc[5] += x * w1.y; acc[6] += x * w1.z; acc[7] += x * w1.w;
    }
  };
  float res[8];
  load_w(p.in[11] + (size_t)l * 64 * 512, 64);
  __syncthreads();
#pragma unroll
  for (int i = 0; i < 8; ++i) res[i] = p.in[10][l * 512 + h * 64 + jg * 8 + i];
  lora(SL(3), SL(3), 64, res);
  __syncthreads();
#pragma unroll
  for (int i = 0; i < 8; ++i) {
    const float x = -res[i];
    const float sp = (x > 20.f) ? x : log1pf(__expf(x));
    SL(3)[lt * 65 + jg * 8 + i] = -__expf(-sp - 0.5f);
  }
  load_w(p.in[13] + (size_t)l * 64 * 512, 64);
  __syncthreads();
#pragma unroll
  for (int i = 0; i < 8; ++i) res[i] = p.in[12][l * 512 + h * 64 + jg * 8 + i];
  lora(SL(4), SL(4), 64, res);
  __syncthreads();
#pragma unroll
  for (int i = 0; i < 8; ++i) SL(4)[lt * 65 + jg * 8 + i] = sigm(res[i]);
  load_w(p.in[14] + (size_t)l * 128 * 512, 128);
  __syncthreads();
#pragma unroll
  for (int i = 0; i < 8; ++i) res[i] = 0.f;
  lora(SL(5), SL(6), 128, res);
  __syncthreads();
  if (!sample) {
    u16* ga = (u16*)(p.ws + WS_GA) + (size_t)item * 4096;
    *(uint4*)(ga + lt * 64 + jg * 8) = pack8(res);
    if (tid < 64) {
      float c = 0.f;
      for (int t = 0; t < 64; ++t) { c += SL(3)[t * 65 + tid]; SL(5)[t * 65 + tid] = c; }
      gc[tid] = __expf(c);
    }
  } else {
#pragma unroll
    for (int i = 0; i < 8; ++i) SL(6)[lt * 65 + jg * 8 + i] = res[i];
  }
  __syncthreads();
  {
    const int t = tid >> 3, j0 = (tid & 7) * 8;
    const float* kkw = p.in[15] + l * 512 + h * 64;
    const float* kaw = p.in[16] + l * 512 + h * 64;
    const float* rkw = p.in[17] + l * 512 + h * 64;
    float kr[8], av[8], rv[8], kkv[8], kf[8];
    float nrm = 0.f, bdot = 0.f;
#pragma unroll
    for (int i = 0; i < 8; ++i) {
      const int j = j0 + i;
      kr[i] = SL(1)[t * 65 + j]; av[i] = SL(4)[t * 65 + j]; rv[i] = SL(0)[t * 65 + j];
      kkv[i] = kr[i] * kkw[j];
      nrm += kkv[i] * kkv[i];
      kf[i] = kr[i] * (1.f + (av[i] - 1.f) * kaw[j]);
      bdot += rv[i] * kf[i] * rkw[j];
    }
    nrm += __shfl_xor(nrm, 1, 64); nrm += __shfl_xor(nrm, 2, 64); nrm += __shfl_xor(nrm, 4, 64);
    bdot += __shfl_xor(bdot, 1, 64); bdot += __shfl_xor(bdot, 2, 64); bdot += __shfl_xor(bdot, 4, 64);
    const float rn = 1.f / fmaxf(sqrtf(nrm), 1e-12f);
    if (!sample) {
      float bo[8];
#pragma unroll
      for (int i = 0; i < 8; ++i) {
        const int j = j0 + i;
        const float cum = SL(5)[t * 65 + j], dl = SL(3)[t * 65 + j];
        const float eg = __expf(cum), egi = __expf(-cum), egp = __expf(cum - dl);
        const float kk = kkv[i] * rn;
        SL(0)[t * 65 + j] = rv[i] * eg;
        SL(1)[t * 65 + j] = kf[i] * egi;
        SL(3)[t * 65 + j] = kk * av[i] * egi;
        SL(4)[t * 65 + j] = kk * egp;
        bo[i] = bdot * SL(2)[t * 65 + j];
      }
      u16* bop = (u16*)(p.ws + WS_BO) + (size_t)item * 4096;
      *(uint4*)(bop + t * 64 + j0) = pack8(bo);
    } else {
#pragma unroll
      for (int i = 0; i < 8; ++i) {
        const int j = j0 + i;
        const float kk = kkv[i] * rn;
        const float dl = SL(3)[t * 65 + j];
        SL(1)[t * 65 + j] = kf[i];
        SL(3)[t * 65 + j] = __expf(dl);
        SL(4)[t * 65 + j] = kk;
        SL(5)[t * 65 + j] = kk * av[i];
      }
      if ((tid & 7) == 0) bd[t] = bdot;
    }
  }
  __syncthreads();
  if (sample) {
    const float lng = p.in[18][l * 512 + h * 64 + lane], lnb = p.in[19][l * 512 + h * 64 + lane];
    for (int round = 0; round < 2; ++round) {
      const int seq = wave + 8 * round;
      const int b = cidx * 16 + seq;
      float S[64];
      const float* sp = p.in[3] + ((size_t)((l * 128 + b) * 8 + h) * 64 + lane) * 64;
#pragma unroll
      for (int k = 0; k < 64; k += 4) { float4 v = *(const float4*)(sp + k); S[k] = v.x; S[k + 1] = v.y; S[k + 2] = v.z; S[k + 3] = v.w; }
      for (int tt = 0; tt < 4; ++tt) {
        const int t = seq * 4 + tt;
        float sk = 0.f;
#pragma unroll
        for (int kc = 0; kc < 64; kc += 8) {
#pragma unroll
          for (int k = kc; k < kc + 8; ++k) sk += S[k] * SL(4)[t * 65 + k];
          __builtin_amdgcn_sched_barrier(0);
        }
        const float vt = SL(2)[t * 65 + lane];
        float y = 0.f;
#pragma unroll
        for (int kc = 0; kc < 64; kc += 8) {
#pragma unroll
          for (int k = kc; k < kc + 8; ++k) {
            S[k] = S[k] * SL(3)[t * 65 + k] - sk * SL(5)[t * 65 + k] + vt * SL(1)[t * 65 + k];
            y += S[k] * SL(0)[t * 65 + k];
          }
          __builtin_amdgcn_sched_barrier(0);
        }
        const float mean = wave_sum(y) * (1.f / 64.f);
        const float d = y - mean;
        const float var = wave_sum(d * d) * (1.f / 64.f);
        const float yn = d * rsqrtf(var + 64e-5f) * lng + lnb;
        const float o = (yn + bd[t] * vt) * SL(6)[t * 65 + lane];
        if (!dry) zw_[(size_t)(M_P + b * 4 + tt) * ZLD + h * 64 + lane] = f2bf(o);
      }
      float* op = p.out + O_SWKV + ((size_t)((l * 128 + b) * 8 + h) * 64 + lane) * 64;
#pragma unroll
      for (int k = 0; k < 64; k += 4) *(float4*)(op + k) = make_float4(S[k], S[k + 1], S[k + 2], S[k + 3]);
    }
    return;
  }
  {
    const int i = lane, tg = wave;
    float ab[8], ak[8], akr[8], abr[8];
#pragma unroll
    for (int q = 0; q < 8; ++q) { ab[q] = 0.f; ak[q] = 0.f; akr[q] = 0.f; abr[q] = 0.f; }
#pragma unroll 2
    for (int k = 0; k < 64; ++k) {
      const float xb = SL(3)[i * 65 + k], xk = SL(1)[i * 65 + k];
#pragma unroll
      for (int q = 0; q < 8; ++q) {
        const int t = tg * 8 + q;
        const float yk = SL(4)[t * 65 + k], yr = SL(0)[t * 65 + k];
        ab[q] += xb * yk; ak[q] += xk * yk; akr[q] += xk * yr; abr[q] += xb * yr;
      }
    }
    __syncthreads();
#pragma unroll
    for (int q = 0; q < 8; ++q) {
      const int t = tg * 8 + q;
      SL(6)[i * 65 + t] = (i < t) ? ab[q] : 0.f;
      SL(7)[i * 65 + t] = (i < t) ? ak[q] : 0.f;
      SL(8)[i * 65 + t] = (i <= t) ? akr[q] : 0.f;
      SL(5)[i * 65 + t] = (i <= t) ? abr[q] : 0.f;
    }
  }
  __syncthreads();
  {
    const int t = tid >> 3, j0 = (tid & 7) * 8;
#pragma unroll
    for (int i = 0; i < 8; ++i) { const float g = gc[j0 + i]; SL(3)[t * 65 + j0 + i] *= g; SL(1)[t * 65 + j0 + i] *= g; }
  }
  __syncthreads();
  if (tid < 128) {
    float* X_ = (tid < 64) ? SL(5) : SL(3);
    const int col = tid & 63;
    for (int i = 62; i >= 0; --i) {
      float a = X_[i * 65 + col];
#pragma unroll 4
      for (int t = i + 1; t < 64; ++t) a -= SL(6)[i * 65 + t] * X_[t * 65 + col];
      X_[i * 65 + col] = a;
    }
  }
  __syncthreads();
  {
    const int c = tid & 127, ig = tid >> 7;
    const int which = c >> 6, cq = c & 63;
    const float* N_ = which ? SL(3) : SL(5);
    float a[16];
#pragma unroll
    for (int q = 0; q < 16; ++q) a[q] = 0.f;
#pragma unroll 2
    for (int t = 0; t < 64; ++t) {
      const float n = N_[t * 65 + cq];
#pragma unroll
      for (int q = 0; q < 16; ++q) a[q] += SL(7)[(ig * 16 + q) * 65 + t] * n;
    }
    float* T_ = which ? SL(1) : SL(8);
#pragma unroll
    for (int q = 0; q < 16; ++q) T_[(ig * 16 + q) * 65 + cq] -= a[q];
  }
  __syncthreads();
  {
    const int x = lane, yg = wave;
    float w2[8], pp[8], yl[8], qq[8];
#pragma unroll
    for (int q = 0; q < 8; ++q) { w2[q] = 0.f; pp[q] = 0.f; yl[q] = 0.f; qq[q] = 0.f; }
#pragma unroll 2
    for (int j = 0; j < 64; ++j) {
      const float l5 = SL(5)[j * 65 + x], l4 = SL(4)[j * 65 + x], l8 = SL(8)[j * 65 + x], l2 = SL(2)[j * 65 + x];
#pragma unroll
      for (int q = 0; q < 8; ++q) {
        const int y = yg * 8 + q;
        w2[q] += l5 * SL(4)[j * 65 + y];
        pp[q] += l4 * SL(3)[j * 65 + y];
        yl[q] += l8 * SL(2)[j * 65 + y];
        qq[q] += l2 * SL(1)[j * 65 + y];
      }
    }
    float o1[8];
#pragma unroll
    for (int q = 0; q < 8; ++q) {
      const int y = yg * 8 + q;
      o1[q] = SL(0)[x * 65 + y] - w2[q];
    }
    u16* Pf = (u16*)(p.ws + WS_PP) + (size_t)item * 4096;
    float* Qf = (float*)(p.ws + WS_Q) + (size_t)item * 4096;
    if (tid < 64) ((float*)(p.ws + WS_GC))[(size_t)item * 64 + tid] = gc[tid];
    {
      const int s_ = x >> 4, kk = x & 15, hh = (kk >> 2) & 1, jj = ((kk >> 3) << 2) | (kk & 3);
#pragma unroll
      for (int q = 0; q < 8; ++q) {
        const int y = yg * 8 + q;
        Pf[(((y >> 5) * 4 + s_) * 64 + (y & 31) + 32 * hh) * 8 + jj] = f2bf(-pp[q]);
        const int k2 = y & 31, reg = ((k2 >> 3) << 2) | (k2 & 3), h2 = (k2 >> 2) & 1;
        Qf[(((x >> 5) * 2 + (y >> 5)) * 16 + reg) * 64 + (x & 31) + 32 * h2] = qq[q];
      }
    }
    u16* W2p = (u16*)(p.ws + WS_W2) + (size_t)item * 4096 + x * 64 + yg * 8;
    u16* YLp = (u16*)(p.ws + WS_YL) + (size_t)item * 4096 + x * 64 + yg * 8;
    *(uint4*)W2p = pack8(o1);
    *(uint4*)YLp = pack8(yl);
  }
}

template <bool SWA = false, bool SWB = false>
__device__ __forceinline__ void mm_tile(const u16* Aop, int lda, const u16* Bop, int ldb, int mt, int nt, int r, int h, int ksteps, f32x16& acc) {
  const int ra = mt * 32 + r, rb = nt * 32 + r;
  const u16* ap = Aop + ra * lda;
  const u16* bp = Bop + rb * ldb;
  const int swa = SWA ? ((ra >> 3) & 7) : 0, swb = SWB ? ((rb >> 3) & 7) : 0;
#pragma unroll 4
  for (int s = 0; s < ksteps; ++s) {
    const bf16x8 a = *(const bf16x8*)(ap + (((2 * s + h) ^ swa) << 3));
    const bf16x8 b = *(const bf16x8*)(bp + (((2 * s + h) ^ swb) << 3));
    acc = __builtin_amdgcn_mfma_f32_32x32x16_bf16(a, b, acc, 0, 0, 0);
  }
}
#define SWZ(row, col) ((row) * 72 + (((((col) >> 3) ^ (((row) >> 3) & 7)) << 3) | ((col) & 7)))
__device__ __forceinline__ void store_T(u16* T, int ldt, int mt, int nt, int r, int h, const f32x16& acc) {
#pragma unroll
  for (int g = 0; g < 4; ++g) {
    uint2 o; o.x = pack2(acc[4 * g], acc[4 * g + 1]); o.y = pack2(acc[4 * g + 2], acc[4 * g + 3]);
    *(uint2*)(T + (nt * 32 + r) * ldt + mt * 32 + 8 * g + 4 * h) = o;
  }
}
__device__ __forceinline__ void tri16(const float* Ab, float* Xc) {
  float a0 = Xc[0];
  float a1 = Xc[65];
  float a2 = Xc[130];
  float a3 = Xc[195];
  float a4 = Xc[260];
  float a5 = Xc[325];
  float a6 = Xc[390];
  float a7 = Xc[455];
  float a8 = Xc[520];
  float a9 = Xc[585];
  float a10 = Xc[650];
  float a11 = Xc[715];
  float a12 = Xc[780];
  float a13 = Xc[845];
  float a14 = Xc[910];
  float a15 = Xc[975];
  const float4 c14_12 = *(const float4*)(Ab + 964);
  const float4 c13_12 = *(const float4*)(Ab + 896);
  const float4 c12_12 = *(const float4*)(Ab + 828);
  const float4 c11_12 = *(const float4*)(Ab + 760);
  a14 -= c14_12.w * a15;
  const float4 c10_8 = *(const float4*)(Ab + 688);
  const float4 c10_12 = *(const float4*)(Ab + 692);
  a13 -= c13_12.z * a14;
  a13 -= c13_12.w * a15;
  const float4 c9_8 = *(const float4*)(Ab + 620);
  const float4 c9_12 = *(const float4*)(Ab + 624);
  a12 -= c12_12.y * a13;
  a12 -= c12_12.z * a14;
  a12 -= c12_12.w * a15;
  const float4 c8_8 = *(const float4*)(Ab + 552);
  const float4 c8_12 = *(const float4*)(Ab + 556);
  a11 -= c11_12.x * a12;
  a11 -= c11_12.y * a13;
  a11 -= c11_12.z * a14;
  a11 -= c11_12.w * a15;
  const float4 c7_8 = *(const float4*)(Ab + 484);
  const float4 c7_12 = *(const float4*)(Ab + 488);
  a10 -= c10_8.w * a11;
  a10 -= c10_12.x * a12;
  a10 -= c10_12.y * a13;
  a10 -= c10_12.z * a14;
  a10 -= c10_12.w * a15;
  const float4 c6_4 = *(const float4*)(Ab + 412);
  const float4 c6_8 = *(const float4*)(Ab + 416);
  const float4 c6_12 = *(const float4*)(Ab + 420);
  a9 -= c9_8.z * a10;
  a9 -= c9_8.w * a11;
  a9 -= c9_12.x * a12;
  a9 -= c9_12.y * a13;
  a9 -= c9_12.z * a14;
  a9 -= c9_12.w * a15;
  const float4 c5_4 = *(const float4*)(Ab + 344);
  const float4 c5_8 = *(const float4*)(Ab + 348);
  const float4 c5_12 = *(const float4*)(Ab + 352);
  a8 -= c8_8.y * a9;
  a8 -= c8_8.z * a10;
  a8 -= c8_8.w * a11;
  a8 -= c8_12.x * a12;
  a8 -= c8_12.y * a13;
  a8 -= c8_12.z * a14;
  a8 -= c8_12.w * a15;
  const float4 c4_4 = *(const float4*)(Ab + 276);
  const float4 c4_8 = *(const float4*)(Ab + 280);
  const float4 c4_12 = *(const float4*)(Ab + 284);
  a7 -= c7_8.x * a8;
  a7 -= c7_8.y * a9;
  a7 -= c7_8.z * a10;
  a7 -= c7_8.w * a11;
  a7 -= c7_12.x * a12;
  a7 -= c7_12.y * a13;
  a7 -= c7_12.z * a14;
  a7 -= c7_12.w * a15;
  const float4 c3_4 = *(const float4*)(Ab + 208);
  const float4 c3_8 = *(const float4*)(Ab + 212);
  const float4 c3_12 = *(const float4*)(Ab + 216);
  a6 -= c6_4.w * a7;
  a6 -= c6_8.x * a8;
  a6 -= c6_8.y * a9;
  a6 -= c6_8.z * a10;
  a6 -= c6_8.w * a11;
  a6 -= c6_12.x * a12;
  a6 -= c6_12.y * a13;
  a6 -= c6_12.z * a14;
  a6 -= c6_12.w * a15;
  const float4 c2_0 = *(const float4*)(Ab + 136);
  const float4 c2_4 = *(const float4*)(Ab + 140);
  const float4 c2_8 = *(const float4*)(Ab + 144);
  const float4 c2_12 = *(const float4*)(Ab + 148);
  a5 -= c5_4.z * a6;
  a5 -= c5_4.w * a7;
  a5 -= c5_8.x * a8;
  a5 -= c5_8.y * a9;
  a5 -= c5_8.z * a10;
  a5 -= c5_8.w * a11;
  a5 -= c5_12.x * a12;
  a5 -= c5_12.y * a13;
  a5 -= c5_12.z * a14;
  a5 -= c5_12.w * a15;
  const float4 c1_0 = *(const float4*)(Ab + 68);
  const float4 c1_4 = *(const float4*)(Ab + 72);
  const float4 c1_8 = *(const float4*)(Ab + 76);
  const float4 c1_12 = *(const float4*)(Ab + 80);
  a4 -= c4_4.y * a5;
  a4 -= c4_4.z * a6;
  a4 -= c4_4.w * a7;
  a4 -= c4_8.x * a8;
  a4 -= c4_8.y * a9;
  a4 -= c4_8.z * a10;
  a4 -= c4_8.w * a11;
  a4 -= c4_12.x * a12;
  a4 -= c4_12.y * a13;
  a4 -= c4_12.z * a14;
  a4 -= c4_12.w * a15;
  const float4 c0_0 = *(const float4*)(Ab + 0);
  const float4 c0_4 = *(const float4*)(Ab + 4);
  const float4 c0_8 = *(const float4*)(Ab + 8);
  const float4 c0_12 = *(const float4*)(Ab + 12);
  a3 -= c3_4.x * a4;
  a3 -= c3_4.y * a5;
  a3 -= c3_4.z * a6;
  a3 -= c3_4.w * a7;
  a3 -= c3_8.x * a8;
  a3 -= c3_8.y * a9;
  a3 -= c3_8.z * a10;
  a3 -= c3_8.w * a11;
  a3 -= c3_12.x * a12;
  a3 -= c3_12.y * a13;
  a3 -= c3_12.z * a14;
  a3 -= c3_12.w * a15;
  a2 -= c2_0.w * a3;
  a2 -= c2_4.x * a4;
  a2 -= c2_4.y * a5;
  a2 -= c2_4.z * a6;
  a2 -= c2_4.w * a7;
  a2 -= c2_8.x * a8;
  a2 -= c2_8.y * a9;
  a2 -= c2_8.z * a10;
  a2 -= c2_8.w * a11;
  a2 -= c2_12.x * a12;
  a2 -= c2_12.y * a13;
  a2 -= c2_12.z * a14;
  a2 -= c2_12.w * a15;
  a1 -= c1_0.z * a2;
  a1 -= c1_0.w * a3;
  a1 -= c1_4.x * a4;
  a1 -= c1_4.y * a5;
  a1 -= c1_4.z * a6;
  a1 -= c1_4.w * a7;
  a1 -= c1_8.x * a8;
  a1 -= c1_8.y * a9;
  a1 -= c1_8.z * a10;
  a1 -= c1_8.w * a11;
  a1 -= c1_12.x * a12;
  a1 -= c1_12.y * a13;
  a1 -= c1_12.z * a14;
  a1 -= c1_12.w * a15;
  a0 -= c0_0.y * a1;
  a0 -= c0_0.z * a2;
  a0 -= c0_0.w * a3;
  a0 -= c0_4.x * a4;
  a0 -= c0_4.y * a5;
  a0 -= c0_4.z * a6;
  a0 -= c0_4.w * a7;
  a0 -= c0_8.x * a8;
  a0 -= c0_8.y * a9;
  a0 -= c0_8.z * a10;
  a0 -= c0_8.w * a11;
  a0 -= c0_12.x * a12;
  a0 -= c0_12.y * a13;
  a0 -= c0_12.z * a14;
  a0 -= c0_12.w * a15;
  Xc[0] = a0;
  Xc[65] = a1;
  Xc[130] = a2;
  Xc[195] = a3;
  Xc[260] = a4;
  Xc[325] = a5;
  Xc[390] = a6;
  Xc[455] = a7;
  Xc[520] = a8;
  Xc[585] = a9;
  Xc[650] = a10;
  Xc[715] = a11;
  Xc[780] = a12;
  Xc[845] = a13;
  Xc[910] = a14;
  Xc[975] = a15;
}
#define FS(i) (ldsf + (i) * 4160)
__device__ __forceinline__ void rwkv_item2(const Params& p, int l, int item, float* ldsf) {
  const int tid = opq(threadIdx.x), lane = tid & 63, wave = tid >> 6;
  const int r = lane & 31, hf = lane >> 5;
  const int h = item & 7, cidx = item >> 3, rowbase = cidx * 64, cc = cidx & 127;
  const u16* z = (const u16*)(p.ws + WS_Z);
  const float* mu = p.in[9] + l * 1792;
  u16* BBp = (u16*)((unsigned char*)ldsf + 83200);
  u16* XW = BBp;            u16* XA = BBp + 4608;    u16* XG = BBp + 9216;   u16* WT = BBp + 17920;
  u16* Rn = BBp;            u16* Kn = BBp + 4608;    u16* Bn = BBp + 9216;   u16* Cn = BBp + 13824;
  u16* CT = BBp + 18432;    u16* KHT = BBp + 23040;  u16* VT = BBp + 27648;
  float* gc = (float*)(BBp + 32256);
  u16* AK = (u16*)FS(2);    u16* NTm = AK + 4608;
  u16* MT = (u16*)FS(0);    u16* KQT = (u16*)FS(1);
  float* Abp = (float*)((unsigned char*)ldsf + 60928);
  const int mt = (wave >> 1) & 1, nt = wave & 1, grp = wave >> 2;
  const uint4* lwsrc = (const uint4*)((const u16*)(p.ws + WS_LW) + (size_t)h * 17920);
  const float bias_w = p.in[10][l * 512 + h * 64 + nt * 32 + r], bias_a = p.in[12][l * 512 + h * 64 + nt * 32 + r];
  float kkw_[8], kaw_[8], rkw_[8];
  {
    const int j0 = (tid & 7) * 8;
    const float* q1 = p.in[15] + l * 512 + h * 64 + j0; const float* q2 = p.in[16] + l * 512 + h * 64 + j0; const float* q3 = p.in[17] + l * 512 + h * 64 + j0;
    const float4 x0 = *(const float4*)q1, x1 = *(const float4*)(q1 + 4), y0 = *(const float4*)q2, y1 = *(const float4*)(q2 + 4), z0 = *(const float4*)q3, z1 = *(const float4*)(q3 + 4);
    kkw_[0] = x0.x; kkw_[1] = x0.y; kkw_[2] = x0.z; kkw_[3] = x0.w; kkw_[4] = x1.x; kkw_[5] = x1.y; kkw_[6] = x1.z; kkw_[7] = x1.w;
    kaw_[0] = y0.x; kaw_[1] = y0.y; kaw_[2] = y0.z; kaw_[3] = y0.w; kaw_[4] = y1.x; kaw_[5] = y1.y; kaw_[6] = y1.z; kaw_[7] = y1.w;
    rkw_[0] = z0.x; rkw_[1] = z0.y; rkw_[2] = z0.z; rkw_[3] = z0.w; rkw_[4] = z1.x; rkw_[5] = z1.y; rkw_[6] = z1.z; rkw_[7] = z1.w;
  }
  const uint4 g2a = lwsrc[1152 + tid], g2b = lwsrc[1152 + 512 + tid], g2c = (tid < 64) ? lwsrc[1152 + 1024 + tid] : make_uint4(0, 0, 0, 0);
  __syncthreads();
  {
    const int t = tid >> 3, c8 = (tid & 7) * 8;
    const int m = rowbase + t;
    const int zcs[7] = {h * 64, 512 + h * 64, 1024 + h * 64, 1536, 1600, 1664, 1728};
#pragma unroll
    for (int gi = 0; gi < 7; ++gi) {
      const int zc = zcs[gi] + c8;
      float cur[8], prv[8], v[8];
      const float4 mu0 = *(const float4*)(mu + zc), mu1 = *(const float4*)(mu + zc + 4);
      const float muv[8] = {mu0.x, mu0.y, mu0.z, mu0.w, mu1.x, mu1.y, mu1.z, mu1.w};
      unpack8(*(const uint4*)(z + (size_t)m * ZLD + zc), cur);
      if (t == 0 && cc == 0) {
#pragma unroll
        for (int i = 0; i < 8; ++i) prv[i] = 0.f;
      } else {
        unpack8(*(const uint4*)(z + (size_t)(m - 1) * ZLD + zc), prv);
      }
#pragma unroll
      for (int i = 0; i < 8; ++i) {
        float x = cur[i] + muv[i] * (prv[i] - cur[i]);
        if (gi == 3) x = 1.f - 2.f * __builtin_amdgcn_rcpf(1.f + __expf(2.f * x));
        if (gi >= 5) x = sigm(x);
        v[i] = x;
      }
      if (gi < 2) {
        float* d = FS(gi) + t * 65 + c8;
#pragma unroll
        for (int i = 0; i < 8; ++i) d[i] = v[i];
      } else if (gi == 2) {
#pragma unroll
        for (int i = 0; i < 8; ++i) VT[SWZ(c8 + i, t)] = f2bf(v[i]);
      } else if (gi == 3) { *(uint4*)(XW + t * 72 + c8) = pack8(v); }
      else if (gi == 4) { *(uint4*)(XA + t * 72 + c8) = pack8(v); }
      else { *(uint4*)(XG + t * 136 + (gi - 5) * 64 + c8) = pack8(v); }
    }
  }
  {
    uint4* d = (uint4*)WT;
    for (int e = tid; e < 1152; e += 512) d[e] = lwsrc[e];
  }
  __syncthreads();
  {
    f32x16 acc;
#pragma unroll
    for (int i = 0; i < 16; ++i) acc[i] = 0.f;
    mm_tile(grp ? XA : XW, 72, grp ? WT + 4608 : WT, 72, mt, nt, r, hf, 4, acc);
    const int j = nt * 32 + r;
    const float bias = grp ? bias_a : bias_w;
#pragma unroll
    for (int reg = 0; reg < 16; ++reg) {
      const int t = mt * 32 + ROWOFF(reg, hf);
      const float x = acc[reg] + bias;
      if (grp) FS(3)[t * 65 + j] = sigm(x);
      else {
        const float nx = -x;
        const float sp = (nx > 20.f) ? nx : __logf(1.f + __expf(nx));
        FS(4)[t * 65 + j] = -__expf(-sp - 0.5f);
      }
    }
  }
  __syncthreads();
  {
    uint4* d = (uint4*)WT;
    d[tid] = g2a; d[512 + tid] = g2b; if (tid < 64) d[1024 + tid] = g2c;
  }
  float* psum = (float*)((unsigned char*)ldsf + 147968);
  float pl[8];
  {
    const int j = tid & 63, sg = tid >> 6;
    float c = 0.f;
#pragma unroll
    for (int u = 0; u < 8; ++u) { c += FS(4)[(sg * 8 + u) * 65 + j]; pl[u] = c; }
    psum[sg * 64 + j] = c;
  }
  __syncthreads();
  {
    const int j = tid & 63, sg = tid >> 6;
    float off = 0.f, tot = 0.f;
#pragma unroll
    for (int q = 0; q < 8; ++q) { const float v = psum[q * 64 + j]; tot += v; if (q < sg) off += v; }
#pragma unroll
    for (int u = 0; u < 8; ++u) FS(2)[(sg * 8 + u) * 65 + j] = off + pl[u];
    if (sg == 0) { const float g = __expf(tot); gc[j] = g; ((float*)(p.ws + WS_GC))[(size_t)item * 64 + j] = g; }
  }
  if (grp == 0) {
    f32x16 acc;
#pragma unroll
    for (int i = 0; i < 16; ++i) acc[i] = 0.f;
    mm_tile(XG, 136, WT, 136, mt, nt, r, hf, 8, acc);
    u16* ga = (u16*)(p.ws + WS_GA) + (size_t)item * 4096;
#pragma unroll
    for (int reg = 0; reg < 16; ++reg) ga[(mt * 32 + ROWOFF(reg, hf)) * 64 + nt * 32 + r] = f2bf(acc[reg]);
  }
  __syncthreads();
  {
    const int t = tid >> 3, j0 = (tid & 7) * 8;
    float kr[8], av[8], rv[8], kkv[8], kf[8];
    float nrm = 0.f, bdot = 0.f;
#pragma unroll
    for (int i = 0; i < 8; ++i) {
      const int j = j0 + i;
      kr[i] = FS(1)[t * 65 + j]; av[i] = FS(3)[t * 65 + j]; rv[i] = FS(0)[t * 65 + j];
      kkv[i] = kr[i] * kkw_[i];
      nrm += kkv[i] * kkv[i];
      kf[i] = kr[i] * (1.f + (av[i] - 1.f) * kaw_[i]);
      bdot += rv[i] * kf[i] * rkw_[i];
    }
    nrm += __shfl_xor(nrm, 1, 64); nrm += __shfl_xor(nrm, 2, 64); nrm += __shfl_xor(nrm, 4, 64);
    bdot += __shfl_xor(bdot, 1, 64); bdot += __shfl_xor(bdot, 2, 64); bdot += __shfl_xor(bdot, 4, 64);
    const float rn = 1.f / fmaxf(sqrtf(nrm), 1e-12f);
    float o_r[8], o_k[8], o_b[8], o_c[8], bo[8];
#pragma unroll
    for (int i = 0; i < 8; ++i) {
      const int j = j0 + i;
      const float cum = FS(2)[t * 65 + j], dl = FS(4)[t * 65 + j];
      const float eg = __expf(cum), egi = __expf(-cum), egp = __expf(cum - dl);
      const float kk = kkv[i] * rn;
      const float g = gc[j];
      o_r[i] = rv[i] * eg; o_k[i] = kf[i] * egi; o_b[i] = kk * av[i] * egi; o_c[i] = kk * egp;
      CT[SWZ(j, t)] = f2bf(o_c[i]);
      KHT[SWZ(j, t)] = f2bf(o_k[i] * g);
      FS(1)[t * 65 + j] = o_b[i] * g;
      bo[i] = bdot * bf2f(VT[SWZ(j, t)]);
    }
    *(uint4*)(Rn + t * 72 + j0) = pack8(o_r);
    *(uint4*)(Kn + t * 72 + j0) = pack8(o_k);
    *(uint4*)(Bn + t * 72 + j0) = pack8(o_b);
    *(uint4*)(Cn + t * 72 + j0) = pack8(o_c);
    u16* bop = (u16*)(p.ws + WS_BO) + (size_t)item * 4096;
    *(uint4*)(bop + t * 64 + j0) = pack8(bo);
  }
  __syncthreads();
  f32x16 akr;
#pragma unroll
  for (int i = 0; i < 16; ++i) akr[i] = 0.f;
  if (grp == 0) {
    f32x16 ab, abr;
#pragma unroll
    for (int i = 0; i < 16; ++i) { ab[i] = 0.f; abr[i] = 0.f; }
    mm_tile(Bn, 72, Cn, 72, mt, nt, r, hf, 4, ab);
    mm_tile(Bn, 72, Rn, 72, mt, nt, r, hf, 4, abr);
    const int t = nt * 32 + r;
#pragma unroll
    for (int reg = 0; reg < 16; ++reg) {
      const int i = mt * 32 + ROWOFF(reg, hf);
      Abp[i * 68 + t] = (i < t) ? ab[reg] : 0.f;
      FS(0)[i * 65 + t] = (i <= t) ? abr[reg] : 0.f;
    }
  } else {
    f32x16 akt;
#pragma unroll
    for (int i = 0; i < 16; ++i) akt[i] = 0.f;
    mm_tile(Cn, 72, Kn, 72, mt, nt, r, hf, 4, akt);
    {
      const int i = nt * 32 + r;
#pragma unroll
      for (int reg = 0; reg < 16; ++reg) { const int t = mt * 32 + ROWOFF(reg, hf); if (!(i < t)) akt[reg] = 0.f; }
    }
    store_T(AK, 72, mt, nt, r, hf, akt);
    mm_tile(Kn, 72, Rn, 72, mt, nt, r, hf, 4, akr);
    {
      const int t = nt * 32 + r;
#pragma unroll
      for (int reg = 0; reg < 16; ++reg) { const int i = mt * 32 + ROWOFF(reg, hf); if (!(i <= t)) akr[reg] = 0.f; }
    }
  }
  __syncthreads();
#pragma unroll 1
  for (int I = 3; I >= 0; --I) {
    if (tid < 128) {
      float* X_ = (tid < 64) ? FS(0) : FS(1);
      tri16(Abp + I * 16 * 69, X_ + I * 16 * 65 + (tid & 63));
    }
    __syncthreads();
    if (I > 0) {
      const int c = tid & 127, rg = tid >> 7;
      float* X_ = (c < 64) ? FS(0) : FS(1);
      const int col = c & 63;
      float xv[16];
#pragma unroll
      for (int t = 0; t < 16; ++t) xv[t] = X_[(I * 16 + t) * 65 + col];
      for (int i = rg; i < I * 16; i += 4) {
        const float* ar = Abp + i * 68 + I * 16;
        const float4 c0 = *(const float4*)ar, c1 = *(const float4*)(ar + 4), c2 = *(const float4*)(ar + 8), c3 = *(const float4*)(ar + 12);
        float a = c0.x * xv[0] + c0.y * xv[1] + c0.z * xv[2] + c0.w * xv[3];
        a += c1.x * xv[4] + c1.y * xv[5] + c1.z * xv[6] + c1.w * xv[7];
        a += c2.x * xv[8] + c2.y * xv[9] + c2.z * xv[10] + c2.w * xv[11];
        a += c3.x * xv[12] + c3.y * xv[13] + c3.z * xv[14] + c3.w * xv[15];
        X_[i * 65 + col] -= a;
      }
      __syncthreads();
    }
  }
  {
    const int c = tid >> 2, q = tid & 3;
    const float* X_ = (c < 64) ? FS(0) : FS(1);
    const int col = c & 63;
    float o0[8], o1[8];
#pragma unroll
    for (int u = 0; u < 8; ++u) { o0[u] = -X_[(q * 16 + u) * 65 + col]; o1[u] = -X_[(q * 16 + 8 + u) * 65 + col]; }
    u16* dst = NTm + c * 72 + q * 16;
    *(uint4*)dst = pack8(o0);
    *(uint4*)(dst + 8) = pack8(o1);
  }
  __syncthreads();
  if (grp == 1) {
    mm_tile(AK, 72, NTm, 72, mt, nt, r, hf, 4, akr);
    store_T(MT, 72, mt, nt, r, hf, akr);
  } else {
    f32x16 d2;
#pragma unroll
    for (int i = 0; i < 16; ++i) d2[i] = 0.f;
    mm_tile(AK, 72, NTm + 64 * 72, 72, mt, nt, r, hf, 4, d2);
#pragma unroll
    for (int g = 0; g < 4; ++g) {
      const int idx = (nt * 32 + r) * 72 + mt * 32 + 8 * g + 4 * hf;
      const uint2 kh = *(const uint2*)(KHT + SWZ(nt * 32 + r, mt * 32 + 8 * g + 4 * hf));
      uint2 o;
      o.x = pack2(d2[4 * g] + __uint_as_float(kh.x << 16), d2[4 * g + 1] + __uint_as_float(kh.x & 0xFFFF0000u));
      o.y = pack2(d2[4 * g + 2] + __uint_as_float(kh.y << 16), d2[4 * g + 3] + __uint_as_float(kh.y & 0xFFFF0000u));
      *(uint2*)(KQT + idx) = o;
    }
  }
  __syncthreads();
  if (grp == 0) {
    f32x16 w2, yl;
#pragma unroll
    for (int i = 0; i < 16; ++i) { w2[i] = 0.f; yl[i] = 0.f; }
    mm_tile<false, true>(NTm, 72, CT, 72, mt, nt, r, hf, 4, w2);
    mm_tile<false, true>(MT, 72, VT, 72, mt, nt, r, hf, 4, yl);
    u16* W2p = (u16*)(p.ws + WS_W2) + (size_t)item * 4096;
    u16* YLp = (u16*)(p.ws + WS_YL) + (size_t)item * 4096;
#pragma unroll
    for (int reg = 0; reg < 16; ++reg) {
      const int t = mt * 32 + ROWOFF(reg, hf), n = nt * 32 + r;
      W2p[t * 64 + n] = f2bf(w2[reg] + bf2f(Rn[t * 72 + n]));
      YLp[t * 64 + n] = f2bf(yl[reg]);
    }
  } else {
    f32x16 pp, qt;
#pragma unroll
    for (int i = 0; i < 16; ++i) { pp[i] = 0.f; qt[i] = 0.f; }
    mm_tile<true, false>(CT, 72, NTm + 64 * 72, 72, mt, nt, r, hf, 4, pp);
    mm_tile<false, true>(KQT, 72, VT, 72, mt, nt, r, hf, 4, qt);
    uint4* Pf = (uint4*)((u16*)(p.ws + WS_PP) + (size_t)item * 4096);
    float* Qf = (float*)(p.ws + WS_Q) + (size_t)item * 4096;
#pragma unroll
    for (int s2 = 0; s2 < 2; ++s2) {
      uint4 o;
      o.x = pack2(pp[s2 * 8 + 0], pp[s2 * 8 + 1]); o.y = pack2(pp[s2 * 8 + 2], pp[s2 * 8 + 3]);
      o.z = pack2(pp[s2 * 8 + 4], pp[s2 * 8 + 5]); o.w = pack2(pp[s2 * 8 + 6], pp[s2 * 8 + 7]);
      Pf[(nt * 4 + mt * 2 + s2) * 64 + lane] = o;
    }
#pragma unroll
    for (int reg = 0; reg < 16; ++reg) Qf[((nt * 2 + mt) * 16 + reg) * 64 + lane] = qt[reg];
  }
}

template <int K_> struct IC { static constexpr int value = K_; };
__device__ __forceinline__ void rwkv_scan(const Params& p, int l, int bh, float* ldsf, bool dry = false) {
  const int tid = opq(threadIdx.x), lane = tid & 63, wave = tid >> 6;
  const int b = bh >> 3, h = bh & 7;
  unsigned char* ring = (unsigned char*)ldsf + 32768;
  uint4* xch = (uint4*)((unsigned char*)ldsf + 32768 + 49152);
  __syncthreads();
  {
    const float* G0 = (const float*)(p.ws + WS_GC);
    for (int e = tid; e < 8192; e += NT) ldsf[e] = G0[(size_t)((b * 128 + (e >> 6)) * 8 + h) * 64 + (e & 63)];
    if (tid < 256) { for (int e = tid; e < 1024; e += 256) xch[e] = make_uint4(0, 0, 0, 0); }
  }
  const bool helper = wave >= 4;
  const u16* PPb = (const u16*)(p.ws + WS_PP);
  const float* Qb = (const float*)(p.ws + WS_Q);
  if (helper) {
    const bool isP = wave < 6;
    const int hidx = isP ? (tid - 256) : (tid - 384);
    const int hdst = isP ? hidx : 512 + hidx;
#define SC_GLOAD(c, R) do { const size_t id_ = (size_t)((b * 128 + (c)) * 8 + h); \
      if (isP) { const uint4* src_ = (const uint4*)(PPb + id_ * 4096) + hidx; R##0 = src_[0]; R##1 = src_[128]; R##2 = src_[256]; R##3 = src_[384]; } \
      else { const uint4* src_ = (const uint4*)(Qb + id_ * 4096) + hidx; R##0 = src_[0]; R##1 = src_[128]; R##2 = src_[256]; R##3 = src_[384]; \
             R##4 = src_[512]; R##5 = src_[640]; R##6 = src_[768]; R##7 = src_[896]; } } while (0)
#define SC_LWRITE(c, R) do { uint4* slot_ = (uint4*)(ring + ((c) & 1) * 24576) + hdst; \
      slot_[0] = R##0; slot_[128] = R##1; slot_[256] = R##2; slot_[384] = R##3; \
      if (!isP) { slot_[512] = R##4; slot_[640] = R##5; slot_[768] = R##6; slot_[896] = R##7; } } while (0)
    uint4 a0, a1, a2, a3, a4, a5, a6, a7, b0, b1, b2, b3, b4, b5, b6, b7, c0, c1, c2, c3, c4, c5, c6, c7, d0, d1, d2, d3, d4, d5, d6, d7;
    a4 = a5 = a6 = a7 = b4 = b5 = b6 = b7 = c4 = c5 = c6 = c7 = d4 = d5 = d6 = d7 = make_uint4(0, 0, 0, 0);
    SC_GLOAD(0, a); SC_LWRITE(0, a);
    SC_GLOAD(1, b); SC_GLOAD(2, c); SC_GLOAD(3, d);
    __syncthreads();
#pragma unroll 1
    for (int cc = 0; cc < 128; cc += 4) {
      if (cc + 4 < 128) SC_GLOAD(cc + 4, a);
      SC_LWRITE(cc + 1, b);
      asm volatile("s_waitcnt lgkmcnt(0)\n\ts_barrier" ::: "memory");
      if (cc + 5 < 128) SC_GLOAD(cc + 5, b);
      SC_LWRITE(cc + 2, c);
      asm volatile("s_waitcnt lgkmcnt(0)\n\ts_barrier" ::: "memory");
      if (cc + 6 < 128) SC_GLOAD(cc + 6, c);
      SC_LWRITE(cc + 3, d);
      asm volatile("s_waitcnt lgkmcnt(0)\n\ts_barrier" ::: "memory");
      if (cc + 7 < 128) SC_GLOAD(cc + 7, d);
      if (cc + 4 < 128) SC_LWRITE(cc + 4, a);
      asm volatile("s_waitcnt lgkmcnt(0)\n\ts_barrier" ::: "memory");
    }
    return;
  }
  __syncthreads();
  const int vt = wave & 1, kt2 = wave >> 1, hf = lane >> 5;
  f32x16 S;
#pragma unroll
  for (int i = 0; i < 16; ++i) S[i] = 0.f;
  uint4 own0 = make_uint4(0, 0, 0, 0), own1 = make_uint4(0, 0, 0, 0);
#pragma unroll 1
  for (int cc = 0; cc < 128; ++cc) {
    const size_t id = (size_t)((b * 128 + cc) * 8 + h);
    const int lofs = opq(lane);
    float* Qg = (float*)Qb + id * 4096 + (vt * 2 + kt2) * 1024 + lofs;
    const uint4* slotA = (const uint4*)(ring + (cc & 1) * 24576) + kt2 * 256 + lofs;
    const float* slotQ = (const float*)(ring + (cc & 1) * 24576 + 8192) + (vt * 2 + kt2) * 1024 + lofs;
    const float* gcp = ldsf + cc * 64 + kt2 * 32 + 4 * (lofs >> 5);
    const uint4* xin = xch + (((cc & 1) * 2 + vt) * 2 + (kt2 ^ 1)) * 128 + lofs;
    uint4* xout = xch + ((((cc + 1) & 1) * 2 + vt) * 2 + kt2) * 128 + lofs;
    f32x16 acc;
#pragma unroll
    for (int reg = 0; reg < 16; ++reg) acc[reg] = S[reg] * gcp[((reg) & 3) + 8 * ((reg) >> 2)] + slotQ[reg * 64];
#pragma unroll
    for (int reg = 0; reg < 16; ++reg) if (!dry) Qg[reg * 64] = S[reg];
    const uint4 p0 = xin[0], p1 = xin[64];
#pragma unroll
    for (int s_ = 0; s_ < 4; ++s_) {
      union { uint4 u; bf16x8 v; } bfr, af;
      const bool mine = (s_ >> 1) == kt2;
      bfr.u = mine ? ((s_ & 1) ? own1 : own0) : ((s_ & 1) ? p1 : p0);
      af.u = slotA[s_ * 64];
      acc = __builtin_amdgcn_mfma_f32_32x32x16_bf16(af.v, bfr.v, acc, 0, 0, 0);
    }
    S = acc;
    own0 = make_uint4(pack2(S[0], S[1]), pack2(S[2], S[3]), pack2(S[4], S[5]), pack2(S[6], S[7]));
    own1 = make_uint4(pack2(S[8], S[9]), pack2(S[10], S[11]), pack2(S[12], S[13]), pack2(S[14], S[15]));
    xout[0] = own0; xout[64] = own1;
    asm volatile("s_waitcnt lgkmcnt(0)\n\ts_barrier" ::: "memory");
  }
  {
    float* o = p.out + O_PWKV + ((size_t)((l * 2 + b) * 8 + h) * 64 + vt * 32 + (lane & 31)) * 64 + kt2 * 32;
#pragma unroll
    for (int reg = 0; reg < 16; ++reg) o[ROWOFF(reg, hf)] = S[reg];
  }
}

__device__ __forceinline__ void rwkv_out(const Params& p, int l, int item, float* ldsf) {
  const int tid = opq(threadIdx.x), lane = tid & 63, wave = tid >> 6;
  const int h = item & 7, cidx = item >> 3;
  float* Sl = ldsf; float* Wl = ldsf + 4160;
  const float* Sg = (const float*)(p.ws + WS_Q) + (size_t)item * 4096;
  const u16* W2 = (const u16*)(p.ws + WS_W2) + (size_t)item * 4096;
  const u16* YL = (const u16*)(p.ws + WS_YL) + (size_t)item * 4096;
  const u16* BO = (const u16*)(p.ws + WS_BO) + (size_t)item * 4096;
  const u16* GA = (const u16*)(p.ws + WS_GA) + (size_t)item * 4096;
  u16* z = (u16*)(p.ws + WS_Z);
  __syncthreads();
  {
    const int row = tid >> 3, c = (tid & 7) * 8;
#pragma unroll
    for (int i = 0; i < 8; ++i) {
      const int idx = i * 512 + tid;
      const int ln = idx & 63, reg = (idx >> 6) & 15, kt = (idx >> 10) & 1, vt = idx >> 11;
      Sl[(vt * 32 + (ln & 31)) * 65 + kt * 32 + ROWOFF(reg, ln >> 5)] = Sg[idx];
    }
    float w[8];
    unpack8(*(const uint4*)(W2 + row * 64 + c), w);
    float* e = Wl + row * 65 + c;
#pragma unroll
    for (int i = 0; i < 8; ++i) e[i] = w[i];
  }
  __syncthreads();
  float y[8];
#pragma unroll
  for (int q = 0; q < 8; ++q) y[q] = bf2f(YL[(wave * 8 + q) * 64 + lane]);
#pragma unroll 2
  for (int k = 0; k < 64; ++k) {
    const float s = Sl[lane * 65 + k];
#pragma unroll
    for (int q = 0; q < 8; ++q) y[q] += s * Wl[(wave * 8 + q) * 65 + k];
  }
  const float lng = p.in[18][l * 512 + h * 64 + lane], lnb = p.in[19][l * 512 + h * 64 + lane];
#pragma unroll
  for (int q = 0; q < 8; ++q) {
    const int t = wave * 8 + q;
    const float mean = wave_sum(y[q]) * (1.f / 64.f);
    const float d = y[q] - mean;
    const float var = wave_sum(d * d) * (1.f / 64.f);
    const float yn = d * rsqrtf(var + 64e-5f) * lng + lnb;
    const float o = (yn + bf2f(BO[t * 64 + lane])) * bf2f(GA[t * 64 + lane]);
    z[(size_t)(cidx * 64 + t) * ZLD + h * 64 + lane] = f2bf(o);
  }
}

__device__ __forceinline__ void rwkv_out4(const Params& p, int l, int item0, float* ldsf) {
  const int tid = opq(threadIdx.x), lane = tid & 63, wave = tid >> 6;
  const int r = lane & 31, hf = lane >> 5;
  const int pair = wave >> 1, nt = wave & 1;
  const int item = item0 + pair;
  const int h = item & 7, cidx = item >> 3;
  u16* Sl = (u16*)ldsf + pair * 4608;
  const float* Sg = (const float*)(p.ws + WS_Q) + (size_t)item * 4096;
  const u16* W2 = (const u16*)(p.ws + WS_W2) + (size_t)item * 4096;
  const u16* YL = (const u16*)(p.ws + WS_YL) + (size_t)item * 4096;
  const u16* BO = (const u16*)(p.ws + WS_BO) + (size_t)item * 4096;
  const u16* GA = (const u16*)(p.ws + WS_GA) + (size_t)item * 4096;
  u16* z = (u16*)(p.ws + WS_Z);
  __syncthreads();
  {
    const int lt = tid & 127;
#pragma unroll
    for (int q = 0; q < 8; ++q) {
      const int e = q * 128 + lt;
      const int ln = e & 63, g = (e >> 6) & 3, kt = (e >> 8) & 1, vt = (e >> 9) & 1;
      const float* sp = Sg + ((vt * 2 + kt) * 16 + 4 * g) * 64 + ln;
      const float a0 = sp[0], a1 = sp[64], a2 = sp[128], a3 = sp[192];
      uint2 o; o.x = pack2(a0, a1); o.y = pack2(a2, a3);
      *(uint2*)(Sl + (vt * 32 + (ln & 31)) * 72 + kt * 32 + 8 * g + 4 * (ln >> 5)) = o;
    }
  }
  bf16x8 bfr[4];
#pragma unroll
  for (int s_ = 0; s_ < 4; ++s_) bfr[s_] = *(const bf16x8*)(W2 + (nt * 32 + r) * 64 + s_ * 16 + hf * 8);
  __syncthreads();
  f32x16 acc[2];
#pragma unroll
  for (int mt = 0; mt < 2; ++mt) {
#pragma unroll
    for (int i = 0; i < 16; ++i) acc[mt][i] = 0.f;
#pragma unroll
    for (int s_ = 0; s_ < 4; ++s_) {
      const bf16x8 a = *(const bf16x8*)(Sl + (mt * 32 + r) * 72 + s_ * 16 + hf * 8);
      acc[mt] = __builtin_amdgcn_mfma_f32_32x32x16_bf16(a, bfr[s_], acc[mt], 0, 0, 0);
    }
  }
  const int t = nt * 32 + r;
  float sum = 0.f;
#pragma unroll
  for (int mt = 0; mt < 2; ++mt)
#pragma unroll
    for (int g = 0; g < 4; ++g) {
      const uint2 yl = *(const uint2*)(YL + t * 64 + mt * 32 + 8 * g + 4 * hf);
      acc[mt][4 * g + 0] += __uint_as_float(yl.x << 16); acc[mt][4 * g + 1] += __uint_as_float(yl.x & 0xFFFF0000u);
      acc[mt][4 * g + 2] += __uint_as_float(yl.y << 16); acc[mt][4 * g + 3] += __uint_as_float(yl.y & 0xFFFF0000u);
      sum += acc[mt][4 * g] + acc[mt][4 * g + 1] + acc[mt][4 * g + 2] + acc[mt][4 * g + 3];
    }
  sum += __shfl_xor(sum, 32, 64);
  const float mean = sum * (1.f / 64.f);
  float vs = 0.f;
#pragma unroll
  for (int mt = 0; mt < 2; ++mt)
#pragma unroll
    for (int i = 0; i < 16; ++i) { const float d = acc[mt][i] - mean; vs += d * d; }
  vs += __shfl_xor(vs, 32, 64);
  const float rstd = rsqrtf(vs * (1.f / 64.f) + 64e-5f);
  const float* lng = p.in[18] + l * 512 + h * 64;
  const float* lnb = p.in[19] + l * 512 + h * 64;
  u16* zrow = z + (size_t)(cidx * 64 + t) * ZLD + h * 64;
#pragma unroll
  for (int mt = 0; mt < 2; ++mt)
#pragma unroll
    for (int g = 0; g < 4; ++g) {
      const int v0 = mt * 32 + 8 * g + 4 * hf;
      const uint2 bo = *(const uint2*)(BO + t * 64 + v0);
      const uint2 ga = *(const uint2*)(GA + t * 64 + v0);
      const float4 lg = *(const float4*)(lng + v0), lb = *(const float4*)(lnb + v0);
      const float bo_[4] = {__uint_as_float(bo.x << 16), __uint_as_float(bo.x & 0xFFFF0000u), __uint_as_float(bo.y << 16), __uint_as_float(bo.y & 0xFFFF0000u)};
      const float ga_[4] = {__uint_as_float(ga.x << 16), __uint_as_float(ga.x & 0xFFFF0000u), __uint_as_float(ga.y << 16), __uint_as_float(ga.y & 0xFFFF0000u)};
      const float lg_[4] = {lg.x, lg.y, lg.z, lg.w}, lb_[4] = {lb.x, lb.y, lb.z, lb.w};
      float o[4];
#pragma unroll
      for (int u = 0; u < 4; ++u) o[u] = ((acc[mt][4 * g + u] - mean) * rstd * lg_[u] + lb_[u] + bo_[u]) * ga_[u];
      uint2 ov; ov.x = pack2(o[0], o[1]); ov.y = pack2(o[2], o[3]);
      *(uint2*)(zrow + v0) = ov;
    }
}

__device__ __forceinline__ void attn_prompt(const Params& p, int l, int item, u16* lds, bool dry = false) {
  const int tid = opq(threadIdx.x), lane = tid & 63, wave = tid >> 6;
  const int r = lane & 31, h = lane >> 5;
  const int kvh = item & 1, n = (item >> 1) & 63, b = item >> 7;
  u16* z = (u16*)(p.ws + WS_Z);
  u16* Ks = lds;
  u16* Vt = lds + 256 * 72;
  __syncthreads();
  {
    const int key = tid >> 1, half = tid & 1;
    const int t = (n - 1) * 128 + key;
    uint4 kv[4], vv[4];
    if (t >= 0) {
      const u16* kp = z + (size_t)(b * 8192 + t) * ZLD + 2304 + kvh * 64 + half * 32;
      const u16* vp = z + (size_t)(b * 8192 + t) * ZLD + 2432 + kvh * 64 + half * 32;
#pragma unroll
      for (int i = 0; i < 4; ++i) { kv[i] = *(const uint4*)(kp + i * 8); vv[i] = *(const uint4*)(vp + i * 8); }
    } else {
#pragma unroll
      for (int i = 0; i < 4; ++i) { kv[i] = make_uint4(0, 0, 0, 0); vv[i] = make_uint4(0, 0, 0, 0); }
    }
#pragma unroll
    for (int i = 0; i < 4; ++i) {
      *(uint4*)(Ks + key * 72 + half * 32 + i * 8) = kv[i];
      const unsigned w[4] = {vv[i].x, vv[i].y, vv[i].z, vv[i].w};
#pragma unroll
      for (int q = 0; q < 4; ++q) {
        const int d = half * 32 + i * 8 + q * 2;
        Vt[d * 264 + key] = (u16)(w[q] & 0xFFFFu);
        Vt[(d + 1) * 264 + key] = (u16)(w[q] >> 16);
      }
    }
  }
  __syncthreads();
#pragma unroll 1
  for (int uu = 0; uu < 2; ++uu) {
    const int u = wave * 2 + uu;
    const int hq = kvh * 4 + (u >> 2), qg = u & 3;
    const int qrow = b * 8192 + n * 128 + qg * 32 + r;
    u16* qp = z + (size_t)qrow * ZLD + 1792 + hq * 64;
    bf16x8 qf[4];
#pragma unroll
    for (int s = 0; s < 4; ++s) qf[s] = *(const bf16x8*)(qp + s * 16 + h * 8);
    f32x16 sc[5];
#pragma unroll
    for (int i5 = 0; i5 < 5; ++i5) {
#pragma unroll
      for (int i = 0; i < 16; ++i) sc[i5][i] = 0.f;
      const int kt = qg + i5;
#pragma unroll
      for (int s = 0; s < 4; ++s) {
        bf16x8 kf = *(const bf16x8*)(Ks + (kt * 32 + r) * 72 + s * 16 + h * 8);
        sc[i5] = __builtin_amdgcn_mfma_f32_32x32x16_bf16(kf, qf[s], sc[i5], 0, 0, 0);
      }
      __builtin_amdgcn_sched_barrier(0);
    }
    const int qi = qg * 32 + r;
    const float sink = p.in[20][l * 8 + hq];
    float mx = -1e30f;
#pragma unroll
    for (int i5 = 0; i5 < 5; ++i5)
#pragma unroll
      for (int reg = 0; reg < 16; ++reg) {
        const int j = (qg + i5) * 32 + ROWOFF(reg, h);
        const bool ok = (j > qi) && (j <= qi + 128) && (n > 0 || j >= 128);
        const float s = ok ? sc[i5][reg] * 0.125f : -1e30f;
        sc[i5][reg] = s;
        mx = fmaxf(mx, s);
      }
    mx = fmaxf(mx, __shfl_xor(mx, 32, 64));
    mx = fmaxf(mx, sink);
    float sum = 0.f;
#pragma unroll
    for (int i5 = 0; i5 < 5; ++i5)
#pragma unroll
      for (int reg = 0; reg < 16; ++reg) { const float e = __expf(sc[i5][reg] - mx); sc[i5][reg] = e; sum += e; }
    sum += __shfl_xor(sum, 32, 64);
    const float rden = 1.f / (sum + __expf(sink - mx));
    f32x16 oacc[2];
#pragma unroll
    for (int i = 0; i < 16; ++i) { oacc[0][i] = 0.f; oacc[1][i] = 0.f; }
#pragma unroll
    for (int i5 = 0; i5 < 5; ++i5) {
      const int kt = qg + i5;
#pragma unroll
      for (int s2 = 0; s2 < 2; ++s2) {
        bf16x8 pf;
#pragma unroll
        for (int j = 0; j < 8; ++j) pf[j] = (short)f2bf(sc[i5][s2 * 8 + j] * rden);
#pragma unroll
        for (int dt = 0; dt < 2; ++dt) {
          const u16* vp = Vt + (dt * 32 + r) * 264 + kt * 32 + s2 * 16 + h * 4;
          const uint2 lo = *(const uint2*)vp, hi = *(const uint2*)(vp + 8);
          union { uint4 u; bf16x8 v; } cv;
          cv.u = make_uint4(lo.x, lo.y, hi.x, hi.y);
          oacc[dt] = __builtin_amdgcn_mfma_f32_32x32x16_bf16(cv.v, pf, oacc[dt], 0, 0, 0);
        }
        __builtin_amdgcn_sched_barrier(0);
      }
    }
#pragma unroll
    for (int dt = 0; dt < 2; ++dt)
#pragma unroll
      for (int g4 = 0; g4 < 4; ++g4) {
        const int d = dt * 32 + 8 * g4 + 4 * h;
        uint2 o;
        o.x = pack2(oacc[dt][g4 * 4 + 0], oacc[dt][g4 * 4 + 1]);
        o.y = pack2(oacc[dt][g4 * 4 + 2], oacc[dt][g4 * 4 + 3]);
        if (!dry) *(uint2*)(qp + d) = o;
      }
  }
}

__device__ __forceinline__ void attn_sample(const Params& p, int l, int item, float* ldsf, bool dry = false) {
  const int tid = opq(threadIdx.x);
  const int kvh = item & 1, b = item >> 1;
  u16* z = (u16*)(p.ws + WS_Z);
  float* Kl = ldsf;
  float* Vl = ldsf + 132 * 65;
  float* Ql = Vl + 132 * 65;
  float* Pl = Ql + 16 * 64;
  __syncthreads();
  for (int e = tid; e < 132 * 8; e += NT) {
    const int j = e >> 3, c = (e & 7) * 8;
    float k[8], v[8];
    if (j < 128) {
      const float* kp = p.in[4] + ((size_t)((l * 128 + b) * 128 + j) * 2 + kvh) * 64 + c;
      const float* vp = p.in[5] + ((size_t)((l * 128 + b) * 128 + j) * 2 + kvh) * 64 + c;
      float4 a = *(const float4*)kp, a2 = *(const float4*)(kp + 4);
      float4 c1 = *(const float4*)vp, c2 = *(const float4*)(vp + 4);
      k[0] = a.x; k[1] = a.y; k[2] = a.z; k[3] = a.w; k[4] = a2.x; k[5] = a2.y; k[6] = a2.z; k[7] = a2.w;
      v[0] = c1.x; v[1] = c1.y; v[2] = c1.z; v[3] = c1.w; v[4] = c2.x; v[5] = c2.y; v[6] = c2.z; v[7] = c2.w;
    } else {
      const size_t row = M_P + b * 4 + (j - 128);
      unpack8(*(const uint4*)(z + row * ZLD + 2304 + kvh * 64 + c), k);
      unpack8(*(const uint4*)(z + row * ZLD + 2432 + kvh * 64 + c), v);
    }
#pragma unroll
    for (int i = 0; i < 8; ++i) { Kl[j * 65 + c + i] = k[i]; Vl[j * 65 + c + i] = v[i]; }
    if (j >= 4) {
      float* ok = p.out + O_SK + ((size_t)((l * 128 + b) * 128 + (j - 4)) * 2 + kvh) * 64 + c;
      float* ov = p.out + O_SV + ((size_t)((l * 128 + b) * 128 + (j - 4)) * 2 + kvh) * 64 + c;
      *(float4*)ok = make_float4(k[0], k[1], k[2], k[3]); *(float4*)(ok + 4) = make_float4(k[4], k[5], k[6], k[7]);
      *(float4*)ov = make_float4(v[0], v[1], v[2], v[3]); *(float4*)(ov + 4) = make_float4(v[4], v[5], v[6], v[7]);
    }
  }
  if (tid < 128) {
    const int row = tid >> 3, c = (tid & 7) * 8;
    const int hl = row >> 2, t = row & 3;
    float q[8];
    unpack8(*(const uint4*)(z + (size_t)(M_P + b * 4 + t) * ZLD + 1792 + (kvh * 4 + hl) * 64 + c), q);
#pragma unroll
    for (int i = 0; i < 8; ++i) Ql[row * 64 + c + i] = q[i];
  }
  __syncthreads();
  const int row = tid >> 5, jl = tid & 31;
  const int t = row & 3, hq = kvh * 4 + (row >> 2);
  float sc[5];
  float mx = -1e30f;
#pragma unroll
  for (int jj = 0; jj < 5; ++jj) {
    const int j = jl + 32 * jj;
    float s = -1e30f;
    if (j < 132 && j > t && j <= t + 128) {
      float a = 0.f;
#pragma unroll 8
      for (int d = 0; d < 64; ++d) a += Ql[row * 64 + d] * Kl[j * 65 + d];
      s = a * 0.125f;
    }
    sc[jj] = s; mx = fmaxf(mx, s);
    __builtin_amdgcn_sched_barrier(0);
  }
#pragma unroll
  for (int o = 16; o >= 1; o >>= 1) mx = fmaxf(mx, __shfl_xor(mx, o, 64));
  const float sink = p.in[20][l * 8 + hq];
  mx = fmaxf(mx, sink);
  float sum = 0.f;
#pragma unroll
  for (int jj = 0; jj < 5; ++jj) { sc[jj] = __expf(sc[jj] - mx); sum += sc[jj]; }
#pragma unroll
  for (int o = 16; o >= 1; o >>= 1) sum += __shfl_xor(sum, o, 64);
  const float rden = 1.f / (sum + __expf(sink - mx));
#pragma unroll
  for (int jj = 0; jj < 5; ++jj) { const int j = jl + 32 * jj; if (j < 136) Pl[row * 136 + j] = sc[jj] * rden; }
  __syncthreads();
  {
    const int d = jl * 2;
    float o0 = 0.f, o1 = 0.f;
#pragma unroll 4
    for (int j = 0; j < 132; ++j) { const float pr = Pl[row * 136 + j]; o0 += pr * Vl[j * 65 + d]; o1 += pr * Vl[j * 65 + d + 1]; }
    if (!dry) *(unsigned*)(z + (size_t)(M_P + b * 4 + t) * ZLD + 1792 + hq * 64 + d) = pack2(o0, o1);
  }
}

__device__ __forceinline__ void phase_convgelu(const Params& p, int l, bool dry = false) {
  u16* cu = (u16*)(p.ws + WS_CU);
  const float* cw = p.in[26] + (size_t)l * 3 * 2816;
  const float* cb = p.in[27] + (size_t)l * 2816;
  for (int it = blockIdx.x; it < 2112; it += gridDim.x) {
    const int tid = opq(threadIdx.x);
    if (tid >= 352) continue;
    const int j0 = tid * 8;
    float w0[8], w1[8], w2[8], bb[8];
#pragma unroll
    for (int i = 0; i < 8; ++i) { w0[i] = cw[j0 + i]; w1[i] = cw[2816 + j0 + i]; w2[i] = cw[5632 + j0 + i]; bb[i] = cb[j0 + i]; }
    float c1[8], c2[8];
    for (int rr = 0; rr < 8; ++rr) {
      const int row = it * 8 + rr;
      const bool prompt = row < M_P;
      int b, t;
      if (prompt) { b = row >> 13; t = row & 8191; } else { b = (row - M_P) >> 2; t = (row - M_P) & 3; }
      if (t == 0) {
        if (prompt) {
#pragma unroll
          for (int i = 0; i < 8; ++i) { c1[i] = 0.f; c2[i] = 0.f; }
        } else {
          const float* st = p.in[6] + (size_t)((l * 128 + b) * 2) * 2816 + j0;
#pragma unroll
          for (int i = 0; i < 8; ++i) { c2[i] = st[i]; c1[i] = st[2816 + i]; }
        }
      } else if (rr == 0) {
        unpack8(*(const uint4*)(cu + (size_t)(row - 1) * 5632 + j0), c1);
        if (t >= 2) unpack8(*(const uint4*)(cu + (size_t)(row - 2) * 5632 + j0), c2);
        else {
#pragma unroll
          for (int i = 0; i < 8; ++i) c2[i] = 0.f;
        }
      }
      float c0[8], up[8], a[8];
      unpack8(*(const uint4*)(cu + (size_t)row * 5632 + j0), c0);
      unpack8(*(const uint4*)(cu + (size_t)row * 5632 + 2816 + j0), up);
#pragma unroll
      for (int i = 0; i < 8; ++i) {
        const float cv = bb[i] + w0[i] * c2[i] + w1[i] * c1[i] + w2[i] * c0[i];
        a[i] = gelu_fast(cv) * up[i];
      }
      if (!dry) *(uint4*)(cu + (size_t)row * 5632 + 2816 + j0) = pack8(a);
      if (prompt && t >= 8190) {
        float* o = p.out + O_PCONV + (size_t)((l * 2 + b) * 2 + (t - 8190)) * 2816 + j0;
        *(float4*)o = make_float4(c0[0], c0[1], c0[2], c0[3]); *(float4*)(o + 4) = make_float4(c0[4], c0[5], c0[6], c0[7]);
      } else if (!prompt && t >= 2) {
        float* o = p.out + O_SCONV + (size_t)((l * 128 + b) * 2 + (t - 2)) * 2816 + j0;
        *(float4*)o = make_float4(c0[0], c0[1], c0[2], c0[3]); *(float4*)(o + 4) = make_float4(c0[4], c0[5], c0[6], c0[7]);
      }
#pragma unroll
      for (int i = 0; i < 8; ++i) { c2[i] = c1[i]; c1[i] = c0[i]; }
    }
  }
}

__device__ __forceinline__ void phase_final(const Params& p) {
  float* X = p.out;
  const float* g = p.in[29];
  for (int it = blockIdx.x; it < 2112; it += gridDim.x) {
    const int tid = opq(threadIdx.x);
    const int lane = tid & 63;
    const int row = it * 8 + (tid >> 6);
    float4 v[4];
    float ss = 0.f;
#pragma unroll
    for (int i = 0; i < 4; ++i) {
      v[i] = *(const float4*)(X + (size_t)row * 1024 + i * 256 + lane * 4);
      if (gridDim.x == 256 && row >= M_P) {
        const u16* partb = (const u16*)(p.ws + WS_DP) + (size_t)(row - M_P) * 1024 + i * 256 + lane * 4;
        for (int k = 0; k < 11; ++k) { const uint2 q = *(const uint2*)(partb + (size_t)k * 512 * 1024);
          v[i].x += __uint_as_float(q.x << 16); v[i].y += __uint_as_float(q.x & 0xFFFF0000u); v[i].z += __uint_as_float(q.y << 16); v[i].w += __uint_as_float(q.y & 0xFFFF0000u); }
      }
      ss += v[i].x * v[i].x + v[i].y * v[i].y + v[i].z * v[i].z + v[i].w * v[i].w;
    }
    ss = wave_sum(ss);
    const float rs = rsqrtf(ss * (1.f / 1024.f) + 1e-6f);
#pragma unroll
    for (int i = 0; i < 4; ++i) {
      const float4 gg = *(const float4*)(g + i * 256 + lane * 4);
      *(float4*)(X + (size_t)row * 1024 + i * 256 + lane * 4) =
          make_float4(v[i].x * rs * gg.x, v[i].y * rs * gg.y, v[i].z * rs * gg.z, v[i].w * rs * gg.w);
    }
  }
}

#define XB_TMO      128
#define XB_XCNT(j)  (256  + 64 * (j))
#define XB_XSUB(j)  (1280 + 64 * (j))
#define XB_XGEN(j)  (2304 + 64 * (j))
#define XB_TOP      3328
#define XB_TOPGEN   3392
#define XCD_BAR_WORDS 3456
#define XB_SPIN_CAP (1u << 18)
#define LAS __attribute__((address_space(3)))

__device__ __forceinline__ unsigned xb_ld(unsigned* p)              { return __hip_atomic_load(p, __ATOMIC_RELAXED, __HIP_MEMORY_SCOPE_AGENT); }
__device__ __forceinline__ unsigned xb_add(unsigned* p, unsigned v) { return __hip_atomic_fetch_add(p, v, __ATOMIC_RELAXED, __HIP_MEMORY_SCOPE_AGENT); }
__device__ __forceinline__ unsigned xb_xcc_id() { return (unsigned)__builtin_amdgcn_s_getreg((3 << 11) | 20) & 0xFu; }
#define XB_SPIN(cond, bar) do { unsigned _sp = 0; while (cond) { __builtin_amdgcn_s_sleep(1); \
    if ((++_sp & 255u) == 0u) { if (xb_ld(&(bar)[XB_TMO])) break; if (_sp > XB_SPIN_CAP) { atomicAdd(&(bar)[XB_TMO], 1u); break; } } } } while (0)

struct XcdBarrier {
    unsigned* bar; unsigned x;
    volatile LAS unsigned* st;
};

__device__ __forceinline__ XcdBarrier xcd_barrier_post(unsigned* bar, volatile LAS unsigned* st) {
    XcdBarrier b; b.bar = bar; b.x = xb_xcc_id(); b.st = st;
    if (threadIdx.x == 0) (void)xb_add(&bar[XB_XCNT(b.x)], 1u);
    return b;
}
__device__ __forceinline__ void xcd_barrier_complete(unsigned* bar, unsigned x, unsigned& nloc, unsigned& nx) {
    const unsigned G = gridDim.x * gridDim.y * gridDim.z;
    unsigned sum, cnt, mine, sp = 0u;
    for (;;) {
        sum = 0u; cnt = 0u; mine = 0u;
#pragma unroll
        for (unsigned j = 0; j < 16; ++j) { const unsigned c = xb_ld(&bar[XB_XCNT(j)]); sum += c; cnt += (c > 0u) ? 1u : 0u; mine = (j == x) ? c : mine; }
        if (sum == G) break;
        __builtin_amdgcn_s_sleep(1);
        if ((++sp & 255u) == 0u) { if (xb_ld(&bar[XB_TMO])) break; if (sp > XB_SPIN_CAP) { atomicAdd(&bar[XB_TMO], 1u); break; } }
    }
    nloc = mine > 0u ? mine : 1u; nx = cnt > 0u ? cnt : 1u;
}

__device__ __forceinline__ void xcd_barrier(const XcdBarrier& b) {
    asm volatile("s_waitcnt vmcnt(0)" ::: "memory");
    __syncthreads();
    if (threadIdx.x == 0) {
        unsigned* bar = b.bar;
        __builtin_amdgcn_s_waitcnt(0);
        unsigned nloc = b.st[0], nx = b.st[1];
        if (nloc == 0u) { xcd_barrier_complete(bar, b.x, nloc, nx); b.st[0] = nloc; b.st[1] = nx; }
        const unsigned old = xb_add(&bar[XB_XSUB(b.x)], 1u);
        const unsigned gen = old / nloc;
        if (old + 1u == (gen + 1u) * nloc) {
            __builtin_amdgcn_fence(__ATOMIC_RELEASE, "agent");
            asm volatile("s_waitcnt vmcnt(0)" ::: "memory");
            const unsigned og = xb_add(&bar[XB_TOP], 1u);
            const unsigned tg = og / nx;
            if (og + 1u == (tg + 1u) * nx) xb_add(&bar[XB_TOPGEN], 1u);
            else XB_SPIN(xb_ld(&bar[XB_TOPGEN]) == tg, bar);
            __builtin_amdgcn_fence(__ATOMIC_ACQUIRE, "agent");
            xb_add(&bar[XB_XGEN(b.x)], 1u);
            asm volatile("s_waitcnt vmcnt(0)" ::: "memory");
        } else {
            XB_SPIN(xb_ld(&bar[XB_XGEN(b.x)]) == gen, bar);
            __builtin_amdgcn_fence(__ATOMIC_ACQUIRE, "agent");
            asm volatile("s_waitcnt vmcnt(0)" ::: "memory");
        }
    }
    __syncthreads();
}

#define WS_BAR 256000000ull
#if COOP
#ifndef SYNC_RPT
#define SYNC_RPT 1
#endif
#define PH_SYNC(idx) do { if ((idx) + 1 < ph_hi && (idx) >= ph_lo) { for (int sr_ = 0; sr_ < SYNC_RPT; ++sr_) xcd_barrier(xb); } } while (0)
#else
#define PH_SYNC(idx) do { } while (0)
#endif
#define PH_ON(idx, bit) (((KMASK >> (bit)) & 1) && ph_lo <= (idx) && (idx) < ph_hi)

__device__ __forceinline__ Params load_params() {
  auto kp0 = __builtin_amdgcn_kernarg_segment_ptr();
  asm volatile("" : "+s"(kp0));
  auto kq = (const __constant__ unsigned long long*)kp0;
  Params p;
#pragma unroll
  for (int i = 0; i < 30; ++i) p.in[i] = (const float*)kq[i];
  p.out = (float*)kq[30];
  p.ws = (unsigned char*)kq[31];
  p.ph_lo = 0; p.ph_hi = 0;
  return p;
}

template <int KMASK, int l>
__device__ __forceinline__ void layer_phases(int ph_lo, int ph_hi, unsigned char* lds_raw, const XcdBarrier& xb) {
  float* ldsf = (float*)lds_raw;
  u16* ldsh = (u16*)lds_raw;
  const int base = l * 12;
  if (PH_ON(base + 0, 0)) { const Params p = load_params(); RPT(0) phase_prep(p, l, 0, ldsf); }
  PH_SYNC(base + 0);
  if (PH_ON(base + 1, 1)) {
    const Params p = load_params();
    EpiInproj E; E.z = (u16*)(p.ws + WS_Z); E.out = p.out; E.l = l;
    RPT(1) run_gemm(lds_raw, (const u16*)(p.ws + WS_H), 1024, (const u16*)(p.ws + WS_WT) + WT_IN, 2560, 1024, E);
  }
  PH_SYNC(base + 1);
  if (PH_ON(base + 2, 2)) {
    const Params p = load_params();
    if (gridDim.x == 256) {
      if (blockIdx.x >= 64) for (int it = (int)blockIdx.x - 64; it < 264; it += 192) rope_item(p, l, it, false);
    } else {
      for (int it = blockIdx.x; it < 264; it += gridDim.x) rope_item(p, l, it, false);
    }
    if (blockIdx.x < 64) rwkv_item(p, l, 2048 + blockIdx.x, ldsf, false);
    {
      const Params p2 = load_params();
      int i0, n;
      if (gridDim.x == 256) { if (blockIdx.x < 64) { i0 = blockIdx.x * 5; n = 5; } else { i0 = 320 + (blockIdx.x - 64) * 9; n = 9; } }
      else { i0 = 0; n = 0; }
      RPT(2) {
        if (gridDim.x == 256) { for (int i = 0; i < n; ++i) rwkv_item2(p2, l, i0 + i, ldsf); }
        else { for (int it = blockIdx.x; it < 2048; it += gridDim.x) rwkv_item2(p2, l, it, ldsf); }
      }
    }
  }
  PH_SYNC(base + 2);
  if (PH_ON(base + 3, 3)) {
    const Params p = load_params();
    if (blockIdx.x < 16) { RPT(3) rwkv_scan(p, l, blockIdx.x, ldsf, DRY(3)); }
    else {
      RPT(15) for (int it = blockIdx.x - 16; it < 512; it += gridDim.x - 16) {
        if (it < 256) attn_prompt(p, l, it, ldsh, DRY(15)); else attn_sample(p, l, it - 256, ldsf, DRY(15));
      }
      if (gridDim.x == 256 && blockIdx.x < 32) {
        EpiSig Es; Es.sr = (u16*)(p.ws + WS_SG); Es.sa = (u16*)(p.ws + WS_SG) + (size_t)512 * 1024;
        run_gemm_ex(lds_raw, (const u16*)(p.ws + WS_H) + (size_t)M_P * 1024, 1024, (const u16*)(p.ws + WS_WT) + WT_G, 1024, 512, 2048, 1024, 16,
                    (int)blockIdx.x - 16, Es);
      }
    }
  }
  PH_SYNC(base + 3);
  if (PH_ON(base + 4, 4)) {
    const Params p = load_params();
    RPT(4) for (int it = blockIdx.x * 4; it < 2048; it += gridDim.x * 4) rwkv_out4(p, l, it, ldsf);
  }
  PH_SYNC(base + 4);
  if (PH_ON(base + 5, 5)) {
    const Params p = load_params();
    EpiStoreBf16 E1; E1.O = (u16*)(p.ws + WS_T1); E1.ldc = 1024; E1.rowoff = 0;
    EpiStoreBf16 E2; E2.O = (u16*)(p.ws + WS_T2); E2.ldc = 1024; E2.rowoff = 0;
    const u16* zA = (const u16*)(p.ws + WS_Z);
    const u16* Wr = (const u16*)(p.ws + WS_WT) + WT_BRA;
    const u16* Wa = (const u16*)(p.ws + WS_WT) + WT_BRB;
    RPT(5) {
      if (gridDim.x == 256) {
        run_gemm_ex(lds_raw, zA, ZLD, Wr, 512, M_P, 1024, 512, 256, (int)blockIdx.x, E1);
        run_gemm_ex(lds_raw, zA + 1792, ZLD, Wa, 512, M_P, 1024, 512, 256, (int)blockIdx.x, E2);
        const int wh = (blockIdx.x >> 3) & 1, ks = (blockIdx.x >> 4) & 1;
        EpiStoreBf16 E3; E3.ldc = 1024; E3.rowoff = 0; E3.O = (u16*)(p.ws + WS_SG) + (size_t)(2 + wh * 2 + ks) * 512 * 1024;
        run_gemm_ex(lds_raw, zA + (size_t)M_P * ZLD + (wh ? 1792 : 0) + ks * 256, ZLD, (wh ? Wa : Wr) + ks * 256, 512, 512, 1024, 256, 8,
                    (blockIdx.x < 32) ? (int)(blockIdx.x & 7) : -1, E3);

      } else {
        run_gemm(lds_raw, zA, ZLD, Wr, 1024, 512, E1);
        run_gemm(lds_raw, zA + 1792, ZLD, Wa, 1024, 512, E2);
      }
    }
  }
  PH_SYNC(base + 5);
  if (PH_ON(base + 6, 6)) {
    const Params p = load_params();
    EpiMerge E; E.t1 = (const u16*)(p.ws + WS_T1); E.t2 = (const u16*)(p.ws + WS_T2); E.mg = (u16*)(p.ws + WS_MG);
    RPT(6) {
      if (gridDim.x == 256) {
        run_gemm_ex(lds_raw, (const u16*)(p.ws + WS_H), 1024, (const u16*)(p.ws + WS_WT) + WT_G, 1024, M_P, 2048, 1024, 256, (int)blockIdx.x, E);
        const int gid = blockIdx.x * NT + opq(threadIdx.x);
        if (gid < 65536) {
          const int r_ = gid >> 7, c_ = (gid & 127) * 8;
          const size_t offs = (size_t)r_ * 1024 + c_, offm = (size_t)(M_P + r_) * 1024 + c_;
          float a[8], b[8], gr[8], ga[8], o[8];
          {
            const u16* pb = (const u16*)(p.ws + WS_SG) + (size_t)2 * 512 * 1024 + offs;
            float a1[8], b1[8];
            unpack8(*(const uint4*)pb, a); unpack8(*(const uint4*)(pb + (size_t)512 * 1024), a1);
            unpack8(*(const uint4*)(pb + (size_t)2 * 512 * 1024), b); unpack8(*(const uint4*)(pb + (size_t)3 * 512 * 1024), b1);
#pragma unroll
            for (int i = 0; i < 8; ++i) { a[i] += a1[i]; b[i] += b1[i]; }
          }
          unpack8(*(const uint4*)((const u16*)(p.ws + WS_SG) + offs), gr);
          unpack8(*(const uint4*)((const u16*)(p.ws + WS_SG) + (size_t)512 * 1024 + offs), ga);
#pragma unroll
          for (int i = 0; i < 8; ++i) o[i] = gr[i] * a[i] + ga[i] * b[i];
          *(uint4*)(E.mg + offm) = pack8(o);
        }
      } else {
        run_gemm(lds_raw, (const u16*)(p.ws + WS_H), 1024, (const u16*)(p.ws + WS_WT) + WT_G, 2048, 1024, E);
      }
    }
  }
  PH_SYNC(base + 6);
  if (PH_ON(base + 7, 7)) {
    const Params p = load_params();
    EpiResid E; E.X = p.out;
    RPT(7) {
      E.dry = DRY(7); E.X = p.out; E.pbf = nullptr;
      if (gridDim.x == 256) {
        E.atomic = false; E.rowoff = 0;
        run_gemm_ex(lds_raw, (const u16*)(p.ws + WS_MG), 1024, (const u16*)(p.ws + WS_WT) + WT_OUT, 1024, M_P, 1024, 1024, 256, (int)blockIdx.x, E);
        const int ks = blockIdx.x >> 3;
        E.atomic = true; E.rowoff = 0; E.X = (float*)(p.ws + WS_T1) + (size_t)ks * 512 * 1024;
        run_gemm_ex(lds_raw, (const u16*)(p.ws + WS_MG) + (size_t)M_P * 1024 + ks * 256, 1024, (const u16*)(p.ws + WS_WT) + WT_OUT + ks * 256, 1024,
                    512, 1024, 256, 8, (blockIdx.x < 32) ? (int)(blockIdx.x & 7) : -1, E);
      } else {
        E.atomic = false; E.rowoff = 0;
        run_gemm(lds_raw, (const u16*)(p.ws + WS_MG), 1024, (const u16*)(p.ws + WS_WT) + WT_OUT, 1024, 1024, E);
      }
    }
  }
  PH_SYNC(base + 7);
  if (PH_ON(base + 8, 8)) { const Params p = load_params(); RPT(8) phase_prep(p, l, 1, ldsf); }
  PH_SYNC(base + 8);
  if (PH_ON(base + 9, 9)) {
    const Params p = load_params();
    EpiFfnIn E; E.cu = (u16*)(p.ws + WS_CU);
    RPT(9) run_gemm(lds_raw, (const u16*)(p.ws + WS_H), 1024, (const u16*)(p.ws + WS_WTF) + WT_FIN, 5632, 1024, E);
  }
  PH_SYNC(base + 9);
  if (PH_ON(base + 10, 10)) { const Params p = load_params(); RPT(10) phase_convgelu(p, l, DRY(10)); }
  PH_SYNC(base + 10);
  if (PH_ON(base + 11, 11)) {
    const Params p = load_params();
    EpiResid E; E.X = p.out;
    RPT(11) {
      E.dry = DRY(11); E.X = p.out; E.pbf = nullptr;
      const u16* Aa = (const u16*)(p.ws + WS_CU) + 2816;
      const u16* Bd = (const u16*)(p.ws + WS_WTF) + WT_FDN;
      if (gridDim.x == 256) {
        E.atomic = false; E.rowoff = 0;
        run_gemm_ex(lds_raw, Aa, 5632, Bd, 2816, M_P, 1024, 2816, 256, (int)blockIdx.x, E);
        const int ks = blockIdx.x >> 3;
        E.atomic = true; E.rowoff = 0; E.X = nullptr; E.pbf = (u16*)(p.ws + WS_DP) + (size_t)ks * 512 * 1024;
        run_gemm_ex(lds_raw, Aa + (size_t)M_P * 5632 + ks * 256, 5632, Bd + ks * 256, 2816, 512, 1024, 256, 8, (blockIdx.x < 88) ? (int)(blockIdx.x & 7) : -1, E);
      } else {
        E.atomic = false; E.rowoff = 0;
        run_gemm(lds_raw, Aa, 5632, Bd, 1024, 2816, E);
      }
    }
  }
  PH_SYNC(base + 11);
}

template <int KMASK>
__global__ void __launch_bounds__(NT) fwd_kernel(Params pin) {
  extern __shared__ __attribute__((aligned(16))) unsigned char lds_raw[];
  const int ph_lo = pin.ph_lo, ph_hi = pin.ph_hi;
  XcdBarrier xb;
  {
    volatile LAS unsigned* st = (volatile LAS unsigned*)(lds_raw + (LDS_BYTES - 16));
    if (threadIdx.x < 2) st[threadIdx.x] = 0u;
    __syncthreads();
    xb = xcd_barrier_post((unsigned*)(pin.ws + WS_BAR), st);
  }
  if (ph_hi > 100000) cg::this_grid().sync();
  layer_phases<KMASK, 0>(ph_lo, ph_hi, lds_raw, xb);
  layer_phases<KMASK, 1>(ph_lo, ph_hi, lds_raw, xb);
  if (PH_ON(NPH - 1, 12)) { const Params p = load_params(); phase_final(p); }
}

extern "C" void kernel_launch(void* const* d_in, const int* in_sizes, int n_in, void* d_out, int out_size, void* d_ws,
                              size_t ws_size, hipStream_t stream) {
  static int grid = 0;
  if (grid == 0) {
    int dev = 0, cus = 0;
    (void)hipGetDevice(&dev);
    (void)hipDeviceGetAttribute(&cus, hipDeviceAttributeMultiprocessorCount, dev);
    grid = cus > 0 ? cus : 256;
    (void)hipFuncSetAttribute((const void*)fwd_kernel<PHMASK>, hipFuncAttributeMaxDynamicSharedMemorySize, LDS_BYTES);
    (void)hipGetLastError();
  }
  Params p{};
  for (int i = 0; i < 30; ++i) p.in[i] = (const float*)d_in[i];
  p.out = (float*)d_out;
  p.ws = (unsigned char*)d_ws;
#if COOP
  (void)hipMemsetAsync((unsigned char*)d_ws + WS_BAR, 0, XCD_BAR_WORDS * 4, stream);
  p.ph_lo = 0; p.ph_hi = NPH;
  void* args[] = {&p};
  hipError_t e = hipLaunchCooperativeKernel((const void*)fwd_kernel<PHMASK>, dim3(grid), dim3(NT), args, LDS_BYTES, stream);
  if (e != hipSuccess) fprintf(stderr, "cooperative launch failed: %s (grid %d)\n", hipGetErrorString(e), grid);
#else
  for (int ph = 0; ph < NPH; ++ph) {
    p.ph_lo = ph; p.ph_hi = ph + 1;
    hipLaunchKernelGGL(fwd_kernel<PHMASK>, dim3(grid), dim3(NT), LDS_BYTES, stream, p);
  }
#endif
}
```
